# Optimizing an MI355X kernel written in HIP

```python
import jax
import jax.numpy as jnp
from jax import lax
import numpy as np

D_MODEL = 1024
BATCH = 8
SEQ = 4096
DEPTH = 2

CTX_LEN = 256
GRID_W = 64
HEAD_DIM = 64
NA_WIDTH = D_MODEL // 2
NA_HEADS = NA_WIDTH // HEAD_DIM
NA_WIN_ROWS = 8
NA_WIN_COLS = 16
NA_QCB = 16
NA_KCB = 32
RW_WIDTH = D_MODEL // 4
RW_HEADS = RW_WIDTH // HEAD_DIM
RW_DECAY_RANK = 64
RW_A_RANK = 64
RW_GATE_RANK = 128
RW_LORA = RW_DECAY_RANK + RW_A_RANK + RW_GATE_RANK
RW_IN = 3 * RW_WIDTH + 2 * RW_LORA
RW_GN_EPS = 64e-5
CV_WIDTH = D_MODEL // 4
CV_CONV_LEN = 31
MIX_WIDTH = NA_WIDTH + RW_WIDTH + CV_WIDTH
IN_WIDTH = 3 * NA_WIDTH + RW_IN + 2 * CV_WIDTH
D_FF = 2816
N_EXPERTS = 8
TOP_K = 2
D_FF_EXPERT = 3584
MOE_BLOCK = 128
N_DENSE_LAYERS = (DEPTH + 1) // 2
N_MOE_LAYERS = DEPTH // 2
RMS_EPS = 1e-6
LN_EPS = 1e-5

kernel_name = 'hybrid_natten_rwkv7_conformer_moe_dit'


def _rmsnorm(x, g):
    xf = x.astype(jnp.float32)
    y = xf * lax.rsqrt(jnp.mean(xf * xf, axis=-1, keepdims=True) + RMS_EPS)
    return (y * g.astype(jnp.float32)).astype(x.dtype)


def _layernorm(x, g, b):
    xf = x.astype(jnp.float32)
    mu = jnp.mean(xf, axis=-1, keepdims=True)
    var = jnp.mean(jnp.square(xf - mu), axis=-1, keepdims=True)
    y = (xf - mu) * lax.rsqrt(var + LN_EPS)
    return (y * g.astype(jnp.float32) + b.astype(jnp.float32)).astype(x.dtype)


def _modulate(h, shift, scale):
    return h * (1 + scale) + shift


def _swiglu(h, w_gate, w_up, w_down):
    return (jax.nn.silu(h @ w_gate) * (h @ w_up)) @ w_down


def _moe_swiglu(h, router, w_gate, w_up, w_down):
    shp = h.shape
    d = shp[-1]
    xt = h.reshape(-1, d)
    n_tok = xt.shape[0]
    n_asg = n_tok * TOP_K
    logits = (xt @ router).astype(jnp.float32)
    top_logit, top_e = lax.top_k(logits, TOP_K)
    gates = jax.nn.softmax(top_logit, axis=-1)
    flat_e = top_e.reshape(-1)
    flat_tok = jnp.arange(n_asg, dtype=jnp.int32) // TOP_K
    order = jnp.argsort(flat_e)
    s_e = flat_e[order]
    s_tok = flat_tok[order]
    s_gate = gates.reshape(-1)[order]
    counts = jnp.bincount(flat_e, length=N_EXPERTS)
    padded = (counts + MOE_BLOCK - 1) // MOE_BLOCK * MOE_BLOCK
    pad_end = jnp.cumsum(padded)
    pad_start = pad_end - padded
    start = jnp.cumsum(counts) - counts
    dest = pad_start[s_e] + jnp.arange(n_asg, dtype=jnp.int32) - start[s_e]
    n_blocks = (n_asg + MOE_BLOCK - 1) // MOE_BLOCK + N_EXPERTS
    slot_tok = jnp.full((n_blocks * MOE_BLOCK,), n_tok, jnp.int32).at[dest].set(s_tok)
    block_e = jnp.minimum(jnp.searchsorted(pad_end, jnp.arange(n_blocks) * MOE_BLOCK, side='right'), N_EXPERTS - 1)
    x_pad = jnp.concatenate([xt, jnp.zeros((1, d), xt.dtype)], axis=0)
    xb = x_pad[slot_tok].reshape(n_blocks, MOE_BLOCK, d)

    def expert_block(args):
        x_blk, e = args
        return _swiglu(x_blk, w_gate[e], w_up[e], w_down[e])

    yb = lax.map(expert_block, (xb, block_e)).reshape(-1, d)
    y = jnp.zeros_like(xt).at[s_tok].add(yb[dest] * s_gate[:, None].astype(xt.dtype))
    return y.reshape(shp)


def _na_column_layout():
    n_cb = GRID_W // NA_QCB
    q_cols = np.arange(GRID_W).reshape(n_cb, NA_QCB)
    blk_start = np.clip(np.arange(n_cb) * NA_QCB - NA_WIN_COLS // 2, 0, GRID_W - NA_KCB)
    key_cols = blk_start[:, None] + np.arange(NA_KCB)[None, :]
    win_start = np.clip(q_cols - NA_WIN_COLS // 2, 0, GRID_W - NA_WIN_COLS)
    kcol = key_cols[:, None, :]
    ws = win_start[:, :, None]
    mask = (kcol >= ws) & (kcol < ws + NA_WIN_COLS)
    rel_idx = np.clip(kcol - q_cols[:, :, None] + NA_WIN_COLS - 1, 0, 2 * NA_WIN_COLS - 2)
    return key_cols, mask, rel_idx


def _neighbourhood_attention(q, k, v, kc, vc, rpb):
    B, N, H, dh = q.shape
    rows = N // GRID_W
    kr = min(NA_WIN_ROWS, rows)
    n_cb = GRID_W // NA_QCB
    key_cols, col_mask, rel_idx = _na_column_layout()
    qg = (q * dh ** -0.5).reshape(B, rows, GRID_W, H, dh).transpose(1, 0, 3, 2, 4)
    kg = k.reshape(B, rows, GRID_W, H, dh).transpose(0, 3, 1, 2, 4)
    vg = v.reshape(B, rows, GRID_W, H, dh).transpose(0, 3, 1, 2, 4)
    kct = kc.transpose(0, 2, 1, 3)
    vct = vc.transpose(0, 2, 1, 3)
    rpb_cols = rpb[:, :, rel_idx]
    n_win = kr * NA_KCB

    def one_row(args):
        i, qi = args
        rs = jnp.clip(i - kr // 2, 0, rows - kr)
        ks = lax.dynamic_slice_in_dim(kg, rs, kr, axis=2)[:, :, :, key_cols]
        vs = lax.dynamic_slice_in_dim(vg, rs, kr, axis=2)[:, :, :, key_cols]
        qb = qi.reshape(B, H, n_cb, NA_QCB, dh)
        s_win = jnp.einsum('bhcqd,bhrckd->bhcqrk', qb, ks).astype(jnp.float32)
        bias = lax.dynamic_slice_in_dim(rpb_cols, rs - i + NA_WIN_ROWS - 1, kr, axis=1)
        bias = bias.transpose(0, 2, 3, 1, 4).astype(jnp.float32)
        s_win = jnp.where(col_mask[:, :, None, :], s_win + bias, -jnp.inf)
        s_ctx = jnp.einsum('bhcqd,bhld->bhcql', qb, kct).astype(jnp.float32)
        s = jnp.concatenate([s_win.reshape(B, H, n_cb, NA_QCB, n_win), s_ctx], axis=-1)
        p = jax.nn.softmax(s, axis=-1).astype(v.dtype)
        p_win = p[..., :n_win].reshape(B, H, n_cb, NA_QCB, kr, NA_KCB)
        o = (jnp.einsum('bhcqrk,bhrckd->bhcqd', p_win, vs)
             + jnp.einsum('bhcql,bhld->bhcqd', p[..., n_win:], vct))
        return o.reshape(B, H, GRID_W, dh)

    out = lax.map(one_row, (jnp.arange(rows), qg))
    return out.transpose(1, 0, 3, 2, 4).reshape(B, N, H * dh)


def _context_attention(q, k, v):
    B, L, H, dh = q.shape
    s = jnp.einsum('blhd,bmhd->bhlm', q, k).astype(jnp.float32) * (dh ** -0.5)
    p = jax.nn.softmax(s, axis=-1).astype(v.dtype)
    return jnp.einsum('bhlm,bmhd->blhd', p, v).reshape(B, L, H * dh)


def _token_shift(u, mu_prev, mu_next):
    zero = jnp.zeros_like(u[:, :1])
    prev = jnp.concatenate([zero, u[:, :-1]], axis=1)
    nxt = jnp.concatenate([u[:, 1:], zero], axis=1)
    return u + mu_prev * (prev - u) + mu_next * (nxt - u)


def _head_norm(y, g, b):
    mu = jnp.mean(y, axis=-1, keepdims=True)
    var = jnp.mean(jnp.square(y - mu), axis=-1, keepdims=True)
    yn = (y - mu) * lax.rsqrt(var + RW_GN_EPS)
    return yn.reshape(y.shape[0], y.shape[1], -1) * g + b


def _rwkv7_scan(r, w, k, v, z, b):
    G, H, dh = r.shape[1:]

    def step(S, inp):
        r_t, w_t, k_t, v_t, z_t, b_t = inp
        s_z = jnp.einsum('ghvk,ghk->ghv', S, z_t)
        S = S * w_t[:, :, None, :] + s_z[..., None] * b_t[:, :, None, :] + v_t[..., None] * k_t[:, :, None, :]
        return S, jnp.einsum('ghvk,ghk->ghv', S, r_t)

    _, y = lax.scan(step, jnp.zeros((G, H, dh, dh), jnp.float32), (r, w, k, v, z, b))
    return y


def _bi_rwkv7(ul, uc, mu_prev, mu_next, w0, w2, a0, a2, g2, k_k, k_a, r_k, gn_g, gn_b, need_ctx_out):
    B, N, _ = ul.shape
    L = uc.shape[1]
    T = L + N
    u = jnp.concatenate([_token_shift(uc, mu_prev, mu_next), _token_shift(ul, mu_prev, mu_next)],
                        axis=1).astype(jnp.float32)
    heads = lambda t: t.reshape(B, T, RW_HEADS, HEAD_DIM)
    r = u[..., :RW_WIDTH]
    k = u[..., RW_WIDTH:2 * RW_WIDTH]
    v = u[..., 2 * RW_WIDTH:3 * RW_WIDTH]
    kk = heads(k * k_k)
    kk = kk * lax.rsqrt(jnp.sum(kk * kk, axis=-1, keepdims=True) + 1e-12)
    rh, vh = heads(r), heads(v)
    per_dir = []
    for d in range(2):
        lo = 3 * RW_WIDTH + d * RW_LORA
        wd = u[..., lo:lo + RW_DECAY_RANK]
        ad = u[..., lo + RW_DECAY_RANK:lo + RW_DECAY_RANK + RW_A_RANK]
        gd = u[..., lo + RW_DECAY_RANK + RW_A_RANK:lo + RW_LORA]
        log_w = -jax.nn.softplus(-(w0[d] + jnp.tanh(wd) @ w2[d])) - 0.5
        decay = jnp.exp(-jnp.exp(log_w))
        a = jax.nn.sigmoid(a0[d] + ad @ a2[d])
        g = jax.nn.sigmoid(gd) @ g2[d]
        kd = heads(k * (1.0 + (a - 1.0) * k_a))
        per_dir.append((heads(decay), kd, kk * heads(a), g))
    perm = np.concatenate([np.arange(L)[::-1], L + np.arange(N)[::-1]])

    def stack(t_f, t_b):
        return jnp.concatenate([t_f, t_b[:, perm]], axis=0).swapaxes(0, 1)

    (w_f, k_f, b_f, _), (w_b, k_b, b_b, _) = per_dir
    y = _rwkv7_scan(stack(rh, rh), stack(w_f, w_b), stack(k_f, k_b), stack(vh, vh),
                    stack(-kk, -kk), stack(b_f, b_b)).swapaxes(0, 1)
    t0 = 0 if need_ctx_out else L
    y_dirs = (y[:B, t0:], y[B:][:, perm][:, t0:])
    outs = []
    for (_, kd, _, g), yd in zip(per_dir, y_dirs):
        bonus = (jnp.sum(rh * kd * r_k, axis=-1, keepdims=True) * vh)[:, t0:].reshape(B, T - t0, RW_WIDTH)
        outs.append((_head_norm(yd, gn_g, gn_b) + bonus) * g[:, t0:])
    out = (outs[0] + outs[1]).astype(ul.dtype)
    out_l = out[:, L - t0:]
    out_c = out[:, :L] if need_ctx_out else None
    return out_l, out_c


def _conformer_conv(u, dw_w, dw_b, ln_g, ln_b):
    h = u[..., :CV_WIDTH] * jax.nn.sigmoid(u[..., CV_WIDTH:])
    h = lax.conv_general_dilated(h, dw_w[:, None, :], (1,), [(CV_CONV_LEN // 2, CV_CONV_LEN // 2)],
                                 dimension_numbers=('NWC', 'WIO', 'NWC'),
                                 feature_group_count=CV_WIDTH) + dw_b
    return jax.nn.silu(_layernorm(h, ln_g, ln_b))


def _mixers(hl, hc, w_in, w_out, na_rpb, rw_mu_prev, rw_mu_next, rw_w0, rw_w2, rw_a0, rw_a2, rw_g2,
            rw_k_k, rw_k_a, rw_r_k, rw_gn_g, rw_gn_b, cv_dw_w, cv_dw_b, cv_ln_g, cv_ln_b, need_ctx_out):
    o_rw = 3 * NA_WIDTH
    o_cv = o_rw + RW_IN
    heads = lambda t: t.reshape(t.shape[0], t.shape[1], NA_HEADS, HEAD_DIM)
    pl = hl @ w_in
    c_off = 0 if need_ctx_out else NA_WIDTH
    pc = hc @ (w_in if need_ctx_out else w_in[:, NA_WIDTH:o_cv])
    kc = heads(pc[..., NA_WIDTH - c_off:2 * NA_WIDTH - c_off])
    vc = heads(pc[..., 2 * NA_WIDTH - c_off:o_rw - c_off])
    na_l = _neighbourhood_attention(heads(pl[..., :NA_WIDTH]), heads(pl[..., NA_WIDTH:2 * NA_WIDTH]),
                                    heads(pl[..., 2 * NA_WIDTH:o_rw]), kc, vc, na_rpb)
    rw_l, rw_c = _bi_rwkv7(pl[..., o_rw:o_cv], pc[..., o_rw - c_off:o_cv - c_off], rw_mu_prev, rw_mu_next,
                           rw_w0, rw_w2, rw_a0, rw_a2, rw_g2, rw_k_k, rw_k_a, rw_r_k, rw_gn_g, rw_gn_b,
                           need_ctx_out)
    cv_l = _conformer_conv(pl[..., o_cv:], cv_dw_w, cv_dw_b, cv_ln_g, cv_ln_b)
    out_l = jnp.concatenate([na_l, rw_l, cv_l], axis=-1) @ w_out
    if not need_ctx_out:
        return out_l, None
    na_c = _context_attention(heads(pc[..., :NA_WIDTH]), kc, vc)
    cv_c = _conformer_conv(pc[..., o_cv:], cv_dw_w, cv_dw_b, cv_ln_g, cv_ln_b)
    out_c = jnp.concatenate([na_c, rw_c, cv_c], axis=-1) @ w_out
    return out_l, out_c


def setup_inputs(seed: int = 0) -> dict:
    key = jax.random.key(seed)
    ks = iter(jax.random.split(key, 40))
    f32 = jnp.float32

    def nrm(shape, std):
        return jax.random.normal(next(ks), shape, f32) * std

    def uni(shape, lo, hi):
        return jax.random.uniform(next(ks), shape, f32, lo, hi)

    D = D_MODEL
    return {
        'x': nrm((BATCH, SEQ, D), 1.0),
        'c': nrm((BATCH, D), 1.0),
        'ctx': nrm((BATCH, CTX_LEN, D), 1.0),
        'c_ctx': nrm((D,), 1.0),
        'norm1_g': 1.0 + nrm((DEPTH, D), 0.02),
        'norm2_g': 1.0 + nrm((DEPTH, D), 0.02),
        'mod_w': nrm((DEPTH, D, 6 * D), 0.5 * D ** -0.5),
        'mod_b': nrm((DEPTH, 6 * D), 0.02),
        'w_in': nrm((DEPTH, D, IN_WIDTH), D ** -0.5),
        'w_out': nrm((DEPTH, MIX_WIDTH, D), MIX_WIDTH ** -0.5),
        'na_rpb': nrm((DEPTH, NA_HEADS, 2 * NA_WIN_ROWS - 1, 2 * NA_WIN_COLS - 1), 0.1),
        'rw_mu_prev': uni((DEPTH, RW_IN), 0.0, 0.5),
        'rw_mu_next': uni((DEPTH, RW_IN), 0.0, 0.5),
        'rw_w0': uni((DEPTH, 2, RW_WIDTH), -6.0, 1.0),
        'rw_w2': nrm((DEPTH, 2, RW_DECAY_RANK, RW_WIDTH), 0.5 * RW_DECAY_RANK ** -0.5),
        'rw_a0': nrm((DEPTH, 2, RW_WIDTH), 0.3),
        'rw_a2': nrm((DEPTH, 2, RW_A_RANK, RW_WIDTH), 0.5 * RW_A_RANK ** -0.5),
        'rw_g2': nrm((DEPTH, 2, RW_GATE_RANK, RW_WIDTH), RW_GATE_RANK ** -0.5),
        'rw_k_k': 0.85 + nrm((DEPTH, RW_WIDTH), 0.02),
        'rw_k_a': 1.0 + nrm((DEPTH, RW_WIDTH), 0.02),
        'rw_r_k': nrm((DEPTH, RW_HEADS, HEAD_DIM), 0.1),
        'rw_gn_g': 1.0 + nrm((DEPTH, RW_WIDTH), 0.02),
        'rw_gn_b': nrm((DEPTH, RW_WIDTH), 0.02),
        'cv_dw_w': nrm((DEPTH, CV_CONV_LEN, CV_WIDTH), CV_CONV_LEN ** -0.5),
        'cv_dw_b': nrm((DEPTH, CV_WIDTH), 0.02),
        'cv_ln_g': 1.0 + nrm((DEPTH, CV_WIDTH), 0.02),
        'cv_ln_b': nrm((DEPTH, CV_WIDTH), 0.02),
        'ffn_w_gate': nrm((N_DENSE_LAYERS, D, D_FF), D ** -0.5),
        'ffn_w_up': nrm((N_DENSE_LAYERS, D, D_FF), D ** -0.5),
        'ffn_w_down': nrm((N_DENSE_LAYERS, D_FF, D), D_FF ** -0.5),
        'moe_router': nrm((N_MOE_LAYERS, D, N_EXPERTS), D ** -0.5),
        'moe_w_gate': nrm((N_MOE_LAYERS, N_EXPERTS, D, D_FF_EXPERT), D ** -0.5),
        'moe_w_up': nrm((N_MOE_LAYERS, N_EXPERTS, D, D_FF_EXPERT), D ** -0.5),
        'moe_w_down': nrm((N_MOE_LAYERS, N_EXPERTS, D_FF_EXPERT, D), D_FF_EXPERT ** -0.5),
        'final_g': 1.0 + nrm((D,), 0.02),
    }


def reference(x, c, ctx, c_ctx, norm1_g, norm2_g, mod_w, mod_b, w_in, w_out, na_rpb, rw_mu_prev, rw_mu_next,
              rw_w0, rw_w2, rw_a0, rw_a2, rw_g2, rw_k_k, rw_k_a, rw_r_k, rw_gn_g, rw_gn_b, cv_dw_w, cv_dw_b,
              cv_ln_g, cv_ln_b, ffn_w_gate, ffn_w_up, ffn_w_down, moe_router, moe_w_gate, moe_w_up, moe_w_down,
              final_g):
    c_sil = jax.nn.silu(c)
    cc_sil = jax.nn.silu(c_ctx)
    xl, xc = x, ctx
    for layer in range(DEPTH):
        need_ctx = layer < DEPTH - 1
        sh1, sc1, g1, sh2, sc2, g2 = jnp.split((c_sil @ mod_w[layer] + mod_b[layer])[:, None, :], 6, axis=-1)
        csh1, csc1, cg1, csh2, csc2, cg2 = jnp.split(cc_sil @ mod_w[layer] + mod_b[layer], 6, axis=-1)
        hl = _modulate(_rmsnorm(xl, norm1_g[layer]), sh1, sc1)
        hc = _modulate(_rmsnorm(xc, norm1_g[layer]), csh1, csc1)
        mix_l, mix_c = _mixers(hl, hc, w_in[layer], w_out[layer], na_rpb[layer], rw_mu_prev[layer],
                               rw_mu_next[layer], rw_w0[layer], rw_w2[layer], rw_a0[layer], rw_a2[layer],
                               rw_g2[layer], rw_k_k[layer], rw_k_a[layer], rw_r_k[layer], rw_gn_g[layer],
                               rw_gn_b[layer], cv_dw_w[layer], cv_dw_b[layer], cv_ln_g[layer], cv_ln_b[layer],
                               need_ctx)
        xl = xl + g1 * mix_l
        hl = _modulate(_rmsnorm(xl, norm2_g[layer]), sh2, sc2)
        j = layer // 2
        if layer % 2 == 0:
            xl = xl + g2 * _swiglu(hl, ffn_w_gate[j], ffn_w_up[j], ffn_w_down[j])
        else:
            xl = xl + g2 * _moe_swiglu(hl, moe_router[j], moe_w_gate[j], moe_w_up[j], moe_w_down[j])
        if need_ctx:
            xc = xc + cg1 * mix_c
            hc = _modulate(_rmsnorm(xc, norm2_g[layer]), csh2, csc2)
            if layer % 2 == 0:
                xc = xc + cg2 * _swiglu(hc, ffn_w_gate[j], ffn_w_up[j], ffn_w_down[j])
            else:
                xc = xc + cg2 * _moe_swiglu(hc, moe_router[j], moe_w_gate[j], moe_w_up[j], moe_w_down[j])
    return _rmsnorm(xl, final_g)
```

```cpp
#include <hip/hip_runtime.h>
#include <stdint.h>
#include <stdio.h>

#ifndef MK_MASK
#define MK_MASK 0xFFFFFFFFu
#endif
#define MKB(k) (((MK_MASK) >> (k)) & 1u)
#ifndef MK_LAST
#define MK_LAST 99
#endif
#ifndef MK_ONE_LAUNCH
#define MK_ONE_LAUNCH 0
#endif

#define LAS __attribute__((address_space(3)))
typedef unsigned short bf16_t;
typedef _Float16 f16_t;
typedef short bf16x8 __attribute__((ext_vector_type(8)));
typedef float f32x4 __attribute__((ext_vector_type(4)));
typedef float f32x2 __attribute__((ext_vector_type(2)));
typedef unsigned u32x4 __attribute__((ext_vector_type(4)));
typedef unsigned u32x2 __attribute__((ext_vector_type(2)));
typedef f16_t f16x4 __attribute__((ext_vector_type(4)));
typedef f16_t f16x8 __attribute__((ext_vector_type(8)));

constexpr int D = 1024, NB = 8, SEQ = 4096, CTXL = 256, TT = CTXL + SEQ;
constexpr int NLAT = NB * SEQ, NCTX = NB * CTXL, NROW = NLAT + NCTX;
constexpr int INW = 3328, DFF = 2816, DFE = 3584, NEXP = 8;
constexpr int O_Q = 0, O_K = 512, O_V = 1024, O_RW = 1536, O_CV = 2816;
constexpr int MODW = 6 * D;
constexpr int NTHREADS = 512, NWAVES = 8;
constexpr int LDS_BYTES = 160 * 1024;
constexpr int LDS_MISC = LDS_BYTES - 256;

constexpr size_t al256(size_t x) { return (x + 255) & ~(size_t)255; }
constexpr size_t WS_CTL   = 0;
constexpr size_t CTL_BYTES = 65536;
constexpr size_t WS_MODV  = WS_CTL + CTL_BYTES;
constexpr size_t WS_BTIN  = al256(WS_MODV + (size_t)2 * 9 * MODW * 4);
constexpr size_t WS_BTOUT = al256(WS_BTIN + (size_t)2 * INW * D * 2);
constexpr size_t WS_BTGU  = al256(WS_BTOUT + (size_t)2 * D * D * 2);
constexpr size_t WS_BTDN  = al256(WS_BTGU + (size_t)2 * DFF * D * 2);
constexpr size_t WS_MOE   = al256(WS_BTDN + (size_t)D * DFF * 2);
constexpr size_t MOE_GU_BYTES = (size_t)2 * DFE * D * 2, MOE_DN_BYTES = (size_t)D * DFE * 2, MOE_E_BYTES = MOE_GU_BYTES + MOE_DN_BYTES;
constexpr size_t WS_SH    = WS_MOE;
constexpr size_t SH_BYTES = (size_t)NB * 4 * TT * 192 * 2;
constexpr size_t WS_SD    = WS_SH + SH_BYTES;
constexpr size_t WS_XC    = al256(WS_MOE + (size_t)NEXP * MOE_E_BYTES);
constexpr size_t WS_HL    = al256(WS_XC + (size_t)NCTX * D * 4);
constexpr size_t WS_Y     = WS_HL;
constexpr size_t WS_PL    = al256(WS_HL + (size_t)NROW * D * 2);
constexpr size_t WS_MIX   = al256(WS_PL + (size_t)NROW * INW * 2);
constexpr size_t WS_H     = WS_PL;
constexpr size_t WS_ROUTE = al256(WS_MIX + (size_t)NROW * D * 2);
constexpr size_t RT_TOKE  = 0;
constexpr size_t RT_TOKG  = RT_TOKE + (size_t)NLAT * 2 * 4;
constexpr size_t RT_TOKP  = RT_TOKG + (size_t)NLAT * 2 * 4;
constexpr size_t RT_RMAP  = RT_TOKP + (size_t)NLAT * 2 * 4;
constexpr size_t RT_SGATE = RT_RMAP + (size_t)2 * NROW * 4;
constexpr size_t WS_END   = al256(WS_ROUTE + RT_SGATE + (size_t)2 * NROW * 4);
static_assert(SH_BYTES * 3 <= (size_t)NEXP * MOE_E_BYTES, "scan inputs must fit the MoE weight region");
static_assert((size_t)NROW * DFE * 2 <= (size_t)NROW * INW * 2 + (size_t)NROW * D * 2, "H must fit PL+MIX");

constexpr int CW_BAR = 0;
constexpr int CW_MOECNT = 4096;

#define XB_TMO      128
#define XB_XCNT(j)  (256  + 64 * (j))
#define XB_XSUB(j)  (1280 + 64 * (j))
#define XB_XGEN(j)  (2304 + 64 * (j))
#define XB_TOP      3328
#define XB_TOPGEN   3392
#define XCD_BAR_WORDS 3456
#define XB_SPIN_CAP (1u << 22)

__device__ __forceinline__ unsigned xb_ld(unsigned* p)              { return __hip_atomic_load(p, __ATOMIC_RELAXED, __HIP_MEMORY_SCOPE_AGENT); }
__device__ __forceinline__ unsigned xb_add(unsigned* p, unsigned v) { return __hip_atomic_fetch_add(p, v, __ATOMIC_RELAXED, __HIP_MEMORY_SCOPE_AGENT); }
__device__ __forceinline__ unsigned xb_xcc_id() { return (unsigned)__builtin_amdgcn_s_getreg((3 << 11) | 20) & 0xFu; }
#define XB_SPIN(cond, bar) do { unsigned _sp = 0; while (cond) { __builtin_amdgcn_s_sleep(1); \
    if ((++_sp & 255u) == 0u) { if (xb_ld(&(bar)[XB_TMO])) break; if (_sp > XB_SPIN_CAP) { atomicAdd(&(bar)[XB_TMO], 1u); break; } } } } while (0)

struct XcdBarrier { unsigned* bar; unsigned x; volatile LAS unsigned* st; };

__device__ __forceinline__ XcdBarrier xcd_barrier_post(unsigned* bar, volatile LAS unsigned* st) {
    XcdBarrier b; b.bar = bar; b.x = xb_xcc_id(); b.st = st;
    if (threadIdx.x == 0) (void)xb_add(&bar[XB_XCNT(b.x)], 1u);
    return b;
}
__device__ __forceinline__ void xcd_barrier_complete(unsigned* bar, unsigned x, unsigned& nloc, unsigned& nx) {
    const unsigned G = gridDim.x * gridDim.y * gridDim.z;
    unsigned sum, cnt, mine, sp = 0u;
    for (;;) {
        sum = 0u; cnt = 0u; mine = 0u;
#pragma unroll
        for (unsigned j = 0; j < 16; ++j) { const unsigned c = xb_ld(&bar[XB_XCNT(j)]); sum += c; cnt += (c > 0u) ? 1u : 0u; mine = (j == x) ? c : mine; }
        if (sum == G) break;
        __builtin_amdgcn_s_sleep(1);
        if ((++sp & 255u) == 0u) { if (xb_ld(&bar[XB_TMO])) break; if (sp > XB_SPIN_CAP) { atomicAdd(&bar[XB_TMO], 1u); break; } }
    }
    nloc = mine > 0u ? mine : 1u; nx = cnt > 0u ? cnt : 1u;
}
__device__ __forceinline__ void xcd_barrier(const XcdBarrier& b) {
    asm volatile("s_waitcnt vmcnt(0)" ::: "memory");
    __syncthreads();
    if (threadIdx.x == 0) {
        unsigned* bar = b.bar;
        __builtin_amdgcn_s_waitcnt(0);
        unsigned nloc = b.st[0], nx = b.st[1];
        if (nloc == 0u) { xcd_barrier_complete(bar, b.x, nloc, nx); b.st[0] = nloc; b.st[1] = nx; }
        const unsigned old = xb_add(&bar[XB_XSUB(b.x)], 1u);
        const unsigned gen = old / nloc;
        if (old + 1u == (gen + 1u) * nloc) {
            __builtin_amdgcn_fence(__ATOMIC_RELEASE, "agent");
            asm volatile("s_waitcnt vmcnt(0)" ::: "memory");
            const unsigned og = xb_add(&bar[XB_TOP], 1u);
            const unsigned tg = og / nx;
            if (og + 1u == (tg + 1u) * nx) xb_add(&bar[XB_TOPGEN], 1u);
            else XB_SPIN(xb_ld(&bar[XB_TOPGEN]) == tg, bar);
            __builtin_amdgcn_fence(__ATOMIC_ACQUIRE, "agent");
            xb_add(&bar[XB_XGEN(b.x)], 1u);
            asm volatile("s_waitcnt vmcnt(0)" ::: "memory");
        } else {
            XB_SPIN(xb_ld(&bar[XB_XGEN(b.x)]) == gen, bar);
            __builtin_amdgcn_fence(__ATOMIC_ACQUIRE, "agent");
            asm volatile("s_waitcnt vmcnt(0)" ::: "memory");
        }
    }
    __syncthreads();
}

__device__ __forceinline__ float bf2f(bf16_t b) { return __uint_as_float(((unsigned)b) << 16); }
__device__ __forceinline__ bf16_t f2bf(float f) { unsigned u = __float_as_uint(f); u += 0x7FFFu + ((u >> 16) & 1u); return (bf16_t)(u >> 16); }
__device__ __forceinline__ unsigned pk_bf16(float lo, float hi) { return (unsigned)f2bf(lo) | ((unsigned)f2bf(hi) << 16); }
__device__ __forceinline__ unsigned cvt_pk_bf16(float lo, float hi) { unsigned r; asm volatile("v_cvt_pk_bf16_f32 %0, %1, %2" : "=v"(r) : "v"(lo), "v"(hi)); return r; }
__device__ __forceinline__ float sigmoidf_(float x) { return 1.0f / (1.0f + __expf(-x)); }
__device__ __forceinline__ float siluf_(float x) { return x / (1.0f + __expf(-x)); }
__device__ __forceinline__ float wave_sum(float v) {
#pragma unroll
    for (int o = 32; o >= 1; o >>= 1) v += __shfl_xor(v, o);
    return v;
}
__device__ __forceinline__ float sum16(float v) {
    v += __shfl_xor(v, 1); v += __shfl_xor(v, 2); v += __shfl_xor(v, 4); v += __shfl_xor(v, 8); return v;
}
__device__ __forceinline__ void unpack4(u32x2 w, float (&f)[4]) {
    f[0] = __uint_as_float(w.x << 16); f[1] = __uint_as_float(w.x & 0xffff0000u); f[2] = __uint_as_float(w.y << 16); f[3] = __uint_as_float(w.y & 0xffff0000u);
}
__device__ __forceinline__ void unpack8(u32x4 w, float* f) {
    f[0] = __uint_as_float(w.x << 16); f[1] = __uint_as_float(w.x & 0xffff0000u); f[2] = __uint_as_float(w.y << 16); f[3] = __uint_as_float(w.y & 0xffff0000u);
    f[4] = __uint_as_float(w.z << 16); f[5] = __uint_as_float(w.z & 0xffff0000u); f[6] = __uint_as_float(w.w << 16); f[7] = __uint_as_float(w.w & 0xffff0000u);
}

struct Params {
    const float* in[35];
    float* out; unsigned char* ws;
    int ph_lo, ph_hi;
};
enum { I_X = 0, I_C, I_CTX, I_CCTX, I_N1G, I_N2G, I_MODW, I_MODB, I_WIN, I_WOUT, I_RPB, I_MUP, I_MUN, I_W0, I_W2, I_A0, I_A2, I_G2, I_KK, I_KA, I_RK, I_GNG, I_GNB,
       I_DWW, I_DWB, I_LNG, I_LNB, I_FG, I_FU, I_FD, I_ROUTER, I_MG, I_MU, I_MD, I_FINALG };

__device__ __forceinline__ int row_mi(int r) { return r < NLAT ? (r >> 12) : 8; }

namespace pg8 {
constexpr int BM = 256, BK = 64, HALF = 128, HTB = HALF * BK * 2, STAGE_BYTES = 8 * HTB, NXCD = 8, WGM = 8;
__device__ __forceinline__ int lds_byte(int r, int c) { const int st = (r >> 4) * 2 + (c >> 5), rr = r & 15, cc = c & 31, ob = rr * 64 + cc * 2; return st * 1024 + (ob ^ (((ob >> 9) & 1) << 5)); }
__device__ __forceinline__ void stage_rc(int b, int& R, int& C) { const int st = b / 1024, sb = b % 1024, swz = sb ^ (((sb >> 9) & 1) << 5); R = (st >> 1) * 16 + swz / 64; C = (st & 1) * 32 + (swz % 64) / 2; }
__device__ __forceinline__ int perm32(int rho) { const int n = rho >> 4, i = rho & 15; return 8 * (i >> 2) + 4 * n + (i & 3); }
struct Unit { int pm, pn; };

struct TileOrder {
    int nM, nN, nwg, G, c;
    __device__ void init(int nM_, int nN_, int G_, int c_) { nM = nM_; nN = nN_; nwg = nM * nN; G = G_; c = c_; }
    __device__ bool next(int i, Unit& u) const {
        const long L = (long)i * G + c; if (L >= nwg) return false;
        int wgid = (int)L; { const int q = nwg / NXCD, r = nwg % NXCD, xcd = wgid % NXCD, off = wgid / NXCD; wgid = (xcd < r ? xcd * (q + 1) : r * (q + 1) + (xcd - r) * q) + off; }
        const int nig = WGM * nN, gid = wgid / nig, fm = gid * WGM, gsz = (nM - fm) < WGM ? (nM - fm) : WGM;
        u.pm = fm + ((wgid % nig) % gsz); u.pn = (wgid % nig) / gsz; return true;
    }
};
struct DenseSched : TileOrder {
    const bf16_t* A; const bf16_t* Bt; int K;
    __device__ __forceinline__ const char* aptr(const Unit& u) const { return (const char*)A + (size_t)u.pm * BM * K * 2; }
    __device__ __forceinline__ const char* bptr(const Unit& u) const { return (const char*)Bt + (size_t)u.pn * BM * K * 2; }
    __device__ __forceinline__ const char* abase() const { return (const char*)A; }
    __device__ __forceinline__ int arow(const Unit&, int) const { return 0; }
};
struct MoeSched : TileOrder {
    const bf16_t* A; const unsigned char* Bt0; size_t e_stride; int K; const int* rowmap; int tstart[9];
    __device__ __forceinline__ int expert(int pm) const { int e = 0;
#pragma unroll
        for (int j = 1; j < 8; ++j) e += (pm >= tstart[j]) ? 1 : 0;
        return e; }
    __device__ __forceinline__ const char* aptr(const Unit& u) const { return (const char*)A + (size_t)u.pm * BM * K * 2; }
    __device__ __forceinline__ const char* bptr(const Unit& u) const { return (const char*)Bt0 + (size_t)expert(u.pm) * e_stride + (size_t)u.pn * BM * K * 2; }
    __device__ __forceinline__ const char* abase() const { return (const char*)A; }
    __device__ __forceinline__ int arow(const Unit& u, int r) const { const int t = rowmap[u.pm * BM + r]; return t < 0 ? 0 : t; }
};

struct EpiBf16 {
    static constexpr bool PERM = true;
    bf16_t* O; int ldc; int nscale; float scale;
    __device__ __forceinline__ void operator()(const f32x4 (&acc)[2][2][4][2], const Unit& u, int wr, int wc, int fr, int fq) const {
        const int row0 = u.pm * BM + wr * 64 + fr, col0 = u.pn * BM + wc * 32 + 8 * fq;
        const float s = u.pn < nscale ? scale : 1.0f;
#pragma unroll
        for (int ai = 0; ai < 2; ++ai)
#pragma unroll
            for (int m = 0; m < 4; ++m) { bf16_t* rowp = O + (size_t)(row0 + ai * HALF + m * 16) * ldc + col0;
#pragma unroll
                for (int bj = 0; bj < 2; ++bj) { const f32x4 v0 = acc[ai][bj][m][0] * s, v1 = acc[ai][bj][m][1] * s;
                    u32x4 w; w.x = cvt_pk_bf16(v0[0], v0[1]); w.y = cvt_pk_bf16(v0[2], v0[3]); w.z = cvt_pk_bf16(v1[0], v1[1]); w.w = cvt_pk_bf16(v1[2], v1[3]);
                    *(u32x4*)(rowp + bj * HALF) = w; } }
    }
};
struct EpiSwiGLU {
    static constexpr bool PERM = true;
    bf16_t* H; int ldh;
    __device__ __forceinline__ void operator()(const f32x4 (&acc)[2][2][4][2], const Unit& u, int wr, int wc, int fr, int fq) const {
        const int row0 = u.pm * BM + wr * 64 + fr, col0 = u.pn * HALF + wc * 32 + 8 * fq;
#pragma unroll
        for (int ai = 0; ai < 2; ++ai)
#pragma unroll
            for (int m = 0; m < 4; ++m) { bf16_t* rowp = H + (size_t)(row0 + ai * HALF + m * 16) * ldh + col0;
                float h[8];
#pragma unroll
                for (int n = 0; n < 2; ++n)
#pragma unroll
                    for (int j = 0; j < 4; ++j) { const float g = acc[ai][0][m][n][j], up = acc[ai][1][m][n][j]; h[n * 4 + j] = g / (1.0f + __expf(-g)) * up; }
                u32x4 w; w.x = cvt_pk_bf16(h[0], h[1]); w.y = cvt_pk_bf16(h[2], h[3]); w.z = cvt_pk_bf16(h[4], h[5]); w.w = cvt_pk_bf16(h[6], h[7]);
                *(u32x4*)rowp = w; }
    }
};
struct EpiRes {
    static constexpr bool PERM = false;
    const float* resL; const float* resC; float* outL; float* outC; const float* gvec;
    __device__ __forceinline__ void operator()(const f32x4 (&acc)[2][2][4][2], const Unit& u, int wr, int wc, int fr, int fq) const {
        const int r0 = u.pm * BM; const bool lat = r0 < NLAT;
        const float* res = lat ? resL + (size_t)r0 * D : resC + (size_t)(r0 - NLAT) * D;
        float* out = lat ? outL + (size_t)r0 * D : outC + (size_t)(r0 - NLAT) * D;
        const float* gv = gvec + (size_t)(lat ? (r0 >> 12) : 8) * MODW;
        const int rl = wr * 64 + fr, col0 = u.pn * BM + wc * 32 + 4 * fq;
        f32x4 g[2][2];
#pragma unroll
        for (int bj = 0; bj < 2; ++bj)
#pragma unroll
            for (int n = 0; n < 2; ++n) g[bj][n] = *(const f32x4*)(gv + col0 + bj * HALF + n * 16);
#pragma unroll
        for (int ai = 0; ai < 2; ++ai)
#pragma unroll
            for (int m = 0; m < 4; ++m) { const size_t off = (size_t)(rl + ai * HALF + m * 16) * D + col0;
#pragma unroll
                for (int bj = 0; bj < 2; ++bj)
#pragma unroll
                    for (int n = 0; n < 2; ++n) { const f32x4 rv = *(const f32x4*)(res + off + bj * HALF + n * 16);
                        *(f32x4*)(out + off + bj * HALF + n * 16) = rv + g[bj][n] * acc[ai][bj][m][n]; } }
    }
};
struct EpiMoeDown {
    static constexpr bool PERM = false;
    float* xl; const float* gvec; const int* rowmap; const float* sgate;
    __device__ __forceinline__ void operator()(const f32x4 (&acc)[2][2][4][2], const Unit& u, int wr, int wc, int fr, int fq) const {
        const int rl = u.pm * BM + wr * 64 + fr, col0 = u.pn * BM + wc * 32 + 4 * fq;
#pragma unroll
        for (int ai = 0; ai < 2; ++ai)
#pragma unroll
            for (int m = 0; m < 4; ++m) { const int slot = rl + ai * HALF + m * 16; const int tok = rowmap[slot];
                if (tok >= 0) { const float sg = sgate[slot]; const float* gv = gvec + (size_t)(tok >> 12) * MODW + col0; float* xp = xl + (size_t)tok * D + col0;
#pragma unroll
                    for (int bj = 0; bj < 2; ++bj)
#pragma unroll
                        for (int n = 0; n < 2; ++n) { const f32x4 g = *(const f32x4*)(gv + bj * HALF + n * 16); const f32x4 rv = *(const f32x4*)(xp + bj * HALF + n * 16);
                            *(f32x4*)(xp + bj * HALF + n * 16) = rv + (g * sg) * acc[ai][bj][m][n]; } } }
    }
};

template <class Epi, class Sched, bool GATHER>
__device__ __forceinline__ void gemm_phase(LAS unsigned char* lds, const int K, const Sched& S, const Epi& E) {
    int tid_ = threadIdx.x; asm volatile("" : "+v"(tid_));
    const int tid = tid_, wid = __builtin_amdgcn_readfirstlane(tid >> 6), lane = tid & 63, wr = wid >> 2, wc = wid & 3, fr = lane & 15, fq = lane >> 4;
    const int nt = K / BK;
    unsigned voffA[2], voffB[2]; int RA[2], CA[2];
#pragma unroll
    for (int i = 0; i < 2; ++i) { int R, C; stage_rc(tid * 16 + i * 8192, R, C); const int Rb = Epi::PERM ? ((R & ~31) + perm32(R & 31)) : R;
        voffA[i] = (unsigned)(R * K + C) * 2u; voffB[i] = (unsigned)(Rb * K + C) * 2u; RA[i] = R; CA[i] = C; }
    const size_t kstep = (size_t)(BK * 2);
    const size_t hstep = (size_t)HALF * K * 2;
    const unsigned ldsw = (unsigned)wid * 1024u;
    const int aoff = lds_byte(wr * 64 + fr, fq * 8), boff = lds_byte(wc * 32 + fr, fq * 8);
#define PG8_SA(b, h) (((b) * 2 + (h)) * HTB)
#define PG8_SB(b, h) ((4 + (b) * 2 + (h)) * HTB)
#define PG8_STAGE(bufoff, gbase, voff) do { _Pragma("unroll") for (int _i = 0; _i < 2; ++_i) \
        __builtin_amdgcn_global_load_lds((const unsigned*)((const char*)(gbase) + (voff)[_i]), (LAS unsigned*)(lds + (bufoff) + ldsw + _i * 8192), 16, 0, 0); } while (0)
#define PG8_LDA(dst, b, h) do { _Pragma("unroll") for (int m = 0; m < 4; ++m) _Pragma("unroll") for (int k = 0; k < 2; ++k) dst[m][k] = *(const LAS bf16x8*)(lds + PG8_SA(b, h) + aoff + m * 2048 + k * 1024); } while (0)
#define PG8_LDB(dst, b, h) do { _Pragma("unroll") for (int n = 0; n < 2; ++n) _Pragma("unroll") for (int k = 0; k < 2; ++k) dst[n][k] = *(const LAS bf16x8*)(lds + PG8_SB(b, h) + boff + n * 2048 + k * 1024); } while (0)
#define PG8_MMA(ai, bj, At, Bt) do { __builtin_amdgcn_s_setprio(1); _Pragma("unroll") for (int m = 0; m < 4; ++m) _Pragma("unroll") for (int n = 0; n < 2; ++n) _Pragma("unroll") for (int k = 0; k < 2; ++k) \
        acc[ai][bj][m][n] = __builtin_amdgcn_mfma_f32_16x16x32_bf16(Bt[n][k], At[m][k], acc[ai][bj][m][n], 0, 0, 0); __builtin_amdgcn_s_setprio(0); } while (0)
#define PG8_WAIT_V(n) asm volatile("s_waitcnt vmcnt(" #n ")" ::: "memory")
#define PG8_WAIT_L(n) asm volatile("s_waitcnt lgkmcnt(" #n ")" ::: "memory")
#define PG8_BAR __builtin_amdgcn_s_barrier()
#define PG8_SCHED __builtin_amdgcn_sched_barrier(0)
#define PG8_STAGE_A(bufoff, TS, H) do { if constexpr (GATHER) { PG8_STAGE(bufoff, gA##TS, oA##TS[H]); } else { PG8_STAGE(bufoff, a##TS + (H) * hstep, voffA); } } while (0)
    Unit cur, nxt; int ui = 0;
    if (!S.next(0, cur)) return;
    f32x4 acc[2][2][4][2];
#pragma unroll
    for (int a = 0; a < 2; ++a)
#pragma unroll
        for (int b = 0; b < 2; ++b)
#pragma unroll
            for (int m = 0; m < 4; ++m)
#pragma unroll
                for (int n = 0; n < 2; ++n) acc[a][b][m][n] = (f32x4){0.f, 0.f, 0.f, 0.f};
    bf16x8 At[4][2], B0[2][2], B1[2][2];
    const char* Abase = S.abase();
    unsigned aoC[2][2] = {{0u, 0u}, {0u, 0u}}, aoN[2][2] = {{0u, 0u}, {0u, 0u}};
    if constexpr (GATHER) {
#pragma unroll
        for (int h = 0; h < 2; ++h)
#pragma unroll
            for (int i = 0; i < 2; ++i) aoC[h][i] = (unsigned)(S.arow(cur, h * HALF + RA[i]) * K + CA[i]) * 2u;
    }
    const char* cA = GATHER ? Abase : S.aptr(cur); const char* cB = S.bptr(cur);
    if constexpr (GATHER) {
        PG8_STAGE(PG8_SB(0, 0), cB, voffB); PG8_STAGE(PG8_SA(0, 0), Abase, aoC[0]); PG8_STAGE(PG8_SB(0, 1), cB + hstep, voffB); PG8_STAGE(PG8_SA(0, 1), Abase, aoC[1]);
    } else {
        PG8_STAGE(PG8_SB(0, 0), cB, voffB); PG8_STAGE(PG8_SA(0, 0), cA, voffA); PG8_STAGE(PG8_SB(0, 1), cB + hstep, voffB); PG8_STAGE(PG8_SA(0, 1), cA + hstep, voffA);
    }
    if (wr == 1) PG8_BAR;
    PG8_WAIT_V(4); PG8_BAR;
    if constexpr (GATHER) {
        PG8_STAGE(PG8_SB(1, 0), cB + kstep, voffB); PG8_STAGE(PG8_SA(1, 0), Abase + kstep, aoC[0]); PG8_STAGE(PG8_SB(1, 1), cB + hstep + kstep, voffB);
    } else {
        PG8_STAGE(PG8_SB(1, 0), cB + kstep, voffB); PG8_STAGE(PG8_SA(1, 0), cA + kstep, voffA); PG8_STAGE(PG8_SB(1, 1), cB + hstep + kstep, voffB);
    }
    PG8_WAIT_V(6); PG8_BAR;
    for (;;) {
        const bool has_next = S.next(ui + 1, nxt);
        const char* nA = has_next ? (GATHER ? Abase : S.aptr(nxt)) : cA; const char* nB = has_next ? S.bptr(nxt) : cB;
        if constexpr (GATHER) {
            if (has_next) {
#pragma unroll
                for (int h = 0; h < 2; ++h)
#pragma unroll
                    for (int i = 0; i < 2; ++i) aoN[h][i] = (unsigned)(S.arow(nxt, h * HALF + RA[i]) * K + CA[i]) * 2u;
            } else {
#pragma unroll
                for (int h = 0; h < 2; ++h)
#pragma unroll
                    for (int i = 0; i < 2; ++i) aoN[h][i] = aoC[h][i];
            }
        }
        for (int t = 0; t < nt; t += 2) {
            const bool last = (t == nt - 2);
            const char* a1 = cA + (size_t)(t + 1) * kstep;
            const char* a2 = last ? nA : cA + (size_t)(t + 2) * kstep; const char* b2 = last ? nB : cB + (size_t)(t + 2) * kstep;
            const char* a3 = a2 + kstep; const char* b3 = b2 + kstep;
            const char* gA1 = Abase + (size_t)(t + 1) * kstep; const char* gA2 = Abase + (last ? (size_t)0 : (size_t)(t + 2) * kstep); const char* gA3 = gA2 + kstep;
            unsigned oA1[2][2], oA2[2][2], oA3[2][2];
#pragma unroll
            for (int h = 0; h < 2; ++h)
#pragma unroll
                for (int i = 0; i < 2; ++i) { oA1[h][i] = aoC[h][i]; oA2[h][i] = last ? aoN[h][i] : aoC[h][i]; oA3[h][i] = oA2[h][i]; }
            (void)a1; (void)a3; (void)gA1; (void)gA3; (void)oA1; (void)oA3;
            PG8_LDB(B0, 0, 0); PG8_SCHED; PG8_LDA(At, 0, 0); PG8_STAGE_A(PG8_SA(1, 1), 1, 1);
            PG8_WAIT_L(8); PG8_BAR; PG8_WAIT_L(0); PG8_MMA(0, 0, At, B0); PG8_BAR; PG8_SCHED;
            PG8_LDB(B1, 0, 1); PG8_STAGE(PG8_SB(0, 0), b2, voffB);
            PG8_BAR; PG8_WAIT_L(0); PG8_MMA(0, 1, At, B1); PG8_BAR;
            PG8_LDA(At, 0, 1); PG8_STAGE_A(PG8_SA(0, 0), 2, 0);
            PG8_BAR; PG8_WAIT_L(0); PG8_MMA(1, 0, At, B0); PG8_BAR; PG8_SCHED;
            PG8_STAGE(PG8_SB(0, 1), b2 + hstep, voffB);
            PG8_WAIT_V(6); PG8_BAR; PG8_MMA(1, 1, At, B1); PG8_BAR;
            PG8_LDB(B0, 1, 0); PG8_SCHED; PG8_LDA(At, 1, 0); PG8_STAGE_A(PG8_SA(0, 1), 2, 1);
            PG8_WAIT_L(8); PG8_BAR; PG8_WAIT_L(0); PG8_MMA(0, 0, At, B0); PG8_BAR; PG8_SCHED;
            PG8_LDB(B1, 1, 1); PG8_STAGE(PG8_SB(1, 0), b3, voffB);
            PG8_BAR; PG8_WAIT_L(0); PG8_MMA(0, 1, At, B1); PG8_BAR;
            PG8_LDA(At, 1, 1); PG8_STAGE_A(PG8_SA(1, 0), 3, 0);
            PG8_BAR; PG8_WAIT_L(0); PG8_MMA(1, 0, At, B0); PG8_BAR; PG8_SCHED;
            PG8_STAGE(PG8_SB(1, 1), b3 + hstep, voffB);
            PG8_WAIT_V(6); PG8_BAR; PG8_MMA(1, 1, At, B1); PG8_BAR;
        }
        E(acc, cur, wr, wc, fr, fq);
        if (!has_next) break;
#pragma unroll
        for (int a = 0; a < 2; ++a)
#pragma unroll
            for (int b = 0; b < 2; ++b)
#pragma unroll
                for (int m = 0; m < 4; ++m)
#pragma unroll
                    for (int n = 0; n < 2; ++n) acc[a][b][m][n] = (f32x4){0.f, 0.f, 0.f, 0.f};
        cur = nxt; cA = nA; cB = nB; ++ui;
        if constexpr (GATHER) {
#pragma unroll
            for (int h = 0; h < 2; ++h)
#pragma unroll
                for (int i = 0; i < 2; ++i) aoC[h][i] = aoN[h][i];
        }
    }
    PG8_WAIT_V(0);
    if (wr == 0) PG8_BAR;
    PG8_BAR;
#undef PG8_SA
#undef PG8_SB
#undef PG8_STAGE
#undef PG8_STAGE_A
#undef PG8_LDA
#undef PG8_LDB
#undef PG8_MMA
#undef PG8_WAIT_V
#undef PG8_WAIT_L
#undef PG8_BAR
#undef PG8_SCHED
}
}

struct Frame {
    LAS unsigned char* lds; int tid, lane, wave, G, bid, gw, nw;
    unsigned char* ws;
};
extern __shared__ __attribute__((aligned(16))) unsigned char lds_raw[];
typedef const __attribute__((address_space(4))) Params* KP;
__device__ __forceinline__ Params load_params(const void* kp_) {
    const unsigned long long v = (unsigned long long)kp_;
    const unsigned lo = __builtin_amdgcn_readfirstlane((unsigned)v), hi = __builtin_amdgcn_readfirstlane((unsigned)(v >> 32));
    KP kp = (KP)(((unsigned long long)hi << 32) | lo);
    Params P;
#pragma unroll
    for (int i = 0; i < 35; ++i) P.in[i] = kp->in[i];
    P.out = kp->out; P.ws = kp->ws; P.ph_lo = kp->ph_lo; P.ph_hi = kp->ph_hi;
    return P;
}
#define PHASE static __attribute__((noinline)) __device__ void
#define PHASE_INL static __device__ __forceinline__ void
__device__ __forceinline__ Frame make_frame(unsigned char* ws) {
    Frame F; F.lds = (LAS unsigned char*)lds_raw; F.tid = threadIdx.x; F.lane = F.tid & 63; F.wave = __builtin_amdgcn_readfirstlane(F.tid >> 6);
    F.G = gridDim.x; F.bid = blockIdx.x; F.gw = F.bid * NWAVES + F.wave; F.nw = F.G * NWAVES; F.ws = ws; return F;
}
#define PHASE_ENTER const Params P = load_params(kp_); const Frame F = make_frame(P.ws)

__device__ __forceinline__ void conv_job(const Frame& F, const float* src, bf16_t* dst, int K, int N, int mode) {
    LAS float* tile = (LAS float*)(F.lds + F.wave * (64 * 65 * 4));
    const int tk = K / 64, tn = N / 64, ntile = tk * tn, lane = F.lane;
    for (int t = F.gw; t < ntile; t += F.nw) {
        const int k0 = (t / tn) * 64, n0 = (t % tn) * 64;
#pragma unroll 4
        for (int i = 0; i < 16; ++i) { const int row = i * 4 + (lane >> 4), c4 = (lane & 15) * 4;
            const f32x4 v = *(const f32x4*)(src + (size_t)(k0 + row) * N + n0 + c4);
            tile[row * 65 + c4 + 0] = v[0]; tile[row * 65 + c4 + 1] = v[1]; tile[row * 65 + c4 + 2] = v[2]; tile[row * 65 + c4 + 3] = v[3]; }
        __builtin_amdgcn_wave_barrier(); asm volatile("s_waitcnt lgkmcnt(0)" ::: "memory");
#pragma unroll 2
        for (int i = 0; i < 8; ++i) { const int n = i * 8 + (lane >> 3), kc = (lane & 7) * 8;
            float f[8];
#pragma unroll
            for (int j = 0; j < 8; ++j) f[j] = tile[(kc + j) * 65 + n];
            const int ng = n0 + n; const int drow = mode == 0 ? ng : ((ng >> 7) * 256 + (mode == 2 ? 128 : 0) + (ng & 127));
            u32x4 w; w.x = pk_bf16(f[0], f[1]); w.y = pk_bf16(f[2], f[3]); w.z = pk_bf16(f[4], f[5]); w.w = pk_bf16(f[6], f[7]);
            *(u32x4*)(dst + (size_t)drow * K + k0 + kc) = w; }
        __builtin_amdgcn_wave_barrier(); asm volatile("s_waitcnt lgkmcnt(0)" ::: "memory");
    }
}

__device__ __forceinline__ void phase_prologue(const Frame& F, const Params& P) {
    float* modv = (float*)(F.ws + WS_MODV);
    LAS float* s = (LAS float*)F.lds;
    LAS float* red = (LAS float*)(F.lds + 9 * 1024 * 4);
    for (int cb = F.bid; cb < (2 * MODW) / 64; cb += F.G) {
        for (int i = F.tid; i < 9 * 1024; i += NTHREADS) { const int mi = i >> 10, k = i & 1023; const float c = mi < 8 ? P.in[I_C][mi * D + k] : P.in[I_CCTX][k]; s[i] = siluf_(c); }
        __syncthreads();
        const int colg = cb * 64 + F.lane, l = colg / MODW, col = colg % MODW;
        const float* w = P.in[I_MODW] + (size_t)l * D * MODW + col;
        float acc[9];
#pragma unroll
        for (int mi = 0; mi < 9; ++mi) acc[mi] = 0.f;
        const int kb = F.wave * 128;
#pragma unroll 8
        for (int k = 0; k < 128; ++k) { const float wv = w[(size_t)(kb + k) * MODW];
#pragma unroll
            for (int mi = 0; mi < 9; ++mi) acc[mi] += s[mi * 1024 + kb + k] * wv; }
#pragma unroll
        for (int mi = 0; mi < 9; ++mi) red[(F.wave * 9 + mi) * 64 + F.lane] = acc[mi];
        __syncthreads();
        for (int i = F.tid; i < 9 * 64; i += NTHREADS) { const int mi = i >> 6, ln = i & 63; float a = 0.f;
#pragma unroll
            for (int w8 = 0; w8 < 8; ++w8) a += red[(w8 * 9 + mi) * 64 + ln];
            const int cg = cb * 64 + ln, l2 = cg / MODW, c2 = cg % MODW;
            modv[((size_t)l2 * 9 + mi) * MODW + c2] = a + P.in[I_MODB][l2 * MODW + c2]; }
        __syncthreads();
    }
    for (int l = 0; l < 2; ++l) {
        conv_job(F, P.in[I_WIN] + (size_t)l * D * INW, (bf16_t*)(F.ws + WS_BTIN) + (size_t)l * INW * D, D, INW, 0);
        conv_job(F, P.in[I_WOUT] + (size_t)l * D * D, (bf16_t*)(F.ws + WS_BTOUT) + (size_t)l * D * D, D, D, 0);
    }
    conv_job(F, P.in[I_FG], (bf16_t*)(F.ws + WS_BTGU), D, DFF, 1);
    conv_job(F, P.in[I_FU], (bf16_t*)(F.ws + WS_BTGU), D, DFF, 2);
    conv_job(F, P.in[I_FD], (bf16_t*)(F.ws + WS_BTDN), DFF, D, 0);
}
__device__ __forceinline__ void phase_moe_convert(const Frame& F, const Params& P) {
    for (int e = 0; e < NEXP; ++e) {
        bf16_t* gu = (bf16_t*)(F.ws + WS_MOE + (size_t)e * MOE_E_BYTES); bf16_t* dn = (bf16_t*)(F.ws + WS_MOE + (size_t)e * MOE_E_BYTES + MOE_GU_BYTES);
        conv_job(F, P.in[I_MG] + (size_t)e * D * DFE, gu, D, DFE, 1);
        conv_job(F, P.in[I_MU] + (size_t)e * D * DFE, gu, D, DFE, 2);
        conv_job(F, P.in[I_MD] + (size_t)e * DFE * D, dn, DFE, D, 0);
    }
}

template <bool ROUTER>
__device__ __forceinline__ void phase_norm(const Frame& F, const Params& P, int l, int which, int nrows, const float* srcL, const float* srcC) {
    const float* g = (which == 0 ? P.in[I_N1G] : P.in[I_N2G]) + l * D;
    const float* modv = (const float*)(F.ws + WS_MODV) + (size_t)l * 9 * MODW + (which == 0 ? 0 : 3 * D);
    bf16_t* HL = (bf16_t*)(F.ws + WS_HL);
    LAS float* rt = (LAS float*)F.lds;
    if (ROUTER) {
        for (int i = F.tid; i < D * NEXP; i += NTHREADS) rt[i] = P.in[I_ROUTER][i];
        int* rmap = (int*)(F.ws + WS_ROUTE + RT_RMAP);
        for (int i = F.bid * NTHREADS + F.tid; i < 2 * NROW; i += F.G * NTHREADS) rmap[i] = -1;
        __syncthreads();
    }
    const int lane = F.lane;
    for (int r = F.gw; r < nrows; r += F.nw) {
        const float* xr = r < NLAT ? srcL + (size_t)r * D : srcC + (size_t)(r - NLAT) * D;
        const float* mv = modv + (size_t)row_mi(r) * MODW;
        f32x4 x[4]; float ss = 0.f;
#pragma unroll
        for (int j = 0; j < 4; ++j) { x[j] = *(const f32x4*)(xr + j * 256 + lane * 4); ss += x[j][0] * x[j][0] + x[j][1] * x[j][1] + x[j][2] * x[j][2] + x[j][3] * x[j][3]; }
        ss = wave_sum(ss);
        const float rstd = rsqrtf(ss * (1.0f / D) + 1e-6f);
        float lg[NEXP];
        if (ROUTER) {
#pragma unroll
            for (int e = 0; e < NEXP; ++e) lg[e] = 0.f;
        }
#pragma unroll
        for (int j = 0; j < 4; ++j) { const int c = j * 256 + lane * 4;
            const f32x4 gg = *(const f32x4*)(g + c), sh = *(const f32x4*)(mv + c), sc = *(const f32x4*)(mv + D + c);
            f32x4 y = (x[j] * rstd * gg) * (sc + 1.0f) + sh;
            u32x2 w; w.x = pk_bf16(y[0], y[1]); w.y = pk_bf16(y[2], y[3]);
            *(u32x2*)(HL + (size_t)r * D + c) = w;
            if (ROUTER) {
#pragma unroll
                for (int q = 0; q < 4; ++q) { const f32x4 r0 = *(const LAS f32x4*)(rt + (c + q) * 8), r1 = *(const LAS f32x4*)(rt + (c + q) * 8 + 4);
                    lg[0] += y[q] * r0[0]; lg[1] += y[q] * r0[1]; lg[2] += y[q] * r0[2]; lg[3] += y[q] * r0[3];
                    lg[4] += y[q] * r1[0]; lg[5] += y[q] * r1[1]; lg[6] += y[q] * r1[2]; lg[7] += y[q] * r1[3]; asm volatile("" ::: "memory"); }
            }
        }
        if (ROUTER) {
#pragma unroll
            for (int e = 0; e < NEXP; ++e) lg[e] = wave_sum(lg[e]);
            if (lane == 0) {
                int e1 = 0; float l1 = lg[0];
#pragma unroll
                for (int e = 1; e < NEXP; ++e) if (lg[e] > l1) { l1 = lg[e]; e1 = e; }
                int e2 = -1; float l2 = -3.0e38f;
#pragma unroll
                for (int e = 0; e < NEXP; ++e) if (e != e1 && lg[e] > l2) { l2 = lg[e]; e2 = e; }
                const float ex = __expf(l2 - l1), g1 = 1.0f / (1.0f + ex), g2 = ex * g1;
                unsigned* cnt = (unsigned*)(F.ws + WS_CTL) + CW_MOECNT;
                const unsigned p1 = atomicAdd(cnt + e1, 1u), p2 = atomicAdd(cnt + 8 + e2, 1u);
                int* te = (int*)(F.ws + WS_ROUTE + RT_TOKE); float* tg = (float*)(F.ws + WS_ROUTE + RT_TOKG); int* tp = (int*)(F.ws + WS_ROUTE + RT_TOKP);
                te[r * 2] = e1; te[r * 2 + 1] = e2; tg[r * 2] = g1; tg[r * 2 + 1] = g2; tp[r * 2] = (int)p1; tp[r * 2 + 1] = (int)p2;
            }
        }
    }
}
__device__ __forceinline__ void moe_tstart(const Frame& F, int pass, int (&ts)[9]) {
    const unsigned* cnt = (const unsigned*)(F.ws + WS_CTL) + CW_MOECNT + pass * 8;
    int a = 0;
#pragma unroll
    for (int e = 0; e < 8; ++e) { ts[e] = a; a += (int)((__hip_atomic_load(cnt + e, __ATOMIC_RELAXED, __HIP_MEMORY_SCOPE_AGENT) + 255u) >> 8); }
    ts[8] = a;
}
__device__ __forceinline__ void phase_moe_rowmap(const Frame& F) {
    int ts0[9], ts1[9]; moe_tstart(F, 0, ts0); moe_tstart(F, 1, ts1);
    const int* te = (const int*)(F.ws + WS_ROUTE + RT_TOKE); const float* tg = (const float*)(F.ws + WS_ROUTE + RT_TOKG); const int* tp = (const int*)(F.ws + WS_ROUTE + RT_TOKP);
    int* rmap = (int*)(F.ws + WS_ROUTE + RT_RMAP); float* sg = (float*)(F.ws + WS_ROUTE + RT_SGATE);
    for (int t = F.bid * NTHREADS + F.tid; t < NLAT; t += F.G * NTHREADS) {
        { const int e = te[t * 2]; int st = 0;
#pragma unroll
          for (int j = 0; j < 8; ++j) st = (e == j) ? ts0[j] : st;
          const int slot = st * 256 + tp[t * 2]; rmap[slot] = t; sg[slot] = tg[t * 2]; }
        { const int e = te[t * 2 + 1]; int st = 0;
#pragma unroll
          for (int j = 0; j < 8; ++j) st = (e == j) ? ts1[j] : st;
          const int slot = st * 256 + tp[t * 2 + 1]; rmap[NROW + slot] = t; sg[NROW + slot] = tg[t * 2 + 1]; }
    }
}

struct RowGeo { int b, tt, pos, len; };
__device__ __forceinline__ RowGeo row_geo(int r) { RowGeo g; if (r < NLAT) { g.b = r >> 12; g.pos = r & 4095; g.len = SEQ; g.tt = CTXL + g.pos; } else { const int q = r - NLAT; g.b = q >> 8; g.pos = q & 255; g.len = CTXL; g.tt = g.pos; } return g; }

__device__ __forceinline__ void rw_shift4(const bf16_t* PL, const float* mup, const float* mun, int r, const RowGeo& g, int j, float (&u)[4]) {
    const bf16_t* p = PL + (size_t)r * INW + O_RW + j;
    float c[4], pv[4] = {0.f, 0.f, 0.f, 0.f}, nv[4] = {0.f, 0.f, 0.f, 0.f};
    unpack4(*(const u32x2*)p, c);
    if (g.pos > 0) unpack4(*(const u32x2*)(p - INW), pv);
    if (g.pos < g.len - 1) unpack4(*(const u32x2*)(p + INW), nv);
    const f32x4 mp = *(const f32x4*)(mup + j), mn = *(const f32x4*)(mun + j);
#pragma unroll
    for (int q = 0; q < 4; ++q) u[q] = c[q] + mp[q] * (pv[q] - c[q]) + mn[q] * (nv[q] - c[q]);
}

__device__ __forceinline__ void phase_rw_prep(const Frame& F, const Params& P, int l) {
    const bf16_t* PL = (const bf16_t*)(F.ws + WS_PL);
    const float* mup = P.in[I_MUP] + l * 1280; const float* mun = P.in[I_MUN] + l * 1280;
    LAS float* lw = (LAS float*)(F.lds + F.wave * 1024);
    f16_t* SH = (f16_t*)(F.ws + WS_SH); f16_t* SD = (f16_t*)(F.ws + WS_SD);
    const int lane = F.lane, c4 = lane * 4, h = lane >> 4, cw = (lane & 15) * 4;
    const f32x4 kkw = *(const f32x4*)(P.in[I_KK] + l * 256 + c4), kaw = *(const f32x4*)(P.in[I_KA] + l * 256 + c4);
    for (int r = F.gw; r < NROW; r += F.nw) {
        const RowGeo g = row_geo(r);
        float ur[4], uk[4], uv[4], u3[4], u4[4];
        rw_shift4(PL, mup, mun, r, g, c4, ur); rw_shift4(PL, mup, mun, r, g, 256 + c4, uk); rw_shift4(PL, mup, mun, r, g, 512 + c4, uv);
        rw_shift4(PL, mup, mun, r, g, 768 + c4, u3); rw_shift4(PL, mup, mun, r, g, 1024 + c4, u4);
        if (lane < 16) {
#pragma unroll
            for (int q = 0; q < 4; ++q) { lw[c4 + q] = tanhf(u3[q]); lw[64 + c4 + q] = tanhf(u4[q]); }
        } else if (lane < 32) {
#pragma unroll
            for (int q = 0; q < 4; ++q) { lw[128 + c4 - 64 + q] = u3[q]; lw[192 + c4 - 64 + q] = u4[q]; }
        }
        __builtin_amdgcn_wave_barrier(); asm volatile("s_waitcnt lgkmcnt(0)" ::: "memory");
        float km[4], ss = 0.f;
#pragma unroll
        for (int q = 0; q < 4; ++q) { km[q] = uk[q] * kkw[q]; ss += km[q] * km[q]; }
        ss = sum16(ss);
        const float rn = rsqrtf(ss + 1e-12f);
        float kkv[4];
#pragma unroll
        for (int q = 0; q < 4; ++q) kkv[q] = km[q] * rn;
        const size_t shrow = ((size_t)(g.b * 4 + h) * TT + g.tt) * 192;
        { f16x4 o;
#pragma unroll
          for (int q = 0; q < 4; ++q) o[q] = (f16_t)ur[q];
          *(f16x4*)(SH + shrow + cw) = o;
#pragma unroll
          for (int q = 0; q < 4; ++q) o[q] = (f16_t)uv[q];
          *(f16x4*)(SH + shrow + 64 + cw) = o;
#pragma unroll
          for (int q = 0; q < 4; ++q) o[q] = (f16_t)(-kkv[q]);
          *(f16x4*)(SH + shrow + 128 + cw) = o; }
#pragma unroll 1
        for (int d = 0; d < 2; ++d) {
            const float* w2 = P.in[I_W2] + (size_t)((l * 2 + d) * 64) * 256 + c4; const float* a2 = P.in[I_A2] + (size_t)((l * 2 + d) * 64) * 256 + c4;
            f32x4 xw = *(const f32x4*)(P.in[I_W0] + (l * 2 + d) * 256 + c4), xa = *(const f32x4*)(P.in[I_A0] + (l * 2 + d) * 256 + c4);
#pragma unroll 4
            for (int k = 0; k < 64; ++k) { const float tw = lw[d * 64 + k], ta = lw[128 + d * 64 + k];
                xw += *(const f32x4*)(w2 + (size_t)k * 256) * tw; xa += *(const f32x4*)(a2 + (size_t)k * 256) * ta; }
            f16x4 o1, o2, o3;
#pragma unroll
            for (int q = 0; q < 4; ++q) {
                const float nx = -xw[q]; const float sp = fmaxf(nx, 0.f) + log1pf(__expf(-fabsf(nx)));
                const float e = __expf(-sp - 0.5f);
                const float omw = -expm1f(-e);
                const float a = sigmoidf_(xa[q]);
                o1[q] = (f16_t)omw; o2[q] = (f16_t)(uk[q] * (1.0f + (a - 1.0f) * kaw[q])); o3[q] = (f16_t)(kkv[q] * a);
            }
            const size_t sdrow = ((size_t)((d * 8 + g.b) * 4 + h) * TT + g.tt) * 192;
            *(f16x4*)(SD + sdrow + cw) = o1; *(f16x4*)(SD + sdrow + 64 + cw) = o2; *(f16x4*)(SD + sdrow + 128 + cw) = o3;
        }
        __builtin_amdgcn_wave_barrier();
    }
}

constexpr int SC_CH = 32;
constexpr int SC_BUF = SC_CH * 6 * 64 * 4;
__device__ __forceinline__ float dpp_sum16(float v) {
    v += __builtin_bit_cast(float, __builtin_amdgcn_update_dpp(0, __builtin_bit_cast(int, v), 0xB1, 0xF, 0xF, true));
    v += __builtin_bit_cast(float, __builtin_amdgcn_update_dpp(0, __builtin_bit_cast(int, v), 0x4E, 0xF, 0xF, true));
    v += __builtin_bit_cast(float, __builtin_amdgcn_update_dpp(0, __builtin_bit_cast(int, v), 0x141, 0xF, 0xF, true));
    v += __builtin_bit_cast(float, __builtin_amdgcn_update_dpp(0, __builtin_bit_cast(int, v), 0x140, 0xF, 0xF, true));
    return v;
}
__device__ __forceinline__ int scan_tt0(int d, int c) { return d == 0 ? c * SC_CH : (c < 8 ? 224 - 32 * c : 4576 - 32 * c); }
__device__ __forceinline__ void scan_load_chunk(LAS unsigned char* lds, const f16_t* sh, const f16_t* sd, int d, int c, int lt) {
    const int t0 = scan_tt0(d, c);
    u32x4 ld[6];
#pragma unroll
    for (int i = 0; i < 3; ++i) { const int p = lt + i * 256; ld[i] = *(const u32x4*)(sh + (size_t)t0 * 192 + p * 8); ld[3 + i] = *(const u32x4*)(sd + (size_t)t0 * 192 + p * 8); }
    LAS float* buf = (LAS float*)(lds + (c & 1) * SC_BUF);
#pragma unroll
    for (int i = 0; i < 6; ++i) { const int p = lt + (i % 3) * 256; const int ms = p / 24, wi = p % 24, kind = wi >> 3, e0 = (wi & 7) * 8; const int st = d == 0 ? ms : (SC_CH - 1 - ms);
        const f16x8 hv = __builtin_bit_cast(f16x8, ld[i]); float f[8];
#pragma unroll
        for (int q = 0; q < 8; ++q) f[q] = (float)hv[q];
        if (i >= 3 && kind == 0) {
#pragma unroll
            for (int q = 0; q < 8; ++q) f[q] = 1.0f - f[q];
        }
        LAS float* dst = buf + (st * 6 + (i < 3 ? kind : 3 + kind)) * 64 + e0;
        *(LAS f32x4*)dst = (f32x4){f[0], f[1], f[2], f[3]}; *(LAS f32x4*)(dst + 4) = (f32x4){f[4], f[5], f[6], f[7]}; }
}
__device__ __forceinline__ void phase_scan(const Frame& F) {
    const f16_t* SH = (const f16_t*)(F.ws + WS_SH); const f16_t* SD = (const f16_t*)(F.ws + WS_SD);
    float* Y = (float*)(F.ws + WS_Y);
    const int tid = F.tid, lane = F.lane, wave = F.wave;
    constexpr int NCHUNK = TT / SC_CH;
    for (int item = F.bid; item < 256; item += F.G) {
        const int xg = item & 7, sl = item >> 3, chain = xg * 8 + (sl >> 2), quarter = sl & 3;
        const int d = chain >> 5, b = (chain >> 2) & 7, h = chain & 3;
        const f16_t* sh = SH + (size_t)(b * 4 + h) * TT * 192; const f16_t* sd = SD + (size_t)((d * 8 + b) * 4 + h) * TT * 192;
        const bool loader = wave >= 4; const int lt = tid - 256;
        if (loader) scan_load_chunk(F.lds, sh, sd, d, 0, lt);
        __syncthreads();
        float S0 = 0.f, S1 = 0.f, S2 = 0.f, S3 = 0.f;
        const int row = quarter * 16 + (wave & 3) * 4 + (lane >> 4), j0 = (lane & 15) * 4;
        float* yp = Y + ((size_t)(d * 8 + b) * TT) * 256 + h * 64 + row;
        for (int c = 0; c < NCHUNK; ++c) {
            if (loader) {
                if (c + 1 < NCHUNK) scan_load_chunk(F.lds, sh, sd, d, c + 1, lt);
            } else {
                const LAS float* buf = (const LAS float*)(F.lds + (c & 1) * SC_BUF);
                const int t0 = scan_tt0(d, c);
#pragma unroll 4
                for (int i = 0; i < SC_CH; ++i) {
                    const LAS float* sp = buf + i * 384;
                    const f32x4 r4 = *(const LAS f32x4*)(sp + j0), z4 = *(const LAS f32x4*)(sp + 128 + j0), w4 = *(const LAS f32x4*)(sp + 192 + j0),
                                k4 = *(const LAS f32x4*)(sp + 256 + j0), b4 = *(const LAS f32x4*)(sp + 320 + j0);
                    const float vr = sp[64 + row];
                    float sz = S0 * z4[0] + S1 * z4[1] + S2 * z4[2] + S3 * z4[3];
                    sz = dpp_sum16(sz);
                    S0 = S0 * w4[0] + (sz * b4[0] + vr * k4[0]); S1 = S1 * w4[1] + (sz * b4[1] + vr * k4[1]);
                    S2 = S2 * w4[2] + (sz * b4[2] + vr * k4[2]); S3 = S3 * w4[3] + (sz * b4[3] + vr * k4[3]);
                    float y = S0 * r4[0] + S1 * r4[1] + S2 * r4[2] + S3 * r4[3];
                    y = dpp_sum16(y);
                    const int tt = d == 0 ? t0 + i : t0 + SC_CH - 1 - i;
                    if ((lane & 15) == 0) yp[(size_t)tt * 256] = y;
                }
            }
            __syncthreads();
        }
    }
}

__device__ __forceinline__ void phase_rw_post(const Frame& F, const Params& P, int l, int nrows) {
    const bf16_t* PL = (const bf16_t*)(F.ws + WS_PL); bf16_t* MIX = (bf16_t*)(F.ws + WS_MIX);
    const f16_t* SH = (const f16_t*)(F.ws + WS_SH); const f16_t* SD = (const f16_t*)(F.ws + WS_SD); const float* Y = (const float*)(F.ws + WS_Y);
    const float* mup = P.in[I_MUP] + l * 1280; const float* mun = P.in[I_MUN] + l * 1280;
    LAS float* sg = (LAS float*)(F.lds + F.wave * 1024);
    const int lane = F.lane, c4 = lane * 4, h = lane >> 4, cw = (lane & 15) * 4;
    const f32x4 rk = *(const f32x4*)(P.in[I_RK] + l * 256 + c4), gng = *(const f32x4*)(P.in[I_GNG] + l * 256 + c4), gnb = *(const f32x4*)(P.in[I_GNB] + l * 256 + c4);
    for (int r = F.gw; r < nrows; r += F.nw) {
        const RowGeo g = row_geo(r);
        float u3[4], u4[4];
        rw_shift4(PL, mup, mun, r, g, 768 + c4, u3); rw_shift4(PL, mup, mun, r, g, 1024 + c4, u4);
        if (lane >= 32) {
#pragma unroll
            for (int q = 0; q < 4; ++q) { sg[c4 - 128 + q] = sigmoidf_(u3[q]); sg[128 + c4 - 128 + q] = sigmoidf_(u4[q]); }
        }
        __builtin_amdgcn_wave_barrier(); asm volatile("s_waitcnt lgkmcnt(0)" ::: "memory");
        const size_t shrow = ((size_t)(g.b * 4 + h) * TT + g.tt) * 192;
        const f16x4 rh = *(const f16x4*)(SH + shrow + cw), vh = *(const f16x4*)(SH + shrow + 64 + cw);
        float out[4] = {0.f, 0.f, 0.f, 0.f};
#pragma unroll
        for (int d = 0; d < 2; ++d) {
            const float* g2 = P.in[I_G2] + (size_t)((l * 2 + d) * 128) * 256 + c4;
            f32x4 gg = (f32x4){0.f, 0.f, 0.f, 0.f};
#pragma unroll 8
            for (int k = 0; k < 128; ++k) gg += *(const f32x4*)(g2 + (size_t)k * 256) * sg[d * 128 + k];
            const f32x4 y = *(const f32x4*)(Y + ((size_t)(d * 8 + g.b) * TT + g.tt) * 256 + c4);
            const float mu = sum16(y[0] + y[1] + y[2] + y[3]) * (1.0f / 64.0f);
            float vs = 0.f;
#pragma unroll
            for (int q = 0; q < 4; ++q) { const float dd = y[q] - mu; vs += dd * dd; }
            const float rstd = rsqrtf(sum16(vs) * (1.0f / 64.0f) + 64e-5f);
            const size_t sdrow = ((size_t)((d * 8 + g.b) * 4 + h) * TT + g.tt) * 192;
            const f16x4 kdh = *(const f16x4*)(SD + sdrow + 64 + cw);
            float bs = 0.f;
#pragma unroll
            for (int q = 0; q < 4; ++q) bs += (float)rh[q] * (float)kdh[q] * rk[q];
            bs = sum16(bs);
#pragma unroll
            for (int q = 0; q < 4; ++q) out[q] += ((y[q] - mu) * rstd * gng[q] + gnb[q] + bs * (float)vh[q]) * gg[q];
        }
        u32x2 w; w.x = pk_bf16(out[0], out[1]); w.y = pk_bf16(out[2], out[3]);
        *(u32x2*)(MIX + (size_t)r * D + 512 + c4) = w;
        __builtin_amdgcn_wave_barrier();
    }
}

__device__ __forceinline__ void phase_conv(const Frame& F, const Params& P, int l, int nrows) {
    const bf16_t* PL = (const bf16_t*)(F.ws + WS_PL); bf16_t* MIX = (bf16_t*)(F.ws + WS_MIX);
    const int lane = F.lane, c4 = lane * 4;
    const float* dw = P.in[I_DWW] + (size_t)l * 31 * 256 + c4;
    const f32x4 dwb = *(const f32x4*)(P.in[I_DWB] + l * 256 + c4), lng = *(const f32x4*)(P.in[I_LNG] + l * 256 + c4), lnb = *(const f32x4*)(P.in[I_LNB] + l * 256 + c4);
    for (int r = F.gw; r < nrows; r += F.nw) {
        const RowGeo g = row_geo(r);
        f32x4 acc = dwb;
#pragma unroll 1
        for (int j = 0; j < 31; ++j) { const int tp = g.pos + j - 15;
            if (tp >= 0 && tp < g.len) { const bf16_t* p = PL + (size_t)(r + j - 15) * INW + O_CV + c4; float a[4], bb[4];
                unpack4(*(const u32x2*)p, a); unpack4(*(const u32x2*)(p + 256), bb);
                const f32x4 w = *(const f32x4*)(dw + j * 256);
#pragma unroll
                for (int q = 0; q < 4; ++q) acc[q] += a[q] * sigmoidf_(bb[q]) * w[q]; } }
        const float mu = wave_sum(acc[0] + acc[1] + acc[2] + acc[3]) * (1.0f / 256.0f);
        float vs = 0.f;
#pragma unroll
        for (int q = 0; q < 4; ++q) { const float dd = acc[q] - mu; vs += dd * dd; }
        const float rstd = rsqrtf(wave_sum(vs) * (1.0f / 256.0f) + 1e-5f);
        float o[4];
#pragma unroll
        for (int q = 0; q < 4; ++q) o[q] = siluf_((acc[q] - mu) * rstd * lng[q] + lnb[q]);
        u32x2 w; w.x = pk_bf16(o[0], o[1]); w.y = pk_bf16(o[2], o[3]);
        *(u32x2*)(MIX + (size_t)r * D + 768 + c4) = w;
    }
}

__device__ __forceinline__ void phase_na_simple(const Frame& F, const Params& P, int l, int nq) {
    const bf16_t* PL = (const bf16_t*)(F.ws + WS_PL); bf16_t* MIX = (bf16_t*)(F.ws + WS_MIX);
    const float* rpb = P.in[I_RPB] + (size_t)l * 8 * 15 * 31;
    int tid_ = F.tid; asm volatile("" : "+v"(tid_));
    for (int gid = F.bid * NTHREADS + tid_; gid < nq * 8; gid += F.G * NTHREADS) {
        const int r = gid >> 3, h = gid & 7;
        const RowGeo g = row_geo(r);
        float q[64], o[64];
        { const bf16_t* qp = PL + (size_t)r * INW + O_Q + h * 64;
#pragma unroll
          for (int i = 0; i < 8; ++i) unpack8(*(const u32x4*)(qp + i * 8), q + i * 8); }
#pragma unroll
        for (int i = 0; i < 64; ++i) o[i] = 0.f;
        float m = -3.0e38f, lsum = 0.f;
        const bool lat = r < NLAT;
        const int gi = g.pos >> 6, gc = g.pos & 63;
        const int rs = min(max(gi - 4, 0), 56), wsc = min(max(gc - 8, 0), 48);
        const int nkey = lat ? 384 : 256;
#pragma unroll 1
        for (int kx = 0; kx < nkey; ++kx) {
            const bool win = lat && kx < 128;
            int krow; float bias = 0.f;
            if (win) { const int r8 = kx >> 4, cc = kx & 15; krow = g.b * SEQ + (rs + r8) * 64 + wsc + cc; bias = rpb[(h * 15 + (rs + r8 - gi + 7)) * 31 + (wsc + cc - gc + 15)]; }
            else krow = NLAT + g.b * CTXL + (kx - (lat ? 128 : 0));
            const bf16_t* kp = PL + (size_t)krow * INW + O_K + h * 64; float a = bias;
#pragma unroll
            for (int i = 0; i < 8; ++i) { float kf[8]; unpack8(*(const u32x4*)(kp + i * 8), kf);
#pragma unroll
                for (int j = 0; j < 8; ++j) a += q[i * 8 + j] * kf[j]; }
            if (a > m) { const float alpha = __expf(m - a); lsum *= alpha;
#pragma unroll
                for (int i = 0; i < 64; ++i) o[i] *= alpha;
                m = a; }
            const float p = __expf(a - m); lsum += p;
            const bf16_t* vp = kp + (O_V - O_K);
#pragma unroll
            for (int i = 0; i < 8; ++i) { float vf[8]; unpack8(*(const u32x4*)(vp + i * 8), vf);
#pragma unroll
                for (int j = 0; j < 8; ++j) o[i * 8 + j] += p * vf[j]; }
        }
        const float inv = 1.0f / lsum;
        bf16_t* op = MIX + (size_t)r * D + h * 64;
#pragma unroll
        for (int i = 0; i < 8; ++i) { u32x4 w; w.x = pk_bf16(o[i * 8] * inv, o[i * 8 + 1] * inv); w.y = pk_bf16(o[i * 8 + 2] * inv, o[i * 8 + 3] * inv);
            w.z = pk_bf16(o[i * 8 + 4] * inv, o[i * 8 + 5] * inv); w.w = pk_bf16(o[i * 8 + 6] * inv, o[i * 8 + 7] * inv); *(u32x4*)(op + i * 8) = w; }
    }
}

__device__ __forceinline__ void phase_final(const Frame& F, const Params& P) {
    float* out = P.out; const float* g = P.in[I_FINALG]; const int lane = F.lane;
    for (int r = F.gw; r < NLAT; r += F.nw) {
        float* xr = out + (size_t)r * D; f32x4 x[4]; float ss = 0.f;
#pragma unroll
        for (int j = 0; j < 4; ++j) { x[j] = *(const f32x4*)(xr + j * 256 + lane * 4); ss += x[j][0] * x[j][0] + x[j][1] * x[j][1] + x[j][2] * x[j][2] + x[j][3] * x[j][3]; }
        ss = wave_sum(ss); const float rstd = rsqrtf(ss * (1.0f / D) + 1e-6f);
#pragma unroll
        for (int j = 0; j < 4; ++j) { const f32x4 gg = *(const f32x4*)(g + j * 256 + lane * 4); *(f32x4*)(xr + j * 256 + lane * 4) = x[j] * rstd * gg; }
    }
}

constexpr int PH_L0 = 1, PH_PER_L0 = 9, PH_L1 = PH_L0 + PH_PER_L0, PH_PER_L1 = 12, PH_FINAL = PH_L1 + PH_PER_L1, N_PHASES = PH_FINAL + 1;
#define RFL(x) __builtin_amdgcn_readfirstlane(x)

PHASE ph_prologue(const void* kp_) { PHASE_ENTER; if constexpr (MKB(0)) phase_prologue(F, P); }
PHASE ph_norm1(const void* kp_, int l_) { PHASE_ENTER; const int l = RFL(l_);
    if constexpr (MKB(1)) phase_norm<false>(F, P, l, 0, NROW, l == 0 ? P.in[I_X] : P.out, l == 0 ? P.in[I_CTX] : (const float*)(F.ws + WS_XC)); }
PHASE_INL ph_gemm_win(const void* kp_, int l_) { PHASE_ENTER; const int l = RFL(l_);
    pg8::DenseSched S; S.init(NROW / 256, INW / 256, F.G, F.bid); S.A = (const bf16_t*)(F.ws + WS_HL); S.Bt = (const bf16_t*)(F.ws + WS_BTIN) + (size_t)l * INW * D; S.K = D;
    pg8::EpiBf16 E{(bf16_t*)(F.ws + WS_PL), INW, 2, 0.125f};
    if constexpr (MKB(2)) pg8::gemm_phase<pg8::EpiBf16, pg8::DenseSched, false>(F.lds, D, S, E); }
PHASE ph_rw_prep(const void* kp_, int l_) { PHASE_ENTER; const int l = RFL(l_); if constexpr (MKB(3)) phase_rw_prep(F, P, l); }
PHASE ph_conv(const void* kp_, int l_) { PHASE_ENTER; const int l = RFL(l_); if constexpr (MKB(4)) phase_conv(F, P, l, l == 0 ? NROW : NLAT); }
PHASE_INL ph_na(const void* kp_, int l_) { PHASE_ENTER; const int l = RFL(l_); if constexpr (MKB(5)) phase_na_simple(F, P, l, l == 0 ? NROW : NLAT); }
PHASE ph_scan(const void* kp_) { PHASE_ENTER; if constexpr (MKB(6)) phase_scan(F); }
PHASE ph_rw_post(const void* kp_, int l_) { PHASE_ENTER; const int l = RFL(l_); if constexpr (MKB(7)) phase_rw_post(F, P, l, l == 0 ? NROW : NLAT); }
PHASE_INL ph_gemm_wout(const void* kp_, int l_) { PHASE_ENTER; const int l = RFL(l_);
    float* XC = (float*)(F.ws + WS_XC);
    pg8::DenseSched S; S.init((l == 0 ? NROW : NLAT) / 256, D / 256, F.G, F.bid); S.A = (const bf16_t*)(F.ws + WS_MIX); S.Bt = (const bf16_t*)(F.ws + WS_BTOUT) + (size_t)l * D * D; S.K = D;
    pg8::EpiRes E{l == 0 ? P.in[I_X] : P.out, l == 0 ? P.in[I_CTX] : XC, P.out, XC, (const float*)(F.ws + WS_MODV) + (size_t)l * 9 * MODW + 2 * D};
    if constexpr (MKB(8)) pg8::gemm_phase<pg8::EpiRes, pg8::DenseSched, false>(F.lds, D, S, E); }
PHASE ph_norm2_l0(const void* kp_) { PHASE_ENTER; if constexpr (MKB(9)) phase_norm<false>(F, P, 0, 1, NROW, P.out, (const float*)(F.ws + WS_XC)); }
PHASE_INL ph_gemm_ffn_gu(const void* kp_) { PHASE_ENTER;
    pg8::DenseSched S; S.init(NROW / 256, (2 * DFF) / 256, F.G, F.bid); S.A = (const bf16_t*)(F.ws + WS_HL); S.Bt = (const bf16_t*)(F.ws + WS_BTGU); S.K = D;
    pg8::EpiSwiGLU E{(bf16_t*)(F.ws + WS_H), DFF};
    if constexpr (MKB(10)) pg8::gemm_phase<pg8::EpiSwiGLU, pg8::DenseSched, false>(F.lds, D, S, E); }
PHASE_INL ph_gemm_ffn_dn(const void* kp_) { PHASE_ENTER;
    float* XC = (float*)(F.ws + WS_XC);
    pg8::DenseSched S; S.init(NROW / 256, D / 256, F.G, F.bid); S.A = (const bf16_t*)(F.ws + WS_H); S.Bt = (const bf16_t*)(F.ws + WS_BTDN); S.K = DFF;
    pg8::EpiRes E{P.out, XC, P.out, XC, (const float*)(F.ws + WS_MODV) + 5 * D};
    if constexpr (MKB(11)) pg8::gemm_phase<pg8::EpiRes, pg8::DenseSched, false>(F.lds, DFF, S, E); }
PHASE ph_norm2_l1(const void* kp_) { PHASE_ENTER; if constexpr (MKB(12)) phase_norm<true>(F, P, 1, 1, NLAT, P.out, (const float*)(F.ws + WS_XC)); }
PHASE ph_moe_prep(const void* kp_) { PHASE_ENTER; if constexpr (MKB(13)) { phase_moe_rowmap(F); phase_moe_convert(F, P); } }
PHASE_INL ph_gemm_moe_gu(const void* kp_, int pass_) { PHASE_ENTER; const int pass = RFL(pass_);
    pg8::MoeSched S; moe_tstart(F, pass, S.tstart); S.init(S.tstart[8], (2 * DFE) / 256, F.G, F.bid);
    S.A = (const bf16_t*)(F.ws + WS_HL); S.Bt0 = F.ws + WS_MOE; S.e_stride = MOE_E_BYTES; S.K = D; S.rowmap = (const int*)(F.ws + WS_ROUTE + RT_RMAP) + pass * NROW;
    pg8::EpiSwiGLU E{(bf16_t*)(F.ws + WS_H), DFE};
    if constexpr (MKB(14)) pg8::gemm_phase<pg8::EpiSwiGLU, pg8::MoeSched, true>(F.lds, D, S, E); }
PHASE_INL ph_gemm_moe_dn(const void* kp_, int pass_) { PHASE_ENTER; const int pass = RFL(pass_);
    pg8::MoeSched S; moe_tstart(F, pass, S.tstart); S.init(S.tstart[8], D / 256, F.G, F.bid);
    S.A = (const bf16_t*)(F.ws + WS_H); S.Bt0 = F.ws + WS_MOE + MOE_GU_BYTES; S.e_stride = MOE_E_BYTES; S.K = DFE; S.rowmap = nullptr;
    pg8::EpiMoeDown E{P.out, (const float*)(F.ws + WS_MODV) + (size_t)9 * MODW + 5 * D, (const int*)(F.ws + WS_ROUTE + RT_RMAP) + pass * NROW, (const float*)(F.ws + WS_ROUTE + RT_SGATE) + pass * NROW};
    if constexpr (MKB(15)) pg8::gemm_phase<pg8::EpiMoeDown, pg8::MoeSched, false>(F.lds, DFE, S, E); }
PHASE ph_final(const void* kp_) { PHASE_ENTER; if constexpr (MKB(16)) phase_final(F, P); }

__global__ void __launch_bounds__(NTHREADS, 2) mk_fwd(Params P) {
    const void* kp = (const void*)__builtin_amdgcn_kernarg_segment_ptr();
    LAS unsigned char* lds = (LAS unsigned char*)lds_raw;
    volatile LAS unsigned* misc = (volatile LAS unsigned*)(lds + LDS_MISC);
    if (threadIdx.x < 4) misc[threadIdx.x] = 0u;
    __syncthreads();
    const int lo = P.ph_lo, hi = P.ph_hi;
    XcdBarrier bar; bar.bar = (unsigned*)(P.ws + WS_CTL) + CW_BAR; bar.x = 0; bar.st = misc;
    if (hi - lo > 1) bar = xcd_barrier_post((unsigned*)(P.ws + WS_CTL) + CW_BAR, misc);
#define IN(k) (lo <= (k) && (k) < hi)
#define SEAM(k) do { if (IN((k) + 1)) xcd_barrier(bar); } while (0)
    if (IN(0)) { ph_prologue(kp); SEAM(0); }
#pragma unroll 1
    for (int l = 0; l < 2; ++l) {
        const int pb = l == 0 ? PH_L0 : PH_L1;
        if (IN(pb + 0)) { ph_norm1(kp, l); SEAM(pb + 0); }
        if (IN(pb + 1)) { ph_gemm_win(kp, l); SEAM(pb + 1); }
        if (IN(pb + 2)) { ph_rw_prep(kp, l); ph_conv(kp, l); ph_na(kp, l); SEAM(pb + 2); }
        if (IN(pb + 3)) { ph_scan(kp); SEAM(pb + 3); }
        if (IN(pb + 4)) { ph_rw_post(kp, l); SEAM(pb + 4); }
        if (IN(pb + 5)) { ph_gemm_wout(kp, l); SEAM(pb + 5); }
        if (l == 0) {
            if (IN(pb + 6)) { ph_norm2_l0(kp); SEAM(pb + 6); }
            if (IN(pb + 7)) { ph_gemm_ffn_gu(kp); SEAM(pb + 7); }
            if (IN(pb + 8)) { ph_gemm_ffn_dn(kp); SEAM(pb + 8); }
        } else {
            if (IN(pb + 6)) { ph_norm2_l1(kp); SEAM(pb + 6); }
            if (IN(pb + 7)) { ph_moe_prep(kp); SEAM(pb + 7); }
#pragma unroll 1
            for (int pass = 0; pass < 2; ++pass) {
                if (IN(pb + 8 + 2 * pass)) { ph_gemm_moe_gu(kp, pass); SEAM(pb + 8 + 2 * pass); }
                if (IN(pb + 9 + 2 * pass)) { ph_gemm_moe_dn(kp, pass); SEAM(pb + 9 + 2 * pass); }
            }
        }
    }
    if (IN(PH_FINAL)) ph_final(kp);
#undef IN
#undef SEAM
}

extern "C" void kernel_launch(void* const* d_in, const int* in_sizes, int n_in, void* d_out, int out_size, void* d_ws, size_t ws_size, hipStream_t stream) {
    static int grid = 0;
    if (grid == 0) {
        if (n_in != 35 || out_size != NLAT * D || ws_size < WS_END) { fprintf(stderr, "kernel_launch: unexpected shapes (n_in %d out %d ws %zu need %zu)\n", n_in, out_size, ws_size, (size_t)WS_END); grid = -1; return; }
        int dev = 0, cus = 0, per_cu = 0;
        if (hipGetDevice(&dev) != hipSuccess || hipDeviceGetAttribute(&cus, hipDeviceAttributeMultiprocessorCount, dev) != hipSuccess) { grid = -1; return; }
        if (hipFuncSetAttribute((const void*)mk_fwd, hipFuncAttributeMaxDynamicSharedMemorySize, LDS_BYTES) != hipSuccess) { fprintf(stderr, "kernel_launch: hipFuncSetAttribute failed\n"); grid = -1; return; }
        if (hipOccupancyMaxActiveBlocksPerMultiprocessor(&per_cu, (const void*)mk_fwd, NTHREADS, LDS_BYTES) != hipSuccess || per_cu < 1) { fprintf(stderr, "kernel_launch: occupancy query says %d\n", per_cu); (void)hipGetLastError(); }
        grid = cus;
    }
    if (grid < 0) return;
    (void)hipMemsetAsync((char*)d_ws + WS_CTL, 0, CTL_BYTES, stream);
    Params p{};
    for (int i = 0; i < 35; ++i) p.in[i] = (const float*)d_in[i];
    p.out = (float*)d_out; p.ws = (unsigned char*)d_ws;
#if MK_ONE_LAUNCH
    p.ph_lo = 0; p.ph_hi = N_PHASES;
    hipLaunchKernelGGL(mk_fwd, dim3(grid), dim3(NTHREADS), LDS_BYTES, stream, p);
#else
    for (int k = 0; k < N_PHASES && k <= MK_LAST; ++k) { p.ph_lo = k; p.ph_hi = k + 1; hipLaunchKernelGGL(mk_fwd, dim3(grid), dim3(NTHREADS), LDS_BYTES, stream, p); }
#endif
}
```

```cpp
#include <hip/hip_runtime.h>
#include <stdint.h>
#include <stdio.h>

#ifndef MK_MASK
#define MK_MASK 0xFFFFFFFFu
#endif
#define MKB(k) (((MK_MASK) >> (k)) & 1u)
#ifndef MK_LAST
#define MK_LAST 99
#endif
#ifndef MK_ONE_LAUNCH
#define MK_ONE_LAUNCH 1
#endif

#define LAS __attribute__((address_space(3)))
typedef unsigned short bf16_t;
typedef _Float16 f16_t;
typedef short bf16x8 __attribute__((ext_vector_type(8)));
typedef float f32x4 __attribute__((ext_vector_type(4)));
typedef float f32x2 __attribute__((ext_vector_type(2)));
typedef unsigned u32x4 __attribute__((ext_vector_type(4)));
typedef unsigned u32x2 __attribute__((ext_vector_type(2)));
typedef f16_t f16x4 __attribute__((ext_vector_type(4)));
typedef f16_t f16x8 __attribute__((ext_vector_type(8)));

constexpr int D = 1024, NB = 8, SEQ = 4096, CTXL = 256, TT = CTXL + SEQ;
constexpr int NLAT = NB * SEQ, NCTX = NB * CTXL, NROW = NLAT + NCTX;
constexpr int INW = 3328, DFF = 2816, DFE = 3584, NEXP = 8;
constexpr int O_Q = 0, O_K = 512, O_V = 1024, O_RW = 1536, O_CV = 2816;
constexpr int MODW = 6 * D;
constexpr int NTHREADS = 512, NWAVES = 8;
constexpr int LDS_BYTES = 160 * 1024;
constexpr int LDS_MISC = LDS_BYTES - 256;

constexpr size_t al256(size_t x) { return (x + 255) & ~(size_t)255; }
constexpr size_t WS_CTL   = 0;
constexpr size_t CTL_BYTES = 65536;
constexpr size_t WS_MODV  = WS_CTL + CTL_BYTES;
constexpr size_t WS_BTIN  = al256(WS_MODV + (size_t)2 * 9 * MODW * 4);
constexpr size_t WS_BTOUT = al256(WS_BTIN + (size_t)2 * INW * D * 2);
constexpr size_t WS_BTGU  = al256(WS_BTOUT + (size_t)2 * D * D * 2);
constexpr size_t WS_BTDN  = al256(WS_BTGU + (size_t)2 * DFF * D * 2);
constexpr size_t WS_MOE   = al256(WS_BTDN + (size_t)D * DFF * 2);
constexpr size_t MOE_GU_BYTES = (size_t)2 * DFE * D * 2, MOE_DN_BYTES = (size_t)D * DFE * 2, MOE_E_BYTES = MOE_GU_BYTES + MOE_DN_BYTES;
constexpr size_t WS_SH    = WS_MOE;
constexpr size_t SH_BYTES = (size_t)NB * 4 * TT * 192 * 2;
constexpr size_t WS_SD    = WS_SH + SH_BYTES;
constexpr size_t WS_XC    = al256(WS_MOE + (size_t)NEXP * MOE_E_BYTES);
constexpr size_t WS_HL    = al256(WS_XC + (size_t)NCTX * D * 4);
constexpr size_t WS_Y     = WS_HL;
constexpr size_t WS_PL    = al256(WS_HL + (size_t)NROW * D * 2);
constexpr size_t WS_MIX   = al256(WS_PL + (size_t)NROW * INW * 2);
constexpr size_t WS_H     = WS_PL;
constexpr size_t WS_ROUTE = al256(WS_MIX + (size_t)NROW * D * 2);
constexpr size_t RT_TOKE  = 0;
constexpr size_t RT_TOKG  = RT_TOKE + (size_t)NLAT * 2 * 4;
constexpr size_t RT_TOKP  = RT_TOKG + (size_t)NLAT * 2 * 4;
constexpr size_t RT_RMAP  = RT_TOKP + (size_t)NLAT * 2 * 4;
constexpr size_t RT_SGATE = RT_RMAP + (size_t)2 * NROW * 4;
constexpr size_t WS_END   = al256(WS_ROUTE + RT_SGATE + (size_t)2 * NROW * 4);
static_assert(SH_BYTES * 3 <= (size_t)NEXP * MOE_E_BYTES, "scan inputs must fit the MoE weight region");
static_assert((size_t)NROW * DFE * 2 <= (size_t)NROW * INW * 2 + (size_t)NROW * D * 2, "H must fit PL+MIX");

constexpr int CW_BAR = 0;
constexpr int CW_MOECNT = 4096;

#define XB_TMO      128
#define XB_XCNT(j)  (256  + 64 * (j))
#define XB_XSUB(j)  (1280 + 64 * (j))
#define XB_XGEN(j)  (2304 + 64 * (j))
#define XB_TOP      3328
#define XB_TOPGEN   3392
#define XCD_BAR_WORDS 3456
#define XB_SPIN_CAP (1u << 22)

__device__ __forceinline__ unsigned xb_ld(unsigned* p)              { return __hip_atomic_load(p, __ATOMIC_RELAXED, __HIP_MEMORY_SCOPE_AGENT); }
__device__ __forceinline__ unsigned xb_add(unsigned* p, unsigned v) { return __hip_atomic_fetch_add(p, v, __ATOMIC_RELAXED, __HIP_MEMORY_SCOPE_AGENT); }
__device__ __forceinline__ unsigned xb_xcc_id() { return (unsigned)__builtin_amdgcn_s_getreg((3 << 11) | 20) & 0xFu; }
#define XB_SPIN(cond, bar) do { unsigned _sp = 0; while (cond) { __builtin_amdgcn_s_sleep(1); \
    if ((++_sp & 255u) == 0u) { if (xb_ld(&(bar)[XB_TMO])) break; if (_sp > XB_SPIN_CAP) { atomicAdd(&(bar)[XB_TMO], 1u); break; } } } } while (0)

struct XcdBarrier { unsigned* bar; unsigned x; volatile LAS unsigned* st; };

__device__ __forceinline__ XcdBarrier xcd_barrier_post(unsigned* bar, volatile LAS unsigned* st) {
    XcdBarrier b; b.bar = bar; b.x = xb_xcc_id(); b.st = st;
    if (threadIdx.x == 0) (void)xb_add(&bar[XB_XCNT(b.x)], 1u);
    return b;
}
__device__ __forceinline__ void xcd_barrier_complete(unsigned* bar, unsigned x, unsigned& nloc, unsigned& nx) {
    const unsigned G = gridDim.x * gridDim.y * gridDim.z;
    unsigned sum, cnt, mine, sp = 0u;
    for (;;) {
        sum = 0u; cnt = 0u; mine = 0u;
#pragma unroll
        for (unsigned j = 0; j < 16; ++j) { const unsigned c = xb_ld(&bar[XB_XCNT(j)]); sum += c; cnt += (c > 0u) ? 1u : 0u; mine = (j == x) ? c : mine; }
        if (sum == G) break;
        __builtin_amdgcn_s_sleep(1);
        if ((++sp & 255u) == 0u) { if (xb_ld(&bar[XB_TMO])) break; if (sp > XB_SPIN_CAP) { atomicAdd(&bar[XB_TMO], 1u); break; } }
    }
    nloc = mine > 0u ? mine : 1u; nx = cnt > 0u ? cnt : 1u;
}
__device__ __forceinline__ void xcd_barrier(const XcdBarrier& b) {
    asm volatile("s_waitcnt vmcnt(0)" ::: "memory");
    __syncthreads();
    if (threadIdx.x == 0) {
        unsigned* bar = b.bar;
        __builtin_amdgcn_s_waitcnt(0);
        unsigned nloc = b.st[0], nx = b.st[1];
        if (nloc == 0u) { xcd_barrier_complete(bar, b.x, nloc, nx); b.st[0] = nloc; b.st[1] = nx; }
        const unsigned old = xb_add(&bar[XB_XSUB(b.x)], 1u);
        const unsigned gen = old / nloc;
        if (old + 1u == (gen + 1u) * nloc) {
            __builtin_amdgcn_fence(__ATOMIC_RELEASE, "agent");
            asm volatile("s_waitcnt vmcnt(0)" ::: "memory");
            const unsigned og = xb_add(&bar[XB_TOP], 1u);
            const unsigned tg = og / nx;
            if (og + 1u == (tg + 1u) * nx) xb_add(&bar[XB_TOPGEN], 1u);
            else XB_SPIN(xb_ld(&bar[XB_TOPGEN]) == tg, bar);
            __builtin_amdgcn_fence(__ATOMIC_ACQUIRE, "agent");
            xb_add(&bar[XB_XGEN(b.x)], 1u);
            asm volatile("s_waitcnt vmcnt(0)" ::: "memory");
        } else {
            XB_SPIN(xb_ld(&bar[XB_XGEN(b.x)]) == gen, bar);
            __builtin_amdgcn_fence(__ATOMIC_ACQUIRE, "agent");
            asm volatile("s_waitcnt vmcnt(0)" ::: "memory");
        }
    }
    __syncthreads();
}

__device__ __forceinline__ float bf2f(bf16_t b) { return __uint_as_float(((unsigned)b) << 16); }
__device__ __forceinline__ bf16_t f2bf(float f) { unsigned u = __float_as_uint(f); u += 0x7FFFu + ((u >> 16) & 1u); return (bf16_t)(u >> 16); }
__device__ __forceinline__ unsigned pk_bf16(float lo, float hi) { return (unsigned)f2bf(lo) | ((unsigned)f2bf(hi) << 16); }
__device__ __forceinline__ unsigned cvt_pk_bf16(float lo, float hi) { unsigned r; asm volatile("v_cvt_pk_bf16_f32 %0, %1, %2" : "=v"(r) : "v"(lo), "v"(hi)); return r; }
__device__ __forceinline__ float sigmoidf_(float x) { return 1.0f / (1.0f + __expf(-x)); }
__device__ __forceinline__ float siluf_(float x) { return x / (1.0f + __expf(-x)); }
__device__ __forceinline__ float wave_sum(float v) {
#pragma unroll
    for (int o = 32; o >= 1; o >>= 1) v += __shfl_xor(v, o);
    return v;
}
__device__ __forceinline__ float sum16(float v) {
    v += __shfl_xor(v, 1); v += __shfl_xor(v, 2); v += __shfl_xor(v, 4); v += __shfl_xor(v, 8); return v;
}
__device__ __forceinline__ void unpack4(u32x2 w, float (&f)[4]) {
    f[0] = __uint_as_float(w.x << 16); f[1] = __uint_as_float(w.x & 0xffff0000u); f[2] = __uint_as_float(w.y << 16); f[3] = __uint_as_float(w.y & 0xffff0000u);
}
__device__ __forceinline__ void unpack8(u32x4 w, float* f) {
    f[0] = __uint_as_float(w.x << 16); f[1] = __uint_as_float(w.x & 0xffff0000u); f[2] = __uint_as_float(w.y << 16); f[3] = __uint_as_float(w.y & 0xffff0000u);
    f[4] = __uint_as_float(w.z << 16); f[5] = __uint_as_float(w.z & 0xffff0000u); f[6] = __uint_as_float(w.w << 16); f[7] = __uint_as_float(w.w & 0xffff0000u);
}

struct Params {
    const float* in[35];
    float* out; unsigned char* ws;
    int ph_lo, ph_hi;
};
enum { I_X = 0, I_C, I_CTX, I_CCTX, I_N1G, I_N2G, I_MODW, I_MODB, I_WIN, I_WOUT, I_RPB, I_MUP, I_MUN, I_W0, I_W2, I_A0, I_A2, I_G2, I_KK, I_KA, I_RK, I_GNG, I_GNB,
       I_DWW, I_DWB, I_LNG, I_LNB, I_FG, I_FU, I_FD, I_ROUTER, I_MG, I_MU, I_MD, I_FINALG };

__device__ __forceinline__ int row_mi(int r) { return r < NLAT ? (r >> 12) : 8; }

namespace pg8 {
constexpr int BM = 256, BK = 64, HALF = 128, HTB = HALF * BK * 2, STAGE_BYTES = 8 * HTB, NXCD = 8, WGM = 8;
__device__ __forceinline__ int lds_byte(int r, int c) { const int st = (r >> 4) * 2 + (c >> 5), rr = r & 15, cc = c & 31, ob = rr * 64 + cc * 2; return st * 1024 + (ob ^ (((ob >> 9) & 1) << 5)); }
__device__ __forceinline__ void stage_rc(int b, int& R, int& C) { const int st = b / 1024, sb = b % 1024, swz = sb ^ (((sb >> 9) & 1) << 5); R = (st >> 1) * 16 + swz / 64; C = (st & 1) * 32 + (swz % 64) / 2; }
__device__ __forceinline__ int perm32(int rho) { const int n = rho >> 4, i = rho & 15; return 8 * (i >> 2) + 4 * n + (i & 3); }
struct Unit { int pm, pn; };

struct TileOrder {
    int nM, nN, nwg, G, c;
    __device__ void init(int nM_, int nN_, int G_, int c_) { nM = nM_; nN = nN_; nwg = nM * nN; G = G_; c = c_; }
    __device__ bool next(int i, Unit& u) const {
        const long L = (long)i * G + c; if (L >= nwg) return false;
        int wgid = (int)L; { const int q = nwg / NXCD, r = nwg % NXCD, xcd = wgid % NXCD, off = wgid / NXCD; wgid = (xcd < r ? xcd * (q + 1) : r * (q + 1) + (xcd - r) * q) + off; }
        const int nig = WGM * nN, gid = wgid / nig, fm = gid * WGM, gsz = (nM - fm) < WGM ? (nM - fm) : WGM;
        u.pm = fm + ((wgid % nig) % gsz); u.pn = (wgid % nig) / gsz; return true;
    }
};
struct DenseSched : TileOrder {
    const bf16_t* A; const bf16_t* Bt; int K;
    __device__ __forceinline__ const char* aptr(const Unit& u) const { return (const char*)A + (size_t)u.pm * BM * K * 2; }
    __device__ __forceinline__ const char* bptr(const Unit& u) const { return (const char*)Bt + (size_t)u.pn * BM * K * 2; }
    __device__ __forceinline__ const char* abase() const { return (const char*)A; }
    __device__ __forceinline__ int arow(const Unit&, int) const { return 0; }
};
struct MoeSched : TileOrder {
    const bf16_t* A; const unsigned char* Bt0; size_t e_stride; int K; const int* rowmap; int tstart[9];
    __device__ __forceinline__ int expert(int pm) const { int e = 0;
#pragma unroll
        for (int j = 1; j < 8; ++j) e += (pm >= tstart[j]) ? 1 : 0;
        return e; }
    __device__ __forceinline__ const char* aptr(const Unit& u) const { return (const char*)A + (size_t)u.pm * BM * K * 2; }
    __device__ __forceinline__ const char* bptr(const Unit& u) const { return (const char*)Bt0 + (size_t)expert(u.pm) * e_stride + (size_t)u.pn * BM * K * 2; }
    __device__ __forceinline__ const char* abase() const { return (const char*)A; }
    __device__ __forceinline__ int arow(const Unit& u, int r) const { const int t = rowmap[u.pm * BM + r]; return t < 0 ? 0 : t; }
};

struct EpiBf16 {
    static constexpr bool PERM = true;
    bf16_t* O; int ldc; int nscale; float scale;
    __device__ __forceinline__ void operator()(const f32x4 (&acc)[2][2][4][2], const Unit& u, int wr, int wc, int fr, int fq) const {
        const int row0 = u.pm * BM + wr * 64 + fr, col0 = u.pn * BM + wc * 32 + 8 * fq;
        const float s = u.pn < nscale ? scale : 1.0f;
#pragma unroll
        for (int ai = 0; ai < 2; ++ai)
#pragma unroll
            for (int m = 0; m < 4; ++m) { bf16_t* rowp = O + (size_t)(row0 + ai * HALF + m * 16) * ldc + col0;
#pragma unroll
                for (int bj = 0; bj < 2; ++bj) { const f32x4 v0 = acc[ai][bj][m][0] * s, v1 = acc[ai][bj][m][1] * s;
                    u32x4 w; w.x = cvt_pk_bf16(v0[0], v0[1]); w.y = cvt_pk_bf16(v0[2], v0[3]); w.z = cvt_pk_bf16(v1[0], v1[1]); w.w = cvt_pk_bf16(v1[2], v1[3]);
                    *(u32x4*)(rowp + bj * HALF) = w; } }
    }
};
struct EpiSwiGLU {
    static constexpr bool PERM = true;
    bf16_t* H; int ldh;
    __device__ __forceinline__ void operator()(const f32x4 (&acc)[2][2][4][2], const Unit& u, int wr, int wc, int fr, int fq) const {
        const int row0 = u.pm * BM + wr * 64 + fr, col0 = u.pn * HALF + wc * 32 + 8 * fq;
#pragma unroll
        for (int ai = 0; ai < 2; ++ai)
#pragma unroll
            for (int m = 0; m < 4; ++m) { bf16_t* rowp = H + (size_t)(row0 + ai * HALF + m * 16) * ldh + col0;
                float h[8];
#pragma unroll
                for (int n = 0; n < 2; ++n)
#pragma unroll
                    for (int j = 0; j < 4; ++j) { const float g = acc[ai][0][m][n][j], up = acc[ai][1][m][n][j]; h[n * 4 + j] = g / (1.0f + __expf(-g)) * up; }
                u32x4 w; w.x = cvt_pk_bf16(h[0], h[1]); w.y = cvt_pk_bf16(h[2], h[3]); w.z = cvt_pk_bf16(h[4], h[5]); w.w = cvt_pk_bf16(h[6], h[7]);
                *(u32x4*)rowp = w; }
    }
};
struct EpiRes {
    static constexpr bool PERM = false;
    const float* resL; const float* resC; float* outL; float* outC; const float* gvec;
    __device__ __forceinline__ void operator()(const f32x4 (&acc)[2][2][4][2], const Unit& u, int wr, int wc, int fr, int fq) const {
        const int r0 = u.pm * BM; const bool lat = r0 < NLAT;
        const float* res = lat ? resL + (size_t)r0 * D : resC + (size_t)(r0 - NLAT) * D;
        float* out = lat ? outL + (size_t)r0 * D : outC + (size_t)(r0 - NLAT) * D;
        const float* gv = gvec + (size_t)(lat ? (r0 >> 12) : 8) * MODW;
        const int rl = wr * 64 + fr, col0 = u.pn * BM + wc * 32 + 4 * fq;
        f32x4 g[2][2];
#pragma unroll
        for (int bj = 0; bj < 2; ++bj)
#pragma unroll
            for (int n = 0; n < 2; ++n) g[bj][n] = *(const f32x4*)(gv + col0 + bj * HALF + n * 16);
#pragma unroll
        for (int ai = 0; ai < 2; ++ai)
#pragma unroll
            for (int m = 0; m < 4; ++m) { const size_t off = (size_t)(rl + ai * HALF + m * 16) * D + col0;
#pragma unroll
                for (int bj = 0; bj < 2; ++bj)
#pragma unroll
                    for (int n = 0; n < 2; ++n) { const f32x4 rv = *(const f32x4*)(res + off + bj * HALF + n * 16);
                        *(f32x4*)(out + off + bj * HALF + n * 16) = rv + g[bj][n] * acc[ai][bj][m][n]; } }
    }
};
struct EpiMoeDown {
    static constexpr bool PERM = false;
    float* xl; const float* gvec; const int* rowmap; const float* sgate;
    __device__ __forceinline__ void operator()(const f32x4 (&acc)[2][2][4][2], const Unit& u, int wr, int wc, int fr, int fq) const {
        const int rl = u.pm * BM + wr * 64 + fr, col0 = u.pn * BM + wc * 32 + 4 * fq;
#pragma unroll
        for (int ai = 0; ai < 2; ++ai)
#pragma unroll
            for (int m = 0; m < 4; ++m) { const int slot = rl + ai * HALF + m * 16; const int tok = rowmap[slot];
                if (tok >= 0) { const float sg = sgate[slot]; const float* gv = gvec + (size_t)(tok >> 12) * MODW + col0; float* xp = xl + (size_t)tok * D + col0;
#pragma unroll
                    for (int bj = 0; bj < 2; ++bj)
#pragma unroll
                        for (int n = 0; n < 2; ++n) { const f32x4 g = *(const f32x4*)(gv + bj * HALF + n * 16); const f32x4 rv = *(const f32x4*)(xp + bj * HALF + n * 16);
                            *(f32x4*)(xp + bj * HALF + n * 16) = rv + (g * sg) * acc[ai][bj][m][n]; } } }
    }
};

template <class Epi, class Sched, bool GATHER>
__device__ __forceinline__ void gemm_phase(LAS unsigned char* lds, const int K, const Sched& S, const Epi& E) {
    int tid_ = threadIdx.x; asm volatile("" : "+v"(tid_));
    const int tid = tid_, wid = __builtin_amdgcn_readfirstlane(tid >> 6), lane = tid & 63, wr = wid >> 2, wc = wid & 3, fr = lane & 15, fq = lane >> 4;
    const int nt = K / BK;
    unsigned voffA[2], voffB[2]; int RA[2], CA[2];
#pragma unroll
    for (int i = 0; i < 2; ++i) { int R, C; stage_rc(tid * 16 + i * 8192, R, C); const int Rb = Epi::PERM ? ((R & ~31) + perm32(R & 31)) : R;
        voffA[i] = (unsigned)(R * K + C) * 2u; voffB[i] = (unsigned)(Rb * K + C) * 2u; RA[i] = R; CA[i] = C; }
    const size_t kstep = (size_t)(BK * 2);
    const size_t hstep = (size_t)HALF * K * 2;
    const unsigned ldsw = (unsigned)wid * 1024u;
    const int aoff = lds_byte(wr * 64 + fr, fq * 8), boff = lds_byte(wc * 32 + fr, fq * 8);
#define PG8_SA(b, h) (((b) * 2 + (h)) * HTB)
#define PG8_SB(b, h) ((4 + (b) * 2 + (h)) * HTB)
#define PG8_STAGE(bufoff, gbase, voff) do { _Pragma("unroll") for (int _i = 0; _i < 2; ++_i) \
        __builtin_amdgcn_global_load_lds((const unsigned*)((const char*)(gbase) + (voff)[_i]), (LAS unsigned*)(lds + (bufoff) + ldsw + _i * 8192), 16, 0, 0); } while (0)
#define PG8_LDA(dst, b, h) do { _Pragma("unroll") for (int m = 0; m < 4; ++m) _Pragma("unroll") for (int k = 0; k < 2; ++k) dst[m][k] = *(const LAS bf16x8*)(lds + PG8_SA(b, h) + aoff + m * 2048 + k * 1024); } while (0)
#define PG8_LDB(dst, b, h) do { _Pragma("unroll") for (int n = 0; n < 2; ++n) _Pragma("unroll") for (int k = 0; k < 2; ++k) dst[n][k] = *(const LAS bf16x8*)(lds + PG8_SB(b, h) + boff + n * 2048 + k * 1024); } while (0)
#define PG8_MMA(ai, bj, At, Bt) do { __builtin_amdgcn_s_setprio(1); _Pragma("unroll") for (int m = 0; m < 4; ++m) _Pragma("unroll") for (int n = 0; n < 2; ++n) _Pragma("unroll") for (int k = 0; k < 2; ++k) \
        acc[ai][bj][m][n] = __builtin_amdgcn_mfma_f32_16x16x32_bf16(Bt[n][k], At[m][k], acc[ai][bj][m][n], 0, 0, 0); __builtin_amdgcn_s_setprio(0); } while (0)
#define PG8_WAIT_V(n) asm volatile("s_waitcnt vmcnt(" #n ")" ::: "memory")
#define PG8_WAIT_L(n) asm volatile("s_waitcnt lgkmcnt(" #n ")" ::: "memory")
#define PG8_BAR __builtin_amdgcn_s_barrier()
#define PG8_SCHED __builtin_amdgcn_sched_barrier(0)
#define PG8_STAGE_A(bufoff, TS, H) do { if constexpr (GATHER) { PG8_STAGE(bufoff, gA##TS, oA##TS[H]); } else { PG8_STAGE(bufoff, a##TS + (H) * hstep, voffA); } } while (0)
    Unit cur, nxt; int ui = 0;
    if (!S.next(0, cur)) return;
    f32x4 acc[2][2][4][2];
#pragma unroll
    for (int a = 0; a < 2; ++a)
#pragma unroll
        for (int b = 0; b < 2; ++b)
#pragma unroll
            for (int m = 0; m < 4; ++m)
#pragma unroll
                for (int n = 0; n < 2; ++n) acc[a][b][m][n] = (f32x4){0.f, 0.f, 0.f, 0.f};
    bf16x8 At[4][2], B0[2][2], B1[2][2];
    const char* Abase = S.abase();
    unsigned aoC[2][2] = {{0u, 0u}, {0u, 0u}}, aoN[2][2] = {{0u, 0u}, {0u, 0u}};
    if constexpr (GATHER) {
#pragma unroll
        for (int h = 0; h < 2; ++h)
#pragma unroll
            for (int i = 0; i < 2; ++i) aoC[h][i] = (unsigned)(S.arow(cur, h * HALF + RA[i]) * K + CA[i]) * 2u;
    }
    const char* cA = GATHER ? Abase : S.aptr(cur); const char* cB = S.bptr(cur);
    if constexpr (GATHER) {
        PG8_STAGE(PG8_SB(0, 0), cB, voffB); PG8_STAGE(PG8_SA(0, 0), Abase, aoC[0]); PG8_STAGE(PG8_SB(0, 1), cB + hstep, voffB); PG8_STAGE(PG8_SA(0, 1), Abase, aoC[1]);
    } else {
        PG8_STAGE(PG8_SB(0, 0), cB, voffB); PG8_STAGE(PG8_SA(0, 0), cA, voffA); PG8_STAGE(PG8_SB(0, 1), cB + hstep, voffB); PG8_STAGE(PG8_SA(0, 1), cA + hstep, voffA);
    }
    if (wr == 1) PG8_BAR;
    PG8_WAIT_V(4); PG8_BAR;
    if constexpr (GATHER) {
        PG8_STAGE(PG8_SB(1, 0), cB + kstep, voffB); PG8_STAGE(PG8_SA(1, 0), Abase + kstep, aoC[0]); PG8_STAGE(PG8_SB(1, 1), cB + hstep + kstep, voffB);
    } else {
        PG8_STAGE(PG8_SB(1, 0), cB + kstep, voffB); PG8_STAGE(PG8_SA(1, 0), cA + kstep, voffA); PG8_STAGE(PG8_SB(1, 1), cB + hstep + kstep, voffB);
    }
    PG8_WAIT_V(6); PG8_BAR;
    for (;;) {
        const bool has_next = S.next(ui + 1, nxt);
        const char* nA = has_next ? (GATHER ? Abase : S.aptr(nxt)) : cA; const char* nB = has_next ? S.bptr(nxt) : cB;
        if constexpr (GATHER) {
            if (has_next) {
#pragma unroll
                for (int h = 0; h < 2; ++h)
#pragma unroll
                    for (int i = 0; i < 2; ++i) aoN[h][i] = (unsigned)(S.arow(nxt, h * HALF + RA[i]) * K + CA[i]) * 2u;
            } else {
#pragma unroll
                for (int h = 0; h < 2; ++h)
#pragma unroll
                    for (int i = 0; i < 2; ++i) aoN[h][i] = aoC[h][i];
            }
        }
        for (int t = 0; t < nt; t += 2) {
            const bool last = (t == nt - 2);
            const char* a1 = cA + (size_t)(t + 1) * kstep;
            const char* a2 = last ? nA : cA + (size_t)(t + 2) * kstep; const char* b2 = last ? nB : cB + (size_t)(t + 2) * kstep;
            const char* a3 = a2 + kstep; const char* b3 = b2 + kstep;
            const char* gA1 = Abase + (size_t)(t + 1) * kstep; const char* gA2 = Abase + (last ? (size_t)0 : (size_t)(t + 2) * kstep); const char* gA3 = gA2 + kstep;
            unsigned oA1[2][2], oA2[2][2], oA3[2][2];
#pragma unroll
            for (int h = 0; h < 2; ++h)
#pragma unroll
                for (int i = 0; i < 2; ++i) { oA1[h][i] = aoC[h][i]; oA2[h][i] = last ? aoN[h][i] : aoC[h][i]; oA3[h][i] = oA2[h][i]; }
            (void)a1; (void)a3; (void)gA1; (void)gA3; (void)oA1; (void)oA3;
            PG8_LDB(B0, 0, 0); PG8_SCHED; PG8_LDA(At, 0, 0); PG8_STAGE_A(PG8_SA(1, 1), 1, 1);
            PG8_WAIT_L(8); PG8_BAR; PG8_WAIT_L(0); PG8_MMA(0, 0, At, B0); PG8_BAR; PG8_SCHED;
            PG8_LDB(B1, 0, 1); PG8_STAGE(PG8_SB(0, 0), b2, voffB);
            PG8_BAR; PG8_WAIT_L(0); PG8_MMA(0, 1, At, B1); PG8_BAR;
            PG8_LDA(At, 0, 1); PG8_STAGE_A(PG8_SA(0, 0), 2, 0);
            PG8_BAR; PG8_WAIT_L(0); PG8_MMA(1, 0, At, B0); PG8_BAR; PG8_SCHED;
            PG8_STAGE(PG8_SB(0, 1), b2 + hstep, voffB);
            PG8_WAIT_V(6); PG8_BAR; PG8_MMA(1, 1, At, B1); PG8_BAR;
            PG8_LDB(B0, 1, 0); PG8_SCHED; PG8_LDA(At, 1, 0); PG8_STAGE_A(PG8_SA(0, 1), 2, 1);
            PG8_WAIT_L(8); PG8_BAR; PG8_WAIT_L(0); PG8_MMA(0, 0, At, B0); PG8_BAR; PG8_SCHED;
            PG8_LDB(B1, 1, 1); PG8_STAGE(PG8_SB(1, 0), b3, voffB);
            PG8_BAR; PG8_WAIT_L(0); PG8_MMA(0, 1, At, B1); PG8_BAR;
            PG8_LDA(At, 1, 1); PG8_STAGE_A(PG8_SA(1, 0), 3, 0);
            PG8_BAR; PG8_WAIT_L(0); PG8_MMA(1, 0, At, B0); PG8_BAR; PG8_SCHED;
            PG8_STAGE(PG8_SB(1, 1), b3 + hstep, voffB);
            PG8_WAIT_V(6); PG8_BAR; PG8_MMA(1, 1, At, B1); PG8_BAR;
        }
        E(acc, cur, wr, wc, fr, fq);
        if (!has_next) break;
#pragma unroll
        for (int a = 0; a < 2; ++a)
#pragma unroll
            for (int b = 0; b < 2; ++b)
#pragma unroll
                for (int m = 0; m < 4; ++m)
#pragma unroll
                    for (int n = 0; n < 2; ++n) acc[a][b][m][n] = (f32x4){0.f, 0.f, 0.f, 0.f};
        cur = nxt; cA = nA; cB = nB; ++ui;
        if constexpr (GATHER) {
#pragma unroll
            for (int h = 0; h < 2; ++h)
#pragma unroll
                for (int i = 0; i < 2; ++i) aoC[h][i] = aoN[h][i];
        }
    }
    PG8_WAIT_V(0);
    if (wr == 0) PG8_BAR;
    PG8_BAR;
#undef PG8_SA
#undef PG8_SB
#undef PG8_STAGE
#undef PG8_STAGE_A
#undef PG8_LDA
#undef PG8_LDB
#undef PG8_MMA
#undef PG8_WAIT_V
#undef PG8_WAIT_L
#undef PG8_BAR
#undef PG8_SCHED
}
}

struct Frame {
    LAS unsigned char* lds; int tid, lane, wave, G, bid, gw, nw;
    unsigned char* ws;
};
extern __shared__ __attribute__((aligned(16))) unsigned char lds_raw[];
typedef const __attribute__((address_space(4))) Params* KP;
__device__ __forceinline__ Params load_params(const void* kp_) {
    const unsigned long long v = (unsigned long long)kp_;
    const unsigned lo = __builtin_amdgcn_readfirstlane((unsigned)v), hi = __builtin_amdgcn_readfirstlane((unsigned)(v >> 32));
    KP kp = (KP)(((unsigned long long)hi << 32) | lo);
    Params P;
#pragma unroll
    for (int i = 0; i < 35; ++i) P.in[i] = kp->in[i];
    P.out = kp->out; P.ws = kp->ws; P.ph_lo = kp->ph_lo; P.ph_hi = kp->ph_hi;
    return P;
}
#define PHASE static __attribute__((noinline)) __device__ void
#define PHASE_INL static __device__ __forceinline__ void
__device__ __forceinline__ Frame make_frame(unsigned char* ws) {
    Frame F; F.lds = (LAS unsigned char*)lds_raw; F.tid = threadIdx.x; F.lane = F.tid & 63; F.wave = __builtin_amdgcn_readfirstlane(F.tid >> 6);
    F.G = gridDim.x; F.bid = blockIdx.x; F.gw = F.bid * NWAVES + F.wave; F.nw = F.G * NWAVES; F.ws = ws; return F;
}
#define PHASE_ENTER const Params P = load_params(kp_); const Frame F = make_frame(P.ws)

__device__ __forceinline__ void conv_job(const Frame& F, const float* src, bf16_t* dst, int K, int N, int mode) {
    LAS float* tile = (LAS float*)(F.lds + F.wave * (64 * 65 * 4));
    const int tk = K / 64, tn = N / 64, ntile = tk * tn, lane = F.lane;
    for (int t = F.gw; t < ntile; t += F.nw) {
        const int k0 = (t / tn) * 64, n0 = (t % tn) * 64;
#pragma unroll 4
        for (int i = 0; i < 16; ++i) { const int row = i * 4 + (lane >> 4), c4 = (lane & 15) * 4;
            const f32x4 v = *(const f32x4*)(src + (size_t)(k0 + row) * N + n0 + c4);
            tile[row * 65 + c4 + 0] = v[0]; tile[row * 65 + c4 + 1] = v[1]; tile[row * 65 + c4 + 2] = v[2]; tile[row * 65 + c4 + 3] = v[3]; }
        __builtin_amdgcn_wave_barrier(); asm volatile("s_waitcnt lgkmcnt(0)" ::: "memory");
#pragma unroll 2
        for (int i = 0; i < 8; ++i) { const int n = i * 8 + (lane >> 3), kc = (lane & 7) * 8;
            float f[8];
#pragma unroll
            for (int j = 0; j < 8; ++j) f[j] = tile[(kc + j) * 65 + n];
            const int ng = n0 + n; const int drow = mode == 0 ? ng : ((ng >> 7) * 256 + (mode == 2 ? 128 : 0) + (ng & 127));
            u32x4 w; w.x = pk_bf16(f[0], f[1]); w.y = pk_bf16(f[2], f[3]); w.z = pk_bf16(f[4], f[5]); w.w = pk_bf16(f[6], f[7]);
            *(u32x4*)(dst + (size_t)drow * K + k0 + kc) = w; }
        __builtin_amdgcn_wave_barrier(); asm volatile("s_waitcnt lgkmcnt(0)" ::: "memory");
    }
}

__device__ __forceinline__ void phase_prologue(const Frame& F, const Params& P) {
    float* modv = (float*)(F.ws + WS_MODV);
    LAS float* s = (LAS float*)F.lds;
    LAS float* red = (LAS float*)(F.lds + 9 * 1024 * 4);
    for (int cb = F.bid; cb < (2 * MODW) / 64; cb += F.G) {
        for (int i = F.tid; i < 9 * 1024; i += NTHREADS) { const int mi = i >> 10, k = i & 1023; const float c = mi < 8 ? P.in[I_C][mi * D + k] : P.in[I_CCTX][k]; s[i] = siluf_(c); }
        __syncthreads();
        const int colg = cb * 64 + F.lane, l = colg / MODW, col = colg % MODW;
        const float* w = P.in[I_MODW] + (size_t)l * D * MODW + col;
        float acc[9];
#pragma unroll
        for (int mi = 0; mi < 9; ++mi) acc[mi] = 0.f;
        const int kb = F.wave * 128;
#pragma unroll 8
        for (int k = 0; k < 128; ++k) { const float wv = w[(size_t)(kb + k) * MODW];
#pragma unroll
            for (int mi = 0; mi < 9; ++mi) acc[mi] += s[mi * 1024 + kb + k] * wv; }
#pragma unroll
        for (int mi = 0; mi < 9; ++mi) red[(F.wave * 9 + mi) * 64 + F.lane] = acc[mi];
        __syncthreads();
        for (int i = F.tid; i < 9 * 64; i += NTHREADS) { const int mi = i >> 6, ln = i & 63; float a = 0.f;
#pragma unroll
            for (int w8 = 0; w8 < 8; ++w8) a += red[(w8 * 9 + mi) * 64 + ln];
            const int cg = cb * 64 + ln, l2 = cg / MODW, c2 = cg % MODW;
            modv[((size_t)l2 * 9 + mi) * MODW + c2] = a + P.in[I_MODB][l2 * MODW + c2]; }
        __syncthreads();
    }
    for (int l = 0; l < 2; ++l) {
        conv_job(F, P.in[I_WIN] + (size_t)l * D * INW, (bf16_t*)(F.ws + WS_BTIN) + (size_t)l * INW * D, D, INW, 0);
        conv_job(F, P.in[I_WOUT] + (size_t)l * D * D, (bf16_t*)(F.ws + WS_BTOUT) + (size_t)l * D * D, D, D, 0);
    }
    conv_job(F, P.in[I_FG], (bf16_t*)(F.ws + WS_BTGU), D, DFF, 1);
    conv_job(F, P.in[I_FU], (bf16_t*)(F.ws + WS_BTGU), D, DFF, 2);
    conv_job(F, P.in[I_FD], (bf16_t*)(F.ws + WS_BTDN), DFF, D, 0);
}
__device__ __forceinline__ void phase_moe_convert(const Frame& F, const Params& P) {
    for (int e = 0; e < NEXP; ++e) {
        bf16_t* gu = (bf16_t*)(F.ws + WS_MOE + (size_t)e * MOE_E_BYTES); bf16_t* dn = (bf16_t*)(F.ws + WS_MOE + (size_t)e * MOE_E_BYTES + MOE_GU_BYTES);
        conv_job(F, P.in[I_MG] + (size_t)e * D * DFE, gu, D, DFE, 1);
        conv_job(F, P.in[I_MU] + (size_t)e * D * DFE, gu, D, DFE, 2);
        conv_job(F, P.in[I_MD] + (size_t)e * DFE * D, dn, DFE, D, 0);
    }
}

template <bool ROUTER>
__device__ __forceinline__ void phase_norm(const Frame& F, const Params& P, int l, int which, int nrows, const float* srcL, const float* srcC) {
    const float* g = (which == 0 ? P.in[I_N1G] : P.in[I_N2G]) + l * D;
    const float* modv = (const float*)(F.ws + WS_MODV) + (size_t)l * 9 * MODW + (which == 0 ? 0 : 3 * D);
    bf16_t* HL = (bf16_t*)(F.ws + WS_HL);
    LAS float* rt = (LAS float*)F.lds;
    if (ROUTER) {
        for (int i = F.tid; i < D * NEXP; i += NTHREADS) rt[i] = P.in[I_ROUTER][i];
        int* rmap = (int*)(F.ws + WS_ROUTE + RT_RMAP);
        for (int i = F.bid * NTHREADS + F.tid; i < 2 * NROW; i += F.G * NTHREADS) rmap[i] = -1;
        __syncthreads();
    }
    const int lane = F.lane;
    for (int r = F.gw; r < nrows; r += F.nw) {
        const float* xr = r < NLAT ? srcL + (size_t)r * D : srcC + (size_t)(r - NLAT) * D;
        const float* mv = modv + (size_t)row_mi(r) * MODW;
        f32x4 x[4]; float ss = 0.f;
#pragma unroll
        for (int j = 0; j < 4; ++j) { x[j] = *(const f32x4*)(xr + j * 256 + lane * 4); ss += x[j][0] * x[j][0] + x[j][1] * x[j][1] + x[j][2] * x[j][2] + x[j][3] * x[j][3]; }
        ss = wave_sum(ss);
        const float rstd = rsqrtf(ss * (1.0f / D) + 1e-6f);
        float lg[NEXP];
        if (ROUTER) {
#pragma unroll
            for (int e = 0; e < NEXP; ++e) lg[e] = 0.f;
        }
#pragma unroll
        for (int j = 0; j < 4; ++j) { const int c = j * 256 + lane * 4;
            const f32x4 gg = *(const f32x4*)(g + c), sh = *(const f32x4*)(mv + c), sc = *(const f32x4*)(mv + D + c);
            f32x4 y = (x[j] * rstd * gg) * (sc + 1.0f) + sh;
            u32x2 w; w.x = pk_bf16(y[0], y[1]); w.y = pk_bf16(y[2], y[3]);
            *(u32x2*)(HL + (size_t)r * D + c) = w;
            if (ROUTER) {
#pragma unroll
                for (int q = 0; q < 4; ++q) { const f32x4 r0 = *(const LAS f32x4*)(rt + (c + q) * 8), r1 = *(const LAS f32x4*)(rt + (c + q) * 8 + 4);
                    lg[0] += y[q] * r0[0]; lg[1] += y[q] * r0[1]; lg[2] += y[q] * r0[2]; lg[3] += y[q] * r0[3];
                    lg[4] += y[q] * r1[0]; lg[5] += y[q] * r1[1]; lg[6] += y[q] * r1[2]; lg[7] += y[q] * r1[3]; asm volatile("" ::: "memory"); }
            }
        }
        if (ROUTER) {
#pragma unroll
            for (int e = 0; e < NEXP; ++e) lg[e] = wave_sum(lg[e]);
            if (lane == 0) {
                int e1 = 0; float l1 = lg[0];
#pragma unroll
                for (int e = 1; e < NEXP; ++e) if (lg[e] > l1) { l1 = lg[e]; e1 = e; }
                int e2 = -1; float l2 = -3.0e38f;
#pragma unroll
                for (int e = 0; e < NEXP; ++e) if (e != e1 && lg[e] > l2) { l2 = lg[e]; e2 = e; }
                const float ex = __expf(l2 - l1), g1 = 1.0f / (1.0f + ex), g2 = ex * g1;
                unsigned* cnt = (unsigned*)(F.ws + WS_CTL) + CW_MOECNT;
                const unsigned p1 = atomicAdd(cnt + e1, 1u), p2 = atomicAdd(cnt + 8 + e2, 1u);
                int* te = (int*)(F.ws + WS_ROUTE + RT_TOKE); float* tg = (float*)(F.ws + WS_ROUTE + RT_TOKG); int* tp = (int*)(F.ws + WS_ROUTE + RT_TOKP);
                te[r * 2] = e1; te[r * 2 + 1] = e2; tg[r * 2] = g1; tg[r * 2 + 1] = g2; tp[r * 2] = (int)p1; tp[r * 2 + 1] = (int)p2;
            }
        }
    }
}
__device__ __forceinline__ void moe_tstart(const Frame& F, int pass, int (&ts)[9]) {
    const unsigned* cnt = (const unsigned*)(F.ws + WS_CTL) + CW_MOECNT + pass * 8;
    int a = 0;
#pragma unroll
    for (int e = 0; e < 8; ++e) { ts[e] = a; a += (int)((__hip_atomic_load(cnt + e, __ATOMIC_RELAXED, __HIP_MEMORY_SCOPE_AGENT) + 255u) >> 8); }
    ts[8] = a;
}
__device__ __forceinline__ void phase_moe_rowmap(const Frame& F) {
    int ts0[9], ts1[9]; moe_tstart(F, 0, ts0); moe_tstart(F, 1, ts1);
    const int* te = (const int*)(F.ws + WS_ROUTE + RT_TOKE); const float* tg = (const float*)(F.ws + WS_ROUTE + RT_TOKG); const int* tp = (const int*)(F.ws + WS_ROUTE + RT_TOKP);
    int* rmap = (int*)(F.ws + WS_ROUTE + RT_RMAP); float* sg = (float*)(F.ws + WS_ROUTE + RT_SGATE);
    for (int t = F.bid * NTHREADS + F.tid; t < NLAT; t += F.G * NTHREADS) {
        { const int e = te[t * 2]; int st = 0;
#pragma unroll
          for (int j = 0; j < 8; ++j) st = (e == j) ? ts0[j] : st;
          const int slot = st * 256 + tp[t * 2]; rmap[slot] = t; sg[slot] = tg[t * 2]; }
        { const int e = te[t * 2 + 1]; int st = 0;
#pragma unroll
          for (int j = 0; j < 8; ++j) st = (e == j) ? ts1[j] : st;
          const int slot = st * 256 + tp[t * 2 + 1]; rmap[NROW + slot] = t; sg[NROW + slot] = tg[t * 2 + 1]; }
    }
}

struct RowGeo { int b, tt, pos, len; };
__device__ __forceinline__ RowGeo row_geo(int r) { RowGeo g; if (r < NLAT) { g.b = r >> 12; g.pos = r & 4095; g.len = SEQ; g.tt = CTXL + g.pos; } else { const int q = r - NLAT; g.b = q >> 8; g.pos = q & 255; g.len = CTXL; g.tt = g.pos; } return g; }

__device__ __forceinline__ void rw_shift4(const bf16_t* PL, const float* mup, const float* mun, int r, const RowGeo& g, int j, float (&u)[4]) {
    const bf16_t* p = PL + (size_t)r * INW + O_RW + j;
    float c[4], pv[4] = {0.f, 0.f, 0.f, 0.f}, nv[4] = {0.f, 0.f, 0.f, 0.f};
    unpack4(*(const u32x2*)p, c);
    if (g.pos > 0) unpack4(*(const u32x2*)(p - INW), pv);
    if (g.pos < g.len - 1) unpack4(*(const u32x2*)(p + INW), nv);
    const f32x4 mp = *(const f32x4*)(mup + j), mn = *(const f32x4*)(mun + j);
#pragma unroll
    for (int q = 0; q < 4; ++q) u[q] = c[q] + mp[q] * (pv[q] - c[q]) + mn[q] * (nv[q] - c[q]);
}

__device__ __forceinline__ void phase_rw_prep(const Frame& F, const Params& P, int l) {
    const bf16_t* PL = (const bf16_t*)(F.ws + WS_PL);
    const float* mup = P.in[I_MUP] + l * 1280; const float* mun = P.in[I_MUN] + l * 1280;
    LAS float* lw = (LAS float*)(F.lds + F.wave * 1024);
    f16_t* SH = (f16_t*)(F.ws + WS_SH); f16_t* SD = (f16_t*)(F.ws + WS_SD);
    const int lane = F.lane, c4 = lane * 4, h = lane >> 4, cw = (lane & 15) * 4;
    const f32x4 kkw = *(const f32x4*)(P.in[I_KK] + l * 256 + c4), kaw = *(const f32x4*)(P.in[I_KA] + l * 256 + c4);
    for (int r = F.gw; r < NROW; r += F.nw) {
        const RowGeo g = row_geo(r);
        float ur[4], uk[4], uv[4], u3[4], u4[4];
        rw_shift4(PL, mup, mun, r, g, c4, ur); rw_shift4(PL, mup, mun, r, g, 256 + c4, uk); rw_shift4(PL, mup, mun, r, g, 512 + c4, uv);
        rw_shift4(PL, mup, mun, r, g, 768 + c4, u3); rw_shift4(PL, mup, mun, r, g, 1024 + c4, u4);
        if (lane < 16) {
#pragma unroll
            for (int q = 0; q < 4; ++q) { lw[c4 + q] = tanhf(u3[q]); lw[64 + c4 + q] = tanhf(u4[q]); }
        } else if (lane < 32) {
#pragma unroll
            for (int q = 0; q < 4; ++q) { lw[128 + c4 - 64 + q] = u3[q]; lw[192 + c4 - 64 + q] = u4[q]; }
        }
        __builtin_amdgcn_wave_barrier(); asm volatile("s_waitcnt lgkmcnt(0)" ::: "memory");
        float km[4], ss = 0.f;
#pragma unroll
        for (int q = 0; q < 4; ++q) { km[q] = uk[q] * kkw[q]; ss += km[q] * km[q]; }
        ss = sum16(ss);
        const float rn = rsqrtf(ss + 1e-12f);
        float kkv[4];
#pragma unroll
        for (int q = 0; q < 4; ++q) kkv[q] = km[q] * rn;
        const size_t shrow = ((size_t)(g.b * 4 + h) * TT + g.tt) * 192;
        { f16x4 o;
#pragma unroll
          for (int q = 0; q < 4; ++q) o[q] = (f16_t)ur[q];
          *(f16x4*)(SH + shrow + cw) = o;
#pragma unroll
          for (int q = 0; q < 4; ++q) o[q] = (f16_t)uv[q];
          *(f16x4*)(SH + shrow + 64 + cw) = o;
#pragma unroll
          for (int q = 0; q < 4; ++q) o[q] = (f16_t)(-kkv[q]);
          *(f16x4*)(SH + shrow + 128 + cw) = o; }
#pragma unroll 1
        for (int d = 0; d < 2; ++d) {
            const float* w2 = P.in[I_W2] + (size_t)((l * 2 + d) * 64) * 256 + c4; const float* a2 = P.in[I_A2] + (size_t)((l * 2 + d) * 64) * 256 + c4;
            f32x4 xw = *(const f32x4*)(P.in[I_W0] + (l * 2 + d) * 256 + c4), xa = *(const f32x4*)(P.in[I_A0] + (l * 2 + d) * 256 + c4);
#pragma unroll 4
            for (int k = 0; k < 64; ++k) { const float tw = lw[d * 64 + k], ta = lw[128 + d * 64 + k];
                xw += *(const f32x4*)(w2 + (size_t)k * 256) * tw; xa += *(const f32x4*)(a2 + (size_t)k * 256) * ta; }
            f16x4 o1, o2, o3;
#pragma unroll
            for (int q = 0; q < 4; ++q) {
                const float nx = -xw[q]; const float sp = fmaxf(nx, 0.f) + log1pf(__expf(-fabsf(nx)));
                const float e = __expf(-sp - 0.5f);
                const float omw = -expm1f(-e);
                const float a = sigmoidf_(xa[q]);
                o1[q] = (f16_t)omw; o2[q] = (f16_t)(uk[q] * (1.0f + (a - 1.0f) * kaw[q])); o3[q] = (f16_t)(kkv[q] * a);
            }
            const size_t sdrow = ((size_t)((d * 8 + g.b) * 4 + h) * TT + g.tt) * 192;
            *(f16x4*)(SD + sdrow + cw) = o1; *(f16x4*)(SD + sdrow + 64 + cw) = o2; *(f16x4*)(SD + sdrow + 128 + cw) = o3;
        }
        __builtin_amdgcn_wave_barrier();
    }
}

constexpr int SC_CH = 32;
constexpr int SC_BUF = SC_CH * 6 * 64 * 4;
__device__ __forceinline__ float dpp_sum16(float v) {
    v += __builtin_bit_cast(float, __builtin_amdgcn_update_dpp(0, __builtin_bit_cast(int, v), 0xB1, 0xF, 0xF, true));
    v += __builtin_bit_cast(float, __builtin_amdgcn_update_dpp(0, __builtin_bit_cast(int, v), 0x4E, 0xF, 0xF, true));
    v += __builtin_bit_cast(float, __builtin_amdgcn_update_dpp(0, __builtin_bit_cast(int, v), 0x141, 0xF, 0xF, true));
    v += __builtin_bit_cast(float, __builtin_amdgcn_update_dpp(0, __builtin_bit_cast(int, v), 0x140, 0xF, 0xF, true));
    return v;
}
__device__ __forceinline__ int scan_tt0(int d, int c) { return d == 0 ? c * SC_CH : (c < 8 ? 224 - 32 * c : 4576 - 32 * c); }
__device__ __forceinline__ void scan_load_chunk(LAS unsigned char* lds, const f16_t* sh, const f16_t* sd, int d, int c, int lt) {
    const int t0 = scan_tt0(d, c);
    u32x4 ld[6];
#pragma unroll
    for (int i = 0; i < 3; ++i) { const int p = lt + i * 256; ld[i] = *(const u32x4*)(sh + (size_t)t0 * 192 + p * 8); ld[3 + i] = *(const u32x4*)(sd + (size_t)t0 * 192 + p * 8); }
    LAS float* buf = (LAS float*)(lds + (c & 1) * SC_BUF);
#pragma unroll
    for (int i = 0; i < 6; ++i) { const int p = lt + (i % 3) * 256; const int ms = p / 24, wi = p % 24, kind = wi >> 3, e0 = (wi & 7) * 8; const int st = d == 0 ? ms : (SC_CH - 1 - ms);
        const f16x8 hv = __builtin_bit_cast(f16x8, ld[i]); float f[8];
#pragma unroll
        for (int q = 0; q < 8; ++q) f[q] = (float)hv[q];
        if (i >= 3 && kind == 0) {
#pragma unroll
            for (int q = 0; q < 8; ++q) f[q] = 1.0f - f[q];
        }
        LAS float* dst = buf + (st * 6 + (i < 3 ? kind : 3 + kind)) * 64 + e0;
        *(LAS f32x4*)dst = (f32x4){f[0], f[1], f[2], f[3]}; *(LAS f32x4*)(dst + 4) = (f32x4){f[4], f[5], f[6], f[7]}; }
}
__device__ __forceinline__ void phase_scan(const Frame& F) {
    const f16_t* SH = (const f16_t*)(F.ws + WS_SH); const f16_t* SD = (const f16_t*)(F.ws + WS_SD);
    float* Y = (float*)(F.ws + WS_Y);
    const int tid = F.tid, lane = F.lane, wave = F.wave;
    constexpr int NCHUNK = TT / SC_CH;
    for (int item = F.bid; item < 256; item += F.G) {
        const int xg = item & 7, sl = item >> 3, chain = xg * 8 + (sl >> 2), quarter = sl & 3;
        const int d = chain >> 5, b = (chain >> 2) & 7, h = chain & 3;
        const f16_t* sh = SH + (size_t)(b * 4 + h) * TT * 192; const f16_t* sd = SD + (size_t)((d * 8 + b) * 4 + h) * TT * 192;
        const bool loader = wave >= 4; const int lt = tid - 256;
        if (loader) scan_load_chunk(F.lds, sh, sd, d, 0, lt);
        __syncthreads();
        float S0 = 0.f, S1 = 0.f, S2 = 0.f, S3 = 0.f;
        const int row = quarter * 16 + (wave & 3) * 4 + (lane >> 4), j0 = (lane & 15) * 4;
        float* yp = Y + ((size_t)(d * 8 + b) * TT) * 256 + h * 64 + row;
        for (int c = 0; c < NCHUNK; ++c) {
            if (loader) {
                if (c + 1 < NCHUNK) scan_load_chunk(F.lds, sh, sd, d, c + 1, lt);
            } else {
                const LAS float* buf = (const LAS float*)(F.lds + (c & 1) * SC_BUF);
                const int t0 = scan_tt0(d, c);
#pragma unroll 4
                for (int i = 0; i < SC_CH; ++i) {
                    const LAS float* sp = buf + i * 384;
                    const f32x4 r4 = *(const LAS f32x4*)(sp + j0), z4 = *(const LAS f32x4*)(sp + 128 + j0), w4 = *(const LAS f32x4*)(sp + 192 + j0),
                                k4 = *(const LAS f32x4*)(sp + 256 + j0), b4 = *(const LAS f32x4*)(sp + 320 + j0);
                    const float vr = sp[64 + row];
                    float sz = S0 * z4[0] + S1 * z4[1] + S2 * z4[2] + S3 * z4[3];
                    sz = dpp_sum16(sz);
                    S0 = S0 * w4[0] + (sz * b4[0] + vr * k4[0]); S1 = S1 * w4[1] + (sz * b4[1] + vr * k4[1]);
                    S2 = S2 * w4[2] + (sz * b4[2] + vr * k4[2]); S3 = S3 * w4[3] + (sz * b4[3] + vr * k4[3]);
                    float y = S0 * r4[0] + S1 * r4[1] + S2 * r4[2] + S3 * r4[3];
                    y = dpp_sum16(y);
                    const int tt = d == 0 ? t0 + i : t0 + SC_CH - 1 - i;
                    if ((lane & 15) == 0) yp[(size_t)tt * 256] = y;
                }
            }
            __syncthreads();
        }
    }
}

__device__ __forceinline__ void phase_rw_post(const Frame& F, const Params& P, int l, int nrows) {
    const bf16_t* PL = (const bf16_t*)(F.ws + WS_PL); bf16_t* MIX = (bf16_t*)(F.ws + WS_MIX);
    const f16_t* SH = (const f16_t*)(F.ws + WS_SH); const f16_t* SD = (const f16_t*)(F.ws + WS_SD); const float* Y = (const float*)(F.ws + WS_Y);
    const float* mup = P.in[I_MUP] + l * 1280; const float* mun = P.in[I_MUN] + l * 1280;
    LAS float* sg = (LAS float*)(F.lds + F.wave * 1024);
    const int lane = F.lane, c4 = lane * 4, h = lane >> 4, cw = (lane & 15) * 4;
    const f32x4 rk = *(const f32x4*)(P.in[I_RK] + l * 256 + c4), gng = *(const f32x4*)(P.in[I_GNG] + l * 256 + c4), gnb = *(const f32x4*)(P.in[I_GNB] + l * 256 + c4);
    for (int r = F.gw; r < nrows; r += F.nw) {
        const RowGeo g = row_geo(r);
        float u3[4], u4[4];
        rw_shift4(PL, mup, mun, r, g, 768 + c4, u3); rw_shift4(PL, mup, mun, r, g, 1024 + c4, u4);
        if (lane >= 32) {
#pragma unroll
            for (int q = 0; q < 4; ++q) { sg[c4 - 128 + q] = sigmoidf_(u3[q]); sg[128 + c4 - 128 + q] = sigmoidf_(u4[q]); }
        }
        __builtin_amdgcn_wave_barrier(); asm volatile("s_waitcnt lgkmcnt(0)" ::: "memory");
        const size_t shrow = ((size_t)(g.b * 4 + h) * TT + g.tt) * 192;
        const f16x4 rh = *(const f16x4*)(SH + shrow + cw), vh = *(const f16x4*)(SH + shrow + 64 + cw);
        float out[4] = {0.f, 0.f, 0.f, 0.f};
#pragma unroll
        for (int d = 0; d < 2; ++d) {
            const float* g2 = P.in[I_G2] + (size_t)((l * 2 + d) * 128) * 256 + c4;
            f32x4 gg = (f32x4){0.f, 0.f, 0.f, 0.f};
#pragma unroll 8
            for (int k = 0; k < 128; ++k) gg += *(const f32x4*)(g2 + (size_t)k * 256) * sg[d * 128 + k];
            const f32x4 y = *(const f32x4*)(Y + ((size_t)(d * 8 + g.b) * TT + g.tt) * 256 + c4);
            const float mu = sum16(y[0] + y[1] + y[2] + y[3]) * (1.0f / 64.0f);
            float vs = 0.f;
#pragma unroll
            for (int q = 0; q < 4; ++q) { const float dd = y[q] - mu; vs += dd * dd; }
            const float rstd = rsqrtf(sum16(vs) * (1.0f / 64.0f) + 64e-5f);
            const size_t sdrow = ((size_t)((d * 8 + g.b) * 4 + h) * TT + g.tt) * 192;
            const f16x4 kdh = *(const f16x4*)(SD + sdrow + 64 + cw);
            float bs = 0.f;
#pragma unroll
            for (int q = 0; q < 4; ++q) bs += (float)rh[q] * (float)kdh[q] * rk[q];
            bs = sum16(bs);
#pragma unroll
            for (int q = 0; q < 4; ++q) out[q] += ((y[q] - mu) * rstd * gng[q] + gnb[q] + bs * (float)vh[q]) * gg[q];
        }
        u32x2 w; w.x = pk_bf16(out[0], out[1]); w.y = pk_bf16(out[2], out[3]);
        *(u32x2*)(MIX + (size_t)r * D + 512 + c4) = w;
        __builtin_amdgcn_wave_barrier();
    }
}

__device__ __forceinline__ void phase_conv(const Frame& F, const Params& P, int l, int nrows) {
    const bf16_t* PL = (const bf16_t*)(F.ws + WS_PL); bf16_t* MIX = (bf16_t*)(F.ws + WS_MIX);
    const int lane = F.lane, c4 = lane * 4;
    const float* dw = P.in[I_DWW] + (size_t)l * 31 * 256 + c4;
    const f32x4 dwb = *(const f32x4*)(P.in[I_DWB] + l * 256 + c4), lng = *(const f32x4*)(P.in[I_LNG] + l * 256 + c4), lnb = *(const f32x4*)(P.in[I_LNB] + l * 256 + c4);
    for (int r = F.gw; r < nrows; r += F.nw) {
        const RowGeo g = row_geo(r);
        f32x4 acc = dwb;
#pragma unroll 1
        for (int j = 0; j < 31; ++j) { const int tp = g.pos + j - 15;
            if (tp >= 0 && tp < g.len) { const bf16_t* p = PL + (size_t)(r + j - 15) * INW + O_CV + c4; float a[4], bb[4];
                unpack4(*(const u32x2*)p, a); unpack4(*(const u32x2*)(p + 256), bb);
                const f32x4 w = *(const f32x4*)(dw + j * 256);
#pragma unroll
                for (int q = 0; q < 4; ++q) acc[q] += a[q] * sigmoidf_(bb[q]) * w[q]; } }
        const float mu = wave_sum(acc[0] + acc[1] + acc[2] + acc[3]) * (1.0f / 256.0f);
        float vs = 0.f;
#pragma unroll
        for (int q = 0; q < 4; ++q) { const float dd = acc[q] - mu; vs += dd * dd; }
        const float rstd = rsqrtf(wave_sum(vs) * (1.0f / 256.0f) + 1e-5f);
        float o[4];
#pragma unroll
        for (int q = 0; q < 4; ++q) o[q] = siluf_((acc[q] - mu) * rstd * lng[q] + lnb[q]);
        u32x2 w; w.x = pk_bf16(o[0], o[1]); w.y = pk_bf16(o[2], o[3]);
        *(u32x2*)(MIX + (size_t)r * D + 768 + c4) = w;
    }
}

__device__ __forceinline__ void phase_na_simple(const Frame& F, const Params& P, int l, int nq) {
    const bf16_t* PL = (const bf16_t*)(F.ws + WS_PL); bf16_t* MIX = (bf16_t*)(F.ws + WS_MIX);
    const float* rpb = P.in[I_RPB] + (size_t)l * 8 * 15 * 31;
    int tid_ = F.tid; asm volatile("" : "+v"(tid_));
    for (int gid = F.bid * NTHREADS + tid_; gid < nq * 8; gid += F.G * NTHREADS) {
        const int r = gid >> 3, h = gid & 7;
        const RowGeo g = row_geo(r);
        float q[64], o[64];
        { const bf16_t* qp = PL + (size_t)r * INW + O_Q + h * 64;
#pragma unroll
          for (int i = 0; i < 8; ++i) unpack8(*(const u32x4*)(qp + i * 8), q + i * 8); }
#pragma unroll
        for (int i = 0; i < 64; ++i) o[i] = 0.f;
        float m = -3.0e38f, lsum = 0.f;
        const bool lat = r < NLAT;
        const int gi = g.pos >> 6, gc = g.pos & 63;
        const int rs = min(max(gi - 4, 0), 56), wsc = min(max(gc - 8, 0), 48);
        const int nkey = lat ? 384 : 256;
#pragma unroll 1
        for (int kx = 0; kx < nkey; ++kx) {
            const bool win = lat && kx < 128;
            int krow; float bias = 0.f;
            if (win) { const int r8 = kx >> 4, cc = kx & 15; krow = g.b * SEQ + (rs + r8) * 64 + wsc + cc; bias = rpb[(h * 15 + (rs + r8 - gi + 7)) * 31 + (wsc + cc - gc + 15)]; }
            else krow = NLAT + g.b * CTXL + (kx - (lat ? 128 : 0));
            const bf16_t* kp = PL + (size_t)krow * INW + O_K + h * 64; float a = bias;
#pragma unroll
            for (int i = 0; i < 8; ++i) { float kf[8]; unpack8(*(const u32x4*)(kp + i * 8), kf);
#pragma unroll
                for (int j = 0; j < 8; ++j) a += q[i * 8 + j] * kf[j]; }
            if (a > m) { const float alpha = __expf(m - a); lsum *= alpha;
#pragma unroll
                for (int i = 0; i < 64; ++i) o[i] *= alpha;
                m = a; }
            const float p = __expf(a - m); lsum += p;
            const bf16_t* vp = kp + (O_V - O_K);
#pragma unroll
            for (int i = 0; i < 8; ++i) { float vf[8]; unpack8(*(const u32x4*)(vp + i * 8), vf);
#pragma unroll
                for (int j = 0; j < 8; ++j) o[i * 8 + j] += p * vf[j]; }
        }
        const float inv = 1.0f / lsum;
        bf16_t* op = MIX + (size_t)r * D + h * 64;
#pragma unroll
        for (int i = 0; i < 8; ++i) { u32x4 w; w.x = pk_bf16(o[i * 8] * inv, o[i * 8 + 1] * inv); w.y = pk_bf16(o[i * 8 + 2] * inv, o[i * 8 + 3] * inv);
            w.z = pk_bf16(o[i * 8 + 4] * inv, o[i * 8 + 5] * inv); w.w = pk_bf16(o[i * 8 + 6] * inv, o[i * 8 + 7] * inv); *(u32x4*)(op + i * 8) = w; }
    }
}

__device__ __forceinline__ void phase_final(const Frame& F, const Params& P) {
    float* out = P.out; const float* g = P.in[I_FINALG]; const int lane = F.lane;
    for (int r = F.gw; r < NLAT; r += F.nw) {
        float* xr = out + (size_t)r * D; f32x4 x[4]; float ss = 0.f;
#pragma unroll
        for (int j = 0; j < 4; ++j) { x[j] = *(const f32x4*)(xr + j * 256 + lane * 4); ss += x[j][0] * x[j][0] + x[j][1] * x[j][1] + x[j][2] * x[j][2] + x[j][3] * x[j][3]; }
        ss = wave_sum(ss); const float rstd = rsqrtf(ss * (1.0f / D) + 1e-6f);
#pragma unroll
        for (int j = 0; j < 4; ++j) { const f32x4 gg = *(const f32x4*)(g + j * 256 + lane * 4); *(f32x4*)(xr + j * 256 + lane * 4) = x[j] * rstd * gg; }
    }
}

constexpr int PH_L0 = 1, PH_PER_L0 = 9, PH_L1 = PH_L0 + PH_PER_L0, PH_PER_L1 = 12, PH_FINAL = PH_L1 + PH_PER_L1, N_PHASES = PH_FINAL + 1;
#define RFL(x) __builtin_amdgcn_readfirstlane(x)

PHASE ph_prologue(const void* kp_) { PHASE_ENTER; if constexpr (MKB(0)) phase_prologue(F, P); }
PHASE ph_norm1(const void* kp_, int l_) { PHASE_ENTER; const int l = RFL(l_);
    if constexpr (MKB(1)) phase_norm<false>(F, P, l, 0, NROW, l == 0 ? P.in[I_X] : P.out, l == 0 ? P.in[I_CTX] : (const float*)(F.ws + WS_XC)); }
PHASE_INL ph_gemm_win(const void* kp_, int l_) { PHASE_ENTER; const int l = RFL(l_);
    pg8::DenseSched S; S.init(NROW / 256, INW / 256, F.G, F.bid); S.A = (const bf16_t*)(F.ws + WS_HL); S.Bt = (const bf16_t*)(F.ws + WS_BTIN) + (size_t)l * INW * D; S.K = D;
    pg8::EpiBf16 E{(bf16_t*)(F.ws + WS_PL), INW, 2, 0.125f};
    if constexpr (MKB(2)) pg8::gemm_phase<pg8::EpiBf16, pg8::DenseSched, false>(F.lds, D, S, E); }
PHASE ph_rw_prep(const void* kp_, int l_) { PHASE_ENTER; const int l = RFL(l_); if constexpr (MKB(3)) phase_rw_prep(F, P, l); }
PHASE ph_conv(const void* kp_, int l_) { PHASE_ENTER; const int l = RFL(l_); if constexpr (MKB(4)) phase_conv(F, P, l, l == 0 ? NROW : NLAT); }
PHASE_INL ph_na(const void* kp_, int l_) { PHASE_ENTER; const int l = RFL(l_); if constexpr (MKB(5)) phase_na_simple(F, P, l, l == 0 ? NROW : NLAT); }
PHASE ph_scan(const void* kp_) { PHASE_ENTER; if constexpr (MKB(6)) phase_scan(F); }
PHASE ph_rw_post(const void* kp_, int l_) { PHASE_ENTER; const int l = RFL(l_); if constexpr (MKB(7)) phase_rw_post(F, P, l, l == 0 ? NROW : NLAT); }
PHASE_INL ph_gemm_wout(const void* kp_, int l_) { PHASE_ENTER; const int l = RFL(l_);
    float* XC = (float*)(F.ws + WS_XC);
    pg8::DenseSched S; S.init((l == 0 ? NROW : NLAT) / 256, D / 256, F.G, F.bid); S.A = (const bf16_t*)(F.ws + WS_MIX); S.Bt = (const bf16_t*)(F.ws + WS_BTOUT) + (size_t)l * D * D; S.K = D;
    pg8::EpiRes E{l == 0 ? P.in[I_X] : P.out, l == 0 ? P.in[I_CTX] : XC, P.out, XC, (const float*)(F.ws + WS_MODV) + (size_t)l * 9 * MODW + 2 * D};
    if constexpr (MKB(8)) pg8::gemm_phase<pg8::EpiRes, pg8::DenseSched, false>(F.lds, D, S, E); }
PHASE ph_norm2_l0(const void* kp_) { PHASE_ENTER; if constexpr (MKB(9)) phase_norm<false>(F, P, 0, 1, NROW, P.out, (const float*)(F.ws + WS_XC)); }
PHASE_INL ph_gemm_ffn_gu(const void* kp_) { PHASE_ENTER;
    pg8::DenseSched S; S.init(NROW / 256, (2 * DFF) / 256, F.G, F.bid); S.A = (const bf16_t*)(F.ws + WS_HL); S.Bt = (const bf16_t*)(F.ws + WS_BTGU); S.K = D;
    pg8::EpiSwiGLU E{(bf16_t*)(F.ws + WS_H), DFF};
    if constexpr (MKB(10)) pg8::gemm_phase<pg8::EpiSwiGLU, pg8::DenseSched, false>(F.lds, D, S, E); }
PHASE_INL ph_gemm_ffn_dn(const void* kp_) { PHASE_ENTER;
    float* XC = (float*)(F.ws + WS_XC);
    pg8::DenseSched S; S.init(NROW / 256, D / 256, F.G, F.bid); S.A = (const bf16_t*)(F.ws + WS_H); S.Bt = (const bf16_t*)(F.ws + WS_BTDN); S.K = DFF;
    pg8::EpiRes E{P.out, XC, P.out, XC, (const float*)(F.ws + WS_MODV) + 5 * D};
    if constexpr (MKB(11)) pg8::gemm_phase<pg8::EpiRes, pg8::DenseSched, false>(F.lds, DFF, S, E); }
PHASE ph_norm2_l1(const void* kp_) { PHASE_ENTER; if constexpr (MKB(12)) phase_norm<true>(F, P, 1, 1, NLAT, P.out, (const float*)(F.ws + WS_XC)); }
PHASE ph_moe_prep(const void* kp_) { PHASE_ENTER; if constexpr (MKB(13)) { phase_moe_rowmap(F); phase_moe_convert(F, P); } }
PHASE_INL ph_gemm_moe_gu(const void* kp_, int pass_) { PHASE_ENTER; const int pass = RFL(pass_);
    pg8::MoeSched S; moe_tstart(F, pass, S.tstart); S.init(S.tstart[8], (2 * DFE) / 256, F.G, F.bid);
    S.A = (const bf16_t*)(F.ws + WS_HL); S.Bt0 = F.ws + WS_MOE; S.e_stride = MOE_E_BYTES; S.K = D; S.rowmap = (const int*)(F.ws + WS_ROUTE + RT_RMAP) + pass * NROW;
    pg8::EpiSwiGLU E{(bf16_t*)(F.ws + WS_H), DFE};
    if constexpr (MKB(14)) pg8::gemm_phase<pg8::EpiSwiGLU, pg8::MoeSched, true>(F.lds, D, S, E); }
PHASE_INL ph_gemm_moe_dn(const void* kp_, int pass_) { PHASE_ENTER; const int pass = RFL(pass_);
    pg8::MoeSched S; moe_tstart(F, pass, S.tstart); S.init(S.tstart[8], D / 256, F.G, F.bid);
    S.A = (const bf16_t*)(F.ws + WS_H); S.Bt0 = F.ws + WS_MOE + MOE_GU_BYTES; S.e_stride = MOE_E_BYTES; S.K = DFE; S.rowmap = nullptr;
    pg8::EpiMoeDown E{P.out, (const float*)(F.ws + WS_MODV) + (size_t)9 * MODW + 5 * D, (const int*)(F.ws + WS_ROUTE + RT_RMAP) + pass * NROW, (const float*)(F.ws + WS_ROUTE + RT_SGATE) + pass * NROW};
    if constexpr (MKB(15)) pg8::gemm_phase<pg8::EpiMoeDown, pg8::MoeSched, false>(F.lds, DFE, S, E); }
PHASE ph_final(const void* kp_) { PHASE_ENTER; if constexpr (MKB(16)) phase_final(F, P); }

__global__ void __launch_bounds__(NTHREADS, 2) mk_fwd(Params P) {
    const void* kp = (const void*)__builtin_amdgcn_kernarg_segment_ptr();
    LAS unsigned char* lds = (LAS unsigned char*)lds_raw;
    volatile LAS unsigned* misc = (volatile LAS unsigned*)(lds + LDS_MISC);
    if (threadIdx.x < 4) misc[threadIdx.x] = 0u;
    __syncthreads();
    const int lo = P.ph_lo, hi = P.ph_hi;
    XcdBarrier bar; bar.bar = (unsigned*)(P.ws + WS_CTL) + CW_BAR; bar.x = 0; bar.st = misc;
    if (hi - lo > 1) bar = xcd_barrier_post((unsigned*)(P.ws + WS_CTL) + CW_BAR, misc);
#define IN(k) (lo <= (k) && (k) < hi)
#define SEAM(k) do { if (IN((k) + 1)) xcd_barrier(bar); } while (0)
    if (IN(0)) { ph_prologue(kp); SEAM(0); }
#pragma unroll 1
    for (int l = 0; l < 2; ++l) {
        const int pb = l == 0 ? PH_L0 : PH_L1;
        if (IN(pb + 0)) { ph_norm1(kp, l); SEAM(pb + 0); }
        if (IN(pb + 1)) { ph_gemm_win(kp, l); SEAM(pb + 1); }
        if (IN(pb + 2)) { ph_rw_prep(kp, l); ph_conv(kp, l); ph_na(kp, l); SEAM(pb + 2); }
        if (IN(pb + 3)) { ph_scan(kp); SEAM(pb + 3); }
        if (IN(pb + 4)) { ph_rw_post(kp, l); SEAM(pb + 4); }
        if (IN(pb + 5)) { ph_gemm_wout(kp, l); SEAM(pb + 5); }
        if (l == 0) {
            if (IN(pb + 6)) { ph_norm2_l0(kp); SEAM(pb + 6); }
            if (IN(pb + 7)) { ph_gemm_ffn_gu(kp); SEAM(pb + 7); }
            if (IN(pb + 8)) { ph_gemm_ffn_dn(kp); SEAM(pb + 8); }
        } else {
            if (IN(pb + 6)) { ph_norm2_l1(kp); SEAM(pb + 6); }
            if (IN(pb + 7)) { ph_moe_prep(kp); SEAM(pb + 7); }
#pragma unroll 1
            for (int pass = 0; pass < 2; ++pass) {
                if (IN(pb + 8 + 2 * pass)) { ph_gemm_moe_gu(kp, pass); SEAM(pb + 8 + 2 * pass); }
                if (IN(pb + 9 + 2 * pass)) { ph_gemm_moe_dn(kp, pass); SEAM(pb + 9 + 2 * pass); }
            }
        }
    }
    if (IN(PH_FINAL)) ph_final(kp);
#undef IN
#undef SEAM
}

extern "C" void kernel_launch(void* const* d_in, const int* in_sizes, int n_in, void* d_out, int out_size, void* d_ws, size_t ws_size, hipStream_t stream) {
    static int grid = 0;
    if (grid == 0) {
        if (n_in != 35 || out_size != NLAT * D || ws_size < WS_END) { fprintf(stderr, "kernel_launch: unexpected shapes (n_in %d out %d ws %zu need %zu)\n", n_in, out_size, ws_size, (size_t)WS_END); grid = -1; return; }
        int dev = 0, cus = 0, per_cu = 0;
        if (hipGetDevice(&dev) != hipSuccess || hipDeviceGetAttribute(&cus, hipDeviceAttributeMultiprocessorCount, dev) != hipSuccess) { grid = -1; return; }
        if (hipFuncSetAttribute((const void*)mk_fwd, hipFuncAttributeMaxDynamicSharedMemorySize, LDS_BYTES) != hipSuccess) { fprintf(stderr, "kernel_launch: hipFuncSetAttribute failed\n"); grid = -1; return; }
        if (hipOccupancyMaxActiveBlocksPerMultiprocessor(&per_cu, (const void*)mk_fwd, NTHREADS, LDS_BYTES) != hipSuccess || per_cu < 1) { fprintf(stderr, "kernel_launch: occupancy query says %d\n", per_cu); (void)hipGetLastError(); }
        grid = cus;
    }
    if (grid < 0) return;
    (void)hipMemsetAsync((char*)d_ws + WS_CTL, 0, CTL_BYTES, stream);
    Params p{};
    for (int i = 0; i < 35; ++i) p.in[i] = (const float*)d_in[i];
    p.out = (float*)d_out; p.ws = (unsigned char*)d_ws;
#if MK_ONE_LAUNCH
    p.ph_lo = 0; p.ph_hi = N_PHASES;
    hipLaunchKernelGGL(mk_fwd, dim3(grid), dim3(NTHREADS), LDS_BYTES, stream, p);
#else
    for (int k = 0; k < N_PHASES && k <= MK_LAST; ++k) { p.ph_lo = k; p.ph_hi = k + 1; hipLaunchKernelGGL(mk_fwd, dim3(grid), dim3(NTHREADS), LDS_BYTES, stream, p); }
#endif
}
```

```cpp
#include <hip/hip_runtime.h>
#include <stdint.h>
#include <stdio.h>

#ifndef MK_MASK
#define MK_MASK 0xFFFFFFFFu
#endif
#define MKB(k) (((MK_MASK) >> (k)) & 1u)
#ifndef MK_LAST
#define MK_LAST 99
#endif
#ifndef MK_ONE_LAUNCH
#define MK_ONE_LAUNCH 1
#endif

#define LAS __attribute__((address_space(3)))
typedef unsigned short bf16_t;
typedef _Float16 f16_t;
typedef short bf16x8 __attribute__((ext_vector_type(8)));
typedef float f32x4 __attribute__((ext_vector_type(4)));
typedef float f32x2 __attribute__((ext_vector_type(2)));
typedef unsigned u32x4 __attribute__((ext_vector_type(4)));
typedef unsigned u32x2 __attribute__((ext_vector_type(2)));
typedef f16_t f16x4 __attribute__((ext_vector_type(4)));
typedef f16_t f16x8 __attribute__((ext_vector_type(8)));

constexpr int D = 1024, NB = 8, SEQ = 4096, CTXL = 256, TT = CTXL + SEQ;
constexpr int NLAT = NB * SEQ, NCTX = NB * CTXL, NROW = NLAT + NCTX;
constexpr int INW = 3328, DFF = 2816, DFE = 3584, NEXP = 8;
constexpr int O_Q = 0, O_K = 512, O_V = 1024, O_RW = 1536, O_CV = 2816;
constexpr int MODW = 6 * D;
constexpr int NTHREADS = 512, NWAVES = 8;
constexpr int LDS_BYTES = 160 * 1024;
constexpr int LDS_MISC = LDS_BYTES - 256;

constexpr size_t al256(size_t x) { return (x + 255) & ~(size_t)255; }
constexpr size_t WS_CTL   = 0;
constexpr size_t CTL_BYTES = 65536;
constexpr size_t WS_MODV  = WS_CTL + CTL_BYTES;
constexpr size_t WS_BTIN  = al256(WS_MODV + (size_t)2 * 9 * MODW * 4);
constexpr size_t WS_BTOUT = al256(WS_BTIN + (size_t)2 * INW * D * 2);
constexpr size_t WS_BTGU  = al256(WS_BTOUT + (size_t)2 * D * D * 2);
constexpr size_t WS_BTDN  = al256(WS_BTGU + (size_t)2 * DFF * D * 2);
constexpr size_t WS_MOE   = al256(WS_BTDN + (size_t)D * DFF * 2);
constexpr size_t MOE_GU_BYTES = (size_t)2 * DFE * D * 2, MOE_DN_BYTES = (size_t)D * DFE * 2, MOE_E_BYTES = MOE_GU_BYTES + MOE_DN_BYTES;
constexpr size_t WS_SH    = WS_MOE;
constexpr size_t SH_BYTES = (size_t)NB * 4 * TT * 192 * 2;
constexpr size_t WS_SD    = WS_SH + SH_BYTES;
constexpr size_t WS_XC    = al256(WS_MOE + (size_t)NEXP * MOE_E_BYTES);
constexpr size_t WS_HL    = al256(WS_XC + (size_t)NCTX * D * 4);
constexpr size_t WS_Y     = WS_HL;
constexpr size_t WS_PL    = al256(WS_HL + (size_t)NROW * D * 2);
constexpr size_t WS_MIX   = al256(WS_PL + (size_t)NROW * INW * 2);
constexpr size_t WS_H     = WS_PL;
constexpr size_t WS_ROUTE = al256(WS_MIX + (size_t)NROW * D * 2);
constexpr size_t RT_TOKE  = 0;
constexpr size_t RT_TOKG  = RT_TOKE + (size_t)NLAT * 2 * 4;
constexpr size_t RT_TOKP  = RT_TOKG + (size_t)NLAT * 2 * 4;
constexpr size_t RT_RMAP  = RT_TOKP + (size_t)NLAT * 2 * 4;
constexpr size_t RT_SGATE = RT_RMAP + (size_t)2 * NROW * 4;
constexpr size_t WS_END   = al256(WS_ROUTE + RT_SGATE + (size_t)2 * NROW * 4);
static_assert(SH_BYTES * 3 <= (size_t)NEXP * MOE_E_BYTES, "scan inputs must fit the MoE weight region");
static_assert((size_t)NROW * DFE * 2 <= (size_t)NROW * INW * 2 + (size_t)NROW * D * 2, "H must fit PL+MIX");

constexpr int CW_BAR = 0;
constexpr int CW_MOECNT = 4096;

#define XB_TMO      128
#define XB_XCNT(j)  (256  + 64 * (j))
#define XB_XSUB(j)  (1280 + 64 * (j))
#define XB_XGEN(j)  (2304 + 64 * (j))
#define XB_TOP      3328
#define XB_TOPGEN   3392
#define XCD_BAR_WORDS 3456
#define XB_SPIN_CAP (1u << 22)

__device__ __forceinline__ unsigned xb_ld(unsigned* p)              { return __hip_atomic_load(p, __ATOMIC_RELAXED, __HIP_MEMORY_SCOPE_AGENT); }
__device__ __forceinline__ unsigned xb_add(unsigned* p, unsigned v) { return __hip_atomic_fetch_add(p, v, __ATOMIC_RELAXED, __HIP_MEMORY_SCOPE_AGENT); }
__device__ __forceinline__ unsigned xb_xcc_id() { return (unsigned)__builtin_amdgcn_s_getreg((3 << 11) | 20) & 0xFu; }
#define XB_SPIN(cond, bar) do { unsigned _sp = 0; while (cond) { __builtin_amdgcn_s_sleep(1); \
    if ((++_sp & 255u) == 0u) { if (xb_ld(&(bar)[XB_TMO])) break; if (_sp > XB_SPIN_CAP) { atomicAdd(&(bar)[XB_TMO], 1u); break; } } } } while (0)

struct XcdBarrier { unsigned* bar; unsigned x; volatile LAS unsigned* st; };

__device__ __forceinline__ XcdBarrier xcd_barrier_post(unsigned* bar, volatile LAS unsigned* st) {
    XcdBarrier b; b.bar = bar; b.x = xb_xcc_id(); b.st = st;
    if (threadIdx.x == 0) (void)xb_add(&bar[XB_XCNT(b.x)], 1u);
    return b;
}
__device__ __forceinline__ void xcd_barrier_complete(unsigned* bar, unsigned x, unsigned& nloc, unsigned& nx) {
    const unsigned G = gridDim.x * gridDim.y * gridDim.z;
    unsigned sum, cnt, mine, sp = 0u;
    for (;;) {
        sum = 0u; cnt = 0u; mine = 0u;
#pragma unroll
        for (unsigned j = 0; j < 16; ++j) { const unsigned c = xb_ld(&bar[XB_XCNT(j)]); sum += c; cnt += (c > 0u) ? 1u : 0u; mine = (j == x) ? c : mine; }
        if (sum == G) break;
        __builtin_amdgcn_s_sleep(1);
        if ((++sp & 255u) == 0u) { if (xb_ld(&bar[XB_TMO])) break; if (sp > XB_SPIN_CAP) { atomicAdd(&bar[XB_TMO], 1u); break; } }
    }
    nloc = mine > 0u ? mine : 1u; nx = cnt > 0u ? cnt : 1u;
}
__device__ __forceinline__ void xcd_barrier(const XcdBarrier& b) {
    asm volatile("s_waitcnt vmcnt(0)" ::: "memory");
    __syncthreads();
    if (threadIdx.x == 0) {
        unsigned* bar = b.bar;
        __builtin_amdgcn_s_waitcnt(0);
        unsigned nloc = b.st[0], nx = b.st[1];
        if (nloc == 0u) { xcd_barrier_complete(bar, b.x, nloc, nx); b.st[0] = nloc; b.st[1] = nx; }
        const unsigned old = xb_add(&bar[XB_XSUB(b.x)], 1u);
        const unsigned gen = old / nloc;
        if (old + 1u == (gen + 1u) * nloc) {
            __builtin_amdgcn_fence(__ATOMIC_RELEASE, "agent");
            asm volatile("s_waitcnt vmcnt(0)" ::: "memory");
            const unsigned og = xb_add(&bar[XB_TOP], 1u);
            const unsigned tg = og / nx;
            if (og + 1u == (tg + 1u) * nx) xb_add(&bar[XB_TOPGEN], 1u);
            else XB_SPIN(xb_ld(&bar[XB_TOPGEN]) == tg, bar);
            __builtin_amdgcn_fence(__ATOMIC_ACQUIRE, "agent");
            xb_add(&bar[XB_XGEN(b.x)], 1u);
            asm volatile("s_waitcnt vmcnt(0)" ::: "memory");
        } else {
            XB_SPIN(xb_ld(&bar[XB_XGEN(b.x)]) == gen, bar);
            __builtin_amdgcn_fence(__ATOMIC_ACQUIRE, "agent");
            asm volatile("s_waitcnt vmcnt(0)" ::: "memory");
        }
    }
    __syncthreads();
}

__device__ __forceinline__ float bf2f(bf16_t b) { return __uint_as_float(((unsigned)b) << 16); }
__device__ __forceinline__ bf16_t f2bf(float f) { unsigned u = __float_as_uint(f); u += 0x7FFFu + ((u >> 16) & 1u); return (bf16_t)(u >> 16); }
__device__ __forceinline__ unsigned pk_bf16(float lo, float hi) { return (unsigned)f2bf(lo) | ((unsigned)f2bf(hi) << 16); }
__device__ __forceinline__ unsigned cvt_pk_bf16(float lo, float hi) { unsigned r; asm volatile("v_cvt_pk_bf16_f32 %0, %1, %2" : "=v"(r) : "v"(lo), "v"(hi)); return r; }
__device__ __forceinline__ float sigmoidf_(float x) { return 1.0f / (1.0f + __expf(-x)); }
__device__ __forceinline__ float siluf_(float x) { return x / (1.0f + __expf(-x)); }
__device__ __forceinline__ float wave_sum(float v) {
#pragma unroll
    for (int o = 32; o >= 1; o >>= 1) v += __shfl_xor(v, o);
    return v;
}
__device__ __forceinline__ float sum16(float v) {
    v += __shfl_xor(v, 1); v += __shfl_xor(v, 2); v += __shfl_xor(v, 4); v += __shfl_xor(v, 8); return v;
}
__device__ __forceinline__ void unpack4(u32x2 w, float (&f)[4]) {
    f[0] = __uint_as_float(w.x << 16); f[1] = __uint_as_float(w.x & 0xffff0000u); f[2] = __uint_as_float(w.y << 16); f[3] = __uint_as_float(w.y & 0xffff0000u);
}
__device__ __forceinline__ void unpack8(u32x4 w, float* f) {
    f[0] = __uint_as_float(w.x << 16); f[1] = __uint_as_float(w.x & 0xffff0000u); f[2] = __uint_as_float(w.y << 16); f[3] = __uint_as_float(w.y & 0xffff0000u);
    f[4] = __uint_as_float(w.z << 16); f[5] = __uint_as_float(w.z & 0xffff0000u); f[6] = __uint_as_float(w.w << 16); f[7] = __uint_as_float(w.w & 0xffff0000u);
}

struct Params {
    const float* in[35];
    float* out; unsigned char* ws;
    int ph_lo, ph_hi;
};
enum { I_X = 0, I_C, I_CTX, I_CCTX, I_N1G, I_N2G, I_MODW, I_MODB, I_WIN, I_WOUT, I_RPB, I_MUP, I_MUN, I_W0, I_W2, I_A0, I_A2, I_G2, I_KK, I_KA, I_RK, I_GNG, I_GNB,
       I_DWW, I_DWB, I_LNG, I_LNB, I_FG, I_FU, I_FD, I_ROUTER, I_MG, I_MU, I_MD, I_FINALG };

__device__ __forceinline__ int row_mi(int r) { return r < NLAT ? (r >> 12) : 8; }

namespace pg8 {
constexpr int BM = 256, BK = 64, HALF = 128, HTB = HALF * BK * 2, STAGE_BYTES = 8 * HTB, NXCD = 8, WGM = 8;
__device__ __forceinline__ int lds_byte(int r, int c) { const int st = (r >> 4) * 2 + (c >> 5), rr = r & 15, cc = c & 31, ob = rr * 64 + cc * 2; return st * 1024 + (ob ^ (((ob >> 9) & 1) << 5)); }
__device__ __forceinline__ void stage_rc(int b, int& R, int& C) { const int st = b / 1024, sb = b % 1024, swz = sb ^ (((sb >> 9) & 1) << 5); R = (st >> 1) * 16 + swz / 64; C = (st & 1) * 32 + (swz % 64) / 2; }
__device__ __forceinline__ int perm32(int rho) { const int n = rho >> 4, i = rho & 15; return 8 * (i >> 2) + 4 * n + (i & 3); }
struct Unit { int pm, pn; };

struct TileOrder {
    int nM, nN, nwg, G, c;
    __device__ void init(int nM_, int nN_, int G_, int c_) { nM = nM_; nN = nN_; nwg = nM * nN; G = G_; c = c_; }
    __device__ bool next(int i, Unit& u) const {
        const long L = (long)i * G + c; if (L >= nwg) return false;
        int wgid = (int)L; { const int q = nwg / NXCD, r = nwg % NXCD, xcd = wgid % NXCD, off = wgid / NXCD; wgid = (xcd < r ? xcd * (q + 1) : r * (q + 1) + (xcd - r) * q) + off; }
        const int nig = WGM * nN, gid = wgid / nig, fm = gid * WGM, gsz = (nM - fm) < WGM ? (nM - fm) : WGM;
        u.pm = fm + ((wgid % nig) % gsz); u.pn = (wgid % nig) / gsz; return true;
    }
};
struct DenseSched : TileOrder {
    const bf16_t* A; const bf16_t* Bt; int K;
    __device__ __forceinline__ const char* aptr(const Unit& u) const { return (const char*)A + (size_t)u.pm * BM * K * 2; }
    __device__ __forceinline__ const char* bptr(const Unit& u) const { return (const char*)Bt + (size_t)u.pn * BM * K * 2; }
    __device__ __forceinline__ const char* abase() const { return (const char*)A; }
    __device__ __forceinline__ int arow(const Unit&, int) const { return 0; }
};
struct MoeSched : TileOrder {
    const bf16_t* A; const unsigned char* Bt0; size_t e_stride; int K; const int* rowmap; int tstart[9];
    __device__ __forceinline__ int expert(int pm) const { int e = 0;
#pragma unroll
        for (int j = 1; j < 8; ++j) e += (pm >= tstart[j]) ? 1 : 0;
        return e; }
    __device__ __forceinline__ const char* aptr(const Unit& u) const { return (const char*)A + (size_t)u.pm * BM * K * 2; }
    __device__ __forceinline__ const char* bptr(const Unit& u) const { return (const char*)Bt0 + (size_t)expert(u.pm) * e_stride + (size_t)u.pn * BM * K * 2; }
    __device__ __forceinline__ const char* abase() const { return (const char*)A; }
    __device__ __forceinline__ int arow(const Unit& u, int r) const { const int t = rowmap[u.pm * BM + r]; return t < 0 ? 0 : t; }
};

struct EpiBf16 {
    static constexpr bool PERM = true;
    bf16_t* O; int ldc; int nscale; float scale;
    __device__ __forceinline__ void operator()(const f32x4 (&acc)[2][2][4][2], const Unit& u, int wr, int wc, int fr, int fq) const {
        const int row0 = u.pm * BM + wr * 64 + fr, col0 = u.pn * BM + wc * 32 + 8 * fq;
        const float s = u.pn < nscale ? scale : 1.0f;
#pragma unroll
        for (int ai = 0; ai < 2; ++ai)
#pragma unroll
            for (int m = 0; m < 4; ++m) { bf16_t* rowp = O + (size_t)(row0 + ai * HALF + m * 16) * ldc + col0;
#pragma unroll
                for (int bj = 0; bj < 2; ++bj) { const f32x4 v0 = acc[ai][bj][m][0] * s, v1 = acc[ai][bj][m][1] * s;
                    u32x4 w; w.x = cvt_pk_bf16(v0[0], v0[1]); w.y = cvt_pk_bf16(v0[2], v0[3]); w.z = cvt_pk_bf16(v1[0], v1[1]); w.w = cvt_pk_bf16(v1[2], v1[3]);
                    *(u32x4*)(rowp + bj * HALF) = w; } }
    }
};
struct EpiSwiGLU {
    static constexpr bool PERM = true;
    bf16_t* H; int ldh;
    __device__ __forceinline__ void operator()(const f32x4 (&acc)[2][2][4][2], const Unit& u, int wr, int wc, int fr, int fq) const {
        const int row0 = u.pm * BM + wr * 64 + fr, col0 = u.pn * HALF + wc * 32 + 8 * fq;
#pragma unroll
        for (int ai = 0; ai < 2; ++ai)
#pragma unroll
            for (int m = 0; m < 4; ++m) { bf16_t* rowp = H + (size_t)(row0 + ai * HALF + m * 16) * ldh + col0;
                float h[8];
#pragma unroll
                for (int n = 0; n < 2; ++n)
#pragma unroll
                    for (int j = 0; j < 4; ++j) { const float g = acc[ai][0][m][n][j], up = acc[ai][1][m][n][j]; h[n * 4 + j] = g / (1.0f + __expf(-g)) * up; }
                u32x4 w; w.x = cvt_pk_bf16(h[0], h[1]); w.y = cvt_pk_bf16(h[2], h[3]); w.z = cvt_pk_bf16(h[4], h[5]); w.w = cvt_pk_bf16(h[6], h[7]);
                *(u32x4*)rowp = w; }
    }
};
struct EpiRes {
    static constexpr bool PERM = false;
    const float* resL; const float* resC; float* outL; float* outC; const float* gvec;
    __device__ __forceinline__ void operator()(const f32x4 (&acc)[2][2][4][2], const Unit& u, int wr, int wc, int fr, int fq) const {
        const int r0 = u.pm * BM; const bool lat = r0 < NLAT;
        const float* res = lat ? resL + (size_t)r0 * D : resC + (size_t)(r0 - NLAT) * D;
        float* out = lat ? outL + (size_t)r0 * D : outC + (size_t)(r0 - NLAT) * D;
        const float* gv = gvec + (size_t)(lat ? (r0 >> 12) : 8) * MODW;
        const int rl = wr * 64 + fr, col0 = u.pn * BM + wc * 32 + 4 * fq;
        f32x4 g[2][2];
#pragma unroll
        for (int bj = 0; bj < 2; ++bj)
#pragma unroll
            for (int n = 0; n < 2; ++n) g[bj][n] = *(const f32x4*)(gv + col0 + bj * HALF + n * 16);
#pragma unroll
        for (int ai = 0; ai < 2; ++ai)
#pragma unroll
            for (int m = 0; m < 4; ++m) { const size_t off = (size_t)(rl + ai * HALF + m * 16) * D + col0;
#pragma unroll
                for (int bj = 0; bj < 2; ++bj)
#pragma unroll
                    for (int n = 0; n < 2; ++n) { const f32x4 rv = *(const f32x4*)(res + off + bj * HALF + n * 16);
                        *(f32x4*)(out + off + bj * HALF + n * 16) = rv + g[bj][n] * acc[ai][bj][m][n]; } }
    }
};
struct EpiMoeDown {
    static constexpr bool PERM = false;
    float* xl; const float* gvec; const int* rowmap; const float* sgate;
    __device__ __forceinline__ void operator()(const f32x4 (&acc)[2][2][4][2], const Unit& u, int wr, int wc, int fr, int fq) const {
        const int rl = u.pm * BM + wr * 64 + fr, col0 = u.pn * BM + wc * 32 + 4 * fq;
#pragma unroll
        for (int ai = 0; ai < 2; ++ai)
#pragma unroll
            for (int m = 0; m < 4; ++m) { const int slot = rl + ai * HALF + m * 16; const int tok = rowmap[slot];
                if (tok >= 0) { const float sg = sgate[slot]; const float* gv = gvec + (size_t)(tok >> 12) * MODW + col0; float* xp = xl + (size_t)tok * D + col0;
#pragma unroll
                    for (int bj = 0; bj < 2; ++bj)
#pragma unroll
                        for (int n = 0; n < 2; ++n) { const f32x4 g = *(const f32x4*)(gv + bj * HALF + n * 16); const f32x4 rv = *(const f32x4*)(xp + bj * HALF + n * 16);
                            *(f32x4*)(xp + bj * HALF + n * 16) = rv + (g * sg) * acc[ai][bj][m][n]; } } }
    }
};

template <class Epi, class Sched, bool GATHER>
__device__ __forceinline__ void gemm_phase(LAS unsigned char* lds, const int K, const Sched& S, const Epi& E) {
    int tid_ = threadIdx.x; asm volatile("" : "+v"(tid_));
    const int tid = tid_, wid = __builtin_amdgcn_readfirstlane(tid >> 6), lane = tid & 63, wr = wid >> 2, wc = wid & 3, fr = lane & 15, fq = lane >> 4;
    const int nt = K / BK;
    unsigned voffA[2], voffB[2]; int RA[2], CA[2];
#pragma unroll
    for (int i = 0; i < 2; ++i) { int R, C; stage_rc(tid * 16 + i * 8192, R, C); const int Rb = Epi::PERM ? ((R & ~31) + perm32(R & 31)) : R;
        voffA[i] = (unsigned)(R * K + C) * 2u; voffB[i] = (unsigned)(Rb * K + C) * 2u; RA[i] = R; CA[i] = C; }
    const size_t kstep = (size_t)(BK * 2);
    const size_t hstep = (size_t)HALF * K * 2;
    const unsigned ldsw = (unsigned)wid * 1024u;
    const int aoff = lds_byte(wr * 64 + fr, fq * 8), boff = lds_byte(wc * 32 + fr, fq * 8);
#define PG8_SA(b, h) (((b) * 2 + (h)) * HTB)
#define PG8_SB(b, h) ((4 + (b) * 2 + (h)) * HTB)
#define PG8_STAGE(bufoff, gbase, voff) do { _Pragma("unroll") for (int _i = 0; _i < 2; ++_i) \
        __builtin_amdgcn_global_load_lds((const unsigned*)((const char*)(gbase) + (voff)[_i]), (LAS unsigned*)(lds + (bufoff) + ldsw + _i * 8192), 16, 0, 0); } while (0)
#define PG8_LDA(dst, b, h) do { _Pragma("unroll") for (int m = 0; m < 4; ++m) _Pragma("unroll") for (int k = 0; k < 2; ++k) dst[m][k] = *(const LAS bf16x8*)(lds + PG8_SA(b, h) + aoff + m * 2048 + k * 1024); } while (0)
#define PG8_LDB(dst, b, h) do { _Pragma("unroll") for (int n = 0; n < 2; ++n) _Pragma("unroll") for (int k = 0; k < 2; ++k) dst[n][k] = *(const LAS bf16x8*)(lds + PG8_SB(b, h) + boff + n * 2048 + k * 1024); } while (0)
#define PG8_MMA(ai, bj, At, Bt) do { __builtin_amdgcn_s_setprio(1); _Pragma("unroll") for (int m = 0; m < 4; ++m) _Pragma("unroll") for (int n = 0; n < 2; ++n) _Pragma("unroll") for (int k = 0; k < 2; ++k) \
        acc[ai][bj][m][n] = __builtin_amdgcn_mfma_f32_16x16x32_bf16(Bt[n][k], At[m][k], acc[ai][bj][m][n], 0, 0, 0); __builtin_amdgcn_s_setprio(0); } while (0)
#define PG8_WAIT_V(n) asm volatile("s_waitcnt vmcnt(" #n ")" ::: "memory")
#define PG8_WAIT_L(n) asm volatile("s_waitcnt lgkmcnt(" #n ")" ::: "memory")
#define PG8_BAR __builtin_amdgcn_s_barrier()
#define PG8_SCHED __builtin_amdgcn_sched_barrier(0)
#define PG8_STAGE_A(bufoff, TS, H) do { if constexpr (GATHER) { PG8_STAGE(bufoff, gA##TS, oA##TS[H]); } else { PG8_STAGE(bufoff, a##TS + (H) * hstep, voffA); } } while (0)
    Unit cur, nxt; int ui = 0;
    if (!S.next(0, cur)) return;
    f32x4 acc[2][2][4][2];
#pragma unroll
    for (int a = 0; a < 2; ++a)
#pragma unroll
        for (int b = 0; b < 2; ++b)
#pragma unroll
            for (int m = 0; m < 4; ++m)
#pragma unroll
                for (int n = 0; n < 2; ++n) acc[a][b][m][n] = (f32x4){0.f, 0.f, 0.f, 0.f};
    bf16x8 At[4][2], B0[2][2], B1[2][2];
    const char* Abase = S.abase();
    unsigned aoC[2][2] = {{0u, 0u}, {0u, 0u}}, aoN[2][2] = {{0u, 0u}, {0u, 0u}};
    if constexpr (GATHER) {
#pragma unroll
        for (int h = 0; h < 2; ++h)
#pragma unroll
            for (int i = 0; i < 2; ++i) aoC[h][i] = (unsigned)(S.arow(cur, h * HALF + RA[i]) * K + CA[i]) * 2u;
    }
    const char* cA = GATHER ? Abase : S.aptr(cur); const char* cB = S.bptr(cur);
    if constexpr (GATHER) {
        PG8_STAGE(PG8_SB(0, 0), cB, voffB); PG8_STAGE(PG8_SA(0, 0), Abase, aoC[0]); PG8_STAGE(PG8_SB(0, 1), cB + hstep, voffB); PG8_STAGE(PG8_SA(0, 1), Abase, aoC[1]);
    } else {
        PG8_STAGE(PG8_SB(0, 0), cB, voffB); PG8_STAGE(PG8_SA(0, 0), cA, voffA); PG8_STAGE(PG8_SB(0, 1), cB + hstep, voffB); PG8_STAGE(PG8_SA(0, 1), cA + hstep, voffA);
    }
    if (wr == 1) PG8_BAR;
    PG8_WAIT_V(4); PG8_BAR;
    if constexpr (GATHER) {
        PG8_STAGE(PG8_SB(1, 0), cB + kstep, voffB); PG8_STAGE(PG8_SA(1, 0), Abase + kstep, aoC[0]); PG8_STAGE(PG8_SB(1, 1), cB + hstep + kstep, voffB);
    } else {
        PG8_STAGE(PG8_SB(1, 0), cB + kstep, voffB); PG8_STAGE(PG8_SA(1, 0), cA + kstep, voffA); PG8_STAGE(PG8_SB(1, 1), cB + hstep + kstep, voffB);
    }
    PG8_WAIT_V(6); PG8_BAR;
    for (;;) {
        const bool has_next = S.next(ui + 1, nxt);
        const char* nA = has_next ? (GATHER ? Abase : S.aptr(nxt)) : cA; const char* nB = has_next ? S.bptr(nxt) : cB;
        if constexpr (GATHER) {
            if (has_next) {
#pragma unroll
                for (int h = 0; h < 2; ++h)
#pragma unroll
                    for (int i = 0; i < 2; ++i) aoN[h][i] = (unsigned)(S.arow(nxt, h * HALF + RA[i]) * K + CA[i]) * 2u;
            } else {
#pragma unroll
                for (int h = 0; h < 2; ++h)
#pragma unroll
                    for (int i = 0; i < 2; ++i) aoN[h][i] = aoC[h][i];
            }
        }
        for (int t = 0; t < nt; t += 2) {
            const bool last = (t == nt - 2);
            const char* a1 = cA + (size_t)(t + 1) * kstep;
            const char* a2 = last ? nA : cA + (size_t)(t + 2) * kstep; const char* b2 = last ? nB : cB + (size_t)(t + 2) * kstep;
            const char* a3 = a2 + kstep; const char* b3 = b2 + kstep;
            const char* gA1 = Abase + (size_t)(t + 1) * kstep; const char* gA2 = Abase + (last ? (size_t)0 : (size_t)(t + 2) * kstep); const char* gA3 = gA2 + kstep;
            unsigned oA1[2][2], oA2[2][2], oA3[2][2];
#pragma unroll
            for (int h = 0; h < 2; ++h)
#pragma unroll
                for (int i = 0; i < 2; ++i) { oA1[h][i] = aoC[h][i]; oA2[h][i] = last ? aoN[h][i] : aoC[h][i]; oA3[h][i] = oA2[h][i]; }
            (void)a1; (void)a3; (void)gA1; (void)gA3; (void)oA1; (void)oA3;
            PG8_LDB(B0, 0, 0); PG8_SCHED; PG8_LDA(At, 0, 0); PG8_STAGE_A(PG8_SA(1, 1), 1, 1);
            PG8_WAIT_L(8); PG8_BAR; PG8_WAIT_L(0); PG8_MMA(0, 0, At, B0); PG8_BAR; PG8_SCHED;
            PG8_LDB(B1, 0, 1); PG8_STAGE(PG8_SB(0, 0), b2, voffB);
            PG8_BAR; PG8_WAIT_L(0); PG8_MMA(0, 1, At, B1); PG8_BAR;
            PG8_LDA(At, 0, 1); PG8_STAGE_A(PG8_SA(0, 0), 2, 0);
            PG8_BAR; PG8_WAIT_L(0); PG8_MMA(1, 0, At, B0); PG8_BAR; PG8_SCHED;
            PG8_STAGE(PG8_SB(0, 1), b2 + hstep, voffB);
            PG8_WAIT_V(6); PG8_BAR; PG8_MMA(1, 1, At, B1); PG8_BAR;
            PG8_LDB(B0, 1, 0); PG8_SCHED; PG8_LDA(At, 1, 0); PG8_STAGE_A(PG8_SA(0, 1), 2, 1);
            PG8_WAIT_L(8); PG8_BAR; PG8_WAIT_L(0); PG8_MMA(0, 0, At, B0); PG8_BAR; PG8_SCHED;
            PG8_LDB(B1, 1, 1); PG8_STAGE(PG8_SB(1, 0), b3, voffB);
            PG8_BAR; PG8_WAIT_L(0); PG8_MMA(0, 1, At, B1); PG8_BAR;
            PG8_LDA(At, 1, 1); PG8_STAGE_A(PG8_SA(1, 0), 3, 0);
            PG8_BAR; PG8_WAIT_L(0); PG8_MMA(1, 0, At, B0); PG8_BAR; PG8_SCHED;
            PG8_STAGE(PG8_SB(1, 1), b3 + hstep, voffB);
            PG8_WAIT_V(6); PG8_BAR; PG8_MMA(1, 1, At, B1); PG8_BAR;
        }
        { int t2 = tid; asm volatile("" : "+v"(t2)); const int l2 = t2 & 63; E(acc, cur, wr, wc, l2 & 15, l2 >> 4); }
        if (!has_next) break;
#pragma unroll
        for (int a = 0; a < 2; ++a)
#pragma unroll
            for (int b = 0; b < 2; ++b)
#pragma unroll
                for (int m = 0; m < 4; ++m)
#pragma unroll
                    for (int n = 0; n < 2; ++n) acc[a][b][m][n] = (f32x4){0.f, 0.f, 0.f, 0.f};
        cur = nxt; cA = nA; cB = nB; ++ui;
        if constexpr (GATHER) {
#pragma unroll
            for (int h = 0; h < 2; ++h)
#pragma unroll
                for (int i = 0; i < 2; ++i) aoC[h][i] = aoN[h][i];
        }
    }
    PG8_WAIT_V(0);
    if (wr == 0) PG8_BAR;
    PG8_BAR;
#undef PG8_SA
#undef PG8_SB
#undef PG8_STAGE
#undef PG8_STAGE_A
#undef PG8_LDA
#undef PG8_LDB
#undef PG8_MMA
#undef PG8_WAIT_V
#undef PG8_WAIT_L
#undef PG8_BAR
#undef PG8_SCHED
}
}

struct Frame {
    LAS unsigned char* lds; int tid, lane, wave, G, bid, gw, nw;
    unsigned char* ws;
};
extern __shared__ __attribute__((aligned(16))) unsigned char lds_raw[];
typedef const __attribute__((address_space(4))) Params* KP;
__device__ __forceinline__ Params load_params(const void* kp_) {
    const unsigned long long v = (unsigned long long)kp_;
    const unsigned lo = __builtin_amdgcn_readfirstlane((unsigned)v), hi = __builtin_amdgcn_readfirstlane((unsigned)(v >> 32));
    KP kp = (KP)(((unsigned long long)hi << 32) | lo);
    Params P;
#pragma unroll
    for (int i = 0; i < 35; ++i) P.in[i] = kp->in[i];
    P.out = kp->out; P.ws = kp->ws; P.ph_lo = kp->ph_lo; P.ph_hi = kp->ph_hi;
    return P;
}
#define PHASE static __attribute__((noinline)) __device__ void
#define PHASE_INL static __device__ __forceinline__ void
__device__ __forceinline__ Frame make_frame(unsigned char* ws) {
    int t_ = threadIdx.x; asm volatile("" : "+v"(t_));
    Frame F; F.lds = (LAS unsigned char*)lds_raw; F.tid = t_; F.lane = F.tid & 63; F.wave = __builtin_amdgcn_readfirstlane(F.tid >> 6);
    F.G = gridDim.x; F.bid = blockIdx.x; F.gw = F.bid * NWAVES + F.wave; F.nw = F.G * NWAVES; F.ws = ws; return F;
}
#define PHASE_ENTER const Params P = load_params(kp_); const Frame F = make_frame(P.ws)

__device__ __forceinline__ void conv_job(const Frame& F, const float* src, bf16_t* dst, int K, int N, int mode) {
    LAS float* tile = (LAS float*)(F.lds + F.wave * (64 * 65 * 4));
    const int tk = K / 64, tn = N / 64, ntile = tk * tn, lane = F.lane;
    for (int t = F.gw; t < ntile; t += F.nw) {
        const int k0 = (t / tn) * 64, n0 = (t % tn) * 64;
#pragma unroll 4
        for (int i = 0; i < 16; ++i) { const int row = i * 4 + (lane >> 4), c4 = (lane & 15) * 4;
            const f32x4 v = *(const f32x4*)(src + (size_t)(k0 + row) * N + n0 + c4);
            tile[row * 65 + c4 + 0] = v[0]; tile[row * 65 + c4 + 1] = v[1]; tile[row * 65 + c4 + 2] = v[2]; tile[row * 65 + c4 + 3] = v[3]; }
        __builtin_amdgcn_wave_barrier(); asm volatile("s_waitcnt lgkmcnt(0)" ::: "memory");
#pragma unroll 2
        for (int i = 0; i < 8; ++i) { const int n = i * 8 + (lane >> 3), kc = (lane & 7) * 8;
            float f[8];
#pragma unroll
            for (int j = 0; j < 8; ++j) f[j] = tile[(kc + j) * 65 + n];
            const int ng = n0 + n; const int drow = mode == 0 ? ng : ((ng >> 7) * 256 + (mode == 2 ? 128 : 0) + (ng & 127));
            u32x4 w; w.x = pk_bf16(f[0], f[1]); w.y = pk_bf16(f[2], f[3]); w.z = pk_bf16(f[4], f[5]); w.w = pk_bf16(f[6], f[7]);
            *(u32x4*)(dst + (size_t)drow * K + k0 + kc) = w; }
        __builtin_amdgcn_wave_barrier(); asm volatile("s_waitcnt lgkmcnt(0)" ::: "memory");
    }
}

__device__ __forceinline__ void phase_prologue(const Frame& F, const Params& P) {
    float* modv = (float*)(F.ws + WS_MODV);
    LAS float* s = (LAS float*)F.lds;
    LAS float* red = (LAS float*)(F.lds + 9 * 1024 * 4);
    for (int cb = F.bid; cb < (2 * MODW) / 64; cb += F.G) {
        for (int i = F.tid; i < 9 * 1024; i += NTHREADS) { const int mi = i >> 10, k = i & 1023; const float c = mi < 8 ? P.in[I_C][mi * D + k] : P.in[I_CCTX][k]; s[i] = siluf_(c); }
        __syncthreads();
        const int colg = cb * 64 + F.lane, l = colg / MODW, col = colg % MODW;
        const float* w = P.in[I_MODW] + (size_t)l * D * MODW + col;
        float acc[9];
#pragma unroll
        for (int mi = 0; mi < 9; ++mi) acc[mi] = 0.f;
        const int kb = F.wave * 128;
#pragma unroll 8
        for (int k = 0; k < 128; ++k) { const float wv = w[(size_t)(kb + k) * MODW];
#pragma unroll
            for (int mi = 0; mi < 9; ++mi) acc[mi] += s[mi * 1024 + kb + k] * wv; }
#pragma unroll
        for (int mi = 0; mi < 9; ++mi) red[(F.wave * 9 + mi) * 64 + F.lane] = acc[mi];
        __syncthreads();
        for (int i = F.tid; i < 9 * 64; i += NTHREADS) { const int mi = i >> 6, ln = i & 63; float a = 0.f;
#pragma unroll
            for (int w8 = 0; w8 < 8; ++w8) a += red[(w8 * 9 + mi) * 64 + ln];
            const int cg = cb * 64 + ln, l2 = cg / MODW, c2 = cg % MODW;
            modv[((size_t)l2 * 9 + mi) * MODW + c2] = a + P.in[I_MODB][l2 * MODW + c2]; }
        __syncthreads();
    }
    for (int l = 0; l < 2; ++l) {
        conv_job(F, P.in[I_WIN] + (size_t)l * D * INW, (bf16_t*)(F.ws + WS_BTIN) + (size_t)l * INW * D, D, INW, 0);
        conv_job(F, P.in[I_WOUT] + (size_t)l * D * D, (bf16_t*)(F.ws + WS_BTOUT) + (size_t)l * D * D, D, D, 0);
    }
    conv_job(F, P.in[I_FG], (bf16_t*)(F.ws + WS_BTGU), D, DFF, 1);
    conv_job(F, P.in[I_FU], (bf16_t*)(F.ws + WS_BTGU), D, DFF, 2);
    conv_job(F, P.in[I_FD], (bf16_t*)(F.ws + WS_BTDN), DFF, D, 0);
}
__device__ __forceinline__ void phase_moe_convert(const Frame& F, const Params& P) {
    for (int e = 0; e < NEXP; ++e) {
        bf16_t* gu = (bf16_t*)(F.ws + WS_MOE + (size_t)e * MOE_E_BYTES); bf16_t* dn = (bf16_t*)(F.ws + WS_MOE + (size_t)e * MOE_E_BYTES + MOE_GU_BYTES);
        conv_job(F, P.in[I_MG] + (size_t)e * D * DFE, gu, D, DFE, 1);
        conv_job(F, P.in[I_MU] + (size_t)e * D * DFE, gu, D, DFE, 2);
        conv_job(F, P.in[I_MD] + (size_t)e * DFE * D, dn, DFE, D, 0);
    }
}

template <bool ROUTER>
__device__ __forceinline__ void phase_norm(const Frame& F, const Params& P, int l, int which, int nrows, const float* srcL, const float* srcC) {
    const float* g = (which == 0 ? P.in[I_N1G] : P.in[I_N2G]) + l * D;
    const float* modv = (const float*)(F.ws + WS_MODV) + (size_t)l * 9 * MODW + (which == 0 ? 0 : 3 * D);
    bf16_t* HL = (bf16_t*)(F.ws + WS_HL);
    LAS float* rt = (LAS float*)F.lds;
    if (ROUTER) {
        for (int i = F.tid; i < D * NEXP; i += NTHREADS) rt[i] = P.in[I_ROUTER][i];
        int* rmap = (int*)(F.ws + WS_ROUTE + RT_RMAP);
        for (int i = F.bid * NTHREADS + F.tid; i < 2 * NROW; i += F.G * NTHREADS) rmap[i] = -1;
        __syncthreads();
    }
    const int lane = F.lane;
    for (int r = F.gw; r < nrows; r += F.nw) {
        const float* xr = r < NLAT ? srcL + (size_t)r * D : srcC + (size_t)(r - NLAT) * D;
        const float* mv = modv + (size_t)row_mi(r) * MODW;
        f32x4 x[4]; float ss = 0.f;
#pragma unroll
        for (int j = 0; j < 4; ++j) { x[j] = *(const f32x4*)(xr + j * 256 + lane * 4); ss += x[j][0] * x[j][0] + x[j][1] * x[j][1] + x[j][2] * x[j][2] + x[j][3] * x[j][3]; }
        ss = wave_sum(ss);
        const float rstd = rsqrtf(ss * (1.0f / D) + 1e-6f);
        float lg[NEXP];
        if (ROUTER) {
#pragma unroll
            for (int e = 0; e < NEXP; ++e) lg[e] = 0.f;
        }
#pragma unroll
        for (int j = 0; j < 4; ++j) { const int c = j * 256 + lane * 4;
            const f32x4 gg = *(const f32x4*)(g + c), sh = *(const f32x4*)(mv + c), sc = *(const f32x4*)(mv + D + c);
            f32x4 y = (x[j] * rstd * gg) * (sc + 1.0f) + sh;
            u32x2 w; w.x = pk_bf16(y[0], y[1]); w.y = pk_bf16(y[2], y[3]);
            *(u32x2*)(HL + (size_t)r * D + c) = w;
            if (ROUTER) {
#pragma unroll
                for (int q = 0; q < 4; ++q) { const f32x4 r0 = *(const LAS f32x4*)(rt + (c + q) * 8), r1 = *(const LAS f32x4*)(rt + (c + q) * 8 + 4);
                    lg[0] += y[q] * r0[0]; lg[1] += y[q] * r0[1]; lg[2] += y[q] * r0[2]; lg[3] += y[q] * r0[3];
                    lg[4] += y[q] * r1[0]; lg[5] += y[q] * r1[1]; lg[6] += y[q] * r1[2]; lg[7] += y[q] * r1[3]; asm volatile("" ::: "memory"); }
            }
        }
        if (ROUTER) {
#pragma unroll
            for (int e = 0; e < NEXP; ++e) lg[e] = wave_sum(lg[e]);
            if (lane == 0) {
                int e1 = 0; float l1 = lg[0];
#pragma unroll
                for (int e = 1; e < NEXP; ++e) if (lg[e] > l1) { l1 = lg[e]; e1 = e; }
                int e2 = -1; float l2 = -3.0e38f;
#pragma unroll
                for (int e = 0; e < NEXP; ++e) if (e != e1 && lg[e] > l2) { l2 = lg[e]; e2 = e; }
                const float ex = __expf(l2 - l1), g1 = 1.0f / (1.0f + ex), g2 = ex * g1;
                unsigned* cnt = (unsigned*)(F.ws + WS_CTL) + CW_MOECNT;
                const unsigned p1 = atomicAdd(cnt + e1, 1u), p2 = atomicAdd(cnt + 8 + e2, 1u);
                int* te = (int*)(F.ws + WS_ROUTE + RT_TOKE); float* tg = (float*)(F.ws + WS_ROUTE + RT_TOKG); int* tp = (int*)(F.ws + WS_ROUTE + RT_TOKP);
                te[r * 2] = e1; te[r * 2 + 1] = e2; tg[r * 2] = g1; tg[r * 2 + 1] = g2; tp[r * 2] = (int)p1; tp[r * 2 + 1] = (int)p2;
            }
        }
    }
}
__device__ __forceinline__ void moe_tstart(const Frame& F, int pass, int (&ts)[9]) {
    const unsigned* cnt = (const unsigned*)(F.ws + WS_CTL) + CW_MOECNT + pass * 8;
    int a = 0;
#pragma unroll
    for (int e = 0; e < 8; ++e) { ts[e] = a; a += (int)((__hip_atomic_load(cnt + e, __ATOMIC_RELAXED, __HIP_MEMORY_SCOPE_AGENT) + 255u) >> 8); }
    ts[8] = a;
}
__device__ __forceinline__ void phase_moe_rowmap(const Frame& F) {
    int ts0[9], ts1[9]; moe_tstart(F, 0, ts0); moe_tstart(F, 1, ts1);
    const int* te = (const int*)(F.ws + WS_ROUTE + RT_TOKE); const float* tg = (const float*)(F.ws + WS_ROUTE + RT_TOKG); const int* tp = (const int*)(F.ws + WS_ROUTE + RT_TOKP);
    int* rmap = (int*)(F.ws + WS_ROUTE + RT_RMAP); float* sg = (float*)(F.ws + WS_ROUTE + RT_SGATE);
    for (int t = F.bid * NTHREADS + F.tid; t < NLAT; t += F.G * NTHREADS) {
        { const int e = te[t * 2]; int st = 0;
#pragma unroll
          for (int j = 0; j < 8; ++j) st = (e == j) ? ts0[j] : st;
          const int slot = st * 256 + tp[t * 2]; rmap[slot] = t; sg[slot] = tg[t * 2]; }
        { const int e = te[t * 2 + 1]; int st = 0;
#pragma unroll
          for (int j = 0; j < 8; ++j) st = (e == j) ? ts1[j] : st;
          const int slot = st * 256 + tp[t * 2 + 1]; rmap[NROW + slot] = t; sg[NROW + slot] = tg[t * 2 + 1]; }
    }
}

struct RowGeo { int b, tt, pos, len; };
__device__ __forceinline__ RowGeo row_geo(int r) { RowGeo g; if (r < NLAT) { g.b = r >> 12; g.pos = r & 4095; g.len = SEQ; g.tt = CTXL + g.pos; } else { const int q = r - NLAT; g.b = q >> 8; g.pos = q & 255; g.len = CTXL; g.tt = g.pos; } return g; }

__device__ __forceinline__ void rw_shift4(const bf16_t* PL, const float* mup, const float* mun, int r, const RowGeo& g, int j, float (&u)[4]) {
    const bf16_t* p = PL + (size_t)r * INW + O_RW + j;
    float c[4], pv[4] = {0.f, 0.f, 0.f, 0.f}, nv[4] = {0.f, 0.f, 0.f, 0.f};
    unpack4(*(const u32x2*)p, c);
    if (g.pos > 0) unpack4(*(const u32x2*)(p - INW), pv);
    if (g.pos < g.len - 1) unpack4(*(const u32x2*)(p + INW), nv);
    const f32x4 mp = *(const f32x4*)(mup + j), mn = *(const f32x4*)(mun + j);
#pragma unroll
    for (int q = 0; q < 4; ++q) u[q] = c[q] + mp[q] * (pv[q] - c[q]) + mn[q] * (nv[q] - c[q]);
}

__device__ __forceinline__ void phase_rw_prep(const Frame& F, const Params& P, int l) {
    const bf16_t* PL = (const bf16_t*)(F.ws + WS_PL);
    const float* mup = P.in[I_MUP] + l * 1280; const float* mun = P.in[I_MUN] + l * 1280;
    LAS float* lw = (LAS float*)(F.lds + F.wave * 1024);
    f16_t* SH = (f16_t*)(F.ws + WS_SH); f16_t* SD = (f16_t*)(F.ws + WS_SD);
    const int lane = F.lane, c4 = lane * 4, h = lane >> 4, cw = (lane & 15) * 4;
    const f32x4 kkw = *(const f32x4*)(P.in[I_KK] + l * 256 + c4), kaw = *(const f32x4*)(P.in[I_KA] + l * 256 + c4);
    for (int r = F.gw; r < NROW; r += F.nw) {
        const RowGeo g = row_geo(r);
        float ur[4], uk[4], uv[4], u3[4], u4[4];
        rw_shift4(PL, mup, mun, r, g, c4, ur); rw_shift4(PL, mup, mun, r, g, 256 + c4, uk); rw_shift4(PL, mup, mun, r, g, 512 + c4, uv);
        rw_shift4(PL, mup, mun, r, g, 768 + c4, u3); rw_shift4(PL, mup, mun, r, g, 1024 + c4, u4);
        if (lane < 16) {
#pragma unroll
            for (int q = 0; q < 4; ++q) { lw[c4 + q] = tanhf(u3[q]); lw[64 + c4 + q] = tanhf(u4[q]); }
        } else if (lane < 32) {
#pragma unroll
            for (int q = 0; q < 4; ++q) { lw[128 + c4 - 64 + q] = u3[q]; lw[192 + c4 - 64 + q] = u4[q]; }
        }
        __builtin_amdgcn_wave_barrier(); asm volatile("s_waitcnt lgkmcnt(0)" ::: "memory");
        float km[4], ss = 0.f;
#pragma unroll
        for (int q = 0; q < 4; ++q) { km[q] = uk[q] * kkw[q]; ss += km[q] * km[q]; }
        ss = sum16(ss);
        const float rn = rsqrtf(ss + 1e-12f);
        float kkv[4];
#pragma unroll
        for (int q = 0; q < 4; ++q) kkv[q] = km[q] * rn;
        const size_t shrow = ((size_t)(g.b * 4 + h) * TT + g.tt) * 192;
        { f16x4 o;
#pragma unroll
          for (int q = 0; q < 4; ++q) o[q] = (f16_t)ur[q];
          *(f16x4*)(SH + shrow + cw) = o;
#pragma unroll
          for (int q = 0; q < 4; ++q) o[q] = (f16_t)uv[q];
          *(f16x4*)(SH + shrow + 64 + cw) = o;
#pragma unroll
          for (int q = 0; q < 4; ++q) o[q] = (f16_t)(-kkv[q]);
          *(f16x4*)(SH + shrow + 128 + cw) = o; }
#pragma unroll 1
        for (int d = 0; d < 2; ++d) {
            const float* w2 = P.in[I_W2] + (size_t)((l * 2 + d) * 64) * 256 + c4; const float* a2 = P.in[I_A2] + (size_t)((l * 2 + d) * 64) * 256 + c4;
            f32x4 xw = *(const f32x4*)(P.in[I_W0] + (l * 2 + d) * 256 + c4), xa = *(const f32x4*)(P.in[I_A0] + (l * 2 + d) * 256 + c4);
#pragma unroll 4
            for (int k = 0; k < 64; ++k) { const float tw = lw[d * 64 + k], ta = lw[128 + d * 64 + k];
                xw += *(const f32x4*)(w2 + (size_t)k * 256) * tw; xa += *(const f32x4*)(a2 + (size_t)k * 256) * ta; }
            f16x4 o1, o2, o3;
#pragma unroll
            for (int q = 0; q < 4; ++q) {
                const float nx = -xw[q]; const float sp = fmaxf(nx, 0.f) + log1pf(__expf(-fabsf(nx)));
                const float e = __expf(-sp - 0.5f);
                const float omw = -expm1f(-e);
                const float a = sigmoidf_(xa[q]);
                o1[q] = (f16_t)omw; o2[q] = (f16_t)(uk[q] * (1.0f + (a - 1.0f) * kaw[q])); o3[q] = (f16_t)(kkv[q] * a);
            }
            const size_t sdrow = ((size_t)((d * 8 + g.b) * 4 + h) * TT + g.tt) * 192;
            *(f16x4*)(SD + sdrow + cw) = o1; *(f16x4*)(SD + sdrow + 64 + cw) = o2; *(f16x4*)(SD + sdrow + 128 + cw) = o3;
        }
        __builtin_amdgcn_wave_barrier();
    }
}

constexpr int SC_CH = 32;
constexpr int SC_BUF = SC_CH * 6 * 64 * 4;
__device__ __forceinline__ float dpp_sum16(float v) {
    v += __builtin_bit_cast(float, __builtin_amdgcn_update_dpp(0, __builtin_bit_cast(int, v), 0xB1, 0xF, 0xF, true));
    v += __builtin_bit_cast(float, __builtin_amdgcn_update_dpp(0, __builtin_bit_cast(int, v), 0x4E, 0xF, 0xF, true));
    v += __builtin_bit_cast(float, __builtin_amdgcn_update_dpp(0, __builtin_bit_cast(int, v), 0x141, 0xF, 0xF, true));
    v += __builtin_bit_cast(float, __builtin_amdgcn_update_dpp(0, __builtin_bit_cast(int, v), 0x140, 0xF, 0xF, true));
    return v;
}
__device__ __forceinline__ int scan_tt0(int d, int c) { return d == 0 ? c * SC_CH : (c < 8 ? 224 - 32 * c : 4576 - 32 * c); }
__device__ __forceinline__ void scan_load_chunk(LAS unsigned char* lds, const f16_t* sh, const f16_t* sd, int d, int c, int lt) {
    const int t0 = scan_tt0(d, c);
    u32x4 ld[6];
#pragma unroll
    for (int i = 0; i < 3; ++i) { const int p = lt + i * 256; ld[i] = *(const u32x4*)(sh + (size_t)t0 * 192 + p * 8); ld[3 + i] = *(const u32x4*)(sd + (size_t)t0 * 192 + p * 8); }
    LAS float* buf = (LAS float*)(lds + (c & 1) * SC_BUF);
#pragma unroll
    for (int i = 0; i < 6; ++i) { const int p = lt + (i % 3) * 256; const int ms = p / 24, wi = p % 24, kind = wi >> 3, e0 = (wi & 7) * 8; const int st = d == 0 ? ms : (SC_CH - 1 - ms);
        const f16x8 hv = __builtin_bit_cast(f16x8, ld[i]); float f[8];
#pragma unroll
        for (int q = 0; q < 8; ++q) f[q] = (float)hv[q];
        if (i >= 3 && kind == 0) {
#pragma unroll
            for (int q = 0; q < 8; ++q) f[q] = 1.0f - f[q];
        }
        LAS float* dst = buf + (st * 6 + (i < 3 ? kind : 3 + kind)) * 64 + e0;
        *(LAS f32x4*)dst = (f32x4){f[0], f[1], f[2], f[3]}; *(LAS f32x4*)(dst + 4) = (f32x4){f[4], f[5], f[6], f[7]}; }
}
__device__ __forceinline__ void phase_scan(const Frame& F) {
    const f16_t* SH = (const f16_t*)(F.ws + WS_SH); const f16_t* SD = (const f16_t*)(F.ws + WS_SD);
    float* Y = (float*)(F.ws + WS_Y);
    const int tid = F.tid, lane = F.lane, wave = F.wave;
    constexpr int NCHUNK = TT / SC_CH;
    for (int item = F.bid; item < 256; item += F.G) {
        const int xg = item & 7, sl = item >> 3, chain = xg * 8 + (sl >> 2), quarter = sl & 3;
        const int d = chain >> 5, b = (chain >> 2) & 7, h = chain & 3;
        const f16_t* sh = SH + (size_t)(b * 4 + h) * TT * 192; const f16_t* sd = SD + (size_t)((d * 8 + b) * 4 + h) * TT * 192;
        const bool loader = wave >= 4; const int lt = tid - 256;
        if (loader) scan_load_chunk(F.lds, sh, sd, d, 0, lt);
        __syncthreads();
        float S0 = 0.f, S1 = 0.f, S2 = 0.f, S3 = 0.f;
        const int row = quarter * 16 + (wave & 3) * 4 + (lane >> 4), j0 = (lane & 15) * 4;
        float* yp = Y + ((size_t)(d * 8 + b) * TT) * 256 + h * 64 + row;
        for (int c = 0; c < NCHUNK; ++c) {
            if (loader) {
                if (c + 1 < NCHUNK) scan_load_chunk(F.lds, sh, sd, d, c + 1, lt);
            } else {
                const LAS float* buf = (const LAS float*)(F.lds + (c & 1) * SC_BUF);
                const int t0 = scan_tt0(d, c);
#pragma unroll 4
                for (int i = 0; i < SC_CH; ++i) {
                    const LAS float* sp = buf + i * 384;
                    const f32x4 r4 = *(const LAS f32x4*)(sp + j0), z4 = *(const LAS f32x4*)(sp + 128 + j0), w4 = *(const LAS f32x4*)(sp + 192 + j0),
                                k4 = *(const LAS f32x4*)(sp + 256 + j0), b4 = *(const LAS f32x4*)(sp + 320 + j0);
                    const float vr = sp[64 + row];
                    float sz = S0 * z4[0] + S1 * z4[1] + S2 * z4[2] + S3 * z4[3];
                    sz = dpp_sum16(sz);
                    S0 = S0 * w4[0] + (sz * b4[0] + vr * k4[0]); S1 = S1 * w4[1] + (sz * b4[1] + vr * k4[1]);
                    S2 = S2 * w4[2] + (sz * b4[2] + vr * k4[2]); S3 = S3 * w4[3] + (sz * b4[3] + vr * k4[3]);
                    float y = S0 * r4[0] + S1 * r4[1] + S2 * r4[2] + S3 * r4[3];
                    y = dpp_sum16(y);
                    const int tt = d == 0 ? t0 + i : t0 + SC_CH - 1 - i;
                    if ((lane & 15) == 0) yp[(size_t)tt * 256] = y;
                }
            }
            __syncthreads();
        }
    }
}

__device__ __forceinline__ void phase_rw_post(const Frame& F, const Params& P, int l, int nrows) {
    const bf16_t* PL = (const bf16_t*)(F.ws + WS_PL); bf16_t* MIX = (bf16_t*)(F.ws + WS_MIX);
    const f16_t* SH = (const f16_t*)(F.ws + WS_SH); const f16_t* SD = (const f16_t*)(F.ws + WS_SD); const float* Y = (const float*)(F.ws + WS_Y);
    const float* mup = P.in[I_MUP] + l * 1280; const float* mun = P.in[I_MUN] + l * 1280;
    LAS float* sg = (LAS float*)(F.lds + F.wave * 1024);
    const int lane = F.lane, c4 = lane * 4, h = lane >> 4, cw = (lane & 15) * 4;
    const f32x4 rk = *(const f32x4*)(P.in[I_RK] + l * 256 + c4), gng = *(const f32x4*)(P.in[I_GNG] + l * 256 + c4), gnb = *(const f32x4*)(P.in[I_GNB] + l * 256 + c4);
    for (int r = F.gw; r < nrows; r += F.nw) {
        const RowGeo g = row_geo(r);
        float u3[4], u4[4];
        rw_shift4(PL, mup, mun, r, g, 768 + c4, u3); rw_shift4(PL, mup, mun, r, g, 1024 + c4, u4);
        if (lane >= 32) {
#pragma unroll
            for (int q = 0; q < 4; ++q) { sg[c4 - 128 + q] = sigmoidf_(u3[q]); sg[128 + c4 - 128 + q] = sigmoidf_(u4[q]); }
        }
        __builtin_amdgcn_wave_barrier(); asm volatile("s_waitcnt lgkmcnt(0)" ::: "memory");
        const size_t shrow = ((size_t)(g.b * 4 + h) * TT + g.tt) * 192;
        const f16x4 rh = *(const f16x4*)(SH + shrow + cw), vh = *(const f16x4*)(SH + shrow + 64 + cw);
        float out[4] = {0.f, 0.f, 0.f, 0.f};
#pragma unroll
        for (int d = 0; d < 2; ++d) {
            const float* g2 = P.in[I_G2] + (size_t)((l * 2 + d) * 128) * 256 + c4;
            f32x4 gg = (f32x4){0.f, 0.f, 0.f, 0.f};
#pragma unroll 8
            for (int k = 0; k < 128; ++k) gg += *(const f32x4*)(g2 + (size_t)k * 256) * sg[d * 128 + k];
            const f32x4 y = *(const f32x4*)(Y + ((size_t)(d * 8 + g.b) * TT + g.tt) * 256 + c4);
            const float mu = sum16(y[0] + y[1] + y[2] + y[3]) * (1.0f / 64.0f);
            float vs = 0.f;
#pragma unroll
            for (int q = 0; q < 4; ++q) { const float dd = y[q] - mu; vs += dd * dd; }
            const float rstd = rsqrtf(sum16(vs) * (1.0f / 64.0f) + 64e-5f);
            const size_t sdrow = ((size_t)((d * 8 + g.b) * 4 + h) * TT + g.tt) * 192;
            const f16x4 kdh = *(const f16x4*)(SD + sdrow + 64 + cw);
            float bs = 0.f;
#pragma unroll
            for (int q = 0; q < 4; ++q) bs += (float)rh[q] * (float)kdh[q] * rk[q];
            bs = sum16(bs);
#pragma unroll
            for (int q = 0; q < 4; ++q) out[q] += ((y[q] - mu) * rstd * gng[q] + gnb[q] + bs * (float)vh[q]) * gg[q];
        }
        u32x2 w; w.x = pk_bf16(out[0], out[1]); w.y = pk_bf16(out[2], out[3]);
        *(u32x2*)(MIX + (size_t)r * D + 512 + c4) = w;
        __builtin_amdgcn_wave_barrier();
    }
}

__device__ __forceinline__ void phase_conv(const Frame& F, const Params& P, int l, int nrows) {
    const bf16_t* PL = (const bf16_t*)(F.ws + WS_PL); bf16_t* MIX = (bf16_t*)(F.ws + WS_MIX);
    const int lane = F.lane, c4 = lane * 4;
    const float* dw = P.in[I_DWW] + (size_t)l * 31 * 256 + c4;
    const f32x4 dwb = *(const f32x4*)(P.in[I_DWB] + l * 256 + c4), lng = *(const f32x4*)(P.in[I_LNG] + l * 256 + c4), lnb = *(const f32x4*)(P.in[I_LNB] + l * 256 + c4);
    for (int r = F.gw; r < nrows; r += F.nw) {
        const RowGeo g = row_geo(r);
        f32x4 acc = dwb;
#pragma unroll 1
        for (int j = 0; j < 31; ++j) { const int tp = g.pos + j - 15;
            if (tp >= 0 && tp < g.len) { const bf16_t* p = PL + (size_t)(r + j - 15) * INW + O_CV + c4; float a[4], bb[4];
                unpack4(*(const u32x2*)p, a); unpack4(*(const u32x2*)(p + 256), bb);
                const f32x4 w = *(const f32x4*)(dw + j * 256);
#pragma unroll
                for (int q = 0; q < 4; ++q) acc[q] += a[q] * sigmoidf_(bb[q]) * w[q]; } }
        const float mu = wave_sum(acc[0] + acc[1] + acc[2] + acc[3]) * (1.0f / 256.0f);
        float vs = 0.f;
#pragma unroll
        for (int q = 0; q < 4; ++q) { const float dd = acc[q] - mu; vs += dd * dd; }
        const float rstd = rsqrtf(wave_sum(vs) * (1.0f / 256.0f) + 1e-5f);
        float o[4];
#pragma unroll
        for (int q = 0; q < 4; ++q) o[q] = siluf_((acc[q] - mu) * rstd * lng[q] + lnb[q]);
        u32x2 w; w.x = pk_bf16(o[0], o[1]); w.y = pk_bf16(o[2], o[3]);
        *(u32x2*)(MIX + (size_t)r * D + 768 + c4) = w;
    }
}

__device__ __forceinline__ void phase_na_simple(const Frame& F, const Params& P, int l, int nq) {
    const bf16_t* PL = (const bf16_t*)(F.ws + WS_PL); bf16_t* MIX = (bf16_t*)(F.ws + WS_MIX);
    const float* rpb = P.in[I_RPB] + (size_t)l * 8 * 15 * 31;
    int tid_ = F.tid; asm volatile("" : "+v"(tid_));
    for (int gid = F.bid * NTHREADS + tid_; gid < nq * 8; gid += F.G * NTHREADS) {
        const int r = gid >> 3, h = gid & 7;
        const RowGeo g = row_geo(r);
        float q[64], o[64];
        { const bf16_t* qp = PL + (size_t)r * INW + O_Q + h * 64;
#pragma unroll
          for (int i = 0; i < 8; ++i) unpack8(*(const u32x4*)(qp + i * 8), q + i * 8); }
#pragma unroll
        for (int i = 0; i < 64; ++i) o[i] = 0.f;
        float m = -3.0e38f, lsum = 0.f;
        const bool lat = r < NLAT;
        const int gi = g.pos >> 6, gc = g.pos & 63;
        const int rs = min(max(gi - 4, 0), 56), wsc = min(max(gc - 8, 0), 48);
        const int nkey = lat ? 384 : 256;
#pragma unroll 1
        for (int kx = 0; kx < nkey; ++kx) {
            const bool win = lat && kx < 128;
            int krow; float bias = 0.f;
            if (win) { const int r8 = kx >> 4, cc = kx & 15; krow = g.b * SEQ + (rs + r8) * 64 + wsc + cc; bias = rpb[(h * 15 + (rs + r8 - gi + 7)) * 31 + (wsc + cc - gc + 15)]; }
            else krow = NLAT + g.b * CTXL + (kx - (lat ? 128 : 0));
            const bf16_t* kp = PL + (size_t)krow * INW + O_K + h * 64; float a = bias;
#pragma unroll
            for (int i = 0; i < 8; ++i) { float kf[8]; unpack8(*(const u32x4*)(kp + i * 8), kf);
#pragma unroll
                for (int j = 0; j < 8; ++j) a += q[i * 8 + j] * kf[j]; }
            if (a > m) { const float alpha = __expf(m - a); lsum *= alpha;
#pragma unroll
                for (int i = 0; i < 64; ++i) o[i] *= alpha;
                m = a; }
            const float p = __expf(a - m); lsum += p;
            const bf16_t* vp = kp + (O_V - O_K);
#pragma unroll
            for (int i = 0; i < 8; ++i) { float vf[8]; unpack8(*(const u32x4*)(vp + i * 8), vf);
#pragma unroll
                for (int j = 0; j < 8; ++j) o[i * 8 + j] += p * vf[j]; }
        }
        const float inv = 1.0f / lsum;
        bf16_t* op = MIX + (size_t)r * D + h * 64;
#pragma unroll
        for (int i = 0; i < 8; ++i) { u32x4 w; w.x = pk_bf16(o[i * 8] * inv, o[i * 8 + 1] * inv); w.y = pk_bf16(o[i * 8 + 2] * inv, o[i * 8 + 3] * inv);
            w.z = pk_bf16(o[i * 8 + 4] * inv, o[i * 8 + 5] * inv); w.w = pk_bf16(o[i * 8 + 6] * inv, o[i * 8 + 7] * inv); *(u32x4*)(op + i * 8) = w; }
    }
}

typedef short v4i16_t __attribute__((ext_vector_type(4)));
constexpr int NA_CK = 0, NA_CV = 32768, NA_RPB = 65536, NA_WV = 81920;
__device__ __forceinline__ bf16x8 na_pack8(const f32x4& a, const f32x4& b) {
    u32x4 w; w.x = cvt_pk_bf16(a[0], a[1]); w.y = cvt_pk_bf16(a[2], a[3]); w.z = cvt_pk_bf16(b[0], b[1]); w.w = cvt_pk_bf16(b[2], b[3]); return __builtin_bit_cast(bf16x8, w);
}
__device__ __forceinline__ bf16x8 na_vfrag(LAS unsigned char* blk, int lane, int dt) {
    const int g = lane >> 4, qq = (lane & 15) >> 2, p = lane & 3;
    const int r0 = 4 * g + qq, r1 = 16 + 4 * g + qq;
    const v4i16_t lo = __builtin_amdgcn_ds_read_tr16_b64_v4i16((LAS v4i16_t*)(blk + r0 * 128 + ((dt ^ ((r0 >> 1) & 3)) * 32) + p * 8));
    const v4i16_t hi = __builtin_amdgcn_ds_read_tr16_b64_v4i16((LAS v4i16_t*)(blk + r1 * 128 + ((dt ^ ((r1 >> 1) & 3)) * 32) + p * 8));
    bf16x8 r; r[0] = lo[0]; r[1] = lo[1]; r[2] = lo[2]; r[3] = lo[3]; r[4] = hi[0]; r[5] = hi[1]; r[6] = hi[2]; r[7] = hi[3]; return r;
}
template <bool WINDOW>
__device__ __forceinline__ void na_item(const Frame& F, const bf16_t* PL, bf16_t* MIX, int b, int h, int qrow0  , int gi, int cb) {
    const int lane = F.lane, ql = lane & 15, g = lane >> 4;
    LAS unsigned char* CK = F.lds + NA_CK; LAS unsigned char* CV = F.lds + NA_CV; const LAS float* RPB = (const LAS float*)(F.lds + NA_RPB);
    LAS unsigned char* WV = F.lds + NA_WV + F.wave * 4096;
    bf16x8 Qf[2];
    { const bf16_t* qp = PL + (size_t)(qrow0 + ql) * INW + O_Q + h * 64 + 8 * g; Qf[0] = *(const bf16x8*)qp; Qf[1] = *(const bf16x8*)(qp + 32); }
    f32x4 acc[4];
#pragma unroll
    for (int dt = 0; dt < 4; ++dt) acc[dt] = (f32x4){0.f, 0.f, 0.f, 0.f};
    float m_run = -3.0e38f, l_run = 0.f;
    if constexpr (WINDOW) {
        const int rs = min(max(gi - 4, 0), 56), kc0 = min(max(16 * cb - 8, 0), 32), qcol = 16 * cb + ql, wsq = min(max(qcol - 8, 0), 48);
        const size_t krow0 = (size_t)b * SEQ + (size_t)rs * 64 + kc0;
        f32x4 s[16];
#pragma unroll
        for (int t = 0; t < 16; ++t) { const bf16_t* kp = PL + (krow0 + (size_t)(t >> 1) * 64 + (t & 1) * 16 + ql) * INW + O_K + h * 64 + 8 * g;
            const bf16x8 k0 = *(const bf16x8*)kp, k1 = *(const bf16x8*)(kp + 32);
            s[t] = __builtin_amdgcn_mfma_f32_16x16x32_bf16(k0, Qf[0], (f32x4){0.f, 0.f, 0.f, 0.f}, 0, 0, 0);
            s[t] = __builtin_amdgcn_mfma_f32_16x16x32_bf16(k1, Qf[1], s[t], 0, 0, 0); }
        float mx = -3.0e38f;
#pragma unroll
        for (int t = 0; t < 16; ++t) { const LAS float* bp = RPB + (h * 15 + (rs + (t >> 1) - gi + 7)) * 31 + 15 - qcol;
#pragma unroll
            for (int j = 0; j < 4; ++j) { const int kcol = kc0 + (t & 1) * 16 + 4 * g + j; const bool ok = kcol >= wsq && kcol < wsq + 16;
                const float v = ok ? s[t][j] + bp[ok ? kcol : qcol] : -INFINITY; s[t][j] = v; mx = fmaxf(mx, v); } }
        mx = fmaxf(mx, __shfl_xor(mx, 16)); mx = fmaxf(mx, __shfl_xor(mx, 32));
        m_run = mx;
        float ls = 0.f;
#pragma unroll
        for (int t = 0; t < 16; ++t)
#pragma unroll
            for (int j = 0; j < 4; ++j) { const float p = __expf(s[t][j] - mx); s[t][j] = p; ls += p; }
        l_run = ls;
#pragma unroll
        for (int r8 = 0; r8 < 8; ++r8) {
            { const int vr = lane >> 1, part = lane & 1;
              const bf16_t* vp = PL + (krow0 + (size_t)r8 * 64 + vr) * INW + O_V + h * 64 + part * 32;
              u32x4 v0 = *(const u32x4*)vp, v1 = *(const u32x4*)(vp + 8), v2 = *(const u32x4*)(vp + 16), v3 = *(const u32x4*)(vp + 24);
              LAS unsigned char* wr = WV + vr * 128; const int sw = (vr >> 1) & 3;
              *(LAS u32x4*)(wr + (((2 * part) ^ sw) * 32)) = v0; *(LAS u32x4*)(wr + (((2 * part) ^ sw) * 32) + 16) = v1;
              *(LAS u32x4*)(wr + (((2 * part + 1) ^ sw) * 32)) = v2; *(LAS u32x4*)(wr + (((2 * part + 1) ^ sw) * 32) + 16) = v3; }
            __builtin_amdgcn_wave_barrier(); asm volatile("" ::: "memory");
            const bf16x8 pf = na_pack8(s[2 * r8], s[2 * r8 + 1]);
#pragma unroll
            for (int dt = 0; dt < 4; ++dt) { const bf16x8 vf = na_vfrag(WV, lane, dt); acc[dt] = __builtin_amdgcn_mfma_f32_16x16x32_bf16(vf, pf, acc[dt], 0, 0, 0); }
            __builtin_amdgcn_wave_barrier(); asm volatile("" ::: "memory");
        }
    }
    {
        f32x4 s[16];
#pragma unroll
        for (int t = 0; t < 16; ++t) { const int key = 16 * t + ql; const LAS unsigned char* kr = CK + key * 128;
            const bf16x8 k0 = *(const LAS bf16x8*)(kr + ((g ^ (key & 7)) * 16)), k1 = *(const LAS bf16x8*)(kr + (((g + 4) ^ (key & 7)) * 16));
            s[t] = __builtin_amdgcn_mfma_f32_16x16x32_bf16(k0, Qf[0], (f32x4){0.f, 0.f, 0.f, 0.f}, 0, 0, 0);
            s[t] = __builtin_amdgcn_mfma_f32_16x16x32_bf16(k1, Qf[1], s[t], 0, 0, 0); }
        float mx = m_run;
#pragma unroll
        for (int t = 0; t < 16; ++t)
#pragma unroll
            for (int j = 0; j < 4; ++j) mx = fmaxf(mx, s[t][j]);
        mx = fmaxf(mx, __shfl_xor(mx, 16)); mx = fmaxf(mx, __shfl_xor(mx, 32));
        const float alpha = __expf(m_run - mx);
        float ls = l_run * alpha;
#pragma unroll
        for (int dt = 0; dt < 4; ++dt) acc[dt] *= alpha;
#pragma unroll
        for (int t = 0; t < 16; ++t)
#pragma unroll
            for (int j = 0; j < 4; ++j) { const float p = __expf(s[t][j] - mx); s[t][j] = p; ls += p; }
        l_run = ls;
#pragma unroll
        for (int blk = 0; blk < 8; ++blk) { const bf16x8 pf = na_pack8(s[2 * blk], s[2 * blk + 1]);
#pragma unroll
            for (int dt = 0; dt < 4; ++dt) { const bf16x8 vf = na_vfrag(CV + blk * 4096, lane, dt); acc[dt] = __builtin_amdgcn_mfma_f32_16x16x32_bf16(vf, pf, acc[dt], 0, 0, 0); } }
    }
    float lt = l_run; lt += __shfl_xor(lt, 16); lt += __shfl_xor(lt, 32);
    const float inv = 1.0f / lt;
    bf16_t* op = MIX + (size_t)(qrow0 + ql) * D + h * 64 + 4 * g;
#pragma unroll
    for (int dt = 0; dt < 4; ++dt) { u32x2 w; w.x = cvt_pk_bf16(acc[dt][0] * inv, acc[dt][1] * inv); w.y = cvt_pk_bf16(acc[dt][2] * inv, acc[dt][3] * inv); *(u32x2*)(op + dt * 16) = w; }
}
__device__ __forceinline__ void phase_na_mfma(const Frame& F, const Params& P, int l, bool ctx_queries) {
    const bf16_t* PL = (const bf16_t*)(F.ws + WS_PL); bf16_t* MIX = (bf16_t*)(F.ws + WS_MIX);
    int tid_ = F.tid; asm volatile("" : "+v"(tid_));
    const int tid = tid_;
    { const float* rpb = P.in[I_RPB] + (size_t)l * 8 * 15 * 31; LAS float* R = (LAS float*)(F.lds + NA_RPB); for (int i = tid; i < 8 * 15 * 31; i += NTHREADS) R[i] = rpb[i]; }
    for (int unit = F.bid; unit < 256; unit += F.G) {
        const int quarter = unit & 3, h = (unit >> 2) & 7, b = unit >> 5;
        __syncthreads();
        { const int key = tid >> 1, part = tid & 1; const bf16_t* kp = PL + (size_t)(NLAT + b * CTXL + key) * INW + O_K + h * 64 + part * 32; const bf16_t* vp = kp + (O_V - O_K);
          LAS unsigned char* kr = F.lds + NA_CK + key * 128; LAS unsigned char* vr = F.lds + NA_CV + key * 128; const int sw = (key >> 1) & 3;
#pragma unroll
          for (int c = 0; c < 4; ++c) { *(LAS u32x4*)(kr + (((4 * part + c) ^ (key & 7)) * 16)) = *(const u32x4*)(kp + 8 * c);
              const int c16 = 4 * part + c; *(LAS u32x4*)(vr + (((c16 >> 1) ^ sw) * 32) + (c16 & 1) * 16) = *(const u32x4*)(vp + 8 * c); } }
        __syncthreads();
        for (int it = F.wave; it < 64; it += NWAVES) { const int gi = quarter * 16 + (it >> 2), cb = it & 3;
            na_item<true>(F, PL, MIX, b, h, b * SEQ + gi * 64 + cb * 16, gi, cb); }
        if (ctx_queries && F.wave < 4) na_item<false>(F, PL, MIX, b, h, NLAT + b * CTXL + (quarter * 4 + F.wave) * 16, 0, 0);
    }
}

__device__ __forceinline__ void phase_final(const Frame& F, const Params& P) {
    float* out = P.out; const float* g = P.in[I_FINALG]; const int lane = F.lane;
    for (int r = F.gw; r < NLAT; r += F.nw) {
        float* xr = out + (size_t)r * D; f32x4 x[4]; float ss = 0.f;
#pragma unroll
        for (int j = 0; j < 4; ++j) { x[j] = *(const f32x4*)(xr + j * 256 + lane * 4); ss += x[j][0] * x[j][0] + x[j][1] * x[j][1] + x[j][2] * x[j][2] + x[j][3] * x[j][3]; }
        ss = wave_sum(ss); const float rstd = rsqrtf(ss * (1.0f / D) + 1e-6f);
#pragma unroll
        for (int j = 0; j < 4; ++j) { const f32x4 gg = *(const f32x4*)(g + j * 256 + lane * 4); *(f32x4*)(xr + j * 256 + lane * 4) = x[j] * rstd * gg; }
    }
}

constexpr int PH_L0 = 1, PH_PER_L0 = 9, PH_L1 = PH_L0 + PH_PER_L0, PH_PER_L1 = 12, PH_FINAL = PH_L1 + PH_PER_L1, N_PHASES = PH_FINAL + 1;
#define RFL(x) __builtin_amdgcn_readfirstlane(x)

PHASE ph_prologue(const void* kp_) { PHASE_ENTER; if constexpr (MKB(0)) phase_prologue(F, P); }
PHASE ph_norm1(const void* kp_, int l_) { PHASE_ENTER; const int l = RFL(l_);
    if constexpr (MKB(1)) phase_norm<false>(F, P, l, 0, NROW, l == 0 ? P.in[I_X] : P.out, l == 0 ? P.in[I_CTX] : (const float*)(F.ws + WS_XC)); }
PHASE_INL ph_gemm_win(const void* kp_, int l_) { PHASE_ENTER; const int l = RFL(l_);
    pg8::DenseSched S; S.init(NROW / 256, INW / 256, F.G, F.bid); S.A = (const bf16_t*)(F.ws + WS_HL); S.Bt = (const bf16_t*)(F.ws + WS_BTIN) + (size_t)l * INW * D; S.K = D;
    pg8::EpiBf16 E{(bf16_t*)(F.ws + WS_PL), INW, 2, 0.125f};
    if constexpr (MKB(2)) pg8::gemm_phase<pg8::EpiBf16, pg8::DenseSched, false>(F.lds, D, S, E); }
PHASE ph_rw_prep(const void* kp_, int l_) { PHASE_ENTER; const int l = RFL(l_); if constexpr (MKB(3)) phase_rw_prep(F, P, l); }
PHASE ph_conv(const void* kp_, int l_) { PHASE_ENTER; const int l = RFL(l_); if constexpr (MKB(4)) phase_conv(F, P, l, l == 0 ? NROW : NLAT); }
PHASE_INL ph_na(const void* kp_, int l_) { PHASE_ENTER; const int l = RFL(l_); if constexpr (MKB(5)) phase_na_mfma(F, P, l, l == 0); }
PHASE ph_scan(const void* kp_) { PHASE_ENTER; if constexpr (MKB(6)) phase_scan(F); }
PHASE ph_rw_post(const void* kp_, int l_) { PHASE_ENTER; const int l = RFL(l_); if constexpr (MKB(7)) phase_rw_post(F, P, l, l == 0 ? NROW : NLAT); }
PHASE_INL ph_gemm_wout(const void* kp_, int l_) { PHASE_ENTER; const int l = RFL(l_);
    float* XC = (float*)(F.ws + WS_XC);
    pg8::DenseSched S; S.init((l == 0 ? NROW : NLAT) / 256, D / 256, F.G, F.bid); S.A = (const bf16_t*)(F.ws + WS_MIX); S.Bt = (const bf16_t*)(F.ws + WS_BTOUT) + (size_t)l * D * D; S.K = D;
    pg8::EpiRes E{l == 0 ? P.in[I_X] : P.out, l == 0 ? P.in[I_CTX] : XC, P.out, XC, (const float*)(F.ws + WS_MODV) + (size_t)l * 9 * MODW + 2 * D};
    if constexpr (MKB(8)) pg8::gemm_phase<pg8::EpiRes, pg8::DenseSched, false>(F.lds, D, S, E); }
PHASE ph_norm2_l0(const void* kp_) { PHASE_ENTER; if constexpr (MKB(9)) phase_norm<false>(F, P, 0, 1, NROW, P.out, (const float*)(F.ws + WS_XC)); }
PHASE_INL ph_gemm_ffn_gu(const void* kp_) { PHASE_ENTER;
    pg8::DenseSched S; S.init(NROW / 256, (2 * DFF) / 256, F.G, F.bid); S.A = (const bf16_t*)(F.ws + WS_HL); S.Bt = (const bf16_t*)(F.ws + WS_BTGU); S.K = D;
    pg8::EpiSwiGLU E{(bf16_t*)(F.ws + WS_H), DFF};
    if constexpr (MKB(10)) pg8::gemm_phase<pg8::EpiSwiGLU, pg8::DenseSched, false>(F.lds, D, S, E); }
PHASE_INL ph_gemm_ffn_dn(const void* kp_) { PHASE_ENTER;
    float* XC = (float*)(F.ws + WS_XC);
    pg8::DenseSched S; S.init(NROW / 256, D / 256, F.G, F.bid); S.A = (const bf16_t*)(F.ws + WS_H); S.Bt = (const bf16_t*)(F.ws + WS_BTDN); S.K = DFF;
    pg8::EpiRes E{P.out, XC, P.out, XC, (const float*)(F.ws + WS_MODV) + 5 * D};
    if constexpr (MKB(11)) pg8::gemm_phase<pg8::EpiRes, pg8::DenseSched, false>(F.lds, DFF, S, E); }
PHASE ph_norm2_l1(const void* kp_) { PHASE_ENTER; if constexpr (MKB(12)) phase_norm<true>(F, P, 1, 1, NLAT, P.out, (const float*)(F.ws + WS_XC)); }
PHASE ph_moe_prep(const void* kp_) { PHASE_ENTER; if constexpr (MKB(13)) { phase_moe_rowmap(F); phase_moe_convert(F, P); } }
PHASE_INL ph_gemm_moe_gu(const void* kp_, int pass_) { PHASE_ENTER; const int pass = RFL(pass_);
    pg8::MoeSched S; moe_tstart(F, pass, S.tstart); S.init(S.tstart[8], (2 * DFE) / 256, F.G, F.bid);
    S.A = (const bf16_t*)(F.ws + WS_HL); S.Bt0 = F.ws + WS_MOE; S.e_stride = MOE_E_BYTES; S.K = D; S.rowmap = (const int*)(F.ws + WS_ROUTE + RT_RMAP) + pass * NROW;
    pg8::EpiSwiGLU E{(bf16_t*)(F.ws + WS_H), DFE};
    if constexpr (MKB(14)) pg8::gemm_phase<pg8::EpiSwiGLU, pg8::MoeSched, true>(F.lds, D, S, E); }
PHASE_INL ph_gemm_moe_dn(const void* kp_, int pass_) { PHASE_ENTER; const int pass = RFL(pass_);
    pg8::MoeSched S; moe_tstart(F, pass, S.tstart); S.init(S.tstart[8], D / 256, F.G, F.bid);
    S.A = (const bf16_t*)(F.ws + WS_H); S.Bt0 = F.ws + WS_MOE + MOE_GU_BYTES; S.e_stride = MOE_E_BYTES; S.K = DFE; S.rowmap = nullptr;
    pg8::EpiMoeDown E{P.out, (const float*)(F.ws + WS_MODV) + (size_t)9 * MODW + 5 * D, (const int*)(F.ws + WS_ROUTE + RT_RMAP) + pass * NROW, (const float*)(F.ws + WS_ROUTE + RT_SGATE) + pass * NROW};
    if constexpr (MKB(15)) pg8::gemm_phase<pg8::EpiMoeDown, pg8::MoeSched, false>(F.lds, DFE, S, E); }
PHASE ph_final(const void* kp_) { PHASE_ENTER; if constexpr (MKB(16)) phase_final(F, P); }

static __attribute__((noinline)) __device__ void grid_barrier(const void* bar_, unsigned x_) {
    const unsigned long long v = (unsigned long long)bar_;
    const unsigned lo = __builtin_amdgcn_readfirstlane((unsigned)v), hi = __builtin_amdgcn_readfirstlane((unsigned)(v >> 32));
    XcdBarrier b; b.bar = (unsigned*)(((unsigned long long)hi << 32) | lo); b.x = __builtin_amdgcn_readfirstlane(x_);
    b.st = (volatile LAS unsigned*)((LAS unsigned char*)lds_raw + LDS_MISC);
    xcd_barrier(b);
}
__device__ __forceinline__ bool ph_in(int lo, int hi, int k) { asm volatile("" : "+s"(lo), "+s"(hi)); return lo <= k && k < hi; }

__global__ void __launch_bounds__(NTHREADS, 2) mk_fwd(Params P) {
    const void* kp = (const void*)__builtin_amdgcn_kernarg_segment_ptr();
    LAS unsigned char* lds = (LAS unsigned char*)lds_raw;
    volatile LAS unsigned* misc = (volatile LAS unsigned*)(lds + LDS_MISC);
    if (threadIdx.x < 4) misc[threadIdx.x] = 0u;
    __syncthreads();
    const int lo = P.ph_lo, hi = P.ph_hi;
    XcdBarrier bar; bar.bar = (unsigned*)(P.ws + WS_CTL) + CW_BAR; bar.x = 0; bar.st = misc;
    if (hi - lo > 1) bar = xcd_barrier_post((unsigned*)(P.ws + WS_CTL) + CW_BAR, misc);
#define IN(k) ph_in(lo, hi, (k))
#define SEAM(k) do { if (IN((k) + 1)) grid_barrier((const void*)bar.bar, bar.x); } while (0)
    if (IN(0)) { ph_prologue(kp); SEAM(0); }
#pragma unroll 1
    for (int l = 0; l < 2; ++l) {
        const int pb = l == 0 ? PH_L0 : PH_L1;
        if (IN(pb + 0)) { ph_norm1(kp, l); SEAM(pb + 0); }
        if (IN(pb + 1)) { ph_gemm_win(kp, l); SEAM(pb + 1); }
        if (IN(pb + 2)) { ph_rw_prep(kp, l); ph_conv(kp, l); ph_na(kp, l); SEAM(pb + 2); }
        if (IN(pb + 3)) { ph_scan(kp); SEAM(pb + 3); }
        if (IN(pb + 4)) { ph_rw_post(kp, l); SEAM(pb + 4); }
        if (IN(pb + 5)) { ph_gemm_wout(kp, l); SEAM(pb + 5); }
        if (l == 0) {
            if (IN(pb + 6)) { ph_norm2_l0(kp); SEAM(pb + 6); }
            if (IN(pb + 7)) { ph_gemm_ffn_gu(kp); SEAM(pb + 7); }
            if (IN(pb + 8)) { ph_gemm_ffn_dn(kp); SEAM(pb + 8); }
        } else {
            if (IN(pb + 6)) { ph_norm2_l1(kp); SEAM(pb + 6); }
            if (IN(pb + 7)) { ph_moe_prep(kp); SEAM(pb + 7); }
#pragma unroll 1
            for (int pass = 0; pass < 2; ++pass) {
                if (IN(pb + 8 + 2 * pass)) { ph_gemm_moe_gu(kp, pass); SEAM(pb + 8 + 2 * pass); }
                if (IN(pb + 9 + 2 * pass)) { ph_gemm_moe_dn(kp, pass); SEAM(pb + 9 + 2 * pass); }
            }
        }
    }
    if (IN(PH_FINAL)) ph_final(kp);
#undef IN
#undef SEAM
}

extern "C" void kernel_launch(void* const* d_in, const int* in_sizes, int n_in, void* d_out, int out_size, void* d_ws, size_t ws_size, hipStream_t stream) {
    static int grid = 0;
    if (grid == 0) {
        if (n_in != 35 || out_size != NLAT * D || ws_size < WS_END) { fprintf(stderr, "kernel_launch: unexpected shapes (n_in %d out %d ws %zu need %zu)\n", n_in, out_size, ws_size, (size_t)WS_END); grid = -1; return; }
        int dev = 0, cus = 0, per_cu = 0;
        if (hipGetDevice(&dev) != hipSuccess || hipDeviceGetAttribute(&cus, hipDeviceAttributeMultiprocessorCount, dev) != hipSuccess) { grid = -1; return; }
        if (hipFuncSetAttribute((const void*)mk_fwd, hipFuncAttributeMaxDynamicSharedMemorySize, LDS_BYTES) != hipSuccess) { fprintf(stderr, "kernel_launch: hipFuncSetAttribute failed\n"); grid = -1; return; }
        if (hipOccupancyMaxActiveBlocksPerMultiprocessor(&per_cu, (const void*)mk_fwd, NTHREADS, LDS_BYTES) != hipSuccess || per_cu < 1) { fprintf(stderr, "kernel_launch: occupancy query says %d\n", per_cu); (void)hipGetLastError(); }
        grid = cus;
    }
    if (grid < 0) return;
    (void)hipMemsetAsync((char*)d_ws + WS_CTL, 0, CTL_BYTES, stream);
    Params p{};
    for (int i = 0; i < 35; ++i) p.in[i] = (const float*)d_in[i];
    p.out = (float*)d_out; p.ws = (unsigned char*)d_ws;
#if MK_ONE_LAUNCH
    p.ph_lo = 0; p.ph_hi = N_PHASES;
    hipLaunchKernelGGL(mk_fwd, dim3(grid), dim3(NTHREADS), LDS_BYTES, stream, p);
#else
    for (int k = 0; k < N_PHASES && k <= MK_LAST; ++k) { p.ph_lo = k; p.ph_hi = k + 1; hipLaunchKernelGGL(mk_fwd, dim3(grid), dim3(NTHREADS), LDS_BYTES, stream, p); }
#endif
}
```

```cpp
#include <hip/hip_runtime.h>
#include <stdint.h>
#include <stdio.h>

#ifndef MK_MASK
#define MK_MASK 0xFFFFFFFFu
#endif
#define MKB(k) (((MK_MASK) >> (k)) & 1u)
#ifndef REP_SCAN
#define REP_SCAN 1
#endif
#ifndef REP_NA
#define REP_NA 1
#endif
#ifndef REP_GEMM
#define REP_GEMM 1
#endif
#ifndef REP_PP
#define REP_PP 1
#endif
#ifndef MK_LAST
#define MK_LAST 99
#endif
#ifndef MK_ONE_LAUNCH
#define MK_ONE_LAUNCH 1
#endif

#define LAS __attribute__((address_space(3)))
typedef unsigned short bf16_t;
typedef _Float16 f16_t;
typedef short bf16x8 __attribute__((ext_vector_type(8)));
typedef float f32x4 __attribute__((ext_vector_type(4)));
typedef float f32x2 __attribute__((ext_vector_type(2)));
typedef unsigned u32x4 __attribute__((ext_vector_type(4)));
typedef unsigned u32x2 __attribute__((ext_vector_type(2)));
typedef f16_t f16x4 __attribute__((ext_vector_type(4)));
typedef f16_t f16x8 __attribute__((ext_vector_type(8)));

constexpr int D = 1024, NB = 8, SEQ = 4096, CTXL = 256, TT = CTXL + SEQ;
constexpr int NLAT = NB * SEQ, NCTX = NB * CTXL, NROW = NLAT + NCTX;
constexpr int INW = 3328, DFF = 2816, DFE = 3584, NEXP = 8;
constexpr int O_Q = 0, O_K = 512, O_V = 1024, O_RW = 1536, O_CV = 2816;
constexpr int MODW = 6 * D;
constexpr int NTHREADS = 512, NWAVES = 8;
constexpr int LDS_BYTES = 160 * 1024;
constexpr int LDS_MISC = LDS_BYTES - 256;

constexpr size_t al256(size_t x) { return (x + 255) & ~(size_t)255; }
constexpr size_t WS_CTL   = 0;
constexpr size_t CTL_BYTES = 65536;
constexpr size_t WS_MODV  = WS_CTL + CTL_BYTES;
constexpr size_t WS_BTIN  = al256(WS_MODV + (size_t)2 * 9 * MODW * 4);
constexpr size_t WS_BTOUT = al256(WS_BTIN + (size_t)2 * INW * D * 2);
constexpr size_t WS_BTGU  = al256(WS_BTOUT + (size_t)2 * D * D * 2);
constexpr size_t WS_BTDN  = al256(WS_BTGU + (size_t)2 * DFF * D * 2);
constexpr size_t WS_LORA  = al256(WS_BTDN + (size_t)D * DFF * 2);
constexpr size_t LORA_LD_BYTES = (size_t)(256 * 64 * 2 + 256 * 128) * 2;
constexpr size_t WS_MOE   = al256(WS_LORA + 4 * LORA_LD_BYTES);
constexpr size_t MOE_GU_BYTES = (size_t)2 * DFE * D * 2, MOE_DN_BYTES = (size_t)D * DFE * 2, MOE_E_BYTES = MOE_GU_BYTES + MOE_DN_BYTES;
constexpr size_t WS_SH    = WS_MOE;
constexpr size_t SH_BYTES = (size_t)NB * 4 * TT * 192 * 2;
constexpr size_t WS_SD    = WS_SH + SH_BYTES;
constexpr size_t WS_XC    = al256(WS_MOE + (size_t)NEXP * MOE_E_BYTES);
constexpr size_t WS_HL    = al256(WS_XC + (size_t)NCTX * D * 4);
constexpr size_t WS_Y     = WS_HL;
constexpr size_t WS_PL    = al256(WS_HL + (size_t)NROW * D * 2);
constexpr size_t WS_MIX   = al256(WS_PL + (size_t)NROW * INW * 2);
constexpr size_t WS_H     = WS_PL;
constexpr size_t WS_ROUTE = al256(WS_MIX + (size_t)NROW * D * 2);
constexpr size_t RT_TOKE  = 0;
constexpr size_t RT_TOKG  = RT_TOKE + (size_t)NLAT * 2 * 4;
constexpr size_t RT_TOKP  = RT_TOKG + (size_t)NLAT * 2 * 4;
constexpr size_t RT_RMAP  = RT_TOKP + (size_t)NLAT * 2 * 4;
constexpr size_t RT_SGATE = RT_RMAP + (size_t)2 * NROW * 4;
constexpr size_t WS_END   = al256(WS_ROUTE + RT_SGATE + (size_t)2 * NROW * 4);
static_assert(SH_BYTES * 3 <= (size_t)NEXP * MOE_E_BYTES, "scan inputs must fit the MoE weight region");
static_assert((size_t)NROW * DFE * 2 <= (size_t)NROW * INW * 2 + (size_t)NROW * D * 2, "H must fit PL+MIX");

constexpr int CW_BAR = 0;
constexpr int CW_MOECNT = 4096;

#define XB_TMO      128
#define XB_XCNT(j)  (256  + 64 * (j))
#define XB_XSUB(j)  (1280 + 64 * (j))
#define XB_XGEN(j)  (2304 + 64 * (j))
#define XB_TOP      3328
#define XB_TOPGEN   3392
#define XCD_BAR_WORDS 3456
#define XB_SPIN_CAP (1u << 22)

__device__ __forceinline__ unsigned xb_ld(unsigned* p)              { return __hip_atomic_load(p, __ATOMIC_RELAXED, __HIP_MEMORY_SCOPE_AGENT); }
__device__ __forceinline__ unsigned xb_add(unsigned* p, unsigned v) { return __hip_atomic_fetch_add(p, v, __ATOMIC_RELAXED, __HIP_MEMORY_SCOPE_AGENT); }
__device__ __forceinline__ unsigned xb_xcc_id() { return (unsigned)__builtin_amdgcn_s_getreg((3 << 11) | 20) & 0xFu; }
#define XB_SPIN(cond, bar) do { unsigned _sp = 0; while (cond) { __builtin_amdgcn_s_sleep(1); \
    if ((++_sp & 255u) == 0u) { if (xb_ld(&(bar)[XB_TMO])) break; if (_sp > XB_SPIN_CAP) { atomicAdd(&(bar)[XB_TMO], 1u); break; } } } } while (0)

struct XcdBarrier { unsigned* bar; unsigned x; volatile LAS unsigned* st; };

__device__ __forceinline__ XcdBarrier xcd_barrier_post(unsigned* bar, volatile LAS unsigned* st, int tid) {
    XcdBarrier b; b.bar = bar; b.x = xb_xcc_id(); b.st = st;
    if (tid == 0) (void)xb_add(&bar[XB_XCNT(b.x)], 1u);
    return b;
}
__device__ __forceinline__ void xcd_barrier_complete(unsigned* bar, unsigned x, unsigned& nloc, unsigned& nx) {
    const unsigned G = gridDim.x * gridDim.y * gridDim.z;
    unsigned sum, cnt, mine, sp = 0u;
    for (;;) {
        sum = 0u; cnt = 0u; mine = 0u;
#pragma unroll
        for (unsigned j = 0; j < 16; ++j) { const unsigned c = xb_ld(&bar[XB_XCNT(j)]); sum += c; cnt += (c > 0u) ? 1u : 0u; mine = (j == x) ? c : mine; }
        if (sum == G) break;
        __builtin_amdgcn_s_sleep(1);
        if ((++sp & 255u) == 0u) { if (xb_ld(&bar[XB_TMO])) break; if (sp > XB_SPIN_CAP) { atomicAdd(&bar[XB_TMO], 1u); break; } }
    }
    nloc = mine > 0u ? mine : 1u; nx = cnt > 0u ? cnt : 1u;
}
__device__ __forceinline__ void xcd_barrier(const XcdBarrier& b, int tid) {
    asm volatile("s_waitcnt vmcnt(0)" ::: "memory");
    __syncthreads();
    if (tid == 0) {
        unsigned* bar = b.bar;
        __builtin_amdgcn_s_waitcnt(0);
        unsigned nloc = b.st[0], nx = b.st[1];
        if (nloc == 0u) { xcd_barrier_complete(bar, b.x, nloc, nx); b.st[0] = nloc; b.st[1] = nx; }
        const unsigned old = xb_add(&bar[XB_XSUB(b.x)], 1u);
        const unsigned gen = old / nloc;
        if (old + 1u == (gen + 1u) * nloc) {
            __builtin_amdgcn_fence(__ATOMIC_RELEASE, "agent");
            asm volatile("s_waitcnt vmcnt(0)" ::: "memory");
            const unsigned og = xb_add(&bar[XB_TOP], 1u);
            const unsigned tg = og / nx;
            if (og + 1u == (tg + 1u) * nx) xb_add(&bar[XB_TOPGEN], 1u);
            else XB_SPIN(xb_ld(&bar[XB_TOPGEN]) == tg, bar);
            __builtin_amdgcn_fence(__ATOMIC_ACQUIRE, "agent");
            xb_add(&bar[XB_XGEN(b.x)], 1u);
            asm volatile("s_waitcnt vmcnt(0)" ::: "memory");
        } else {
            XB_SPIN(xb_ld(&bar[XB_XGEN(b.x)]) == gen, bar);
            __builtin_amdgcn_fence(__ATOMIC_ACQUIRE, "agent");
            asm volatile("s_waitcnt vmcnt(0)" ::: "memory");
        }
    }
    __syncthreads();
}

__device__ __forceinline__ int lane_id() { return (int)__builtin_amdgcn_mbcnt_hi(~0u, __builtin_amdgcn_mbcnt_lo(~0u, 0u)); }
__device__ __forceinline__ float bf2f(bf16_t b) { return __uint_as_float(((unsigned)b) << 16); }
__device__ __forceinline__ bf16_t f2bf(float f) { unsigned u = __float_as_uint(f); u += 0x7FFFu + ((u >> 16) & 1u); return (bf16_t)(u >> 16); }
__device__ __forceinline__ unsigned pk_bf16(float lo, float hi) { return (unsigned)f2bf(lo) | ((unsigned)f2bf(hi) << 16); }
__device__ __forceinline__ unsigned cvt_pk_bf16(float lo, float hi) { unsigned r; asm volatile("v_cvt_pk_bf16_f32 %0, %1, %2" : "=v"(r) : "v"(lo), "v"(hi)); return r; }
__device__ __forceinline__ float sigmoidf_(float x) { return 1.0f / (1.0f + __expf(-x)); }
__device__ __forceinline__ float siluf_(float x) { return x / (1.0f + __expf(-x)); }
__device__ __forceinline__ float wave_sum(float v) {
#pragma unroll
    for (int o = 32; o >= 1; o >>= 1) v += __shfl_xor(v, o);
    return v;
}
__device__ __forceinline__ float sum16(float v) {
    v += __shfl_xor(v, 1); v += __shfl_xor(v, 2); v += __shfl_xor(v, 4); v += __shfl_xor(v, 8); return v;
}
__device__ __forceinline__ void unpack4(u32x2 w, float (&f)[4]) {
    f[0] = __uint_as_float(w.x << 16); f[1] = __uint_as_float(w.x & 0xffff0000u); f[2] = __uint_as_float(w.y << 16); f[3] = __uint_as_float(w.y & 0xffff0000u);
}
__device__ __forceinline__ void unpack8(u32x4 w, float* f) {
    f[0] = __uint_as_float(w.x << 16); f[1] = __uint_as_float(w.x & 0xffff0000u); f[2] = __uint_as_float(w.y << 16); f[3] = __uint_as_float(w.y & 0xffff0000u);
    f[4] = __uint_as_float(w.z << 16); f[5] = __uint_as_float(w.z & 0xffff0000u); f[6] = __uint_as_float(w.w << 16); f[7] = __uint_as_float(w.w & 0xffff0000u);
}

struct Params {
    const float* in[35];
    float* out; unsigned char* ws;
    int ph_lo, ph_hi;
};
enum { I_X = 0, I_C, I_CTX, I_CCTX, I_N1G, I_N2G, I_MODW, I_MODB, I_WIN, I_WOUT, I_RPB, I_MUP, I_MUN, I_W0, I_W2, I_A0, I_A2, I_G2, I_KK, I_KA, I_RK, I_GNG, I_GNB,
       I_DWW, I_DWB, I_LNG, I_LNB, I_FG, I_FU, I_FD, I_ROUTER, I_MG, I_MU, I_MD, I_FINALG };

__device__ __forceinline__ int row_mi(int r) { return r < NLAT ? (r >> 12) : 8; }

namespace pg8 {
constexpr int BM = 256, BK = 64, HALF = 128, HTB = HALF * BK * 2, STAGE_BYTES = 8 * HTB, NXCD = 8, WGM = 8;
__device__ __forceinline__ int lds_byte(int r, int c) { const int st = (r >> 4) * 2 + (c >> 5), rr = r & 15, cc = c & 31, ob = rr * 64 + cc * 2; return st * 1024 + (ob ^ (((ob >> 9) & 1) << 5)); }
__device__ __forceinline__ void stage_rc(int b, int& R, int& C) { const int st = b / 1024, sb = b % 1024, swz = sb ^ (((sb >> 9) & 1) << 5); R = (st >> 1) * 16 + swz / 64; C = (st & 1) * 32 + (swz % 64) / 2; }
__device__ __forceinline__ int perm32(int rho) { const int n = rho >> 4, i = rho & 15; return 8 * (i >> 2) + 4 * n + (i & 3); }
struct Unit { int pm, pn; };

struct TileOrder {
    int nM, nN, nwg, G, c;
    __device__ void init(int nM_, int nN_, int G_, int c_) { nM = nM_; nN = nN_; nwg = nM * nN; G = G_; c = c_; }
    __device__ bool next(int i, Unit& u) const {
        const long L = (long)i * G + c; if (L >= nwg) return false;
        int wgid = (int)L; { const int q = nwg / NXCD, r = nwg % NXCD, xcd = wgid % NXCD, off = wgid / NXCD; wgid = (xcd < r ? xcd * (q + 1) : r * (q + 1) + (xcd - r) * q) + off; }
        const int nig = WGM * nN, gid = wgid / nig, fm = gid * WGM, gsz = (nM - fm) < WGM ? (nM - fm) : WGM;
        u.pm = fm + ((wgid % nig) % gsz); u.pn = (wgid % nig) / gsz; return true;
    }
};
struct DenseSched : TileOrder {
    const bf16_t* A; const bf16_t* Bt; int K;
    __device__ __forceinline__ const char* aptr(const Unit& u) const { return (const char*)A + (size_t)u.pm * BM * K * 2; }
    __device__ __forceinline__ const char* bptr(const Unit& u) const { return (const char*)Bt + (size_t)u.pn * BM * K * 2; }
    __device__ __forceinline__ const char* abase() const { return (const char*)A; }
    __device__ __forceinline__ int arow(const Unit&, int) const { return 0; }
};
struct MoeSched : TileOrder {
    const bf16_t* A; const unsigned char* Bt0; size_t e_stride; int K; const int* rowmap; int tstart[9];
    __device__ __forceinline__ int expert(int pm) const { int e = 0;
#pragma unroll
        for (int j = 1; j < 8; ++j) e += (pm >= tstart[j]) ? 1 : 0;
        return e; }
    __device__ __forceinline__ const char* aptr(const Unit& u) const { return (const char*)A + (size_t)u.pm * BM * K * 2; }
    __device__ __forceinline__ const char* bptr(const Unit& u) const { return (const char*)Bt0 + (size_t)expert(u.pm) * e_stride + (size_t)u.pn * BM * K * 2; }
    __device__ __forceinline__ const char* abase() const { return (const char*)A; }
    __device__ __forceinline__ int arow(const Unit& u, int r) const { const int t = rowmap[u.pm * BM + r]; return t < 0 ? 0 : t; }
};

struct EpiBf16 {
    static constexpr bool PERM = true;
    bf16_t* O; int ldc; int nscale; float scale;
    __device__ __forceinline__ void operator()(const f32x4 (&acc)[2][2][4][2], const Unit& u, int wr, int wc, int fr, int fq) const {
        const int row0 = u.pm * BM + wr * 64 + fr, col0 = u.pn * BM + wc * 32 + 8 * fq;
        const float s = u.pn < nscale ? scale : 1.0f;
#pragma unroll
        for (int ai = 0; ai < 2; ++ai)
#pragma unroll
            for (int m = 0; m < 4; ++m) { bf16_t* rowp = O + (size_t)(row0 + ai * HALF + m * 16) * ldc + col0;
#pragma unroll
                for (int bj = 0; bj < 2; ++bj) { const f32x4 v0 = acc[ai][bj][m][0] * s, v1 = acc[ai][bj][m][1] * s;
                    u32x4 w; w.x = cvt_pk_bf16(v0[0], v0[1]); w.y = cvt_pk_bf16(v0[2], v0[3]); w.z = cvt_pk_bf16(v1[0], v1[1]); w.w = cvt_pk_bf16(v1[2], v1[3]);
                    *(u32x4*)(rowp + bj * HALF) = w; } }
    }
};
struct EpiSwiGLU {
    static constexpr bool PERM = true;
    bf16_t* H; int ldh;
    __device__ __forceinline__ void operator()(const f32x4 (&acc)[2][2][4][2], const Unit& u, int wr, int wc, int fr, int fq) const {
        const int row0 = u.pm * BM + wr * 64 + fr, col0 = u.pn * HALF + wc * 32 + 8 * fq;
#pragma unroll
        for (int ai = 0; ai < 2; ++ai)
#pragma unroll
            for (int m = 0; m < 4; ++m) { bf16_t* rowp = H + (size_t)(row0 + ai * HALF + m * 16) * ldh + col0;
                float h[8];
#pragma unroll
                for (int n = 0; n < 2; ++n)
#pragma unroll
                    for (int j = 0; j < 4; ++j) { const float g = acc[ai][0][m][n][j], up = acc[ai][1][m][n][j]; h[n * 4 + j] = g / (1.0f + __expf(-g)) * up; }
                u32x4 w; w.x = cvt_pk_bf16(h[0], h[1]); w.y = cvt_pk_bf16(h[2], h[3]); w.z = cvt_pk_bf16(h[4], h[5]); w.w = cvt_pk_bf16(h[6], h[7]);
                *(u32x4*)rowp = w; }
    }
};
struct EpiRes {
    static constexpr bool PERM = false;
    const float* resL; const float* resC; float* outL; float* outC; const float* gvec;
    __device__ __forceinline__ void operator()(const f32x4 (&acc)[2][2][4][2], const Unit& u, int wr, int wc, int fr, int fq) const {
        const int r0 = u.pm * BM; const bool lat = r0 < NLAT;
        const float* res = lat ? resL + (size_t)r0 * D : resC + (size_t)(r0 - NLAT) * D;
        float* out = lat ? outL + (size_t)r0 * D : outC + (size_t)(r0 - NLAT) * D;
        const float* gv = gvec + (size_t)(lat ? (r0 >> 12) : 8) * MODW;
        const int rl = wr * 64 + fr, col0 = u.pn * BM + wc * 32 + 4 * fq;
        f32x4 g[2][2];
#pragma unroll
        for (int bj = 0; bj < 2; ++bj)
#pragma unroll
            for (int n = 0; n < 2; ++n) g[bj][n] = *(const f32x4*)(gv + col0 + bj * HALF + n * 16);
#pragma unroll
        for (int ai = 0; ai < 2; ++ai)
#pragma unroll
            for (int m = 0; m < 4; ++m) { const size_t off = (size_t)(rl + ai * HALF + m * 16) * D + col0;
#pragma unroll
                for (int bj = 0; bj < 2; ++bj)
#pragma unroll
                    for (int n = 0; n < 2; ++n) { const f32x4 rv = *(const f32x4*)(res + off + bj * HALF + n * 16);
                        *(f32x4*)(out + off + bj * HALF + n * 16) = rv + g[bj][n] * acc[ai][bj][m][n]; } }
    }
};
struct EpiMoeDown {
    static constexpr bool PERM = false;
    float* xl; const float* gvec; const int* rowmap; const float* sgate;
    __device__ __forceinline__ void operator()(const f32x4 (&acc)[2][2][4][2], const Unit& u, int wr, int wc, int fr, int fq) const {
        const int rl = u.pm * BM + wr * 64 + fr, col0 = u.pn * BM + wc * 32 + 4 * fq;
#pragma unroll
        for (int ai = 0; ai < 2; ++ai)
#pragma unroll
            for (int m = 0; m < 4; ++m) { const int slot = rl + ai * HALF + m * 16; const int tok = rowmap[slot];
                if (tok >= 0) { const float sg = sgate[slot]; const float* gv = gvec + (size_t)(tok >> 12) * MODW + col0; float* xp = xl + (size_t)tok * D + col0;
#pragma unroll
                    for (int bj = 0; bj < 2; ++bj)
#pragma unroll
                        for (int n = 0; n < 2; ++n) { const f32x4 g = *(const f32x4*)(gv + bj * HALF + n * 16); const f32x4 rv = *(const f32x4*)(xp + bj * HALF + n * 16);
                            *(f32x4*)(xp + bj * HALF + n * 16) = rv + (g * sg) * acc[ai][bj][m][n]; } } }
    }
};

template <class Epi, class Sched, bool GATHER>
__device__ __forceinline__ void gemm_phase(LAS unsigned char* lds, const int K, const Sched& S, const Epi& E, const int wave_) {
    int tid_ = wave_ * 64 + lane_id(); asm volatile("" : "+v"(tid_));
    const int tid = tid_, wid = wave_, lane = tid & 63, wr = wid >> 2, wc = wid & 3, fr = lane & 15, fq = lane >> 4;
    const int nt = K / BK;
    unsigned voffA[2], voffB[2]; int RA[2], CA[2];
#pragma unroll
    for (int i = 0; i < 2; ++i) { int R, C; stage_rc(tid * 16 + i * 8192, R, C); const int Rb = Epi::PERM ? ((R & ~31) + perm32(R & 31)) : R;
        voffA[i] = (unsigned)(R * K + C) * 2u; voffB[i] = (unsigned)(Rb * K + C) * 2u; RA[i] = R; CA[i] = C; }
    const size_t kstep = (size_t)(BK * 2);
    const size_t hstep = (size_t)HALF * K * 2;
    const unsigned ldsw = (unsigned)wid * 1024u;
    const int aoff = lds_byte(wr * 64 + fr, fq * 8), boff = lds_byte(wc * 32 + fr, fq * 8);
#define PG8_SA(b, h) (((b) * 2 + (h)) * HTB)
#define PG8_SB(b, h) ((4 + (b) * 2 + (h)) * HTB)
#define PG8_STAGE(bufoff, gbase, voff) do { _Pragma("unroll") for (int _i = 0; _i < 2; ++_i) \
        __builtin_amdgcn_global_load_lds((const unsigned*)((const char*)(gbase) + (voff)[_i]), (LAS unsigned*)(lds + (bufoff) + ldsw + _i * 8192), 16, 0, 0); } while (0)
#define PG8_LDA(dst, b, h) do { _Pragma("unroll") for (int m = 0; m < 4; ++m) _Pragma("unroll") for (int k = 0; k < 2; ++k) dst[m][k] = *(const LAS bf16x8*)(lds + PG8_SA(b, h) + aoff + m * 2048 + k * 1024); } while (0)
#define PG8_LDB(dst, b, h) do { _Pragma("unroll") for (int n = 0; n < 2; ++n) _Pragma("unroll") for (int k = 0; k < 2; ++k) dst[n][k] = *(const LAS bf16x8*)(lds + PG8_SB(b, h) + boff + n * 2048 + k * 1024); } while (0)
#define PG8_MMA(ai, bj, At, Bt) do { __builtin_amdgcn_s_setprio(1); _Pragma("unroll") for (int m = 0; m < 4; ++m) _Pragma("unroll") for (int n = 0; n < 2; ++n) _Pragma("unroll") for (int k = 0; k < 2; ++k) \
        acc[ai][bj][m][n] = __builtin_amdgcn_mfma_f32_16x16x32_bf16(Bt[n][k], At[m][k], acc[ai][bj][m][n], 0, 0, 0); __builtin_amdgcn_s_setprio(0); } while (0)
#define PG8_WAIT_V(n) asm volatile("s_waitcnt vmcnt(" #n ")" ::: "memory")
#define PG8_WAIT_L(n) asm volatile("s_waitcnt lgkmcnt(" #n ")" ::: "memory")
#define PG8_BAR __builtin_amdgcn_s_barrier()
#define PG8_SCHED __builtin_amdgcn_sched_barrier(0)
#define PG8_STAGE_A(bufoff, TS, H) do { if constexpr (GATHER) { PG8_STAGE(bufoff, gA##TS, oA##TS[H]); } else { PG8_STAGE(bufoff, a##TS + (H) * hstep, voffA); } } while (0)
    Unit cur, nxt; int ui = 0;
    if (!S.next(0, cur)) return;
    f32x4 acc[2][2][4][2];
#pragma unroll
    for (int a = 0; a < 2; ++a)
#pragma unroll
        for (int b = 0; b < 2; ++b)
#pragma unroll
            for (int m = 0; m < 4; ++m)
#pragma unroll
                for (int n = 0; n < 2; ++n) acc[a][b][m][n] = (f32x4){0.f, 0.f, 0.f, 0.f};
    bf16x8 At[4][2], B0[2][2], B1[2][2];
    const char* Abase = S.abase();
    unsigned aoC[2][2] = {{0u, 0u}, {0u, 0u}}, aoN[2][2] = {{0u, 0u}, {0u, 0u}};
    if constexpr (GATHER) {
#pragma unroll
        for (int h = 0; h < 2; ++h)
#pragma unroll
            for (int i = 0; i < 2; ++i) aoC[h][i] = (unsigned)(S.arow(cur, h * HALF + RA[i]) * K + CA[i]) * 2u;
    }
    const char* cA = GATHER ? Abase : S.aptr(cur); const char* cB = S.bptr(cur);
    if constexpr (GATHER) {
        PG8_STAGE(PG8_SB(0, 0), cB, voffB); PG8_STAGE(PG8_SA(0, 0), Abase, aoC[0]); PG8_STAGE(PG8_SB(0, 1), cB + hstep, voffB); PG8_STAGE(PG8_SA(0, 1), Abase, aoC[1]);
    } else {
        PG8_STAGE(PG8_SB(0, 0), cB, voffB); PG8_STAGE(PG8_SA(0, 0), cA, voffA); PG8_STAGE(PG8_SB(0, 1), cB + hstep, voffB); PG8_STAGE(PG8_SA(0, 1), cA + hstep, voffA);
    }
    if (wr == 1) PG8_BAR;
    PG8_WAIT_V(4); PG8_BAR;
    if constexpr (GATHER) {
        PG8_STAGE(PG8_SB(1, 0), cB + kstep, voffB); PG8_STAGE(PG8_SA(1, 0), Abase + kstep, aoC[0]); PG8_STAGE(PG8_SB(1, 1), cB + hstep + kstep, voffB);
    } else {
        PG8_STAGE(PG8_SB(1, 0), cB + kstep, voffB); PG8_STAGE(PG8_SA(1, 0), cA + kstep, voffA); PG8_STAGE(PG8_SB(1, 1), cB + hstep + kstep, voffB);
    }
    PG8_WAIT_V(6); PG8_BAR;
    for (;;) {
        const bool has_next = S.next(ui + 1, nxt);
        const char* nA = has_next ? (GATHER ? Abase : S.aptr(nxt)) : cA; const char* nB = has_next ? S.bptr(nxt) : cB;
        if constexpr (GATHER) {
            if (has_next) {
#pragma unroll
                for (int h = 0; h < 2; ++h)
#pragma unroll
                    for (int i = 0; i < 2; ++i) aoN[h][i] = (unsigned)(S.arow(nxt, h * HALF + RA[i]) * K + CA[i]) * 2u;
            } else {
#pragma unroll
                for (int h = 0; h < 2; ++h)
#pragma unroll
                    for (int i = 0; i < 2; ++i) aoN[h][i] = aoC[h][i];
            }
        }
        for (int t = 0; t < nt; t += 2) {
            const bool last = (t == nt - 2);
            const char* a1 = cA + (size_t)(t + 1) * kstep;
            const char* a2 = last ? nA : cA + (size_t)(t + 2) * kstep; const char* b2 = last ? nB : cB + (size_t)(t + 2) * kstep;
            const char* a3 = a2 + kstep; const char* b3 = b2 + kstep;
            const char* gA1 = Abase + (size_t)(t + 1) * kstep; const char* gA2 = Abase + (last ? (size_t)0 : (size_t)(t + 2) * kstep); const char* gA3 = gA2 + kstep;
            unsigned oA1[2][2], oA2[2][2], oA3[2][2];
#pragma unroll
            for (int h = 0; h < 2; ++h)
#pragma unroll
                for (int i = 0; i < 2; ++i) { oA1[h][i] = aoC[h][i]; oA2[h][i] = last ? aoN[h][i] : aoC[h][i]; oA3[h][i] = oA2[h][i]; }
            (void)a1; (void)a3; (void)gA1; (void)gA3; (void)oA1; (void)oA3;
            PG8_LDB(B0, 0, 0); PG8_SCHED; PG8_LDA(At, 0, 0); PG8_STAGE_A(PG8_SA(1, 1), 1, 1);
            PG8_WAIT_L(8); PG8_BAR; PG8_WAIT_L(0); PG8_MMA(0, 0, At, B0); PG8_BAR; PG8_SCHED;
            PG8_LDB(B1, 0, 1); PG8_STAGE(PG8_SB(0, 0), b2, voffB);
            PG8_BAR; PG8_WAIT_L(0); PG8_MMA(0, 1, At, B1); PG8_BAR;
            PG8_LDA(At, 0, 1); PG8_STAGE_A(PG8_SA(0, 0), 2, 0);
            PG8_BAR; PG8_WAIT_L(0); PG8_MMA(1, 0, At, B0); PG8_BAR; PG8_SCHED;
            PG8_STAGE(PG8_SB(0, 1), b2 + hstep, voffB);
            PG8_WAIT_V(6); PG8_BAR; PG8_MMA(1, 1, At, B1); PG8_BAR;
            PG8_LDB(B0, 1, 0); PG8_SCHED; PG8_LDA(At, 1, 0); PG8_STAGE_A(PG8_SA(0, 1), 2, 1);
            PG8_WAIT_L(8); PG8_BAR; PG8_WAIT_L(0); PG8_MMA(0, 0, At, B0); PG8_BAR; PG8_SCHED;
            PG8_LDB(B1, 1, 1); PG8_STAGE(PG8_SB(1, 0), b3, voffB);
            PG8_BAR; PG8_WAIT_L(0); PG8_MMA(0, 1, At, B1); PG8_BAR;
            PG8_LDA(At, 1, 1); PG8_STAGE_A(PG8_SA(1, 0), 3, 0);
            PG8_BAR; PG8_WAIT_L(0); PG8_MMA(1, 0, At, B0); PG8_BAR; PG8_SCHED;
            PG8_STAGE(PG8_SB(1, 1), b3 + hstep, voffB);
            PG8_WAIT_V(6); PG8_BAR; PG8_MMA(1, 1, At, B1); PG8_BAR;
        }
        { int t2 = tid; asm volatile("" : "+v"(t2)); const int l2 = t2 & 63; E(acc, cur, wr, wc, l2 & 15, l2 >> 4); }
        if (!has_next) break;
#pragma unroll
        for (int a = 0; a < 2; ++a)
#pragma unroll
            for (int b = 0; b < 2; ++b)
#pragma unroll
                for (int m = 0; m < 4; ++m)
#pragma unroll
                    for (int n = 0; n < 2; ++n) acc[a][b][m][n] = (f32x4){0.f, 0.f, 0.f, 0.f};
        cur = nxt; cA = nA; cB = nB; ++ui;
        if constexpr (GATHER) {
#pragma unroll
            for (int h = 0; h < 2; ++h)
#pragma unroll
                for (int i = 0; i < 2; ++i) aoC[h][i] = aoN[h][i];
        }
    }
    PG8_WAIT_V(0);
    if (wr == 0) PG8_BAR;
    PG8_BAR;
#undef PG8_SA
#undef PG8_SB
#undef PG8_STAGE
#undef PG8_STAGE_A
#undef PG8_LDA
#undef PG8_LDB
#undef PG8_MMA
#undef PG8_WAIT_V
#undef PG8_WAIT_L
#undef PG8_BAR
#undef PG8_SCHED
}
}

struct Frame {
    LAS unsigned char* lds; int tid, lane, wave, G, bid, gw, nw;
    unsigned char* ws;
};
extern __shared__ __attribute__((aligned(16))) unsigned char lds_raw[];
typedef const __attribute__((address_space(4))) Params* KP;
__device__ __forceinline__ Params load_params(const void* kp_) {
    const unsigned long long v = (unsigned long long)kp_;
    const unsigned lo = __builtin_amdgcn_readfirstlane((unsigned)v), hi = __builtin_amdgcn_readfirstlane((unsigned)(v >> 32));
    KP kp = (KP)(((unsigned long long)hi << 32) | lo);
    Params P;
#pragma unroll
    for (int i = 0; i < 35; ++i) P.in[i] = kp->in[i];
    P.out = kp->out; P.ws = kp->ws; P.ph_lo = kp->ph_lo; P.ph_hi = kp->ph_hi;
    return P;
}
#define PHASE static __attribute__((noinline)) __device__ void
#define PHASE_INL static __device__ __forceinline__ void
__device__ __forceinline__ Frame make_frame(unsigned char* ws, int wave_) {
    Frame F; F.lds = (LAS unsigned char*)lds_raw; F.wave = __builtin_amdgcn_readfirstlane(wave_);
    int t_ = F.wave * 64 + lane_id(); asm volatile("" : "+v"(t_));
    F.tid = t_; F.lane = F.tid & 63;
    F.G = gridDim.x; F.bid = blockIdx.x; F.gw = F.bid * NWAVES + F.wave; F.nw = F.G * NWAVES; F.ws = ws; return F;
}
#define PHASE_ENTER const Params P = load_params(kp_); const Frame F = make_frame(P.ws, wv_)

__device__ __forceinline__ void conv_job(const Frame& F, const float* src, bf16_t* dst, int K, int N, int mode) {
    LAS float* tile = (LAS float*)(F.lds + F.wave * (64 * 65 * 4));
    const int tk = K / 64, tn = N / 64, ntile = tk * tn, lane = F.lane;
    for (int t = F.gw; t < ntile; t += F.nw) {
        const int k0 = (t / tn) * 64, n0 = (t % tn) * 64;
#pragma unroll 4
        for (int i = 0; i < 16; ++i) { const int row = i * 4 + (lane >> 4), c4 = (lane & 15) * 4;
            const f32x4 v = *(const f32x4*)(src + (size_t)(k0 + row) * N + n0 + c4);
            tile[row * 65 + c4 + 0] = v[0]; tile[row * 65 + c4 + 1] = v[1]; tile[row * 65 + c4 + 2] = v[2]; tile[row * 65 + c4 + 3] = v[3]; }
        __builtin_amdgcn_wave_barrier(); asm volatile("s_waitcnt lgkmcnt(0)" ::: "memory");
#pragma unroll 2
        for (int i = 0; i < 8; ++i) { const int n = i * 8 + (lane >> 3), kc = (lane & 7) * 8;
            float f[8];
#pragma unroll
            for (int j = 0; j < 8; ++j) f[j] = tile[(kc + j) * 65 + n];
            const int ng = n0 + n; const int drow = mode == 0 ? ng : ((ng >> 7) * 256 + (mode == 2 ? 128 : 0) + (ng & 127));
            u32x4 w; w.x = pk_bf16(f[0], f[1]); w.y = pk_bf16(f[2], f[3]); w.z = pk_bf16(f[4], f[5]); w.w = pk_bf16(f[6], f[7]);
            *(u32x4*)(dst + (size_t)drow * K + k0 + kc) = w; }
        __builtin_amdgcn_wave_barrier(); asm volatile("s_waitcnt lgkmcnt(0)" ::: "memory");
    }
}

__device__ __forceinline__ void phase_prologue(const Frame& F, const Params& P) {
    float* modv = (float*)(F.ws + WS_MODV);
    LAS float* s = (LAS float*)F.lds;
    LAS float* red = (LAS float*)(F.lds + 9 * 1024 * 4);
    for (int cb = F.bid; cb < (2 * MODW) / 64; cb += F.G) {
        for (int i = F.tid; i < 9 * 1024; i += NTHREADS) { const int mi = i >> 10, k = i & 1023; const float c = mi < 8 ? P.in[I_C][mi * D + k] : P.in[I_CCTX][k]; s[i] = siluf_(c); }
        __syncthreads();
        const int colg = cb * 64 + F.lane, l = colg / MODW, col = colg % MODW;
        const float* w = P.in[I_MODW] + (size_t)l * D * MODW + col;
        float acc[9];
#pragma unroll
        for (int mi = 0; mi < 9; ++mi) acc[mi] = 0.f;
        const int kb = F.wave * 128;
#pragma unroll 8
        for (int k = 0; k < 128; ++k) { const float wv = w[(size_t)(kb + k) * MODW];
#pragma unroll
            for (int mi = 0; mi < 9; ++mi) acc[mi] += s[mi * 1024 + kb + k] * wv; }
#pragma unroll
        for (int mi = 0; mi < 9; ++mi) red[(F.wave * 9 + mi) * 64 + F.lane] = acc[mi];
        __syncthreads();
        for (int i = F.tid; i < 9 * 64; i += NTHREADS) { const int mi = i >> 6, ln = i & 63; float a = 0.f;
#pragma unroll
            for (int w8 = 0; w8 < 8; ++w8) a += red[(w8 * 9 + mi) * 64 + ln];
            const int cg = cb * 64 + ln, l2 = cg / MODW, c2 = cg % MODW;
            modv[((size_t)l2 * 9 + mi) * MODW + c2] = a + P.in[I_MODB][l2 * MODW + c2]; }
        __syncthreads();
    }
    for (int l = 0; l < 2; ++l) {
        conv_job(F, P.in[I_WIN] + (size_t)l * D * INW, (bf16_t*)(F.ws + WS_BTIN) + (size_t)l * INW * D, D, INW, 0);
        conv_job(F, P.in[I_WOUT] + (size_t)l * D * D, (bf16_t*)(F.ws + WS_BTOUT) + (size_t)l * D * D, D, D, 0);
    }
    conv_job(F, P.in[I_FG], (bf16_t*)(F.ws + WS_BTGU), D, DFF, 1);
    conv_job(F, P.in[I_FU], (bf16_t*)(F.ws + WS_BTGU), D, DFF, 2);
    conv_job(F, P.in[I_FD], (bf16_t*)(F.ws + WS_BTDN), DFF, D, 0);
    for (int ld = 0; ld < 4; ++ld) { bf16_t* base = (bf16_t*)(F.ws + WS_LORA + (size_t)ld * LORA_LD_BYTES);
        conv_job(F, P.in[I_W2] + (size_t)ld * 64 * 256, base, 64, 256, 0);
        conv_job(F, P.in[I_A2] + (size_t)ld * 64 * 256, base + 256 * 64, 64, 256, 0);
        conv_job(F, P.in[I_G2] + (size_t)ld * 128 * 256, base + 2 * 256 * 64, 128, 256, 0); }
}
__device__ __forceinline__ void phase_moe_convert(const Frame& F, const Params& P) {
    for (int e = 0; e < NEXP; ++e) {
        bf16_t* gu = (bf16_t*)(F.ws + WS_MOE + (size_t)e * MOE_E_BYTES); bf16_t* dn = (bf16_t*)(F.ws + WS_MOE + (size_t)e * MOE_E_BYTES + MOE_GU_BYTES);
        conv_job(F, P.in[I_MG] + (size_t)e * D * DFE, gu, D, DFE, 1);
        conv_job(F, P.in[I_MU] + (size_t)e * D * DFE, gu, D, DFE, 2);
        conv_job(F, P.in[I_MD] + (size_t)e * DFE * D, dn, DFE, D, 0);
    }
}

template <bool ROUTER>
__device__ __forceinline__ void phase_norm(const Frame& F, const Params& P, int l, int which, int nrows, const float* srcL, const float* srcC) {
    const float* g = (which == 0 ? P.in[I_N1G] : P.in[I_N2G]) + l * D;
    const float* modv = (const float*)(F.ws + WS_MODV) + (size_t)l * 9 * MODW + (which == 0 ? 0 : 3 * D);
    bf16_t* HL = (bf16_t*)(F.ws + WS_HL);
    LAS float* rt = (LAS float*)F.lds;
    if (ROUTER) {
        for (int i = F.tid; i < D * NEXP; i += NTHREADS) rt[i] = P.in[I_ROUTER][i];
        int* rmap = (int*)(F.ws + WS_ROUTE + RT_RMAP);
        for (int i = F.bid * NTHREADS + F.tid; i < 2 * NROW; i += F.G * NTHREADS) rmap[i] = -1;
        __syncthreads();
    }
    const int lane = F.lane;
    for (int r = F.gw; r < nrows; r += F.nw) {
        const float* xr = r < NLAT ? srcL + (size_t)r * D : srcC + (size_t)(r - NLAT) * D;
        const float* mv = modv + (size_t)row_mi(r) * MODW;
        f32x4 x[4]; float ss = 0.f;
#pragma unroll
        for (int j = 0; j < 4; ++j) { x[j] = *(const f32x4*)(xr + j * 256 + lane * 4); ss += x[j][0] * x[j][0] + x[j][1] * x[j][1] + x[j][2] * x[j][2] + x[j][3] * x[j][3]; }
        ss = wave_sum(ss);
        const float rstd = rsqrtf(ss * (1.0f / D) + 1e-6f);
        float lg[NEXP];
        if (ROUTER) {
#pragma unroll
            for (int e = 0; e < NEXP; ++e) lg[e] = 0.f;
        }
#pragma unroll
        for (int j = 0; j < 4; ++j) { const int c = j * 256 + lane * 4;
            const f32x4 gg = *(const f32x4*)(g + c), sh = *(const f32x4*)(mv + c), sc = *(const f32x4*)(mv + D + c);
            f32x4 y = (x[j] * rstd * gg) * (sc + 1.0f) + sh;
            u32x2 w; w.x = pk_bf16(y[0], y[1]); w.y = pk_bf16(y[2], y[3]);
            *(u32x2*)(HL + (size_t)r * D + c) = w;
            if (ROUTER) {
#pragma unroll
                for (int q = 0; q < 4; ++q) { const f32x4 r0 = *(const LAS f32x4*)(rt + (c + q) * 8), r1 = *(const LAS f32x4*)(rt + (c + q) * 8 + 4);
                    lg[0] += y[q] * r0[0]; lg[1] += y[q] * r0[1]; lg[2] += y[q] * r0[2]; lg[3] += y[q] * r0[3];
                    lg[4] += y[q] * r1[0]; lg[5] += y[q] * r1[1]; lg[6] += y[q] * r1[2]; lg[7] += y[q] * r1[3]; asm volatile("" ::: "memory"); }
            }
        }
        if (ROUTER) {
#pragma unroll
            for (int e = 0; e < NEXP; ++e) lg[e] = wave_sum(lg[e]);
            if (lane == 0) {
                int e1 = 0; float l1 = lg[0];
#pragma unroll
                for (int e = 1; e < NEXP; ++e) if (lg[e] > l1) { l1 = lg[e]; e1 = e; }
                int e2 = -1; float l2 = -3.0e38f;
#pragma unroll
                for (int e = 0; e < NEXP; ++e) if (e != e1 && lg[e] > l2) { l2 = lg[e]; e2 = e; }
                const float ex = __expf(l2 - l1), g1 = 1.0f / (1.0f + ex), g2 = ex * g1;
                unsigned* cnt = (unsigned*)(F.ws + WS_CTL) + CW_MOECNT;
                const unsigned p1 = atomicAdd(cnt + e1, 1u), p2 = atomicAdd(cnt + 8 + e2, 1u);
                int* te = (int*)(F.ws + WS_ROUTE + RT_TOKE); float* tg = (float*)(F.ws + WS_ROUTE + RT_TOKG); int* tp = (int*)(F.ws + WS_ROUTE + RT_TOKP);
                te[r * 2] = e1; te[r * 2 + 1] = e2; tg[r * 2] = g1; tg[r * 2 + 1] = g2; tp[r * 2] = (int)p1; tp[r * 2 + 1] = (int)p2;
            }
        }
    }
}
__device__ __forceinline__ void moe_tstart(const Frame& F, int pass, int (&ts)[9]) {
    const unsigned* cnt = (const unsigned*)(F.ws + WS_CTL) + CW_MOECNT + pass * 8;
    int a = 0;
#pragma unroll
    for (int e = 0; e < 8; ++e) { ts[e] = a; a += (int)((__hip_atomic_load(cnt + e, __ATOMIC_RELAXED, __HIP_MEMORY_SCOPE_AGENT) + 255u) >> 8); }
    ts[8] = a;
}
__device__ __forceinline__ void phase_moe_rowmap(const Frame& F) {
    int ts0[9], ts1[9]; moe_tstart(F, 0, ts0); moe_tstart(F, 1, ts1);
    const int* te = (const int*)(F.ws + WS_ROUTE + RT_TOKE); const float* tg = (const float*)(F.ws + WS_ROUTE + RT_TOKG); const int* tp = (const int*)(F.ws + WS_ROUTE + RT_TOKP);
    int* rmap = (int*)(F.ws + WS_ROUTE + RT_RMAP); float* sg = (float*)(F.ws + WS_ROUTE + RT_SGATE);
    for (int t = F.bid * NTHREADS + F.tid; t < NLAT; t += F.G * NTHREADS) {
        { const int e = te[t * 2]; int st = 0;
#pragma unroll
          for (int j = 0; j < 8; ++j) st = (e == j) ? ts0[j] : st;
          const int slot = st * 256 + tp[t * 2]; rmap[slot] = t; sg[slot] = tg[t * 2]; }
        { const int e = te[t * 2 + 1]; int st = 0;
#pragma unroll
          for (int j = 0; j < 8; ++j) st = (e == j) ? ts1[j] : st;
          const int slot = st * 256 + tp[t * 2 + 1]; rmap[NROW + slot] = t; sg[NROW + slot] = tg[t * 2 + 1]; }
    }
}

struct RowGeo { int b, tt, pos, len; };
__device__ __forceinline__ RowGeo row_geo(int r) { RowGeo g; if (r < NLAT) { g.b = r >> 12; g.pos = r & 4095; g.len = SEQ; g.tt = CTXL + g.pos; } else { const int q = r - NLAT; g.b = q >> 8; g.pos = q & 255; g.len = CTXL; g.tt = g.pos; } return g; }

__device__ __forceinline__ void rw_shift4(const bf16_t* PL, const float* mup, const float* mun, int r, const RowGeo& g, int j, float (&u)[4]) {
    const bf16_t* p = PL + (size_t)r * INW + O_RW + j;
    const bool hp = g.pos > 0, hn = g.pos < g.len - 1;
    float c[4], pv[4], nv[4];
    unpack4(*(const u32x2*)p, c); unpack4(*(const u32x2*)(p - (hp ? INW : 0)), pv); unpack4(*(const u32x2*)(p + (hn ? INW : 0)), nv);
    const f32x4 mp = *(const f32x4*)(mup + j), mn = *(const f32x4*)(mun + j);
#pragma unroll
    for (int q = 0; q < 4; ++q) u[q] = c[q] + mp[q] * ((hp ? pv[q] : 0.f) - c[q]) + mn[q] * ((hn ? nv[q] : 0.f) - c[q]);
}

__device__ __forceinline__ void rw_shift8(const bf16_t* PL, const float* mup, const float* mun, int r, const RowGeo& g, int j, float (&u)[8]) {
    const bf16_t* p = PL + (size_t)r * INW + O_RW + j;
    const bool hp = g.pos > 0, hn = g.pos < g.len - 1;
    float c[8], pv[8], nv[8];
    unpack8(*(const u32x4*)p, c); unpack8(*(const u32x4*)(p - (hp ? INW : 0)), pv); unpack8(*(const u32x4*)(p + (hn ? INW : 0)), nv);
    const f32x4 mp0 = *(const f32x4*)(mup + j), mp1 = *(const f32x4*)(mup + j + 4), mn0 = *(const f32x4*)(mun + j), mn1 = *(const f32x4*)(mun + j + 4);
#pragma unroll
    for (int q = 0; q < 4; ++q) { u[q] = c[q] + mp0[q] * ((hp ? pv[q] : 0.f) - c[q]) + mn0[q] * ((hn ? nv[q] : 0.f) - c[q]);
        u[4 + q] = c[4 + q] + mp1[q] * ((hp ? pv[4 + q] : 0.f) - c[4 + q]) + mn1[q] * ((hn ? nv[4 + q] : 0.f) - c[4 + q]); }
}
__device__ __forceinline__ bf16x8 pack8f(const float (&f)[8]) {
    u32x4 w; w.x = cvt_pk_bf16(f[0], f[1]); w.y = cvt_pk_bf16(f[2], f[3]); w.z = cvt_pk_bf16(f[4], f[5]); w.w = cvt_pk_bf16(f[6], f[7]); return __builtin_bit_cast(bf16x8, w);
}
__device__ __forceinline__ void phase_rw_prep(const Frame& F, const Params& P, int l) {
    const bf16_t* PL = (const bf16_t*)(F.ws + WS_PL);
    const float* mup = P.in[I_MUP] + l * 1280; const float* mun = P.in[I_MUN] + l * 1280;
    f16_t* SH = (f16_t*)(F.ws + WS_SH); f16_t* SD = (f16_t*)(F.ws + WS_SD);
    const int lane = F.lane;
    for (int tile = F.gw; tile < NROW / 16; tile += F.nw) {
        int l1 = lane; asm volatile("" : "+v"(l1)); const int tk = l1 & 15, g = l1 >> 4;
        const int r = tile * 16 + tk; const RowGeo geo = row_geo(r);
        bf16x8 tw[2][2], ta[2][2];
#pragma unroll
        for (int d = 0; d < 2; ++d)
#pragma unroll
            for (int kk = 0; kk < 2; ++kk) { float u[8];
                rw_shift8(PL, mup, mun, r, geo, 768 + 256 * d + 32 * kk + 8 * g, u);
#pragma unroll
                for (int q = 0; q < 8; ++q) u[q] = 1.0f - 2.0f / (1.0f + __expf(2.0f * u[q]));
                tw[d][kk] = pack8f(u);
                rw_shift8(PL, mup, mun, r, geo, 832 + 256 * d + 32 * kk + 8 * g, u); ta[d][kk] = pack8f(u); asm volatile("" ::: "memory"); }
#pragma unroll 1
        for (int h = 0; h < 4; ++h) {
            int l2 = lane; asm volatile("" : "+v"(l2)); const int tk = l2 & 15, g = l2 >> 4;
            const int r = tile * 16 + tk; const RowGeo geo = row_geo(r);
            float ur[4][4], uk[4][4], uv[4][4], kkv[4][4]; float ss = 0.f;
#pragma unroll
            for (int t = 0; t < 4; ++t) { const int c = 64 * h + 16 * t + 4 * g;
                rw_shift4(PL, mup, mun, r, geo, c, ur[t]); rw_shift4(PL, mup, mun, r, geo, 256 + c, uk[t]); rw_shift4(PL, mup, mun, r, geo, 512 + c, uv[t]);
                const f32x4 kkw = *(const f32x4*)(P.in[I_KK] + l * 256 + c);
#pragma unroll
                for (int q = 0; q < 4; ++q) { kkv[t][q] = uk[t][q] * kkw[q]; ss += kkv[t][q] * kkv[t][q]; } asm volatile("" ::: "memory"); }
            ss += __shfl_xor(ss, 16); ss += __shfl_xor(ss, 32);
            const float rn = rsqrtf(ss + 1e-12f);
            const size_t shrow = ((size_t)(geo.b * 4 + h) * TT + geo.tt) * 192;
#pragma unroll
            for (int t = 0; t < 4; ++t) { f16x4 o1, o2, o3;
#pragma unroll
                for (int q = 0; q < 4; ++q) { kkv[t][q] *= rn; o1[q] = (f16_t)ur[t][q]; o2[q] = (f16_t)uv[t][q]; o3[q] = (f16_t)(-kkv[t][q]); }
                f16_t* sp = SH + shrow + 16 * t + 4 * g; *(f16x4*)sp = o1; *(f16x4*)(sp + 64) = o2; *(f16x4*)(sp + 128) = o3; }
#pragma unroll 1
            for (int d = 0; d < 2; ++d) {
                const bf16_t* w2t = (const bf16_t*)(F.ws + WS_LORA + (size_t)(l * 2 + d) * LORA_LD_BYTES); const bf16_t* a2t = w2t + 256 * 64;
                const size_t sdrow = ((size_t)((d * 8 + geo.b) * 4 + h) * TT + geo.tt) * 192;
                const bf16x8 tw0 = d ? tw[1][0] : tw[0][0], tw1 = d ? tw[1][1] : tw[0][1], ta0 = d ? ta[1][0] : ta[0][0], ta1 = d ? ta[1][1] : ta[0][1];
#pragma unroll
                for (int t = 0; t < 4; ++t) { const int c = 64 * h + 16 * t + 4 * g;
                    const bf16_t* wr = w2t + (size_t)(64 * h + 16 * t + tk) * 64 + 8 * g; const bf16_t* ar = a2t + (size_t)(64 * h + 16 * t + tk) * 64 + 8 * g;
                    f32x4 xw = *(const f32x4*)(P.in[I_W0] + (l * 2 + d) * 256 + c), xa = *(const f32x4*)(P.in[I_A0] + (l * 2 + d) * 256 + c);
                    xw = __builtin_amdgcn_mfma_f32_16x16x32_bf16(*(const bf16x8*)wr, tw0, xw, 0, 0, 0); xw = __builtin_amdgcn_mfma_f32_16x16x32_bf16(*(const bf16x8*)(wr + 32), tw1, xw, 0, 0, 0);
                    xa = __builtin_amdgcn_mfma_f32_16x16x32_bf16(*(const bf16x8*)ar, ta0, xa, 0, 0, 0); xa = __builtin_amdgcn_mfma_f32_16x16x32_bf16(*(const bf16x8*)(ar + 32), ta1, xa, 0, 0, 0);
                    const f32x4 kaw = *(const f32x4*)(P.in[I_KA] + l * 256 + c);
                    f16x4 o1, o2, o3;
#pragma unroll
                    for (int q = 0; q < 4; ++q) {
                        const float nx = -xw[q]; const float sp = fmaxf(nx, 0.f) + __logf(1.0f + __expf(-fabsf(nx)));
                        const float e = __expf(-sp - 0.5f);
                        const float omw = 1.0f - __expf(-e);
                        const float a = sigmoidf_(xa[q]);
                        o1[q] = (f16_t)omw; o2[q] = (f16_t)(uk[t][q] * (1.0f + (a - 1.0f) * kaw[q])); o3[q] = (f16_t)(kkv[t][q] * a); }
                    f16_t* sp = SD + sdrow + 16 * t + 4 * g; *(f16x4*)sp = o1; *(f16x4*)(sp + 64) = o2; *(f16x4*)(sp + 128) = o3; asm volatile("" ::: "memory"); }
            }
        }
    }
}

constexpr int SC_CH = 32;
constexpr int SC_BUF = SC_CH * 6 * 64 * 4;
__device__ __forceinline__ float dpp_sum16(float v) {
    v += __builtin_bit_cast(float, __builtin_amdgcn_update_dpp(0, __builtin_bit_cast(int, v), 0xB1, 0xF, 0xF, true));
    v += __builtin_bit_cast(float, __builtin_amdgcn_update_dpp(0, __builtin_bit_cast(int, v), 0x4E, 0xF, 0xF, true));
    v += __builtin_bit_cast(float, __builtin_amdgcn_update_dpp(0, __builtin_bit_cast(int, v), 0x141, 0xF, 0xF, true));
    v += __builtin_bit_cast(float, __builtin_amdgcn_update_dpp(0, __builtin_bit_cast(int, v), 0x140, 0xF, 0xF, true));
    return v;
}
__device__ __forceinline__ int scan_tt0(int d, int c) { return d == 0 ? c * SC_CH : (c < 8 ? 224 - 32 * c : 4576 - 32 * c); }
__device__ __forceinline__ void scan_load_chunk(LAS unsigned char* lds, const f16_t* sh, const f16_t* sd, int d, int c, int lt) {
    const int t0 = scan_tt0(d, c);
    u32x4 ld[6];
#pragma unroll
    for (int i = 0; i < 3; ++i) { const int p = lt + i * 256; ld[i] = *(const u32x4*)(sh + (size_t)t0 * 192 + p * 8); ld[3 + i] = *(const u32x4*)(sd + (size_t)t0 * 192 + p * 8); }
    LAS float* buf = (LAS float*)(lds + (c & 1) * SC_BUF);
#pragma unroll
    for (int i = 0; i < 6; ++i) { const int p = lt + (i % 3) * 256; const int ms = p / 24, wi = p % 24, kind = wi >> 3, e0 = (wi & 7) * 8; const int st = d == 0 ? ms : (SC_CH - 1 - ms);
        const f16x8 hv = __builtin_bit_cast(f16x8, ld[i]); float f[8];
#pragma unroll
        for (int q = 0; q < 8; ++q) f[q] = (float)hv[q];
        if (i >= 3 && kind == 0) {
#pragma unroll
            for (int q = 0; q < 8; ++q) f[q] = 1.0f - f[q];
        }
        LAS float* dst = buf + (st * 6 + (i < 3 ? kind : 3 + kind)) * 64 + e0;
        *(LAS f32x4*)dst = (f32x4){f[0], f[1], f[2], f[3]}; *(LAS f32x4*)(dst + 4) = (f32x4){f[4], f[5], f[6], f[7]}; }
}
__device__ __forceinline__ void phase_scan(const Frame& F) {
    const f16_t* SH = (const f16_t*)(F.ws + WS_SH); const f16_t* SD = (const f16_t*)(F.ws + WS_SD);
    float* Y = (float*)(F.ws + WS_Y);
    const int tid = F.tid, lane = F.lane, wave = F.wave;
    constexpr int NCHUNK = TT / SC_CH;
    for (int item = F.bid; item < 256; item += F.G) {
        const int xg = item & 7, sl = item >> 3, chain = xg * 8 + (sl >> 2), quarter = sl & 3;
        const int d = chain >> 5, b = (chain >> 2) & 7, h = chain & 3;
        const f16_t* sh = SH + (size_t)(b * 4 + h) * TT * 192; const f16_t* sd = SD + (size_t)((d * 8 + b) * 4 + h) * TT * 192;
        const bool loader = wave >= 4; const int lt = tid - 256;
        if (loader) scan_load_chunk(F.lds, sh, sd, d, 0, lt);
        __syncthreads();
        float S0 = 0.f, S1 = 0.f, S2 = 0.f, S3 = 0.f;
        const int row = quarter * 16 + (wave & 3) * 4 + (lane >> 4), j0 = (lane & 15) * 4;
        float* yp = Y + ((size_t)(d * 8 + b) * TT) * 256 + h * 64 + row;
        for (int c = 0; c < NCHUNK; ++c) {
            if (loader) {
                if (c + 1 < NCHUNK) scan_load_chunk(F.lds, sh, sd, d, c + 1, lt);
            } else {
                const LAS float* buf = (const LAS float*)(F.lds + (c & 1) * SC_BUF);
                const int t0 = scan_tt0(d, c);
                f32x4 r4 = *(const LAS f32x4*)(buf + j0), z4 = *(const LAS f32x4*)(buf + 128 + j0), w4 = *(const LAS f32x4*)(buf + 192 + j0),
                      k4 = *(const LAS f32x4*)(buf + 256 + j0), b4 = *(const LAS f32x4*)(buf + 320 + j0);
                float vr = buf[64 + row], ysel = 0.f;
#pragma unroll 8
                for (int i = 0; i < SC_CH; ++i) {
                    f32x4 r4n = r4, z4n = z4, w4n = w4, k4n = k4, b4n = b4; float vrn = vr;
                    if (i + 1 < SC_CH) { const LAS float* sp = buf + (i + 1) * 384;
                        r4n = *(const LAS f32x4*)(sp + j0); z4n = *(const LAS f32x4*)(sp + 128 + j0); w4n = *(const LAS f32x4*)(sp + 192 + j0);
                        k4n = *(const LAS f32x4*)(sp + 256 + j0); b4n = *(const LAS f32x4*)(sp + 320 + j0); vrn = sp[64 + row]; }
                    float sz = (S0 * z4[0] + S1 * z4[1]) + (S2 * z4[2] + S3 * z4[3]);
                    sz = dpp_sum16(sz);
                    S0 = S0 * w4[0] + (sz * b4[0] + vr * k4[0]); S1 = S1 * w4[1] + (sz * b4[1] + vr * k4[1]);
                    S2 = S2 * w4[2] + (sz * b4[2] + vr * k4[2]); S3 = S3 * w4[3] + (sz * b4[3] + vr * k4[3]);
                    float y = (S0 * r4[0] + S1 * r4[1]) + (S2 * r4[2] + S3 * r4[3]);
                    y = dpp_sum16(y);
                    ysel = ((lane & 15) == (i & 15)) ? y : ysel;
                    if ((i & 15) == 15) { const int st = (i - 15) + (lane & 15); const int tt = d == 0 ? t0 + st : t0 + SC_CH - 1 - st; yp[(size_t)tt * 256] = ysel; }
                    r4 = r4n; z4 = z4n; w4 = w4n; k4 = k4n; b4 = b4n; vr = vrn;
                }
            }
            __syncthreads();
        }
    }
}

__device__ __forceinline__ void phase_rw_post(const Frame& F, const Params& P, int l, int nrows) {
    const bf16_t* PL = (const bf16_t*)(F.ws + WS_PL); bf16_t* MIX = (bf16_t*)(F.ws + WS_MIX);
    const f16_t* SH = (const f16_t*)(F.ws + WS_SH); const f16_t* SD = (const f16_t*)(F.ws + WS_SD); const float* Y = (const float*)(F.ws + WS_Y);
    const float* mup = P.in[I_MUP] + l * 1280; const float* mun = P.in[I_MUN] + l * 1280;
    const int lane = F.lane;
    for (int tile = F.gw; tile < nrows / 16; tile += F.nw) {
        int l1 = lane; asm volatile("" : "+v"(l1)); const int tk = l1 & 15, g = l1 >> 4;
        const int r = tile * 16 + tk; const RowGeo geo = row_geo(r);
        bf16x8 sg[2][4];
#pragma unroll
        for (int d = 0; d < 2; ++d)
#pragma unroll
            for (int kk = 0; kk < 4; ++kk) { float u[8]; rw_shift8(PL, mup, mun, r, geo, 896 + 256 * d + 32 * kk + 8 * g, u);
#pragma unroll
                for (int q = 0; q < 8; ++q) u[q] = sigmoidf_(u[q]);
                sg[d][kk] = pack8f(u); asm volatile("" ::: "memory"); }
#pragma unroll 1
        for (int h = 0; h < 4; ++h) {
            int l2 = lane; asm volatile("" : "+v"(l2)); const int tk = l2 & 15, g = l2 >> 4;
            const int r = tile * 16 + tk; const RowGeo geo = row_geo(r);
            const size_t shrow = ((size_t)(geo.b * 4 + h) * TT + geo.tt) * 192;
            float out[4][4];
#pragma unroll
            for (int t = 0; t < 4; ++t)
#pragma unroll
                for (int q = 0; q < 4; ++q) out[t][q] = 0.f;
#pragma unroll 1
            for (int d = 0; d < 2; ++d) {
                const bf16_t* g2t = (const bf16_t*)(F.ws + WS_LORA + (size_t)(l * 2 + d) * LORA_LD_BYTES) + 2 * 256 * 64;
                const size_t sdrow = ((size_t)((d * 8 + geo.b) * 4 + h) * TT + geo.tt) * 192;
                const float* yrow = Y + ((size_t)(d * 8 + geo.b) * TT + geo.tt) * 256 + 64 * h + 4 * g;
                bf16x8 sgd[4];
#pragma unroll
                for (int kk = 0; kk < 4; ++kk) sgd[kk] = d ? sg[1][kk] : sg[0][kk];
                f32x4 y[4], gg[4]; float sm = 0.f, bs = 0.f;
#pragma unroll
                for (int t = 0; t < 4; ++t) { const int c = 64 * h + 16 * t + 4 * g;
                    y[t] = *(const f32x4*)(yrow + 16 * t); sm += (y[t][0] + y[t][1]) + (y[t][2] + y[t][3]);
                    const f16x4 rh = *(const f16x4*)(SH + shrow + 16 * t + 4 * g), kdh = *(const f16x4*)(SD + sdrow + 64 + 16 * t + 4 * g);
                    const f32x4 rk = *(const f32x4*)(P.in[I_RK] + l * 256 + c);
#pragma unroll
                    for (int q = 0; q < 4; ++q) bs += (float)rh[q] * (float)kdh[q] * rk[q];
                    const bf16_t* gr = g2t + (size_t)(64 * h + 16 * t + tk) * 128 + 8 * g;
                    f32x4 a = (f32x4){0.f, 0.f, 0.f, 0.f};
#pragma unroll
                    for (int kk = 0; kk < 4; ++kk) a = __builtin_amdgcn_mfma_f32_16x16x32_bf16(*(const bf16x8*)(gr + 32 * kk), sgd[kk], a, 0, 0, 0);
                    gg[t] = a; asm volatile("" ::: "memory"); }
                sm += __shfl_xor(sm, 16); sm += __shfl_xor(sm, 32); bs += __shfl_xor(bs, 16); bs += __shfl_xor(bs, 32);
                const float mu = sm * (1.0f / 64.0f); float vs = 0.f;
#pragma unroll
                for (int t = 0; t < 4; ++t)
#pragma unroll
                    for (int q = 0; q < 4; ++q) { const float dd = y[t][q] - mu; vs += dd * dd; }
                vs += __shfl_xor(vs, 16); vs += __shfl_xor(vs, 32);
                const float rstd = rsqrtf(vs * (1.0f / 64.0f) + 64e-5f);
#pragma unroll
                for (int t = 0; t < 4; ++t) { const int c = 64 * h + 16 * t + 4 * g;
                    const f32x4 gng = *(const f32x4*)(P.in[I_GNG] + l * 256 + c), gnb = *(const f32x4*)(P.in[I_GNB] + l * 256 + c);
                    const f16x4 vh = *(const f16x4*)(SH + shrow + 64 + 16 * t + 4 * g);
#pragma unroll
                    for (int q = 0; q < 4; ++q) out[t][q] += ((y[t][q] - mu) * rstd * gng[q] + gnb[q] + bs * (float)vh[q]) * gg[t][q]; }
            }
#pragma unroll
            for (int t = 0; t < 4; ++t) { u32x2 w; w.x = cvt_pk_bf16(out[t][0], out[t][1]); w.y = cvt_pk_bf16(out[t][2], out[t][3]);
                *(u32x2*)(MIX + (size_t)r * D + 512 + 64 * h + 16 * t + 4 * g) = w; }
        }
    }
}

constexpr int CV_SEG = 64, CV_ROWS = CV_SEG + 30, CV_H = 0, CV_W = CV_ROWS * 256 * 4;
__device__ __forceinline__ void phase_conv(const Frame& F, const Params& P, int l, int nrows) {
    const bf16_t* PL = (const bf16_t*)(F.ws + WS_PL); bf16_t* MIX = (bf16_t*)(F.ws + WS_MIX);
    const int lane = F.lane, c4 = lane * 4, wave = F.wave;
    LAS float* H = (LAS float*)(F.lds + CV_H); LAS float* W = (LAS float*)(F.lds + CV_W);
    for (int i = F.tid; i < 31 * 256; i += NTHREADS) W[i] = P.in[I_DWW][(size_t)l * 31 * 256 + i];
    const f32x4 dwb = *(const f32x4*)(P.in[I_DWB] + l * 256 + c4), lng = *(const f32x4*)(P.in[I_LNG] + l * 256 + c4), lnb = *(const f32x4*)(P.in[I_LNB] + l * 256 + c4);
    for (int seg = F.bid; seg < nrows / CV_SEG; seg += F.G) {
        const int r0 = seg * CV_SEG; const RowGeo g0 = row_geo(r0);
        __syncthreads();
#pragma unroll 4
        for (int k = 0; k < 12; ++k) { const int rr = wave + 8 * k;
            if (rr < CV_ROWS) { const int pos = g0.pos - 15 + rr; f32x4 hv = (f32x4){0.f, 0.f, 0.f, 0.f};
                if (pos >= 0 && pos < g0.len) { const bf16_t* p = PL + (size_t)(r0 - 15 + rr) * INW + O_CV + c4; float a[4], bb[4];
                    unpack4(*(const u32x2*)p, a); unpack4(*(const u32x2*)(p + 256), bb);
#pragma unroll
                    for (int q = 0; q < 4; ++q) hv[q] = a[q] * sigmoidf_(bb[q]); }
                *(LAS f32x4*)(H + rr * 256 + c4) = hv; } }
        __syncthreads();
        f32x4 acc[8];
#pragma unroll
        for (int t = 0; t < 8; ++t) acc[t] = dwb;
#pragma unroll 1
        for (int j = 0; j < 31; ++j) { const f32x4 w = *(const LAS f32x4*)(W + j * 256 + c4);
#pragma unroll
            for (int t = 0; t < 8; ++t) acc[t] += *(const LAS f32x4*)(H + (wave * 8 + t + j) * 256 + c4) * w; }
#pragma unroll
        for (int t = 0; t < 8; ++t) {
            const float mu = wave_sum((acc[t][0] + acc[t][1]) + (acc[t][2] + acc[t][3])) * (1.0f / 256.0f);
            float vs = 0.f;
#pragma unroll
            for (int q = 0; q < 4; ++q) { const float dd = acc[t][q] - mu; vs += dd * dd; }
            const float rstd = rsqrtf(wave_sum(vs) * (1.0f / 256.0f) + 1e-5f);
            float o[4];
#pragma unroll
            for (int q = 0; q < 4; ++q) o[q] = siluf_((acc[t][q] - mu) * rstd * lng[q] + lnb[q]);
            u32x2 w; w.x = pk_bf16(o[0], o[1]); w.y = pk_bf16(o[2], o[3]);
            *(u32x2*)(MIX + (size_t)(r0 + wave * 8 + t) * D + 768 + c4) = w; }
    }
}

__device__ __forceinline__ void phase_na_simple(const Frame& F, const Params& P, int l, int nq) {
    const bf16_t* PL = (const bf16_t*)(F.ws + WS_PL); bf16_t* MIX = (bf16_t*)(F.ws + WS_MIX);
    const float* rpb = P.in[I_RPB] + (size_t)l * 8 * 15 * 31;
    int tid_ = F.tid; asm volatile("" : "+v"(tid_));
    for (int gid = F.bid * NTHREADS + tid_; gid < nq * 8; gid += F.G * NTHREADS) {
        const int r = gid >> 3, h = gid & 7;
        const RowGeo g = row_geo(r);
        float q[64], o[64];
        { const bf16_t* qp = PL + (size_t)r * INW + O_Q + h * 64;
#pragma unroll
          for (int i = 0; i < 8; ++i) unpack8(*(const u32x4*)(qp + i * 8), q + i * 8); }
#pragma unroll
        for (int i = 0; i < 64; ++i) o[i] = 0.f;
        float m = -3.0e38f, lsum = 0.f;
        const bool lat = r < NLAT;
        const int gi = g.pos >> 6, gc = g.pos & 63;
        const int rs = min(max(gi - 4, 0), 56), wsc = min(max(gc - 8, 0), 48);
        const int nkey = lat ? 384 : 256;
#pragma unroll 1
        for (int kx = 0; kx < nkey; ++kx) {
            const bool win = lat && kx < 128;
            int krow; float bias = 0.f;
            if (win) { const int r8 = kx >> 4, cc = kx & 15; krow = g.b * SEQ + (rs + r8) * 64 + wsc + cc; bias = rpb[(h * 15 + (rs + r8 - gi + 7)) * 31 + (wsc + cc - gc + 15)]; }
            else krow = NLAT + g.b * CTXL + (kx - (lat ? 128 : 0));
            const bf16_t* kp = PL + (size_t)krow * INW + O_K + h * 64; float a = bias;
#pragma unroll
            for (int i = 0; i < 8; ++i) { float kf[8]; unpack8(*(const u32x4*)(kp + i * 8), kf);
#pragma unroll
                for (int j = 0; j < 8; ++j) a += q[i * 8 + j] * kf[j]; }
            if (a > m) { const float alpha = __expf(m - a); lsum *= alpha;
#pragma unroll
                for (int i = 0; i < 64; ++i) o[i] *= alpha;
                m = a; }
            const float p = __expf(a - m); lsum += p;
            const bf16_t* vp = kp + (O_V - O_K);
#pragma unroll
            for (int i = 0; i < 8; ++i) { float vf[8]; unpack8(*(const u32x4*)(vp + i * 8), vf);
#pragma unroll
                for (int j = 0; j < 8; ++j) o[i * 8 + j] += p * vf[j]; }
        }
        const float inv = 1.0f / lsum;
        bf16_t* op = MIX + (size_t)r * D + h * 64;
#pragma unroll
        for (int i = 0; i < 8; ++i) { u32x4 w; w.x = pk_bf16(o[i * 8] * inv, o[i * 8 + 1] * inv); w.y = pk_bf16(o[i * 8 + 2] * inv, o[i * 8 + 3] * inv);
            w.z = pk_bf16(o[i * 8 + 4] * inv, o[i * 8 + 5] * inv); w.w = pk_bf16(o[i * 8 + 6] * inv, o[i * 8 + 7] * inv); *(u32x4*)(op + i * 8) = w; }
    }
}

typedef short v4i16_t __attribute__((ext_vector_type(4)));
constexpr int NA_CK = 0, NA_CV = 32768, NA_RPB = 65536, NA_WV = 81920;
__device__ __forceinline__ bf16x8 na_pack8(const f32x4& a, const f32x4& b) {
    u32x4 w; w.x = cvt_pk_bf16(a[0], a[1]); w.y = cvt_pk_bf16(a[2], a[3]); w.z = cvt_pk_bf16(b[0], b[1]); w.w = cvt_pk_bf16(b[2], b[3]); return __builtin_bit_cast(bf16x8, w);
}
__device__ __forceinline__ bf16x8 na_vfrag(LAS unsigned char* blk, int lane, int dt) {
    const int g = lane >> 4, qq = (lane & 15) >> 2, p = lane & 3;
    const int r0 = 4 * g + qq, r1 = 16 + 4 * g + qq;
    const v4i16_t lo = __builtin_amdgcn_ds_read_tr16_b64_v4i16((LAS v4i16_t*)(blk + r0 * 128 + ((dt ^ ((r0 >> 1) & 3)) * 32) + p * 8));
    const v4i16_t hi = __builtin_amdgcn_ds_read_tr16_b64_v4i16((LAS v4i16_t*)(blk + r1 * 128 + ((dt ^ ((r1 >> 1) & 3)) * 32) + p * 8));
    bf16x8 r; r[0] = lo[0]; r[1] = lo[1]; r[2] = lo[2]; r[3] = lo[3]; r[4] = hi[0]; r[5] = hi[1]; r[6] = hi[2]; r[7] = hi[3]; return r;
}
template <bool WINDOW>
__device__ __forceinline__ void na_item(const Frame& F, const bf16_t* PL, bf16_t* MIX, int b, int h, int qrow0  , int gi, int cb) {
    const int lane = F.lane, ql = lane & 15, g = lane >> 4;
    LAS unsigned char* CK = F.lds + NA_CK; LAS unsigned char* CV = F.lds + NA_CV; const LAS float* RPB = (const LAS float*)(F.lds + NA_RPB);
    LAS unsigned char* WV = F.lds + NA_WV + F.wave * 4096;
    bf16x8 Qf[2];
    { const bf16_t* qp = PL + (size_t)(qrow0 + ql) * INW + O_Q + h * 64 + 8 * g; Qf[0] = *(const bf16x8*)qp; Qf[1] = *(const bf16x8*)(qp + 32); }
    f32x4 acc[4];
#pragma unroll
    for (int dt = 0; dt < 4; ++dt) acc[dt] = (f32x4){0.f, 0.f, 0.f, 0.f};
    float m_run = -3.0e38f, l_run = 0.f;
    if constexpr (WINDOW) {
        const int rs = min(max(gi - 4, 0), 56), kc0 = min(max(16 * cb - 8, 0), 32), qcol = 16 * cb + ql, wsq = min(max(qcol - 8, 0), 48);
        const size_t krow0 = (size_t)b * SEQ + (size_t)rs * 64 + kc0;
        f32x4 s[16];
#pragma unroll
        for (int t = 0; t < 16; ++t) { const bf16_t* kp = PL + (krow0 + (size_t)(t >> 1) * 64 + (t & 1) * 16 + ql) * INW + O_K + h * 64 + 8 * g;
            const bf16x8 k0 = *(const bf16x8*)kp, k1 = *(const bf16x8*)(kp + 32);
            s[t] = __builtin_amdgcn_mfma_f32_16x16x32_bf16(k0, Qf[0], (f32x4){0.f, 0.f, 0.f, 0.f}, 0, 0, 0);
            s[t] = __builtin_amdgcn_mfma_f32_16x16x32_bf16(k1, Qf[1], s[t], 0, 0, 0); }
        float mx = -3.0e38f;
#pragma unroll
        for (int t = 0; t < 16; ++t) { const LAS float* bp = RPB + (h * 15 + (rs + (t >> 1) - gi + 7)) * 31 + 15 - qcol;
#pragma unroll
            for (int j = 0; j < 4; ++j) { const int kcol = kc0 + (t & 1) * 16 + 4 * g + j; const bool ok = kcol >= wsq && kcol < wsq + 16;
                const float v = ok ? s[t][j] + bp[ok ? kcol : qcol] : -INFINITY; s[t][j] = v; mx = fmaxf(mx, v); } }
        mx = fmaxf(mx, __shfl_xor(mx, 16)); mx = fmaxf(mx, __shfl_xor(mx, 32));
        m_run = mx;
        float ls = 0.f;
#pragma unroll
        for (int t = 0; t < 16; ++t)
#pragma unroll
            for (int j = 0; j < 4; ++j) { const float p = __expf(s[t][j] - mx); s[t][j] = p; ls += p; }
        l_run = ls;
#pragma unroll
        for (int r8 = 0; r8 < 8; ++r8) {
            { const int vr = lane >> 1, part = lane & 1;
              const bf16_t* vp = PL + (krow0 + (size_t)r8 * 64 + vr) * INW + O_V + h * 64 + part * 32;
              u32x4 v0 = *(const u32x4*)vp, v1 = *(const u32x4*)(vp + 8), v2 = *(const u32x4*)(vp + 16), v3 = *(const u32x4*)(vp + 24);
              LAS unsigned char* wr = WV + vr * 128; const int sw = (vr >> 1) & 3;
              *(LAS u32x4*)(wr + (((2 * part) ^ sw) * 32)) = v0; *(LAS u32x4*)(wr + (((2 * part) ^ sw) * 32) + 16) = v1;
              *(LAS u32x4*)(wr + (((2 * part + 1) ^ sw) * 32)) = v2; *(LAS u32x4*)(wr + (((2 * part + 1) ^ sw) * 32) + 16) = v3; }
            __builtin_amdgcn_wave_barrier(); asm volatile("" ::: "memory");
            const bf16x8 pf = na_pack8(s[2 * r8], s[2 * r8 + 1]);
#pragma unroll
            for (int dt = 0; dt < 4; ++dt) { const bf16x8 vf = na_vfrag(WV, lane, dt); acc[dt] = __builtin_amdgcn_mfma_f32_16x16x32_bf16(vf, pf, acc[dt], 0, 0, 0); }
            __builtin_amdgcn_wave_barrier(); asm volatile("" ::: "memory");
        }
    }
    {
        f32x4 s[16];
#pragma unroll
        for (int t = 0; t < 16; ++t) { const int key = 16 * t + ql; const LAS unsigned char* kr = CK + key * 128;
            const bf16x8 k0 = *(const LAS bf16x8*)(kr + ((g ^ (key & 7)) * 16)), k1 = *(const LAS bf16x8*)(kr + (((g + 4) ^ (key & 7)) * 16));
            s[t] = __builtin_amdgcn_mfma_f32_16x16x32_bf16(k0, Qf[0], (f32x4){0.f, 0.f, 0.f, 0.f}, 0, 0, 0);
            s[t] = __builtin_amdgcn_mfma_f32_16x16x32_bf16(k1, Qf[1], s[t], 0, 0, 0); }
        float mx = m_run;
#pragma unroll
        for (int t = 0; t < 16; ++t)
#pragma unroll
            for (int j = 0; j < 4; ++j) mx = fmaxf(mx, s[t][j]);
        mx = fmaxf(mx, __shfl_xor(mx, 16)); mx = fmaxf(mx, __shfl_xor(mx, 32));
        const float alpha = __expf(m_run - mx);
        float ls = l_run * alpha;
#pragma unroll
        for (int dt = 0; dt < 4; ++dt) acc[dt] *= alpha;
#pragma unroll
        for (int t = 0; t < 16; ++t)
#pragma unroll
            for (int j = 0; j < 4; ++j) { const float p = __expf(s[t][j] - mx); s[t][j] = p; ls += p; }
        l_run = ls;
#pragma unroll
        for (int blk = 0; blk < 8; ++blk) { const bf16x8 pf = na_pack8(s[2 * blk], s[2 * blk + 1]);
#pragma unroll
            for (int dt = 0; dt < 4; ++dt) { const bf16x8 vf = na_vfrag(CV + blk * 4096, lane, dt); acc[dt] = __builtin_amdgcn_mfma_f32_16x16x32_bf16(vf, pf, acc[dt], 0, 0, 0); } }
    }
    float lt = l_run; lt += __shfl_xor(lt, 16); lt += __shfl_xor(lt, 32);
    const float inv = 1.0f / lt;
    bf16_t* op = MIX + (size_t)(qrow0 + ql) * D + h * 64 + 4 * g;
#pragma unroll
    for (int dt = 0; dt < 4; ++dt) { u32x2 w; w.x = cvt_pk_bf16(acc[dt][0] * inv, acc[dt][1] * inv); w.y = cvt_pk_bf16(acc[dt][2] * inv, acc[dt][3] * inv); *(u32x2*)(op + dt * 16) = w; }
}
__device__ __forceinline__ void phase_na_mfma(const Frame& F, const Params& P, int l, bool ctx_queries) {
    const bf16_t* PL = (const bf16_t*)(F.ws + WS_PL); bf16_t* MIX = (bf16_t*)(F.ws + WS_MIX);
    int tid_ = F.tid; asm volatile("" : "+v"(tid_));
    const int tid = tid_;
    { const float* rpb = P.in[I_RPB] + (size_t)l * 8 * 15 * 31; LAS float* R = (LAS float*)(F.lds + NA_RPB); for (int i = tid; i < 8 * 15 * 31; i += NTHREADS) R[i] = rpb[i]; }
    for (int unit = F.bid; unit < 256; unit += F.G) {
        const int quarter = unit & 3, h = (unit >> 2) & 7, b = unit >> 5;
        __syncthreads();
        { int t2 = tid; asm volatile("" : "+v"(t2)); const int key = t2 >> 1, part = t2 & 1; const bf16_t* kp = PL + (size_t)(NLAT + b * CTXL + key) * INW + O_K + h * 64 + part * 32; const bf16_t* vp = kp + (O_V - O_K);
          LAS unsigned char* kr = F.lds + NA_CK + key * 128; LAS unsigned char* vr = F.lds + NA_CV + key * 128; const int sw = (key >> 1) & 3;
#pragma unroll
          for (int c = 0; c < 4; ++c) { *(LAS u32x4*)(kr + (((4 * part + c) ^ (key & 7)) * 16)) = *(const u32x4*)(kp + 8 * c);
              const int c16 = 4 * part + c; *(LAS u32x4*)(vr + (((c16 >> 1) ^ sw) * 32) + (c16 & 1) * 16) = *(const u32x4*)(vp + 8 * c); } }
        __syncthreads();
        for (int it = F.wave; it < 64; it += NWAVES) { const int gi = quarter * 16 + (it >> 2), cb = it & 3;
            na_item<true>(F, PL, MIX, b, h, b * SEQ + gi * 64 + cb * 16, gi, cb); }
        if (ctx_queries && F.wave < 4) na_item<false>(F, PL, MIX, b, h, NLAT + b * CTXL + (quarter * 4 + F.wave) * 16, 0, 0);
    }
}

__device__ __forceinline__ void phase_final(const Frame& F, const Params& P) {
    float* out = P.out; const float* g = P.in[I_FINALG]; const int lane = F.lane;
    for (int r = F.gw; r < NLAT; r += F.nw) {
        float* xr = out + (size_t)r * D; f32x4 x[4]; float ss = 0.f;
#pragma unroll
        for (int j = 0; j < 4; ++j) { x[j] = *(const f32x4*)(xr + j * 256 + lane * 4); ss += x[j][0] * x[j][0] + x[j][1] * x[j][1] + x[j][2] * x[j][2] + x[j][3] * x[j][3]; }
        ss = wave_sum(ss); const float rstd = rsqrtf(ss * (1.0f / D) + 1e-6f);
#pragma unroll
        for (int j = 0; j < 4; ++j) { const f32x4 gg = *(const f32x4*)(g + j * 256 + lane * 4); *(f32x4*)(xr + j * 256 + lane * 4) = x[j] * rstd * gg; }
    }
}

constexpr int PH_L0 = 1, PH_PER_L0 = 9, PH_L1 = PH_L0 + PH_PER_L0, PH_PER_L1 = 12, PH_FINAL = PH_L1 + PH_PER_L1, N_PHASES = PH_FINAL + 1;
#define RFL(x) __builtin_amdgcn_readfirstlane(x)

PHASE ph_prologue(const void* kp_, int wv_) { PHASE_ENTER; if constexpr (MKB(0)) phase_prologue(F, P); }
PHASE ph_norm1(const void* kp_, int wv_, int l_) { PHASE_ENTER; const int l = RFL(l_);
    if constexpr (MKB(1)) phase_norm<false>(F, P, l, 0, NROW, l == 0 ? P.in[I_X] : P.out, l == 0 ? P.in[I_CTX] : (const float*)(F.ws + WS_XC)); }
PHASE_INL ph_gemm_win(const void* kp_, int wv_, int l_) { PHASE_ENTER; const int l = RFL(l_);
    pg8::DenseSched S; S.init(NROW / 256, INW / 256, F.G, F.bid); S.A = (const bf16_t*)(F.ws + WS_HL); S.Bt = (const bf16_t*)(F.ws + WS_BTIN) + (size_t)l * INW * D; S.K = D;
    pg8::EpiBf16 E{(bf16_t*)(F.ws + WS_PL), INW, 2, 0.125f};
    if constexpr (MKB(2)) pg8::gemm_phase<pg8::EpiBf16, pg8::DenseSched, false>(F.lds, D, S, E, F.wave); }
PHASE_INL ph_rw_prep(const void* kp_, int wv_, int l_) { PHASE_ENTER; const int l = RFL(l_); if constexpr (MKB(3)) phase_rw_prep(F, P, l); }
PHASE ph_conv(const void* kp_, int wv_, int l_) { PHASE_ENTER; const int l = RFL(l_); if constexpr (MKB(4)) phase_conv(F, P, l, l == 0 ? NROW : NLAT); }
PHASE_INL ph_na(const void* kp_, int wv_, int l_) { PHASE_ENTER; const int l = RFL(l_); if constexpr (MKB(5)) phase_na_mfma(F, P, l, l == 0); }
PHASE ph_scan(const void* kp_, int wv_) { PHASE_ENTER; if constexpr (MKB(6)) phase_scan(F); }
PHASE_INL ph_rw_post(const void* kp_, int wv_, int l_) { PHASE_ENTER; const int l = RFL(l_); if constexpr (MKB(7)) phase_rw_post(F, P, l, l == 0 ? NROW : NLAT); }
PHASE_INL ph_gemm_wout(const void* kp_, int wv_, int l_) { PHASE_ENTER; const int l = RFL(l_);
    float* XC = (float*)(F.ws + WS_XC);
    pg8::DenseSched S; S.init((l == 0 ? NROW : NLAT) / 256, D / 256, F.G, F.bid); S.A = (const bf16_t*)(F.ws + WS_MIX); S.Bt = (const bf16_t*)(F.ws + WS_BTOUT) + (size_t)l * D * D; S.K = D;
    pg8::EpiRes E{l == 0 ? P.in[I_X] : P.out, l == 0 ? P.in[I_CTX] : XC, P.out, XC, (const float*)(F.ws + WS_MODV) + (size_t)l * 9 * MODW + 2 * D};
    if constexpr (MKB(8)) pg8::gemm_phase<pg8::EpiRes, pg8::DenseSched, false>(F.lds, D, S, E, F.wave); }
PHASE ph_norm2_l0(const void* kp_, int wv_) { PHASE_ENTER; if constexpr (MKB(9)) phase_norm<false>(F, P, 0, 1, NROW, P.out, (const float*)(F.ws + WS_XC)); }
PHASE_INL ph_gemm_ffn_gu(const void* kp_, int wv_) { PHASE_ENTER;
    pg8::DenseSched S; S.init(NROW / 256, (2 * DFF) / 256, F.G, F.bid); S.A = (const bf16_t*)(F.ws + WS_HL); S.Bt = (const bf16_t*)(F.ws + WS_BTGU); S.K = D;
    pg8::EpiSwiGLU E{(bf16_t*)(F.ws + WS_H), DFF};
    if constexpr (MKB(10)) pg8::gemm_phase<pg8::EpiSwiGLU, pg8::DenseSched, false>(F.lds, D, S, E, F.wave); }
PHASE_INL ph_gemm_ffn_dn(const void* kp_, int wv_) { PHASE_ENTER;
    float* XC = (float*)(F.ws + WS_XC);
    pg8::DenseSched S; S.init(NROW / 256, D / 256, F.G, F.bid); S.A = (const bf16_t*)(F.ws + WS_H); S.Bt = (const bf16_t*)(F.ws + WS_BTDN); S.K = DFF;
    pg8::EpiRes E{P.out, XC, P.out, XC, (const float*)(F.ws + WS_MODV) + 5 * D};
    if constexpr (MKB(11)) pg8::gemm_phase<pg8::EpiRes, pg8::DenseSched, false>(F.lds, DFF, S, E, F.wave); }
PHASE ph_norm2_l1(const void* kp_, int wv_) { PHASE_ENTER; if constexpr (MKB(12)) phase_norm<true>(F, P, 1, 1, NLAT, P.out, (const float*)(F.ws + WS_XC)); }
PHASE ph_moe_prep(const void* kp_, int wv_) { PHASE_ENTER; if constexpr (MKB(13)) { phase_moe_rowmap(F); phase_moe_convert(F, P); } }
PHASE_INL ph_gemm_moe_gu(const void* kp_, int wv_, int pass_) { PHASE_ENTER; const int pass = RFL(pass_);
    pg8::MoeSched S; moe_tstart(F, pass, S.tstart); S.init(S.tstart[8], (2 * DFE) / 256, F.G, F.bid);
    S.A = (const bf16_t*)(F.ws + WS_HL); S.Bt0 = F.ws + WS_MOE; S.e_stride = MOE_E_BYTES; S.K = D; S.rowmap = (const int*)(F.ws + WS_ROUTE + RT_RMAP) + pass * NROW;
    pg8::EpiSwiGLU E{(bf16_t*)(F.ws + WS_H), DFE};
    if constexpr (MKB(14)) pg8::gemm_phase<pg8::EpiSwiGLU, pg8::MoeSched, true>(F.lds, D, S, E, F.wave); }
PHASE_INL ph_gemm_moe_dn(const void* kp_, int wv_, int pass_) { PHASE_ENTER; const int pass = RFL(pass_);
    pg8::MoeSched S; moe_tstart(F, pass, S.tstart); S.init(S.tstart[8], D / 256, F.G, F.bid);
    S.A = (const bf16_t*)(F.ws + WS_H); S.Bt0 = F.ws + WS_MOE + MOE_GU_BYTES; S.e_stride = MOE_E_BYTES; S.K = DFE; S.rowmap = nullptr;
    pg8::EpiMoeDown E{P.out, (const float*)(F.ws + WS_MODV) + (size_t)9 * MODW + 5 * D, (const int*)(F.ws + WS_ROUTE + RT_RMAP) + pass * NROW, (const float*)(F.ws + WS_ROUTE + RT_SGATE) + pass * NROW};
    if constexpr (MKB(15)) pg8::gemm_phase<pg8::EpiMoeDown, pg8::MoeSched, false>(F.lds, DFE, S, E, F.wave); }
PHASE ph_final(const void* kp_, int wv_) { PHASE_ENTER; if constexpr (MKB(16)) phase_final(F, P); }

static __attribute__((noinline)) __device__ void grid_barrier(const void* bar_, unsigned x_, int wv_) {
    const unsigned long long v = (unsigned long long)bar_;
    const unsigned lo = __builtin_amdgcn_readfirstlane((unsigned)v), hi = __builtin_amdgcn_readfirstlane((unsigned)(v >> 32));
    XcdBarrier b; b.bar = (unsigned*)(((unsigned long long)hi << 32) | lo); b.x = __builtin_amdgcn_readfirstlane(x_);
    b.st = (volatile LAS unsigned*)((LAS unsigned char*)lds_raw + LDS_MISC);
    xcd_barrier(b, __builtin_amdgcn_readfirstlane(wv_) * 64 + lane_id());
}
__device__ __forceinline__ bool ph_in(int lo, int hi, int k) { asm volatile("" : "+s"(lo), "+s"(hi)); return lo <= k && k < hi; }

__global__ void __launch_bounds__(NTHREADS, 2) mk_fwd(Params P) {
    const void* kp = (const void*)__builtin_amdgcn_kernarg_segment_ptr();
    LAS unsigned char* lds = (LAS unsigned char*)lds_raw;
    volatile LAS unsigned* misc = (volatile LAS unsigned*)(lds + LDS_MISC);
    const int wv = __builtin_amdgcn_readfirstlane((int)(threadIdx.x >> 6));
    if (wv == 0 && lane_id() < 4) misc[lane_id()] = 0u;
    __syncthreads();
    const int lo = P.ph_lo, hi = P.ph_hi;
    XcdBarrier bar; bar.bar = (unsigned*)(P.ws + WS_CTL) + CW_BAR; bar.x = 0; bar.st = misc;
    if (hi - lo > 1) bar = xcd_barrier_post((unsigned*)(P.ws + WS_CTL) + CW_BAR, misc, wv * 64 + lane_id());
#define IN(k) ph_in(lo, hi, (k))
#define SEAM(k) do { if (IN((k) + 1)) grid_barrier((const void*)bar.bar, bar.x, wv); } while (0)
    if (IN(0)) { ph_prologue(kp, wv); SEAM(0); }
#define LAYER_COMMON(l, pb) \
    if (IN((pb) + 0)) { ph_norm1(kp, wv, (l)); SEAM((pb) + 0); } \
    if (IN((pb) + 1)) { for (int rep = 0; rep < REP_GEMM; ++rep) ph_gemm_win(kp, wv, (l)); SEAM((pb) + 1); } \
    if (IN((pb) + 2)) { for (int rep = 0; rep < REP_PP; ++rep) ph_rw_prep(kp, wv, (l)); ph_conv(kp, wv, (l)); for (int rep = 0; rep < REP_NA; ++rep) ph_na(kp, wv, (l)); SEAM((pb) + 2); } \
    if (IN((pb) + 3)) { for (int rep = 0; rep < REP_SCAN; ++rep) ph_scan(kp, wv); SEAM((pb) + 3); } \
    if (IN((pb) + 4)) { for (int rep = 0; rep < REP_PP; ++rep) ph_rw_post(kp, wv, (l)); SEAM((pb) + 4); } \
    if (IN((pb) + 5)) { ph_gemm_wout(kp, wv, (l)); SEAM((pb) + 5); }
    LAYER_COMMON(0, PH_L0)
    if (IN(PH_L0 + 6)) { ph_norm2_l0(kp, wv); SEAM(PH_L0 + 6); }
    if (IN(PH_L0 + 7)) { for (int rep = 0; rep < REP_GEMM; ++rep) ph_gemm_ffn_gu(kp, wv); SEAM(PH_L0 + 7); }
    if (IN(PH_L0 + 8)) { ph_gemm_ffn_dn(kp, wv); SEAM(PH_L0 + 8); }
    LAYER_COMMON(1, PH_L1)
    if (IN(PH_L1 + 6)) { ph_norm2_l1(kp, wv); SEAM(PH_L1 + 6); }
    if (IN(PH_L1 + 7)) { ph_moe_prep(kp, wv); SEAM(PH_L1 + 7); }
#pragma unroll 1
    for (int pass = 0; pass < 2; ++pass) {
        if (IN(PH_L1 + 8 + 2 * pass)) { for (int rep = 0; rep < REP_GEMM; ++rep) ph_gemm_moe_gu(kp, wv, pass); SEAM(PH_L1 + 8 + 2 * pass); }
        if (IN(PH_L1 + 9 + 2 * pass)) { ph_gemm_moe_dn(kp, wv, pass); SEAM(PH_L1 + 9 + 2 * pass); }
    }
#undef LAYER_COMMON
    if (IN(PH_FINAL)) ph_final(kp, wv);
#undef IN
#undef SEAM
}

extern "C" void kernel_launch(void* const* d_in, const int* in_sizes, int n_in, void* d_out, int out_size, void* d_ws, size_t ws_size, hipStream_t stream) {
    static int grid = 0;
    if (grid == 0) {
        if (n_in != 35 || out_size != NLAT * D || ws_size < WS_END) { fprintf(stderr, "kernel_launch: unexpected shapes (n_in %d out %d ws %zu need %zu)\n", n_in, out_size, ws_size, (size_t)WS_END); grid = -1; return; }
        int dev = 0, cus = 0, per_cu = 0;
        if (hipGetDevice(&dev) != hipSuccess || hipDeviceGetAttribute(&cus, hipDeviceAttributeMultiprocessorCount, dev) != hipSuccess) { grid = -1; return; }
        if (hipFuncSetAttribute((const void*)mk_fwd, hipFuncAttributeMaxDynamicSharedMemorySize, LDS_BYTES) != hipSuccess) { fprintf(stderr, "kernel_launch: hipFuncSetAttribute failed\n"); grid = -1; return; }
        if (hipOccupancyMaxActiveBlocksPerMultiprocessor(&per_cu, (const void*)mk_fwd, NTHREADS, LDS_BYTES) != hipSuccess || per_cu < 1) { fprintf(stderr, "kernel_launch: occupancy query says %d\n", per_cu); (void)hipGetLastError(); }
        grid = cus;
    }
    if (grid < 0) return;
    (void)hipMemsetAsync((char*)d_ws + WS_CTL, 0, CTL_BYTES, stream);
    Params p{};
    for (int i = 0; i < 35; ++i) p.in[i] = (const float*)d_in[i];
    p.out = (float*)d_out; p.ws = (unsigned char*)d_ws;
#if MK_ONE_LAUNCH
    p.ph_lo = 0; p.ph_hi = N_PHASES;
    hipLaunchKernelGGL(mk_fwd, dim3(grid), dim3(NTHREADS), LDS_BYTES, stream, p);
#else
    for (int k = 0; k < N_PHASES && k <= MK_LAST; ++k) { p.ph_lo = k; p.ph_hi = k + 1; hipLaunchKernelGGL(mk_fwd, dim3(grid), dim3(NTHREADS), LDS_BYTES, stream, p); }
#endif
}
```

```cpp
#include <hip/hip_runtime.h>
#include <stdint.h>
#include <stdio.h>

#ifndef MK_MASK
#define MK_MASK 0xFFFFFFFFu
#endif
#define MKB(k) (((MK_MASK) >> (k)) & 1u)
#ifndef REP_SCAN
#define REP_SCAN 1
#endif
#ifndef REP_NA
#define REP_NA 1
#endif
#ifndef REP_GEMM
#define REP_GEMM 1
#endif
#ifndef REP_PP
#define REP_PP 1
#endif
#ifndef REP_CONV
#define REP_CONV 1
#endif
#ifndef REP_NORM
#define REP_NORM 1
#endif
#ifndef REP_PRO
#define REP_PRO 1
#endif
#ifndef MK_LAST
#define MK_LAST 99
#endif
#ifndef MK_ONE_LAUNCH
#define MK_ONE_LAUNCH 1
#endif

#define LAS __attribute__((address_space(3)))
typedef unsigned short bf16_t;
typedef _Float16 f16_t;
typedef short bf16x8 __attribute__((ext_vector_type(8)));
typedef float f32x4 __attribute__((ext_vector_type(4)));
typedef float f32x2 __attribute__((ext_vector_type(2)));
typedef unsigned u32x4 __attribute__((ext_vector_type(4)));
typedef unsigned u32x2 __attribute__((ext_vector_type(2)));
typedef f16_t f16x4 __attribute__((ext_vector_type(4)));
typedef f16_t f16x8 __attribute__((ext_vector_type(8)));
typedef short v4i16_t __attribute__((ext_vector_type(4)));

constexpr int D = 1024, NB = 8, SEQ = 4096, CTXL = 256, TT = CTXL + SEQ;
constexpr int NLAT = NB * SEQ, NCTX = NB * CTXL, NROW = NLAT + NCTX;
constexpr int INW = 3328, DFF = 2816, DFE = 3584, NEXP = 8;
constexpr int O_Q = 0, O_K = 512, O_V = 1024, O_RW = 1536, O_CV = 2816;
constexpr int MODW = 6 * D;
constexpr int NTHREADS = 512, NWAVES = 8;
constexpr int LDS_BYTES = 160 * 1024;
constexpr int LDS_MISC = LDS_BYTES - 256;

constexpr size_t al256(size_t x) { return (x + 255) & ~(size_t)255; }
constexpr size_t WS_CTL   = 0;
constexpr size_t CTL_BYTES = 65536;
constexpr size_t WS_MODV  = WS_CTL + CTL_BYTES;
constexpr size_t WS_BTIN  = al256(WS_MODV + (size_t)2 * 9 * MODW * 4);
constexpr size_t WS_BTOUT = al256(WS_BTIN + (size_t)2 * INW * D * 2);
constexpr size_t WS_BTGU  = al256(WS_BTOUT + (size_t)2 * D * D * 2);
constexpr size_t WS_BTDN  = al256(WS_BTGU + (size_t)2 * DFF * D * 2);
constexpr size_t WS_LORA  = al256(WS_BTDN + (size_t)D * DFF * 2);
constexpr size_t LORA_LD_BYTES = (size_t)(256 * 64 * 2 + 256 * 128) * 2;
constexpr size_t WS_MOE   = al256(WS_LORA + 4 * LORA_LD_BYTES);
constexpr size_t MOE_GU_BYTES = (size_t)2 * DFE * D * 2, MOE_DN_BYTES = (size_t)D * DFE * 2, MOE_E_BYTES = MOE_GU_BYTES + MOE_DN_BYTES;
constexpr size_t WS_SH    = WS_MOE;
constexpr size_t SH_BYTES = (size_t)NB * 4 * TT * 192 * 2;
constexpr size_t WS_SD    = WS_SH + SH_BYTES;
constexpr size_t WS_XC    = al256(WS_MOE + (size_t)NEXP * MOE_E_BYTES);
constexpr size_t WS_HL    = al256(WS_XC + (size_t)NCTX * D * 4);
constexpr size_t WS_Y     = WS_HL;
constexpr size_t WS_PL    = al256(WS_HL + (size_t)NROW * D * 2);
constexpr size_t WS_MIX   = al256(WS_PL + (size_t)NROW * INW * 2);
constexpr size_t WS_H     = WS_PL;
constexpr size_t WS_ROUTE = al256(WS_MIX + (size_t)NROW * D * 2);
constexpr size_t RT_TOKE  = 0;
constexpr size_t RT_TOKG  = RT_TOKE + (size_t)NLAT * 2 * 4;
constexpr size_t RT_TOKP  = RT_TOKG + (size_t)NLAT * 2 * 4;
constexpr size_t RT_RMAP  = RT_TOKP + (size_t)NLAT * 2 * 4;
constexpr size_t RT_SGATE = RT_RMAP + (size_t)2 * NROW * 4;
constexpr size_t WS_END   = al256(WS_ROUTE + RT_SGATE + (size_t)2 * NROW * 4);
static_assert(SH_BYTES * 3 <= (size_t)NEXP * MOE_E_BYTES, "scan inputs must fit the MoE weight region");
static_assert((size_t)NROW * DFE * 2 <= (size_t)NROW * INW * 2 + (size_t)NROW * D * 2, "H must fit PL+MIX");

constexpr int CW_BAR = 0;
constexpr int CW_MOECNT = 4096;

#define XB_TMO      128
#define XB_XCNT(j)  (256  + 64 * (j))
#define XB_XSUB(j)  (1280 + 64 * (j))
#define XB_XGEN(j)  (2304 + 64 * (j))
#define XB_TOP      3328
#define XB_TOPGEN   3392
#define XCD_BAR_WORDS 3456
#define XB_SPIN_CAP (1u << 22)

__device__ __forceinline__ unsigned xb_ld(unsigned* p)              { return __hip_atomic_load(p, __ATOMIC_RELAXED, __HIP_MEMORY_SCOPE_AGENT); }
__device__ __forceinline__ unsigned xb_add(unsigned* p, unsigned v) { return __hip_atomic_fetch_add(p, v, __ATOMIC_RELAXED, __HIP_MEMORY_SCOPE_AGENT); }
__device__ __forceinline__ unsigned xb_xcc_id() { return (unsigned)__builtin_amdgcn_s_getreg((3 << 11) | 20) & 0xFu; }
#define XB_SPIN(cond, bar) do { unsigned _sp = 0; while (cond) { __builtin_amdgcn_s_sleep(1); \
    if ((++_sp & 255u) == 0u) { if (xb_ld(&(bar)[XB_TMO])) break; if (_sp > XB_SPIN_CAP) { atomicAdd(&(bar)[XB_TMO], 1u); break; } } } } while (0)

struct XcdBarrier { unsigned* bar; unsigned x; volatile LAS unsigned* st; };

__device__ __forceinline__ XcdBarrier xcd_barrier_post(unsigned* bar, volatile LAS unsigned* st, int tid) {
    XcdBarrier b; b.bar = bar; b.x = xb_xcc_id(); b.st = st;
    if (tid == 0) (void)xb_add(&bar[XB_XCNT(b.x)], 1u);
    return b;
}
__device__ __forceinline__ void xcd_barrier_complete(unsigned* bar, unsigned x, unsigned& nloc, unsigned& nx) {
    const unsigned G = gridDim.x * gridDim.y * gridDim.z;
    unsigned sum, cnt, mine, sp = 0u;
    for (;;) {
        sum = 0u; cnt = 0u; mine = 0u;
#pragma unroll
        for (unsigned j = 0; j < 16; ++j) { const unsigned c = xb_ld(&bar[XB_XCNT(j)]); sum += c; cnt += (c > 0u) ? 1u : 0u; mine = (j == x) ? c : mine; }
        if (sum == G) break;
        __builtin_amdgcn_s_sleep(1);
        if ((++sp & 255u) == 0u) { if (xb_ld(&bar[XB_TMO])) break; if (sp > XB_SPIN_CAP) { atomicAdd(&bar[XB_TMO], 1u); break; } }
    }
    nloc = mine > 0u ? mine : 1u; nx = cnt > 0u ? cnt : 1u;
}
__device__ __forceinline__ void xcd_barrier(const XcdBarrier& b, int tid) {
    asm volatile("s_waitcnt vmcnt(0)" ::: "memory");
    __syncthreads();
    if (tid == 0) {
        unsigned* bar = b.bar;
        __builtin_amdgcn_s_waitcnt(0);
        unsigned nloc = b.st[0], nx = b.st[1];
        if (nloc == 0u) { xcd_barrier_complete(bar, b.x, nloc, nx); b.st[0] = nloc; b.st[1] = nx; }
        const unsigned old = xb_add(&bar[XB_XSUB(b.x)], 1u);
        const unsigned gen = old / nloc;
        if (old + 1u == (gen + 1u) * nloc) {
            __builtin_amdgcn_fence(__ATOMIC_RELEASE, "agent");
            asm volatile("s_waitcnt vmcnt(0)" ::: "memory");
            const unsigned og = xb_add(&bar[XB_TOP], 1u);
            const unsigned tg = og / nx;
            if (og + 1u == (tg + 1u) * nx) xb_add(&bar[XB_TOPGEN], 1u);
            else XB_SPIN(xb_ld(&bar[XB_TOPGEN]) == tg, bar);
            __builtin_amdgcn_fence(__ATOMIC_ACQUIRE, "agent");
            xb_add(&bar[XB_XGEN(b.x)], 1u);
            asm volatile("s_waitcnt vmcnt(0)" ::: "memory");
        } else {
            XB_SPIN(xb_ld(&bar[XB_XGEN(b.x)]) == gen, bar);
            __builtin_amdgcn_fence(__ATOMIC_ACQUIRE, "agent");
            asm volatile("s_waitcnt vmcnt(0)" ::: "memory");
        }
    }
    __syncthreads();
}

__device__ __forceinline__ int lane_id() { return (int)__builtin_amdgcn_mbcnt_hi(~0u, __builtin_amdgcn_mbcnt_lo(~0u, 0u)); }
__device__ __forceinline__ float bf2f(bf16_t b) { return __uint_as_float(((unsigned)b) << 16); }
__device__ __forceinline__ bf16_t f2bf(float f) { unsigned u = __float_as_uint(f); u += 0x7FFFu + ((u >> 16) & 1u); return (bf16_t)(u >> 16); }
__device__ __forceinline__ unsigned pk_bf16(float lo, float hi) { return (unsigned)f2bf(lo) | ((unsigned)f2bf(hi) << 16); }
typedef __bf16 bf16x2_t __attribute__((ext_vector_type(2)));
__device__ __forceinline__ unsigned cvt_pk_bf16(float lo, float hi) { return __builtin_bit_cast(unsigned, __builtin_convertvector((f32x2){lo, hi}, bf16x2_t)); }
__device__ __forceinline__ float sigmoidf_(float x) { return 1.0f / (1.0f + __expf(-x)); }
__device__ __forceinline__ float siluf_(float x) { return x / (1.0f + __expf(-x)); }
__device__ __forceinline__ float wave_sum(float v) {
#pragma unroll
    for (int o = 32; o >= 1; o >>= 1) v += __shfl_xor(v, o);
    return v;
}
__device__ __forceinline__ float sum16(float v) {
    v += __shfl_xor(v, 1); v += __shfl_xor(v, 2); v += __shfl_xor(v, 4); v += __shfl_xor(v, 8); return v;
}
__device__ __forceinline__ void unpack4(u32x2 w, float (&f)[4]) {
    f[0] = __uint_as_float(w.x << 16); f[1] = __uint_as_float(w.x & 0xffff0000u); f[2] = __uint_as_float(w.y << 16); f[3] = __uint_as_float(w.y & 0xffff0000u);
}
__device__ __forceinline__ void unpack8(u32x4 w, float* f) {
    f[0] = __uint_as_float(w.x << 16); f[1] = __uint_as_float(w.x & 0xffff0000u); f[2] = __uint_as_float(w.y << 16); f[3] = __uint_as_float(w.y & 0xffff0000u);
    f[4] = __uint_as_float(w.z << 16); f[5] = __uint_as_float(w.z & 0xffff0000u); f[6] = __uint_as_float(w.w << 16); f[7] = __uint_as_float(w.w & 0xffff0000u);
}

struct Params {
    const float* in[35];
    float* out; unsigned char* ws;
    int ph_lo, ph_hi;
};
enum { I_X = 0, I_C, I_CTX, I_CCTX, I_N1G, I_N2G, I_MODW, I_MODB, I_WIN, I_WOUT, I_RPB, I_MUP, I_MUN, I_W0, I_W2, I_A0, I_A2, I_G2, I_KK, I_KA, I_RK, I_GNG, I_GNB,
       I_DWW, I_DWB, I_LNG, I_LNB, I_FG, I_FU, I_FD, I_ROUTER, I_MG, I_MU, I_MD, I_FINALG };

__device__ __forceinline__ int row_mi(int r) { return r < NLAT ? (r >> 12) : 8; }

namespace pg8 {
constexpr int BM = 256, BK = 64, HALF = 128, HTB = HALF * BK * 2, STAGE_BYTES = 8 * HTB, NXCD = 8, WGM = 8;
__device__ __forceinline__ int lds_byte(int r, int c) { const int st = (r >> 4) * 2 + (c >> 5), rr = r & 15, cc = c & 31, ob = rr * 64 + cc * 2; return st * 1024 + (ob ^ (((ob >> 9) & 1) << 5)); }
__device__ __forceinline__ void stage_rc(int b, int& R, int& C) { const int st = b / 1024, sb = b % 1024, swz = sb ^ (((sb >> 9) & 1) << 5); R = (st >> 1) * 16 + swz / 64; C = (st & 1) * 32 + (swz % 64) / 2; }
__device__ __forceinline__ int perm32(int rho) { const int n = rho >> 4, i = rho & 15; return 8 * (i >> 2) + 4 * n + (i & 3); }
struct Unit { int pm, pn; };

struct TileOrder {
    int nM, nN, nwg, G, c;
    __device__ void init(int nM_, int nN_, int G_, int c_) { nM = nM_; nN = nN_; nwg = nM * nN; G = G_; c = c_; }
    __device__ bool next(int i, Unit& u) const {
        const long L = (long)i * G + c; if (L >= nwg) return false;
        int wgid = (int)L; { const int q = nwg / NXCD, r = nwg % NXCD, xcd = wgid % NXCD, off = wgid / NXCD; wgid = (xcd < r ? xcd * (q + 1) : r * (q + 1) + (xcd - r) * q) + off; }
        const int nig = WGM * nN, gid = wgid / nig, fm = gid * WGM, gsz = (nM - fm) < WGM ? (nM - fm) : WGM;
        u.pm = fm + ((wgid % nig) % gsz); u.pn = (wgid % nig) / gsz; return true;
    }
};
struct DenseSched : TileOrder {
    const bf16_t* A; const bf16_t* Bt; int K;
    __device__ __forceinline__ const char* aptr(const Unit& u) const { return (const char*)A + (size_t)u.pm * BM * K * 2; }
    __device__ __forceinline__ const char* bptr(const Unit& u) const { return (const char*)Bt + (size_t)u.pn * BM * K * 2; }
    __device__ __forceinline__ const char* abase() const { return (const char*)A; }
    __device__ __forceinline__ int arow(const Unit&, int) const { return 0; }
};
struct MoeSched : TileOrder {
    const bf16_t* A; const unsigned char* Bt0; size_t e_stride; int K; const int* rowmap; int tstart[9];
    __device__ __forceinline__ int expert(int pm) const { int e = 0;
#pragma unroll
        for (int j = 1; j < 8; ++j) e += (pm >= tstart[j]) ? 1 : 0;
        return e; }
    __device__ __forceinline__ const char* aptr(const Unit& u) const { return (const char*)A + (size_t)u.pm * BM * K * 2; }
    __device__ __forceinline__ const char* bptr(const Unit& u) const { return (const char*)Bt0 + (size_t)expert(u.pm) * e_stride + (size_t)u.pn * BM * K * 2; }
    __device__ __forceinline__ const char* abase() const { return (const char*)A; }
    __device__ __forceinline__ int arow(const Unit& u, int r) const { const int t = rowmap[u.pm * BM + r]; return t < 0 ? 0 : t; }
};

struct EpiBf16 {
    static constexpr bool PERM = true;
    bf16_t* O; int ldc; int nscale; float scale;
    __device__ __forceinline__ void operator()(const f32x4 (&acc)[2][2][4][2], const Unit& u, int wr, int wc, int fr, int fq) const {
        const int row0 = u.pm * BM + wr * 64 + fr, col0 = u.pn * BM + wc * 32 + 8 * fq;
        const float s = u.pn < nscale ? scale : 1.0f;
#pragma unroll
        for (int ai = 0; ai < 2; ++ai)
#pragma unroll
            for (int m = 0; m < 4; ++m) { bf16_t* rowp = O + (size_t)(row0 + ai * HALF + m * 16) * ldc + col0;
#pragma unroll
                for (int bj = 0; bj < 2; ++bj) { const f32x4 v0 = acc[ai][bj][m][0] * s, v1 = acc[ai][bj][m][1] * s;
                    u32x4 w; w.x = cvt_pk_bf16(v0[0], v0[1]); w.y = cvt_pk_bf16(v0[2], v0[3]); w.z = cvt_pk_bf16(v1[0], v1[1]); w.w = cvt_pk_bf16(v1[2], v1[3]);
                    *(u32x4*)(rowp + bj * HALF) = w; } }
    }
};
struct EpiSwiGLU {
    static constexpr bool PERM = true;
    bf16_t* H; int ldh;
    __device__ __forceinline__ void operator()(const f32x4 (&acc)[2][2][4][2], const Unit& u, int wr, int wc, int fr, int fq) const {
        const int row0 = u.pm * BM + wr * 64 + fr, col0 = u.pn * HALF + wc * 32 + 8 * fq;
#pragma unroll
        for (int ai = 0; ai < 2; ++ai)
#pragma unroll
            for (int m = 0; m < 4; ++m) { bf16_t* rowp = H + (size_t)(row0 + ai * HALF + m * 16) * ldh + col0;
                float h[8];
#pragma unroll
                for (int n = 0; n < 2; ++n)
#pragma unroll
                    for (int j = 0; j < 4; ++j) { const float g = acc[ai][0][m][n][j], up = acc[ai][1][m][n][j]; h[n * 4 + j] = g / (1.0f + __expf(-g)) * up; }
                u32x4 w; w.x = cvt_pk_bf16(h[0], h[1]); w.y = cvt_pk_bf16(h[2], h[3]); w.z = cvt_pk_bf16(h[4], h[5]); w.w = cvt_pk_bf16(h[6], h[7]);
                *(u32x4*)rowp = w; }
    }
};
struct EpiRes {
    static constexpr bool PERM = false;
    const float* resL; const float* resC; float* outL; float* outC; const float* gvec;
    __device__ __forceinline__ void operator()(const f32x4 (&acc)[2][2][4][2], const Unit& u, int wr, int wc, int fr, int fq) const {
        const int r0 = u.pm * BM; const bool lat = r0 < NLAT;
        const float* res = lat ? resL + (size_t)r0 * D : resC + (size_t)(r0 - NLAT) * D;
        float* out = lat ? outL + (size_t)r0 * D : outC + (size_t)(r0 - NLAT) * D;
        const float* gv = gvec + (size_t)(lat ? (r0 >> 12) : 8) * MODW;
        const int rl = wr * 64 + fr, col0 = u.pn * BM + wc * 32 + 4 * fq;
        f32x4 g[2][2];
#pragma unroll
        for (int bj = 0; bj < 2; ++bj)
#pragma unroll
            for (int n = 0; n < 2; ++n) g[bj][n] = *(const f32x4*)(gv + col0 + bj * HALF + n * 16);
#pragma unroll
        for (int ai = 0; ai < 2; ++ai)
#pragma unroll
            for (int m = 0; m < 4; ++m) { const size_t off = (size_t)(rl + ai * HALF + m * 16) * D + col0;
#pragma unroll
                for (int bj = 0; bj < 2; ++bj)
#pragma unroll
                    for (int n = 0; n < 2; ++n) { const f32x4 rv = *(const f32x4*)(res + off + bj * HALF + n * 16);
                        *(f32x4*)(out + off + bj * HALF + n * 16) = rv + g[bj][n] * acc[ai][bj][m][n]; } }
    }
};
struct EpiMoeDown {
    static constexpr bool PERM = false;
    float* xl; const float* gvec; const int* rowmap; const float* sgate;
    __device__ __forceinline__ void operator()(const f32x4 (&acc)[2][2][4][2], const Unit& u, int wr, int wc, int fr, int fq) const {
        const int rl = u.pm * BM + wr * 64 + fr, col0 = u.pn * BM + wc * 32 + 4 * fq;
#pragma unroll
        for (int ai = 0; ai < 2; ++ai)
#pragma unroll
            for (int m = 0; m < 4; ++m) { const int slot = rl + ai * HALF + m * 16; const int tok = rowmap[slot];
                if (tok >= 0) { const float sg = sgate[slot]; const float* gv = gvec + (size_t)(tok >> 12) * MODW + col0; float* xp = xl + (size_t)tok * D + col0;
#pragma unroll
                    for (int bj = 0; bj < 2; ++bj)
#pragma unroll
                        for (int n = 0; n < 2; ++n) { const f32x4 g = *(const f32x4*)(gv + bj * HALF + n * 16); const f32x4 rv = *(const f32x4*)(xp + bj * HALF + n * 16);
                            *(f32x4*)(xp + bj * HALF + n * 16) = rv + (g * sg) * acc[ai][bj][m][n]; } } }
    }
};

template <class Epi, class Sched, bool GATHER>
__device__ __forceinline__ void gemm_phase(LAS unsigned char* lds, const int K, const Sched& S, const Epi& E, const int wave_) {
    int tid_ = wave_ * 64 + lane_id(); asm volatile("" : "+v"(tid_));
    const int tid = tid_, wid = wave_, lane = tid & 63, wr = wid >> 2, wc = wid & 3, fr = lane & 15, fq = lane >> 4;
    const int nt = K / BK;
    unsigned voffA[2], voffB[2]; int RA[2], CA[2];
#pragma unroll
    for (int i = 0; i < 2; ++i) { int R, C; stage_rc(tid * 16 + i * 8192, R, C); const int Rb = Epi::PERM ? ((R & ~31) + perm32(R & 31)) : R;
        voffA[i] = (unsigned)(R * K + C) * 2u; voffB[i] = (unsigned)(Rb * K + C) * 2u; RA[i] = R; CA[i] = C; }
    const size_t kstep = (size_t)(BK * 2);
    const size_t hstep = (size_t)HALF * K * 2;
    const unsigned ldsw = (unsigned)wid * 1024u;
    const int aoff = lds_byte(wr * 64 + fr, fq * 8), boff = lds_byte(wc * 32 + fr, fq * 8);
#define PG8_SA(b, h) (((b) * 2 + (h)) * HTB)
#define PG8_SB(b, h) ((4 + (b) * 2 + (h)) * HTB)
#define PG8_STAGE(bufoff, gbase, voff) do { _Pragma("unroll") for (int _i = 0; _i < 2; ++_i) \
        __builtin_amdgcn_global_load_lds((const unsigned*)((const char*)(gbase) + (voff)[_i]), (LAS unsigned*)(lds + (bufoff) + ldsw + _i * 8192), 16, 0, 0); } while (0)
#define PG8_LDA(dst, b, h) do { _Pragma("unroll") for (int m = 0; m < 4; ++m) _Pragma("unroll") for (int k = 0; k < 2; ++k) dst[m][k] = *(const LAS bf16x8*)(lds + PG8_SA(b, h) + aoff + m * 2048 + k * 1024); } while (0)
#define PG8_LDB(dst, b, h) do { _Pragma("unroll") for (int n = 0; n < 2; ++n) _Pragma("unroll") for (int k = 0; k < 2; ++k) dst[n][k] = *(const LAS bf16x8*)(lds + PG8_SB(b, h) + boff + n * 2048 + k * 1024); } while (0)
#define PG8_MMA(ai, bj, At, Bt) do { __builtin_amdgcn_s_setprio(1); _Pragma("unroll") for (int m = 0; m < 4; ++m) _Pragma("unroll") for (int n = 0; n < 2; ++n) _Pragma("unroll") for (int k = 0; k < 2; ++k) \
        acc[ai][bj][m][n] = __builtin_amdgcn_mfma_f32_16x16x32_bf16(Bt[n][k], At[m][k], acc[ai][bj][m][n], 0, 0, 0); __builtin_amdgcn_s_setprio(0); } while (0)
#define PG8_WAIT_V(n) asm volatile("s_waitcnt vmcnt(" #n ")" ::: "memory")
#define PG8_WAIT_L(n) asm volatile("s_waitcnt lgkmcnt(" #n ")" ::: "memory")
#define PG8_BAR __builtin_amdgcn_s_barrier()
#define PG8_SCHED __builtin_amdgcn_sched_barrier(0)
#define PG8_STAGE_A(bufoff, TS, H) do { if constexpr (GATHER) { PG8_STAGE(bufoff, gA##TS, oA##TS[H]); } else { PG8_STAGE(bufoff, a##TS + (H) * hstep, voffA); } } while (0)
    Unit cur, nxt; int ui = 0;
    if (!S.next(0, cur)) return;
    f32x4 acc[2][2][4][2];
#pragma unroll
    for (int a = 0; a < 2; ++a)
#pragma unroll
        for (int b = 0; b < 2; ++b)
#pragma unroll
            for (int m = 0; m < 4; ++m)
#pragma unroll
                for (int n = 0; n < 2; ++n) acc[a][b][m][n] = (f32x4){0.f, 0.f, 0.f, 0.f};
    bf16x8 At[4][2], B0[2][2], B1[2][2];
    const char* Abase = S.abase();
    unsigned aoC[2][2] = {{0u, 0u}, {0u, 0u}}, aoN[2][2] = {{0u, 0u}, {0u, 0u}};
    if constexpr (GATHER) {
#pragma unroll
        for (int h = 0; h < 2; ++h)
#pragma unroll
            for (int i = 0; i < 2; ++i) aoC[h][i] = (unsigned)(S.arow(cur, h * HALF + RA[i]) * K + CA[i]) * 2u;
    }
    const char* cA = GATHER ? Abase : S.aptr(cur); const char* cB = S.bptr(cur);
    if constexpr (GATHER) {
        PG8_STAGE(PG8_SB(0, 0), cB, voffB); PG8_STAGE(PG8_SA(0, 0), Abase, aoC[0]); PG8_STAGE(PG8_SB(0, 1), cB + hstep, voffB); PG8_STAGE(PG8_SA(0, 1), Abase, aoC[1]);
    } else {
        PG8_STAGE(PG8_SB(0, 0), cB, voffB); PG8_STAGE(PG8_SA(0, 0), cA, voffA); PG8_STAGE(PG8_SB(0, 1), cB + hstep, voffB); PG8_STAGE(PG8_SA(0, 1), cA + hstep, voffA);
    }
    if (wr == 1) PG8_BAR;
    PG8_WAIT_V(4); PG8_BAR;
    if constexpr (GATHER) {
        PG8_STAGE(PG8_SB(1, 0), cB + kstep, voffB); PG8_STAGE(PG8_SA(1, 0), Abase + kstep, aoC[0]); PG8_STAGE(PG8_SB(1, 1), cB + hstep + kstep, voffB);
    } else {
        PG8_STAGE(PG8_SB(1, 0), cB + kstep, voffB); PG8_STAGE(PG8_SA(1, 0), cA + kstep, voffA); PG8_STAGE(PG8_SB(1, 1), cB + hstep + kstep, voffB);
    }
    PG8_WAIT_V(6); PG8_BAR;
    for (;;) {
        const bool has_next = S.next(ui + 1, nxt);
        const char* nA = has_next ? (GATHER ? Abase : S.aptr(nxt)) : cA; const char* nB = has_next ? S.bptr(nxt) : cB;
        if constexpr (GATHER) {
            if (has_next) {
#pragma unroll
                for (int h = 0; h < 2; ++h)
#pragma unroll
                    for (int i = 0; i < 2; ++i) aoN[h][i] = (unsigned)(S.arow(nxt, h * HALF + RA[i]) * K + CA[i]) * 2u;
            } else {
#pragma unroll
                for (int h = 0; h < 2; ++h)
#pragma unroll
                    for (int i = 0; i < 2; ++i) aoN[h][i] = aoC[h][i];
            }
        }
        for (int t = 0; t < nt; t += 2) {
            const bool last = (t == nt - 2);
            const char* a1 = cA + (size_t)(t + 1) * kstep;
            const char* a2 = last ? nA : cA + (size_t)(t + 2) * kstep; const char* b2 = last ? nB : cB + (size_t)(t + 2) * kstep;
            const char* a3 = a2 + kstep; const char* b3 = b2 + kstep;
            const char* gA1 = Abase + (size_t)(t + 1) * kstep; const char* gA2 = Abase + (last ? (size_t)0 : (size_t)(t + 2) * kstep); const char* gA3 = gA2 + kstep;
            unsigned oA1[2][2], oA2[2][2], oA3[2][2];
#pragma unroll
            for (int h = 0; h < 2; ++h)
#pragma unroll
                for (int i = 0; i < 2; ++i) { oA1[h][i] = aoC[h][i]; oA2[h][i] = last ? aoN[h][i] : aoC[h][i]; oA3[h][i] = oA2[h][i]; }
            (void)a1; (void)a3; (void)gA1; (void)gA3; (void)oA1; (void)oA3;
            PG8_LDB(B0, 0, 0); PG8_SCHED; PG8_LDA(At, 0, 0); PG8_STAGE_A(PG8_SA(1, 1), 1, 1);
            PG8_WAIT_L(8); PG8_BAR; PG8_WAIT_L(0); PG8_MMA(0, 0, At, B0); PG8_BAR; PG8_SCHED;
            PG8_LDB(B1, 0, 1); PG8_STAGE(PG8_SB(0, 0), b2, voffB);
            PG8_BAR; PG8_WAIT_L(0); PG8_MMA(0, 1, At, B1); PG8_BAR;
            PG8_LDA(At, 0, 1); PG8_STAGE_A(PG8_SA(0, 0), 2, 0);
            PG8_BAR; PG8_WAIT_L(0); PG8_MMA(1, 0, At, B0); PG8_BAR; PG8_SCHED;
            PG8_STAGE(PG8_SB(0, 1), b2 + hstep, voffB);
            PG8_WAIT_V(6); PG8_BAR; PG8_MMA(1, 1, At, B1); PG8_BAR;
            PG8_LDB(B0, 1, 0); PG8_SCHED; PG8_LDA(At, 1, 0); PG8_STAGE_A(PG8_SA(0, 1), 2, 1);
            PG8_WAIT_L(8); PG8_BAR; PG8_WAIT_L(0); PG8_MMA(0, 0, At, B0); PG8_BAR; PG8_SCHED;
            PG8_LDB(B1, 1, 1); PG8_STAGE(PG8_SB(1, 0), b3, voffB);
            PG8_BAR; PG8_WAIT_L(0); PG8_MMA(0, 1, At, B1); PG8_BAR;
            PG8_LDA(At, 1, 1); PG8_STAGE_A(PG8_SA(1, 0), 3, 0);
            PG8_BAR; PG8_WAIT_L(0); PG8_MMA(1, 0, At, B0); PG8_BAR; PG8_SCHED;
            PG8_STAGE(PG8_SB(1, 1), b3 + hstep, voffB);
            PG8_WAIT_V(6); PG8_BAR; PG8_MMA(1, 1, At, B1); PG8_BAR;
        }
        { int t2 = tid; asm volatile("" : "+v"(t2)); const int l2 = t2 & 63; E(acc, cur, wr, wc, l2 & 15, l2 >> 4); }
        if (!has_next) break;
#pragma unroll
        for (int a = 0; a < 2; ++a)
#pragma unroll
            for (int b = 0; b < 2; ++b)
#pragma unroll
                for (int m = 0; m < 4; ++m)
#pragma unroll
                    for (int n = 0; n < 2; ++n) acc[a][b][m][n] = (f32x4){0.f, 0.f, 0.f, 0.f};
        cur = nxt; cA = nA; cB = nB; ++ui;
        if constexpr (GATHER) {
#pragma unroll
            for (int h = 0; h < 2; ++h)
#pragma unroll
                for (int i = 0; i < 2; ++i) aoC[h][i] = aoN[h][i];
        }
    }
    PG8_WAIT_V(0);
    if (wr == 0) PG8_BAR;
    PG8_BAR;
#undef PG8_SA
#undef PG8_SB
#undef PG8_STAGE
#undef PG8_STAGE_A
#undef PG8_LDA
#undef PG8_LDB
#undef PG8_MMA
#undef PG8_WAIT_V
#undef PG8_WAIT_L
#undef PG8_BAR
#undef PG8_SCHED
}
}

struct Frame {
    LAS unsigned char* lds; int tid, lane, wave, G, bid, gw, nw;
    unsigned char* ws;
};
extern __shared__ __attribute__((aligned(16))) unsigned char lds_raw[];
typedef const __attribute__((address_space(4))) Params* KP;
__device__ __forceinline__ Params load_params(const void* kp_) {
    const unsigned long long v = (unsigned long long)kp_;
    const unsigned lo = __builtin_amdgcn_readfirstlane((unsigned)v), hi = __builtin_amdgcn_readfirstlane((unsigned)(v >> 32));
    KP kp = (KP)(((unsigned long long)hi << 32) | lo);
    Params P;
#pragma unroll
    for (int i = 0; i < 35; ++i) P.in[i] = kp->in[i];
    P.out = kp->out; P.ws = kp->ws; P.ph_lo = kp->ph_lo; P.ph_hi = kp->ph_hi;
    return P;
}
#define PHASE static __attribute__((noinline)) __device__ void
#define PHASE_INL static __device__ __forceinline__ void
__device__ __forceinline__ Frame make_frame(unsigned char* ws, int wave_) {
    Frame F; F.lds = (LAS unsigned char*)lds_raw; F.wave = __builtin_amdgcn_readfirstlane(wave_);
    int t_ = F.wave * 64 + lane_id(); asm volatile("" : "+v"(t_));
    F.tid = t_; F.lane = F.tid & 63;
    F.G = gridDim.x; F.bid = blockIdx.x; F.gw = F.bid * NWAVES + F.wave; F.nw = F.G * NWAVES; F.ws = ws; return F;
}
__device__ __forceinline__ Frame sub_frame(Frame F, int bid, int G) { F.bid = bid; F.G = G; F.gw = F.bid * NWAVES + F.wave; F.nw = F.G * NWAVES; return F; }
#define PHASE_ENTER const Params P = load_params(kp_); const Frame F = make_frame(P.ws, wv_)

__device__ __forceinline__ void conv_job(const Frame& F, const float* src, bf16_t* dst, int K, int N, int mode) {
    LAS float* tile = (LAS float*)(F.lds + F.wave * (64 * 65 * 4));
    const int tk = K / 64, tn = N / 64, ntile = tk * tn, lane = F.lane;
    for (int t = F.gw; t < ntile; t += F.nw) {
        const int k0 = (t / tn) * 64, n0 = (t % tn) * 64;
#pragma unroll 4
        for (int i = 0; i < 16; ++i) { const int row = i * 4 + (lane >> 4), c4 = (lane & 15) * 4;
            const f32x4 v = *(const f32x4*)(src + (size_t)(k0 + row) * N + n0 + c4);
            tile[row * 65 + c4 + 0] = v[0]; tile[row * 65 + c4 + 1] = v[1]; tile[row * 65 + c4 + 2] = v[2]; tile[row * 65 + c4 + 3] = v[3]; }
        __builtin_amdgcn_wave_barrier(); asm volatile("s_waitcnt lgkmcnt(0)" ::: "memory");
#pragma unroll 2
        for (int i = 0; i < 8; ++i) { const int n = i * 8 + (lane >> 3), kc = (lane & 7) * 8;
            float f[8];
#pragma unroll
            for (int j = 0; j < 8; ++j) f[j] = tile[(kc + j) * 65 + n];
            const int ng = n0 + n; const int drow = mode == 0 ? ng : ((ng >> 7) * 256 + (mode == 2 ? 128 : 0) + (ng & 127));
            u32x4 w; w.x = pk_bf16(f[0], f[1]); w.y = pk_bf16(f[2], f[3]); w.z = pk_bf16(f[4], f[5]); w.w = pk_bf16(f[6], f[7]);
            *(u32x4*)(dst + (size_t)drow * K + k0 + kc) = w; }
        __builtin_amdgcn_wave_barrier(); asm volatile("s_waitcnt lgkmcnt(0)" ::: "memory");
    }
}

__device__ __forceinline__ void phase_prologue(const Frame& F, const Params& P) {
    float* modv = (float*)(F.ws + WS_MODV);
    LAS float* s = (LAS float*)F.lds;
    LAS float* red = (LAS float*)(F.lds + 9 * 1024 * 4);
    for (int cb = F.bid; cb < (2 * MODW) / 64; cb += F.G) {
        for (int i = F.tid; i < 9 * 1024; i += NTHREADS) { const int mi = i >> 10, k = i & 1023; const float c = mi < 8 ? P.in[I_C][mi * D + k] : P.in[I_CCTX][k]; s[i] = siluf_(c); }
        __syncthreads();
        const int colg = cb * 64 + F.lane, l = colg / MODW, col = colg % MODW;
        const float* w = P.in[I_MODW] + (size_t)l * D * MODW + col;
        float acc[9];
#pragma unroll
        for (int mi = 0; mi < 9; ++mi) acc[mi] = 0.f;
        const int kb = F.wave * 128;
#pragma unroll 8
        for (int k = 0; k < 128; ++k) { const float wv = w[(size_t)(kb + k) * MODW];
#pragma unroll
            for (int mi = 0; mi < 9; ++mi) acc[mi] += s[mi * 1024 + kb + k] * wv; }
#pragma unroll
        for (int mi = 0; mi < 9; ++mi) red[(F.wave * 9 + mi) * 64 + F.lane] = acc[mi];
        __syncthreads();
        for (int i = F.tid; i < 9 * 64; i += NTHREADS) { const int mi = i >> 6, ln = i & 63; float a = 0.f;
#pragma unroll
            for (int w8 = 0; w8 < 8; ++w8) a += red[(w8 * 9 + mi) * 64 + ln];
            const int cg = cb * 64 + ln, l2 = cg / MODW, c2 = cg % MODW;
            modv[((size_t)l2 * 9 + mi) * MODW + c2] = a + P.in[I_MODB][l2 * MODW + c2]; }
        __syncthreads();
    }
    for (int l = 0; l < 2; ++l) {
        conv_job(F, P.in[I_WIN] + (size_t)l * D * INW, (bf16_t*)(F.ws + WS_BTIN) + (size_t)l * INW * D, D, INW, 0);
        conv_job(F, P.in[I_WOUT] + (size_t)l * D * D, (bf16_t*)(F.ws + WS_BTOUT) + (size_t)l * D * D, D, D, 0);
    }
    conv_job(F, P.in[I_FG], (bf16_t*)(F.ws + WS_BTGU), D, DFF, 1);
    conv_job(F, P.in[I_FU], (bf16_t*)(F.ws + WS_BTGU), D, DFF, 2);
    conv_job(F, P.in[I_FD], (bf16_t*)(F.ws + WS_BTDN), DFF, D, 0);
    for (int ld = 0; ld < 4; ++ld) { bf16_t* base = (bf16_t*)(F.ws + WS_LORA + (size_t)ld * LORA_LD_BYTES);
        conv_job(F, P.in[I_W2] + (size_t)ld * 64 * 256, base, 64, 256, 0);
        conv_job(F, P.in[I_A2] + (size_t)ld * 64 * 256, base + 256 * 64, 64, 256, 0);
        conv_job(F, P.in[I_G2] + (size_t)ld * 128 * 256, base + 2 * 256 * 64, 128, 256, 0); }
}
__device__ __forceinline__ void phase_moe_convert(const Frame& F, const Params& P) {
    for (int e = 0; e < NEXP; ++e) {
        bf16_t* gu = (bf16_t*)(F.ws + WS_MOE + (size_t)e * MOE_E_BYTES); bf16_t* dn = (bf16_t*)(F.ws + WS_MOE + (size_t)e * MOE_E_BYTES + MOE_GU_BYTES);
        conv_job(F, P.in[I_MG] + (size_t)e * D * DFE, gu, D, DFE, 1);
        conv_job(F, P.in[I_MU] + (size_t)e * D * DFE, gu, D, DFE, 2);
        conv_job(F, P.in[I_MD] + (size_t)e * DFE * D, dn, DFE, D, 0);
    }
}

template <bool ROUTER>
__device__ __forceinline__ void phase_norm(const Frame& F, const Params& P, int l, int which, int nrows, const float* srcL, const float* srcC) {
    const float* g = (which == 0 ? P.in[I_N1G] : P.in[I_N2G]) + l * D;
    const float* modv = (const float*)(F.ws + WS_MODV) + (size_t)l * 9 * MODW + (which == 0 ? 0 : 3 * D);
    bf16_t* HL = (bf16_t*)(F.ws + WS_HL);
    LAS float* rt = (LAS float*)F.lds;
    if (ROUTER) {
        for (int i = F.tid; i < D * NEXP; i += NTHREADS) rt[i] = P.in[I_ROUTER][i];
        int* rmap = (int*)(F.ws + WS_ROUTE + RT_RMAP);
        for (int i = F.bid * NTHREADS + F.tid; i < 2 * NROW; i += F.G * NTHREADS) rmap[i] = -1;
        __syncthreads();
    }
    const int lane = F.lane;
    for (int r = F.gw; r < nrows; r += F.nw) {
        const float* xr = r < NLAT ? srcL + (size_t)r * D : srcC + (size_t)(r - NLAT) * D;
        const float* mv = modv + (size_t)row_mi(r) * MODW;
        f32x4 x[4]; float ss = 0.f;
#pragma unroll
        for (int j = 0; j < 4; ++j) { x[j] = *(const f32x4*)(xr + j * 256 + lane * 4); ss += x[j][0] * x[j][0] + x[j][1] * x[j][1] + x[j][2] * x[j][2] + x[j][3] * x[j][3]; }
        ss = wave_sum(ss);
        const float rstd = rsqrtf(ss * (1.0f / D) + 1e-6f);
        float lg[NEXP];
        if (ROUTER) {
#pragma unroll
            for (int e = 0; e < NEXP; ++e) lg[e] = 0.f;
        }
#pragma unroll
        for (int j = 0; j < 4; ++j) { const int c = j * 256 + lane * 4;
            const f32x4 gg = *(const f32x4*)(g + c), sh = *(const f32x4*)(mv + c), sc = *(const f32x4*)(mv + D + c);
            f32x4 y = (x[j] * rstd * gg) * (sc + 1.0f) + sh;
            u32x2 w; w.x = pk_bf16(y[0], y[1]); w.y = pk_bf16(y[2], y[3]);
            *(u32x2*)(HL + (size_t)r * D + c) = w;
            if (ROUTER) {
#pragma unroll
                for (int q = 0; q < 4; ++q) { const f32x4 r0 = *(const LAS f32x4*)(rt + (c + q) * 8), r1 = *(const LAS f32x4*)(rt + (c + q) * 8 + 4);
                    lg[0] += y[q] * r0[0]; lg[1] += y[q] * r0[1]; lg[2] += y[q] * r0[2]; lg[3] += y[q] * r0[3];
                    lg[4] += y[q] * r1[0]; lg[5] += y[q] * r1[1]; lg[6] += y[q] * r1[2]; lg[7] += y[q] * r1[3]; asm volatile("" ::: "memory"); }
            }
        }
        if (ROUTER) {
#pragma unroll
            for (int e = 0; e < NEXP; ++e) lg[e] = wave_sum(lg[e]);
            if (lane == 0) {
                int e1 = 0; float l1 = lg[0];
#pragma unroll
                for (int e = 1; e < NEXP; ++e) if (lg[e] > l1) { l1 = lg[e]; e1 = e; }
                int e2 = -1; float l2 = -3.0e38f;
#pragma unroll
                for (int e = 0; e < NEXP; ++e) if (e != e1 && lg[e] > l2) { l2 = lg[e]; e2 = e; }
                if (e2 < 0) { e2 = e1 == 0 ? 1 : 0; l2 = l1; }
                const float ex = __expf(l2 - l1), g1 = 1.0f / (1.0f + ex), g2 = ex * g1;
                unsigned* cnt = (unsigned*)(F.ws + WS_CTL) + CW_MOECNT;
                const unsigned p1 = atomicAdd(cnt + e1, 1u), p2 = atomicAdd(cnt + 8 + e2, 1u);
                int* te = (int*)(F.ws + WS_ROUTE + RT_TOKE); float* tg = (float*)(F.ws + WS_ROUTE + RT_TOKG); int* tp = (int*)(F.ws + WS_ROUTE + RT_TOKP);
                te[r * 2] = e1; te[r * 2 + 1] = e2; tg[r * 2] = g1; tg[r * 2 + 1] = g2; tp[r * 2] = (int)p1; tp[r * 2 + 1] = (int)p2;
            }
        }
    }
}
__device__ __forceinline__ void moe_tstart(const Frame& F, int pass, int (&ts)[9]) {
    const unsigned* cnt = (const unsigned*)(F.ws + WS_CTL) + CW_MOECNT + pass * 8;
    int a = 0;
#pragma unroll
    for (int e = 0; e < 8; ++e) { ts[e] = a; a += (int)((__hip_atomic_load(cnt + e, __ATOMIC_RELAXED, __HIP_MEMORY_SCOPE_AGENT) + 255u) >> 8); }
    ts[8] = a;
}
__device__ __forceinline__ void phase_moe_rowmap(const Frame& F) {
    int ts0[9], ts1[9]; moe_tstart(F, 0, ts0); moe_tstart(F, 1, ts1);
    const int* te = (const int*)(F.ws + WS_ROUTE + RT_TOKE); const float* tg = (const float*)(F.ws + WS_ROUTE + RT_TOKG); const int* tp = (const int*)(F.ws + WS_ROUTE + RT_TOKP);
    int* rmap = (int*)(F.ws + WS_ROUTE + RT_RMAP); float* sg = (float*)(F.ws + WS_ROUTE + RT_SGATE);
    for (int t = F.bid * NTHREADS + F.tid; t < NLAT; t += F.G * NTHREADS) {
        { const int e = te[t * 2]; int st = 0;
#pragma unroll
          for (int j = 0; j < 8; ++j) st = (e == j) ? ts0[j] : st;
          const int slot = st * 256 + tp[t * 2]; rmap[slot] = t; sg[slot] = tg[t * 2]; }
        { const int e = te[t * 2 + 1]; int st = 0;
#pragma unroll
          for (int j = 0; j < 8; ++j) st = (e == j) ? ts1[j] : st;
          const int slot = st * 256 + tp[t * 2 + 1]; rmap[NROW + slot] = t; sg[NROW + slot] = tg[t * 2 + 1]; }
    }
}

struct RowGeo { int b, tt, pos, len; };
__device__ __forceinline__ RowGeo row_geo(int r) { RowGeo g; if (r < NLAT) { g.b = r >> 12; g.pos = r & 4095; g.len = SEQ; g.tt = CTXL + g.pos; } else { const int q = r - NLAT; g.b = q >> 8; g.pos = q & 255; g.len = CTXL; g.tt = g.pos; } return g; }

__device__ __forceinline__ void rw_shift4(const bf16_t* PL, const float* mup, const float* mun, int r, const RowGeo& g, int j, float (&u)[4]) {
    const bf16_t* p = PL + (size_t)r * INW + O_RW + j;
    const bool hp = g.pos > 0, hn = g.pos < g.len - 1;
    float c[4], pv[4], nv[4];
    unpack4(*(const u32x2*)p, c); unpack4(*(const u32x2*)(p - (hp ? INW : 0)), pv); unpack4(*(const u32x2*)(p + (hn ? INW : 0)), nv);
    const f32x4 mp = *(const f32x4*)(mup + j), mn = *(const f32x4*)(mun + j);
#pragma unroll
    for (int q = 0; q < 4; ++q) u[q] = c[q] + mp[q] * ((hp ? pv[q] : 0.f) - c[q]) + mn[q] * ((hn ? nv[q] : 0.f) - c[q]);
}

__device__ __forceinline__ void rw_shift8(const bf16_t* PL, const float* mup, const float* mun, int r, const RowGeo& g, int j, float (&u)[8]) {
    const bf16_t* p = PL + (size_t)r * INW + O_RW + j;
    const bool hp = g.pos > 0, hn = g.pos < g.len - 1;
    float c[8], pv[8], nv[8];
    unpack8(*(const u32x4*)p, c); unpack8(*(const u32x4*)(p - (hp ? INW : 0)), pv); unpack8(*(const u32x4*)(p + (hn ? INW : 0)), nv);
    const f32x4 mp0 = *(const f32x4*)(mup + j), mp1 = *(const f32x4*)(mup + j + 4), mn0 = *(const f32x4*)(mun + j), mn1 = *(const f32x4*)(mun + j + 4);
#pragma unroll
    for (int q = 0; q < 4; ++q) { u[q] = c[q] + mp0[q] * ((hp ? pv[q] : 0.f) - c[q]) + mn0[q] * ((hn ? nv[q] : 0.f) - c[q]);
        u[4 + q] = c[4 + q] + mp1[q] * ((hp ? pv[4 + q] : 0.f) - c[4 + q]) + mn1[q] * ((hn ? nv[4 + q] : 0.f) - c[4 + q]); }
}
__device__ __forceinline__ bf16x8 pack8f(const float (&f)[8]) {
    u32x4 w; w.x = cvt_pk_bf16(f[0], f[1]); w.y = cvt_pk_bf16(f[2], f[3]); w.z = cvt_pk_bf16(f[4], f[5]); w.w = cvt_pk_bf16(f[6], f[7]); return __builtin_bit_cast(bf16x8, w);
}
__device__ __forceinline__ void phase_rw_prep(const Frame& F, const Params& P, int l) {
    const bf16_t* PL = (const bf16_t*)(F.ws + WS_PL);
    const float* mup = P.in[I_MUP] + l * 1280; const float* mun = P.in[I_MUN] + l * 1280;
    f16_t* SH = (f16_t*)(F.ws + WS_SH); f16_t* SD = (f16_t*)(F.ws + WS_SD);
    const int lane = F.lane;
    for (int tile = F.gw; tile < NROW / 16; tile += F.nw) {
        int l1 = lane; asm volatile("" : "+v"(l1)); const int tk = l1 & 15, g = l1 >> 4;
        const int r = tile * 16 + tk; const RowGeo geo = row_geo(r);
        bf16x8 tw[2][2], ta[2][2];
#pragma unroll
        for (int d = 0; d < 2; ++d)
#pragma unroll
            for (int kk = 0; kk < 2; ++kk) { float u[8];
                rw_shift8(PL, mup, mun, r, geo, 768 + 256 * d + 32 * kk + 8 * g, u);
#pragma unroll
                for (int q = 0; q < 8; ++q) u[q] = 1.0f - 2.0f / (1.0f + __expf(2.0f * u[q]));
                tw[d][kk] = pack8f(u);
                rw_shift8(PL, mup, mun, r, geo, 832 + 256 * d + 32 * kk + 8 * g, u); ta[d][kk] = pack8f(u); asm volatile("" ::: "memory"); }
#pragma unroll 1
        for (int h = 0; h < 4; ++h) {
            int l2 = lane; asm volatile("" : "+v"(l2)); const int tk = l2 & 15, g = l2 >> 4;
            const int r = tile * 16 + tk; const RowGeo geo = row_geo(r);
            float ur[4][4], uk[4][4], uv[4][4], kkv[4][4]; float ss = 0.f;
#pragma unroll
            for (int t = 0; t < 4; ++t) { const int c = 64 * h + 16 * t + 4 * g;
                rw_shift4(PL, mup, mun, r, geo, c, ur[t]); rw_shift4(PL, mup, mun, r, geo, 256 + c, uk[t]); rw_shift4(PL, mup, mun, r, geo, 512 + c, uv[t]);
                const f32x4 kkw = *(const f32x4*)(P.in[I_KK] + l * 256 + c);
#pragma unroll
                for (int q = 0; q < 4; ++q) { kkv[t][q] = uk[t][q] * kkw[q]; ss += kkv[t][q] * kkv[t][q]; } asm volatile("" ::: "memory"); }
            ss += __shfl_xor(ss, 16); ss += __shfl_xor(ss, 32);
            const float rn = rsqrtf(ss + 1e-12f);
            const size_t shrow = ((size_t)(geo.b * 4 + h) * TT + geo.tt) * 192;
#pragma unroll
            for (int t = 0; t < 4; ++t) { f16x4 o1, o2, o3;
#pragma unroll
                for (int q = 0; q < 4; ++q) { kkv[t][q] *= rn; o1[q] = (f16_t)ur[t][q]; o2[q] = (f16_t)uv[t][q]; o3[q] = (f16_t)(-kkv[t][q]); }
                f16_t* sp = SH + shrow + 16 * t + 4 * g; *(f16x4*)sp = o1; *(f16x4*)(sp + 64) = o2; *(f16x4*)(sp + 128) = o3; }
#pragma unroll 1
            for (int d = 0; d < 2; ++d) {
                const bf16_t* w2t = (const bf16_t*)(F.ws + WS_LORA + (size_t)(l * 2 + d) * LORA_LD_BYTES); const bf16_t* a2t = w2t + 256 * 64;
                const size_t sdrow = ((size_t)((d * 8 + geo.b) * 4 + h) * TT + geo.tt) * 192;
                const bf16x8 tw0 = d ? tw[1][0] : tw[0][0], tw1 = d ? tw[1][1] : tw[0][1], ta0 = d ? ta[1][0] : ta[0][0], ta1 = d ? ta[1][1] : ta[0][1];
#pragma unroll
                for (int t = 0; t < 4; ++t) { const int c = 64 * h + 16 * t + 4 * g;
                    const bf16_t* wr = w2t + (size_t)(64 * h + 16 * t + tk) * 64 + 8 * g; const bf16_t* ar = a2t + (size_t)(64 * h + 16 * t + tk) * 64 + 8 * g;
                    f32x4 xw = *(const f32x4*)(P.in[I_W0] + (l * 2 + d) * 256 + c), xa = *(const f32x4*)(P.in[I_A0] + (l * 2 + d) * 256 + c);
                    xw = __builtin_amdgcn_mfma_f32_16x16x32_bf16(*(const bf16x8*)wr, tw0, xw, 0, 0, 0); xw = __builtin_amdgcn_mfma_f32_16x16x32_bf16(*(const bf16x8*)(wr + 32), tw1, xw, 0, 0, 0);
                    xa = __builtin_amdgcn_mfma_f32_16x16x32_bf16(*(const bf16x8*)ar, ta0, xa, 0, 0, 0); xa = __builtin_amdgcn_mfma_f32_16x16x32_bf16(*(const bf16x8*)(ar + 32), ta1, xa, 0, 0, 0);
                    const f32x4 kaw = *(const f32x4*)(P.in[I_KA] + l * 256 + c);
                    f16x4 o1, o2, o3;
#pragma unroll
                    for (int q = 0; q < 4; ++q) {
                        const float nx = -xw[q]; const float sp = fmaxf(nx, 0.f) + __logf(1.0f + __expf(-fabsf(nx)));
                        const float e = __expf(-sp - 0.5f);
                        const float omw = 1.0f - __expf(-e);
                        const float a = sigmoidf_(xa[q]);
                        o1[q] = (f16_t)omw; o2[q] = (f16_t)(uk[t][q] * (1.0f + (a - 1.0f) * kaw[q])); o3[q] = (f16_t)(kkv[t][q] * a); }
                    f16_t* sp = SD + sdrow + 16 * t + 4 * g; *(f16x4*)sp = o1; *(f16x4*)(sp + 64) = o2; *(f16x4*)(sp + 128) = o3; asm volatile("" ::: "memory"); }
            }
        }
    }
}

constexpr int SC_CH = 32;
constexpr int SC_BUF = SC_CH * 6 * 64 * 4;
__device__ __forceinline__ float dpp_sum16(float v) {
    v += __builtin_bit_cast(float, __builtin_amdgcn_update_dpp(0, __builtin_bit_cast(int, v), 0xB1, 0xF, 0xF, true));
    v += __builtin_bit_cast(float, __builtin_amdgcn_update_dpp(0, __builtin_bit_cast(int, v), 0x4E, 0xF, 0xF, true));
    v += __builtin_bit_cast(float, __builtin_amdgcn_update_dpp(0, __builtin_bit_cast(int, v), 0x141, 0xF, 0xF, true));
    v += __builtin_bit_cast(float, __builtin_amdgcn_update_dpp(0, __builtin_bit_cast(int, v), 0x140, 0xF, 0xF, true));
    return v;
}
__device__ __forceinline__ int scan_tt0(int d, int c) { return d == 0 ? c * SC_CH : (c < 8 ? 224 - 32 * c : 4576 - 32 * c); }
constexpr int CS_ZP = 0, CS_RPP = 2048, CS_BH = 4096, CS_KH = 6144, CS_VV = 8192, CS_MT = 10240, CS_NT = 11264, CS_WC = 12288, CS_SLOT = 12544;
constexpr int CS_ZIMG = 8 * CS_SLOT;
constexpr int CS_NCHUNK = TT / 16;
__device__ __forceinline__ int cs_tt(int d, int q, int s) { const int st = 16 * q + s; return d == 0 ? st : (st < CTXL ? CTXL - 1 - st : TT + CTXL - 1 - st); }
__device__ __forceinline__ float dpp_shr(float old, float v, int) { return v; }
template <int N> __device__ __forceinline__ float row_shr(float v, float old) {
    return __builtin_bit_cast(float, __builtin_amdgcn_update_dpp(__builtin_bit_cast(int, old), __builtin_bit_cast(int, v), 0x110 + N, 0xF, 0xF, false));
}
__device__ __forceinline__ bf16x8 cs_pack(const float (&a)[4], const float (&b)[4]) {
    u32x4 w; w.x = cvt_pk_bf16(a[0], a[1]); w.y = cvt_pk_bf16(a[2], a[3]); w.z = cvt_pk_bf16(b[0], b[1]); w.w = cvt_pk_bf16(b[2], b[3]); return __builtin_bit_cast(bf16x8, w);
}
__device__ __forceinline__ bf16x8 cs_op16(const f32x4& x) { u32x4 w; w.x = cvt_pk_bf16(x[0], x[1]); w.y = cvt_pk_bf16(x[2], x[3]); w.z = 0u; w.w = 0u; return __builtin_bit_cast(bf16x8, w); }
#define CS_MFMA(a, b, c) __builtin_amdgcn_mfma_f32_16x16x32_bf16((a), (b), (c), 0, 0, 0)
__device__ __forceinline__ f32x4 cs_mm16(const f32x4& xt_d, const f32x4& y_d) { return CS_MFMA(cs_op16(xt_d), cs_op16(y_d), ((f32x4){0.f, 0.f, 0.f, 0.f})); }
__device__ __forceinline__ v4i16_t cs_tr(const LAS unsigned char* img, int lane, int T) {
    const int g = lane >> 4, q = (lane & 15) >> 2, p = lane & 3;
    return __builtin_amdgcn_ds_read_tr16_b64_v4i16((LAS v4i16_t*)(img + (4 * g + q) * 128 + p * 32 + (T >> 1) * 16 + (T & 1) * 8));
}
__device__ __forceinline__ bf16x8 cs_lo(v4i16_t x) { bf16x8 r; r[0] = x[0]; r[1] = x[1]; r[2] = x[2]; r[3] = x[3]; r[4] = 0; r[5] = 0; r[6] = 0; r[7] = 0; return r; }

__device__ __forceinline__ void cs_prepass(LAS unsigned char* lds, LAS unsigned char* slot, LAS unsigned char* zimg, const f16_t* sh, const f16_t* sd, int d, int q, int lane) {
    const int s = lane & 15, g = lane >> 4;
    const int tt = cs_tt(d, q, s);
    const f16_t* shp = sh + (size_t)tt * 192 + 4 * g; const f16_t* sdp = sd + (size_t)tt * 192 + 4 * g;
    float Wc[4][4], Wp[4][4], iW[4][4];
#pragma unroll
    for (int T = 0; T < 4; ++T) { const f16x4 x4 = *(const f16x4*)(sdp + 16 * T);
#pragma unroll
        for (int j = 0; j < 4; ++j) { float wc = 1.0f - (float)x4[j];
            wc *= row_shr<1>(wc, 1.0f); wc *= row_shr<2>(wc, 1.0f); wc *= row_shr<4>(wc, 1.0f); wc *= row_shr<8>(wc, 1.0f);
            Wc[T][j] = wc; Wp[T][j] = row_shr<1>(wc, 1.0f); iW[T][j] = 1.0f / wc; } }
    if (s == 15) {
#pragma unroll
        for (int T = 0; T < 4; ++T) *(LAS f32x4*)(slot + CS_WC + (16 * T + 4 * g) * 4) = (f32x4){Wc[T][0], Wc[T][1], Wc[T][2], Wc[T][3]}; }
    asm volatile("" ::: "memory");
    bf16x8 oZ[2], oR[2], oB[2], oK[2];
    const int ioff = s * 128 + g * 32;
#define CS_STAGE(dst, src, SC, IMG) do { float t_[4][4]; \
        _Pragma("unroll") for (int T = 0; T < 4; ++T) { const f16x4 q4 = *(const f16x4*)((src) + 16 * T); \
            _Pragma("unroll") for (int j = 0; j < 4; ++j) t_[T][j] = (float)q4[j] * SC; } \
        _Pragma("unroll") for (int kk = 0; kk < 2; ++kk) { dst[kk] = cs_pack(t_[2 * kk], t_[2 * kk + 1]); if (IMG) *(LAS bf16x8*)((IMG) + ioff + kk * 16) = dst[kk]; } \
        asm volatile("" ::: "memory"); } while (0)
    CS_STAGE(oZ, shp + 128, Wp[T][j], zimg);
    CS_STAGE(oR, shp, Wc[T][j], (LAS unsigned char*)nullptr);
    CS_STAGE(oB, sdp + 128, iW[T][j], slot + CS_BH);
    CS_STAGE(oK, sdp + 64, iW[T][j], slot + CS_KH);
    { bf16x8 oV[2]; CS_STAGE(oV, shp + 64, 1.0f, slot + CS_VV); }
#undef CS_STAGE
    const f32x4 zero4 = (f32x4){0.f, 0.f, 0.f, 0.f};
    f32x4 A_D = CS_MFMA(oB[1], oZ[1], CS_MFMA(oB[0], oZ[0], zero4)), AT_D = CS_MFMA(oZ[1], oB[1], CS_MFMA(oZ[0], oB[0], zero4));
    f32x4 BkT_D = CS_MFMA(oZ[1], oK[1], CS_MFMA(oZ[0], oK[0], zero4));
    f32x4 Ar_D = CS_MFMA(oB[1], oR[1], CS_MFMA(oB[0], oR[0], zero4)), Kr_D = CS_MFMA(oK[1], oR[1], CS_MFMA(oK[0], oR[0], zero4));
    f32x4 I_D;
#pragma unroll
    for (int j = 0; j < 4; ++j) { const int m = 4 * g + j;
        A_D[j] = m < s ? A_D[j] : 0.f; AT_D[j] = s < m ? AT_D[j] : 0.f; BkT_D[j] = s < m ? BkT_D[j] : 0.f;
        Ar_D[j] = m <= s ? Ar_D[j] : 0.f; Kr_D[j] = m <= s ? Kr_D[j] : 0.f; I_D[j] = m == s ? 1.f : 0.f; }
    f32x4 Ab, AbT, A1, A2m;
#pragma unroll
    for (int j = 0; j < 4; ++j) { const int m = 4 * g + j; const bool b0 = (m >> 2) == (s >> 2), b1 = (m >> 3) == (s >> 3);
        Ab[j] = b0 ? A_D[j] : 0.f; AbT[j] = b0 ? AT_D[j] : 0.f; A1[j] = (b1 && !b0) ? A_D[j] : 0.f; A2m[j] = b1 ? 0.f : A_D[j]; }
    const f32x4 Ab2 = cs_mm16(AbT, Ab), Ab2T = cs_mm16(Ab, AbT);
    const f32x4 P0 = I_D + Ab, P0T = I_D + AbT;
    const f32x4 T0 = P0 + cs_mm16(P0T, Ab2), T0T = P0T + cs_mm16(Ab2, P0T);
    (void)Ab2T;
    const f32x4 ZT = cs_mm16(A1, T0T);
    const f32x4 T1 = T0 + cs_mm16(ZT, T0), T1T = T0T + cs_mm16(T0, ZT);
    const f32x4 Z2T = cs_mm16(A2m, T1T);
    const f32x4 T_D = T1 + cs_mm16(Z2T, T1);
    const f32x4 M_D = cs_mm16(BkT_D, T_D), MT_D = cs_mm16(T_D, BkT_D);
    const f32x4 N_D = cs_mm16(MT_D, Ar_D) + Kr_D;
    { u32x4 w; w.x = cvt_pk_bf16(M_D[0], M_D[1]); w.y = cvt_pk_bf16(M_D[2], M_D[3]); w.z = 0u; w.w = 0u; *(LAS u32x4*)(slot + CS_MT + s * 64 + g * 16) = w;
      w.x = cvt_pk_bf16(N_D[0], N_D[1]); w.y = cvt_pk_bf16(N_D[2], N_D[3]); *(LAS u32x4*)(slot + CS_NT + s * 64 + g * 16) = w; }
    __builtin_amdgcn_wave_barrier(); asm volatile("" ::: "memory");
    const bf16x8 oT = cs_op16(T_D), oAr = cs_op16(Ar_D);
    float Zp[4][4];
#pragma unroll
    for (int T = 0; T < 4; ++T) { const f32x4 zp = CS_MFMA(cs_lo(cs_tr(zimg, lane, T)), oT, zero4);
#pragma unroll
        for (int j = 0; j < 4; ++j) Zp[T][j] = zp[j]; }
#pragma unroll
    for (int kk = 0; kk < 2; ++kk) *(LAS bf16x8*)(slot + CS_ZP + s * 128 + g * 32 + kk * 16) = cs_pack(Zp[2 * kk], Zp[2 * kk + 1]);
    __builtin_amdgcn_wave_barrier(); asm volatile("" ::: "memory");
    float Rp[4][4];
#pragma unroll
    for (int T = 0; T < 4; ++T) { const f32x4 rp = CS_MFMA(cs_lo(cs_tr(slot + CS_ZP, lane, T)), oAr, zero4);
#pragma unroll
        for (int j = 0; j < 4; ++j) Rp[T][j] = rp[j] + bf2f((bf16_t)oR[T >> 1][(T & 1) * 4 + j]); }
#pragma unroll
    for (int kk = 0; kk < 2; ++kk) *(LAS bf16x8*)(slot + CS_RPP + s * 128 + g * 32 + kk * 16) = cs_pack(Rp[2 * kk], Rp[2 * kk + 1]);
    (void)lds;
}
__device__ __forceinline__ void cs_scan_chunk(const LAS unsigned char* slot, f32x4 (&acc)[4], float* yp  , int d, int q, int wave, int lane) {
    const int s = lane & 15, g = lane >> 4;
    const f32x4 zero4 = (f32x4){0.f, 0.f, 0.f, 0.f};
    bf16x8 Xb[2];
#pragma unroll
    for (int kk = 0; kk < 2; ++kk) { u32x4 w; w.x = cvt_pk_bf16(acc[2 * kk][0], acc[2 * kk][1]); w.y = cvt_pk_bf16(acc[2 * kk][2], acc[2 * kk][3]);
        w.z = cvt_pk_bf16(acc[2 * kk + 1][0], acc[2 * kk + 1][1]); w.w = cvt_pk_bf16(acc[2 * kk + 1][2], acc[2 * kk + 1][3]); Xb[kk] = __builtin_bit_cast(bf16x8, w); }
    const v4i16_t vt = cs_tr(slot + CS_VV, lane, wave);
    const bf16x8 Vb = cs_lo(vt);
    const int arow = s * 128 + g * 32, a16 = s * 64 + g * 16;
    f32x4 UT = CS_MFMA(*(const LAS bf16x8*)(slot + CS_ZP + arow), Xb[0], zero4); UT = CS_MFMA(*(const LAS bf16x8*)(slot + CS_ZP + arow + 16), Xb[1], UT); UT = CS_MFMA(*(const LAS bf16x8*)(slot + CS_MT + a16), Vb, UT);
    f32x4 YT = CS_MFMA(*(const LAS bf16x8*)(slot + CS_RPP + arow), Xb[0], zero4); YT = CS_MFMA(*(const LAS bf16x8*)(slot + CS_RPP + arow + 16), Xb[1], YT); YT = CS_MFMA(*(const LAS bf16x8*)(slot + CS_NT + a16), Vb, YT);
#pragma unroll
    for (int j = 0; j < 4; ++j) yp[(size_t)cs_tt(d, q, 4 * g + j) * 256] = YT[j];
    bf16x8 UV; { u32x2 w; w.x = cvt_pk_bf16(UT[0], UT[1]); w.y = cvt_pk_bf16(UT[2], UT[3]); const v4i16_t ub = __builtin_bit_cast(v4i16_t, w);
        UV[0] = ub[0]; UV[1] = ub[1]; UV[2] = ub[2]; UV[3] = ub[3]; UV[4] = vt[0]; UV[5] = vt[1]; UV[6] = vt[2]; UV[7] = vt[3]; }
#pragma unroll
    for (int T = 0; T < 4; ++T) { const v4i16_t bh = cs_tr(slot + CS_BH, lane, T), kh = cs_tr(slot + CS_KH, lane, T);
        bf16x8 BK; BK[0] = bh[0]; BK[1] = bh[1]; BK[2] = bh[2]; BK[3] = bh[3]; BK[4] = kh[0]; BK[5] = kh[1]; BK[6] = kh[2]; BK[7] = kh[3];
        acc[T] = CS_MFMA(BK, UV, acc[T]);
        acc[T] *= *(const LAS f32x4*)(slot + CS_WC + (16 * T + 4 * g) * 4); }
}
__device__ __forceinline__ void phase_scan(const Frame& F) {
    const f16_t* SH = (const f16_t*)(F.ws + WS_SH); const f16_t* SD = (const f16_t*)(F.ws + WS_SD);
    float* Y = (float*)(F.ws + WS_Y);
    const int lane = F.lane, wave = F.wave;
    for (int chain = F.bid; chain < 64; chain += F.G) {
        const int d = chain >> 5, b = (chain >> 2) & 7, h = chain & 3;
        const f16_t* sh = SH + (size_t)(b * 4 + h) * TT * 192; const f16_t* sd = SD + (size_t)((d * 8 + b) * 4 + h) * TT * 192;
        float* yp = Y + ((size_t)(d * 8 + b) * TT) * 256 + h * 64 + 16 * (wave & 3) + (lane & 15);
        f32x4 acc[4];
#pragma unroll
        for (int T = 0; T < 4; ++T) acc[T] = (f32x4){0.f, 0.f, 0.f, 0.f};
        __syncthreads();
        if (wave >= 4) cs_prepass(F.lds, F.lds + (wave - 4) * CS_SLOT, F.lds + CS_ZIMG + (wave - 4) * 2048, sh, sd, d, wave - 4, lane);
        __syncthreads();
        for (int r = 0; r < CS_NCHUNK / 4; ++r) {
            if (wave >= 4) { if (r + 1 < CS_NCHUNK / 4) cs_prepass(F.lds, F.lds + (((r + 1) & 1) * 4 + (wave - 4)) * CS_SLOT, F.lds + CS_ZIMG + (wave - 4) * 2048, sh, sd, d, 4 * (r + 1) + (wave - 4), lane); }
            else {
#pragma unroll 1
                for (int c4 = 0; c4 < 4; ++c4) cs_scan_chunk(F.lds + ((r & 1) * 4 + c4) * CS_SLOT, acc, yp, d, 4 * r + c4, wave, lane);
            }
            __syncthreads();
        }
    }
}

__device__ __forceinline__ void phase_rw_post(const Frame& F, const Params& P, int l, int nrows) {
    const bf16_t* PL = (const bf16_t*)(F.ws + WS_PL); bf16_t* MIX = (bf16_t*)(F.ws + WS_MIX);
    const f16_t* SH = (const f16_t*)(F.ws + WS_SH); const f16_t* SD = (const f16_t*)(F.ws + WS_SD); const float* Y = (const float*)(F.ws + WS_Y);
    const float* mup = P.in[I_MUP] + l * 1280; const float* mun = P.in[I_MUN] + l * 1280;
    const int lane = F.lane;
    for (int tile = F.gw; tile < nrows / 16; tile += F.nw) {
        int l1 = lane; asm volatile("" : "+v"(l1)); const int tk = l1 & 15, g = l1 >> 4;
        const int r = tile * 16 + tk; const RowGeo geo = row_geo(r);
        bf16x8 sg[2][4];
#pragma unroll
        for (int d = 0; d < 2; ++d)
#pragma unroll
            for (int kk = 0; kk < 4; ++kk) { float u[8]; rw_shift8(PL, mup, mun, r, geo, 896 + 256 * d + 32 * kk + 8 * g, u);
#pragma unroll
                for (int q = 0; q < 8; ++q) u[q] = sigmoidf_(u[q]);
                sg[d][kk] = pack8f(u); asm volatile("" ::: "memory"); }
#pragma unroll 1
        for (int h = 0; h < 4; ++h) {
            int l2 = lane; asm volatile("" : "+v"(l2)); const int tk = l2 & 15, g = l2 >> 4;
            const int r = tile * 16 + tk; const RowGeo geo = row_geo(r);
            const size_t shrow = ((size_t)(geo.b * 4 + h) * TT + geo.tt) * 192;
            float out[4][4];
#pragma unroll
            for (int t = 0; t < 4; ++t)
#pragma unroll
                for (int q = 0; q < 4; ++q) out[t][q] = 0.f;
#pragma unroll 1
            for (int d = 0; d < 2; ++d) {
                const bf16_t* g2t = (const bf16_t*)(F.ws + WS_LORA + (size_t)(l * 2 + d) * LORA_LD_BYTES) + 2 * 256 * 64;
                const size_t sdrow = ((size_t)((d * 8 + geo.b) * 4 + h) * TT + geo.tt) * 192;
                const float* yrow = Y + ((size_t)(d * 8 + geo.b) * TT + geo.tt) * 256 + 64 * h + 4 * g;
                bf16x8 sgd[4];
#pragma unroll
                for (int kk = 0; kk < 4; ++kk) sgd[kk] = d ? sg[1][kk] : sg[0][kk];
                f32x4 y[4], gg[4]; float sm = 0.f, bs = 0.f;
#pragma unroll
                for (int t = 0; t < 4; ++t) { const int c = 64 * h + 16 * t + 4 * g;
                    y[t] = *(const f32x4*)(yrow + 16 * t); sm += (y[t][0] + y[t][1]) + (y[t][2] + y[t][3]);
                    const f16x4 rh = *(const f16x4*)(SH + shrow + 16 * t + 4 * g), kdh = *(const f16x4*)(SD + sdrow + 64 + 16 * t + 4 * g);
                    const f32x4 rk = *(const f32x4*)(P.in[I_RK] + l * 256 + c);
#pragma unroll
                    for (int q = 0; q < 4; ++q) bs += (float)rh[q] * (float)kdh[q] * rk[q];
                    const bf16_t* gr = g2t + (size_t)(64 * h + 16 * t + tk) * 128 + 8 * g;
                    f32x4 a = (f32x4){0.f, 0.f, 0.f, 0.f};
#pragma unroll
                    for (int kk = 0; kk < 4; ++kk) a = __builtin_amdgcn_mfma_f32_16x16x32_bf16(*(const bf16x8*)(gr + 32 * kk), sgd[kk], a, 0, 0, 0);
                    gg[t] = a; asm volatile("" ::: "memory"); }
                sm += __shfl_xor(sm, 16); sm += __shfl_xor(sm, 32); bs += __shfl_xor(bs, 16); bs += __shfl_xor(bs, 32);
                const float mu = sm * (1.0f / 64.0f); float vs = 0.f;
#pragma unroll
                for (int t = 0; t < 4; ++t)
#pragma unroll
                    for (int q = 0; q < 4; ++q) { const float dd = y[t][q] - mu; vs += dd * dd; }
                vs += __shfl_xor(vs, 16); vs += __shfl_xor(vs, 32);
                const float rstd = rsqrtf(vs * (1.0f / 64.0f) + 64e-5f);
#pragma unroll
                for (int t = 0; t < 4; ++t) { const int c = 64 * h + 16 * t + 4 * g;
                    const f32x4 gng = *(const f32x4*)(P.in[I_GNG] + l * 256 + c), gnb = *(const f32x4*)(P.in[I_GNB] + l * 256 + c);
                    const f16x4 vh = *(const f16x4*)(SH + shrow + 64 + 16 * t + 4 * g);
#pragma unroll
                    for (int q = 0; q < 4; ++q) out[t][q] += ((y[t][q] - mu) * rstd * gng[q] + gnb[q] + bs * (float)vh[q]) * gg[t][q]; }
            }
#pragma unroll
            for (int t = 0; t < 4; ++t) { u32x2 w; w.x = cvt_pk_bf16(out[t][0], out[t][1]); w.y = cvt_pk_bf16(out[t][2], out[t][3]);
                *(u32x2*)(MIX + (size_t)r * D + 512 + 64 * h + 16 * t + 4 * g) = w; }
        }
    }
}

constexpr int CV_SEG = 64, CV_ROWS = CV_SEG + 30, CV_H = 0, CV_W = CV_ROWS * 256 * 4;
__device__ __forceinline__ void phase_conv(const Frame& F, const Params& P, int l, int nrows) {
    const bf16_t* PL = (const bf16_t*)(F.ws + WS_PL); bf16_t* MIX = (bf16_t*)(F.ws + WS_MIX);
    const int lane = F.lane, c4 = lane * 4, wave = F.wave;
    LAS float* H = (LAS float*)(F.lds + CV_H); LAS float* W = (LAS float*)(F.lds + CV_W);
    for (int i = F.tid; i < 31 * 256; i += NTHREADS) W[i] = P.in[I_DWW][(size_t)l * 31 * 256 + i];
    const f32x4 dwb = *(const f32x4*)(P.in[I_DWB] + l * 256 + c4), lng = *(const f32x4*)(P.in[I_LNG] + l * 256 + c4), lnb = *(const f32x4*)(P.in[I_LNB] + l * 256 + c4);
    for (int seg = F.bid; seg < nrows / CV_SEG; seg += F.G) {
        const int r0 = seg * CV_SEG; const RowGeo g0 = row_geo(r0);
        __syncthreads();
#pragma unroll 4
        for (int k = 0; k < 12; ++k) { const int rr = wave + 8 * k;
            if (rr < CV_ROWS) { const int pos = g0.pos - 15 + rr; f32x4 hv = (f32x4){0.f, 0.f, 0.f, 0.f};
                if (pos >= 0 && pos < g0.len) { const bf16_t* p = PL + (size_t)(r0 - 15 + rr) * INW + O_CV + c4; float a[4], bb[4];
                    unpack4(*(const u32x2*)p, a); unpack4(*(const u32x2*)(p + 256), bb);
#pragma unroll
                    for (int q = 0; q < 4; ++q) hv[q] = a[q] * sigmoidf_(bb[q]); }
                *(LAS f32x4*)(H + rr * 256 + c4) = hv; } }
        __syncthreads();
        f32x4 acc[8];
#pragma unroll
        for (int t = 0; t < 8; ++t) acc[t] = dwb;
#pragma unroll 1
        for (int j = 0; j < 31; ++j) { const f32x4 w = *(const LAS f32x4*)(W + j * 256 + c4);
#pragma unroll
            for (int t = 0; t < 8; ++t) acc[t] += *(const LAS f32x4*)(H + (wave * 8 + t + j) * 256 + c4) * w; }
#pragma unroll
        for (int t = 0; t < 8; ++t) {
            const float mu = wave_sum((acc[t][0] + acc[t][1]) + (acc[t][2] + acc[t][3])) * (1.0f / 256.0f);
            float vs = 0.f;
#pragma unroll
            for (int q = 0; q < 4; ++q) { const float dd = acc[t][q] - mu; vs += dd * dd; }
            const float rstd = rsqrtf(wave_sum(vs) * (1.0f / 256.0f) + 1e-5f);
            float o[4];
#pragma unroll
            for (int q = 0; q < 4; ++q) o[q] = siluf_((acc[t][q] - mu) * rstd * lng[q] + lnb[q]);
            u32x2 w; w.x = pk_bf16(o[0], o[1]); w.y = pk_bf16(o[2], o[3]);
            *(u32x2*)(MIX + (size_t)(r0 + wave * 8 + t) * D + 768 + c4) = w; }
    }
}

__device__ __forceinline__ void phase_na_simple(const Frame& F, const Params& P, int l, int nq) {
    const bf16_t* PL = (const bf16_t*)(F.ws + WS_PL); bf16_t* MIX = (bf16_t*)(F.ws + WS_MIX);
    const float* rpb = P.in[I_RPB] + (size_t)l * 8 * 15 * 31;
    int tid_ = F.tid; asm volatile("" : "+v"(tid_));
    for (int gid = F.bid * NTHREADS + tid_; gid < nq * 8; gid += F.G * NTHREADS) {
        const int r = gid >> 3, h = gid & 7;
        const RowGeo g = row_geo(r);
        float q[64], o[64];
        { const bf16_t* qp = PL + (size_t)r * INW + O_Q + h * 64;
#pragma unroll
          for (int i = 0; i < 8; ++i) unpack8(*(const u32x4*)(qp + i * 8), q + i * 8); }
#pragma unroll
        for (int i = 0; i < 64; ++i) o[i] = 0.f;
        float m = -3.0e38f, lsum = 0.f;
        const bool lat = r < NLAT;
        const int gi = g.pos >> 6, gc = g.pos & 63;
        const int rs = min(max(gi - 4, 0), 56), wsc = min(max(gc - 8, 0), 48);
        const int nkey = lat ? 384 : 256;
#pragma unroll 1
        for (int kx = 0; kx < nkey; ++kx) {
            const bool win = lat && kx < 128;
            int krow; float bias = 0.f;
            if (win) { const int r8 = kx >> 4, cc = kx & 15; krow = g.b * SEQ + (rs + r8) * 64 + wsc + cc; bias = rpb[(h * 15 + (rs + r8 - gi + 7)) * 31 + (wsc + cc - gc + 15)]; }
            else krow = NLAT + g.b * CTXL + (kx - (lat ? 128 : 0));
            const bf16_t* kp = PL + (size_t)krow * INW + O_K + h * 64; float a = bias;
#pragma unroll
            for (int i = 0; i < 8; ++i) { float kf[8]; unpack8(*(const u32x4*)(kp + i * 8), kf);
#pragma unroll
                for (int j = 0; j < 8; ++j) a += q[i * 8 + j] * kf[j]; }
            if (a > m) { const float alpha = __expf(m - a); lsum *= alpha;
#pragma unroll
                for (int i = 0; i < 64; ++i) o[i] *= alpha;
                m = a; }
            const float p = __expf(a - m); lsum += p;
            const bf16_t* vp = kp + (O_V - O_K);
#pragma unroll
            for (int i = 0; i < 8; ++i) { float vf[8]; unpack8(*(const u32x4*)(vp + i * 8), vf);
#pragma unroll
                for (int j = 0; j < 8; ++j) o[i * 8 + j] += p * vf[j]; }
        }
        const float inv = 1.0f / lsum;
        bf16_t* op = MIX + (size_t)r * D + h * 64;
#pragma unroll
        for (int i = 0; i < 8; ++i) { u32x4 w; w.x = pk_bf16(o[i * 8] * inv, o[i * 8 + 1] * inv); w.y = pk_bf16(o[i * 8 + 2] * inv, o[i * 8 + 3] * inv);
            w.z = pk_bf16(o[i * 8 + 4] * inv, o[i * 8 + 5] * inv); w.w = pk_bf16(o[i * 8 + 6] * inv, o[i * 8 + 7] * inv); *(u32x4*)(op + i * 8) = w; }
    }
}

constexpr int NA_CK = 0, NA_CV = 32768, NA_RPB = 65536, NA_WV = 81920;
__device__ __forceinline__ bf16x8 na_pack8(const f32x4& a, const f32x4& b) {
    u32x4 w; w.x = cvt_pk_bf16(a[0], a[1]); w.y = cvt_pk_bf16(a[2], a[3]); w.z = cvt_pk_bf16(b[0], b[1]); w.w = cvt_pk_bf16(b[2], b[3]); return __builtin_bit_cast(bf16x8, w);
}
__device__ __forceinline__ bf16x8 na_vfrag(LAS unsigned char* blk, int lane, int dt) {
    const int g = lane >> 4, qq = (lane & 15) >> 2, p = lane & 3;
    const int r0 = 4 * g + qq, r1 = 16 + 4 * g + qq;
    const v4i16_t lo = __builtin_amdgcn_ds_read_tr16_b64_v4i16((LAS v4i16_t*)(blk + r0 * 128 + ((dt ^ ((r0 >> 1) & 3)) * 32) + p * 8));
    const v4i16_t hi = __builtin_amdgcn_ds_read_tr16_b64_v4i16((LAS v4i16_t*)(blk + r1 * 128 + ((dt ^ ((r1 >> 1) & 3)) * 32) + p * 8));
    bf16x8 r; r[0] = lo[0]; r[1] = lo[1]; r[2] = lo[2]; r[3] = lo[3]; r[4] = hi[0]; r[5] = hi[1]; r[6] = hi[2]; r[7] = hi[3]; return r;
}
template <bool WINDOW>
__device__ __forceinline__ void na_item(const Frame& F, const bf16_t* PL, bf16_t* MIX, int b, int h, int qrow0  , int gi, int cb) {
    const int lane = F.lane, ql = lane & 15, g = lane >> 4;
    LAS unsigned char* CK = F.lds + NA_CK; LAS unsigned char* CV = F.lds + NA_CV; const LAS float* RPB = (const LAS float*)(F.lds + NA_RPB);
    LAS unsigned char* WV = F.lds + NA_WV + F.wave * 4096;
    bf16x8 Qf[2];
    { const bf16_t* qp = PL + (size_t)(qrow0 + ql) * INW + O_Q + h * 64 + 8 * g; Qf[0] = *(const bf16x8*)qp; Qf[1] = *(const bf16x8*)(qp + 32); }
    f32x4 acc[4];
#pragma unroll
    for (int dt = 0; dt < 4; ++dt) acc[dt] = (f32x4){0.f, 0.f, 0.f, 0.f};
    float m_run = -3.0e38f, l_run = 0.f;
    if constexpr (WINDOW) {
        const int rs = min(max(gi - 4, 0), 56), kc0 = min(max(16 * cb - 8, 0), 32), qcol = 16 * cb + ql, wsq = min(max(qcol - 8, 0), 48);
        const size_t krow0 = (size_t)b * SEQ + (size_t)rs * 64 + kc0;
        f32x4 s[16];
#pragma unroll
        for (int t = 0; t < 16; ++t) { const bf16_t* kp = PL + (krow0 + (size_t)(t >> 1) * 64 + (t & 1) * 16 + ql) * INW + O_K + h * 64 + 8 * g;
            const bf16x8 k0 = *(const bf16x8*)kp, k1 = *(const bf16x8*)(kp + 32);
            s[t] = __builtin_amdgcn_mfma_f32_16x16x32_bf16(k0, Qf[0], (f32x4){0.f, 0.f, 0.f, 0.f}, 0, 0, 0);
            s[t] = __builtin_amdgcn_mfma_f32_16x16x32_bf16(k1, Qf[1], s[t], 0, 0, 0); }
        float mx = -3.0e38f;
#pragma unroll
        for (int t = 0; t < 16; ++t) { const LAS float* bp = RPB + (h * 15 + (rs + (t >> 1) - gi + 7)) * 31 + 15 - qcol;
#pragma unroll
            for (int j = 0; j < 4; ++j) { const int kcol = kc0 + (t & 1) * 16 + 4 * g + j; const bool ok = kcol >= wsq && kcol < wsq + 16;
                const float v = ok ? s[t][j] + bp[ok ? kcol : qcol] : -INFINITY; s[t][j] = v; mx = fmaxf(mx, v); } }
        mx = fmaxf(mx, __shfl_xor(mx, 16)); mx = fmaxf(mx, __shfl_xor(mx, 32));
        m_run = mx;
        float ls = 0.f;
#pragma unroll
        for (int t = 0; t < 16; ++t)
#pragma unroll
            for (int j = 0; j < 4; ++j) { const float p = __expf(s[t][j] - mx); s[t][j] = p; ls += p; }
        l_run = ls;
#pragma unroll
        for (int r8 = 0; r8 < 8; ++r8) {
            { const int vr = lane >> 1, part = lane & 1;
              const bf16_t* vp = PL + (krow0 + (size_t)r8 * 64 + vr) * INW + O_V + h * 64 + part * 32;
              u32x4 v0 = *(const u32x4*)vp, v1 = *(const u32x4*)(vp + 8), v2 = *(const u32x4*)(vp + 16), v3 = *(const u32x4*)(vp + 24);
              LAS unsigned char* wr = WV + vr * 128; const int sw = (vr >> 1) & 3;
              *(LAS u32x4*)(wr + (((2 * part) ^ sw) * 32)) = v0; *(LAS u32x4*)(wr + (((2 * part) ^ sw) * 32) + 16) = v1;
              *(LAS u32x4*)(wr + (((2 * part + 1) ^ sw) * 32)) = v2; *(LAS u32x4*)(wr + (((2 * part + 1) ^ sw) * 32) + 16) = v3; }
            __builtin_amdgcn_wave_barrier(); asm volatile("" ::: "memory");
            const bf16x8 pf = na_pack8(s[2 * r8], s[2 * r8 + 1]);
#pragma unroll
            for (int dt = 0; dt < 4; ++dt) { const bf16x8 vf = na_vfrag(WV, lane, dt); acc[dt] = __builtin_amdgcn_mfma_f32_16x16x32_bf16(vf, pf, acc[dt], 0, 0, 0); }
            __builtin_amdgcn_wave_barrier(); asm volatile("" ::: "memory");
        }
    }
    {
        f32x4 s[16];
#pragma unroll
        for (int t = 0; t < 16; ++t) { const int key = 16 * t + ql; const LAS unsigned char* kr = CK + key * 128;
            const bf16x8 k0 = *(const LAS bf16x8*)(kr + ((g ^ (key & 7)) * 16)), k1 = *(const LAS bf16x8*)(kr + (((g + 4) ^ (key & 7)) * 16));
            s[t] = __builtin_amdgcn_mfma_f32_16x16x32_bf16(k0, Qf[0], (f32x4){0.f, 0.f, 0.f, 0.f}, 0, 0, 0);
            s[t] = __builtin_amdgcn_mfma_f32_16x16x32_bf16(k1, Qf[1], s[t], 0, 0, 0); }
        float mx = m_run;
#pragma unroll
        for (int t = 0; t < 16; ++t)
#pragma unroll
            for (int j = 0; j < 4; ++j) mx = fmaxf(mx, s[t][j]);
        mx = fmaxf(mx, __shfl_xor(mx, 16)); mx = fmaxf(mx, __shfl_xor(mx, 32));
        const float alpha = __expf(m_run - mx);
        float ls = l_run * alpha;
#pragma unroll
        for (int dt = 0; dt < 4; ++dt) acc[dt] *= alpha;
#pragma unroll
        for (int t = 0; t < 16; ++t)
#pragma unroll
            for (int j = 0; j < 4; ++j) { const float p = __expf(s[t][j] - mx); s[t][j] = p; ls += p; }
        l_run = ls;
#pragma unroll
        for (int blk = 0; blk < 8; ++blk) { const bf16x8 pf = na_pack8(s[2 * blk], s[2 * blk + 1]);
#pragma unroll
            for (int dt = 0; dt < 4; ++dt) { const bf16x8 vf = na_vfrag(CV + blk * 4096, lane, dt); acc[dt] = __builtin_amdgcn_mfma_f32_16x16x32_bf16(vf, pf, acc[dt], 0, 0, 0); } }
    }
    float lt = l_run; lt += __shfl_xor(lt, 16); lt += __shfl_xor(lt, 32);
    const float inv = 1.0f / lt;
    bf16_t* op = MIX + (size_t)(qrow0 + ql) * D + h * 64 + 4 * g;
#pragma unroll
    for (int dt = 0; dt < 4; ++dt) { u32x2 w; w.x = cvt_pk_bf16(acc[dt][0] * inv, acc[dt][1] * inv); w.y = cvt_pk_bf16(acc[dt][2] * inv, acc[dt][3] * inv); *(u32x2*)(op + dt * 16) = w; }
}
__device__ __forceinline__ void phase_na_mfma(const Frame& F, const Params& P, int l, bool ctx_queries) {
    const bf16_t* PL = (const bf16_t*)(F.ws + WS_PL); bf16_t* MIX = (bf16_t*)(F.ws + WS_MIX);
    int tid_ = F.tid; asm volatile("" : "+v"(tid_));
    const int tid = tid_;
    { const float* rpb = P.in[I_RPB] + (size_t)l * 8 * 15 * 31; LAS float* R = (LAS float*)(F.lds + NA_RPB); for (int i = tid; i < 8 * 15 * 31; i += NTHREADS) R[i] = rpb[i]; }
    for (int unit = F.bid; unit < 256; unit += F.G) {
        const int quarter = unit & 3, h = (unit >> 2) & 7, b = unit >> 5;
        __syncthreads();
        { int t2 = tid; asm volatile("" : "+v"(t2)); const int key = t2 >> 1, part = t2 & 1; const bf16_t* kp = PL + (size_t)(NLAT + b * CTXL + key) * INW + O_K + h * 64 + part * 32; const bf16_t* vp = kp + (O_V - O_K);
          LAS unsigned char* kr = F.lds + NA_CK + key * 128; LAS unsigned char* vr = F.lds + NA_CV + key * 128; const int sw = (key >> 1) & 3;
#pragma unroll
          for (int c = 0; c < 4; ++c) { *(LAS u32x4*)(kr + (((4 * part + c) ^ (key & 7)) * 16)) = *(const u32x4*)(kp + 8 * c);
              const int c16 = 4 * part + c; *(LAS u32x4*)(vr + (((c16 >> 1) ^ sw) * 32) + (c16 & 1) * 16) = *(const u32x4*)(vp + 8 * c); } }
        __syncthreads();
        for (int it = F.wave; it < 64; it += NWAVES) { const int gi = quarter * 16 + (it >> 2), cb = it & 3;
            na_item<true>(F, PL, MIX, b, h, b * SEQ + gi * 64 + cb * 16, gi, cb); }
        if (ctx_queries && F.wave < 4) na_item<false>(F, PL, MIX, b, h, NLAT + b * CTXL + (quarter * 4 + F.wave) * 16, 0, 0);
    }
}

__device__ __forceinline__ void phase_final(const Frame& F, const Params& P) {
    float* out = P.out; const float* g = P.in[I_FINALG]; const int lane = F.lane;
    for (int r = F.gw; r < NLAT; r += F.nw) {
        float* xr = out + (size_t)r * D; f32x4 x[4]; float ss = 0.f;
#pragma unroll
        for (int j = 0; j < 4; ++j) { x[j] = *(const f32x4*)(xr + j * 256 + lane * 4); ss += x[j][0] * x[j][0] + x[j][1] * x[j][1] + x[j][2] * x[j][2] + x[j][3] * x[j][3]; }
        ss = wave_sum(ss); const float rstd = rsqrtf(ss * (1.0f / D) + 1e-6f);
#pragma unroll
        for (int j = 0; j < 4; ++j) { const f32x4 gg = *(const f32x4*)(g + j * 256 + lane * 4); *(f32x4*)(xr + j * 256 + lane * 4) = x[j] * rstd * gg; }
    }
}

constexpr int PH_L0 = 1, PH_PER_L0 = 9, PH_L1 = PH_L0 + PH_PER_L0, PH_PER_L1 = 12, PH_FINAL = PH_L1 + PH_PER_L1, N_PHASES = PH_FINAL + 1;
#define RFL(x) __builtin_amdgcn_readfirstlane(x)

PHASE ph_prologue(const void* kp_, int wv_) { PHASE_ENTER; if constexpr (MKB(0)) phase_prologue(F, P); }
PHASE ph_norm1(const void* kp_, int wv_, int l_) { PHASE_ENTER; const int l = RFL(l_);
    if constexpr (MKB(1)) phase_norm<false>(F, P, l, 0, NROW, l == 0 ? P.in[I_X] : P.out, l == 0 ? P.in[I_CTX] : (const float*)(F.ws + WS_XC)); }
PHASE_INL ph_gemm_win(const void* kp_, int wv_, int l_) { PHASE_ENTER; const int l = RFL(l_);
    pg8::DenseSched S; S.init(NROW / 256, INW / 256, F.G, F.bid); S.A = (const bf16_t*)(F.ws + WS_HL); S.Bt = (const bf16_t*)(F.ws + WS_BTIN) + (size_t)l * INW * D; S.K = D;
    pg8::EpiBf16 E{(bf16_t*)(F.ws + WS_PL), INW, 2, 0.125f};
    if constexpr (MKB(2)) pg8::gemm_phase<pg8::EpiBf16, pg8::DenseSched, false>(F.lds, D, S, E, F.wave); }
PHASE_INL ph_rw_prep(const void* kp_, int wv_, int l_) { PHASE_ENTER; const int l = RFL(l_); if constexpr (MKB(3)) phase_rw_prep(F, P, l); }
PHASE ph_conv(const void* kp_, int wv_, int l_, int bid_, int G_) { PHASE_ENTER; const int l = RFL(l_); if constexpr (MKB(4)) phase_conv(sub_frame(F, RFL(bid_), RFL(G_)), P, l, l == 0 ? NROW : NLAT); }
PHASE_INL ph_na(const void* kp_, int wv_, int l_, int bid_, int G_) { PHASE_ENTER; const int l = RFL(l_); if constexpr (MKB(5)) phase_na_mfma(sub_frame(F, RFL(bid_), RFL(G_)), P, l, l == 0); }
PHASE_INL ph_scan(const void* kp_, int wv_, int bid_, int G_) { PHASE_ENTER; if constexpr (MKB(6)) phase_scan(sub_frame(F, RFL(bid_), RFL(G_))); }
PHASE_INL ph_rw_post(const void* kp_, int wv_, int l_) { PHASE_ENTER; const int l = RFL(l_); if constexpr (MKB(7)) phase_rw_post(F, P, l, l == 0 ? NROW : NLAT); }
PHASE_INL ph_gemm_wout(const void* kp_, int wv_, int l_) { PHASE_ENTER; const int l = RFL(l_);
    float* XC = (float*)(F.ws + WS_XC);
    pg8::DenseSched S; S.init((l == 0 ? NROW : NLAT) / 256, D / 256, F.G, F.bid); S.A = (const bf16_t*)(F.ws + WS_MIX); S.Bt = (const bf16_t*)(F.ws + WS_BTOUT) + (size_t)l * D * D; S.K = D;
    pg8::EpiRes E{l == 0 ? P.in[I_X] : P.out, l == 0 ? P.in[I_CTX] : XC, P.out, XC, (const float*)(F.ws + WS_MODV) + (size_t)l * 9 * MODW + 2 * D};
    if constexpr (MKB(8)) pg8::gemm_phase<pg8::EpiRes, pg8::DenseSched, false>(F.lds, D, S, E, F.wave); }
PHASE ph_norm2_l0(const void* kp_, int wv_) { PHASE_ENTER; if constexpr (MKB(9)) phase_norm<false>(F, P, 0, 1, NROW, P.out, (const float*)(F.ws + WS_XC)); }
PHASE_INL ph_gemm_ffn_gu(const void* kp_, int wv_) { PHASE_ENTER;
    pg8::DenseSched S; S.init(NROW / 256, (2 * DFF) / 256, F.G, F.bid); S.A = (const bf16_t*)(F.ws + WS_HL); S.Bt = (const bf16_t*)(F.ws + WS_BTGU); S.K = D;
    pg8::EpiSwiGLU E{(bf16_t*)(F.ws + WS_H), DFF};
    if constexpr (MKB(10)) pg8::gemm_phase<pg8::EpiSwiGLU, pg8::DenseSched, false>(F.lds, D, S, E, F.wave); }
PHASE_INL ph_gemm_ffn_dn(const void* kp_, int wv_) { PHASE_ENTER;
    float* XC = (float*)(F.ws + WS_XC);
    pg8::DenseSched S; S.init(NROW / 256, D / 256, F.G, F.bid); S.A = (const bf16_t*)(F.ws + WS_H); S.Bt = (const bf16_t*)(F.ws + WS_BTDN); S.K = DFF;
    pg8::EpiRes E{P.out, XC, P.out, XC, (const float*)(F.ws + WS_MODV) + 5 * D};
    if constexpr (MKB(11)) pg8::gemm_phase<pg8::EpiRes, pg8::DenseSched, false>(F.lds, DFF, S, E, F.wave); }
PHASE ph_norm2_l1(const void* kp_, int wv_) { PHASE_ENTER; if constexpr (MKB(12)) phase_norm<true>(F, P, 1, 1, NLAT, P.out, (const float*)(F.ws + WS_XC)); }
PHASE ph_moe_prep(const void* kp_, int wv_) { PHASE_ENTER; if constexpr (MKB(13)) { phase_moe_rowmap(F); phase_moe_convert(F, P); } }
PHASE_INL ph_gemm_moe_gu(const void* kp_, int wv_, int pass_) { PHASE_ENTER; const int pass = RFL(pass_);
    pg8::MoeSched S; moe_tstart(F, pass, S.tstart); S.init(S.tstart[8], (2 * DFE) / 256, F.G, F.bid);
    S.A = (const bf16_t*)(F.ws + WS_HL); S.Bt0 = F.ws + WS_MOE; S.e_stride = MOE_E_BYTES; S.K = D; S.rowmap = (const int*)(F.ws + WS_ROUTE + RT_RMAP) + pass * NROW;
    pg8::EpiSwiGLU E{(bf16_t*)(F.ws + WS_H), DFE};
    if constexpr (MKB(14)) pg8::gemm_phase<pg8::EpiSwiGLU, pg8::MoeSched, true>(F.lds, D, S, E, F.wave); }
PHASE_INL ph_gemm_moe_dn(const void* kp_, int wv_, int pass_) { PHASE_ENTER; const int pass = RFL(pass_);
    pg8::MoeSched S; moe_tstart(F, pass, S.tstart); S.init(S.tstart[8], D / 256, F.G, F.bid);
    S.A = (const bf16_t*)(F.ws + WS_H); S.Bt0 = F.ws + WS_MOE + MOE_GU_BYTES; S.e_stride = MOE_E_BYTES; S.K = DFE; S.rowmap = nullptr;
    pg8::EpiMoeDown E{P.out, (const float*)(F.ws + WS_MODV) + (size_t)9 * MODW + 5 * D, (const int*)(F.ws + WS_ROUTE + RT_RMAP) + pass * NROW, (const float*)(F.ws + WS_ROUTE + RT_SGATE) + pass * NROW};
    if constexpr (MKB(15)) pg8::gemm_phase<pg8::EpiMoeDown, pg8::MoeSched, false>(F.lds, DFE, S, E, F.wave); }
PHASE ph_final(const void* kp_, int wv_) { PHASE_ENTER; if constexpr (MKB(16)) phase_final(F, P); }

static __attribute__((noinline)) __device__ void grid_barrier(const void* bar_, unsigned x_, int wv_) {
    const unsigned long long v = (unsigned long long)bar_;
    const unsigned lo = __builtin_amdgcn_readfirstlane((unsigned)v), hi = __builtin_amdgcn_readfirstlane((unsigned)(v >> 32));
    XcdBarrier b; b.bar = (unsigned*)(((unsigned long long)hi << 32) | lo); b.x = __builtin_amdgcn_readfirstlane(x_);
    b.st = (volatile LAS unsigned*)((LAS unsigned char*)lds_raw + LDS_MISC);
    xcd_barrier(b, __builtin_amdgcn_readfirstlane(wv_) * 64 + lane_id());
}
__device__ __forceinline__ bool ph_in(int lo, int hi, int k) { asm volatile("" : "+s"(lo), "+s"(hi)); return lo <= k && k < hi; }

__global__ void __launch_bounds__(NTHREADS, 2) mk_fwd(Params P) {
    const void* kp = (const void*)__builtin_amdgcn_kernarg_segment_ptr();
    LAS unsigned char* lds = (LAS unsigned char*)lds_raw;
    volatile LAS unsigned* misc = (volatile LAS unsigned*)(lds + LDS_MISC);
    const int wv = __builtin_amdgcn_readfirstlane((int)(threadIdx.x >> 6));
    if (wv == 0 && lane_id() < 4) misc[lane_id()] = 0u;
    __syncthreads();
    const int lo = P.ph_lo, hi = P.ph_hi;
    XcdBarrier bar; bar.bar = (unsigned*)(P.ws + WS_CTL) + CW_BAR; bar.x = 0; bar.st = misc;
    if (hi - lo > 1) bar = xcd_barrier_post((unsigned*)(P.ws + WS_CTL) + CW_BAR, misc, wv * 64 + lane_id());
#define IN(k) ph_in(lo, hi, (k))
#define SEAM(k) do { if (IN((k) + 1)) grid_barrier((const void*)bar.bar, bar.x, wv); } while (0)
    if (IN(0)) { for (int rep = 0; rep < REP_PRO; ++rep) ph_prologue(kp, wv); SEAM(0); }
#define LAYER_COMMON(l, pb) \
    if (IN((pb) + 0)) { for (int rep = 0; rep < REP_NORM; ++rep) ph_norm1(kp, wv, (l)); SEAM((pb) + 0); } \
    if (IN((pb) + 1)) { for (int rep = 0; rep < REP_GEMM; ++rep) ph_gemm_win(kp, wv, (l)); SEAM((pb) + 1); } \
    if (IN((pb) + 2)) { for (int rep = 0; rep < REP_PP; ++rep) ph_rw_prep(kp, wv, (l)); SEAM((pb) + 2); } \
    if (IN((pb) + 3)) { const int bx = (int)blockIdx.x, Gx = (int)gridDim.x; \
        if (Gx == 256) { if (bx < 64) { for (int rep = 0; rep < REP_SCAN; ++rep) ph_scan(kp, wv, bx, 64); ph_na(kp, wv, (l), 192 + bx, 256); } \
            else { for (int rep = 0; rep < REP_CONV; ++rep) ph_conv(kp, wv, (l), bx - 64, 192); for (int rep = 0; rep < REP_NA; ++rep) ph_na(kp, wv, (l), bx - 64, 256); } } \
        else { ph_conv(kp, wv, (l), bx, Gx); ph_na(kp, wv, (l), bx, Gx); ph_scan(kp, wv, bx, Gx); } SEAM((pb) + 3); } \
    if (IN((pb) + 4)) { for (int rep = 0; rep < REP_PP; ++rep) ph_rw_post(kp, wv, (l)); SEAM((pb) + 4); } \
    if (IN((pb) + 5)) { ph_gemm_wout(kp, wv, (l)); SEAM((pb) + 5); }
    LAYER_COMMON(0, PH_L0)
    if (IN(PH_L0 + 6)) { ph_norm2_l0(kp, wv); SEAM(PH_L0 + 6); }
    if (IN(PH_L0 + 7)) { for (int rep = 0; rep < REP_GEMM; ++rep) ph_gemm_ffn_gu(kp, wv); SEAM(PH_L0 + 7); }
    if (IN(PH_L0 + 8)) { ph_gemm_ffn_dn(kp, wv); SEAM(PH_L0 + 8); }
    LAYER_COMMON(1, PH_L1)
    if (IN(PH_L1 + 6)) { ph_norm2_l1(kp, wv); SEAM(PH_L1 + 6); }
    if (IN(PH_L1 + 7)) { for (int rep = 0; rep < REP_PRO; ++rep) ph_moe_prep(kp, wv); SEAM(PH_L1 + 7); }
#pragma unroll 1
    for (int pass = 0; pass < 2; ++pass) {
        if (IN(PH_L1 + 8 + 2 * pass)) { for (int rep = 0; rep < REP_GEMM; ++rep) ph_gemm_moe_gu(kp, wv, pass); SEAM(PH_L1 + 8 + 2 * pass); }
        if (IN(PH_L1 + 9 + 2 * pass)) { ph_gemm_moe_dn(kp, wv, pass); SEAM(PH_L1 + 9 + 2 * pass); }
    }
#undef LAYER_COMMON
    if (IN(PH_FINAL)) ph_final(kp, wv);
#undef IN
#undef SEAM
}

extern "C" void kernel_launch(void* const* d_in, const int* in_sizes, int n_in, void* d_out, int out_size, void* d_ws, size_t ws_size, hipStream_t stream) {
    static int grid = 0;
    if (grid == 0) {
        if (n_in != 35 || out_size != NLAT * D || ws_size < WS_END) { fprintf(stderr, "kernel_launch: unexpected shapes (n_in %d out %d ws %zu need %zu)\n", n_in, out_size, ws_size, (size_t)WS_END); grid = -1; return; }
        int dev = 0, cus = 0, per_cu = 0;
        if (hipGetDevice(&dev) != hipSuccess || hipDeviceGetAttribute(&cus, hipDeviceAttributeMultiprocessorCount, dev) != hipSuccess) { grid = -1; return; }
        if (hipFuncSetAttribute((const void*)mk_fwd, hipFuncAttributeMaxDynamicSharedMemorySize, LDS_BYTES) != hipSuccess) { fprintf(stderr, "kernel_launch: hipFuncSetAttribute failed\n"); grid = -1; return; }
        if (hipOccupancyMaxActiveBlocksPerMultiprocessor(&per_cu, (const void*)mk_fwd, NTHREADS, LDS_BYTES) != hipSuccess || per_cu < 1) { fprintf(stderr, "kernel_launch: occupancy query says %d\n", per_cu); (void)hipGetLastError(); }
        grid = cus;
    }
    if (grid < 0) return;
    (void)hipMemsetAsync((char*)d_ws + WS_CTL, 0, CTL_BYTES, stream);
    Params p{};
    for (int i = 0; i < 35; ++i) p.in[i] = (const float*)d_in[i];
    p.out = (float*)d_out; p.ws = (unsigned char*)d_ws;
#if MK_ONE_LAUNCH
    p.ph_lo = 0; p.ph_hi = N_PHASES;
    hipLaunchKernelGGL(mk_fwd, dim3(grid), dim3(NTHREADS), LDS_BYTES, stream, p);
#else
    for (int k = 0; k < N_PHASES && k <= MK_LAST; ++k) { p.ph_lo = k; p.ph_hi = k + 1; hipLaunchKernelGGL(mk_fwd, dim3(grid), dim3(NTHREADS), LDS_BYTES, stream, p); }
#endif
}
```

```cpp
#include <hip/hip_runtime.h>
#include <stdint.h>
#include <stdio.h>

#ifndef MK_MASK
#define MK_MASK 0xFFFFFFFFu
#endif
#define MKB(k) (((MK_MASK) >> (k)) & 1u)
#ifndef REP_SCAN
#define REP_SCAN 1
#endif
#ifndef REP_NA
#define REP_NA 1
#endif
#ifndef REP_GEMM
#define REP_GEMM 1
#endif
#ifndef REP_PP
#define REP_PP 1
#endif
#ifndef REP_CONV
#define REP_CONV 1
#endif
#ifndef REP_NORM
#define REP_NORM 1
#endif
#ifndef REP_PRO
#define REP_PRO 1
#endif
#ifndef MK_LAST
#define MK_LAST 99
#endif
#ifndef MK_ONE_LAUNCH
#define MK_ONE_LAUNCH 1
#endif

#define LAS __attribute__((address_space(3)))
typedef unsigned short bf16_t;
typedef _Float16 f16_t;
typedef short bf16x8 __attribute__((ext_vector_type(8)));
typedef float f32x4 __attribute__((ext_vector_type(4)));
typedef float f32x2 __attribute__((ext_vector_type(2)));
typedef unsigned u32x4 __attribute__((ext_vector_type(4)));
typedef unsigned u32x2 __attribute__((ext_vector_type(2)));
typedef f16_t f16x4 __attribute__((ext_vector_type(4)));
typedef f16_t f16x8 __attribute__((ext_vector_type(8)));
typedef short v4i16_t __attribute__((ext_vector_type(4)));

constexpr int D = 1024, NB = 8, SEQ = 4096, CTXL = 256, TT = CTXL + SEQ;
constexpr int NLAT = NB * SEQ, NCTX = NB * CTXL, NROW = NLAT + NCTX;
constexpr int INW = 3328, DFF = 2816, DFE = 3584, NEXP = 8;
constexpr int O_Q = 0, O_K = 512, O_V = 1024, O_RW = 1536, O_CV = 2816;
constexpr int MODW = 6 * D;
constexpr int NTHREADS = 512, NWAVES = 8;
constexpr int LDS_BYTES = 160 * 1024;
constexpr int LDS_MISC = LDS_BYTES - 256;

constexpr size_t al256(size_t x) { return (x + 255) & ~(size_t)255; }
constexpr size_t WS_CTL   = 0;
constexpr size_t CTL_BYTES = 65536;
constexpr size_t WS_MODV  = WS_CTL + CTL_BYTES;
constexpr size_t WS_BTIN  = al256(WS_MODV + (size_t)2 * 9 * MODW * 4);
constexpr size_t WS_BTOUT = al256(WS_BTIN + (size_t)2 * INW * D * 2);
constexpr size_t WS_BTGU  = al256(WS_BTOUT + (size_t)2 * D * D * 2);
constexpr size_t WS_BTDN  = al256(WS_BTGU + (size_t)2 * DFF * D * 2);
constexpr size_t WS_LORA  = al256(WS_BTDN + (size_t)D * DFF * 2);
constexpr size_t LORA_LD_BYTES = (size_t)(256 * 64 * 2 + 256 * 128) * 2;
constexpr size_t WS_MOE   = al256(WS_LORA + 4 * LORA_LD_BYTES);
constexpr size_t MOE_GU_BYTES = (size_t)2 * DFE * D * 2, MOE_DN_BYTES = (size_t)D * DFE * 2, MOE_E_BYTES = MOE_GU_BYTES + MOE_DN_BYTES;
constexpr size_t WS_SH    = WS_MOE;
constexpr size_t SH_BYTES = (size_t)NB * 4 * TT * 192 * 2;
constexpr size_t WS_SD    = WS_SH + SH_BYTES;
constexpr size_t WS_XC    = al256(WS_MOE + (size_t)NEXP * MOE_E_BYTES);
constexpr size_t WS_HL    = al256(WS_XC + (size_t)NCTX * D * 4);
constexpr size_t WS_Y     = WS_HL;
constexpr size_t WS_PL    = al256(WS_HL + (size_t)NROW * D * 2);
constexpr size_t WS_MIX   = al256(WS_PL + (size_t)NROW * INW * 2);
constexpr size_t WS_H     = WS_PL;
constexpr size_t WS_ROUTE = al256(WS_MIX + (size_t)NROW * D * 2);
constexpr size_t RT_TOKE  = 0;
constexpr size_t RT_TOKG  = RT_TOKE + (size_t)NLAT * 2 * 4;
constexpr size_t RT_TOKP  = RT_TOKG + (size_t)NLAT * 2 * 4;
constexpr size_t RT_RMAP  = RT_TOKP + (size_t)NLAT * 2 * 4;
constexpr size_t RT_SGATE = RT_RMAP + (size_t)2 * NROW * 4;
constexpr size_t WS_END   = al256(WS_ROUTE + RT_SGATE + (size_t)2 * NROW * 4);
static_assert(SH_BYTES * 3 <= (size_t)NEXP * MOE_E_BYTES, "scan inputs must fit the MoE weight region");
static_assert((size_t)NROW * DFE * 2 <= (size_t)NROW * INW * 2 + (size_t)NROW * D * 2, "H must fit PL+MIX");

constexpr int CW_BAR = 0;
constexpr int CW_MOECNT = 4096;

#define XB_TMO      128
#define XB_XCNT(j)  (256  + 64 * (j))
#define XB_XSUB(j)  (1280 + 64 * (j))
#define XB_XGEN(j)  (2304 + 64 * (j))
#define XB_TOP      3328
#define XB_TOPGEN   3392
#define XCD_BAR_WORDS 3456
#define XB_SPIN_CAP (1u << 22)

__device__ __forceinline__ unsigned xb_ld(unsigned* p)              { return __hip_atomic_load(p, __ATOMIC_RELAXED, __HIP_MEMORY_SCOPE_AGENT); }
__device__ __forceinline__ unsigned xb_add(unsigned* p, unsigned v) { return __hip_atomic_fetch_add(p, v, __ATOMIC_RELAXED, __HIP_MEMORY_SCOPE_AGENT); }
__device__ __forceinline__ unsigned xb_xcc_id() { return (unsigned)__builtin_amdgcn_s_getreg((3 << 11) | 20) & 0xFu; }
#define XB_SPIN(cond, bar) do { unsigned _sp = 0; while (cond) { __builtin_amdgcn_s_sleep(1); \
    if ((++_sp & 255u) == 0u) { if (xb_ld(&(bar)[XB_TMO])) break; if (_sp > XB_SPIN_CAP) { atomicAdd(&(bar)[XB_TMO], 1u); break; } } } } while (0)

struct XcdBarrier { unsigned* bar; unsigned x; volatile LAS unsigned* st; };

__device__ __forceinline__ XcdBarrier xcd_barrier_post(unsigned* bar, volatile LAS unsigned* st, int tid) {
    XcdBarrier b; b.bar = bar; b.x = xb_xcc_id(); b.st = st;
    if (tid == 0) (void)xb_add(&bar[XB_XCNT(b.x)], 1u);
    return b;
}
__device__ __forceinline__ void xcd_barrier_complete(unsigned* bar, unsigned x, unsigned& nloc, unsigned& nx) {
    const unsigned G = gridDim.x * gridDim.y * gridDim.z;
    unsigned sum, cnt, mine, sp = 0u;
    for (;;) {
        sum = 0u; cnt = 0u; mine = 0u;
#pragma unroll
        for (unsigned j = 0; j < 16; ++j) { const unsigned c = xb_ld(&bar[XB_XCNT(j)]); sum += c; cnt += (c > 0u) ? 1u : 0u; mine = (j == x) ? c : mine; }
        if (sum == G) break;
        __builtin_amdgcn_s_sleep(1);
        if ((++sp & 255u) == 0u) { if (xb_ld(&bar[XB_TMO])) break; if (sp > XB_SPIN_CAP) { atomicAdd(&bar[XB_TMO], 1u); break; } }
    }
    nloc = mine > 0u ? mine : 1u; nx = cnt > 0u ? cnt : 1u;
}
__device__ __forceinline__ void xcd_barrier(const XcdBarrier& b, int tid) {
    asm volatile("s_waitcnt vmcnt(0)" ::: "memory");
    __syncthreads();
    if (tid == 0) {
        unsigned* bar = b.bar;
        __builtin_amdgcn_s_waitcnt(0);
        unsigned nloc = b.st[0], nx = b.st[1];
        if (nloc == 0u) { xcd_barrier_complete(bar, b.x, nloc, nx); b.st[0] = nloc; b.st[1] = nx; }
        const unsigned old = xb_add(&bar[XB_XSUB(b.x)], 1u);
        const unsigned gen = old / nloc;
        if (old + 1u == (gen + 1u) * nloc) {
            __builtin_amdgcn_fence(__ATOMIC_RELEASE, "agent");
            asm volatile("s_waitcnt vmcnt(0)" ::: "memory");
            const unsigned og = xb_add(&bar[XB_TOP], 1u);
            const unsigned tg = og / nx;
            if (og + 1u == (tg + 1u) * nx) xb_add(&bar[XB_TOPGEN], 1u);
            else XB_SPIN(xb_ld(&bar[XB_TOPGEN]) == tg, bar);
            __builtin_amdgcn_fence(__ATOMIC_ACQUIRE, "agent");
            xb_add(&bar[XB_XGEN(b.x)], 1u);
            asm volatile("s_waitcnt vmcnt(0)" ::: "memory");
        } else {
            XB_SPIN(xb_ld(&bar[XB_XGEN(b.x)]) == gen, bar);
            __builtin_amdgcn_fence(__ATOMIC_ACQUIRE, "agent");
            asm volatile("s_waitcnt vmcnt(0)" ::: "memory");
        }
    }
    __syncthreads();
}

__device__ __forceinline__ int lane_id() { return (int)__builtin_amdgcn_mbcnt_hi(~0u, __builtin_amdgcn_mbcnt_lo(~0u, 0u)); }
__device__ __forceinline__ float bf2f(bf16_t b) { return __uint_as_float(((unsigned)b) << 16); }
__device__ __forceinline__ bf16_t f2bf(float f) { unsigned u = __float_as_uint(f); u += 0x7FFFu + ((u >> 16) & 1u); return (bf16_t)(u >> 16); }
__device__ __forceinline__ unsigned pk_bf16(float lo, float hi) { return (unsigned)f2bf(lo) | ((unsigned)f2bf(hi) << 16); }
typedef __bf16 bf16x2_t __attribute__((ext_vector_type(2)));
__device__ __forceinline__ unsigned cvt_pk_bf16(float lo, float hi) { return __builtin_bit_cast(unsigned, __builtin_convertvector((f32x2){lo, hi}, bf16x2_t)); }
__device__ __forceinline__ float sigmoidf_(float x) { return 1.0f / (1.0f + __expf(-x)); }
__device__ __forceinline__ float siluf_(float x) { return x / (1.0f + __expf(-x)); }
__device__ __forceinline__ float wave_sum(float v) {
#pragma unroll
    for (int o = 32; o >= 1; o >>= 1) v += __shfl_xor(v, o);
    return v;
}
__device__ __forceinline__ float sum16(float v) {
    v += __shfl_xor(v, 1); v += __shfl_xor(v, 2); v += __shfl_xor(v, 4); v += __shfl_xor(v, 8); return v;
}
__device__ __forceinline__ void unpack4(u32x2 w, float (&f)[4]) {
    f[0] = __uint_as_float(w.x << 16); f[1] = __uint_as_float(w.x & 0xffff0000u); f[2] = __uint_as_float(w.y << 16); f[3] = __uint_as_float(w.y & 0xffff0000u);
}
__device__ __forceinline__ void unpack8(u32x4 w, float* f) {
    f[0] = __uint_as_float(w.x << 16); f[1] = __uint_as_float(w.x & 0xffff0000u); f[2] = __uint_as_float(w.y << 16); f[3] = __uint_as_float(w.y & 0xffff0000u);
    f[4] = __uint_as_float(w.z << 16); f[5] = __uint_as_float(w.z & 0xffff0000u); f[6] = __uint_as_float(w.w << 16); f[7] = __uint_as_float(w.w & 0xffff0000u);
}

struct Params {
    const float* in[35];
    float* out; unsigned char* ws;
    int ph_lo, ph_hi;
};
enum { I_X = 0, I_C, I_CTX, I_CCTX, I_N1G, I_N2G, I_MODW, I_MODB, I_WIN, I_WOUT, I_RPB, I_MUP, I_MUN, I_W0, I_W2, I_A0, I_A2, I_G2, I_KK, I_KA, I_RK, I_GNG, I_GNB,
       I_DWW, I_DWB, I_LNG, I_LNB, I_FG, I_FU, I_FD, I_ROUTER, I_MG, I_MU, I_MD, I_FINALG };

__device__ __forceinline__ int row_mi(int r) { return r < NLAT ? (r >> 12) : 8; }

namespace pg8 {
constexpr int BM = 256, BK = 64, HALF = 128, HTB = HALF * BK * 2, STAGE_BYTES = 8 * HTB, NXCD = 8, WGM = 8;
__device__ __forceinline__ int lds_byte(int r, int c) { const int st = (r >> 4) * 2 + (c >> 5), rr = r & 15, cc = c & 31, ob = rr * 64 + cc * 2; return st * 1024 + (ob ^ (((ob >> 9) & 1) << 5)); }
__device__ __forceinline__ void stage_rc(int b, int& R, int& C) { const int st = b / 1024, sb = b % 1024, swz = sb ^ (((sb >> 9) & 1) << 5); R = (st >> 1) * 16 + swz / 64; C = (st & 1) * 32 + (swz % 64) / 2; }
__device__ __forceinline__ int perm32(int rho) { const int n = rho >> 4, i = rho & 15; return 8 * (i >> 2) + 4 * n + (i & 3); }
struct Unit { int pm, pn; };

struct TileOrder {
    int nM, nN, nwg, G, c;
    __device__ void init(int nM_, int nN_, int G_, int c_) { nM = nM_; nN = nN_; nwg = nM * nN; G = G_; c = c_; }
    __device__ bool next(int i, Unit& u) const {
        const long L = (long)i * G + c; if (L >= nwg) return false;
        int wgid = (int)L; { const int q = nwg / NXCD, r = nwg % NXCD, xcd = wgid % NXCD, off = wgid / NXCD; wgid = (xcd < r ? xcd * (q + 1) : r * (q + 1) + (xcd - r) * q) + off; }
        const int nig = WGM * nN, gid = wgid / nig, fm = gid * WGM, gsz = (nM - fm) < WGM ? (nM - fm) : WGM;
        u.pm = fm + ((wgid % nig) % gsz); u.pn = (wgid % nig) / gsz; return true;
    }
};
struct DenseSched : TileOrder {
    const bf16_t* A; const bf16_t* Bt; int K;
    __device__ __forceinline__ const char* aptr(const Unit& u) const { return (const char*)A + (size_t)u.pm * BM * K * 2; }
    __device__ __forceinline__ const char* bptr(const Unit& u) const { return (const char*)Bt + (size_t)u.pn * BM * K * 2; }
    __device__ __forceinline__ const char* abase() const { return (const char*)A; }
    __device__ __forceinline__ int arow(const Unit&, int) const { return 0; }
};
struct MoeSched : TileOrder {
    const bf16_t* A; const unsigned char* Bt0; size_t e_stride; int K; const int* rowmap; int tstart[9];
    __device__ __forceinline__ int expert(int pm) const { int e = 0;
#pragma unroll
        for (int j = 1; j < 8; ++j) e += (pm >= tstart[j]) ? 1 : 0;
        return e; }
    __device__ __forceinline__ const char* aptr(const Unit& u) const { return (const char*)A + (size_t)u.pm * BM * K * 2; }
    __device__ __forceinline__ const char* bptr(const Unit& u) const { return (const char*)Bt0 + (size_t)expert(u.pm) * e_stride + (size_t)u.pn * BM * K * 2; }
    __device__ __forceinline__ const char* abase() const { return (const char*)A; }
    __device__ __forceinline__ int arow(const Unit& u, int r) const { const int t = rowmap[u.pm * BM + r]; return t < 0 ? 0 : t; }
};

struct EpiBf16 {
    static constexpr bool PERM = true;
    bf16_t* O; int ldc; int nscale; float scale;
    __device__ __forceinline__ void operator()(const f32x4 (&acc)[2][2][4][2], const Unit& u, int wr, int wc, int fr, int fq) const {
        const int row0 = u.pm * BM + wr * 64 + fr, col0 = u.pn * BM + wc * 32 + 8 * fq;
        const float s = u.pn < nscale ? scale : 1.0f;
#pragma unroll
        for (int ai = 0; ai < 2; ++ai)
#pragma unroll
            for (int m = 0; m < 4; ++m) { bf16_t* rowp = O + (size_t)(row0 + ai * HALF + m * 16) * ldc + col0;
#pragma unroll
                for (int bj = 0; bj < 2; ++bj) { const f32x4 v0 = acc[ai][bj][m][0] * s, v1 = acc[ai][bj][m][1] * s;
                    u32x4 w; w.x = cvt_pk_bf16(v0[0], v0[1]); w.y = cvt_pk_bf16(v0[2], v0[3]); w.z = cvt_pk_bf16(v1[0], v1[1]); w.w = cvt_pk_bf16(v1[2], v1[3]);
                    *(u32x4*)(rowp + bj * HALF) = w; } }
    }
};
struct EpiSwiGLU {
    static constexpr bool PERM = true;
    bf16_t* H; int ldh;
    __device__ __forceinline__ void operator()(const f32x4 (&acc)[2][2][4][2], const Unit& u, int wr, int wc, int fr, int fq) const {
        const int row0 = u.pm * BM + wr * 64 + fr, col0 = u.pn * HALF + wc * 32 + 8 * fq;
#pragma unroll
        for (int ai = 0; ai < 2; ++ai)
#pragma unroll
            for (int m = 0; m < 4; ++m) { bf16_t* rowp = H + (size_t)(row0 + ai * HALF + m * 16) * ldh + col0;
                float h[8];
#pragma unroll
                for (int n = 0; n < 2; ++n)
#pragma unroll
                    for (int j = 0; j < 4; ++j) { const float g = acc[ai][0][m][n][j], up = acc[ai][1][m][n][j]; h[n * 4 + j] = g / (1.0f + __expf(-g)) * up; }
                u32x4 w; w.x = cvt_pk_bf16(h[0], h[1]); w.y = cvt_pk_bf16(h[2], h[3]); w.z = cvt_pk_bf16(h[4], h[5]); w.w = cvt_pk_bf16(h[6], h[7]);
                *(u32x4*)rowp = w; }
    }
};
struct EpiRes {
    static constexpr bool PERM = false;
    const float* resL; const float* resC; float* outL; float* outC; const float* gvec;
    __device__ __forceinline__ void operator()(const f32x4 (&acc)[2][2][4][2], const Unit& u, int wr, int wc, int fr, int fq) const {
        const int r0 = u.pm * BM; const bool lat = r0 < NLAT;
        const float* res = lat ? resL + (size_t)r0 * D : resC + (size_t)(r0 - NLAT) * D;
        float* out = lat ? outL + (size_t)r0 * D : outC + (size_t)(r0 - NLAT) * D;
        const float* gv = gvec + (size_t)(lat ? (r0 >> 12) : 8) * MODW;
        const int rl = wr * 64 + fr, col0 = u.pn * BM + wc * 32 + 4 * fq;
        f32x4 g[2][2];
#pragma unroll
        for (int bj = 0; bj < 2; ++bj)
#pragma unroll
            for (int n = 0; n < 2; ++n) g[bj][n] = *(const f32x4*)(gv + col0 + bj * HALF + n * 16);
#pragma unroll
        for (int ai = 0; ai < 2; ++ai)
#pragma unroll
            for (int m = 0; m < 4; ++m) { const size_t off = (size_t)(rl + ai * HALF + m * 16) * D + col0;
#pragma unroll
                for (int bj = 0; bj < 2; ++bj)
#pragma unroll
                    for (int n = 0; n < 2; ++n) { const f32x4 rv = *(const f32x4*)(res + off + bj * HALF + n * 16);
                        *(f32x4*)(out + off + bj * HALF + n * 16) = rv + g[bj][n] * acc[ai][bj][m][n]; } }
    }
};
struct EpiMoeDown {
    static constexpr bool PERM = false;
    float* xl; const float* gvec; const int* rowmap; const float* sgate;
    __device__ __forceinline__ void operator()(const f32x4 (&acc)[2][2][4][2], const Unit& u, int wr, int wc, int fr, int fq) const {
        const int rl = u.pm * BM + wr * 64 + fr, col0 = u.pn * BM + wc * 32 + 4 * fq;
#pragma unroll
        for (int ai = 0; ai < 2; ++ai)
#pragma unroll
            for (int m = 0; m < 4; ++m) { const int slot = rl + ai * HALF + m * 16; const int tok = rowmap[slot];
                if (tok >= 0) { const float sg = sgate[slot]; const float* gv = gvec + (size_t)(tok >> 12) * MODW + col0; float* xp = xl + (size_t)tok * D + col0;
#pragma unroll
                    for (int bj = 0; bj < 2; ++bj)
#pragma unroll
                        for (int n = 0; n < 2; ++n) { const f32x4 g = *(const f32x4*)(gv + bj * HALF + n * 16); const f32x4 rv = *(const f32x4*)(xp + bj * HALF + n * 16);
                            *(f32x4*)(xp + bj * HALF + n * 16) = rv + (g * sg) * acc[ai][bj][m][n]; } } }
    }
};

template <class Epi, class Sched, bool GATHER>
__device__ __forceinline__ void gemm_phase(LAS unsigned char* lds, const int K, const Sched& S, const Epi& E, const int wave_) {
    int tid_ = wave_ * 64 + lane_id(); asm volatile("" : "+v"(tid_));
    const int tid = tid_, wid = wave_, lane = tid & 63, wr = wid >> 2, wc = wid & 3, fr = lane & 15, fq = lane >> 4;
    const int nt = K / BK;
    unsigned voffA[2], voffB[2]; int RA[2], CA[2];
#pragma unroll
    for (int i = 0; i < 2; ++i) { int R, C; stage_rc(tid * 16 + i * 8192, R, C); const int Rb = Epi::PERM ? ((R & ~31) + perm32(R & 31)) : R;
        voffA[i] = (unsigned)(R * K + C) * 2u; voffB[i] = (unsigned)(Rb * K + C) * 2u; RA[i] = R; CA[i] = C; }
    const size_t kstep = (size_t)(BK * 2);
    const size_t hstep = (size_t)HALF * K * 2;
    const unsigned ldsw = (unsigned)wid * 1024u;
    const int aoff = lds_byte(wr * 64 + fr, fq * 8), boff = lds_byte(wc * 32 + fr, fq * 8);
#define PG8_SA(b, h) (((b) * 2 + (h)) * HTB)
#define PG8_SB(b, h) ((4 + (b) * 2 + (h)) * HTB)
#define PG8_STAGE(bufoff, gbase, voff) do { _Pragma("unroll") for (int _i = 0; _i < 2; ++_i) \
        __builtin_amdgcn_global_load_lds((const unsigned*)((const char*)(gbase) + (voff)[_i]), (LAS unsigned*)(lds + (bufoff) + ldsw + _i * 8192), 16, 0, 0); } while (0)
#define PG8_LDA(dst, b, h) do { _Pragma("unroll") for (int m = 0; m < 4; ++m) _Pragma("unroll") for (int k = 0; k < 2; ++k) dst[m][k] = *(const LAS bf16x8*)(lds + PG8_SA(b, h) + aoff + m * 2048 + k * 1024); } while (0)
#define PG8_LDB(dst, b, h) do { _Pragma("unroll") for (int n = 0; n < 2; ++n) _Pragma("unroll") for (int k = 0; k < 2; ++k) dst[n][k] = *(const LAS bf16x8*)(lds + PG8_SB(b, h) + boff + n * 2048 + k * 1024); } while (0)
#define PG8_MMA(ai, bj, At, Bt) do { __builtin_amdgcn_s_setprio(1); _Pragma("unroll") for (int m = 0; m < 4; ++m) _Pragma("unroll") for (int n = 0; n < 2; ++n) _Pragma("unroll") for (int k = 0; k < 2; ++k) \
        acc[ai][bj][m][n] = __builtin_amdgcn_mfma_f32_16x16x32_bf16(Bt[n][k], At[m][k], acc[ai][bj][m][n], 0, 0, 0); __builtin_amdgcn_s_setprio(0); } while (0)
#define PG8_WAIT_V(n) asm volatile("s_waitcnt vmcnt(" #n ")" ::: "memory")
#define PG8_WAIT_L(n) asm volatile("s_waitcnt lgkmcnt(" #n ")" ::: "memory")
#define PG8_BAR __builtin_amdgcn_s_barrier()
#define PG8_SCHED __builtin_amdgcn_sched_barrier(0)
#define PG8_STAGE_A(bufoff, TS, H) do { if constexpr (GATHER) { PG8_STAGE(bufoff, gA##TS, oA##TS[H]); } else { PG8_STAGE(bufoff, a##TS + (H) * hstep, voffA); } } while (0)
    Unit cur, nxt; int ui = 0;
    if (!S.next(0, cur)) return;
    f32x4 acc[2][2][4][2];
#pragma unroll
    for (int a = 0; a < 2; ++a)
#pragma unroll
        for (int b = 0; b < 2; ++b)
#pragma unroll
            for (int m = 0; m < 4; ++m)
#pragma unroll
                for (int n = 0; n < 2; ++n) acc[a][b][m][n] = (f32x4){0.f, 0.f, 0.f, 0.f};
    bf16x8 At[4][2], B0[2][2], B1[2][2];
    const char* Abase = S.abase();
    unsigned aoC[2][2] = {{0u, 0u}, {0u, 0u}}, aoN[2][2] = {{0u, 0u}, {0u, 0u}};
    if constexpr (GATHER) {
#pragma unroll
        for (int h = 0; h < 2; ++h)
#pragma unroll
            for (int i = 0; i < 2; ++i) aoC[h][i] = (unsigned)(S.arow(cur, h * HALF + RA[i]) * K + CA[i]) * 2u;
    }
    const char* cA = GATHER ? Abase : S.aptr(cur); const char* cB = S.bptr(cur);
    if constexpr (GATHER) {
        PG8_STAGE(PG8_SB(0, 0), cB, voffB); PG8_STAGE(PG8_SA(0, 0), Abase, aoC[0]); PG8_STAGE(PG8_SB(0, 1), cB + hstep, voffB); PG8_STAGE(PG8_SA(0, 1), Abase, aoC[1]);
    } else {
        PG8_STAGE(PG8_SB(0, 0), cB, voffB); PG8_STAGE(PG8_SA(0, 0), cA, voffA); PG8_STAGE(PG8_SB(0, 1), cB + hstep, voffB); PG8_STAGE(PG8_SA(0, 1), cA + hstep, voffA);
    }
    if (wr == 1) PG8_BAR;
    PG8_WAIT_V(4); PG8_BAR;
    if constexpr (GATHER) {
        PG8_STAGE(PG8_SB(1, 0), cB + kstep, voffB); PG8_STAGE(PG8_SA(1, 0), Abase + kstep, aoC[0]); PG8_STAGE(PG8_SB(1, 1), cB + hstep + kstep, voffB);
    } else {
        PG8_STAGE(PG8_SB(1, 0), cB + kstep, voffB); PG8_STAGE(PG8_SA(1, 0), cA + kstep, voffA); PG8_STAGE(PG8_SB(1, 1), cB + hstep + kstep, voffB);
    }
    PG8_WAIT_V(6); PG8_BAR;
    for (;;) {
        const bool has_next = S.next(ui + 1, nxt);
        const char* nA = has_next ? (GATHER ? Abase : S.aptr(nxt)) : cA; const char* nB = has_next ? S.bptr(nxt) : cB;
        if constexpr (GATHER) {
            if (has_next) {
#pragma unroll
                for (int h = 0; h < 2; ++h)
#pragma unroll
                    for (int i = 0; i < 2; ++i) aoN[h][i] = (unsigned)(S.arow(nxt, h * HALF + RA[i]) * K + CA[i]) * 2u;
            } else {
#pragma unroll
                for (int h = 0; h < 2; ++h)
#pragma unroll
                    for (int i = 0; i < 2; ++i) aoN[h][i] = aoC[h][i];
            }
        }
        for (int t = 0; t < nt; t += 2) {
            const bool last = (t == nt - 2);
            const char* a1 = cA + (size_t)(t + 1) * kstep;
            const char* a2 = last ? nA : cA + (size_t)(t + 2) * kstep; const char* b2 = last ? nB : cB + (size_t)(t + 2) * kstep;
            const char* a3 = a2 + kstep; const char* b3 = b2 + kstep;
            const char* gA1 = Abase + (size_t)(t + 1) * kstep; const char* gA2 = Abase + (last ? (size_t)0 : (size_t)(t + 2) * kstep); const char* gA3 = gA2 + kstep;
            unsigned oA1[2][2], oA2[2][2], oA3[2][2];
#pragma unroll
            for (int h = 0; h < 2; ++h)
#pragma unroll
                for (int i = 0; i < 2; ++i) { oA1[h][i] = aoC[h][i]; oA2[h][i] = last ? aoN[h][i] : aoC[h][i]; oA3[h][i] = oA2[h][i]; }
            (void)a1; (void)a3; (void)gA1; (void)gA3; (void)oA1; (void)oA3;
            PG8_LDB(B0, 0, 0); PG8_SCHED; PG8_LDA(At, 0, 0); PG8_STAGE_A(PG8_SA(1, 1), 1, 1);
            PG8_WAIT_L(8); PG8_BAR; PG8_WAIT_L(0); PG8_MMA(0, 0, At, B0); PG8_BAR; PG8_SCHED;
            PG8_LDB(B1, 0, 1); PG8_STAGE(PG8_SB(0, 0), b2, voffB);
            PG8_BAR; PG8_WAIT_L(0); PG8_MMA(0, 1, At, B1); PG8_BAR;
            PG8_LDA(At, 0, 1); PG8_STAGE_A(PG8_SA(0, 0), 2, 0);
            PG8_BAR; PG8_WAIT_L(0); PG8_MMA(1, 0, At, B0); PG8_BAR; PG8_SCHED;
            PG8_STAGE(PG8_SB(0, 1), b2 + hstep, voffB);
            PG8_WAIT_V(6); PG8_BAR; PG8_MMA(1, 1, At, B1); PG8_BAR;
            PG8_LDB(B0, 1, 0); PG8_SCHED; PG8_LDA(At, 1, 0); PG8_STAGE_A(PG8_SA(0, 1), 2, 1);
            PG8_WAIT_L(8); PG8_BAR; PG8_WAIT_L(0); PG8_MMA(0, 0, At, B0); PG8_BAR; PG8_SCHED;
            PG8_LDB(B1, 1, 1); PG8_STAGE(PG8_SB(1, 0), b3, voffB);
            PG8_BAR; PG8_WAIT_L(0); PG8_MMA(0, 1, At, B1); PG8_BAR;
            PG8_LDA(At, 1, 1); PG8_STAGE_A(PG8_SA(1, 0), 3, 0);
            PG8_BAR; PG8_WAIT_L(0); PG8_MMA(1, 0, At, B0); PG8_BAR; PG8_SCHED;
            PG8_STAGE(PG8_SB(1, 1), b3 + hstep, voffB);
            PG8_WAIT_V(6); PG8_BAR; PG8_MMA(1, 1, At, B1); PG8_BAR;
        }
        { int t2 = tid; asm volatile("" : "+v"(t2)); const int l2 = t2 & 63; E(acc, cur, wr, wc, l2 & 15, l2 >> 4); }
        if (!has_next) break;
#pragma unroll
        for (int a = 0; a < 2; ++a)
#pragma unroll
            for (int b = 0; b < 2; ++b)
#pragma unroll
                for (int m = 0; m < 4; ++m)
#pragma unroll
                    for (int n = 0; n < 2; ++n) acc[a][b][m][n] = (f32x4){0.f, 0.f, 0.f, 0.f};
        cur = nxt; cA = nA; cB = nB; ++ui;
        if constexpr (GATHER) {
#pragma unroll
            for (int h = 0; h < 2; ++h)
#pragma unroll
                for (int i = 0; i < 2; ++i) aoC[h][i] = aoN[h][i];
        }
    }
    PG8_WAIT_V(0);
    if (wr == 0) PG8_BAR;
    PG8_BAR;
#undef PG8_SA
#undef PG8_SB
#undef PG8_STAGE
#undef PG8_STAGE_A
#undef PG8_LDA
#undef PG8_LDB
#undef PG8_MMA
#undef PG8_WAIT_V
#undef PG8_WAIT_L
#undef PG8_BAR
#undef PG8_SCHED
}
}

struct Frame {
    LAS unsigned char* lds; int tid, lane, wave, G, bid, gw, nw;
    unsigned char* ws;
};
extern __shared__ __attribute__((aligned(16))) unsigned char lds_raw[];
typedef const __attribute__((address_space(4))) Params* KP;
__device__ __forceinline__ Params load_params(const void* kp_) {
    const unsigned long long v = (unsigned long long)kp_;
    const unsigned lo = __builtin_amdgcn_readfirstlane((unsigned)v), hi = __builtin_amdgcn_readfirstlane((unsigned)(v >> 32));
    KP kp = (KP)(((unsigned long long)hi << 32) | lo);
    Params P;
#pragma unroll
    for (int i = 0; i < 35; ++i) P.in[i] = kp->in[i];
    P.out = kp->out; P.ws = kp->ws; P.ph_lo = kp->ph_lo; P.ph_hi = kp->ph_hi;
    return P;
}
#define PHASE static __attribute__((noinline)) __device__ void
#define PHASE_INL static __device__ __forceinline__ void
__device__ __forceinline__ Frame make_frame(unsigned char* ws, int wave_) {
    Frame F; F.lds = (LAS unsigned char*)lds_raw; F.wave = __builtin_amdgcn_readfirstlane(wave_);
    int t_ = F.wave * 64 + lane_id(); asm volatile("" : "+v"(t_));
    F.tid = t_; F.lane = F.tid & 63;
    F.G = gridDim.x; F.bid = blockIdx.x; F.gw = F.bid * NWAVES + F.wave; F.nw = F.G * NWAVES; F.ws = ws; return F;
}
__device__ __forceinline__ Frame sub_frame(Frame F, int bid, int G) { F.bid = bid; F.G = G; F.gw = F.bid * NWAVES + F.wave; F.nw = F.G * NWAVES; return F; }
#define PHASE_ENTER const Params P = load_params(kp_); const Frame F = make_frame(P.ws, wv_)

__device__ __forceinline__ void conv_job(const Frame& F, const float* src, bf16_t* dst, int K, int N, int mode) {
    LAS float* tile = (LAS float*)(F.lds + F.wave * (64 * 65 * 4));
    const int tk = K / 64, tn = N / 64, ntile = tk * tn, lane = F.lane;
    for (int t = F.gw; t < ntile; t += F.nw) {
        const int k0 = (t / tn) * 64, n0 = (t % tn) * 64;
#pragma unroll 4
        for (int i = 0; i < 16; ++i) { const int row = i * 4 + (lane >> 4), c4 = (lane & 15) * 4;
            const f32x4 v = *(const f32x4*)(src + (size_t)(k0 + row) * N + n0 + c4);
            tile[row * 65 + c4 + 0] = v[0]; tile[row * 65 + c4 + 1] = v[1]; tile[row * 65 + c4 + 2] = v[2]; tile[row * 65 + c4 + 3] = v[3]; }
        __builtin_amdgcn_wave_barrier(); asm volatile("s_waitcnt lgkmcnt(0)" ::: "memory");
#pragma unroll 2
        for (int i = 0; i < 8; ++i) { const int n = i * 8 + (lane >> 3), kc = (lane & 7) * 8;
            float f[8];
#pragma unroll
            for (int j = 0; j < 8; ++j) f[j] = tile[(kc + j) * 65 + n];
            const int ng = n0 + n; const int drow = mode == 0 ? ng : ((ng >> 7) * 256 + (mode == 2 ? 128 : 0) + (ng & 127));
            u32x4 w; w.x = pk_bf16(f[0], f[1]); w.y = pk_bf16(f[2], f[3]); w.z = pk_bf16(f[4], f[5]); w.w = pk_bf16(f[6], f[7]);
            *(u32x4*)(dst + (size_t)drow * K + k0 + kc) = w; }
        __builtin_amdgcn_wave_barrier(); asm volatile("s_waitcnt lgkmcnt(0)" ::: "memory");
    }
}

__device__ __forceinline__ void phase_prologue(const Frame& F, const Params& P) {
    float* modv = (float*)(F.ws + WS_MODV);
    LAS float* s = (LAS float*)F.lds;
    LAS float* red = (LAS float*)(F.lds + 9 * 1024 * 4);
    for (int cb = F.bid; cb < (2 * MODW) / 64; cb += F.G) {
        for (int i = F.tid; i < 9 * 1024; i += NTHREADS) { const int mi = i >> 10, k = i & 1023; const float c = mi < 8 ? P.in[I_C][mi * D + k] : P.in[I_CCTX][k]; s[i] = siluf_(c); }
        __syncthreads();
        const int colg = cb * 64 + F.lane, l = colg / MODW, col = colg % MODW;
        const float* w = P.in[I_MODW] + (size_t)l * D * MODW + col;
        float acc[9];
#pragma unroll
        for (int mi = 0; mi < 9; ++mi) acc[mi] = 0.f;
        const int kb = F.wave * 128;
#pragma unroll 8
        for (int k = 0; k < 128; ++k) { const float wv = w[(size_t)(kb + k) * MODW];
#pragma unroll
            for (int mi = 0; mi < 9; ++mi) acc[mi] += s[mi * 1024 + kb + k] * wv; }
#pragma unroll
        for (int mi = 0; mi < 9; ++mi) red[(F.wave * 9 + mi) * 64 + F.lane] = acc[mi];
        __syncthreads();
        for (int i = F.tid; i < 9 * 64; i += NTHREADS) { const int mi = i >> 6, ln = i & 63; float a = 0.f;
#pragma unroll
            for (int w8 = 0; w8 < 8; ++w8) a += red[(w8 * 9 + mi) * 64 + ln];
            const int cg = cb * 64 + ln, l2 = cg / MODW, c2 = cg % MODW;
            modv[((size_t)l2 * 9 + mi) * MODW + c2] = a + P.in[I_MODB][l2 * MODW + c2]; }
        __syncthreads();
    }
    for (int l = 0; l < 2; ++l) {
        conv_job(F, P.in[I_WIN] + (size_t)l * D * INW, (bf16_t*)(F.ws + WS_BTIN) + (size_t)l * INW * D, D, INW, 0);
        conv_job(F, P.in[I_WOUT] + (size_t)l * D * D, (bf16_t*)(F.ws + WS_BTOUT) + (size_t)l * D * D, D, D, 0);
    }
    conv_job(F, P.in[I_FG], (bf16_t*)(F.ws + WS_BTGU), D, DFF, 1);
    conv_job(F, P.in[I_FU], (bf16_t*)(F.ws + WS_BTGU), D, DFF, 2);
    conv_job(F, P.in[I_FD], (bf16_t*)(F.ws + WS_BTDN), DFF, D, 0);
    for (int ld = 0; ld < 4; ++ld) { bf16_t* base = (bf16_t*)(F.ws + WS_LORA + (size_t)ld * LORA_LD_BYTES);
        conv_job(F, P.in[I_W2] + (size_t)ld * 64 * 256, base, 64, 256, 0);
        conv_job(F, P.in[I_A2] + (size_t)ld * 64 * 256, base + 256 * 64, 64, 256, 0);
        conv_job(F, P.in[I_G2] + (size_t)ld * 128 * 256, base + 2 * 256 * 64, 128, 256, 0); }
}
__device__ __forceinline__ void phase_moe_convert(const Frame& F, const Params& P) {
    for (int e = 0; e < NEXP; ++e) {
        bf16_t* gu = (bf16_t*)(F.ws + WS_MOE + (size_t)e * MOE_E_BYTES); bf16_t* dn = (bf16_t*)(F.ws + WS_MOE + (size_t)e * MOE_E_BYTES + MOE_GU_BYTES);
        conv_job(F, P.in[I_MG] + (size_t)e * D * DFE, gu, D, DFE, 1);
        conv_job(F, P.in[I_MU] + (size_t)e * D * DFE, gu, D, DFE, 2);
        conv_job(F, P.in[I_MD] + (size_t)e * DFE * D, dn, DFE, D, 0);
    }
}

template <bool ROUTER>
__device__ __forceinline__ void phase_norm(const Frame& F, const Params& P, int l, int which, int nrows, const float* srcL, const float* srcC) {
    const float* g = (which == 0 ? P.in[I_N1G] : P.in[I_N2G]) + l * D;
    const float* modv = (const float*)(F.ws + WS_MODV) + (size_t)l * 9 * MODW + (which == 0 ? 0 : 3 * D);
    bf16_t* HL = (bf16_t*)(F.ws + WS_HL);
    LAS float* rt = (LAS float*)F.lds;
    if (ROUTER) {
        for (int i = F.tid; i < D * NEXP; i += NTHREADS) rt[i] = P.in[I_ROUTER][i];
        int* rmap = (int*)(F.ws + WS_ROUTE + RT_RMAP);
        for (int i = F.bid * NTHREADS + F.tid; i < 2 * NROW; i += F.G * NTHREADS) rmap[i] = -1;
        __syncthreads();
    }
    const int lane = F.lane;
    for (int r = F.gw; r < nrows; r += F.nw) {
        const float* xr = r < NLAT ? srcL + (size_t)r * D : srcC + (size_t)(r - NLAT) * D;
        const float* mv = modv + (size_t)row_mi(r) * MODW;
        f32x4 x[4]; float ss = 0.f;
#pragma unroll
        for (int j = 0; j < 4; ++j) { x[j] = *(const f32x4*)(xr + j * 256 + lane * 4); ss += x[j][0] * x[j][0] + x[j][1] * x[j][1] + x[j][2] * x[j][2] + x[j][3] * x[j][3]; }
        ss = wave_sum(ss);
        const float rstd = rsqrtf(ss * (1.0f / D) + 1e-6f);
        float lg[NEXP];
        if (ROUTER) {
#pragma unroll
            for (int e = 0; e < NEXP; ++e) lg[e] = 0.f;
        }
#pragma unroll
        for (int j = 0; j < 4; ++j) { const int c = j * 256 + lane * 4;
            const f32x4 gg = *(const f32x4*)(g + c), sh = *(const f32x4*)(mv + c), sc = *(const f32x4*)(mv + D + c);
            f32x4 y = (x[j] * rstd * gg) * (sc + 1.0f) + sh;
            u32x2 w; w.x = pk_bf16(y[0], y[1]); w.y = pk_bf16(y[2], y[3]);
            *(u32x2*)(HL + (size_t)r * D + c) = w;
            if (ROUTER) {
#pragma unroll
                for (int q = 0; q < 4; ++q) { const f32x4 r0 = *(const LAS f32x4*)(rt + (c + q) * 8), r1 = *(const LAS f32x4*)(rt + (c + q) * 8 + 4);
                    lg[0] += y[q] * r0[0]; lg[1] += y[q] * r0[1]; lg[2] += y[q] * r0[2]; lg[3] += y[q] * r0[3];
                    lg[4] += y[q] * r1[0]; lg[5] += y[q] * r1[1]; lg[6] += y[q] * r1[2]; lg[7] += y[q] * r1[3]; asm volatile("" ::: "memory"); }
            }
        }
        if (ROUTER) {
#pragma unroll
            for (int e = 0; e < NEXP; ++e) lg[e] = wave_sum(lg[e]);
            if (lane == 0) {
                int e1 = 0; float l1 = lg[0];
#pragma unroll
                for (int e = 1; e < NEXP; ++e) if (lg[e] > l1) { l1 = lg[e]; e1 = e; }
                int e2 = -1; float l2 = -3.0e38f;
#pragma unroll
                for (int e = 0; e < NEXP; ++e) if (e != e1 && lg[e] > l2) { l2 = lg[e]; e2 = e; }
                if (e2 < 0) { e2 = e1 == 0 ? 1 : 0; l2 = l1; }
                const float ex = __expf(l2 - l1), g1 = 1.0f / (1.0f + ex), g2 = ex * g1;
                unsigned* cnt = (unsigned*)(F.ws + WS_CTL) + CW_MOECNT;
                const unsigned p1 = atomicAdd(cnt + e1, 1u), p2 = atomicAdd(cnt + 8 + e2, 1u);
                int* te = (int*)(F.ws + WS_ROUTE + RT_TOKE); float* tg = (float*)(F.ws + WS_ROUTE + RT_TOKG); int* tp = (int*)(F.ws + WS_ROUTE + RT_TOKP);
                te[r * 2] = e1; te[r * 2 + 1] = e2; tg[r * 2] = g1; tg[r * 2 + 1] = g2; tp[r * 2] = (int)p1; tp[r * 2 + 1] = (int)p2;
            }
        }
    }
}
__device__ __forceinline__ void moe_tstart(const Frame& F, int pass, int (&ts)[9]) {
    const unsigned* cnt = (const unsigned*)(F.ws + WS_CTL) + CW_MOECNT + pass * 8;
    int a = 0;
#pragma unroll
    for (int e = 0; e < 8; ++e) { ts[e] = a; a += (int)((__hip_atomic_load(cnt + e, __ATOMIC_RELAXED, __HIP_MEMORY_SCOPE_AGENT) + 255u) >> 8); }
    ts[8] = a;
}
__device__ __forceinline__ void phase_moe_rowmap(const Frame& F) {
    int ts0[9], ts1[9]; moe_tstart(F, 0, ts0); moe_tstart(F, 1, ts1);
    const int* te = (const int*)(F.ws + WS_ROUTE + RT_TOKE); const float* tg = (const float*)(F.ws + WS_ROUTE + RT_TOKG); const int* tp = (const int*)(F.ws + WS_ROUTE + RT_TOKP);
    int* rmap = (int*)(F.ws + WS_ROUTE + RT_RMAP); float* sg = (float*)(F.ws + WS_ROUTE + RT_SGATE);
    for (int t = F.bid * NTHREADS + F.tid; t < NLAT; t += F.G * NTHREADS) {
        { const int e = te[t * 2]; int st = 0;
#pragma unroll
          for (int j = 0; j < 8; ++j) st = (e == j) ? ts0[j] : st;
          const int slot = st * 256 + tp[t * 2]; rmap[slot] = t; sg[slot] = tg[t * 2]; }
        { const int e = te[t * 2 + 1]; int st = 0;
#pragma unroll
          for (int j = 0; j < 8; ++j) st = (e == j) ? ts1[j] : st;
          const int slot = st * 256 + tp[t * 2 + 1]; rmap[NROW + slot] = t; sg[NROW + slot] = tg[t * 2 + 1]; }
    }
}

struct RowGeo { int b, tt, pos, len; };
__device__ __forceinline__ RowGeo row_geo(int r) { RowGeo g; if (r < NLAT) { g.b = r >> 12; g.pos = r & 4095; g.len = SEQ; g.tt = CTXL + g.pos; } else { const int q = r - NLAT; g.b = q >> 8; g.pos = q & 255; g.len = CTXL; g.tt = g.pos; } return g; }

__device__ __forceinline__ void rw_shift4(const bf16_t* PL, const float* mup, const float* mun, int r, const RowGeo& g, int j, float (&u)[4]) {
    const bf16_t* p = PL + (size_t)r * INW + O_RW + j;
    const bool hp = g.pos > 0, hn = g.pos < g.len - 1;
    float c[4], pv[4], nv[4];
    unpack4(*(const u32x2*)p, c); unpack4(*(const u32x2*)(p - (hp ? INW : 0)), pv); unpack4(*(const u32x2*)(p + (hn ? INW : 0)), nv);
    const f32x4 mp = *(const f32x4*)(mup + j), mn = *(const f32x4*)(mun + j);
#pragma unroll
    for (int q = 0; q < 4; ++q) u[q] = c[q] + mp[q] * ((hp ? pv[q] : 0.f) - c[q]) + mn[q] * ((hn ? nv[q] : 0.f) - c[q]);
}

__device__ __forceinline__ void rw_shift8(const bf16_t* PL, const float* mup, const float* mun, int r, const RowGeo& g, int j, float (&u)[8]) {
    const bf16_t* p = PL + (size_t)r * INW + O_RW + j;
    const bool hp = g.pos > 0, hn = g.pos < g.len - 1;
    float c[8], pv[8], nv[8];
    unpack8(*(const u32x4*)p, c); unpack8(*(const u32x4*)(p - (hp ? INW : 0)), pv); unpack8(*(const u32x4*)(p + (hn ? INW : 0)), nv);
    const f32x4 mp0 = *(const f32x4*)(mup + j), mp1 = *(const f32x4*)(mup + j + 4), mn0 = *(const f32x4*)(mun + j), mn1 = *(const f32x4*)(mun + j + 4);
#pragma unroll
    for (int q = 0; q < 4; ++q) { u[q] = c[q] + mp0[q] * ((hp ? pv[q] : 0.f) - c[q]) + mn0[q] * ((hn ? nv[q] : 0.f) - c[q]);
        u[4 + q] = c[4 + q] + mp1[q] * ((hp ? pv[4 + q] : 0.f) - c[4 + q]) + mn1[q] * ((hn ? nv[4 + q] : 0.f) - c[4 + q]); }
}
__device__ __forceinline__ bf16x8 pack8f(const float (&f)[8]) {
    u32x4 w; w.x = cvt_pk_bf16(f[0], f[1]); w.y = cvt_pk_bf16(f[2], f[3]); w.z = cvt_pk_bf16(f[4], f[5]); w.w = cvt_pk_bf16(f[6], f[7]); return __builtin_bit_cast(bf16x8, w);
}
__device__ __forceinline__ void phase_rw_prep(const Frame& F, const Params& P, int l) {
    const bf16_t* PL = (const bf16_t*)(F.ws + WS_PL);
    const float* mup = P.in[I_MUP] + l * 1280; const float* mun = P.in[I_MUN] + l * 1280;
    f16_t* SH = (f16_t*)(F.ws + WS_SH); f16_t* SD = (f16_t*)(F.ws + WS_SD);
    const int lane = F.lane;
    for (int tile = F.gw; tile < NROW / 16; tile += F.nw) {
        int l1 = lane; asm volatile("" : "+v"(l1)); const int tk = l1 & 15, g = l1 >> 4;
        const int r = tile * 16 + tk; const RowGeo geo = row_geo(r);
        bf16x8 tw[2][2], ta[2][2];
#pragma unroll
        for (int d = 0; d < 2; ++d)
#pragma unroll
            for (int kk = 0; kk < 2; ++kk) { float u[8];
                rw_shift8(PL, mup, mun, r, geo, 768 + 256 * d + 32 * kk + 8 * g, u);
#pragma unroll
                for (int q = 0; q < 8; ++q) u[q] = 1.0f - 2.0f / (1.0f + __expf(2.0f * u[q]));
                tw[d][kk] = pack8f(u);
                rw_shift8(PL, mup, mun, r, geo, 832 + 256 * d + 32 * kk + 8 * g, u); ta[d][kk] = pack8f(u); asm volatile("" ::: "memory"); }
#pragma unroll 1
        for (int h = 0; h < 4; ++h) {
            int l2 = lane; asm volatile("" : "+v"(l2)); const int tk = l2 & 15, g = l2 >> 4;
            const int r = tile * 16 + tk; const RowGeo geo = row_geo(r);
            float ur[4][4], uk[4][4], uv[4][4], kkv[4][4]; float ss = 0.f;
#pragma unroll
            for (int t = 0; t < 4; ++t) { const int c = 64 * h + 16 * t + 4 * g;
                rw_shift4(PL, mup, mun, r, geo, c, ur[t]); rw_shift4(PL, mup, mun, r, geo, 256 + c, uk[t]); rw_shift4(PL, mup, mun, r, geo, 512 + c, uv[t]);
                const f32x4 kkw = *(const f32x4*)(P.in[I_KK] + l * 256 + c);
#pragma unroll
                for (int q = 0; q < 4; ++q) { kkv[t][q] = uk[t][q] * kkw[q]; ss += kkv[t][q] * kkv[t][q]; } asm volatile("" ::: "memory"); }
            ss += __shfl_xor(ss, 16); ss += __shfl_xor(ss, 32);
            const float rn = rsqrtf(ss + 1e-12f);
            const size_t shrow = ((size_t)(geo.b * 4 + h) * TT + geo.tt) * 192;
#pragma unroll
            for (int t = 0; t < 4; ++t) { f16x4 o1, o2, o3;
#pragma unroll
                for (int q = 0; q < 4; ++q) { kkv[t][q] *= rn; o1[q] = (f16_t)ur[t][q]; o2[q] = (f16_t)uv[t][q]; o3[q] = (f16_t)(-kkv[t][q]); }
                f16_t* sp = SH + shrow + 16 * t + 4 * g; *(f16x4*)sp = o1; *(f16x4*)(sp + 64) = o2; *(f16x4*)(sp + 128) = o3; }
#pragma unroll 1
            for (int d = 0; d < 2; ++d) {
                const bf16_t* w2t = (const bf16_t*)(F.ws + WS_LORA + (size_t)(l * 2 + d) * LORA_LD_BYTES); const bf16_t* a2t = w2t + 256 * 64;
                const size_t sdrow = ((size_t)((d * 8 + geo.b) * 4 + h) * TT + geo.tt) * 192;
                const bf16x8 tw0 = d ? tw[1][0] : tw[0][0], tw1 = d ? tw[1][1] : tw[0][1], ta0 = d ? ta[1][0] : ta[0][0], ta1 = d ? ta[1][1] : ta[0][1];
#pragma unroll
                for (int t = 0; t < 4; ++t) { const int c = 64 * h + 16 * t + 4 * g;
                    const bf16_t* wr = w2t + (size_t)(64 * h + 16 * t + tk) * 64 + 8 * g; const bf16_t* ar = a2t + (size_t)(64 * h + 16 * t + tk) * 64 + 8 * g;
                    f32x4 xw = *(const f32x4*)(P.in[I_W0] + (l * 2 + d) * 256 + c), xa = *(const f32x4*)(P.in[I_A0] + (l * 2 + d) * 256 + c);
                    xw = __builtin_amdgcn_mfma_f32_16x16x32_bf16(*(const bf16x8*)wr, tw0, xw, 0, 0, 0); xw = __builtin_amdgcn_mfma_f32_16x16x32_bf16(*(const bf16x8*)(wr + 32), tw1, xw, 0, 0, 0);
                    xa = __builtin_amdgcn_mfma_f32_16x16x32_bf16(*(const bf16x8*)ar, ta0, xa, 0, 0, 0); xa = __builtin_amdgcn_mfma_f32_16x16x32_bf16(*(const bf16x8*)(ar + 32), ta1, xa, 0, 0, 0);
                    const f32x4 kaw = *(const f32x4*)(P.in[I_KA] + l * 256 + c);
                    f16x4 o1, o2, o3;
#pragma unroll
                    for (int q = 0; q < 4; ++q) {
                        const float nx = -xw[q]; const float sp = fmaxf(nx, 0.f) + __logf(1.0f + __expf(-fabsf(nx)));
                        const float e = __expf(-sp - 0.5f);
                        const float omw = 1.0f - __expf(-e);
                        const float a = sigmoidf_(xa[q]);
                        o1[q] = (f16_t)omw; o2[q] = (f16_t)(uk[t][q] * (1.0f + (a - 1.0f) * kaw[q])); o3[q] = (f16_t)(kkv[t][q] * a); }
                    f16_t* sp = SD + sdrow + 16 * t + 4 * g; *(f16x4*)sp = o1; *(f16x4*)(sp + 64) = o2; *(f16x4*)(sp + 128) = o3; asm volatile("" ::: "memory"); }
            }
        }
    }
}

constexpr int SC_CH = 32;
constexpr int SC_BUF = SC_CH * 6 * 64 * 4;
__device__ __forceinline__ float dpp_sum16(float v) {
    v += __builtin_bit_cast(float, __builtin_amdgcn_update_dpp(0, __builtin_bit_cast(int, v), 0xB1, 0xF, 0xF, true));
    v += __builtin_bit_cast(float, __builtin_amdgcn_update_dpp(0, __builtin_bit_cast(int, v), 0x4E, 0xF, 0xF, true));
    v += __builtin_bit_cast(float, __builtin_amdgcn_update_dpp(0, __builtin_bit_cast(int, v), 0x141, 0xF, 0xF, true));
    v += __builtin_bit_cast(float, __builtin_amdgcn_update_dpp(0, __builtin_bit_cast(int, v), 0x140, 0xF, 0xF, true));
    return v;
}
__device__ __forceinline__ int scan_tt0(int d, int c) { return d == 0 ? c * SC_CH : (c < 8 ? 224 - 32 * c : 4576 - 32 * c); }
constexpr int CS_ZP = 0, CS_RPP = 2048, CS_BH = 4096, CS_KH = 6144, CS_VV = 8192, CS_MT = 10240, CS_NT = 11264, CS_WC = 12288, CS_SLOT = 12544;
constexpr int CS_ZIMG = 8 * CS_SLOT;
constexpr int CS_NCHUNK = TT / 16;
__device__ __forceinline__ int cs_tt(int d, int q, int s) { const int st = 16 * q + s; return d == 0 ? st : (st < CTXL ? CTXL - 1 - st : TT + CTXL - 1 - st); }
__device__ __forceinline__ float dpp_shr(float old, float v, int) { return v; }
template <int N> __device__ __forceinline__ float row_shr(float v, float old) {
    return __builtin_bit_cast(float, __builtin_amdgcn_update_dpp(__builtin_bit_cast(int, old), __builtin_bit_cast(int, v), 0x110 + N, 0xF, 0xF, false));
}
__device__ __forceinline__ bf16x8 cs_pack(const float (&a)[4], const float (&b)[4]) {
    u32x4 w; w.x = cvt_pk_bf16(a[0], a[1]); w.y = cvt_pk_bf16(a[2], a[3]); w.z = cvt_pk_bf16(b[0], b[1]); w.w = cvt_pk_bf16(b[2], b[3]); return __builtin_bit_cast(bf16x8, w);
}
__device__ __forceinline__ bf16x8 cs_op16(const f32x4& x) { u32x4 w; w.x = cvt_pk_bf16(x[0], x[1]); w.y = cvt_pk_bf16(x[2], x[3]); w.z = 0u; w.w = 0u; return __builtin_bit_cast(bf16x8, w); }
#define CS_MFMA(a, b, c) __builtin_amdgcn_mfma_f32_16x16x32_bf16((a), (b), (c), 0, 0, 0)
__device__ __forceinline__ f32x4 cs_mm16(const f32x4& xt_d, const f32x4& y_d) { return CS_MFMA(cs_op16(xt_d), cs_op16(y_d), ((f32x4){0.f, 0.f, 0.f, 0.f})); }
__device__ __forceinline__ v4i16_t cs_tr(const LAS unsigned char* img, int lane, int T) {
    const int g = lane >> 4, q = (lane & 15) >> 2, p = lane & 3;
    return __builtin_amdgcn_ds_read_tr16_b64_v4i16((LAS v4i16_t*)(img + (4 * g + q) * 128 + p * 32 + (T >> 1) * 16 + (T & 1) * 8));
}
__device__ __forceinline__ bf16x8 cs_lo(v4i16_t x) { bf16x8 r; r[0] = x[0]; r[1] = x[1]; r[2] = x[2]; r[3] = x[3]; r[4] = 0; r[5] = 0; r[6] = 0; r[7] = 0; return r; }

struct CsRaw { u32x2 x[4], z[4], r[4], b[4], k[4], v[4]; };
__device__ __forceinline__ void cs_load(CsRaw& R, const f16_t* sh, const f16_t* sd, int d, int q, int lane) {
    const int s = lane & 15, g = lane >> 4; const int tt = cs_tt(d, q, s);
    const f16_t* shp = sh + (size_t)tt * 192 + 4 * g; const f16_t* sdp = sd + (size_t)tt * 192 + 4 * g;
#pragma unroll
    for (int T = 0; T < 4; ++T) { R.x[T] = *(const u32x2*)(sdp + 16 * T); R.z[T] = *(const u32x2*)(shp + 128 + 16 * T); R.r[T] = *(const u32x2*)(shp + 16 * T);
        R.b[T] = *(const u32x2*)(sdp + 128 + 16 * T); R.k[T] = *(const u32x2*)(sdp + 64 + 16 * T); R.v[T] = *(const u32x2*)(shp + 64 + 16 * T); }
}
__device__ __forceinline__ void cs_prepass(LAS unsigned char* slot, LAS unsigned char* zimg, CsRaw& raw, const f16_t* sh, const f16_t* sd, int d, int qn, int lane) {
    const int s = lane & 15, g = lane >> 4;
    float Wc[4][4], Wp[4][4], iW[4][4];
#pragma unroll
    for (int T = 0; T < 4; ++T) { const f16x4 x4 = __builtin_bit_cast(f16x4, raw.x[T]);
#pragma unroll
        for (int j = 0; j < 4; ++j) { float wc = 1.0f - (float)x4[j];
            wc *= row_shr<1>(wc, 1.0f); wc *= row_shr<2>(wc, 1.0f); wc *= row_shr<4>(wc, 1.0f); wc *= row_shr<8>(wc, 1.0f);
            Wc[T][j] = wc; Wp[T][j] = row_shr<1>(wc, 1.0f); iW[T][j] = __builtin_amdgcn_rcpf(wc); } }
    if (s == 15) {
#pragma unroll
        for (int T = 0; T < 4; ++T) *(LAS f32x4*)(slot + CS_WC + (16 * T + 4 * g) * 4) = (f32x4){Wc[T][0], Wc[T][1], Wc[T][2], Wc[T][3]}; }
    bf16x8 oZ[2], oR[2], oB[2], oK[2];
    const int ioff = s * 128 + g * 32;
#define CS_STAGE(dst, SRC, SC, IMG) do { float t_[4][4]; \
        _Pragma("unroll") for (int T = 0; T < 4; ++T) { const f16x4 q4 = __builtin_bit_cast(f16x4, SRC[T]); \
            _Pragma("unroll") for (int j = 0; j < 4; ++j) t_[T][j] = (float)q4[j] * SC; } \
        _Pragma("unroll") for (int kk = 0; kk < 2; ++kk) { dst[kk] = cs_pack(t_[2 * kk], t_[2 * kk + 1]); if (IMG) *(LAS bf16x8*)((IMG) + ioff + kk * 16) = dst[kk]; } \
        } while (0)
    CS_STAGE(oZ, raw.z, Wp[T][j], zimg);
    CS_STAGE(oR, raw.r, Wc[T][j], (LAS unsigned char*)nullptr);
    CS_STAGE(oB, raw.b, iW[T][j], slot + CS_BH);
    CS_STAGE(oK, raw.k, iW[T][j], slot + CS_KH);
    { bf16x8 oV[2]; CS_STAGE(oV, raw.v, 1.0f, slot + CS_VV); }
#undef CS_STAGE
    asm volatile("" ::: "memory");
    if (qn >= 0) cs_load(raw, sh, sd, d, qn, lane);
    const f32x4 zero4 = (f32x4){0.f, 0.f, 0.f, 0.f};
    f32x4 A_D = CS_MFMA(oB[1], oZ[1], CS_MFMA(oB[0], oZ[0], zero4)), AT_D = CS_MFMA(oZ[1], oB[1], CS_MFMA(oZ[0], oB[0], zero4));
    f32x4 BkT_D = CS_MFMA(oZ[1], oK[1], CS_MFMA(oZ[0], oK[0], zero4));
    f32x4 Ar_D = CS_MFMA(oB[1], oR[1], CS_MFMA(oB[0], oR[0], zero4)), Kr_D = CS_MFMA(oK[1], oR[1], CS_MFMA(oK[0], oR[0], zero4));
    f32x4 I_D;
#pragma unroll
    for (int j = 0; j < 4; ++j) { const int m = 4 * g + j;
        A_D[j] = m < s ? A_D[j] : 0.f; AT_D[j] = s < m ? AT_D[j] : 0.f; BkT_D[j] = s < m ? BkT_D[j] : 0.f;
        Ar_D[j] = m <= s ? Ar_D[j] : 0.f; Kr_D[j] = m <= s ? Kr_D[j] : 0.f; I_D[j] = m == s ? 1.f : 0.f; }
    f32x4 Ab, AbT, A1, A2m;
#pragma unroll
    for (int j = 0; j < 4; ++j) { const int m = 4 * g + j; const bool b0 = (m >> 2) == (s >> 2), b1 = (m >> 3) == (s >> 3);
        Ab[j] = b0 ? A_D[j] : 0.f; AbT[j] = b0 ? AT_D[j] : 0.f; A1[j] = (b1 && !b0) ? A_D[j] : 0.f; A2m[j] = b1 ? 0.f : A_D[j]; }
    const f32x4 Ab2 = cs_mm16(AbT, Ab), Ab2T = cs_mm16(Ab, AbT);
    const f32x4 P0 = I_D + Ab, P0T = I_D + AbT;
    const f32x4 T0 = P0 + cs_mm16(P0T, Ab2), T0T = P0T + cs_mm16(Ab2, P0T);
    (void)Ab2T;
    const f32x4 ZT = cs_mm16(A1, T0T);
    const f32x4 T1 = T0 + cs_mm16(ZT, T0), T1T = T0T + cs_mm16(T0, ZT);
    const f32x4 Z2T = cs_mm16(A2m, T1T);
    const f32x4 T_D = T1 + cs_mm16(Z2T, T1);
    const f32x4 M_D = cs_mm16(BkT_D, T_D), MT_D = cs_mm16(T_D, BkT_D);
    const f32x4 N_D = cs_mm16(MT_D, Ar_D) + Kr_D;
    { u32x4 w; w.x = cvt_pk_bf16(M_D[0], M_D[1]); w.y = cvt_pk_bf16(M_D[2], M_D[3]); w.z = 0u; w.w = 0u; *(LAS u32x4*)(slot + CS_MT + s * 64 + g * 16) = w;
      w.x = cvt_pk_bf16(N_D[0], N_D[1]); w.y = cvt_pk_bf16(N_D[2], N_D[3]); *(LAS u32x4*)(slot + CS_NT + s * 64 + g * 16) = w; }
    __builtin_amdgcn_wave_barrier(); asm volatile("" ::: "memory");
    const bf16x8 oT = cs_op16(T_D), oAr = cs_op16(Ar_D);
    float Zp[4][4];
#pragma unroll
    for (int T = 0; T < 4; ++T) { const f32x4 zp = CS_MFMA(cs_lo(cs_tr(zimg, lane, T)), oT, zero4);
#pragma unroll
        for (int j = 0; j < 4; ++j) Zp[T][j] = zp[j]; }
#pragma unroll
    for (int kk = 0; kk < 2; ++kk) *(LAS bf16x8*)(slot + CS_ZP + s * 128 + g * 32 + kk * 16) = cs_pack(Zp[2 * kk], Zp[2 * kk + 1]);
    __builtin_amdgcn_wave_barrier(); asm volatile("" ::: "memory");
    float Rp[4][4];
#pragma unroll
    for (int T = 0; T < 4; ++T) { const f32x4 rp = CS_MFMA(cs_lo(cs_tr(slot + CS_ZP, lane, T)), oAr, zero4);
#pragma unroll
        for (int j = 0; j < 4; ++j) Rp[T][j] = rp[j] + bf2f((bf16_t)oR[T >> 1][(T & 1) * 4 + j]); }
#pragma unroll
    for (int kk = 0; kk < 2; ++kk) *(LAS bf16x8*)(slot + CS_RPP + s * 128 + g * 32 + kk * 16) = cs_pack(Rp[2 * kk], Rp[2 * kk + 1]);
}
__device__ __forceinline__ void cs_scan_chunk(const LAS unsigned char* slot, f32x4 (&acc)[4], float* yp  , int d, int q, int wave, int lane) {
    const int s = lane & 15, g = lane >> 4;
    const f32x4 zero4 = (f32x4){0.f, 0.f, 0.f, 0.f};
    bf16x8 Xb[2];
#pragma unroll
    for (int kk = 0; kk < 2; ++kk) { u32x4 w; w.x = cvt_pk_bf16(acc[2 * kk][0], acc[2 * kk][1]); w.y = cvt_pk_bf16(acc[2 * kk][2], acc[2 * kk][3]);
        w.z = cvt_pk_bf16(acc[2 * kk + 1][0], acc[2 * kk + 1][1]); w.w = cvt_pk_bf16(acc[2 * kk + 1][2], acc[2 * kk + 1][3]); Xb[kk] = __builtin_bit_cast(bf16x8, w); }
    const v4i16_t vt = cs_tr(slot + CS_VV, lane, wave);
    const bf16x8 Vb = cs_lo(vt);
    const int arow = s * 128 + g * 32, a16 = s * 64 + g * 16;
    f32x4 UT = CS_MFMA(*(const LAS bf16x8*)(slot + CS_ZP + arow), Xb[0], zero4); UT = CS_MFMA(*(const LAS bf16x8*)(slot + CS_ZP + arow + 16), Xb[1], UT); UT = CS_MFMA(*(const LAS bf16x8*)(slot + CS_MT + a16), Vb, UT);
    f32x4 YT = CS_MFMA(*(const LAS bf16x8*)(slot + CS_RPP + arow), Xb[0], zero4); YT = CS_MFMA(*(const LAS bf16x8*)(slot + CS_RPP + arow + 16), Xb[1], YT); YT = CS_MFMA(*(const LAS bf16x8*)(slot + CS_NT + a16), Vb, YT);
#pragma unroll
    for (int j = 0; j < 4; ++j) yp[(size_t)cs_tt(d, q, 4 * g + j) * 256] = YT[j];
    bf16x8 UV; { u32x2 w; w.x = cvt_pk_bf16(UT[0], UT[1]); w.y = cvt_pk_bf16(UT[2], UT[3]); const v4i16_t ub = __builtin_bit_cast(v4i16_t, w);
        UV[0] = ub[0]; UV[1] = ub[1]; UV[2] = ub[2]; UV[3] = ub[3]; UV[4] = vt[0]; UV[5] = vt[1]; UV[6] = vt[2]; UV[7] = vt[3]; }
#pragma unroll
    for (int T = 0; T < 4; ++T) { const v4i16_t bh = cs_tr(slot + CS_BH, lane, T), kh = cs_tr(slot + CS_KH, lane, T);
        bf16x8 BK; BK[0] = bh[0]; BK[1] = bh[1]; BK[2] = bh[2]; BK[3] = bh[3]; BK[4] = kh[0]; BK[5] = kh[1]; BK[6] = kh[2]; BK[7] = kh[3];
        acc[T] = CS_MFMA(BK, UV, acc[T]);
        acc[T] *= *(const LAS f32x4*)(slot + CS_WC + (16 * T + 4 * g) * 4); }
}
__device__ __forceinline__ void phase_scan(const Frame& F) {
    const f16_t* SH = (const f16_t*)(F.ws + WS_SH); const f16_t* SD = (const f16_t*)(F.ws + WS_SD);
    float* Y = (float*)(F.ws + WS_Y);
    const int lane = F.lane, wave = F.wave;
    for (int chain = F.bid; chain < 64; chain += F.G) {
        const int d = chain >> 5, b = (chain >> 2) & 7, h = chain & 3;
        const f16_t* sh = SH + (size_t)(b * 4 + h) * TT * 192; const f16_t* sd = SD + (size_t)((d * 8 + b) * 4 + h) * TT * 192;
        float* yp = Y + ((size_t)(d * 8 + b) * TT) * 256 + h * 64 + 16 * (wave & 3) + (lane & 15);
        f32x4 acc[4];
#pragma unroll
        for (int T = 0; T < 4; ++T) acc[T] = (f32x4){0.f, 0.f, 0.f, 0.f};
        __syncthreads();
        CsRaw rawA, rawB;
        const int pw = wave - 4;
        constexpr int NR = CS_NCHUNK / 4;
        if (wave >= 4) { cs_load(rawA, sh, sd, d, pw, lane); cs_load(rawB, sh, sd, d, 4 + pw, lane);
            cs_prepass(F.lds + pw * CS_SLOT, F.lds + CS_ZIMG + pw * 2048, rawA, sh, sd, d, 8 + pw, lane); }
        __syncthreads();
        for (int r = 0; r < NR; r += 2) {
            if (wave >= 4) { cs_prepass(F.lds + (4 + pw) * CS_SLOT, F.lds + CS_ZIMG + pw * 2048, rawB, sh, sd, d, (r + 3 < NR) ? 4 * (r + 3) + pw : -1, lane); }
            else {
#pragma unroll 1
                for (int c4 = 0; c4 < 4; ++c4) cs_scan_chunk(F.lds + c4 * CS_SLOT, acc, yp, d, 4 * r + c4, wave, lane);
            }
            asm volatile("s_waitcnt lgkmcnt(0)" ::: "memory"); __builtin_amdgcn_s_barrier(); asm volatile("" ::: "memory");
            if (wave >= 4) { if (r + 2 < NR) cs_prepass(F.lds + pw * CS_SLOT, F.lds + CS_ZIMG + pw * 2048, rawA, sh, sd, d, (r + 4 < NR) ? 4 * (r + 4) + pw : -1, lane); }
            else {
#pragma unroll 1
                for (int c4 = 0; c4 < 4; ++c4) cs_scan_chunk(F.lds + (4 + c4) * CS_SLOT, acc, yp, d, 4 * (r + 1) + c4, wave, lane);
            }
            asm volatile("s_waitcnt lgkmcnt(0)" ::: "memory"); __builtin_amdgcn_s_barrier(); asm volatile("" ::: "memory");
        }
    }
}

__device__ __forceinline__ void phase_rw_post(const Frame& F, const Params& P, int l, int nrows) {
    const bf16_t* PL = (const bf16_t*)(F.ws + WS_PL); bf16_t* MIX = (bf16_t*)(F.ws + WS_MIX);
    const f16_t* SH = (const f16_t*)(F.ws + WS_SH); const f16_t* SD = (const f16_t*)(F.ws + WS_SD); const float* Y = (const float*)(F.ws + WS_Y);
    const float* mup = P.in[I_MUP] + l * 1280; const float* mun = P.in[I_MUN] + l * 1280;
    const int lane = F.lane;
    for (int tile = F.gw; tile < nrows / 16; tile += F.nw) {
        int l1 = lane; asm volatile("" : "+v"(l1)); const int tk = l1 & 15, g = l1 >> 4;
        const int r = tile * 16 + tk; const RowGeo geo = row_geo(r);
        bf16x8 sg[2][4];
#pragma unroll
        for (int d = 0; d < 2; ++d)
#pragma unroll
            for (int kk = 0; kk < 4; ++kk) { float u[8]; rw_shift8(PL, mup, mun, r, geo, 896 + 256 * d + 32 * kk + 8 * g, u);
#pragma unroll
                for (int q = 0; q < 8; ++q) u[q] = sigmoidf_(u[q]);
                sg[d][kk] = pack8f(u); asm volatile("" ::: "memory"); }
#pragma unroll 1
        for (int h = 0; h < 4; ++h) {
            int l2 = lane; asm volatile("" : "+v"(l2)); const int tk = l2 & 15, g = l2 >> 4;
            const int r = tile * 16 + tk; const RowGeo geo = row_geo(r);
            const size_t shrow = ((size_t)(geo.b * 4 + h) * TT + geo.tt) * 192;
            float out[4][4];
#pragma unroll
            for (int t = 0; t < 4; ++t)
#pragma unroll
                for (int q = 0; q < 4; ++q) out[t][q] = 0.f;
#pragma unroll 1
            for (int d = 0; d < 2; ++d) {
                const bf16_t* g2t = (const bf16_t*)(F.ws + WS_LORA + (size_t)(l * 2 + d) * LORA_LD_BYTES) + 2 * 256 * 64;
                const size_t sdrow = ((size_t)((d * 8 + geo.b) * 4 + h) * TT + geo.tt) * 192;
                const float* yrow = Y + ((size_t)(d * 8 + geo.b) * TT + geo.tt) * 256 + 64 * h + 4 * g;
                bf16x8 sgd[4];
#pragma unroll
                for (int kk = 0; kk < 4; ++kk) sgd[kk] = d ? sg[1][kk] : sg[0][kk];
                f32x4 y[4], gg[4]; float sm = 0.f, bs = 0.f;
#pragma unroll
                for (int t = 0; t < 4; ++t) { const int c = 64 * h + 16 * t + 4 * g;
                    y[t] = *(const f32x4*)(yrow + 16 * t); sm += (y[t][0] + y[t][1]) + (y[t][2] + y[t][3]);
                    const f16x4 rh = *(const f16x4*)(SH + shrow + 16 * t + 4 * g), kdh = *(const f16x4*)(SD + sdrow + 64 + 16 * t + 4 * g);
                    const f32x4 rk = *(const f32x4*)(P.in[I_RK] + l * 256 + c);
#pragma unroll
                    for (int q = 0; q < 4; ++q) bs += (float)rh[q] * (float)kdh[q] * rk[q];
                    const bf16_t* gr = g2t + (size_t)(64 * h + 16 * t + tk) * 128 + 8 * g;
                    f32x4 a = (f32x4){0.f, 0.f, 0.f, 0.f};
#pragma unroll
                    for (int kk = 0; kk < 4; ++kk) a = __builtin_amdgcn_mfma_f32_16x16x32_bf16(*(const bf16x8*)(gr + 32 * kk), sgd[kk], a, 0, 0, 0);
                    gg[t] = a; asm volatile("" ::: "memory"); }
                sm += __shfl_xor(sm, 16); sm += __shfl_xor(sm, 32); bs += __shfl_xor(bs, 16); bs += __shfl_xor(bs, 32);
                const float mu = sm * (1.0f / 64.0f); float vs = 0.f;
#pragma unroll
                for (int t = 0; t < 4; ++t)
#pragma unroll
                    for (int q = 0; q < 4; ++q) { const float dd = y[t][q] - mu; vs += dd * dd; }
                vs += __shfl_xor(vs, 16); vs += __shfl_xor(vs, 32);
                const float rstd = rsqrtf(vs * (1.0f / 64.0f) + 64e-5f);
#pragma unroll
                for (int t = 0; t < 4; ++t) { const int c = 64 * h + 16 * t + 4 * g;
                    const f32x4 gng = *(const f32x4*)(P.in[I_GNG] + l * 256 + c), gnb = *(const f32x4*)(P.in[I_GNB] + l * 256 + c);
                    const f16x4 vh = *(const f16x4*)(SH + shrow + 64 + 16 * t + 4 * g);
#pragma unroll
                    for (int q = 0; q < 4; ++q) out[t][q] += ((y[t][q] - mu) * rstd * gng[q] + gnb[q] + bs * (float)vh[q]) * gg[t][q]; }
            }
#pragma unroll
            for (int t = 0; t < 4; ++t) { u32x2 w; w.x = cvt_pk_bf16(out[t][0], out[t][1]); w.y = cvt_pk_bf16(out[t][2], out[t][3]);
                *(u32x2*)(MIX + (size_t)r * D + 512 + 64 * h + 16 * t + 4 * g) = w; }
        }
    }
}

constexpr int CV_SEG = 64, CV_ROWS = CV_SEG + 30, CV_H = 0, CV_W = CV_ROWS * 256 * 4;
__device__ __forceinline__ void phase_conv(const Frame& F, const Params& P, int l, int nrows) {
    const bf16_t* PL = (const bf16_t*)(F.ws + WS_PL); bf16_t* MIX = (bf16_t*)(F.ws + WS_MIX);
    const int lane = F.lane, c4 = lane * 4, wave = F.wave;
    LAS float* H = (LAS float*)(F.lds + CV_H); LAS float* W = (LAS float*)(F.lds + CV_W);
    for (int i = F.tid; i < 31 * 256; i += NTHREADS) W[i] = P.in[I_DWW][(size_t)l * 31 * 256 + i];
    const f32x4 dwb = *(const f32x4*)(P.in[I_DWB] + l * 256 + c4), lng = *(const f32x4*)(P.in[I_LNG] + l * 256 + c4), lnb = *(const f32x4*)(P.in[I_LNB] + l * 256 + c4);
    for (int seg = F.bid; seg < nrows / CV_SEG; seg += F.G) {
        const int r0 = seg * CV_SEG; const RowGeo g0 = row_geo(r0);
        __syncthreads();
#pragma unroll 4
        for (int k = 0; k < 12; ++k) { const int rr = wave + 8 * k;
            if (rr < CV_ROWS) { const int pos = g0.pos - 15 + rr; f32x4 hv = (f32x4){0.f, 0.f, 0.f, 0.f};
                if (pos >= 0 && pos < g0.len) { const bf16_t* p = PL + (size_t)(r0 - 15 + rr) * INW + O_CV + c4; float a[4], bb[4];
                    unpack4(*(const u32x2*)p, a); unpack4(*(const u32x2*)(p + 256), bb);
#pragma unroll
                    for (int q = 0; q < 4; ++q) hv[q] = a[q] * sigmoidf_(bb[q]); }
                *(LAS f32x4*)(H + rr * 256 + c4) = hv; } }
        __syncthreads();
        f32x4 acc[8];
#pragma unroll
        for (int t = 0; t < 8; ++t) acc[t] = dwb;
#pragma unroll 1
        for (int j = 0; j < 31; ++j) { const f32x4 w = *(const LAS f32x4*)(W + j * 256 + c4);
#pragma unroll
            for (int t = 0; t < 8; ++t) acc[t] += *(const LAS f32x4*)(H + (wave * 8 + t + j) * 256 + c4) * w; }
#pragma unroll
        for (int t = 0; t < 8; ++t) {
            const float mu = wave_sum((acc[t][0] + acc[t][1]) + (acc[t][2] + acc[t][3])) * (1.0f / 256.0f);
            float vs = 0.f;
#pragma unroll
            for (int q = 0; q < 4; ++q) { const float dd = acc[t][q] - mu; vs += dd * dd; }
            const float rstd = rsqrtf(wave_sum(vs) * (1.0f / 256.0f) + 1e-5f);
            float o[4];
#pragma unroll
            for (int q = 0; q < 4; ++q) o[q] = siluf_((acc[t][q] - mu) * rstd * lng[q] + lnb[q]);
            u32x2 w; w.x = pk_bf16(o[0], o[1]); w.y = pk_bf16(o[2], o[3]);
            *(u32x2*)(MIX + (size_t)(r0 + wave * 8 + t) * D + 768 + c4) = w; }
    }
}

__device__ __forceinline__ void phase_na_simple(const Frame& F, const Params& P, int l, int nq) {
    const bf16_t* PL = (const bf16_t*)(F.ws + WS_PL); bf16_t* MIX = (bf16_t*)(F.ws + WS_MIX);
    const float* rpb = P.in[I_RPB] + (size_t)l * 8 * 15 * 31;
    int tid_ = F.tid; asm volatile("" : "+v"(tid_));
    for (int gid = F.bid * NTHREADS + tid_; gid < nq * 8; gid += F.G * NTHREADS) {
        const int r = gid >> 3, h = gid & 7;
        const RowGeo g = row_geo(r);
        float q[64], o[64];
        { const bf16_t* qp = PL + (size_t)r * INW + O_Q + h * 64;
#pragma unroll
          for (int i = 0; i < 8; ++i) unpack8(*(const u32x4*)(qp + i * 8), q + i * 8); }
#pragma unroll
        for (int i = 0; i < 64; ++i) o[i] = 0.f;
        float m = -3.0e38f, lsum = 0.f;
        const bool lat = r < NLAT;
        const int gi = g.pos >> 6, gc = g.pos & 63;
        const int rs = min(max(gi - 4, 0), 56), wsc = min(max(gc - 8, 0), 48);
        const int nkey = lat ? 384 : 256;
#pragma unroll 1
        for (int kx = 0; kx < nkey; ++kx) {
            const bool win = lat && kx < 128;
            int krow; float bias = 0.f;
            if (win) { const int r8 = kx >> 4, cc = kx & 15; krow = g.b * SEQ + (rs + r8) * 64 + wsc + cc; bias = rpb[(h * 15 + (rs + r8 - gi + 7)) * 31 + (wsc + cc - gc + 15)]; }
            else krow = NLAT + g.b * CTXL + (kx - (lat ? 128 : 0));
            const bf16_t* kp = PL + (size_t)krow * INW + O_K + h * 64; float a = bias;
#pragma unroll
            for (int i = 0; i < 8; ++i) { float kf[8]; unpack8(*(const u32x4*)(kp + i * 8), kf);
#pragma unroll
                for (int j = 0; j < 8; ++j) a += q[i * 8 + j] * kf[j]; }
            if (a > m) { const float alpha = __expf(m - a); lsum *= alpha;
#pragma unroll
                for (int i = 0; i < 64; ++i) o[i] *= alpha;
                m = a; }
            const float p = __expf(a - m); lsum += p;
            const bf16_t* vp = kp + (O_V - O_K);
#pragma unroll
            for (int i = 0; i < 8; ++i) { float vf[8]; unpack8(*(const u32x4*)(vp + i * 8), vf);
#pragma unroll
                for (int j = 0; j < 8; ++j) o[i * 8 + j] += p * vf[j]; }
        }
        const float inv = 1.0f / lsum;
        bf16_t* op = MIX + (size_t)r * D + h * 64;
#pragma unroll
        for (int i = 0; i < 8; ++i) { u32x4 w; w.x = pk_bf16(o[i * 8] * inv, o[i * 8 + 1] * inv); w.y = pk_bf16(o[i * 8 + 2] * inv, o[i * 8 + 3] * inv);
            w.z = pk_bf16(o[i * 8 + 4] * inv, o[i * 8 + 5] * inv); w.w = pk_bf16(o[i * 8 + 6] * inv, o[i * 8 + 7] * inv); *(u32x4*)(op + i * 8) = w; }
    }
}

constexpr int NA_CK = 0, NA_CV = 32768, NA_RPB = 65536, NA_WV = 81920;
__device__ __forceinline__ bf16x8 na_pack8(const f32x4& a, const f32x4& b) {
    u32x4 w; w.x = cvt_pk_bf16(a[0], a[1]); w.y = cvt_pk_bf16(a[2], a[3]); w.z = cvt_pk_bf16(b[0], b[1]); w.w = cvt_pk_bf16(b[2], b[3]); return __builtin_bit_cast(bf16x8, w);
}
__device__ __forceinline__ bf16x8 na_vfrag(LAS unsigned char* blk, int lane, int dt) {
    const int g = lane >> 4, qq = (lane & 15) >> 2, p = lane & 3;
    const int r0 = 4 * g + qq, r1 = 16 + 4 * g + qq;
    const v4i16_t lo = __builtin_amdgcn_ds_read_tr16_b64_v4i16((LAS v4i16_t*)(blk + r0 * 128 + ((dt ^ ((r0 >> 1) & 3)) * 32) + p * 8));
    const v4i16_t hi = __builtin_amdgcn_ds_read_tr16_b64_v4i16((LAS v4i16_t*)(blk + r1 * 128 + ((dt ^ ((r1 >> 1) & 3)) * 32) + p * 8));
    bf16x8 r; r[0] = lo[0]; r[1] = lo[1]; r[2] = lo[2]; r[3] = lo[3]; r[4] = hi[0]; r[5] = hi[1]; r[6] = hi[2]; r[7] = hi[3]; return r;
}
template <bool WINDOW>
__device__ __forceinline__ void na_item(const Frame& F, const bf16_t* PL, bf16_t* MIX, int b, int h, int qrow0  , int gi, int cb) {
    const int lane = F.lane, ql = lane & 15, g = lane >> 4;
    LAS unsigned char* CK = F.lds + NA_CK; LAS unsigned char* CV = F.lds + NA_CV; const LAS float* RPB = (const LAS float*)(F.lds + NA_RPB);
    LAS unsigned char* WV = F.lds + NA_WV + F.wave * 4096;
    bf16x8 Qf[2];
    { const bf16_t* qp = PL + (size_t)(qrow0 + ql) * INW + O_Q + h * 64 + 8 * g; Qf[0] = *(const bf16x8*)qp; Qf[1] = *(const bf16x8*)(qp + 32); }
    f32x4 acc[4];
#pragma unroll
    for (int dt = 0; dt < 4; ++dt) acc[dt] = (f32x4){0.f, 0.f, 0.f, 0.f};
    float m_run = -3.0e38f, l_run = 0.f;
    if constexpr (WINDOW) {
        const int rs = min(max(gi - 4, 0), 56), kc0 = min(max(16 * cb - 8, 0), 32), qcol = 16 * cb + ql, wsq = min(max(qcol - 8, 0), 48);
        const size_t krow0 = (size_t)b * SEQ + (size_t)rs * 64 + kc0;
        f32x4 s[16];
#pragma unroll
        for (int t = 0; t < 16; ++t) { const bf16_t* kp = PL + (krow0 + (size_t)(t >> 1) * 64 + (t & 1) * 16 + ql) * INW + O_K + h * 64 + 8 * g;
            const bf16x8 k0 = *(const bf16x8*)kp, k1 = *(const bf16x8*)(kp + 32);
            s[t] = __builtin_amdgcn_mfma_f32_16x16x32_bf16(k0, Qf[0], (f32x4){0.f, 0.f, 0.f, 0.f}, 0, 0, 0);
            s[t] = __builtin_amdgcn_mfma_f32_16x16x32_bf16(k1, Qf[1], s[t], 0, 0, 0); }
        float mx = -3.0e38f;
#pragma unroll
        for (int t = 0; t < 16; ++t) { const LAS float* bp = RPB + (h * 15 + (rs + (t >> 1) - gi + 7)) * 31 + 15 - qcol;
#pragma unroll
            for (int j = 0; j < 4; ++j) { const int kcol = kc0 + (t & 1) * 16 + 4 * g + j; const bool ok = kcol >= wsq && kcol < wsq + 16;
                const float v = ok ? s[t][j] + bp[ok ? kcol : qcol] : -INFINITY; s[t][j] = v; mx = fmaxf(mx, v); } }
        mx = fmaxf(mx, __shfl_xor(mx, 16)); mx = fmaxf(mx, __shfl_xor(mx, 32));
        m_run = mx;
        float ls = 0.f;
#pragma unroll
        for (int t = 0; t < 16; ++t)
#pragma unroll
            for (int j = 0; j < 4; ++j) { const float p = __expf(s[t][j] - mx); s[t][j] = p; ls += p; }
        l_run = ls;
#pragma unroll
        for (int r8 = 0; r8 < 8; ++r8) {
            { const int vr = lane >> 1, part = lane & 1;
              const bf16_t* vp = PL + (krow0 + (size_t)r8 * 64 + vr) * INW + O_V + h * 64 + part * 32;
              u32x4 v0 = *(const u32x4*)vp, v1 = *(const u32x4*)(vp + 8), v2 = *(const u32x4*)(vp + 16), v3 = *(const u32x4*)(vp + 24);
              LAS unsigned char* wr = WV + vr * 128; const int sw = (vr >> 1) & 3;
              *(LAS u32x4*)(wr + (((2 * part) ^ sw) * 32)) = v0; *(LAS u32x4*)(wr + (((2 * part) ^ sw) * 32) + 16) = v1;
              *(LAS u32x4*)(wr + (((2 * part + 1) ^ sw) * 32)) = v2; *(LAS u32x4*)(wr + (((2 * part + 1) ^ sw) * 32) + 16) = v3; }
            __builtin_amdgcn_wave_barrier(); asm volatile("" ::: "memory");
            const bf16x8 pf = na_pack8(s[2 * r8], s[2 * r8 + 1]);
#pragma unroll
            for (int dt = 0; dt < 4; ++dt) { const bf16x8 vf = na_vfrag(WV, lane, dt); acc[dt] = __builtin_amdgcn_mfma_f32_16x16x32_bf16(vf, pf, acc[dt], 0, 0, 0); }
            __builtin_amdgcn_wave_barrier(); asm volatile("" ::: "memory");
        }
    }
    {
        f32x4 s[16];
#pragma unroll
        for (int t = 0; t < 16; ++t) { const int key = 16 * t + ql; const LAS unsigned char* kr = CK + key * 128;
            const bf16x8 k0 = *(const LAS bf16x8*)(kr + ((g ^ (key & 7)) * 16)), k1 = *(const LAS bf16x8*)(kr + (((g + 4) ^ (key & 7)) * 16));
            s[t] = __builtin_amdgcn_mfma_f32_16x16x32_bf16(k0, Qf[0], (f32x4){0.f, 0.f, 0.f, 0.f}, 0, 0, 0);
            s[t] = __builtin_amdgcn_mfma_f32_16x16x32_bf16(k1, Qf[1], s[t], 0, 0, 0); }
        float mx = m_run;
#pragma unroll
        for (int t = 0; t < 16; ++t)
#pragma unroll
            for (int j = 0; j < 4; ++j) mx = fmaxf(mx, s[t][j]);
        mx = fmaxf(mx, __shfl_xor(mx, 16)); mx = fmaxf(mx, __shfl_xor(mx, 32));
        const float alpha = __expf(m_run - mx);
        float ls = l_run * alpha;
#pragma unroll
        for (int dt = 0; dt < 4; ++dt) acc[dt] *= alpha;
#pragma unroll
        for (int t = 0; t < 16; ++t)
#pragma unroll
            for (int j = 0; j < 4; ++j) { const float p = __expf(s[t][j] - mx); s[t][j] = p; ls += p; }
        l_run = ls;
#pragma unroll
        for (int blk = 0; blk < 8; ++blk) { const bf16x8 pf = na_pack8(s[2 * blk], s[2 * blk + 1]);
#pragma unroll
            for (int dt = 0; dt < 4; ++dt) { const bf16x8 vf = na_vfrag(CV + blk * 4096, lane, dt); acc[dt] = __builtin_amdgcn_mfma_f32_16x16x32_bf16(vf, pf, acc[dt], 0, 0, 0); } }
    }
    float lt = l_run; lt += __shfl_xor(lt, 16); lt += __shfl_xor(lt, 32);
    const float inv = 1.0f / lt;
    bf16_t* op = MIX + (size_t)(qrow0 + ql) * D + h * 64 + 4 * g;
#pragma unroll
    for (int dt = 0; dt < 4; ++dt) { u32x2 w; w.x = cvt_pk_bf16(acc[dt][0] * inv, acc[dt][1] * inv); w.y = cvt_pk_bf16(acc[dt][2] * inv, acc[dt][3] * inv); *(u32x2*)(op + dt * 16) = w; }
}
__device__ __forceinline__ void phase_na_mfma(const Frame& F, const Params& P, int l, bool ctx_queries) {
    const bf16_t* PL = (const bf16_t*)(F.ws + WS_PL); bf16_t* MIX = (bf16_t*)(F.ws + WS_MIX);
    int tid_ = F.tid; asm volatile("" : "+v"(tid_));
    const int tid = tid_;
    { const float* rpb = P.in[I_RPB] + (size_t)l * 8 * 15 * 31; LAS float* R = (LAS float*)(F.lds + NA_RPB); for (int i = tid; i < 8 * 15 * 31; i += NTHREADS) R[i] = rpb[i]; }
    for (int unit = F.bid; unit < 256; unit += F.G) {
        const int quarter = unit & 3, h = (unit >> 2) & 7, b = unit >> 5;
        __syncthreads();
        { int t2 = tid; asm volatile("" : "+v"(t2)); const int key = t2 >> 1, part = t2 & 1; const bf16_t* kp = PL + (size_t)(NLAT + b * CTXL + key) * INW + O_K + h * 64 + part * 32; const bf16_t* vp = kp + (O_V - O_K);
          LAS unsigned char* kr = F.lds + NA_CK + key * 128; LAS unsigned char* vr = F.lds + NA_CV + key * 128; const int sw = (key >> 1) & 3;
#pragma unroll
          for (int c = 0; c < 4; ++c) { *(LAS u32x4*)(kr + (((4 * part + c) ^ (key & 7)) * 16)) = *(const u32x4*)(kp + 8 * c);
              const int c16 = 4 * part + c; *(LAS u32x4*)(vr + (((c16 >> 1) ^ sw) * 32) + (c16 & 1) * 16) = *(const u32x4*)(vp + 8 * c); } }
        __syncthreads();
        for (int it = F.wave; it < 64; it += NWAVES) { const int gi = quarter * 16 + (it >> 2), cb = it & 3;
            na_item<true>(F, PL, MIX, b, h, b * SEQ + gi * 64 + cb * 16, gi, cb); }
        if (ctx_queries && F.wave < 4) na_item<false>(F, PL, MIX, b, h, NLAT + b * CTXL + (quarter * 4 + F.wave) * 16, 0, 0);
    }
}

__device__ __forceinline__ void phase_final(const Frame& F, const Params& P) {
    float* out = P.out; const float* g = P.in[I_FINALG]; const int lane = F.lane;
    for (int r = F.gw; r < NLAT; r += F.nw) {
        float* xr = out + (size_t)r * D; f32x4 x[4]; float ss = 0.f;
#pragma unroll
        for (int j = 0; j < 4; ++j) { x[j] = *(const f32x4*)(xr + j * 256 + lane * 4); ss += x[j][0] * x[j][0] + x[j][1] * x[j][1] + x[j][2] * x[j][2] + x[j][3] * x[j][3]; }
        ss = wave_sum(ss); const float rstd = rsqrtf(ss * (1.0f / D) + 1e-6f);
#pragma unroll
        for (int j = 0; j < 4; ++j) { const f32x4 gg = *(const f32x4*)(g + j * 256 + lane * 4); *(f32x4*)(xr + j * 256 + lane * 4) = x[j] * rstd * gg; }
    }
}

constexpr int PH_L0 = 1, PH_PER_L0 = 9, PH_L1 = PH_L0 + PH_PER_L0, PH_PER_L1 = 12, PH_FINAL = PH_L1 + PH_PER_L1, N_PHASES = PH_FINAL + 1;
#define RFL(x) __builtin_amdgcn_readfirstlane(x)

PHASE ph_prologue(const void* kp_, int wv_) { PHASE_ENTER; if constexpr (MKB(0)) phase_prologue(F, P); }
PHASE ph_norm1(const void* kp_, int wv_, int l_) { PHASE_ENTER; const int l = RFL(l_);
    if constexpr (MKB(1)) phase_norm<false>(F, P, l, 0, NROW, l == 0 ? P.in[I_X] : P.out, l == 0 ? P.in[I_CTX] : (const float*)(F.ws + WS_XC)); }
PHASE_INL ph_gemm_win(const void* kp_, int wv_, int l_) { PHASE_ENTER; const int l = RFL(l_);
    pg8::DenseSched S; S.init(NROW / 256, INW / 256, F.G, F.bid); S.A = (const bf16_t*)(F.ws + WS_HL); S.Bt = (const bf16_t*)(F.ws + WS_BTIN) + (size_t)l * INW * D; S.K = D;
    pg8::EpiBf16 E{(bf16_t*)(F.ws + WS_PL), INW, 2, 0.125f};
    if constexpr (MKB(2)) pg8::gemm_phase<pg8::EpiBf16, pg8::DenseSched, false>(F.lds, D, S, E, F.wave); }
PHASE_INL ph_rw_prep(const void* kp_, int wv_, int l_) { PHASE_ENTER; const int l = RFL(l_); if constexpr (MKB(3)) phase_rw_prep(F, P, l); }
PHASE ph_conv(const void* kp_, int wv_, int l_, int bid_, int G_) { PHASE_ENTER; const int l = RFL(l_); if constexpr (MKB(4)) phase_conv(sub_frame(F, RFL(bid_), RFL(G_)), P, l, l == 0 ? NROW : NLAT); }
PHASE_INL ph_na(const void* kp_, int wv_, int l_, int bid_, int G_) { PHASE_ENTER; const int l = RFL(l_); if constexpr (MKB(5)) phase_na_mfma(sub_frame(F, RFL(bid_), RFL(G_)), P, l, l == 0); }
PHASE_INL ph_scan(const void* kp_, int wv_, int bid_, int G_) { PHASE_ENTER; if constexpr (MKB(6)) phase_scan(sub_frame(F, RFL(bid_), RFL(G_))); }
PHASE_INL ph_rw_post(const void* kp_, int wv_, int l_) { PHASE_ENTER; const int l = RFL(l_); if constexpr (MKB(7)) phase_rw_post(F, P, l, l == 0 ? NROW : NLAT); }
PHASE_INL ph_gemm_wout(const void* kp_, int wv_, int l_) { PHASE_ENTER; const int l = RFL(l_);
    float* XC = (float*)(F.ws + WS_XC);
    pg8::DenseSched S; S.init((l == 0 ? NROW : NLAT) / 256, D / 256, F.G, F.bid); S.A = (const bf16_t*)(F.ws + WS_MIX); S.Bt = (const bf16_t*)(F.ws + WS_BTOUT) + (size_t)l * D * D; S.K = D;
    pg8::EpiRes E{l == 0 ? P.in[I_X] : P.out, l == 0 ? P.in[I_CTX] : XC, P.out, XC, (const float*)(F.ws + WS_MODV) + (size_t)l * 9 * MODW + 2 * D};
    if constexpr (MKB(8)) pg8::gemm_phase<pg8::EpiRes, pg8::DenseSched, false>(F.lds, D, S, E, F.wave); }
PHASE ph_norm2_l0(const void* kp_, int wv_) { PHASE_ENTER; if constexpr (MKB(9)) phase_norm<false>(F, P, 0, 1, NROW, P.out, (const float*)(F.ws + WS_XC)); }
PHASE_INL ph_gemm_ffn_gu(const void* kp_, int wv_) { PHASE_ENTER;
    pg8::DenseSched S; S.init(NROW / 256, (2 * DFF) / 256, F.G, F.bid); S.A = (const bf16_t*)(F.ws + WS_HL); S.Bt = (const bf16_t*)(F.ws + WS_BTGU); S.K = D;
    pg8::EpiSwiGLU E{(bf16_t*)(F.ws + WS_H), DFF};
    if constexpr (MKB(10)) pg8::gemm_phase<pg8::EpiSwiGLU, pg8::DenseSched, false>(F.lds, D, S, E, F.wave); }
PHASE_INL ph_gemm_ffn_dn(const void* kp_, int wv_) { PHASE_ENTER;
    float* XC = (float*)(F.ws + WS_XC);
    pg8::DenseSched S; S.init(NROW / 256, D / 256, F.G, F.bid); S.A = (const bf16_t*)(F.ws + WS_H); S.Bt = (const bf16_t*)(F.ws + WS_BTDN); S.K = DFF;
    pg8::EpiRes E{P.out, XC, P.out, XC, (const float*)(F.ws + WS_MODV) + 5 * D};
    if constexpr (MKB(11)) pg8::gemm_phase<pg8::EpiRes, pg8::DenseSched, false>(F.lds, DFF, S, E, F.wave); }
PHASE ph_norm2_l1(const void* kp_, int wv_) { PHASE_ENTER; if constexpr (MKB(12)) phase_norm<true>(F, P, 1, 1, NLAT, P.out, (const float*)(F.ws + WS_XC)); }
PHASE ph_moe_prep(const void* kp_, int wv_) { PHASE_ENTER; if constexpr (MKB(13)) { phase_moe_rowmap(F); phase_moe_convert(F, P); } }
PHASE_INL ph_gemm_moe_gu(const void* kp_, int wv_, int pass_) { PHASE_ENTER; const int pass = RFL(pass_);
    pg8::MoeSched S; moe_tstart(F, pass, S.tstart); S.init(S.tstart[8], (2 * DFE) / 256, F.G, F.bid);
    S.A = (const bf16_t*)(F.ws + WS_HL); S.Bt0 = F.ws + WS_MOE; S.e_stride = MOE_E_BYTES; S.K = D; S.rowmap = (const int*)(F.ws + WS_ROUTE + RT_RMAP) + pass * NROW;
    pg8::EpiSwiGLU E{(bf16_t*)(F.ws + WS_H), DFE};
    if constexpr (MKB(14)) pg8::gemm_phase<pg8::EpiSwiGLU, pg8::MoeSched, true>(F.lds, D, S, E, F.wave); }
PHASE_INL ph_gemm_moe_dn(const void* kp_, int wv_, int pass_) { PHASE_ENTER; const int pass = RFL(pass_);
    pg8::MoeSched S; moe_tstart(F, pass, S.tstart); S.init(S.tstart[8], D / 256, F.G, F.bid);
    S.A = (const bf16_t*)(F.ws + WS_H); S.Bt0 = F.ws + WS_MOE + MOE_GU_BYTES; S.e_stride = MOE_E_BYTES; S.K = DFE; S.rowmap = nullptr;
    pg8::EpiMoeDown E{P.out, (const float*)(F.ws + WS_MODV) + (size_t)9 * MODW + 5 * D, (const int*)(F.ws + WS_ROUTE + RT_RMAP) + pass * NROW, (const float*)(F.ws + WS_ROUTE + RT_SGATE) + pass * NROW};
    if constexpr (MKB(15)) pg8::gemm_phase<pg8::EpiMoeDown, pg8::MoeSched, false>(F.lds, DFE, S, E, F.wave); }
PHASE ph_final(const void* kp_, int wv_) { PHASE_ENTER; if constexpr (MKB(16)) phase_final(F, P); }

static __attribute__((noinline)) __device__ void grid_barrier(const void* bar_, unsigned x_, int wv_) {
    const unsigned long long v = (unsigned long long)bar_;
    const unsigned lo = __builtin_amdgcn_readfirstlane((unsigned)v), hi = __builtin_amdgcn_readfirstlane((unsigned)(v >> 32));
    XcdBarrier b; b.bar = (unsigned*)(((unsigned long long)hi << 32) | lo); b.x = __builtin_amdgcn_readfirstlane(x_);
    b.st = (volatile LAS unsigned*)((LAS unsigned char*)lds_raw + LDS_MISC);
    xcd_barrier(b, __builtin_amdgcn_readfirstlane(wv_) * 64 + lane_id());
}
__device__ __forceinline__ bool ph_in(int lo, int hi, int k) { asm volatile("" : "+s"(lo), "+s"(hi)); return lo <= k && k < hi; }

__global__ void __launch_bounds__(NTHREADS, 2) mk_fwd(Params P) {
    const void* kp = (const void*)__builtin_amdgcn_kernarg_segment_ptr();
    LAS unsigned char* lds = (LAS unsigned char*)lds_raw;
    volatile LAS unsigned* misc = (volatile LAS unsigned*)(lds + LDS_MISC);
    const int wv = __builtin_amdgcn_readfirstlane((int)(threadIdx.x >> 6));
    if (wv == 0 && lane_id() < 4) misc[lane_id()] = 0u;
    __syncthreads();
    const int lo = P.ph_lo, hi = P.ph_hi;
    XcdBarrier bar; bar.bar = (unsigned*)(P.ws + WS_CTL) + CW_BAR; bar.x = 0; bar.st = misc;
    if (hi - lo > 1) bar = xcd_barrier_post((unsigned*)(P.ws + WS_CTL) + CW_BAR, misc, wv * 64 + lane_id());
#define IN(k) ph_in(lo, hi, (k))
#define SEAM(k) do { if (IN((k) + 1)) grid_barrier((const void*)bar.bar, bar.x, wv); } while (0)
    if (IN(0)) { for (int rep = 0; rep < REP_PRO; ++rep) ph_prologue(kp, wv); SEAM(0); }
#define LAYER_COMMON(l, pb) \
    if (IN((pb) + 0)) { for (int rep = 0; rep < REP_NORM; ++rep) ph_norm1(kp, wv, (l)); SEAM((pb) + 0); } \
    if (IN((pb) + 1)) { for (int rep = 0; rep < REP_GEMM; ++rep) ph_gemm_win(kp, wv, (l)); SEAM((pb) + 1); } \
    if (IN((pb) + 2)) { for (int rep = 0; rep < REP_PP; ++rep) ph_rw_prep(kp, wv, (l)); SEAM((pb) + 2); } \
    if (IN((pb) + 3)) { const int bx = (int)blockIdx.x, Gx = (int)gridDim.x; \
        if (Gx == 256) { if (bx < 64) { for (int rep = 0; rep < REP_SCAN; ++rep) ph_scan(kp, wv, bx, 64); } \
            else { for (int rep = 0; rep < REP_CONV; ++rep) ph_conv(kp, wv, (l), bx - 64, 192); for (int rep = 0; rep < REP_NA; ++rep) ph_na(kp, wv, (l), bx - 64, 192); } } \
        else { ph_conv(kp, wv, (l), bx, Gx); ph_na(kp, wv, (l), bx, Gx); ph_scan(kp, wv, bx, Gx); } SEAM((pb) + 3); } \
    if (IN((pb) + 4)) { for (int rep = 0; rep < REP_PP; ++rep) ph_rw_post(kp, wv, (l)); SEAM((pb) + 4); } \
    if (IN((pb) + 5)) { ph_gemm_wout(kp, wv, (l)); SEAM((pb) + 5); }
    LAYER_COMMON(0, PH_L0)
    if (IN(PH_L0 + 6)) { ph_norm2_l0(kp, wv); SEAM(PH_L0 + 6); }
    if (IN(PH_L0 + 7)) { for (int rep = 0; rep < REP_GEMM; ++rep) ph_gemm_ffn_gu(kp, wv); SEAM(PH_L0 + 7); }
    if (IN(PH_L0 + 8)) { ph_gemm_ffn_dn(kp, wv); SEAM(PH_L0 + 8); }
    LAYER_COMMON(1, PH_L1)
    if (IN(PH_L1 + 6)) { ph_norm2_l1(kp, wv); SEAM(PH_L1 + 6); }
    if (IN(PH_L1 + 7)) { for (int rep = 0; rep < REP_PRO; ++rep) ph_moe_prep(kp, wv); SEAM(PH_L1 + 7); }
#pragma unroll 1
    for (int pass = 0; pass < 2; ++pass) {
        if (IN(PH_L1 + 8 + 2 * pass)) { for (int rep = 0; rep < REP_GEMM; ++rep) ph_gemm_moe_gu(kp, wv, pass); SEAM(PH_L1 + 8 + 2 * pass); }
        if (IN(PH_L1 + 9 + 2 * pass)) { ph_gemm_moe_dn(kp, wv, pass); SEAM(PH_L1 + 9 + 2 * pass); }
    }
#undef LAYER_COMMON
    if (IN(PH_FINAL)) ph_final(kp, wv);
#undef IN
#undef SEAM
}

extern "C" void kernel_launch(void* const* d_in, const int* in_sizes, int n_in, void* d_out, int out_size, void* d_ws, size_t ws_size, hipStream_t stream) {
    static int grid = 0;
    if (grid == 0) {
        if (n_in != 35 || out_size != NLAT * D || ws_size < WS_END) { fprintf(stderr, "kernel_launch: unexpected shapes (n_in %d out %d ws %zu need %zu)\n", n_in, out_size, ws_size, (size_t)WS_END); grid = -1; return; }
        int dev = 0, cus = 0, per_cu = 0;
        if (hipGetDevice(&dev) != hipSuccess || hipDeviceGetAttribute(&cus, hipDeviceAttributeMultiprocessorCount, dev) != hipSuccess) { grid = -1; return; }
        if (hipFuncSetAttribute((const void*)mk_fwd, hipFuncAttributeMaxDynamicSharedMemorySize, LDS_BYTES) != hipSuccess) { fprintf(stderr, "kernel_launch: hipFuncSetAttribute failed\n"); grid = -1; return; }
        if (hipOccupancyMaxActiveBlocksPerMultiprocessor(&per_cu, (const void*)mk_fwd, NTHREADS, LDS_BYTES) != hipSuccess || per_cu < 1) { fprintf(stderr, "kernel_launch: occupancy query says %d\n", per_cu); (void)hipGetLastError(); }
        grid = cus;
    }
    if (grid < 0) return;
    (void)hipMemsetAsync((char*)d_ws + WS_CTL, 0, CTL_BYTES, stream);
    Params p{};
    for (int i = 0; i < 35; ++i) p.in[i] = (const float*)d_in[i];
    p.out = (float*)d_out; p.ws = (unsigned char*)d_ws;
#if MK_ONE_LAUNCH
    p.ph_lo = 0; p.ph_hi = N_PHASES;
    hipLaunchKernelGGL(mk_fwd, dim3(grid), dim3(NTHREADS), LDS_BYTES, stream, p);
#else
    for (int k = 0; k < N_PHASES && k <= MK_LAST; ++k) { p.ph_lo = k; p.ph_hi = k + 1; hipLaunchKernelGGL(mk_fwd, dim3(grid), dim3(NTHREADS), LDS_BYTES, stream, p); }
#endif
}
```

```cpp
#include <hip/hip_runtime.h>
#include <stdint.h>
#include <stdio.h>

#ifndef MK_MASK
#define MK_MASK 0xFFFFFFFFu
#endif
#define MKB(k) (((MK_MASK) >> (k)) & 1u)
#ifndef REP_SCAN
#define REP_SCAN 1
#endif
#ifndef REP_NA
#define REP_NA 1
#endif
#ifndef REP_GEMM
#define REP_GEMM 1
#endif
#ifndef REP_PP
#define REP_PP 1
#endif
#ifndef REP_POST
#define REP_POST 1
#endif
#ifndef REP_CONV
#define REP_CONV 1
#endif
#ifndef REP_NORM
#define REP_NORM 1
#endif
#ifndef REP_PRO
#define REP_PRO 1
#endif
#ifndef MK_LAST
#define MK_LAST 99
#endif
#ifndef MK_ONE_LAUNCH
#define MK_ONE_LAUNCH 1
#endif

#define LAS __attribute__((address_space(3)))
typedef unsigned short bf16_t;
typedef _Float16 f16_t;
typedef short bf16x8 __attribute__((ext_vector_type(8)));
typedef float f32x4 __attribute__((ext_vector_type(4)));
typedef float f32x2 __attribute__((ext_vector_type(2)));
typedef unsigned u32x4 __attribute__((ext_vector_type(4)));
typedef unsigned u32x2 __attribute__((ext_vector_type(2)));
typedef f16_t f16x4 __attribute__((ext_vector_type(4)));
typedef f16_t f16x8 __attribute__((ext_vector_type(8)));
typedef short v4i16_t __attribute__((ext_vector_type(4)));

constexpr int D = 1024, NB = 8, SEQ = 4096, CTXL = 256, TT = CTXL + SEQ;
constexpr int NLAT = NB * SEQ, NCTX = NB * CTXL, NROW = NLAT + NCTX;
constexpr int INW = 3328, DFF = 2816, DFE = 3584, NEXP = 8;
constexpr int O_Q = 0, O_K = 512, O_V = 1024, O_RW = 1536, O_CV = 2816;
constexpr int MODW = 6 * D;
constexpr int NTHREADS = 512, NWAVES = 8;
constexpr int LDS_BYTES = 160 * 1024;
constexpr int LDS_MISC = LDS_BYTES - 256;

constexpr size_t al256(size_t x) { return (x + 255) & ~(size_t)255; }
constexpr size_t WS_CTL   = 0;
constexpr size_t CTL_BYTES = 65536;
constexpr size_t WS_MODV  = WS_CTL + CTL_BYTES;
constexpr size_t WS_BTIN  = al256(WS_MODV + (size_t)2 * 9 * MODW * 4);
constexpr size_t WS_BTOUT = al256(WS_BTIN + (size_t)2 * INW * D * 2);
constexpr size_t WS_BTGU  = al256(WS_BTOUT + (size_t)2 * D * D * 2);
constexpr size_t WS_BTDN  = al256(WS_BTGU + (size_t)2 * DFF * D * 2);
constexpr size_t WS_LORA  = al256(WS_BTDN + (size_t)D * DFF * 2);
constexpr size_t LORA_LD_BYTES = (size_t)(256 * 64 * 2 + 256 * 128) * 2;
constexpr size_t WS_MOE   = al256(WS_LORA + 4 * LORA_LD_BYTES);
constexpr size_t MOE_GU_BYTES = (size_t)2 * DFE * D * 2, MOE_DN_BYTES = (size_t)D * DFE * 2, MOE_E_BYTES = MOE_GU_BYTES + MOE_DN_BYTES;
constexpr size_t WS_SH    = WS_MOE;
constexpr size_t SH_BYTES = (size_t)NB * 4 * TT * 192 * 2;
constexpr size_t WS_SD    = WS_SH + SH_BYTES;
constexpr size_t WS_XC    = al256(WS_MOE + (size_t)NEXP * MOE_E_BYTES);
constexpr size_t WS_HL    = al256(WS_XC + (size_t)NCTX * D * 4);
constexpr size_t WS_Y     = WS_HL;
constexpr size_t WS_PL    = al256(WS_HL + (size_t)NROW * D * 2);
constexpr size_t WS_MIX   = al256(WS_PL + (size_t)NROW * INW * 2);
constexpr size_t WS_H     = WS_PL;
constexpr size_t WS_ROUTE = al256(WS_MIX + (size_t)NROW * D * 2);
constexpr size_t RT_TOKE  = 0;
constexpr size_t RT_TOKG  = RT_TOKE + (size_t)NLAT * 2 * 4;
constexpr size_t RT_TOKP  = RT_TOKG + (size_t)NLAT * 2 * 4;
constexpr size_t RT_RMAP  = RT_TOKP + (size_t)NLAT * 2 * 4;
constexpr size_t RT_SGATE = RT_RMAP + (size_t)2 * NROW * 4;
constexpr size_t WS_END   = al256(WS_ROUTE + RT_SGATE + (size_t)2 * NROW * 4);
static_assert(SH_BYTES * 3 <= (size_t)NEXP * MOE_E_BYTES, "scan inputs must fit the MoE weight region");
static_assert((size_t)NROW * DFE * 2 <= (size_t)NROW * INW * 2 + (size_t)NROW * D * 2, "H must fit PL+MIX");

constexpr int CW_BAR = 0;
constexpr int CW_MOECNT = 4096;

#define XB_TMO      128
#define XB_XCNT(j)  (256  + 64 * (j))
#define XB_XSUB(j)  (1280 + 64 * (j))
#define XB_XGEN(j)  (2304 + 64 * (j))
#define XB_TOP      3328
#define XB_TOPGEN   3392
#define XCD_BAR_WORDS 3456
#define XB_SPIN_CAP (1u << 22)

__device__ __forceinline__ unsigned xb_ld(unsigned* p)              { return __hip_atomic_load(p, __ATOMIC_RELAXED, __HIP_MEMORY_SCOPE_AGENT); }
__device__ __forceinline__ unsigned xb_add(unsigned* p, unsigned v) { return __hip_atomic_fetch_add(p, v, __ATOMIC_RELAXED, __HIP_MEMORY_SCOPE_AGENT); }
__device__ __forceinline__ unsigned xb_xcc_id() { return (unsigned)__builtin_amdgcn_s_getreg((3 << 11) | 20) & 0xFu; }
#define XB_SPIN(cond, bar) do { unsigned _sp = 0; while (cond) { __builtin_amdgcn_s_sleep(1); \
    if ((++_sp & 255u) == 0u) { if (xb_ld(&(bar)[XB_TMO])) break; if (_sp > XB_SPIN_CAP) { atomicAdd(&(bar)[XB_TMO], 1u); break; } } } } while (0)

struct XcdBarrier { unsigned* bar; unsigned x; volatile LAS unsigned* st; };

__device__ __forceinline__ XcdBarrier xcd_barrier_post(unsigned* bar, volatile LAS unsigned* st, int tid) {
    XcdBarrier b; b.bar = bar; b.x = xb_xcc_id(); b.st = st;
    if (tid == 0) (void)xb_add(&bar[XB_XCNT(b.x)], 1u);
    return b;
}
__device__ __forceinline__ void xcd_barrier_complete(unsigned* bar, unsigned x, unsigned& nloc, unsigned& nx) {
    const unsigned G = gridDim.x * gridDim.y * gridDim.z;
    unsigned sum, cnt, mine, sp = 0u;
    for (;;) {
        sum = 0u; cnt = 0u; mine = 0u;
#pragma unroll
        for (unsigned j = 0; j < 16; ++j) { const unsigned c = xb_ld(&bar[XB_XCNT(j)]); sum += c; cnt += (c > 0u) ? 1u : 0u; mine = (j == x) ? c : mine; }
        if (sum == G) break;
        __builtin_amdgcn_s_sleep(1);
        if ((++sp & 255u) == 0u) { if (xb_ld(&bar[XB_TMO])) break; if (sp > XB_SPIN_CAP) { atomicAdd(&bar[XB_TMO], 1u); break; } }
    }
    nloc = mine > 0u ? mine : 1u; nx = cnt > 0u ? cnt : 1u;
}
__device__ __forceinline__ void xcd_barrier(const XcdBarrier& b, int tid) {
    asm volatile("s_waitcnt vmcnt(0)" ::: "memory");
    __syncthreads();
    if (tid == 0) {
        unsigned* bar = b.bar;
        __builtin_amdgcn_s_waitcnt(0);
        unsigned nloc = b.st[0], nx = b.st[1];
        if (nloc == 0u) { xcd_barrier_complete(bar, b.x, nloc, nx); b.st[0] = nloc; b.st[1] = nx; }
        const unsigned old = xb_add(&bar[XB_XSUB(b.x)], 1u);
        const unsigned gen = old / nloc;
        if (old + 1u == (gen + 1u) * nloc) {
            __builtin_amdgcn_fence(__ATOMIC_RELEASE, "agent");
            asm volatile("s_waitcnt vmcnt(0)" ::: "memory");
            const unsigned og = xb_add(&bar[XB_TOP], 1u);
            const unsigned tg = og / nx;
            if (og + 1u == (tg + 1u) * nx) xb_add(&bar[XB_TOPGEN], 1u);
            else XB_SPIN(xb_ld(&bar[XB_TOPGEN]) == tg, bar);
            __builtin_amdgcn_fence(__ATOMIC_ACQUIRE, "agent");
            xb_add(&bar[XB_XGEN(b.x)], 1u);
            asm volatile("s_waitcnt vmcnt(0)" ::: "memory");
        } else {
            XB_SPIN(xb_ld(&bar[XB_XGEN(b.x)]) == gen, bar);
            __builtin_amdgcn_fence(__ATOMIC_ACQUIRE, "agent");
            asm volatile("s_waitcnt vmcnt(0)" ::: "memory");
        }
    }
    __syncthreads();
}

__device__ __forceinline__ int lane_id() { return (int)__builtin_amdgcn_mbcnt_hi(~0u, __builtin_amdgcn_mbcnt_lo(~0u, 0u)); }
__device__ __forceinline__ float bf2f(bf16_t b) { return __uint_as_float(((unsigned)b) << 16); }
__device__ __forceinline__ bf16_t f2bf(float f) { unsigned u = __float_as_uint(f); u += 0x7FFFu + ((u >> 16) & 1u); return (bf16_t)(u >> 16); }
__device__ __forceinline__ unsigned pk_bf16(float lo, float hi) { return (unsigned)f2bf(lo) | ((unsigned)f2bf(hi) << 16); }
typedef __bf16 bf16x2_t __attribute__((ext_vector_type(2)));
__device__ __forceinline__ unsigned cvt_pk_bf16(float lo, float hi) { return __builtin_bit_cast(unsigned, __builtin_convertvector((f32x2){lo, hi}, bf16x2_t)); }
__device__ __forceinline__ float sigmoidf_(float x) { return 1.0f / (1.0f + __expf(-x)); }
__device__ __forceinline__ float siluf_(float x) { return x / (1.0f + __expf(-x)); }
__device__ __forceinline__ float wave_sum(float v) {
#pragma unroll
    for (int o = 32; o >= 1; o >>= 1) v += __shfl_xor(v, o);
    return v;
}
__device__ __forceinline__ float sum16(float v) {
    v += __shfl_xor(v, 1); v += __shfl_xor(v, 2); v += __shfl_xor(v, 4); v += __shfl_xor(v, 8); return v;
}
__device__ __forceinline__ void unpack4(u32x2 w, float (&f)[4]) {
    f[0] = __uint_as_float(w.x << 16); f[1] = __uint_as_float(w.x & 0xffff0000u); f[2] = __uint_as_float(w.y << 16); f[3] = __uint_as_float(w.y & 0xffff0000u);
}
__device__ __forceinline__ void unpack8(u32x4 w, float* f) {
    f[0] = __uint_as_float(w.x << 16); f[1] = __uint_as_float(w.x & 0xffff0000u); f[2] = __uint_as_float(w.y << 16); f[3] = __uint_as_float(w.y & 0xffff0000u);
    f[4] = __uint_as_float(w.z << 16); f[5] = __uint_as_float(w.z & 0xffff0000u); f[6] = __uint_as_float(w.w << 16); f[7] = __uint_as_float(w.w & 0xffff0000u);
}

struct Params {
    const float* in[35];
    float* out; unsigned char* ws;
    int ph_lo, ph_hi;
};
enum { I_X = 0, I_C, I_CTX, I_CCTX, I_N1G, I_N2G, I_MODW, I_MODB, I_WIN, I_WOUT, I_RPB, I_MUP, I_MUN, I_W0, I_W2, I_A0, I_A2, I_G2, I_KK, I_KA, I_RK, I_GNG, I_GNB,
       I_DWW, I_DWB, I_LNG, I_LNB, I_FG, I_FU, I_FD, I_ROUTER, I_MG, I_MU, I_MD, I_FINALG };

__device__ __forceinline__ int row_mi(int r) { return r < NLAT ? (r >> 12) : 8; }

namespace pg8 {
constexpr int BM = 256, BK = 64, HALF = 128, HTB = HALF * BK * 2, STAGE_BYTES = 8 * HTB, NXCD = 8, WGM = 8;
__device__ __forceinline__ int lds_byte(int r, int c) { const int st = (r >> 4) * 2 + (c >> 5), rr = r & 15, cc = c & 31, ob = rr * 64 + cc * 2; return st * 1024 + (ob ^ (((ob >> 9) & 1) << 5)); }
__device__ __forceinline__ void stage_rc(int b, int& R, int& C) { const int st = b / 1024, sb = b % 1024, swz = sb ^ (((sb >> 9) & 1) << 5); R = (st >> 1) * 16 + swz / 64; C = (st & 1) * 32 + (swz % 64) / 2; }
__device__ __forceinline__ int perm32(int rho) { const int n = rho >> 4, i = rho & 15; return 8 * (i >> 2) + 4 * n + (i & 3); }
struct Unit { int pm, pn; };

struct TileOrder {
    int nM, nN, nwg, G, c;
    __device__ void init(int nM_, int nN_, int G_, int c_) { nM = nM_; nN = nN_; nwg = nM * nN; G = G_; c = c_; }
    __device__ bool next(int i, Unit& u) const {
        const long L = (long)i * G + c; if (L >= nwg) return false;
        int wgid = (int)L; { const int q = nwg / NXCD, r = nwg % NXCD, xcd = wgid % NXCD, off = wgid / NXCD; wgid = (xcd < r ? xcd * (q + 1) : r * (q + 1) + (xcd - r) * q) + off; }
        const int nig = WGM * nN, gid = wgid / nig, fm = gid * WGM, gsz = (nM - fm) < WGM ? (nM - fm) : WGM;
        u.pm = fm + ((wgid % nig) % gsz); u.pn = (wgid % nig) / gsz; return true;
    }
};
struct DenseSched : TileOrder {
    const bf16_t* A; const bf16_t* Bt; int K;
    __device__ __forceinline__ const char* aptr(const Unit& u) const { return (const char*)A + (size_t)u.pm * BM * K * 2; }
    __device__ __forceinline__ const char* bptr(const Unit& u) const { return (const char*)Bt + (size_t)u.pn * BM * K * 2; }
    __device__ __forceinline__ const char* abase() const { return (const char*)A; }
    __device__ __forceinline__ int arow(const Unit&, int) const { return 0; }
};
struct MoeSched : TileOrder {
    const bf16_t* A; const unsigned char* Bt0; size_t e_stride; int K; const int* rowmap; int tstart[9];
    __device__ __forceinline__ int expert(int pm) const { int e = 0;
#pragma unroll
        for (int j = 1; j < 8; ++j) e += (pm >= tstart[j]) ? 1 : 0;
        return e; }
    __device__ __forceinline__ const char* aptr(const Unit& u) const { return (const char*)A + (size_t)u.pm * BM * K * 2; }
    __device__ __forceinline__ const char* bptr(const Unit& u) const { return (const char*)Bt0 + (size_t)expert(u.pm) * e_stride + (size_t)u.pn * BM * K * 2; }
    __device__ __forceinline__ const char* abase() const { return (const char*)A; }
    __device__ __forceinline__ int arow(const Unit& u, int r) const { const int t = rowmap[u.pm * BM + r]; return t < 0 ? 0 : t; }
};

struct EpiBf16 {
    static constexpr bool PERM = true;
    bf16_t* O; int ldc; int nscale; float scale;
    __device__ __forceinline__ void operator()(const f32x4 (&acc)[2][2][4][2], const Unit& u, int wr, int wc, int fr, int fq) const {
        const int row0 = u.pm * BM + wr * 64 + fr, col0 = u.pn * BM + wc * 32 + 8 * fq;
        const float s = u.pn < nscale ? scale : 1.0f;
#pragma unroll
        for (int ai = 0; ai < 2; ++ai)
#pragma unroll
            for (int m = 0; m < 4; ++m) { bf16_t* rowp = O + (size_t)(row0 + ai * HALF + m * 16) * ldc + col0;
#pragma unroll
                for (int bj = 0; bj < 2; ++bj) { const f32x4 v0 = acc[ai][bj][m][0] * s, v1 = acc[ai][bj][m][1] * s;
                    u32x4 w; w.x = cvt_pk_bf16(v0[0], v0[1]); w.y = cvt_pk_bf16(v0[2], v0[3]); w.z = cvt_pk_bf16(v1[0], v1[1]); w.w = cvt_pk_bf16(v1[2], v1[3]);
                    *(u32x4*)(rowp + bj * HALF) = w; } }
    }
};
struct EpiSwiGLU {
    static constexpr bool PERM = true;
    bf16_t* H; int ldh;
    __device__ __forceinline__ void operator()(const f32x4 (&acc)[2][2][4][2], const Unit& u, int wr, int wc, int fr, int fq) const {
        const int row0 = u.pm * BM + wr * 64 + fr, col0 = u.pn * HALF + wc * 32 + 8 * fq;
#pragma unroll
        for (int ai = 0; ai < 2; ++ai)
#pragma unroll
            for (int m = 0; m < 4; ++m) { bf16_t* rowp = H + (size_t)(row0 + ai * HALF + m * 16) * ldh + col0;
                float h[8];
#pragma unroll
                for (int n = 0; n < 2; ++n)
#pragma unroll
                    for (int j = 0; j < 4; ++j) { const float g = acc[ai][0][m][n][j], up = acc[ai][1][m][n][j]; h[n * 4 + j] = g / (1.0f + __expf(-g)) * up; }
                u32x4 w; w.x = cvt_pk_bf16(h[0], h[1]); w.y = cvt_pk_bf16(h[2], h[3]); w.z = cvt_pk_bf16(h[4], h[5]); w.w = cvt_pk_bf16(h[6], h[7]);
                *(u32x4*)rowp = w; }
    }
};
struct EpiRes {
    static constexpr bool PERM = false;
    const float* resL; const float* resC; float* outL; float* outC; const float* gvec;
    __device__ __forceinline__ void operator()(const f32x4 (&acc)[2][2][4][2], const Unit& u, int wr, int wc, int fr, int fq) const {
        const int r0 = u.pm * BM; const bool lat = r0 < NLAT;
        const float* res = lat ? resL + (size_t)r0 * D : resC + (size_t)(r0 - NLAT) * D;
        float* out = lat ? outL + (size_t)r0 * D : outC + (size_t)(r0 - NLAT) * D;
        const float* gv = gvec + (size_t)(lat ? (r0 >> 12) : 8) * MODW;
        const int rl = wr * 64 + fr, col0 = u.pn * BM + wc * 32 + 4 * fq;
        f32x4 g[2][2];
#pragma unroll
        for (int bj = 0; bj < 2; ++bj)
#pragma unroll
            for (int n = 0; n < 2; ++n) g[bj][n] = *(const f32x4*)(gv + col0 + bj * HALF + n * 16);
#pragma unroll
        for (int ai = 0; ai < 2; ++ai)
#pragma unroll
            for (int m = 0; m < 4; ++m) { const size_t off = (size_t)(rl + ai * HALF + m * 16) * D + col0;
#pragma unroll
                for (int bj = 0; bj < 2; ++bj)
#pragma unroll
                    for (int n = 0; n < 2; ++n) { const f32x4 rv = *(const f32x4*)(res + off + bj * HALF + n * 16);
                        *(f32x4*)(out + off + bj * HALF + n * 16) = rv + g[bj][n] * acc[ai][bj][m][n]; } }
    }
};
struct EpiMoeDown {
    static constexpr bool PERM = false;
    float* xl; const float* gvec; const int* rowmap; const float* sgate;
    __device__ __forceinline__ void operator()(const f32x4 (&acc)[2][2][4][2], const Unit& u, int wr, int wc, int fr, int fq) const {
        const int rl = u.pm * BM + wr * 64 + fr, col0 = u.pn * BM + wc * 32 + 4 * fq;
#pragma unroll
        for (int ai = 0; ai < 2; ++ai)
#pragma unroll
            for (int m = 0; m < 4; ++m) { const int slot = rl + ai * HALF + m * 16; const int tok = rowmap[slot];
                if (tok >= 0) { const float sg = sgate[slot]; const float* gv = gvec + (size_t)(tok >> 12) * MODW + col0; float* xp = xl + (size_t)tok * D + col0;
#pragma unroll
                    for (int bj = 0; bj < 2; ++bj)
#pragma unroll
                        for (int n = 0; n < 2; ++n) { const f32x4 g = *(const f32x4*)(gv + bj * HALF + n * 16); const f32x4 rv = *(const f32x4*)(xp + bj * HALF + n * 16);
                            *(f32x4*)(xp + bj * HALF + n * 16) = rv + (g * sg) * acc[ai][bj][m][n]; } } }
    }
};

template <class Epi, class Sched, bool GATHER>
__device__ __forceinline__ void gemm_phase(LAS unsigned char* lds, const int K, const Sched& S, const Epi& E, const int wave_) {
    int tid_ = wave_ * 64 + lane_id(); asm volatile("" : "+v"(tid_));
    const int tid = tid_, wid = wave_, lane = tid & 63, wr = wid >> 2, wc = wid & 3, fr = lane & 15, fq = lane >> 4;
    const int nt = K / BK;
    unsigned voffA[2], voffB[2]; int RA[2], CA[2];
#pragma unroll
    for (int i = 0; i < 2; ++i) { int R, C; stage_rc(tid * 16 + i * 8192, R, C); const int Rb = Epi::PERM ? ((R & ~31) + perm32(R & 31)) : R;
        voffA[i] = (unsigned)(R * K + C) * 2u; voffB[i] = (unsigned)(Rb * K + C) * 2u; RA[i] = R; CA[i] = C; }
    const size_t kstep = (size_t)(BK * 2);
    const size_t hstep = (size_t)HALF * K * 2;
    const unsigned ldsw = (unsigned)wid * 1024u;
    const int aoff = lds_byte(wr * 64 + fr, fq * 8), boff = lds_byte(wc * 32 + fr, fq * 8);
#define PG8_SA(b, h) (((b) * 2 + (h)) * HTB)
#define PG8_SB(b, h) ((4 + (b) * 2 + (h)) * HTB)
#define PG8_STAGE(bufoff, gbase, voff) do { _Pragma("unroll") for (int _i = 0; _i < 2; ++_i) \
        __builtin_amdgcn_global_load_lds((const unsigned*)((const char*)(gbase) + (voff)[_i]), (LAS unsigned*)(lds + (bufoff) + ldsw + _i * 8192), 16, 0, 0); } while (0)
#define PG8_LDA(dst, b, h) do { _Pragma("unroll") for (int m = 0; m < 4; ++m) _Pragma("unroll") for (int k = 0; k < 2; ++k) dst[m][k] = *(const LAS bf16x8*)(lds + PG8_SA(b, h) + aoff + m * 2048 + k * 1024); } while (0)
#define PG8_LDB(dst, b, h) do { _Pragma("unroll") for (int n = 0; n < 2; ++n) _Pragma("unroll") for (int k = 0; k < 2; ++k) dst[n][k] = *(const LAS bf16x8*)(lds + PG8_SB(b, h) + boff + n * 2048 + k * 1024); } while (0)
#define PG8_MMA(ai, bj, At, Bt) do { __builtin_amdgcn_s_setprio(1); _Pragma("unroll") for (int m = 0; m < 4; ++m) _Pragma("unroll") for (int n = 0; n < 2; ++n) _Pragma("unroll") for (int k = 0; k < 2; ++k) \
        acc[ai][bj][m][n] = __builtin_amdgcn_mfma_f32_16x16x32_bf16(Bt[n][k], At[m][k], acc[ai][bj][m][n], 0, 0, 0); __builtin_amdgcn_s_setprio(0); } while (0)
#define PG8_WAIT_V(n) asm volatile("s_waitcnt vmcnt(" #n ")" ::: "memory")
#define PG8_WAIT_L(n) asm volatile("s_waitcnt lgkmcnt(" #n ")" ::: "memory")
#define PG8_BAR __builtin_amdgcn_s_barrier()
#define PG8_SCHED __builtin_amdgcn_sched_barrier(0)
#define PG8_STAGE_A(bufoff, TS, H) do { if constexpr (GATHER) { PG8_STAGE(bufoff, gA##TS, oA##TS[H]); } else { PG8_STAGE(bufoff, a##TS + (H) * hstep, voffA); } } while (0)
    Unit cur, nxt; int ui = 0;
    if (!S.next(0, cur)) return;
    f32x4 acc[2][2][4][2];
#pragma unroll
    for (int a = 0; a < 2; ++a)
#pragma unroll
        for (int b = 0; b < 2; ++b)
#pragma unroll
            for (int m = 0; m < 4; ++m)
#pragma unroll
                for (int n = 0; n < 2; ++n) acc[a][b][m][n] = (f32x4){0.f, 0.f, 0.f, 0.f};
    bf16x8 At[4][2], B0[2][2], B1[2][2];
    const char* Abase = S.abase();
    unsigned aoC[2][2] = {{0u, 0u}, {0u, 0u}}, aoN[2][2] = {{0u, 0u}, {0u, 0u}};
    if constexpr (GATHER) {
#pragma unroll
        for (int h = 0; h < 2; ++h)
#pragma unroll
            for (int i = 0; i < 2; ++i) aoC[h][i] = (unsigned)(S.arow(cur, h * HALF + RA[i]) * K + CA[i]) * 2u;
    }
    const char* cA = GATHER ? Abase : S.aptr(cur); const char* cB = S.bptr(cur);
    if constexpr (GATHER) {
        PG8_STAGE(PG8_SB(0, 0), cB, voffB); PG8_STAGE(PG8_SA(0, 0), Abase, aoC[0]); PG8_STAGE(PG8_SB(0, 1), cB + hstep, voffB); PG8_STAGE(PG8_SA(0, 1), Abase, aoC[1]);
    } else {
        PG8_STAGE(PG8_SB(0, 0), cB, voffB); PG8_STAGE(PG8_SA(0, 0), cA, voffA); PG8_STAGE(PG8_SB(0, 1), cB + hstep, voffB); PG8_STAGE(PG8_SA(0, 1), cA + hstep, voffA);
    }
    if (wr == 1) PG8_BAR;
    PG8_WAIT_V(4); PG8_BAR;
    if constexpr (GATHER) {
        PG8_STAGE(PG8_SB(1, 0), cB + kstep, voffB); PG8_STAGE(PG8_SA(1, 0), Abase + kstep, aoC[0]); PG8_STAGE(PG8_SB(1, 1), cB + hstep + kstep, voffB);
    } else {
        PG8_STAGE(PG8_SB(1, 0), cB + kstep, voffB); PG8_STAGE(PG8_SA(1, 0), cA + kstep, voffA); PG8_STAGE(PG8_SB(1, 1), cB + hstep + kstep, voffB);
    }
    PG8_WAIT_V(6); PG8_BAR;
    for (;;) {
        const bool has_next = S.next(ui + 1, nxt);
        const char* nA = has_next ? (GATHER ? Abase : S.aptr(nxt)) : cA; const char* nB = has_next ? S.bptr(nxt) : cB;
        if constexpr (GATHER) {
            if (has_next) {
#pragma unroll
                for (int h = 0; h < 2; ++h)
#pragma unroll
                    for (int i = 0; i < 2; ++i) aoN[h][i] = (unsigned)(S.arow(nxt, h * HALF + RA[i]) * K + CA[i]) * 2u;
            } else {
#pragma unroll
                for (int h = 0; h < 2; ++h)
#pragma unroll
                    for (int i = 0; i < 2; ++i) aoN[h][i] = aoC[h][i];
            }
        }
        for (int t = 0; t < nt; t += 2) {
            const bool last = (t == nt - 2);
            const char* a1 = cA + (size_t)(t + 1) * kstep;
            const char* a2 = last ? nA : cA + (size_t)(t + 2) * kstep; const char* b2 = last ? nB : cB + (size_t)(t + 2) * kstep;
            const char* a3 = a2 + kstep; const char* b3 = b2 + kstep;
            const char* gA1 = Abase + (size_t)(t + 1) * kstep; const char* gA2 = Abase + (last ? (size_t)0 : (size_t)(t + 2) * kstep); const char* gA3 = gA2 + kstep;
            unsigned oA1[2][2], oA2[2][2], oA3[2][2];
#pragma unroll
            for (int h = 0; h < 2; ++h)
#pragma unroll
                for (int i = 0; i < 2; ++i) { oA1[h][i] = aoC[h][i]; oA2[h][i] = last ? aoN[h][i] : aoC[h][i]; oA3[h][i] = oA2[h][i]; }
            (void)a1; (void)a3; (void)gA1; (void)gA3; (void)oA1; (void)oA3;
            PG8_LDB(B0, 0, 0); PG8_SCHED; PG8_LDA(At, 0, 0); PG8_STAGE_A(PG8_SA(1, 1), 1, 1);
            PG8_WAIT_L(8); PG8_BAR; PG8_WAIT_L(0); PG8_MMA(0, 0, At, B0); PG8_BAR; PG8_SCHED;
            PG8_LDB(B1, 0, 1); PG8_STAGE(PG8_SB(0, 0), b2, voffB);
            PG8_BAR; PG8_WAIT_L(0); PG8_MMA(0, 1, At, B1); PG8_BAR;
            PG8_LDA(At, 0, 1); PG8_STAGE_A(PG8_SA(0, 0), 2, 0);
            PG8_BAR; PG8_WAIT_L(0); PG8_MMA(1, 0, At, B0); PG8_BAR; PG8_SCHED;
            PG8_STAGE(PG8_SB(0, 1), b2 + hstep, voffB);
            PG8_WAIT_V(6); PG8_BAR; PG8_MMA(1, 1, At, B1); PG8_BAR;
            PG8_LDB(B0, 1, 0); PG8_SCHED; PG8_LDA(At, 1, 0); PG8_STAGE_A(PG8_SA(0, 1), 2, 1);
            PG8_WAIT_L(8); PG8_BAR; PG8_WAIT_L(0); PG8_MMA(0, 0, At, B0); PG8_BAR; PG8_SCHED;
            PG8_LDB(B1, 1, 1); PG8_STAGE(PG8_SB(1, 0), b3, voffB);
            PG8_BAR; PG8_WAIT_L(0); PG8_MMA(0, 1, At, B1); PG8_BAR;
            PG8_LDA(At, 1, 1); PG8_STAGE_A(PG8_SA(1, 0), 3, 0);
            PG8_BAR; PG8_WAIT_L(0); PG8_MMA(1, 0, At, B0); PG8_BAR; PG8_SCHED;
            PG8_STAGE(PG8_SB(1, 1), b3 + hstep, voffB);
            PG8_WAIT_V(6); PG8_BAR; PG8_MMA(1, 1, At, B1); PG8_BAR;
        }
        { int t2 = tid; asm volatile("" : "+v"(t2)); const int l2 = t2 & 63; E(acc, cur, wr, wc, l2 & 15, l2 >> 4); }
        if (!has_next) break;
#pragma unroll
        for (int a = 0; a < 2; ++a)
#pragma unroll
            for (int b = 0; b < 2; ++b)
#pragma unroll
                for (int m = 0; m < 4; ++m)
#pragma unroll
                    for (int n = 0; n < 2; ++n) acc[a][b][m][n] = (f32x4){0.f, 0.f, 0.f, 0.f};
        cur = nxt; cA = nA; cB = nB; ++ui;
        if constexpr (GATHER) {
#pragma unroll
            for (int h = 0; h < 2; ++h)
#pragma unroll
                for (int i = 0; i < 2; ++i) aoC[h][i] = aoN[h][i];
        }
    }
    PG8_WAIT_V(0);
    if (wr == 0) PG8_BAR;
    PG8_BAR;
#undef PG8_SA
#undef PG8_SB
#undef PG8_STAGE
#undef PG8_STAGE_A
#undef PG8_LDA
#undef PG8_LDB
#undef PG8_MMA
#undef PG8_WAIT_V
#undef PG8_WAIT_L
#undef PG8_BAR
#undef PG8_SCHED
}
}

struct Frame {
    LAS unsigned char* lds; int tid, lane, wave, G, bid, gw, nw;
    unsigned char* ws;
};
extern __shared__ __attribute__((aligned(16))) unsigned char lds_raw[];
typedef const __attribute__((address_space(4))) Params* KP;
__device__ __forceinline__ Params load_params(const void* kp_) {
    const unsigned long long v = (unsigned long long)kp_;
    const unsigned lo = __builtin_amdgcn_readfirstlane((unsigned)v), hi = __builtin_amdgcn_readfirstlane((unsigned)(v >> 32));
    KP kp = (KP)(((unsigned long long)hi << 32) | lo);
    Params P;
#pragma unroll
    for (int i = 0; i < 35; ++i) P.in[i] = kp->in[i];
    P.out = kp->out; P.ws = kp->ws; P.ph_lo = kp->ph_lo; P.ph_hi = kp->ph_hi;
    return P;
}
#define PHASE static __attribute__((noinline)) __device__ void
#define PHASE_INL static __device__ __forceinline__ void
__device__ __forceinline__ Frame make_frame(unsigned char* ws, int wave_) {
    Frame F; F.lds = (LAS unsigned char*)lds_raw; F.wave = __builtin_amdgcn_readfirstlane(wave_);
    int t_ = F.wave * 64 + lane_id(); asm volatile("" : "+v"(t_));
    F.tid = t_; F.lane = F.tid & 63;
    F.G = gridDim.x; F.bid = blockIdx.x; F.gw = F.bid * NWAVES + F.wave; F.nw = F.G * NWAVES; F.ws = ws; return F;
}
__device__ __forceinline__ Frame sub_frame(Frame F, int bid, int G) { F.bid = bid; F.G = G; F.gw = F.bid * NWAVES + F.wave; F.nw = F.G * NWAVES; return F; }
#define PHASE_ENTER const Params P = load_params(kp_); const Frame F = make_frame(P.ws, wv_)

__device__ __forceinline__ void conv_job(const Frame& F, const float* src, bf16_t* dst, int K, int N, int mode) {
    LAS float* tile = (LAS float*)(F.lds + F.wave * (64 * 65 * 4));
    const int tk = K / 64, tn = N / 64, ntile = tk * tn, lane = F.lane;
    for (int t = F.gw; t < ntile; t += F.nw) {
        const int k0 = (t / tn) * 64, n0 = (t % tn) * 64;
#pragma unroll 4
        for (int i = 0; i < 16; ++i) { const int row = i * 4 + (lane >> 4), c4 = (lane & 15) * 4;
            const f32x4 v = *(const f32x4*)(src + (size_t)(k0 + row) * N + n0 + c4);
            tile[row * 65 + c4 + 0] = v[0]; tile[row * 65 + c4 + 1] = v[1]; tile[row * 65 + c4 + 2] = v[2]; tile[row * 65 + c4 + 3] = v[3]; }
        __builtin_amdgcn_wave_barrier(); asm volatile("s_waitcnt lgkmcnt(0)" ::: "memory");
#pragma unroll 2
        for (int i = 0; i < 8; ++i) { const int n = i * 8 + (lane >> 3), kc = (lane & 7) * 8;
            float f[8];
#pragma unroll
            for (int j = 0; j < 8; ++j) f[j] = tile[(kc + j) * 65 + n];
            const int ng = n0 + n; const int drow = mode == 0 ? ng : ((ng >> 7) * 256 + (mode == 2 ? 128 : 0) + (ng & 127));
            u32x4 w; w.x = pk_bf16(f[0], f[1]); w.y = pk_bf16(f[2], f[3]); w.z = pk_bf16(f[4], f[5]); w.w = pk_bf16(f[6], f[7]);
            *(u32x4*)(dst + (size_t)drow * K + k0 + kc) = w; }
        __builtin_amdgcn_wave_barrier(); asm volatile("s_waitcnt lgkmcnt(0)" ::: "memory");
    }
}

__device__ __forceinline__ void phase_prologue(const Frame& F, const Params& P) {
    float* modv = (float*)(F.ws + WS_MODV);
    LAS float* s = (LAS float*)F.lds;
    LAS float* red = (LAS float*)(F.lds + 9 * 1024 * 4);
    for (int cb = F.bid; cb < (2 * MODW) / 64; cb += F.G) {
        for (int i = F.tid; i < 9 * 1024; i += NTHREADS) { const int mi = i >> 10, k = i & 1023; const float c = mi < 8 ? P.in[I_C][mi * D + k] : P.in[I_CCTX][k]; s[i] = siluf_(c); }
        __syncthreads();
        const int colg = cb * 64 + F.lane, l = colg / MODW, col = colg % MODW;
        const float* w = P.in[I_MODW] + (size_t)l * D * MODW + col;
        float acc[9];
#pragma unroll
        for (int mi = 0; mi < 9; ++mi) acc[mi] = 0.f;
        const int kb = F.wave * 128;
#pragma unroll 8
        for (int k = 0; k < 128; ++k) { const float wv = w[(size_t)(kb + k) * MODW];
#pragma unroll
            for (int mi = 0; mi < 9; ++mi) acc[mi] += s[mi * 1024 + kb + k] * wv; }
#pragma unroll
        for (int mi = 0; mi < 9; ++mi) red[(F.wave * 9 + mi) * 64 + F.lane] = acc[mi];
        __syncthreads();
        for (int i = F.tid; i < 9 * 64; i += NTHREADS) { const int mi = i >> 6, ln = i & 63; float a = 0.f;
#pragma unroll
            for (int w8 = 0; w8 < 8; ++w8) a += red[(w8 * 9 + mi) * 64 + ln];
            const int cg = cb * 64 + ln, l2 = cg / MODW, c2 = cg % MODW;
            modv[((size_t)l2 * 9 + mi) * MODW + c2] = a + P.in[I_MODB][l2 * MODW + c2]; }
        __syncthreads();
    }
    for (int l = 0; l < 2; ++l) {
        conv_job(F, P.in[I_WIN] + (size_t)l * D * INW, (bf16_t*)(F.ws + WS_BTIN) + (size_t)l * INW * D, D, INW, 0);
        conv_job(F, P.in[I_WOUT] + (size_t)l * D * D, (bf16_t*)(F.ws + WS_BTOUT) + (size_t)l * D * D, D, D, 0);
    }
    conv_job(F, P.in[I_FG], (bf16_t*)(F.ws + WS_BTGU), D, DFF, 1);
    conv_job(F, P.in[I_FU], (bf16_t*)(F.ws + WS_BTGU), D, DFF, 2);
    conv_job(F, P.in[I_FD], (bf16_t*)(F.ws + WS_BTDN), DFF, D, 0);
    for (int ld = 0; ld < 4; ++ld) { bf16_t* base = (bf16_t*)(F.ws + WS_LORA + (size_t)ld * LORA_LD_BYTES);
        conv_job(F, P.in[I_W2] + (size_t)ld * 64 * 256, base, 64, 256, 0);
        conv_job(F, P.in[I_A2] + (size_t)ld * 64 * 256, base + 256 * 64, 64, 256, 0);
        conv_job(F, P.in[I_G2] + (size_t)ld * 128 * 256, base + 2 * 256 * 64, 128, 256, 0); }
}
__device__ __forceinline__ void phase_moe_convert(const Frame& F, const Params& P) {
    for (int e = 0; e < NEXP; ++e) {
        bf16_t* gu = (bf16_t*)(F.ws + WS_MOE + (size_t)e * MOE_E_BYTES); bf16_t* dn = (bf16_t*)(F.ws + WS_MOE + (size_t)e * MOE_E_BYTES + MOE_GU_BYTES);
        conv_job(F, P.in[I_MG] + (size_t)e * D * DFE, gu, D, DFE, 1);
        conv_job(F, P.in[I_MU] + (size_t)e * D * DFE, gu, D, DFE, 2);
        conv_job(F, P.in[I_MD] + (size_t)e * DFE * D, dn, DFE, D, 0);
    }
}

template <bool ROUTER>
__device__ __forceinline__ void phase_norm(const Frame& F, const Params& P, int l, int which, int nrows, const float* srcL, const float* srcC) {
    const float* g = (which == 0 ? P.in[I_N1G] : P.in[I_N2G]) + l * D;
    const float* modv = (const float*)(F.ws + WS_MODV) + (size_t)l * 9 * MODW + (which == 0 ? 0 : 3 * D);
    bf16_t* HL = (bf16_t*)(F.ws + WS_HL);
    LAS float* rt = (LAS float*)F.lds;
    if (ROUTER) {
        for (int i = F.tid; i < D * NEXP; i += NTHREADS) rt[i] = P.in[I_ROUTER][i];
        int* rmap = (int*)(F.ws + WS_ROUTE + RT_RMAP);
        for (int i = F.bid * NTHREADS + F.tid; i < 2 * NROW; i += F.G * NTHREADS) rmap[i] = -1;
        __syncthreads();
    }
    const int lane = F.lane;
    for (int r = F.gw; r < nrows; r += F.nw) {
        const float* xr = r < NLAT ? srcL + (size_t)r * D : srcC + (size_t)(r - NLAT) * D;
        const float* mv = modv + (size_t)row_mi(r) * MODW;
        f32x4 x[4]; float ss = 0.f;
#pragma unroll
        for (int j = 0; j < 4; ++j) { x[j] = *(const f32x4*)(xr + j * 256 + lane * 4); ss += x[j][0] * x[j][0] + x[j][1] * x[j][1] + x[j][2] * x[j][2] + x[j][3] * x[j][3]; }
        ss = wave_sum(ss);
        const float rstd = rsqrtf(ss * (1.0f / D) + 1e-6f);
        float lg[NEXP];
        if (ROUTER) {
#pragma unroll
            for (int e = 0; e < NEXP; ++e) lg[e] = 0.f;
        }
#pragma unroll
        for (int j = 0; j < 4; ++j) { const int c = j * 256 + lane * 4;
            const f32x4 gg = *(const f32x4*)(g + c), sh = *(const f32x4*)(mv + c), sc = *(const f32x4*)(mv + D + c);
            f32x4 y = (x[j] * rstd * gg) * (sc + 1.0f) + sh;
            u32x2 w; w.x = pk_bf16(y[0], y[1]); w.y = pk_bf16(y[2], y[3]);
            *(u32x2*)(HL + (size_t)r * D + c) = w;
            if (ROUTER) {
#pragma unroll
                for (int q = 0; q < 4; ++q) { const f32x4 r0 = *(const LAS f32x4*)(rt + (c + q) * 8), r1 = *(const LAS f32x4*)(rt + (c + q) * 8 + 4);
                    lg[0] += y[q] * r0[0]; lg[1] += y[q] * r0[1]; lg[2] += y[q] * r0[2]; lg[3] += y[q] * r0[3];
                    lg[4] += y[q] * r1[0]; lg[5] += y[q] * r1[1]; lg[6] += y[q] * r1[2]; lg[7] += y[q] * r1[3]; asm volatile("" ::: "memory"); }
            }
        }
        if (ROUTER) {
#pragma unroll
            for (int e = 0; e < NEXP; ++e) lg[e] = wave_sum(lg[e]);
            if (lane == 0) {
                int e1 = 0; float l1 = lg[0];
#pragma unroll
                for (int e = 1; e < NEXP; ++e) if (lg[e] > l1) { l1 = lg[e]; e1 = e; }
                int e2 = -1; float l2 = -3.0e38f;
#pragma unroll
                for (int e = 0; e < NEXP; ++e) if (e != e1 && lg[e] > l2) { l2 = lg[e]; e2 = e; }
                if (e2 < 0) { e2 = e1 == 0 ? 1 : 0; l2 = l1; }
                const float ex = __expf(l2 - l1), g1 = 1.0f / (1.0f + ex), g2 = ex * g1;
                unsigned* cnt = (unsigned*)(F.ws + WS_CTL) + CW_MOECNT;
                const unsigned p1 = atomicAdd(cnt + e1, 1u), p2 = atomicAdd(cnt + 8 + e2, 1u);
                int* te = (int*)(F.ws + WS_ROUTE + RT_TOKE); float* tg = (float*)(F.ws + WS_ROUTE + RT_TOKG); int* tp = (int*)(F.ws + WS_ROUTE + RT_TOKP);
                te[r * 2] = e1; te[r * 2 + 1] = e2; tg[r * 2] = g1; tg[r * 2 + 1] = g2; tp[r * 2] = (int)p1; tp[r * 2 + 1] = (int)p2;
            }
        }
    }
}
__device__ __forceinline__ void moe_tstart(const Frame& F, int pass, int (&ts)[9]) {
    const unsigned* cnt = (const unsigned*)(F.ws + WS_CTL) + CW_MOECNT + pass * 8;
    int a = 0;
#pragma unroll
    for (int e = 0; e < 8; ++e) { ts[e] = a; a += (int)((__hip_atomic_load(cnt + e, __ATOMIC_RELAXED, __HIP_MEMORY_SCOPE_AGENT) + 255u) >> 8); }
    ts[8] = a;
}
__device__ __forceinline__ void phase_moe_rowmap(const Frame& F) {
    int ts0[9], ts1[9]; moe_tstart(F, 0, ts0); moe_tstart(F, 1, ts1);
    const int* te = (const int*)(F.ws + WS_ROUTE + RT_TOKE); const float* tg = (const float*)(F.ws + WS_ROUTE + RT_TOKG); const int* tp = (const int*)(F.ws + WS_ROUTE + RT_TOKP);
    int* rmap = (int*)(F.ws + WS_ROUTE + RT_RMAP); float* sg = (float*)(F.ws + WS_ROUTE + RT_SGATE);
    for (int t = F.bid * NTHREADS + F.tid; t < NLAT; t += F.G * NTHREADS) {
        { const int e = te[t * 2]; int st = 0;
#pragma unroll
          for (int j = 0; j < 8; ++j) st = (e == j) ? ts0[j] : st;
          const int slot = st * 256 + tp[t * 2]; rmap[slot] = t; sg[slot] = tg[t * 2]; }
        { const int e = te[t * 2 + 1]; int st = 0;
#pragma unroll
          for (int j = 0; j < 8; ++j) st = (e == j) ? ts1[j] : st;
          const int slot = st * 256 + tp[t * 2 + 1]; rmap[NROW + slot] = t; sg[NROW + slot] = tg[t * 2 + 1]; }
    }
}

struct RowGeo { int b, tt, pos, len; };
__device__ __forceinline__ RowGeo row_geo(int r) { RowGeo g; if (r < NLAT) { g.b = r >> 12; g.pos = r & 4095; g.len = SEQ; g.tt = CTXL + g.pos; } else { const int q = r - NLAT; g.b = q >> 8; g.pos = q & 255; g.len = CTXL; g.tt = g.pos; } return g; }

__device__ __forceinline__ void rw_shift4(const bf16_t* PL, const float* mup, const float* mun, int r, const RowGeo& g, int j, float (&u)[4]) {
    const bf16_t* p = PL + (size_t)r * INW + O_RW + j;
    const bool hp = g.pos > 0, hn = g.pos < g.len - 1;
    float c[4], pv[4], nv[4];
    unpack4(*(const u32x2*)p, c); unpack4(*(const u32x2*)(p - (hp ? INW : 0)), pv); unpack4(*(const u32x2*)(p + (hn ? INW : 0)), nv);
    const f32x4 mp = *(const f32x4*)(mup + j), mn = *(const f32x4*)(mun + j);
#pragma unroll
    for (int q = 0; q < 4; ++q) u[q] = c[q] + mp[q] * ((hp ? pv[q] : 0.f) - c[q]) + mn[q] * ((hn ? nv[q] : 0.f) - c[q]);
}

__device__ __forceinline__ void rw_shift8(const bf16_t* PL, const float* mup, const float* mun, int r, const RowGeo& g, int j, float (&u)[8]) {
    const bf16_t* p = PL + (size_t)r * INW + O_RW + j;
    const bool hp = g.pos > 0, hn = g.pos < g.len - 1;
    float c[8], pv[8], nv[8];
    unpack8(*(const u32x4*)p, c); unpack8(*(const u32x4*)(p - (hp ? INW : 0)), pv); unpack8(*(const u32x4*)(p + (hn ? INW : 0)), nv);
    const f32x4 mp0 = *(const f32x4*)(mup + j), mp1 = *(const f32x4*)(mup + j + 4), mn0 = *(const f32x4*)(mun + j), mn1 = *(const f32x4*)(mun + j + 4);
#pragma unroll
    for (int q = 0; q < 4; ++q) { u[q] = c[q] + mp0[q] * ((hp ? pv[q] : 0.f) - c[q]) + mn0[q] * ((hn ? nv[q] : 0.f) - c[q]);
        u[4 + q] = c[4 + q] + mp1[q] * ((hp ? pv[4 + q] : 0.f) - c[4 + q]) + mn1[q] * ((hn ? nv[4 + q] : 0.f) - c[4 + q]); }
}
__device__ __forceinline__ bf16x8 pack8f(const float (&f)[8]) {
    u32x4 w; w.x = cvt_pk_bf16(f[0], f[1]); w.y = cvt_pk_bf16(f[2], f[3]); w.z = cvt_pk_bf16(f[4], f[5]); w.w = cvt_pk_bf16(f[6], f[7]); return __builtin_bit_cast(bf16x8, w);
}
constexpr int RL_MUP = 0, RL_MUN = 5120, RL_KK = 10240, RL_KA = 11264, RL_W0 = 12288, RL_A0 = 14336, RL_RK = 16384, RL_GNG = 17408, RL_GNB = 18432, RL_END = 19456;
__device__ __forceinline__ void rw_stage_tables(const Frame& F, const Params& P, int l) {
    LAS float* T = (LAS float*)F.lds;
    for (int i = F.tid; i < 1280; i += NTHREADS) { T[RL_MUP / 4 + i] = P.in[I_MUP][l * 1280 + i]; T[RL_MUN / 4 + i] = P.in[I_MUN][l * 1280 + i]; }
    for (int i = F.tid; i < 256; i += NTHREADS) { T[RL_KK / 4 + i] = P.in[I_KK][l * 256 + i]; T[RL_KA / 4 + i] = P.in[I_KA][l * 256 + i]; T[RL_RK / 4 + i] = P.in[I_RK][l * 256 + i];
        T[RL_GNG / 4 + i] = P.in[I_GNG][l * 256 + i]; T[RL_GNB / 4 + i] = P.in[I_GNB][l * 256 + i]; }
    for (int i = F.tid; i < 512; i += NTHREADS) { T[RL_W0 / 4 + i] = P.in[I_W0][l * 512 + i]; T[RL_A0 / 4 + i] = P.in[I_A0][l * 512 + i]; }
    __syncthreads();
}
__device__ __forceinline__ void rw_mix8(const LAS float* T, const u32x4 (&raw)[3], bool hp, bool hn, int j, float (&u)[8]) {
    float c[8], pv[8], nv[8]; unpack8(raw[0], c); unpack8(raw[1], pv); unpack8(raw[2], nv);
    const f32x4 mp0 = *(const LAS f32x4*)(T + RL_MUP / 4 + j), mp1 = *(const LAS f32x4*)(T + RL_MUP / 4 + j + 4), mn0 = *(const LAS f32x4*)(T + RL_MUN / 4 + j), mn1 = *(const LAS f32x4*)(T + RL_MUN / 4 + j + 4);
#pragma unroll
    for (int q = 0; q < 4; ++q) { u[q] = c[q] + mp0[q] * ((hp ? pv[q] : 0.f) - c[q]) + mn0[q] * ((hn ? nv[q] : 0.f) - c[q]);
        u[4 + q] = c[4 + q] + mp1[q] * ((hp ? pv[4 + q] : 0.f) - c[4 + q]) + mn1[q] * ((hn ? nv[4 + q] : 0.f) - c[4 + q]); }
}
__device__ __forceinline__ void rw_mix4(const LAS float* T, const u32x2 (&raw)[3], bool hp, bool hn, int j, float (&u)[4]) {
    float c[4], pv[4], nv[4]; unpack4(raw[0], c); unpack4(raw[1], pv); unpack4(raw[2], nv);
    const f32x4 mp = *(const LAS f32x4*)(T + RL_MUP / 4 + j), mn = *(const LAS f32x4*)(T + RL_MUN / 4 + j);
#pragma unroll
    for (int q = 0; q < 4; ++q) u[q] = c[q] + mp[q] * ((hp ? pv[q] : 0.f) - c[q]) + mn[q] * ((hn ? nv[q] : 0.f) - c[q]);
}
__device__ __forceinline__ void phase_rw_prep(const Frame& F, const Params& P, int l) {
    const bf16_t* PL = (const bf16_t*)(F.ws + WS_PL);
    f16_t* SH = (f16_t*)(F.ws + WS_SH); f16_t* SD = (f16_t*)(F.ws + WS_SD);
    const int lane = F.lane;
    rw_stage_tables(F, P, l);
    const LAS float* T = (const LAS float*)F.lds;
    for (int tile = F.gw; tile < NROW / 16; tile += F.nw) {
        int l1 = lane; asm volatile("" : "+v"(l1)); const int tk = l1 & 15, g = l1 >> 4;
        const int r = tile * 16 + tk; const RowGeo geo = row_geo(r);
        const bool hp = geo.pos > 0, hn = geo.pos < geo.len - 1;
        const bf16_t* prow = PL + (size_t)r * INW + O_RW; const int dprev = hp ? -INW : 0, dnext = hn ? INW : 0;
        bf16x8 tw[2][2], ta[2][2];
#pragma unroll
        for (int d = 0; d < 2; ++d) { u32x4 raw[4][3];
#pragma unroll
          for (int i = 0; i < 4; ++i) { const bf16_t* p = prow + 768 + 256 * d + 64 * (i & 1) + 32 * (i >> 1) + 8 * g;
              raw[i][0] = *(const u32x4*)p; raw[i][1] = *(const u32x4*)(p + dprev); raw[i][2] = *(const u32x4*)(p + dnext); }
#pragma unroll
          for (int i = 0; i < 4; ++i) { float u[8]; rw_mix8(T, raw[i], hp, hn, 768 + 256 * d + 64 * (i & 1) + 32 * (i >> 1) + 8 * g, u);
              if ((i & 1) == 0) {
#pragma unroll
                  for (int q = 0; q < 8; ++q) u[q] = 1.0f - 2.0f / (1.0f + __expf(2.0f * u[q]));
                  tw[d][i >> 1] = pack8f(u); }
              else ta[d][i >> 1] = pack8f(u); }
          asm volatile("" ::: "memory"); }
        asm volatile("" ::: "memory");
#pragma unroll 1
        for (int h = 0; h < 4; ++h) {
            int l2 = lane; asm volatile("" : "+v"(l2)); const int tk = l2 & 15, g = l2 >> 4;
            const int r = tile * 16 + tk; const RowGeo geo = row_geo(r);
            const bool hp = geo.pos > 0, hn = geo.pos < geo.len - 1;
            const bf16_t* prow = PL + (size_t)r * INW + O_RW + 64 * h + 8 * g; const int dprev = hp ? -INW : 0, dnext = hn ? INW : 0;
            float ur[4][4], uk[4][4], uv[4][4], kkv[4][4]; float ss = 0.f;
            { u32x4 raw[6][3];
#pragma unroll
              for (int i = 0; i < 6; ++i) { const bf16_t* p = prow + 256 * (i >> 1) + 32 * (i & 1);
                  raw[i][0] = *(const u32x4*)p; raw[i][1] = *(const u32x4*)(p + dprev); raw[i][2] = *(const u32x4*)(p + dnext); }
#pragma unroll
              for (int u = 0; u < 2; ++u) { float x8[8]; const int c = 64 * h + 32 * u + 8 * g;
                  rw_mix8(T, raw[u], hp, hn, c, x8);
#pragma unroll
                  for (int e = 0; e < 8; ++e) ur[2 * u + (e >> 2)][e & 3] = x8[e];
                  rw_mix8(T, raw[2 + u], hp, hn, 256 + c, x8);
#pragma unroll
                  for (int e = 0; e < 8; ++e) uk[2 * u + (e >> 2)][e & 3] = x8[e];
                  rw_mix8(T, raw[4 + u], hp, hn, 512 + c, x8);
#pragma unroll
                  for (int e = 0; e < 8; ++e) uv[2 * u + (e >> 2)][e & 3] = x8[e];
                  const f32x4 k0 = *(const LAS f32x4*)(T + RL_KK / 4 + c), k1 = *(const LAS f32x4*)(T + RL_KK / 4 + c + 4);
#pragma unroll
                  for (int q = 0; q < 4; ++q) { kkv[2 * u][q] = uk[2 * u][q] * k0[q]; kkv[2 * u + 1][q] = uk[2 * u + 1][q] * k1[q]; ss += kkv[2 * u][q] * kkv[2 * u][q] + kkv[2 * u + 1][q] * kkv[2 * u + 1][q]; } } }
            ss += __shfl_xor(ss, 16); ss += __shfl_xor(ss, 32);
            const float rn = rsqrtf(ss + 1e-12f);
            const size_t shrow = ((size_t)(geo.b * 4 + h) * TT + geo.tt) * 192;
#pragma unroll
            for (int u = 0; u < 2; ++u) { f16x8 o1, o2, o3;
#pragma unroll
                for (int e = 0; e < 8; ++e) { const int t = 2 * u + (e >> 2), q = e & 3; kkv[t][q] *= rn; o1[e] = (f16_t)ur[t][q]; o2[e] = (f16_t)uv[t][q]; o3[e] = (f16_t)(-kkv[t][q]); }
                f16_t* sp = SH + shrow + 32 * u + 8 * g; *(f16x8*)sp = o1; *(f16x8*)(sp + 64) = o2; *(f16x8*)(sp + 128) = o3; }
#pragma unroll 1
            for (int d = 0; d < 2; ++d) {
                const bf16_t* w2t = (const bf16_t*)(F.ws + WS_LORA + (size_t)(l * 2 + d) * LORA_LD_BYTES); const bf16_t* a2t = w2t + 256 * 64;
                const size_t sdrow = ((size_t)((d * 8 + geo.b) * 4 + h) * TT + geo.tt) * 192;
                const bf16x8 tw0 = d ? tw[1][0] : tw[0][0], tw1 = d ? tw[1][1] : tw[0][1], ta0 = d ? ta[1][0] : ta[0][0], ta1 = d ? ta[1][1] : ta[0][1];
                bf16x8 wf[4][2], af[4][2];
#pragma unroll
                for (int t = 0; t < 4; ++t) { const int wrow = 64 * h + 32 * (t >> 1) + 8 * (tk >> 2) + 4 * (t & 1) + (tk & 3);
                    const bf16_t* wr = w2t + (size_t)wrow * 64 + 8 * g; const bf16_t* ar = a2t + (size_t)wrow * 64 + 8 * g;
                    wf[t][0] = *(const bf16x8*)wr; wf[t][1] = *(const bf16x8*)(wr + 32); af[t][0] = *(const bf16x8*)ar; af[t][1] = *(const bf16x8*)(ar + 32); }
                f16x8 o1[2], o2[2], o3[2];
#pragma unroll
                for (int t = 0; t < 4; ++t) { const int c = 64 * h + 32 * (t >> 1) + 8 * g + 4 * (t & 1);
                    f32x4 xw = *(const LAS f32x4*)(T + RL_W0 / 4 + d * 256 + c), xa = *(const LAS f32x4*)(T + RL_A0 / 4 + d * 256 + c);
                    xw = __builtin_amdgcn_mfma_f32_16x16x32_bf16(wf[t][0], tw0, xw, 0, 0, 0); xw = __builtin_amdgcn_mfma_f32_16x16x32_bf16(wf[t][1], tw1, xw, 0, 0, 0);
                    xa = __builtin_amdgcn_mfma_f32_16x16x32_bf16(af[t][0], ta0, xa, 0, 0, 0); xa = __builtin_amdgcn_mfma_f32_16x16x32_bf16(af[t][1], ta1, xa, 0, 0, 0);
                    const f32x4 kaw = *(const LAS f32x4*)(T + RL_KA / 4 + c);
#pragma unroll
                    for (int q = 0; q < 4; ++q) {
                        const float nx = -xw[q]; const float sp = fmaxf(nx, 0.f) + __logf(1.0f + __expf(-fabsf(nx)));
                        const float e = __expf(-sp - 0.5f);
                        const float omw = 1.0f - __expf(-e);
                        const float a = sigmoidf_(xa[q]);
                        o1[t >> 1][(t & 1) * 4 + q] = (f16_t)omw; o2[t >> 1][(t & 1) * 4 + q] = (f16_t)(uk[t][q] * (1.0f + (a - 1.0f) * kaw[q])); o3[t >> 1][(t & 1) * 4 + q] = (f16_t)(kkv[t][q] * a); } }
#pragma unroll
                for (int u = 0; u < 2; ++u) { f16_t* sp = SD + sdrow + 32 * u + 8 * g; *(f16x8*)sp = o1[u]; *(f16x8*)(sp + 64) = o2[u]; *(f16x8*)(sp + 128) = o3[u]; }
                asm volatile("" ::: "memory");
            }
        }
    }
    __syncthreads();
}

constexpr int CS_ZP = 0, CS_RPP = 2048, CS_BH = 4096, CS_KH = 6144, CS_VV = 8192, CS_MT = 10240, CS_NT = 11264, CS_WC = 12288, CS_SLOT = 12544;
constexpr int CS_ZIMG = 8 * CS_SLOT;
constexpr int CS_NCHUNK = TT / 16;
__device__ __forceinline__ int cs_tt(int d, int q, int s) { const int st = 16 * q + s; return d == 0 ? st : (st < CTXL ? CTXL - 1 - st : TT + CTXL - 1 - st); }
__device__ __forceinline__ float dpp_shr(float old, float v, int) { return v; }
template <int N> __device__ __forceinline__ float row_shr(float v, float old) {
    return __builtin_bit_cast(float, __builtin_amdgcn_update_dpp(__builtin_bit_cast(int, old), __builtin_bit_cast(int, v), 0x110 + N, 0xF, 0xF, false));
}
__device__ __forceinline__ bf16x8 cs_pack(const float (&a)[4], const float (&b)[4]) {
    u32x4 w; w.x = cvt_pk_bf16(a[0], a[1]); w.y = cvt_pk_bf16(a[2], a[3]); w.z = cvt_pk_bf16(b[0], b[1]); w.w = cvt_pk_bf16(b[2], b[3]); return __builtin_bit_cast(bf16x8, w);
}
__device__ __forceinline__ bf16x8 cs_op16(const f32x4& x) { u32x4 w; w.x = cvt_pk_bf16(x[0], x[1]); w.y = cvt_pk_bf16(x[2], x[3]); w.z = 0u; w.w = 0u; return __builtin_bit_cast(bf16x8, w); }
#define CS_MFMA(a, b, c) __builtin_amdgcn_mfma_f32_16x16x32_bf16((a), (b), (c), 0, 0, 0)
__device__ __forceinline__ f32x4 cs_mm16(const f32x4& xt_d, const f32x4& y_d) { return CS_MFMA(cs_op16(xt_d), cs_op16(y_d), ((f32x4){0.f, 0.f, 0.f, 0.f})); }
__device__ __forceinline__ v4i16_t cs_tr(const LAS unsigned char* img, int lane, int T) {
    const int g = lane >> 4, q = (lane & 15) >> 2, p = lane & 3;
    return __builtin_amdgcn_ds_read_tr16_b64_v4i16((LAS v4i16_t*)(img + (4 * g + q) * 128 + p * 32 + (T >> 1) * 16 + (T & 1) * 8));
}
__device__ __forceinline__ bf16x8 cs_lo(v4i16_t x) { bf16x8 r; r[0] = x[0]; r[1] = x[1]; r[2] = x[2]; r[3] = x[3]; r[4] = 0; r[5] = 0; r[6] = 0; r[7] = 0; return r; }

struct CsRaw { u32x2 x[4], z[4], r[4], b[4], k[4], v[4]; };
__device__ __forceinline__ void cs_load(CsRaw& R, const f16_t* sh, const f16_t* sd, int d, int q, int lane) {
    const int s = lane & 15, g = lane >> 4; const int tt = cs_tt(d, q, s);
    const f16_t* shp = sh + (size_t)tt * 192 + 4 * g; const f16_t* sdp = sd + (size_t)tt * 192 + 4 * g;
#pragma unroll
    for (int T = 0; T < 4; ++T) { R.x[T] = *(const u32x2*)(sdp + 16 * T); R.z[T] = *(const u32x2*)(shp + 128 + 16 * T); R.r[T] = *(const u32x2*)(shp + 16 * T);
        R.b[T] = *(const u32x2*)(sdp + 128 + 16 * T); R.k[T] = *(const u32x2*)(sdp + 64 + 16 * T); R.v[T] = *(const u32x2*)(shp + 64 + 16 * T); }
}
__device__ __forceinline__ void cs_prepass(LAS unsigned char* slot, LAS unsigned char* zimg, CsRaw& raw, const f16_t* sh, const f16_t* sd, int d, int qn, int lane) {
    const int s = lane & 15, g = lane >> 4;
    float Wc[4][4], Wp[4][4], iW[4][4];
#pragma unroll
    for (int T = 0; T < 4; ++T) { const f16x4 x4 = __builtin_bit_cast(f16x4, raw.x[T]);
#pragma unroll
        for (int j = 0; j < 4; ++j) { float wc = 1.0f - (float)x4[j];
            wc *= row_shr<1>(wc, 1.0f); wc *= row_shr<2>(wc, 1.0f); wc *= row_shr<4>(wc, 1.0f); wc *= row_shr<8>(wc, 1.0f);
            Wc[T][j] = wc; Wp[T][j] = row_shr<1>(wc, 1.0f); iW[T][j] = __builtin_amdgcn_rcpf(wc); } }
    if (s == 15) {
#pragma unroll
        for (int T = 0; T < 4; ++T) *(LAS f32x4*)(slot + CS_WC + (16 * T + 4 * g) * 4) = (f32x4){Wc[T][0], Wc[T][1], Wc[T][2], Wc[T][3]}; }
    bf16x8 oZ[2], oR[2], oB[2], oK[2];
    const int ioff = s * 128 + g * 32;
#define CS_STAGE(dst, SRC, SC, IMG) do { float t_[4][4]; \
        _Pragma("unroll") for (int T = 0; T < 4; ++T) { const f16x4 q4 = __builtin_bit_cast(f16x4, SRC[T]); \
            _Pragma("unroll") for (int j = 0; j < 4; ++j) t_[T][j] = (float)q4[j] * SC; } \
        _Pragma("unroll") for (int kk = 0; kk < 2; ++kk) { dst[kk] = cs_pack(t_[2 * kk], t_[2 * kk + 1]); if (IMG) *(LAS bf16x8*)((IMG) + ioff + kk * 16) = dst[kk]; } \
        } while (0)
    CS_STAGE(oZ, raw.z, Wp[T][j], zimg);
    CS_STAGE(oR, raw.r, Wc[T][j], (LAS unsigned char*)nullptr);
    CS_STAGE(oB, raw.b, iW[T][j], slot + CS_BH);
    CS_STAGE(oK, raw.k, iW[T][j], slot + CS_KH);
    { bf16x8 oV[2]; CS_STAGE(oV, raw.v, 1.0f, slot + CS_VV); }
#undef CS_STAGE
    asm volatile("" ::: "memory");
    if (qn >= 0) cs_load(raw, sh, sd, d, qn, lane);
    const f32x4 zero4 = (f32x4){0.f, 0.f, 0.f, 0.f};
    f32x4 A_D = CS_MFMA(oB[1], oZ[1], CS_MFMA(oB[0], oZ[0], zero4)), AT_D = CS_MFMA(oZ[1], oB[1], CS_MFMA(oZ[0], oB[0], zero4));
    f32x4 BkT_D = CS_MFMA(oZ[1], oK[1], CS_MFMA(oZ[0], oK[0], zero4));
    f32x4 Ar_D = CS_MFMA(oB[1], oR[1], CS_MFMA(oB[0], oR[0], zero4)), Kr_D = CS_MFMA(oK[1], oR[1], CS_MFMA(oK[0], oR[0], zero4));
    f32x4 I_D;
#pragma unroll
    for (int j = 0; j < 4; ++j) { const int m = 4 * g + j;
        A_D[j] = m < s ? A_D[j] : 0.f; AT_D[j] = s < m ? AT_D[j] : 0.f; BkT_D[j] = s < m ? BkT_D[j] : 0.f;
        Ar_D[j] = m <= s ? Ar_D[j] : 0.f; Kr_D[j] = m <= s ? Kr_D[j] : 0.f; I_D[j] = m == s ? 1.f : 0.f; }
    f32x4 Ab, AbT, A1, A2m;
#pragma unroll
    for (int j = 0; j < 4; ++j) { const int m = 4 * g + j; const bool b0 = (m >> 2) == (s >> 2), b1 = (m >> 3) == (s >> 3);
        Ab[j] = b0 ? A_D[j] : 0.f; AbT[j] = b0 ? AT_D[j] : 0.f; A1[j] = (b1 && !b0) ? A_D[j] : 0.f; A2m[j] = b1 ? 0.f : A_D[j]; }
    const f32x4 Ab2 = cs_mm16(AbT, Ab), Ab2T = cs_mm16(Ab, AbT);
    const f32x4 P0 = I_D + Ab, P0T = I_D + AbT;
    const f32x4 T0 = P0 + cs_mm16(P0T, Ab2), T0T = P0T + cs_mm16(Ab2, P0T);
    (void)Ab2T;
    const f32x4 ZT = cs_mm16(A1, T0T);
    const f32x4 T1 = T0 + cs_mm16(ZT, T0), T1T = T0T + cs_mm16(T0, ZT);
    const f32x4 Z2T = cs_mm16(A2m, T1T);
    const f32x4 T_D = T1 + cs_mm16(Z2T, T1);
    const f32x4 M_D = cs_mm16(BkT_D, T_D), MT_D = cs_mm16(T_D, BkT_D);
    const f32x4 N_D = cs_mm16(MT_D, Ar_D) + Kr_D;
    { u32x4 w; w.x = cvt_pk_bf16(M_D[0], M_D[1]); w.y = cvt_pk_bf16(M_D[2], M_D[3]); w.z = 0u; w.w = 0u; *(LAS u32x4*)(slot + CS_MT + s * 64 + g * 16) = w;
      w.x = cvt_pk_bf16(N_D[0], N_D[1]); w.y = cvt_pk_bf16(N_D[2], N_D[3]); *(LAS u32x4*)(slot + CS_NT + s * 64 + g * 16) = w; }
    __builtin_amdgcn_wave_barrier(); asm volatile("" ::: "memory");
    const bf16x8 oT = cs_op16(T_D), oAr = cs_op16(Ar_D);
    float Zp[4][4];
#pragma unroll
    for (int T = 0; T < 4; ++T) { const f32x4 zp = CS_MFMA(cs_lo(cs_tr(zimg, lane, T)), oT, zero4);
#pragma unroll
        for (int j = 0; j < 4; ++j) Zp[T][j] = zp[j]; }
#pragma unroll
    for (int kk = 0; kk < 2; ++kk) *(LAS bf16x8*)(slot + CS_ZP + s * 128 + g * 32 + kk * 16) = cs_pack(Zp[2 * kk], Zp[2 * kk + 1]);
    __builtin_amdgcn_wave_barrier(); asm volatile("" ::: "memory");
    float Rp[4][4];
#pragma unroll
    for (int T = 0; T < 4; ++T) { const f32x4 rp = CS_MFMA(cs_lo(cs_tr(slot + CS_ZP, lane, T)), oAr, zero4);
#pragma unroll
        for (int j = 0; j < 4; ++j) Rp[T][j] = rp[j] + bf2f((bf16_t)oR[T >> 1][(T & 1) * 4 + j]); }
#pragma unroll
    for (int kk = 0; kk < 2; ++kk) *(LAS bf16x8*)(slot + CS_RPP + s * 128 + g * 32 + kk * 16) = cs_pack(Rp[2 * kk], Rp[2 * kk + 1]);
}
__device__ __forceinline__ void cs_scan_chunk(const LAS unsigned char* slot, f32x4 (&acc)[4], float* yp  , int d, int q, int wave, int lane) {
    const int s = lane & 15, g = lane >> 4;
    const f32x4 zero4 = (f32x4){0.f, 0.f, 0.f, 0.f};
    bf16x8 Xb[2];
#pragma unroll
    for (int kk = 0; kk < 2; ++kk) { u32x4 w; w.x = cvt_pk_bf16(acc[2 * kk][0], acc[2 * kk][1]); w.y = cvt_pk_bf16(acc[2 * kk][2], acc[2 * kk][3]);
        w.z = cvt_pk_bf16(acc[2 * kk + 1][0], acc[2 * kk + 1][1]); w.w = cvt_pk_bf16(acc[2 * kk + 1][2], acc[2 * kk + 1][3]); Xb[kk] = __builtin_bit_cast(bf16x8, w); }
    const v4i16_t vt = cs_tr(slot + CS_VV, lane, wave);
    const bf16x8 Vb = cs_lo(vt);
    const int arow = s * 128 + g * 32, a16 = s * 64 + g * 16;
    f32x4 UT = CS_MFMA(*(const LAS bf16x8*)(slot + CS_ZP + arow), Xb[0], zero4); UT = CS_MFMA(*(const LAS bf16x8*)(slot + CS_ZP + arow + 16), Xb[1], UT); UT = CS_MFMA(*(const LAS bf16x8*)(slot + CS_MT + a16), Vb, UT);
    f32x4 YT = CS_MFMA(*(const LAS bf16x8*)(slot + CS_RPP + arow), Xb[0], zero4); YT = CS_MFMA(*(const LAS bf16x8*)(slot + CS_RPP + arow + 16), Xb[1], YT); YT = CS_MFMA(*(const LAS bf16x8*)(slot + CS_NT + a16), Vb, YT);
#pragma unroll
    for (int j = 0; j < 4; ++j) yp[(size_t)cs_tt(d, q, 4 * g + j) * 256] = YT[j];
    bf16x8 UV; { u32x2 w; w.x = cvt_pk_bf16(UT[0], UT[1]); w.y = cvt_pk_bf16(UT[2], UT[3]); const v4i16_t ub = __builtin_bit_cast(v4i16_t, w);
        UV[0] = ub[0]; UV[1] = ub[1]; UV[2] = ub[2]; UV[3] = ub[3]; UV[4] = vt[0]; UV[5] = vt[1]; UV[6] = vt[2]; UV[7] = vt[3]; }
#pragma unroll
    for (int T = 0; T < 4; ++T) { const v4i16_t bh = cs_tr(slot + CS_BH, lane, T), kh = cs_tr(slot + CS_KH, lane, T);
        bf16x8 BK; BK[0] = bh[0]; BK[1] = bh[1]; BK[2] = bh[2]; BK[3] = bh[3]; BK[4] = kh[0]; BK[5] = kh[1]; BK[6] = kh[2]; BK[7] = kh[3];
        acc[T] = CS_MFMA(BK, UV, acc[T]);
        acc[T] *= *(const LAS f32x4*)(slot + CS_WC + (16 * T + 4 * g) * 4); }
}
__device__ __forceinline__ void phase_scan(const Frame& F) {
    const f16_t* SH = (const f16_t*)(F.ws + WS_SH); const f16_t* SD = (const f16_t*)(F.ws + WS_SD);
    float* Y = (float*)(F.ws + WS_Y);
    const int lane = F.lane, wave = F.wave;
    for (int chain = F.bid; chain < 64; chain += F.G) {
        const int d = chain >> 5, b = (chain >> 2) & 7, h = chain & 3;
        const f16_t* sh = SH + (size_t)(b * 4 + h) * TT * 192; const f16_t* sd = SD + (size_t)((d * 8 + b) * 4 + h) * TT * 192;
        float* yp = Y + ((size_t)(d * 8 + b) * TT) * 256 + h * 64 + 16 * (wave & 3) + (lane & 15);
        f32x4 acc[4];
#pragma unroll
        for (int T = 0; T < 4; ++T) acc[T] = (f32x4){0.f, 0.f, 0.f, 0.f};
        __syncthreads();
        CsRaw rawA, rawB;
        const int pw = wave - 4;
        constexpr int NR = CS_NCHUNK / 4;
        if (wave >= 4) { cs_load(rawA, sh, sd, d, pw, lane); cs_load(rawB, sh, sd, d, 4 + pw, lane);
            cs_prepass(F.lds + pw * CS_SLOT, F.lds + CS_ZIMG + pw * 2048, rawA, sh, sd, d, 8 + pw, lane); }
        __syncthreads();
        for (int r = 0; r < NR; r += 2) {
            if (wave >= 4) { cs_prepass(F.lds + (4 + pw) * CS_SLOT, F.lds + CS_ZIMG + pw * 2048, rawB, sh, sd, d, (r + 3 < NR) ? 4 * (r + 3) + pw : -1, lane); }
            else {
#pragma unroll 1
                for (int c4 = 0; c4 < 4; ++c4) cs_scan_chunk(F.lds + c4 * CS_SLOT, acc, yp, d, 4 * r + c4, wave, lane);
            }
            asm volatile("s_waitcnt lgkmcnt(0)" ::: "memory"); __builtin_amdgcn_s_barrier(); asm volatile("" ::: "memory");
            if (wave >= 4) { if (r + 2 < NR) cs_prepass(F.lds + pw * CS_SLOT, F.lds + CS_ZIMG + pw * 2048, rawA, sh, sd, d, (r + 4 < NR) ? 4 * (r + 4) + pw : -1, lane); }
            else {
#pragma unroll 1
                for (int c4 = 0; c4 < 4; ++c4) cs_scan_chunk(F.lds + (4 + c4) * CS_SLOT, acc, yp, d, 4 * (r + 1) + c4, wave, lane);
            }
            asm volatile("s_waitcnt lgkmcnt(0)" ::: "memory"); __builtin_amdgcn_s_barrier(); asm volatile("" ::: "memory");
        }
    }
}

__device__ __forceinline__ void phase_rw_post(const Frame& F, const Params& P, int l, int nrows) {
    const bf16_t* PL = (const bf16_t*)(F.ws + WS_PL); bf16_t* MIX = (bf16_t*)(F.ws + WS_MIX);
    const f16_t* SH = (const f16_t*)(F.ws + WS_SH); const f16_t* SD = (const f16_t*)(F.ws + WS_SD); const float* Y = (const float*)(F.ws + WS_Y);
    const int lane = F.lane;
    rw_stage_tables(F, P, l);
    const LAS float* T = (const LAS float*)F.lds;
    for (int tile = F.gw; tile < nrows / 16; tile += F.nw) {
        int l1 = lane; asm volatile("" : "+v"(l1)); const int tk = l1 & 15, g = l1 >> 4;
        const int r = tile * 16 + tk; const RowGeo geo = row_geo(r);
        const bool hp = geo.pos > 0, hn = geo.pos < geo.len - 1;
        const bf16_t* prow = PL + (size_t)r * INW + O_RW; const int dprev = hp ? -INW : 0, dnext = hn ? INW : 0;
        bf16x8 sg[2][4];
#pragma unroll
        for (int d = 0; d < 2; ++d) { u32x4 raw[4][3];
#pragma unroll
            for (int kk = 0; kk < 4; ++kk) { const bf16_t* p = prow + 896 + 256 * d + 32 * kk + 8 * g;
                raw[kk][0] = *(const u32x4*)p; raw[kk][1] = *(const u32x4*)(p + dprev); raw[kk][2] = *(const u32x4*)(p + dnext); }
#pragma unroll
            for (int kk = 0; kk < 4; ++kk) { float u[8]; rw_mix8(T, raw[kk], hp, hn, 896 + 256 * d + 32 * kk + 8 * g, u);
#pragma unroll
                for (int q = 0; q < 8; ++q) u[q] = sigmoidf_(u[q]);
                sg[d][kk] = pack8f(u); }
            asm volatile("" ::: "memory"); }
#pragma unroll 1
        for (int h = 0; h < 4; ++h) {
            int l2 = lane; asm volatile("" : "+v"(l2)); const int tk = l2 & 15, g = l2 >> 4;
            const int r = tile * 16 + tk; const RowGeo geo = row_geo(r);
            const size_t shrow = ((size_t)(geo.b * 4 + h) * TT + geo.tt) * 192;
            float out[4][4];
#pragma unroll
            for (int t = 0; t < 4; ++t)
#pragma unroll
                for (int q = 0; q < 4; ++q) out[t][q] = 0.f;
            f16x8 rh[2], vh[2];
#pragma unroll
            for (int u = 0; u < 2; ++u) { rh[u] = *(const f16x8*)(SH + shrow + 32 * u + 8 * g); vh[u] = *(const f16x8*)(SH + shrow + 64 + 32 * u + 8 * g); }
#pragma unroll 1
            for (int d = 0; d < 2; ++d) {
                const bf16_t* g2t = (const bf16_t*)(F.ws + WS_LORA + (size_t)(l * 2 + d) * LORA_LD_BYTES) + 2 * 256 * 64;
                const size_t sdrow = ((size_t)((d * 8 + geo.b) * 4 + h) * TT + geo.tt) * 192;
                const float* yrow = Y + ((size_t)(d * 8 + geo.b) * TT + geo.tt) * 256 + 64 * h + 8 * g;
                bf16x8 sgd[4];
#pragma unroll
                for (int kk = 0; kk < 4; ++kk) sgd[kk] = d ? sg[1][kk] : sg[0][kk];
                f32x4 y[4], gg[4]; f16x8 kdh[2]; bf16x8 gf[4][4];
#pragma unroll
                for (int u = 0; u < 2; ++u) { y[2 * u] = *(const f32x4*)(yrow + 32 * u); y[2 * u + 1] = *(const f32x4*)(yrow + 32 * u + 4); kdh[u] = *(const f16x8*)(SD + sdrow + 64 + 32 * u + 8 * g); }
#pragma unroll
                for (int t = 0; t < 4; ++t) { const bf16_t* gr = g2t + (size_t)(64 * h + 32 * (t >> 1) + 8 * (tk >> 2) + 4 * (t & 1) + (tk & 3)) * 128 + 8 * g;
#pragma unroll
                    for (int kk = 0; kk < 4; ++kk) gf[t][kk] = *(const bf16x8*)(gr + 32 * kk); }
                float sm = 0.f, bs = 0.f;
#pragma unroll
                for (int t = 0; t < 4; ++t) { const int c = 64 * h + 32 * (t >> 1) + 8 * g + 4 * (t & 1);
                    sm += (y[t][0] + y[t][1]) + (y[t][2] + y[t][3]);
                    const f32x4 rk = *(const LAS f32x4*)(T + RL_RK / 4 + c);
#pragma unroll
                    for (int q = 0; q < 4; ++q) bs += (float)rh[t >> 1][(t & 1) * 4 + q] * (float)kdh[t >> 1][(t & 1) * 4 + q] * rk[q];
                    f32x4 a = (f32x4){0.f, 0.f, 0.f, 0.f};
#pragma unroll
                    for (int kk = 0; kk < 4; ++kk) a = __builtin_amdgcn_mfma_f32_16x16x32_bf16(gf[t][kk], sgd[kk], a, 0, 0, 0);
                    gg[t] = a; }
                sm += __shfl_xor(sm, 16); sm += __shfl_xor(sm, 32); bs += __shfl_xor(bs, 16); bs += __shfl_xor(bs, 32);
                const float mu = sm * (1.0f / 64.0f); float vs = 0.f;
#pragma unroll
                for (int t = 0; t < 4; ++t)
#pragma unroll
                    for (int q = 0; q < 4; ++q) { const float dd = y[t][q] - mu; vs += dd * dd; }
                vs += __shfl_xor(vs, 16); vs += __shfl_xor(vs, 32);
                const float rstd = rsqrtf(vs * (1.0f / 64.0f) + 64e-5f);
#pragma unroll
                for (int t = 0; t < 4; ++t) { const int c = 64 * h + 32 * (t >> 1) + 8 * g + 4 * (t & 1);
                    const f32x4 gng = *(const LAS f32x4*)(T + RL_GNG / 4 + c), gnb = *(const LAS f32x4*)(T + RL_GNB / 4 + c);
#pragma unroll
                    for (int q = 0; q < 4; ++q) out[t][q] += ((y[t][q] - mu) * rstd * gng[q] + gnb[q] + bs * (float)vh[t >> 1][(t & 1) * 4 + q]) * gg[t][q]; }
                asm volatile("" ::: "memory");
            }
#pragma unroll
            for (int u = 0; u < 2; ++u) { u32x4 w; w.x = cvt_pk_bf16(out[2 * u][0], out[2 * u][1]); w.y = cvt_pk_bf16(out[2 * u][2], out[2 * u][3]); w.z = cvt_pk_bf16(out[2 * u + 1][0], out[2 * u + 1][1]); w.w = cvt_pk_bf16(out[2 * u + 1][2], out[2 * u + 1][3]);
                *(u32x4*)(MIX + (size_t)r * D + 512 + 64 * h + 32 * u + 8 * g) = w; }
        }
    }
    __syncthreads();
}

constexpr int CV_SEG = 64, CV_ROWS = CV_SEG + 30, CV_H = 0, CV_W = CV_ROWS * 256 * 4;
__device__ __forceinline__ void phase_conv(const Frame& F, const Params& P, int l, int nrows) {
    const bf16_t* PL = (const bf16_t*)(F.ws + WS_PL); bf16_t* MIX = (bf16_t*)(F.ws + WS_MIX);
    const int lane = F.lane, c4 = lane * 4, wave = F.wave;
    LAS float* H = (LAS float*)(F.lds + CV_H); LAS float* W = (LAS float*)(F.lds + CV_W);
    for (int i = F.tid; i < 31 * 256; i += NTHREADS) W[i] = P.in[I_DWW][(size_t)l * 31 * 256 + i];
    const f32x4 dwb = *(const f32x4*)(P.in[I_DWB] + l * 256 + c4), lng = *(const f32x4*)(P.in[I_LNG] + l * 256 + c4), lnb = *(const f32x4*)(P.in[I_LNB] + l * 256 + c4);
    for (int seg = F.bid; seg < nrows / CV_SEG; seg += F.G) {
        const int r0 = seg * CV_SEG; const RowGeo g0 = row_geo(r0);
        __syncthreads();
#pragma unroll 4
        for (int k = 0; k < 12; ++k) { const int rr = wave + 8 * k;
            if (rr < CV_ROWS) { const int pos = g0.pos - 15 + rr; f32x4 hv = (f32x4){0.f, 0.f, 0.f, 0.f};
                if (pos >= 0 && pos < g0.len) { const bf16_t* p = PL + (size_t)(r0 - 15 + rr) * INW + O_CV + c4; float a[4], bb[4];
                    unpack4(*(const u32x2*)p, a); unpack4(*(const u32x2*)(p + 256), bb);
#pragma unroll
                    for (int q = 0; q < 4; ++q) hv[q] = a[q] * sigmoidf_(bb[q]); }
                *(LAS f32x4*)(H + rr * 256 + c4) = hv; } }
        __syncthreads();
        f32x4 acc[8];
#pragma unroll
        for (int t = 0; t < 8; ++t) acc[t] = dwb;
#pragma unroll 1
        for (int j = 0; j < 31; ++j) { const f32x4 w = *(const LAS f32x4*)(W + j * 256 + c4);
#pragma unroll
            for (int t = 0; t < 8; ++t) acc[t] += *(const LAS f32x4*)(H + (wave * 8 + t + j) * 256 + c4) * w; }
#pragma unroll
        for (int t = 0; t < 8; ++t) {
            const float mu = wave_sum((acc[t][0] + acc[t][1]) + (acc[t][2] + acc[t][3])) * (1.0f / 256.0f);
            float vs = 0.f;
#pragma unroll
            for (int q = 0; q < 4; ++q) { const float dd = acc[t][q] - mu; vs += dd * dd; }
            const float rstd = rsqrtf(wave_sum(vs) * (1.0f / 256.0f) + 1e-5f);
            float o[4];
#pragma unroll
            for (int q = 0; q < 4; ++q) o[q] = siluf_((acc[t][q] - mu) * rstd * lng[q] + lnb[q]);
            u32x2 w; w.x = pk_bf16(o[0], o[1]); w.y = pk_bf16(o[2], o[3]);
            *(u32x2*)(MIX + (size_t)(r0 + wave * 8 + t) * D + 768 + c4) = w; }
    }
}

__device__ __forceinline__ void phase_na_simple(const Frame& F, const Params& P, int l, int nq) {
    const bf16_t* PL = (const bf16_t*)(F.ws + WS_PL); bf16_t* MIX = (bf16_t*)(F.ws + WS_MIX);
    const float* rpb = P.in[I_RPB] + (size_t)l * 8 * 15 * 31;
    int tid_ = F.tid; asm volatile("" : "+v"(tid_));
    for (int gid = F.bid * NTHREADS + tid_; gid < nq * 8; gid += F.G * NTHREADS) {
        const int r = gid >> 3, h = gid & 7;
        const RowGeo g = row_geo(r);
        float q[64], o[64];
        { const bf16_t* qp = PL + (size_t)r * INW + O_Q + h * 64;
#pragma unroll
          for (int i = 0; i < 8; ++i) unpack8(*(const u32x4*)(qp + i * 8), q + i * 8); }
#pragma unroll
        for (int i = 0; i < 64; ++i) o[i] = 0.f;
        float m = -3.0e38f, lsum = 0.f;
        const bool lat = r < NLAT;
        const int gi = g.pos >> 6, gc = g.pos & 63;
        const int rs = min(max(gi - 4, 0), 56), wsc = min(max(gc - 8, 0), 48);
        const int nkey = lat ? 384 : 256;
#pragma unroll 1
        for (int kx = 0; kx < nkey; ++kx) {
            const bool win = lat && kx < 128;
            int krow; float bias = 0.f;
            if (win) { const int r8 = kx >> 4, cc = kx & 15; krow = g.b * SEQ + (rs + r8) * 64 + wsc + cc; bias = rpb[(h * 15 + (rs + r8 - gi + 7)) * 31 + (wsc + cc - gc + 15)]; }
            else krow = NLAT + g.b * CTXL + (kx - (lat ? 128 : 0));
            const bf16_t* kp = PL + (size_t)krow * INW + O_K + h * 64; float a = bias;
#pragma unroll
            for (int i = 0; i < 8; ++i) { float kf[8]; unpack8(*(const u32x4*)(kp + i * 8), kf);
#pragma unroll
                for (int j = 0; j < 8; ++j) a += q[i * 8 + j] * kf[j]; }
            if (a > m) { const float alpha = __expf(m - a); lsum *= alpha;
#pragma unroll
                for (int i = 0; i < 64; ++i) o[i] *= alpha;
                m = a; }
            const float p = __expf(a - m); lsum += p;
            const bf16_t* vp = kp + (O_V - O_K);
#pragma unroll
            for (int i = 0; i < 8; ++i) { float vf[8]; unpack8(*(const u32x4*)(vp + i * 8), vf);
#pragma unroll
                for (int j = 0; j < 8; ++j) o[i * 8 + j] += p * vf[j]; }
        }
        const float inv = 1.0f / lsum;
        bf16_t* op = MIX + (size_t)r * D + h * 64;
#pragma unroll
        for (int i = 0; i < 8; ++i) { u32x4 w; w.x = pk_bf16(o[i * 8] * inv, o[i * 8 + 1] * inv); w.y = pk_bf16(o[i * 8 + 2] * inv, o[i * 8 + 3] * inv);
            w.z = pk_bf16(o[i * 8 + 4] * inv, o[i * 8 + 5] * inv); w.w = pk_bf16(o[i * 8 + 6] * inv, o[i * 8 + 7] * inv); *(u32x4*)(op + i * 8) = w; }
    }
}

constexpr int NA_CK = 0, NA_CV = 32768, NA_RPB = 65536, NA_WV = 81920;
__device__ __forceinline__ bf16x8 na_pack8(const f32x4& a, const f32x4& b) {
    u32x4 w; w.x = cvt_pk_bf16(a[0], a[1]); w.y = cvt_pk_bf16(a[2], a[3]); w.z = cvt_pk_bf16(b[0], b[1]); w.w = cvt_pk_bf16(b[2], b[3]); return __builtin_bit_cast(bf16x8, w);
}
__device__ __forceinline__ bf16x8 na_vfrag(LAS unsigned char* blk, int lane, int dt) {
    const int g = lane >> 4, qq = (lane & 15) >> 2, p = lane & 3;
    const int r0 = 4 * g + qq, r1 = 16 + 4 * g + qq;
    const v4i16_t lo = __builtin_amdgcn_ds_read_tr16_b64_v4i16((LAS v4i16_t*)(blk + r0 * 128 + ((dt ^ ((r0 >> 1) & 3)) * 32) + p * 8));
    const v4i16_t hi = __builtin_amdgcn_ds_read_tr16_b64_v4i16((LAS v4i16_t*)(blk + r1 * 128 + ((dt ^ ((r1 >> 1) & 3)) * 32) + p * 8));
    bf16x8 r; r[0] = lo[0]; r[1] = lo[1]; r[2] = lo[2]; r[3] = lo[3]; r[4] = hi[0]; r[5] = hi[1]; r[6] = hi[2]; r[7] = hi[3]; return r;
}
template <bool WINDOW>
__device__ __forceinline__ void na_item(const Frame& F, const bf16_t* PL, bf16_t* MIX, int b, int h, int qrow0  , int gi, int cb) {
    const int lane = F.lane, ql = lane & 15, g = lane >> 4;
    LAS unsigned char* CK = F.lds + NA_CK; LAS unsigned char* CV = F.lds + NA_CV; const LAS float* RPB = (const LAS float*)(F.lds + NA_RPB);
    LAS unsigned char* WV = F.lds + NA_WV + F.wave * 4096;
    bf16x8 Qf[2];
    { const bf16_t* qp = PL + (size_t)(qrow0 + ql) * INW + O_Q + h * 64 + 8 * g; Qf[0] = *(const bf16x8*)qp; Qf[1] = *(const bf16x8*)(qp + 32); }
    f32x4 acc[4];
#pragma unroll
    for (int dt = 0; dt < 4; ++dt) acc[dt] = (f32x4){0.f, 0.f, 0.f, 0.f};
    float m_run = -3.0e38f, l_run = 0.f;
    if constexpr (WINDOW) {
        const int rs = min(max(gi - 4, 0), 56), kc0 = min(max(16 * cb - 8, 0), 32), qcol = 16 * cb + ql, wsq = min(max(qcol - 8, 0), 48);
        const size_t krow0 = (size_t)b * SEQ + (size_t)rs * 64 + kc0;
        f32x4 s[16];
#pragma unroll
        for (int t = 0; t < 16; ++t) { const bf16_t* kp = PL + (krow0 + (size_t)(t >> 1) * 64 + (t & 1) * 16 + ql) * INW + O_K + h * 64 + 8 * g;
            const bf16x8 k0 = *(const bf16x8*)kp, k1 = *(const bf16x8*)(kp + 32);
            s[t] = __builtin_amdgcn_mfma_f32_16x16x32_bf16(k0, Qf[0], (f32x4){0.f, 0.f, 0.f, 0.f}, 0, 0, 0);
            s[t] = __builtin_amdgcn_mfma_f32_16x16x32_bf16(k1, Qf[1], s[t], 0, 0, 0); }
        float mx = -3.0e38f;
#pragma unroll
        for (int t = 0; t < 16; ++t) { const LAS float* bp = RPB + (h * 15 + (rs + (t >> 1) - gi + 7)) * 31 + 15 - qcol;
#pragma unroll
            for (int j = 0; j < 4; ++j) { const int kcol = kc0 + (t & 1) * 16 + 4 * g + j; const bool ok = kcol >= wsq && kcol < wsq + 16;
                const float v = ok ? s[t][j] + bp[ok ? kcol : qcol] : -INFINITY; s[t][j] = v; mx = fmaxf(mx, v); } }
        mx = fmaxf(mx, __shfl_xor(mx, 16)); mx = fmaxf(mx, __shfl_xor(mx, 32));
        m_run = mx;
        float ls = 0.f;
#pragma unroll
        for (int t = 0; t < 16; ++t)
#pragma unroll
            for (int j = 0; j < 4; ++j) { const float p = __expf(s[t][j] - mx); s[t][j] = p; ls += p; }
        l_run = ls;
#pragma unroll
        for (int r8 = 0; r8 < 8; ++r8) {
            { const int vr = lane >> 1, part = lane & 1;
              const bf16_t* vp = PL + (krow0 + (size_t)r8 * 64 + vr) * INW + O_V + h * 64 + part * 32;
              u32x4 v0 = *(const u32x4*)vp, v1 = *(const u32x4*)(vp + 8), v2 = *(const u32x4*)(vp + 16), v3 = *(const u32x4*)(vp + 24);
              LAS unsigned char* wr = WV + vr * 128; const int sw = (vr >> 1) & 3;
              *(LAS u32x4*)(wr + (((2 * part) ^ sw) * 32)) = v0; *(LAS u32x4*)(wr + (((2 * part) ^ sw) * 32) + 16) = v1;
              *(LAS u32x4*)(wr + (((2 * part + 1) ^ sw) * 32)) = v2; *(LAS u32x4*)(wr + (((2 * part + 1) ^ sw) * 32) + 16) = v3; }
            __builtin_amdgcn_wave_barrier(); asm volatile("" ::: "memory");
            const bf16x8 pf = na_pack8(s[2 * r8], s[2 * r8 + 1]);
#pragma unroll
            for (int dt = 0; dt < 4; ++dt) { const bf16x8 vf = na_vfrag(WV, lane, dt); acc[dt] = __builtin_amdgcn_mfma_f32_16x16x32_bf16(vf, pf, acc[dt], 0, 0, 0); }
            __builtin_amdgcn_wave_barrier(); asm volatile("" ::: "memory");
        }
    }
    {
        f32x4 s[16];
#pragma unroll
        for (int t = 0; t < 16; ++t) { const int key = 16 * t + ql; const LAS unsigned char* kr = CK + key * 128;
            const bf16x8 k0 = *(const LAS bf16x8*)(kr + ((g ^ (key & 7)) * 16)), k1 = *(const LAS bf16x8*)(kr + (((g + 4) ^ (key & 7)) * 16));
            s[t] = __builtin_amdgcn_mfma_f32_16x16x32_bf16(k0, Qf[0], (f32x4){0.f, 0.f, 0.f, 0.f}, 0, 0, 0);
            s[t] = __builtin_amdgcn_mfma_f32_16x16x32_bf16(k1, Qf[1], s[t], 0, 0, 0); }
        float mx = m_run;
#pragma unroll
        for (int t = 0; t < 16; ++t)
#pragma unroll
            for (int j = 0; j < 4; ++j) mx = fmaxf(mx, s[t][j]);
        mx = fmaxf(mx, __shfl_xor(mx, 16)); mx = fmaxf(mx, __shfl_xor(mx, 32));
        const float alpha = __expf(m_run - mx);
        float ls = l_run * alpha;
#pragma unroll
        for (int dt = 0; dt < 4; ++dt) acc[dt] *= alpha;
#pragma unroll
        for (int t = 0; t < 16; ++t)
#pragma unroll
            for (int j = 0; j < 4; ++j) { const float p = __expf(s[t][j] - mx); s[t][j] = p; ls += p; }
        l_run = ls;
#pragma unroll
        for (int blk = 0; blk < 8; ++blk) { const bf16x8 pf = na_pack8(s[2 * blk], s[2 * blk + 1]);
#pragma unroll
            for (int dt = 0; dt < 4; ++dt) { const bf16x8 vf = na_vfrag(CV + blk * 4096, lane, dt); acc[dt] = __builtin_amdgcn_mfma_f32_16x16x32_bf16(vf, pf, acc[dt], 0, 0, 0); } }
    }
    float lt = l_run; lt += __shfl_xor(lt, 16); lt += __shfl_xor(lt, 32);
    const float inv = 1.0f / lt;
    bf16_t* op = MIX + (size_t)(qrow0 + ql) * D + h * 64 + 4 * g;
#pragma unroll
    for (int dt = 0; dt < 4; ++dt) { u32x2 w; w.x = cvt_pk_bf16(acc[dt][0] * inv, acc[dt][1] * inv); w.y = cvt_pk_bf16(acc[dt][2] * inv, acc[dt][3] * inv); *(u32x2*)(op + dt * 16) = w; }
}
__device__ __forceinline__ void phase_na_mfma(const Frame& F, const Params& P, int l, bool ctx_queries) {
    const bf16_t* PL = (const bf16_t*)(F.ws + WS_PL); bf16_t* MIX = (bf16_t*)(F.ws + WS_MIX);
    int tid_ = F.tid; asm volatile("" : "+v"(tid_));
    const int tid = tid_;
    { const float* rpb = P.in[I_RPB] + (size_t)l * 8 * 15 * 31; LAS float* R = (LAS float*)(F.lds + NA_RPB); for (int i = tid; i < 8 * 15 * 31; i += NTHREADS) R[i] = rpb[i]; }
    for (int unit = F.bid; unit < 256; unit += F.G) {
        const int quarter = unit & 3, h = (unit >> 2) & 7, b = unit >> 5;
        __syncthreads();
        { int t2 = tid; asm volatile("" : "+v"(t2)); const int key = t2 >> 1, part = t2 & 1; const bf16_t* kp = PL + (size_t)(NLAT + b * CTXL + key) * INW + O_K + h * 64 + part * 32; const bf16_t* vp = kp + (O_V - O_K);
          LAS unsigned char* kr = F.lds + NA_CK + key * 128; LAS unsigned char* vr = F.lds + NA_CV + key * 128; const int sw = (key >> 1) & 3;
#pragma unroll
          for (int c = 0; c < 4; ++c) { *(LAS u32x4*)(kr + (((4 * part + c) ^ (key & 7)) * 16)) = *(const u32x4*)(kp + 8 * c);
              const int c16 = 4 * part + c; *(LAS u32x4*)(vr + (((c16 >> 1) ^ sw) * 32) + (c16 & 1) * 16) = *(const u32x4*)(vp + 8 * c); } }
        __syncthreads();
        for (int it = F.wave; it < 64; it += NWAVES) { const int gi = quarter * 16 + (it >> 2), cb = it & 3;
            na_item<true>(F, PL, MIX, b, h, b * SEQ + gi * 64 + cb * 16, gi, cb); }
        if (ctx_queries && F.wave < 4) na_item<false>(F, PL, MIX, b, h, NLAT + b * CTXL + (quarter * 4 + F.wave) * 16, 0, 0);
    }
}

__device__ __forceinline__ void phase_final(const Frame& F, const Params& P) {
    float* out = P.out; const float* g = P.in[I_FINALG]; const int lane = F.lane;
    for (int r = F.gw; r < NLAT; r += F.nw) {
        float* xr = out + (size_t)r * D; f32x4 x[4]; float ss = 0.f;
#pragma unroll
        for (int j = 0; j < 4; ++j) { x[j] = *(const f32x4*)(xr + j * 256 + lane * 4); ss += x[j][0] * x[j][0] + x[j][1] * x[j][1] + x[j][2] * x[j][2] + x[j][3] * x[j][3]; }
        ss = wave_sum(ss); const float rstd = rsqrtf(ss * (1.0f / D) + 1e-6f);
#pragma unroll
        for (int j = 0; j < 4; ++j) { const f32x4 gg = *(const f32x4*)(g + j * 256 + lane * 4); *(f32x4*)(xr + j * 256 + lane * 4) = x[j] * rstd * gg; }
    }
}

constexpr int PH_L0 = 1, PH_PER_L0 = 9, PH_L1 = PH_L0 + PH_PER_L0, PH_PER_L1 = 12, PH_FINAL = PH_L1 + PH_PER_L1, N_PHASES = PH_FINAL + 1;
#define RFL(x) __builtin_amdgcn_readfirstlane(x)

PHASE ph_prologue(const void* kp_, int wv_) { PHASE_ENTER; if constexpr (MKB(0)) phase_prologue(F, P); }
PHASE ph_norm1(const void* kp_, int wv_, int l_) { PHASE_ENTER; const int l = RFL(l_);
    if constexpr (MKB(1)) phase_norm<false>(F, P, l, 0, NROW, l == 0 ? P.in[I_X] : P.out, l == 0 ? P.in[I_CTX] : (const float*)(F.ws + WS_XC)); }
PHASE_INL ph_gemm_win(const void* kp_, int wv_, int l_) { PHASE_ENTER; const int l = RFL(l_);
    pg8::DenseSched S; S.init(NROW / 256, INW / 256, F.G, F.bid); S.A = (const bf16_t*)(F.ws + WS_HL); S.Bt = (const bf16_t*)(F.ws + WS_BTIN) + (size_t)l * INW * D; S.K = D;
    pg8::EpiBf16 E{(bf16_t*)(F.ws + WS_PL), INW, 2, 0.125f};
    if constexpr (MKB(2)) pg8::gemm_phase<pg8::EpiBf16, pg8::DenseSched, false>(F.lds, D, S, E, F.wave); }
PHASE_INL ph_rw_prep(const void* kp_, int wv_, int l_) { PHASE_ENTER; const int l = RFL(l_); if constexpr (MKB(3)) phase_rw_prep(F, P, l); }
PHASE ph_conv(const void* kp_, int wv_, int l_, int bid_, int G_) { PHASE_ENTER; const int l = RFL(l_); if constexpr (MKB(4)) phase_conv(sub_frame(F, RFL(bid_), RFL(G_)), P, l, l == 0 ? NROW : NLAT); }
PHASE_INL ph_na(const void* kp_, int wv_, int l_, int bid_, int G_) { PHASE_ENTER; const int l = RFL(l_); if constexpr (MKB(5)) phase_na_mfma(sub_frame(F, RFL(bid_), RFL(G_)), P, l, l == 0); }
PHASE_INL ph_scan(const void* kp_, int wv_, int bid_, int G_) { PHASE_ENTER; if constexpr (MKB(6)) phase_scan(sub_frame(F, RFL(bid_), RFL(G_))); }
PHASE_INL ph_rw_post(const void* kp_, int wv_, int l_) { PHASE_ENTER; const int l = RFL(l_); if constexpr (MKB(7)) phase_rw_post(F, P, l, l == 0 ? NROW : NLAT); }
PHASE_INL ph_gemm_wout(const void* kp_, int wv_, int l_) { PHASE_ENTER; const int l = RFL(l_);
    float* XC = (float*)(F.ws + WS_XC);
    pg8::DenseSched S; S.init((l == 0 ? NROW : NLAT) / 256, D / 256, F.G, F.bid); S.A = (const bf16_t*)(F.ws + WS_MIX); S.Bt = (const bf16_t*)(F.ws + WS_BTOUT) + (size_t)l * D * D; S.K = D;
    pg8::EpiRes E{l == 0 ? P.in[I_X] : P.out, l == 0 ? P.in[I_CTX] : XC, P.out, XC, (const float*)(F.ws + WS_MODV) + (size_t)l * 9 * MODW + 2 * D};
    if constexpr (MKB(8)) pg8::gemm_phase<pg8::EpiRes, pg8::DenseSched, false>(F.lds, D, S, E, F.wave); }
PHASE ph_norm2_l0(const void* kp_, int wv_) { PHASE_ENTER; if constexpr (MKB(9)) phase_norm<false>(F, P, 0, 1, NROW, P.out, (const float*)(F.ws + WS_XC)); }
PHASE_INL ph_gemm_ffn_gu(const void* kp_, int wv_) { PHASE_ENTER;
    pg8::DenseSched S; S.init(NROW / 256, (2 * DFF) / 256, F.G, F.bid); S.A = (const bf16_t*)(F.ws + WS_HL); S.Bt = (const bf16_t*)(F.ws + WS_BTGU); S.K = D;
    pg8::EpiSwiGLU E{(bf16_t*)(F.ws + WS_H), DFF};
    if constexpr (MKB(10)) pg8::gemm_phase<pg8::EpiSwiGLU, pg8::DenseSched, false>(F.lds, D, S, E, F.wave); }
PHASE_INL ph_gemm_ffn_dn(const void* kp_, int wv_) { PHASE_ENTER;
    float* XC = (float*)(F.ws + WS_XC);
    pg8::DenseSched S; S.init(NROW / 256, D / 256, F.G, F.bid); S.A = (const bf16_t*)(F.ws + WS_H); S.Bt = (const bf16_t*)(F.ws + WS_BTDN); S.K = DFF;
    pg8::EpiRes E{P.out, XC, P.out, XC, (const float*)(F.ws + WS_MODV) + 5 * D};
    if constexpr (MKB(11)) pg8::gemm_phase<pg8::EpiRes, pg8::DenseSched, false>(F.lds, DFF, S, E, F.wave); }
PHASE ph_norm2_l1(const void* kp_, int wv_) { PHASE_ENTER; if constexpr (MKB(12)) phase_norm<true>(F, P, 1, 1, NLAT, P.out, (const float*)(F.ws + WS_XC)); }
PHASE ph_moe_prep(const void* kp_, int wv_) { PHASE_ENTER; if constexpr (MKB(13)) { phase_moe_rowmap(F); phase_moe_convert(F, P); } }
PHASE_INL ph_gemm_moe_gu(const void* kp_, int wv_, int pass_) { PHASE_ENTER; const int pass = RFL(pass_);
    pg8::MoeSched S; moe_tstart(F, pass, S.tstart); S.init(S.tstart[8], (2 * DFE) / 256, F.G, F.bid);
    S.A = (const bf16_t*)(F.ws + WS_HL); S.Bt0 = F.ws + WS_MOE; S.e_stride = MOE_E_BYTES; S.K = D; S.rowmap = (const int*)(F.ws + WS_ROUTE + RT_RMAP) + pass * NROW;
    pg8::EpiSwiGLU E{(bf16_t*)(F.ws + WS_H), DFE};
    if constexpr (MKB(14)) pg8::gemm_phase<pg8::EpiSwiGLU, pg8::MoeSched, true>(F.lds, D, S, E, F.wave); }
PHASE_INL ph_gemm_moe_dn(const void* kp_, int wv_, int pass_) { PHASE_ENTER; const int pass = RFL(pass_);
    pg8::MoeSched S; moe_tstart(F, pass, S.tstart); S.init(S.tstart[8], D / 256, F.G, F.bid);
    S.A = (const bf16_t*)(F.ws + WS_H); S.Bt0 = F.ws + WS_MOE + MOE_GU_BYTES; S.e_stride = MOE_E_BYTES; S.K = DFE; S.rowmap = nullptr;
    pg8::EpiMoeDown E{P.out, (const float*)(F.ws + WS_MODV) + (size_t)9 * MODW + 5 * D, (const int*)(F.ws + WS_ROUTE + RT_RMAP) + pass * NROW, (const float*)(F.ws + WS_ROUTE + RT_SGATE) + pass * NROW};
    if constexpr (MKB(15)) pg8::gemm_phase<pg8::EpiMoeDown, pg8::MoeSched, false>(F.lds, DFE, S, E, F.wave); }
PHASE ph_final(const void* kp_, int wv_) { PHASE_ENTER; if constexpr (MKB(16)) phase_final(F, P); }

static __attribute__((noinline)) __device__ void grid_barrier(const void* bar_, unsigned x_, int wv_) {
    const unsigned long long v = (unsigned long long)bar_;
    const unsigned lo = __builtin_amdgcn_readfirstlane((unsigned)v), hi = __builtin_amdgcn_readfirstlane((unsigned)(v >> 32));
    XcdBarrier b; b.bar = (unsigned*)(((unsigned long long)hi << 32) | lo); b.x = __builtin_amdgcn_readfirstlane(x_);
    b.st = (volatile LAS unsigned*)((LAS unsigned char*)lds_raw + LDS_MISC);
    xcd_barrier(b, __builtin_amdgcn_readfirstlane(wv_) * 64 + lane_id());
}
__device__ __forceinline__ bool ph_in(int lo, int hi, int k) { asm volatile("" : "+s"(lo), "+s"(hi)); return lo <= k && k < hi; }

__global__ void __launch_bounds__(NTHREADS, 2) mk_fwd(Params P) {
    const void* kp = (const void*)__builtin_amdgcn_kernarg_segment_ptr();
    LAS unsigned char* lds = (LAS unsigned char*)lds_raw;
    volatile LAS unsigned* misc = (volatile LAS unsigned*)(lds + LDS_MISC);
    const int wv = __builtin_amdgcn_readfirstlane((int)(threadIdx.x >> 6));
    if (wv == 0 && lane_id() < 4) misc[lane_id()] = 0u;
    __syncthreads();
    const int lo = P.ph_lo, hi = P.ph_hi;
    XcdBarrier bar; bar.bar = (unsigned*)(P.ws + WS_CTL) + CW_BAR; bar.x = 0; bar.st = misc;
    if (hi - lo > 1) bar = xcd_barrier_post((unsigned*)(P.ws + WS_CTL) + CW_BAR, misc, wv * 64 + lane_id());
#define IN(k) ph_in(lo, hi, (k))
#define SEAM(k) do { if (IN((k) + 1)) grid_barrier((const void*)bar.bar, bar.x, wv); } while (0)
    if (IN(0)) { for (int rep = 0; rep < REP_PRO; ++rep) ph_prologue(kp, wv); SEAM(0); }
#define LAYER_COMMON(l, pb) \
    if (IN((pb) + 0)) { for (int rep = 0; rep < REP_NORM; ++rep) ph_norm1(kp, wv, (l)); SEAM((pb) + 0); } \
    if (IN((pb) + 1)) { for (int rep = 0; rep < REP_GEMM; ++rep) ph_gemm_win(kp, wv, (l)); SEAM((pb) + 1); } \
    if (IN((pb) + 2)) { for (int rep = 0; rep < REP_PP; ++rep) ph_rw_prep(kp, wv, (l)); SEAM((pb) + 2); } \
    if (IN((pb) + 3)) { const int bx = (int)blockIdx.x, Gx = (int)gridDim.x; \
        if (Gx == 256) { if (bx < 64) { for (int rep = 0; rep < REP_SCAN; ++rep) ph_scan(kp, wv, bx, 64); } \
            else { for (int rep = 0; rep < REP_CONV; ++rep) ph_conv(kp, wv, (l), bx - 64, 192); for (int rep = 0; rep < REP_NA; ++rep) ph_na(kp, wv, (l), bx - 64, 192); } } \
        else { ph_conv(kp, wv, (l), bx, Gx); ph_na(kp, wv, (l), bx, Gx); ph_scan(kp, wv, bx, Gx); } SEAM((pb) + 3); } \
    if (IN((pb) + 4)) { for (int rep = 0; rep < REP_POST; ++rep) ph_rw_post(kp, wv, (l)); SEAM((pb) + 4); } \
    if (IN((pb) + 5)) { ph_gemm_wout(kp, wv, (l)); SEAM((pb) + 5); }
    LAYER_COMMON(0, PH_L0)
    if (IN(PH_L0 + 6)) { ph_norm2_l0(kp, wv); SEAM(PH_L0 + 6); }
    if (IN(PH_L0 + 7)) { for (int rep = 0; rep < REP_GEMM; ++rep) ph_gemm_ffn_gu(kp, wv); SEAM(PH_L0 + 7); }
    if (IN(PH_L0 + 8)) { ph_gemm_ffn_dn(kp, wv); SEAM(PH_L0 + 8); }
    LAYER_COMMON(1, PH_L1)
    if (IN(PH_L1 + 6)) { ph_norm2_l1(kp, wv); SEAM(PH_L1 + 6); }
    if (IN(PH_L1 + 7)) { for (int rep = 0; rep < REP_PRO; ++rep) ph_moe_prep(kp, wv); SEAM(PH_L1 + 7); }
#pragma unroll 1
    for (int pass = 0; pass < 2; ++pass) {
        if (IN(PH_L1 + 8 + 2 * pass)) { for (int rep = 0; rep < REP_GEMM; ++rep) ph_gemm_moe_gu(kp, wv, pass); SEAM(PH_L1 + 8 + 2 * pass); }
        if (IN(PH_L1 + 9 + 2 * pass)) { ph_gemm_moe_dn(kp, wv, pass); SEAM(PH_L1 + 9 + 2 * pass); }
    }
#undef LAYER_COMMON
    if (IN(PH_FINAL)) ph_final(kp, wv);
#undef IN
#undef SEAM
}

extern "C" void kernel_launch(void* const* d_in, const int* in_sizes, int n_in, void* d_out, int out_size, void* d_ws, size_t ws_size, hipStream_t stream) {
    static int grid = 0;
    if (grid == 0) {
        if (n_in != 35 || out_size != NLAT * D || ws_size < WS_END) { fprintf(stderr, "kernel_launch: unexpected shapes (n_in %d out %d ws %zu need %zu)\n", n_in, out_size, ws_size, (size_t)WS_END); grid = -1; return; }
        int dev = 0, cus = 0, per_cu = 0;
        if (hipGetDevice(&dev) != hipSuccess || hipDeviceGetAttribute(&cus, hipDeviceAttributeMultiprocessorCount, dev) != hipSuccess) { grid = -1; return; }
        if (hipFuncSetAttribute((const void*)mk_fwd, hipFuncAttributeMaxDynamicSharedMemorySize, LDS_BYTES) != hipSuccess) { fprintf(stderr, "kernel_launch: hipFuncSetAttribute failed\n"); grid = -1; return; }
        if (hipOccupancyMaxActiveBlocksPerMultiprocessor(&per_cu, (const void*)mk_fwd, NTHREADS, LDS_BYTES) != hipSuccess || per_cu < 1) { fprintf(stderr, "kernel_launch: occupancy query says %d\n", per_cu); (void)hipGetLastError(); }
        grid = cus;
    }
    if (grid < 0) return;
    (void)hipMemsetAsync((char*)d_ws + WS_CTL, 0, CTL_BYTES, stream);
    Params p{};
    for (int i = 0; i < 35; ++i) p.in[i] = (const float*)d_in[i];
    p.out = (float*)d_out; p.ws = (unsigned char*)d_ws;
#if MK_ONE_LAUNCH
    p.ph_lo = 0; p.ph_hi = N_PHASES;
    hipLaunchKernelGGL(mk_fwd, dim3(grid), dim3(NTHREADS), LDS_BYTES, stream, p);
#else
    for (int k = 0; k < N_PHASES && k <= MK_LAST; ++k) { p.ph_lo = k; p.ph_hi = k + 1; hipLaunchKernelGGL(mk_fwd, dim3(grid), dim3(NTHREADS), LDS_BYTES, stream, p); }
#endif
}
```

```cpp
#include <hip/hip_runtime.h>
#include <stdint.h>
#include <stdio.h>

#ifndef MK_MASK
#define MK_MASK 0xFFFFFFFFu
#endif
#define MKB(k) (((MK_MASK) >> (k)) & 1u)
#ifndef REP_SCAN
#define REP_SCAN 1
#endif
#ifndef REP_NA
#define REP_NA 1
#endif
#ifndef REP_GEMM
#define REP_GEMM 1
#endif
#ifndef REP_PP
#define REP_PP 1
#endif
#ifndef REP_POST
#define REP_POST 1
#endif
#ifndef REP_CONV
#define REP_CONV 1
#endif
#ifndef REP_NORM
#define REP_NORM 1
#endif
#ifndef REP_PRO
#define REP_PRO 1
#endif
#ifndef MK_LAST
#define MK_LAST 99
#endif
#ifndef MK_ONE_LAUNCH
#define MK_ONE_LAUNCH 1
#endif

#define LAS __attribute__((address_space(3)))
typedef unsigned short bf16_t;
typedef _Float16 f16_t;
typedef short bf16x8 __attribute__((ext_vector_type(8)));
typedef float f32x4 __attribute__((ext_vector_type(4)));
typedef float f32x2 __attribute__((ext_vector_type(2)));
typedef unsigned u32x4 __attribute__((ext_vector_type(4)));
typedef unsigned u32x2 __attribute__((ext_vector_type(2)));
typedef f16_t f16x4 __attribute__((ext_vector_type(4)));
typedef f16_t f16x8 __attribute__((ext_vector_type(8)));
typedef short v4i16_t __attribute__((ext_vector_type(4)));

constexpr int D = 1024, NB = 8, SEQ = 4096, CTXL = 256, TT = CTXL + SEQ;
constexpr int NLAT = NB * SEQ, NCTX = NB * CTXL, NROW = NLAT + NCTX;
constexpr int INW = 3328, DFF = 2816, DFE = 3584, NEXP = 8;
constexpr int O_Q = 0, O_K = 512, O_V = 1024, O_RW = 1536, O_CV = 2816;
constexpr int MODW = 6 * D;
constexpr int NTHREADS = 512, NWAVES = 8;
constexpr int LDS_BYTES = 160 * 1024;
constexpr int LDS_MISC = LDS_BYTES - 256;

constexpr size_t al256(size_t x) { return (x + 255) & ~(size_t)255; }
constexpr size_t WS_CTL   = 0;
constexpr size_t CTL_BYTES = 65536;
constexpr size_t WS_MODV  = WS_CTL + CTL_BYTES;
constexpr size_t WS_BTIN  = al256(WS_MODV + (size_t)2 * 9 * MODW * 4);
constexpr size_t WS_BTOUT = al256(WS_BTIN + (size_t)2 * INW * D * 2);
constexpr size_t WS_BTGU  = al256(WS_BTOUT + (size_t)2 * D * D * 2);
constexpr size_t WS_BTDN  = al256(WS_BTGU + (size_t)2 * DFF * D * 2);
constexpr size_t WS_LORA  = al256(WS_BTDN + (size_t)D * DFF * 2);
constexpr size_t LORA_LD_BYTES = (size_t)(256 * 64 * 2 + 256 * 128) * 2;
constexpr size_t WS_MOE   = al256(WS_LORA + 4 * LORA_LD_BYTES);
constexpr size_t MOE_GU_BYTES = (size_t)2 * DFE * D * 2, MOE_DN_BYTES = (size_t)D * DFE * 2, MOE_E_BYTES = MOE_GU_BYTES + MOE_DN_BYTES;
constexpr size_t WS_SH    = WS_MOE;
constexpr size_t SH_BYTES = (size_t)NB * 4 * TT * 192 * 2;
constexpr size_t WS_SD    = WS_SH + SH_BYTES;
constexpr size_t WS_XC    = al256(WS_MOE + (size_t)NEXP * MOE_E_BYTES);
constexpr size_t WS_HL    = al256(WS_XC + (size_t)NCTX * D * 4);
constexpr size_t WS_Y     = WS_HL;
constexpr size_t WS_PL    = al256(WS_HL + (size_t)NROW * D * 2);
constexpr size_t WS_MIX   = al256(WS_PL + (size_t)NROW * INW * 2);
constexpr size_t WS_H     = WS_PL;
constexpr size_t WS_ROUTE = al256(WS_MIX + (size_t)NROW * D * 2);
constexpr size_t RT_TOKE  = 0;
constexpr size_t RT_TOKG  = RT_TOKE + (size_t)NLAT * 2 * 4;
constexpr size_t RT_TOKP  = RT_TOKG + (size_t)NLAT * 2 * 4;
constexpr size_t RT_RMAP  = RT_TOKP + (size_t)NLAT * 2 * 4;
constexpr size_t RT_SGATE = RT_RMAP + (size_t)2 * NROW * 4;
constexpr size_t WS_END   = al256(WS_ROUTE + RT_SGATE + (size_t)2 * NROW * 4);
static_assert(SH_BYTES * 3 <= (size_t)NEXP * MOE_E_BYTES, "scan inputs must fit the MoE weight region");
static_assert((size_t)NROW * DFE * 2 <= (size_t)NROW * INW * 2 + (size_t)NROW * D * 2, "H must fit PL+MIX");

constexpr int CW_BAR = 0;
constexpr int CW_MOECNT = 4096;

#define XB_TMO      128
#define XB_XCNT(j)  (256  + 64 * (j))
#define XB_XSUB(j)  (1280 + 64 * (j))
#define XB_XGEN(j)  (2304 + 64 * (j))
#define XB_TOP      3328
#define XB_TOPGEN   3392
#define XCD_BAR_WORDS 3456
#define XB_SPIN_CAP (1u << 22)

__device__ __forceinline__ unsigned xb_ld(unsigned* p)              { return __hip_atomic_load(p, __ATOMIC_RELAXED, __HIP_MEMORY_SCOPE_AGENT); }
__device__ __forceinline__ unsigned xb_add(unsigned* p, unsigned v) { return __hip_atomic_fetch_add(p, v, __ATOMIC_RELAXED, __HIP_MEMORY_SCOPE_AGENT); }
__device__ __forceinline__ unsigned xb_xcc_id() { return (unsigned)__builtin_amdgcn_s_getreg((3 << 11) | 20) & 0xFu; }
#define XB_SPIN(cond, bar) do { unsigned _sp = 0; while (cond) { __builtin_amdgcn_s_sleep(1); \
    if ((++_sp & 255u) == 0u) { if (xb_ld(&(bar)[XB_TMO])) break; if (_sp > XB_SPIN_CAP) { atomicAdd(&(bar)[XB_TMO], 1u); break; } } } } while (0)

struct XcdBarrier { unsigned* bar; unsigned x; volatile LAS unsigned* st; };

__device__ __forceinline__ XcdBarrier xcd_barrier_post(unsigned* bar, volatile LAS unsigned* st, int tid) {
    XcdBarrier b; b.bar = bar; b.x = xb_xcc_id(); b.st = st;
    if (tid == 0) (void)xb_add(&bar[XB_XCNT(b.x)], 1u);
    return b;
}
__device__ __forceinline__ void xcd_barrier_complete(unsigned* bar, unsigned x, unsigned& nloc, unsigned& nx) {
    const unsigned G = gridDim.x * gridDim.y * gridDim.z;
    unsigned sum, cnt, mine, sp = 0u;
    for (;;) {
        sum = 0u; cnt = 0u; mine = 0u;
#pragma unroll
        for (unsigned j = 0; j < 16; ++j) { const unsigned c = xb_ld(&bar[XB_XCNT(j)]); sum += c; cnt += (c > 0u) ? 1u : 0u; mine = (j == x) ? c : mine; }
        if (sum == G) break;
        __builtin_amdgcn_s_sleep(1);
        if ((++sp & 255u) == 0u) { if (xb_ld(&bar[XB_TMO])) break; if (sp > XB_SPIN_CAP) { atomicAdd(&bar[XB_TMO], 1u); break; } }
    }
    nloc = mine > 0u ? mine : 1u; nx = cnt > 0u ? cnt : 1u;
}
__device__ __forceinline__ void xcd_barrier(const XcdBarrier& b, int tid) {
    asm volatile("s_waitcnt vmcnt(0)" ::: "memory");
    __syncthreads();
    if (tid == 0) {
        unsigned* bar = b.bar;
        __builtin_amdgcn_s_waitcnt(0);
        unsigned nloc = b.st[0], nx = b.st[1];
        if (nloc == 0u) { xcd_barrier_complete(bar, b.x, nloc, nx); b.st[0] = nloc; b.st[1] = nx; }
        const unsigned old = xb_add(&bar[XB_XSUB(b.x)], 1u);
        const unsigned gen = old / nloc;
        if (old + 1u == (gen + 1u) * nloc) {
            __builtin_amdgcn_fence(__ATOMIC_RELEASE, "agent");
            asm volatile("s_waitcnt vmcnt(0)" ::: "memory");
            const unsigned og = xb_add(&bar[XB_TOP], 1u);
            const unsigned tg = og / nx;
            if (og + 1u == (tg + 1u) * nx) xb_add(&bar[XB_TOPGEN], 1u);
            else XB_SPIN(xb_ld(&bar[XB_TOPGEN]) == tg, bar);
            __builtin_amdgcn_fence(__ATOMIC_ACQUIRE, "agent");
            xb_add(&bar[XB_XGEN(b.x)], 1u);
            asm volatile("s_waitcnt vmcnt(0)" ::: "memory");
        } else {
            XB_SPIN(xb_ld(&bar[XB_XGEN(b.x)]) == gen, bar);
            __builtin_amdgcn_fence(__ATOMIC_ACQUIRE, "agent");
            asm volatile("s_waitcnt vmcnt(0)" ::: "memory");
        }
    }
    __syncthreads();
}

__device__ __forceinline__ int lane_id() { return (int)__builtin_amdgcn_mbcnt_hi(~0u, __builtin_amdgcn_mbcnt_lo(~0u, 0u)); }
__device__ __forceinline__ float bf2f(bf16_t b) { return __uint_as_float(((unsigned)b) << 16); }
__device__ __forceinline__ bf16_t f2bf(float f) { unsigned u = __float_as_uint(f); u += 0x7FFFu + ((u >> 16) & 1u); return (bf16_t)(u >> 16); }
__device__ __forceinline__ unsigned pk_bf16(float lo, float hi) { return (unsigned)f2bf(lo) | ((unsigned)f2bf(hi) << 16); }
typedef __bf16 bf16x2_t __attribute__((ext_vector_type(2)));
__device__ __forceinline__ unsigned cvt_pk_bf16(float lo, float hi) { return __builtin_bit_cast(unsigned, __builtin_convertvector((f32x2){lo, hi}, bf16x2_t)); }
__device__ __forceinline__ float sigmoidf_(float x) { return 1.0f / (1.0f + __expf(-x)); }
__device__ __forceinline__ float siluf_(float x) { return x / (1.0f + __expf(-x)); }
__device__ __forceinline__ float wave_sum(float v) {
#pragma unroll
    for (int o = 32; o >= 1; o >>= 1) v += __shfl_xor(v, o);
    return v;
}
__device__ __forceinline__ float sum16(float v) {
    v += __shfl_xor(v, 1); v += __shfl_xor(v, 2); v += __shfl_xor(v, 4); v += __shfl_xor(v, 8); return v;
}
__device__ __forceinline__ void unpack4(u32x2 w, float (&f)[4]) {
    f[0] = __uint_as_float(w.x << 16); f[1] = __uint_as_float(w.x & 0xffff0000u); f[2] = __uint_as_float(w.y << 16); f[3] = __uint_as_float(w.y & 0xffff0000u);
}
__device__ __forceinline__ void unpack8(u32x4 w, float* f) {
    f[0] = __uint_as_float(w.x << 16); f[1] = __uint_as_float(w.x & 0xffff0000u); f[2] = __uint_as_float(w.y << 16); f[3] = __uint_as_float(w.y & 0xffff0000u);
    f[4] = __uint_as_float(w.z << 16); f[5] = __uint_as_float(w.z & 0xffff0000u); f[6] = __uint_as_float(w.w << 16); f[7] = __uint_as_float(w.w & 0xffff0000u);
}

struct Params {
    const float* in[35];
    float* out; unsigned char* ws;
    int ph_lo, ph_hi;
};
enum { I_X = 0, I_C, I_CTX, I_CCTX, I_N1G, I_N2G, I_MODW, I_MODB, I_WIN, I_WOUT, I_RPB, I_MUP, I_MUN, I_W0, I_W2, I_A0, I_A2, I_G2, I_KK, I_KA, I_RK, I_GNG, I_GNB,
       I_DWW, I_DWB, I_LNG, I_LNB, I_FG, I_FU, I_FD, I_ROUTER, I_MG, I_MU, I_MD, I_FINALG };

__device__ __forceinline__ int row_mi(int r) { return r < NLAT ? (r >> 12) : 8; }

namespace pg8 {
constexpr int BM = 256, BK = 64, HALF = 128, HTB = HALF * BK * 2, STAGE_BYTES = 8 * HTB, NXCD = 8, WGM = 8;
__device__ __forceinline__ int lds_byte(int r, int c) { const int st = (r >> 4) * 2 + (c >> 5), rr = r & 15, cc = c & 31, ob = rr * 64 + cc * 2; return st * 1024 + (ob ^ (((ob >> 9) & 1) << 5)); }
__device__ __forceinline__ void stage_rc(int b, int& R, int& C) { const int st = b / 1024, sb = b % 1024, swz = sb ^ (((sb >> 9) & 1) << 5); R = (st >> 1) * 16 + swz / 64; C = (st & 1) * 32 + (swz % 64) / 2; }
__device__ __forceinline__ int perm32(int rho) { const int n = rho >> 4, i = rho & 15; return 8 * (i >> 2) + 4 * n + (i & 3); }
struct Unit { int pm, pn; };

struct TileOrder {
    int nM, nN, nwg, G, c;
    __device__ void init(int nM_, int nN_, int G_, int c_) { nM = nM_; nN = nN_; nwg = nM * nN; G = G_; c = c_; }
    __device__ bool next(int i, Unit& u) const {
        const long L = (long)i * G + c; if (L >= nwg) return false;
        int wgid = (int)L; { const int q = nwg / NXCD, r = nwg % NXCD, xcd = wgid % NXCD, off = wgid / NXCD; wgid = (xcd < r ? xcd * (q + 1) : r * (q + 1) + (xcd - r) * q) + off; }
        const int nig = WGM * nN, gid = wgid / nig, fm = gid * WGM, gsz = (nM - fm) < WGM ? (nM - fm) : WGM;
        u.pm = fm + ((wgid % nig) % gsz); u.pn = (wgid % nig) / gsz; return true;
    }
};
struct DenseSched : TileOrder {
    const bf16_t* A; const bf16_t* Bt; int K;
    __device__ __forceinline__ const char* aptr(const Unit& u) const { return (const char*)A + (size_t)u.pm * BM * K * 2; }
    __device__ __forceinline__ const char* bptr(const Unit& u) const { return (const char*)Bt + (size_t)u.pn * BM * K * 2; }
    __device__ __forceinline__ const char* abase() const { return (const char*)A; }
    __device__ __forceinline__ int arow(const Unit&, int) const { return 0; }
};
struct MoeSched : TileOrder {
    const bf16_t* A; const unsigned char* Bt0; size_t e_stride; int K; const int* rowmap; int tstart[9];
    __device__ __forceinline__ int expert(int pm) const { int e = 0;
#pragma unroll
        for (int j = 1; j < 8; ++j) e += (pm >= tstart[j]) ? 1 : 0;
        return e; }
    __device__ __forceinline__ const char* aptr(const Unit& u) const { return (const char*)A + (size_t)u.pm * BM * K * 2; }
    __device__ __forceinline__ const char* bptr(const Unit& u) const { return (const char*)Bt0 + (size_t)expert(u.pm) * e_stride + (size_t)u.pn * BM * K * 2; }
    __device__ __forceinline__ const char* abase() const { return (const char*)A; }
    __device__ __forceinline__ int arow(const Unit& u, int r) const { const int t = rowmap[u.pm * BM + r]; return t < 0 ? 0 : t; }
};

struct EpiBf16 {
    static constexpr bool PERM = true;
    bf16_t* O; int ldc; int nscale; float scale;
    __device__ __forceinline__ void operator()(const f32x4 (&acc)[2][2][4][2], const Unit& u, int wr, int wc, int fr, int fq) const {
        const int row0 = u.pm * BM + wr * 64 + fr, col0 = u.pn * BM + wc * 32 + 8 * fq;
        const float s = u.pn < nscale ? scale : 1.0f;
#pragma unroll
        for (int ai = 0; ai < 2; ++ai)
#pragma unroll
            for (int m = 0; m < 4; ++m) { bf16_t* rowp = O + (size_t)(row0 + ai * HALF + m * 16) * ldc + col0;
#pragma unroll
                for (int bj = 0; bj < 2; ++bj) { const f32x4 v0 = acc[ai][bj][m][0] * s, v1 = acc[ai][bj][m][1] * s;
                    u32x4 w; w.x = cvt_pk_bf16(v0[0], v0[1]); w.y = cvt_pk_bf16(v0[2], v0[3]); w.z = cvt_pk_bf16(v1[0], v1[1]); w.w = cvt_pk_bf16(v1[2], v1[3]);
                    *(u32x4*)(rowp + bj * HALF) = w; } }
    }
};
struct EpiSwiGLU {
    static constexpr bool PERM = true;
    bf16_t* H; int ldh;
    __device__ __forceinline__ void operator()(const f32x4 (&acc)[2][2][4][2], const Unit& u, int wr, int wc, int fr, int fq) const {
        const int row0 = u.pm * BM + wr * 64 + fr, col0 = u.pn * HALF + wc * 32 + 8 * fq;
#pragma unroll
        for (int ai = 0; ai < 2; ++ai)
#pragma unroll
            for (int m = 0; m < 4; ++m) { bf16_t* rowp = H + (size_t)(row0 + ai * HALF + m * 16) * ldh + col0;
                float h[8];
#pragma unroll
                for (int n = 0; n < 2; ++n)
#pragma unroll
                    for (int j = 0; j < 4; ++j) { const float g = acc[ai][0][m][n][j], up = acc[ai][1][m][n][j]; h[n * 4 + j] = g / (1.0f + __expf(-g)) * up; }
                u32x4 w; w.x = cvt_pk_bf16(h[0], h[1]); w.y = cvt_pk_bf16(h[2], h[3]); w.z = cvt_pk_bf16(h[4], h[5]); w.w = cvt_pk_bf16(h[6], h[7]);
                *(u32x4*)rowp = w; }
    }
};
struct EpiRes {
    static constexpr bool PERM = false;
    const float* resL; const float* resC; float* outL; float* outC; const float* gvec;
    __device__ __forceinline__ void operator()(const f32x4 (&acc)[2][2][4][2], const Unit& u, int wr, int wc, int fr, int fq) const {
        const int r0 = u.pm * BM; const bool lat = r0 < NLAT;
        const float* res = lat ? resL + (size_t)r0 * D : resC + (size_t)(r0 - NLAT) * D;
        float* out = lat ? outL + (size_t)r0 * D : outC + (size_t)(r0 - NLAT) * D;
        const float* gv = gvec + (size_t)(lat ? (r0 >> 12) : 8) * MODW;
        const int rl = wr * 64 + fr, col0 = u.pn * BM + wc * 32 + 4 * fq;
        f32x4 g[2][2];
#pragma unroll
        for (int bj = 0; bj < 2; ++bj)
#pragma unroll
            for (int n = 0; n < 2; ++n) g[bj][n] = *(const f32x4*)(gv + col0 + bj * HALF + n * 16);
#pragma unroll
        for (int ai = 0; ai < 2; ++ai)
#pragma unroll
            for (int m = 0; m < 4; ++m) { const size_t off = (size_t)(rl + ai * HALF + m * 16) * D + col0;
#pragma unroll
                for (int bj = 0; bj < 2; ++bj)
#pragma unroll
                    for (int n = 0; n < 2; ++n) { const f32x4 rv = *(const f32x4*)(res + off + bj * HALF + n * 16);
                        *(f32x4*)(out + off + bj * HALF + n * 16) = rv + g[bj][n] * acc[ai][bj][m][n]; } }
    }
};
struct EpiMoeDown {
    static constexpr bool PERM = false;
    float* xl; const float* gvec; const int* rowmap; const float* sgate;
    __device__ __forceinline__ void operator()(const f32x4 (&acc)[2][2][4][2], const Unit& u, int wr, int wc, int fr, int fq) const {
        const int rl = u.pm * BM + wr * 64 + fr, col0 = u.pn * BM + wc * 32 + 4 * fq;
#pragma unroll
        for (int ai = 0; ai < 2; ++ai)
#pragma unroll
            for (int m = 0; m < 4; ++m) { const int slot = rl + ai * HALF + m * 16; const int tok = rowmap[slot];
                if (tok >= 0) { const float sg = sgate[slot]; const float* gv = gvec + (size_t)(tok >> 12) * MODW + col0; float* xp = xl + (size_t)tok * D + col0;
#pragma unroll
                    for (int bj = 0; bj < 2; ++bj)
#pragma unroll
                        for (int n = 0; n < 2; ++n) { const f32x4 g = *(const f32x4*)(gv + bj * HALF + n * 16); const f32x4 rv = *(const f32x4*)(xp + bj * HALF + n * 16);
                            *(f32x4*)(xp + bj * HALF + n * 16) = rv + (g * sg) * acc[ai][bj][m][n]; } } }
    }
};

template <class Epi, class Sched, bool GATHER>
__device__ __forceinline__ void gemm_phase(LAS unsigned char* lds, const int K, const Sched& S, const Epi& E, const int wave_) {
    int tid_ = wave_ * 64 + lane_id(); asm volatile("" : "+v"(tid_));
    const int tid = tid_, wid = wave_, lane = tid & 63, wr = wid >> 2, wc = wid & 3, fr = lane & 15, fq = lane >> 4;
    const int nt = K / BK;
    unsigned voffA[2], voffB[2]; int RA[2], CA[2];
#pragma unroll
    for (int i = 0; i < 2; ++i) { int R, C; stage_rc(tid * 16 + i * 8192, R, C); const int Rb = Epi::PERM ? ((R & ~31) + perm32(R & 31)) : R;
        voffA[i] = (unsigned)(R * K + C) * 2u; voffB[i] = (unsigned)(Rb * K + C) * 2u; RA[i] = R; CA[i] = C; }
    const size_t kstep = (size_t)(BK * 2);
    const size_t hstep = (size_t)HALF * K * 2;
    const unsigned ldsw = (unsigned)wid * 1024u;
    const int aoff = lds_byte(wr * 64 + fr, fq * 8), boff = lds_byte(wc * 32 + fr, fq * 8);
#define PG8_SA(b, h) (((b) * 2 + (h)) * HTB)
#define PG8_SB(b, h) ((4 + (b) * 2 + (h)) * HTB)
#define PG8_STAGE(bufoff, gbase, voff) do { _Pragma("unroll") for (int _i = 0; _i < 2; ++_i) \
        __builtin_amdgcn_global_load_lds((const unsigned*)((const char*)(gbase) + (voff)[_i]), (LAS unsigned*)(lds + (bufoff) + ldsw + _i * 8192), 16, 0, 0); } while (0)
#define PG8_LDA(dst, b, h) do { _Pragma("unroll") for (int m = 0; m < 4; ++m) _Pragma("unroll") for (int k = 0; k < 2; ++k) dst[m][k] = *(const LAS bf16x8*)(lds + PG8_SA(b, h) + aoff + m * 2048 + k * 1024); } while (0)
#define PG8_LDB(dst, b, h) do { _Pragma("unroll") for (int n = 0; n < 2; ++n) _Pragma("unroll") for (int k = 0; k < 2; ++k) dst[n][k] = *(const LAS bf16x8*)(lds + PG8_SB(b, h) + boff + n * 2048 + k * 1024); } while (0)
#define PG8_MMA(ai, bj, At, Bt) do { __builtin_amdgcn_s_setprio(1); _Pragma("unroll") for (int m = 0; m < 4; ++m) _Pragma("unroll") for (int n = 0; n < 2; ++n) _Pragma("unroll") for (int k = 0; k < 2; ++k) \
        acc[ai][bj][m][n] = __builtin_amdgcn_mfma_f32_16x16x32_bf16(Bt[n][k], At[m][k], acc[ai][bj][m][n], 0, 0, 0); __builtin_amdgcn_s_setprio(0); } while (0)
#define PG8_WAIT_V(n) asm volatile("s_waitcnt vmcnt(" #n ")" ::: "memory")
#define PG8_WAIT_L(n) asm volatile("s_waitcnt lgkmcnt(" #n ")" ::: "memory")
#define PG8_BAR __builtin_amdgcn_s_barrier()
#define PG8_SCHED __builtin_amdgcn_sched_barrier(0)
#define PG8_STAGE_A(bufoff, TS, H) do { if constexpr (GATHER) { PG8_STAGE(bufoff, gA##TS, oA##TS[H]); } else { PG8_STAGE(bufoff, a##TS + (H) * hstep, voffA); } } while (0)
    Unit cur, nxt; int ui = 0;
    if (!S.next(0, cur)) return;
    f32x4 acc[2][2][4][2];
#pragma unroll
    for (int a = 0; a < 2; ++a)
#pragma unroll
        for (int b = 0; b < 2; ++b)
#pragma unroll
            for (int m = 0; m < 4; ++m)
#pragma unroll
                for (int n = 0; n < 2; ++n) acc[a][b][m][n] = (f32x4){0.f, 0.f, 0.f, 0.f};
    bf16x8 At[4][2], B0[2][2], B1[2][2];
    const char* Abase = S.abase();
    unsigned aoC[2][2] = {{0u, 0u}, {0u, 0u}}, aoN[2][2] = {{0u, 0u}, {0u, 0u}};
    if constexpr (GATHER) {
#pragma unroll
        for (int h = 0; h < 2; ++h)
#pragma unroll
            for (int i = 0; i < 2; ++i) aoC[h][i] = (unsigned)(S.arow(cur, h * HALF + RA[i]) * K + CA[i]) * 2u;
    }
    const char* cA = GATHER ? Abase : S.aptr(cur); const char* cB = S.bptr(cur);
    if constexpr (GATHER) {
        PG8_STAGE(PG8_SB(0, 0), cB, voffB); PG8_STAGE(PG8_SA(0, 0), Abase, aoC[0]); PG8_STAGE(PG8_SB(0, 1), cB + hstep, voffB); PG8_STAGE(PG8_SA(0, 1), Abase, aoC[1]);
    } else {
        PG8_STAGE(PG8_SB(0, 0), cB, voffB); PG8_STAGE(PG8_SA(0, 0), cA, voffA); PG8_STAGE(PG8_SB(0, 1), cB + hstep, voffB); PG8_STAGE(PG8_SA(0, 1), cA + hstep, voffA);
    }
    if (wr == 1) PG8_BAR;
    PG8_WAIT_V(4); PG8_BAR;
    if constexpr (GATHER) {
        PG8_STAGE(PG8_SB(1, 0), cB + kstep, voffB); PG8_STAGE(PG8_SA(1, 0), Abase + kstep, aoC[0]); PG8_STAGE(PG8_SB(1, 1), cB + hstep + kstep, voffB);
    } else {
        PG8_STAGE(PG8_SB(1, 0), cB + kstep, voffB); PG8_STAGE(PG8_SA(1, 0), cA + kstep, voffA); PG8_STAGE(PG8_SB(1, 1), cB + hstep + kstep, voffB);
    }
    PG8_WAIT_V(6); PG8_BAR;
    for (;;) {
        const bool has_next = S.next(ui + 1, nxt);
        const char* nA = has_next ? (GATHER ? Abase : S.aptr(nxt)) : cA; const char* nB = has_next ? S.bptr(nxt) : cB;
        if constexpr (GATHER) {
            if (has_next) {
#pragma unroll
                for (int h = 0; h < 2; ++h)
#pragma unroll
                    for (int i = 0; i < 2; ++i) aoN[h][i] = (unsigned)(S.arow(nxt, h * HALF + RA[i]) * K + CA[i]) * 2u;
            } else {
#pragma unroll
                for (int h = 0; h < 2; ++h)
#pragma unroll
                    for (int i = 0; i < 2; ++i) aoN[h][i] = aoC[h][i];
            }
        }
        for (int t = 0; t < nt; t += 2) {
            const bool last = (t == nt - 2);
            const char* a1 = cA + (size_t)(t + 1) * kstep;
            const char* a2 = last ? nA : cA + (size_t)(t + 2) * kstep; const char* b2 = last ? nB : cB + (size_t)(t + 2) * kstep;
            const char* a3 = a2 + kstep; const char* b3 = b2 + kstep;
            const char* gA1 = Abase + (size_t)(t + 1) * kstep; const char* gA2 = Abase + (last ? (size_t)0 : (size_t)(t + 2) * kstep); const char* gA3 = gA2 + kstep;
            unsigned oA1[2][2], oA2[2][2], oA3[2][2];
#pragma unroll
            for (int h = 0; h < 2; ++h)
#pragma unroll
                for (int i = 0; i < 2; ++i) { oA1[h][i] = aoC[h][i]; oA2[h][i] = last ? aoN[h][i] : aoC[h][i]; oA3[h][i] = oA2[h][i]; }
            (void)a1; (void)a3; (void)gA1; (void)gA3; (void)oA1; (void)oA3;
            PG8_LDB(B0, 0, 0); PG8_SCHED; PG8_LDA(At, 0, 0); PG8_STAGE_A(PG8_SA(1, 1), 1, 1);
            PG8_WAIT_L(8); PG8_BAR; PG8_WAIT_L(0); PG8_MMA(0, 0, At, B0); PG8_BAR; PG8_SCHED;
            PG8_LDB(B1, 0, 1); PG8_STAGE(PG8_SB(0, 0), b2, voffB);
            PG8_BAR; PG8_WAIT_L(0); PG8_MMA(0, 1, At, B1); PG8_BAR;
            PG8_LDA(At, 0, 1); PG8_STAGE_A(PG8_SA(0, 0), 2, 0);
            PG8_BAR; PG8_WAIT_L(0); PG8_MMA(1, 0, At, B0); PG8_BAR; PG8_SCHED;
            PG8_STAGE(PG8_SB(0, 1), b2 + hstep, voffB);
            PG8_WAIT_V(6); PG8_BAR; PG8_MMA(1, 1, At, B1); PG8_BAR;
            PG8_LDB(B0, 1, 0); PG8_SCHED; PG8_LDA(At, 1, 0); PG8_STAGE_A(PG8_SA(0, 1), 2, 1);
            PG8_WAIT_L(8); PG8_BAR; PG8_WAIT_L(0); PG8_MMA(0, 0, At, B0); PG8_BAR; PG8_SCHED;
            PG8_LDB(B1, 1, 1); PG8_STAGE(PG8_SB(1, 0), b3, voffB);
            PG8_BAR; PG8_WAIT_L(0); PG8_MMA(0, 1, At, B1); PG8_BAR;
            PG8_LDA(At, 1, 1); PG8_STAGE_A(PG8_SA(1, 0), 3, 0);
            PG8_BAR; PG8_WAIT_L(0); PG8_MMA(1, 0, At, B0); PG8_BAR; PG8_SCHED;
            PG8_STAGE(PG8_SB(1, 1), b3 + hstep, voffB);
            PG8_WAIT_V(6); PG8_BAR; PG8_MMA(1, 1, At, B1); PG8_BAR;
        }
        { int t2 = tid; asm volatile("" : "+v"(t2)); const int l2 = t2 & 63; E(acc, cur, wr, wc, l2 & 15, l2 >> 4); }
        if (!has_next) break;
#pragma unroll
        for (int a = 0; a < 2; ++a)
#pragma unroll
            for (int b = 0; b < 2; ++b)
#pragma unroll
                for (int m = 0; m < 4; ++m)
#pragma unroll
                    for (int n = 0; n < 2; ++n) acc[a][b][m][n] = (f32x4){0.f, 0.f, 0.f, 0.f};
        cur = nxt; cA = nA; cB = nB; ++ui;
        if constexpr (GATHER) {
#pragma unroll
            for (int h = 0; h < 2; ++h)
#pragma unroll
                for (int i = 0; i < 2; ++i) aoC[h][i] = aoN[h][i];
        }
    }
    PG8_WAIT_V(0);
    if (wr == 0) PG8_BAR;
    PG8_BAR;
#undef PG8_SA
#undef PG8_SB
#undef PG8_STAGE
#undef PG8_STAGE_A
#undef PG8_LDA
#undef PG8_LDB
#undef PG8_MMA
#undef PG8_WAIT_V
#undef PG8_WAIT_L
#undef PG8_BAR
#undef PG8_SCHED
}
}

struct Frame {
    LAS unsigned char* lds; int tid, lane, wave, G, bid, gw, nw;
    unsigned char* ws;
};
extern __shared__ __attribute__((aligned(16))) unsigned char lds_raw[];
typedef const __attribute__((address_space(4))) Params* KP;
__device__ __forceinline__ Params load_params(const void* kp_) {
    const unsigned long long v = (unsigned long long)kp_;
    const unsigned lo = __builtin_amdgcn_readfirstlane((unsigned)v), hi = __builtin_amdgcn_readfirstlane((unsigned)(v >> 32));
    KP kp = (KP)(((unsigned long long)hi << 32) | lo);
    Params P;
#pragma unroll
    for (int i = 0; i < 35; ++i) P.in[i] = kp->in[i];
    P.out = kp->out; P.ws = kp->ws; P.ph_lo = kp->ph_lo; P.ph_hi = kp->ph_hi;
    return P;
}
#define PHASE static __attribute__((noinline)) __device__ void
#define PHASE_INL static __device__ __forceinline__ void
__device__ __forceinline__ Frame make_frame(unsigned char* ws, int wave_) {
    Frame F; F.lds = (LAS unsigned char*)lds_raw; F.wave = __builtin_amdgcn_readfirstlane(wave_);
    int t_ = F.wave * 64 + lane_id(); asm volatile("" : "+v"(t_));
    F.tid = t_; F.lane = F.tid & 63;
    F.G = gridDim.x; F.bid = blockIdx.x; F.gw = F.bid * NWAVES + F.wave; F.nw = F.G * NWAVES; F.ws = ws; return F;
}
__device__ __forceinline__ Frame sub_frame(Frame F, int bid, int G) { F.bid = bid; F.G = G; F.gw = F.bid * NWAVES + F.wave; F.nw = F.G * NWAVES; return F; }
#define PHASE_ENTER const Params P = load_params(kp_); const Frame F = make_frame(P.ws, wv_)

__device__ __forceinline__ void conv_job(const Frame& F, const float* src, bf16_t* dst, int K, int N, int mode) {
    LAS float* tile = (LAS float*)(F.lds + F.wave * (64 * 65 * 4));
    const int tk = K / 64, tn = N / 64, ntile = tk * tn, lane = F.lane;
    for (int t = F.gw; t < ntile; t += F.nw) {
        const int k0 = (t / tn) * 64, n0 = (t % tn) * 64;
#pragma unroll 4
        for (int i = 0; i < 16; ++i) { const int row = i * 4 + (lane >> 4), c4 = (lane & 15) * 4;
            const f32x4 v = *(const f32x4*)(src + (size_t)(k0 + row) * N + n0 + c4);
            tile[row * 65 + c4 + 0] = v[0]; tile[row * 65 + c4 + 1] = v[1]; tile[row * 65 + c4 + 2] = v[2]; tile[row * 65 + c4 + 3] = v[3]; }
        __builtin_amdgcn_wave_barrier(); asm volatile("s_waitcnt lgkmcnt(0)" ::: "memory");
#pragma unroll 2
        for (int i = 0; i < 8; ++i) { const int n = i * 8 + (lane >> 3), kc = (lane & 7) * 8;
            float f[8];
#pragma unroll
            for (int j = 0; j < 8; ++j) f[j] = tile[(kc + j) * 65 + n];
            const int ng = n0 + n; const int drow = mode == 0 ? ng : ((ng >> 7) * 256 + (mode == 2 ? 128 : 0) + (ng & 127));
            u32x4 w; w.x = pk_bf16(f[0], f[1]); w.y = pk_bf16(f[2], f[3]); w.z = pk_bf16(f[4], f[5]); w.w = pk_bf16(f[6], f[7]);
            *(u32x4*)(dst + (size_t)drow * K + k0 + kc) = w; }
        __builtin_amdgcn_wave_barrier(); asm volatile("s_waitcnt lgkmcnt(0)" ::: "memory");
    }
}

__device__ __forceinline__ void phase_prologue(const Frame& F, const Params& P) {
    float* modv = (float*)(F.ws + WS_MODV);
    LAS float* s = (LAS float*)F.lds;
    LAS float* red = (LAS float*)(F.lds + 9 * 1024 * 4);
    for (int cb = F.bid; cb < (2 * MODW) / 64; cb += F.G) {
        for (int i = F.tid; i < 9 * 1024; i += NTHREADS) { const int mi = i >> 10, k = i & 1023; const float c = mi < 8 ? P.in[I_C][mi * D + k] : P.in[I_CCTX][k]; s[i] = siluf_(c); }
        __syncthreads();
        const int colg = cb * 64 + F.lane, l = colg / MODW, col = colg % MODW;
        const float* w = P.in[I_MODW] + (size_t)l * D * MODW + col;
        float acc[9];
#pragma unroll
        for (int mi = 0; mi < 9; ++mi) acc[mi] = 0.f;
        const int kb = F.wave * 128;
#pragma unroll 8
        for (int k = 0; k < 128; ++k) { const float wv = w[(size_t)(kb + k) * MODW];
#pragma unroll
            for (int mi = 0; mi < 9; ++mi) acc[mi] += s[mi * 1024 + kb + k] * wv; }
#pragma unroll
        for (int mi = 0; mi < 9; ++mi) red[(F.wave * 9 + mi) * 64 + F.lane] = acc[mi];
        __syncthreads();
        for (int i = F.tid; i < 9 * 64; i += NTHREADS) { const int mi = i >> 6, ln = i & 63; float a = 0.f;
#pragma unroll
            for (int w8 = 0; w8 < 8; ++w8) a += red[(w8 * 9 + mi) * 64 + ln];
            const int cg = cb * 64 + ln, l2 = cg / MODW, c2 = cg % MODW;
            modv[((size_t)l2 * 9 + mi) * MODW + c2] = a + P.in[I_MODB][l2 * MODW + c2]; }
        __syncthreads();
    }
    for (int l = 0; l < 2; ++l) {
        conv_job(F, P.in[I_WIN] + (size_t)l * D * INW, (bf16_t*)(F.ws + WS_BTIN) + (size_t)l * INW * D, D, INW, 0);
        conv_job(F, P.in[I_WOUT] + (size_t)l * D * D, (bf16_t*)(F.ws + WS_BTOUT) + (size_t)l * D * D, D, D, 0);
    }
    conv_job(F, P.in[I_FG], (bf16_t*)(F.ws + WS_BTGU), D, DFF, 1);
    conv_job(F, P.in[I_FU], (bf16_t*)(F.ws + WS_BTGU), D, DFF, 2);
    conv_job(F, P.in[I_FD], (bf16_t*)(F.ws + WS_BTDN), DFF, D, 0);
    for (int ld = 0; ld < 4; ++ld) { bf16_t* base = (bf16_t*)(F.ws + WS_LORA + (size_t)ld * LORA_LD_BYTES);
        conv_job(F, P.in[I_W2] + (size_t)ld * 64 * 256, base, 64, 256, 0);
        conv_job(F, P.in[I_A2] + (size_t)ld * 64 * 256, base + 256 * 64, 64, 256, 0);
        conv_job(F, P.in[I_G2] + (size_t)ld * 128 * 256, base + 2 * 256 * 64, 128, 256, 0); }
}
__device__ __forceinline__ void phase_moe_convert(const Frame& F, const Params& P) {
    for (int e = 0; e < NEXP; ++e) {
        bf16_t* gu = (bf16_t*)(F.ws + WS_MOE + (size_t)e * MOE_E_BYTES); bf16_t* dn = (bf16_t*)(F.ws + WS_MOE + (size_t)e * MOE_E_BYTES + MOE_GU_BYTES);
        conv_job(F, P.in[I_MG] + (size_t)e * D * DFE, gu, D, DFE, 1);
        conv_job(F, P.in[I_MU] + (size_t)e * D * DFE, gu, D, DFE, 2);
        conv_job(F, P.in[I_MD] + (size_t)e * DFE * D, dn, DFE, D, 0);
    }
}

template <bool ROUTER>
__device__ __forceinline__ void phase_norm(const Frame& F, const Params& P, int l, int which, int nrows, const float* srcL, const float* srcC) {
    const float* g = (which == 0 ? P.in[I_N1G] : P.in[I_N2G]) + l * D;
    const float* modv = (const float*)(F.ws + WS_MODV) + (size_t)l * 9 * MODW + (which == 0 ? 0 : 3 * D);
    bf16_t* HL = (bf16_t*)(F.ws + WS_HL);
    LAS float* rt = (LAS float*)F.lds;
    if (ROUTER) {
        for (int i = F.tid; i < D * NEXP; i += NTHREADS) rt[i] = P.in[I_ROUTER][i];
        int* rmap = (int*)(F.ws + WS_ROUTE + RT_RMAP);
        for (int i = F.bid * NTHREADS + F.tid; i < 2 * NROW; i += F.G * NTHREADS) rmap[i] = -1;
        __syncthreads();
    }
    const int lane = F.lane;
    for (int r = F.gw; r < nrows; r += F.nw) {
        const float* xr = r < NLAT ? srcL + (size_t)r * D : srcC + (size_t)(r - NLAT) * D;
        const float* mv = modv + (size_t)row_mi(r) * MODW;
        f32x4 x[4]; float ss = 0.f;
#pragma unroll
        for (int j = 0; j < 4; ++j) { x[j] = *(const f32x4*)(xr + j * 256 + lane * 4); ss += x[j][0] * x[j][0] + x[j][1] * x[j][1] + x[j][2] * x[j][2] + x[j][3] * x[j][3]; }
        ss = wave_sum(ss);
        const float rstd = rsqrtf(ss * (1.0f / D) + 1e-6f);
        float lg[NEXP];
        if (ROUTER) {
#pragma unroll
            for (int e = 0; e < NEXP; ++e) lg[e] = 0.f;
        }
#pragma unroll
        for (int j = 0; j < 4; ++j) { const int c = j * 256 + lane * 4;
            const f32x4 gg = *(const f32x4*)(g + c), sh = *(const f32x4*)(mv + c), sc = *(const f32x4*)(mv + D + c);
            f32x4 y = (x[j] * rstd * gg) * (sc + 1.0f) + sh;
            u32x2 w; w.x = pk_bf16(y[0], y[1]); w.y = pk_bf16(y[2], y[3]);
            *(u32x2*)(HL + (size_t)r * D + c) = w;
            if (ROUTER) {
#pragma unroll
                for (int q = 0; q < 4; ++q) { const f32x4 r0 = *(const LAS f32x4*)(rt + (c + q) * 8), r1 = *(const LAS f32x4*)(rt + (c + q) * 8 + 4);
                    lg[0] += y[q] * r0[0]; lg[1] += y[q] * r0[1]; lg[2] += y[q] * r0[2]; lg[3] += y[q] * r0[3];
                    lg[4] += y[q] * r1[0]; lg[5] += y[q] * r1[1]; lg[6] += y[q] * r1[2]; lg[7] += y[q] * r1[3]; asm volatile("" ::: "memory"); }
            }
        }
        if (ROUTER) {
#pragma unroll
            for (int e = 0; e < NEXP; ++e) lg[e] = wave_sum(lg[e]);
            if (lane == 0) {
                int e1 = 0; float l1 = lg[0];
#pragma unroll
                for (int e = 1; e < NEXP; ++e) if (lg[e] > l1) { l1 = lg[e]; e1 = e; }
                int e2 = -1; float l2 = -3.0e38f;
#pragma unroll
                for (int e = 0; e < NEXP; ++e) if (e != e1 && lg[e] > l2) { l2 = lg[e]; e2 = e; }
                if (e2 < 0) { e2 = e1 == 0 ? 1 : 0; l2 = l1; }
                const float ex = __expf(l2 - l1), g1 = 1.0f / (1.0f + ex), g2 = ex * g1;
                unsigned* cnt = (unsigned*)(F.ws + WS_CTL) + CW_MOECNT;
                const unsigned p1 = atomicAdd(cnt + e1, 1u), p2 = atomicAdd(cnt + 8 + e2, 1u);
                int* te = (int*)(F.ws + WS_ROUTE + RT_TOKE); float* tg = (float*)(F.ws + WS_ROUTE + RT_TOKG); int* tp = (int*)(F.ws + WS_ROUTE + RT_TOKP);
                te[r * 2] = e1; te[r * 2 + 1] = e2; tg[r * 2] = g1; tg[r * 2 + 1] = g2; tp[r * 2] = (int)p1; tp[r * 2 + 1] = (int)p2;
            }
        }
    }
}
__device__ __forceinline__ void moe_tstart(const Frame& F, int pass, int (&ts)[9]) {
    const unsigned* cnt = (const unsigned*)(F.ws + WS_CTL) + CW_MOECNT + pass * 8;
    int a = 0;
#pragma unroll
    for (int e = 0; e < 8; ++e) { ts[e] = a; a += (int)((__hip_atomic_load(cnt + e, __ATOMIC_RELAXED, __HIP_MEMORY_SCOPE_AGENT) + 255u) >> 8); }
    ts[8] = a;
}
__device__ __forceinline__ void phase_moe_rowmap(const Frame& F) {
    int ts0[9], ts1[9]; moe_tstart(F, 0, ts0); moe_tstart(F, 1, ts1);
    const int* te = (const int*)(F.ws + WS_ROUTE + RT_TOKE); const float* tg = (const float*)(F.ws + WS_ROUTE + RT_TOKG); const int* tp = (const int*)(F.ws + WS_ROUTE + RT_TOKP);
    int* rmap = (int*)(F.ws + WS_ROUTE + RT_RMAP); float* sg = (float*)(F.ws + WS_ROUTE + RT_SGATE);
    for (int t = F.bid * NTHREADS + F.tid; t < NLAT; t += F.G * NTHREADS) {
        { const int e = te[t * 2]; int st = 0;
#pragma unroll
          for (int j = 0; j < 8; ++j) st = (e == j) ? ts0[j] : st;
          const int slot = st * 256 + tp[t * 2]; rmap[slot] = t; sg[slot] = tg[t * 2]; }
        { const int e = te[t * 2 + 1]; int st = 0;
#pragma unroll
          for (int j = 0; j < 8; ++j) st = (e == j) ? ts1[j] : st;
          const int slot = st * 256 + tp[t * 2 + 1]; rmap[NROW + slot] = t; sg[NROW + slot] = tg[t * 2 + 1]; }
    }
}

struct RowGeo { int b, tt, pos, len; };
__device__ __forceinline__ RowGeo row_geo(int r) { RowGeo g; if (r < NLAT) { g.b = r >> 12; g.pos = r & 4095; g.len = SEQ; g.tt = CTXL + g.pos; } else { const int q = r - NLAT; g.b = q >> 8; g.pos = q & 255; g.len = CTXL; g.tt = g.pos; } return g; }

__device__ __forceinline__ void rw_shift4(const bf16_t* PL, const float* mup, const float* mun, int r, const RowGeo& g, int j, float (&u)[4]) {
    const bf16_t* p = PL + (size_t)r * INW + O_RW + j;
    const bool hp = g.pos > 0, hn = g.pos < g.len - 1;
    float c[4], pv[4], nv[4];
    unpack4(*(const u32x2*)p, c); unpack4(*(const u32x2*)(p - (hp ? INW : 0)), pv); unpack4(*(const u32x2*)(p + (hn ? INW : 0)), nv);
    const f32x4 mp = *(const f32x4*)(mup + j), mn = *(const f32x4*)(mun + j);
#pragma unroll
    for (int q = 0; q < 4; ++q) u[q] = c[q] + mp[q] * ((hp ? pv[q] : 0.f) - c[q]) + mn[q] * ((hn ? nv[q] : 0.f) - c[q]);
}

__device__ __forceinline__ void rw_shift8(const bf16_t* PL, const float* mup, const float* mun, int r, const RowGeo& g, int j, float (&u)[8]) {
    const bf16_t* p = PL + (size_t)r * INW + O_RW + j;
    const bool hp = g.pos > 0, hn = g.pos < g.len - 1;
    float c[8], pv[8], nv[8];
    unpack8(*(const u32x4*)p, c); unpack8(*(const u32x4*)(p - (hp ? INW : 0)), pv); unpack8(*(const u32x4*)(p + (hn ? INW : 0)), nv);
    const f32x4 mp0 = *(const f32x4*)(mup + j), mp1 = *(const f32x4*)(mup + j + 4), mn0 = *(const f32x4*)(mun + j), mn1 = *(const f32x4*)(mun + j + 4);
#pragma unroll
    for (int q = 0; q < 4; ++q) { u[q] = c[q] + mp0[q] * ((hp ? pv[q] : 0.f) - c[q]) + mn0[q] * ((hn ? nv[q] : 0.f) - c[q]);
        u[4 + q] = c[4 + q] + mp1[q] * ((hp ? pv[4 + q] : 0.f) - c[4 + q]) + mn1[q] * ((hn ? nv[4 + q] : 0.f) - c[4 + q]); }
}
__device__ __forceinline__ bf16x8 pack8f(const float (&f)[8]) {
    u32x4 w; w.x = cvt_pk_bf16(f[0], f[1]); w.y = cvt_pk_bf16(f[2], f[3]); w.z = cvt_pk_bf16(f[4], f[5]); w.w = cvt_pk_bf16(f[6], f[7]); return __builtin_bit_cast(bf16x8, w);
}
constexpr int RL_MUP = 0, RL_MUN = 5120, RL_KK = 10240, RL_KA = 11264, RL_W0 = 12288, RL_A0 = 14336, RL_RK = 16384, RL_GNG = 17408, RL_GNB = 18432, RL_END = 19456;
__device__ __forceinline__ void rw_stage_tables(const Frame& F, const Params& P, int l) {
    LAS float* T = (LAS float*)F.lds;
    for (int i = F.tid; i < 1280; i += NTHREADS) { T[RL_MUP / 4 + i] = P.in[I_MUP][l * 1280 + i]; T[RL_MUN / 4 + i] = P.in[I_MUN][l * 1280 + i]; }
    for (int i = F.tid; i < 256; i += NTHREADS) { T[RL_KK / 4 + i] = P.in[I_KK][l * 256 + i]; T[RL_KA / 4 + i] = P.in[I_KA][l * 256 + i]; T[RL_RK / 4 + i] = P.in[I_RK][l * 256 + i];
        T[RL_GNG / 4 + i] = P.in[I_GNG][l * 256 + i]; T[RL_GNB / 4 + i] = P.in[I_GNB][l * 256 + i]; }
    for (int i = F.tid; i < 512; i += NTHREADS) { T[RL_W0 / 4 + i] = P.in[I_W0][l * 512 + i]; T[RL_A0 / 4 + i] = P.in[I_A0][l * 512 + i]; }
    __syncthreads();
}
__device__ __forceinline__ void rw_mix8(const LAS float* T, const u32x4 (&raw)[3], bool hp, bool hn, int j, float (&u)[8]) {
    float c[8], pv[8], nv[8]; unpack8(raw[0], c); unpack8(raw[1], pv); unpack8(raw[2], nv);
    const f32x4 mp0 = *(const LAS f32x4*)(T + RL_MUP / 4 + j), mp1 = *(const LAS f32x4*)(T + RL_MUP / 4 + j + 4), mn0 = *(const LAS f32x4*)(T + RL_MUN / 4 + j), mn1 = *(const LAS f32x4*)(T + RL_MUN / 4 + j + 4);
#pragma unroll
    for (int q = 0; q < 4; ++q) { u[q] = c[q] + mp0[q] * ((hp ? pv[q] : 0.f) - c[q]) + mn0[q] * ((hn ? nv[q] : 0.f) - c[q]);
        u[4 + q] = c[4 + q] + mp1[q] * ((hp ? pv[4 + q] : 0.f) - c[4 + q]) + mn1[q] * ((hn ? nv[4 + q] : 0.f) - c[4 + q]); }
}
__device__ __forceinline__ void rw_mix4(const LAS float* T, const u32x2 (&raw)[3], bool hp, bool hn, int j, float (&u)[4]) {
    float c[4], pv[4], nv[4]; unpack4(raw[0], c); unpack4(raw[1], pv); unpack4(raw[2], nv);
    const f32x4 mp = *(const LAS f32x4*)(T + RL_MUP / 4 + j), mn = *(const LAS f32x4*)(T + RL_MUN / 4 + j);
#pragma unroll
    for (int q = 0; q < 4; ++q) u[q] = c[q] + mp[q] * ((hp ? pv[q] : 0.f) - c[q]) + mn[q] * ((hn ? nv[q] : 0.f) - c[q]);
}
__device__ __forceinline__ void phase_rw_prep(const Frame& F, const Params& P, int l) {
    const bf16_t* PL = (const bf16_t*)(F.ws + WS_PL);
    f16_t* SH = (f16_t*)(F.ws + WS_SH); f16_t* SD = (f16_t*)(F.ws + WS_SD);
    const int lane = F.lane;
    rw_stage_tables(F, P, l);
    const LAS float* T = (const LAS float*)F.lds;
    for (int item = F.gw; item < NLAT / 16 + (NCTX / 16) * 4; item += F.nw) {
        const int tile = item < NLAT / 16 ? item : NLAT / 16 + ((item - NLAT / 16) >> 2), h0 = item < NLAT / 16 ? 0 : ((item - NLAT / 16) & 3), h1 = item < NLAT / 16 ? 4 : h0 + 1;
        int l1 = lane; asm volatile("" : "+v"(l1)); const int tk = l1 & 15, g = l1 >> 4;
        const int r = tile * 16 + tk; const RowGeo geo = row_geo(r);
        const bool hp = geo.pos > 0, hn = geo.pos < geo.len - 1;
        const bf16_t* prow = PL + (size_t)r * INW + O_RW; const int dprev = hp ? -INW : 0, dnext = hn ? INW : 0;
        bf16x8 tw[2][2], ta[2][2];
#pragma unroll
        for (int d = 0; d < 2; ++d) { u32x4 raw[4][3];
#pragma unroll
          for (int i = 0; i < 4; ++i) { const bf16_t* p = prow + 768 + 256 * d + 64 * (i & 1) + 32 * (i >> 1) + 8 * g;
              raw[i][0] = *(const u32x4*)p; raw[i][1] = *(const u32x4*)(p + dprev); raw[i][2] = *(const u32x4*)(p + dnext); }
#pragma unroll
          for (int i = 0; i < 4; ++i) { float u[8]; rw_mix8(T, raw[i], hp, hn, 768 + 256 * d + 64 * (i & 1) + 32 * (i >> 1) + 8 * g, u);
              if ((i & 1) == 0) {
#pragma unroll
                  for (int q = 0; q < 8; ++q) u[q] = 1.0f - 2.0f / (1.0f + __expf(2.0f * u[q]));
                  tw[d][i >> 1] = pack8f(u); }
              else ta[d][i >> 1] = pack8f(u); }
          asm volatile("" ::: "memory"); }
        asm volatile("" ::: "memory");
#pragma unroll 1
        for (int h = h0; h < h1; ++h) {
            int l2 = lane; asm volatile("" : "+v"(l2)); const int tk = l2 & 15, g = l2 >> 4;
            const int r = tile * 16 + tk; const RowGeo geo = row_geo(r);
            const bool hp = geo.pos > 0, hn = geo.pos < geo.len - 1;
            const bf16_t* prow = PL + (size_t)r * INW + O_RW + 64 * h + 8 * g; const int dprev = hp ? -INW : 0, dnext = hn ? INW : 0;
            float ur[4][4], uk[4][4], uv[4][4], kkv[4][4]; float ss = 0.f;
            { u32x4 raw[6][3];
#pragma unroll
              for (int i = 0; i < 6; ++i) { const bf16_t* p = prow + 256 * (i >> 1) + 32 * (i & 1);
                  raw[i][0] = *(const u32x4*)p; raw[i][1] = *(const u32x4*)(p + dprev); raw[i][2] = *(const u32x4*)(p + dnext); }
#pragma unroll
              for (int u = 0; u < 2; ++u) { float x8[8]; const int c = 64 * h + 32 * u + 8 * g;
                  rw_mix8(T, raw[u], hp, hn, c, x8);
#pragma unroll
                  for (int e = 0; e < 8; ++e) ur[2 * u + (e >> 2)][e & 3] = x8[e];
                  rw_mix8(T, raw[2 + u], hp, hn, 256 + c, x8);
#pragma unroll
                  for (int e = 0; e < 8; ++e) uk[2 * u + (e >> 2)][e & 3] = x8[e];
                  rw_mix8(T, raw[4 + u], hp, hn, 512 + c, x8);
#pragma unroll
                  for (int e = 0; e < 8; ++e) uv[2 * u + (e >> 2)][e & 3] = x8[e];
                  const f32x4 k0 = *(const LAS f32x4*)(T + RL_KK / 4 + c), k1 = *(const LAS f32x4*)(T + RL_KK / 4 + c + 4);
#pragma unroll
                  for (int q = 0; q < 4; ++q) { kkv[2 * u][q] = uk[2 * u][q] * k0[q]; kkv[2 * u + 1][q] = uk[2 * u + 1][q] * k1[q]; ss += kkv[2 * u][q] * kkv[2 * u][q] + kkv[2 * u + 1][q] * kkv[2 * u + 1][q]; } } }
            ss += __shfl_xor(ss, 16); ss += __shfl_xor(ss, 32);
            const float rn = rsqrtf(ss + 1e-12f);
            const size_t shrow = ((size_t)(geo.b * 4 + h) * TT + geo.tt) * 192;
#pragma unroll
            for (int u = 0; u < 2; ++u) { f16x8 o1, o2, o3;
#pragma unroll
                for (int e = 0; e < 8; ++e) { const int t = 2 * u + (e >> 2), q = e & 3; kkv[t][q] *= rn; o1[e] = (f16_t)ur[t][q]; o2[e] = (f16_t)uv[t][q]; o3[e] = (f16_t)(-kkv[t][q]); }
                f16_t* sp = SH + shrow + 32 * u + 8 * g; *(f16x8*)sp = o1; *(f16x8*)(sp + 64) = o2; *(f16x8*)(sp + 128) = o3; }
#pragma unroll 1
            for (int d = 0; d < 2; ++d) {
                const bf16_t* w2t = (const bf16_t*)(F.ws + WS_LORA + (size_t)(l * 2 + d) * LORA_LD_BYTES); const bf16_t* a2t = w2t + 256 * 64;
                const size_t sdrow = ((size_t)((d * 8 + geo.b) * 4 + h) * TT + geo.tt) * 192;
                const bf16x8 tw0 = d ? tw[1][0] : tw[0][0], tw1 = d ? tw[1][1] : tw[0][1], ta0 = d ? ta[1][0] : ta[0][0], ta1 = d ? ta[1][1] : ta[0][1];
                bf16x8 wf[4][2], af[4][2];
#pragma unroll
                for (int t = 0; t < 4; ++t) { const int wrow = 64 * h + 32 * (t >> 1) + 8 * (tk >> 2) + 4 * (t & 1) + (tk & 3);
                    const bf16_t* wr = w2t + (size_t)wrow * 64 + 8 * g; const bf16_t* ar = a2t + (size_t)wrow * 64 + 8 * g;
                    wf[t][0] = *(const bf16x8*)wr; wf[t][1] = *(const bf16x8*)(wr + 32); af[t][0] = *(const bf16x8*)ar; af[t][1] = *(const bf16x8*)(ar + 32); }
                f16x8 o1[2], o2[2], o3[2];
#pragma unroll
                for (int t = 0; t < 4; ++t) { const int c = 64 * h + 32 * (t >> 1) + 8 * g + 4 * (t & 1);
                    f32x4 xw = *(const LAS f32x4*)(T + RL_W0 / 4 + d * 256 + c), xa = *(const LAS f32x4*)(T + RL_A0 / 4 + d * 256 + c);
                    xw = __builtin_amdgcn_mfma_f32_16x16x32_bf16(wf[t][0], tw0, xw, 0, 0, 0); xw = __builtin_amdgcn_mfma_f32_16x16x32_bf16(wf[t][1], tw1, xw, 0, 0, 0);
                    xa = __builtin_amdgcn_mfma_f32_16x16x32_bf16(af[t][0], ta0, xa, 0, 0, 0); xa = __builtin_amdgcn_mfma_f32_16x16x32_bf16(af[t][1], ta1, xa, 0, 0, 0);
                    const f32x4 kaw = *(const LAS f32x4*)(T + RL_KA / 4 + c);
#pragma unroll
                    for (int q = 0; q < 4; ++q) {
                        const float nx = -xw[q]; const float sp = fmaxf(nx, 0.f) + __logf(1.0f + __expf(-fabsf(nx)));
                        const float e = __expf(-sp - 0.5f);
                        const float omw = 1.0f - __expf(-e);
                        const float a = sigmoidf_(xa[q]);
                        o1[t >> 1][(t & 1) * 4 + q] = (f16_t)omw; o2[t >> 1][(t & 1) * 4 + q] = (f16_t)(uk[t][q] * (1.0f + (a - 1.0f) * kaw[q])); o3[t >> 1][(t & 1) * 4 + q] = (f16_t)(kkv[t][q] * a); } }
#pragma unroll
                for (int u = 0; u < 2; ++u) { f16_t* sp = SD + sdrow + 32 * u + 8 * g; *(f16x8*)sp = o1[u]; *(f16x8*)(sp + 64) = o2[u]; *(f16x8*)(sp + 128) = o3[u]; }
                asm volatile("" ::: "memory");
            }
        }
    }
    __syncthreads();
}

constexpr int CS_ZP = 0, CS_RPP = 2048, CS_BH = 4096, CS_KH = 6144, CS_VV = 8192, CS_MT = 10240, CS_NT = 11264, CS_WC = 12288, CS_SLOT = 12544;
constexpr int CS_ZIMG = 8 * CS_SLOT;
constexpr int CS_NCHUNK = TT / 16;
__device__ __forceinline__ int cs_tt(int d, int q, int s) { const int st = 16 * q + s; return d == 0 ? st : (st < CTXL ? CTXL - 1 - st : TT + CTXL - 1 - st); }
__device__ __forceinline__ float dpp_shr(float old, float v, int) { return v; }
template <int N> __device__ __forceinline__ float row_shr(float v, float old) {
    return __builtin_bit_cast(float, __builtin_amdgcn_update_dpp(__builtin_bit_cast(int, old), __builtin_bit_cast(int, v), 0x110 + N, 0xF, 0xF, false));
}
__device__ __forceinline__ bf16x8 cs_pack(const float (&a)[4], const float (&b)[4]) {
    u32x4 w; w.x = cvt_pk_bf16(a[0], a[1]); w.y = cvt_pk_bf16(a[2], a[3]); w.z = cvt_pk_bf16(b[0], b[1]); w.w = cvt_pk_bf16(b[2], b[3]); return __builtin_bit_cast(bf16x8, w);
}
__device__ __forceinline__ bf16x8 cs_op16(const f32x4& x) { u32x4 w; w.x = cvt_pk_bf16(x[0], x[1]); w.y = cvt_pk_bf16(x[2], x[3]); w.z = 0u; w.w = 0u; return __builtin_bit_cast(bf16x8, w); }
#define CS_MFMA(a, b, c) __builtin_amdgcn_mfma_f32_16x16x32_bf16((a), (b), (c), 0, 0, 0)
__device__ __forceinline__ f32x4 cs_mm16(const f32x4& xt_d, const f32x4& y_d) { return CS_MFMA(cs_op16(xt_d), cs_op16(y_d), ((f32x4){0.f, 0.f, 0.f, 0.f})); }
__device__ __forceinline__ v4i16_t cs_tr(const LAS unsigned char* img, int lane, int T) {
    const int g = lane >> 4, q = (lane & 15) >> 2, p = lane & 3;
    return __builtin_amdgcn_ds_read_tr16_b64_v4i16((LAS v4i16_t*)(img + (4 * g + q) * 128 + p * 32 + (T >> 1) * 16 + (T & 1) * 8));
}
__device__ __forceinline__ bf16x8 cs_lo(v4i16_t x) { bf16x8 r; r[0] = x[0]; r[1] = x[1]; r[2] = x[2]; r[3] = x[3]; r[4] = 0; r[5] = 0; r[6] = 0; r[7] = 0; return r; }

struct CsRaw { u32x2 x[4], z[4], r[4], b[4], k[4], v[4]; };
__device__ __forceinline__ void cs_load(CsRaw& R, const f16_t* sh, const f16_t* sd, int d, int q, int lane) {
    const int s = lane & 15, g = lane >> 4; const int tt = cs_tt(d, q, s);
    const f16_t* shp = sh + (size_t)tt * 192 + 4 * g; const f16_t* sdp = sd + (size_t)tt * 192 + 4 * g;
#pragma unroll
    for (int T = 0; T < 4; ++T) { R.x[T] = *(const u32x2*)(sdp + 16 * T); R.z[T] = *(const u32x2*)(shp + 128 + 16 * T); R.r[T] = *(const u32x2*)(shp + 16 * T);
        R.b[T] = *(const u32x2*)(sdp + 128 + 16 * T); R.k[T] = *(const u32x2*)(sdp + 64 + 16 * T); R.v[T] = *(const u32x2*)(shp + 64 + 16 * T); }
}
__device__ __forceinline__ void cs_prepass(LAS unsigned char* slot, LAS unsigned char* zimg, CsRaw& raw, const f16_t* sh, const f16_t* sd, int d, int qn, int lane) {
    const int s = lane & 15, g = lane >> 4;
    float Wc[4][4], Wp[4][4], iW[4][4];
#pragma unroll
    for (int T = 0; T < 4; ++T) { const f16x4 x4 = __builtin_bit_cast(f16x4, raw.x[T]);
#pragma unroll
        for (int j = 0; j < 4; ++j) { float wc = 1.0f - (float)x4[j];
            wc *= row_shr<1>(wc, 1.0f); wc *= row_shr<2>(wc, 1.0f); wc *= row_shr<4>(wc, 1.0f); wc *= row_shr<8>(wc, 1.0f);
            Wc[T][j] = wc; Wp[T][j] = row_shr<1>(wc, 1.0f); iW[T][j] = __builtin_amdgcn_rcpf(wc); } }
    if (s == 15) {
#pragma unroll
        for (int T = 0; T < 4; ++T) *(LAS f32x4*)(slot + CS_WC + (16 * T + 4 * g) * 4) = (f32x4){Wc[T][0], Wc[T][1], Wc[T][2], Wc[T][3]}; }
    bf16x8 oZ[2], oR[2], oB[2], oK[2];
    const int ioff = s * 128 + g * 32;
#define CS_STAGE(dst, SRC, SC, IMG) do { float t_[4][4]; \
        _Pragma("unroll") for (int T = 0; T < 4; ++T) { const f16x4 q4 = __builtin_bit_cast(f16x4, SRC[T]); \
            _Pragma("unroll") for (int j = 0; j < 4; ++j) t_[T][j] = (float)q4[j] * SC; } \
        _Pragma("unroll") for (int kk = 0; kk < 2; ++kk) { dst[kk] = cs_pack(t_[2 * kk], t_[2 * kk + 1]); if (IMG) *(LAS bf16x8*)((IMG) + ioff + kk * 16) = dst[kk]; } \
        } while (0)
    CS_STAGE(oZ, raw.z, Wp[T][j], zimg);
    CS_STAGE(oR, raw.r, Wc[T][j], (LAS unsigned char*)nullptr);
    CS_STAGE(oB, raw.b, iW[T][j], slot + CS_BH);
    CS_STAGE(oK, raw.k, iW[T][j], slot + CS_KH);
    { bf16x8 oV[2]; CS_STAGE(oV, raw.v, 1.0f, slot + CS_VV); }
#undef CS_STAGE
    asm volatile("" ::: "memory");
    if (qn >= 0) cs_load(raw, sh, sd, d, qn, lane);
    const f32x4 zero4 = (f32x4){0.f, 0.f, 0.f, 0.f};
    f32x4 A_D = CS_MFMA(oB[1], oZ[1], CS_MFMA(oB[0], oZ[0], zero4)), AT_D = CS_MFMA(oZ[1], oB[1], CS_MFMA(oZ[0], oB[0], zero4));
    f32x4 BkT_D = CS_MFMA(oZ[1], oK[1], CS_MFMA(oZ[0], oK[0], zero4));
    f32x4 Ar_D = CS_MFMA(oB[1], oR[1], CS_MFMA(oB[0], oR[0], zero4)), Kr_D = CS_MFMA(oK[1], oR[1], CS_MFMA(oK[0], oR[0], zero4));
    f32x4 I_D;
#pragma unroll
    for (int j = 0; j < 4; ++j) { const int m = 4 * g + j;
        A_D[j] = m < s ? A_D[j] : 0.f; AT_D[j] = s < m ? AT_D[j] : 0.f; BkT_D[j] = s < m ? BkT_D[j] : 0.f;
        Ar_D[j] = m <= s ? Ar_D[j] : 0.f; Kr_D[j] = m <= s ? Kr_D[j] : 0.f; I_D[j] = m == s ? 1.f : 0.f; }
    f32x4 Ab, AbT, A1, A2m;
#pragma unroll
    for (int j = 0; j < 4; ++j) { const int m = 4 * g + j; const bool b0 = (m >> 2) == (s >> 2), b1 = (m >> 3) == (s >> 3);
        Ab[j] = b0 ? A_D[j] : 0.f; AbT[j] = b0 ? AT_D[j] : 0.f; A1[j] = (b1 && !b0) ? A_D[j] : 0.f; A2m[j] = b1 ? 0.f : A_D[j]; }
    const f32x4 Ab2 = cs_mm16(AbT, Ab), Ab2T = cs_mm16(Ab, AbT);
    const f32x4 P0 = I_D + Ab, P0T = I_D + AbT;
    const f32x4 T0 = P0 + cs_mm16(P0T, Ab2), T0T = P0T + cs_mm16(Ab2, P0T);
    (void)Ab2T;
    const f32x4 ZT = cs_mm16(A1, T0T);
    const f32x4 T1 = T0 + cs_mm16(ZT, T0), T1T = T0T + cs_mm16(T0, ZT);
    const f32x4 Z2T = cs_mm16(A2m, T1T);
    const f32x4 T_D = T1 + cs_mm16(Z2T, T1);
    const f32x4 M_D = cs_mm16(BkT_D, T_D), MT_D = cs_mm16(T_D, BkT_D);
    const f32x4 N_D = cs_mm16(MT_D, Ar_D) + Kr_D;
    { u32x4 w; w.x = cvt_pk_bf16(M_D[0], M_D[1]); w.y = cvt_pk_bf16(M_D[2], M_D[3]); w.z = 0u; w.w = 0u; *(LAS u32x4*)(slot + CS_MT + s * 64 + g * 16) = w;
      w.x = cvt_pk_bf16(N_D[0], N_D[1]); w.y = cvt_pk_bf16(N_D[2], N_D[3]); *(LAS u32x4*)(slot + CS_NT + s * 64 + g * 16) = w; }
    __builtin_amdgcn_wave_barrier(); asm volatile("" ::: "memory");
    const bf16x8 oT = cs_op16(T_D), oAr = cs_op16(Ar_D);
    float Zp[4][4];
#pragma unroll
    for (int T = 0; T < 4; ++T) { const f32x4 zp = CS_MFMA(cs_lo(cs_tr(zimg, lane, T)), oT, zero4);
#pragma unroll
        for (int j = 0; j < 4; ++j) Zp[T][j] = zp[j]; }
#pragma unroll
    for (int kk = 0; kk < 2; ++kk) *(LAS bf16x8*)(slot + CS_ZP + s * 128 + g * 32 + kk * 16) = cs_pack(Zp[2 * kk], Zp[2 * kk + 1]);
    __builtin_amdgcn_wave_barrier(); asm volatile("" ::: "memory");
    float Rp[4][4];
#pragma unroll
    for (int T = 0; T < 4; ++T) { const f32x4 rp = CS_MFMA(cs_lo(cs_tr(slot + CS_ZP, lane, T)), oAr, zero4);
#pragma unroll
        for (int j = 0; j < 4; ++j) Rp[T][j] = rp[j] + bf2f((bf16_t)oR[T >> 1][(T & 1) * 4 + j]); }
#pragma unroll
    for (int kk = 0; kk < 2; ++kk) *(LAS bf16x8*)(slot + CS_RPP + s * 128 + g * 32 + kk * 16) = cs_pack(Rp[2 * kk], Rp[2 * kk + 1]);
}
__device__ __forceinline__ void cs_scan_chunk(const LAS unsigned char* slot, f32x4 (&acc)[4], float* yp  , int d, int q, int wave, int lane) {
    const int s = lane & 15, g = lane >> 4;
    const f32x4 zero4 = (f32x4){0.f, 0.f, 0.f, 0.f};
    bf16x8 Xb[2];
#pragma unroll
    for (int kk = 0; kk < 2; ++kk) { u32x4 w; w.x = cvt_pk_bf16(acc[2 * kk][0], acc[2 * kk][1]); w.y = cvt_pk_bf16(acc[2 * kk][2], acc[2 * kk][3]);
        w.z = cvt_pk_bf16(acc[2 * kk + 1][0], acc[2 * kk + 1][1]); w.w = cvt_pk_bf16(acc[2 * kk + 1][2], acc[2 * kk + 1][3]); Xb[kk] = __builtin_bit_cast(bf16x8, w); }
    const v4i16_t vt = cs_tr(slot + CS_VV, lane, wave);
    const bf16x8 Vb = cs_lo(vt);
    const int arow = s * 128 + g * 32, a16 = s * 64 + g * 16;
    f32x4 UT = CS_MFMA(*(const LAS bf16x8*)(slot + CS_ZP + arow), Xb[0], zero4); UT = CS_MFMA(*(const LAS bf16x8*)(slot + CS_ZP + arow + 16), Xb[1], UT); UT = CS_MFMA(*(const LAS bf16x8*)(slot + CS_MT + a16), Vb, UT);
    f32x4 YT = CS_MFMA(*(const LAS bf16x8*)(slot + CS_RPP + arow), Xb[0], zero4); YT = CS_MFMA(*(const LAS bf16x8*)(slot + CS_RPP + arow + 16), Xb[1], YT); YT = CS_MFMA(*(const LAS bf16x8*)(slot + CS_NT + a16), Vb, YT);
#pragma unroll
    for (int j = 0; j < 4; ++j) yp[(size_t)cs_tt(d, q, 4 * g + j) * 256] = YT[j];
    bf16x8 UV; { u32x2 w; w.x = cvt_pk_bf16(UT[0], UT[1]); w.y = cvt_pk_bf16(UT[2], UT[3]); const v4i16_t ub = __builtin_bit_cast(v4i16_t, w);
        UV[0] = ub[0]; UV[1] = ub[1]; UV[2] = ub[2]; UV[3] = ub[3]; UV[4] = vt[0]; UV[5] = vt[1]; UV[6] = vt[2]; UV[7] = vt[3]; }
#pragma unroll
    for (int T = 0; T < 4; ++T) { const v4i16_t bh = cs_tr(slot + CS_BH, lane, T), kh = cs_tr(slot + CS_KH, lane, T);
        bf16x8 BK; BK[0] = bh[0]; BK[1] = bh[1]; BK[2] = bh[2]; BK[3] = bh[3]; BK[4] = kh[0]; BK[5] = kh[1]; BK[6] = kh[2]; BK[7] = kh[3];
        acc[T] = CS_MFMA(BK, UV, acc[T]);
        acc[T] *= *(const LAS f32x4*)(slot + CS_WC + (16 * T + 4 * g) * 4); }
}
__device__ __forceinline__ void phase_scan(const Frame& F) {
    const f16_t* SH = (const f16_t*)(F.ws + WS_SH); const f16_t* SD = (const f16_t*)(F.ws + WS_SD);
    float* Y = (float*)(F.ws + WS_Y);
    const int lane = F.lane, wave = F.wave;
    for (int chain = F.bid; chain < 64; chain += F.G) {
        const int d = chain >> 5, b = (chain >> 2) & 7, h = chain & 3;
        const f16_t* sh = SH + (size_t)(b * 4 + h) * TT * 192; const f16_t* sd = SD + (size_t)((d * 8 + b) * 4 + h) * TT * 192;
        float* yp = Y + ((size_t)(d * 8 + b) * TT) * 256 + h * 64 + 16 * (wave & 3) + (lane & 15);
        f32x4 acc[4];
#pragma unroll
        for (int T = 0; T < 4; ++T) acc[T] = (f32x4){0.f, 0.f, 0.f, 0.f};
        __syncthreads();
        CsRaw rawA, rawB;
        const int pw = wave - 4;
        constexpr int NR = CS_NCHUNK / 4;
        if (wave >= 4) { cs_load(rawA, sh, sd, d, pw, lane); cs_load(rawB, sh, sd, d, 4 + pw, lane);
            cs_prepass(F.lds + pw * CS_SLOT, F.lds + CS_ZIMG + pw * 2048, rawA, sh, sd, d, 8 + pw, lane); }
        __syncthreads();
        for (int r = 0; r < NR; r += 2) {
            if (wave >= 4) { cs_prepass(F.lds + (4 + pw) * CS_SLOT, F.lds + CS_ZIMG + pw * 2048, rawB, sh, sd, d, (r + 3 < NR) ? 4 * (r + 3) + pw : -1, lane); }
            else {
#pragma unroll 1
                for (int c4 = 0; c4 < 4; ++c4) cs_scan_chunk(F.lds + c4 * CS_SLOT, acc, yp, d, 4 * r + c4, wave, lane);
            }
            asm volatile("s_waitcnt lgkmcnt(0)" ::: "memory"); __builtin_amdgcn_s_barrier(); asm volatile("" ::: "memory");
            if (wave >= 4) { if (r + 2 < NR) cs_prepass(F.lds + pw * CS_SLOT, F.lds + CS_ZIMG + pw * 2048, rawA, sh, sd, d, (r + 4 < NR) ? 4 * (r + 4) + pw : -1, lane); }
            else {
#pragma unroll 1
                for (int c4 = 0; c4 < 4; ++c4) cs_scan_chunk(F.lds + (4 + c4) * CS_SLOT, acc, yp, d, 4 * (r + 1) + c4, wave, lane);
            }
            asm volatile("s_waitcnt lgkmcnt(0)" ::: "memory"); __builtin_amdgcn_s_barrier(); asm volatile("" ::: "memory");
        }
    }
}

__device__ __forceinline__ void phase_rw_post(const Frame& F, const Params& P, int l, int nrows) {
    const bf16_t* PL = (const bf16_t*)(F.ws + WS_PL); bf16_t* MIX = (bf16_t*)(F.ws + WS_MIX);
    const f16_t* SH = (const f16_t*)(F.ws + WS_SH); const f16_t* SD = (const f16_t*)(F.ws + WS_SD); const float* Y = (const float*)(F.ws + WS_Y);
    const int lane = F.lane;
    rw_stage_tables(F, P, l);
    const LAS float* T = (const LAS float*)F.lds;
    for (int item = F.gw; item < NLAT / 16 + ((nrows - NLAT) / 16) * 4; item += F.nw) {
        const int tile = item < NLAT / 16 ? item : NLAT / 16 + ((item - NLAT / 16) >> 2), h0 = item < NLAT / 16 ? 0 : ((item - NLAT / 16) & 3), h1 = item < NLAT / 16 ? 4 : h0 + 1;
        int l1 = lane; asm volatile("" : "+v"(l1)); const int tk = l1 & 15, g = l1 >> 4;
        const int r = tile * 16 + tk; const RowGeo geo = row_geo(r);
        const bool hp = geo.pos > 0, hn = geo.pos < geo.len - 1;
        const bf16_t* prow = PL + (size_t)r * INW + O_RW; const int dprev = hp ? -INW : 0, dnext = hn ? INW : 0;
        bf16x8 sg[2][4];
#pragma unroll
        for (int d = 0; d < 2; ++d) { u32x4 raw[4][3];
#pragma unroll
            for (int kk = 0; kk < 4; ++kk) { const bf16_t* p = prow + 896 + 256 * d + 32 * kk + 8 * g;
                raw[kk][0] = *(const u32x4*)p; raw[kk][1] = *(const u32x4*)(p + dprev); raw[kk][2] = *(const u32x4*)(p + dnext); }
#pragma unroll
            for (int kk = 0; kk < 4; ++kk) { float u[8]; rw_mix8(T, raw[kk], hp, hn, 896 + 256 * d + 32 * kk + 8 * g, u);
#pragma unroll
                for (int q = 0; q < 8; ++q) u[q] = sigmoidf_(u[q]);
                sg[d][kk] = pack8f(u); }
            asm volatile("" ::: "memory"); }
#pragma unroll 1
        for (int h = h0; h < h1; ++h) {
            int l2 = lane; asm volatile("" : "+v"(l2)); const int tk = l2 & 15, g = l2 >> 4;
            const int r = tile * 16 + tk; const RowGeo geo = row_geo(r);
            const size_t shrow = ((size_t)(geo.b * 4 + h) * TT + geo.tt) * 192;
            float out[4][4];
#pragma unroll
            for (int t = 0; t < 4; ++t)
#pragma unroll
                for (int q = 0; q < 4; ++q) out[t][q] = 0.f;
            f16x8 rh[2], vh[2];
#pragma unroll
            for (int u = 0; u < 2; ++u) { rh[u] = *(const f16x8*)(SH + shrow + 32 * u + 8 * g); vh[u] = *(const f16x8*)(SH + shrow + 64 + 32 * u + 8 * g); }
#pragma unroll 1
            for (int d = 0; d < 2; ++d) {
                const bf16_t* g2t = (const bf16_t*)(F.ws + WS_LORA + (size_t)(l * 2 + d) * LORA_LD_BYTES) + 2 * 256 * 64;
                const size_t sdrow = ((size_t)((d * 8 + geo.b) * 4 + h) * TT + geo.tt) * 192;
                const float* yrow = Y + ((size_t)(d * 8 + geo.b) * TT + geo.tt) * 256 + 64 * h + 8 * g;
                bf16x8 sgd[4];
#pragma unroll
                for (int kk = 0; kk < 4; ++kk) sgd[kk] = d ? sg[1][kk] : sg[0][kk];
                f32x4 y[4], gg[4]; f16x8 kdh[2]; bf16x8 gf[4][4];
#pragma unroll
                for (int u = 0; u < 2; ++u) { y[2 * u] = *(const f32x4*)(yrow + 32 * u); y[2 * u + 1] = *(const f32x4*)(yrow + 32 * u + 4); kdh[u] = *(const f16x8*)(SD + sdrow + 64 + 32 * u + 8 * g); }
#pragma unroll
                for (int t = 0; t < 4; ++t) { const bf16_t* gr = g2t + (size_t)(64 * h + 32 * (t >> 1) + 8 * (tk >> 2) + 4 * (t & 1) + (tk & 3)) * 128 + 8 * g;
#pragma unroll
                    for (int kk = 0; kk < 4; ++kk) gf[t][kk] = *(const bf16x8*)(gr + 32 * kk); }
                float sm = 0.f, bs = 0.f;
#pragma unroll
                for (int t = 0; t < 4; ++t) { const int c = 64 * h + 32 * (t >> 1) + 8 * g + 4 * (t & 1);
                    sm += (y[t][0] + y[t][1]) + (y[t][2] + y[t][3]);
                    const f32x4 rk = *(const LAS f32x4*)(T + RL_RK / 4 + c);
#pragma unroll
                    for (int q = 0; q < 4; ++q) bs += (float)rh[t >> 1][(t & 1) * 4 + q] * (float)kdh[t >> 1][(t & 1) * 4 + q] * rk[q];
                    f32x4 a = (f32x4){0.f, 0.f, 0.f, 0.f};
#pragma unroll
                    for (int kk = 0; kk < 4; ++kk) a = __builtin_amdgcn_mfma_f32_16x16x32_bf16(gf[t][kk], sgd[kk], a, 0, 0, 0);
                    gg[t] = a; }
                sm += __shfl_xor(sm, 16); sm += __shfl_xor(sm, 32); bs += __shfl_xor(bs, 16); bs += __shfl_xor(bs, 32);
                const float mu = sm * (1.0f / 64.0f); float vs = 0.f;
#pragma unroll
                for (int t = 0; t < 4; ++t)
#pragma unroll
                    for (int q = 0; q < 4; ++q) { const float dd = y[t][q] - mu; vs += dd * dd; }
                vs += __shfl_xor(vs, 16); vs += __shfl_xor(vs, 32);
                const float rstd = rsqrtf(vs * (1.0f / 64.0f) + 64e-5f);
#pragma unroll
                for (int t = 0; t < 4; ++t) { const int c = 64 * h + 32 * (t >> 1) + 8 * g + 4 * (t & 1);
                    const f32x4 gng = *(const LAS f32x4*)(T + RL_GNG / 4 + c), gnb = *(const LAS f32x4*)(T + RL_GNB / 4 + c);
#pragma unroll
                    for (int q = 0; q < 4; ++q) out[t][q] += ((y[t][q] - mu) * rstd * gng[q] + gnb[q] + bs * (float)vh[t >> 1][(t & 1) * 4 + q]) * gg[t][q]; }
                asm volatile("" ::: "memory");
            }
#pragma unroll
            for (int u = 0; u < 2; ++u) { u32x4 w; w.x = cvt_pk_bf16(out[2 * u][0], out[2 * u][1]); w.y = cvt_pk_bf16(out[2 * u][2], out[2 * u][3]); w.z = cvt_pk_bf16(out[2 * u + 1][0], out[2 * u + 1][1]); w.w = cvt_pk_bf16(out[2 * u + 1][2], out[2 * u + 1][3]);
                *(u32x4*)(MIX + (size_t)r * D + 512 + 64 * h + 32 * u + 8 * g) = w; }
        }
    }
    __syncthreads();
}

constexpr int CV_SEG = 64, CV_ROWS = CV_SEG + 30, CV_H = 0, CV_W = CV_ROWS * 256 * 4;
__device__ __forceinline__ void phase_conv(const Frame& F, const Params& P, int l, int nrows) {
    const bf16_t* PL = (const bf16_t*)(F.ws + WS_PL); bf16_t* MIX = (bf16_t*)(F.ws + WS_MIX);
    const int lane = F.lane, c4 = lane * 4, wave = F.wave;
    LAS float* H = (LAS float*)(F.lds + CV_H); LAS float* W = (LAS float*)(F.lds + CV_W);
    for (int i = F.tid; i < 31 * 256; i += NTHREADS) W[i] = P.in[I_DWW][(size_t)l * 31 * 256 + i];
    const f32x4 dwb = *(const f32x4*)(P.in[I_DWB] + l * 256 + c4), lng = *(const f32x4*)(P.in[I_LNG] + l * 256 + c4), lnb = *(const f32x4*)(P.in[I_LNB] + l * 256 + c4);
    for (int seg = F.bid; seg < nrows / CV_SEG; seg += F.G) {
        const int r0 = seg * CV_SEG; const RowGeo g0 = row_geo(r0);
        __syncthreads();
#pragma unroll 4
        for (int k = 0; k < 12; ++k) { const int rr = wave + 8 * k;
            if (rr < CV_ROWS) { const int pos = g0.pos - 15 + rr; f32x4 hv = (f32x4){0.f, 0.f, 0.f, 0.f};
                if (pos >= 0 && pos < g0.len) { const bf16_t* p = PL + (size_t)(r0 - 15 + rr) * INW + O_CV + c4; float a[4], bb[4];
                    unpack4(*(const u32x2*)p, a); unpack4(*(const u32x2*)(p + 256), bb);
#pragma unroll
                    for (int q = 0; q < 4; ++q) hv[q] = a[q] * sigmoidf_(bb[q]); }
                *(LAS f32x4*)(H + rr * 256 + c4) = hv; } }
        __syncthreads();
        f32x4 acc[8];
#pragma unroll
        for (int t = 0; t < 8; ++t) acc[t] = dwb;
#pragma unroll 1
        for (int j = 0; j < 31; ++j) { const f32x4 w = *(const LAS f32x4*)(W + j * 256 + c4);
#pragma unroll
            for (int t = 0; t < 8; ++t) acc[t] += *(const LAS f32x4*)(H + (wave * 8 + t + j) * 256 + c4) * w; }
#pragma unroll
        for (int t = 0; t < 8; ++t) {
            const float mu = wave_sum((acc[t][0] + acc[t][1]) + (acc[t][2] + acc[t][3])) * (1.0f / 256.0f);
            float vs = 0.f;
#pragma unroll
            for (int q = 0; q < 4; ++q) { const float dd = acc[t][q] - mu; vs += dd * dd; }
            const float rstd = rsqrtf(wave_sum(vs) * (1.0f / 256.0f) + 1e-5f);
            float o[4];
#pragma unroll
            for (int q = 0; q < 4; ++q) o[q] = siluf_((acc[t][q] - mu) * rstd * lng[q] + lnb[q]);
            u32x2 w; w.x = pk_bf16(o[0], o[1]); w.y = pk_bf16(o[2], o[3]);
            *(u32x2*)(MIX + (size_t)(r0 + wave * 8 + t) * D + 768 + c4) = w; }
    }
}

__device__ __forceinline__ void phase_na_simple(const Frame& F, const Params& P, int l, int nq) {
    const bf16_t* PL = (const bf16_t*)(F.ws + WS_PL); bf16_t* MIX = (bf16_t*)(F.ws + WS_MIX);
    const float* rpb = P.in[I_RPB] + (size_t)l * 8 * 15 * 31;
    int tid_ = F.tid; asm volatile("" : "+v"(tid_));
    for (int gid = F.bid * NTHREADS + tid_; gid < nq * 8; gid += F.G * NTHREADS) {
        const int r = gid >> 3, h = gid & 7;
        const RowGeo g = row_geo(r);
        float q[64], o[64];
        { const bf16_t* qp = PL + (size_t)r * INW + O_Q + h * 64;
#pragma unroll
          for (int i = 0; i < 8; ++i) unpack8(*(const u32x4*)(qp + i * 8), q + i * 8); }
#pragma unroll
        for (int i = 0; i < 64; ++i) o[i] = 0.f;
        float m = -3.0e38f, lsum = 0.f;
        const bool lat = r < NLAT;
        const int gi = g.pos >> 6, gc = g.pos & 63;
        const int rs = min(max(gi - 4, 0), 56), wsc = min(max(gc - 8, 0), 48);
        const int nkey = lat ? 384 : 256;
#pragma unroll 1
        for (int kx = 0; kx < nkey; ++kx) {
            const bool win = lat && kx < 128;
            int krow; float bias = 0.f;
            if (win) { const int r8 = kx >> 4, cc = kx & 15; krow = g.b * SEQ + (rs + r8) * 64 + wsc + cc; bias = rpb[(h * 15 + (rs + r8 - gi + 7)) * 31 + (wsc + cc - gc + 15)]; }
            else krow = NLAT + g.b * CTXL + (kx - (lat ? 128 : 0));
            const bf16_t* kp = PL + (size_t)krow * INW + O_K + h * 64; float a = bias;
#pragma unroll
            for (int i = 0; i < 8; ++i) { float kf[8]; unpack8(*(const u32x4*)(kp + i * 8), kf);
#pragma unroll
                for (int j = 0; j < 8; ++j) a += q[i * 8 + j] * kf[j]; }
            if (a > m) { const float alpha = __expf(m - a); lsum *= alpha;
#pragma unroll
                for (int i = 0; i < 64; ++i) o[i] *= alpha;
                m = a; }
            const float p = __expf(a - m); lsum += p;
            const bf16_t* vp = kp + (O_V - O_K);
#pragma unroll
            for (int i = 0; i < 8; ++i) { float vf[8]; unpack8(*(const u32x4*)(vp + i * 8), vf);
#pragma unroll
                for (int j = 0; j < 8; ++j) o[i * 8 + j] += p * vf[j]; }
        }
        const float inv = 1.0f / lsum;
        bf16_t* op = MIX + (size_t)r * D + h * 64;
#pragma unroll
        for (int i = 0; i < 8; ++i) { u32x4 w; w.x = pk_bf16(o[i * 8] * inv, o[i * 8 + 1] * inv); w.y = pk_bf16(o[i * 8 + 2] * inv, o[i * 8 + 3] * inv);
            w.z = pk_bf16(o[i * 8 + 4] * inv, o[i * 8 + 5] * inv); w.w = pk_bf16(o[i * 8 + 6] * inv, o[i * 8 + 7] * inv); *(u32x4*)(op + i * 8) = w; }
    }
}

constexpr int NA_CK = 0, NA_CV = 32768, NA_RPB = 65536, NA_WV = 81920;
__device__ __forceinline__ bf16x8 na_pack8(const f32x4& a, const f32x4& b) {
    u32x4 w; w.x = cvt_pk_bf16(a[0], a[1]); w.y = cvt_pk_bf16(a[2], a[3]); w.z = cvt_pk_bf16(b[0], b[1]); w.w = cvt_pk_bf16(b[2], b[3]); return __builtin_bit_cast(bf16x8, w);
}
__device__ __forceinline__ bf16x8 na_vfrag(LAS unsigned char* blk, int lane, int dt) {
    const int g = lane >> 4, qq = (lane & 15) >> 2, p = lane & 3;
    const int r0 = 4 * g + qq, r1 = 16 + 4 * g + qq;
    const v4i16_t lo = __builtin_amdgcn_ds_read_tr16_b64_v4i16((LAS v4i16_t*)(blk + r0 * 128 + ((dt ^ ((r0 >> 1) & 3)) * 32) + p * 8));
    const v4i16_t hi = __builtin_amdgcn_ds_read_tr16_b64_v4i16((LAS v4i16_t*)(blk + r1 * 128 + ((dt ^ ((r1 >> 1) & 3)) * 32) + p * 8));
    bf16x8 r; r[0] = lo[0]; r[1] = lo[1]; r[2] = lo[2]; r[3] = lo[3]; r[4] = hi[0]; r[5] = hi[1]; r[6] = hi[2]; r[7] = hi[3]; return r;
}
template <bool WINDOW>
__device__ __forceinline__ void na_item(const Frame& F, const bf16_t* PL, bf16_t* MIX, int b, int h, int qrow0  , int gi, int cb) {
    const int lane = F.lane, ql = lane & 15, g = lane >> 4;
    LAS unsigned char* CK = F.lds + NA_CK; LAS unsigned char* CV = F.lds + NA_CV; const LAS float* RPB = (const LAS float*)(F.lds + NA_RPB);
    LAS unsigned char* WV = F.lds + NA_WV + F.wave * 4096;
    bf16x8 Qf[2];
    { const bf16_t* qp = PL + (size_t)(qrow0 + ql) * INW + O_Q + h * 64 + 8 * g; Qf[0] = *(const bf16x8*)qp; Qf[1] = *(const bf16x8*)(qp + 32); }
    f32x4 acc[4];
#pragma unroll
    for (int dt = 0; dt < 4; ++dt) acc[dt] = (f32x4){0.f, 0.f, 0.f, 0.f};
    float m_run = -3.0e38f, l_run = 0.f;
    if constexpr (WINDOW) {
        const int rs = min(max(gi - 4, 0), 56), kc0 = min(max(16 * cb - 8, 0), 32), qcol = 16 * cb + ql, wsq = min(max(qcol - 8, 0), 48);
        const size_t krow0 = (size_t)b * SEQ + (size_t)rs * 64 + kc0;
        f32x4 s[16];
#pragma unroll
        for (int t = 0; t < 16; ++t) { const bf16_t* kp = PL + (krow0 + (size_t)(t >> 1) * 64 + (t & 1) * 16 + ql) * INW + O_K + h * 64 + 8 * g;
            const bf16x8 k0 = *(const bf16x8*)kp, k1 = *(const bf16x8*)(kp + 32);
            s[t] = __builtin_amdgcn_mfma_f32_16x16x32_bf16(k0, Qf[0], (f32x4){0.f, 0.f, 0.f, 0.f}, 0, 0, 0);
            s[t] = __builtin_amdgcn_mfma_f32_16x16x32_bf16(k1, Qf[1], s[t], 0, 0, 0); }
        float mx = -3.0e38f;
#pragma unroll
        for (int t = 0; t < 16; ++t) { const LAS float* bp = RPB + (h * 15 + (rs + (t >> 1) - gi + 7)) * 31 + 15 - qcol;
#pragma unroll
            for (int j = 0; j < 4; ++j) { const int kcol = kc0 + (t & 1) * 16 + 4 * g + j; const bool ok = kcol >= wsq && kcol < wsq + 16;
                const float v = ok ? s[t][j] + bp[ok ? kcol : qcol] : -INFINITY; s[t][j] = v; mx = fmaxf(mx, v); } }
        mx = fmaxf(mx, __shfl_xor(mx, 16)); mx = fmaxf(mx, __shfl_xor(mx, 32));
        m_run = mx;
        float ls = 0.f;
#pragma unroll
        for (int t = 0; t < 16; ++t)
#pragma unroll
            for (int j = 0; j < 4; ++j) { const float p = __expf(s[t][j] - mx); s[t][j] = p; ls += p; }
        l_run = ls;
#pragma unroll
        for (int r8 = 0; r8 < 8; ++r8) {
            { const int vr = lane >> 1, part = lane & 1;
              const bf16_t* vp = PL + (krow0 + (size_t)r8 * 64 + vr) * INW + O_V + h * 64 + part * 32;
              u32x4 v0 = *(const u32x4*)vp, v1 = *(const u32x4*)(vp + 8), v2 = *(const u32x4*)(vp + 16), v3 = *(const u32x4*)(vp + 24);
              LAS unsigned char* wr = WV + vr * 128; const int sw = (vr >> 1) & 3;
              *(LAS u32x4*)(wr + (((2 * part) ^ sw) * 32)) = v0; *(LAS u32x4*)(wr + (((2 * part) ^ sw) * 32) + 16) = v1;
              *(LAS u32x4*)(wr + (((2 * part + 1) ^ sw) * 32)) = v2; *(LAS u32x4*)(wr + (((2 * part + 1) ^ sw) * 32) + 16) = v3; }
            __builtin_amdgcn_wave_barrier(); asm volatile("" ::: "memory");
            const bf16x8 pf = na_pack8(s[2 * r8], s[2 * r8 + 1]);
#pragma unroll
            for (int dt = 0; dt < 4; ++dt) { const bf16x8 vf = na_vfrag(WV, lane, dt); acc[dt] = __builtin_amdgcn_mfma_f32_16x16x32_bf16(vf, pf, acc[dt], 0, 0, 0); }
            __builtin_amdgcn_wave_barrier(); asm volatile("" ::: "memory");
        }
    }
    {
        f32x4 s[16];
#pragma unroll
        for (int t = 0; t < 16; ++t) { const int key = 16 * t + ql; const LAS unsigned char* kr = CK + key * 128;
            const bf16x8 k0 = *(const LAS bf16x8*)(kr + ((g ^ (key & 7)) * 16)), k1 = *(const LAS bf16x8*)(kr + (((g + 4) ^ (key & 7)) * 16));
            s[t] = __builtin_amdgcn_mfma_f32_16x16x32_bf16(k0, Qf[0], (f32x4){0.f, 0.f, 0.f, 0.f}, 0, 0, 0);
            s[t] = __builtin_amdgcn_mfma_f32_16x16x32_bf16(k1, Qf[1], s[t], 0, 0, 0); }
        float mx = m_run;
#pragma unroll
        for (int t = 0; t < 16; ++t)
#pragma unroll
            for (int j = 0; j < 4; ++j) mx = fmaxf(mx, s[t][j]);
        mx = fmaxf(mx, __shfl_xor(mx, 16)); mx = fmaxf(mx, __shfl_xor(mx, 32));
        const float alpha = __expf(m_run - mx);
        float ls = l_run * alpha;
#pragma unroll
        for (int dt = 0; dt < 4; ++dt) acc[dt] *= alpha;
#pragma unroll
        for (int t = 0; t < 16; ++t)
#pragma unroll
            for (int j = 0; j < 4; ++j) { const float p = __expf(s[t][j] - mx); s[t][j] = p; ls += p; }
        l_run = ls;
#pragma unroll
        for (int blk = 0; blk < 8; ++blk) { const bf16x8 pf = na_pack8(s[2 * blk], s[2 * blk + 1]);
#pragma unroll
            for (int dt = 0; dt < 4; ++dt) { const bf16x8 vf = na_vfrag(CV + blk * 4096, lane, dt); acc[dt] = __builtin_amdgcn_mfma_f32_16x16x32_bf16(vf, pf, acc[dt], 0, 0, 0); } }
    }
    float lt = l_run; lt += __shfl_xor(lt, 16); lt += __shfl_xor(lt, 32);
    const float inv = 1.0f / lt;
    bf16_t* op = MIX + (size_t)(qrow0 + ql) * D + h * 64 + 4 * g;
#pragma unroll
    for (int dt = 0; dt < 4; ++dt) { u32x2 w; w.x = cvt_pk_bf16(acc[dt][0] * inv, acc[dt][1] * inv); w.y = cvt_pk_bf16(acc[dt][2] * inv, acc[dt][3] * inv); *(u32x2*)(op + dt * 16) = w; }
}
__device__ __forceinline__ void phase_na_mfma(const Frame& F, const Params& P, int l, bool ctx_queries) {
    const bf16_t* PL = (const bf16_t*)(F.ws + WS_PL); bf16_t* MIX = (bf16_t*)(F.ws + WS_MIX);
    int tid_ = F.tid; asm volatile("" : "+v"(tid_));
    const int tid = tid_;
    { const float* rpb = P.in[I_RPB] + (size_t)l * 8 * 15 * 31; LAS float* R = (LAS float*)(F.lds + NA_RPB); for (int i = tid; i < 8 * 15 * 31; i += NTHREADS) R[i] = rpb[i]; }
    for (int unit = F.bid; unit < 256; unit += F.G) {
        const int quarter = unit & 3, h = (unit >> 2) & 7, b = unit >> 5;
        __syncthreads();
        { int t2 = tid; asm volatile("" : "+v"(t2)); const int key = t2 >> 1, part = t2 & 1; const bf16_t* kp = PL + (size_t)(NLAT + b * CTXL + key) * INW + O_K + h * 64 + part * 32; const bf16_t* vp = kp + (O_V - O_K);
          LAS unsigned char* kr = F.lds + NA_CK + key * 128; LAS unsigned char* vr = F.lds + NA_CV + key * 128; const int sw = (key >> 1) & 3;
#pragma unroll
          for (int c = 0; c < 4; ++c) { *(LAS u32x4*)(kr + (((4 * part + c) ^ (key & 7)) * 16)) = *(const u32x4*)(kp + 8 * c);
              const int c16 = 4 * part + c; *(LAS u32x4*)(vr + (((c16 >> 1) ^ sw) * 32) + (c16 & 1) * 16) = *(const u32x4*)(vp + 8 * c); } }
        __syncthreads();
        for (int it = F.wave; it < 64; it += NWAVES) { const int gi = quarter * 16 + (it >> 2), cb = it & 3;
            na_item<true>(F, PL, MIX, b, h, b * SEQ + gi * 64 + cb * 16, gi, cb); }
        if (ctx_queries && F.wave < 4) na_item<false>(F, PL, MIX, b, h, NLAT + b * CTXL + (quarter * 4 + F.wave) * 16, 0, 0);
    }
}

__device__ __forceinline__ void phase_final(const Frame& F, const Params& P) {
    float* out = P.out; const float* g = P.in[I_FINALG]; const int lane = F.lane;
    for (int r = F.gw; r < NLAT; r += F.nw) {
        float* xr = out + (size_t)r * D; f32x4 x[4]; float ss = 0.f;
#pragma unroll
        for (int j = 0; j < 4; ++j) { x[j] = *(const f32x4*)(xr + j * 256 + lane * 4); ss += x[j][0] * x[j][0] + x[j][1] * x[j][1] + x[j][2] * x[j][2] + x[j][3] * x[j][3]; }
        ss = wave_sum(ss); const float rstd = rsqrtf(ss * (1.0f / D) + 1e-6f);
#pragma unroll
        for (int j = 0; j < 4; ++j) { const f32x4 gg = *(const f32x4*)(g + j * 256 + lane * 4); *(f32x4*)(xr + j * 256 + lane * 4) = x[j] * rstd * gg; }
    }
}

constexpr int PH_L0 = 1, PH_PER_L0 = 9, PH_L1 = PH_L0 + PH_PER_L0, PH_PER_L1 = 12, PH_FINAL = PH_L1 + PH_PER_L1, N_PHASES = PH_FINAL + 1;
#define RFL(x) __builtin_amdgcn_readfirstlane(x)

PHASE ph_prologue(const void* kp_, int wv_) { PHASE_ENTER; if constexpr (MKB(0)) phase_prologue(F, P); }
PHASE ph_norm1(const void* kp_, int wv_, int l_) { PHASE_ENTER; const int l = RFL(l_);
    if constexpr (MKB(1)) phase_norm<false>(F, P, l, 0, NROW, l == 0 ? P.in[I_X] : P.out, l == 0 ? P.in[I_CTX] : (const float*)(F.ws + WS_XC)); }
PHASE_INL ph_gemm_win(const void* kp_, int wv_, int l_) { PHASE_ENTER; const int l = RFL(l_);
    pg8::DenseSched S; S.init(NROW / 256, INW / 256, F.G, F.bid); S.A = (const bf16_t*)(F.ws + WS_HL); S.Bt = (const bf16_t*)(F.ws + WS_BTIN) + (size_t)l * INW * D; S.K = D;
    pg8::EpiBf16 E{(bf16_t*)(F.ws + WS_PL), INW, 2, 0.125f};
    if constexpr (MKB(2)) pg8::gemm_phase<pg8::EpiBf16, pg8::DenseSched, false>(F.lds, D, S, E, F.wave); }
PHASE_INL ph_rw_prep(const void* kp_, int wv_, int l_) { PHASE_ENTER; const int l = RFL(l_); if constexpr (MKB(3)) phase_rw_prep(F, P, l); }
PHASE ph_conv(const void* kp_, int wv_, int l_, int bid_, int G_) { PHASE_ENTER; const int l = RFL(l_); if constexpr (MKB(4)) phase_conv(sub_frame(F, RFL(bid_), RFL(G_)), P, l, l == 0 ? NROW : NLAT); }
PHASE_INL ph_na(const void* kp_, int wv_, int l_, int bid_, int G_) { PHASE_ENTER; const int l = RFL(l_); if constexpr (MKB(5)) phase_na_mfma(sub_frame(F, RFL(bid_), RFL(G_)), P, l, l == 0); }
PHASE_INL ph_scan(const void* kp_, int wv_, int bid_, int G_) { PHASE_ENTER; if constexpr (MKB(6)) phase_scan(sub_frame(F, RFL(bid_), RFL(G_))); }
PHASE_INL ph_rw_post(const void* kp_, int wv_, int l_) { PHASE_ENTER; const int l = RFL(l_); if constexpr (MKB(7)) phase_rw_post(F, P, l, l == 0 ? NROW : NLAT); }
PHASE_INL ph_gemm_wout(const void* kp_, int wv_, int l_) { PHASE_ENTER; const int l = RFL(l_);
    float* XC = (float*)(F.ws + WS_XC);
    pg8::DenseSched S; S.init((l == 0 ? NROW : NLAT) / 256, D / 256, F.G, F.bid); S.A = (const bf16_t*)(F.ws + WS_MIX); S.Bt = (const bf16_t*)(F.ws + WS_BTOUT) + (size_t)l * D * D; S.K = D;
    pg8::EpiRes E{l == 0 ? P.in[I_X] : P.out, l == 0 ? P.in[I_CTX] : XC, P.out, XC, (const float*)(F.ws + WS_MODV) + (size_t)l * 9 * MODW + 2 * D};
    if constexpr (MKB(8)) pg8::gemm_phase<pg8::EpiRes, pg8::DenseSched, false>(F.lds, D, S, E, F.wave); }
PHASE ph_norm2_l0(const void* kp_, int wv_) { PHASE_ENTER; if constexpr (MKB(9)) phase_norm<false>(F, P, 0, 1, NROW, P.out, (const float*)(F.ws + WS_XC)); }
PHASE_INL ph_gemm_ffn_gu(const void* kp_, int wv_) { PHASE_ENTER;
    pg8::DenseSched S; S.init(NROW / 256, (2 * DFF) / 256, F.G, F.bid); S.A = (const bf16_t*)(F.ws + WS_HL); S.Bt = (const bf16_t*)(F.ws + WS_BTGU); S.K = D;
    pg8::EpiSwiGLU E{(bf16_t*)(F.ws + WS_H), DFF};
    if constexpr (MKB(10)) pg8::gemm_phase<pg8::EpiSwiGLU, pg8::DenseSched, false>(F.lds, D, S, E, F.wave); }
PHASE_INL ph_gemm_ffn_dn(const void* kp_, int wv_) { PHASE_ENTER;
    float* XC = (float*)(F.ws + WS_XC);
    pg8::DenseSched S; S.init(NROW / 256, D / 256, F.G, F.bid); S.A = (const bf16_t*)(F.ws + WS_H); S.Bt = (const bf16_t*)(F.ws + WS_BTDN); S.K = DFF;
    pg8::EpiRes E{P.out, XC, P.out, XC, (const float*)(F.ws + WS_MODV) + 5 * D};
    if constexpr (MKB(11)) pg8::gemm_phase<pg8::EpiRes, pg8::DenseSched, false>(F.lds, DFF, S, E, F.wave); }
PHASE ph_norm2_l1(const void* kp_, int wv_) { PHASE_ENTER; if constexpr (MKB(12)) phase_norm<true>(F, P, 1, 1, NLAT, P.out, (const float*)(F.ws + WS_XC)); }
PHASE ph_moe_prep(const void* kp_, int wv_) { PHASE_ENTER; if constexpr (MKB(13)) { phase_moe_rowmap(F); phase_moe_convert(F, P); } }
PHASE_INL ph_gemm_moe_gu(const void* kp_, int wv_, int pass_) { PHASE_ENTER; const int pass = RFL(pass_);
    pg8::MoeSched S; moe_tstart(F, pass, S.tstart); S.init(S.tstart[8], (2 * DFE) / 256, F.G, F.bid);
    S.A = (const bf16_t*)(F.ws + WS_HL); S.Bt0 = F.ws + WS_MOE; S.e_stride = MOE_E_BYTES; S.K = D; S.rowmap = (const int*)(F.ws + WS_ROUTE + RT_RMAP) + pass * NROW;
    pg8::EpiSwiGLU E{(bf16_t*)(F.ws + WS_H), DFE};
    if constexpr (MKB(14)) pg8::gemm_phase<pg8::EpiSwiGLU, pg8::MoeSched, true>(F.lds, D, S, E, F.wave); }
PHASE_INL ph_gemm_moe_dn(const void* kp_, int wv_, int pass_) { PHASE_ENTER; const int pass = RFL(pass_);
    pg8::MoeSched S; moe_tstart(F, pass, S.tstart); S.init(S.tstart[8], D / 256, F.G, F.bid);
    S.A = (const bf16_t*)(F.ws + WS_H); S.Bt0 = F.ws + WS_MOE + MOE_GU_BYTES; S.e_stride = MOE_E_BYTES; S.K = DFE; S.rowmap = nullptr;
    pg8::EpiMoeDown E{P.out, (const float*)(F.ws + WS_MODV) + (size_t)9 * MODW + 5 * D, (const int*)(F.ws + WS_ROUTE + RT_RMAP) + pass * NROW, (const float*)(F.ws + WS_ROUTE + RT_SGATE) + pass * NROW};
    if constexpr (MKB(15)) pg8::gemm_phase<pg8::EpiMoeDown, pg8::MoeSched, false>(F.lds, DFE, S, E, F.wave); }
PHASE ph_final(const void* kp_, int wv_) { PHASE_ENTER; if constexpr (MKB(16)) phase_final(F, P); }

static __attribute__((noinline)) __device__ void grid_barrier(const void* bar_, unsigned x_, int wv_) {
    const unsigned long long v = (unsigned long long)bar_;
    const unsigned lo = __builtin_amdgcn_readfirstlane((unsigned)v), hi = __builtin_amdgcn_readfirstlane((unsigned)(v >> 32));
    XcdBarrier b; b.bar = (unsigned*)(((unsigned long long)hi << 32) | lo); b.x = __builtin_amdgcn_readfirstlane(x_);
    b.st = (volatile LAS unsigned*)((LAS unsigned char*)lds_raw + LDS_MISC);
    xcd_barrier(b, __builtin_amdgcn_readfirstlane(wv_) * 64 + lane_id());
}
__device__ __forceinline__ bool ph_in(int lo, int hi, int k) { asm volatile("" : "+s"(lo), "+s"(hi)); return lo <= k && k < hi; }

__global__ void __launch_bounds__(NTHREADS, 2) mk_fwd(Params P) {
    const void* kp = (const void*)__builtin_amdgcn_kernarg_segment_ptr();
    LAS unsigned char* lds = (LAS unsigned char*)lds_raw;
    volatile LAS unsigned* misc = (volatile LAS unsigned*)(lds + LDS_MISC);
    const int wv = __builtin_amdgcn_readfirstlane((int)(threadIdx.x >> 6));
    if (wv == 0 && lane_id() < 4) misc[lane_id()] = 0u;
    __syncthreads();
    const int lo = P.ph_lo, hi = P.ph_hi;
    XcdBarrier bar; bar.bar = (unsigned*)(P.ws + WS_CTL) + CW_BAR; bar.x = 0; bar.st = misc;
    if (hi - lo > 1) bar = xcd_barrier_post((unsigned*)(P.ws + WS_CTL) + CW_BAR, misc, wv * 64 + lane_id());
#define IN(k) ph_in(lo, hi, (k))
#define SEAM(k) do { if (IN((k) + 1)) grid_barrier((const void*)bar.bar, bar.x, wv); } while (0)
    if (IN(0)) { for (int rep = 0; rep < REP_PRO; ++rep) ph_prologue(kp, wv); SEAM(0); }
#define LAYER_COMMON(l, pb) \
    if (IN((pb) + 0)) { for (int rep = 0; rep < REP_NORM; ++rep) ph_norm1(kp, wv, (l)); SEAM((pb) + 0); } \
    if (IN((pb) + 1)) { for (int rep = 0; rep < REP_GEMM; ++rep) ph_gemm_win(kp, wv, (l)); SEAM((pb) + 1); } \
    if (IN((pb) + 2)) { for (int rep = 0; rep < REP_PP; ++rep) ph_rw_prep(kp, wv, (l)); SEAM((pb) + 2); } \
    if (IN((pb) + 3)) { const int bx = (int)blockIdx.x, Gx = (int)gridDim.x; \
        if (Gx == 256) { if (bx < 64) { for (int rep = 0; rep < REP_SCAN; ++rep) ph_scan(kp, wv, bx, 64); } \
            else { for (int rep = 0; rep < REP_CONV; ++rep) ph_conv(kp, wv, (l), bx - 64, 192); for (int rep = 0; rep < REP_NA; ++rep) ph_na(kp, wv, (l), bx - 64, 192); } } \
        else { ph_conv(kp, wv, (l), bx, Gx); ph_na(kp, wv, (l), bx, Gx); ph_scan(kp, wv, bx, Gx); } SEAM((pb) + 3); } \
    if (IN((pb) + 4)) { for (int rep = 0; rep < REP_POST; ++rep) ph_rw_post(kp, wv, (l)); SEAM((pb) + 4); } \
    if (IN((pb) + 5)) { ph_gemm_wout(kp, wv, (l)); SEAM((pb) + 5); }
    LAYER_COMMON(0, PH_L0)
    if (IN(PH_L0 + 6)) { ph_norm2_l0(kp, wv); SEAM(PH_L0 + 6); }
    if (IN(PH_L0 + 7)) { for (int rep = 0; rep < REP_GEMM; ++rep) ph_gemm_ffn_gu(kp, wv); SEAM(PH_L0 + 7); }
    if (IN(PH_L0 + 8)) { ph_gemm_ffn_dn(kp, wv); SEAM(PH_L0 + 8); }
    LAYER_COMMON(1, PH_L1)
    if (IN(PH_L1 + 6)) { ph_norm2_l1(kp, wv); SEAM(PH_L1 + 6); }
    if (IN(PH_L1 + 7)) { for (int rep = 0; rep < REP_PRO; ++rep) ph_moe_prep(kp, wv); SEAM(PH_L1 + 7); }
#pragma unroll 1
    for (int pass = 0; pass < 2; ++pass) {
        if (IN(PH_L1 + 8 + 2 * pass)) { for (int rep = 0; rep < REP_GEMM; ++rep) ph_gemm_moe_gu(kp, wv, pass); SEAM(PH_L1 + 8 + 2 * pass); }
        if (IN(PH_L1 + 9 + 2 * pass)) { ph_gemm_moe_dn(kp, wv, pass); SEAM(PH_L1 + 9 + 2 * pass); }
    }
#undef LAYER_COMMON
    if (IN(PH_FINAL)) ph_final(kp, wv);
#undef IN
#undef SEAM
}

extern "C" void kernel_launch(void* const* d_in, const int* in_sizes, int n_in, void* d_out, int out_size, void* d_ws, size_t ws_size, hipStream_t stream) {
    static int grid = 0;
    if (grid == 0) {
        if (n_in != 35 || out_size != NLAT * D || ws_size < WS_END) { fprintf(stderr, "kernel_launch: unexpected shapes (n_in %d out %d ws %zu need %zu)\n", n_in, out_size, ws_size, (size_t)WS_END); grid = -1; return; }
        int dev = 0, cus = 0, per_cu = 0;
        if (hipGetDevice(&dev) != hipSuccess || hipDeviceGetAttribute(&cus, hipDeviceAttributeMultiprocessorCount, dev) != hipSuccess) { grid = -1; return; }
        if (hipFuncSetAttribute((const void*)mk_fwd, hipFuncAttributeMaxDynamicSharedMemorySize, LDS_BYTES) != hipSuccess) { fprintf(stderr, "kernel_launch: hipFuncSetAttribute failed\n"); grid = -1; return; }
        if (hipOccupancyMaxActiveBlocksPerMultiprocessor(&per_cu, (const void*)mk_fwd, NTHREADS, LDS_BYTES) != hipSuccess || per_cu < 1) { fprintf(stderr, "kernel_launch: occupancy query says %d\n", per_cu); (void)hipGetLastError(); }
        grid = cus;
    }
    if (grid < 0) return;
    (void)hipMemsetAsync((char*)d_ws + WS_CTL, 0, CTL_BYTES, stream);
    Params p{};
    for (int i = 0; i < 35; ++i) p.in[i] = (const float*)d_in[i];
    p.out = (float*)d_out; p.ws = (unsigned char*)d_ws;
#if MK_ONE_LAUNCH
    p.ph_lo = 0; p.ph_hi = N_PHASES;
    hipLaunchKernelGGL(mk_fwd, dim3(grid), dim3(NTHREADS), LDS_BYTES, stream, p);
#else
    for (int k = 0; k < N_PHASES && k <= MK_LAST; ++k) { p.ph_lo = k; p.ph_hi = k + 1; hipLaunchKernelGGL(mk_fwd, dim3(grid), dim3(NTHREADS), LDS_BYTES, stream, p); }
#endif
}
```

```cpp
#include <hip/hip_runtime.h>
#include <stdint.h>
#include <stdio.h>

#ifndef MK_MASK
#define MK_MASK 0xFFFFFFFFu
#endif
#define MKB(k) (((MK_MASK) >> (k)) & 1u)
#ifndef REP_SCAN
#define REP_SCAN 1
#endif
#ifndef REP_NA
#define REP_NA 1
#endif
#ifndef REP_GEMM
#define REP_GEMM 1
#endif
#ifndef REP_PP
#define REP_PP 1
#endif
#ifndef REP_POST
#define REP_POST 1
#endif
#ifndef REP_CONV
#define REP_CONV 1
#endif
#ifndef REP_NORM
#define REP_NORM 1
#endif
#ifndef REP_PRO
#define REP_PRO 1
#endif
#ifndef MK_LAST
#define MK_LAST 99
#endif
#ifndef MK_ONE_LAUNCH
#define MK_ONE_LAUNCH 1
#endif

#define LAS __attribute__((address_space(3)))
typedef unsigned short bf16_t;
typedef _Float16 f16_t;
typedef short bf16x8 __attribute__((ext_vector_type(8)));
typedef float f32x4 __attribute__((ext_vector_type(4)));
typedef float f32x2 __attribute__((ext_vector_type(2)));
typedef unsigned u32x4 __attribute__((ext_vector_type(4)));
typedef unsigned u32x2 __attribute__((ext_vector_type(2)));
typedef f16_t f16x4 __attribute__((ext_vector_type(4)));
typedef f16_t f16x8 __attribute__((ext_vector_type(8)));
typedef short v4i16_t __attribute__((ext_vector_type(4)));

constexpr int D = 1024, NB = 8, SEQ = 4096, CTXL = 256, TT = CTXL + SEQ;
constexpr int NLAT = NB * SEQ, NCTX = NB * CTXL, NROW = NLAT + NCTX;
constexpr int INW = 3328, DFF = 2816, DFE = 3584, NEXP = 8;
constexpr int O_Q = 0, O_K = 512, O_V = 1024, O_RW = 1536, O_CV = 2816;
constexpr int MODW = 6 * D;
constexpr int NTHREADS = 512, NWAVES = 8;
constexpr int LDS_BYTES = 160 * 1024;
constexpr int LDS_MISC = LDS_BYTES - 256;

constexpr size_t al256(size_t x) { return (x + 255) & ~(size_t)255; }
constexpr size_t WS_CTL   = 0;
constexpr size_t CTL_BYTES = 65536;
constexpr size_t WS_MODV  = WS_CTL + CTL_BYTES;
constexpr size_t WS_BTIN  = al256(WS_MODV + (size_t)2 * 9 * MODW * 4);
constexpr size_t WS_BTOUT = al256(WS_BTIN + (size_t)2 * INW * D * 2);
constexpr size_t WS_BTGU  = al256(WS_BTOUT + (size_t)2 * D * D * 2);
constexpr size_t WS_BTDN  = al256(WS_BTGU + (size_t)2 * DFF * D * 2);
constexpr size_t WS_LORA  = al256(WS_BTDN + (size_t)D * DFF * 2);
constexpr size_t LORA_LD_BYTES = (size_t)(256 * 64 * 2 + 256 * 128) * 2;
constexpr size_t WS_MOE   = al256(WS_LORA + 4 * LORA_LD_BYTES);
constexpr size_t MOE_GU_BYTES = (size_t)2 * DFE * D * 2, MOE_DN_BYTES = (size_t)D * DFE * 2, MOE_E_BYTES = MOE_GU_BYTES + MOE_DN_BYTES;
constexpr size_t WS_SH    = WS_MOE;
constexpr size_t SH_BYTES = (size_t)NB * 4 * TT * 192 * 2;
constexpr size_t WS_SD    = WS_SH + SH_BYTES;
constexpr size_t WS_XC    = al256(WS_MOE + (size_t)NEXP * MOE_E_BYTES);
constexpr size_t WS_HL    = al256(WS_XC + (size_t)NCTX * D * 4);
constexpr size_t WS_Y     = WS_HL;
constexpr size_t WS_PL    = al256(WS_HL + (size_t)NROW * D * 2);
constexpr size_t WS_MIX   = al256(WS_PL + (size_t)NROW * INW * 2);
constexpr size_t WS_H     = WS_PL;
constexpr size_t WS_ROUTE = al256(WS_MIX + (size_t)NROW * D * 2);
constexpr size_t RT_TOKE  = 0;
constexpr size_t RT_TOKG  = RT_TOKE + (size_t)NLAT * 2 * 4;
constexpr size_t RT_TOKP  = RT_TOKG + (size_t)NLAT * 2 * 4;
constexpr size_t RT_RMAP  = RT_TOKP + (size_t)NLAT * 2 * 4;
constexpr size_t RT_SGATE = RT_RMAP + (size_t)2 * NROW * 4;
constexpr size_t WS_END   = al256(WS_ROUTE + RT_SGATE + (size_t)2 * NROW * 4);
static_assert(SH_BYTES * 3 <= (size_t)NEXP * MOE_E_BYTES, "scan inputs must fit the MoE weight region");
static_assert((size_t)NROW * DFE * 2 <= (size_t)NROW * INW * 2 + (size_t)NROW * D * 2, "H must fit PL+MIX");

constexpr int CW_BAR = 0;
constexpr int CW_MOECNT = 4096;

#define XB_TMO      128
#define XB_XCNT(j)  (256  + 64 * (j))
#define XB_XSUB(j)  (1280 + 64 * (j))
#define XB_XGEN(j)  (2304 + 64 * (j))
#define XB_TOP      3328
#define XB_TOPGEN   3392
#define XCD_BAR_WORDS 3456
#define XB_SPIN_CAP (1u << 22)

__device__ __forceinline__ unsigned xb_ld(unsigned* p)              { return __hip_atomic_load(p, __ATOMIC_RELAXED, __HIP_MEMORY_SCOPE_AGENT); }
__device__ __forceinline__ unsigned xb_add(unsigned* p, unsigned v) { return __hip_atomic_fetch_add(p, v, __ATOMIC_RELAXED, __HIP_MEMORY_SCOPE_AGENT); }
__device__ __forceinline__ unsigned xb_xcc_id() { return (unsigned)__builtin_amdgcn_s_getreg((3 << 11) | 20) & 0xFu; }
#define XB_SPIN(cond, bar) do { unsigned _sp = 0; while (cond) { __builtin_amdgcn_s_sleep(1); \
    if ((++_sp & 255u) == 0u) { if (xb_ld(&(bar)[XB_TMO])) break; if (_sp > XB_SPIN_CAP) { atomicAdd(&(bar)[XB_TMO], 1u); break; } } } } while (0)

struct XcdBarrier { unsigned* bar; unsigned x; volatile LAS unsigned* st; };

__device__ __forceinline__ XcdBarrier xcd_barrier_post(unsigned* bar, volatile LAS unsigned* st, int tid) {
    XcdBarrier b; b.bar = bar; b.x = xb_xcc_id(); b.st = st;
    if (tid == 0) (void)xb_add(&bar[XB_XCNT(b.x)], 1u);
    return b;
}
__device__ __forceinline__ void xcd_barrier_complete(unsigned* bar, unsigned x, unsigned& nloc, unsigned& nx) {
    const unsigned G = gridDim.x * gridDim.y * gridDim.z;
    unsigned sum, cnt, mine, sp = 0u;
    for (;;) {
        sum = 0u; cnt = 0u; mine = 0u;
#pragma unroll
        for (unsigned j = 0; j < 16; ++j) { const unsigned c = xb_ld(&bar[XB_XCNT(j)]); sum += c; cnt += (c > 0u) ? 1u : 0u; mine = (j == x) ? c : mine; }
        if (sum == G) break;
        __builtin_amdgcn_s_sleep(1);
        if ((++sp & 255u) == 0u) { if (xb_ld(&bar[XB_TMO])) break; if (sp > XB_SPIN_CAP) { atomicAdd(&bar[XB_TMO], 1u); break; } }
    }
    nloc = mine > 0u ? mine : 1u; nx = cnt > 0u ? cnt : 1u;
}
__device__ __forceinline__ void xcd_barrier(const XcdBarrier& b, int tid) {
    asm volatile("s_waitcnt vmcnt(0)" ::: "memory");
    __syncthreads();
    if (tid == 0) {
        unsigned* bar = b.bar;
        __builtin_amdgcn_s_waitcnt(0);
        unsigned nloc = b.st[0], nx = b.st[1];
        if (nloc == 0u) { xcd_barrier_complete(bar, b.x, nloc, nx); b.st[0] = nloc; b.st[1] = nx; }
        const unsigned old = xb_add(&bar[XB_XSUB(b.x)], 1u);
        const unsigned gen = old / nloc;
        if (old + 1u == (gen + 1u) * nloc) {
            __builtin_amdgcn_fence(__ATOMIC_RELEASE, "agent");
            asm volatile("s_waitcnt vmcnt(0)" ::: "memory");
            const unsigned og = xb_add(&bar[XB_TOP], 1u);
            const unsigned tg = og / nx;
            if (og + 1u == (tg + 1u) * nx) xb_add(&bar[XB_TOPGEN], 1u);
            else XB_SPIN(xb_ld(&bar[XB_TOPGEN]) == tg, bar);
            __builtin_amdgcn_fence(__ATOMIC_ACQUIRE, "agent");
            xb_add(&bar[XB_XGEN(b.x)], 1u);
            asm volatile("s_waitcnt vmcnt(0)" ::: "memory");
        } else {
            XB_SPIN(xb_ld(&bar[XB_XGEN(b.x)]) == gen, bar);
            __builtin_amdgcn_fence(__ATOMIC_ACQUIRE, "agent");
            asm volatile("s_waitcnt vmcnt(0)" ::: "memory");
        }
    }
    __syncthreads();
}

__device__ __forceinline__ int lane_id() { return (int)__builtin_amdgcn_mbcnt_hi(~0u, __builtin_amdgcn_mbcnt_lo(~0u, 0u)); }
__device__ __forceinline__ float bf2f(bf16_t b) { return __uint_as_float(((unsigned)b) << 16); }
__device__ __forceinline__ bf16_t f2bf(float f) { unsigned u = __float_as_uint(f); u += 0x7FFFu + ((u >> 16) & 1u); return (bf16_t)(u >> 16); }
__device__ __forceinline__ unsigned pk_bf16(float lo, float hi) { return (unsigned)f2bf(lo) | ((unsigned)f2bf(hi) << 16); }
typedef __bf16 bf16x2_t __attribute__((ext_vector_type(2)));
__device__ __forceinline__ unsigned cvt_pk_bf16(float lo, float hi) { return __builtin_bit_cast(unsigned, __builtin_convertvector((f32x2){lo, hi}, bf16x2_t)); }
__device__ __forceinline__ float sigmoidf_(float x) { return 1.0f / (1.0f + __expf(-x)); }
__device__ __forceinline__ float siluf_(float x) { return x / (1.0f + __expf(-x)); }
__device__ __forceinline__ float wave_sum(float v) {
#pragma unroll
    for (int o = 32; o >= 1; o >>= 1) v += __shfl_xor(v, o);
    return v;
}
__device__ __forceinline__ float sum16(float v) {
    v += __shfl_xor(v, 1); v += __shfl_xor(v, 2); v += __shfl_xor(v, 4); v += __shfl_xor(v, 8); return v;
}
__device__ __forceinline__ void unpack4(u32x2 w, float (&f)[4]) {
    f[0] = __uint_as_float(w.x << 16); f[1] = __uint_as_float(w.x & 0xffff0000u); f[2] = __uint_as_float(w.y << 16); f[3] = __uint_as_float(w.y & 0xffff0000u);
}
__device__ __forceinline__ void unpack8(u32x4 w, float* f) {
    f[0] = __uint_as_float(w.x << 16); f[1] = __uint_as_float(w.x & 0xffff0000u); f[2] = __uint_as_float(w.y << 16); f[3] = __uint_as_float(w.y & 0xffff0000u);
    f[4] = __uint_as_float(w.z << 16); f[5] = __uint_as_float(w.z & 0xffff0000u); f[6] = __uint_as_float(w.w << 16); f[7] = __uint_as_float(w.w & 0xffff0000u);
}

struct Params {
    const float* in[35];
    float* out; unsigned char* ws;
    int ph_lo, ph_hi;
};
enum { I_X = 0, I_C, I_CTX, I_CCTX, I_N1G, I_N2G, I_MODW, I_MODB, I_WIN, I_WOUT, I_RPB, I_MUP, I_MUN, I_W0, I_W2, I_A0, I_A2, I_G2, I_KK, I_KA, I_RK, I_GNG, I_GNB,
       I_DWW, I_DWB, I_LNG, I_LNB, I_FG, I_FU, I_FD, I_ROUTER, I_MG, I_MU, I_MD, I_FINALG };

__device__ __forceinline__ int row_mi(int r) { return r < NLAT ? (r >> 12) : 8; }

namespace pg8 {
constexpr int BM = 256, BK = 64, HALF = 128, HTB = HALF * BK * 2, STAGE_BYTES = 8 * HTB, NXCD = 8, WGM = 8;
__device__ __forceinline__ int lds_byte(int r, int c) { const int st = (r >> 4) * 2 + (c >> 5), rr = r & 15, cc = c & 31, ob = rr * 64 + cc * 2; return st * 1024 + (ob ^ (((ob >> 9) & 1) << 5)); }
__device__ __forceinline__ void stage_rc(int b, int& R, int& C) { const int st = b / 1024, sb = b % 1024, swz = sb ^ (((sb >> 9) & 1) << 5); R = (st >> 1) * 16 + swz / 64; C = (st & 1) * 32 + (swz % 64) / 2; }
__device__ __forceinline__ int perm32(int rho) { const int n = rho >> 4, i = rho & 15; return 8 * (i >> 2) + 4 * n + (i & 3); }
struct Unit { int pm, pn; };

struct TileOrder {
    int nM, nN, nwg, G, c;
    __device__ void init(int nM_, int nN_, int G_, int c_) { nM = nM_; nN = nN_; nwg = nM * nN; G = G_; c = c_; }
    __device__ bool next(int i, Unit& u) const {
        const long L = (long)i * G + c; if (L >= nwg) return false;
        int wgid = (int)L; { const int q = nwg / NXCD, r = nwg % NXCD, xcd = wgid % NXCD, off = wgid / NXCD; wgid = (xcd < r ? xcd * (q + 1) : r * (q + 1) + (xcd - r) * q) + off; }
        const int nig = WGM * nN, gid = wgid / nig, fm = gid * WGM, gsz = (nM - fm) < WGM ? (nM - fm) : WGM;
        u.pm = fm + ((wgid % nig) % gsz); u.pn = (wgid % nig) / gsz; return true;
    }
};
struct DenseSched : TileOrder {
    const bf16_t* A; const bf16_t* Bt; int K;
    __device__ __forceinline__ const char* aptr(const Unit& u) const { return (const char*)A + (size_t)u.pm * BM * K * 2; }
    __device__ __forceinline__ const char* bptr(const Unit& u) const { return (const char*)Bt + (size_t)u.pn * BM * K * 2; }
    __device__ __forceinline__ const char* abase() const { return (const char*)A; }
    __device__ __forceinline__ int arow(const Unit&, int) const { return 0; }
};
struct MoeSched : TileOrder {
    const bf16_t* A; const unsigned char* Bt0; size_t e_stride; int K; const int* rowmap; int tstart[9];
    __device__ __forceinline__ int expert(int pm) const { int e = 0;
#pragma unroll
        for (int j = 1; j < 8; ++j) e += (pm >= tstart[j]) ? 1 : 0;
        return e; }
    __device__ __forceinline__ const char* aptr(const Unit& u) const { return (const char*)A + (size_t)u.pm * BM * K * 2; }
    __device__ __forceinline__ const char* bptr(const Unit& u) const { return (const char*)Bt0 + (size_t)expert(u.pm) * e_stride + (size_t)u.pn * BM * K * 2; }
    __device__ __forceinline__ const char* abase() const { return (const char*)A; }
    __device__ __forceinline__ int arow(const Unit& u, int r) const { const int t = rowmap[u.pm * BM + r]; return t < 0 ? 0 : t; }
};

struct EpiBf16 {
    static constexpr bool PERM = true;
    bf16_t* O; int ldc; int nscale; float scale;
    __device__ __forceinline__ void operator()(const f32x4 (&acc)[2][2][4][2], const Unit& u, int wr, int wc, int fr, int fq) const {
        const int row0 = u.pm * BM + wr * 64 + fr, col0 = u.pn * BM + wc * 32 + 8 * fq;
        const float s = u.pn < nscale ? scale : 1.0f;
#pragma unroll
        for (int ai = 0; ai < 2; ++ai)
#pragma unroll
            for (int m = 0; m < 4; ++m) { bf16_t* rowp = O + (size_t)(row0 + ai * HALF + m * 16) * ldc + col0;
#pragma unroll
                for (int bj = 0; bj < 2; ++bj) { const f32x4 v0 = acc[ai][bj][m][0] * s, v1 = acc[ai][bj][m][1] * s;
                    u32x4 w; w.x = cvt_pk_bf16(v0[0], v0[1]); w.y = cvt_pk_bf16(v0[2], v0[3]); w.z = cvt_pk_bf16(v1[0], v1[1]); w.w = cvt_pk_bf16(v1[2], v1[3]);
                    *(u32x4*)(rowp + bj * HALF) = w; } }
    }
};
struct EpiSwiGLU {
    static constexpr bool PERM = true;
    bf16_t* H; int ldh;
    __device__ __forceinline__ void operator()(const f32x4 (&acc)[2][2][4][2], const Unit& u, int wr, int wc, int fr, int fq) const {
        const int row0 = u.pm * BM + wr * 64 + fr, col0 = u.pn * HALF + wc * 32 + 8 * fq;
#pragma unroll
        for (int ai = 0; ai < 2; ++ai)
#pragma unroll
            for (int m = 0; m < 4; ++m) { bf16_t* rowp = H + (size_t)(row0 + ai * HALF + m * 16) * ldh + col0;
                float h[8];
#pragma unroll
                for (int n = 0; n < 2; ++n)
#pragma unroll
                    for (int j = 0; j < 4; ++j) { const float g = acc[ai][0][m][n][j], up = acc[ai][1][m][n][j]; h[n * 4 + j] = g / (1.0f + __expf(-g)) * up; }
                u32x4 w; w.x = cvt_pk_bf16(h[0], h[1]); w.y = cvt_pk_bf16(h[2], h[3]); w.z = cvt_pk_bf16(h[4], h[5]); w.w = cvt_pk_bf16(h[6], h[7]);
                *(u32x4*)rowp = w; }
    }
};
struct EpiRes {
    static constexpr bool PERM = false;
    const float* resL; const float* resC; float* outL; float* outC; const float* gvec;
    __device__ __forceinline__ void operator()(const f32x4 (&acc)[2][2][4][2], const Unit& u, int wr, int wc, int fr, int fq) const {
        const int r0 = u.pm * BM; const bool lat = r0 < NLAT;
        const float* res = lat ? resL + (size_t)r0 * D : resC + (size_t)(r0 - NLAT) * D;
        float* out = lat ? outL + (size_t)r0 * D : outC + (size_t)(r0 - NLAT) * D;
        const float* gv = gvec + (size_t)(lat ? (r0 >> 12) : 8) * MODW;
        const int rl = wr * 64 + fr, col0 = u.pn * BM + wc * 32 + 4 * fq;
        f32x4 g[2][2];
#pragma unroll
        for (int bj = 0; bj < 2; ++bj)
#pragma unroll
            for (int n = 0; n < 2; ++n) g[bj][n] = *(const f32x4*)(gv + col0 + bj * HALF + n * 16);
#pragma unroll
        for (int ai = 0; ai < 2; ++ai)
#pragma unroll
            for (int m = 0; m < 4; ++m) { const size_t off = (size_t)(rl + ai * HALF + m * 16) * D + col0;
#pragma unroll
                for (int bj = 0; bj < 2; ++bj)
#pragma unroll
                    for (int n = 0; n < 2; ++n) { const f32x4 rv = *(const f32x4*)(res + off + bj * HALF + n * 16);
                        *(f32x4*)(out + off + bj * HALF + n * 16) = rv + g[bj][n] * acc[ai][bj][m][n]; } }
    }
};
struct EpiMoeDown {
    static constexpr bool PERM = false;
    float* xl; const float* gvec; const int* rowmap; const float* sgate;
    __device__ __forceinline__ void operator()(const f32x4 (&acc)[2][2][4][2], const Unit& u, int wr, int wc, int fr, int fq) const {
        const int rl = u.pm * BM + wr * 64 + fr, col0 = u.pn * BM + wc * 32 + 4 * fq;
#pragma unroll
        for (int ai = 0; ai < 2; ++ai)
#pragma unroll
            for (int m = 0; m < 4; ++m) { const int slot = rl + ai * HALF + m * 16; const int tok = rowmap[slot];
                if (tok >= 0) { const float sg = sgate[slot]; const float* gv = gvec + (size_t)(tok >> 12) * MODW + col0; float* xp = xl + (size_t)tok * D + col0;
#pragma unroll
                    for (int bj = 0; bj < 2; ++bj)
#pragma unroll
                        for (int n = 0; n < 2; ++n) { const f32x4 g = *(const f32x4*)(gv + bj * HALF + n * 16); const f32x4 rv = *(const f32x4*)(xp + bj * HALF + n * 16);
                            *(f32x4*)(xp + bj * HALF + n * 16) = rv + (g * sg) * acc[ai][bj][m][n]; } } }
    }
};

template <class Epi, class Sched, bool GATHER>
__device__ __forceinline__ void gemm_phase(LAS unsigned char* lds, const int K, const Sched& S, const Epi& E, const int wave_) {
    int tid_ = wave_ * 64 + lane_id(); asm volatile("" : "+v"(tid_));
    const int tid = tid_, wid = wave_, lane = tid & 63, wr = wid >> 2, wc = wid & 3, fr = lane & 15, fq = lane >> 4;
    const int nt = K / BK;
    unsigned voffA[2], voffB[2]; int RA[2], CA[2];
#pragma unroll
    for (int i = 0; i < 2; ++i) { int R, C; stage_rc(tid * 16 + i * 8192, R, C); const int Rb = Epi::PERM ? ((R & ~31) + perm32(R & 31)) : R;
        voffA[i] = (unsigned)(R * K + C) * 2u; voffB[i] = (unsigned)(Rb * K + C) * 2u; RA[i] = R; CA[i] = C; }
    const size_t kstep = (size_t)(BK * 2);
    const size_t hstep = (size_t)HALF * K * 2;
    const unsigned ldsw = (unsigned)wid * 1024u;
    const int aoff = lds_byte(wr * 64 + fr, fq * 8), boff = lds_byte(wc * 32 + fr, fq * 8);
#define PG8_SA(b, h) (((b) * 2 + (h)) * HTB)
#define PG8_SB(b, h) ((4 + (b) * 2 + (h)) * HTB)
#define PG8_STAGE(bufoff, gbase, voff) do { _Pragma("unroll") for (int _i = 0; _i < 2; ++_i) \
        __builtin_amdgcn_global_load_lds((const unsigned*)((const char*)(gbase) + (voff)[_i]), (LAS unsigned*)(lds + (bufoff) + ldsw + _i * 8192), 16, 0, 0); } while (0)
#define PG8_LDA(dst, b, h) do { _Pragma("unroll") for (int m = 0; m < 4; ++m) _Pragma("unroll") for (int k = 0; k < 2; ++k) dst[m][k] = *(const LAS bf16x8*)(lds + PG8_SA(b, h) + aoff + m * 2048 + k * 1024); } while (0)
#define PG8_LDB(dst, b, h) do { _Pragma("unroll") for (int n = 0; n < 2; ++n) _Pragma("unroll") for (int k = 0; k < 2; ++k) dst[n][k] = *(const LAS bf16x8*)(lds + PG8_SB(b, h) + boff + n * 2048 + k * 1024); } while (0)
#define PG8_MMA(ai, bj, At, Bt) do { __builtin_amdgcn_s_setprio(1); _Pragma("unroll") for (int m = 0; m < 4; ++m) _Pragma("unroll") for (int n = 0; n < 2; ++n) _Pragma("unroll") for (int k = 0; k < 2; ++k) \
        acc[ai][bj][m][n] = __builtin_amdgcn_mfma_f32_16x16x32_bf16(Bt[n][k], At[m][k], acc[ai][bj][m][n], 0, 0, 0); __builtin_amdgcn_s_setprio(0); } while (0)
#define PG8_WAIT_V(n) asm volatile("s_waitcnt vmcnt(" #n ")" ::: "memory")
#define PG8_WAIT_L(n) asm volatile("s_waitcnt lgkmcnt(" #n ")" ::: "memory")
#define PG8_BAR __builtin_amdgcn_s_barrier()
#define PG8_SCHED __builtin_amdgcn_sched_barrier(0)
#define PG8_STAGE_A(bufoff, TS, H) do { if constexpr (GATHER) { PG8_STAGE(bufoff, gA##TS, oA##TS[H]); } else { PG8_STAGE(bufoff, a##TS + (H) * hstep, voffA); } } while (0)
    Unit cur, nxt; int ui = 0;
    if (!S.next(0, cur)) return;
    f32x4 acc[2][2][4][2];
#pragma unroll
    for (int a = 0; a < 2; ++a)
#pragma unroll
        for (int b = 0; b < 2; ++b)
#pragma unroll
            for (int m = 0; m < 4; ++m)
#pragma unroll
                for (int n = 0; n < 2; ++n) acc[a][b][m][n] = (f32x4){0.f, 0.f, 0.f, 0.f};
    bf16x8 At[4][2], B0[2][2], B1[2][2];
    const char* Abase = S.abase();
    unsigned aoC[2][2] = {{0u, 0u}, {0u, 0u}}, aoN[2][2] = {{0u, 0u}, {0u, 0u}};
    if constexpr (GATHER) {
#pragma unroll
        for (int h = 0; h < 2; ++h)
#pragma unroll
            for (int i = 0; i < 2; ++i) aoC[h][i] = (unsigned)(S.arow(cur, h * HALF + RA[i]) * K + CA[i]) * 2u;
    }
    const char* cA = GATHER ? Abase : S.aptr(cur); const char* cB = S.bptr(cur);
    if constexpr (GATHER) {
        PG8_STAGE(PG8_SB(0, 0), cB, voffB); PG8_STAGE(PG8_SA(0, 0), Abase, aoC[0]); PG8_STAGE(PG8_SB(0, 1), cB + hstep, voffB); PG8_STAGE(PG8_SA(0, 1), Abase, aoC[1]);
    } else {
        PG8_STAGE(PG8_SB(0, 0), cB, voffB); PG8_STAGE(PG8_SA(0, 0), cA, voffA); PG8_STAGE(PG8_SB(0, 1), cB + hstep, voffB); PG8_STAGE(PG8_SA(0, 1), cA + hstep, voffA);
    }
    if (wr == 1) PG8_BAR;
    PG8_WAIT_V(4); PG8_BAR;
    if constexpr (GATHER) {
        PG8_STAGE(PG8_SB(1, 0), cB + kstep, voffB); PG8_STAGE(PG8_SA(1, 0), Abase + kstep, aoC[0]); PG8_STAGE(PG8_SB(1, 1), cB + hstep + kstep, voffB);
    } else {
        PG8_STAGE(PG8_SB(1, 0), cB + kstep, voffB); PG8_STAGE(PG8_SA(1, 0), cA + kstep, voffA); PG8_STAGE(PG8_SB(1, 1), cB + hstep + kstep, voffB);
    }
    PG8_WAIT_V(6); PG8_BAR;
    for (;;) {
        const bool has_next = S.next(ui + 1, nxt);
        const char* nA = has_next ? (GATHER ? Abase : S.aptr(nxt)) : cA; const char* nB = has_next ? S.bptr(nxt) : cB;
        if constexpr (GATHER) {
            if (has_next) {
#pragma unroll
                for (int h = 0; h < 2; ++h)
#pragma unroll
                    for (int i = 0; i < 2; ++i) aoN[h][i] = (unsigned)(S.arow(nxt, h * HALF + RA[i]) * K + CA[i]) * 2u;
            } else {
#pragma unroll
                for (int h = 0; h < 2; ++h)
#pragma unroll
                    for (int i = 0; i < 2; ++i) aoN[h][i] = aoC[h][i];
            }
        }
        for (int t = 0; t < nt; t += 2) {
            const bool last = (t == nt - 2);
            const char* a1 = cA + (size_t)(t + 1) * kstep;
            const char* a2 = last ? nA : cA + (size_t)(t + 2) * kstep; const char* b2 = last ? nB : cB + (size_t)(t + 2) * kstep;
            const char* a3 = a2 + kstep; const char* b3 = b2 + kstep;
            const char* gA1 = Abase + (size_t)(t + 1) * kstep; const char* gA2 = Abase + (last ? (size_t)0 : (size_t)(t + 2) * kstep); const char* gA3 = gA2 + kstep;
            unsigned oA1[2][2], oA2[2][2], oA3[2][2];
#pragma unroll
            for (int h = 0; h < 2; ++h)
#pragma unroll
                for (int i = 0; i < 2; ++i) { oA1[h][i] = aoC[h][i]; oA2[h][i] = last ? aoN[h][i] : aoC[h][i]; oA3[h][i] = oA2[h][i]; }
            (void)a1; (void)a3; (void)gA1; (void)gA3; (void)oA1; (void)oA3;
            PG8_LDB(B0, 0, 0); PG8_SCHED; PG8_LDA(At, 0, 0); PG8_STAGE_A(PG8_SA(1, 1), 1, 1);
            PG8_WAIT_L(8); PG8_BAR; PG8_WAIT_L(0); PG8_MMA(0, 0, At, B0); PG8_BAR; PG8_SCHED;
            PG8_LDB(B1, 0, 1); PG8_STAGE(PG8_SB(0, 0), b2, voffB);
            PG8_BAR; PG8_WAIT_L(0); PG8_MMA(0, 1, At, B1); PG8_BAR;
            PG8_LDA(At, 0, 1); PG8_STAGE_A(PG8_SA(0, 0), 2, 0);
            PG8_BAR; PG8_WAIT_L(0); PG8_MMA(1, 0, At, B0); PG8_BAR; PG8_SCHED;
            PG8_STAGE(PG8_SB(0, 1), b2 + hstep, voffB);
            PG8_WAIT_V(6); PG8_BAR; PG8_MMA(1, 1, At, B1); PG8_BAR;
            PG8_LDB(B0, 1, 0); PG8_SCHED; PG8_LDA(At, 1, 0); PG8_STAGE_A(PG8_SA(0, 1), 2, 1);
            PG8_WAIT_L(8); PG8_BAR; PG8_WAIT_L(0); PG8_MMA(0, 0, At, B0); PG8_BAR; PG8_SCHED;
            PG8_LDB(B1, 1, 1); PG8_STAGE(PG8_SB(1, 0), b3, voffB);
            PG8_BAR; PG8_WAIT_L(0); PG8_MMA(0, 1, At, B1); PG8_BAR;
            PG8_LDA(At, 1, 1); PG8_STAGE_A(PG8_SA(1, 0), 3, 0);
            PG8_BAR; PG8_WAIT_L(0); PG8_MMA(1, 0, At, B0); PG8_BAR; PG8_SCHED;
            PG8_STAGE(PG8_SB(1, 1), b3 + hstep, voffB);
            PG8_WAIT_V(6); PG8_BAR; PG8_MMA(1, 1, At, B1); PG8_BAR;
        }
        { int t2 = tid; asm volatile("" : "+v"(t2)); const int l2 = t2 & 63; E(acc, cur, wr, wc, l2 & 15, l2 >> 4); }
        if (!has_next) break;
#pragma unroll
        for (int a = 0; a < 2; ++a)
#pragma unroll
            for (int b = 0; b < 2; ++b)
#pragma unroll
                for (int m = 0; m < 4; ++m)
#pragma unroll
                    for (int n = 0; n < 2; ++n) acc[a][b][m][n] = (f32x4){0.f, 0.f, 0.f, 0.f};
        cur = nxt; cA = nA; cB = nB; ++ui;
        if constexpr (GATHER) {
#pragma unroll
            for (int h = 0; h < 2; ++h)
#pragma unroll
                for (int i = 0; i < 2; ++i) aoC[h][i] = aoN[h][i];
        }
    }
    PG8_WAIT_V(0);
    if (wr == 0) PG8_BAR;
    PG8_BAR;
#undef PG8_SA
#undef PG8_SB
#undef PG8_STAGE
#undef PG8_STAGE_A
#undef PG8_LDA
#undef PG8_LDB
#undef PG8_MMA
#undef PG8_WAIT_V
#undef PG8_WAIT_L
#undef PG8_BAR
#undef PG8_SCHED
}
}

struct Frame {
    LAS unsigned char* lds; int tid, lane, wave, G, bid, gw, nw;
    unsigned char* ws;
};
extern __shared__ __attribute__((aligned(16))) unsigned char lds_raw[];
typedef const __attribute__((address_space(4))) Params* KP;
__device__ __forceinline__ Params load_params(const void* kp_) {
    const unsigned long long v = (unsigned long long)kp_;
    const unsigned lo = __builtin_amdgcn_readfirstlane((unsigned)v), hi = __builtin_amdgcn_readfirstlane((unsigned)(v >> 32));
    KP kp = (KP)(((unsigned long long)hi << 32) | lo);
    Params P;
#pragma unroll
    for (int i = 0; i < 35; ++i) P.in[i] = kp->in[i];
    P.out = kp->out; P.ws = kp->ws; P.ph_lo = kp->ph_lo; P.ph_hi = kp->ph_hi;
    return P;
}
#define PHASE static __attribute__((noinline)) __device__ void
#define PHASE_INL static __device__ __forceinline__ void
__device__ __forceinline__ Frame make_frame(unsigned char* ws, int wave_) {
    Frame F; F.lds = (LAS unsigned char*)lds_raw; F.wave = __builtin_amdgcn_readfirstlane(wave_);
    int t_ = F.wave * 64 + lane_id(); asm volatile("" : "+v"(t_));
    F.tid = t_; F.lane = F.tid & 63;
    F.G = gridDim.x; F.bid = blockIdx.x; F.gw = F.bid * NWAVES + F.wave; F.nw = F.G * NWAVES; F.ws = ws; return F;
}
__device__ __forceinline__ Frame sub_frame(Frame F, int bid, int G) { F.bid = bid; F.G = G; F.gw = F.bid * NWAVES + F.wave; F.nw = F.G * NWAVES; return F; }
#define PHASE_ENTER const Params P = load_params(kp_); const Frame F = make_frame(P.ws, wv_)

__device__ __forceinline__ void conv_job(const Frame& F, const float* src, bf16_t* dst, int K, int N, int mode) {
    LAS float* tile = (LAS float*)(F.lds + F.wave * (64 * 65 * 4));
    const int tk = K / 64, tn = N / 64, ntile = tk * tn, lane = F.lane;
    for (int t = F.gw; t < ntile; t += F.nw) {
        const int k0 = (t / tn) * 64, n0 = (t % tn) * 64;
#pragma unroll 4
        for (int i = 0; i < 16; ++i) { const int row = i * 4 + (lane >> 4), c4 = (lane & 15) * 4;
            const f32x4 v = *(const f32x4*)(src + (size_t)(k0 + row) * N + n0 + c4);
            tile[row * 65 + c4 + 0] = v[0]; tile[row * 65 + c4 + 1] = v[1]; tile[row * 65 + c4 + 2] = v[2]; tile[row * 65 + c4 + 3] = v[3]; }
        __builtin_amdgcn_wave_barrier(); asm volatile("s_waitcnt lgkmcnt(0)" ::: "memory");
#pragma unroll 2
        for (int i = 0; i < 8; ++i) { const int n = i * 8 + (lane >> 3), kc = (lane & 7) * 8;
            float f[8];
#pragma unroll
            for (int j = 0; j < 8; ++j) f[j] = tile[(kc + j) * 65 + n];
            const int ng = n0 + n; const int drow = mode == 0 ? ng : ((ng >> 7) * 256 + (mode == 2 ? 128 : 0) + (ng & 127));
            u32x4 w; w.x = pk_bf16(f[0], f[1]); w.y = pk_bf16(f[2], f[3]); w.z = pk_bf16(f[4], f[5]); w.w = pk_bf16(f[6], f[7]);
            *(u32x4*)(dst + (size_t)drow * K + k0 + kc) = w; }
        __builtin_amdgcn_wave_barrier(); asm volatile("s_waitcnt lgkmcnt(0)" ::: "memory");
    }
}

__device__ __forceinline__ void phase_prologue(const Frame& F, const Params& P) {
    float* modv = (float*)(F.ws + WS_MODV);
    LAS float* s = (LAS float*)F.lds;
    LAS float* red = (LAS float*)(F.lds + 9 * 1024 * 4);
    for (int cb = F.bid; cb < (2 * MODW) / 64; cb += F.G) {
        for (int i = F.tid; i < 9 * 1024; i += NTHREADS) { const int mi = i >> 10, k = i & 1023; const float c = mi < 8 ? P.in[I_C][mi * D + k] : P.in[I_CCTX][k]; s[i] = siluf_(c); }
        __syncthreads();
        const int colg = cb * 64 + F.lane, l = colg / MODW, col = colg % MODW;
        const float* w = P.in[I_MODW] + (size_t)l * D * MODW + col;
        float acc[9];
#pragma unroll
        for (int mi = 0; mi < 9; ++mi) acc[mi] = 0.f;
        const int kb = F.wave * 128;
#pragma unroll 8
        for (int k = 0; k < 128; ++k) { const float wv = w[(size_t)(kb + k) * MODW];
#pragma unroll
            for (int mi = 0; mi < 9; ++mi) acc[mi] += s[mi * 1024 + kb + k] * wv; }
#pragma unroll
        for (int mi = 0; mi < 9; ++mi) red[(F.wave * 9 + mi) * 64 + F.lane] = acc[mi];
        __syncthreads();
        for (int i = F.tid; i < 9 * 64; i += NTHREADS) { const int mi = i >> 6, ln = i & 63; float a = 0.f;
#pragma unroll
            for (int w8 = 0; w8 < 8; ++w8) a += red[(w8 * 9 + mi) * 64 + ln];
            const int cg = cb * 64 + ln, l2 = cg / MODW, c2 = cg % MODW;
            modv[((size_t)l2 * 9 + mi) * MODW + c2] = a + P.in[I_MODB][l2 * MODW + c2]; }
        __syncthreads();
    }
    for (int l = 0; l < 2; ++l) {
        conv_job(F, P.in[I_WIN] + (size_t)l * D * INW, (bf16_t*)(F.ws + WS_BTIN) + (size_t)l * INW * D, D, INW, 0);
        conv_job(F, P.in[I_WOUT] + (size_t)l * D * D, (bf16_t*)(F.ws + WS_BTOUT) + (size_t)l * D * D, D, D, 0);
    }
    conv_job(F, P.in[I_FG], (bf16_t*)(F.ws + WS_BTGU), D, DFF, 1);
    conv_job(F, P.in[I_FU], (bf16_t*)(F.ws + WS_BTGU), D, DFF, 2);
    conv_job(F, P.in[I_FD], (bf16_t*)(F.ws + WS_BTDN), DFF, D, 0);
    for (int ld = 0; ld < 4; ++ld) { bf16_t* base = (bf16_t*)(F.ws + WS_LORA + (size_t)ld * LORA_LD_BYTES);
        conv_job(F, P.in[I_W2] + (size_t)ld * 64 * 256, base, 64, 256, 0);
        conv_job(F, P.in[I_A2] + (size_t)ld * 64 * 256, base + 256 * 64, 64, 256, 0);
        conv_job(F, P.in[I_G2] + (size_t)ld * 128 * 256, base + 2 * 256 * 64, 128, 256, 0); }
}
__device__ __forceinline__ void phase_moe_convert(const Frame& F, const Params& P) {
    for (int e = 0; e < NEXP; ++e) {
        bf16_t* gu = (bf16_t*)(F.ws + WS_MOE + (size_t)e * MOE_E_BYTES); bf16_t* dn = (bf16_t*)(F.ws + WS_MOE + (size_t)e * MOE_E_BYTES + MOE_GU_BYTES);
        conv_job(F, P.in[I_MG] + (size_t)e * D * DFE, gu, D, DFE, 1);
        conv_job(F, P.in[I_MU] + (size_t)e * D * DFE, gu, D, DFE, 2);
        conv_job(F, P.in[I_MD] + (size_t)e * DFE * D, dn, DFE, D, 0);
    }
}

template <bool ROUTER>
__device__ __forceinline__ void phase_norm(const Frame& F, const Params& P, int l, int which, int nrows, const float* srcL, const float* srcC) {
    const float* g = (which == 0 ? P.in[I_N1G] : P.in[I_N2G]) + l * D;
    const float* modv = (const float*)(F.ws + WS_MODV) + (size_t)l * 9 * MODW + (which == 0 ? 0 : 3 * D);
    bf16_t* HL = (bf16_t*)(F.ws + WS_HL);
    LAS float* rt = (LAS float*)F.lds;
    if (ROUTER) {
        for (int i = F.tid; i < D * NEXP; i += NTHREADS) rt[i] = P.in[I_ROUTER][i];
        int* rmap = (int*)(F.ws + WS_ROUTE + RT_RMAP);
        for (int i = F.bid * NTHREADS + F.tid; i < 2 * NROW; i += F.G * NTHREADS) rmap[i] = -1;
        __syncthreads();
    }
    const int lane = F.lane;
    for (int r = F.gw; r < nrows; r += F.nw) {
        const float* xr = r < NLAT ? srcL + (size_t)r * D : srcC + (size_t)(r - NLAT) * D;
        const float* mv = modv + (size_t)row_mi(r) * MODW;
        f32x4 x[4]; float ss = 0.f;
#pragma unroll
        for (int j = 0; j < 4; ++j) { x[j] = *(const f32x4*)(xr + j * 256 + lane * 4); ss += x[j][0] * x[j][0] + x[j][1] * x[j][1] + x[j][2] * x[j][2] + x[j][3] * x[j][3]; }
        ss = wave_sum(ss);
        const float rstd = rsqrtf(ss * (1.0f / D) + 1e-6f);
        float lg[NEXP];
        if (ROUTER) {
#pragma unroll
            for (int e = 0; e < NEXP; ++e) lg[e] = 0.f;
        }
#pragma unroll
        for (int j = 0; j < 4; ++j) { const int c = j * 256 + lane * 4;
            const f32x4 gg = *(const f32x4*)(g + c), sh = *(const f32x4*)(mv + c), sc = *(const f32x4*)(mv + D + c);
            f32x4 y = (x[j] * rstd * gg) * (sc + 1.0f) + sh;
            u32x2 w; w.x = pk_bf16(y[0], y[1]); w.y = pk_bf16(y[2], y[3]);
            *(u32x2*)(HL + (size_t)r * D + c) = w;
            if (ROUTER) {
#pragma unroll
                for (int q = 0; q < 4; ++q) { const f32x4 r0 = *(const LAS f32x4*)(rt + (c + q) * 8), r1 = *(const LAS f32x4*)(rt + (c + q) * 8 + 4);
                    lg[0] += y[q] * r0[0]; lg[1] += y[q] * r0[1]; lg[2] += y[q] * r0[2]; lg[3] += y[q] * r0[3];
                    lg[4] += y[q] * r1[0]; lg[5] += y[q] * r1[1]; lg[6] += y[q] * r1[2]; lg[7] += y[q] * r1[3]; asm volatile("" ::: "memory"); }
            }
        }
        if (ROUTER) {
#pragma unroll
            for (int e = 0; e < NEXP; ++e) lg[e] = wave_sum(lg[e]);
            if (lane == 0) {
                int e1 = 0; float l1 = lg[0];
#pragma unroll
                for (int e = 1; e < NEXP; ++e) if (lg[e] > l1) { l1 = lg[e]; e1 = e; }
                int e2 = -1; float l2 = -3.0e38f;
#pragma unroll
                for (int e = 0; e < NEXP; ++e) if (e != e1 && lg[e] > l2) { l2 = lg[e]; e2 = e; }
                if (e2 < 0) { e2 = e1 == 0 ? 1 : 0; l2 = l1; }
                const float ex = __expf(l2 - l1), g1 = 1.0f / (1.0f + ex), g2 = ex * g1;
                unsigned* cnt = (unsigned*)(F.ws + WS_CTL) + CW_MOECNT;
                const unsigned p1 = atomicAdd(cnt + e1, 1u), p2 = atomicAdd(cnt + 8 + e2, 1u);
                int* te = (int*)(F.ws + WS_ROUTE + RT_TOKE); float* tg = (float*)(F.ws + WS_ROUTE + RT_TOKG); int* tp = (int*)(F.ws + WS_ROUTE + RT_TOKP);
                te[r * 2] = e1; te[r * 2 + 1] = e2; tg[r * 2] = g1; tg[r * 2 + 1] = g2; tp[r * 2] = (int)p1; tp[r * 2 + 1] = (int)p2;
            }
        }
    }
}
__device__ __forceinline__ void moe_tstart(const Frame& F, int pass, int (&ts)[9]) {
    const unsigned* cnt = (const unsigned*)(F.ws + WS_CTL) + CW_MOECNT + pass * 8;
    int a = 0;
#pragma unroll
    for (int e = 0; e < 8; ++e) { ts[e] = a; a += (int)((__hip_atomic_load(cnt + e, __ATOMIC_RELAXED, __HIP_MEMORY_SCOPE_AGENT) + 255u) >> 8); }
    ts[8] = a;
}
__device__ __forceinline__ void phase_moe_rowmap(const Frame& F) {
    int ts0[9], ts1[9]; moe_tstart(F, 0, ts0); moe_tstart(F, 1, ts1);
    const int* te = (const int*)(F.ws + WS_ROUTE + RT_TOKE); const float* tg = (const float*)(F.ws + WS_ROUTE + RT_TOKG); const int* tp = (const int*)(F.ws + WS_ROUTE + RT_TOKP);
    int* rmap = (int*)(F.ws + WS_ROUTE + RT_RMAP); float* sg = (float*)(F.ws + WS_ROUTE + RT_SGATE);
    for (int t = F.bid * NTHREADS + F.tid; t < NLAT; t += F.G * NTHREADS) {
        { const int e = te[t * 2]; int st = 0;
#pragma unroll
          for (int j = 0; j < 8; ++j) st = (e == j) ? ts0[j] : st;
          const int slot = st * 256 + tp[t * 2]; rmap[slot] = t; sg[slot] = tg[t * 2]; }
        { const int e = te[t * 2 + 1]; int st = 0;
#pragma unroll
          for (int j = 0; j < 8; ++j) st = (e == j) ? ts1[j] : st;
          const int slot = st * 256 + tp[t * 2 + 1]; rmap[NROW + slot] = t; sg[NROW + slot] = tg[t * 2 + 1]; }
    }
}

struct RowGeo { int b, tt, pos, len; };
__device__ __forceinline__ RowGeo row_geo(int r) { RowGeo g; if (r < NLAT) { g.b = r >> 12; g.pos = r & 4095; g.len = SEQ; g.tt = CTXL + g.pos; } else { const int q = r - NLAT; g.b = q >> 8; g.pos = q & 255; g.len = CTXL; g.tt = g.pos; } return g; }

__device__ __forceinline__ void rw_shift4(const bf16_t* PL, const float* mup, const float* mun, int r, const RowGeo& g, int j, float (&u)[4]) {
    const bf16_t* p = PL + (size_t)r * INW + O_RW + j;
    const bool hp = g.pos > 0, hn = g.pos < g.len - 1;
    float c[4], pv[4], nv[4];
    unpack4(*(const u32x2*)p, c); unpack4(*(const u32x2*)(p - (hp ? INW : 0)), pv); unpack4(*(const u32x2*)(p + (hn ? INW : 0)), nv);
    const f32x4 mp = *(const f32x4*)(mup + j), mn = *(const f32x4*)(mun + j);
#pragma unroll
    for (int q = 0; q < 4; ++q) u[q] = c[q] + mp[q] * ((hp ? pv[q] : 0.f) - c[q]) + mn[q] * ((hn ? nv[q] : 0.f) - c[q]);
}

__device__ __forceinline__ void rw_shift8(const bf16_t* PL, const float* mup, const float* mun, int r, const RowGeo& g, int j, float (&u)[8]) {
    const bf16_t* p = PL + (size_t)r * INW + O_RW + j;
    const bool hp = g.pos > 0, hn = g.pos < g.len - 1;
    float c[8], pv[8], nv[8];
    unpack8(*(const u32x4*)p, c); unpack8(*(const u32x4*)(p - (hp ? INW : 0)), pv); unpack8(*(const u32x4*)(p + (hn ? INW : 0)), nv);
    const f32x4 mp0 = *(const f32x4*)(mup + j), mp1 = *(const f32x4*)(mup + j + 4), mn0 = *(const f32x4*)(mun + j), mn1 = *(const f32x4*)(mun + j + 4);
#pragma unroll
    for (int q = 0; q < 4; ++q) { u[q] = c[q] + mp0[q] * ((hp ? pv[q] : 0.f) - c[q]) + mn0[q] * ((hn ? nv[q] : 0.f) - c[q]);
        u[4 + q] = c[4 + q] + mp1[q] * ((hp ? pv[4 + q] : 0.f) - c[4 + q]) + mn1[q] * ((hn ? nv[4 + q] : 0.f) - c[4 + q]); }
}
__device__ __forceinline__ bf16x8 pack8f(const float (&f)[8]) {
    u32x4 w; w.x = cvt_pk_bf16(f[0], f[1]); w.y = cvt_pk_bf16(f[2], f[3]); w.z = cvt_pk_bf16(f[4], f[5]); w.w = cvt_pk_bf16(f[6], f[7]); return __builtin_bit_cast(bf16x8, w);
}
constexpr int RL_MUP = 0, RL_MUN = 5120, RL_KK = 10240, RL_KA = 11264, RL_W0 = 12288, RL_A0 = 14336, RL_RK = 16384, RL_GNG = 17408, RL_GNB = 18432, RL_END = 19456;
__device__ __forceinline__ void rw_stage_tables(const Frame& F, const Params& P, int l) {
    LAS float* T = (LAS float*)F.lds;
    for (int i = F.tid; i < 1280; i += NTHREADS) { T[RL_MUP / 4 + i] = P.in[I_MUP][l * 1280 + i]; T[RL_MUN / 4 + i] = P.in[I_MUN][l * 1280 + i]; }
    for (int i = F.tid; i < 256; i += NTHREADS) { T[RL_KK / 4 + i] = P.in[I_KK][l * 256 + i]; T[RL_KA / 4 + i] = P.in[I_KA][l * 256 + i]; T[RL_RK / 4 + i] = P.in[I_RK][l * 256 + i];
        T[RL_GNG / 4 + i] = P.in[I_GNG][l * 256 + i]; T[RL_GNB / 4 + i] = P.in[I_GNB][l * 256 + i]; }
    for (int i = F.tid; i < 512; i += NTHREADS) { T[RL_W0 / 4 + i] = P.in[I_W0][l * 512 + i]; T[RL_A0 / 4 + i] = P.in[I_A0][l * 512 + i]; }
    __syncthreads();
}
__device__ __forceinline__ void rw_mix8(const LAS float* T, const u32x4 (&raw)[3], bool hp, bool hn, int j, float (&u)[8]) {
    float c[8], pv[8], nv[8]; unpack8(raw[0], c); unpack8(raw[1], pv); unpack8(raw[2], nv);
    const f32x4 mp0 = *(const LAS f32x4*)(T + RL_MUP / 4 + j), mp1 = *(const LAS f32x4*)(T + RL_MUP / 4 + j + 4), mn0 = *(const LAS f32x4*)(T + RL_MUN / 4 + j), mn1 = *(const LAS f32x4*)(T + RL_MUN / 4 + j + 4);
#pragma unroll
    for (int q = 0; q < 4; ++q) { u[q] = c[q] + mp0[q] * ((hp ? pv[q] : 0.f) - c[q]) + mn0[q] * ((hn ? nv[q] : 0.f) - c[q]);
        u[4 + q] = c[4 + q] + mp1[q] * ((hp ? pv[4 + q] : 0.f) - c[4 + q]) + mn1[q] * ((hn ? nv[4 + q] : 0.f) - c[4 + q]); }
}
__device__ __forceinline__ void rw_mix4(const LAS float* T, const u32x2 (&raw)[3], bool hp, bool hn, int j, float (&u)[4]) {
    float c[4], pv[4], nv[4]; unpack4(raw[0], c); unpack4(raw[1], pv); unpack4(raw[2], nv);
    const f32x4 mp = *(const LAS f32x4*)(T + RL_MUP / 4 + j), mn = *(const LAS f32x4*)(T + RL_MUN / 4 + j);
#pragma unroll
    for (int q = 0; q < 4; ++q) u[q] = c[q] + mp[q] * ((hp ? pv[q] : 0.f) - c[q]) + mn[q] * ((hn ? nv[q] : 0.f) - c[q]);
}
__device__ __forceinline__ void phase_rw_prep(const Frame& F, const Params& P, int l) {
    const bf16_t* PL = (const bf16_t*)(F.ws + WS_PL);
    f16_t* SH = (f16_t*)(F.ws + WS_SH); f16_t* SD = (f16_t*)(F.ws + WS_SD);
    const int lane = F.lane;
    rw_stage_tables(F, P, l);
    const LAS float* T = (const LAS float*)F.lds;
    for (int item = F.gw; item < NLAT / 16 + (NCTX / 16) * 4; item += F.nw) {
        const int tile = item < NLAT / 16 ? item : NLAT / 16 + ((item - NLAT / 16) >> 2), h0 = item < NLAT / 16 ? 0 : ((item - NLAT / 16) & 3), h1 = item < NLAT / 16 ? 4 : h0 + 1;
        int l1 = lane; asm volatile("" : "+v"(l1)); const int tk = l1 & 15, g = l1 >> 4;
        const int r = tile * 16 + tk; const RowGeo geo = row_geo(r);
        const bool hp = geo.pos > 0, hn = geo.pos < geo.len - 1;
        const bf16_t* prow = PL + (size_t)r * INW + O_RW; const int dprev = hp ? -INW : 0, dnext = hn ? INW : 0;
        bf16x8 tw[2][2], ta[2][2];
#pragma unroll
        for (int d = 0; d < 2; ++d) { u32x4 raw[4][3];
#pragma unroll
          for (int i = 0; i < 4; ++i) { const bf16_t* p = prow + 768 + 256 * d + 64 * (i & 1) + 32 * (i >> 1) + 8 * g;
              raw[i][0] = *(const u32x4*)p; raw[i][1] = *(const u32x4*)(p + dprev); raw[i][2] = *(const u32x4*)(p + dnext); }
#pragma unroll
          for (int i = 0; i < 4; ++i) { float u[8]; rw_mix8(T, raw[i], hp, hn, 768 + 256 * d + 64 * (i & 1) + 32 * (i >> 1) + 8 * g, u);
              if ((i & 1) == 0) {
#pragma unroll
                  for (int q = 0; q < 8; ++q) u[q] = 1.0f - 2.0f / (1.0f + __expf(2.0f * u[q]));
                  tw[d][i >> 1] = pack8f(u); }
              else ta[d][i >> 1] = pack8f(u); }
          asm volatile("" ::: "memory"); }
        asm volatile("" ::: "memory");
#pragma unroll 1
        for (int h = h0; h < h1; ++h) {
            int l2 = lane; asm volatile("" : "+v"(l2)); const int tk = l2 & 15, g = l2 >> 4;
            const int r = tile * 16 + tk; const RowGeo geo = row_geo(r);
            const bool hp = geo.pos > 0, hn = geo.pos < geo.len - 1;
            const bf16_t* prow = PL + (size_t)r * INW + O_RW + 64 * h + 8 * g; const int dprev = hp ? -INW : 0, dnext = hn ? INW : 0;
            float ur[4][4], uk[4][4], uv[4][4], kkv[4][4]; float ss = 0.f;
            { u32x4 raw[6][3];
#pragma unroll
              for (int i = 0; i < 6; ++i) { const bf16_t* p = prow + 256 * (i >> 1) + 32 * (i & 1);
                  raw[i][0] = *(const u32x4*)p; raw[i][1] = *(const u32x4*)(p + dprev); raw[i][2] = *(const u32x4*)(p + dnext); }
#pragma unroll
              for (int u = 0; u < 2; ++u) { float x8[8]; const int c = 64 * h + 32 * u + 8 * g;
                  rw_mix8(T, raw[u], hp, hn, c, x8);
#pragma unroll
                  for (int e = 0; e < 8; ++e) ur[2 * u + (e >> 2)][e & 3] = x8[e];
                  rw_mix8(T, raw[2 + u], hp, hn, 256 + c, x8);
#pragma unroll
                  for (int e = 0; e < 8; ++e) uk[2 * u + (e >> 2)][e & 3] = x8[e];
                  rw_mix8(T, raw[4 + u], hp, hn, 512 + c, x8);
#pragma unroll
                  for (int e = 0; e < 8; ++e) uv[2 * u + (e >> 2)][e & 3] = x8[e];
                  const f32x4 k0 = *(const LAS f32x4*)(T + RL_KK / 4 + c), k1 = *(const LAS f32x4*)(T + RL_KK / 4 + c + 4);
#pragma unroll
                  for (int q = 0; q < 4; ++q) { kkv[2 * u][q] = uk[2 * u][q] * k0[q]; kkv[2 * u + 1][q] = uk[2 * u + 1][q] * k1[q]; ss += kkv[2 * u][q] * kkv[2 * u][q] + kkv[2 * u + 1][q] * kkv[2 * u + 1][q]; } } }
            ss += __shfl_xor(ss, 16); ss += __shfl_xor(ss, 32);
            const float rn = rsqrtf(ss + 1e-12f);
            const size_t shrow = ((size_t)(geo.b * 4 + h) * TT + geo.tt) * 192;
#pragma unroll
            for (int u = 0; u < 2; ++u) { f16x8 o1, o2, o3;
#pragma unroll
                for (int e = 0; e < 8; ++e) { const int t = 2 * u + (e >> 2), q = e & 3; kkv[t][q] *= rn; o1[e] = (f16_t)ur[t][q]; o2[e] = (f16_t)uv[t][q]; o3[e] = (f16_t)(-kkv[t][q]); }
                f16_t* sp = SH + shrow + 32 * u + 8 * g; *(f16x8*)sp = o1; *(f16x8*)(sp + 64) = o2; *(f16x8*)(sp + 128) = o3; }
#pragma unroll 1
            for (int d = 0; d < 2; ++d) {
                const bf16_t* w2t = (const bf16_t*)(F.ws + WS_LORA + (size_t)(l * 2 + d) * LORA_LD_BYTES); const bf16_t* a2t = w2t + 256 * 64;
                const size_t sdrow = ((size_t)((d * 8 + geo.b) * 4 + h) * TT + geo.tt) * 192;
                const bf16x8 tw0 = d ? tw[1][0] : tw[0][0], tw1 = d ? tw[1][1] : tw[0][1], ta0 = d ? ta[1][0] : ta[0][0], ta1 = d ? ta[1][1] : ta[0][1];
                bf16x8 wf[4][2], af[4][2];
#pragma unroll
                for (int t = 0; t < 4; ++t) { const int wrow = 64 * h + 32 * (t >> 1) + 8 * (tk >> 2) + 4 * (t & 1) + (tk & 3);
                    const bf16_t* wr = w2t + (size_t)wrow * 64 + 8 * g; const bf16_t* ar = a2t + (size_t)wrow * 64 + 8 * g;
                    wf[t][0] = *(const bf16x8*)wr; wf[t][1] = *(const bf16x8*)(wr + 32); af[t][0] = *(const bf16x8*)ar; af[t][1] = *(const bf16x8*)(ar + 32); }
                f16x8 o1[2], o2[2], o3[2];
#pragma unroll
                for (int t = 0; t < 4; ++t) { const int c = 64 * h + 32 * (t >> 1) + 8 * g + 4 * (t & 1);
                    f32x4 xw = *(const LAS f32x4*)(T + RL_W0 / 4 + d * 256 + c), xa = *(const LAS f32x4*)(T + RL_A0 / 4 + d * 256 + c);
                    xw = __builtin_amdgcn_mfma_f32_16x16x32_bf16(wf[t][0], tw0, xw, 0, 0, 0); xw = __builtin_amdgcn_mfma_f32_16x16x32_bf16(wf[t][1], tw1, xw, 0, 0, 0);
                    xa = __builtin_amdgcn_mfma_f32_16x16x32_bf16(af[t][0], ta0, xa, 0, 0, 0); xa = __builtin_amdgcn_mfma_f32_16x16x32_bf16(af[t][1], ta1, xa, 0, 0, 0);
                    const f32x4 kaw = *(const LAS f32x4*)(T + RL_KA / 4 + c);
#pragma unroll
                    for (int q = 0; q < 4; ++q) {
                        const float nx = -xw[q]; const float sp = fmaxf(nx, 0.f) + __logf(1.0f + __expf(-fabsf(nx)));
                        const float e = __expf(-sp - 0.5f);
                        const float omw = 1.0f - __expf(-e);
                        const float a = sigmoidf_(xa[q]);
                        o1[t >> 1][(t & 1) * 4 + q] = (f16_t)omw; o2[t >> 1][(t & 1) * 4 + q] = (f16_t)(uk[t][q] * (1.0f + (a - 1.0f) * kaw[q])); o3[t >> 1][(t & 1) * 4 + q] = (f16_t)(kkv[t][q] * a); } }
#pragma unroll
                for (int u = 0; u < 2; ++u) { f16_t* sp = SD + sdrow + 32 * u + 8 * g; *(f16x8*)sp = o1[u]; *(f16x8*)(sp + 64) = o2[u]; *(f16x8*)(sp + 128) = o3[u]; }
                asm volatile("" ::: "memory");
            }
        }
    }
    __syncthreads();
}

constexpr int CS_ZP = 0, CS_RPP = 2048, CS_BH = 4096, CS_KH = 6144, CS_VV = 8192, CS_MT = 10240, CS_NT = 11264, CS_WC = 12288, CS_SLOT = 12544;
constexpr int CS_ZIMG = 8 * CS_SLOT;
constexpr int CS_NCHUNK = TT / 16;
__device__ __forceinline__ int cs_tt(int d, int q, int s) { const int st = 16 * q + s; return d == 0 ? st : (st < CTXL ? CTXL - 1 - st : TT + CTXL - 1 - st); }
__device__ __forceinline__ float dpp_shr(float old, float v, int) { return v; }
template <int N> __device__ __forceinline__ float row_shr(float v, float old) {
    return __builtin_bit_cast(float, __builtin_amdgcn_update_dpp(__builtin_bit_cast(int, old), __builtin_bit_cast(int, v), 0x110 + N, 0xF, 0xF, false));
}
__device__ __forceinline__ bf16x8 cs_pack(const float (&a)[4], const float (&b)[4]) {
    u32x4 w; w.x = cvt_pk_bf16(a[0], a[1]); w.y = cvt_pk_bf16(a[2], a[3]); w.z = cvt_pk_bf16(b[0], b[1]); w.w = cvt_pk_bf16(b[2], b[3]); return __builtin_bit_cast(bf16x8, w);
}
__device__ __forceinline__ bf16x8 cs_op16(const f32x4& x) { u32x4 w; w.x = cvt_pk_bf16(x[0], x[1]); w.y = cvt_pk_bf16(x[2], x[3]); w.z = 0u; w.w = 0u; return __builtin_bit_cast(bf16x8, w); }
#define CS_MFMA(a, b, c) __builtin_amdgcn_mfma_f32_16x16x32_bf16((a), (b), (c), 0, 0, 0)
__device__ __forceinline__ f32x4 cs_mm16(const f32x4& xt_d, const f32x4& y_d) { return CS_MFMA(cs_op16(xt_d), cs_op16(y_d), ((f32x4){0.f, 0.f, 0.f, 0.f})); }
__device__ __forceinline__ v4i16_t cs_tr(const LAS unsigned char* img, int lane, int T) {
    const int g = lane >> 4, q = (lane & 15) >> 2, p = lane & 3;
    return __builtin_amdgcn_ds_read_tr16_b64_v4i16((LAS v4i16_t*)(img + (4 * g + q) * 128 + p * 32 + (T >> 1) * 16 + (T & 1) * 8));
}
__device__ __forceinline__ bf16x8 cs_lo(v4i16_t x) { bf16x8 r; r[0] = x[0]; r[1] = x[1]; r[2] = x[2]; r[3] = x[3]; r[4] = 0; r[5] = 0; r[6] = 0; r[7] = 0; return r; }

struct CsRaw { u32x2 x[4], z[4], r[4], b[4], k[4], v[4]; };
__device__ __forceinline__ void cs_load(CsRaw& R, const f16_t* sh, const f16_t* sd, int d, int q, int lane) {
    const int s = lane & 15, g = lane >> 4; const int tt = cs_tt(d, q, s);
    const f16_t* shp = sh + (size_t)tt * 192 + 4 * g; const f16_t* sdp = sd + (size_t)tt * 192 + 4 * g;
#pragma unroll
    for (int T = 0; T < 4; ++T) { R.x[T] = *(const u32x2*)(sdp + 16 * T); R.z[T] = *(const u32x2*)(shp + 128 + 16 * T); R.r[T] = *(const u32x2*)(shp + 16 * T);
        R.b[T] = *(const u32x2*)(sdp + 128 + 16 * T); R.k[T] = *(const u32x2*)(sdp + 64 + 16 * T); R.v[T] = *(const u32x2*)(shp + 64 + 16 * T); }
}
__device__ __forceinline__ void cs_prepass(LAS unsigned char* slot, LAS unsigned char* zimg, CsRaw& raw, const f16_t* sh, const f16_t* sd, int d, int qn, int lane) {
    const int s = lane & 15, g = lane >> 4;
    float Wc[4][4], Wp[4][4], iW[4][4];
#pragma unroll
    for (int T = 0; T < 4; ++T) { const f16x4 x4 = __builtin_bit_cast(f16x4, raw.x[T]);
#pragma unroll
        for (int j = 0; j < 4; ++j) { float wc = 1.0f - (float)x4[j];
            wc *= row_shr<1>(wc, 1.0f); wc *= row_shr<2>(wc, 1.0f); wc *= row_shr<4>(wc, 1.0f); wc *= row_shr<8>(wc, 1.0f);
            Wc[T][j] = wc; Wp[T][j] = row_shr<1>(wc, 1.0f); iW[T][j] = __builtin_amdgcn_rcpf(wc); } }
    if (s == 15) {
#pragma unroll
        for (int T = 0; T < 4; ++T) *(LAS f32x4*)(slot + CS_WC + (16 * T + 4 * g) * 4) = (f32x4){Wc[T][0], Wc[T][1], Wc[T][2], Wc[T][3]}; }
    bf16x8 oZ[2], oR[2], oB[2], oK[2];
    const int ioff = s * 128 + g * 32;
#define CS_STAGE(dst, SRC, SC, IMG) do { float t_[4][4]; \
        _Pragma("unroll") for (int T = 0; T < 4; ++T) { const f16x4 q4 = __builtin_bit_cast(f16x4, SRC[T]); \
            _Pragma("unroll") for (int j = 0; j < 4; ++j) t_[T][j] = (float)q4[j] * SC; } \
        _Pragma("unroll") for (int kk = 0; kk < 2; ++kk) { dst[kk] = cs_pack(t_[2 * kk], t_[2 * kk + 1]); if (IMG) *(LAS bf16x8*)((IMG) + ioff + kk * 16) = dst[kk]; } \
        } while (0)
    CS_STAGE(oZ, raw.z, Wp[T][j], zimg);
    CS_STAGE(oR, raw.r, Wc[T][j], (LAS unsigned char*)nullptr);
    CS_STAGE(oB, raw.b, iW[T][j], slot + CS_BH);
    CS_STAGE(oK, raw.k, iW[T][j], slot + CS_KH);
    { bf16x8 oV[2]; CS_STAGE(oV, raw.v, 1.0f, slot + CS_VV); }
#undef CS_STAGE
    asm volatile("" ::: "memory");
    if (qn >= 0) cs_load(raw, sh, sd, d, qn, lane);
    const f32x4 zero4 = (f32x4){0.f, 0.f, 0.f, 0.f};
    f32x4 A_D = CS_MFMA(oB[1], oZ[1], CS_MFMA(oB[0], oZ[0], zero4)), AT_D = CS_MFMA(oZ[1], oB[1], CS_MFMA(oZ[0], oB[0], zero4));
    f32x4 BkT_D = CS_MFMA(oZ[1], oK[1], CS_MFMA(oZ[0], oK[0], zero4));
    f32x4 Ar_D = CS_MFMA(oB[1], oR[1], CS_MFMA(oB[0], oR[0], zero4)), Kr_D = CS_MFMA(oK[1], oR[1], CS_MFMA(oK[0], oR[0], zero4));
    f32x4 I_D;
#pragma unroll
    for (int j = 0; j < 4; ++j) { const int m = 4 * g + j;
        A_D[j] = m < s ? A_D[j] : 0.f; AT_D[j] = s < m ? AT_D[j] : 0.f; BkT_D[j] = s < m ? BkT_D[j] : 0.f;
        Ar_D[j] = m <= s ? Ar_D[j] : 0.f; Kr_D[j] = m <= s ? Kr_D[j] : 0.f; I_D[j] = m == s ? 1.f : 0.f; }
    f32x4 Ab, AbT, A1, A2m;
#pragma unroll
    for (int j = 0; j < 4; ++j) { const int m = 4 * g + j; const bool b0 = (m >> 2) == (s >> 2), b1 = (m >> 3) == (s >> 3);
        Ab[j] = b0 ? A_D[j] : 0.f; AbT[j] = b0 ? AT_D[j] : 0.f; A1[j] = (b1 && !b0) ? A_D[j] : 0.f; A2m[j] = b1 ? 0.f : A_D[j]; }
    const f32x4 Ab2 = cs_mm16(AbT, Ab), Ab2T = cs_mm16(Ab, AbT);
    const f32x4 P0 = I_D + Ab, P0T = I_D + AbT;
    const f32x4 T0 = P0 + cs_mm16(P0T, Ab2), T0T = P0T + cs_mm16(Ab2, P0T);
    (void)Ab2T;
    const f32x4 ZT = cs_mm16(A1, T0T);
    const f32x4 T1 = T0 + cs_mm16(ZT, T0), T1T = T0T + cs_mm16(T0, ZT);
    const f32x4 Z2T = cs_mm16(A2m, T1T);
    const f32x4 T_D = T1 + cs_mm16(Z2T, T1);
    const f32x4 M_D = cs_mm16(BkT_D, T_D), MT_D = cs_mm16(T_D, BkT_D);
    const f32x4 N_D = cs_mm16(MT_D, Ar_D) + Kr_D;
    { u32x4 w; w.x = cvt_pk_bf16(M_D[0], M_D[1]); w.y = cvt_pk_bf16(M_D[2], M_D[3]); w.z = 0u; w.w = 0u; *(LAS u32x4*)(slot + CS_MT + s * 64 + g * 16) = w;
      w.x = cvt_pk_bf16(N_D[0], N_D[1]); w.y = cvt_pk_bf16(N_D[2], N_D[3]); *(LAS u32x4*)(slot + CS_NT + s * 64 + g * 16) = w; }
    __builtin_amdgcn_wave_barrier(); asm volatile("" ::: "memory");
    const bf16x8 oT = cs_op16(T_D), oAr = cs_op16(Ar_D);
    float Zp[4][4];
#pragma unroll
    for (int T = 0; T < 4; ++T) { const f32x4 zp = CS_MFMA(cs_lo(cs_tr(zimg, lane, T)), oT, zero4);
#pragma unroll
        for (int j = 0; j < 4; ++j) Zp[T][j] = zp[j]; }
#pragma unroll
    for (int kk = 0; kk < 2; ++kk) *(LAS bf16x8*)(slot + CS_ZP + s * 128 + g * 32 + kk * 16) = cs_pack(Zp[2 * kk], Zp[2 * kk + 1]);
    __builtin_amdgcn_wave_barrier(); asm volatile("" ::: "memory");
    float Rp[4][4];
#pragma unroll
    for (int T = 0; T < 4; ++T) { const f32x4 rp = CS_MFMA(cs_lo(cs_tr(slot + CS_ZP, lane, T)), oAr, zero4);
#pragma unroll
        for (int j = 0; j < 4; ++j) Rp[T][j] = rp[j] + bf2f((bf16_t)oR[T >> 1][(T & 1) * 4 + j]); }
#pragma unroll
    for (int kk = 0; kk < 2; ++kk) *(LAS bf16x8*)(slot + CS_RPP + s * 128 + g * 32 + kk * 16) = cs_pack(Rp[2 * kk], Rp[2 * kk + 1]);
}
__device__ __forceinline__ void cs_scan_chunk(const LAS unsigned char* slot, f32x4 (&acc)[4], float* yp  , int d, int q, int wave, int lane) {
    const int s = lane & 15, g = lane >> 4;
    const f32x4 zero4 = (f32x4){0.f, 0.f, 0.f, 0.f};
    bf16x8 Xb[2];
#pragma unroll
    for (int kk = 0; kk < 2; ++kk) { u32x4 w; w.x = cvt_pk_bf16(acc[2 * kk][0], acc[2 * kk][1]); w.y = cvt_pk_bf16(acc[2 * kk][2], acc[2 * kk][3]);
        w.z = cvt_pk_bf16(acc[2 * kk + 1][0], acc[2 * kk + 1][1]); w.w = cvt_pk_bf16(acc[2 * kk + 1][2], acc[2 * kk + 1][3]); Xb[kk] = __builtin_bit_cast(bf16x8, w); }
    const v4i16_t vt = cs_tr(slot + CS_VV, lane, wave);
    const bf16x8 Vb = cs_lo(vt);
    const int arow = s * 128 + g * 32, a16 = s * 64 + g * 16;
    f32x4 UT = CS_MFMA(*(const LAS bf16x8*)(slot + CS_ZP + arow), Xb[0], zero4); UT = CS_MFMA(*(const LAS bf16x8*)(slot + CS_ZP + arow + 16), Xb[1], UT); UT = CS_MFMA(*(const LAS bf16x8*)(slot + CS_MT + a16), Vb, UT);
    f32x4 YT = CS_MFMA(*(const LAS bf16x8*)(slot + CS_RPP + arow), Xb[0], zero4); YT = CS_MFMA(*(const LAS bf16x8*)(slot + CS_RPP + arow + 16), Xb[1], YT); YT = CS_MFMA(*(const LAS bf16x8*)(slot + CS_NT + a16), Vb, YT);
#pragma unroll
    for (int j = 0; j < 4; ++j) yp[(size_t)cs_tt(d, q, 4 * g + j) * 256] = YT[j];
    bf16x8 UV; { u32x2 w; w.x = cvt_pk_bf16(UT[0], UT[1]); w.y = cvt_pk_bf16(UT[2], UT[3]); const v4i16_t ub = __builtin_bit_cast(v4i16_t, w);
        UV[0] = ub[0]; UV[1] = ub[1]; UV[2] = ub[2]; UV[3] = ub[3]; UV[4] = vt[0]; UV[5] = vt[1]; UV[6] = vt[2]; UV[7] = vt[3]; }
#pragma unroll
    for (int T = 0; T < 4; ++T) { const v4i16_t bh = cs_tr(slot + CS_BH, lane, T), kh = cs_tr(slot + CS_KH, lane, T);
        bf16x8 BK; BK[0] = bh[0]; BK[1] = bh[1]; BK[2] = bh[2]; BK[3] = bh[3]; BK[4] = kh[0]; BK[5] = kh[1]; BK[6] = kh[2]; BK[7] = kh[3];
        acc[T] = CS_MFMA(BK, UV, acc[T]);
        acc[T] *= *(const LAS f32x4*)(slot + CS_WC + (16 * T + 4 * g) * 4); }
}
__device__ __forceinline__ void phase_scan(const Frame& F) {
    const f16_t* SH = (const f16_t*)(F.ws + WS_SH); const f16_t* SD = (const f16_t*)(F.ws + WS_SD);
    float* Y = (float*)(F.ws + WS_Y);
    const int lane = F.lane, wave = F.wave;
    for (int chain = F.bid; chain < 64; chain += F.G) {
        const int d = chain >> 5, b = (chain >> 2) & 7, h = chain & 3;
        const f16_t* sh = SH + (size_t)(b * 4 + h) * TT * 192; const f16_t* sd = SD + (size_t)((d * 8 + b) * 4 + h) * TT * 192;
        float* yp = Y + ((size_t)(d * 8 + b) * TT) * 256 + h * 64 + 16 * (wave & 3) + (lane & 15);
        f32x4 acc[4];
#pragma unroll
        for (int T = 0; T < 4; ++T) acc[T] = (f32x4){0.f, 0.f, 0.f, 0.f};
        __syncthreads();
        CsRaw raw;
        constexpr int NR = CS_NCHUNK / 8;
        cs_load(raw, sh, sd, d, wave, lane);
        for (int R = 0; R < NR; ++R) {
            cs_prepass(F.lds + wave * CS_SLOT, F.lds + CS_ZIMG + wave * 2048, raw, sh, sd, d, (R + 1 < NR) ? 8 * (R + 1) + wave : -1, lane);
            asm volatile("s_waitcnt lgkmcnt(0)" ::: "memory"); __builtin_amdgcn_s_barrier(); asm volatile("" ::: "memory");
            if (wave < 4) {
#pragma unroll 1
                for (int c8 = 0; c8 < 8; ++c8) cs_scan_chunk(F.lds + c8 * CS_SLOT, acc, yp, d, 8 * R + c8, wave, lane);
            }
            asm volatile("s_waitcnt lgkmcnt(0)" ::: "memory"); __builtin_amdgcn_s_barrier(); asm volatile("" ::: "memory");
        }
    }
}

__device__ __forceinline__ void phase_rw_post(const Frame& F, const Params& P, int l, int nrows) {
    const bf16_t* PL = (const bf16_t*)(F.ws + WS_PL); bf16_t* MIX = (bf16_t*)(F.ws + WS_MIX);
    const f16_t* SH = (const f16_t*)(F.ws + WS_SH); const f16_t* SD = (const f16_t*)(F.ws + WS_SD); const float* Y = (const float*)(F.ws + WS_Y);
    const int lane = F.lane;
    rw_stage_tables(F, P, l);
    const LAS float* T = (const LAS float*)F.lds;
    for (int item = F.gw; item < NLAT / 16 + ((nrows - NLAT) / 16) * 4; item += F.nw) {
        const int tile = item < NLAT / 16 ? item : NLAT / 16 + ((item - NLAT / 16) >> 2), h0 = item < NLAT / 16 ? 0 : ((item - NLAT / 16) & 3), h1 = item < NLAT / 16 ? 4 : h0 + 1;
        int l1 = lane; asm volatile("" : "+v"(l1)); const int tk = l1 & 15, g = l1 >> 4;
        const int r = tile * 16 + tk; const RowGeo geo = row_geo(r);
        const bool hp = geo.pos > 0, hn = geo.pos < geo.len - 1;
        const bf16_t* prow = PL + (size_t)r * INW + O_RW; const int dprev = hp ? -INW : 0, dnext = hn ? INW : 0;
        bf16x8 sg[2][4];
#pragma unroll
        for (int d = 0; d < 2; ++d) { u32x4 raw[4][3];
#pragma unroll
            for (int kk = 0; kk < 4; ++kk) { const bf16_t* p = prow + 896 + 256 * d + 32 * kk + 8 * g;
                raw[kk][0] = *(const u32x4*)p; raw[kk][1] = *(const u32x4*)(p + dprev); raw[kk][2] = *(const u32x4*)(p + dnext); }
#pragma unroll
            for (int kk = 0; kk < 4; ++kk) { float u[8]; rw_mix8(T, raw[kk], hp, hn, 896 + 256 * d + 32 * kk + 8 * g, u);
#pragma unroll
                for (int q = 0; q < 8; ++q) u[q] = sigmoidf_(u[q]);
                sg[d][kk] = pack8f(u); }
            asm volatile("" ::: "memory"); }
#pragma unroll 1
        for (int h = h0; h < h1; ++h) {
            int l2 = lane; asm volatile("" : "+v"(l2)); const int tk = l2 & 15, g = l2 >> 4;
            const int r = tile * 16 + tk; const RowGeo geo = row_geo(r);
            const size_t shrow = ((size_t)(geo.b * 4 + h) * TT + geo.tt) * 192;
            float out[4][4];
#pragma unroll
            for (int t = 0; t < 4; ++t)
#pragma unroll
                for (int q = 0; q < 4; ++q) out[t][q] = 0.f;
            f16x8 rh[2], vh[2];
#pragma unroll
            for (int u = 0; u < 2; ++u) { rh[u] = *(const f16x8*)(SH + shrow + 32 * u + 8 * g); vh[u] = *(const f16x8*)(SH + shrow + 64 + 32 * u + 8 * g); }
#pragma unroll 1
            for (int d = 0; d < 2; ++d) {
                const bf16_t* g2t = (const bf16_t*)(F.ws + WS_LORA + (size_t)(l * 2 + d) * LORA_LD_BYTES) + 2 * 256 * 64;
                const size_t sdrow = ((size_t)((d * 8 + geo.b) * 4 + h) * TT + geo.tt) * 192;
                const float* yrow = Y + ((size_t)(d * 8 + geo.b) * TT + geo.tt) * 256 + 64 * h + 8 * g;
                bf16x8 sgd[4];
#pragma unroll
                for (int kk = 0; kk < 4; ++kk) sgd[kk] = d ? sg[1][kk] : sg[0][kk];
                f32x4 y[4], gg[4]; f16x8 kdh[2]; bf16x8 gf[4][4];
#pragma unroll
                for (int u = 0; u < 2; ++u) { y[2 * u] = *(const f32x4*)(yrow + 32 * u); y[2 * u + 1] = *(const f32x4*)(yrow + 32 * u + 4); kdh[u] = *(const f16x8*)(SD + sdrow + 64 + 32 * u + 8 * g); }
#pragma unroll
                for (int t = 0; t < 4; ++t) { const bf16_t* gr = g2t + (size_t)(64 * h + 32 * (t >> 1) + 8 * (tk >> 2) + 4 * (t & 1) + (tk & 3)) * 128 + 8 * g;
#pragma unroll
                    for (int kk = 0; kk < 4; ++kk) gf[t][kk] = *(const bf16x8*)(gr + 32 * kk); }
                float sm = 0.f, bs = 0.f;
#pragma unroll
                for (int t = 0; t < 4; ++t) { const int c = 64 * h + 32 * (t >> 1) + 8 * g + 4 * (t & 1);
                    sm += (y[t][0] + y[t][1]) + (y[t][2] + y[t][3]);
                    const f32x4 rk = *(const LAS f32x4*)(T + RL_RK / 4 + c);
#pragma unroll
                    for (int q = 0; q < 4; ++q) bs += (float)rh[t >> 1][(t & 1) * 4 + q] * (float)kdh[t >> 1][(t & 1) * 4 + q] * rk[q];
                    f32x4 a = (f32x4){0.f, 0.f, 0.f, 0.f};
#pragma unroll
                    for (int kk = 0; kk < 4; ++kk) a = __builtin_amdgcn_mfma_f32_16x16x32_bf16(gf[t][kk], sgd[kk], a, 0, 0, 0);
                    gg[t] = a; }
                sm += __shfl_xor(sm, 16); sm += __shfl_xor(sm, 32); bs += __shfl_xor(bs, 16); bs += __shfl_xor(bs, 32);
                const float mu = sm * (1.0f / 64.0f); float vs = 0.f;
#pragma unroll
                for (int t = 0; t < 4; ++t)
#pragma unroll
                    for (int q = 0; q < 4; ++q) { const float dd = y[t][q] - mu; vs += dd * dd; }
                vs += __shfl_xor(vs, 16); vs += __shfl_xor(vs, 32);
                const float rstd = rsqrtf(vs * (1.0f / 64.0f) + 64e-5f);
#pragma unroll
                for (int t = 0; t < 4; ++t) { const int c = 64 * h + 32 * (t >> 1) + 8 * g + 4 * (t & 1);
                    const f32x4 gng = *(const LAS f32x4*)(T + RL_GNG / 4 + c), gnb = *(const LAS f32x4*)(T + RL_GNB / 4 + c);
#pragma unroll
                    for (int q = 0; q < 4; ++q) out[t][q] += ((y[t][q] - mu) * rstd * gng[q] + gnb[q] + bs * (float)vh[t >> 1][(t & 1) * 4 + q]) * gg[t][q]; }
                asm volatile("" ::: "memory");
            }
#pragma unroll
            for (int u = 0; u < 2; ++u) { u32x4 w; w.x = cvt_pk_bf16(out[2 * u][0], out[2 * u][1]); w.y = cvt_pk_bf16(out[2 * u][2], out[2 * u][3]); w.z = cvt_pk_bf16(out[2 * u + 1][0], out[2 * u + 1][1]); w.w = cvt_pk_bf16(out[2 * u + 1][2], out[2 * u + 1][3]);
                *(u32x4*)(MIX + (size_t)r * D + 512 + 64 * h + 32 * u + 8 * g) = w; }
        }
    }
    __syncthreads();
}

constexpr int CV_SEG = 64, CV_ROWS = CV_SEG + 30, CV_H = 0, CV_W = CV_ROWS * 256 * 4;
__device__ __forceinline__ void phase_conv(const Frame& F, const Params& P, int l, int nrows) {
    const bf16_t* PL = (const bf16_t*)(F.ws + WS_PL); bf16_t* MIX = (bf16_t*)(F.ws + WS_MIX);
    const int lane = F.lane, c4 = lane * 4, wave = F.wave;
    LAS float* H = (LAS float*)(F.lds + CV_H); LAS float* W = (LAS float*)(F.lds + CV_W);
    for (int i = F.tid; i < 31 * 256; i += NTHREADS) W[i] = P.in[I_DWW][(size_t)l * 31 * 256 + i];
    const f32x4 dwb = *(const f32x4*)(P.in[I_DWB] + l * 256 + c4), lng = *(const f32x4*)(P.in[I_LNG] + l * 256 + c4), lnb = *(const f32x4*)(P.in[I_LNB] + l * 256 + c4);
    for (int seg = F.bid; seg < nrows / CV_SEG; seg += F.G) {
        const int r0 = seg * CV_SEG; const RowGeo g0 = row_geo(r0);
        __syncthreads();
#pragma unroll 4
        for (int k = 0; k < 12; ++k) { const int rr = wave + 8 * k;
            if (rr < CV_ROWS) { const int pos = g0.pos - 15 + rr; f32x4 hv = (f32x4){0.f, 0.f, 0.f, 0.f};
                if (pos >= 0 && pos < g0.len) { const bf16_t* p = PL + (size_t)(r0 - 15 + rr) * INW + O_CV + c4; float a[4], bb[4];
                    unpack4(*(const u32x2*)p, a); unpack4(*(const u32x2*)(p + 256), bb);
#pragma unroll
                    for (int q = 0; q < 4; ++q) hv[q] = a[q] * sigmoidf_(bb[q]); }
                *(LAS f32x4*)(H + rr * 256 + c4) = hv; } }
        __syncthreads();
        f32x4 acc[8];
#pragma unroll
        for (int t = 0; t < 8; ++t) acc[t] = dwb;
#pragma unroll 1
        for (int j = 0; j < 31; ++j) { const f32x4 w = *(const LAS f32x4*)(W + j * 256 + c4);
#pragma unroll
            for (int t = 0; t < 8; ++t) acc[t] += *(const LAS f32x4*)(H + (wave * 8 + t + j) * 256 + c4) * w; }
#pragma unroll
        for (int t = 0; t < 8; ++t) {
            const float mu = wave_sum((acc[t][0] + acc[t][1]) + (acc[t][2] + acc[t][3])) * (1.0f / 256.0f);
            float vs = 0.f;
#pragma unroll
            for (int q = 0; q < 4; ++q) { const float dd = acc[t][q] - mu; vs += dd * dd; }
            const float rstd = rsqrtf(wave_sum(vs) * (1.0f / 256.0f) + 1e-5f);
            float o[4];
#pragma unroll
            for (int q = 0; q < 4; ++q) o[q] = siluf_((acc[t][q] - mu) * rstd * lng[q] + lnb[q]);
            u32x2 w; w.x = pk_bf16(o[0], o[1]); w.y = pk_bf16(o[2], o[3]);
            *(u32x2*)(MIX + (size_t)(r0 + wave * 8 + t) * D + 768 + c4) = w; }
    }
}

__device__ __forceinline__ void phase_na_simple(const Frame& F, const Params& P, int l, int nq) {
    const bf16_t* PL = (const bf16_t*)(F.ws + WS_PL); bf16_t* MIX = (bf16_t*)(F.ws + WS_MIX);
    const float* rpb = P.in[I_RPB] + (size_t)l * 8 * 15 * 31;
    int tid_ = F.tid; asm volatile("" : "+v"(tid_));
    for (int gid = F.bid * NTHREADS + tid_; gid < nq * 8; gid += F.G * NTHREADS) {
        const int r = gid >> 3, h = gid & 7;
        const RowGeo g = row_geo(r);
        float q[64], o[64];
        { const bf16_t* qp = PL + (size_t)r * INW + O_Q + h * 64;
#pragma unroll
          for (int i = 0; i < 8; ++i) unpack8(*(const u32x4*)(qp + i * 8), q + i * 8); }
#pragma unroll
        for (int i = 0; i < 64; ++i) o[i] = 0.f;
        float m = -3.0e38f, lsum = 0.f;
        const bool lat = r < NLAT;
        const int gi = g.pos >> 6, gc = g.pos & 63;
        const int rs = min(max(gi - 4, 0), 56), wsc = min(max(gc - 8, 0), 48);
        const int nkey = lat ? 384 : 256;
#pragma unroll 1
        for (int kx = 0; kx < nkey; ++kx) {
            const bool win = lat && kx < 128;
            int krow; float bias = 0.f;
            if (win) { const int r8 = kx >> 4, cc = kx & 15; krow = g.b * SEQ + (rs + r8) * 64 + wsc + cc; bias = rpb[(h * 15 + (rs + r8 - gi + 7)) * 31 + (wsc + cc - gc + 15)]; }
            else krow = NLAT + g.b * CTXL + (kx - (lat ? 128 : 0));
            const bf16_t* kp = PL + (size_t)krow * INW + O_K + h * 64; float a = bias;
#pragma unroll
            for (int i = 0; i < 8; ++i) { float kf[8]; unpack8(*(const u32x4*)(kp + i * 8), kf);
#pragma unroll
                for (int j = 0; j < 8; ++j) a += q[i * 8 + j] * kf[j]; }
            if (a > m) { const float alpha = __expf(m - a); lsum *= alpha;
#pragma unroll
                for (int i = 0; i < 64; ++i) o[i] *= alpha;
                m = a; }
            const float p = __expf(a - m); lsum += p;
            const bf16_t* vp = kp + (O_V - O_K);
#pragma unroll
            for (int i = 0; i < 8; ++i) { float vf[8]; unpack8(*(const u32x4*)(vp + i * 8), vf);
#pragma unroll
                for (int j = 0; j < 8; ++j) o[i * 8 + j] += p * vf[j]; }
        }
        const float inv = 1.0f / lsum;
        bf16_t* op = MIX + (size_t)r * D + h * 64;
#pragma unroll
        for (int i = 0; i < 8; ++i) { u32x4 w; w.x = pk_bf16(o[i * 8] * inv, o[i * 8 + 1] * inv); w.y = pk_bf16(o[i * 8 + 2] * inv, o[i * 8 + 3] * inv);
            w.z = pk_bf16(o[i * 8 + 4] * inv, o[i * 8 + 5] * inv); w.w = pk_bf16(o[i * 8 + 6] * inv, o[i * 8 + 7] * inv); *(u32x4*)(op + i * 8) = w; }
    }
}

constexpr int NA_CK = 0, NA_CV = 32768, NA_RPB = 65536, NA_WV = 81920;
__device__ __forceinline__ bf16x8 na_pack8(const f32x4& a, const f32x4& b) {
    u32x4 w; w.x = cvt_pk_bf16(a[0], a[1]); w.y = cvt_pk_bf16(a[2], a[3]); w.z = cvt_pk_bf16(b[0], b[1]); w.w = cvt_pk_bf16(b[2], b[3]); return __builtin_bit_cast(bf16x8, w);
}
__device__ __forceinline__ bf16x8 na_vfrag(LAS unsigned char* blk, int lane, int dt) {
    const int g = lane >> 4, qq = (lane & 15) >> 2, p = lane & 3;
    const int r0 = 4 * g + qq, r1 = 16 + 4 * g + qq;
    const v4i16_t lo = __builtin_amdgcn_ds_read_tr16_b64_v4i16((LAS v4i16_t*)(blk + r0 * 128 + ((dt ^ ((r0 >> 1) & 3)) * 32) + p * 8));
    const v4i16_t hi = __builtin_amdgcn_ds_read_tr16_b64_v4i16((LAS v4i16_t*)(blk + r1 * 128 + ((dt ^ ((r1 >> 1) & 3)) * 32) + p * 8));
    bf16x8 r; r[0] = lo[0]; r[1] = lo[1]; r[2] = lo[2]; r[3] = lo[3]; r[4] = hi[0]; r[5] = hi[1]; r[6] = hi[2]; r[7] = hi[3]; return r;
}
template <bool WINDOW>
__device__ __forceinline__ void na_item(const Frame& F, const bf16_t* PL, bf16_t* MIX, int b, int h, int qrow0  , int gi, int cb) {
    const int lane = F.lane, ql = lane & 15, g = lane >> 4;
    LAS unsigned char* CK = F.lds + NA_CK; LAS unsigned char* CV = F.lds + NA_CV; const LAS float* RPB = (const LAS float*)(F.lds + NA_RPB);
    LAS unsigned char* WV = F.lds + NA_WV + F.wave * 4096;
    bf16x8 Qf[2];
    { const bf16_t* qp = PL + (size_t)(qrow0 + ql) * INW + O_Q + h * 64 + 8 * g; Qf[0] = *(const bf16x8*)qp; Qf[1] = *(const bf16x8*)(qp + 32); }
    f32x4 acc[4];
#pragma unroll
    for (int dt = 0; dt < 4; ++dt) acc[dt] = (f32x4){0.f, 0.f, 0.f, 0.f};
    float m_run = -3.0e38f, l_run = 0.f;
    if constexpr (WINDOW) {
        const int rs = min(max(gi - 4, 0), 56), kc0 = min(max(16 * cb - 8, 0), 32), qcol = 16 * cb + ql, wsq = min(max(qcol - 8, 0), 48);
        const size_t krow0 = (size_t)b * SEQ + (size_t)rs * 64 + kc0;
        f32x4 s[16];
#pragma unroll
        for (int t = 0; t < 16; ++t) { const bf16_t* kp = PL + (krow0 + (size_t)(t >> 1) * 64 + (t & 1) * 16 + ql) * INW + O_K + h * 64 + 8 * g;
            const bf16x8 k0 = *(const bf16x8*)kp, k1 = *(const bf16x8*)(kp + 32);
            s[t] = __builtin_amdgcn_mfma_f32_16x16x32_bf16(k0, Qf[0], (f32x4){0.f, 0.f, 0.f, 0.f}, 0, 0, 0);
            s[t] = __builtin_amdgcn_mfma_f32_16x16x32_bf16(k1, Qf[1], s[t], 0, 0, 0); }
        const int vr = lane >> 1, part = lane & 1;
        const bf16_t* vbase = PL + (krow0 + vr) * INW + O_V + h * 64 + part * 32;
        u32x4 vbuf[4][4];
#pragma unroll
        for (int k = 0; k < 4; ++k) { const bf16_t* vp = vbase + (size_t)k * 64 * INW; vbuf[k][0] = *(const u32x4*)vp; vbuf[k][1] = *(const u32x4*)(vp + 8); vbuf[k][2] = *(const u32x4*)(vp + 16); vbuf[k][3] = *(const u32x4*)(vp + 24); }
        float mx = -3.0e38f;
#pragma unroll
        for (int t = 0; t < 16; ++t) { const LAS float* bp = RPB + (h * 15 + (rs + (t >> 1) - gi + 7)) * 31 + 15 - qcol;
#pragma unroll
            for (int j = 0; j < 4; ++j) { const int kcol = kc0 + (t & 1) * 16 + 4 * g + j; const bool ok = kcol >= wsq && kcol < wsq + 16;
                const float v = ok ? s[t][j] + bp[ok ? kcol : qcol] : -INFINITY; s[t][j] = v; mx = fmaxf(mx, v); } }
        mx = fmaxf(mx, __shfl_xor(mx, 16)); mx = fmaxf(mx, __shfl_xor(mx, 32));
        m_run = mx;
        float ls = 0.f;
#pragma unroll
        for (int t = 0; t < 16; ++t)
#pragma unroll
            for (int j = 0; j < 4; ++j) { const float p = __expf(s[t][j] - mx); s[t][j] = p; ls += p; }
        l_run = ls;
#pragma unroll
        for (int r8 = 0; r8 < 8; ++r8) {
            { LAS unsigned char* wr = WV + vr * 128; const int sw = (vr >> 1) & 3;
              *(LAS u32x4*)(wr + (((2 * part) ^ sw) * 32)) = vbuf[r8 & 3][0]; *(LAS u32x4*)(wr + (((2 * part) ^ sw) * 32) + 16) = vbuf[r8 & 3][1];
              *(LAS u32x4*)(wr + (((2 * part + 1) ^ sw) * 32)) = vbuf[r8 & 3][2]; *(LAS u32x4*)(wr + (((2 * part + 1) ^ sw) * 32) + 16) = vbuf[r8 & 3][3];
              if (r8 + 4 < 8) { const bf16_t* vp = vbase + (size_t)(r8 + 4) * 64 * INW;
                  vbuf[r8 & 3][0] = *(const u32x4*)vp; vbuf[r8 & 3][1] = *(const u32x4*)(vp + 8); vbuf[r8 & 3][2] = *(const u32x4*)(vp + 16); vbuf[r8 & 3][3] = *(const u32x4*)(vp + 24); } }
            __builtin_amdgcn_wave_barrier(); asm volatile("" ::: "memory");
            const bf16x8 pf = na_pack8(s[2 * r8], s[2 * r8 + 1]);
#pragma unroll
            for (int dt = 0; dt < 4; ++dt) { const bf16x8 vf = na_vfrag(WV, lane, dt); acc[dt] = __builtin_amdgcn_mfma_f32_16x16x32_bf16(vf, pf, acc[dt], 0, 0, 0); }
            __builtin_amdgcn_wave_barrier(); asm volatile("" ::: "memory");
        }
    }
    {
        f32x4 s[16];
#pragma unroll
        for (int t = 0; t < 16; ++t) { const int key = 16 * t + ql; const LAS unsigned char* kr = CK + key * 128;
            const bf16x8 k0 = *(const LAS bf16x8*)(kr + ((g ^ (key & 7)) * 16)), k1 = *(const LAS bf16x8*)(kr + (((g + 4) ^ (key & 7)) * 16));
            s[t] = __builtin_amdgcn_mfma_f32_16x16x32_bf16(k0, Qf[0], (f32x4){0.f, 0.f, 0.f, 0.f}, 0, 0, 0);
            s[t] = __builtin_amdgcn_mfma_f32_16x16x32_bf16(k1, Qf[1], s[t], 0, 0, 0); }
        float mx = m_run;
#pragma unroll
        for (int t = 0; t < 16; ++t)
#pragma unroll
            for (int j = 0; j < 4; ++j) mx = fmaxf(mx, s[t][j]);
        mx = fmaxf(mx, __shfl_xor(mx, 16)); mx = fmaxf(mx, __shfl_xor(mx, 32));
        const float alpha = __expf(m_run - mx);
        float ls = l_run * alpha;
#pragma unroll
        for (int dt = 0; dt < 4; ++dt) acc[dt] *= alpha;
#pragma unroll
        for (int t = 0; t < 16; ++t)
#pragma unroll
            for (int j = 0; j < 4; ++j) { const float p = __expf(s[t][j] - mx); s[t][j] = p; ls += p; }
        l_run = ls;
#pragma unroll
        for (int blk = 0; blk < 8; ++blk) { const bf16x8 pf = na_pack8(s[2 * blk], s[2 * blk + 1]);
#pragma unroll
            for (int dt = 0; dt < 4; ++dt) { const bf16x8 vf = na_vfrag(CV + blk * 4096, lane, dt); acc[dt] = __builtin_amdgcn_mfma_f32_16x16x32_bf16(vf, pf, acc[dt], 0, 0, 0); } }
    }
    float lt = l_run; lt += __shfl_xor(lt, 16); lt += __shfl_xor(lt, 32);
    const float inv = 1.0f / lt;
    bf16_t* op = MIX + (size_t)(qrow0 + ql) * D + h * 64 + 4 * g;
#pragma unroll
    for (int dt = 0; dt < 4; ++dt) { u32x2 w; w.x = cvt_pk_bf16(acc[dt][0] * inv, acc[dt][1] * inv); w.y = cvt_pk_bf16(acc[dt][2] * inv, acc[dt][3] * inv); *(u32x2*)(op + dt * 16) = w; }
}
__device__ __forceinline__ void phase_na_mfma(const Frame& F, const Params& P, int l, bool ctx_queries) {
    const bf16_t* PL = (const bf16_t*)(F.ws + WS_PL); bf16_t* MIX = (bf16_t*)(F.ws + WS_MIX);
    int tid_ = F.tid; asm volatile("" : "+v"(tid_));
    const int tid = tid_;
    { const float* rpb = P.in[I_RPB] + (size_t)l * 8 * 15 * 31; LAS float* R = (LAS float*)(F.lds + NA_RPB); for (int i = tid; i < 8 * 15 * 31; i += NTHREADS) R[i] = rpb[i]; }
    for (int unit = F.bid; unit < 512; unit += F.G) {
        const int eighth = unit & 7, h = (unit >> 3) & 7, b = unit >> 6;
        __syncthreads();
        { int t2 = tid; asm volatile("" : "+v"(t2)); const int key = t2 >> 1, part = t2 & 1; const bf16_t* kp = PL + (size_t)(NLAT + b * CTXL + key) * INW + O_K + h * 64 + part * 32; const bf16_t* vp = kp + (O_V - O_K);
          LAS unsigned char* kr = F.lds + NA_CK + key * 128; LAS unsigned char* vr = F.lds + NA_CV + key * 128; const int sw = (key >> 1) & 3;
#pragma unroll
          for (int c = 0; c < 4; ++c) { *(LAS u32x4*)(kr + (((4 * part + c) ^ (key & 7)) * 16)) = *(const u32x4*)(kp + 8 * c);
              const int c16 = 4 * part + c; *(LAS u32x4*)(vr + (((c16 >> 1) ^ sw) * 32) + (c16 & 1) * 16) = *(const u32x4*)(vp + 8 * c); } }
        __syncthreads();
        for (int it = F.wave; it < 32; it += NWAVES) { const int gi = eighth * 8 + (it >> 2), cb = it & 3;
            na_item<true>(F, PL, MIX, b, h, b * SEQ + gi * 64 + cb * 16, gi, cb); }
        if (ctx_queries && F.wave < 2) na_item<false>(F, PL, MIX, b, h, NLAT + b * CTXL + (eighth * 2 + F.wave) * 16, 0, 0);
    }
}

__device__ __forceinline__ void phase_final(const Frame& F, const Params& P) {
    float* out = P.out; const float* g = P.in[I_FINALG]; const int lane = F.lane;
    for (int r = F.gw; r < NLAT; r += F.nw) {
        float* xr = out + (size_t)r * D; f32x4 x[4]; float ss = 0.f;
#pragma unroll
        for (int j = 0; j < 4; ++j) { x[j] = *(const f32x4*)(xr + j * 256 + lane * 4); ss += x[j][0] * x[j][0] + x[j][1] * x[j][1] + x[j][2] * x[j][2] + x[j][3] * x[j][3]; }
        ss = wave_sum(ss); const float rstd = rsqrtf(ss * (1.0f / D) + 1e-6f);
#pragma unroll
        for (int j = 0; j < 4; ++j) { const f32x4 gg = *(const f32x4*)(g + j * 256 + lane * 4); *(f32x4*)(xr + j * 256 + lane * 4) = x[j] * rstd * gg; }
    }
}

constexpr int PH_L0 = 1, PH_PER_L0 = 9, PH_L1 = PH_L0 + PH_PER_L0, PH_PER_L1 = 12, PH_FINAL = PH_L1 + PH_PER_L1, N_PHASES = PH_FINAL + 1;
#define RFL(x) __builtin_amdgcn_readfirstlane(x)

PHASE ph_prologue(const void* kp_, int wv_) { PHASE_ENTER; if constexpr (MKB(0)) phase_prologue(F, P); }
PHASE ph_norm1(const void* kp_, int wv_, int l_) { PHASE_ENTER; const int l = RFL(l_);
    if constexpr (MKB(1)) phase_norm<false>(F, P, l, 0, NROW, l == 0 ? P.in[I_X] : P.out, l == 0 ? P.in[I_CTX] : (const float*)(F.ws + WS_XC)); }
PHASE_INL ph_gemm_win(const void* kp_, int wv_, int l_) { PHASE_ENTER; const int l = RFL(l_);
    pg8::DenseSched S; S.init(NROW / 256, INW / 256, F.G, F.bid); S.A = (const bf16_t*)(F.ws + WS_HL); S.Bt = (const bf16_t*)(F.ws + WS_BTIN) + (size_t)l * INW * D; S.K = D;
    pg8::EpiBf16 E{(bf16_t*)(F.ws + WS_PL), INW, 2, 0.125f};
    if constexpr (MKB(2)) pg8::gemm_phase<pg8::EpiBf16, pg8::DenseSched, false>(F.lds, D, S, E, F.wave); }
PHASE_INL ph_rw_prep(const void* kp_, int wv_, int l_) { PHASE_ENTER; const int l = RFL(l_); if constexpr (MKB(3)) phase_rw_prep(F, P, l); }
PHASE ph_conv(const void* kp_, int wv_, int l_, int bid_, int G_) { PHASE_ENTER; const int l = RFL(l_); if constexpr (MKB(4)) phase_conv(sub_frame(F, RFL(bid_), RFL(G_)), P, l, l == 0 ? NROW : NLAT); }
PHASE_INL ph_na(const void* kp_, int wv_, int l_, int bid_, int G_) { PHASE_ENTER; const int l = RFL(l_); if constexpr (MKB(5)) phase_na_mfma(sub_frame(F, RFL(bid_), RFL(G_)), P, l, l == 0); }
PHASE_INL ph_scan(const void* kp_, int wv_, int bid_, int G_) { PHASE_ENTER; if constexpr (MKB(6)) phase_scan(sub_frame(F, RFL(bid_), RFL(G_))); }
PHASE_INL ph_rw_post(const void* kp_, int wv_, int l_) { PHASE_ENTER; const int l = RFL(l_); if constexpr (MKB(7)) phase_rw_post(F, P, l, l == 0 ? NROW : NLAT); }
PHASE_INL ph_gemm_wout(const void* kp_, int wv_, int l_) { PHASE_ENTER; const int l = RFL(l_);
    float* XC = (float*)(F.ws + WS_XC);
    pg8::DenseSched S; S.init((l == 0 ? NROW : NLAT) / 256, D / 256, F.G, F.bid); S.A = (const bf16_t*)(F.ws + WS_MIX); S.Bt = (const bf16_t*)(F.ws + WS_BTOUT) + (size_t)l * D * D; S.K = D;
    pg8::EpiRes E{l == 0 ? P.in[I_X] : P.out, l == 0 ? P.in[I_CTX] : XC, P.out, XC, (const float*)(F.ws + WS_MODV) + (size_t)l * 9 * MODW + 2 * D};
    if constexpr (MKB(8)) pg8::gemm_phase<pg8::EpiRes, pg8::DenseSched, false>(F.lds, D, S, E, F.wave); }
PHASE ph_norm2_l0(const void* kp_, int wv_) { PHASE_ENTER; if constexpr (MKB(9)) phase_norm<false>(F, P, 0, 1, NROW, P.out, (const float*)(F.ws + WS_XC)); }
PHASE_INL ph_gemm_ffn_gu(const void* kp_, int wv_) { PHASE_ENTER;
    pg8::DenseSched S; S.init(NROW / 256, (2 * DFF) / 256, F.G, F.bid); S.A = (const bf16_t*)(F.ws + WS_HL); S.Bt = (const bf16_t*)(F.ws + WS_BTGU); S.K = D;
    pg8::EpiSwiGLU E{(bf16_t*)(F.ws + WS_H), DFF};
    if constexpr (MKB(10)) pg8::gemm_phase<pg8::EpiSwiGLU, pg8::DenseSched, false>(F.lds, D, S, E, F.wave); }
PHASE_INL ph_gemm_ffn_dn(const void* kp_, int wv_) { PHASE_ENTER;
    float* XC = (float*)(F.ws + WS_XC);
    pg8::DenseSched S; S.init(NROW / 256, D / 256, F.G, F.bid); S.A = (const bf16_t*)(F.ws + WS_H); S.Bt = (const bf16_t*)(F.ws + WS_BTDN); S.K = DFF;
    pg8::EpiRes E{P.out, XC, P.out, XC, (const float*)(F.ws + WS_MODV) + 5 * D};
    if constexpr (MKB(11)) pg8::gemm_phase<pg8::EpiRes, pg8::DenseSched, false>(F.lds, DFF, S, E, F.wave); }
PHASE ph_norm2_l1(const void* kp_, int wv_) { PHASE_ENTER; if constexpr (MKB(12)) phase_norm<true>(F, P, 1, 1, NLAT, P.out, (const float*)(F.ws + WS_XC)); }
PHASE ph_moe_prep(const void* kp_, int wv_) { PHASE_ENTER; if constexpr (MKB(13)) { phase_moe_rowmap(F); phase_moe_convert(F, P); } }
PHASE_INL ph_gemm_moe_gu(const void* kp_, int wv_, int pass_) { PHASE_ENTER; const int pass = RFL(pass_);
    pg8::MoeSched S; moe_tstart(F, pass, S.tstart); S.init(S.tstart[8], (2 * DFE) / 256, F.G, F.bid);
    S.A = (const bf16_t*)(F.ws + WS_HL); S.Bt0 = F.ws + WS_MOE; S.e_stride = MOE_E_BYTES; S.K = D; S.rowmap = (const int*)(F.ws + WS_ROUTE + RT_RMAP) + pass * NROW;
    pg8::EpiSwiGLU E{(bf16_t*)(F.ws + WS_H), DFE};
    if constexpr (MKB(14)) pg8::gemm_phase<pg8::EpiSwiGLU, pg8::MoeSched, true>(F.lds, D, S, E, F.wave); }
PHASE_INL ph_gemm_moe_dn(const void* kp_, int wv_, int pass_) { PHASE_ENTER; const int pass = RFL(pass_);
    pg8::MoeSched S; moe_tstart(F, pass, S.tstart); S.init(S.tstart[8], D / 256, F.G, F.bid);
    S.A = (const bf16_t*)(F.ws + WS_H); S.Bt0 = F.ws + WS_MOE + MOE_GU_BYTES; S.e_stride = MOE_E_BYTES; S.K = DFE; S.rowmap = nullptr;
    pg8::EpiMoeDown E{P.out, (const float*)(F.ws + WS_MODV) + (size_t)9 * MODW + 5 * D, (const int*)(F.ws + WS_ROUTE + RT_RMAP) + pass * NROW, (const float*)(F.ws + WS_ROUTE + RT_SGATE) + pass * NROW};
    if constexpr (MKB(15)) pg8::gemm_phase<pg8::EpiMoeDown, pg8::MoeSched, false>(F.lds, DFE, S, E, F.wave); }
PHASE ph_final(const void* kp_, int wv_) { PHASE_ENTER; if constexpr (MKB(16)) phase_final(F, P); }

static __attribute__((noinline)) __device__ void grid_barrier(const void* bar_, unsigned x_, int wv_) {
    const unsigned long long v = (unsigned long long)bar_;
    const unsigned lo = __builtin_amdgcn_readfirstlane((unsigned)v), hi = __builtin_amdgcn_readfirstlane((unsigned)(v >> 32));
    XcdBarrier b; b.bar = (unsigned*)(((unsigned long long)hi << 32) | lo); b.x = __builtin_amdgcn_readfirstlane(x_);
    b.st = (volatile LAS unsigned*)((LAS unsigned char*)lds_raw + LDS_MISC);
    xcd_barrier(b, __builtin_amdgcn_readfirstlane(wv_) * 64 + lane_id());
}
__device__ __forceinline__ bool ph_in(int lo, int hi, int k) { asm volatile("" : "+s"(lo), "+s"(hi)); return lo <= k && k < hi; }

__global__ void __launch_bounds__(NTHREADS, 2) mk_fwd(Params P) {
    const void* kp = (const void*)__builtin_amdgcn_kernarg_segment_ptr();
    LAS unsigned char* lds = (LAS unsigned char*)lds_raw;
    volatile LAS unsigned* misc = (volatile LAS unsigned*)(lds + LDS_MISC);
    const int wv = __builtin_amdgcn_readfirstlane((int)(threadIdx.x >> 6));
    if (wv == 0 && lane_id() < 4) misc[lane_id()] = 0u;
    __syncthreads();
    const int lo = P.ph_lo, hi = P.ph_hi;
    XcdBarrier bar; bar.bar = (unsigned*)(P.ws + WS_CTL) + CW_BAR; bar.x = 0; bar.st = misc;
    if (hi - lo > 1) bar = xcd_barrier_post((unsigned*)(P.ws + WS_CTL) + CW_BAR, misc, wv * 64 + lane_id());
#define IN(k) ph_in(lo, hi, (k))
#define SEAM(k) do { if (IN((k) + 1)) grid_barrier((const void*)bar.bar, bar.x, wv); } while (0)
    if (IN(0)) { for (int rep = 0; rep < REP_PRO; ++rep) ph_prologue(kp, wv); SEAM(0); }
#define LAYER_COMMON(l, pb) \
    if (IN((pb) + 0)) { for (int rep = 0; rep < REP_NORM; ++rep) ph_norm1(kp, wv, (l)); SEAM((pb) + 0); } \
    if (IN((pb) + 1)) { for (int rep = 0; rep < REP_GEMM; ++rep) ph_gemm_win(kp, wv, (l)); SEAM((pb) + 1); } \
    if (IN((pb) + 2)) { for (int rep = 0; rep < REP_PP; ++rep) ph_rw_prep(kp, wv, (l)); SEAM((pb) + 2); } \
    if (IN((pb) + 3)) { const int bx = (int)blockIdx.x, Gx = (int)gridDim.x; \
        if (Gx == 256) { if (bx < 64) { for (int rep = 0; rep < REP_SCAN; ++rep) ph_scan(kp, wv, bx, 64); } \
            else { for (int rep = 0; rep < REP_CONV; ++rep) ph_conv(kp, wv, (l), bx - 64, 192); for (int rep = 0; rep < REP_NA; ++rep) ph_na(kp, wv, (l), bx - 64, 192); } } \
        else { ph_conv(kp, wv, (l), bx, Gx); ph_na(kp, wv, (l), bx, Gx); ph_scan(kp, wv, bx, Gx); } SEAM((pb) + 3); } \
    if (IN((pb) + 4)) { for (int rep = 0; rep < REP_POST; ++rep) ph_rw_post(kp, wv, (l)); SEAM((pb) + 4); } \
    if (IN((pb) + 5)) { ph_gemm_wout(kp, wv, (l)); SEAM((pb) + 5); }
    LAYER_COMMON(0, PH_L0)
    if (IN(PH_L0 + 6)) { ph_norm2_l0(kp, wv); SEAM(PH_L0 + 6); }
    if (IN(PH_L0 + 7)) { for (int rep = 0; rep < REP_GEMM; ++rep) ph_gemm_ffn_gu(kp, wv); SEAM(PH_L0 + 7); }
    if (IN(PH_L0 + 8)) { ph_gemm_ffn_dn(kp, wv); SEAM(PH_L0 + 8); }
    LAYER_COMMON(1, PH_L1)
    if (IN(PH_L1 + 6)) { ph_norm2_l1(kp, wv); SEAM(PH_L1 + 6); }
    if (IN(PH_L1 + 7)) { for (int rep = 0; rep < REP_PRO; ++rep) ph_moe_prep(kp, wv); SEAM(PH_L1 + 7); }
#pragma unroll 1
    for (int pass = 0; pass < 2; ++pass) {
        if (IN(PH_L1 + 8 + 2 * pass)) { for (int rep = 0; rep < REP_GEMM; ++rep) ph_gemm_moe_gu(kp, wv, pass); SEAM(PH_L1 + 8 + 2 * pass); }
        if (IN(PH_L1 + 9 + 2 * pass)) { ph_gemm_moe_dn(kp, wv, pass); SEAM(PH_L1 + 9 + 2 * pass); }
    }
#undef LAYER_COMMON
    if (IN(PH_FINAL)) ph_final(kp, wv);
#undef IN
#undef SEAM
}

extern "C" void kernel_launch(void* const* d_in, const int* in_sizes, int n_in, void* d_out, int out_size, void* d_ws, size_t ws_size, hipStream_t stream) {
    static int grid = 0;
    if (grid == 0) {
        if (n_in != 35 || out_size != NLAT * D || ws_size < WS_END) { fprintf(stderr, "kernel_launch: unexpected shapes (n_in %d out %d ws %zu need %zu)\n", n_in, out_size, ws_size, (size_t)WS_END); grid = -1; return; }
        int dev = 0, cus = 0, per_cu = 0;
        if (hipGetDevice(&dev) != hipSuccess || hipDeviceGetAttribute(&cus, hipDeviceAttributeMultiprocessorCount, dev) != hipSuccess) { grid = -1; return; }
        if (hipFuncSetAttribute((const void*)mk_fwd, hipFuncAttributeMaxDynamicSharedMemorySize, LDS_BYTES) != hipSuccess) { fprintf(stderr, "kernel_launch: hipFuncSetAttribute failed\n"); grid = -1; return; }
        if (hipOccupancyMaxActiveBlocksPerMultiprocessor(&per_cu, (const void*)mk_fwd, NTHREADS, LDS_BYTES) != hipSuccess || per_cu < 1) { fprintf(stderr, "kernel_launch: occupancy query says %d\n", per_cu); (void)hipGetLastError(); }
        grid = cus;
    }
    if (grid < 0) return;
    (void)hipMemsetAsync((char*)d_ws + WS_CTL, 0, CTL_BYTES, stream);
    Params p{};
    for (int i = 0; i < 35; ++i) p.in[i] = (const float*)d_in[i];
    p.out = (float*)d_out; p.ws = (unsigned char*)d_ws;
#if MK_ONE_LAUNCH
    p.ph_lo = 0; p.ph_hi = N_PHASES;
    hipLaunchKernelGGL(mk_fwd, dim3(grid), dim3(NTHREADS), LDS_BYTES, stream, p);
#else
    for (int k = 0; k < N_PHASES && k <= MK_LAST; ++k) { p.ph_lo = k; p.ph_hi = k + 1; hipLaunchKernelGGL(mk_fwd, dim3(grid), dim3(NTHREADS), LDS_BYTES, stream, p); }
#endif
}
```

```cpp
#include <hip/hip_runtime.h>
#include <stdint.h>
#include <stdio.h>

#ifndef MK_MASK
#define MK_MASK 0xFFFFFFFFu
#endif
#define MKB(k) (((MK_MASK) >> (k)) & 1u)
#ifndef REP_SCAN
#define REP_SCAN 1
#endif
#ifndef REP_NA
#define REP_NA 1
#endif
#ifndef REP_GEMM
#define REP_GEMM 1
#endif
#ifndef REP_PP
#define REP_PP 1
#endif
#ifndef REP_POST
#define REP_POST 1
#endif
#ifndef REP_CONV
#define REP_CONV 1
#endif
#ifndef REP_NORM
#define REP_NORM 1
#endif
#ifndef REP_PRO
#define REP_PRO 1
#endif
#ifndef MK_LAST
#define MK_LAST 99
#endif
#ifndef MK_ONE_LAUNCH
#define MK_ONE_LAUNCH 1
#endif

#define LAS __attribute__((address_space(3)))
typedef unsigned short bf16_t;
typedef _Float16 f16_t;
typedef short bf16x8 __attribute__((ext_vector_type(8)));
typedef float f32x4 __attribute__((ext_vector_type(4)));
typedef float f32x2 __attribute__((ext_vector_type(2)));
typedef unsigned u32x4 __attribute__((ext_vector_type(4)));
typedef unsigned u32x2 __attribute__((ext_vector_type(2)));
typedef f16_t f16x4 __attribute__((ext_vector_type(4)));
typedef f16_t f16x8 __attribute__((ext_vector_type(8)));
typedef short v4i16_t __attribute__((ext_vector_type(4)));

constexpr int D = 1024, NB = 8, SEQ = 4096, CTXL = 256, TT = CTXL + SEQ;
constexpr int NLAT = NB * SEQ, NCTX = NB * CTXL, NROW = NLAT + NCTX;
constexpr int INW = 3328, DFF = 2816, DFE = 3584, NEXP = 8;
constexpr int O_Q = 0, O_K = 512, O_V = 1024, O_RW = 1536, O_CV = 2816;
constexpr int MODW = 6 * D;
constexpr int NTHREADS = 512, NWAVES = 8;
constexpr int LDS_BYTES = 160 * 1024;
constexpr int LDS_MISC = LDS_BYTES - 256;

constexpr size_t al256(size_t x) { return (x + 255) & ~(size_t)255; }
constexpr size_t WS_CTL   = 0;
constexpr size_t CTL_BYTES = 65536;
constexpr size_t WS_MODV  = WS_CTL + CTL_BYTES;
constexpr size_t WS_BTIN  = al256(WS_MODV + (size_t)2 * 9 * MODW * 4);
constexpr size_t WS_BTOUT = al256(WS_BTIN + (size_t)2 * INW * D * 2);
constexpr size_t WS_BTGU  = al256(WS_BTOUT + (size_t)2 * D * D * 2);
constexpr size_t WS_BTDN  = al256(WS_BTGU + (size_t)2 * DFF * D * 2);
constexpr size_t WS_LORA  = al256(WS_BTDN + (size_t)D * DFF * 2);
constexpr size_t LORA_LD_BYTES = (size_t)(256 * 64 * 2 + 256 * 128) * 2;
constexpr size_t WS_MOE   = al256(WS_LORA + 4 * LORA_LD_BYTES);
constexpr size_t MOE_GU_BYTES = (size_t)2 * DFE * D * 2, MOE_DN_BYTES = (size_t)D * DFE * 2, MOE_E_BYTES = MOE_GU_BYTES + MOE_DN_BYTES;
constexpr size_t WS_SH    = WS_MOE;
constexpr size_t SH_BYTES = (size_t)NB * 4 * TT * 192 * 2;
constexpr size_t WS_SD    = WS_SH + SH_BYTES;
constexpr size_t WS_XC    = al256(WS_MOE + (size_t)NEXP * MOE_E_BYTES);
constexpr size_t WS_HL    = al256(WS_XC + (size_t)NCTX * D * 4);
constexpr size_t WS_Y     = WS_HL;
constexpr size_t WS_PL    = al256(WS_HL + (size_t)NROW * D * 2);
constexpr size_t WS_MIX   = al256(WS_PL + (size_t)NROW * INW * 2);
constexpr size_t WS_H     = WS_PL;
constexpr size_t WS_ROUTE = al256(WS_MIX + (size_t)NROW * D * 2);
constexpr size_t RT_TOKE  = 0;
constexpr size_t RT_TOKG  = RT_TOKE + (size_t)NLAT * 2 * 4;
constexpr size_t RT_TOKP  = RT_TOKG + (size_t)NLAT * 2 * 4;
constexpr size_t RT_RMAP  = RT_TOKP + (size_t)NLAT * 2 * 4;
constexpr size_t RT_SGATE = RT_RMAP + (size_t)2 * NROW * 4;
constexpr size_t WS_END   = al256(WS_ROUTE + RT_SGATE + (size_t)2 * NROW * 4);
static_assert(SH_BYTES * 3 <= (size_t)NEXP * MOE_E_BYTES, "scan inputs must fit the MoE weight region");
static_assert((size_t)NROW * DFE * 2 <= (size_t)NROW * INW * 2 + (size_t)NROW * D * 2, "H must fit PL+MIX");

constexpr int CW_BAR = 0;
constexpr int CW_MOECNT = 4096;

#define XB_TMO      128
#define XB_XCNT(j)  (256  + 64 * (j))
#define XB_XSUB(j)  (1280 + 64 * (j))
#define XB_XGEN(j)  (2304 + 64 * (j))
#define XB_TOP      3328
#define XB_TOPGEN   3392
#define XCD_BAR_WORDS 3456
#define XB_SPIN_CAP (1u << 22)

__device__ __forceinline__ unsigned xb_ld(unsigned* p)              { return __hip_atomic_load(p, __ATOMIC_RELAXED, __HIP_MEMORY_SCOPE_AGENT); }
__device__ __forceinline__ unsigned xb_add(unsigned* p, unsigned v) { return __hip_atomic_fetch_add(p, v, __ATOMIC_RELAXED, __HIP_MEMORY_SCOPE_AGENT); }
__device__ __forceinline__ unsigned xb_xcc_id() { return (unsigned)__builtin_amdgcn_s_getreg((3 << 11) | 20) & 0xFu; }
#define XB_SPIN(cond, bar) do { unsigned _sp = 0; while (cond) { __builtin_amdgcn_s_sleep(1); \
    if ((++_sp & 255u) == 0u) { if (xb_ld(&(bar)[XB_TMO])) break; if (_sp > XB_SPIN_CAP) { atomicAdd(&(bar)[XB_TMO], 1u); break; } } } } while (0)

struct XcdBarrier { unsigned* bar; unsigned x; volatile LAS unsigned* st; };

__device__ __forceinline__ XcdBarrier xcd_barrier_post(unsigned* bar, volatile LAS unsigned* st, int tid) {
    XcdBarrier b; b.bar = bar; b.x = xb_xcc_id(); b.st = st;
    if (tid == 0) (void)xb_add(&bar[XB_XCNT(b.x)], 1u);
    return b;
}
__device__ __forceinline__ void xcd_barrier_complete(unsigned* bar, unsigned x, unsigned& nloc, unsigned& nx) {
    const unsigned G = gridDim.x * gridDim.y * gridDim.z;
    unsigned sum, cnt, mine, sp = 0u;
    for (;;) {
        sum = 0u; cnt = 0u; mine = 0u;
#pragma unroll
        for (unsigned j = 0; j < 16; ++j) { const unsigned c = xb_ld(&bar[XB_XCNT(j)]); sum += c; cnt += (c > 0u) ? 1u : 0u; mine = (j == x) ? c : mine; }
        if (sum == G) break;
        __builtin_amdgcn_s_sleep(1);
        if ((++sp & 255u) == 0u) { if (xb_ld(&bar[XB_TMO])) break; if (sp > XB_SPIN_CAP) { atomicAdd(&bar[XB_TMO], 1u); break; } }
    }
    nloc = mine > 0u ? mine : 1u; nx = cnt > 0u ? cnt : 1u;
}
__device__ __forceinline__ void xcd_barrier(const XcdBarrier& b, int tid) {
    asm volatile("s_waitcnt vmcnt(0)" ::: "memory");
    __syncthreads();
    if (tid == 0) {
        unsigned* bar = b.bar;
        __builtin_amdgcn_s_waitcnt(0);
        unsigned nloc = b.st[0], nx = b.st[1];
        if (nloc == 0u) { xcd_barrier_complete(bar, b.x, nloc, nx); b.st[0] = nloc; b.st[1] = nx; }
        const unsigned old = xb_add(&bar[XB_XSUB(b.x)], 1u);
        const unsigned gen = old / nloc;
        if (old + 1u == (gen + 1u) * nloc) {
            __builtin_amdgcn_fence(__ATOMIC_RELEASE, "agent");
            asm volatile("s_waitcnt vmcnt(0)" ::: "memory");
            const unsigned og = xb_add(&bar[XB_TOP], 1u);
            const unsigned tg = og / nx;
            if (og + 1u == (tg + 1u) * nx) xb_add(&bar[XB_TOPGEN], 1u);
            else XB_SPIN(xb_ld(&bar[XB_TOPGEN]) == tg, bar);
            __builtin_amdgcn_fence(__ATOMIC_ACQUIRE, "agent");
            xb_add(&bar[XB_XGEN(b.x)], 1u);
            asm volatile("s_waitcnt vmcnt(0)" ::: "memory");
        } else {
            XB_SPIN(xb_ld(&bar[XB_XGEN(b.x)]) == gen, bar);
            __builtin_amdgcn_fence(__ATOMIC_ACQUIRE, "agent");
            asm volatile("s_waitcnt vmcnt(0)" ::: "memory");
        }
    }
    __syncthreads();
}

__device__ __forceinline__ int lane_id() { return (int)__builtin_amdgcn_mbcnt_hi(~0u, __builtin_amdgcn_mbcnt_lo(~0u, 0u)); }
__device__ __forceinline__ float bf2f(bf16_t b) { return __uint_as_float(((unsigned)b) << 16); }
__device__ __forceinline__ bf16_t f2bf(float f) { unsigned u = __float_as_uint(f); u += 0x7FFFu + ((u >> 16) & 1u); return (bf16_t)(u >> 16); }
__device__ __forceinline__ unsigned pk_bf16(float lo, float hi) { return (unsigned)f2bf(lo) | ((unsigned)f2bf(hi) << 16); }
typedef __bf16 bf16x2_t __attribute__((ext_vector_type(2)));
__device__ __forceinline__ unsigned cvt_pk_bf16(float lo, float hi) { return __builtin_bit_cast(unsigned, __builtin_convertvector((f32x2){lo, hi}, bf16x2_t)); }
__device__ __forceinline__ float sigmoidf_(float x) { return 1.0f / (1.0f + __expf(-x)); }
__device__ __forceinline__ float siluf_(float x) { return x / (1.0f + __expf(-x)); }
__device__ __forceinline__ float wave_sum(float v) {
#pragma unroll
    for (int o = 32; o >= 1; o >>= 1) v += __shfl_xor(v, o);
    return v;
}
__device__ __forceinline__ float sum16(float v) {
    v += __shfl_xor(v, 1); v += __shfl_xor(v, 2); v += __shfl_xor(v, 4); v += __shfl_xor(v, 8); return v;
}
__device__ __forceinline__ void unpack4(u32x2 w, float (&f)[4]) {
    f[0] = __uint_as_float(w.x << 16); f[1] = __uint_as_float(w.x & 0xffff0000u); f[2] = __uint_as_float(w.y << 16); f[3] = __uint_as_float(w.y & 0xffff0000u);
}
__device__ __forceinline__ void unpack8(u32x4 w, float* f) {
    f[0] = __uint_as_float(w.x << 16); f[1] = __uint_as_float(w.x & 0xffff0000u); f[2] = __uint_as_float(w.y << 16); f[3] = __uint_as_float(w.y & 0xffff0000u);
    f[4] = __uint_as_float(w.z << 16); f[5] = __uint_as_float(w.z & 0xffff0000u); f[6] = __uint_as_float(w.w << 16); f[7] = __uint_as_float(w.w & 0xffff0000u);
}

struct Params {
    const float* in[35];
    float* out; unsigned char* ws;
    int ph_lo, ph_hi;
};
enum { I_X = 0, I_C, I_CTX, I_CCTX, I_N1G, I_N2G, I_MODW, I_MODB, I_WIN, I_WOUT, I_RPB, I_MUP, I_MUN, I_W0, I_W2, I_A0, I_A2, I_G2, I_KK, I_KA, I_RK, I_GNG, I_GNB,
       I_DWW, I_DWB, I_LNG, I_LNB, I_FG, I_FU, I_FD, I_ROUTER, I_MG, I_MU, I_MD, I_FINALG };

__device__ __forceinline__ int row_mi(int r) { return r < NLAT ? (r >> 12) : 8; }

namespace pg8 {
constexpr int BM = 256, BK = 64, HALF = 128, HTB = HALF * BK * 2, STAGE_BYTES = 8 * HTB, NXCD = 8, WGM = 8;
__device__ __forceinline__ int lds_byte(int r, int c) { const int st = (r >> 4) * 2 + (c >> 5), rr = r & 15, cc = c & 31, ob = rr * 64 + cc * 2; return st * 1024 + (ob ^ (((ob >> 9) & 1) << 5)); }
__device__ __forceinline__ void stage_rc(int b, int& R, int& C) { const int st = b / 1024, sb = b % 1024, swz = sb ^ (((sb >> 9) & 1) << 5); R = (st >> 1) * 16 + swz / 64; C = (st & 1) * 32 + (swz % 64) / 2; }
__device__ __forceinline__ int perm32(int rho) { const int n = rho >> 4, i = rho & 15; return 8 * (i >> 2) + 4 * n + (i & 3); }
struct Unit { int pm, pn; };

struct TileOrder {
    int nM, nN, nwg, G, c;
    __device__ void init(int nM_, int nN_, int G_, int c_) { nM = nM_; nN = nN_; nwg = nM * nN; G = G_; c = c_; }
    __device__ bool next(int i, Unit& u) const {
        const long L = (long)i * G + c; if (L >= nwg) return false;
        int wgid = (int)L; { const int q = nwg / NXCD, r = nwg % NXCD, xcd = wgid % NXCD, off = wgid / NXCD; wgid = (xcd < r ? xcd * (q + 1) : r * (q + 1) + (xcd - r) * q) + off; }
        const int nig = WGM * nN, gid = wgid / nig, fm = gid * WGM, gsz = (nM - fm) < WGM ? (nM - fm) : WGM;
        u.pm = fm + ((wgid % nig) % gsz); u.pn = (wgid % nig) / gsz; return true;
    }
};
struct DenseSched : TileOrder {
    const bf16_t* A; const bf16_t* Bt; int K;
    __device__ __forceinline__ const char* aptr(const Unit& u) const { return (const char*)A + (size_t)u.pm * BM * K * 2; }
    __device__ __forceinline__ const char* bptr(const Unit& u) const { return (const char*)Bt + (size_t)u.pn * BM * K * 2; }
    __device__ __forceinline__ const char* abase() const { return (const char*)A; }
    __device__ __forceinline__ int arow(const Unit&, int) const { return 0; }
};
struct MoeSched : TileOrder {
    const bf16_t* A; const unsigned char* Bt0; size_t e_stride; int K; const int* rowmap; int tstart[9];
    __device__ __forceinline__ int expert(int pm) const { int e = 0;
#pragma unroll
        for (int j = 1; j < 8; ++j) e += (pm >= tstart[j]) ? 1 : 0;
        return e; }
    __device__ __forceinline__ const char* aptr(const Unit& u) const { return (const char*)A + (size_t)u.pm * BM * K * 2; }
    __device__ __forceinline__ const char* bptr(const Unit& u) const { return (const char*)Bt0 + (size_t)expert(u.pm) * e_stride + (size_t)u.pn * BM * K * 2; }
    __device__ __forceinline__ const char* abase() const { return (const char*)A; }
    __device__ __forceinline__ int arow(const Unit& u, int r) const { const int t = rowmap[u.pm * BM + r]; return t < 0 ? 0 : t; }
};

struct EpiBf16 {
    static constexpr bool PERM = true;
    bf16_t* O; int ldc; int nscale; float scale;
    __device__ __forceinline__ void operator()(const f32x4 (&acc)[2][2][4][2], const Unit& u, int wr, int wc, int fr, int fq) const {
        const int row0 = u.pm * BM + wr * 64 + fr, col0 = u.pn * BM + wc * 32 + 8 * fq;
        const float s = u.pn < nscale ? scale : 1.0f;
#pragma unroll
        for (int ai = 0; ai < 2; ++ai)
#pragma unroll
            for (int m = 0; m < 4; ++m) { bf16_t* rowp = O + (size_t)(row0 + ai * HALF + m * 16) * ldc + col0;
#pragma unroll
                for (int bj = 0; bj < 2; ++bj) { const f32x4 v0 = acc[ai][bj][m][0] * s, v1 = acc[ai][bj][m][1] * s;
                    u32x4 w; w.x = cvt_pk_bf16(v0[0], v0[1]); w.y = cvt_pk_bf16(v0[2], v0[3]); w.z = cvt_pk_bf16(v1[0], v1[1]); w.w = cvt_pk_bf16(v1[2], v1[3]);
                    *(u32x4*)(rowp + bj * HALF) = w; } }
    }
};
struct EpiSwiGLU {
    static constexpr bool PERM = true;
    bf16_t* H; int ldh;
    __device__ __forceinline__ void operator()(const f32x4 (&acc)[2][2][4][2], const Unit& u, int wr, int wc, int fr, int fq) const {
        const int row0 = u.pm * BM + wr * 64 + fr, col0 = u.pn * HALF + wc * 32 + 8 * fq;
#pragma unroll
        for (int ai = 0; ai < 2; ++ai)
#pragma unroll
            for (int m = 0; m < 4; ++m) { bf16_t* rowp = H + (size_t)(row0 + ai * HALF + m * 16) * ldh + col0;
                float h[8];
#pragma unroll
                for (int n = 0; n < 2; ++n)
#pragma unroll
                    for (int j = 0; j < 4; ++j) { const float g = acc[ai][0][m][n][j], up = acc[ai][1][m][n][j]; h[n * 4 + j] = g / (1.0f + __expf(-g)) * up; }
                u32x4 w; w.x = cvt_pk_bf16(h[0], h[1]); w.y = cvt_pk_bf16(h[2], h[3]); w.z = cvt_pk_bf16(h[4], h[5]); w.w = cvt_pk_bf16(h[6], h[7]);
                *(u32x4*)rowp = w; }
    }
};
struct EpiRes {
    static constexpr bool PERM = false;
    const float* resL; const float* resC; float* outL; float* outC; const float* gvec;
    __device__ __forceinline__ void operator()(const f32x4 (&acc)[2][2][4][2], const Unit& u, int wr, int wc, int fr, int fq) const {
        const int r0 = u.pm * BM; const bool lat = r0 < NLAT;
        const float* res = lat ? resL + (size_t)r0 * D : resC + (size_t)(r0 - NLAT) * D;
        float* out = lat ? outL + (size_t)r0 * D : outC + (size_t)(r0 - NLAT) * D;
        const float* gv = gvec + (size_t)(lat ? (r0 >> 12) : 8) * MODW;
        const int rl = wr * 64 + fr, col0 = u.pn * BM + wc * 32 + 4 * fq;
        f32x4 g[2][2];
#pragma unroll
        for (int bj = 0; bj < 2; ++bj)
#pragma unroll
            for (int n = 0; n < 2; ++n) g[bj][n] = *(const f32x4*)(gv + col0 + bj * HALF + n * 16);
#pragma unroll
        for (int ai = 0; ai < 2; ++ai)
#pragma unroll
            for (int m = 0; m < 4; ++m) { const size_t off = (size_t)(rl + ai * HALF + m * 16) * D + col0;
#pragma unroll
                for (int bj = 0; bj < 2; ++bj)
#pragma unroll
                    for (int n = 0; n < 2; ++n) { const f32x4 rv = *(const f32x4*)(res + off + bj * HALF + n * 16);
                        *(f32x4*)(out + off + bj * HALF + n * 16) = rv + g[bj][n] * acc[ai][bj][m][n]; } }
    }
};
struct EpiMoeDown {
    static constexpr bool PERM = false;
    float* xl; const float* gvec; const int* rowmap; const float* sgate;
    __device__ __forceinline__ void operator()(const f32x4 (&acc)[2][2][4][2], const Unit& u, int wr, int wc, int fr, int fq) const {
        const int rl = u.pm * BM + wr * 64 + fr, col0 = u.pn * BM + wc * 32 + 4 * fq;
#pragma unroll
        for (int ai = 0; ai < 2; ++ai)
#pragma unroll
            for (int m = 0; m < 4; ++m) { const int slot = rl + ai * HALF + m * 16; const int tok = rowmap[slot];
                if (tok >= 0) { const float sg = sgate[slot]; const float* gv = gvec + (size_t)(tok >> 12) * MODW + col0; float* xp = xl + (size_t)tok * D + col0;
#pragma unroll
                    for (int bj = 0; bj < 2; ++bj)
#pragma unroll
                        for (int n = 0; n < 2; ++n) { const f32x4 g = *(const f32x4*)(gv + bj * HALF + n * 16); const f32x4 rv = *(const f32x4*)(xp + bj * HALF + n * 16);
                            *(f32x4*)(xp + bj * HALF + n * 16) = rv + (g * sg) * acc[ai][bj][m][n]; } } }
    }
};

template <class Epi, class Sched, bool GATHER>
__device__ __forceinline__ void gemm_phase(LAS unsigned char* lds, const int K, const Sched& S, const Epi& E, const int wave_) {
    int tid_ = wave_ * 64 + lane_id(); asm volatile("" : "+v"(tid_));
    const int tid = tid_, wid = wave_, lane = tid & 63, wr = wid >> 2, wc = wid & 3, fr = lane & 15, fq = lane >> 4;
    const int nt = K / BK;
    unsigned voffA[2], voffB[2]; int RA[2], CA[2];
#pragma unroll
    for (int i = 0; i < 2; ++i) { int R, C; stage_rc(tid * 16 + i * 8192, R, C); const int Rb = Epi::PERM ? ((R & ~31) + perm32(R & 31)) : R;
        voffA[i] = (unsigned)(R * K + C) * 2u; voffB[i] = (unsigned)(Rb * K + C) * 2u; RA[i] = R; CA[i] = C; }
    const size_t kstep = (size_t)(BK * 2);
    const size_t hstep = (size_t)HALF * K * 2;
    const unsigned ldsw = (unsigned)wid * 1024u;
    const int aoff = lds_byte(wr * 64 + fr, fq * 8), boff = lds_byte(wc * 32 + fr, fq * 8);
#define PG8_SA(b, h) (((b) * 2 + (h)) * HTB)
#define PG8_SB(b, h) ((4 + (b) * 2 + (h)) * HTB)
#define PG8_STAGE(bufoff, gbase, voff) do { _Pragma("unroll") for (int _i = 0; _i < 2; ++_i) \
        __builtin_amdgcn_global_load_lds((const unsigned*)((const char*)(gbase) + (voff)[_i]), (LAS unsigned*)(lds + (bufoff) + ldsw + _i * 8192), 16, 0, 0); } while (0)
#define PG8_LDA(dst, b, h) do { _Pragma("unroll") for (int m = 0; m < 4; ++m) _Pragma("unroll") for (int k = 0; k < 2; ++k) dst[m][k] = *(const LAS bf16x8*)(lds + PG8_SA(b, h) + aoff + m * 2048 + k * 1024); } while (0)
#define PG8_LDB(dst, b, h) do { _Pragma("unroll") for (int n = 0; n < 2; ++n) _Pragma("unroll") for (int k = 0; k < 2; ++k) dst[n][k] = *(const LAS bf16x8*)(lds + PG8_SB(b, h) + boff + n * 2048 + k * 1024); } while (0)
#define PG8_MMA(ai, bj, At, Bt) do { __builtin_amdgcn_s_setprio(1); _Pragma("unroll") for (int m = 0; m < 4; ++m) _Pragma("unroll") for (int n = 0; n < 2; ++n) _Pragma("unroll") for (int k = 0; k < 2; ++k) \
        acc[ai][bj][m][n] = __builtin_amdgcn_mfma_f32_16x16x32_bf16(Bt[n][k], At[m][k], acc[ai][bj][m][n], 0, 0, 0); __builtin_amdgcn_s_setprio(0); } while (0)
#define PG8_WAIT_V(n) asm volatile("s_waitcnt vmcnt(" #n ")" ::: "memory")
#define PG8_WAIT_L(n) asm volatile("s_waitcnt lgkmcnt(" #n ")" ::: "memory")
#define PG8_BAR __builtin_amdgcn_s_barrier()
#define PG8_SCHED __builtin_amdgcn_sched_barrier(0)
#define PG8_STAGE_A(bufoff, TS, H) do { if constexpr (GATHER) { PG8_STAGE(bufoff, gA##TS, oA##TS[H]); } else { PG8_STAGE(bufoff, a##TS + (H) * hstep, voffA); } } while (0)
    Unit cur, nxt; int ui = 0;
    if (!S.next(0, cur)) return;
    f32x4 acc[2][2][4][2];
#pragma unroll
    for (int a = 0; a < 2; ++a)
#pragma unroll
        for (int b = 0; b < 2; ++b)
#pragma unroll
            for (int m = 0; m < 4; ++m)
#pragma unroll
                for (int n = 0; n < 2; ++n) acc[a][b][m][n] = (f32x4){0.f, 0.f, 0.f, 0.f};
    bf16x8 At[4][2], B0[2][2], B1[2][2];
    const char* Abase = S.abase();
    unsigned aoC[2][2] = {{0u, 0u}, {0u, 0u}}, aoN[2][2] = {{0u, 0u}, {0u, 0u}};
    if constexpr (GATHER) {
#pragma unroll
        for (int h = 0; h < 2; ++h)
#pragma unroll
            for (int i = 0; i < 2; ++i) aoC[h][i] = (unsigned)(S.arow(cur, h * HALF + RA[i]) * K + CA[i]) * 2u;
    }
    const char* cA = GATHER ? Abase : S.aptr(cur); const char* cB = S.bptr(cur);
    if constexpr (GATHER) {
        PG8_STAGE(PG8_SB(0, 0), cB, voffB); PG8_STAGE(PG8_SA(0, 0), Abase, aoC[0]); PG8_STAGE(PG8_SB(0, 1), cB + hstep, voffB); PG8_STAGE(PG8_SA(0, 1), Abase, aoC[1]);
    } else {
        PG8_STAGE(PG8_SB(0, 0), cB, voffB); PG8_STAGE(PG8_SA(0, 0), cA, voffA); PG8_STAGE(PG8_SB(0, 1), cB + hstep, voffB); PG8_STAGE(PG8_SA(0, 1), cA + hstep, voffA);
    }
    if (wr == 1) PG8_BAR;
    PG8_WAIT_V(4); PG8_BAR;
    if constexpr (GATHER) {
        PG8_STAGE(PG8_SB(1, 0), cB + kstep, voffB); PG8_STAGE(PG8_SA(1, 0), Abase + kstep, aoC[0]); PG8_STAGE(PG8_SB(1, 1), cB + hstep + kstep, voffB);
    } else {
        PG8_STAGE(PG8_SB(1, 0), cB + kstep, voffB); PG8_STAGE(PG8_SA(1, 0), cA + kstep, voffA); PG8_STAGE(PG8_SB(1, 1), cB + hstep + kstep, voffB);
    }
    PG8_WAIT_V(6); PG8_BAR;
    for (;;) {
        const bool has_next = S.next(ui + 1, nxt);
        const char* nA = has_next ? (GATHER ? Abase : S.aptr(nxt)) : cA; const char* nB = has_next ? S.bptr(nxt) : cB;
        if constexpr (GATHER) {
            if (has_next) {
#pragma unroll
                for (int h = 0; h < 2; ++h)
#pragma unroll
                    for (int i = 0; i < 2; ++i) aoN[h][i] = (unsigned)(S.arow(nxt, h * HALF + RA[i]) * K + CA[i]) * 2u;
            } else {
#pragma unroll
                for (int h = 0; h < 2; ++h)
#pragma unroll
                    for (int i = 0; i < 2; ++i) aoN[h][i] = aoC[h][i];
            }
        }
        for (int t = 0; t < nt; t += 2) {
            const bool last = (t == nt - 2);
            const char* a1 = cA + (size_t)(t + 1) * kstep;
            const char* a2 = last ? nA : cA + (size_t)(t + 2) * kstep; const char* b2 = last ? nB : cB + (size_t)(t + 2) * kstep;
            const char* a3 = a2 + kstep; const char* b3 = b2 + kstep;
            const char* gA1 = Abase + (size_t)(t + 1) * kstep; const char* gA2 = Abase + (last ? (size_t)0 : (size_t)(t + 2) * kstep); const char* gA3 = gA2 + kstep;
            unsigned oA1[2][2], oA2[2][2], oA3[2][2];
#pragma unroll
            for (int h = 0; h < 2; ++h)
#pragma unroll
                for (int i = 0; i < 2; ++i) { oA1[h][i] = aoC[h][i]; oA2[h][i] = last ? aoN[h][i] : aoC[h][i]; oA3[h][i] = oA2[h][i]; }
            (void)a1; (void)a3; (void)gA1; (void)gA3; (void)oA1; (void)oA3;
            PG8_LDB(B0, 0, 0); PG8_SCHED; PG8_LDA(At, 0, 0); PG8_STAGE_A(PG8_SA(1, 1), 1, 1);
            PG8_WAIT_L(8); PG8_BAR; PG8_WAIT_L(0); PG8_MMA(0, 0, At, B0); PG8_BAR; PG8_SCHED;
            PG8_LDB(B1, 0, 1); PG8_STAGE(PG8_SB(0, 0), b2, voffB);
            PG8_BAR; PG8_WAIT_L(0); PG8_MMA(0, 1, At, B1); PG8_BAR;
            PG8_LDA(At, 0, 1); PG8_STAGE_A(PG8_SA(0, 0), 2, 0);
            PG8_BAR; PG8_WAIT_L(0); PG8_MMA(1, 0, At, B0); PG8_BAR; PG8_SCHED;
            PG8_STAGE(PG8_SB(0, 1), b2 + hstep, voffB);
            PG8_WAIT_V(6); PG8_BAR; PG8_MMA(1, 1, At, B1); PG8_BAR;
            PG8_LDB(B0, 1, 0); PG8_SCHED; PG8_LDA(At, 1, 0); PG8_STAGE_A(PG8_SA(0, 1), 2, 1);
            PG8_WAIT_L(8); PG8_BAR; PG8_WAIT_L(0); PG8_MMA(0, 0, At, B0); PG8_BAR; PG8_SCHED;
            PG8_LDB(B1, 1, 1); PG8_STAGE(PG8_SB(1, 0), b3, voffB);
            PG8_BAR; PG8_WAIT_L(0); PG8_MMA(0, 1, At, B1); PG8_BAR;
            PG8_LDA(At, 1, 1); PG8_STAGE_A(PG8_SA(1, 0), 3, 0);
            PG8_BAR; PG8_WAIT_L(0); PG8_MMA(1, 0, At, B0); PG8_BAR; PG8_SCHED;
            PG8_STAGE(PG8_SB(1, 1), b3 + hstep, voffB);
            PG8_WAIT_V(6); PG8_BAR; PG8_MMA(1, 1, At, B1); PG8_BAR;
        }
        { int t2 = tid; asm volatile("" : "+v"(t2)); const int l2 = t2 & 63; E(acc, cur, wr, wc, l2 & 15, l2 >> 4); }
        if (!has_next) break;
#pragma unroll
        for (int a = 0; a < 2; ++a)
#pragma unroll
            for (int b = 0; b < 2; ++b)
#pragma unroll
                for (int m = 0; m < 4; ++m)
#pragma unroll
                    for (int n = 0; n < 2; ++n) acc[a][b][m][n] = (f32x4){0.f, 0.f, 0.f, 0.f};
        cur = nxt; cA = nA; cB = nB; ++ui;
        if constexpr (GATHER) {
#pragma unroll
            for (int h = 0; h < 2; ++h)
#pragma unroll
                for (int i = 0; i < 2; ++i) aoC[h][i] = aoN[h][i];
        }
    }
    PG8_WAIT_V(0);
    if (wr == 0) PG8_BAR;
    PG8_BAR;
#undef PG8_SA
#undef PG8_SB
#undef PG8_STAGE
#undef PG8_STAGE_A
#undef PG8_LDA
#undef PG8_LDB
#undef PG8_MMA
#undef PG8_WAIT_V
#undef PG8_WAIT_L
#undef PG8_BAR
#undef PG8_SCHED
}
}

struct Frame {
    LAS unsigned char* lds; int tid, lane, wave, G, bid, gw, nw;
    unsigned char* ws;
};
extern __shared__ __attribute__((aligned(16))) unsigned char lds_raw[];
typedef const __attribute__((address_space(4))) Params* KP;
__device__ __forceinline__ Params load_params(const void* kp_) {
    const unsigned long long v = (unsigned long long)kp_;
    const unsigned lo = __builtin_amdgcn_readfirstlane((unsigned)v), hi = __builtin_amdgcn_readfirstlane((unsigned)(v >> 32));
    KP kp = (KP)(((unsigned long long)hi << 32) | lo);
    Params P;
#pragma unroll
    for (int i = 0; i < 35; ++i) P.in[i] = kp->in[i];
    P.out = kp->out; P.ws = kp->ws; P.ph_lo = kp->ph_lo; P.ph_hi = kp->ph_hi;
    return P;
}
#define PHASE static __attribute__((noinline)) __device__ void
#define PHASE_INL static __device__ __forceinline__ void
__device__ __forceinline__ Frame make_frame(unsigned char* ws, int wave_) {
    Frame F; F.lds = (LAS unsigned char*)lds_raw; F.wave = __builtin_amdgcn_readfirstlane(wave_);
    int t_ = F.wave * 64 + lane_id(); asm volatile("" : "+v"(t_));
    F.tid = t_; F.lane = F.tid & 63;
    F.G = gridDim.x; F.bid = blockIdx.x; F.gw = F.bid * NWAVES + F.wave; F.nw = F.G * NWAVES; F.ws = ws; return F;
}
__device__ __forceinline__ Frame sub_frame(Frame F, int bid, int G) { F.bid = bid; F.G = G; F.gw = F.bid * NWAVES + F.wave; F.nw = F.G * NWAVES; return F; }
#define PHASE_ENTER const Params P = load_params(kp_); const Frame F = make_frame(P.ws, wv_)

__device__ __forceinline__ void conv_job(const Frame& F, const float* src, bf16_t* dst, int K, int N, int mode) {
    LAS float* tile = (LAS float*)(F.lds + F.wave * (64 * 65 * 4));
    const int tk = K / 64, tn = N / 64, ntile = tk * tn, lane = F.lane;
    for (int t = F.gw; t < ntile; t += F.nw) {
        const int k0 = (t / tn) * 64, n0 = (t % tn) * 64;
#pragma unroll 4
        for (int i = 0; i < 16; ++i) { const int row = i * 4 + (lane >> 4), c4 = (lane & 15) * 4;
            const f32x4 v = *(const f32x4*)(src + (size_t)(k0 + row) * N + n0 + c4);
            tile[row * 65 + c4 + 0] = v[0]; tile[row * 65 + c4 + 1] = v[1]; tile[row * 65 + c4 + 2] = v[2]; tile[row * 65 + c4 + 3] = v[3]; }
        __builtin_amdgcn_wave_barrier(); asm volatile("s_waitcnt lgkmcnt(0)" ::: "memory");
#pragma unroll 2
        for (int i = 0; i < 8; ++i) { const int n = i * 8 + (lane >> 3), kc = (lane & 7) * 8;
            float f[8];
#pragma unroll
            for (int j = 0; j < 8; ++j) f[j] = tile[(kc + j) * 65 + n];
            const int ng = n0 + n; const int drow = mode == 0 ? ng : ((ng >> 7) * 256 + (mode == 2 ? 128 : 0) + (ng & 127));
            u32x4 w; w.x = pk_bf16(f[0], f[1]); w.y = pk_bf16(f[2], f[3]); w.z = pk_bf16(f[4], f[5]); w.w = pk_bf16(f[6], f[7]);
            *(u32x4*)(dst + (size_t)drow * K + k0 + kc) = w; }
        __builtin_amdgcn_wave_barrier(); asm volatile("s_waitcnt lgkmcnt(0)" ::: "memory");
    }
}

__device__ __forceinline__ void phase_prologue(const Frame& F, const Params& P) {
    float* modv = (float*)(F.ws + WS_MODV);
    LAS float* s = (LAS float*)F.lds;
    LAS float* red = (LAS float*)(F.lds + 9 * 1024 * 4);
    for (int cb = F.bid; cb < (2 * MODW) / 64; cb += F.G) {
        for (int i = F.tid; i < 9 * 1024; i += NTHREADS) { const int mi = i >> 10, k = i & 1023; const float c = mi < 8 ? P.in[I_C][mi * D + k] : P.in[I_CCTX][k]; s[i] = siluf_(c); }
        __syncthreads();
        const int colg = cb * 64 + F.lane, l = colg / MODW, col = colg % MODW;
        const float* w = P.in[I_MODW] + (size_t)l * D * MODW + col;
        float acc[9];
#pragma unroll
        for (int mi = 0; mi < 9; ++mi) acc[mi] = 0.f;
        const int kb = F.wave * 128;
#pragma unroll 8
        for (int k = 0; k < 128; ++k) { const float wv = w[(size_t)(kb + k) * MODW];
#pragma unroll
            for (int mi = 0; mi < 9; ++mi) acc[mi] += s[mi * 1024 + kb + k] * wv; }
#pragma unroll
        for (int mi = 0; mi < 9; ++mi) red[(F.wave * 9 + mi) * 64 + F.lane] = acc[mi];
        __syncthreads();
        for (int i = F.tid; i < 9 * 64; i += NTHREADS) { const int mi = i >> 6, ln = i & 63; float a = 0.f;
#pragma unroll
            for (int w8 = 0; w8 < 8; ++w8) a += red[(w8 * 9 + mi) * 64 + ln];
            const int cg = cb * 64 + ln, l2 = cg / MODW, c2 = cg % MODW;
            modv[((size_t)l2 * 9 + mi) * MODW + c2] = a + P.in[I_MODB][l2 * MODW + c2]; }
        __syncthreads();
    }
    for (int l = 0; l < 2; ++l) {
        conv_job(F, P.in[I_WIN] + (size_t)l * D * INW, (bf16_t*)(F.ws + WS_BTIN) + (size_t)l * INW * D, D, INW, 0);
        conv_job(F, P.in[I_WOUT] + (size_t)l * D * D, (bf16_t*)(F.ws + WS_BTOUT) + (size_t)l * D * D, D, D, 0);
    }
    conv_job(F, P.in[I_FG], (bf16_t*)(F.ws + WS_BTGU), D, DFF, 1);
    conv_job(F, P.in[I_FU], (bf16_t*)(F.ws + WS_BTGU), D, DFF, 2);
    conv_job(F, P.in[I_FD], (bf16_t*)(F.ws + WS_BTDN), DFF, D, 0);
    for (int ld = 0; ld < 4; ++ld) { bf16_t* base = (bf16_t*)(F.ws + WS_LORA + (size_t)ld * LORA_LD_BYTES);
        conv_job(F, P.in[I_W2] + (size_t)ld * 64 * 256, base, 64, 256, 0);
        conv_job(F, P.in[I_A2] + (size_t)ld * 64 * 256, base + 256 * 64, 64, 256, 0);
        conv_job(F, P.in[I_G2] + (size_t)ld * 128 * 256, base + 2 * 256 * 64, 128, 256, 0); }
}
__device__ __forceinline__ void phase_moe_convert(const Frame& F, const Params& P) {
    for (int e = 0; e < NEXP; ++e) {
        bf16_t* gu = (bf16_t*)(F.ws + WS_MOE + (size_t)e * MOE_E_BYTES); bf16_t* dn = (bf16_t*)(F.ws + WS_MOE + (size_t)e * MOE_E_BYTES + MOE_GU_BYTES);
        conv_job(F, P.in[I_MG] + (size_t)e * D * DFE, gu, D, DFE, 1);
        conv_job(F, P.in[I_MU] + (size_t)e * D * DFE, gu, D, DFE, 2);
        conv_job(F, P.in[I_MD] + (size_t)e * DFE * D, dn, DFE, D, 0);
    }
}

template <bool ROUTER>
__device__ __forceinline__ void phase_norm(const Frame& F, const Params& P, int l, int which, int nrows, const float* srcL, const float* srcC) {
    const float* g = (which == 0 ? P.in[I_N1G] : P.in[I_N2G]) + l * D;
    const float* modv = (const float*)(F.ws + WS_MODV) + (size_t)l * 9 * MODW + (which == 0 ? 0 : 3 * D);
    bf16_t* HL = (bf16_t*)(F.ws + WS_HL);
    LAS float* rt = (LAS float*)F.lds;
    if (ROUTER) {
        for (int i = F.tid; i < D * NEXP; i += NTHREADS) rt[i] = P.in[I_ROUTER][i];
        int* rmap = (int*)(F.ws + WS_ROUTE + RT_RMAP);
        for (int i = F.bid * NTHREADS + F.tid; i < 2 * NROW; i += F.G * NTHREADS) rmap[i] = -1;
        __syncthreads();
    }
    const int lane = F.lane;
    for (int r = F.gw; r < nrows; r += F.nw) {
        const float* xr = r < NLAT ? srcL + (size_t)r * D : srcC + (size_t)(r - NLAT) * D;
        const float* mv = modv + (size_t)row_mi(r) * MODW;
        f32x4 x[4]; float ss = 0.f;
#pragma unroll
        for (int j = 0; j < 4; ++j) { x[j] = *(const f32x4*)(xr + j * 256 + lane * 4); ss += x[j][0] * x[j][0] + x[j][1] * x[j][1] + x[j][2] * x[j][2] + x[j][3] * x[j][3]; }
        ss = wave_sum(ss);
        const float rstd = rsqrtf(ss * (1.0f / D) + 1e-6f);
        float lg[NEXP];
        if (ROUTER) {
#pragma unroll
            for (int e = 0; e < NEXP; ++e) lg[e] = 0.f;
        }
#pragma unroll
        for (int j = 0; j < 4; ++j) { const int c = j * 256 + lane * 4;
            const f32x4 gg = *(const f32x4*)(g + c), sh = *(const f32x4*)(mv + c), sc = *(const f32x4*)(mv + D + c);
            f32x4 y = (x[j] * rstd * gg) * (sc + 1.0f) + sh;
            u32x2 w; w.x = pk_bf16(y[0], y[1]); w.y = pk_bf16(y[2], y[3]);
            *(u32x2*)(HL + (size_t)r * D + c) = w;
            if (ROUTER) {
#pragma unroll
                for (int q = 0; q < 4; ++q) { const f32x4 r0 = *(const LAS f32x4*)(rt + (c + q) * 8), r1 = *(const LAS f32x4*)(rt + (c + q) * 8 + 4);
                    lg[0] += y[q] * r0[0]; lg[1] += y[q] * r0[1]; lg[2] += y[q] * r0[2]; lg[3] += y[q] * r0[3];
                    lg[4] += y[q] * r1[0]; lg[5] += y[q] * r1[1]; lg[6] += y[q] * r1[2]; lg[7] += y[q] * r1[3]; asm volatile("" ::: "memory"); }
            }
        }
        if (ROUTER) {
#pragma unroll
            for (int e = 0; e < NEXP; ++e) lg[e] = wave_sum(lg[e]);
            if (lane == 0) {
                int e1 = 0; float l1 = lg[0];
#pragma unroll
                for (int e = 1; e < NEXP; ++e) if (lg[e] > l1) { l1 = lg[e]; e1 = e; }
                int e2 = -1; float l2 = -3.0e38f;
#pragma unroll
                for (int e = 0; e < NEXP; ++e) if (e != e1 && lg[e] > l2) { l2 = lg[e]; e2 = e; }
                if (e2 < 0) { e2 = e1 == 0 ? 1 : 0; l2 = l1; }
                const float ex = __expf(l2 - l1), g1 = 1.0f / (1.0f + ex), g2 = ex * g1;
                unsigned* cnt = (unsigned*)(F.ws + WS_CTL) + CW_MOECNT;
                const unsigned p1 = atomicAdd(cnt + e1, 1u), p2 = atomicAdd(cnt + 8 + e2, 1u);
                int* te = (int*)(F.ws + WS_ROUTE + RT_TOKE); float* tg = (float*)(F.ws + WS_ROUTE + RT_TOKG); int* tp = (int*)(F.ws + WS_ROUTE + RT_TOKP);
                te[r * 2] = e1; te[r * 2 + 1] = e2; tg[r * 2] = g1; tg[r * 2 + 1] = g2; tp[r * 2] = (int)p1; tp[r * 2 + 1] = (int)p2;
            }
        }
    }
}
__device__ __forceinline__ void moe_tstart(const Frame& F, int pass, int (&ts)[9]) {
    const unsigned* cnt = (const unsigned*)(F.ws + WS_CTL) + CW_MOECNT + pass * 8;
    int a = 0;
#pragma unroll
    for (int e = 0; e < 8; ++e) { ts[e] = a; a += (int)((__hip_atomic_load(cnt + e, __ATOMIC_RELAXED, __HIP_MEMORY_SCOPE_AGENT) + 255u) >> 8); }
    ts[8] = a;
}
__device__ __forceinline__ void phase_moe_rowmap(const Frame& F) {
    int ts0[9], ts1[9]; moe_tstart(F, 0, ts0); moe_tstart(F, 1, ts1);
    const int* te = (const int*)(F.ws + WS_ROUTE + RT_TOKE); const float* tg = (const float*)(F.ws + WS_ROUTE + RT_TOKG); const int* tp = (const int*)(F.ws + WS_ROUTE + RT_TOKP);
    int* rmap = (int*)(F.ws + WS_ROUTE + RT_RMAP); float* sg = (float*)(F.ws + WS_ROUTE + RT_SGATE);
    for (int t = F.bid * NTHREADS + F.tid; t < NLAT; t += F.G * NTHREADS) {
        { const int e = te[t * 2]; int st = 0;
#pragma unroll
          for (int j = 0; j < 8; ++j) st = (e == j) ? ts0[j] : st;
          const int slot = st * 256 + tp[t * 2]; rmap[slot] = t; sg[slot] = tg[t * 2]; }
        { const int e = te[t * 2 + 1]; int st = 0;
#pragma unroll
          for (int j = 0; j < 8; ++j) st = (e == j) ? ts1[j] : st;
          const int slot = st * 256 + tp[t * 2 + 1]; rmap[NROW + slot] = t; sg[NROW + slot] = tg[t * 2 + 1]; }
    }
}

struct RowGeo { int b, tt, pos, len; };
__device__ __forceinline__ RowGeo row_geo(int r) { RowGeo g; if (r < NLAT) { g.b = r >> 12; g.pos = r & 4095; g.len = SEQ; g.tt = CTXL + g.pos; } else { const int q = r - NLAT; g.b = q >> 8; g.pos = q & 255; g.len = CTXL; g.tt = g.pos; } return g; }

__device__ __forceinline__ void rw_shift4(const bf16_t* PL, const float* mup, const float* mun, int r, const RowGeo& g, int j, float (&u)[4]) {
    const bf16_t* p = PL + (size_t)r * INW + O_RW + j;
    const bool hp = g.pos > 0, hn = g.pos < g.len - 1;
    float c[4], pv[4], nv[4];
    unpack4(*(const u32x2*)p, c); unpack4(*(const u32x2*)(p - (hp ? INW : 0)), pv); unpack4(*(const u32x2*)(p + (hn ? INW : 0)), nv);
    const f32x4 mp = *(const f32x4*)(mup + j), mn = *(const f32x4*)(mun + j);
#pragma unroll
    for (int q = 0; q < 4; ++q) u[q] = c[q] + mp[q] * ((hp ? pv[q] : 0.f) - c[q]) + mn[q] * ((hn ? nv[q] : 0.f) - c[q]);
}

__device__ __forceinline__ void rw_shift8(const bf16_t* PL, const float* mup, const float* mun, int r, const RowGeo& g, int j, float (&u)[8]) {
    const bf16_t* p = PL + (size_t)r * INW + O_RW + j;
    const bool hp = g.pos > 0, hn = g.pos < g.len - 1;
    float c[8], pv[8], nv[8];
    unpack8(*(const u32x4*)p, c); unpack8(*(const u32x4*)(p - (hp ? INW : 0)), pv); unpack8(*(const u32x4*)(p + (hn ? INW : 0)), nv);
    const f32x4 mp0 = *(const f32x4*)(mup + j), mp1 = *(const f32x4*)(mup + j + 4), mn0 = *(const f32x4*)(mun + j), mn1 = *(const f32x4*)(mun + j + 4);
#pragma unroll
    for (int q = 0; q < 4; ++q) { u[q] = c[q] + mp0[q] * ((hp ? pv[q] : 0.f) - c[q]) + mn0[q] * ((hn ? nv[q] : 0.f) - c[q]);
        u[4 + q] = c[4 + q] + mp1[q] * ((hp ? pv[4 + q] : 0.f) - c[4 + q]) + mn1[q] * ((hn ? nv[4 + q] : 0.f) - c[4 + q]); }
}
__device__ __forceinline__ bf16x8 pack8f(const float (&f)[8]) {
    u32x4 w; w.x = cvt_pk_bf16(f[0], f[1]); w.y = cvt_pk_bf16(f[2], f[3]); w.z = cvt_pk_bf16(f[4], f[5]); w.w = cvt_pk_bf16(f[6], f[7]); return __builtin_bit_cast(bf16x8, w);
}
constexpr int RL_MUP = 0, RL_MUN = 5120, RL_KK = 10240, RL_KA = 11264, RL_W0 = 12288, RL_A0 = 14336, RL_RK = 16384, RL_GNG = 17408, RL_GNB = 18432, RL_END = 19456;
__device__ __forceinline__ void rw_stage_tables(const Frame& F, const Params& P, int l) {
    LAS float* T = (LAS float*)F.lds;
    for (int i = F.tid; i < 1280; i += NTHREADS) { T[RL_MUP / 4 + i] = P.in[I_MUP][l * 1280 + i]; T[RL_MUN / 4 + i] = P.in[I_MUN][l * 1280 + i]; }
    for (int i = F.tid; i < 256; i += NTHREADS) { T[RL_KK / 4 + i] = P.in[I_KK][l * 256 + i]; T[RL_KA / 4 + i] = P.in[I_KA][l * 256 + i]; T[RL_RK / 4 + i] = P.in[I_RK][l * 256 + i];
        T[RL_GNG / 4 + i] = P.in[I_GNG][l * 256 + i]; T[RL_GNB / 4 + i] = P.in[I_GNB][l * 256 + i]; }
    for (int i = F.tid; i < 512; i += NTHREADS) { T[RL_W0 / 4 + i] = P.in[I_W0][l * 512 + i]; T[RL_A0 / 4 + i] = P.in[I_A0][l * 512 + i]; }
    __syncthreads();
}
__device__ __forceinline__ void rw_mix8(const LAS float* T, const u32x4 (&raw)[3], bool hp, bool hn, int j, float (&u)[8]) {
    float c[8], pv[8], nv[8]; unpack8(raw[0], c); unpack8(raw[1], pv); unpack8(raw[2], nv);
    const f32x4 mp0 = *(const LAS f32x4*)(T + RL_MUP / 4 + j), mp1 = *(const LAS f32x4*)(T + RL_MUP / 4 + j + 4), mn0 = *(const LAS f32x4*)(T + RL_MUN / 4 + j), mn1 = *(const LAS f32x4*)(T + RL_MUN / 4 + j + 4);
#pragma unroll
    for (int q = 0; q < 4; ++q) { u[q] = c[q] + mp0[q] * ((hp ? pv[q] : 0.f) - c[q]) + mn0[q] * ((hn ? nv[q] : 0.f) - c[q]);
        u[4 + q] = c[4 + q] + mp1[q] * ((hp ? pv[4 + q] : 0.f) - c[4 + q]) + mn1[q] * ((hn ? nv[4 + q] : 0.f) - c[4 + q]); }
}
__device__ __forceinline__ void rw_mix4(const LAS float* T, const u32x2 (&raw)[3], bool hp, bool hn, int j, float (&u)[4]) {
    float c[4], pv[4], nv[4]; unpack4(raw[0], c); unpack4(raw[1], pv); unpack4(raw[2], nv);
    const f32x4 mp = *(const LAS f32x4*)(T + RL_MUP / 4 + j), mn = *(const LAS f32x4*)(T + RL_MUN / 4 + j);
#pragma unroll
    for (int q = 0; q < 4; ++q) u[q] = c[q] + mp[q] * ((hp ? pv[q] : 0.f) - c[q]) + mn[q] * ((hn ? nv[q] : 0.f) - c[q]);
}
__device__ __forceinline__ void phase_rw_prep(const Frame& F, const Params& P, int l) {
    const bf16_t* PL = (const bf16_t*)(F.ws + WS_PL);
    f16_t* SH = (f16_t*)(F.ws + WS_SH); f16_t* SD = (f16_t*)(F.ws + WS_SD);
    const int lane = F.lane;
    rw_stage_tables(F, P, l);
    const LAS float* T = (const LAS float*)F.lds;
    for (int item = F.gw; item < NLAT / 16 + (NCTX / 16) * 4; item += F.nw) {
        const int tile = item < NLAT / 16 ? item : NLAT / 16 + ((item - NLAT / 16) >> 2), h0 = item < NLAT / 16 ? 0 : ((item - NLAT / 16) & 3), h1 = item < NLAT / 16 ? 4 : h0 + 1;
        int l1 = lane; asm volatile("" : "+v"(l1)); const int tk = l1 & 15, g = l1 >> 4;
        const int r = tile * 16 + tk; const RowGeo geo = row_geo(r);
        const bool hp = geo.pos > 0, hn = geo.pos < geo.len - 1;
        const bf16_t* prow = PL + (size_t)r * INW + O_RW; const int dprev = hp ? -INW : 0, dnext = hn ? INW : 0;
        bf16x8 tw[2][2], ta[2][2];
#pragma unroll
        for (int d = 0; d < 2; ++d) { u32x4 raw[4][3];
#pragma unroll
          for (int i = 0; i < 4; ++i) { const bf16_t* p = prow + 768 + 256 * d + 64 * (i & 1) + 32 * (i >> 1) + 8 * g;
              raw[i][0] = *(const u32x4*)p; raw[i][1] = *(const u32x4*)(p + dprev); raw[i][2] = *(const u32x4*)(p + dnext); }
#pragma unroll
          for (int i = 0; i < 4; ++i) { float u[8]; rw_mix8(T, raw[i], hp, hn, 768 + 256 * d + 64 * (i & 1) + 32 * (i >> 1) + 8 * g, u);
              if ((i & 1) == 0) {
#pragma unroll
                  for (int q = 0; q < 8; ++q) u[q] = 1.0f - 2.0f / (1.0f + __expf(2.0f * u[q]));
                  tw[d][i >> 1] = pack8f(u); }
              else ta[d][i >> 1] = pack8f(u); }
          asm volatile("" ::: "memory"); }
        asm volatile("" ::: "memory");
#pragma unroll 1
        for (int h = h0; h < h1; ++h) {
            int l2 = lane; asm volatile("" : "+v"(l2)); const int tk = l2 & 15, g = l2 >> 4;
            const int r = tile * 16 + tk; const RowGeo geo = row_geo(r);
            const bool hp = geo.pos > 0, hn = geo.pos < geo.len - 1;
            const bf16_t* prow = PL + (size_t)r * INW + O_RW + 64 * h + 8 * g; const int dprev = hp ? -INW : 0, dnext = hn ? INW : 0;
            float ur[4][4], uk[4][4], uv[4][4], kkv[4][4]; float ss = 0.f;
            { u32x4 raw[6][3];
#pragma unroll
              for (int i = 0; i < 6; ++i) { const bf16_t* p = prow + 256 * (i >> 1) + 32 * (i & 1);
                  raw[i][0] = *(const u32x4*)p; raw[i][1] = *(const u32x4*)(p + dprev); raw[i][2] = *(const u32x4*)(p + dnext); }
#pragma unroll
              for (int u = 0; u < 2; ++u) { float x8[8]; const int c = 64 * h + 32 * u + 8 * g;
                  rw_mix8(T, raw[u], hp, hn, c, x8);
#pragma unroll
                  for (int e = 0; e < 8; ++e) ur[2 * u + (e >> 2)][e & 3] = x8[e];
                  rw_mix8(T, raw[2 + u], hp, hn, 256 + c, x8);
#pragma unroll
                  for (int e = 0; e < 8; ++e) uk[2 * u + (e >> 2)][e & 3] = x8[e];
                  rw_mix8(T, raw[4 + u], hp, hn, 512 + c, x8);
#pragma unroll
                  for (int e = 0; e < 8; ++e) uv[2 * u + (e >> 2)][e & 3] = x8[e];
                  const f32x4 k0 = *(const LAS f32x4*)(T + RL_KK / 4 + c), k1 = *(const LAS f32x4*)(T + RL_KK / 4 + c + 4);
#pragma unroll
                  for (int q = 0; q < 4; ++q) { kkv[2 * u][q] = uk[2 * u][q] * k0[q]; kkv[2 * u + 1][q] = uk[2 * u + 1][q] * k1[q]; ss += kkv[2 * u][q] * kkv[2 * u][q] + kkv[2 * u + 1][q] * kkv[2 * u + 1][q]; } } }
            ss += __shfl_xor(ss, 16); ss += __shfl_xor(ss, 32);
            const float rn = rsqrtf(ss + 1e-12f);
            const size_t shrow = ((size_t)(geo.b * 4 + h) * TT + geo.tt) * 192;
#pragma unroll
            for (int u = 0; u < 2; ++u) { f16x8 o1, o2, o3;
#pragma unroll
                for (int e = 0; e < 8; ++e) { const int t = 2 * u + (e >> 2), q = e & 3; kkv[t][q] *= rn; o1[e] = (f16_t)ur[t][q]; o2[e] = (f16_t)uv[t][q]; o3[e] = (f16_t)(-kkv[t][q]); }
                f16_t* sp = SH + shrow + 32 * u + 8 * g; *(f16x8*)sp = o1; *(f16x8*)(sp + 64) = o2; *(f16x8*)(sp + 128) = o3; }
#pragma unroll 1
            for (int d = 0; d < 2; ++d) {
                const bf16_t* w2t = (const bf16_t*)(F.ws + WS_LORA + (size_t)(l * 2 + d) * LORA_LD_BYTES); const bf16_t* a2t = w2t + 256 * 64;
                const size_t sdrow = ((size_t)((d * 8 + geo.b) * 4 + h) * TT + geo.tt) * 192;
                const bf16x8 tw0 = d ? tw[1][0] : tw[0][0], tw1 = d ? tw[1][1] : tw[0][1], ta0 = d ? ta[1][0] : ta[0][0], ta1 = d ? ta[1][1] : ta[0][1];
                bf16x8 wf[4][2], af[4][2];
#pragma unroll
                for (int t = 0; t < 4; ++t) { const int wrow = 64 * h + 32 * (t >> 1) + 8 * (tk >> 2) + 4 * (t & 1) + (tk & 3);
                    const bf16_t* wr = w2t + (size_t)wrow * 64 + 8 * g; const bf16_t* ar = a2t + (size_t)wrow * 64 + 8 * g;
                    wf[t][0] = *(const bf16x8*)wr; wf[t][1] = *(const bf16x8*)(wr + 32); af[t][0] = *(const bf16x8*)ar; af[t][1] = *(const bf16x8*)(ar + 32); }
                f16x8 o1[2], o2[2], o3[2];
#pragma unroll
                for (int t = 0; t < 4; ++t) { const int c = 64 * h + 32 * (t >> 1) + 8 * g + 4 * (t & 1);
                    f32x4 xw = *(const LAS f32x4*)(T + RL_W0 / 4 + d * 256 + c), xa = *(const LAS f32x4*)(T + RL_A0 / 4 + d * 256 + c);
                    xw = __builtin_amdgcn_mfma_f32_16x16x32_bf16(wf[t][0], tw0, xw, 0, 0, 0); xw = __builtin_amdgcn_mfma_f32_16x16x32_bf16(wf[t][1], tw1, xw, 0, 0, 0);
                    xa = __builtin_amdgcn_mfma_f32_16x16x32_bf16(af[t][0], ta0, xa, 0, 0, 0); xa = __builtin_amdgcn_mfma_f32_16x16x32_bf16(af[t][1], ta1, xa, 0, 0, 0);
                    const f32x4 kaw = *(const LAS f32x4*)(T + RL_KA / 4 + c);
#pragma unroll
                    for (int q = 0; q < 4; ++q) {
                        const float nx = -xw[q]; const float sp = fmaxf(nx, 0.f) + __logf(1.0f + __expf(-fabsf(nx)));
                        const float e = __expf(-sp - 0.5f);
                        const float omw = 1.0f - __expf(-e);
                        const float a = sigmoidf_(xa[q]);
                        o1[t >> 1][(t & 1) * 4 + q] = (f16_t)omw; o2[t >> 1][(t & 1) * 4 + q] = (f16_t)(uk[t][q] * (1.0f + (a - 1.0f) * kaw[q])); o3[t >> 1][(t & 1) * 4 + q] = (f16_t)(kkv[t][q] * a); } }
#pragma unroll
                for (int u = 0; u < 2; ++u) { f16_t* sp = SD + sdrow + 32 * u + 8 * g; *(f16x8*)sp = o1[u]; *(f16x8*)(sp + 64) = o2[u]; *(f16x8*)(sp + 128) = o3[u]; }
                asm volatile("" ::: "memory");
            }
        }
    }
    __syncthreads();
}

constexpr int CS_ZP = 0, CS_RPP = 2048, CS_BH = 4096, CS_KH = 6144, CS_VV = 8192, CS_MT = 10240, CS_NT = 11264, CS_WC = 12288, CS_SLOT = 12544;
constexpr int CS_ZIMG = 8 * CS_SLOT;
constexpr int CS_NCHUNK = TT / 16;
__device__ __forceinline__ int cs_tt(int d, int q, int s) { const int st = 16 * q + s; return d == 0 ? st : (st < CTXL ? CTXL - 1 - st : TT + CTXL - 1 - st); }
__device__ __forceinline__ float dpp_shr(float old, float v, int) { return v; }
template <int N> __device__ __forceinline__ float row_shr(float v, float old) {
    return __builtin_bit_cast(float, __builtin_amdgcn_update_dpp(__builtin_bit_cast(int, old), __builtin_bit_cast(int, v), 0x110 + N, 0xF, 0xF, false));
}
__device__ __forceinline__ bf16x8 cs_pack(const float (&a)[4], const float (&b)[4]) {
    u32x4 w; w.x = cvt_pk_bf16(a[0], a[1]); w.y = cvt_pk_bf16(a[2], a[3]); w.z = cvt_pk_bf16(b[0], b[1]); w.w = cvt_pk_bf16(b[2], b[3]); return __builtin_bit_cast(bf16x8, w);
}
__device__ __forceinline__ bf16x8 cs_op16(const f32x4& x) { u32x4 w; w.x = cvt_pk_bf16(x[0], x[1]); w.y = cvt_pk_bf16(x[2], x[3]); w.z = 0u; w.w = 0u; return __builtin_bit_cast(bf16x8, w); }
#define CS_MFMA(a, b, c) __builtin_amdgcn_mfma_f32_16x16x32_bf16((a), (b), (c), 0, 0, 0)
__device__ __forceinline__ f32x4 cs_mm16(const f32x4& xt_d, const f32x4& y_d) { return CS_MFMA(cs_op16(xt_d), cs_op16(y_d), ((f32x4){0.f, 0.f, 0.f, 0.f})); }
__device__ __forceinline__ v4i16_t cs_tr(const LAS unsigned char* img, int lane, int T) {
    const int g = lane >> 4, q = (lane & 15) >> 2, p = lane & 3;
    return __builtin_amdgcn_ds_read_tr16_b64_v4i16((LAS v4i16_t*)(img + (4 * g + q) * 128 + p * 32 + (T >> 1) * 16 + (T & 1) * 8));
}
__device__ __forceinline__ bf16x8 cs_lo(v4i16_t x) { bf16x8 r; r[0] = x[0]; r[1] = x[1]; r[2] = x[2]; r[3] = x[3]; r[4] = 0; r[5] = 0; r[6] = 0; r[7] = 0; return r; }

struct CsRaw { u32x2 x[4], z[4], r[4], b[4], k[4], v[4]; };
__device__ __forceinline__ void cs_load(CsRaw& R, const f16_t* sh, const f16_t* sd, int d, int q, int lane) {
    const int s = lane & 15, g = lane >> 4; const int tt = cs_tt(d, q, s);
    const f16_t* shp = sh + (size_t)tt * 192 + 4 * g; const f16_t* sdp = sd + (size_t)tt * 192 + 4 * g;
#pragma unroll
    for (int T = 0; T < 4; ++T) { R.x[T] = *(const u32x2*)(sdp + 16 * T); R.z[T] = *(const u32x2*)(shp + 128 + 16 * T); R.r[T] = *(const u32x2*)(shp + 16 * T);
        R.b[T] = *(const u32x2*)(sdp + 128 + 16 * T); R.k[T] = *(const u32x2*)(sdp + 64 + 16 * T); R.v[T] = *(const u32x2*)(shp + 64 + 16 * T); }
}
__device__ __forceinline__ void cs_prepass(LAS unsigned char* slot, LAS unsigned char* zimg, CsRaw& raw, const f16_t* sh, const f16_t* sd, int d, int qn, int lane) {
    const int s = lane & 15, g = lane >> 4;
    float Wc[4][4], Wp[4][4], iW[4][4];
#pragma unroll
    for (int T = 0; T < 4; ++T) { const f16x4 x4 = __builtin_bit_cast(f16x4, raw.x[T]);
#pragma unroll
        for (int j = 0; j < 4; ++j) { float wc = 1.0f - (float)x4[j];
            wc *= row_shr<1>(wc, 1.0f); wc *= row_shr<2>(wc, 1.0f); wc *= row_shr<4>(wc, 1.0f); wc *= row_shr<8>(wc, 1.0f);
            Wc[T][j] = wc; Wp[T][j] = row_shr<1>(wc, 1.0f); iW[T][j] = __builtin_amdgcn_rcpf(wc); } }
    if (s == 15) {
#pragma unroll
        for (int T = 0; T < 4; ++T) *(LAS f32x4*)(slot + CS_WC + (16 * T + 4 * g) * 4) = (f32x4){Wc[T][0], Wc[T][1], Wc[T][2], Wc[T][3]}; }
    bf16x8 oZ[2], oR[2], oB[2], oK[2];
    const int ioff = s * 128 + g * 32;
#define CS_STAGE(dst, SRC, SC, IMG) do { float t_[4][4]; \
        _Pragma("unroll") for (int T = 0; T < 4; ++T) { const f16x4 q4 = __builtin_bit_cast(f16x4, SRC[T]); \
            _Pragma("unroll") for (int j = 0; j < 4; ++j) t_[T][j] = (float)q4[j] * SC; } \
        _Pragma("unroll") for (int kk = 0; kk < 2; ++kk) { dst[kk] = cs_pack(t_[2 * kk], t_[2 * kk + 1]); if (IMG) *(LAS bf16x8*)((IMG) + ioff + kk * 16) = dst[kk]; } \
        } while (0)
    CS_STAGE(oZ, raw.z, Wp[T][j], zimg);
    CS_STAGE(oR, raw.r, Wc[T][j], (LAS unsigned char*)nullptr);
    CS_STAGE(oB, raw.b, iW[T][j], slot + CS_BH);
    CS_STAGE(oK, raw.k, iW[T][j], slot + CS_KH);
    { bf16x8 oV[2]; CS_STAGE(oV, raw.v, 1.0f, slot + CS_VV); }
#undef CS_STAGE
    asm volatile("" ::: "memory");
    if (qn >= 0) cs_load(raw, sh, sd, d, qn, lane);
    const f32x4 zero4 = (f32x4){0.f, 0.f, 0.f, 0.f};
    f32x4 A_D = CS_MFMA(oB[1], oZ[1], CS_MFMA(oB[0], oZ[0], zero4)), AT_D = CS_MFMA(oZ[1], oB[1], CS_MFMA(oZ[0], oB[0], zero4));
    f32x4 BkT_D = CS_MFMA(oZ[1], oK[1], CS_MFMA(oZ[0], oK[0], zero4));
    f32x4 Ar_D = CS_MFMA(oB[1], oR[1], CS_MFMA(oB[0], oR[0], zero4)), Kr_D = CS_MFMA(oK[1], oR[1], CS_MFMA(oK[0], oR[0], zero4));
    f32x4 I_D;
#pragma unroll
    for (int j = 0; j < 4; ++j) { const int m = 4 * g + j;
        A_D[j] = m < s ? A_D[j] : 0.f; AT_D[j] = s < m ? AT_D[j] : 0.f; BkT_D[j] = s < m ? BkT_D[j] : 0.f;
        Ar_D[j] = m <= s ? Ar_D[j] : 0.f; Kr_D[j] = m <= s ? Kr_D[j] : 0.f; I_D[j] = m == s ? 1.f : 0.f; }
    f32x4 Ab, AbT, A1, A2m;
#pragma unroll
    for (int j = 0; j < 4; ++j) { const int m = 4 * g + j; const bool b0 = (m >> 2) == (s >> 2), b1 = (m >> 3) == (s >> 3);
        Ab[j] = b0 ? A_D[j] : 0.f; AbT[j] = b0 ? AT_D[j] : 0.f; A1[j] = (b1 && !b0) ? A_D[j] : 0.f; A2m[j] = b1 ? 0.f : A_D[j]; }
    const f32x4 Ab2 = cs_mm16(AbT, Ab), Ab2T = cs_mm16(Ab, AbT);
    const f32x4 P0 = I_D + Ab, P0T = I_D + AbT;
    const f32x4 T0 = P0 + cs_mm16(P0T, Ab2), T0T = P0T + cs_mm16(Ab2, P0T);
    (void)Ab2T;
    const f32x4 ZT = cs_mm16(A1, T0T);
    const f32x4 T1 = T0 + cs_mm16(ZT, T0), T1T = T0T + cs_mm16(T0, ZT);
    const f32x4 Z2T = cs_mm16(A2m, T1T);
    const f32x4 T_D = T1 + cs_mm16(Z2T, T1);
    const f32x4 M_D = cs_mm16(BkT_D, T_D), MT_D = cs_mm16(T_D, BkT_D);
    const f32x4 N_D = cs_mm16(MT_D, Ar_D) + Kr_D;
    { u32x4 w; w.x = cvt_pk_bf16(M_D[0], M_D[1]); w.y = cvt_pk_bf16(M_D[2], M_D[3]); w.z = 0u; w.w = 0u; *(LAS u32x4*)(slot + CS_MT + s * 64 + g * 16) = w;
      w.x = cvt_pk_bf16(N_D[0], N_D[1]); w.y = cvt_pk_bf16(N_D[2], N_D[3]); *(LAS u32x4*)(slot + CS_NT + s * 64 + g * 16) = w; }
    __builtin_amdgcn_wave_barrier(); asm volatile("" ::: "memory");
    const bf16x8 oT = cs_op16(T_D), oAr = cs_op16(Ar_D);
    float Zp[4][4];
#pragma unroll
    for (int T = 0; T < 4; ++T) { const f32x4 zp = CS_MFMA(cs_lo(cs_tr(zimg, lane, T)), oT, zero4);
#pragma unroll
        for (int j = 0; j < 4; ++j) Zp[T][j] = zp[j]; }
#pragma unroll
    for (int kk = 0; kk < 2; ++kk) *(LAS bf16x8*)(slot + CS_ZP + s * 128 + g * 32 + kk * 16) = cs_pack(Zp[2 * kk], Zp[2 * kk + 1]);
    __builtin_amdgcn_wave_barrier(); asm volatile("" ::: "memory");
    float Rp[4][4];
#pragma unroll
    for (int T = 0; T < 4; ++T) { const f32x4 rp = CS_MFMA(cs_lo(cs_tr(slot + CS_ZP, lane, T)), oAr, zero4);
#pragma unroll
        for (int j = 0; j < 4; ++j) Rp[T][j] = rp[j] + bf2f((bf16_t)oR[T >> 1][(T & 1) * 4 + j]); }
#pragma unroll
    for (int kk = 0; kk < 2; ++kk) *(LAS bf16x8*)(slot + CS_RPP + s * 128 + g * 32 + kk * 16) = cs_pack(Rp[2 * kk], Rp[2 * kk + 1]);
}
__device__ __forceinline__ void cs_scan_chunk(const LAS unsigned char* slot, f32x4 (&acc)[4], float* yp  , int d, int q, int wave, int lane) {
    const int s = lane & 15, g = lane >> 4;
    const f32x4 zero4 = (f32x4){0.f, 0.f, 0.f, 0.f};
    bf16x8 Xb[2];
#pragma unroll
    for (int kk = 0; kk < 2; ++kk) { u32x4 w; w.x = cvt_pk_bf16(acc[2 * kk][0], acc[2 * kk][1]); w.y = cvt_pk_bf16(acc[2 * kk][2], acc[2 * kk][3]);
        w.z = cvt_pk_bf16(acc[2 * kk + 1][0], acc[2 * kk + 1][1]); w.w = cvt_pk_bf16(acc[2 * kk + 1][2], acc[2 * kk + 1][3]); Xb[kk] = __builtin_bit_cast(bf16x8, w); }
    const v4i16_t vt = cs_tr(slot + CS_VV, lane, wave);
    const bf16x8 Vb = cs_lo(vt);
    const int arow = s * 128 + g * 32, a16 = s * 64 + g * 16;
    f32x4 UT = CS_MFMA(*(const LAS bf16x8*)(slot + CS_ZP + arow), Xb[0], zero4); UT = CS_MFMA(*(const LAS bf16x8*)(slot + CS_ZP + arow + 16), Xb[1], UT); UT = CS_MFMA(*(const LAS bf16x8*)(slot + CS_MT + a16), Vb, UT);
    f32x4 YT = CS_MFMA(*(const LAS bf16x8*)(slot + CS_RPP + arow), Xb[0], zero4); YT = CS_MFMA(*(const LAS bf16x8*)(slot + CS_RPP + arow + 16), Xb[1], YT); YT = CS_MFMA(*(const LAS bf16x8*)(slot + CS_NT + a16), Vb, YT);
#pragma unroll
    for (int j = 0; j < 4; ++j) yp[(size_t)cs_tt(d, q, 4 * g + j) * 256] = YT[j];
    bf16x8 UV; { u32x2 w; w.x = cvt_pk_bf16(UT[0], UT[1]); w.y = cvt_pk_bf16(UT[2], UT[3]); const v4i16_t ub = __builtin_bit_cast(v4i16_t, w);
        UV[0] = ub[0]; UV[1] = ub[1]; UV[2] = ub[2]; UV[3] = ub[3]; UV[4] = vt[0]; UV[5] = vt[1]; UV[6] = vt[2]; UV[7] = vt[3]; }
#pragma unroll
    for (int T = 0; T < 4; ++T) { const v4i16_t bh = cs_tr(slot + CS_BH, lane, T), kh = cs_tr(slot + CS_KH, lane, T);
        bf16x8 BK; BK[0] = bh[0]; BK[1] = bh[1]; BK[2] = bh[2]; BK[3] = bh[3]; BK[4] = kh[0]; BK[5] = kh[1]; BK[6] = kh[2]; BK[7] = kh[3];
        acc[T] = CS_MFMA(BK, UV, acc[T]);
        acc[T] *= *(const LAS f32x4*)(slot + CS_WC + (16 * T + 4 * g) * 4); }
}
__device__ __forceinline__ void phase_scan(const Frame& F) {
    const f16_t* SH = (const f16_t*)(F.ws + WS_SH); const f16_t* SD = (const f16_t*)(F.ws + WS_SD);
    float* Y = (float*)(F.ws + WS_Y);
    const int lane = F.lane, wave = F.wave;
    for (int chain = F.bid; chain < 64; chain += F.G) {
        const int d = chain >> 5, b = (chain >> 2) & 7, h = chain & 3;
        const f16_t* sh = SH + (size_t)(b * 4 + h) * TT * 192; const f16_t* sd = SD + (size_t)((d * 8 + b) * 4 + h) * TT * 192;
        float* yp = Y + ((size_t)(d * 8 + b) * TT) * 256 + h * 64 + 16 * (wave & 3) + (lane & 15);
        f32x4 acc[4];
#pragma unroll
        for (int T = 0; T < 4; ++T) acc[T] = (f32x4){0.f, 0.f, 0.f, 0.f};
        __syncthreads();
        CsRaw raw;
        constexpr int NR = CS_NCHUNK / 8;
        cs_load(raw, sh, sd, d, wave, lane);
        for (int R = 0; R < NR; ++R) {
            cs_prepass(F.lds + wave * CS_SLOT, F.lds + CS_ZIMG + wave * 2048, raw, sh, sd, d, (R + 1 < NR) ? 8 * (R + 1) + wave : -1, lane);
            asm volatile("s_waitcnt lgkmcnt(0)" ::: "memory"); __builtin_amdgcn_s_barrier(); asm volatile("" ::: "memory");
            if (wave < 4) {
#pragma unroll 1
                for (int c8 = 0; c8 < 8; ++c8) cs_scan_chunk(F.lds + c8 * CS_SLOT, acc, yp, d, 8 * R + c8, wave, lane);
            }
            asm volatile("s_waitcnt lgkmcnt(0)" ::: "memory"); __builtin_amdgcn_s_barrier(); asm volatile("" ::: "memory");
        }
    }
}

__device__ __forceinline__ void phase_rw_post(const Frame& F, const Params& P, int l, int nrows) {
    const bf16_t* PL = (const bf16_t*)(F.ws + WS_PL); bf16_t* MIX = (bf16_t*)(F.ws + WS_MIX);
    const f16_t* SH = (const f16_t*)(F.ws + WS_SH); const f16_t* SD = (const f16_t*)(F.ws + WS_SD); const float* Y = (const float*)(F.ws + WS_Y);
    const int lane = F.lane;
    rw_stage_tables(F, P, l);
    const LAS float* T = (const LAS float*)F.lds;
    for (int item = F.gw; item < NLAT / 16 + ((nrows - NLAT) / 16) * 4; item += F.nw) {
        const int tile = item < NLAT / 16 ? item : NLAT / 16 + ((item - NLAT / 16) >> 2), h0 = item < NLAT / 16 ? 0 : ((item - NLAT / 16) & 3), h1 = item < NLAT / 16 ? 4 : h0 + 1;
        int l1 = lane; asm volatile("" : "+v"(l1)); const int tk = l1 & 15, g = l1 >> 4;
        const int r = tile * 16 + tk; const RowGeo geo = row_geo(r);
        const bool hp = geo.pos > 0, hn = geo.pos < geo.len - 1;
        const bf16_t* prow = PL + (size_t)r * INW + O_RW; const int dprev = hp ? -INW : 0, dnext = hn ? INW : 0;
        bf16x8 sg[2][4];
#pragma unroll
        for (int d = 0; d < 2; ++d) { u32x4 raw[4][3];
#pragma unroll
            for (int kk = 0; kk < 4; ++kk) { const bf16_t* p = prow + 896 + 256 * d + 32 * kk + 8 * g;
                raw[kk][0] = *(const u32x4*)p; raw[kk][1] = *(const u32x4*)(p + dprev); raw[kk][2] = *(const u32x4*)(p + dnext); }
#pragma unroll
            for (int kk = 0; kk < 4; ++kk) { float u[8]; rw_mix8(T, raw[kk], hp, hn, 896 + 256 * d + 32 * kk + 8 * g, u);
#pragma unroll
                for (int q = 0; q < 8; ++q) u[q] = sigmoidf_(u[q]);
                sg[d][kk] = pack8f(u); }
            asm volatile("" ::: "memory"); }
#pragma unroll 1
        for (int h = h0; h < h1; ++h) {
            int l2 = lane; asm volatile("" : "+v"(l2)); const int tk = l2 & 15, g = l2 >> 4;
            const int r = tile * 16 + tk; const RowGeo geo = row_geo(r);
            const size_t shrow = ((size_t)(geo.b * 4 + h) * TT + geo.tt) * 192;
            float out[4][4];
#pragma unroll
            for (int t = 0; t < 4; ++t)
#pragma unroll
                for (int q = 0; q < 4; ++q) out[t][q] = 0.f;
            f16x8 rh[2], vh[2];
#pragma unroll
            for (int u = 0; u < 2; ++u) { rh[u] = *(const f16x8*)(SH + shrow + 32 * u + 8 * g); vh[u] = *(const f16x8*)(SH + shrow + 64 + 32 * u + 8 * g); }
#pragma unroll 1
            for (int d = 0; d < 2; ++d) {
                const bf16_t* g2t = (const bf16_t*)(F.ws + WS_LORA + (size_t)(l * 2 + d) * LORA_LD_BYTES) + 2 * 256 * 64;
                const size_t sdrow = ((size_t)((d * 8 + geo.b) * 4 + h) * TT + geo.tt) * 192;
                const float* yrow = Y + ((size_t)(d * 8 + geo.b) * TT + geo.tt) * 256 + 64 * h + 8 * g;
                bf16x8 sgd[4];
#pragma unroll
                for (int kk = 0; kk < 4; ++kk) sgd[kk] = d ? sg[1][kk] : sg[0][kk];
                f32x4 y[4], gg[4]; f16x8 kdh[2]; bf16x8 gf[4][4];
#pragma unroll
                for (int u = 0; u < 2; ++u) { y[2 * u] = *(const f32x4*)(yrow + 32 * u); y[2 * u + 1] = *(const f32x4*)(yrow + 32 * u + 4); kdh[u] = *(const f16x8*)(SD + sdrow + 64 + 32 * u + 8 * g); }
#pragma unroll
                for (int t = 0; t < 4; ++t) { const bf16_t* gr = g2t + (size_t)(64 * h + 32 * (t >> 1) + 8 * (tk >> 2) + 4 * (t & 1) + (tk & 3)) * 128 + 8 * g;
#pragma unroll
                    for (int kk = 0; kk < 4; ++kk) gf[t][kk] = *(const bf16x8*)(gr + 32 * kk); }
                float sm = 0.f, bs = 0.f;
#pragma unroll
                for (int t = 0; t < 4; ++t) { const int c = 64 * h + 32 * (t >> 1) + 8 * g + 4 * (t & 1);
                    sm += (y[t][0] + y[t][1]) + (y[t][2] + y[t][3]);
                    const f32x4 rk = *(const LAS f32x4*)(T + RL_RK / 4 + c);
#pragma unroll
                    for (int q = 0; q < 4; ++q) bs += (float)rh[t >> 1][(t & 1) * 4 + q] * (float)kdh[t >> 1][(t & 1) * 4 + q] * rk[q];
                    f32x4 a = (f32x4){0.f, 0.f, 0.f, 0.f};
#pragma unroll
                    for (int kk = 0; kk < 4; ++kk) a = __builtin_amdgcn_mfma_f32_16x16x32_bf16(gf[t][kk], sgd[kk], a, 0, 0, 0);
                    gg[t] = a; }
                sm += __shfl_xor(sm, 16); sm += __shfl_xor(sm, 32); bs += __shfl_xor(bs, 16); bs += __shfl_xor(bs, 32);
                const float mu = sm * (1.0f / 64.0f); float vs = 0.f;
#pragma unroll
                for (int t = 0; t < 4; ++t)
#pragma unroll
                    for (int q = 0; q < 4; ++q) { const float dd = y[t][q] - mu; vs += dd * dd; }
                vs += __shfl_xor(vs, 16); vs += __shfl_xor(vs, 32);
                const float rstd = rsqrtf(vs * (1.0f / 64.0f) + 64e-5f);
#pragma unroll
                for (int t = 0; t < 4; ++t) { const int c = 64 * h + 32 * (t >> 1) + 8 * g + 4 * (t & 1);
                    const f32x4 gng = *(const LAS f32x4*)(T + RL_GNG / 4 + c), gnb = *(const LAS f32x4*)(T + RL_GNB / 4 + c);
#pragma unroll
                    for (int q = 0; q < 4; ++q) out[t][q] += ((y[t][q] - mu) * rstd * gng[q] + gnb[q] + bs * (float)vh[t >> 1][(t & 1) * 4 + q]) * gg[t][q]; }
                asm volatile("" ::: "memory");
            }
#pragma unroll
            for (int u = 0; u < 2; ++u) { u32x4 w; w.x = cvt_pk_bf16(out[2 * u][0], out[2 * u][1]); w.y = cvt_pk_bf16(out[2 * u][2], out[2 * u][3]); w.z = cvt_pk_bf16(out[2 * u + 1][0], out[2 * u + 1][1]); w.w = cvt_pk_bf16(out[2 * u + 1][2], out[2 * u + 1][3]);
                *(u32x4*)(MIX + (size_t)r * D + 512 + 64 * h + 32 * u + 8 * g) = w; }
        }
    }
    __syncthreads();
}

constexpr int CV_SEG = 64, CV_ROWS = CV_SEG + 30, CV_H = 0, CV_W = CV_ROWS * 256 * 4;
__device__ __forceinline__ void phase_conv(const Frame& F, const Params& P, int l, int nrows) {
    const bf16_t* PL = (const bf16_t*)(F.ws + WS_PL); bf16_t* MIX = (bf16_t*)(F.ws + WS_MIX);
    const int lane = F.lane, c4 = lane * 4, wave = F.wave;
    LAS float* H = (LAS float*)(F.lds + CV_H); LAS float* W = (LAS float*)(F.lds + CV_W);
    for (int i = F.tid; i < 31 * 256; i += NTHREADS) W[i] = P.in[I_DWW][(size_t)l * 31 * 256 + i];
    const f32x4 dwb = *(const f32x4*)(P.in[I_DWB] + l * 256 + c4), lng = *(const f32x4*)(P.in[I_LNG] + l * 256 + c4), lnb = *(const f32x4*)(P.in[I_LNB] + l * 256 + c4);
    for (int seg = F.bid; seg < nrows / CV_SEG; seg += F.G) {
        const int r0 = seg * CV_SEG; const RowGeo g0 = row_geo(r0);
        __syncthreads();
#pragma unroll 4
        for (int k = 0; k < 12; ++k) { const int rr = wave + 8 * k;
            if (rr < CV_ROWS) { const int pos = g0.pos - 15 + rr; f32x4 hv = (f32x4){0.f, 0.f, 0.f, 0.f};
                if (pos >= 0 && pos < g0.len) { const bf16_t* p = PL + (size_t)(r0 - 15 + rr) * INW + O_CV + c4; float a[4], bb[4];
                    unpack4(*(const u32x2*)p, a); unpack4(*(const u32x2*)(p + 256), bb);
#pragma unroll
                    for (int q = 0; q < 4; ++q) hv[q] = a[q] * sigmoidf_(bb[q]); }
                *(LAS f32x4*)(H + rr * 256 + c4) = hv; } }
        __syncthreads();
        f32x4 acc[8];
#pragma unroll
        for (int t = 0; t < 8; ++t) acc[t] = dwb;
#pragma unroll 1
        for (int j = 0; j < 31; ++j) { const f32x4 w = *(const LAS f32x4*)(W + j * 256 + c4);
#pragma unroll
            for (int t = 0; t < 8; ++t) acc[t] += *(const LAS f32x4*)(H + (wave * 8 + t + j) * 256 + c4) * w; }
#pragma unroll
        for (int t = 0; t < 8; ++t) {
            const float mu = wave_sum((acc[t][0] + acc[t][1]) + (acc[t][2] + acc[t][3])) * (1.0f / 256.0f);
            float vs = 0.f;
#pragma unroll
            for (int q = 0; q < 4; ++q) { const float dd = acc[t][q] - mu; vs += dd * dd; }
            const float rstd = rsqrtf(wave_sum(vs) * (1.0f / 256.0f) + 1e-5f);
            float o[4];
#pragma unroll
            for (int q = 0; q < 4; ++q) o[q] = siluf_((acc[t][q] - mu) * rstd * lng[q] + lnb[q]);
            u32x2 w; w.x = pk_bf16(o[0], o[1]); w.y = pk_bf16(o[2], o[3]);
            *(u32x2*)(MIX + (size_t)(r0 + wave * 8 + t) * D + 768 + c4) = w; }
    }
    __syncthreads();
}

__device__ __forceinline__ void phase_na_simple(const Frame& F, const Params& P, int l, int nq) {
    const bf16_t* PL = (const bf16_t*)(F.ws + WS_PL); bf16_t* MIX = (bf16_t*)(F.ws + WS_MIX);
    const float* rpb = P.in[I_RPB] + (size_t)l * 8 * 15 * 31;
    int tid_ = F.tid; asm volatile("" : "+v"(tid_));
    for (int gid = F.bid * NTHREADS + tid_; gid < nq * 8; gid += F.G * NTHREADS) {
        const int r = gid >> 3, h = gid & 7;
        const RowGeo g = row_geo(r);
        float q[64], o[64];
        { const bf16_t* qp = PL + (size_t)r * INW + O_Q + h * 64;
#pragma unroll
          for (int i = 0; i < 8; ++i) unpack8(*(const u32x4*)(qp + i * 8), q + i * 8); }
#pragma unroll
        for (int i = 0; i < 64; ++i) o[i] = 0.f;
        float m = -3.0e38f, lsum = 0.f;
        const bool lat = r < NLAT;
        const int gi = g.pos >> 6, gc = g.pos & 63;
        const int rs = min(max(gi - 4, 0), 56), wsc = min(max(gc - 8, 0), 48);
        const int nkey = lat ? 384 : 256;
#pragma unroll 1
        for (int kx = 0; kx < nkey; ++kx) {
            const bool win = lat && kx < 128;
            int krow; float bias = 0.f;
            if (win) { const int r8 = kx >> 4, cc = kx & 15; krow = g.b * SEQ + (rs + r8) * 64 + wsc + cc; bias = rpb[(h * 15 + (rs + r8 - gi + 7)) * 31 + (wsc + cc - gc + 15)]; }
            else krow = NLAT + g.b * CTXL + (kx - (lat ? 128 : 0));
            const bf16_t* kp = PL + (size_t)krow * INW + O_K + h * 64; float a = bias;
#pragma unroll
            for (int i = 0; i < 8; ++i) { float kf[8]; unpack8(*(const u32x4*)(kp + i * 8), kf);
#pragma unroll
                for (int j = 0; j < 8; ++j) a += q[i * 8 + j] * kf[j]; }
            if (a > m) { const float alpha = __expf(m - a); lsum *= alpha;
#pragma unroll
                for (int i = 0; i < 64; ++i) o[i] *= alpha;
                m = a; }
            const float p = __expf(a - m); lsum += p;
            const bf16_t* vp = kp + (O_V - O_K);
#pragma unroll
            for (int i = 0; i < 8; ++i) { float vf[8]; unpack8(*(const u32x4*)(vp + i * 8), vf);
#pragma unroll
                for (int j = 0; j < 8; ++j) o[i * 8 + j] += p * vf[j]; }
        }
        const float inv = 1.0f / lsum;
        bf16_t* op = MIX + (size_t)r * D + h * 64;
#pragma unroll
        for (int i = 0; i < 8; ++i) { u32x4 w; w.x = pk_bf16(o[i * 8] * inv, o[i * 8 + 1] * inv); w.y = pk_bf16(o[i * 8 + 2] * inv, o[i * 8 + 3] * inv);
            w.z = pk_bf16(o[i * 8 + 4] * inv, o[i * 8 + 5] * inv); w.w = pk_bf16(o[i * 8 + 6] * inv, o[i * 8 + 7] * inv); *(u32x4*)(op + i * 8) = w; }
    }
}

constexpr int NA_CK = 0, NA_CV = 32768, NA_RPB = 65536, NA_WV = 81920;
__device__ __forceinline__ bf16x8 na_pack8(const f32x4& a, const f32x4& b) {
    u32x4 w; w.x = cvt_pk_bf16(a[0], a[1]); w.y = cvt_pk_bf16(a[2], a[3]); w.z = cvt_pk_bf16(b[0], b[1]); w.w = cvt_pk_bf16(b[2], b[3]); return __builtin_bit_cast(bf16x8, w);
}
__device__ __forceinline__ bf16x8 na_vfrag(LAS unsigned char* blk, int lane, int dt) {
    const int g = lane >> 4, qq = (lane & 15) >> 2, p = lane & 3;
    const int r0 = 4 * g + qq, r1 = 16 + 4 * g + qq;
    const v4i16_t lo = __builtin_amdgcn_ds_read_tr16_b64_v4i16((LAS v4i16_t*)(blk + r0 * 128 + ((dt ^ ((r0 >> 1) & 3)) * 32) + p * 8));
    const v4i16_t hi = __builtin_amdgcn_ds_read_tr16_b64_v4i16((LAS v4i16_t*)(blk + r1 * 128 + ((dt ^ ((r1 >> 1) & 3)) * 32) + p * 8));
    bf16x8 r; r[0] = lo[0]; r[1] = lo[1]; r[2] = lo[2]; r[3] = lo[3]; r[4] = hi[0]; r[5] = hi[1]; r[6] = hi[2]; r[7] = hi[3]; return r;
}
template <bool WINDOW>
__device__ __forceinline__ void na_item(const Frame& F, const bf16_t* PL, bf16_t* MIX, int b, int h, int qrow0  , int gi, int cb) {
    const int lane = F.lane, ql = lane & 15, g = lane >> 4;
    LAS unsigned char* CK = F.lds + NA_CK; LAS unsigned char* CV = F.lds + NA_CV; const LAS float* RPB = (const LAS float*)(F.lds + NA_RPB);
    LAS unsigned char* WV = F.lds + NA_WV + F.wave * 4096;
    bf16x8 Qf[2];
    { const bf16_t* qp = PL + (size_t)(qrow0 + ql) * INW + O_Q + h * 64 + 8 * g; Qf[0] = *(const bf16x8*)qp; Qf[1] = *(const bf16x8*)(qp + 32); }
    f32x4 acc[4];
#pragma unroll
    for (int dt = 0; dt < 4; ++dt) acc[dt] = (f32x4){0.f, 0.f, 0.f, 0.f};
    float m_run = -3.0e38f, l_run = 0.f;
    if constexpr (WINDOW) {
        const int rs = min(max(gi - 4, 0), 56), kc0 = min(max(16 * cb - 8, 0), 32), qcol = 16 * cb + ql, wsq = min(max(qcol - 8, 0), 48);
        const size_t krow0 = (size_t)b * SEQ + (size_t)rs * 64 + kc0;
        f32x4 s[16];
#pragma unroll
        for (int t = 0; t < 16; ++t) { const bf16_t* kp = PL + (krow0 + (size_t)(t >> 1) * 64 + (t & 1) * 16 + ql) * INW + O_K + h * 64 + 8 * g;
            const bf16x8 k0 = *(const bf16x8*)kp, k1 = *(const bf16x8*)(kp + 32);
            s[t] = __builtin_amdgcn_mfma_f32_16x16x32_bf16(k0, Qf[0], (f32x4){0.f, 0.f, 0.f, 0.f}, 0, 0, 0);
            s[t] = __builtin_amdgcn_mfma_f32_16x16x32_bf16(k1, Qf[1], s[t], 0, 0, 0); }
        const int vr = lane >> 1, part = lane & 1;
        const bf16_t* vbase = PL + (krow0 + vr) * INW + O_V + h * 64 + part * 32;
        u32x4 vbuf[4][4];
#pragma unroll
        for (int k = 0; k < 4; ++k) { const bf16_t* vp = vbase + (size_t)k * 64 * INW; vbuf[k][0] = *(const u32x4*)vp; vbuf[k][1] = *(const u32x4*)(vp + 8); vbuf[k][2] = *(const u32x4*)(vp + 16); vbuf[k][3] = *(const u32x4*)(vp + 24); }
        float mx = -3.0e38f;
#pragma unroll
        for (int t = 0; t < 16; ++t) { const LAS float* bp = RPB + (h * 15 + (rs + (t >> 1) - gi + 7)) * 31 + 15 - qcol;
#pragma unroll
            for (int j = 0; j < 4; ++j) { const int kcol = kc0 + (t & 1) * 16 + 4 * g + j; const bool ok = kcol >= wsq && kcol < wsq + 16;
                const float v = ok ? s[t][j] + bp[ok ? kcol : qcol] : -INFINITY; s[t][j] = v; mx = fmaxf(mx, v); } }
        mx = fmaxf(mx, __shfl_xor(mx, 16)); mx = fmaxf(mx, __shfl_xor(mx, 32));
        m_run = mx;
        float ls = 0.f;
#pragma unroll
        for (int t = 0; t < 16; ++t)
#pragma unroll
            for (int j = 0; j < 4; ++j) { const float p = __expf(s[t][j] - mx); s[t][j] = p; ls += p; }
        l_run = ls;
#pragma unroll
        for (int r8 = 0; r8 < 8; ++r8) {
            { LAS unsigned char* wr = WV + vr * 128; const int sw = (vr >> 1) & 3;
              *(LAS u32x4*)(wr + (((2 * part) ^ sw) * 32)) = vbuf[r8 & 3][0]; *(LAS u32x4*)(wr + (((2 * part) ^ sw) * 32) + 16) = vbuf[r8 & 3][1];
              *(LAS u32x4*)(wr + (((2 * part + 1) ^ sw) * 32)) = vbuf[r8 & 3][2]; *(LAS u32x4*)(wr + (((2 * part + 1) ^ sw) * 32) + 16) = vbuf[r8 & 3][3];
              if (r8 + 4 < 8) { const bf16_t* vp = vbase + (size_t)(r8 + 4) * 64 * INW;
                  vbuf[r8 & 3][0] = *(const u32x4*)vp; vbuf[r8 & 3][1] = *(const u32x4*)(vp + 8); vbuf[r8 & 3][2] = *(const u32x4*)(vp + 16); vbuf[r8 & 3][3] = *(const u32x4*)(vp + 24); } }
            __builtin_amdgcn_wave_barrier(); asm volatile("" ::: "memory");
            const bf16x8 pf = na_pack8(s[2 * r8], s[2 * r8 + 1]);
#pragma unroll
            for (int dt = 0; dt < 4; ++dt) { const bf16x8 vf = na_vfrag(WV, lane, dt); acc[dt] = __builtin_amdgcn_mfma_f32_16x16x32_bf16(vf, pf, acc[dt], 0, 0, 0); }
            __builtin_amdgcn_wave_barrier(); asm volatile("" ::: "memory");
        }
    }
    {
        f32x4 s[16];
#pragma unroll
        for (int t = 0; t < 16; ++t) { const int key = 16 * t + ql; const LAS unsigned char* kr = CK + key * 128;
            const bf16x8 k0 = *(const LAS bf16x8*)(kr + ((g ^ (key & 7)) * 16)), k1 = *(const LAS bf16x8*)(kr + (((g + 4) ^ (key & 7)) * 16));
            s[t] = __builtin_amdgcn_mfma_f32_16x16x32_bf16(k0, Qf[0], (f32x4){0.f, 0.f, 0.f, 0.f}, 0, 0, 0);
            s[t] = __builtin_amdgcn_mfma_f32_16x16x32_bf16(k1, Qf[1], s[t], 0, 0, 0); }
        float mx = m_run;
#pragma unroll
        for (int t = 0; t < 16; ++t)
#pragma unroll
            for (int j = 0; j < 4; ++j) mx = fmaxf(mx, s[t][j]);
        mx = fmaxf(mx, __shfl_xor(mx, 16)); mx = fmaxf(mx, __shfl_xor(mx, 32));
        const float alpha = __expf(m_run - mx);
        float ls = l_run * alpha;
#pragma unroll
        for (int dt = 0; dt < 4; ++dt) acc[dt] *= alpha;
#pragma unroll
        for (int t = 0; t < 16; ++t)
#pragma unroll
            for (int j = 0; j < 4; ++j) { const float p = __expf(s[t][j] - mx); s[t][j] = p; ls += p; }
        l_run = ls;
#pragma unroll
        for (int blk = 0; blk < 8; ++blk) { const bf16x8 pf = na_pack8(s[2 * blk], s[2 * blk + 1]);
#pragma unroll
            for (int dt = 0; dt < 4; ++dt) { const bf16x8 vf = na_vfrag(CV + blk * 4096, lane, dt); acc[dt] = __builtin_amdgcn_mfma_f32_16x16x32_bf16(vf, pf, acc[dt], 0, 0, 0); } }
    }
    float lt = l_run; lt += __shfl_xor(lt, 16); lt += __shfl_xor(lt, 32);
    const float inv = 1.0f / lt;
    bf16_t* op = MIX + (size_t)(qrow0 + ql) * D + h * 64 + 4 * g;
#pragma unroll
    for (int dt = 0; dt < 4; ++dt) { u32x2 w; w.x = cvt_pk_bf16(acc[dt][0] * inv, acc[dt][1] * inv); w.y = cvt_pk_bf16(acc[dt][2] * inv, acc[dt][3] * inv); *(u32x2*)(op + dt * 16) = w; }
}
__device__ __forceinline__ void phase_na_mfma(const Frame& F, const Params& P, int l, bool ctx_queries) {
    const bf16_t* PL = (const bf16_t*)(F.ws + WS_PL); bf16_t* MIX = (bf16_t*)(F.ws + WS_MIX);
    int tid_ = F.tid; asm volatile("" : "+v"(tid_));
    const int tid = tid_;
    { const float* rpb = P.in[I_RPB] + (size_t)l * 8 * 15 * 31; LAS float* R = (LAS float*)(F.lds + NA_RPB); for (int i = tid; i < 8 * 15 * 31; i += NTHREADS) R[i] = rpb[i]; }
    for (int unit = F.bid; unit < 512; unit += F.G) {
        const int eighth = unit & 7, h = (unit >> 3) & 7, b = unit >> 6;
        __syncthreads();
        { int t2 = tid; asm volatile("" : "+v"(t2)); const int key = t2 >> 1, part = t2 & 1; const bf16_t* kp = PL + (size_t)(NLAT + b * CTXL + key) * INW + O_K + h * 64 + part * 32; const bf16_t* vp = kp + (O_V - O_K);
          LAS unsigned char* kr = F.lds + NA_CK + key * 128; LAS unsigned char* vr = F.lds + NA_CV + key * 128; const int sw = (key >> 1) & 3;
#pragma unroll
          for (int c = 0; c < 4; ++c) { *(LAS u32x4*)(kr + (((4 * part + c) ^ (key & 7)) * 16)) = *(const u32x4*)(kp + 8 * c);
              const int c16 = 4 * part + c; *(LAS u32x4*)(vr + (((c16 >> 1) ^ sw) * 32) + (c16 & 1) * 16) = *(const u32x4*)(vp + 8 * c); } }
        __syncthreads();
        for (int it = F.wave; it < 32; it += NWAVES) { const int gi = eighth * 8 + (it >> 2), cb = it & 3;
            na_item<true>(F, PL, MIX, b, h, b * SEQ + gi * 64 + cb * 16, gi, cb); }
        if (ctx_queries && F.wave < 2) na_item<false>(F, PL, MIX, b, h, NLAT + b * CTXL + (eighth * 2 + F.wave) * 16, 0, 0);
    }
}

__device__ __forceinline__ void phase_final(const Frame& F, const Params& P) {
    float* out = P.out; const float* g = P.in[I_FINALG]; const int lane = F.lane;
    for (int r = F.gw; r < NLAT; r += F.nw) {
        float* xr = out + (size_t)r * D; f32x4 x[4]; float ss = 0.f;
#pragma unroll
        for (int j = 0; j < 4; ++j) { x[j] = *(const f32x4*)(xr + j * 256 + lane * 4); ss += x[j][0] * x[j][0] + x[j][1] * x[j][1] + x[j][2] * x[j][2] + x[j][3] * x[j][3]; }
        ss = wave_sum(ss); const float rstd = rsqrtf(ss * (1.0f / D) + 1e-6f);
#pragma unroll
        for (int j = 0; j < 4; ++j) { const f32x4 gg = *(const f32x4*)(g + j * 256 + lane * 4); *(f32x4*)(xr + j * 256 + lane * 4) = x[j] * rstd * gg; }
    }
}

constexpr int PH_L0 = 1, PH_PER_L0 = 9, PH_L1 = PH_L0 + PH_PER_L0, PH_PER_L1 = 12, PH_FINAL = PH_L1 + PH_PER_L1, N_PHASES = PH_FINAL + 1;
#define RFL(x) __builtin_amdgcn_readfirstlane(x)

PHASE ph_prologue(const void* kp_, int wv_) { PHASE_ENTER; if constexpr (MKB(0)) phase_prologue(F, P); }
PHASE ph_norm1(const void* kp_, int wv_, int l_) { PHASE_ENTER; const int l = RFL(l_);
    if constexpr (MKB(1)) phase_norm<false>(F, P, l, 0, NROW, l == 0 ? P.in[I_X] : P.out, l == 0 ? P.in[I_CTX] : (const float*)(F.ws + WS_XC)); }
PHASE_INL ph_gemm_win(const void* kp_, int wv_, int l_) { PHASE_ENTER; const int l = RFL(l_);
    pg8::DenseSched S; S.init(NROW / 256, INW / 256, F.G, F.bid); S.A = (const bf16_t*)(F.ws + WS_HL); S.Bt = (const bf16_t*)(F.ws + WS_BTIN) + (size_t)l * INW * D; S.K = D;
    pg8::EpiBf16 E{(bf16_t*)(F.ws + WS_PL), INW, 2, 0.125f};
    if constexpr (MKB(2)) pg8::gemm_phase<pg8::EpiBf16, pg8::DenseSched, false>(F.lds, D, S, E, F.wave); }
PHASE_INL ph_rw_prep(const void* kp_, int wv_, int l_) { PHASE_ENTER; const int l = RFL(l_); if constexpr (MKB(3)) phase_rw_prep(F, P, l); }
PHASE ph_conv(const void* kp_, int wv_, int l_, int bid_, int G_) { PHASE_ENTER; const int l = RFL(l_); if constexpr (MKB(4)) phase_conv(sub_frame(F, RFL(bid_), RFL(G_)), P, l, l == 0 ? NROW : NLAT); }
PHASE_INL ph_na(const void* kp_, int wv_, int l_, int bid_, int G_) { PHASE_ENTER; const int l = RFL(l_); if constexpr (MKB(5)) phase_na_mfma(sub_frame(F, RFL(bid_), RFL(G_)), P, l, l == 0); }
PHASE_INL ph_scan(const void* kp_, int wv_, int bid_, int G_) { PHASE_ENTER; if constexpr (MKB(6)) phase_scan(sub_frame(F, RFL(bid_), RFL(G_))); }
PHASE_INL ph_rw_post(const void* kp_, int wv_, int l_) { PHASE_ENTER; const int l = RFL(l_); if constexpr (MKB(7)) phase_rw_post(F, P, l, l == 0 ? NROW : NLAT); }
PHASE_INL ph_gemm_wout(const void* kp_, int wv_, int l_) { PHASE_ENTER; const int l = RFL(l_);
    float* XC = (float*)(F.ws + WS_XC);
    pg8::DenseSched S; S.init((l == 0 ? NROW : NLAT) / 256, D / 256, F.G, F.bid); S.A = (const bf16_t*)(F.ws + WS_MIX); S.Bt = (const bf16_t*)(F.ws + WS_BTOUT) + (size_t)l * D * D; S.K = D;
    pg8::EpiRes E{l == 0 ? P.in[I_X] : P.out, l == 0 ? P.in[I_CTX] : XC, P.out, XC, (const float*)(F.ws + WS_MODV) + (size_t)l * 9 * MODW + 2 * D};
    if constexpr (MKB(8)) pg8::gemm_phase<pg8::EpiRes, pg8::DenseSched, false>(F.lds, D, S, E, F.wave); }
PHASE ph_norm2_l0(const void* kp_, int wv_) { PHASE_ENTER; if constexpr (MKB(9)) phase_norm<false>(F, P, 0, 1, NROW, P.out, (const float*)(F.ws + WS_XC)); }
PHASE_INL ph_gemm_ffn_gu(const void* kp_, int wv_) { PHASE_ENTER;
    pg8::DenseSched S; S.init(NROW / 256, (2 * DFF) / 256, F.G, F.bid); S.A = (const bf16_t*)(F.ws + WS_HL); S.Bt = (const bf16_t*)(F.ws + WS_BTGU); S.K = D;
    pg8::EpiSwiGLU E{(bf16_t*)(F.ws + WS_H), DFF};
    if constexpr (MKB(10)) pg8::gemm_phase<pg8::EpiSwiGLU, pg8::DenseSched, false>(F.lds, D, S, E, F.wave); }
PHASE_INL ph_gemm_ffn_dn(const void* kp_, int wv_) { PHASE_ENTER;
    float* XC = (float*)(F.ws + WS_XC);
    pg8::DenseSched S; S.init(NROW / 256, D / 256, F.G, F.bid); S.A = (const bf16_t*)(F.ws + WS_H); S.Bt = (const bf16_t*)(F.ws + WS_BTDN); S.K = DFF;
    pg8::EpiRes E{P.out, XC, P.out, XC, (const float*)(F.ws + WS_MODV) + 5 * D};
    if constexpr (MKB(11)) pg8::gemm_phase<pg8::EpiRes, pg8::DenseSched, false>(F.lds, DFF, S, E, F.wave); }
PHASE ph_norm2_l1(const void* kp_, int wv_) { PHASE_ENTER; if constexpr (MKB(12)) phase_norm<true>(F, P, 1, 1, NLAT, P.out, (const float*)(F.ws + WS_XC)); }
PHASE ph_moe_prep(const void* kp_, int wv_) { PHASE_ENTER; if constexpr (MKB(13)) { phase_moe_rowmap(F); phase_moe_convert(F, P); } }
PHASE_INL ph_gemm_moe_gu(const void* kp_, int wv_, int pass_) { PHASE_ENTER; const int pass = RFL(pass_);
    pg8::MoeSched S; moe_tstart(F, pass, S.tstart); S.init(S.tstart[8], (2 * DFE) / 256, F.G, F.bid);
    S.A = (const bf16_t*)(F.ws + WS_HL); S.Bt0 = F.ws + WS_MOE; S.e_stride = MOE_E_BYTES; S.K = D; S.rowmap = (const int*)(F.ws + WS_ROUTE + RT_RMAP) + pass * NROW;
    pg8::EpiSwiGLU E{(bf16_t*)(F.ws + WS_H), DFE};
    if constexpr (MKB(14)) pg8::gemm_phase<pg8::EpiSwiGLU, pg8::MoeSched, true>(F.lds, D, S, E, F.wave); }
PHASE_INL ph_gemm_moe_dn(const void* kp_, int wv_, int pass_) { PHASE_ENTER; const int pass = RFL(pass_);
    pg8::MoeSched S; moe_tstart(F, pass, S.tstart); S.init(S.tstart[8], D / 256, F.G, F.bid);
    S.A = (const bf16_t*)(F.ws + WS_H); S.Bt0 = F.ws + WS_MOE + MOE_GU_BYTES; S.e_stride = MOE_E_BYTES; S.K = DFE; S.rowmap = nullptr;
    pg8::EpiMoeDown E{P.out, (const float*)(F.ws + WS_MODV) + (size_t)9 * MODW + 5 * D, (const int*)(F.ws + WS_ROUTE + RT_RMAP) + pass * NROW, (const float*)(F.ws + WS_ROUTE + RT_SGATE) + pass * NROW};
    if constexpr (MKB(15)) pg8::gemm_phase<pg8::EpiMoeDown, pg8::MoeSched, false>(F.lds, DFE, S, E, F.wave); }
PHASE ph_final(const void* kp_, int wv_) { PHASE_ENTER; if constexpr (MKB(16)) phase_final(F, P); }

static __attribute__((noinline)) __device__ void grid_barrier(const void* bar_, unsigned x_, int wv_) {
    const unsigned long long v = (unsigned long long)bar_;
    const unsigned lo = __builtin_amdgcn_readfirstlane((unsigned)v), hi = __builtin_amdgcn_readfirstlane((unsigned)(v >> 32));
    XcdBarrier b; b.bar = (unsigned*)(((unsigned long long)hi << 32) | lo); b.x = __builtin_amdgcn_readfirstlane(x_);
    b.st = (volatile LAS unsigned*)((LAS unsigned char*)lds_raw + LDS_MISC);
    xcd_barrier(b, __builtin_amdgcn_readfirstlane(wv_) * 64 + lane_id());
}
__device__ __forceinline__ bool ph_in(int lo, int hi, int k) { asm volatile("" : "+s"(lo), "+s"(hi)); return lo <= k && k < hi; }

__global__ void __launch_bounds__(NTHREADS, 2) mk_fwd(Params P) {
    const void* kp = (const void*)__builtin_amdgcn_kernarg_segment_ptr();
    LAS unsigned char* lds = (LAS unsigned char*)lds_raw;
    volatile LAS unsigned* misc = (volatile LAS unsigned*)(lds + LDS_MISC);
    const int wv = __builtin_amdgcn_readfirstlane((int)(threadIdx.x >> 6));
    if (wv == 0 && lane_id() < 4) misc[lane_id()] = 0u;
    __syncthreads();
    const int lo = P.ph_lo, hi = P.ph_hi;
    XcdBarrier bar; bar.bar = (unsigned*)(P.ws + WS_CTL) + CW_BAR; bar.x = 0; bar.st = misc;
    if (hi - lo > 1) bar = xcd_barrier_post((unsigned*)(P.ws + WS_CTL) + CW_BAR, misc, wv * 64 + lane_id());
#define IN(k) ph_in(lo, hi, (k))
#define SEAM(k) do { if (IN((k) + 1)) grid_barrier((const void*)bar.bar, bar.x, wv); } while (0)
    if (IN(0)) { for (int rep = 0; rep < REP_PRO; ++rep) ph_prologue(kp, wv); SEAM(0); }
#define LAYER_COMMON(l, pb) \
    if (IN((pb) + 0)) { for (int rep = 0; rep < REP_NORM; ++rep) ph_norm1(kp, wv, (l)); SEAM((pb) + 0); } \
    if (IN((pb) + 1)) { for (int rep = 0; rep < REP_GEMM; ++rep) ph_gemm_win(kp, wv, (l)); SEAM((pb) + 1); } \
    if (IN((pb) + 2)) { for (int rep = 0; rep < REP_PP; ++rep) ph_rw_prep(kp, wv, (l)); SEAM((pb) + 2); } \
    if (IN((pb) + 3)) { const int bx = (int)blockIdx.x, Gx = (int)gridDim.x; \
        if (Gx == 256) { if (bx < 64) { for (int rep = 0; rep < REP_SCAN; ++rep) ph_scan(kp, wv, bx, 64); } \
            else { for (int rep = 0; rep < REP_CONV; ++rep) ph_conv(kp, wv, (l), bx - 64, 192); for (int rep = 0; rep < REP_NA; ++rep) ph_na(kp, wv, (l), bx - 64, 192); } } \
        else { ph_conv(kp, wv, (l), bx, Gx); ph_na(kp, wv, (l), bx, Gx); ph_scan(kp, wv, bx, Gx); } SEAM((pb) + 3); } \
    if (IN((pb) + 4)) { for (int rep = 0; rep < REP_POST; ++rep) ph_rw_post(kp, wv, (l)); SEAM((pb) + 4); } \
    if (IN((pb) + 5)) { ph_gemm_wout(kp, wv, (l)); SEAM((pb) + 5); }
    LAYER_COMMON(0, PH_L0)
    if (IN(PH_L0 + 6)) { ph_norm2_l0(kp, wv); SEAM(PH_L0 + 6); }
    if (IN(PH_L0 + 7)) { for (int rep = 0; rep < REP_GEMM; ++rep) ph_gemm_ffn_gu(kp, wv); SEAM(PH_L0 + 7); }
    if (IN(PH_L0 + 8)) { ph_gemm_ffn_dn(kp, wv); SEAM(PH_L0 + 8); }
    LAYER_COMMON(1, PH_L1)
    if (IN(PH_L1 + 6)) { ph_norm2_l1(kp, wv); SEAM(PH_L1 + 6); }
    if (IN(PH_L1 + 7)) { for (int rep = 0; rep < REP_PRO; ++rep) ph_moe_prep(kp, wv); SEAM(PH_L1 + 7); }
#pragma unroll 1
    for (int pass = 0; pass < 2; ++pass) {
        if (IN(PH_L1 + 8 + 2 * pass)) { for (int rep = 0; rep < REP_GEMM; ++rep) ph_gemm_moe_gu(kp, wv, pass); SEAM(PH_L1 + 8 + 2 * pass); }
        if (IN(PH_L1 + 9 + 2 * pass)) { ph_gemm_moe_dn(kp, wv, pass); SEAM(PH_L1 + 9 + 2 * pass); }
    }
#undef LAYER_COMMON
    if (IN(PH_FINAL)) ph_final(kp, wv);
#undef IN
#undef SEAM
}

extern "C" void kernel_launch(void* const* d_in, const int* in_sizes, int n_in, void* d_out, int out_size, void* d_ws, size_t ws_size, hipStream_t stream) {
    static int grid = 0;
    if (grid == 0) {
        if (n_in != 35 || out_size != NLAT * D || ws_size < WS_END) { fprintf(stderr, "kernel_launch: unexpected shapes (n_in %d out %d ws %zu need %zu)\n", n_in, out_size, ws_size, (size_t)WS_END); grid = -1; return; }
        int dev = 0, cus = 0, per_cu = 0;
        if (hipGetDevice(&dev) != hipSuccess || hipDeviceGetAttribute(&cus, hipDeviceAttributeMultiprocessorCount, dev) != hipSuccess) { grid = -1; return; }
        if (hipFuncSetAttribute((const void*)mk_fwd, hipFuncAttributeMaxDynamicSharedMemorySize, LDS_BYTES) != hipSuccess) { fprintf(stderr, "kernel_launch: hipFuncSetAttribute failed\n"); grid = -1; return; }
        if (hipOccupancyMaxActiveBlocksPerMultiprocessor(&per_cu, (const void*)mk_fwd, NTHREADS, LDS_BYTES) != hipSuccess || per_cu < 1) { fprintf(stderr, "kernel_launch: occupancy query says %d\n", per_cu); (void)hipGetLastError(); }
        grid = cus;
    }
    if (grid < 0) return;
    (void)hipMemsetAsync((char*)d_ws + WS_CTL, 0, CTL_BYTES, stream);
    Params p{};
    for (int i = 0; i < 35; ++i) p.in[i] = (const float*)d_in[i];
    p.out = (float*)d_out; p.ws = (unsigned char*)d_ws;
#if MK_ONE_LAUNCH
    p.ph_lo = 0; p.ph_hi = N_PHASES;
    hipLaunchKernelGGL(mk_fwd, dim3(grid), dim3(NTHREADS), LDS_BYTES, stream, p);
#else
    for (int k = 0; k < N_PHASES && k <= MK_LAST; ++k) { p.ph_lo = k; p.ph_hi = k + 1; hipLaunchKernelGGL(mk_fwd, dim3(grid), dim3(NTHREADS), LDS_BYTES, stream, p); }
#endif
}
```

```cpp
#include <hip/hip_runtime.h>
#include <stdint.h>
#include <stdio.h>

#ifndef MK_MASK
#define MK_MASK 0xFFFFFFFFu
#endif
#define MKB(k) (((MK_MASK) >> (k)) & 1u)
#ifndef REP_SCAN
#define REP_SCAN 1
#endif
#ifndef REP_NA
#define REP_NA 1
#endif
#ifndef REP_GEMM
#define REP_GEMM 1
#endif
#ifndef REP_PP
#define REP_PP 1
#endif
#ifndef REP_POST
#define REP_POST 1
#endif
#ifndef REP_CONV
#define REP_CONV 1
#endif
#ifndef REP_NORM
#define REP_NORM 1
#endif
#ifndef REP_PRO
#define REP_PRO 1
#endif
#ifndef MK_LAST
#define MK_LAST 99
#endif
#ifndef MK_ONE_LAUNCH
#define MK_ONE_LAUNCH 1
#endif

#define LAS __attribute__((address_space(3)))
typedef unsigned short bf16_t;
typedef _Float16 f16_t;
typedef short bf16x8 __attribute__((ext_vector_type(8)));
typedef float f32x4 __attribute__((ext_vector_type(4)));
typedef float f32x2 __attribute__((ext_vector_type(2)));
typedef unsigned u32x4 __attribute__((ext_vector_type(4)));
typedef unsigned u32x2 __attribute__((ext_vector_type(2)));
typedef f16_t f16x4 __attribute__((ext_vector_type(4)));
typedef f16_t f16x8 __attribute__((ext_vector_type(8)));
typedef short v4i16_t __attribute__((ext_vector_type(4)));

constexpr int D = 1024, NB = 8, SEQ = 4096, CTXL = 256, TT = CTXL + SEQ;
constexpr int NLAT = NB * SEQ, NCTX = NB * CTXL, NROW = NLAT + NCTX;
constexpr int INW = 3328, DFF = 2816, DFE = 3584, NEXP = 8;
constexpr int O_Q = 0, O_K = 512, O_V = 1024, O_RW = 1536, O_CV = 2816;
constexpr int MODW = 6 * D;
constexpr int NTHREADS = 512, NWAVES = 8;
constexpr int LDS_BYTES = 160 * 1024;
constexpr int LDS_MISC = LDS_BYTES - 256;

constexpr size_t al256(size_t x) { return (x + 255) & ~(size_t)255; }
constexpr size_t WS_CTL   = 0;
constexpr size_t CTL_BYTES = 65536;
constexpr size_t WS_MODV  = WS_CTL + CTL_BYTES;
constexpr size_t WS_BTIN  = al256(WS_MODV + (size_t)2 * 9 * MODW * 4);
constexpr size_t WS_BTOUT = al256(WS_BTIN + (size_t)2 * INW * D * 2);
constexpr size_t WS_BTGU  = al256(WS_BTOUT + (size_t)2 * D * D * 2);
constexpr size_t WS_BTDN  = al256(WS_BTGU + (size_t)2 * DFF * D * 2);
constexpr size_t WS_LORA  = al256(WS_BTDN + (size_t)D * DFF * 2);
constexpr size_t LORA_LD_BYTES = (size_t)(256 * 64 * 2 + 256 * 128) * 2;
constexpr size_t WS_MOE   = al256(WS_LORA + 4 * LORA_LD_BYTES);
constexpr size_t MOE_GU_BYTES = (size_t)2 * DFE * D * 2, MOE_DN_BYTES = (size_t)D * DFE * 2, MOE_E_BYTES = MOE_GU_BYTES + MOE_DN_BYTES;
constexpr size_t WS_SH    = WS_MOE;
constexpr size_t SH_BYTES = (size_t)NB * 4 * TT * 192 * 2;
constexpr size_t WS_SD    = WS_SH + SH_BYTES;
constexpr size_t WS_XC    = al256(WS_MOE + (size_t)NEXP * MOE_E_BYTES);
constexpr size_t WS_HL    = al256(WS_XC + (size_t)NCTX * D * 4);
constexpr size_t WS_Y     = WS_HL;
constexpr size_t WS_PL    = al256(WS_HL + (size_t)NROW * D * 2);
constexpr size_t WS_MIX   = al256(WS_PL + (size_t)NROW * INW * 2);
constexpr size_t WS_H     = WS_PL;
constexpr size_t WS_ROUTE = al256(WS_MIX + (size_t)NROW * D * 2);
constexpr size_t RT_TOKE  = 0;
constexpr size_t RT_TOKG  = RT_TOKE + (size_t)NLAT * 2 * 4;
constexpr size_t RT_TOKP  = RT_TOKG + (size_t)NLAT * 2 * 4;
constexpr size_t RT_RMAP  = RT_TOKP + (size_t)NLAT * 2 * 4;
constexpr size_t RT_SGATE = RT_RMAP + (size_t)2 * NROW * 4;
constexpr size_t WS_END   = al256(WS_ROUTE + RT_SGATE + (size_t)2 * NROW * 4);
static_assert(SH_BYTES * 3 <= (size_t)NEXP * MOE_E_BYTES, "scan inputs must fit the MoE weight region");
static_assert((size_t)NROW * DFE * 2 <= (size_t)NROW * INW * 2 + (size_t)NROW * D * 2, "H must fit PL+MIX");

constexpr int CW_BAR = 0;
constexpr int CW_MOECNT = 4096;

#define XB_TMO      128
#define XB_XCNT(j)  (256  + 64 * (j))
#define XB_XSUB(j)  (1280 + 64 * (j))
#define XB_XGEN(j)  (2304 + 64 * (j))
#define XB_TOP      3328
#define XB_TOPGEN   3392
#define XCD_BAR_WORDS 3456
#define XB_SPIN_CAP (1u << 22)

__device__ __forceinline__ unsigned xb_ld(unsigned* p)              { return __hip_atomic_load(p, __ATOMIC_RELAXED, __HIP_MEMORY_SCOPE_AGENT); }
__device__ __forceinline__ unsigned xb_add(unsigned* p, unsigned v) { return __hip_atomic_fetch_add(p, v, __ATOMIC_RELAXED, __HIP_MEMORY_SCOPE_AGENT); }
__device__ __forceinline__ unsigned xb_xcc_id() { return (unsigned)__builtin_amdgcn_s_getreg((3 << 11) | 20) & 0xFu; }
#define XB_SPIN(cond, bar) do { unsigned _sp = 0; while (cond) { __builtin_amdgcn_s_sleep(1); \
    if ((++_sp & 255u) == 0u) { if (xb_ld(&(bar)[XB_TMO])) break; if (_sp > XB_SPIN_CAP) { atomicAdd(&(bar)[XB_TMO], 1u); break; } } } } while (0)

struct XcdBarrier { unsigned* bar; unsigned x; volatile LAS unsigned* st; };

__device__ __forceinline__ XcdBarrier xcd_barrier_post(unsigned* bar, volatile LAS unsigned* st, int tid) {
    XcdBarrier b; b.bar = bar; b.x = xb_xcc_id(); b.st = st;
    if (tid == 0) (void)xb_add(&bar[XB_XCNT(b.x)], 1u);
    return b;
}
__device__ __forceinline__ void xcd_barrier_complete(unsigned* bar, unsigned x, unsigned& nloc, unsigned& nx) {
    const unsigned G = gridDim.x * gridDim.y * gridDim.z;
    unsigned sum, cnt, mine, sp = 0u;
    for (;;) {
        sum = 0u; cnt = 0u; mine = 0u;
#pragma unroll
        for (unsigned j = 0; j < 16; ++j) { const unsigned c = xb_ld(&bar[XB_XCNT(j)]); sum += c; cnt += (c > 0u) ? 1u : 0u; mine = (j == x) ? c : mine; }
        if (sum == G) break;
        __builtin_amdgcn_s_sleep(1);
        if ((++sp & 255u) == 0u) { if (xb_ld(&bar[XB_TMO])) break; if (sp > XB_SPIN_CAP) { atomicAdd(&bar[XB_TMO], 1u); break; } }
    }
    nloc = mine > 0u ? mine : 1u; nx = cnt > 0u ? cnt : 1u;
}
__device__ __forceinline__ void xcd_barrier(const XcdBarrier& b, int tid) {
    asm volatile("s_waitcnt vmcnt(0)" ::: "memory");
    __syncthreads();
    if (tid == 0) {
        unsigned* bar = b.bar;
        __builtin_amdgcn_s_waitcnt(0);
        unsigned nloc = b.st[0], nx = b.st[1];
        if (nloc == 0u) { xcd_barrier_complete(bar, b.x, nloc, nx); b.st[0] = nloc; b.st[1] = nx; }
        const unsigned old = xb_add(&bar[XB_XSUB(b.x)], 1u);
        const unsigned gen = old / nloc;
        if (old + 1u == (gen + 1u) * nloc) {
            __builtin_amdgcn_fence(__ATOMIC_RELEASE, "agent");
            asm volatile("s_waitcnt vmcnt(0)" ::: "memory");
            const unsigned og = xb_add(&bar[XB_TOP], 1u);
            const unsigned tg = og / nx;
            if (og + 1u == (tg + 1u) * nx) xb_add(&bar[XB_TOPGEN], 1u);
            else XB_SPIN(xb_ld(&bar[XB_TOPGEN]) == tg, bar);
            __builtin_amdgcn_fence(__ATOMIC_ACQUIRE, "agent");
            xb_add(&bar[XB_XGEN(b.x)], 1u);
            asm volatile("s_waitcnt vmcnt(0)" ::: "memory");
        } else {
            XB_SPIN(xb_ld(&bar[XB_XGEN(b.x)]) == gen, bar);
            __builtin_amdgcn_fence(__ATOMIC_ACQUIRE, "agent");
            asm volatile("s_waitcnt vmcnt(0)" ::: "memory");
        }
    }
    __syncthreads();
}

__device__ __forceinline__ int lane_id() { return (int)__builtin_amdgcn_mbcnt_hi(~0u, __builtin_amdgcn_mbcnt_lo(~0u, 0u)); }
__device__ __forceinline__ float bf2f(bf16_t b) { return __uint_as_float(((unsigned)b) << 16); }
__device__ __forceinline__ bf16_t f2bf(float f) { unsigned u = __float_as_uint(f); u += 0x7FFFu + ((u >> 16) & 1u); return (bf16_t)(u >> 16); }
__device__ __forceinline__ unsigned pk_bf16(float lo, float hi) { return (unsigned)f2bf(lo) | ((unsigned)f2bf(hi) << 16); }
typedef __bf16 bf16x2_t __attribute__((ext_vector_type(2)));
__device__ __forceinline__ unsigned cvt_pk_bf16(float lo, float hi) { return __builtin_bit_cast(unsigned, __builtin_convertvector((f32x2){lo, hi}, bf16x2_t)); }
__device__ __forceinline__ float sigmoidf_(float x) { return 1.0f / (1.0f + __expf(-x)); }
__device__ __forceinline__ float siluf_(float x) { return x / (1.0f + __expf(-x)); }
__device__ __forceinline__ float wave_sum(float v) {
#pragma unroll
    for (int o = 32; o >= 1; o >>= 1) v += __shfl_xor(v, o);
    return v;
}
__device__ __forceinline__ float sum16(float v) {
    v += __shfl_xor(v, 1); v += __shfl_xor(v, 2); v += __shfl_xor(v, 4); v += __shfl_xor(v, 8); return v;
}
__device__ __forceinline__ void unpack4(u32x2 w, float (&f)[4]) {
    f[0] = __uint_as_float(w.x << 16); f[1] = __uint_as_float(w.x & 0xffff0000u); f[2] = __uint_as_float(w.y << 16); f[3] = __uint_as_float(w.y & 0xffff0000u);
}
__device__ __forceinline__ void unpack8(u32x4 w, float* f) {
    f[0] = __uint_as_float(w.x << 16); f[1] = __uint_as_float(w.x & 0xffff0000u); f[2] = __uint_as_float(w.y << 16); f[3] = __uint_as_float(w.y & 0xffff0000u);
    f[4] = __uint_as_float(w.z << 16); f[5] = __uint_as_float(w.z & 0xffff0000u); f[6] = __uint_as_float(w.w << 16); f[7] = __uint_as_float(w.w & 0xffff0000u);
}

struct Params {
    const float* in[35];
    float* out; unsigned char* ws;
    int ph_lo, ph_hi;
};
enum { I_X = 0, I_C, I_CTX, I_CCTX, I_N1G, I_N2G, I_MODW, I_MODB, I_WIN, I_WOUT, I_RPB, I_MUP, I_MUN, I_W0, I_W2, I_A0, I_A2, I_G2, I_KK, I_KA, I_RK, I_GNG, I_GNB,
       I_DWW, I_DWB, I_LNG, I_LNB, I_FG, I_FU, I_FD, I_ROUTER, I_MG, I_MU, I_MD, I_FINALG };

__device__ __forceinline__ int row_mi(int r) { return r < NLAT ? (r >> 12) : 8; }

namespace pg8 {
constexpr int BM = 256, BK = 64, HALF = 128, HTB = HALF * BK * 2, STAGE_BYTES = 8 * HTB, NXCD = 8, WGM = 8;
__device__ __forceinline__ int lds_byte(int r, int c) { const int st = (r >> 4) * 2 + (c >> 5), rr = r & 15, cc = c & 31, ob = rr * 64 + cc * 2; return st * 1024 + (ob ^ (((ob >> 9) & 1) << 5)); }
__device__ __forceinline__ void stage_rc(int b, int& R, int& C) { const int st = b / 1024, sb = b % 1024, swz = sb ^ (((sb >> 9) & 1) << 5); R = (st >> 1) * 16 + swz / 64; C = (st & 1) * 32 + (swz % 64) / 2; }
__device__ __forceinline__ int perm32(int rho) { const int n = rho >> 4, i = rho & 15; return 8 * (i >> 2) + 4 * n + (i & 3); }
struct Unit { int pm, pn, sub, ah, hb; };

struct TileOrder {
    int nM, nN, nwg, G, c, full;
    __device__ void init(int nM_, int nN_, int G_, int c_) { nM = nM_; nN = nN_; nwg = nM * nN; G = G_; c = c_; full = nwg; }
    __device__ void split_tail() { full = (nwg / G) * G; }
    __device__ bool next(int i, Unit& u) const {
        long L = (long)i * G + c;
        u.sub = 0; u.ah = 0; u.hb = 0;
        if (L >= (long)full + 4L * (nwg - full)) return false;
        if (L >= full) { const int j = (int)(L - full); L = full + (j >> 2); u.sub = 1; u.ah = (j >> 1) & 1; u.hb = j & 1; }
        int wgid = (int)L; { const int q = nwg / NXCD, r = nwg % NXCD, xcd = wgid % NXCD, off = wgid / NXCD; wgid = (xcd < r ? xcd * (q + 1) : r * (q + 1) + (xcd - r) * q) + off; }
        const int nig = WGM * nN, gid = wgid / nig, fm = gid * WGM, gsz = (nM - fm) < WGM ? (nM - fm) : WGM;
        u.pm = fm + ((wgid % nig) % gsz); u.pn = (wgid % nig) / gsz; return true;
    }
};
struct DenseSched : TileOrder {
    const bf16_t* A; const bf16_t* Bt; int K;
    __device__ __forceinline__ const char* aptr(const Unit& u) const { return (const char*)A + (size_t)u.pm * BM * K * 2; }
    __device__ __forceinline__ const char* bptr(const Unit& u) const { return (const char*)Bt + (size_t)u.pn * BM * K * 2; }
    __device__ __forceinline__ const char* abase() const { return (const char*)A; }
    __device__ __forceinline__ int arow(const Unit&, int) const { return 0; }
};
struct MoeSched : TileOrder {
    const bf16_t* A; const unsigned char* Bt0; size_t e_stride; int K; const int* rowmap; int tstart[9];
    __device__ __forceinline__ int expert(int pm) const { int e = 0;
#pragma unroll
        for (int j = 1; j < 8; ++j) e += (pm >= tstart[j]) ? 1 : 0;
        return e; }
    __device__ __forceinline__ const char* aptr(const Unit& u) const { return (const char*)A + (size_t)u.pm * BM * K * 2; }
    __device__ __forceinline__ const char* bptr(const Unit& u) const { return (const char*)Bt0 + (size_t)expert(u.pm) * e_stride + (size_t)u.pn * BM * K * 2; }
    __device__ __forceinline__ const char* abase() const { return (const char*)A; }
    __device__ __forceinline__ int arow(const Unit& u, int r) const { const int t = rowmap[u.pm * BM + r]; return t < 0 ? 0 : t; }
};

struct EpiBf16 {
    static constexpr bool PERM = true;
    bf16_t* O; int ldc; int nscale; float scale;
    __device__ __forceinline__ void operator()(const f32x4 (&acc)[2][2][4][2], const Unit& u, int wr, int wc, int fr, int fq) const {
        const int row0 = u.pm * BM + wr * 64 + fr, col0 = u.pn * BM + wc * 32 + 8 * fq;
        const float s = u.pn < nscale ? scale : 1.0f;
#pragma unroll
        for (int ai = 0; ai < 2; ++ai)
#pragma unroll
            for (int m = 0; m < 4; ++m) { bf16_t* rowp = O + (size_t)(row0 + ai * HALF + m * 16) * ldc + col0;
#pragma unroll
                for (int bj = 0; bj < 2; ++bj) { const f32x4 v0 = acc[ai][bj][m][0] * s, v1 = acc[ai][bj][m][1] * s;
                    u32x4 w; w.x = cvt_pk_bf16(v0[0], v0[1]); w.y = cvt_pk_bf16(v0[2], v0[3]); w.z = cvt_pk_bf16(v1[0], v1[1]); w.w = cvt_pk_bf16(v1[2], v1[3]);
                    *(u32x4*)(rowp + bj * HALF) = w; } }
    }
};
struct EpiSwiGLU {
    static constexpr bool PERM = true;
    bf16_t* H; int ldh;
    __device__ __forceinline__ void operator()(const f32x4 (&acc)[2][2][4][2], const Unit& u, int wr, int wc, int fr, int fq) const {
        const int row0 = u.pm * BM + wr * 64 + fr, col0 = u.pn * HALF + wc * 32 + 8 * fq;
#pragma unroll
        for (int ai = 0; ai < 2; ++ai)
#pragma unroll
            for (int m = 0; m < 4; ++m) { bf16_t* rowp = H + (size_t)(row0 + ai * HALF + m * 16) * ldh + col0;
                float h[8];
#pragma unroll
                for (int n = 0; n < 2; ++n)
#pragma unroll
                    for (int j = 0; j < 4; ++j) { const float g = acc[ai][0][m][n][j], up = acc[ai][1][m][n][j]; h[n * 4 + j] = g / (1.0f + __expf(-g)) * up; }
                u32x4 w; w.x = cvt_pk_bf16(h[0], h[1]); w.y = cvt_pk_bf16(h[2], h[3]); w.z = cvt_pk_bf16(h[4], h[5]); w.w = cvt_pk_bf16(h[6], h[7]);
                *(u32x4*)rowp = w; }
    }
};
struct EpiRes {
    static constexpr bool PERM = false;
    const float* resL; const float* resC; float* outL; float* outC; const float* gvec;
    __device__ __forceinline__ void operator()(const f32x4 (&acc)[2][2][4][2], const Unit& u, int wr, int wc, int fr, int fq) const {
        const int r0 = u.pm * BM; const bool lat = r0 < NLAT;
        const float* res = lat ? resL + (size_t)r0 * D : resC + (size_t)(r0 - NLAT) * D;
        float* out = lat ? outL + (size_t)r0 * D : outC + (size_t)(r0 - NLAT) * D;
        const float* gv = gvec + (size_t)(lat ? (r0 >> 12) : 8) * MODW;
        const int rl = wr * 64 + fr, col0 = u.pn * BM + wc * 32 + 4 * fq;
        const int nq = u.sub ? 1 : 2, ro = u.sub ? u.ah * HALF : 0, co = u.sub ? u.hb * HALF : 0;
        f32x4 g[2][2];
#pragma unroll
        for (int bj = 0; bj < 2; ++bj)
#pragma unroll
            for (int n = 0; n < 2; ++n) g[bj][n] = *(const f32x4*)(gv + col0 + co + (u.sub ? 0 : bj * HALF) + n * 16);
#pragma unroll
        for (int ai = 0; ai < 2; ++ai) if (ai < nq)
#pragma unroll
            for (int m = 0; m < 4; ++m) { const size_t off = (size_t)(rl + ro + ai * HALF + m * 16) * D + col0 + co;
#pragma unroll
                for (int bj = 0; bj < 2; ++bj) if (bj < nq)
#pragma unroll
                    for (int n = 0; n < 2; ++n) { const f32x4 rv = *(const f32x4*)(res + off + bj * HALF + n * 16);
                        *(f32x4*)(out + off + bj * HALF + n * 16) = rv + g[bj][n] * acc[ai][bj][m][n]; } }
    }
};
struct EpiMoeDown {
    static constexpr bool PERM = false;
    float* xl; const float* gvec; const int* rowmap; const float* sgate;
    __device__ __forceinline__ void operator()(const f32x4 (&acc)[2][2][4][2], const Unit& u, int wr, int wc, int fr, int fq) const {
        const int nq = u.sub ? 1 : 2;
        const int rl = u.pm * BM + wr * 64 + fr + (u.sub ? u.ah * HALF : 0), col0 = u.pn * BM + wc * 32 + 4 * fq + (u.sub ? u.hb * HALF : 0);
#pragma unroll
        for (int ai = 0; ai < 2; ++ai) if (ai < nq)
#pragma unroll
            for (int m = 0; m < 4; ++m) { const int slot = rl + ai * HALF + m * 16; const int tok = rowmap[slot];
                if (tok >= 0) { const float sg = sgate[slot]; const float* gv = gvec + (size_t)(tok >> 12) * MODW + col0; float* xp = xl + (size_t)tok * D + col0;
#pragma unroll
                    for (int bj = 0; bj < 2; ++bj) if (bj < nq)
#pragma unroll
                        for (int n = 0; n < 2; ++n) { const f32x4 g = *(const f32x4*)(gv + bj * HALF + n * 16); const f32x4 rv = *(const f32x4*)(xp + bj * HALF + n * 16);
                            *(f32x4*)(xp + bj * HALF + n * 16) = rv + (g * sg) * acc[ai][bj][m][n]; } } }
    }
};

template <class Epi, class Sched, bool GATHER>
__device__ __forceinline__ void gemm_phase(LAS unsigned char* lds, const int K, const Sched& S, const Epi& E, const int wave_) {
    int tid_ = wave_ * 64 + lane_id(); asm volatile("" : "+v"(tid_));
    const int tid = tid_, wid = wave_, lane = tid & 63, wr = wid >> 2, wc = wid & 3, fr = lane & 15, fq = lane >> 4;
    const int nt = K / BK;
    unsigned voffA[2], voffB[2]; int RA[2], CA[2];
#pragma unroll
    for (int i = 0; i < 2; ++i) { int R, C; stage_rc(tid * 16 + i * 8192, R, C); const int Rb = Epi::PERM ? ((R & ~31) + perm32(R & 31)) : R;
        voffA[i] = (unsigned)(R * K + C) * 2u; voffB[i] = (unsigned)(Rb * K + C) * 2u; RA[i] = R; CA[i] = C; }
    const size_t kstep = (size_t)(BK * 2);
    const size_t hstep = (size_t)HALF * K * 2;
    const unsigned ldsw = (unsigned)wid * 1024u;
    const int aoff = lds_byte(wr * 64 + fr, fq * 8), boff = lds_byte(wc * 32 + fr, fq * 8);
#define PG8_SA(b, h) (((b) * 2 + (h)) * HTB)
#define PG8_SB(b, h) ((4 + (b) * 2 + (h)) * HTB)
#define PG8_STAGE(bufoff, gbase, voff) do { _Pragma("unroll") for (int _i = 0; _i < 2; ++_i) \
        __builtin_amdgcn_global_load_lds((const unsigned*)((const char*)(gbase) + (voff)[_i]), (LAS unsigned*)(lds + (bufoff) + ldsw + _i * 8192), 16, 0, 0); } while (0)
#define PG8_LDA(dst, b, h) do { _Pragma("unroll") for (int m = 0; m < 4; ++m) _Pragma("unroll") for (int k = 0; k < 2; ++k) dst[m][k] = *(const LAS bf16x8*)(lds + PG8_SA(b, h) + aoff + m * 2048 + k * 1024); } while (0)
#define PG8_LDB(dst, b, h) do { _Pragma("unroll") for (int n = 0; n < 2; ++n) _Pragma("unroll") for (int k = 0; k < 2; ++k) dst[n][k] = *(const LAS bf16x8*)(lds + PG8_SB(b, h) + boff + n * 2048 + k * 1024); } while (0)
#define PG8_MMA(ai, bj, At, Bt) do { __builtin_amdgcn_s_setprio(1); _Pragma("unroll") for (int m = 0; m < 4; ++m) _Pragma("unroll") for (int n = 0; n < 2; ++n) _Pragma("unroll") for (int k = 0; k < 2; ++k) \
        acc[ai][bj][m][n] = __builtin_amdgcn_mfma_f32_16x16x32_bf16(Bt[n][k], At[m][k], acc[ai][bj][m][n], 0, 0, 0); __builtin_amdgcn_s_setprio(0); } while (0)
#define PG8_WAIT_V(n) asm volatile("s_waitcnt vmcnt(" #n ")" ::: "memory")
#define PG8_WAIT_L(n) asm volatile("s_waitcnt lgkmcnt(" #n ")" ::: "memory")
#define PG8_BAR __builtin_amdgcn_s_barrier()
#define PG8_SCHED __builtin_amdgcn_sched_barrier(0)
#define PG8_STAGE_A(bufoff, TS, H) do { if constexpr (GATHER) { PG8_STAGE(bufoff, gA##TS, oA##TS[H]); } else { PG8_STAGE(bufoff, a##TS + (H) * hA##TS, voffA); } } while (0)
    Unit cur, nxt; int ui = 0;
    if (!S.next(0, cur)) return;
    f32x4 acc[2][2][4][2];
#pragma unroll
    for (int a = 0; a < 2; ++a)
#pragma unroll
        for (int b = 0; b < 2; ++b)
#pragma unroll
            for (int m = 0; m < 4; ++m)
#pragma unroll
                for (int n = 0; n < 2; ++n) acc[a][b][m][n] = (f32x4){0.f, 0.f, 0.f, 0.f};
    bf16x8 At[4][2], B0[2][2], B1[2][2];
    const char* Abase = S.abase();
    unsigned aoC[2][2] = {{0u, 0u}, {0u, 0u}}, aoN[2][2] = {{0u, 0u}, {0u, 0u}};
    if constexpr (GATHER) {
#pragma unroll
        for (int h = 0; h < 2; ++h)
#pragma unroll
            for (int i = 0; i < 2; ++i) aoC[h][i] = (unsigned)(S.arow(cur, h * HALF + RA[i]) * K + CA[i]) * 2u;
    }
    size_t hAc = cur.sub ? 0 : hstep, hBc = hAc, hAn = hAc, hBn = hAc;
    const char* cA = GATHER ? Abase : S.aptr(cur) + (cur.sub ? cur.ah * hstep : 0); const char* cB = S.bptr(cur) + (cur.sub ? cur.hb * hstep : 0);
    if constexpr (GATHER) {
        PG8_STAGE(PG8_SB(0, 0), cB, voffB); PG8_STAGE(PG8_SA(0, 0), Abase, aoC[0]); PG8_STAGE(PG8_SB(0, 1), cB + hstep, voffB); PG8_STAGE(PG8_SA(0, 1), Abase, aoC[1]);
    } else {
        PG8_STAGE(PG8_SB(0, 0), cB, voffB); PG8_STAGE(PG8_SA(0, 0), cA, voffA); PG8_STAGE(PG8_SB(0, 1), cB + hBc, voffB); PG8_STAGE(PG8_SA(0, 1), cA + hAc, voffA);
    }
    if (wr == 1) PG8_BAR;
    PG8_WAIT_V(4); PG8_BAR;
    if constexpr (GATHER) {
        PG8_STAGE(PG8_SB(1, 0), cB + kstep, voffB); PG8_STAGE(PG8_SA(1, 0), Abase + kstep, aoC[0]); PG8_STAGE(PG8_SB(1, 1), cB + hstep + kstep, voffB);
    } else {
        PG8_STAGE(PG8_SB(1, 0), cB + kstep, voffB); PG8_STAGE(PG8_SA(1, 0), cA + kstep, voffA); PG8_STAGE(PG8_SB(1, 1), cB + hBc + kstep, voffB);
    }
    PG8_WAIT_V(6); PG8_BAR;
    for (;;) {
        const bool has_next = S.next(ui + 1, nxt);
        const char* nA = has_next ? (GATHER ? Abase : S.aptr(nxt) + (nxt.sub ? nxt.ah * hstep : 0)) : cA; const char* nB = has_next ? S.bptr(nxt) + (nxt.sub ? nxt.hb * hstep : 0) : cB;
        hAn = has_next ? (nxt.sub ? 0 : hstep) : hAc; hBn = hAn;
        if constexpr (GATHER) {
            if (has_next) {
#pragma unroll
                for (int h = 0; h < 2; ++h)
#pragma unroll
                    for (int i = 0; i < 2; ++i) aoN[h][i] = (unsigned)(S.arow(nxt, h * HALF + RA[i]) * K + CA[i]) * 2u;
            } else {
#pragma unroll
                for (int h = 0; h < 2; ++h)
#pragma unroll
                    for (int i = 0; i < 2; ++i) aoN[h][i] = aoC[h][i];
            }
        }
        for (int t = 0; t < nt; t += 2) {
            const bool last = (t == nt - 2);
            const char* a1 = cA + (size_t)(t + 1) * kstep;
            const char* a2 = last ? nA : cA + (size_t)(t + 2) * kstep; const char* b2 = last ? nB : cB + (size_t)(t + 2) * kstep;
            const char* a3 = a2 + kstep; const char* b3 = b2 + kstep;
            const size_t hA1 = hAc, hA2 = last ? hAn : hAc, hA3 = hA2, hB2 = last ? hBn : hBc; (void)hA1; (void)hA3;
            const char* gA1 = Abase + (size_t)(t + 1) * kstep; const char* gA2 = Abase + (last ? (size_t)0 : (size_t)(t + 2) * kstep); const char* gA3 = gA2 + kstep;
            unsigned oA1[2][2], oA2[2][2], oA3[2][2];
#pragma unroll
            for (int h = 0; h < 2; ++h)
#pragma unroll
                for (int i = 0; i < 2; ++i) { oA1[h][i] = aoC[h][i]; oA2[h][i] = last ? aoN[h][i] : aoC[h][i]; oA3[h][i] = oA2[h][i]; }
            (void)a1; (void)a3; (void)gA1; (void)gA3; (void)oA1; (void)oA3;
            PG8_LDB(B0, 0, 0); PG8_SCHED; PG8_LDA(At, 0, 0); PG8_STAGE_A(PG8_SA(1, 1), 1, 1);
            PG8_WAIT_L(8); PG8_BAR; PG8_WAIT_L(0); PG8_MMA(0, 0, At, B0); PG8_BAR; PG8_SCHED;
            PG8_LDB(B1, 0, 1); PG8_STAGE(PG8_SB(0, 0), b2, voffB);
            PG8_BAR; PG8_WAIT_L(0); if (!cur.sub) PG8_MMA(0, 1, At, B1); PG8_BAR;
            PG8_LDA(At, 0, 1); PG8_STAGE_A(PG8_SA(0, 0), 2, 0);
            PG8_BAR; PG8_WAIT_L(0); if (!cur.sub) PG8_MMA(1, 0, At, B0); PG8_BAR; PG8_SCHED;
            PG8_STAGE(PG8_SB(0, 1), b2 + hB2, voffB);
            PG8_WAIT_V(6); PG8_BAR; if (!cur.sub) PG8_MMA(1, 1, At, B1); PG8_BAR;
            PG8_LDB(B0, 1, 0); PG8_SCHED; PG8_LDA(At, 1, 0); PG8_STAGE_A(PG8_SA(0, 1), 2, 1);
            PG8_WAIT_L(8); PG8_BAR; PG8_WAIT_L(0); PG8_MMA(0, 0, At, B0); PG8_BAR; PG8_SCHED;
            PG8_LDB(B1, 1, 1); PG8_STAGE(PG8_SB(1, 0), b3, voffB);
            PG8_BAR; PG8_WAIT_L(0); if (!cur.sub) PG8_MMA(0, 1, At, B1); PG8_BAR;
            PG8_LDA(At, 1, 1); PG8_STAGE_A(PG8_SA(1, 0), 3, 0);
            PG8_BAR; PG8_WAIT_L(0); if (!cur.sub) PG8_MMA(1, 0, At, B0); PG8_BAR; PG8_SCHED;
            PG8_STAGE(PG8_SB(1, 1), b3 + hB2, voffB);
            PG8_WAIT_V(6); PG8_BAR; if (!cur.sub) PG8_MMA(1, 1, At, B1); PG8_BAR;
        }
        { int t2 = tid; asm volatile("" : "+v"(t2)); const int l2 = t2 & 63; E(acc, cur, wr, wc, l2 & 15, l2 >> 4); }
        if (!has_next) break;
#pragma unroll
        for (int a = 0; a < 2; ++a)
#pragma unroll
            for (int b = 0; b < 2; ++b)
#pragma unroll
                for (int m = 0; m < 4; ++m)
#pragma unroll
                    for (int n = 0; n < 2; ++n) acc[a][b][m][n] = (f32x4){0.f, 0.f, 0.f, 0.f};
        cur = nxt; cA = nA; cB = nB; hAc = hAn; hBc = hBn; ++ui;
        if constexpr (GATHER) {
#pragma unroll
            for (int h = 0; h < 2; ++h)
#pragma unroll
                for (int i = 0; i < 2; ++i) aoC[h][i] = aoN[h][i];
        }
    }
    PG8_WAIT_V(0);
    if (wr == 0) PG8_BAR;
    PG8_BAR;
#undef PG8_SA
#undef PG8_SB
#undef PG8_STAGE
#undef PG8_STAGE_A
#undef PG8_LDA
#undef PG8_LDB
#undef PG8_MMA
#undef PG8_WAIT_V
#undef PG8_WAIT_L
#undef PG8_BAR
#undef PG8_SCHED
}
}

struct Frame {
    LAS unsigned char* lds; int tid, lane, wave, G, bid, gw, nw;
    unsigned char* ws;
};
extern __shared__ __attribute__((aligned(16))) unsigned char lds_raw[];
typedef const __attribute__((address_space(4))) Params* KP;
__device__ __forceinline__ Params load_params(const void* kp_) {
    const unsigned long long v = (unsigned long long)kp_;
    const unsigned lo = __builtin_amdgcn_readfirstlane((unsigned)v), hi = __builtin_amdgcn_readfirstlane((unsigned)(v >> 32));
    KP kp = (KP)(((unsigned long long)hi << 32) | lo);
    Params P;
#pragma unroll
    for (int i = 0; i < 35; ++i) P.in[i] = kp->in[i];
    P.out = kp->out; P.ws = kp->ws; P.ph_lo = kp->ph_lo; P.ph_hi = kp->ph_hi;
    return P;
}
#define PHASE static __attribute__((noinline)) __device__ void
#define PHASE_INL static __device__ __forceinline__ void
__device__ __forceinline__ Frame make_frame(unsigned char* ws, int wave_) {
    Frame F; F.lds = (LAS unsigned char*)lds_raw; F.wave = __builtin_amdgcn_readfirstlane(wave_);
    int t_ = F.wave * 64 + lane_id(); asm volatile("" : "+v"(t_));
    F.tid = t_; F.lane = F.tid & 63;
    F.G = gridDim.x; F.bid = blockIdx.x; F.gw = F.bid * NWAVES + F.wave; F.nw = F.G * NWAVES; F.ws = ws; return F;
}
__device__ __forceinline__ Frame sub_frame(Frame F, int bid, int G) { F.bid = bid; F.G = G; F.gw = F.bid * NWAVES + F.wave; F.nw = F.G * NWAVES; return F; }
#define PHASE_ENTER const Params P = load_params(kp_); const Frame F = make_frame(P.ws, wv_)

__device__ __forceinline__ void conv_job(const Frame& F, const float* src, bf16_t* dst, int K, int N, int mode) {
    LAS float* tile = (LAS float*)(F.lds + F.wave * (64 * 65 * 4));
    const int tk = K / 64, tn = N / 64, ntile = tk * tn, lane = F.lane;
    for (int t = F.gw; t < ntile; t += F.nw) {
        const int k0 = (t / tn) * 64, n0 = (t % tn) * 64;
#pragma unroll 4
        for (int i = 0; i < 16; ++i) { const int row = i * 4 + (lane >> 4), c4 = (lane & 15) * 4;
            const f32x4 v = *(const f32x4*)(src + (size_t)(k0 + row) * N + n0 + c4);
            tile[row * 65 + c4 + 0] = v[0]; tile[row * 65 + c4 + 1] = v[1]; tile[row * 65 + c4 + 2] = v[2]; tile[row * 65 + c4 + 3] = v[3]; }
        __builtin_amdgcn_wave_barrier(); asm volatile("s_waitcnt lgkmcnt(0)" ::: "memory");
#pragma unroll 2
        for (int i = 0; i < 8; ++i) { const int n = i * 8 + (lane >> 3), kc = (lane & 7) * 8;
            float f[8];
#pragma unroll
            for (int j = 0; j < 8; ++j) f[j] = tile[(kc + j) * 65 + n];
            const int ng = n0 + n; const int drow = mode == 0 ? ng : ((ng >> 7) * 256 + (mode == 2 ? 128 : 0) + (ng & 127));
            u32x4 w; w.x = pk_bf16(f[0], f[1]); w.y = pk_bf16(f[2], f[3]); w.z = pk_bf16(f[4], f[5]); w.w = pk_bf16(f[6], f[7]);
            *(u32x4*)(dst + (size_t)drow * K + k0 + kc) = w; }
        __builtin_amdgcn_wave_barrier(); asm volatile("s_waitcnt lgkmcnt(0)" ::: "memory");
    }
}

__device__ __forceinline__ void phase_prologue(const Frame& F, const Params& P) {
    float* modv = (float*)(F.ws + WS_MODV);
    LAS float* s = (LAS float*)F.lds;
    LAS float* red = (LAS float*)(F.lds + 9 * 1024 * 4);
    for (int cb = F.bid; cb < (2 * MODW) / 64; cb += F.G) {
        for (int i = F.tid; i < 9 * 1024; i += NTHREADS) { const int mi = i >> 10, k = i & 1023; const float c = mi < 8 ? P.in[I_C][mi * D + k] : P.in[I_CCTX][k]; s[i] = siluf_(c); }
        __syncthreads();
        const int colg = cb * 64 + F.lane, l = colg / MODW, col = colg % MODW;
        const float* w = P.in[I_MODW] + (size_t)l * D * MODW + col;
        float acc[9];
#pragma unroll
        for (int mi = 0; mi < 9; ++mi) acc[mi] = 0.f;
        const int kb = F.wave * 128;
#pragma unroll 8
        for (int k = 0; k < 128; ++k) { const float wv = w[(size_t)(kb + k) * MODW];
#pragma unroll
            for (int mi = 0; mi < 9; ++mi) acc[mi] += s[mi * 1024 + kb + k] * wv; }
#pragma unroll
        for (int mi = 0; mi < 9; ++mi) red[(F.wave * 9 + mi) * 64 + F.lane] = acc[mi];
        __syncthreads();
        for (int i = F.tid; i < 9 * 64; i += NTHREADS) { const int mi = i >> 6, ln = i & 63; float a = 0.f;
#pragma unroll
            for (int w8 = 0; w8 < 8; ++w8) a += red[(w8 * 9 + mi) * 64 + ln];
            const int cg = cb * 64 + ln, l2 = cg / MODW, c2 = cg % MODW;
            modv[((size_t)l2 * 9 + mi) * MODW + c2] = a + P.in[I_MODB][l2 * MODW + c2]; }
        __syncthreads();
    }
    for (int l = 0; l < 2; ++l) {
        conv_job(F, P.in[I_WIN] + (size_t)l * D * INW, (bf16_t*)(F.ws + WS_BTIN) + (size_t)l * INW * D, D, INW, 0);
        conv_job(F, P.in[I_WOUT] + (size_t)l * D * D, (bf16_t*)(F.ws + WS_BTOUT) + (size_t)l * D * D, D, D, 0);
    }
    conv_job(F, P.in[I_FG], (bf16_t*)(F.ws + WS_BTGU), D, DFF, 1);
    conv_job(F, P.in[I_FU], (bf16_t*)(F.ws + WS_BTGU), D, DFF, 2);
    conv_job(F, P.in[I_FD], (bf16_t*)(F.ws + WS_BTDN), DFF, D, 0);
    for (int ld = 0; ld < 4; ++ld) { bf16_t* base = (bf16_t*)(F.ws + WS_LORA + (size_t)ld * LORA_LD_BYTES);
        conv_job(F, P.in[I_W2] + (size_t)ld * 64 * 256, base, 64, 256, 0);
        conv_job(F, P.in[I_A2] + (size_t)ld * 64 * 256, base + 256 * 64, 64, 256, 0);
        conv_job(F, P.in[I_G2] + (size_t)ld * 128 * 256, base + 2 * 256 * 64, 128, 256, 0); }
}
__device__ __forceinline__ void phase_moe_convert(const Frame& F, const Params& P) {
    for (int e = 0; e < NEXP; ++e) {
        bf16_t* gu = (bf16_t*)(F.ws + WS_MOE + (size_t)e * MOE_E_BYTES); bf16_t* dn = (bf16_t*)(F.ws + WS_MOE + (size_t)e * MOE_E_BYTES + MOE_GU_BYTES);
        conv_job(F, P.in[I_MG] + (size_t)e * D * DFE, gu, D, DFE, 1);
        conv_job(F, P.in[I_MU] + (size_t)e * D * DFE, gu, D, DFE, 2);
        conv_job(F, P.in[I_MD] + (size_t)e * DFE * D, dn, DFE, D, 0);
    }
}

template <bool ROUTER>
__device__ __forceinline__ void phase_norm(const Frame& F, const Params& P, int l, int which, int nrows, const float* srcL, const float* srcC) {
    const float* g = (which == 0 ? P.in[I_N1G] : P.in[I_N2G]) + l * D;
    const float* modv = (const float*)(F.ws + WS_MODV) + (size_t)l * 9 * MODW + (which == 0 ? 0 : 3 * D);
    bf16_t* HL = (bf16_t*)(F.ws + WS_HL);
    LAS float* rt = (LAS float*)F.lds;
    if (ROUTER) {
        for (int i = F.tid; i < D * NEXP; i += NTHREADS) rt[i] = P.in[I_ROUTER][i];
        int* rmap = (int*)(F.ws + WS_ROUTE + RT_RMAP);
        for (int i = F.bid * NTHREADS + F.tid; i < 2 * NROW; i += F.G * NTHREADS) rmap[i] = -1;
        __syncthreads();
    }
    const int lane = F.lane;
    for (int r = F.gw; r < nrows; r += F.nw) {
        const float* xr = r < NLAT ? srcL + (size_t)r * D : srcC + (size_t)(r - NLAT) * D;
        const float* mv = modv + (size_t)row_mi(r) * MODW;
        f32x4 x[4]; float ss = 0.f;
#pragma unroll
        for (int j = 0; j < 4; ++j) { x[j] = *(const f32x4*)(xr + j * 256 + lane * 4); ss += x[j][0] * x[j][0] + x[j][1] * x[j][1] + x[j][2] * x[j][2] + x[j][3] * x[j][3]; }
        ss = wave_sum(ss);
        const float rstd = rsqrtf(ss * (1.0f / D) + 1e-6f);
        float lg[NEXP];
        if (ROUTER) {
#pragma unroll
            for (int e = 0; e < NEXP; ++e) lg[e] = 0.f;
        }
#pragma unroll
        for (int j = 0; j < 4; ++j) { const int c = j * 256 + lane * 4;
            const f32x4 gg = *(const f32x4*)(g + c), sh = *(const f32x4*)(mv + c), sc = *(const f32x4*)(mv + D + c);
            f32x4 y = (x[j] * rstd * gg) * (sc + 1.0f) + sh;
            u32x2 w; w.x = pk_bf16(y[0], y[1]); w.y = pk_bf16(y[2], y[3]);
            *(u32x2*)(HL + (size_t)r * D + c) = w;
            if (ROUTER) {
#pragma unroll
                for (int q = 0; q < 4; ++q) { const f32x4 r0 = *(const LAS f32x4*)(rt + (c + q) * 8), r1 = *(const LAS f32x4*)(rt + (c + q) * 8 + 4);
                    lg[0] += y[q] * r0[0]; lg[1] += y[q] * r0[1]; lg[2] += y[q] * r0[2]; lg[3] += y[q] * r0[3];
                    lg[4] += y[q] * r1[0]; lg[5] += y[q] * r1[1]; lg[6] += y[q] * r1[2]; lg[7] += y[q] * r1[3]; asm volatile("" ::: "memory"); }
            }
        }
        if (ROUTER) {
#pragma unroll
            for (int e = 0; e < NEXP; ++e) lg[e] = wave_sum(lg[e]);
            if (lane == 0) {
                int e1 = 0; float l1 = lg[0];
#pragma unroll
                for (int e = 1; e < NEXP; ++e) if (lg[e] > l1) { l1 = lg[e]; e1 = e; }
                int e2 = -1; float l2 = -3.0e38f;
#pragma unroll
                for (int e = 0; e < NEXP; ++e) if (e != e1 && lg[e] > l2) { l2 = lg[e]; e2 = e; }
                if (e2 < 0) { e2 = e1 == 0 ? 1 : 0; l2 = l1; }
                const float ex = __expf(l2 - l1), g1 = 1.0f / (1.0f + ex), g2 = ex * g1;
                unsigned* cnt = (unsigned*)(F.ws + WS_CTL) + CW_MOECNT;
                const unsigned p1 = atomicAdd(cnt + e1, 1u), p2 = atomicAdd(cnt + 8 + e2, 1u);
                int* te = (int*)(F.ws + WS_ROUTE + RT_TOKE); float* tg = (float*)(F.ws + WS_ROUTE + RT_TOKG); int* tp = (int*)(F.ws + WS_ROUTE + RT_TOKP);
                te[r * 2] = e1; te[r * 2 + 1] = e2; tg[r * 2] = g1; tg[r * 2 + 1] = g2; tp[r * 2] = (int)p1; tp[r * 2 + 1] = (int)p2;
            }
        }
    }
}
__device__ __forceinline__ void moe_tstart(const Frame& F, int pass, int (&ts)[9]) {
    const unsigned* cnt = (const unsigned*)(F.ws + WS_CTL) + CW_MOECNT + pass * 8;
    int a = 0;
#pragma unroll
    for (int e = 0; e < 8; ++e) { ts[e] = a; a += (int)((__hip_atomic_load(cnt + e, __ATOMIC_RELAXED, __HIP_MEMORY_SCOPE_AGENT) + 255u) >> 8); }
    ts[8] = a;
}
__device__ __forceinline__ void phase_moe_rowmap(const Frame& F) {
    int ts0[9], ts1[9]; moe_tstart(F, 0, ts0); moe_tstart(F, 1, ts1);
    const int* te = (const int*)(F.ws + WS_ROUTE + RT_TOKE); const float* tg = (const float*)(F.ws + WS_ROUTE + RT_TOKG); const int* tp = (const int*)(F.ws + WS_ROUTE + RT_TOKP);
    int* rmap = (int*)(F.ws + WS_ROUTE + RT_RMAP); float* sg = (float*)(F.ws + WS_ROUTE + RT_SGATE);
    for (int t = F.bid * NTHREADS + F.tid; t < NLAT; t += F.G * NTHREADS) {
        { const int e = te[t * 2]; int st = 0;
#pragma unroll
          for (int j = 0; j < 8; ++j) st = (e == j) ? ts0[j] : st;
          const int slot = st * 256 + tp[t * 2]; rmap[slot] = t; sg[slot] = tg[t * 2]; }
        { const int e = te[t * 2 + 1]; int st = 0;
#pragma unroll
          for (int j = 0; j < 8; ++j) st = (e == j) ? ts1[j] : st;
          const int slot = st * 256 + tp[t * 2 + 1]; rmap[NROW + slot] = t; sg[NROW + slot] = tg[t * 2 + 1]; }
    }
}

struct RowGeo { int b, tt, pos, len; };
__device__ __forceinline__ RowGeo row_geo(int r) { RowGeo g; if (r < NLAT) { g.b = r >> 12; g.pos = r & 4095; g.len = SEQ; g.tt = CTXL + g.pos; } else { const int q = r - NLAT; g.b = q >> 8; g.pos = q & 255; g.len = CTXL; g.tt = g.pos; } return g; }

__device__ __forceinline__ void rw_shift4(const bf16_t* PL, const float* mup, const float* mun, int r, const RowGeo& g, int j, float (&u)[4]) {
    const bf16_t* p = PL + (size_t)r * INW + O_RW + j;
    const bool hp = g.pos > 0, hn = g.pos < g.len - 1;
    float c[4], pv[4], nv[4];
    unpack4(*(const u32x2*)p, c); unpack4(*(const u32x2*)(p - (hp ? INW : 0)), pv); unpack4(*(const u32x2*)(p + (hn ? INW : 0)), nv);
    const f32x4 mp = *(const f32x4*)(mup + j), mn = *(const f32x4*)(mun + j);
#pragma unroll
    for (int q = 0; q < 4; ++q) u[q] = c[q] + mp[q] * ((hp ? pv[q] : 0.f) - c[q]) + mn[q] * ((hn ? nv[q] : 0.f) - c[q]);
}

__device__ __forceinline__ void rw_shift8(const bf16_t* PL, const float* mup, const float* mun, int r, const RowGeo& g, int j, float (&u)[8]) {
    const bf16_t* p = PL + (size_t)r * INW + O_RW + j;
    const bool hp = g.pos > 0, hn = g.pos < g.len - 1;
    float c[8], pv[8], nv[8];
    unpack8(*(const u32x4*)p, c); unpack8(*(const u32x4*)(p - (hp ? INW : 0)), pv); unpack8(*(const u32x4*)(p + (hn ? INW : 0)), nv);
    const f32x4 mp0 = *(const f32x4*)(mup + j), mp1 = *(const f32x4*)(mup + j + 4), mn0 = *(const f32x4*)(mun + j), mn1 = *(const f32x4*)(mun + j + 4);
#pragma unroll
    for (int q = 0; q < 4; ++q) { u[q] = c[q] + mp0[q] * ((hp ? pv[q] : 0.f) - c[q]) + mn0[q] * ((hn ? nv[q] : 0.f) - c[q]);
        u[4 + q] = c[4 + q] + mp1[q] * ((hp ? pv[4 + q] : 0.f) - c[4 + q]) + mn1[q] * ((hn ? nv[4 + q] : 0.f) - c[4 + q]); }
}
__device__ __forceinline__ bf16x8 pack8f(const float (&f)[8]) {
    u32x4 w; w.x = cvt_pk_bf16(f[0], f[1]); w.y = cvt_pk_bf16(f[2], f[3]); w.z = cvt_pk_bf16(f[4], f[5]); w.w = cvt_pk_bf16(f[6], f[7]); return __builtin_bit_cast(bf16x8, w);
}
constexpr int RL_MUP = 0, RL_MUN = 5120, RL_KK = 10240, RL_KA = 11264, RL_W0 = 12288, RL_A0 = 14336, RL_RK = 16384, RL_GNG = 17408, RL_GNB = 18432, RL_END = 19456;
__device__ __forceinline__ void rw_stage_tables(const Frame& F, const Params& P, int l) {
    LAS float* T = (LAS float*)F.lds;
    for (int i = F.tid; i < 1280; i += NTHREADS) { T[RL_MUP / 4 + i] = P.in[I_MUP][l * 1280 + i]; T[RL_MUN / 4 + i] = P.in[I_MUN][l * 1280 + i]; }
    for (int i = F.tid; i < 256; i += NTHREADS) { T[RL_KK / 4 + i] = P.in[I_KK][l * 256 + i]; T[RL_KA / 4 + i] = P.in[I_KA][l * 256 + i]; T[RL_RK / 4 + i] = P.in[I_RK][l * 256 + i];
        T[RL_GNG / 4 + i] = P.in[I_GNG][l * 256 + i]; T[RL_GNB / 4 + i] = P.in[I_GNB][l * 256 + i]; }
    for (int i = F.tid; i < 512; i += NTHREADS) { T[RL_W0 / 4 + i] = P.in[I_W0][l * 512 + i]; T[RL_A0 / 4 + i] = P.in[I_A0][l * 512 + i]; }
    __syncthreads();
}
__device__ __forceinline__ void rw_mix8(const LAS float* T, const u32x4 (&raw)[3], bool hp, bool hn, int j, float (&u)[8]) {
    float c[8], pv[8], nv[8]; unpack8(raw[0], c); unpack8(raw[1], pv); unpack8(raw[2], nv);
    const f32x4 mp0 = *(const LAS f32x4*)(T + RL_MUP / 4 + j), mp1 = *(const LAS f32x4*)(T + RL_MUP / 4 + j + 4), mn0 = *(const LAS f32x4*)(T + RL_MUN / 4 + j), mn1 = *(const LAS f32x4*)(T + RL_MUN / 4 + j + 4);
#pragma unroll
    for (int q = 0; q < 4; ++q) { u[q] = c[q] + mp0[q] * ((hp ? pv[q] : 0.f) - c[q]) + mn0[q] * ((hn ? nv[q] : 0.f) - c[q]);
        u[4 + q] = c[4 + q] + mp1[q] * ((hp ? pv[4 + q] : 0.f) - c[4 + q]) + mn1[q] * ((hn ? nv[4 + q] : 0.f) - c[4 + q]); }
}
__device__ __forceinline__ void rw_mix4(const LAS float* T, const u32x2 (&raw)[3], bool hp, bool hn, int j, float (&u)[4]) {
    float c[4], pv[4], nv[4]; unpack4(raw[0], c); unpack4(raw[1], pv); unpack4(raw[2], nv);
    const f32x4 mp = *(const LAS f32x4*)(T + RL_MUP / 4 + j), mn = *(const LAS f32x4*)(T + RL_MUN / 4 + j);
#pragma unroll
    for (int q = 0; q < 4; ++q) u[q] = c[q] + mp[q] * ((hp ? pv[q] : 0.f) - c[q]) + mn[q] * ((hn ? nv[q] : 0.f) - c[q]);
}
__device__ __forceinline__ void phase_rw_prep(const Frame& F, const Params& P, int l) {
    const bf16_t* PL = (const bf16_t*)(F.ws + WS_PL);
    f16_t* SH = (f16_t*)(F.ws + WS_SH); f16_t* SD = (f16_t*)(F.ws + WS_SD);
    const int lane = F.lane;
    rw_stage_tables(F, P, l);
    const LAS float* T = (const LAS float*)F.lds;
    for (int item = F.gw; item < NLAT / 16 + (NCTX / 16) * 4; item += F.nw) {
        const int tile = item < NLAT / 16 ? item : NLAT / 16 + ((item - NLAT / 16) >> 2), h0 = item < NLAT / 16 ? 0 : ((item - NLAT / 16) & 3), h1 = item < NLAT / 16 ? 4 : h0 + 1;
        int l1 = lane; asm volatile("" : "+v"(l1)); const int tk = l1 & 15, g = l1 >> 4;
        const int r = tile * 16 + tk; const RowGeo geo = row_geo(r);
        const bool hp = geo.pos > 0, hn = geo.pos < geo.len - 1;
        const bf16_t* prow = PL + (size_t)r * INW + O_RW; const int dprev = hp ? -INW : 0, dnext = hn ? INW : 0;
        bf16x8 tw[2][2], ta[2][2];
#pragma unroll
        for (int d = 0; d < 2; ++d) { u32x4 raw[4][3];
#pragma unroll
          for (int i = 0; i < 4; ++i) { const bf16_t* p = prow + 768 + 256 * d + 64 * (i & 1) + 32 * (i >> 1) + 8 * g;
              raw[i][0] = *(const u32x4*)p; raw[i][1] = *(const u32x4*)(p + dprev); raw[i][2] = *(const u32x4*)(p + dnext); }
#pragma unroll
          for (int i = 0; i < 4; ++i) { float u[8]; rw_mix8(T, raw[i], hp, hn, 768 + 256 * d + 64 * (i & 1) + 32 * (i >> 1) + 8 * g, u);
              if ((i & 1) == 0) {
#pragma unroll
                  for (int q = 0; q < 8; ++q) u[q] = 1.0f - 2.0f / (1.0f + __expf(2.0f * u[q]));
                  tw[d][i >> 1] = pack8f(u); }
              else ta[d][i >> 1] = pack8f(u); }
          asm volatile("" ::: "memory"); }
        asm volatile("" ::: "memory");
#pragma unroll 1
        for (int h = h0; h < h1; ++h) {
            int l2 = lane; asm volatile("" : "+v"(l2)); const int tk = l2 & 15, g = l2 >> 4;
            const int r = tile * 16 + tk; const RowGeo geo = row_geo(r);
            const bool hp = geo.pos > 0, hn = geo.pos < geo.len - 1;
            const bf16_t* prow = PL + (size_t)r * INW + O_RW + 64 * h + 8 * g; const int dprev = hp ? -INW : 0, dnext = hn ? INW : 0;
            float ur[4][4], uk[4][4], uv[4][4], kkv[4][4]; float ss = 0.f;
            { u32x4 raw[6][3];
#pragma unroll
              for (int i = 0; i < 6; ++i) { const bf16_t* p = prow + 256 * (i >> 1) + 32 * (i & 1);
                  raw[i][0] = *(const u32x4*)p; raw[i][1] = *(const u32x4*)(p + dprev); raw[i][2] = *(const u32x4*)(p + dnext); }
#pragma unroll
              for (int u = 0; u < 2; ++u) { float x8[8]; const int c = 64 * h + 32 * u + 8 * g;
                  rw_mix8(T, raw[u], hp, hn, c, x8);
#pragma unroll
                  for (int e = 0; e < 8; ++e) ur[2 * u + (e >> 2)][e & 3] = x8[e];
                  rw_mix8(T, raw[2 + u], hp, hn, 256 + c, x8);
#pragma unroll
                  for (int e = 0; e < 8; ++e) uk[2 * u + (e >> 2)][e & 3] = x8[e];
                  rw_mix8(T, raw[4 + u], hp, hn, 512 + c, x8);
#pragma unroll
                  for (int e = 0; e < 8; ++e) uv[2 * u + (e >> 2)][e & 3] = x8[e];
                  const f32x4 k0 = *(const LAS f32x4*)(T + RL_KK / 4 + c), k1 = *(const LAS f32x4*)(T + RL_KK / 4 + c + 4);
#pragma unroll
                  for (int q = 0; q < 4; ++q) { kkv[2 * u][q] = uk[2 * u][q] * k0[q]; kkv[2 * u + 1][q] = uk[2 * u + 1][q] * k1[q]; ss += kkv[2 * u][q] * kkv[2 * u][q] + kkv[2 * u + 1][q] * kkv[2 * u + 1][q]; } } }
            ss += __shfl_xor(ss, 16); ss += __shfl_xor(ss, 32);
            const float rn = rsqrtf(ss + 1e-12f);
            const size_t shrow = ((size_t)(geo.b * 4 + h) * TT + geo.tt) * 192;
#pragma unroll
            for (int u = 0; u < 2; ++u) { f16x8 o1, o2, o3;
#pragma unroll
                for (int e = 0; e < 8; ++e) { const int t = 2 * u + (e >> 2), q = e & 3; kkv[t][q] *= rn; o1[e] = (f16_t)ur[t][q]; o2[e] = (f16_t)uv[t][q]; o3[e] = (f16_t)(-kkv[t][q]); }
                f16_t* sp = SH + shrow + 32 * u + 8 * g; *(f16x8*)sp = o1; *(f16x8*)(sp + 64) = o2; *(f16x8*)(sp + 128) = o3; }
#pragma unroll 1
            for (int d = 0; d < 2; ++d) {
                const bf16_t* w2t = (const bf16_t*)(F.ws + WS_LORA + (size_t)(l * 2 + d) * LORA_LD_BYTES); const bf16_t* a2t = w2t + 256 * 64;
                const size_t sdrow = ((size_t)((d * 8 + geo.b) * 4 + h) * TT + geo.tt) * 192;
                const bf16x8 tw0 = d ? tw[1][0] : tw[0][0], tw1 = d ? tw[1][1] : tw[0][1], ta0 = d ? ta[1][0] : ta[0][0], ta1 = d ? ta[1][1] : ta[0][1];
                bf16x8 wf[4][2], af[4][2];
#pragma unroll
                for (int t = 0; t < 4; ++t) { const int wrow = 64 * h + 32 * (t >> 1) + 8 * (tk >> 2) + 4 * (t & 1) + (tk & 3);
                    const bf16_t* wr = w2t + (size_t)wrow * 64 + 8 * g; const bf16_t* ar = a2t + (size_t)wrow * 64 + 8 * g;
                    wf[t][0] = *(const bf16x8*)wr; wf[t][1] = *(const bf16x8*)(wr + 32); af[t][0] = *(const bf16x8*)ar; af[t][1] = *(const bf16x8*)(ar + 32); }
                f16x8 o1[2], o2[2], o3[2];
#pragma unroll
                for (int t = 0; t < 4; ++t) { const int c = 64 * h + 32 * (t >> 1) + 8 * g + 4 * (t & 1);
                    f32x4 xw = *(const LAS f32x4*)(T + RL_W0 / 4 + d * 256 + c), xa = *(const LAS f32x4*)(T + RL_A0 / 4 + d * 256 + c);
                    xw = __builtin_amdgcn_mfma_f32_16x16x32_bf16(wf[t][0], tw0, xw, 0, 0, 0); xw = __builtin_amdgcn_mfma_f32_16x16x32_bf16(wf[t][1], tw1, xw, 0, 0, 0);
                    xa = __builtin_amdgcn_mfma_f32_16x16x32_bf16(af[t][0], ta0, xa, 0, 0, 0); xa = __builtin_amdgcn_mfma_f32_16x16x32_bf16(af[t][1], ta1, xa, 0, 0, 0);
                    const f32x4 kaw = *(const LAS f32x4*)(T + RL_KA / 4 + c);
#pragma unroll
                    for (int q = 0; q < 4; ++q) {
                        const float nx = -xw[q]; const float sp = fmaxf(nx, 0.f) + __logf(1.0f + __expf(-fabsf(nx)));
                        const float e = __expf(-sp - 0.5f);
                        const float omw = 1.0f - __expf(-e);
                        const float a = sigmoidf_(xa[q]);
                        o1[t >> 1][(t & 1) * 4 + q] = (f16_t)omw; o2[t >> 1][(t & 1) * 4 + q] = (f16_t)(uk[t][q] * (1.0f + (a - 1.0f) * kaw[q])); o3[t >> 1][(t & 1) * 4 + q] = (f16_t)(kkv[t][q] * a); } }
#pragma unroll
                for (int u = 0; u < 2; ++u) { f16_t* sp = SD + sdrow + 32 * u + 8 * g; *(f16x8*)sp = o1[u]; *(f16x8*)(sp + 64) = o2[u]; *(f16x8*)(sp + 128) = o3[u]; }
                asm volatile("" ::: "memory");
            }
        }
    }
    __syncthreads();
}

constexpr int CS_ZP = 0, CS_RPP = 2048, CS_BH = 4096, CS_KH = 6144, CS_VV = 8192, CS_MT = 10240, CS_NT = 11264, CS_WC = 12288, CS_SLOT = 12544;
constexpr int CS_ZIMG = 8 * CS_SLOT;
constexpr int CS_NCHUNK = TT / 16;
__device__ __forceinline__ int cs_tt(int d, int q, int s) { const int st = 16 * q + s; return d == 0 ? st : (st < CTXL ? CTXL - 1 - st : TT + CTXL - 1 - st); }
__device__ __forceinline__ float dpp_shr(float old, float v, int) { return v; }
template <int N> __device__ __forceinline__ float row_shr(float v, float old) {
    return __builtin_bit_cast(float, __builtin_amdgcn_update_dpp(__builtin_bit_cast(int, old), __builtin_bit_cast(int, v), 0x110 + N, 0xF, 0xF, false));
}
__device__ __forceinline__ bf16x8 cs_pack(const float (&a)[4], const float (&b)[4]) {
    u32x4 w; w.x = cvt_pk_bf16(a[0], a[1]); w.y = cvt_pk_bf16(a[2], a[3]); w.z = cvt_pk_bf16(b[0], b[1]); w.w = cvt_pk_bf16(b[2], b[3]); return __builtin_bit_cast(bf16x8, w);
}
__device__ __forceinline__ bf16x8 cs_op16(const f32x4& x) { u32x4 w; w.x = cvt_pk_bf16(x[0], x[1]); w.y = cvt_pk_bf16(x[2], x[3]); w.z = 0u; w.w = 0u; return __builtin_bit_cast(bf16x8, w); }
#define CS_MFMA(a, b, c) __builtin_amdgcn_mfma_f32_16x16x32_bf16((a), (b), (c), 0, 0, 0)
__device__ __forceinline__ f32x4 cs_mm16(const f32x4& xt_d, const f32x4& y_d) { return CS_MFMA(cs_op16(xt_d), cs_op16(y_d), ((f32x4){0.f, 0.f, 0.f, 0.f})); }
__device__ __forceinline__ v4i16_t cs_tr(const LAS unsigned char* img, int lane, int T) {
    const int g = lane >> 4, q = (lane & 15) >> 2, p = lane & 3;
    return __builtin_amdgcn_ds_read_tr16_b64_v4i16((LAS v4i16_t*)(img + (4 * g + q) * 128 + p * 32 + (T >> 1) * 16 + (T & 1) * 8));
}
__device__ __forceinline__ bf16x8 cs_lo(v4i16_t x) { bf16x8 r; r[0] = x[0]; r[1] = x[1]; r[2] = x[2]; r[3] = x[3]; r[4] = 0; r[5] = 0; r[6] = 0; r[7] = 0; return r; }

struct CsRaw { u32x2 x[4], z[4], r[4], b[4], k[4], v[4]; };
__device__ __forceinline__ void cs_load(CsRaw& R, const f16_t* sh, const f16_t* sd, int d, int q, int lane) {
    const int s = lane & 15, g = lane >> 4; const int tt = cs_tt(d, q, s);
    const f16_t* shp = sh + (size_t)tt * 192 + 4 * g; const f16_t* sdp = sd + (size_t)tt * 192 + 4 * g;
#pragma unroll
    for (int T = 0; T < 4; ++T) { R.x[T] = *(const u32x2*)(sdp + 16 * T); R.z[T] = *(const u32x2*)(shp + 128 + 16 * T); R.r[T] = *(const u32x2*)(shp + 16 * T);
        R.b[T] = *(const u32x2*)(sdp + 128 + 16 * T); R.k[T] = *(const u32x2*)(sdp + 64 + 16 * T); R.v[T] = *(const u32x2*)(shp + 64 + 16 * T); }
}
__device__ __forceinline__ void cs_prepass(LAS unsigned char* slot, LAS unsigned char* zimg, CsRaw& raw, const f16_t* sh, const f16_t* sd, int d, int qn, int lane) {
    const int s = lane & 15, g = lane >> 4;
    float Wc[4][4], Wp[4][4], iW[4][4];
#pragma unroll
    for (int T = 0; T < 4; ++T) { const f16x4 x4 = __builtin_bit_cast(f16x4, raw.x[T]);
#pragma unroll
        for (int j = 0; j < 4; ++j) { float wc = 1.0f - (float)x4[j];
            wc *= row_shr<1>(wc, 1.0f); wc *= row_shr<2>(wc, 1.0f); wc *= row_shr<4>(wc, 1.0f); wc *= row_shr<8>(wc, 1.0f);
            Wc[T][j] = wc; Wp[T][j] = row_shr<1>(wc, 1.0f); iW[T][j] = __builtin_amdgcn_rcpf(wc); } }
    if (s == 15) {
#pragma unroll
        for (int T = 0; T < 4; ++T) *(LAS f32x4*)(slot + CS_WC + (16 * T + 4 * g) * 4) = (f32x4){Wc[T][0], Wc[T][1], Wc[T][2], Wc[T][3]}; }
    bf16x8 oZ[2], oR[2], oB[2], oK[2];
    const int ioff = s * 128 + g * 32;
#define CS_STAGE(dst, SRC, SC, IMG) do { float t_[4][4]; \
        _Pragma("unroll") for (int T = 0; T < 4; ++T) { const f16x4 q4 = __builtin_bit_cast(f16x4, SRC[T]); \
            _Pragma("unroll") for (int j = 0; j < 4; ++j) t_[T][j] = (float)q4[j] * SC; } \
        _Pragma("unroll") for (int kk = 0; kk < 2; ++kk) { dst[kk] = cs_pack(t_[2 * kk], t_[2 * kk + 1]); if (IMG) *(LAS bf16x8*)((IMG) + ioff + kk * 16) = dst[kk]; } \
        } while (0)
    CS_STAGE(oZ, raw.z, Wp[T][j], zimg);
    CS_STAGE(oR, raw.r, Wc[T][j], (LAS unsigned char*)nullptr);
    CS_STAGE(oB, raw.b, iW[T][j], slot + CS_BH);
    CS_STAGE(oK, raw.k, iW[T][j], slot + CS_KH);
    { bf16x8 oV[2]; CS_STAGE(oV, raw.v, 1.0f, slot + CS_VV); }
#undef CS_STAGE
    asm volatile("" ::: "memory");
    if (qn >= 0) cs_load(raw, sh, sd, d, qn, lane);
    const f32x4 zero4 = (f32x4){0.f, 0.f, 0.f, 0.f};
    f32x4 A_D = CS_MFMA(oB[1], oZ[1], CS_MFMA(oB[0], oZ[0], zero4)), AT_D = CS_MFMA(oZ[1], oB[1], CS_MFMA(oZ[0], oB[0], zero4));
    f32x4 BkT_D = CS_MFMA(oZ[1], oK[1], CS_MFMA(oZ[0], oK[0], zero4));
    f32x4 Ar_D = CS_MFMA(oB[1], oR[1], CS_MFMA(oB[0], oR[0], zero4)), Kr_D = CS_MFMA(oK[1], oR[1], CS_MFMA(oK[0], oR[0], zero4));
    f32x4 I_D;
#pragma unroll
    for (int j = 0; j < 4; ++j) { const int m = 4 * g + j;
        A_D[j] = m < s ? A_D[j] : 0.f; AT_D[j] = s < m ? AT_D[j] : 0.f; BkT_D[j] = s < m ? BkT_D[j] : 0.f;
        Ar_D[j] = m <= s ? Ar_D[j] : 0.f; Kr_D[j] = m <= s ? Kr_D[j] : 0.f; I_D[j] = m == s ? 1.f : 0.f; }
    f32x4 Ab, AbT, A1, A2m;
#pragma unroll
    for (int j = 0; j < 4; ++j) { const int m = 4 * g + j; const bool b0 = (m >> 2) == (s >> 2), b1 = (m >> 3) == (s >> 3);
        Ab[j] = b0 ? A_D[j] : 0.f; AbT[j] = b0 ? AT_D[j] : 0.f; A1[j] = (b1 && !b0) ? A_D[j] : 0.f; A2m[j] = b1 ? 0.f : A_D[j]; }
    const f32x4 Ab2 = cs_mm16(AbT, Ab), Ab2T = cs_mm16(Ab, AbT);
    const f32x4 P0 = I_D + Ab, P0T = I_D + AbT;
    const f32x4 T0 = P0 + cs_mm16(P0T, Ab2), T0T = P0T + cs_mm16(Ab2, P0T);
    (void)Ab2T;
    const f32x4 ZT = cs_mm16(A1, T0T);
    const f32x4 T1 = T0 + cs_mm16(ZT, T0), T1T = T0T + cs_mm16(T0, ZT);
    const f32x4 Z2T = cs_mm16(A2m, T1T);
    const f32x4 T_D = T1 + cs_mm16(Z2T, T1);
    const f32x4 M_D = cs_mm16(BkT_D, T_D), MT_D = cs_mm16(T_D, BkT_D);
    const f32x4 N_D = cs_mm16(MT_D, Ar_D) + Kr_D;
    { u32x4 w; w.x = cvt_pk_bf16(M_D[0], M_D[1]); w.y = cvt_pk_bf16(M_D[2], M_D[3]); w.z = 0u; w.w = 0u; *(LAS u32x4*)(slot + CS_MT + s * 64 + g * 16) = w;
      w.x = cvt_pk_bf16(N_D[0], N_D[1]); w.y = cvt_pk_bf16(N_D[2], N_D[3]); *(LAS u32x4*)(slot + CS_NT + s * 64 + g * 16) = w; }
    __builtin_amdgcn_wave_barrier(); asm volatile("" ::: "memory");
    const bf16x8 oT = cs_op16(T_D), oAr = cs_op16(Ar_D);
    float Zp[4][4];
#pragma unroll
    for (int T = 0; T < 4; ++T) { const f32x4 zp = CS_MFMA(cs_lo(cs_tr(zimg, lane, T)), oT, zero4);
#pragma unroll
        for (int j = 0; j < 4; ++j) Zp[T][j] = zp[j]; }
#pragma unroll
    for (int kk = 0; kk < 2; ++kk) *(LAS bf16x8*)(slot + CS_ZP + s * 128 + g * 32 + kk * 16) = cs_pack(Zp[2 * kk], Zp[2 * kk + 1]);
    __builtin_amdgcn_wave_barrier(); asm volatile("" ::: "memory");
    float Rp[4][4];
#pragma unroll
    for (int T = 0; T < 4; ++T) { const f32x4 rp = CS_MFMA(cs_lo(cs_tr(slot + CS_ZP, lane, T)), oAr, zero4);
#pragma unroll
        for (int j = 0; j < 4; ++j) Rp[T][j] = rp[j] + bf2f((bf16_t)oR[T >> 1][(T & 1) * 4 + j]); }
#pragma unroll
    for (int kk = 0; kk < 2; ++kk) *(LAS bf16x8*)(slot + CS_RPP + s * 128 + g * 32 + kk * 16) = cs_pack(Rp[2 * kk], Rp[2 * kk + 1]);
}
__device__ __forceinline__ void cs_scan_chunk(const LAS unsigned char* slot, f32x4 (&acc)[4], float* yp  , int d, int q, int wave, int lane) {
    const int s = lane & 15, g = lane >> 4;
    const f32x4 zero4 = (f32x4){0.f, 0.f, 0.f, 0.f};
    bf16x8 Xb[2];
#pragma unroll
    for (int kk = 0; kk < 2; ++kk) { u32x4 w; w.x = cvt_pk_bf16(acc[2 * kk][0], acc[2 * kk][1]); w.y = cvt_pk_bf16(acc[2 * kk][2], acc[2 * kk][3]);
        w.z = cvt_pk_bf16(acc[2 * kk + 1][0], acc[2 * kk + 1][1]); w.w = cvt_pk_bf16(acc[2 * kk + 1][2], acc[2 * kk + 1][3]); Xb[kk] = __builtin_bit_cast(bf16x8, w); }
    const v4i16_t vt = cs_tr(slot + CS_VV, lane, wave);
    const bf16x8 Vb = cs_lo(vt);
    const int arow = s * 128 + g * 32, a16 = s * 64 + g * 16;
    f32x4 UT = CS_MFMA(*(const LAS bf16x8*)(slot + CS_ZP + arow), Xb[0], zero4); UT = CS_MFMA(*(const LAS bf16x8*)(slot + CS_ZP + arow + 16), Xb[1], UT); UT = CS_MFMA(*(const LAS bf16x8*)(slot + CS_MT + a16), Vb, UT);
    f32x4 YT = CS_MFMA(*(const LAS bf16x8*)(slot + CS_RPP + arow), Xb[0], zero4); YT = CS_MFMA(*(const LAS bf16x8*)(slot + CS_RPP + arow + 16), Xb[1], YT); YT = CS_MFMA(*(const LAS bf16x8*)(slot + CS_NT + a16), Vb, YT);
#pragma unroll
    for (int j = 0; j < 4; ++j) yp[(size_t)cs_tt(d, q, 4 * g + j) * 256] = YT[j];
    bf16x8 UV; { u32x2 w; w.x = cvt_pk_bf16(UT[0], UT[1]); w.y = cvt_pk_bf16(UT[2], UT[3]); const v4i16_t ub = __builtin_bit_cast(v4i16_t, w);
        UV[0] = ub[0]; UV[1] = ub[1]; UV[2] = ub[2]; UV[3] = ub[3]; UV[4] = vt[0]; UV[5] = vt[1]; UV[6] = vt[2]; UV[7] = vt[3]; }
#pragma unroll
    for (int T = 0; T < 4; ++T) { const v4i16_t bh = cs_tr(slot + CS_BH, lane, T), kh = cs_tr(slot + CS_KH, lane, T);
        bf16x8 BK; BK[0] = bh[0]; BK[1] = bh[1]; BK[2] = bh[2]; BK[3] = bh[3]; BK[4] = kh[0]; BK[5] = kh[1]; BK[6] = kh[2]; BK[7] = kh[3];
        acc[T] = CS_MFMA(BK, UV, acc[T]);
        acc[T] *= *(const LAS f32x4*)(slot + CS_WC + (16 * T + 4 * g) * 4); }
}
__device__ __forceinline__ void phase_scan(const Frame& F) {
    const f16_t* SH = (const f16_t*)(F.ws + WS_SH); const f16_t* SD = (const f16_t*)(F.ws + WS_SD);
    float* Y = (float*)(F.ws + WS_Y);
    const int lane = F.lane, wave = F.wave;
    for (int chain = F.bid; chain < 64; chain += F.G) {
        const int d = chain >> 5, b = (chain >> 2) & 7, h = chain & 3;
        const f16_t* sh = SH + (size_t)(b * 4 + h) * TT * 192; const f16_t* sd = SD + (size_t)((d * 8 + b) * 4 + h) * TT * 192;
        float* yp = Y + ((size_t)(d * 8 + b) * TT) * 256 + h * 64 + 16 * (wave & 3) + (lane & 15);
        f32x4 acc[4];
#pragma unroll
        for (int T = 0; T < 4; ++T) acc[T] = (f32x4){0.f, 0.f, 0.f, 0.f};
        __syncthreads();
        CsRaw raw;
        constexpr int NR = CS_NCHUNK / 8;
        cs_load(raw, sh, sd, d, wave, lane);
        for (int R = 0; R < NR; ++R) {
            cs_prepass(F.lds + wave * CS_SLOT, F.lds + CS_ZIMG + wave * 2048, raw, sh, sd, d, (R + 1 < NR) ? 8 * (R + 1) + wave : -1, lane);
            asm volatile("s_waitcnt lgkmcnt(0)" ::: "memory"); __builtin_amdgcn_s_barrier(); asm volatile("" ::: "memory");
            if (wave < 4) {
#pragma unroll 1
                for (int c8 = 0; c8 < 8; ++c8) cs_scan_chunk(F.lds + c8 * CS_SLOT, acc, yp, d, 8 * R + c8, wave, lane);
            }
            asm volatile("s_waitcnt lgkmcnt(0)" ::: "memory"); __builtin_amdgcn_s_barrier(); asm volatile("" ::: "memory");
        }
    }
}

__device__ __forceinline__ void phase_rw_post(const Frame& F, const Params& P, int l, int nrows) {
    const bf16_t* PL = (const bf16_t*)(F.ws + WS_PL); bf16_t* MIX = (bf16_t*)(F.ws + WS_MIX);
    const f16_t* SH = (const f16_t*)(F.ws + WS_SH); const f16_t* SD = (const f16_t*)(F.ws + WS_SD); const float* Y = (const float*)(F.ws + WS_Y);
    const int lane = F.lane;
    rw_stage_tables(F, P, l);
    const LAS float* T = (const LAS float*)F.lds;
    for (int item = F.gw; item < NLAT / 16 + ((nrows - NLAT) / 16) * 4; item += F.nw) {
        const int tile = item < NLAT / 16 ? item : NLAT / 16 + ((item - NLAT / 16) >> 2), h0 = item < NLAT / 16 ? 0 : ((item - NLAT / 16) & 3), h1 = item < NLAT / 16 ? 4 : h0 + 1;
        int l1 = lane; asm volatile("" : "+v"(l1)); const int tk = l1 & 15, g = l1 >> 4;
        const int r = tile * 16 + tk; const RowGeo geo = row_geo(r);
        const bool hp = geo.pos > 0, hn = geo.pos < geo.len - 1;
        const bf16_t* prow = PL + (size_t)r * INW + O_RW; const int dprev = hp ? -INW : 0, dnext = hn ? INW : 0;
        bf16x8 sg[2][4];
#pragma unroll
        for (int d = 0; d < 2; ++d) { u32x4 raw[4][3];
#pragma unroll
            for (int kk = 0; kk < 4; ++kk) { const bf16_t* p = prow + 896 + 256 * d + 32 * kk + 8 * g;
                raw[kk][0] = *(const u32x4*)p; raw[kk][1] = *(const u32x4*)(p + dprev); raw[kk][2] = *(const u32x4*)(p + dnext); }
#pragma unroll
            for (int kk = 0; kk < 4; ++kk) { float u[8]; rw_mix8(T, raw[kk], hp, hn, 896 + 256 * d + 32 * kk + 8 * g, u);
#pragma unroll
                for (int q = 0; q < 8; ++q) u[q] = sigmoidf_(u[q]);
                sg[d][kk] = pack8f(u); }
            asm volatile("" ::: "memory"); }
#pragma unroll 1
        for (int h = h0; h < h1; ++h) {
            int l2 = lane; asm volatile("" : "+v"(l2)); const int tk = l2 & 15, g = l2 >> 4;
            const int r = tile * 16 + tk; const RowGeo geo = row_geo(r);
            const size_t shrow = ((size_t)(geo.b * 4 + h) * TT + geo.tt) * 192;
            float out[4][4];
#pragma unroll
            for (int t = 0; t < 4; ++t)
#pragma unroll
                for (int q = 0; q < 4; ++q) out[t][q] = 0.f;
            f16x8 rh[2], vh[2];
#pragma unroll
            for (int u = 0; u < 2; ++u) { rh[u] = *(const f16x8*)(SH + shrow + 32 * u + 8 * g); vh[u] = *(const f16x8*)(SH + shrow + 64 + 32 * u + 8 * g); }
#pragma unroll 1
            for (int d = 0; d < 2; ++d) {
                const bf16_t* g2t = (const bf16_t*)(F.ws + WS_LORA + (size_t)(l * 2 + d) * LORA_LD_BYTES) + 2 * 256 * 64;
                const size_t sdrow = ((size_t)((d * 8 + geo.b) * 4 + h) * TT + geo.tt) * 192;
                const float* yrow = Y + ((size_t)(d * 8 + geo.b) * TT + geo.tt) * 256 + 64 * h + 8 * g;
                bf16x8 sgd[4];
#pragma unroll
                for (int kk = 0; kk < 4; ++kk) sgd[kk] = d ? sg[1][kk] : sg[0][kk];
                f32x4 y[4], gg[4]; f16x8 kdh[2]; bf16x8 gf[4][4];
#pragma unroll
                for (int u = 0; u < 2; ++u) { y[2 * u] = *(const f32x4*)(yrow + 32 * u); y[2 * u + 1] = *(const f32x4*)(yrow + 32 * u + 4); kdh[u] = *(const f16x8*)(SD + sdrow + 64 + 32 * u + 8 * g); }
#pragma unroll
                for (int t = 0; t < 4; ++t) { const bf16_t* gr = g2t + (size_t)(64 * h + 32 * (t >> 1) + 8 * (tk >> 2) + 4 * (t & 1) + (tk & 3)) * 128 + 8 * g;
#pragma unroll
                    for (int kk = 0; kk < 4; ++kk) gf[t][kk] = *(const bf16x8*)(gr + 32 * kk); }
                float sm = 0.f, bs = 0.f;
#pragma unroll
                for (int t = 0; t < 4; ++t) { const int c = 64 * h + 32 * (t >> 1) + 8 * g + 4 * (t & 1);
                    sm += (y[t][0] + y[t][1]) + (y[t][2] + y[t][3]);
                    const f32x4 rk = *(const LAS f32x4*)(T + RL_RK / 4 + c);
#pragma unroll
                    for (int q = 0; q < 4; ++q) bs += (float)rh[t >> 1][(t & 1) * 4 + q] * (float)kdh[t >> 1][(t & 1) * 4 + q] * rk[q];
                    f32x4 a = (f32x4){0.f, 0.f, 0.f, 0.f};
#pragma unroll
                    for (int kk = 0; kk < 4; ++kk) a = __builtin_amdgcn_mfma_f32_16x16x32_bf16(gf[t][kk], sgd[kk], a, 0, 0, 0);
                    gg[t] = a; }
                sm += __shfl_xor(sm, 16); sm += __shfl_xor(sm, 32); bs += __shfl_xor(bs, 16); bs += __shfl_xor(bs, 32);
                const float mu = sm * (1.0f / 64.0f); float vs = 0.f;
#pragma unroll
                for (int t = 0; t < 4; ++t)
#pragma unroll
                    for (int q = 0; q < 4; ++q) { const float dd = y[t][q] - mu; vs += dd * dd; }
                vs += __shfl_xor(vs, 16); vs += __shfl_xor(vs, 32);
                const float rstd = rsqrtf(vs * (1.0f / 64.0f) + 64e-5f);
#pragma unroll
                for (int t = 0; t < 4; ++t) { const int c = 64 * h + 32 * (t >> 1) + 8 * g + 4 * (t & 1);
                    const f32x4 gng = *(const LAS f32x4*)(T + RL_GNG / 4 + c), gnb = *(const LAS f32x4*)(T + RL_GNB / 4 + c);
#pragma unroll
                    for (int q = 0; q < 4; ++q) out[t][q] += ((y[t][q] - mu) * rstd * gng[q] + gnb[q] + bs * (float)vh[t >> 1][(t & 1) * 4 + q]) * gg[t][q]; }
                asm volatile("" ::: "memory");
            }
#pragma unroll
            for (int u = 0; u < 2; ++u) { u32x4 w; w.x = cvt_pk_bf16(out[2 * u][0], out[2 * u][1]); w.y = cvt_pk_bf16(out[2 * u][2], out[2 * u][3]); w.z = cvt_pk_bf16(out[2 * u + 1][0], out[2 * u + 1][1]); w.w = cvt_pk_bf16(out[2 * u + 1][2], out[2 * u + 1][3]);
                *(u32x4*)(MIX + (size_t)r * D + 512 + 64 * h + 32 * u + 8 * g) = w; }
        }
    }
    __syncthreads();
}

constexpr int CV_SEG = 64, CV_ROWS = CV_SEG + 30, CV_H = 0, CV_W = CV_ROWS * 256 * 4;
__device__ __forceinline__ void phase_conv(const Frame& F, const Params& P, int l, int nrows) {
    const bf16_t* PL = (const bf16_t*)(F.ws + WS_PL); bf16_t* MIX = (bf16_t*)(F.ws + WS_MIX);
    const int lane = F.lane, c4 = lane * 4, wave = F.wave;
    LAS float* H = (LAS float*)(F.lds + CV_H); LAS float* W = (LAS float*)(F.lds + CV_W);
    for (int i = F.tid; i < 31 * 256; i += NTHREADS) W[i] = P.in[I_DWW][(size_t)l * 31 * 256 + i];
    const f32x4 dwb = *(const f32x4*)(P.in[I_DWB] + l * 256 + c4), lng = *(const f32x4*)(P.in[I_LNG] + l * 256 + c4), lnb = *(const f32x4*)(P.in[I_LNB] + l * 256 + c4);
    for (int seg = F.bid; seg < nrows / CV_SEG; seg += F.G) {
        const int r0 = seg * CV_SEG; const RowGeo g0 = row_geo(r0);
        __syncthreads();
#pragma unroll 4
        for (int k = 0; k < 12; ++k) { const int rr = wave + 8 * k;
            if (rr < CV_ROWS) { const int pos = g0.pos - 15 + rr; f32x4 hv = (f32x4){0.f, 0.f, 0.f, 0.f};
                if (pos >= 0 && pos < g0.len) { const bf16_t* p = PL + (size_t)(r0 - 15 + rr) * INW + O_CV + c4; float a[4], bb[4];
                    unpack4(*(const u32x2*)p, a); unpack4(*(const u32x2*)(p + 256), bb);
#pragma unroll
                    for (int q = 0; q < 4; ++q) hv[q] = a[q] * sigmoidf_(bb[q]); }
                *(LAS f32x4*)(H + rr * 256 + c4) = hv; } }
        __syncthreads();
        f32x4 acc[8];
#pragma unroll
        for (int t = 0; t < 8; ++t) acc[t] = dwb;
#pragma unroll 1
        for (int j = 0; j < 31; ++j) { const f32x4 w = *(const LAS f32x4*)(W + j * 256 + c4);
#pragma unroll
            for (int t = 0; t < 8; ++t) acc[t] += *(const LAS f32x4*)(H + (wave * 8 + t + j) * 256 + c4) * w; }
#pragma unroll
        for (int t = 0; t < 8; ++t) {
            const float mu = wave_sum((acc[t][0] + acc[t][1]) + (acc[t][2] + acc[t][3])) * (1.0f / 256.0f);
            float vs = 0.f;
#pragma unroll
            for (int q = 0; q < 4; ++q) { const float dd = acc[t][q] - mu; vs += dd * dd; }
            const float rstd = rsqrtf(wave_sum(vs) * (1.0f / 256.0f) + 1e-5f);
            float o[4];
#pragma unroll
            for (int q = 0; q < 4; ++q) o[q] = siluf_((acc[t][q] - mu) * rstd * lng[q] + lnb[q]);
            u32x2 w; w.x = pk_bf16(o[0], o[1]); w.y = pk_bf16(o[2], o[3]);
            *(u32x2*)(MIX + (size_t)(r0 + wave * 8 + t) * D + 768 + c4) = w; }
    }
    __syncthreads();
}

__device__ __forceinline__ void phase_na_simple(const Frame& F, const Params& P, int l, int nq) {
    const bf16_t* PL = (const bf16_t*)(F.ws + WS_PL); bf16_t* MIX = (bf16_t*)(F.ws + WS_MIX);
    const float* rpb = P.in[I_RPB] + (size_t)l * 8 * 15 * 31;
    int tid_ = F.tid; asm volatile("" : "+v"(tid_));
    for (int gid = F.bid * NTHREADS + tid_; gid < nq * 8; gid += F.G * NTHREADS) {
        const int r = gid >> 3, h = gid & 7;
        const RowGeo g = row_geo(r);
        float q[64], o[64];
        { const bf16_t* qp = PL + (size_t)r * INW + O_Q + h * 64;
#pragma unroll
          for (int i = 0; i < 8; ++i) unpack8(*(const u32x4*)(qp + i * 8), q + i * 8); }
#pragma unroll
        for (int i = 0; i < 64; ++i) o[i] = 0.f;
        float m = -3.0e38f, lsum = 0.f;
        const bool lat = r < NLAT;
        const int gi = g.pos >> 6, gc = g.pos & 63;
        const int rs = min(max(gi - 4, 0), 56), wsc = min(max(gc - 8, 0), 48);
        const int nkey = lat ? 384 : 256;
#pragma unroll 1
        for (int kx = 0; kx < nkey; ++kx) {
            const bool win = lat && kx < 128;
            int krow; float bias = 0.f;
            if (win) { const int r8 = kx >> 4, cc = kx & 15; krow = g.b * SEQ + (rs + r8) * 64 + wsc + cc; bias = rpb[(h * 15 + (rs + r8 - gi + 7)) * 31 + (wsc + cc - gc + 15)]; }
            else krow = NLAT + g.b * CTXL + (kx - (lat ? 128 : 0));
            const bf16_t* kp = PL + (size_t)krow * INW + O_K + h * 64; float a = bias;
#pragma unroll
            for (int i = 0; i < 8; ++i) { float kf[8]; unpack8(*(const u32x4*)(kp + i * 8), kf);
#pragma unroll
                for (int j = 0; j < 8; ++j) a += q[i * 8 + j] * kf[j]; }
            if (a > m) { const float alpha = __expf(m - a); lsum *= alpha;
#pragma unroll
                for (int i = 0; i < 64; ++i) o[i] *= alpha;
                m = a; }
            const float p = __expf(a - m); lsum += p;
            const bf16_t* vp = kp + (O_V - O_K);
#pragma unroll
            for (int i = 0; i < 8; ++i) { float vf[8]; unpack8(*(const u32x4*)(vp + i * 8), vf);
#pragma unroll
                for (int j = 0; j < 8; ++j) o[i * 8 + j] += p * vf[j]; }
        }
        const float inv = 1.0f / lsum;
        bf16_t* op = MIX + (size_t)r * D + h * 64;
#pragma unroll
        for (int i = 0; i < 8; ++i) { u32x4 w; w.x = pk_bf16(o[i * 8] * inv, o[i * 8 + 1] * inv); w.y = pk_bf16(o[i * 8 + 2] * inv, o[i * 8 + 3] * inv);
            w.z = pk_bf16(o[i * 8 + 4] * inv, o[i * 8 + 5] * inv); w.w = pk_bf16(o[i * 8 + 6] * inv, o[i * 8 + 7] * inv); *(u32x4*)(op + i * 8) = w; }
    }
}

constexpr int NA_CK = 0, NA_CV = 32768, NA_RPB = 65536, NA_WV = 81920;
__device__ __forceinline__ bf16x8 na_pack8(const f32x4& a, const f32x4& b) {
    u32x4 w; w.x = cvt_pk_bf16(a[0], a[1]); w.y = cvt_pk_bf16(a[2], a[3]); w.z = cvt_pk_bf16(b[0], b[1]); w.w = cvt_pk_bf16(b[2], b[3]); return __builtin_bit_cast(bf16x8, w);
}
__device__ __forceinline__ bf16x8 na_vfrag(LAS unsigned char* blk, int lane, int dt) {
    const int g = lane >> 4, qq = (lane & 15) >> 2, p = lane & 3;
    const int r0 = 4 * g + qq, r1 = 16 + 4 * g + qq;
    const v4i16_t lo = __builtin_amdgcn_ds_read_tr16_b64_v4i16((LAS v4i16_t*)(blk + r0 * 128 + ((dt ^ ((r0 >> 1) & 3)) * 32) + p * 8));
    const v4i16_t hi = __builtin_amdgcn_ds_read_tr16_b64_v4i16((LAS v4i16_t*)(blk + r1 * 128 + ((dt ^ ((r1 >> 1) & 3)) * 32) + p * 8));
    bf16x8 r; r[0] = lo[0]; r[1] = lo[1]; r[2] = lo[2]; r[3] = lo[3]; r[4] = hi[0]; r[5] = hi[1]; r[6] = hi[2]; r[7] = hi[3]; return r;
}
template <bool WINDOW>
__device__ __forceinline__ void na_item(const Frame& F, const bf16_t* PL, bf16_t* MIX, int b, int h, int qrow0  , int gi, int cb) {
    const int lane = F.lane, ql = lane & 15, g = lane >> 4;
    LAS unsigned char* CK = F.lds + NA_CK; LAS unsigned char* CV = F.lds + NA_CV; const LAS float* RPB = (const LAS float*)(F.lds + NA_RPB);
    LAS unsigned char* WV = F.lds + NA_WV + F.wave * 4096;
    bf16x8 Qf[2];
    { const bf16_t* qp = PL + (size_t)(qrow0 + ql) * INW + O_Q + h * 64 + 8 * g; Qf[0] = *(const bf16x8*)qp; Qf[1] = *(const bf16x8*)(qp + 32); }
    f32x4 acc[4];
#pragma unroll
    for (int dt = 0; dt < 4; ++dt) acc[dt] = (f32x4){0.f, 0.f, 0.f, 0.f};
    float m_run = -3.0e38f, l_run = 0.f;
    if constexpr (WINDOW) {
        const int rs = min(max(gi - 4, 0), 56), kc0 = min(max(16 * cb - 8, 0), 32), qcol = 16 * cb + ql, wsq = min(max(qcol - 8, 0), 48);
        const size_t krow0 = (size_t)b * SEQ + (size_t)rs * 64 + kc0;
        f32x4 s[16];
#pragma unroll
        for (int t = 0; t < 16; ++t) { const bf16_t* kp = PL + (krow0 + (size_t)(t >> 1) * 64 + (t & 1) * 16 + ql) * INW + O_K + h * 64 + 8 * g;
            const bf16x8 k0 = *(const bf16x8*)kp, k1 = *(const bf16x8*)(kp + 32);
            s[t] = __builtin_amdgcn_mfma_f32_16x16x32_bf16(k0, Qf[0], (f32x4){0.f, 0.f, 0.f, 0.f}, 0, 0, 0);
            s[t] = __builtin_amdgcn_mfma_f32_16x16x32_bf16(k1, Qf[1], s[t], 0, 0, 0); }
        const int vr = lane >> 1, part = lane & 1;
        const bf16_t* vbase = PL + (krow0 + vr) * INW + O_V + h * 64 + part * 32;
        u32x4 vbuf[4][4];
#pragma unroll
        for (int k = 0; k < 4; ++k) { const bf16_t* vp = vbase + (size_t)k * 64 * INW; vbuf[k][0] = *(const u32x4*)vp; vbuf[k][1] = *(const u32x4*)(vp + 8); vbuf[k][2] = *(const u32x4*)(vp + 16); vbuf[k][3] = *(const u32x4*)(vp + 24); }
        float mx = -3.0e38f;
#pragma unroll
        for (int t = 0; t < 16; ++t) { const LAS float* bp = RPB + (h * 15 + (rs + (t >> 1) - gi + 7)) * 31 + 15 - qcol;
#pragma unroll
            for (int j = 0; j < 4; ++j) { const int kcol = kc0 + (t & 1) * 16 + 4 * g + j; const bool ok = kcol >= wsq && kcol < wsq + 16;
                const float v = ok ? s[t][j] + bp[ok ? kcol : qcol] : -INFINITY; s[t][j] = v; mx = fmaxf(mx, v); } }
        mx = fmaxf(mx, __shfl_xor(mx, 16)); mx = fmaxf(mx, __shfl_xor(mx, 32));
        m_run = mx;
        float ls = 0.f;
#pragma unroll
        for (int t = 0; t < 16; ++t)
#pragma unroll
            for (int j = 0; j < 4; ++j) { const float p = __expf(s[t][j] - mx); s[t][j] = p; ls += p; }
        l_run = ls;
#pragma unroll
        for (int r8 = 0; r8 < 8; ++r8) {
            { LAS unsigned char* wr = WV + vr * 128; const int sw = (vr >> 1) & 3;
              *(LAS u32x4*)(wr + (((2 * part) ^ sw) * 32)) = vbuf[r8 & 3][0]; *(LAS u32x4*)(wr + (((2 * part) ^ sw) * 32) + 16) = vbuf[r8 & 3][1];
              *(LAS u32x4*)(wr + (((2 * part + 1) ^ sw) * 32)) = vbuf[r8 & 3][2]; *(LAS u32x4*)(wr + (((2 * part + 1) ^ sw) * 32) + 16) = vbuf[r8 & 3][3];
              if (r8 + 4 < 8) { const bf16_t* vp = vbase + (size_t)(r8 + 4) * 64 * INW;
                  vbuf[r8 & 3][0] = *(const u32x4*)vp; vbuf[r8 & 3][1] = *(const u32x4*)(vp + 8); vbuf[r8 & 3][2] = *(const u32x4*)(vp + 16); vbuf[r8 & 3][3] = *(const u32x4*)(vp + 24); } }
            __builtin_amdgcn_wave_barrier(); asm volatile("" ::: "memory");
            const bf16x8 pf = na_pack8(s[2 * r8], s[2 * r8 + 1]);
#pragma unroll
            for (int dt = 0; dt < 4; ++dt) { const bf16x8 vf = na_vfrag(WV, lane, dt); acc[dt] = __builtin_amdgcn_mfma_f32_16x16x32_bf16(vf, pf, acc[dt], 0, 0, 0); }
            __builtin_amdgcn_wave_barrier(); asm volatile("" ::: "memory");
        }
    }
    {
        f32x4 s[16];
#pragma unroll
        for (int t = 0; t < 16; ++t) { const int key = 16 * t + ql; const LAS unsigned char* kr = CK + key * 128;
            const bf16x8 k0 = *(const LAS bf16x8*)(kr + ((g ^ (key & 7)) * 16)), k1 = *(const LAS bf16x8*)(kr + (((g + 4) ^ (key & 7)) * 16));
            s[t] = __builtin_amdgcn_mfma_f32_16x16x32_bf16(k0, Qf[0], (f32x4){0.f, 0.f, 0.f, 0.f}, 0, 0, 0);
            s[t] = __builtin_amdgcn_mfma_f32_16x16x32_bf16(k1, Qf[1], s[t], 0, 0, 0); }
        float mx = m_run;
#pragma unroll
        for (int t = 0; t < 16; ++t)
#pragma unroll
            for (int j = 0; j < 4; ++j) mx = fmaxf(mx, s[t][j]);
        mx = fmaxf(mx, __shfl_xor(mx, 16)); mx = fmaxf(mx, __shfl_xor(mx, 32));
        const float alpha = __expf(m_run - mx);
        float ls = l_run * alpha;
#pragma unroll
        for (int dt = 0; dt < 4; ++dt) acc[dt] *= alpha;
#pragma unroll
        for (int t = 0; t < 16; ++t)
#pragma unroll
            for (int j = 0; j < 4; ++j) { const float p = __expf(s[t][j] - mx); s[t][j] = p; ls += p; }
        l_run = ls;
#pragma unroll
        for (int blk = 0; blk < 8; ++blk) { const bf16x8 pf = na_pack8(s[2 * blk], s[2 * blk + 1]);
#pragma unroll
            for (int dt = 0; dt < 4; ++dt) { const bf16x8 vf = na_vfrag(CV + blk * 4096, lane, dt); acc[dt] = __builtin_amdgcn_mfma_f32_16x16x32_bf16(vf, pf, acc[dt], 0, 0, 0); } }
    }
    float lt = l_run; lt += __shfl_xor(lt, 16); lt += __shfl_xor(lt, 32);
    const float inv = 1.0f / lt;
    bf16_t* op = MIX + (size_t)(qrow0 + ql) * D + h * 64 + 4 * g;
#pragma unroll
    for (int dt = 0; dt < 4; ++dt) { u32x2 w; w.x = cvt_pk_bf16(acc[dt][0] * inv, acc[dt][1] * inv); w.y = cvt_pk_bf16(acc[dt][2] * inv, acc[dt][3] * inv); *(u32x2*)(op + dt * 16) = w; }
}
__device__ __forceinline__ void phase_na_mfma(const Frame& F, const Params& P, int l, bool ctx_queries) {
    const bf16_t* PL = (const bf16_t*)(F.ws + WS_PL); bf16_t* MIX = (bf16_t*)(F.ws + WS_MIX);
    int tid_ = F.tid; asm volatile("" : "+v"(tid_));
    const int tid = tid_;
    { const float* rpb = P.in[I_RPB] + (size_t)l * 8 * 15 * 31; LAS float* R = (LAS float*)(F.lds + NA_RPB); for (int i = tid; i < 8 * 15 * 31; i += NTHREADS) R[i] = rpb[i]; }
    for (int unit = F.bid; unit < 512; unit += F.G) {
        const int eighth = unit & 7, h = (unit >> 3) & 7, b = unit >> 6;
        __syncthreads();
        { int t2 = tid; asm volatile("" : "+v"(t2)); const int key = t2 >> 1, part = t2 & 1; const bf16_t* kp = PL + (size_t)(NLAT + b * CTXL + key) * INW + O_K + h * 64 + part * 32; const bf16_t* vp = kp + (O_V - O_K);
          LAS unsigned char* kr = F.lds + NA_CK + key * 128; LAS unsigned char* vr = F.lds + NA_CV + key * 128; const int sw = (key >> 1) & 3;
#pragma unroll
          for (int c = 0; c < 4; ++c) { *(LAS u32x4*)(kr + (((4 * part + c) ^ (key & 7)) * 16)) = *(const u32x4*)(kp + 8 * c);
              const int c16 = 4 * part + c; *(LAS u32x4*)(vr + (((c16 >> 1) ^ sw) * 32) + (c16 & 1) * 16) = *(const u32x4*)(vp + 8 * c); } }
        __syncthreads();
        for (int it = F.wave; it < 32; it += NWAVES) { const int gi = eighth * 8 + (it >> 2), cb = it & 3;
            na_item<true>(F, PL, MIX, b, h, b * SEQ + gi * 64 + cb * 16, gi, cb); }
        if (ctx_queries && F.wave < 2) na_item<false>(F, PL, MIX, b, h, NLAT + b * CTXL + (eighth * 2 + F.wave) * 16, 0, 0);
    }
}

__device__ __forceinline__ void phase_final(const Frame& F, const Params& P) {
    float* out = P.out; const float* g = P.in[I_FINALG]; const int lane = F.lane;
    for (int r = F.gw; r < NLAT; r += F.nw) {
        float* xr = out + (size_t)r * D; f32x4 x[4]; float ss = 0.f;
#pragma unroll
        for (int j = 0; j < 4; ++j) { x[j] = *(const f32x4*)(xr + j * 256 + lane * 4); ss += x[j][0] * x[j][0] + x[j][1] * x[j][1] + x[j][2] * x[j][2] + x[j][3] * x[j][3]; }
        ss = wave_sum(ss); const float rstd = rsqrtf(ss * (1.0f / D) + 1e-6f);
#pragma unroll
        for (int j = 0; j < 4; ++j) { const f32x4 gg = *(const f32x4*)(g + j * 256 + lane * 4); *(f32x4*)(xr + j * 256 + lane * 4) = x[j] * rstd * gg; }
    }
}

constexpr int PH_L0 = 1, PH_PER_L0 = 9, PH_L1 = PH_L0 + PH_PER_L0, PH_PER_L1 = 12, PH_FINAL = PH_L1 + PH_PER_L1, N_PHASES = PH_FINAL + 1;
#define RFL(x) __builtin_amdgcn_readfirstlane(x)

PHASE ph_prologue(const void* kp_, int wv_) { PHASE_ENTER; if constexpr (MKB(0)) phase_prologue(F, P); }
PHASE ph_norm1(const void* kp_, int wv_, int l_) { PHASE_ENTER; const int l = RFL(l_);
    if constexpr (MKB(1)) phase_norm<false>(F, P, l, 0, NROW, l == 0 ? P.in[I_X] : P.out, l == 0 ? P.in[I_CTX] : (const float*)(F.ws + WS_XC)); }
PHASE_INL ph_gemm_win(const void* kp_, int wv_, int l_) { PHASE_ENTER; const int l = RFL(l_);
    pg8::DenseSched S; S.init(NROW / 256, INW / 256, F.G, F.bid); S.A = (const bf16_t*)(F.ws + WS_HL); S.Bt = (const bf16_t*)(F.ws + WS_BTIN) + (size_t)l * INW * D; S.K = D;
    pg8::EpiBf16 E{(bf16_t*)(F.ws + WS_PL), INW, 2, 0.125f};
    if constexpr (MKB(2)) pg8::gemm_phase<pg8::EpiBf16, pg8::DenseSched, false>(F.lds, D, S, E, F.wave); }
PHASE_INL ph_rw_prep(const void* kp_, int wv_, int l_) { PHASE_ENTER; const int l = RFL(l_); if constexpr (MKB(3)) phase_rw_prep(F, P, l); }
PHASE ph_conv(const void* kp_, int wv_, int l_, int bid_, int G_) { PHASE_ENTER; const int l = RFL(l_); if constexpr (MKB(4)) phase_conv(sub_frame(F, RFL(bid_), RFL(G_)), P, l, l == 0 ? NROW : NLAT); }
PHASE_INL ph_na(const void* kp_, int wv_, int l_, int bid_, int G_) { PHASE_ENTER; const int l = RFL(l_); if constexpr (MKB(5)) phase_na_mfma(sub_frame(F, RFL(bid_), RFL(G_)), P, l, l == 0); }
PHASE_INL ph_scan(const void* kp_, int wv_, int bid_, int G_) { PHASE_ENTER; if constexpr (MKB(6)) phase_scan(sub_frame(F, RFL(bid_), RFL(G_))); }
PHASE_INL ph_rw_post(const void* kp_, int wv_, int l_) { PHASE_ENTER; const int l = RFL(l_); if constexpr (MKB(7)) phase_rw_post(F, P, l, l == 0 ? NROW : NLAT); }
PHASE_INL ph_gemm_wout(const void* kp_, int wv_, int l_) { PHASE_ENTER; const int l = RFL(l_);
    float* XC = (float*)(F.ws + WS_XC);
    pg8::DenseSched S; S.init((l == 0 ? NROW : NLAT) / 256, D / 256, F.G, F.bid); S.A = (const bf16_t*)(F.ws + WS_MIX); S.Bt = (const bf16_t*)(F.ws + WS_BTOUT) + (size_t)l * D * D; S.K = D; S.split_tail();
    pg8::EpiRes E{l == 0 ? P.in[I_X] : P.out, l == 0 ? P.in[I_CTX] : XC, P.out, XC, (const float*)(F.ws + WS_MODV) + (size_t)l * 9 * MODW + 2 * D};
    if constexpr (MKB(8)) pg8::gemm_phase<pg8::EpiRes, pg8::DenseSched, false>(F.lds, D, S, E, F.wave); }
PHASE ph_norm2_l0(const void* kp_, int wv_) { PHASE_ENTER; if constexpr (MKB(9)) phase_norm<false>(F, P, 0, 1, NROW, P.out, (const float*)(F.ws + WS_XC)); }
PHASE_INL ph_gemm_ffn_gu(const void* kp_, int wv_) { PHASE_ENTER;
    pg8::DenseSched S; S.init(NROW / 256, (2 * DFF) / 256, F.G, F.bid); S.A = (const bf16_t*)(F.ws + WS_HL); S.Bt = (const bf16_t*)(F.ws + WS_BTGU); S.K = D;
    pg8::EpiSwiGLU E{(bf16_t*)(F.ws + WS_H), DFF};
    if constexpr (MKB(10)) pg8::gemm_phase<pg8::EpiSwiGLU, pg8::DenseSched, false>(F.lds, D, S, E, F.wave); }
PHASE_INL ph_gemm_ffn_dn(const void* kp_, int wv_) { PHASE_ENTER;
    float* XC = (float*)(F.ws + WS_XC);
    pg8::DenseSched S; S.init(NROW / 256, D / 256, F.G, F.bid); S.A = (const bf16_t*)(F.ws + WS_H); S.Bt = (const bf16_t*)(F.ws + WS_BTDN); S.K = DFF; S.split_tail();
    pg8::EpiRes E{P.out, XC, P.out, XC, (const float*)(F.ws + WS_MODV) + 5 * D};
    if constexpr (MKB(11)) pg8::gemm_phase<pg8::EpiRes, pg8::DenseSched, false>(F.lds, DFF, S, E, F.wave); }
PHASE ph_norm2_l1(const void* kp_, int wv_) { PHASE_ENTER; if constexpr (MKB(12)) phase_norm<true>(F, P, 1, 1, NLAT, P.out, (const float*)(F.ws + WS_XC)); }
PHASE ph_moe_prep(const void* kp_, int wv_) { PHASE_ENTER; if constexpr (MKB(13)) { phase_moe_rowmap(F); phase_moe_convert(F, P); } }
PHASE_INL ph_gemm_moe_gu(const void* kp_, int wv_, int pass_) { PHASE_ENTER; const int pass = RFL(pass_);
    pg8::MoeSched S; moe_tstart(F, pass, S.tstart); S.init(S.tstart[8], (2 * DFE) / 256, F.G, F.bid);
    S.A = (const bf16_t*)(F.ws + WS_HL); S.Bt0 = F.ws + WS_MOE; S.e_stride = MOE_E_BYTES; S.K = D; S.rowmap = (const int*)(F.ws + WS_ROUTE + RT_RMAP) + pass * NROW;
    pg8::EpiSwiGLU E{(bf16_t*)(F.ws + WS_H), DFE};
    if constexpr (MKB(14)) pg8::gemm_phase<pg8::EpiSwiGLU, pg8::MoeSched, true>(F.lds, D, S, E, F.wave); }
PHASE_INL ph_gemm_moe_dn(const void* kp_, int wv_, int pass_) { PHASE_ENTER; const int pass = RFL(pass_);
    pg8::MoeSched S; moe_tstart(F, pass, S.tstart); S.init(S.tstart[8], D / 256, F.G, F.bid);
    S.A = (const bf16_t*)(F.ws + WS_H); S.Bt0 = F.ws + WS_MOE + MOE_GU_BYTES; S.e_stride = MOE_E_BYTES; S.K = DFE; S.split_tail(); S.rowmap = nullptr;
    pg8::EpiMoeDown E{P.out, (const float*)(F.ws + WS_MODV) + (size_t)9 * MODW + 5 * D, (const int*)(F.ws + WS_ROUTE + RT_RMAP) + pass * NROW, (const float*)(F.ws + WS_ROUTE + RT_SGATE) + pass * NROW};
    if constexpr (MKB(15)) pg8::gemm_phase<pg8::EpiMoeDown, pg8::MoeSched, false>(F.lds, DFE, S, E, F.wave); }
PHASE ph_final(const void* kp_, int wv_) { PHASE_ENTER; if constexpr (MKB(16)) phase_final(F, P); }

static __attribute__((noinline)) __device__ void grid_barrier(const void* bar_, unsigned x_, int wv_) {
    const unsigned long long v = (unsigned long long)bar_;
    const unsigned lo = __builtin_amdgcn_readfirstlane((unsigned)v), hi = __builtin_amdgcn_readfirstlane((unsigned)(v >> 32));
    XcdBarrier b; b.bar = (unsigned*)(((unsigned long long)hi << 32) | lo); b.x = __builtin_amdgcn_readfirstlane(x_);
    b.st = (volatile LAS unsigned*)((LAS unsigned char*)lds_raw + LDS_MISC);
    xcd_barrier(b, __builtin_amdgcn_readfirstlane(wv_) * 64 + lane_id());
}
__device__ __forceinline__ bool ph_in(int lo, int hi, int k) { asm volatile("" : "+s"(lo), "+s"(hi)); return lo <= k && k < hi; }

__global__ void __launch_bounds__(NTHREADS, 2) mk_fwd(Params P) {
    const void* kp = (const void*)__builtin_amdgcn_kernarg_segment_ptr();
    LAS unsigned char* lds = (LAS unsigned char*)lds_raw;
    volatile LAS unsigned* misc = (volatile LAS unsigned*)(lds + LDS_MISC);
    const int wv = __builtin_amdgcn_readfirstlane((int)(threadIdx.x >> 6));
    if (wv == 0 && lane_id() < 4) misc[lane_id()] = 0u;
    __syncthreads();
    const int lo = P.ph_lo, hi = P.ph_hi;
    XcdBarrier bar; bar.bar = (unsigned*)(P.ws + WS_CTL) + CW_BAR; bar.x = 0; bar.st = misc;
    if (hi - lo > 1) bar = xcd_barrier_post((unsigned*)(P.ws + WS_CTL) + CW_BAR, misc, wv * 64 + lane_id());
#define IN(k) ph_in(lo, hi, (k))
#define SEAM(k) do { if (IN((k) + 1)) grid_barrier((const void*)bar.bar, bar.x, wv); } while (0)
    if (IN(0)) { for (int rep = 0; rep < REP_PRO; ++rep) ph_prologue(kp, wv); SEAM(0); }
#define LAYER_COMMON(l, pb) \
    if (IN((pb) + 0)) { for (int rep = 0; rep < REP_NORM; ++rep) ph_norm1(kp, wv, (l)); SEAM((pb) + 0); } \
    if (IN((pb) + 1)) { for (int rep = 0; rep < REP_GEMM; ++rep) ph_gemm_win(kp, wv, (l)); SEAM((pb) + 1); } \
    if (IN((pb) + 2)) { for (int rep = 0; rep < REP_PP; ++rep) ph_rw_prep(kp, wv, (l)); SEAM((pb) + 2); } \
    if (IN((pb) + 3)) { const int bx = (int)blockIdx.x, Gx = (int)gridDim.x; \
        if (Gx == 256) { if (bx < 64) { for (int rep = 0; rep < REP_SCAN; ++rep) ph_scan(kp, wv, bx, 64); } \
            else { for (int rep = 0; rep < REP_CONV; ++rep) ph_conv(kp, wv, (l), bx - 64, 192); for (int rep = 0; rep < REP_NA; ++rep) ph_na(kp, wv, (l), bx - 64, 192); } } \
        else { ph_conv(kp, wv, (l), bx, Gx); ph_na(kp, wv, (l), bx, Gx); ph_scan(kp, wv, bx, Gx); } SEAM((pb) + 3); } \
    if (IN((pb) + 4)) { for (int rep = 0; rep < REP_POST; ++rep) ph_rw_post(kp, wv, (l)); SEAM((pb) + 4); } \
    if (IN((pb) + 5)) { ph_gemm_wout(kp, wv, (l)); SEAM((pb) + 5); }
    LAYER_COMMON(0, PH_L0)
    if (IN(PH_L0 + 6)) { ph_norm2_l0(kp, wv); SEAM(PH_L0 + 6); }
    if (IN(PH_L0 + 7)) { for (int rep = 0; rep < REP_GEMM; ++rep) ph_gemm_ffn_gu(kp, wv); SEAM(PH_L0 + 7); }
    if (IN(PH_L0 + 8)) { ph_gemm_ffn_dn(kp, wv); SEAM(PH_L0 + 8); }
    LAYER_COMMON(1, PH_L1)
    if (IN(PH_L1 + 6)) { ph_norm2_l1(kp, wv); SEAM(PH_L1 + 6); }
    if (IN(PH_L1 + 7)) { for (int rep = 0; rep < REP_PRO; ++rep) ph_moe_prep(kp, wv); SEAM(PH_L1 + 7); }
#pragma unroll 1
    for (int pass = 0; pass < 2; ++pass) {
        if (IN(PH_L1 + 8 + 2 * pass)) { for (int rep = 0; rep < REP_GEMM; ++rep) ph_gemm_moe_gu(kp, wv, pass); SEAM(PH_L1 + 8 + 2 * pass); }
        if (IN(PH_L1 + 9 + 2 * pass)) { ph_gemm_moe_dn(kp, wv, pass); SEAM(PH_L1 + 9 + 2 * pass); }
    }
#undef LAYER_COMMON
    if (IN(PH_FINAL)) ph_final(kp, wv);
#undef IN
#undef SEAM
}

extern "C" void kernel_launch(void* const* d_in, const int* in_sizes, int n_in, void* d_out, int out_size, void* d_ws, size_t ws_size, hipStream_t stream) {
    static int grid = 0;
    if (grid == 0) {
        if (n_in != 35 || out_size != NLAT * D || ws_size < WS_END) { fprintf(stderr, "kernel_launch: unexpected shapes (n_in %d out %d ws %zu need %zu)\n", n_in, out_size, ws_size, (size_t)WS_END); grid = -1; return; }
        int dev = 0, cus = 0, per_cu = 0;
        if (hipGetDevice(&dev) != hipSuccess || hipDeviceGetAttribute(&cus, hipDeviceAttributeMultiprocessorCount, dev) != hipSuccess) { grid = -1; return; }
        if (hipFuncSetAttribute((const void*)mk_fwd, hipFuncAttributeMaxDynamicSharedMemorySize, LDS_BYTES) != hipSuccess) { fprintf(stderr, "kernel_launch: hipFuncSetAttribute failed\n"); grid = -1; return; }
        if (hipOccupancyMaxActiveBlocksPerMultiprocessor(&per_cu, (const void*)mk_fwd, NTHREADS, LDS_BYTES) != hipSuccess || per_cu < 1) { fprintf(stderr, "kernel_launch: occupancy query says %d\n", per_cu); (void)hipGetLastError(); }
        grid = cus;
    }
    if (grid < 0) return;
    (void)hipMemsetAsync((char*)d_ws + WS_CTL, 0, CTL_BYTES, stream);
    Params p{};
    for (int i = 0; i < 35; ++i) p.in[i] = (const float*)d_in[i];
    p.out = (float*)d_out; p.ws = (unsigned char*)d_ws;
#if MK_ONE_LAUNCH
    p.ph_lo = 0; p.ph_hi = N_PHASES;
    hipLaunchKernelGGL(mk_fwd, dim3(grid), dim3(NTHREADS), LDS_BYTES, stream, p);
#else
    for (int k = 0; k < N_PHASES && k <= MK_LAST; ++k) { p.ph_lo = k; p.ph_hi = k + 1; hipLaunchKernelGGL(mk_fwd, dim3(grid), dim3(NTHREADS), LDS_BYTES, stream, p); }
#endif
}
```

```cpp
#include <hip/hip_runtime.h>
#include <stdint.h>
#include <stdio.h>

#ifndef MK_MASK
#define MK_MASK 0xFFFFFFFFu
#endif
#define MKB(k) (((MK_MASK) >> (k)) & 1u)
#ifndef REP_SCAN
#define REP_SCAN 1
#endif
#ifndef REP_NA
#define REP_NA 1
#endif
#ifndef REP_GEMM
#define REP_GEMM 1
#endif
#ifndef REP_PP
#define REP_PP 1
#endif
#ifndef REP_POST
#define REP_POST 1
#endif
#ifndef REP_CONV
#define REP_CONV 1
#endif
#ifndef REP_NORM
#define REP_NORM 1
#endif
#ifndef REP_PRO
#define REP_PRO 1
#endif
#ifndef MK_LAST
#define MK_LAST 99
#endif
#ifndef MK_ONE_LAUNCH
#define MK_ONE_LAUNCH 1
#endif

#define LAS __attribute__((address_space(3)))
typedef unsigned short bf16_t;
typedef _Float16 f16_t;
typedef short bf16x8 __attribute__((ext_vector_type(8)));
typedef float f32x4 __attribute__((ext_vector_type(4)));
typedef float f32x2 __attribute__((ext_vector_type(2)));
typedef unsigned u32x4 __attribute__((ext_vector_type(4)));
typedef unsigned u32x2 __attribute__((ext_vector_type(2)));
typedef f16_t f16x4 __attribute__((ext_vector_type(4)));
typedef f16_t f16x8 __attribute__((ext_vector_type(8)));
typedef short v4i16_t __attribute__((ext_vector_type(4)));

constexpr int D = 1024, NB = 8, SEQ = 4096, CTXL = 256, TT = CTXL + SEQ;
constexpr int NLAT = NB * SEQ, NCTX = NB * CTXL, NROW = NLAT + NCTX;
constexpr int INW = 3328, DFF = 2816, DFE = 3584, NEXP = 8;
constexpr int O_Q = 0, O_K = 512, O_V = 1024, O_RW = 1536, O_CV = 2816;
constexpr int MODW = 6 * D;
constexpr int NTHREADS = 512, NWAVES = 8;
constexpr int LDS_BYTES = 160 * 1024;
constexpr int LDS_MISC = LDS_BYTES - 256;

constexpr size_t al256(size_t x) { return (x + 255) & ~(size_t)255; }
constexpr size_t WS_CTL   = 0;
constexpr size_t CTL_BYTES = 65536;
constexpr size_t WS_MODV  = WS_CTL + CTL_BYTES;
constexpr size_t WS_BTIN  = al256(WS_MODV + (size_t)2 * 9 * MODW * 4);
constexpr size_t WS_BTOUT = al256(WS_BTIN + (size_t)2 * INW * D * 2);
constexpr size_t WS_BTGU  = al256(WS_BTOUT + (size_t)2 * D * D * 2);
constexpr size_t WS_BTDN  = al256(WS_BTGU + (size_t)2 * DFF * D * 2);
constexpr size_t WS_LORA  = al256(WS_BTDN + (size_t)D * DFF * 2);
constexpr size_t LORA_LD_BYTES = (size_t)(256 * 64 * 2 + 256 * 128) * 2;
constexpr size_t WS_MOE   = al256(WS_LORA + 4 * LORA_LD_BYTES);
constexpr size_t MOE_GU_BYTES = (size_t)2 * DFE * D * 2, MOE_DN_BYTES = (size_t)D * DFE * 2, MOE_E_BYTES = MOE_GU_BYTES + MOE_DN_BYTES;
constexpr size_t WS_SH    = WS_MOE;
constexpr size_t SH_BYTES = (size_t)NB * 4 * TT * 192 * 2;
constexpr size_t WS_SD    = WS_SH + SH_BYTES;
constexpr size_t WS_XC    = al256(WS_MOE + (size_t)NEXP * MOE_E_BYTES);
constexpr size_t WS_HL    = al256(WS_XC + (size_t)NCTX * D * 4);
constexpr size_t WS_Y     = WS_HL;
constexpr size_t WS_PL    = al256(WS_HL + (size_t)NROW * D * 2);
constexpr size_t WS_MIX   = al256(WS_PL + (size_t)NROW * INW * 2);
constexpr size_t WS_H     = WS_PL;
constexpr size_t WS_ROUTE = al256(WS_MIX + (size_t)NROW * D * 2);
constexpr size_t RT_TOKE  = 0;
constexpr size_t RT_TOKG  = RT_TOKE + (size_t)NLAT * 2 * 4;
constexpr size_t RT_TOKP  = RT_TOKG + (size_t)NLAT * 2 * 4;
constexpr size_t RT_RMAP  = RT_TOKP + (size_t)NLAT * 2 * 4;
constexpr size_t RT_SGATE = RT_RMAP + (size_t)2 * NROW * 4;
constexpr size_t WS_END   = al256(WS_ROUTE + RT_SGATE + (size_t)2 * NROW * 4);
static_assert(SH_BYTES * 3 <= (size_t)NEXP * MOE_E_BYTES, "scan inputs must fit the MoE weight region");
static_assert((size_t)NROW * DFE * 2 <= (size_t)NROW * INW * 2 + (size_t)NROW * D * 2, "H must fit PL+MIX");

constexpr int CW_BAR = 0;
constexpr int CW_MOECNT = 4096;

#define XB_TMO      128
#define XB_XCNT(j)  (256  + 64 * (j))
#define XB_XSUB(j)  (1280 + 64 * (j))
#define XB_XGEN(j)  (2304 + 64 * (j))
#define XB_TOP      3328
#define XB_TOPGEN   3392
#define XCD_BAR_WORDS 3456
#define XB_SPIN_CAP (1u << 22)

__device__ __forceinline__ unsigned xb_ld(unsigned* p)              { return __hip_atomic_load(p, __ATOMIC_RELAXED, __HIP_MEMORY_SCOPE_AGENT); }
__device__ __forceinline__ unsigned xb_add(unsigned* p, unsigned v) { return __hip_atomic_fetch_add(p, v, __ATOMIC_RELAXED, __HIP_MEMORY_SCOPE_AGENT); }
__device__ __forceinline__ unsigned xb_xcc_id() { return (unsigned)__builtin_amdgcn_s_getreg((3 << 11) | 20) & 0xFu; }
#define XB_SPIN(cond, bar) do { unsigned _sp = 0; while (cond) { __builtin_amdgcn_s_sleep(1); \
    if ((++_sp & 255u) == 0u) { if (xb_ld(&(bar)[XB_TMO])) break; if (_sp > XB_SPIN_CAP) { atomicAdd(&(bar)[XB_TMO], 1u); break; } } } } while (0)

struct XcdBarrier { unsigned* bar; unsigned x; volatile LAS unsigned* st; };

__device__ __forceinline__ XcdBarrier xcd_barrier_post(unsigned* bar, volatile LAS unsigned* st, int tid) {
    XcdBarrier b; b.bar = bar; b.x = xb_xcc_id(); b.st = st;
    if (tid == 0) (void)xb_add(&bar[XB_XCNT(b.x)], 1u);
    return b;
}
__device__ __forceinline__ void xcd_barrier_complete(unsigned* bar, unsigned x, unsigned& nloc, unsigned& nx) {
    const unsigned G = gridDim.x * gridDim.y * gridDim.z;
    unsigned sum, cnt, mine, sp = 0u;
    for (;;) {
        sum = 0u; cnt = 0u; mine = 0u;
#pragma unroll
        for (unsigned j = 0; j < 16; ++j) { const unsigned c = xb_ld(&bar[XB_XCNT(j)]); sum += c; cnt += (c > 0u) ? 1u : 0u; mine = (j == x) ? c : mine; }
        if (sum == G) break;
        __builtin_amdgcn_s_sleep(1);
        if ((++sp & 255u) == 0u) { if (xb_ld(&bar[XB_TMO])) break; if (sp > XB_SPIN_CAP) { atomicAdd(&bar[XB_TMO], 1u); break; } }
    }
    nloc = mine > 0u ? mine : 1u; nx = cnt > 0u ? cnt : 1u;
}
__device__ __forceinline__ void xcd_barrier(const XcdBarrier& b, int tid) {
    asm volatile("s_waitcnt vmcnt(0)" ::: "memory");
    __syncthreads();
    if (tid == 0) {
        unsigned* bar = b.bar;
        __builtin_amdgcn_s_waitcnt(0);
        unsigned nloc = b.st[0], nx = b.st[1];
        if (nloc == 0u) { xcd_barrier_complete(bar, b.x, nloc, nx); b.st[0] = nloc; b.st[1] = nx; }
        const unsigned old = xb_add(&bar[XB_XSUB(b.x)], 1u);
        const unsigned gen = old / nloc;
        if (old + 1u == (gen + 1u) * nloc) {
            __builtin_amdgcn_fence(__ATOMIC_RELEASE, "agent");
            asm volatile("s_waitcnt vmcnt(0)" ::: "memory");
            const unsigned og = xb_add(&bar[XB_TOP], 1u);
            const unsigned tg = og / nx;
            if (og + 1u == (tg + 1u) * nx) xb_add(&bar[XB_TOPGEN], 1u);
            else XB_SPIN(xb_ld(&bar[XB_TOPGEN]) == tg, bar);
            __builtin_amdgcn_fence(__ATOMIC_ACQUIRE, "agent");
            xb_add(&bar[XB_XGEN(b.x)], 1u);
            asm volatile("s_waitcnt vmcnt(0)" ::: "memory");
        } else {
            XB_SPIN(xb_ld(&bar[XB_XGEN(b.x)]) == gen, bar);
            __builtin_amdgcn_fence(__ATOMIC_ACQUIRE, "agent");
            asm volatile("s_waitcnt vmcnt(0)" ::: "memory");
        }
    }
    __syncthreads();
}

__device__ __forceinline__ int lane_id() { return (int)__builtin_amdgcn_mbcnt_hi(~0u, __builtin_amdgcn_mbcnt_lo(~0u, 0u)); }
__device__ __forceinline__ float bf2f(bf16_t b) { return __uint_as_float(((unsigned)b) << 16); }
__device__ __forceinline__ bf16_t f2bf(float f) { unsigned u = __float_as_uint(f); u += 0x7FFFu + ((u >> 16) & 1u); return (bf16_t)(u >> 16); }
__device__ __forceinline__ unsigned pk_bf16(float lo, float hi) { return (unsigned)f2bf(lo) | ((unsigned)f2bf(hi) << 16); }
typedef __bf16 bf16x2_t __attribute__((ext_vector_type(2)));
__device__ __forceinline__ unsigned cvt_pk_bf16(float lo, float hi) { return __builtin_bit_cast(unsigned, __builtin_convertvector((f32x2){lo, hi}, bf16x2_t)); }
__device__ __forceinline__ float sigmoidf_(float x) { return 1.0f / (1.0f + __expf(-x)); }
__device__ __forceinline__ float siluf_(float x) { return x / (1.0f + __expf(-x)); }
__device__ __forceinline__ float wave_sum(float v) {
#pragma unroll
    for (int o = 32; o >= 1; o >>= 1) v += __shfl_xor(v, o);
    return v;
}
__device__ __forceinline__ float sum16(float v) {
    v += __shfl_xor(v, 1); v += __shfl_xor(v, 2); v += __shfl_xor(v, 4); v += __shfl_xor(v, 8); return v;
}
__device__ __forceinline__ void unpack4(u32x2 w, float (&f)[4]) {
    f[0] = __uint_as_float(w.x << 16); f[1] = __uint_as_float(w.x & 0xffff0000u); f[2] = __uint_as_float(w.y << 16); f[3] = __uint_as_float(w.y & 0xffff0000u);
}
__device__ __forceinline__ void unpack8(u32x4 w, float* f) {
    f[0] = __uint_as_float(w.x << 16); f[1] = __uint_as_float(w.x & 0xffff0000u); f[2] = __uint_as_float(w.y << 16); f[3] = __uint_as_float(w.y & 0xffff0000u);
    f[4] = __uint_as_float(w.z << 16); f[5] = __uint_as_float(w.z & 0xffff0000u); f[6] = __uint_as_float(w.w << 16); f[7] = __uint_as_float(w.w & 0xffff0000u);
}

struct Params {
    const float* in[35];
    float* out; unsigned char* ws;
    int ph_lo, ph_hi;
};
enum { I_X = 0, I_C, I_CTX, I_CCTX, I_N1G, I_N2G, I_MODW, I_MODB, I_WIN, I_WOUT, I_RPB, I_MUP, I_MUN, I_W0, I_W2, I_A0, I_A2, I_G2, I_KK, I_KA, I_RK, I_GNG, I_GNB,
       I_DWW, I_DWB, I_LNG, I_LNB, I_FG, I_FU, I_FD, I_ROUTER, I_MG, I_MU, I_MD, I_FINALG };

__device__ __forceinline__ int row_mi(int r) { return r < NLAT ? (r >> 12) : 8; }

namespace pg8 {
constexpr int BM = 256, BK = 64, HALF = 128, HTB = HALF * BK * 2, STAGE_BYTES = 8 * HTB, NXCD = 8, WGM = 8;
__device__ __forceinline__ int lds_byte(int r, int c) { const int st = (r >> 4) * 2 + (c >> 5), rr = r & 15, cc = c & 31, ob = rr * 64 + cc * 2; return st * 1024 + (ob ^ (((ob >> 9) & 1) << 5)); }
__device__ __forceinline__ void stage_rc(int b, int& R, int& C) { const int st = b / 1024, sb = b % 1024, swz = sb ^ (((sb >> 9) & 1) << 5); R = (st >> 1) * 16 + swz / 64; C = (st & 1) * 32 + (swz % 64) / 2; }
__device__ __forceinline__ int perm32(int rho) { const int n = rho >> 4, i = rho & 15; return 8 * (i >> 2) + 4 * n + (i & 3); }
struct Unit { int pm, pn, sub, ah, hb; };

struct TileOrder {
    int nM, nN, nwg, G, c, full;
    __device__ void init(int nM_, int nN_, int G_, int c_) { nM = nM_; nN = nN_; nwg = nM * nN; G = G_; c = c_; full = nwg; }
    __device__ void split_tail() { full = (nwg / G) * G; }
    __device__ bool next(int i, Unit& u) const {
        long L = (long)i * G + c;
        u.sub = 0; u.ah = 0; u.hb = 0;
        if (L >= (long)full + 4L * (nwg - full)) return false;
        if (L >= full) { const int j = (int)(L - full); L = full + (j >> 2); u.sub = 1; u.ah = (j >> 1) & 1; u.hb = j & 1; }
        int wgid = (int)L; { const int q = nwg / NXCD, r = nwg % NXCD, xcd = wgid % NXCD, off = wgid / NXCD; wgid = (xcd < r ? xcd * (q + 1) : r * (q + 1) + (xcd - r) * q) + off; }
        const int nig = WGM * nN, gid = wgid / nig, fm = gid * WGM, gsz = (nM - fm) < WGM ? (nM - fm) : WGM;
        u.pm = fm + ((wgid % nig) % gsz); u.pn = (wgid % nig) / gsz; return true;
    }
};
struct DenseSched : TileOrder {
    const bf16_t* A; const bf16_t* Bt; int K;
    __device__ __forceinline__ const char* aptr(const Unit& u) const { return (const char*)A + (size_t)u.pm * BM * K * 2; }
    __device__ __forceinline__ const char* bptr(const Unit& u) const { return (const char*)Bt + (size_t)u.pn * BM * K * 2; }
    __device__ __forceinline__ const char* abase() const { return (const char*)A; }
    __device__ __forceinline__ int arow(const Unit&, int) const { return 0; }
};
struct MoeSched : TileOrder {
    const bf16_t* A; const unsigned char* Bt0; size_t e_stride; int K; const int* rowmap; int tstart[9];
    __device__ __forceinline__ int expert(int pm) const { int e = 0;
#pragma unroll
        for (int j = 1; j < 8; ++j) e += (pm >= tstart[j]) ? 1 : 0;
        return e; }
    __device__ __forceinline__ const char* aptr(const Unit& u) const { return (const char*)A + (size_t)u.pm * BM * K * 2; }
    __device__ __forceinline__ const char* bptr(const Unit& u) const { return (const char*)Bt0 + (size_t)expert(u.pm) * e_stride + (size_t)u.pn * BM * K * 2; }
    __device__ __forceinline__ const char* abase() const { return (const char*)A; }
    __device__ __forceinline__ int arow(const Unit& u, int r) const { const int t = rowmap[u.pm * BM + r]; return t < 0 ? 0 : t; }
};

struct EpiBf16 {
    static constexpr bool PERM = true;
    bf16_t* O; int ldc; int nscale; float scale;
    __device__ __forceinline__ void operator()(const f32x4 (&acc)[2][2][4][2], const Unit& u, int wr, int wc, int fr, int fq) const {
        const int row0 = u.pm * BM + wr * 64 + fr, col0 = u.pn * BM + wc * 32 + 8 * fq;
        const float s = u.pn < nscale ? scale : 1.0f;
#pragma unroll
        for (int ai = 0; ai < 2; ++ai)
#pragma unroll
            for (int m = 0; m < 4; ++m) { bf16_t* rowp = O + (size_t)(row0 + ai * HALF + m * 16) * ldc + col0;
#pragma unroll
                for (int bj = 0; bj < 2; ++bj) { const f32x4 v0 = acc[ai][bj][m][0] * s, v1 = acc[ai][bj][m][1] * s;
                    u32x4 w; w.x = cvt_pk_bf16(v0[0], v0[1]); w.y = cvt_pk_bf16(v0[2], v0[3]); w.z = cvt_pk_bf16(v1[0], v1[1]); w.w = cvt_pk_bf16(v1[2], v1[3]);
                    *(u32x4*)(rowp + bj * HALF) = w; } }
    }
};
struct EpiSwiGLU {
    static constexpr bool PERM = true;
    bf16_t* H; int ldh;
    __device__ __forceinline__ void operator()(const f32x4 (&acc)[2][2][4][2], const Unit& u, int wr, int wc, int fr, int fq) const {
        const int row0 = u.pm * BM + wr * 64 + fr, col0 = u.pn * HALF + wc * 32 + 8 * fq;
#pragma unroll
        for (int ai = 0; ai < 2; ++ai)
#pragma unroll
            for (int m = 0; m < 4; ++m) { bf16_t* rowp = H + (size_t)(row0 + ai * HALF + m * 16) * ldh + col0;
                float h[8];
#pragma unroll
                for (int n = 0; n < 2; ++n)
#pragma unroll
                    for (int j = 0; j < 4; ++j) { const float g = acc[ai][0][m][n][j], up = acc[ai][1][m][n][j]; h[n * 4 + j] = g / (1.0f + __expf(-g)) * up; }
                u32x4 w; w.x = cvt_pk_bf16(h[0], h[1]); w.y = cvt_pk_bf16(h[2], h[3]); w.z = cvt_pk_bf16(h[4], h[5]); w.w = cvt_pk_bf16(h[6], h[7]);
                *(u32x4*)rowp = w; }
    }
};
struct EpiRes {
    static constexpr bool PERM = false;
    const float* resL; const float* resC; float* outL; float* outC; const float* gvec;
    __device__ __forceinline__ void operator()(const f32x4 (&acc)[2][2][4][2], const Unit& u, int wr, int wc, int fr, int fq) const {
        const int r0 = u.pm * BM; const bool lat = r0 < NLAT;
        const float* res = lat ? resL + (size_t)r0 * D : resC + (size_t)(r0 - NLAT) * D;
        float* out = lat ? outL + (size_t)r0 * D : outC + (size_t)(r0 - NLAT) * D;
        const float* gv = gvec + (size_t)(lat ? (r0 >> 12) : 8) * MODW;
        const int rl = wr * 64 + fr, col0 = u.pn * BM + wc * 32 + 4 * fq;
        const int nq = u.sub ? 1 : 2, ro = u.sub ? u.ah * HALF : 0, co = u.sub ? u.hb * HALF : 0;
        f32x4 g[2][2];
#pragma unroll
        for (int bj = 0; bj < 2; ++bj)
#pragma unroll
            for (int n = 0; n < 2; ++n) g[bj][n] = *(const f32x4*)(gv + col0 + co + (u.sub ? 0 : bj * HALF) + n * 16);
#pragma unroll
        for (int ai = 0; ai < 2; ++ai) if (ai < nq)
#pragma unroll
            for (int m = 0; m < 4; ++m) { const size_t off = (size_t)(rl + ro + ai * HALF + m * 16) * D + col0 + co;
#pragma unroll
                for (int bj = 0; bj < 2; ++bj) if (bj < nq)
#pragma unroll
                    for (int n = 0; n < 2; ++n) { const f32x4 rv = *(const f32x4*)(res + off + bj * HALF + n * 16);
                        *(f32x4*)(out + off + bj * HALF + n * 16) = rv + g[bj][n] * acc[ai][bj][m][n]; } }
    }
};
struct EpiMoeDown {
    static constexpr bool PERM = false;
    float* xl; const float* gvec; const int* rowmap; const float* sgate;
    __device__ __forceinline__ void operator()(const f32x4 (&acc)[2][2][4][2], const Unit& u, int wr, int wc, int fr, int fq) const {
        const int nq = u.sub ? 1 : 2;
        const int rl = u.pm * BM + wr * 64 + fr + (u.sub ? u.ah * HALF : 0), col0 = u.pn * BM + wc * 32 + 4 * fq + (u.sub ? u.hb * HALF : 0);
#pragma unroll
        for (int ai = 0; ai < 2; ++ai) if (ai < nq)
#pragma unroll
            for (int m = 0; m < 4; ++m) { const int slot = rl + ai * HALF + m * 16; const int tok = rowmap[slot];
                if (tok >= 0) { const float sg = sgate[slot]; const float* gv = gvec + (size_t)(tok >> 12) * MODW + col0; float* xp = xl + (size_t)tok * D + col0;
#pragma unroll
                    for (int bj = 0; bj < 2; ++bj) if (bj < nq)
#pragma unroll
                        for (int n = 0; n < 2; ++n) { const f32x4 g = *(const f32x4*)(gv + bj * HALF + n * 16); const f32x4 rv = *(const f32x4*)(xp + bj * HALF + n * 16);
                            *(f32x4*)(xp + bj * HALF + n * 16) = rv + (g * sg) * acc[ai][bj][m][n]; } } }
    }
};

template <class Epi, class Sched, bool GATHER>
__device__ __forceinline__ void gemm_phase(LAS unsigned char* lds, const int K, const Sched& S, const Epi& E, const int wave_) {
    int tid_ = wave_ * 64 + lane_id(); asm volatile("" : "+v"(tid_));
    const int tid = tid_, wid = wave_, lane = tid & 63, wr = wid >> 2, wc = wid & 3, fr = lane & 15, fq = lane >> 4;
    const int nt = K / BK;
    unsigned voffA[2], voffB[2]; int RA[2], CA[2];
#pragma unroll
    for (int i = 0; i < 2; ++i) { int R, C; stage_rc(tid * 16 + i * 8192, R, C); const int Rb = Epi::PERM ? ((R & ~31) + perm32(R & 31)) : R;
        voffA[i] = (unsigned)(R * K + C) * 2u; voffB[i] = (unsigned)(Rb * K + C) * 2u; RA[i] = R; CA[i] = C; }
    const size_t kstep = (size_t)(BK * 2);
    const size_t hstep = (size_t)HALF * K * 2;
    const unsigned ldsw = (unsigned)wid * 1024u;
    const int aoff = lds_byte(wr * 64 + fr, fq * 8), boff = lds_byte(wc * 32 + fr, fq * 8);
#define PG8_SA(b, h) (((b) * 2 + (h)) * HTB)
#define PG8_SB(b, h) ((4 + (b) * 2 + (h)) * HTB)
#define PG8_STAGE(bufoff, gbase, voff) do { _Pragma("unroll") for (int _i = 0; _i < 2; ++_i) \
        __builtin_amdgcn_global_load_lds((const unsigned*)((const char*)(gbase) + (voff)[_i]), (LAS unsigned*)(lds + (bufoff) + ldsw + _i * 8192), 16, 0, 0); } while (0)
#define PG8_LDA(dst, b, h) do { _Pragma("unroll") for (int m = 0; m < 4; ++m) _Pragma("unroll") for (int k = 0; k < 2; ++k) dst[m][k] = *(const LAS bf16x8*)(lds + PG8_SA(b, h) + aoff + m * 2048 + k * 1024); } while (0)
#define PG8_LDB(dst, b, h) do { _Pragma("unroll") for (int n = 0; n < 2; ++n) _Pragma("unroll") for (int k = 0; k < 2; ++k) dst[n][k] = *(const LAS bf16x8*)(lds + PG8_SB(b, h) + boff + n * 2048 + k * 1024); } while (0)
#define PG8_MMA(ai, bj, At, Bt) do { __builtin_amdgcn_s_setprio(1); _Pragma("unroll") for (int m = 0; m < 4; ++m) _Pragma("unroll") for (int n = 0; n < 2; ++n) _Pragma("unroll") for (int k = 0; k < 2; ++k) \
        acc[ai][bj][m][n] = __builtin_amdgcn_mfma_f32_16x16x32_bf16(Bt[n][k], At[m][k], acc[ai][bj][m][n], 0, 0, 0); __builtin_amdgcn_s_setprio(0); } while (0)
#define PG8_WAIT_V(n) asm volatile("s_waitcnt vmcnt(" #n ")" ::: "memory")
#define PG8_WAIT_L(n) asm volatile("s_waitcnt lgkmcnt(" #n ")" ::: "memory")
#define PG8_BAR __builtin_amdgcn_s_barrier()
#define PG8_SCHED __builtin_amdgcn_sched_barrier(0)
#define PG8_STAGE_A(bufoff, TS, H) do { if constexpr (GATHER) { PG8_STAGE(bufoff, gA##TS, oA##TS[H]); } else { PG8_STAGE(bufoff, a##TS + (H) * hA##TS, voffA); } } while (0)
    Unit cur, nxt; int ui = 0;
    if (!S.next(0, cur)) return;
    f32x4 acc[2][2][4][2];
#pragma unroll
    for (int a = 0; a < 2; ++a)
#pragma unroll
        for (int b = 0; b < 2; ++b)
#pragma unroll
            for (int m = 0; m < 4; ++m)
#pragma unroll
                for (int n = 0; n < 2; ++n) acc[a][b][m][n] = (f32x4){0.f, 0.f, 0.f, 0.f};
    bf16x8 At[4][2], B0[2][2], B1[2][2];
    const char* Abase = S.abase();
    unsigned aoC[2][2] = {{0u, 0u}, {0u, 0u}}, aoN[2][2] = {{0u, 0u}, {0u, 0u}};
    if constexpr (GATHER) {
#pragma unroll
        for (int h = 0; h < 2; ++h)
#pragma unroll
            for (int i = 0; i < 2; ++i) aoC[h][i] = (unsigned)(S.arow(cur, h * HALF + RA[i]) * K + CA[i]) * 2u;
    }
    size_t hAc = cur.sub ? 0 : hstep, hBc = hAc, hAn = hAc, hBn = hAc;
    const char* cA = GATHER ? Abase : S.aptr(cur) + (cur.sub ? cur.ah * hstep : 0); const char* cB = S.bptr(cur) + (cur.sub ? cur.hb * hstep : 0);
    if constexpr (GATHER) {
        PG8_STAGE(PG8_SB(0, 0), cB, voffB); PG8_STAGE(PG8_SA(0, 0), Abase, aoC[0]); PG8_STAGE(PG8_SB(0, 1), cB + hstep, voffB); PG8_STAGE(PG8_SA(0, 1), Abase, aoC[1]);
    } else {
        PG8_STAGE(PG8_SB(0, 0), cB, voffB); PG8_STAGE(PG8_SA(0, 0), cA, voffA); PG8_STAGE(PG8_SB(0, 1), cB + hBc, voffB); PG8_STAGE(PG8_SA(0, 1), cA + hAc, voffA);
    }
    if (wr == 1) PG8_BAR;
    PG8_WAIT_V(4); PG8_BAR;
    if constexpr (GATHER) {
        PG8_STAGE(PG8_SB(1, 0), cB + kstep, voffB); PG8_STAGE(PG8_SA(1, 0), Abase + kstep, aoC[0]); PG8_STAGE(PG8_SB(1, 1), cB + hstep + kstep, voffB);
    } else {
        PG8_STAGE(PG8_SB(1, 0), cB + kstep, voffB); PG8_STAGE(PG8_SA(1, 0), cA + kstep, voffA); PG8_STAGE(PG8_SB(1, 1), cB + hBc + kstep, voffB);
    }
    PG8_WAIT_V(6); PG8_BAR;
    for (;;) {
        const bool has_next = S.next(ui + 1, nxt);
        const char* nA = has_next ? (GATHER ? Abase : S.aptr(nxt) + (nxt.sub ? nxt.ah * hstep : 0)) : cA; const char* nB = has_next ? S.bptr(nxt) + (nxt.sub ? nxt.hb * hstep : 0) : cB;
        hAn = has_next ? (nxt.sub ? 0 : hstep) : hAc; hBn = hAn;
        if constexpr (GATHER) {
            if (has_next) {
#pragma unroll
                for (int h = 0; h < 2; ++h)
#pragma unroll
                    for (int i = 0; i < 2; ++i) aoN[h][i] = (unsigned)(S.arow(nxt, h * HALF + RA[i]) * K + CA[i]) * 2u;
            } else {
#pragma unroll
                for (int h = 0; h < 2; ++h)
#pragma unroll
                    for (int i = 0; i < 2; ++i) aoN[h][i] = aoC[h][i];
            }
        }
        for (int t = 0; t < nt; t += 2) {
            const bool last = (t == nt - 2);
            const char* a1 = cA + (size_t)(t + 1) * kstep;
            const char* a2 = last ? nA : cA + (size_t)(t + 2) * kstep; const char* b2 = last ? nB : cB + (size_t)(t + 2) * kstep;
            const char* a3 = a2 + kstep; const char* b3 = b2 + kstep;
            const size_t hA1 = hAc, hA2 = last ? hAn : hAc, hA3 = hA2, hB2 = last ? hBn : hBc; (void)hA1; (void)hA3;
            const char* gA1 = Abase + (size_t)(t + 1) * kstep; const char* gA2 = Abase + (last ? (size_t)0 : (size_t)(t + 2) * kstep); const char* gA3 = gA2 + kstep;
            unsigned oA1[2][2], oA2[2][2], oA3[2][2];
#pragma unroll
            for (int h = 0; h < 2; ++h)
#pragma unroll
                for (int i = 0; i < 2; ++i) { oA1[h][i] = aoC[h][i]; oA2[h][i] = last ? aoN[h][i] : aoC[h][i]; oA3[h][i] = oA2[h][i]; }
            (void)a1; (void)a3; (void)gA1; (void)gA3; (void)oA1; (void)oA3;
            PG8_LDB(B0, 0, 0); PG8_SCHED; PG8_LDA(At, 0, 0); PG8_STAGE_A(PG8_SA(1, 1), 1, 1);
            PG8_WAIT_L(8); PG8_BAR; PG8_WAIT_L(0); PG8_MMA(0, 0, At, B0); PG8_BAR; PG8_SCHED;
            PG8_LDB(B1, 0, 1); PG8_STAGE(PG8_SB(0, 0), b2, voffB);
            PG8_BAR; PG8_WAIT_L(0); if (!cur.sub) PG8_MMA(0, 1, At, B1); PG8_BAR;
            PG8_LDA(At, 0, 1); PG8_STAGE_A(PG8_SA(0, 0), 2, 0);
            PG8_BAR; PG8_WAIT_L(0); if (!cur.sub) PG8_MMA(1, 0, At, B0); PG8_BAR; PG8_SCHED;
            PG8_STAGE(PG8_SB(0, 1), b2 + hB2, voffB);
            PG8_WAIT_V(6); PG8_BAR; if (!cur.sub) PG8_MMA(1, 1, At, B1); PG8_BAR;
            PG8_LDB(B0, 1, 0); PG8_SCHED; PG8_LDA(At, 1, 0); PG8_STAGE_A(PG8_SA(0, 1), 2, 1);
            PG8_WAIT_L(8); PG8_BAR; PG8_WAIT_L(0); PG8_MMA(0, 0, At, B0); PG8_BAR; PG8_SCHED;
            PG8_LDB(B1, 1, 1); PG8_STAGE(PG8_SB(1, 0), b3, voffB);
            PG8_BAR; PG8_WAIT_L(0); if (!cur.sub) PG8_MMA(0, 1, At, B1); PG8_BAR;
            PG8_LDA(At, 1, 1); PG8_STAGE_A(PG8_SA(1, 0), 3, 0);
            PG8_BAR; PG8_WAIT_L(0); if (!cur.sub) PG8_MMA(1, 0, At, B0); PG8_BAR; PG8_SCHED;
            PG8_STAGE(PG8_SB(1, 1), b3 + hB2, voffB);
            PG8_WAIT_V(6); PG8_BAR; if (!cur.sub) PG8_MMA(1, 1, At, B1); PG8_BAR;
        }
        { int t2 = tid; asm volatile("" : "+v"(t2)); const int l2 = t2 & 63; E(acc, cur, wr, wc, l2 & 15, l2 >> 4); }
        if (!has_next) break;
#pragma unroll
        for (int a = 0; a < 2; ++a)
#pragma unroll
            for (int b = 0; b < 2; ++b)
#pragma unroll
                for (int m = 0; m < 4; ++m)
#pragma unroll
                    for (int n = 0; n < 2; ++n) acc[a][b][m][n] = (f32x4){0.f, 0.f, 0.f, 0.f};
        cur = nxt; cA = nA; cB = nB; hAc = hAn; hBc = hBn; ++ui;
        if constexpr (GATHER) {
#pragma unroll
            for (int h = 0; h < 2; ++h)
#pragma unroll
                for (int i = 0; i < 2; ++i) aoC[h][i] = aoN[h][i];
        }
    }
    PG8_WAIT_V(0);
    if (wr == 0) PG8_BAR;
    PG8_BAR;
#undef PG8_SA
#undef PG8_SB
#undef PG8_STAGE
#undef PG8_STAGE_A
#undef PG8_LDA
#undef PG8_LDB
#undef PG8_MMA
#undef PG8_WAIT_V
#undef PG8_WAIT_L
#undef PG8_BAR
#undef PG8_SCHED
}
}

struct Frame {
    LAS unsigned char* lds; int tid, lane, wave, G, bid, gw, nw;
    unsigned char* ws;
};
extern __shared__ __attribute__((aligned(16))) unsigned char lds_raw[];
typedef const __attribute__((address_space(4))) Params* KP;
__device__ __forceinline__ Params load_params(const void* kp_) {
    const unsigned long long v = (unsigned long long)kp_;
    const unsigned lo = __builtin_amdgcn_readfirstlane((unsigned)v), hi = __builtin_amdgcn_readfirstlane((unsigned)(v >> 32));
    KP kp = (KP)(((unsigned long long)hi << 32) | lo);
    Params P;
#pragma unroll
    for (int i = 0; i < 35; ++i) P.in[i] = kp->in[i];
    P.out = kp->out; P.ws = kp->ws; P.ph_lo = kp->ph_lo; P.ph_hi = kp->ph_hi;
    return P;
}
#define PHASE static __attribute__((noinline)) __device__ void
#define PHASE_INL static __device__ __forceinline__ void
__device__ __forceinline__ Frame make_frame(unsigned char* ws, int wave_) {
    Frame F; F.lds = (LAS unsigned char*)lds_raw; F.wave = __builtin_amdgcn_readfirstlane(wave_);
    int t_ = F.wave * 64 + lane_id(); asm volatile("" : "+v"(t_));
    F.tid = t_; F.lane = F.tid & 63;
    F.G = gridDim.x; F.bid = blockIdx.x; F.gw = F.bid * NWAVES + F.wave; F.nw = F.G * NWAVES; F.ws = ws; return F;
}
__device__ __forceinline__ Frame sub_frame(Frame F, int bid, int G) { F.bid = bid; F.G = G; F.gw = F.bid * NWAVES + F.wave; F.nw = F.G * NWAVES; return F; }
#define PHASE_ENTER const Params P = load_params(kp_); const Frame F = make_frame(P.ws, wv_)

__device__ __forceinline__ void conv_job(const Frame& F, const float* src, bf16_t* dst, int K, int N, int mode) {
    LAS float* tile = (LAS float*)(F.lds + F.wave * (64 * 65 * 4));
    const int tk = K / 64, tn = N / 64, ntile = tk * tn, lane = F.lane;
    for (int t = F.gw; t < ntile; t += F.nw) {
        const int k0 = (t / tn) * 64, n0 = (t % tn) * 64;
#pragma unroll 4
        for (int i = 0; i < 16; ++i) { const int row = i * 4 + (lane >> 4), c4 = (lane & 15) * 4;
            const f32x4 v = *(const f32x4*)(src + (size_t)(k0 + row) * N + n0 + c4);
            tile[row * 65 + c4 + 0] = v[0]; tile[row * 65 + c4 + 1] = v[1]; tile[row * 65 + c4 + 2] = v[2]; tile[row * 65 + c4 + 3] = v[3]; }
        __builtin_amdgcn_wave_barrier(); asm volatile("s_waitcnt lgkmcnt(0)" ::: "memory");
#pragma unroll 2
        for (int i = 0; i < 8; ++i) { const int n = i * 8 + (lane >> 3), kc = (lane & 7) * 8;
            float f[8];
#pragma unroll
            for (int j = 0; j < 8; ++j) f[j] = tile[(kc + j) * 65 + n];
            const int ng = n0 + n; const int drow = mode == 0 ? ng : ((ng >> 7) * 256 + (mode == 2 ? 128 : 0) + (ng & 127));
            u32x4 w; w.x = pk_bf16(f[0], f[1]); w.y = pk_bf16(f[2], f[3]); w.z = pk_bf16(f[4], f[5]); w.w = pk_bf16(f[6], f[7]);
            *(u32x4*)(dst + (size_t)drow * K + k0 + kc) = w; }
        __builtin_amdgcn_wave_barrier(); asm volatile("s_waitcnt lgkmcnt(0)" ::: "memory");
    }
}

__device__ __forceinline__ void phase_prologue(const Frame& F, const Params& P) {
    float* modv = (float*)(F.ws + WS_MODV);
    LAS float* s = (LAS float*)F.lds;
    LAS float* red = (LAS float*)(F.lds + 9 * 1024 * 4);
    for (int cb = F.bid; cb < (2 * MODW) / 64; cb += F.G) {
        for (int i = F.tid; i < 9 * 1024; i += NTHREADS) { const int mi = i >> 10, k = i & 1023; const float c = mi < 8 ? P.in[I_C][mi * D + k] : P.in[I_CCTX][k]; s[i] = siluf_(c); }
        __syncthreads();
        const int colg = cb * 64 + F.lane, l = colg / MODW, col = colg % MODW;
        const float* w = P.in[I_MODW] + (size_t)l * D * MODW + col;
        float acc[9];
#pragma unroll
        for (int mi = 0; mi < 9; ++mi) acc[mi] = 0.f;
        const int kb = F.wave * 128;
#pragma unroll 8
        for (int k = 0; k < 128; ++k) { const float wv = w[(size_t)(kb + k) * MODW];
#pragma unroll
            for (int mi = 0; mi < 9; ++mi) acc[mi] += s[mi * 1024 + kb + k] * wv; }
#pragma unroll
        for (int mi = 0; mi < 9; ++mi) red[(F.wave * 9 + mi) * 64 + F.lane] = acc[mi];
        __syncthreads();
        for (int i = F.tid; i < 9 * 64; i += NTHREADS) { const int mi = i >> 6, ln = i & 63; float a = 0.f;
#pragma unroll
            for (int w8 = 0; w8 < 8; ++w8) a += red[(w8 * 9 + mi) * 64 + ln];
            const int cg = cb * 64 + ln, l2 = cg / MODW, c2 = cg % MODW;
            modv[((size_t)l2 * 9 + mi) * MODW + c2] = a + P.in[I_MODB][l2 * MODW + c2]; }
        __syncthreads();
    }
    for (int l = 0; l < 2; ++l) {
        conv_job(F, P.in[I_WIN] + (size_t)l * D * INW, (bf16_t*)(F.ws + WS_BTIN) + (size_t)l * INW * D, D, INW, 0);
        conv_job(F, P.in[I_WOUT] + (size_t)l * D * D, (bf16_t*)(F.ws + WS_BTOUT) + (size_t)l * D * D, D, D, 0);
    }
    conv_job(F, P.in[I_FG], (bf16_t*)(F.ws + WS_BTGU), D, DFF, 1);
    conv_job(F, P.in[I_FU], (bf16_t*)(F.ws + WS_BTGU), D, DFF, 2);
    conv_job(F, P.in[I_FD], (bf16_t*)(F.ws + WS_BTDN), DFF, D, 0);
    for (int ld = 0; ld < 4; ++ld) { bf16_t* base = (bf16_t*)(F.ws + WS_LORA + (size_t)ld * LORA_LD_BYTES);
        conv_job(F, P.in[I_W2] + (size_t)ld * 64 * 256, base, 64, 256, 0);
        conv_job(F, P.in[I_A2] + (size_t)ld * 64 * 256, base + 256 * 64, 64, 256, 0);
        conv_job(F, P.in[I_G2] + (size_t)ld * 128 * 256, base + 2 * 256 * 64, 128, 256, 0); }
}
__device__ __forceinline__ void phase_moe_convert(const Frame& F, const Params& P) {
    for (int e = 0; e < NEXP; ++e) {
        bf16_t* gu = (bf16_t*)(F.ws + WS_MOE + (size_t)e * MOE_E_BYTES); bf16_t* dn = (bf16_t*)(F.ws + WS_MOE + (size_t)e * MOE_E_BYTES + MOE_GU_BYTES);
        conv_job(F, P.in[I_MG] + (size_t)e * D * DFE, gu, D, DFE, 1);
        conv_job(F, P.in[I_MU] + (size_t)e * D * DFE, gu, D, DFE, 2);
        conv_job(F, P.in[I_MD] + (size_t)e * DFE * D, dn, DFE, D, 0);
    }
}

template <bool ROUTER>
__device__ __forceinline__ void phase_norm(const Frame& F, const Params& P, int l, int which, int nrows, const float* srcL, const float* srcC) {
    const float* g = (which == 0 ? P.in[I_N1G] : P.in[I_N2G]) + l * D;
    const float* modv = (const float*)(F.ws + WS_MODV) + (size_t)l * 9 * MODW + (which == 0 ? 0 : 3 * D);
    bf16_t* HL = (bf16_t*)(F.ws + WS_HL);
    LAS float* rt = (LAS float*)F.lds;
    if (ROUTER) {
        for (int i = F.tid; i < D * NEXP; i += NTHREADS) rt[i] = P.in[I_ROUTER][i];
        int* rmap = (int*)(F.ws + WS_ROUTE + RT_RMAP);
        for (int i = F.bid * NTHREADS + F.tid; i < 2 * NROW; i += F.G * NTHREADS) rmap[i] = -1;
        __syncthreads();
    }
    const int lane = F.lane;
    for (int r = F.gw; r < nrows; r += F.nw) {
        const float* xr = r < NLAT ? srcL + (size_t)r * D : srcC + (size_t)(r - NLAT) * D;
        const float* mv = modv + (size_t)row_mi(r) * MODW;
        f32x4 x[4]; float ss = 0.f;
#pragma unroll
        for (int j = 0; j < 4; ++j) { x[j] = *(const f32x4*)(xr + j * 256 + lane * 4); ss += x[j][0] * x[j][0] + x[j][1] * x[j][1] + x[j][2] * x[j][2] + x[j][3] * x[j][3]; }
        ss = wave_sum(ss);
        const float rstd = rsqrtf(ss * (1.0f / D) + 1e-6f);
        float lg[NEXP];
        if (ROUTER) {
#pragma unroll
            for (int e = 0; e < NEXP; ++e) lg[e] = 0.f;
        }
#pragma unroll
        for (int j = 0; j < 4; ++j) { const int c = j * 256 + lane * 4;
            const f32x4 gg = *(const f32x4*)(g + c), sh = *(const f32x4*)(mv + c), sc = *(const f32x4*)(mv + D + c);
            f32x4 y = (x[j] * rstd * gg) * (sc + 1.0f) + sh;
            u32x2 w; w.x = pk_bf16(y[0], y[1]); w.y = pk_bf16(y[2], y[3]);
            *(u32x2*)(HL + (size_t)r * D + c) = w;
            if (ROUTER) {
#pragma unroll
                for (int q = 0; q < 4; ++q) { const f32x4 r0 = *(const LAS f32x4*)(rt + (c + q) * 8), r1 = *(const LAS f32x4*)(rt + (c + q) * 8 + 4);
                    lg[0] += y[q] * r0[0]; lg[1] += y[q] * r0[1]; lg[2] += y[q] * r0[2]; lg[3] += y[q] * r0[3];
                    lg[4] += y[q] * r1[0]; lg[5] += y[q] * r1[1]; lg[6] += y[q] * r1[2]; lg[7] += y[q] * r1[3]; asm volatile("" ::: "memory"); }
            }
        }
        if (ROUTER) {
#pragma unroll
            for (int e = 0; e < NEXP; ++e) lg[e] = wave_sum(lg[e]);
            if (lane == 0) {
                int e1 = 0; float l1 = lg[0];
#pragma unroll
                for (int e = 1; e < NEXP; ++e) if (lg[e] > l1) { l1 = lg[e]; e1 = e; }
                int e2 = -1; float l2 = -3.0e38f;
#pragma unroll
                for (int e = 0; e < NEXP; ++e) if (e != e1 && lg[e] > l2) { l2 = lg[e]; e2 = e; }
                if (e2 < 0) { e2 = e1 == 0 ? 1 : 0; l2 = l1; }
                const float ex = __expf(l2 - l1), g1 = 1.0f / (1.0f + ex), g2 = ex * g1;
                unsigned* cnt = (unsigned*)(F.ws + WS_CTL) + CW_MOECNT;
                const unsigned p1 = atomicAdd(cnt + e1, 1u), p2 = atomicAdd(cnt + 8 + e2, 1u);
                int* te = (int*)(F.ws + WS_ROUTE + RT_TOKE); float* tg = (float*)(F.ws + WS_ROUTE + RT_TOKG); int* tp = (int*)(F.ws + WS_ROUTE + RT_TOKP);
                te[r * 2] = e1; te[r * 2 + 1] = e2; tg[r * 2] = g1; tg[r * 2 + 1] = g2; tp[r * 2] = (int)p1; tp[r * 2 + 1] = (int)p2;
            }
        }
    }
}
__device__ __forceinline__ void moe_tstart(const Frame& F, int pass, int (&ts)[9]) {
    const unsigned* cnt = (const unsigned*)(F.ws + WS_CTL) + CW_MOECNT + pass * 8;
    int a = 0;
#pragma unroll
    for (int e = 0; e < 8; ++e) { ts[e] = a; a += (int)((__hip_atomic_load(cnt + e, __ATOMIC_RELAXED, __HIP_MEMORY_SCOPE_AGENT) + 255u) >> 8); }
    ts[8] = a;
}
__device__ __forceinline__ void phase_moe_rowmap(const Frame& F) {
    int ts0[9], ts1[9]; moe_tstart(F, 0, ts0); moe_tstart(F, 1, ts1);
    const int* te = (const int*)(F.ws + WS_ROUTE + RT_TOKE); const float* tg = (const float*)(F.ws + WS_ROUTE + RT_TOKG); const int* tp = (const int*)(F.ws + WS_ROUTE + RT_TOKP);
    int* rmap = (int*)(F.ws + WS_ROUTE + RT_RMAP); float* sg = (float*)(F.ws + WS_ROUTE + RT_SGATE);
    for (int t = F.bid * NTHREADS + F.tid; t < NLAT; t += F.G * NTHREADS) {
        { const int e = te[t * 2]; int st = 0;
#pragma unroll
          for (int j = 0; j < 8; ++j) st = (e == j) ? ts0[j] : st;
          const int slot = st * 256 + tp[t * 2]; rmap[slot] = t; sg[slot] = tg[t * 2]; }
        { const int e = te[t * 2 + 1]; int st = 0;
#pragma unroll
          for (int j = 0; j < 8; ++j) st = (e == j) ? ts1[j] : st;
          const int slot = st * 256 + tp[t * 2 + 1]; rmap[NROW + slot] = t; sg[NROW + slot] = tg[t * 2 + 1]; }
    }
}

struct RowGeo { int b, tt, pos, len; };
__device__ __forceinline__ RowGeo row_geo(int r) { RowGeo g; if (r < NLAT) { g.b = r >> 12; g.pos = r & 4095; g.len = SEQ; g.tt = CTXL + g.pos; } else { const int q = r - NLAT; g.b = q >> 8; g.pos = q & 255; g.len = CTXL; g.tt = g.pos; } return g; }

__device__ __forceinline__ void rw_shift4(const bf16_t* PL, const float* mup, const float* mun, int r, const RowGeo& g, int j, float (&u)[4]) {
    const bf16_t* p = PL + (size_t)r * INW + O_RW + j;
    const bool hp = g.pos > 0, hn = g.pos < g.len - 1;
    float c[4], pv[4], nv[4];
    unpack4(*(const u32x2*)p, c); unpack4(*(const u32x2*)(p - (hp ? INW : 0)), pv); unpack4(*(const u32x2*)(p + (hn ? INW : 0)), nv);
    const f32x4 mp = *(const f32x4*)(mup + j), mn = *(const f32x4*)(mun + j);
#pragma unroll
    for (int q = 0; q < 4; ++q) u[q] = c[q] + mp[q] * ((hp ? pv[q] : 0.f) - c[q]) + mn[q] * ((hn ? nv[q] : 0.f) - c[q]);
}

__device__ __forceinline__ void rw_shift8(const bf16_t* PL, const float* mup, const float* mun, int r, const RowGeo& g, int j, float (&u)[8]) {
    const bf16_t* p = PL + (size_t)r * INW + O_RW + j;
    const bool hp = g.pos > 0, hn = g.pos < g.len - 1;
    float c[8], pv[8], nv[8];
    unpack8(*(const u32x4*)p, c); unpack8(*(const u32x4*)(p - (hp ? INW : 0)), pv); unpack8(*(const u32x4*)(p + (hn ? INW : 0)), nv);
    const f32x4 mp0 = *(const f32x4*)(mup + j), mp1 = *(const f32x4*)(mup + j + 4), mn0 = *(const f32x4*)(mun + j), mn1 = *(const f32x4*)(mun + j + 4);
#pragma unroll
    for (int q = 0; q < 4; ++q) { u[q] = c[q] + mp0[q] * ((hp ? pv[q] : 0.f) - c[q]) + mn0[q] * ((hn ? nv[q] : 0.f) - c[q]);
        u[4 + q] = c[4 + q] + mp1[q] * ((hp ? pv[4 + q] : 0.f) - c[4 + q]) + mn1[q] * ((hn ? nv[4 + q] : 0.f) - c[4 + q]); }
}
__device__ __forceinline__ bf16x8 pack8f(const float (&f)[8]) {
    u32x4 w; w.x = cvt_pk_bf16(f[0], f[1]); w.y = cvt_pk_bf16(f[2], f[3]); w.z = cvt_pk_bf16(f[4], f[5]); w.w = cvt_pk_bf16(f[6], f[7]); return __builtin_bit_cast(bf16x8, w);
}
constexpr int RL_MUP = 0, RL_MUN = 5120, RL_KK = 10240, RL_KA = 11264, RL_W0 = 12288, RL_A0 = 14336, RL_RK = 16384, RL_GNG = 17408, RL_GNB = 18432, RL_END = 19456;
__device__ __forceinline__ void rw_stage_tables(const Frame& F, const Params& P, int l) {
    LAS float* T = (LAS float*)F.lds;
    for (int i = F.tid; i < 1280; i += NTHREADS) { T[RL_MUP / 4 + i] = P.in[I_MUP][l * 1280 + i]; T[RL_MUN / 4 + i] = P.in[I_MUN][l * 1280 + i]; }
    for (int i = F.tid; i < 256; i += NTHREADS) { T[RL_KK / 4 + i] = P.in[I_KK][l * 256 + i]; T[RL_KA / 4 + i] = P.in[I_KA][l * 256 + i]; T[RL_RK / 4 + i] = P.in[I_RK][l * 256 + i];
        T[RL_GNG / 4 + i] = P.in[I_GNG][l * 256 + i]; T[RL_GNB / 4 + i] = P.in[I_GNB][l * 256 + i]; }
    for (int i = F.tid; i < 512; i += NTHREADS) { T[RL_W0 / 4 + i] = P.in[I_W0][l * 512 + i]; T[RL_A0 / 4 + i] = P.in[I_A0][l * 512 + i]; }
    __syncthreads();
}
__device__ __forceinline__ void rw_mix8(const LAS float* T, const u32x4 (&raw)[3], bool hp, bool hn, int j, float (&u)[8]) {
    float c[8], pv[8], nv[8]; unpack8(raw[0], c); unpack8(raw[1], pv); unpack8(raw[2], nv);
    const f32x4 mp0 = *(const LAS f32x4*)(T + RL_MUP / 4 + j), mp1 = *(const LAS f32x4*)(T + RL_MUP / 4 + j + 4), mn0 = *(const LAS f32x4*)(T + RL_MUN / 4 + j), mn1 = *(const LAS f32x4*)(T + RL_MUN / 4 + j + 4);
#pragma unroll
    for (int q = 0; q < 4; ++q) { u[q] = c[q] + mp0[q] * ((hp ? pv[q] : 0.f) - c[q]) + mn0[q] * ((hn ? nv[q] : 0.f) - c[q]);
        u[4 + q] = c[4 + q] + mp1[q] * ((hp ? pv[4 + q] : 0.f) - c[4 + q]) + mn1[q] * ((hn ? nv[4 + q] : 0.f) - c[4 + q]); }
}
__device__ __forceinline__ void rw_mix4(const LAS float* T, const u32x2 (&raw)[3], bool hp, bool hn, int j, float (&u)[4]) {
    float c[4], pv[4], nv[4]; unpack4(raw[0], c); unpack4(raw[1], pv); unpack4(raw[2], nv);
    const f32x4 mp = *(const LAS f32x4*)(T + RL_MUP / 4 + j), mn = *(const LAS f32x4*)(T + RL_MUN / 4 + j);
#pragma unroll
    for (int q = 0; q < 4; ++q) u[q] = c[q] + mp[q] * ((hp ? pv[q] : 0.f) - c[q]) + mn[q] * ((hn ? nv[q] : 0.f) - c[q]);
}
__device__ __forceinline__ void phase_rw_prep(const Frame& F, const Params& P, int l) {
    const bf16_t* PL = (const bf16_t*)(F.ws + WS_PL);
    f16_t* SH = (f16_t*)(F.ws + WS_SH); f16_t* SD = (f16_t*)(F.ws + WS_SD);
    const int lane = F.lane;
    rw_stage_tables(F, P, l);
    const LAS float* T = (const LAS float*)F.lds;
    for (int item = F.gw; item < NLAT / 16 + (NCTX / 16) * 4; item += F.nw) {
        const int tile = item < NLAT / 16 ? item : NLAT / 16 + ((item - NLAT / 16) >> 2), h0 = item < NLAT / 16 ? 0 : ((item - NLAT / 16) & 3), h1 = item < NLAT / 16 ? 4 : h0 + 1;
        int l1 = lane; asm volatile("" : "+v"(l1)); const int tk = l1 & 15, g = l1 >> 4;
        const int r = tile * 16 + tk; const RowGeo geo = row_geo(r);
        const bool hp = geo.pos > 0, hn = geo.pos < geo.len - 1;
        const bf16_t* prow = PL + (size_t)r * INW + O_RW; const int dprev = hp ? -INW : 0, dnext = hn ? INW : 0;
        bf16x8 tw[2][2], ta[2][2];
#pragma unroll
        for (int d = 0; d < 2; ++d) { u32x4 raw[4][3];
#pragma unroll
          for (int i = 0; i < 4; ++i) { const bf16_t* p = prow + 768 + 256 * d + 64 * (i & 1) + 32 * (i >> 1) + 8 * g;
              raw[i][0] = *(const u32x4*)p; raw[i][1] = *(const u32x4*)(p + dprev); raw[i][2] = *(const u32x4*)(p + dnext); }
#pragma unroll
          for (int i = 0; i < 4; ++i) { float u[8]; rw_mix8(T, raw[i], hp, hn, 768 + 256 * d + 64 * (i & 1) + 32 * (i >> 1) + 8 * g, u);
              if ((i & 1) == 0) {
#pragma unroll
                  for (int q = 0; q < 8; ++q) u[q] = 1.0f - 2.0f / (1.0f + __expf(2.0f * u[q]));
                  tw[d][i >> 1] = pack8f(u); }
              else ta[d][i >> 1] = pack8f(u); }
          asm volatile("" ::: "memory"); }
        asm volatile("" ::: "memory");
#pragma unroll 1
        for (int h = h0; h < h1; ++h) {
            int l2 = lane; asm volatile("" : "+v"(l2)); const int tk = l2 & 15, g = l2 >> 4;
            const int r = tile * 16 + tk; const RowGeo geo = row_geo(r);
            const bool hp = geo.pos > 0, hn = geo.pos < geo.len - 1;
            const bf16_t* prow = PL + (size_t)r * INW + O_RW + 64 * h + 8 * g; const int dprev = hp ? -INW : 0, dnext = hn ? INW : 0;
            float ur[4][4], uk[4][4], uv[4][4], kkv[4][4]; float ss = 0.f;
            { u32x4 raw[6][3];
#pragma unroll
              for (int i = 0; i < 6; ++i) { const bf16_t* p = prow + 256 * (i >> 1) + 32 * (i & 1);
                  raw[i][0] = *(const u32x4*)p; raw[i][1] = *(const u32x4*)(p + dprev); raw[i][2] = *(const u32x4*)(p + dnext); }
#pragma unroll
              for (int u = 0; u < 2; ++u) { float x8[8]; const int c = 64 * h + 32 * u + 8 * g;
                  rw_mix8(T, raw[u], hp, hn, c, x8);
#pragma unroll
                  for (int e = 0; e < 8; ++e) ur[2 * u + (e >> 2)][e & 3] = x8[e];
                  rw_mix8(T, raw[2 + u], hp, hn, 256 + c, x8);
#pragma unroll
                  for (int e = 0; e < 8; ++e) uk[2 * u + (e >> 2)][e & 3] = x8[e];
                  rw_mix8(T, raw[4 + u], hp, hn, 512 + c, x8);
#pragma unroll
                  for (int e = 0; e < 8; ++e) uv[2 * u + (e >> 2)][e & 3] = x8[e];
                  const f32x4 k0 = *(const LAS f32x4*)(T + RL_KK / 4 + c), k1 = *(const LAS f32x4*)(T + RL_KK / 4 + c + 4);
#pragma unroll
                  for (int q = 0; q < 4; ++q) { kkv[2 * u][q] = uk[2 * u][q] * k0[q]; kkv[2 * u + 1][q] = uk[2 * u + 1][q] * k1[q]; ss += kkv[2 * u][q] * kkv[2 * u][q] + kkv[2 * u + 1][q] * kkv[2 * u + 1][q]; } } }
            ss += __shfl_xor(ss, 16); ss += __shfl_xor(ss, 32);
            const float rn = rsqrtf(ss + 1e-12f);
            const size_t shrow = ((size_t)(geo.b * 4 + h) * TT + geo.tt) * 192;
#pragma unroll
            for (int u = 0; u < 2; ++u) { f16x8 o1, o2, o3;
#pragma unroll
                for (int e = 0; e < 8; ++e) { const int t = 2 * u + (e >> 2), q = e & 3; kkv[t][q] *= rn; o1[e] = (f16_t)ur[t][q]; o2[e] = (f16_t)uv[t][q]; o3[e] = (f16_t)(-kkv[t][q]); }
                f16_t* sp = SH + shrow + 32 * u + 8 * g; *(f16x8*)sp = o1; *(f16x8*)(sp + 64) = o2; *(f16x8*)(sp + 128) = o3; }
#pragma unroll 1
            for (int d = 0; d < 2; ++d) {
                const bf16_t* w2t = (const bf16_t*)(F.ws + WS_LORA + (size_t)(l * 2 + d) * LORA_LD_BYTES); const bf16_t* a2t = w2t + 256 * 64;
                const size_t sdrow = ((size_t)((d * 8 + geo.b) * 4 + h) * TT + geo.tt) * 192;
                const bf16x8 tw0 = d ? tw[1][0] : tw[0][0], tw1 = d ? tw[1][1] : tw[0][1], ta0 = d ? ta[1][0] : ta[0][0], ta1 = d ? ta[1][1] : ta[0][1];
                bf16x8 wf[4][2], af[4][2];
#pragma unroll
                for (int t = 0; t < 4; ++t) { const int wrow = 64 * h + 32 * (t >> 1) + 8 * (tk >> 2) + 4 * (t & 1) + (tk & 3);
                    const bf16_t* wr = w2t + (size_t)wrow * 64 + 8 * g; const bf16_t* ar = a2t + (size_t)wrow * 64 + 8 * g;
                    wf[t][0] = *(const bf16x8*)wr; wf[t][1] = *(const bf16x8*)(wr + 32); af[t][0] = *(const bf16x8*)ar; af[t][1] = *(const bf16x8*)(ar + 32); }
                f16x8 o1[2], o2[2], o3[2];
#pragma unroll
                for (int t = 0; t < 4; ++t) { const int c = 64 * h + 32 * (t >> 1) + 8 * g + 4 * (t & 1);
                    f32x4 xw = *(const LAS f32x4*)(T + RL_W0 / 4 + d * 256 + c), xa = *(const LAS f32x4*)(T + RL_A0 / 4 + d * 256 + c);
                    xw = __builtin_amdgcn_mfma_f32_16x16x32_bf16(wf[t][0], tw0, xw, 0, 0, 0); xw = __builtin_amdgcn_mfma_f32_16x16x32_bf16(wf[t][1], tw1, xw, 0, 0, 0);
                    xa = __builtin_amdgcn_mfma_f32_16x16x32_bf16(af[t][0], ta0, xa, 0, 0, 0); xa = __builtin_amdgcn_mfma_f32_16x16x32_bf16(af[t][1], ta1, xa, 0, 0, 0);
                    const f32x4 kaw = *(const LAS f32x4*)(T + RL_KA / 4 + c);
#pragma unroll
                    for (int q = 0; q < 4; ++q) {
                        const float nx = -xw[q]; const float sp = fmaxf(nx, 0.f) + __logf(1.0f + __expf(-fabsf(nx)));
                        const float e = __expf(-sp - 0.5f);
                        const float omw = 1.0f - __expf(-e);
                        const float a = sigmoidf_(xa[q]);
                        o1[t >> 1][(t & 1) * 4 + q] = (f16_t)omw; o2[t >> 1][(t & 1) * 4 + q] = (f16_t)(uk[t][q] * (1.0f + (a - 1.0f) * kaw[q])); o3[t >> 1][(t & 1) * 4 + q] = (f16_t)(kkv[t][q] * a); } }
#pragma unroll
                for (int u = 0; u < 2; ++u) { f16_t* sp = SD + sdrow + 32 * u + 8 * g; *(f16x8*)sp = o1[u]; *(f16x8*)(sp + 64) = o2[u]; *(f16x8*)(sp + 128) = o3[u]; }
                asm volatile("" ::: "memory");
            }
        }
    }
    __syncthreads();
}

constexpr int CS_ZP = 0, CS_RPP = 2048, CS_BH = 4096, CS_KH = 6144, CS_VV = 8192, CS_MT = 10240, CS_NT = 11264, CS_WC = 12288, CS_SLOT = 12544;
constexpr int CS_ZIMG = 8 * CS_SLOT;
constexpr int CS_NCHUNK = TT / 16;
__device__ __forceinline__ int cs_tt(int d, int q, int s) { const int st = 16 * q + s; return d == 0 ? st : (st < CTXL ? CTXL - 1 - st : TT + CTXL - 1 - st); }
__device__ __forceinline__ float dpp_shr(float old, float v, int) { return v; }
template <int N> __device__ __forceinline__ float row_shr(float v, float old) {
    return __builtin_bit_cast(float, __builtin_amdgcn_update_dpp(__builtin_bit_cast(int, old), __builtin_bit_cast(int, v), 0x110 + N, 0xF, 0xF, false));
}
__device__ __forceinline__ bf16x8 cs_pack(const float (&a)[4], const float (&b)[4]) {
    u32x4 w; w.x = cvt_pk_bf16(a[0], a[1]); w.y = cvt_pk_bf16(a[2], a[3]); w.z = cvt_pk_bf16(b[0], b[1]); w.w = cvt_pk_bf16(b[2], b[3]); return __builtin_bit_cast(bf16x8, w);
}
__device__ __forceinline__ bf16x8 cs_op16(const f32x4& x) { u32x4 w; w.x = cvt_pk_bf16(x[0], x[1]); w.y = cvt_pk_bf16(x[2], x[3]); w.z = 0u; w.w = 0u; return __builtin_bit_cast(bf16x8, w); }
#define CS_MFMA(a, b, c) __builtin_amdgcn_mfma_f32_16x16x32_bf16((a), (b), (c), 0, 0, 0)
__device__ __forceinline__ f32x4 cs_mm16(const f32x4& xt_d, const f32x4& y_d) { return CS_MFMA(cs_op16(xt_d), cs_op16(y_d), ((f32x4){0.f, 0.f, 0.f, 0.f})); }
__device__ __forceinline__ v4i16_t cs_tr(const LAS unsigned char* img, int lane, int T) {
    const int g = lane >> 4, q = (lane & 15) >> 2, p = lane & 3;
    return __builtin_amdgcn_ds_read_tr16_b64_v4i16((LAS v4i16_t*)(img + (4 * g + q) * 128 + p * 32 + (T >> 1) * 16 + (T & 1) * 8));
}
__device__ __forceinline__ bf16x8 cs_lo(v4i16_t x) { bf16x8 r; r[0] = x[0]; r[1] = x[1]; r[2] = x[2]; r[3] = x[3]; r[4] = 0; r[5] = 0; r[6] = 0; r[7] = 0; return r; }

struct CsRaw { u32x2 x[4], z[4], r[4], b[4], k[4], v[4]; };
__device__ __forceinline__ void cs_load(CsRaw& R, const f16_t* sh, const f16_t* sd, int d, int q, int lane) {
    const int s = lane & 15, g = lane >> 4; const int tt = cs_tt(d, q, s);
    const f16_t* shp = sh + (size_t)tt * 192 + 4 * g; const f16_t* sdp = sd + (size_t)tt * 192 + 4 * g;
#pragma unroll
    for (int T = 0; T < 4; ++T) { R.x[T] = *(const u32x2*)(sdp + 16 * T); R.z[T] = *(const u32x2*)(shp + 128 + 16 * T); R.r[T] = *(const u32x2*)(shp + 16 * T);
        R.b[T] = *(const u32x2*)(sdp + 128 + 16 * T); R.k[T] = *(const u32x2*)(sdp + 64 + 16 * T); R.v[T] = *(const u32x2*)(shp + 64 + 16 * T); }
}
__device__ __forceinline__ void cs_prepass(LAS unsigned char* slot, LAS unsigned char* zimg, CsRaw& raw, const f16_t* sh, const f16_t* sd, int d, int qn, int lane) {
    const int s = lane & 15, g = lane >> 4;
    float Wc[4][4], Wp[4][4], iW[4][4];
#pragma unroll
    for (int T = 0; T < 4; ++T) { const f16x4 x4 = __builtin_bit_cast(f16x4, raw.x[T]);
#pragma unroll
        for (int j = 0; j < 4; ++j) { float wc = 1.0f - (float)x4[j];
            wc *= row_shr<1>(wc, 1.0f); wc *= row_shr<2>(wc, 1.0f); wc *= row_shr<4>(wc, 1.0f); wc *= row_shr<8>(wc, 1.0f);
            Wc[T][j] = wc; Wp[T][j] = row_shr<1>(wc, 1.0f); iW[T][j] = __builtin_amdgcn_rcpf(wc); } }
    if (s == 15) {
#pragma unroll
        for (int T = 0; T < 4; ++T) *(LAS f32x4*)(slot + CS_WC + (16 * T + 4 * g) * 4) = (f32x4){Wc[T][0], Wc[T][1], Wc[T][2], Wc[T][3]}; }
    bf16x8 oZ[2], oR[2], oB[2], oK[2];
    const int ioff = s * 128 + g * 32;
#define CS_STAGE(dst, SRC, SC, IMG) do { float t_[4][4]; \
        _Pragma("unroll") for (int T = 0; T < 4; ++T) { const f16x4 q4 = __builtin_bit_cast(f16x4, SRC[T]); \
            _Pragma("unroll") for (int j = 0; j < 4; ++j) t_[T][j] = (float)q4[j] * SC; } \
        _Pragma("unroll") for (int kk = 0; kk < 2; ++kk) { dst[kk] = cs_pack(t_[2 * kk], t_[2 * kk + 1]); if (IMG) *(LAS bf16x8*)((IMG) + ioff + kk * 16) = dst[kk]; } \
        } while (0)
    CS_STAGE(oZ, raw.z, Wp[T][j], zimg);
    CS_STAGE(oR, raw.r, Wc[T][j], (LAS unsigned char*)nullptr);
    CS_STAGE(oB, raw.b, iW[T][j], slot + CS_BH);
    CS_STAGE(oK, raw.k, iW[T][j], slot + CS_KH);
    { bf16x8 oV[2]; CS_STAGE(oV, raw.v, 1.0f, slot + CS_VV); }
#undef CS_STAGE
    asm volatile("" ::: "memory");
    if (qn >= 0) cs_load(raw, sh, sd, d, qn, lane);
    const f32x4 zero4 = (f32x4){0.f, 0.f, 0.f, 0.f};
    f32x4 A_D = CS_MFMA(oB[1], oZ[1], CS_MFMA(oB[0], oZ[0], zero4)), AT_D = CS_MFMA(oZ[1], oB[1], CS_MFMA(oZ[0], oB[0], zero4));
    f32x4 BkT_D = CS_MFMA(oZ[1], oK[1], CS_MFMA(oZ[0], oK[0], zero4));
    f32x4 Ar_D = CS_MFMA(oB[1], oR[1], CS_MFMA(oB[0], oR[0], zero4)), Kr_D = CS_MFMA(oK[1], oR[1], CS_MFMA(oK[0], oR[0], zero4));
    f32x4 I_D;
#pragma unroll
    for (int j = 0; j < 4; ++j) { const int m = 4 * g + j;
        A_D[j] = m < s ? A_D[j] : 0.f; AT_D[j] = s < m ? AT_D[j] : 0.f; BkT_D[j] = s < m ? BkT_D[j] : 0.f;
        Ar_D[j] = m <= s ? Ar_D[j] : 0.f; Kr_D[j] = m <= s ? Kr_D[j] : 0.f; I_D[j] = m == s ? 1.f : 0.f; }
    f32x4 Ab, AbT, A1, A2m;
#pragma unroll
    for (int j = 0; j < 4; ++j) { const int m = 4 * g + j; const bool b0 = (m >> 2) == (s >> 2), b1 = (m >> 3) == (s >> 3);
        Ab[j] = b0 ? A_D[j] : 0.f; AbT[j] = b0 ? AT_D[j] : 0.f; A1[j] = (b1 && !b0) ? A_D[j] : 0.f; A2m[j] = b1 ? 0.f : A_D[j]; }
    const f32x4 Ab2 = cs_mm16(AbT, Ab), Ab2T = cs_mm16(Ab, AbT);
    const f32x4 P0 = I_D + Ab, P0T = I_D + AbT;
    const f32x4 T0 = P0 + cs_mm16(P0T, Ab2), T0T = P0T + cs_mm16(Ab2, P0T);
    (void)Ab2T;
    const f32x4 ZT = cs_mm16(A1, T0T);
    const f32x4 T1 = T0 + cs_mm16(ZT, T0), T1T = T0T + cs_mm16(T0, ZT);
    const f32x4 Z2T = cs_mm16(A2m, T1T);
    const f32x4 T_D = T1 + cs_mm16(Z2T, T1);
    const f32x4 M_D = cs_mm16(BkT_D, T_D), MT_D = cs_mm16(T_D, BkT_D);
    const f32x4 N_D = cs_mm16(MT_D, Ar_D) + Kr_D;
    { u32x4 w; w.x = cvt_pk_bf16(M_D[0], M_D[1]); w.y = cvt_pk_bf16(M_D[2], M_D[3]); w.z = 0u; w.w = 0u; *(LAS u32x4*)(slot + CS_MT + s * 64 + g * 16) = w;
      w.x = cvt_pk_bf16(N_D[0], N_D[1]); w.y = cvt_pk_bf16(N_D[2], N_D[3]); *(LAS u32x4*)(slot + CS_NT + s * 64 + g * 16) = w; }
    __builtin_amdgcn_wave_barrier(); asm volatile("" ::: "memory");
    const bf16x8 oT = cs_op16(T_D), oAr = cs_op16(Ar_D);
    float Zp[4][4];
#pragma unroll
    for (int T = 0; T < 4; ++T) { const f32x4 zp = CS_MFMA(cs_lo(cs_tr(zimg, lane, T)), oT, zero4);
#pragma unroll
        for (int j = 0; j < 4; ++j) Zp[T][j] = zp[j]; }
#pragma unroll
    for (int kk = 0; kk < 2; ++kk) *(LAS bf16x8*)(slot + CS_ZP + s * 128 + g * 32 + kk * 16) = cs_pack(Zp[2 * kk], Zp[2 * kk + 1]);
    __builtin_amdgcn_wave_barrier(); asm volatile("" ::: "memory");
    float Rp[4][4];
#pragma unroll
    for (int T = 0; T < 4; ++T) { const f32x4 rp = CS_MFMA(cs_lo(cs_tr(slot + CS_ZP, lane, T)), oAr, zero4);
#pragma unroll
        for (int j = 0; j < 4; ++j) Rp[T][j] = rp[j] + bf2f((bf16_t)oR[T >> 1][(T & 1) * 4 + j]); }
#pragma unroll
    for (int kk = 0; kk < 2; ++kk) *(LAS bf16x8*)(slot + CS_RPP + s * 128 + g * 32 + kk * 16) = cs_pack(Rp[2 * kk], Rp[2 * kk + 1]);
}
__device__ __forceinline__ void cs_scan_chunk(const LAS unsigned char* slot, f32x4 (&acc)[4], float* yp  , int d, int q, int wave, int lane) {
    const int s = lane & 15, g = lane >> 4;
    const f32x4 zero4 = (f32x4){0.f, 0.f, 0.f, 0.f};
    bf16x8 Xb[2];
#pragma unroll
    for (int kk = 0; kk < 2; ++kk) { u32x4 w; w.x = cvt_pk_bf16(acc[2 * kk][0], acc[2 * kk][1]); w.y = cvt_pk_bf16(acc[2 * kk][2], acc[2 * kk][3]);
        w.z = cvt_pk_bf16(acc[2 * kk + 1][0], acc[2 * kk + 1][1]); w.w = cvt_pk_bf16(acc[2 * kk + 1][2], acc[2 * kk + 1][3]); Xb[kk] = __builtin_bit_cast(bf16x8, w); }
    const v4i16_t vt = cs_tr(slot + CS_VV, lane, wave);
    const bf16x8 Vb = cs_lo(vt);
    const int arow = s * 128 + g * 32, a16 = s * 64 + g * 16;
    f32x4 UT = CS_MFMA(*(const LAS bf16x8*)(slot + CS_MT + a16), Vb, zero4);
    UT = CS_MFMA(*(const LAS bf16x8*)(slot + CS_ZP + arow), Xb[0], UT); UT = CS_MFMA(*(const LAS bf16x8*)(slot + CS_ZP + arow + 16), Xb[1], UT);
    f32x4 YT = CS_MFMA(*(const LAS bf16x8*)(slot + CS_NT + a16), Vb, zero4); YT = CS_MFMA(*(const LAS bf16x8*)(slot + CS_RPP + arow), Xb[0], YT); YT = CS_MFMA(*(const LAS bf16x8*)(slot + CS_RPP + arow + 16), Xb[1], YT);
#pragma unroll
    for (int j = 0; j < 4; ++j) yp[(size_t)cs_tt(d, q, 4 * g + j) * 256] = YT[j];
    bf16x8 UV; { u32x2 w; w.x = cvt_pk_bf16(UT[0], UT[1]); w.y = cvt_pk_bf16(UT[2], UT[3]); const v4i16_t ub = __builtin_bit_cast(v4i16_t, w);
        UV[0] = ub[0]; UV[1] = ub[1]; UV[2] = ub[2]; UV[3] = ub[3]; UV[4] = vt[0]; UV[5] = vt[1]; UV[6] = vt[2]; UV[7] = vt[3]; }
#pragma unroll
    for (int T = 0; T < 4; ++T) { const v4i16_t bh = cs_tr(slot + CS_BH, lane, T), kh = cs_tr(slot + CS_KH, lane, T);
        bf16x8 BK; BK[0] = bh[0]; BK[1] = bh[1]; BK[2] = bh[2]; BK[3] = bh[3]; BK[4] = kh[0]; BK[5] = kh[1]; BK[6] = kh[2]; BK[7] = kh[3];
        acc[T] = CS_MFMA(BK, UV, acc[T]);
        acc[T] *= *(const LAS f32x4*)(slot + CS_WC + (16 * T + 4 * g) * 4); }
}
__device__ __forceinline__ void phase_scan(const Frame& F) {
    const f16_t* SH = (const f16_t*)(F.ws + WS_SH); const f16_t* SD = (const f16_t*)(F.ws + WS_SD);
    float* Y = (float*)(F.ws + WS_Y);
    const int lane = F.lane, wave = F.wave;
    for (int chain = F.bid; chain < 64; chain += F.G) {
        const int d = chain >> 5, b = (chain >> 2) & 7, h = chain & 3;
        const f16_t* sh = SH + (size_t)(b * 4 + h) * TT * 192; const f16_t* sd = SD + (size_t)((d * 8 + b) * 4 + h) * TT * 192;
        float* yp = Y + ((size_t)(d * 8 + b) * TT) * 256 + h * 64 + 16 * (wave & 3) + (lane & 15);
        f32x4 acc[4];
#pragma unroll
        for (int T = 0; T < 4; ++T) acc[T] = (f32x4){0.f, 0.f, 0.f, 0.f};
        __syncthreads();
        CsRaw raw;
        constexpr int NR = CS_NCHUNK / 8;
        cs_load(raw, sh, sd, d, wave, lane);
        for (int R = 0; R < NR; ++R) {
            cs_prepass(F.lds + wave * CS_SLOT, F.lds + CS_ZIMG + wave * 2048, raw, sh, sd, d, (R + 1 < NR) ? 8 * (R + 1) + wave : -1, lane);
            asm volatile("s_waitcnt lgkmcnt(0)" ::: "memory"); __builtin_amdgcn_s_barrier(); asm volatile("" ::: "memory");
            if (wave < 4) {
#pragma unroll 1
                for (int c8 = 0; c8 < 8; ++c8) cs_scan_chunk(F.lds + c8 * CS_SLOT, acc, yp, d, 8 * R + c8, wave, lane);
            }
            asm volatile("s_waitcnt lgkmcnt(0)" ::: "memory"); __builtin_amdgcn_s_barrier(); asm volatile("" ::: "memory");
        }
    }
}

__device__ __forceinline__ void phase_rw_post(const Frame& F, const Params& P, int l, int nrows) {
    const bf16_t* PL = (const bf16_t*)(F.ws + WS_PL); bf16_t* MIX = (bf16_t*)(F.ws + WS_MIX);
    const f16_t* SH = (const f16_t*)(F.ws + WS_SH); const f16_t* SD = (const f16_t*)(F.ws + WS_SD); const float* Y = (const float*)(F.ws + WS_Y);
    const int lane = F.lane;
    rw_stage_tables(F, P, l);
    const LAS float* T = (const LAS float*)F.lds;
    for (int item = F.gw; item < NLAT / 16 + ((nrows - NLAT) / 16) * 4; item += F.nw) {
        const int tile = item < NLAT / 16 ? item : NLAT / 16 + ((item - NLAT / 16) >> 2), h0 = item < NLAT / 16 ? 0 : ((item - NLAT / 16) & 3), h1 = item < NLAT / 16 ? 4 : h0 + 1;
        int l1 = lane; asm volatile("" : "+v"(l1)); const int tk = l1 & 15, g = l1 >> 4;
        const int r = tile * 16 + tk; const RowGeo geo = row_geo(r);
        const bool hp = geo.pos > 0, hn = geo.pos < geo.len - 1;
        const bf16_t* prow = PL + (size_t)r * INW + O_RW; const int dprev = hp ? -INW : 0, dnext = hn ? INW : 0;
        bf16x8 sg[2][4];
#pragma unroll
        for (int d = 0; d < 2; ++d) { u32x4 raw[4][3];
#pragma unroll
            for (int kk = 0; kk < 4; ++kk) { const bf16_t* p = prow + 896 + 256 * d + 32 * kk + 8 * g;
                raw[kk][0] = *(const u32x4*)p; raw[kk][1] = *(const u32x4*)(p + dprev); raw[kk][2] = *(const u32x4*)(p + dnext); }
#pragma unroll
            for (int kk = 0; kk < 4; ++kk) { float u[8]; rw_mix8(T, raw[kk], hp, hn, 896 + 256 * d + 32 * kk + 8 * g, u);
#pragma unroll
                for (int q = 0; q < 8; ++q) u[q] = sigmoidf_(u[q]);
                sg[d][kk] = pack8f(u); }
            asm volatile("" ::: "memory"); }
#pragma unroll 1
        for (int h = h0; h < h1; ++h) {
            int l2 = lane; asm volatile("" : "+v"(l2)); const int tk = l2 & 15, g = l2 >> 4;
            const int r = tile * 16 + tk; const RowGeo geo = row_geo(r);
            const size_t shrow = ((size_t)(geo.b * 4 + h) * TT + geo.tt) * 192;
            float out[4][4];
#pragma unroll
            for (int t = 0; t < 4; ++t)
#pragma unroll
                for (int q = 0; q < 4; ++q) out[t][q] = 0.f;
            f16x8 rh[2], vh[2];
#pragma unroll
            for (int u = 0; u < 2; ++u) { rh[u] = *(const f16x8*)(SH + shrow + 32 * u + 8 * g); vh[u] = *(const f16x8*)(SH + shrow + 64 + 32 * u + 8 * g); }
#pragma unroll 1
            for (int d = 0; d < 2; ++d) {
                const bf16_t* g2t = (const bf16_t*)(F.ws + WS_LORA + (size_t)(l * 2 + d) * LORA_LD_BYTES) + 2 * 256 * 64;
                const size_t sdrow = ((size_t)((d * 8 + geo.b) * 4 + h) * TT + geo.tt) * 192;
                const float* yrow = Y + ((size_t)(d * 8 + geo.b) * TT + geo.tt) * 256 + 64 * h + 8 * g;
                bf16x8 sgd[4];
#pragma unroll
                for (int kk = 0; kk < 4; ++kk) sgd[kk] = d ? sg[1][kk] : sg[0][kk];
                f32x4 y[4], gg[4]; f16x8 kdh[2]; bf16x8 gf[4][4];
#pragma unroll
                for (int u = 0; u < 2; ++u) { y[2 * u] = *(const f32x4*)(yrow + 32 * u); y[2 * u + 1] = *(const f32x4*)(yrow + 32 * u + 4); kdh[u] = *(const f16x8*)(SD + sdrow + 64 + 32 * u + 8 * g); }
#pragma unroll
                for (int t = 0; t < 4; ++t) { const bf16_t* gr = g2t + (size_t)(64 * h + 32 * (t >> 1) + 8 * (tk >> 2) + 4 * (t & 1) + (tk & 3)) * 128 + 8 * g;
#pragma unroll
                    for (int kk = 0; kk < 4; ++kk) gf[t][kk] = *(const bf16x8*)(gr + 32 * kk); }
                float sm = 0.f, bs = 0.f;
#pragma unroll
                for (int t = 0; t < 4; ++t) { const int c = 64 * h + 32 * (t >> 1) + 8 * g + 4 * (t & 1);
                    sm += (y[t][0] + y[t][1]) + (y[t][2] + y[t][3]);
                    const f32x4 rk = *(const LAS f32x4*)(T + RL_RK / 4 + c);
#pragma unroll
                    for (int q = 0; q < 4; ++q) bs += (float)rh[t >> 1][(t & 1) * 4 + q] * (float)kdh[t >> 1][(t & 1) * 4 + q] * rk[q];
                    f32x4 a = (f32x4){0.f, 0.f, 0.f, 0.f};
#pragma unroll
                    for (int kk = 0; kk < 4; ++kk) a = __builtin_amdgcn_mfma_f32_16x16x32_bf16(gf[t][kk], sgd[kk], a, 0, 0, 0);
                    gg[t] = a; }
                sm += __shfl_xor(sm, 16); sm += __shfl_xor(sm, 32); bs += __shfl_xor(bs, 16); bs += __shfl_xor(bs, 32);
                const float mu = sm * (1.0f / 64.0f); float vs = 0.f;
#pragma unroll
                for (int t = 0; t < 4; ++t)
#pragma unroll
                    for (int q = 0; q < 4; ++q) { const float dd = y[t][q] - mu; vs += dd * dd; }
                vs += __shfl_xor(vs, 16); vs += __shfl_xor(vs, 32);
                const float rstd = rsqrtf(vs * (1.0f / 64.0f) + 64e-5f);
#pragma unroll
                for (int t = 0; t < 4; ++t) { const int c = 64 * h + 32 * (t >> 1) + 8 * g + 4 * (t & 1);
                    const f32x4 gng = *(const LAS f32x4*)(T + RL_GNG / 4 + c), gnb = *(const LAS f32x4*)(T + RL_GNB / 4 + c);
#pragma unroll
                    for (int q = 0; q < 4; ++q) out[t][q] += ((y[t][q] - mu) * rstd * gng[q] + gnb[q] + bs * (float)vh[t >> 1][(t & 1) * 4 + q]) * gg[t][q]; }
                asm volatile("" ::: "memory");
            }
#pragma unroll
            for (int u = 0; u < 2; ++u) { u32x4 w; w.x = cvt_pk_bf16(out[2 * u][0], out[2 * u][1]); w.y = cvt_pk_bf16(out[2 * u][2], out[2 * u][3]); w.z = cvt_pk_bf16(out[2 * u + 1][0], out[2 * u + 1][1]); w.w = cvt_pk_bf16(out[2 * u + 1][2], out[2 * u + 1][3]);
                *(u32x4*)(MIX + (size_t)r * D + 512 + 64 * h + 32 * u + 8 * g) = w; }
        }
    }
    __syncthreads();
}

constexpr int CV_SEG = 64, CV_ROWS = CV_SEG + 30, CV_H = 0, CV_W = CV_ROWS * 256 * 4;
__device__ __forceinline__ void phase_conv(const Frame& F, const Params& P, int l, int nrows) {
    const bf16_t* PL = (const bf16_t*)(F.ws + WS_PL); bf16_t* MIX = (bf16_t*)(F.ws + WS_MIX);
    const int lane = F.lane, c4 = lane * 4, wave = F.wave;
    LAS float* H = (LAS float*)(F.lds + CV_H); LAS float* W = (LAS float*)(F.lds + CV_W);
    for (int i = F.tid; i < 31 * 256; i += NTHREADS) W[i] = P.in[I_DWW][(size_t)l * 31 * 256 + i];
    const f32x4 dwb = *(const f32x4*)(P.in[I_DWB] + l * 256 + c4), lng = *(const f32x4*)(P.in[I_LNG] + l * 256 + c4), lnb = *(const f32x4*)(P.in[I_LNB] + l * 256 + c4);
    for (int seg = F.bid; seg < nrows / CV_SEG; seg += F.G) {
        const int r0 = seg * CV_SEG; const RowGeo g0 = row_geo(r0);
        __syncthreads();
#pragma unroll 4
        for (int k = 0; k < 12; ++k) { const int rr = wave + 8 * k;
            if (rr < CV_ROWS) { const int pos = g0.pos - 15 + rr; f32x4 hv = (f32x4){0.f, 0.f, 0.f, 0.f};
                if (pos >= 0 && pos < g0.len) { const bf16_t* p = PL + (size_t)(r0 - 15 + rr) * INW + O_CV + c4; float a[4], bb[4];
                    unpack4(*(const u32x2*)p, a); unpack4(*(const u32x2*)(p + 256), bb);
#pragma unroll
                    for (int q = 0; q < 4; ++q) hv[q] = a[q] * sigmoidf_(bb[q]); }
                *(LAS f32x4*)(H + rr * 256 + c4) = hv; } }
        __syncthreads();
        f32x4 acc[8];
#pragma unroll
        for (int t = 0; t < 8; ++t) acc[t] = dwb;
#pragma unroll 1
        for (int j = 0; j < 31; ++j) { const f32x4 w = *(const LAS f32x4*)(W + j * 256 + c4);
#pragma unroll
            for (int t = 0; t < 8; ++t) acc[t] += *(const LAS f32x4*)(H + (wave * 8 + t + j) * 256 + c4) * w; }
#pragma unroll
        for (int t = 0; t < 8; ++t) {
            const float mu = wave_sum((acc[t][0] + acc[t][1]) + (acc[t][2] + acc[t][3])) * (1.0f / 256.0f);
            float vs = 0.f;
#pragma unroll
            for (int q = 0; q < 4; ++q) { const float dd = acc[t][q] - mu; vs += dd * dd; }
            const float rstd = rsqrtf(wave_sum(vs) * (1.0f / 256.0f) + 1e-5f);
            float o[4];
#pragma unroll
            for (int q = 0; q < 4; ++q) o[q] = siluf_((acc[t][q] - mu) * rstd * lng[q] + lnb[q]);
            u32x2 w; w.x = pk_bf16(o[0], o[1]); w.y = pk_bf16(o[2], o[3]);
            *(u32x2*)(MIX + (size_t)(r0 + wave * 8 + t) * D + 768 + c4) = w; }
    }
    __syncthreads();
}

__device__ __forceinline__ void phase_na_simple(const Frame& F, const Params& P, int l, int nq) {
    const bf16_t* PL = (const bf16_t*)(F.ws + WS_PL); bf16_t* MIX = (bf16_t*)(F.ws + WS_MIX);
    const float* rpb = P.in[I_RPB] + (size_t)l * 8 * 15 * 31;
    int tid_ = F.tid; asm volatile("" : "+v"(tid_));
    for (int gid = F.bid * NTHREADS + tid_; gid < nq * 8; gid += F.G * NTHREADS) {
        const int r = gid >> 3, h = gid & 7;
        const RowGeo g = row_geo(r);
        float q[64], o[64];
        { const bf16_t* qp = PL + (size_t)r * INW + O_Q + h * 64;
#pragma unroll
          for (int i = 0; i < 8; ++i) unpack8(*(const u32x4*)(qp + i * 8), q + i * 8); }
#pragma unroll
        for (int i = 0; i < 64; ++i) o[i] = 0.f;
        float m = -3.0e38f, lsum = 0.f;
        const bool lat = r < NLAT;
        const int gi = g.pos >> 6, gc = g.pos & 63;
        const int rs = min(max(gi - 4, 0), 56), wsc = min(max(gc - 8, 0), 48);
        const int nkey = lat ? 384 : 256;
#pragma unroll 1
        for (int kx = 0; kx < nkey; ++kx) {
            const bool win = lat && kx < 128;
            int krow; float bias = 0.f;
            if (win) { const int r8 = kx >> 4, cc = kx & 15; krow = g.b * SEQ + (rs + r8) * 64 + wsc + cc; bias = rpb[(h * 15 + (rs + r8 - gi + 7)) * 31 + (wsc + cc - gc + 15)]; }
            else krow = NLAT + g.b * CTXL + (kx - (lat ? 128 : 0));
            const bf16_t* kp = PL + (size_t)krow * INW + O_K + h * 64; float a = bias;
#pragma unroll
            for (int i = 0; i < 8; ++i) { float kf[8]; unpack8(*(const u32x4*)(kp + i * 8), kf);
#pragma unroll
                for (int j = 0; j < 8; ++j) a += q[i * 8 + j] * kf[j]; }
            if (a > m) { const float alpha = __expf(m - a); lsum *= alpha;
#pragma unroll
                for (int i = 0; i < 64; ++i) o[i] *= alpha;
                m = a; }
            const float p = __expf(a - m); lsum += p;
            const bf16_t* vp = kp + (O_V - O_K);
#pragma unroll
            for (int i = 0; i < 8; ++i) { float vf[8]; unpack8(*(const u32x4*)(vp + i * 8), vf);
#pragma unroll
                for (int j = 0; j < 8; ++j) o[i * 8 + j] += p * vf[j]; }
        }
        const float inv = 1.0f / lsum;
        bf16_t* op = MIX + (size_t)r * D + h * 64;
#pragma unroll
        for (int i = 0; i < 8; ++i) { u32x4 w; w.x = pk_bf16(o[i * 8] * inv, o[i * 8 + 1] * inv); w.y = pk_bf16(o[i * 8 + 2] * inv, o[i * 8 + 3] * inv);
            w.z = pk_bf16(o[i * 8 + 4] * inv, o[i * 8 + 5] * inv); w.w = pk_bf16(o[i * 8 + 6] * inv, o[i * 8 + 7] * inv); *(u32x4*)(op + i * 8) = w; }
    }
}

constexpr int NA_CK = 0, NA_CV = 32768, NA_RPB = 65536, NA_WV = 81920;
__device__ __forceinline__ bf16x8 na_pack8(const f32x4& a, const f32x4& b) {
    u32x4 w; w.x = cvt_pk_bf16(a[0], a[1]); w.y = cvt_pk_bf16(a[2], a[3]); w.z = cvt_pk_bf16(b[0], b[1]); w.w = cvt_pk_bf16(b[2], b[3]); return __builtin_bit_cast(bf16x8, w);
}
__device__ __forceinline__ bf16x8 na_vfrag(LAS unsigned char* blk, int lane, int dt) {
    const int g = lane >> 4, qq = (lane & 15) >> 2, p = lane & 3;
    const int r0 = 4 * g + qq, r1 = 16 + 4 * g + qq;
    const v4i16_t lo = __builtin_amdgcn_ds_read_tr16_b64_v4i16((LAS v4i16_t*)(blk + r0 * 128 + ((dt ^ ((r0 >> 1) & 3)) * 32) + p * 8));
    const v4i16_t hi = __builtin_amdgcn_ds_read_tr16_b64_v4i16((LAS v4i16_t*)(blk + r1 * 128 + ((dt ^ ((r1 >> 1) & 3)) * 32) + p * 8));
    bf16x8 r; r[0] = lo[0]; r[1] = lo[1]; r[2] = lo[2]; r[3] = lo[3]; r[4] = hi[0]; r[5] = hi[1]; r[6] = hi[2]; r[7] = hi[3]; return r;
}
template <bool WINDOW>
__device__ __forceinline__ void na_item(const Frame& F, const bf16_t* PL, bf16_t* MIX, int b, int h, int qrow0  , int gi, int cb) {
    const int lane = F.lane, ql = lane & 15, g = lane >> 4;
    LAS unsigned char* CK = F.lds + NA_CK; LAS unsigned char* CV = F.lds + NA_CV; const LAS float* RPB = (const LAS float*)(F.lds + NA_RPB);
    LAS unsigned char* WV = F.lds + NA_WV + F.wave * 4096;
    bf16x8 Qf[2];
    { const bf16_t* qp = PL + (size_t)(qrow0 + ql) * INW + O_Q + h * 64 + 8 * g; Qf[0] = *(const bf16x8*)qp; Qf[1] = *(const bf16x8*)(qp + 32); }
    f32x4 acc[4];
#pragma unroll
    for (int dt = 0; dt < 4; ++dt) acc[dt] = (f32x4){0.f, 0.f, 0.f, 0.f};
    float m_run = -3.0e38f, l_run = 0.f;
    if constexpr (WINDOW) {
        const int rs = min(max(gi - 4, 0), 56), kc0 = min(max(16 * cb - 8, 0), 32), qcol = 16 * cb + ql, wsq = min(max(qcol - 8, 0), 48);
        const size_t krow0 = (size_t)b * SEQ + (size_t)rs * 64 + kc0;
        f32x4 s[16];
#pragma unroll
        for (int t = 0; t < 16; ++t) { const bf16_t* kp = PL + (krow0 + (size_t)(t >> 1) * 64 + (t & 1) * 16 + ql) * INW + O_K + h * 64 + 8 * g;
            const bf16x8 k0 = *(const bf16x8*)kp, k1 = *(const bf16x8*)(kp + 32);
            s[t] = __builtin_amdgcn_mfma_f32_16x16x32_bf16(k0, Qf[0], (f32x4){0.f, 0.f, 0.f, 0.f}, 0, 0, 0);
            s[t] = __builtin_amdgcn_mfma_f32_16x16x32_bf16(k1, Qf[1], s[t], 0, 0, 0); }
        const int vr = lane >> 1, part = lane & 1;
        const bf16_t* vbase = PL + (krow0 + vr) * INW + O_V + h * 64 + part * 32;
        u32x4 vbuf[4][4];
#pragma unroll
        for (int k = 0; k < 4; ++k) { const bf16_t* vp = vbase + (size_t)k * 64 * INW; vbuf[k][0] = *(const u32x4*)vp; vbuf[k][1] = *(const u32x4*)(vp + 8); vbuf[k][2] = *(const u32x4*)(vp + 16); vbuf[k][3] = *(const u32x4*)(vp + 24); }
        float mx = -3.0e38f;
#pragma unroll
        for (int t = 0; t < 16; ++t) { const LAS float* bp = RPB + (h * 15 + (rs + (t >> 1) - gi + 7)) * 31 + 15 - qcol;
#pragma unroll
            for (int j = 0; j < 4; ++j) { const int kcol = kc0 + (t & 1) * 16 + 4 * g + j; const bool ok = kcol >= wsq && kcol < wsq + 16;
                const float v = ok ? s[t][j] + bp[ok ? kcol : qcol] : -INFINITY; s[t][j] = v; mx = fmaxf(mx, v); } }
        mx = fmaxf(mx, __shfl_xor(mx, 16)); mx = fmaxf(mx, __shfl_xor(mx, 32));
        m_run = mx;
        float ls = 0.f;
#pragma unroll
        for (int t = 0; t < 16; ++t)
#pragma unroll
            for (int j = 0; j < 4; ++j) { const float p = __expf(s[t][j] - mx); s[t][j] = p; ls += p; }
        l_run = ls;
#pragma unroll
        for (int r8 = 0; r8 < 8; ++r8) {
            { LAS unsigned char* wr = WV + vr * 128; const int sw = (vr >> 1) & 3;
              *(LAS u32x4*)(wr + (((2 * part) ^ sw) * 32)) = vbuf[r8 & 3][0]; *(LAS u32x4*)(wr + (((2 * part) ^ sw) * 32) + 16) = vbuf[r8 & 3][1];
              *(LAS u32x4*)(wr + (((2 * part + 1) ^ sw) * 32)) = vbuf[r8 & 3][2]; *(LAS u32x4*)(wr + (((2 * part + 1) ^ sw) * 32) + 16) = vbuf[r8 & 3][3];
              if (r8 + 4 < 8) { const bf16_t* vp = vbase + (size_t)(r8 + 4) * 64 * INW;
                  vbuf[r8 & 3][0] = *(const u32x4*)vp; vbuf[r8 & 3][1] = *(const u32x4*)(vp + 8); vbuf[r8 & 3][2] = *(const u32x4*)(vp + 16); vbuf[r8 & 3][3] = *(const u32x4*)(vp + 24); } }
            __builtin_amdgcn_wave_barrier(); asm volatile("" ::: "memory");
            const bf16x8 pf = na_pack8(s[2 * r8], s[2 * r8 + 1]);
#pragma unroll
            for (int dt = 0; dt < 4; ++dt) { const bf16x8 vf = na_vfrag(WV, lane, dt); acc[dt] = __builtin_amdgcn_mfma_f32_16x16x32_bf16(vf, pf, acc[dt], 0, 0, 0); }
            __builtin_amdgcn_wave_barrier(); asm volatile("" ::: "memory");
        }
    }
    {
        f32x4 s[16];
#pragma unroll
        for (int t = 0; t < 16; ++t) { const int key = 16 * t + ql; const LAS unsigned char* kr = CK + key * 128;
            const bf16x8 k0 = *(const LAS bf16x8*)(kr + ((g ^ (key & 7)) * 16)), k1 = *(const LAS bf16x8*)(kr + (((g + 4) ^ (key & 7)) * 16));
            s[t] = __builtin_amdgcn_mfma_f32_16x16x32_bf16(k0, Qf[0], (f32x4){0.f, 0.f, 0.f, 0.f}, 0, 0, 0);
            s[t] = __builtin_amdgcn_mfma_f32_16x16x32_bf16(k1, Qf[1], s[t], 0, 0, 0); }
        float mx = m_run;
#pragma unroll
        for (int t = 0; t < 16; ++t)
#pragma unroll
            for (int j = 0; j < 4; ++j) mx = fmaxf(mx, s[t][j]);
        mx = fmaxf(mx, __shfl_xor(mx, 16)); mx = fmaxf(mx, __shfl_xor(mx, 32));
        const float alpha = __expf(m_run - mx);
        float ls = l_run * alpha;
#pragma unroll
        for (int dt = 0; dt < 4; ++dt) acc[dt] *= alpha;
#pragma unroll
        for (int t = 0; t < 16; ++t)
#pragma unroll
            for (int j = 0; j < 4; ++j) { const float p = __expf(s[t][j] - mx); s[t][j] = p; ls += p; }
        l_run = ls;
#pragma unroll
        for (int blk = 0; blk < 8; ++blk) { const bf16x8 pf = na_pack8(s[2 * blk], s[2 * blk + 1]);
#pragma unroll
            for (int dt = 0; dt < 4; ++dt) { const bf16x8 vf = na_vfrag(CV + blk * 4096, lane, dt); acc[dt] = __builtin_amdgcn_mfma_f32_16x16x32_bf16(vf, pf, acc[dt], 0, 0, 0); } }
    }
    float lt = l_run; lt += __shfl_xor(lt, 16); lt += __shfl_xor(lt, 32);
    const float inv = 1.0f / lt;
    bf16_t* op = MIX + (size_t)(qrow0 + ql) * D + h * 64 + 4 * g;
#pragma unroll
    for (int dt = 0; dt < 4; ++dt) { u32x2 w; w.x = cvt_pk_bf16(acc[dt][0] * inv, acc[dt][1] * inv); w.y = cvt_pk_bf16(acc[dt][2] * inv, acc[dt][3] * inv); *(u32x2*)(op + dt * 16) = w; }
}
__device__ __forceinline__ void phase_na_mfma(const Frame& F, const Params& P, int l, bool ctx_queries) {
    const bf16_t* PL = (const bf16_t*)(F.ws + WS_PL); bf16_t* MIX = (bf16_t*)(F.ws + WS_MIX);
    int tid_ = F.tid; asm volatile("" : "+v"(tid_));
    const int tid = tid_;
    { const float* rpb = P.in[I_RPB] + (size_t)l * 8 * 15 * 31; LAS float* R = (LAS float*)(F.lds + NA_RPB); for (int i = tid; i < 8 * 15 * 31; i += NTHREADS) R[i] = rpb[i]; }
    for (int unit = F.bid; unit < 512; unit += F.G) {
        const int eighth = unit & 7, h = (unit >> 3) & 7, b = unit >> 6;
        __syncthreads();
        { int t2 = tid; asm volatile("" : "+v"(t2)); const int key = t2 >> 1, part = t2 & 1; const bf16_t* kp = PL + (size_t)(NLAT + b * CTXL + key) * INW + O_K + h * 64 + part * 32; const bf16_t* vp = kp + (O_V - O_K);
          LAS unsigned char* kr = F.lds + NA_CK + key * 128; LAS unsigned char* vr = F.lds + NA_CV + key * 128; const int sw = (key >> 1) & 3;
#pragma unroll
          for (int c = 0; c < 4; ++c) { *(LAS u32x4*)(kr + (((4 * part + c) ^ (key & 7)) * 16)) = *(const u32x4*)(kp + 8 * c);
              const int c16 = 4 * part + c; *(LAS u32x4*)(vr + (((c16 >> 1) ^ sw) * 32) + (c16 & 1) * 16) = *(const u32x4*)(vp + 8 * c); } }
        __syncthreads();
        for (int it = F.wave; it < 32; it += NWAVES) { const int gi = eighth * 8 + (it >> 2), cb = it & 3;
            na_item<true>(F, PL, MIX, b, h, b * SEQ + gi * 64 + cb * 16, gi, cb); }
        if (ctx_queries && F.wave < 2) na_item<false>(F, PL, MIX, b, h, NLAT + b * CTXL + (eighth * 2 + F.wave) * 16, 0, 0);
    }
}

__device__ __forceinline__ void phase_final(const Frame& F, const Params& P) {
    float* out = P.out; const float* g = P.in[I_FINALG]; const int lane = F.lane;
    for (int r = F.gw; r < NLAT; r += F.nw) {
        float* xr = out + (size_t)r * D; f32x4 x[4]; float ss = 0.f;
#pragma unroll
        for (int j = 0; j < 4; ++j) { x[j] = *(const f32x4*)(xr + j * 256 + lane * 4); ss += x[j][0] * x[j][0] + x[j][1] * x[j][1] + x[j][2] * x[j][2] + x[j][3] * x[j][3]; }
        ss = wave_sum(ss); const float rstd = rsqrtf(ss * (1.0f / D) + 1e-6f);
#pragma unroll
        for (int j = 0; j < 4; ++j) { const f32x4 gg = *(const f32x4*)(g + j * 256 + lane * 4); *(f32x4*)(xr + j * 256 + lane * 4) = x[j] * rstd * gg; }
    }
}

constexpr int PH_L0 = 1, PH_PER_L0 = 9, PH_L1 = PH_L0 + PH_PER_L0, PH_PER_L1 = 12, PH_FINAL = PH_L1 + PH_PER_L1, N_PHASES = PH_FINAL + 1;
#define RFL(x) __builtin_amdgcn_readfirstlane(x)

PHASE ph_prologue(const void* kp_, int wv_) { PHASE_ENTER; if constexpr (MKB(0)) phase_prologue(F, P); }
PHASE ph_norm1(const void* kp_, int wv_, int l_) { PHASE_ENTER; const int l = RFL(l_);
    if constexpr (MKB(1)) phase_norm<false>(F, P, l, 0, NROW, l == 0 ? P.in[I_X] : P.out, l == 0 ? P.in[I_CTX] : (const float*)(F.ws + WS_XC)); }
PHASE_INL ph_gemm_win(const void* kp_, int wv_, int l_) { PHASE_ENTER; const int l = RFL(l_);
    pg8::DenseSched S; S.init(NROW / 256, INW / 256, F.G, F.bid); S.A = (const bf16_t*)(F.ws + WS_HL); S.Bt = (const bf16_t*)(F.ws + WS_BTIN) + (size_t)l * INW * D; S.K = D;
    pg8::EpiBf16 E{(bf16_t*)(F.ws + WS_PL), INW, 2, 0.125f};
    if constexpr (MKB(2)) pg8::gemm_phase<pg8::EpiBf16, pg8::DenseSched, false>(F.lds, D, S, E, F.wave); }
PHASE_INL ph_rw_prep(const void* kp_, int wv_, int l_) { PHASE_ENTER; const int l = RFL(l_); if constexpr (MKB(3)) phase_rw_prep(F, P, l); }
PHASE ph_conv(const void* kp_, int wv_, int l_, int bid_, int G_) { PHASE_ENTER; const int l = RFL(l_); if constexpr (MKB(4)) phase_conv(sub_frame(F, RFL(bid_), RFL(G_)), P, l, l == 0 ? NROW : NLAT); }
PHASE_INL ph_na(const void* kp_, int wv_, int l_, int bid_, int G_) { PHASE_ENTER; const int l = RFL(l_); if constexpr (MKB(5)) phase_na_mfma(sub_frame(F, RFL(bid_), RFL(G_)), P, l, l == 0); }
PHASE_INL ph_scan(const void* kp_, int wv_, int bid_, int G_) { PHASE_ENTER; if constexpr (MKB(6)) phase_scan(sub_frame(F, RFL(bid_), RFL(G_))); }
PHASE_INL ph_rw_post(const void* kp_, int wv_, int l_) { PHASE_ENTER; const int l = RFL(l_); if constexpr (MKB(7)) phase_rw_post(F, P, l, l == 0 ? NROW : NLAT); }
PHASE_INL ph_gemm_wout(const void* kp_, int wv_, int l_) { PHASE_ENTER; const int l = RFL(l_);
    float* XC = (float*)(F.ws + WS_XC);
    pg8::DenseSched S; S.init((l == 0 ? NROW : NLAT) / 256, D / 256, F.G, F.bid); S.A = (const bf16_t*)(F.ws + WS_MIX); S.Bt = (const bf16_t*)(F.ws + WS_BTOUT) + (size_t)l * D * D; S.K = D; S.split_tail();
    pg8::EpiRes E{l == 0 ? P.in[I_X] : P.out, l == 0 ? P.in[I_CTX] : XC, P.out, XC, (const float*)(F.ws + WS_MODV) + (size_t)l * 9 * MODW + 2 * D};
    if constexpr (MKB(8)) pg8::gemm_phase<pg8::EpiRes, pg8::DenseSched, false>(F.lds, D, S, E, F.wave); }
PHASE ph_norm2_l0(const void* kp_, int wv_) { PHASE_ENTER; if constexpr (MKB(9)) phase_norm<false>(F, P, 0, 1, NROW, P.out, (const float*)(F.ws + WS_XC)); }
PHASE_INL ph_gemm_ffn_gu(const void* kp_, int wv_) { PHASE_ENTER;
    pg8::DenseSched S; S.init(NROW / 256, (2 * DFF) / 256, F.G, F.bid); S.A = (const bf16_t*)(F.ws + WS_HL); S.Bt = (const bf16_t*)(F.ws + WS_BTGU); S.K = D;
    pg8::EpiSwiGLU E{(bf16_t*)(F.ws + WS_H), DFF};
    if constexpr (MKB(10)) pg8::gemm_phase<pg8::EpiSwiGLU, pg8::DenseSched, false>(F.lds, D, S, E, F.wave); }
PHASE_INL ph_gemm_ffn_dn(const void* kp_, int wv_) { PHASE_ENTER;
    float* XC = (float*)(F.ws + WS_XC);
    pg8::DenseSched S; S.init(NROW / 256, D / 256, F.G, F.bid); S.A = (const bf16_t*)(F.ws + WS_H); S.Bt = (const bf16_t*)(F.ws + WS_BTDN); S.K = DFF; S.split_tail();
    pg8::EpiRes E{P.out, XC, P.out, XC, (const float*)(F.ws + WS_MODV) + 5 * D};
    if constexpr (MKB(11)) pg8::gemm_phase<pg8::EpiRes, pg8::DenseSched, false>(F.lds, DFF, S, E, F.wave); }
PHASE ph_norm2_l1(const void* kp_, int wv_) { PHASE_ENTER; if constexpr (MKB(12)) phase_norm<true>(F, P, 1, 1, NLAT, P.out, (const float*)(F.ws + WS_XC)); }
PHASE ph_moe_prep(const void* kp_, int wv_) { PHASE_ENTER; if constexpr (MKB(13)) { phase_moe_rowmap(F); phase_moe_convert(F, P); } }
PHASE_INL ph_gemm_moe_gu(const void* kp_, int wv_, int pass_) { PHASE_ENTER; const int pass = RFL(pass_);
    pg8::MoeSched S; moe_tstart(F, pass, S.tstart); S.init(S.tstart[8], (2 * DFE) / 256, F.G, F.bid);
    S.A = (const bf16_t*)(F.ws + WS_HL); S.Bt0 = F.ws + WS_MOE; S.e_stride = MOE_E_BYTES; S.K = D; S.rowmap = (const int*)(F.ws + WS_ROUTE + RT_RMAP) + pass * NROW;
    pg8::EpiSwiGLU E{(bf16_t*)(F.ws + WS_H), DFE};
    if constexpr (MKB(14)) pg8::gemm_phase<pg8::EpiSwiGLU, pg8::MoeSched, true>(F.lds, D, S, E, F.wave); }
PHASE_INL ph_gemm_moe_dn(const void* kp_, int wv_, int pass_) { PHASE_ENTER; const int pass = RFL(pass_);
    pg8::MoeSched S; moe_tstart(F, pass, S.tstart); S.init(S.tstart[8], D / 256, F.G, F.bid);
    S.A = (const bf16_t*)(F.ws + WS_H); S.Bt0 = F.ws + WS_MOE + MOE_GU_BYTES; S.e_stride = MOE_E_BYTES; S.K = DFE; S.split_tail(); S.rowmap = nullptr;
    pg8::EpiMoeDown E{P.out, (const float*)(F.ws + WS_MODV) + (size_t)9 * MODW + 5 * D, (const int*)(F.ws + WS_ROUTE + RT_RMAP) + pass * NROW, (const float*)(F.ws + WS_ROUTE + RT_SGATE) + pass * NROW};
    if constexpr (MKB(15)) pg8::gemm_phase<pg8::EpiMoeDown, pg8::MoeSched, false>(F.lds, DFE, S, E, F.wave); }
PHASE ph_final(const void* kp_, int wv_) { PHASE_ENTER; if constexpr (MKB(16)) phase_final(F, P); }

static __attribute__((noinline)) __device__ void grid_barrier(const void* bar_, unsigned x_, int wv_) {
    const unsigned long long v = (unsigned long long)bar_;
    const unsigned lo = __builtin_amdgcn_readfirstlane((unsigned)v), hi = __builtin_amdgcn_readfirstlane((unsigned)(v >> 32));
    XcdBarrier b; b.bar = (unsigned*)(((unsigned long long)hi << 32) | lo); b.x = __builtin_amdgcn_readfirstlane(x_);
    b.st = (volatile LAS unsigned*)((LAS unsigned char*)lds_raw + LDS_MISC);
    xcd_barrier(b, __builtin_amdgcn_readfirstlane(wv_) * 64 + lane_id());
}
__device__ __forceinline__ bool ph_in(int lo, int hi, int k) { asm volatile("" : "+s"(lo), "+s"(hi)); return lo <= k && k < hi; }

__global__ void __launch_bounds__(NTHREADS, 2) mk_fwd(Params P) {
    const void* kp = (const void*)__builtin_amdgcn_kernarg_segment_ptr();
    LAS unsigned char* lds = (LAS unsigned char*)lds_raw;
    volatile LAS unsigned* misc = (volatile LAS unsigned*)(lds + LDS_MISC);
    const int wv = __builtin_amdgcn_readfirstlane((int)(threadIdx.x >> 6));
    if (wv == 0 && lane_id() < 4) misc[lane_id()] = 0u;
    __syncthreads();
    const int lo = P.ph_lo, hi = P.ph_hi;
    XcdBarrier bar; bar.bar = (unsigned*)(P.ws + WS_CTL) + CW_BAR; bar.x = 0; bar.st = misc;
    if (hi - lo > 1) bar = xcd_barrier_post((unsigned*)(P.ws + WS_CTL) + CW_BAR, misc, wv * 64 + lane_id());
#define IN(k) ph_in(lo, hi, (k))
#define SEAM(k) do { if (IN((k) + 1)) grid_barrier((const void*)bar.bar, bar.x, wv); } while (0)
    if (IN(0)) { for (int rep = 0; rep < REP_PRO; ++rep) ph_prologue(kp, wv); SEAM(0); }
#define LAYER_COMMON(l, pb) \
    if (IN((pb) + 0)) { for (int rep = 0; rep < REP_NORM; ++rep) ph_norm1(kp, wv, (l)); SEAM((pb) + 0); } \
    if (IN((pb) + 1)) { for (int rep = 0; rep < REP_GEMM; ++rep) ph_gemm_win(kp, wv, (l)); SEAM((pb) + 1); } \
    if (IN((pb) + 2)) { for (int rep = 0; rep < REP_PP; ++rep) ph_rw_prep(kp, wv, (l)); SEAM((pb) + 2); } \
    if (IN((pb) + 3)) { const int bx = (int)blockIdx.x, Gx = (int)gridDim.x; \
        if (Gx == 256) { if (bx < 64) { for (int rep = 0; rep < REP_SCAN; ++rep) ph_scan(kp, wv, bx, 64); } \
            else { for (int rep = 0; rep < REP_CONV; ++rep) ph_conv(kp, wv, (l), bx - 64, 192); for (int rep = 0; rep < REP_NA; ++rep) ph_na(kp, wv, (l), bx - 64, 192); } } \
        else { ph_conv(kp, wv, (l), bx, Gx); ph_na(kp, wv, (l), bx, Gx); ph_scan(kp, wv, bx, Gx); } SEAM((pb) + 3); } \
    if (IN((pb) + 4)) { for (int rep = 0; rep < REP_POST; ++rep) ph_rw_post(kp, wv, (l)); SEAM((pb) + 4); } \
    if (IN((pb) + 5)) { ph_gemm_wout(kp, wv, (l)); SEAM((pb) + 5); }
    LAYER_COMMON(0, PH_L0)
    if (IN(PH_L0 + 6)) { ph_norm2_l0(kp, wv); SEAM(PH_L0 + 6); }
    if (IN(PH_L0 + 7)) { for (int rep = 0; rep < REP_GEMM; ++rep) ph_gemm_ffn_gu(kp, wv); SEAM(PH_L0 + 7); }
    if (IN(PH_L0 + 8)) { ph_gemm_ffn_dn(kp, wv); SEAM(PH_L0 + 8); }
    LAYER_COMMON(1, PH_L1)
    if (IN(PH_L1 + 6)) { ph_norm2_l1(kp, wv); SEAM(PH_L1 + 6); }
    if (IN(PH_L1 + 7)) { for (int rep = 0; rep < REP_PRO; ++rep) ph_moe_prep(kp, wv); SEAM(PH_L1 + 7); }
#pragma unroll 1
    for (int pass = 0; pass < 2; ++pass) {
        if (IN(PH_L1 + 8 + 2 * pass)) { for (int rep = 0; rep < REP_GEMM; ++rep) ph_gemm_moe_gu(kp, wv, pass); SEAM(PH_L1 + 8 + 2 * pass); }
        if (IN(PH_L1 + 9 + 2 * pass)) { ph_gemm_moe_dn(kp, wv, pass); SEAM(PH_L1 + 9 + 2 * pass); }
    }
#undef LAYER_COMMON
    if (IN(PH_FINAL)) ph_final(kp, wv);
#undef IN
#undef SEAM
}

extern "C" void kernel_launch(void* const* d_in, const int* in_sizes, int n_in, void* d_out, int out_size, void* d_ws, size_t ws_size, hipStream_t stream) {
    static int grid = 0;
    if (grid == 0) {
        if (n_in != 35 || out_size != NLAT * D || ws_size < WS_END) { fprintf(stderr, "kernel_launch: unexpected shapes (n_in %d out %d ws %zu need %zu)\n", n_in, out_size, ws_size, (size_t)WS_END); grid = -1; return; }
        int dev = 0, cus = 0, per_cu = 0;
        if (hipGetDevice(&dev) != hipSuccess || hipDeviceGetAttribute(&cus, hipDeviceAttributeMultiprocessorCount, dev) != hipSuccess) { grid = -1; return; }
        if (hipFuncSetAttribute((const void*)mk_fwd, hipFuncAttributeMaxDynamicSharedMemorySize, LDS_BYTES) != hipSuccess) { fprintf(stderr, "kernel_launch: hipFuncSetAttribute failed\n"); grid = -1; return; }
        if (hipOccupancyMaxActiveBlocksPerMultiprocessor(&per_cu, (const void*)mk_fwd, NTHREADS, LDS_BYTES) != hipSuccess || per_cu < 1) { fprintf(stderr, "kernel_launch: occupancy query says %d\n", per_cu); (void)hipGetLastError(); }
        grid = cus;
    }
    if (grid < 0) return;
    (void)hipMemsetAsync((char*)d_ws + WS_CTL, 0, CTL_BYTES, stream);
    Params p{};
    for (int i = 0; i < 35; ++i) p.in[i] = (const float*)d_in[i];
    p.out = (float*)d_out; p.ws = (unsigned char*)d_ws;
#if MK_ONE_LAUNCH
    p.ph_lo = 0; p.ph_hi = N_PHASES;
    hipLaunchKernelGGL(mk_fwd, dim3(grid), dim3(NTHREADS), LDS_BYTES, stream, p);
#else
    for (int k = 0; k < N_PHASES && k <= MK_LAST; ++k) { p.ph_lo = k; p.ph_hi = k + 1; hipLaunchKernelGGL(mk_fwd, dim3(grid), dim3(NTHREADS), LDS_BYTES, stream, p); }
#endif
}
```

```cpp
#include <hip/hip_runtime.h>
#include <stdint.h>
#include <stdio.h>

#ifndef MK_MASK
#define MK_MASK 0xFFFFFFFFu
#endif
#define MKB(k) (((MK_MASK) >> (k)) & 1u)
#ifndef REP_SCAN
#define REP_SCAN 1
#endif
#ifndef REP_NA
#define REP_NA 1
#endif
#ifndef REP_GEMM
#define REP_GEMM 1
#endif
#ifndef REP_PP
#define REP_PP 1
#endif
#ifndef REP_POST
#define REP_POST 1
#endif
#ifndef REP_CONV
#define REP_CONV 1
#endif
#ifndef REP_NORM
#define REP_NORM 1
#endif
#ifndef REP_PRO
#define REP_PRO 1
#endif
#ifndef MK_LAST
#define MK_LAST 99
#endif
#ifndef MK_ONE_LAUNCH
#define MK_ONE_LAUNCH 1
#endif

#define LAS __attribute__((address_space(3)))
typedef unsigned short bf16_t;
typedef _Float16 f16_t;
typedef short bf16x8 __attribute__((ext_vector_type(8)));
typedef float f32x4 __attribute__((ext_vector_type(4)));
typedef float f32x2 __attribute__((ext_vector_type(2)));
typedef unsigned u32x4 __attribute__((ext_vector_type(4)));
typedef unsigned u32x2 __attribute__((ext_vector_type(2)));
typedef f16_t f16x4 __attribute__((ext_vector_type(4)));
typedef f16_t f16x8 __attribute__((ext_vector_type(8)));
typedef short v4i16_t __attribute__((ext_vector_type(4)));

constexpr int D = 1024, NB = 8, SEQ = 4096, CTXL = 256, TT = CTXL + SEQ;
constexpr int NLAT = NB * SEQ, NCTX = NB * CTXL, NROW = NLAT + NCTX;
constexpr int INW = 3328, DFF = 2816, DFE = 3584, NEXP = 8;
constexpr int O_Q = 0, O_K = 512, O_V = 1024, O_RW = 1536, O_CV = 2816;
constexpr int MODW = 6 * D;
constexpr int NTHREADS = 512, NWAVES = 8;
constexpr int LDS_BYTES = 160 * 1024;
constexpr int LDS_MISC = LDS_BYTES - 256;

constexpr size_t al256(size_t x) { return (x + 255) & ~(size_t)255; }
constexpr size_t WS_CTL   = 0;
constexpr size_t CTL_BYTES = 65536;
constexpr size_t WS_MODV  = WS_CTL + CTL_BYTES;
constexpr size_t WS_BTIN  = al256(WS_MODV + (size_t)2 * 9 * MODW * 4);
constexpr size_t WS_BTOUT = al256(WS_BTIN + (size_t)2 * INW * D * 2);
constexpr size_t WS_BTGU  = al256(WS_BTOUT + (size_t)2 * D * D * 2);
constexpr size_t WS_BTDN  = al256(WS_BTGU + (size_t)2 * DFF * D * 2);
constexpr size_t WS_LORA  = al256(WS_BTDN + (size_t)D * DFF * 2);
constexpr size_t LORA_LD_BYTES = (size_t)(256 * 64 * 2 + 256 * 128) * 2;
constexpr size_t WS_MOE   = al256(WS_LORA + 4 * LORA_LD_BYTES);
constexpr size_t MOE_GU_BYTES = (size_t)2 * DFE * D * 2, MOE_DN_BYTES = (size_t)D * DFE * 2, MOE_E_BYTES = MOE_GU_BYTES + MOE_DN_BYTES;
constexpr size_t MOE8_GU_BYTES = (size_t)2 * DFE * D, MOE8_DN_BYTES = (size_t)D * DFE, MOE8_E_BYTES = MOE8_GU_BYTES + MOE8_DN_BYTES;
constexpr float MOE8_GU_SCALE = 32.0f, MOE8_DN_SCALE = 64.0f;
constexpr size_t WS_SH    = WS_MOE;
constexpr size_t SH_BYTES = (size_t)NB * 4 * TT * 192 * 2;
constexpr size_t WS_SD    = WS_SH + SH_BYTES;
constexpr size_t WS_HLG   = WS_MOE + (size_t)NEXP * MOE8_E_BYTES;
static_assert(WS_HLG + (size_t)2 * NROW * D <= WS_MOE + (size_t)NEXP * MOE_E_BYTES, "HLG overflows the MoE region");
constexpr size_t WS_XC    = al256(WS_MOE + (size_t)NEXP * MOE_E_BYTES);
constexpr size_t WS_HL    = al256(WS_XC + (size_t)NCTX * D * 4);
constexpr size_t WS_Y     = WS_HL;
constexpr size_t WS_PL    = al256(WS_HL + (size_t)NROW * D * 2);
constexpr size_t WS_MIX   = al256(WS_PL + (size_t)NROW * INW * 2);
constexpr size_t WS_H     = WS_PL;
constexpr size_t WS_ROUTE = al256(WS_MIX + (size_t)NROW * D * 2);
constexpr size_t RT_TOKE  = 0;
constexpr size_t RT_TOKG  = RT_TOKE + (size_t)NLAT * 2 * 4;
constexpr size_t RT_TOKP  = RT_TOKG + (size_t)NLAT * 2 * 4;
constexpr size_t RT_RMAP  = RT_TOKP + (size_t)NLAT * 2 * 4;
constexpr size_t RT_SGATE = RT_RMAP + (size_t)2 * NROW * 4;
constexpr size_t WS_END   = al256(WS_ROUTE + RT_SGATE + (size_t)2 * NROW * 4);
static_assert(SH_BYTES * 3 <= (size_t)NEXP * MOE_E_BYTES, "scan inputs must fit the MoE weight region");
static_assert((size_t)NROW * DFE * 2 <= (size_t)NROW * INW * 2 + (size_t)NROW * D * 2, "H must fit PL+MIX");

constexpr int CW_BAR = 0;
constexpr int CW_MOECNT = 4096;

#define XB_TMO      128
#define XB_XCNT(j)  (256  + 64 * (j))
#define XB_XSUB(j)  (1280 + 64 * (j))
#define XB_XGEN(j)  (2304 + 64 * (j))
#define XB_TOP      3328
#define XB_TOPGEN   3392
#define XCD_BAR_WORDS 3456
#define XB_SPIN_CAP (1u << 22)

__device__ __forceinline__ unsigned xb_ld(unsigned* p)              { return __hip_atomic_load(p, __ATOMIC_RELAXED, __HIP_MEMORY_SCOPE_AGENT); }
__device__ __forceinline__ unsigned xb_add(unsigned* p, unsigned v) { return __hip_atomic_fetch_add(p, v, __ATOMIC_RELAXED, __HIP_MEMORY_SCOPE_AGENT); }
__device__ __forceinline__ unsigned xb_xcc_id() { return (unsigned)__builtin_amdgcn_s_getreg((3 << 11) | 20) & 0xFu; }
#define XB_SPIN(cond, bar) do { unsigned _sp = 0; while (cond) { __builtin_amdgcn_s_sleep(1); \
    if ((++_sp & 255u) == 0u) { if (xb_ld(&(bar)[XB_TMO])) break; if (_sp > XB_SPIN_CAP) { atomicAdd(&(bar)[XB_TMO], 1u); break; } } } } while (0)

struct XcdBarrier { unsigned* bar; unsigned x; volatile LAS unsigned* st; };

__device__ __forceinline__ XcdBarrier xcd_barrier_post(unsigned* bar, volatile LAS unsigned* st, int tid) {
    XcdBarrier b; b.bar = bar; b.x = xb_xcc_id(); b.st = st;
    if (tid == 0) (void)xb_add(&bar[XB_XCNT(b.x)], 1u);
    return b;
}
__device__ __forceinline__ void xcd_barrier_complete(unsigned* bar, unsigned x, unsigned& nloc, unsigned& nx) {
    const unsigned G = gridDim.x * gridDim.y * gridDim.z;
    unsigned sum, cnt, mine, sp = 0u;
    for (;;) {
        sum = 0u; cnt = 0u; mine = 0u;
#pragma unroll
        for (unsigned j = 0; j < 16; ++j) { const unsigned c = xb_ld(&bar[XB_XCNT(j)]); sum += c; cnt += (c > 0u) ? 1u : 0u; mine = (j == x) ? c : mine; }
        if (sum == G) break;
        __builtin_amdgcn_s_sleep(1);
        if ((++sp & 255u) == 0u) { if (xb_ld(&bar[XB_TMO])) break; if (sp > XB_SPIN_CAP) { atomicAdd(&bar[XB_TMO], 1u); break; } }
    }
    nloc = mine > 0u ? mine : 1u; nx = cnt > 0u ? cnt : 1u;
}
__device__ __forceinline__ void xcd_barrier(const XcdBarrier& b, int tid) {
    asm volatile("s_waitcnt vmcnt(0)" ::: "memory");
    __syncthreads();
    if (tid == 0) {
        unsigned* bar = b.bar;
        __builtin_amdgcn_s_waitcnt(0);
        unsigned nloc = b.st[0], nx = b.st[1];
        if (nloc == 0u) { xcd_barrier_complete(bar, b.x, nloc, nx); b.st[0] = nloc; b.st[1] = nx; }
        const unsigned old = xb_add(&bar[XB_XSUB(b.x)], 1u);
        const unsigned gen = old / nloc;
        if (old + 1u == (gen + 1u) * nloc) {
            __builtin_amdgcn_fence(__ATOMIC_RELEASE, "agent");
            asm volatile("s_waitcnt vmcnt(0)" ::: "memory");
            const unsigned og = xb_add(&bar[XB_TOP], 1u);
            const unsigned tg = og / nx;
            if (og + 1u == (tg + 1u) * nx) xb_add(&bar[XB_TOPGEN], 1u);
            else XB_SPIN(xb_ld(&bar[XB_TOPGEN]) == tg, bar);
            __builtin_amdgcn_fence(__ATOMIC_ACQUIRE, "agent");
            xb_add(&bar[XB_XGEN(b.x)], 1u);
            asm volatile("s_waitcnt vmcnt(0)" ::: "memory");
        } else {
            XB_SPIN(xb_ld(&bar[XB_XGEN(b.x)]) == gen, bar);
            __builtin_amdgcn_fence(__ATOMIC_ACQUIRE, "agent");
            asm volatile("s_waitcnt vmcnt(0)" ::: "memory");
        }
    }
    __syncthreads();
}

__device__ __forceinline__ int lane_id() { return (int)__builtin_amdgcn_mbcnt_hi(~0u, __builtin_amdgcn_mbcnt_lo(~0u, 0u)); }
__device__ __forceinline__ int lane_id_here() { int l; asm volatile("v_mbcnt_lo_u32_b32 %0, -1, 0\n\tv_mbcnt_hi_u32_b32 %0, -1, %0" : "=v"(l)); return l; }
__device__ __forceinline__ float bf2f(bf16_t b) { return __uint_as_float(((unsigned)b) << 16); }
__device__ __forceinline__ bf16_t f2bf(float f) { unsigned u = __float_as_uint(f); u += 0x7FFFu + ((u >> 16) & 1u); return (bf16_t)(u >> 16); }
__device__ __forceinline__ unsigned pk_bf16(float lo, float hi) { return (unsigned)f2bf(lo) | ((unsigned)f2bf(hi) << 16); }
typedef __bf16 bf16x2_t __attribute__((ext_vector_type(2)));
__device__ __forceinline__ unsigned cvt_pk_bf16(float lo, float hi) { return __builtin_bit_cast(unsigned, __builtin_convertvector((f32x2){lo, hi}, bf16x2_t)); }
__device__ __forceinline__ unsigned pk4_fp8(float a, float b, float c, float d) { int w = 0; w = __builtin_amdgcn_cvt_pk_fp8_f32(a, b, w, false); w = __builtin_amdgcn_cvt_pk_fp8_f32(c, d, w, true); return (unsigned)w; }
__device__ __forceinline__ float sigmoidf_(float x) { return 1.0f / (1.0f + __expf(-x)); }
__device__ __forceinline__ float siluf_(float x) { return x / (1.0f + __expf(-x)); }
__device__ __forceinline__ float wave_sum(float v) {
#pragma unroll
    for (int o = 32; o >= 1; o >>= 1) v += __shfl_xor(v, o);
    return v;
}
__device__ __forceinline__ float sum16(float v) {
    v += __shfl_xor(v, 1); v += __shfl_xor(v, 2); v += __shfl_xor(v, 4); v += __shfl_xor(v, 8); return v;
}
__device__ __forceinline__ void unpack4(u32x2 w, float (&f)[4]) {
    f[0] = __uint_as_float(w.x << 16); f[1] = __uint_as_float(w.x & 0xffff0000u); f[2] = __uint_as_float(w.y << 16); f[3] = __uint_as_float(w.y & 0xffff0000u);
}
__device__ __forceinline__ void unpack8(u32x4 w, float* f) {
    f[0] = __uint_as_float(w.x << 16); f[1] = __uint_as_float(w.x & 0xffff0000u); f[2] = __uint_as_float(w.y << 16); f[3] = __uint_as_float(w.y & 0xffff0000u);
    f[4] = __uint_as_float(w.z << 16); f[5] = __uint_as_float(w.z & 0xffff0000u); f[6] = __uint_as_float(w.w << 16); f[7] = __uint_as_float(w.w & 0xffff0000u);
}

struct Params {
    const float* in[35];
    float* out; unsigned char* ws;
    int ph_lo, ph_hi;
};
enum { I_X = 0, I_C, I_CTX, I_CCTX, I_N1G, I_N2G, I_MODW, I_MODB, I_WIN, I_WOUT, I_RPB, I_MUP, I_MUN, I_W0, I_W2, I_A0, I_A2, I_G2, I_KK, I_KA, I_RK, I_GNG, I_GNB,
       I_DWW, I_DWB, I_LNG, I_LNB, I_FG, I_FU, I_FD, I_ROUTER, I_MG, I_MU, I_MD, I_FINALG };

__device__ __forceinline__ int row_mi(int r) { return r < NLAT ? (r >> 12) : 8; }

namespace pg8 {
constexpr int BM = 256, BK = 64, HALF = 128, HTB = HALF * BK * 2, STAGE_BYTES = 8 * HTB, NXCD = 8, WGM = 8;
__device__ __forceinline__ int lds_byte(int r, int c) { const int st = (r >> 4) * 2 + (c >> 5), rr = r & 15, cc = c & 31, ob = rr * 64 + cc * 2; return st * 1024 + (ob ^ (((ob >> 9) & 1) << 5)); }
__device__ __forceinline__ void stage_rc(int b, int& R, int& C) { const int st = b / 1024, sb = b % 1024, swz = sb ^ (((sb >> 9) & 1) << 5); R = (st >> 1) * 16 + swz / 64; C = (st & 1) * 32 + (swz % 64) / 2; }
__device__ __forceinline__ int perm32(int rho) { const int n = rho >> 4, i = rho & 15; return 8 * (i >> 2) + 4 * n + (i & 3); }
struct Unit { int pm, pn, sub, ah, hb; };

struct TileOrder {
    int nM, nN, nwg, G, c, full;
    __device__ void init(int nM_, int nN_, int G_, int c_) { nM = nM_; nN = nN_; nwg = nM * nN; G = G_; c = c_; full = nwg; }
    __device__ void split_tail() { full = (nwg / G) * G; }
    __device__ bool next(int i, Unit& u) const {
        long L = (long)i * G + c;
        u.sub = 0; u.ah = 0; u.hb = 0;
        if (L >= (long)full + 4L * (nwg - full)) return false;
        if (L >= full) { const int j = (int)(L - full); L = full + (j >> 2); u.sub = 1; u.ah = (j >> 1) & 1; u.hb = j & 1; }
        int wgid = (int)L; { const int q = nwg / NXCD, r = nwg % NXCD, xcd = wgid % NXCD, off = wgid / NXCD; wgid = (xcd < r ? xcd * (q + 1) : r * (q + 1) + (xcd - r) * q) + off; }
        const int nig = WGM * nN, gid = wgid / nig, fm = gid * WGM, gsz = (nM - fm) < WGM ? (nM - fm) : WGM;
        u.pm = fm + ((wgid % nig) % gsz); u.pn = (wgid % nig) / gsz; return true;
    }
};
struct DenseSched : TileOrder {
    const bf16_t* A; const bf16_t* Bt; int K;
    __device__ __forceinline__ const char* aptr(const Unit& u) const { return (const char*)A + (size_t)u.pm * BM * K * 2; }
    __device__ __forceinline__ const char* bptr(const Unit& u) const { return (const char*)Bt + (size_t)u.pn * BM * K * 2; }
    __device__ __forceinline__ const char* abase() const { return (const char*)A; }
    __device__ __forceinline__ int arow(const Unit&, int) const { return 0; }
};
struct MoeSched : TileOrder {
    const bf16_t* A; const unsigned char* Bt0; size_t e_stride; int K; const int* rowmap; unsigned tw0, tw1;
    __device__ __forceinline__ void set_tstart(const int (&ts)[9]) {
        tw0 = __builtin_amdgcn_readfirstlane((unsigned)ts[1] | ((unsigned)ts[2] << 8) | ((unsigned)ts[3] << 16) | ((unsigned)ts[4] << 24));
        tw1 = __builtin_amdgcn_readfirstlane((unsigned)ts[5] | ((unsigned)ts[6] << 8) | ((unsigned)ts[7] << 16) | (255u << 24)); }
    __device__ __forceinline__ int expert(int pm) const { int e = 0;
#pragma unroll
        for (int j = 0; j < 4; ++j) { e += (pm >= (int)((tw0 >> (8 * j)) & 255u)) ? 1 : 0; e += (pm >= (int)((tw1 >> (8 * j)) & 255u)) ? 1 : 0; }
        return e; }
    __device__ __forceinline__ const char* aptr(const Unit& u) const { return (const char*)A + (size_t)u.pm * BM * K * 2; }
    __device__ __forceinline__ const char* bptr(const Unit& u) const { return (const char*)Bt0 + (size_t)expert(u.pm) * e_stride + (size_t)u.pn * BM * K * 2; }
    __device__ __forceinline__ const char* abase() const { return (const char*)A; }
    __device__ __forceinline__ int arow(const Unit& u, int r) const { const int t = rowmap[u.pm * BM + r]; return t < 0 ? 0 : t; }
};

struct EpiBf16 {
    static constexpr bool PERM = true;
    bf16_t* O; int ldc; int nscale; float scale;
    __device__ __forceinline__ void operator()(const f32x4 (&acc)[2][2][4][2], const Unit& u, int wr, int wc, int fr, int fq) const {
        const int row0 = u.pm * BM + wr * 64 + fr, col0 = u.pn * BM + wc * 32 + 8 * fq;
        const float s = u.pn < nscale ? scale : 1.0f;
#pragma unroll
        for (int ai = 0; ai < 2; ++ai)
#pragma unroll
            for (int m = 0; m < 4; ++m) { bf16_t* rowp = O + (size_t)(row0 + ai * HALF + m * 16) * ldc + col0;
#pragma unroll
                for (int bj = 0; bj < 2; ++bj) { const f32x4 v0 = acc[ai][bj][m][0] * s, v1 = acc[ai][bj][m][1] * s;
                    u32x4 w; w.x = cvt_pk_bf16(v0[0], v0[1]); w.y = cvt_pk_bf16(v0[2], v0[3]); w.z = cvt_pk_bf16(v1[0], v1[1]); w.w = cvt_pk_bf16(v1[2], v1[3]);
                    *(u32x4*)(rowp + bj * HALF) = w; } }
    }
};
struct EpiSwiGLU {
    static constexpr bool PERM = true;
    bf16_t* H; int ldh;
    __device__ __forceinline__ void operator()(const f32x4 (&acc)[2][2][4][2], const Unit& u, int wr, int wc, int fr, int fq) const {
        const int row0 = u.pm * BM + wr * 64 + fr, col0 = u.pn * HALF + wc * 32 + 8 * fq;
#pragma unroll
        for (int ai = 0; ai < 2; ++ai)
#pragma unroll
            for (int m = 0; m < 4; ++m) { bf16_t* rowp = H + (size_t)(row0 + ai * HALF + m * 16) * ldh + col0;
                float h[8];
#pragma unroll
                for (int n = 0; n < 2; ++n)
#pragma unroll
                    for (int j = 0; j < 4; ++j) { const float g = acc[ai][0][m][n][j], up = acc[ai][1][m][n][j]; h[n * 4 + j] = g / (1.0f + __expf(-g)) * up; }
                u32x4 w; w.x = cvt_pk_bf16(h[0], h[1]); w.y = cvt_pk_bf16(h[2], h[3]); w.z = cvt_pk_bf16(h[4], h[5]); w.w = cvt_pk_bf16(h[6], h[7]);
                *(u32x4*)rowp = w; }
    }
};
struct EpiSwiGLU8 {
    static constexpr bool PERM = true;
    unsigned char* H; int ldh; float inv;
    __device__ __forceinline__ void operator()(const f32x4 (&acc)[2][2][4][2], const Unit& u, int wr, int wc, int fr, int fq) const {
        const int row0 = u.pm * BM + wr * 64 + fr, col0 = u.pn * HALF + wc * 32 + 8 * fq;
#pragma unroll
        for (int ai = 0; ai < 2; ++ai)
#pragma unroll
            for (int m = 0; m < 4; ++m) { unsigned char* rowp = H + (size_t)(row0 + ai * HALF + m * 16) * ldh + col0;
                float h[8];
#pragma unroll
                for (int n = 0; n < 2; ++n)
#pragma unroll
                    for (int j = 0; j < 4; ++j) { const float g = acc[ai][0][m][n][j] * inv, up = acc[ai][1][m][n][j] * inv; h[n * 4 + j] = g / (1.0f + __expf(-g)) * up; }
                u32x2 w; w.x = pk4_fp8(h[0], h[1], h[2], h[3]); w.y = pk4_fp8(h[4], h[5], h[6], h[7]);
                *(u32x2*)rowp = w; }
    }
};
struct EpiRes {
    static constexpr bool PERM = false;
    const float* resL; const float* resC; float* outL; float* outC; const float* gvec;
    __device__ __forceinline__ void operator()(const f32x4 (&acc)[2][2][4][2], const Unit& u, int wr, int wc, int fr, int fq) const {
        const int r0 = u.pm * BM; const bool lat = r0 < NLAT;
        const float* res = lat ? resL + (size_t)r0 * D : resC + (size_t)(r0 - NLAT) * D;
        float* out = lat ? outL + (size_t)r0 * D : outC + (size_t)(r0 - NLAT) * D;
        const float* gv = gvec + (size_t)(lat ? (r0 >> 12) : 8) * MODW;
        const int rl = wr * 64 + fr, col0 = u.pn * BM + wc * 32 + 4 * fq;
        const int nq = u.sub ? 1 : 2, ro = u.sub ? u.ah * HALF : 0, co = u.sub ? u.hb * HALF : 0;
        f32x4 g[2][2];
#pragma unroll
        for (int bj = 0; bj < 2; ++bj)
#pragma unroll
            for (int n = 0; n < 2; ++n) g[bj][n] = *(const f32x4*)(gv + col0 + co + (u.sub ? 0 : bj * HALF) + n * 16);
#pragma unroll
        for (int ai = 0; ai < 2; ++ai) if (ai < nq)
#pragma unroll
            for (int m = 0; m < 4; ++m) { const size_t off = (size_t)(rl + ro + ai * HALF + m * 16) * D + col0 + co;
#pragma unroll
                for (int bj = 0; bj < 2; ++bj) if (bj < nq)
#pragma unroll
                    for (int n = 0; n < 2; ++n) { const f32x4 rv = *(const f32x4*)(res + off + bj * HALF + n * 16);
                        *(f32x4*)(out + off + bj * HALF + n * 16) = rv + g[bj][n] * acc[ai][bj][m][n]; } }
    }
};
struct EpiMoeDown {
    static constexpr bool PERM = false;
    float* xl; const float* gvec; const int* rowmap; const float* sgate; float inv;
    __device__ __forceinline__ void operator()(const f32x4 (&acc)[2][2][4][2], const Unit& u, int wr, int wc, int fr, int fq) const {
        const int nq = u.sub ? 1 : 2;
        const int rl = u.pm * BM + wr * 64 + fr + (u.sub ? u.ah * HALF : 0), col0 = u.pn * BM + wc * 32 + 4 * fq + (u.sub ? u.hb * HALF : 0);
#pragma unroll
        for (int ai = 0; ai < 2; ++ai) if (ai < nq)
#pragma unroll
            for (int m = 0; m < 4; ++m) { const int slot = rl + ai * HALF + m * 16; const int tok = rowmap[slot];
                if (tok >= 0) { const float sg = sgate[slot] * inv; const float* gv = gvec + (size_t)(tok >> 12) * MODW + col0; float* xp = xl + (size_t)tok * D + col0;
#pragma unroll
                    for (int bj = 0; bj < 2; ++bj) if (bj < nq)
#pragma unroll
                        for (int n = 0; n < 2; ++n) { const f32x4 g = *(const f32x4*)(gv + bj * HALF + n * 16); const f32x4 rv = *(const f32x4*)(xp + bj * HALF + n * 16);
                            *(f32x4*)(xp + bj * HALF + n * 16) = rv + (g * sg) * acc[ai][bj][m][n]; } } }
    }
};

__device__ __forceinline__ const char* uni_ptr(const char* p) { const unsigned long long v = (unsigned long long)p; const unsigned lo = __builtin_amdgcn_readfirstlane((unsigned)v), hi = __builtin_amdgcn_readfirstlane((unsigned)(v >> 32)); return (const char*)(((unsigned long long)hi << 32) | lo); }
typedef int v8i32_t __attribute__((ext_vector_type(8)));
__device__ __forceinline__ v8i32_t pg8_cat(const bf16x8& a, const bf16x8& b) { const u32x4 x = __builtin_bit_cast(u32x4, a), y = __builtin_bit_cast(u32x4, b); v8i32_t r; r[0] = (int)x[0]; r[1] = (int)x[1]; r[2] = (int)x[2]; r[3] = (int)x[3]; r[4] = (int)y[0]; r[5] = (int)y[1]; r[6] = (int)y[2]; r[7] = (int)y[3]; return r; }
template <class Epi, class Sched, bool GATHER, bool FP8 = false>
__device__ __forceinline__ void gemm_phase(LAS unsigned char* lds, const int K, const Sched& S, const Epi& E, const int wave_) {
    int tid_ = wave_ * 64 + lane_id_here(); asm volatile("" : "+v"(tid_));
    const int tid = tid_, wid = wave_, lane = tid & 63, wr = wid >> 2, wc = wid & 3, fr = lane & 15, fq = lane >> 4;
    const int nt = K / BK;
    unsigned voffA[2], voffB[2]; int RA[2], CA[2];
#pragma unroll
    for (int i = 0; i < 2; ++i) { int R, C; stage_rc(tid * 16 + i * 8192, R, C); const int Rb = Epi::PERM ? ((R & ~31) + perm32(R & 31)) : R;
        voffA[i] = (unsigned)(R * K + C) * 2u; voffB[i] = (unsigned)(Rb * K + C) * 2u; RA[i] = R; CA[i] = C; }
    const size_t kstep = (size_t)(BK * 2);
    const size_t hstep = (size_t)HALF * K * 2;
    const unsigned ldsw = (unsigned)wid * 1024u;
    const int aoff = lds_byte(wr * 64 + fr, fq * 8), boff = lds_byte(wc * 32 + fr, fq * 8);
#define PG8_SA(b, h) (((b) * 2 + (h)) * HTB)
#define PG8_SB(b, h) ((4 + (b) * 2 + (h)) * HTB)
#define PG8_STAGE(bufoff, gbase, voff) do { _Pragma("unroll") for (int _i = 0; _i < 2; ++_i) { unsigned _o = (voff)[_i]; const char* _g = (const char*)(gbase); asm volatile("" : "+v"(_o), "+s"(_g)); \
        __builtin_amdgcn_global_load_lds((const unsigned*)(_g + _o), (LAS unsigned*)(lds + (bufoff) + ldsw + _i * 8192), 16, 0, 0); } } while (0)
#define PG8_LDA(dst, b, h) do { _Pragma("unroll") for (int m = 0; m < 4; ++m) _Pragma("unroll") for (int k = 0; k < 2; ++k) dst[m][k] = *(const LAS bf16x8*)(lds + PG8_SA(b, h) + aoff + m * 2048 + k * 1024); } while (0)
#define PG8_LDB(dst, b, h) do { _Pragma("unroll") for (int n = 0; n < 2; ++n) _Pragma("unroll") for (int k = 0; k < 2; ++k) dst[n][k] = *(const LAS bf16x8*)(lds + PG8_SB(b, h) + boff + n * 2048 + k * 1024); } while (0)
#define PG8_MMA(ai, bj, At, Bt) do { __builtin_amdgcn_s_setprio(1); _Pragma("unroll") for (int m = 0; m < 4; ++m) _Pragma("unroll") for (int n = 0; n < 2; ++n) { \
        if constexpr (FP8) { acc[ai][bj][m][n] = __builtin_amdgcn_mfma_scale_f32_16x16x128_f8f6f4(pg8_cat(Bt[n][0], Bt[n][1]), pg8_cat(At[m][0], At[m][1]), acc[ai][bj][m][n], 0, 0, 0, 0, 0, 0); } \
        else { _Pragma("unroll") for (int k = 0; k < 2; ++k) acc[ai][bj][m][n] = __builtin_amdgcn_mfma_f32_16x16x32_bf16(Bt[n][k], At[m][k], acc[ai][bj][m][n], 0, 0, 0); } } \
        __builtin_amdgcn_s_setprio(0); } while (0)
#define PG8_WAIT_V(n) asm volatile("s_waitcnt vmcnt(" #n ")" ::: "memory")
#define PG8_WAIT_L(n) asm volatile("s_waitcnt lgkmcnt(" #n ")" ::: "memory")
#define PG8_BAR __builtin_amdgcn_s_barrier()
#define PG8_SCHED __builtin_amdgcn_sched_barrier(0)
#define PG8_STAGE_A(bufoff, TS, H) do { if constexpr (GATHER) { PG8_STAGE(bufoff, gA##TS, oA##TS[H]); } else { PG8_STAGE(bufoff, a##TS + (H) * hA##TS, voffA); } } while (0)
    Unit cur, nxt; int ui = 0;
    if (!S.next(0, cur)) return;
    f32x4 acc[2][2][4][2];
#pragma unroll
    for (int a = 0; a < 2; ++a)
#pragma unroll
        for (int b = 0; b < 2; ++b)
#pragma unroll
            for (int m = 0; m < 4; ++m)
#pragma unroll
                for (int n = 0; n < 2; ++n) acc[a][b][m][n] = (f32x4){0.f, 0.f, 0.f, 0.f};
    bf16x8 At[4][2], B0[2][2], B1[2][2];
    const char* Abase = uni_ptr(S.abase());
    unsigned aoC[2][2] = {{0u, 0u}, {0u, 0u}}, aoN[2][2] = {{0u, 0u}, {0u, 0u}};
    if constexpr (GATHER) {
#pragma unroll
        for (int h = 0; h < 2; ++h)
#pragma unroll
            for (int i = 0; i < 2; ++i) aoC[h][i] = (unsigned)(S.arow(cur, h * HALF + RA[i]) * K + CA[i]) * 2u;
    }
    size_t hAc = cur.sub ? 0 : hstep, hBc = hAc, hAn = hAc, hBn = hAc;
    const char* cA = GATHER ? Abase : uni_ptr(S.aptr(cur) + (cur.sub ? cur.ah * hstep : 0)); const char* cB = uni_ptr(S.bptr(cur) + (cur.sub ? cur.hb * hstep : 0));
    if constexpr (GATHER) {
        PG8_STAGE(PG8_SB(0, 0), cB, voffB); PG8_STAGE(PG8_SA(0, 0), Abase, aoC[0]); PG8_STAGE(PG8_SB(0, 1), cB + hstep, voffB); PG8_STAGE(PG8_SA(0, 1), Abase, aoC[1]);
    } else {
        PG8_STAGE(PG8_SB(0, 0), cB, voffB); PG8_STAGE(PG8_SA(0, 0), cA, voffA); PG8_STAGE(PG8_SB(0, 1), cB + hBc, voffB); PG8_STAGE(PG8_SA(0, 1), cA + hAc, voffA);
    }
    if (wr == 1) PG8_BAR;
    PG8_WAIT_V(4); PG8_BAR;
    if constexpr (GATHER) {
        PG8_STAGE(PG8_SB(1, 0), cB + kstep, voffB); PG8_STAGE(PG8_SA(1, 0), Abase + kstep, aoC[0]); PG8_STAGE(PG8_SB(1, 1), cB + hstep + kstep, voffB);
    } else {
        PG8_STAGE(PG8_SB(1, 0), cB + kstep, voffB); PG8_STAGE(PG8_SA(1, 0), cA + kstep, voffA); PG8_STAGE(PG8_SB(1, 1), cB + hBc + kstep, voffB);
    }
    PG8_WAIT_V(6); PG8_BAR;
    for (;;) {
        const bool has_next = S.next(ui + 1, nxt);
        const char* nA = uni_ptr(has_next ? (GATHER ? Abase : S.aptr(nxt) + (nxt.sub ? nxt.ah * hstep : 0)) : cA); const char* nB = uni_ptr(has_next ? S.bptr(nxt) + (nxt.sub ? nxt.hb * hstep : 0) : cB);
        hAn = has_next ? (nxt.sub ? 0 : hstep) : hAc; hBn = hAn;
        if constexpr (GATHER) {
            if (has_next) {
#pragma unroll
                for (int h = 0; h < 2; ++h)
#pragma unroll
                    for (int i = 0; i < 2; ++i) aoN[h][i] = (unsigned)(S.arow(nxt, h * HALF + RA[i]) * K + CA[i]) * 2u;
            } else {
#pragma unroll
                for (int h = 0; h < 2; ++h)
#pragma unroll
                    for (int i = 0; i < 2; ++i) aoN[h][i] = aoC[h][i];
            }
        }
        for (int t = 0; t < nt; t += 2) {
            const bool last = (t == nt - 2);
            const char* a1 = cA + (size_t)(t + 1) * kstep;
            const char* a2 = last ? nA : cA + (size_t)(t + 2) * kstep; const char* b2 = last ? nB : cB + (size_t)(t + 2) * kstep;
            const char* a3 = a2 + kstep; const char* b3 = b2 + kstep;
            const size_t hA1 = hAc, hA2 = last ? hAn : hAc, hA3 = hA2, hB2 = last ? hBn : hBc; (void)hA1; (void)hA3;
            const char* gA1 = Abase + (size_t)(t + 1) * kstep; const char* gA2 = Abase + (last ? (size_t)0 : (size_t)(t + 2) * kstep); const char* gA3 = gA2 + kstep;
            unsigned oA1[2][2], oA2[2][2], oA3[2][2];
#pragma unroll
            for (int h = 0; h < 2; ++h)
#pragma unroll
                for (int i = 0; i < 2; ++i) { oA1[h][i] = aoC[h][i]; oA2[h][i] = last ? aoN[h][i] : aoC[h][i]; oA3[h][i] = oA2[h][i]; }
            (void)a1; (void)a3; (void)gA1; (void)gA3; (void)oA1; (void)oA3;
            PG8_LDB(B0, 0, 0); PG8_SCHED; PG8_LDA(At, 0, 0); PG8_STAGE_A(PG8_SA(1, 1), 1, 1);
            PG8_WAIT_L(8); PG8_BAR; PG8_WAIT_L(0); PG8_MMA(0, 0, At, B0); PG8_BAR; PG8_SCHED;
            PG8_LDB(B1, 0, 1); PG8_STAGE(PG8_SB(0, 0), b2, voffB);
            PG8_BAR; PG8_WAIT_L(0); if (!cur.sub) PG8_MMA(0, 1, At, B1); PG8_BAR;
            PG8_LDA(At, 0, 1); PG8_STAGE_A(PG8_SA(0, 0), 2, 0);
            PG8_BAR; PG8_WAIT_L(0); if (!cur.sub) PG8_MMA(1, 0, At, B0); PG8_BAR; PG8_SCHED;
            PG8_STAGE(PG8_SB(0, 1), b2 + hB2, voffB);
            PG8_WAIT_V(6); PG8_BAR; if (!cur.sub) PG8_MMA(1, 1, At, B1); PG8_BAR;
            PG8_LDB(B0, 1, 0); PG8_SCHED; PG8_LDA(At, 1, 0); PG8_STAGE_A(PG8_SA(0, 1), 2, 1);
            PG8_WAIT_L(8); PG8_BAR; PG8_WAIT_L(0); PG8_MMA(0, 0, At, B0); PG8_BAR; PG8_SCHED;
            PG8_LDB(B1, 1, 1); PG8_STAGE(PG8_SB(1, 0), b3, voffB);
            PG8_BAR; PG8_WAIT_L(0); if (!cur.sub) PG8_MMA(0, 1, At, B1); PG8_BAR;
            PG8_LDA(At, 1, 1); PG8_STAGE_A(PG8_SA(1, 0), 3, 0);
            PG8_BAR; PG8_WAIT_L(0); if (!cur.sub) PG8_MMA(1, 0, At, B0); PG8_BAR; PG8_SCHED;
            PG8_STAGE(PG8_SB(1, 1), b3 + hB2, voffB);
            PG8_WAIT_V(6); PG8_BAR; if (!cur.sub) PG8_MMA(1, 1, At, B1); PG8_BAR;
        }
        { int t2 = tid; asm volatile("" : "+v"(t2)); const int l2 = t2 & 63; E(acc, cur, wr, wc, l2 & 15, l2 >> 4); }
        if (!has_next) break;
#pragma unroll
        for (int a = 0; a < 2; ++a)
#pragma unroll
            for (int b = 0; b < 2; ++b)
#pragma unroll
                for (int m = 0; m < 4; ++m)
#pragma unroll
                    for (int n = 0; n < 2; ++n) acc[a][b][m][n] = (f32x4){0.f, 0.f, 0.f, 0.f};
        cur = nxt; cA = nA; cB = nB; hAc = hAn; hBc = hBn; ++ui;
        if constexpr (GATHER) {
#pragma unroll
            for (int h = 0; h < 2; ++h)
#pragma unroll
                for (int i = 0; i < 2; ++i) aoC[h][i] = aoN[h][i];
        }
    }
    PG8_WAIT_V(0);
    if (wr == 0) PG8_BAR;
    PG8_BAR;
#undef PG8_SA
#undef PG8_SB
#undef PG8_STAGE
#undef PG8_STAGE_A
#undef PG8_LDA
#undef PG8_LDB
#undef PG8_MMA
#undef PG8_WAIT_V
#undef PG8_WAIT_L
#undef PG8_BAR
#undef PG8_SCHED
}
}

struct Frame {
    LAS unsigned char* lds; int tid, lane, wave, G, bid, gw, nw;
    unsigned char* ws;
};
extern __shared__ __attribute__((aligned(16))) unsigned char lds_raw[];
typedef const __attribute__((address_space(4))) Params* KP;
__device__ __forceinline__ Params load_params(const void* kp_) {
    const unsigned long long v = (unsigned long long)kp_;
    const unsigned lo = __builtin_amdgcn_readfirstlane((unsigned)v), hi = __builtin_amdgcn_readfirstlane((unsigned)(v >> 32));
    KP kp = (KP)(((unsigned long long)hi << 32) | lo);
    Params P;
#pragma unroll
    for (int i = 0; i < 35; ++i) P.in[i] = kp->in[i];
    P.out = kp->out; P.ws = kp->ws; P.ph_lo = kp->ph_lo; P.ph_hi = kp->ph_hi;
    return P;
}
#define PHASE static __attribute__((noinline)) __device__ void
#define PHASE_INL static __device__ __forceinline__ void
__device__ __forceinline__ Frame make_frame(unsigned char* ws, int wave_) {
    Frame F; F.lds = (LAS unsigned char*)lds_raw; F.wave = __builtin_amdgcn_readfirstlane(wave_);
    int t_ = F.wave * 64 + lane_id_here(); asm volatile("" : "+v"(t_));
    F.tid = t_; F.lane = F.tid & 63;
    F.G = gridDim.x; F.bid = blockIdx.x; F.gw = F.bid * NWAVES + F.wave; F.nw = F.G * NWAVES; F.ws = ws; return F;
}
__device__ __forceinline__ Frame sub_frame(Frame F, int bid, int G) { F.bid = bid; F.G = G; F.gw = F.bid * NWAVES + F.wave; F.nw = F.G * NWAVES; return F; }
#define PHASE_ENTER const Params P = load_params(kp_); const Frame F = make_frame(P.ws, wv_)

__device__ __forceinline__ void conv_job(const Frame& F, const float* src, bf16_t* dst, int K, int N, int mode) {
    LAS float* tile = (LAS float*)(F.lds + F.wave * (64 * 65 * 4));
    const int tk = K / 64, tn = N / 64, ntile = tk * tn, lane = F.lane;
    for (int t = F.gw; t < ntile; t += F.nw) {
        const int k0 = (t / tn) * 64, n0 = (t % tn) * 64;
#pragma unroll 4
        for (int i = 0; i < 16; ++i) { const int row = i * 4 + (lane >> 4), c4 = (lane & 15) * 4;
            const f32x4 v = *(const f32x4*)(src + (size_t)(k0 + row) * N + n0 + c4);
            tile[row * 65 + c4 + 0] = v[0]; tile[row * 65 + c4 + 1] = v[1]; tile[row * 65 + c4 + 2] = v[2]; tile[row * 65 + c4 + 3] = v[3]; }
        __builtin_amdgcn_wave_barrier(); asm volatile("s_waitcnt lgkmcnt(0)" ::: "memory");
#pragma unroll 2
        for (int i = 0; i < 8; ++i) { const int n = i * 8 + (lane >> 3), kc = (lane & 7) * 8;
            float f[8];
#pragma unroll
            for (int j = 0; j < 8; ++j) f[j] = tile[(kc + j) * 65 + n];
            const int ng = n0 + n; const int drow = mode == 0 ? ng : ((ng >> 7) * 256 + (mode == 2 ? 128 : 0) + (ng & 127));
            u32x4 w; w.x = pk_bf16(f[0], f[1]); w.y = pk_bf16(f[2], f[3]); w.z = pk_bf16(f[4], f[5]); w.w = pk_bf16(f[6], f[7]);
            *(u32x4*)(dst + (size_t)drow * K + k0 + kc) = w; }
        __builtin_amdgcn_wave_barrier(); asm volatile("s_waitcnt lgkmcnt(0)" ::: "memory");
    }
}

__device__ __forceinline__ void conv_job_fp8(const Frame& F, const float* src, unsigned char* dst, int K, int N, int mode, float scale) {
    LAS float* tile = (LAS float*)(F.lds + F.wave * (64 * 65 * 4));
    const int tk = K / 64, tn = N / 64, ntile = tk * tn, lane = F.lane;
    for (int t = F.gw; t < ntile; t += F.nw) {
        const int k0 = (t / tn) * 64, n0 = (t % tn) * 64;
#pragma unroll 4
        for (int i = 0; i < 16; ++i) { const int row = i * 4 + (lane >> 4), c4 = (lane & 15) * 4;
            const f32x4 v = *(const f32x4*)(src + (size_t)(k0 + row) * N + n0 + c4);
            tile[row * 65 + c4 + 0] = v[0]; tile[row * 65 + c4 + 1] = v[1]; tile[row * 65 + c4 + 2] = v[2]; tile[row * 65 + c4 + 3] = v[3]; }
        __builtin_amdgcn_wave_barrier(); asm volatile("s_waitcnt lgkmcnt(0)" ::: "memory");
#pragma unroll 2
        for (int i = 0; i < 8; ++i) { const int n = i * 8 + (lane >> 3), kc = (lane & 7) * 8;
            float f[8];
#pragma unroll
            for (int j = 0; j < 8; ++j) f[j] = tile[(kc + j) * 65 + n] * scale;
            const int ng = n0 + n; const int drow = mode == 0 ? ng : ((ng >> 7) * 256 + (mode == 2 ? 128 : 0) + (ng & 127));
            u32x2 w; w.x = pk4_fp8(f[0], f[1], f[2], f[3]); w.y = pk4_fp8(f[4], f[5], f[6], f[7]);
            *(u32x2*)(dst + (size_t)drow * K + k0 + kc) = w; }
        __builtin_amdgcn_wave_barrier(); asm volatile("s_waitcnt lgkmcnt(0)" ::: "memory");
    }
}

__device__ __forceinline__ void phase_prologue(const Frame& F, const Params& P) {
    float* modv = (float*)(F.ws + WS_MODV);
    LAS float* s = (LAS float*)F.lds;
    LAS float* red = (LAS float*)(F.lds + 9 * 1024 * 4);
    for (int cb = F.bid; cb < (2 * MODW) / 64; cb += F.G) {
        for (int i = F.tid; i < 9 * 1024; i += NTHREADS) { const int mi = i >> 10, k = i & 1023; const float c = mi < 8 ? P.in[I_C][mi * D + k] : P.in[I_CCTX][k]; s[i] = siluf_(c); }
        __syncthreads();
        const int colg = cb * 64 + F.lane, l = colg / MODW, col = colg % MODW;
        const float* w = P.in[I_MODW] + (size_t)l * D * MODW + col;
        float acc[9];
#pragma unroll
        for (int mi = 0; mi < 9; ++mi) acc[mi] = 0.f;
        const int kb = F.wave * 128;
#pragma unroll 8
        for (int k = 0; k < 128; ++k) { const float wv = w[(size_t)(kb + k) * MODW];
#pragma unroll
            for (int mi = 0; mi < 9; ++mi) acc[mi] += s[mi * 1024 + kb + k] * wv; }
#pragma unroll
        for (int mi = 0; mi < 9; ++mi) red[(F.wave * 9 + mi) * 64 + F.lane] = acc[mi];
        __syncthreads();
        for (int i = F.tid; i < 9 * 64; i += NTHREADS) { const int mi = i >> 6, ln = i & 63; float a = 0.f;
#pragma unroll
            for (int w8 = 0; w8 < 8; ++w8) a += red[(w8 * 9 + mi) * 64 + ln];
            const int cg = cb * 64 + ln, l2 = cg / MODW, c2 = cg % MODW;
            modv[((size_t)l2 * 9 + mi) * MODW + c2] = a + P.in[I_MODB][l2 * MODW + c2]; }
        __syncthreads();
    }
    for (int l = 0; l < 2; ++l) {
        conv_job(F, P.in[I_WIN] + (size_t)l * D * INW, (bf16_t*)(F.ws + WS_BTIN) + (size_t)l * INW * D, D, INW, 0);
        conv_job(F, P.in[I_WOUT] + (size_t)l * D * D, (bf16_t*)(F.ws + WS_BTOUT) + (size_t)l * D * D, D, D, 0);
    }
    conv_job(F, P.in[I_FG], (bf16_t*)(F.ws + WS_BTGU), D, DFF, 1);
    conv_job(F, P.in[I_FU], (bf16_t*)(F.ws + WS_BTGU), D, DFF, 2);
    conv_job(F, P.in[I_FD], (bf16_t*)(F.ws + WS_BTDN), DFF, D, 0);
    for (int ld = 0; ld < 4; ++ld) { bf16_t* base = (bf16_t*)(F.ws + WS_LORA + (size_t)ld * LORA_LD_BYTES);
        conv_job(F, P.in[I_W2] + (size_t)ld * 64 * 256, base, 64, 256, 0);
        conv_job(F, P.in[I_A2] + (size_t)ld * 64 * 256, base + 256 * 64, 64, 256, 0);
        conv_job(F, P.in[I_G2] + (size_t)ld * 128 * 256, base + 2 * 256 * 64, 128, 256, 0); }
}
__device__ __forceinline__ void phase_moe_convert(const Frame& F, const Params& P) {
    for (int e = 0; e < NEXP; ++e) {
        unsigned char* gu = F.ws + WS_MOE + (size_t)e * MOE8_E_BYTES; unsigned char* dn = gu + MOE8_GU_BYTES;
        conv_job_fp8(F, P.in[I_MG] + (size_t)e * D * DFE, gu, D, DFE, 1, MOE8_GU_SCALE);
        conv_job_fp8(F, P.in[I_MU] + (size_t)e * D * DFE, gu, D, DFE, 2, MOE8_GU_SCALE);
        conv_job_fp8(F, P.in[I_MD] + (size_t)e * DFE * D, dn, DFE, D, 0, MOE8_DN_SCALE);
    }
}

template <bool ROUTER>
__device__ __forceinline__ void phase_norm(const Frame& F, const Params& P, int l, int which, int nrows, const float* srcL, const float* srcC) {
    const float* g = (which == 0 ? P.in[I_N1G] : P.in[I_N2G]) + l * D;
    const float* modv = (const float*)(F.ws + WS_MODV) + (size_t)l * 9 * MODW + (which == 0 ? 0 : 3 * D);
    bf16_t* HL = (bf16_t*)(F.ws + WS_HL);
    LAS float* rt = (LAS float*)F.lds;
    if (ROUTER) {
        for (int i = F.tid; i < D * NEXP; i += NTHREADS) rt[i] = P.in[I_ROUTER][i];
        int* rmap = (int*)(F.ws + WS_ROUTE + RT_RMAP);
        for (int i = F.bid * NTHREADS + F.tid; i < 2 * NROW; i += F.G * NTHREADS) rmap[i] = -1;
        __syncthreads();
    }
    const int lane = F.lane;
    for (int r = F.gw; r < nrows; r += F.nw) {
        const float* xr = r < NLAT ? srcL + (size_t)r * D : srcC + (size_t)(r - NLAT) * D;
        const float* mv = modv + (size_t)row_mi(r) * MODW;
        f32x4 x[4]; float ss = 0.f;
#pragma unroll
        for (int j = 0; j < 4; ++j) { x[j] = *(const f32x4*)(xr + j * 256 + lane * 4); ss += x[j][0] * x[j][0] + x[j][1] * x[j][1] + x[j][2] * x[j][2] + x[j][3] * x[j][3]; }
        ss = wave_sum(ss);
        const float rstd = rsqrtf(ss * (1.0f / D) + 1e-6f);
        float lg[NEXP];
        if (ROUTER) {
#pragma unroll
            for (int e = 0; e < NEXP; ++e) lg[e] = 0.f;
        }
#pragma unroll
        for (int j = 0; j < 4; ++j) { const int c = j * 256 + lane * 4;
            const f32x4 gg = *(const f32x4*)(g + c), sh = *(const f32x4*)(mv + c), sc = *(const f32x4*)(mv + D + c);
            f32x4 y = (x[j] * rstd * gg) * (sc + 1.0f) + sh;
            if (ROUTER) { *(unsigned*)((unsigned char*)HL + (size_t)r * D + c) = pk4_fp8(y[0], y[1], y[2], y[3]); }
            else { u32x2 w; w.x = pk_bf16(y[0], y[1]); w.y = pk_bf16(y[2], y[3]); *(u32x2*)(HL + (size_t)r * D + c) = w; }
            if (ROUTER) {
#pragma unroll
                for (int q = 0; q < 4; ++q) { const f32x4 r0 = *(const LAS f32x4*)(rt + (c + q) * 8), r1 = *(const LAS f32x4*)(rt + (c + q) * 8 + 4);
                    lg[0] += y[q] * r0[0]; lg[1] += y[q] * r0[1]; lg[2] += y[q] * r0[2]; lg[3] += y[q] * r0[3];
                    lg[4] += y[q] * r1[0]; lg[5] += y[q] * r1[1]; lg[6] += y[q] * r1[2]; lg[7] += y[q] * r1[3]; asm volatile("" ::: "memory"); }
            }
        }
        if (ROUTER) {
#pragma unroll
            for (int e = 0; e < NEXP; ++e) lg[e] = wave_sum(lg[e]);
            if (lane == 0) {
                int e1 = 0; float l1 = lg[0];
#pragma unroll
                for (int e = 1; e < NEXP; ++e) if (lg[e] > l1) { l1 = lg[e]; e1 = e; }
                int e2 = -1; float l2 = -3.0e38f;
#pragma unroll
                for (int e = 0; e < NEXP; ++e) if (e != e1 && lg[e] > l2) { l2 = lg[e]; e2 = e; }
                if (e2 < 0) { e2 = e1 == 0 ? 1 : 0; l2 = l1; }
                const float ex = __expf(l2 - l1), g1 = 1.0f / (1.0f + ex), g2 = ex * g1;
                unsigned* cnt = (unsigned*)(F.ws + WS_CTL) + CW_MOECNT;
                const unsigned p1 = atomicAdd(cnt + e1, 1u), p2 = atomicAdd(cnt + 8 + e2, 1u);
                int* te = (int*)(F.ws + WS_ROUTE + RT_TOKE); float* tg = (float*)(F.ws + WS_ROUTE + RT_TOKG); int* tp = (int*)(F.ws + WS_ROUTE + RT_TOKP);
                te[r * 2] = e1; te[r * 2 + 1] = e2; tg[r * 2] = g1; tg[r * 2 + 1] = g2; tp[r * 2] = (int)p1; tp[r * 2 + 1] = (int)p2;
            }
        }
    }
}
__device__ __forceinline__ void moe_tstart(const Frame& F, int pass, int (&ts)[9]) {
    const unsigned* cnt = (const unsigned*)(F.ws + WS_CTL) + CW_MOECNT + pass * 8;
    int a = 0;
#pragma unroll
    for (int e = 0; e < 8; ++e) { ts[e] = a; a += (int)((__hip_atomic_load(cnt + e, __ATOMIC_RELAXED, __HIP_MEMORY_SCOPE_AGENT) + 255u) >> 8); }
    ts[8] = a;
}
__device__ __forceinline__ void phase_moe_rowmap(const Frame& F) {
    int ts0[9], ts1[9]; moe_tstart(F, 0, ts0); moe_tstart(F, 1, ts1);
    const int* te = (const int*)(F.ws + WS_ROUTE + RT_TOKE); const float* tg = (const float*)(F.ws + WS_ROUTE + RT_TOKG); const int* tp = (const int*)(F.ws + WS_ROUTE + RT_TOKP);
    int* rmap = (int*)(F.ws + WS_ROUTE + RT_RMAP); float* sg = (float*)(F.ws + WS_ROUTE + RT_SGATE);
    for (int t = F.bid * NTHREADS + F.tid; t < NLAT; t += F.G * NTHREADS) {
        { const int e = te[t * 2]; int st = 0;
#pragma unroll
          for (int j = 0; j < 8; ++j) st = (e == j) ? ts0[j] : st;
          const int slot = st * 256 + tp[t * 2]; rmap[slot] = t; sg[slot] = tg[t * 2]; }
        { const int e = te[t * 2 + 1]; int st = 0;
#pragma unroll
          for (int j = 0; j < 8; ++j) st = (e == j) ? ts1[j] : st;
          const int slot = st * 256 + tp[t * 2 + 1]; rmap[NROW + slot] = t; sg[NROW + slot] = tg[t * 2 + 1]; }
    }
    const unsigned char* HL8 = F.ws + WS_HL; unsigned char* HLG = F.ws + WS_HLG;
#pragma unroll 4
    for (int t = F.gw; t < NLAT; t += F.nw) {
        const int e0 = te[t * 2], e1 = te[t * 2 + 1]; int s0 = 0, s1 = 0;
#pragma unroll
        for (int j = 0; j < 8; ++j) { s0 = (e0 == j) ? ts0[j] : s0; s1 = (e1 == j) ? ts1[j] : s1; }
        const u32x4 v = *(const u32x4*)(HL8 + (size_t)t * D + F.lane * 16);
        *(u32x4*)(HLG + (size_t)(s0 * 256 + tp[t * 2]) * D + F.lane * 16) = v;
        *(u32x4*)(HLG + (size_t)(NROW + s1 * 256 + tp[t * 2 + 1]) * D + F.lane * 16) = v;
    }
    const unsigned* cnt = (const unsigned*)(F.ws + WS_CTL) + CW_MOECNT;
    for (int i = F.gw; i < 2 * 8 * 256; i += F.nw) {
        const int pe = i >> 8, r = i & 255, e = pe & 7; const int c = (int)__hip_atomic_load(cnt + pe, __ATOMIC_RELAXED, __HIP_MEMORY_SCOPE_AGENT);
        int st = 0;
#pragma unroll
        for (int j = 0; j < 8; ++j) st = (e == j) ? (pe < 8 ? ts0[j] : ts1[j]) : st;
        if ((c & 255) != 0 && r >= (c & 255)) *(u32x4*)(HLG + (size_t)((pe >> 3) * NROW + st * 256 + (c & ~255) + r) * D + F.lane * 16) = (u32x4){0u, 0u, 0u, 0u};
    }
}

struct RowGeo { int b, tt, pos, len; };
__device__ __forceinline__ RowGeo row_geo(int r) { RowGeo g; if (r < NLAT) { g.b = r >> 12; g.pos = r & 4095; g.len = SEQ; g.tt = CTXL + g.pos; } else { const int q = r - NLAT; g.b = q >> 8; g.pos = q & 255; g.len = CTXL; g.tt = g.pos; } return g; }

__device__ __forceinline__ void rw_shift4(const bf16_t* PL, const float* mup, const float* mun, int r, const RowGeo& g, int j, float (&u)[4]) {
    const bf16_t* p = PL + (size_t)r * INW + O_RW + j;
    const bool hp = g.pos > 0, hn = g.pos < g.len - 1;
    float c[4], pv[4], nv[4];
    unpack4(*(const u32x2*)p, c); unpack4(*(const u32x2*)(p - (hp ? INW : 0)), pv); unpack4(*(const u32x2*)(p + (hn ? INW : 0)), nv);
    const f32x4 mp = *(const f32x4*)(mup + j), mn = *(const f32x4*)(mun + j);
#pragma unroll
    for (int q = 0; q < 4; ++q) u[q] = c[q] + mp[q] * ((hp ? pv[q] : 0.f) - c[q]) + mn[q] * ((hn ? nv[q] : 0.f) - c[q]);
}

__device__ __forceinline__ void rw_shift8(const bf16_t* PL, const float* mup, const float* mun, int r, const RowGeo& g, int j, float (&u)[8]) {
    const bf16_t* p = PL + (size_t)r * INW + O_RW + j;
    const bool hp = g.pos > 0, hn = g.pos < g.len - 1;
    float c[8], pv[8], nv[8];
    unpack8(*(const u32x4*)p, c); unpack8(*(const u32x4*)(p - (hp ? INW : 0)), pv); unpack8(*(const u32x4*)(p + (hn ? INW : 0)), nv);
    const f32x4 mp0 = *(const f32x4*)(mup + j), mp1 = *(const f32x4*)(mup + j + 4), mn0 = *(const f32x4*)(mun + j), mn1 = *(const f32x4*)(mun + j + 4);
#pragma unroll
    for (int q = 0; q < 4; ++q) { u[q] = c[q] + mp0[q] * ((hp ? pv[q] : 0.f) - c[q]) + mn0[q] * ((hn ? nv[q] : 0.f) - c[q]);
        u[4 + q] = c[4 + q] + mp1[q] * ((hp ? pv[4 + q] : 0.f) - c[4 + q]) + mn1[q] * ((hn ? nv[4 + q] : 0.f) - c[4 + q]); }
}
__device__ __forceinline__ bf16x8 pack8f(const float (&f)[8]) {
    u32x4 w; w.x = cvt_pk_bf16(f[0], f[1]); w.y = cvt_pk_bf16(f[2], f[3]); w.z = cvt_pk_bf16(f[4], f[5]); w.w = cvt_pk_bf16(f[6], f[7]); return __builtin_bit_cast(bf16x8, w);
}
constexpr int RL_MUP = 0, RL_MUN = 5120, RL_KK = 10240, RL_KA = 11264, RL_W0 = 12288, RL_A0 = 14336, RL_RK = 16384, RL_GNG = 17408, RL_GNB = 18432, RL_END = 19456;
__device__ __forceinline__ void rw_stage_tables(const Frame& F, const Params& P, int l) {
    LAS float* T = (LAS float*)F.lds;
    for (int i = F.tid; i < 1280; i += NTHREADS) { T[RL_MUP / 4 + i] = P.in[I_MUP][l * 1280 + i]; T[RL_MUN / 4 + i] = P.in[I_MUN][l * 1280 + i]; }
    for (int i = F.tid; i < 256; i += NTHREADS) { T[RL_KK / 4 + i] = P.in[I_KK][l * 256 + i]; T[RL_KA / 4 + i] = P.in[I_KA][l * 256 + i]; T[RL_RK / 4 + i] = P.in[I_RK][l * 256 + i];
        T[RL_GNG / 4 + i] = P.in[I_GNG][l * 256 + i]; T[RL_GNB / 4 + i] = P.in[I_GNB][l * 256 + i]; }
    for (int i = F.tid; i < 512; i += NTHREADS) { T[RL_W0 / 4 + i] = P.in[I_W0][l * 512 + i]; T[RL_A0 / 4 + i] = P.in[I_A0][l * 512 + i]; }
    __syncthreads();
}
__device__ __forceinline__ void rw_mix8(const LAS float* T, const u32x4 (&raw)[3], bool hp, bool hn, int j, float (&u)[8]) {
    float c[8], pv[8], nv[8]; unpack8(raw[0], c); unpack8(raw[1], pv); unpack8(raw[2], nv);
    const f32x4 mp0 = *(const LAS f32x4*)(T + RL_MUP / 4 + j), mp1 = *(const LAS f32x4*)(T + RL_MUP / 4 + j + 4), mn0 = *(const LAS f32x4*)(T + RL_MUN / 4 + j), mn1 = *(const LAS f32x4*)(T + RL_MUN / 4 + j + 4);
#pragma unroll
    for (int q = 0; q < 4; ++q) { u[q] = c[q] + mp0[q] * ((hp ? pv[q] : 0.f) - c[q]) + mn0[q] * ((hn ? nv[q] : 0.f) - c[q]);
        u[4 + q] = c[4 + q] + mp1[q] * ((hp ? pv[4 + q] : 0.f) - c[4 + q]) + mn1[q] * ((hn ? nv[4 + q] : 0.f) - c[4 + q]); }
}
__device__ __forceinline__ void rw_mix4(const LAS float* T, const u32x2 (&raw)[3], bool hp, bool hn, int j, float (&u)[4]) {
    float c[4], pv[4], nv[4]; unpack4(raw[0], c); unpack4(raw[1], pv); unpack4(raw[2], nv);
    const f32x4 mp = *(const LAS f32x4*)(T + RL_MUP / 4 + j), mn = *(const LAS f32x4*)(T + RL_MUN / 4 + j);
#pragma unroll
    for (int q = 0; q < 4; ++q) u[q] = c[q] + mp[q] * ((hp ? pv[q] : 0.f) - c[q]) + mn[q] * ((hn ? nv[q] : 0.f) - c[q]);
}
__device__ __forceinline__ void phase_rw_prep(const Frame& F, const Params& P, int l) {
    const bf16_t* PL = (const bf16_t*)(F.ws + WS_PL);
    f16_t* SH = (f16_t*)(F.ws + WS_SH); f16_t* SD = (f16_t*)(F.ws + WS_SD);
    const int lane = F.lane;
    rw_stage_tables(F, P, l);
    const LAS float* T = (const LAS float*)F.lds;
    for (int item = F.gw; item < NLAT / 16 + (NCTX / 16) * 4; item += F.nw) {
        const int tile = item < NLAT / 16 ? item : NLAT / 16 + ((item - NLAT / 16) >> 2), h0 = item < NLAT / 16 ? 0 : ((item - NLAT / 16) & 3), h1 = item < NLAT / 16 ? 4 : h0 + 1;
        int l1 = lane; asm volatile("" : "+v"(l1)); const int tk = l1 & 15, g = l1 >> 4;
        const int r = tile * 16 + tk; const RowGeo geo = row_geo(r);
        const bool hp = geo.pos > 0, hn = geo.pos < geo.len - 1;
        const bf16_t* prow = PL + (size_t)r * INW + O_RW; const int dprev = hp ? -INW : 0, dnext = hn ? INW : 0;
        bf16x8 tw[2][2], ta[2][2];
#pragma unroll
        for (int d = 0; d < 2; ++d) { u32x4 raw[4][3];
#pragma unroll
          for (int i = 0; i < 4; ++i) { const bf16_t* p = prow + 768 + 256 * d + 64 * (i & 1) + 32 * (i >> 1) + 8 * g;
              raw[i][0] = *(const u32x4*)p; raw[i][1] = *(const u32x4*)(p + dprev); raw[i][2] = *(const u32x4*)(p + dnext); }
#pragma unroll
          for (int i = 0; i < 4; ++i) { float u[8]; rw_mix8(T, raw[i], hp, hn, 768 + 256 * d + 64 * (i & 1) + 32 * (i >> 1) + 8 * g, u);
              if ((i & 1) == 0) {
#pragma unroll
                  for (int q = 0; q < 8; ++q) u[q] = 1.0f - 2.0f / (1.0f + __expf(2.0f * u[q]));
                  tw[d][i >> 1] = pack8f(u); }
              else ta[d][i >> 1] = pack8f(u); }
          asm volatile("" ::: "memory"); }
        asm volatile("" ::: "memory");
#pragma unroll 1
        for (int h = h0; h < h1; ++h) {
            int l2 = lane; asm volatile("" : "+v"(l2)); const int tk = l2 & 15, g = l2 >> 4;
            const int r = tile * 16 + tk; const RowGeo geo = row_geo(r);
            const bool hp = geo.pos > 0, hn = geo.pos < geo.len - 1;
            const bf16_t* prow = PL + (size_t)r * INW + O_RW + 64 * h + 8 * g; const int dprev = hp ? -INW : 0, dnext = hn ? INW : 0;
            float ur[4][4], uk[4][4], uv[4][4], kkv[4][4]; float ss = 0.f;
            { u32x4 raw[6][3];
#pragma unroll
              for (int i = 0; i < 6; ++i) { const bf16_t* p = prow + 256 * (i >> 1) + 32 * (i & 1);
                  raw[i][0] = *(const u32x4*)p; raw[i][1] = *(const u32x4*)(p + dprev); raw[i][2] = *(const u32x4*)(p + dnext); }
#pragma unroll
              for (int u = 0; u < 2; ++u) { float x8[8]; const int c = 64 * h + 32 * u + 8 * g;
                  rw_mix8(T, raw[u], hp, hn, c, x8);
#pragma unroll
                  for (int e = 0; e < 8; ++e) ur[2 * u + (e >> 2)][e & 3] = x8[e];
                  rw_mix8(T, raw[2 + u], hp, hn, 256 + c, x8);
#pragma unroll
                  for (int e = 0; e < 8; ++e) uk[2 * u + (e >> 2)][e & 3] = x8[e];
                  rw_mix8(T, raw[4 + u], hp, hn, 512 + c, x8);
#pragma unroll
                  for (int e = 0; e < 8; ++e) uv[2 * u + (e >> 2)][e & 3] = x8[e];
                  const f32x4 k0 = *(const LAS f32x4*)(T + RL_KK / 4 + c), k1 = *(const LAS f32x4*)(T + RL_KK / 4 + c + 4);
#pragma unroll
                  for (int q = 0; q < 4; ++q) { kkv[2 * u][q] = uk[2 * u][q] * k0[q]; kkv[2 * u + 1][q] = uk[2 * u + 1][q] * k1[q]; ss += kkv[2 * u][q] * kkv[2 * u][q] + kkv[2 * u + 1][q] * kkv[2 * u + 1][q]; } } }
            ss += __shfl_xor(ss, 16); ss += __shfl_xor(ss, 32);
            const float rn = rsqrtf(ss + 1e-12f);
            const size_t shrow = ((size_t)(geo.b * 4 + h) * TT + geo.tt) * 192;
#pragma unroll
            for (int u = 0; u < 2; ++u) { f16x8 o1, o2, o3;
#pragma unroll
                for (int e = 0; e < 8; ++e) { const int t = 2 * u + (e >> 2), q = e & 3; kkv[t][q] *= rn; o1[e] = (f16_t)ur[t][q]; o2[e] = (f16_t)uv[t][q]; o3[e] = (f16_t)(-kkv[t][q]); }
                f16_t* sp = SH + shrow + 32 * u + 8 * g; *(f16x8*)sp = o1; *(f16x8*)(sp + 64) = o2; *(f16x8*)(sp + 128) = o3; }
#pragma unroll 1
            for (int d = 0; d < 2; ++d) {
                const bf16_t* w2t = (const bf16_t*)(F.ws + WS_LORA + (size_t)(l * 2 + d) * LORA_LD_BYTES); const bf16_t* a2t = w2t + 256 * 64;
                const size_t sdrow = ((size_t)((d * 8 + geo.b) * 4 + h) * TT + geo.tt) * 192;
                const bf16x8 tw0 = d ? tw[1][0] : tw[0][0], tw1 = d ? tw[1][1] : tw[0][1], ta0 = d ? ta[1][0] : ta[0][0], ta1 = d ? ta[1][1] : ta[0][1];
                bf16x8 wf[4][2], af[4][2];
#pragma unroll
                for (int t = 0; t < 4; ++t) { const int wrow = 64 * h + 32 * (t >> 1) + 8 * (tk >> 2) + 4 * (t & 1) + (tk & 3);
                    const bf16_t* wr = w2t + (size_t)wrow * 64 + 8 * g; const bf16_t* ar = a2t + (size_t)wrow * 64 + 8 * g;
                    wf[t][0] = *(const bf16x8*)wr; wf[t][1] = *(const bf16x8*)(wr + 32); af[t][0] = *(const bf16x8*)ar; af[t][1] = *(const bf16x8*)(ar + 32); }
                f16x8 o1[2], o2[2], o3[2];
#pragma unroll
                for (int t = 0; t < 4; ++t) { const int c = 64 * h + 32 * (t >> 1) + 8 * g + 4 * (t & 1);
                    f32x4 xw = *(const LAS f32x4*)(T + RL_W0 / 4 + d * 256 + c), xa = *(const LAS f32x4*)(T + RL_A0 / 4 + d * 256 + c);
                    xw = __builtin_amdgcn_mfma_f32_16x16x32_bf16(wf[t][0], tw0, xw, 0, 0, 0); xw = __builtin_amdgcn_mfma_f32_16x16x32_bf16(wf[t][1], tw1, xw, 0, 0, 0);
                    xa = __builtin_amdgcn_mfma_f32_16x16x32_bf16(af[t][0], ta0, xa, 0, 0, 0); xa = __builtin_amdgcn_mfma_f32_16x16x32_bf16(af[t][1], ta1, xa, 0, 0, 0);
                    const f32x4 kaw = *(const LAS f32x4*)(T + RL_KA / 4 + c);
#pragma unroll
                    for (int q = 0; q < 4; ++q) {
                        const float nx = -xw[q]; const float sp = fmaxf(nx, 0.f) + __logf(1.0f + __expf(-fabsf(nx)));
                        const float e = __expf(-sp - 0.5f);
                        const float omw = 1.0f - __expf(-e);
                        const float a = sigmoidf_(xa[q]);
                        o1[t >> 1][(t & 1) * 4 + q] = (f16_t)omw; o2[t >> 1][(t & 1) * 4 + q] = (f16_t)(uk[t][q] * (1.0f + (a - 1.0f) * kaw[q])); o3[t >> 1][(t & 1) * 4 + q] = (f16_t)(kkv[t][q] * a); } }
#pragma unroll
                for (int u = 0; u < 2; ++u) { f16_t* sp = SD + sdrow + 32 * u + 8 * g; *(f16x8*)sp = o1[u]; *(f16x8*)(sp + 64) = o2[u]; *(f16x8*)(sp + 128) = o3[u]; }
                asm volatile("" ::: "memory");
            }
        }
    }
    __syncthreads();
}

constexpr int CS_ZP = 0, CS_RPP = 2048, CS_BH = 4096, CS_KH = 6144, CS_VV = 8192, CS_MT = 10240, CS_NT = 11264, CS_WC = 12288, CS_SLOT = 12544;
constexpr int CS_ZIMG = 8 * CS_SLOT;
constexpr int CS_NCHUNK = TT / 16;
__device__ __forceinline__ int cs_tt(int d, int q, int s) { const int st = 16 * q + s; return d == 0 ? st : (st < CTXL ? CTXL - 1 - st : TT + CTXL - 1 - st); }
__device__ __forceinline__ float dpp_shr(float old, float v, int) { return v; }
template <int N> __device__ __forceinline__ float row_shr(float v, float old) {
    return __builtin_bit_cast(float, __builtin_amdgcn_update_dpp(__builtin_bit_cast(int, old), __builtin_bit_cast(int, v), 0x110 + N, 0xF, 0xF, false));
}
__device__ __forceinline__ bf16x8 cs_pack(const float (&a)[4], const float (&b)[4]) {
    u32x4 w; w.x = cvt_pk_bf16(a[0], a[1]); w.y = cvt_pk_bf16(a[2], a[3]); w.z = cvt_pk_bf16(b[0], b[1]); w.w = cvt_pk_bf16(b[2], b[3]); return __builtin_bit_cast(bf16x8, w);
}
__device__ __forceinline__ bf16x8 cs_op16(const f32x4& x) { u32x4 w; w.x = cvt_pk_bf16(x[0], x[1]); w.y = cvt_pk_bf16(x[2], x[3]); w.z = 0u; w.w = 0u; return __builtin_bit_cast(bf16x8, w); }
#define CS_MFMA(a, b, c) __builtin_amdgcn_mfma_f32_16x16x32_bf16((a), (b), (c), 0, 0, 0)
__device__ __forceinline__ f32x4 cs_mm16(const f32x4& xt_d, const f32x4& y_d) { return CS_MFMA(cs_op16(xt_d), cs_op16(y_d), ((f32x4){0.f, 0.f, 0.f, 0.f})); }
__device__ __forceinline__ v4i16_t cs_tr(const LAS unsigned char* img, int lane, int T) {
    const int g = lane >> 4, q = (lane & 15) >> 2, p = lane & 3;
    return __builtin_amdgcn_ds_read_tr16_b64_v4i16((LAS v4i16_t*)(img + (4 * g + q) * 128 + p * 32 + (T >> 1) * 16 + (T & 1) * 8));
}
__device__ __forceinline__ bf16x8 cs_lo(v4i16_t x) { bf16x8 r; r[0] = x[0]; r[1] = x[1]; r[2] = x[2]; r[3] = x[3]; r[4] = 0; r[5] = 0; r[6] = 0; r[7] = 0; return r; }

struct CsRaw { u32x2 x[4], z[4], r[4], b[4], k[4], v[4]; };
__device__ __forceinline__ void cs_load(CsRaw& R, const f16_t* sh, const f16_t* sd, int d, int q, int lane) {
    const int s = lane & 15, g = lane >> 4; const int tt = cs_tt(d, q, s);
    const f16_t* shp = sh + (size_t)tt * 192 + 4 * g; const f16_t* sdp = sd + (size_t)tt * 192 + 4 * g;
#pragma unroll
    for (int T = 0; T < 4; ++T) { R.x[T] = *(const u32x2*)(sdp + 16 * T); R.z[T] = *(const u32x2*)(shp + 128 + 16 * T); R.r[T] = *(const u32x2*)(shp + 16 * T);
        R.b[T] = *(const u32x2*)(sdp + 128 + 16 * T); R.k[T] = *(const u32x2*)(sdp + 64 + 16 * T); R.v[T] = *(const u32x2*)(shp + 64 + 16 * T); }
}
__device__ __forceinline__ void cs_prepass(LAS unsigned char* slot, LAS unsigned char* zimg, CsRaw& raw, const f16_t* sh, const f16_t* sd, int d, int qn, int lane) {
    const int s = lane & 15, g = lane >> 4;
    float Wc[4][4], Wp[4][4], iW[4][4];
#pragma unroll
    for (int T = 0; T < 4; ++T) { const f16x4 x4 = __builtin_bit_cast(f16x4, raw.x[T]);
#pragma unroll
        for (int j = 0; j < 4; ++j) { float wc = 1.0f - (float)x4[j];
            wc *= row_shr<1>(wc, 1.0f); wc *= row_shr<2>(wc, 1.0f); wc *= row_shr<4>(wc, 1.0f); wc *= row_shr<8>(wc, 1.0f);
            Wc[T][j] = wc; Wp[T][j] = row_shr<1>(wc, 1.0f); iW[T][j] = __builtin_amdgcn_rcpf(wc); } }
    if (s == 15) {
#pragma unroll
        for (int T = 0; T < 4; ++T) *(LAS f32x4*)(slot + CS_WC + (16 * T + 4 * g) * 4) = (f32x4){Wc[T][0], Wc[T][1], Wc[T][2], Wc[T][3]}; }
    bf16x8 oZ[2], oR[2], oB[2], oK[2];
    const int ioff = s * 128 + g * 32;
#define CS_STAGE(dst, SRC, SC, IMG) do { float t_[4][4]; \
        _Pragma("unroll") for (int T = 0; T < 4; ++T) { const f16x4 q4 = __builtin_bit_cast(f16x4, SRC[T]); \
            _Pragma("unroll") for (int j = 0; j < 4; ++j) t_[T][j] = (float)q4[j] * SC; } \
        _Pragma("unroll") for (int kk = 0; kk < 2; ++kk) { dst[kk] = cs_pack(t_[2 * kk], t_[2 * kk + 1]); if (IMG) *(LAS bf16x8*)((IMG) + ioff + kk * 16) = dst[kk]; } \
        } while (0)
    CS_STAGE(oZ, raw.z, Wp[T][j], zimg);
    CS_STAGE(oR, raw.r, Wc[T][j], (LAS unsigned char*)nullptr);
    CS_STAGE(oB, raw.b, iW[T][j], slot + CS_BH);
    CS_STAGE(oK, raw.k, iW[T][j], slot + CS_KH);
    { bf16x8 oV[2]; CS_STAGE(oV, raw.v, 1.0f, slot + CS_VV); }
#undef CS_STAGE
    asm volatile("" ::: "memory");
    if (qn >= 0) cs_load(raw, sh, sd, d, qn, lane);
    const f32x4 zero4 = (f32x4){0.f, 0.f, 0.f, 0.f};
    f32x4 A_D = CS_MFMA(oB[1], oZ[1], CS_MFMA(oB[0], oZ[0], zero4)), AT_D = CS_MFMA(oZ[1], oB[1], CS_MFMA(oZ[0], oB[0], zero4));
    f32x4 BkT_D = CS_MFMA(oZ[1], oK[1], CS_MFMA(oZ[0], oK[0], zero4));
    f32x4 Ar_D = CS_MFMA(oB[1], oR[1], CS_MFMA(oB[0], oR[0], zero4)), Kr_D = CS_MFMA(oK[1], oR[1], CS_MFMA(oK[0], oR[0], zero4));
    f32x4 I_D;
#pragma unroll
    for (int j = 0; j < 4; ++j) { const int m = 4 * g + j;
        A_D[j] = m < s ? A_D[j] : 0.f; AT_D[j] = s < m ? AT_D[j] : 0.f; BkT_D[j] = s < m ? BkT_D[j] : 0.f;
        Ar_D[j] = m <= s ? Ar_D[j] : 0.f; Kr_D[j] = m <= s ? Kr_D[j] : 0.f; I_D[j] = m == s ? 1.f : 0.f; }
    f32x4 Ab, AbT, A1, A2m;
#pragma unroll
    for (int j = 0; j < 4; ++j) { const int m = 4 * g + j; const bool b0 = (m >> 2) == (s >> 2), b1 = (m >> 3) == (s >> 3);
        Ab[j] = b0 ? A_D[j] : 0.f; AbT[j] = b0 ? AT_D[j] : 0.f; A1[j] = (b1 && !b0) ? A_D[j] : 0.f; A2m[j] = b1 ? 0.f : A_D[j]; }
    const f32x4 Ab2 = cs_mm16(AbT, Ab), Ab2T = cs_mm16(Ab, AbT);
    const f32x4 P0 = I_D + Ab, P0T = I_D + AbT;
    const f32x4 T0 = P0 + cs_mm16(P0T, Ab2), T0T = P0T + cs_mm16(Ab2, P0T);
    (void)Ab2T;
    const f32x4 ZT = cs_mm16(A1, T0T);
    const f32x4 T1 = T0 + cs_mm16(ZT, T0), T1T = T0T + cs_mm16(T0, ZT);
    const f32x4 Z2T = cs_mm16(A2m, T1T);
    const f32x4 T_D = T1 + cs_mm16(Z2T, T1);
    const f32x4 M_D = cs_mm16(BkT_D, T_D), MT_D = cs_mm16(T_D, BkT_D);
    const f32x4 N_D = cs_mm16(MT_D, Ar_D) + Kr_D;
    { u32x4 w; w.x = cvt_pk_bf16(M_D[0], M_D[1]); w.y = cvt_pk_bf16(M_D[2], M_D[3]); w.z = 0u; w.w = 0u; *(LAS u32x4*)(slot + CS_MT + s * 64 + g * 16) = w;
      w.x = cvt_pk_bf16(N_D[0], N_D[1]); w.y = cvt_pk_bf16(N_D[2], N_D[3]); *(LAS u32x4*)(slot + CS_NT + s * 64 + g * 16) = w; }
    __builtin_amdgcn_wave_barrier(); asm volatile("" ::: "memory");
    const bf16x8 oT = cs_op16(T_D), oAr = cs_op16(Ar_D);
    float Zp[4][4];
#pragma unroll
    for (int T = 0; T < 4; ++T) { const f32x4 zp = CS_MFMA(cs_lo(cs_tr(zimg, lane, T)), oT, zero4);
#pragma unroll
        for (int j = 0; j < 4; ++j) Zp[T][j] = zp[j]; }
#pragma unroll
    for (int kk = 0; kk < 2; ++kk) *(LAS bf16x8*)(slot + CS_ZP + s * 128 + g * 32 + kk * 16) = cs_pack(Zp[2 * kk], Zp[2 * kk + 1]);
    __builtin_amdgcn_wave_barrier(); asm volatile("" ::: "memory");
    float Rp[4][4];
#pragma unroll
    for (int T = 0; T < 4; ++T) { const f32x4 rp = CS_MFMA(cs_lo(cs_tr(slot + CS_ZP, lane, T)), oAr, zero4);
#pragma unroll
        for (int j = 0; j < 4; ++j) Rp[T][j] = rp[j] + bf2f((bf16_t)oR[T >> 1][(T & 1) * 4 + j]); }
#pragma unroll
    for (int kk = 0; kk < 2; ++kk) *(LAS bf16x8*)(slot + CS_RPP + s * 128 + g * 32 + kk * 16) = cs_pack(Rp[2 * kk], Rp[2 * kk + 1]);
}
__device__ __forceinline__ void cs_scan_chunk(const LAS unsigned char* slot, f32x4 (&acc)[4], float* yp  , int d, int q, int wave, int lane) {
    const int s = lane & 15, g = lane >> 4;
    const f32x4 zero4 = (f32x4){0.f, 0.f, 0.f, 0.f};
    bf16x8 Xb[2];
#pragma unroll
    for (int kk = 0; kk < 2; ++kk) { u32x4 w; w.x = cvt_pk_bf16(acc[2 * kk][0], acc[2 * kk][1]); w.y = cvt_pk_bf16(acc[2 * kk][2], acc[2 * kk][3]);
        w.z = cvt_pk_bf16(acc[2 * kk + 1][0], acc[2 * kk + 1][1]); w.w = cvt_pk_bf16(acc[2 * kk + 1][2], acc[2 * kk + 1][3]); Xb[kk] = __builtin_bit_cast(bf16x8, w); }
    const v4i16_t vt = cs_tr(slot + CS_VV, lane, wave);
    const bf16x8 Vb = cs_lo(vt);
    const int arow = s * 128 + g * 32, a16 = s * 64 + g * 16;
    f32x4 UT = CS_MFMA(*(const LAS bf16x8*)(slot + CS_MT + a16), Vb, zero4);
    UT = CS_MFMA(*(const LAS bf16x8*)(slot + CS_ZP + arow), Xb[0], UT); UT = CS_MFMA(*(const LAS bf16x8*)(slot + CS_ZP + arow + 16), Xb[1], UT);
    f32x4 YT = CS_MFMA(*(const LAS bf16x8*)(slot + CS_NT + a16), Vb, zero4); YT = CS_MFMA(*(const LAS bf16x8*)(slot + CS_RPP + arow), Xb[0], YT); YT = CS_MFMA(*(const LAS bf16x8*)(slot + CS_RPP + arow + 16), Xb[1], YT);
#pragma unroll
    for (int j = 0; j < 4; ++j) yp[(size_t)cs_tt(d, q, 4 * g + j) * 256] = YT[j];
    bf16x8 UV; { u32x2 w; w.x = cvt_pk_bf16(UT[0], UT[1]); w.y = cvt_pk_bf16(UT[2], UT[3]); const v4i16_t ub = __builtin_bit_cast(v4i16_t, w);
        UV[0] = ub[0]; UV[1] = ub[1]; UV[2] = ub[2]; UV[3] = ub[3]; UV[4] = vt[0]; UV[5] = vt[1]; UV[6] = vt[2]; UV[7] = vt[3]; }
#pragma unroll
    for (int T = 0; T < 4; ++T) { const v4i16_t bh = cs_tr(slot + CS_BH, lane, T), kh = cs_tr(slot + CS_KH, lane, T);
        bf16x8 BK; BK[0] = bh[0]; BK[1] = bh[1]; BK[2] = bh[2]; BK[3] = bh[3]; BK[4] = kh[0]; BK[5] = kh[1]; BK[6] = kh[2]; BK[7] = kh[3];
        acc[T] = CS_MFMA(BK, UV, acc[T]);
        acc[T] *= *(const LAS f32x4*)(slot + CS_WC + (16 * T + 4 * g) * 4); }
}
__device__ __forceinline__ void phase_scan(const Frame& F) {
    const f16_t* SH = (const f16_t*)(F.ws + WS_SH); const f16_t* SD = (const f16_t*)(F.ws + WS_SD);
    float* Y = (float*)(F.ws + WS_Y);
    const int lane = F.lane, wave = F.wave;
    for (int chain = F.bid; chain < 64; chain += F.G) {
        const int d = chain >> 5, b = (chain >> 2) & 7, h = chain & 3;
        const f16_t* sh = SH + (size_t)(b * 4 + h) * TT * 192; const f16_t* sd = SD + (size_t)((d * 8 + b) * 4 + h) * TT * 192;
        float* yp = Y + ((size_t)(d * 8 + b) * TT) * 256 + h * 64 + 16 * (wave & 3) + (lane & 15);
        f32x4 acc[4];
#pragma unroll
        for (int T = 0; T < 4; ++T) acc[T] = (f32x4){0.f, 0.f, 0.f, 0.f};
        __syncthreads();
        CsRaw raw;
        constexpr int NR = CS_NCHUNK / 8;
        cs_load(raw, sh, sd, d, wave, lane);
        for (int R = 0; R < NR; ++R) {
            cs_prepass(F.lds + wave * CS_SLOT, F.lds + CS_ZIMG + wave * 2048, raw, sh, sd, d, (R + 1 < NR) ? 8 * (R + 1) + wave : -1, lane);
            asm volatile("s_waitcnt lgkmcnt(0)" ::: "memory"); __builtin_amdgcn_s_barrier(); asm volatile("" ::: "memory");
            if (wave < 4) {
#pragma unroll 1
                for (int c8 = 0; c8 < 8; ++c8) cs_scan_chunk(F.lds + c8 * CS_SLOT, acc, yp, d, 8 * R + c8, wave, lane);
            }
            asm volatile("s_waitcnt lgkmcnt(0)" ::: "memory"); __builtin_amdgcn_s_barrier(); asm volatile("" ::: "memory");
        }
    }
}

__device__ __forceinline__ void phase_rw_post(const Frame& F, const Params& P, int l, int nrows) {
    const bf16_t* PL = (const bf16_t*)(F.ws + WS_PL); bf16_t* MIX = (bf16_t*)(F.ws + WS_MIX);
    const f16_t* SH = (const f16_t*)(F.ws + WS_SH); const f16_t* SD = (const f16_t*)(F.ws + WS_SD); const float* Y = (const float*)(F.ws + WS_Y);
    const int lane = F.lane;
    rw_stage_tables(F, P, l);
    const LAS float* T = (const LAS float*)F.lds;
    for (int item = F.gw; item < NLAT / 16 + ((nrows - NLAT) / 16) * 4; item += F.nw) {
        const int tile = item < NLAT / 16 ? item : NLAT / 16 + ((item - NLAT / 16) >> 2), h0 = item < NLAT / 16 ? 0 : ((item - NLAT / 16) & 3), h1 = item < NLAT / 16 ? 4 : h0 + 1;
        int l1 = lane; asm volatile("" : "+v"(l1)); const int tk = l1 & 15, g = l1 >> 4;
        const int r = tile * 16 + tk; const RowGeo geo = row_geo(r);
        const bool hp = geo.pos > 0, hn = geo.pos < geo.len - 1;
        const bf16_t* prow = PL + (size_t)r * INW + O_RW; const int dprev = hp ? -INW : 0, dnext = hn ? INW : 0;
        bf16x8 sg[2][4];
#pragma unroll
        for (int d = 0; d < 2; ++d) { u32x4 raw[4][3];
#pragma unroll
            for (int kk = 0; kk < 4; ++kk) { const bf16_t* p = prow + 896 + 256 * d + 32 * kk + 8 * g;
                raw[kk][0] = *(const u32x4*)p; raw[kk][1] = *(const u32x4*)(p + dprev); raw[kk][2] = *(const u32x4*)(p + dnext); }
#pragma unroll
            for (int kk = 0; kk < 4; ++kk) { float u[8]; rw_mix8(T, raw[kk], hp, hn, 896 + 256 * d + 32 * kk + 8 * g, u);
#pragma unroll
                for (int q = 0; q < 8; ++q) u[q] = sigmoidf_(u[q]);
                sg[d][kk] = pack8f(u); }
            asm volatile("" ::: "memory"); }
#pragma unroll 1
        for (int h = h0; h < h1; ++h) {
            int l2 = lane; asm volatile("" : "+v"(l2)); const int tk = l2 & 15, g = l2 >> 4;
            const int r = tile * 16 + tk; const RowGeo geo = row_geo(r);
            const size_t shrow = ((size_t)(geo.b * 4 + h) * TT + geo.tt) * 192;
            float out[4][4];
#pragma unroll
            for (int t = 0; t < 4; ++t)
#pragma unroll
                for (int q = 0; q < 4; ++q) out[t][q] = 0.f;
            f16x8 rh[2], vh[2];
#pragma unroll
            for (int u = 0; u < 2; ++u) { rh[u] = *(const f16x8*)(SH + shrow + 32 * u + 8 * g); vh[u] = *(const f16x8*)(SH + shrow + 64 + 32 * u + 8 * g); }
#pragma unroll 1
            for (int d = 0; d < 2; ++d) {
                const bf16_t* g2t = (const bf16_t*)(F.ws + WS_LORA + (size_t)(l * 2 + d) * LORA_LD_BYTES) + 2 * 256 * 64;
                const size_t sdrow = ((size_t)((d * 8 + geo.b) * 4 + h) * TT + geo.tt) * 192;
                const float* yrow = Y + ((size_t)(d * 8 + geo.b) * TT + geo.tt) * 256 + 64 * h + 8 * g;
                bf16x8 sgd[4];
#pragma unroll
                for (int kk = 0; kk < 4; ++kk) sgd[kk] = d ? sg[1][kk] : sg[0][kk];
                f32x4 y[4], gg[4]; f16x8 kdh[2]; bf16x8 gf[4][4];
#pragma unroll
                for (int u = 0; u < 2; ++u) { y[2 * u] = *(const f32x4*)(yrow + 32 * u); y[2 * u + 1] = *(const f32x4*)(yrow + 32 * u + 4); kdh[u] = *(const f16x8*)(SD + sdrow + 64 + 32 * u + 8 * g); }
#pragma unroll
                for (int t = 0; t < 4; ++t) { const bf16_t* gr = g2t + (size_t)(64 * h + 32 * (t >> 1) + 8 * (tk >> 2) + 4 * (t & 1) + (tk & 3)) * 128 + 8 * g;
#pragma unroll
                    for (int kk = 0; kk < 4; ++kk) gf[t][kk] = *(const bf16x8*)(gr + 32 * kk); }
                float sm = 0.f, bs = 0.f;
#pragma unroll
                for (int t = 0; t < 4; ++t) { const int c = 64 * h + 32 * (t >> 1) + 8 * g + 4 * (t & 1);
                    sm += (y[t][0] + y[t][1]) + (y[t][2] + y[t][3]);
                    const f32x4 rk = *(const LAS f32x4*)(T + RL_RK / 4 + c);
#pragma unroll
                    for (int q = 0; q < 4; ++q) bs += (float)rh[t >> 1][(t & 1) * 4 + q] * (float)kdh[t >> 1][(t & 1) * 4 + q] * rk[q];
                    f32x4 a = (f32x4){0.f, 0.f, 0.f, 0.f};
#pragma unroll
                    for (int kk = 0; kk < 4; ++kk) a = __builtin_amdgcn_mfma_f32_16x16x32_bf16(gf[t][kk], sgd[kk], a, 0, 0, 0);
                    gg[t] = a; }
                sm += __shfl_xor(sm, 16); sm += __shfl_xor(sm, 32); bs += __shfl_xor(bs, 16); bs += __shfl_xor(bs, 32);
                const float mu = sm * (1.0f / 64.0f); float vs = 0.f;
#pragma unroll
                for (int t = 0; t < 4; ++t)
#pragma unroll
                    for (int q = 0; q < 4; ++q) { const float dd = y[t][q] - mu; vs += dd * dd; }
                vs += __shfl_xor(vs, 16); vs += __shfl_xor(vs, 32);
                const float rstd = rsqrtf(vs * (1.0f / 64.0f) + 64e-5f);
#pragma unroll
                for (int t = 0; t < 4; ++t) { const int c = 64 * h + 32 * (t >> 1) + 8 * g + 4 * (t & 1);
                    const f32x4 gng = *(const LAS f32x4*)(T + RL_GNG / 4 + c), gnb = *(const LAS f32x4*)(T + RL_GNB / 4 + c);
#pragma unroll
                    for (int q = 0; q < 4; ++q) out[t][q] += ((y[t][q] - mu) * rstd * gng[q] + gnb[q] + bs * (float)vh[t >> 1][(t & 1) * 4 + q]) * gg[t][q]; }
                asm volatile("" ::: "memory");
            }
#pragma unroll
            for (int u = 0; u < 2; ++u) { u32x4 w; w.x = cvt_pk_bf16(out[2 * u][0], out[2 * u][1]); w.y = cvt_pk_bf16(out[2 * u][2], out[2 * u][3]); w.z = cvt_pk_bf16(out[2 * u + 1][0], out[2 * u + 1][1]); w.w = cvt_pk_bf16(out[2 * u + 1][2], out[2 * u + 1][3]);
                *(u32x4*)(MIX + (size_t)r * D + 512 + 64 * h + 32 * u + 8 * g) = w; }
        }
    }
    __syncthreads();
}

constexpr int CV_SEG = 64, CV_ROWS = CV_SEG + 30, CV_H = 0, CV_W = CV_ROWS * 256 * 4;
__device__ __forceinline__ void phase_conv(const Frame& F, const Params& P, int l, int nrows) {
    const bf16_t* PL = (const bf16_t*)(F.ws + WS_PL); bf16_t* MIX = (bf16_t*)(F.ws + WS_MIX);
    const int lane = F.lane, c4 = lane * 4, wave = F.wave;
    LAS float* H = (LAS float*)(F.lds + CV_H); LAS float* W = (LAS float*)(F.lds + CV_W);
    for (int i = F.tid; i < 31 * 256; i += NTHREADS) W[i] = P.in[I_DWW][(size_t)l * 31 * 256 + i];
    const f32x4 dwb = *(const f32x4*)(P.in[I_DWB] + l * 256 + c4), lng = *(const f32x4*)(P.in[I_LNG] + l * 256 + c4), lnb = *(const f32x4*)(P.in[I_LNB] + l * 256 + c4);
    for (int seg = F.bid; seg < nrows / CV_SEG; seg += F.G) {
        const int r0 = seg * CV_SEG; const RowGeo g0 = row_geo(r0);
        __syncthreads();
#pragma unroll 4
        for (int k = 0; k < 12; ++k) { const int rr = wave + 8 * k;
            if (rr < CV_ROWS) { const int pos = g0.pos - 15 + rr; f32x4 hv = (f32x4){0.f, 0.f, 0.f, 0.f};
                if (pos >= 0 && pos < g0.len) { const bf16_t* p = PL + (size_t)(r0 - 15 + rr) * INW + O_CV + c4; float a[4], bb[4];
                    unpack4(*(const u32x2*)p, a); unpack4(*(const u32x2*)(p + 256), bb);
#pragma unroll
                    for (int q = 0; q < 4; ++q) hv[q] = a[q] * sigmoidf_(bb[q]); }
                *(LAS f32x4*)(H + rr * 256 + c4) = hv; } }
        __syncthreads();
        f32x4 acc[8];
#pragma unroll
        for (int t = 0; t < 8; ++t) acc[t] = dwb;
#pragma unroll 1
        for (int j = 0; j < 31; ++j) { const f32x4 w = *(const LAS f32x4*)(W + j * 256 + c4);
#pragma unroll
            for (int t = 0; t < 8; ++t) acc[t] += *(const LAS f32x4*)(H + (wave * 8 + t + j) * 256 + c4) * w; }
#pragma unroll
        for (int t = 0; t < 8; ++t) {
            const float mu = wave_sum((acc[t][0] + acc[t][1]) + (acc[t][2] + acc[t][3])) * (1.0f / 256.0f);
            float vs = 0.f;
#pragma unroll
            for (int q = 0; q < 4; ++q) { const float dd = acc[t][q] - mu; vs += dd * dd; }
            const float rstd = rsqrtf(wave_sum(vs) * (1.0f / 256.0f) + 1e-5f);
            float o[4];
#pragma unroll
            for (int q = 0; q < 4; ++q) o[q] = siluf_((acc[t][q] - mu) * rstd * lng[q] + lnb[q]);
            u32x2 w; w.x = pk_bf16(o[0], o[1]); w.y = pk_bf16(o[2], o[3]);
            *(u32x2*)(MIX + (size_t)(r0 + wave * 8 + t) * D + 768 + c4) = w; }
    }
    __syncthreads();
}

__device__ __forceinline__ void phase_na_simple(const Frame& F, const Params& P, int l, int nq) {
    const bf16_t* PL = (const bf16_t*)(F.ws + WS_PL); bf16_t* MIX = (bf16_t*)(F.ws + WS_MIX);
    const float* rpb = P.in[I_RPB] + (size_t)l * 8 * 15 * 31;
    int tid_ = F.tid; asm volatile("" : "+v"(tid_));
    for (int gid = F.bid * NTHREADS + tid_; gid < nq * 8; gid += F.G * NTHREADS) {
        const int r = gid >> 3, h = gid & 7;
        const RowGeo g = row_geo(r);
        float q[64], o[64];
        { const bf16_t* qp = PL + (size_t)r * INW + O_Q + h * 64;
#pragma unroll
          for (int i = 0; i < 8; ++i) unpack8(*(const u32x4*)(qp + i * 8), q + i * 8); }
#pragma unroll
        for (int i = 0; i < 64; ++i) o[i] = 0.f;
        float m = -3.0e38f, lsum = 0.f;
        const bool lat = r < NLAT;
        const int gi = g.pos >> 6, gc = g.pos & 63;
        const int rs = min(max(gi - 4, 0), 56), wsc = min(max(gc - 8, 0), 48);
        const int nkey = lat ? 384 : 256;
#pragma unroll 1
        for (int kx = 0; kx < nkey; ++kx) {
            const bool win = lat && kx < 128;
            int krow; float bias = 0.f;
            if (win) { const int r8 = kx >> 4, cc = kx & 15; krow = g.b * SEQ + (rs + r8) * 64 + wsc + cc; bias = rpb[(h * 15 + (rs + r8 - gi + 7)) * 31 + (wsc + cc - gc + 15)]; }
            else krow = NLAT + g.b * CTXL + (kx - (lat ? 128 : 0));
            const bf16_t* kp = PL + (size_t)krow * INW + O_K + h * 64; float a = bias;
#pragma unroll
            for (int i = 0; i < 8; ++i) { float kf[8]; unpack8(*(const u32x4*)(kp + i * 8), kf);
#pragma unroll
                for (int j = 0; j < 8; ++j) a += q[i * 8 + j] * kf[j]; }
            if (a > m) { const float alpha = __expf(m - a); lsum *= alpha;
#pragma unroll
                for (int i = 0; i < 64; ++i) o[i] *= alpha;
                m = a; }
            const float p = __expf(a - m); lsum += p;
            const bf16_t* vp = kp + (O_V - O_K);
#pragma unroll
            for (int i = 0; i < 8; ++i) { float vf[8]; unpack8(*(const u32x4*)(vp + i * 8), vf);
#pragma unroll
                for (int j = 0; j < 8; ++j) o[i * 8 + j] += p * vf[j]; }
        }
        const float inv = 1.0f / lsum;
        bf16_t* op = MIX + (size_t)r * D + h * 64;
#pragma unroll
        for (int i = 0; i < 8; ++i) { u32x4 w; w.x = pk_bf16(o[i * 8] * inv, o[i * 8 + 1] * inv); w.y = pk_bf16(o[i * 8 + 2] * inv, o[i * 8 + 3] * inv);
            w.z = pk_bf16(o[i * 8 + 4] * inv, o[i * 8 + 5] * inv); w.w = pk_bf16(o[i * 8 + 6] * inv, o[i * 8 + 7] * inv); *(u32x4*)(op + i * 8) = w; }
    }
}

constexpr int NA_CK = 0, NA_CV = 32768, NA_RPB = 65536, NA_WV = 81920;
__device__ __forceinline__ bf16x8 na_pack8(const f32x4& a, const f32x4& b) {
    u32x4 w; w.x = cvt_pk_bf16(a[0], a[1]); w.y = cvt_pk_bf16(a[2], a[3]); w.z = cvt_pk_bf16(b[0], b[1]); w.w = cvt_pk_bf16(b[2], b[3]); return __builtin_bit_cast(bf16x8, w);
}
__device__ __forceinline__ bf16x8 na_vfrag(LAS unsigned char* blk, int lane, int dt) {
    const int g = lane >> 4, qq = (lane & 15) >> 2, p = lane & 3;
    const int r0 = 4 * g + qq, r1 = 16 + 4 * g + qq;
    const v4i16_t lo = __builtin_amdgcn_ds_read_tr16_b64_v4i16((LAS v4i16_t*)(blk + r0 * 128 + ((dt ^ ((r0 >> 1) & 3)) * 32) + p * 8));
    const v4i16_t hi = __builtin_amdgcn_ds_read_tr16_b64_v4i16((LAS v4i16_t*)(blk + r1 * 128 + ((dt ^ ((r1 >> 1) & 3)) * 32) + p * 8));
    bf16x8 r; r[0] = lo[0]; r[1] = lo[1]; r[2] = lo[2]; r[3] = lo[3]; r[4] = hi[0]; r[5] = hi[1]; r[6] = hi[2]; r[7] = hi[3]; return r;
}
template <bool WINDOW>
__device__ __forceinline__ void na_item(const Frame& F, const bf16_t* PL, bf16_t* MIX, int b, int h, int qrow0  , int gi, int cb) {
    const int lane = F.lane, ql = lane & 15, g = lane >> 4;
    LAS unsigned char* CK = F.lds + NA_CK; LAS unsigned char* CV = F.lds + NA_CV; const LAS float* RPB = (const LAS float*)(F.lds + NA_RPB);
    LAS unsigned char* WV = F.lds + NA_WV + F.wave * 4096;
    bf16x8 Qf[2];
    { const bf16_t* qp = PL + (size_t)(qrow0 + ql) * INW + O_Q + h * 64 + 8 * g; Qf[0] = *(const bf16x8*)qp; Qf[1] = *(const bf16x8*)(qp + 32); }
    f32x4 acc[4];
#pragma unroll
    for (int dt = 0; dt < 4; ++dt) acc[dt] = (f32x4){0.f, 0.f, 0.f, 0.f};
    float m_run = -3.0e38f, l_run = 0.f;
    if constexpr (WINDOW) {
        const int rs = min(max(gi - 4, 0), 56), kc0 = min(max(16 * cb - 8, 0), 32), qcol = 16 * cb + ql, wsq = min(max(qcol - 8, 0), 48);
        const size_t krow0 = (size_t)b * SEQ + (size_t)rs * 64 + kc0;
        f32x4 s[16];
#pragma unroll
        for (int t = 0; t < 16; ++t) { const bf16_t* kp = PL + (krow0 + (size_t)(t >> 1) * 64 + (t & 1) * 16 + ql) * INW + O_K + h * 64 + 8 * g;
            const bf16x8 k0 = *(const bf16x8*)kp, k1 = *(const bf16x8*)(kp + 32);
            s[t] = __builtin_amdgcn_mfma_f32_16x16x32_bf16(k0, Qf[0], (f32x4){0.f, 0.f, 0.f, 0.f}, 0, 0, 0);
            s[t] = __builtin_amdgcn_mfma_f32_16x16x32_bf16(k1, Qf[1], s[t], 0, 0, 0); }
        const int vr = lane >> 1, part = lane & 1;
        const bf16_t* vbase = PL + (krow0 + vr) * INW + O_V + h * 64 + part * 32;
        u32x4 vbuf[4][4];
#pragma unroll
        for (int k = 0; k < 4; ++k) { const bf16_t* vp = vbase + (size_t)k * 64 * INW; vbuf[k][0] = *(const u32x4*)vp; vbuf[k][1] = *(const u32x4*)(vp + 8); vbuf[k][2] = *(const u32x4*)(vp + 16); vbuf[k][3] = *(const u32x4*)(vp + 24); }
        float mx = -3.0e38f;
#pragma unroll
        for (int t = 0; t < 16; ++t) { const LAS float* bp = RPB + (h * 15 + (rs + (t >> 1) - gi + 7)) * 31 + 15 - qcol;
#pragma unroll
            for (int j = 0; j < 4; ++j) { const int kcol = kc0 + (t & 1) * 16 + 4 * g + j; const bool ok = kcol >= wsq && kcol < wsq + 16;
                const float v = ok ? s[t][j] + bp[ok ? kcol : qcol] : -INFINITY; s[t][j] = v; mx = fmaxf(mx, v); } }
        mx = fmaxf(mx, __shfl_xor(mx, 16)); mx = fmaxf(mx, __shfl_xor(mx, 32));
        m_run = mx;
        float ls = 0.f;
#pragma unroll
        for (int t = 0; t < 16; ++t)
#pragma unroll
            for (int j = 0; j < 4; ++j) { const float p = __expf(s[t][j] - mx); s[t][j] = p; ls += p; }
        l_run = ls;
#pragma unroll
        for (int r8 = 0; r8 < 8; ++r8) {
            { LAS unsigned char* wr = WV + vr * 128; const int sw = (vr >> 1) & 3;
              *(LAS u32x4*)(wr + (((2 * part) ^ sw) * 32)) = vbuf[r8 & 3][0]; *(LAS u32x4*)(wr + (((2 * part) ^ sw) * 32) + 16) = vbuf[r8 & 3][1];
              *(LAS u32x4*)(wr + (((2 * part + 1) ^ sw) * 32)) = vbuf[r8 & 3][2]; *(LAS u32x4*)(wr + (((2 * part + 1) ^ sw) * 32) + 16) = vbuf[r8 & 3][3];
              if (r8 + 4 < 8) { const bf16_t* vp = vbase + (size_t)(r8 + 4) * 64 * INW;
                  vbuf[r8 & 3][0] = *(const u32x4*)vp; vbuf[r8 & 3][1] = *(const u32x4*)(vp + 8); vbuf[r8 & 3][2] = *(const u32x4*)(vp + 16); vbuf[r8 & 3][3] = *(const u32x4*)(vp + 24); } }
            __builtin_amdgcn_wave_barrier(); asm volatile("" ::: "memory");
            const bf16x8 pf = na_pack8(s[2 * r8], s[2 * r8 + 1]);
#pragma unroll
            for (int dt = 0; dt < 4; ++dt) { const bf16x8 vf = na_vfrag(WV, lane, dt); acc[dt] = __builtin_amdgcn_mfma_f32_16x16x32_bf16(vf, pf, acc[dt], 0, 0, 0); }
            __builtin_amdgcn_wave_barrier(); asm volatile("" ::: "memory");
        }
    }
    {
        f32x4 s[16];
#pragma unroll
        for (int t = 0; t < 16; ++t) { const int key = 16 * t + ql; const LAS unsigned char* kr = CK + key * 128;
            const bf16x8 k0 = *(const LAS bf16x8*)(kr + ((g ^ (key & 7)) * 16)), k1 = *(const LAS bf16x8*)(kr + (((g + 4) ^ (key & 7)) * 16));
            s[t] = __builtin_amdgcn_mfma_f32_16x16x32_bf16(k0, Qf[0], (f32x4){0.f, 0.f, 0.f, 0.f}, 0, 0, 0);
            s[t] = __builtin_amdgcn_mfma_f32_16x16x32_bf16(k1, Qf[1], s[t], 0, 0, 0); }
        float mx = m_run;
#pragma unroll
        for (int t = 0; t < 16; ++t)
#pragma unroll
            for (int j = 0; j < 4; ++j) mx = fmaxf(mx, s[t][j]);
        mx = fmaxf(mx, __shfl_xor(mx, 16)); mx = fmaxf(mx, __shfl_xor(mx, 32));
        const float alpha = __expf(m_run - mx);
        float ls = l_run * alpha;
#pragma unroll
        for (int dt = 0; dt < 4; ++dt) acc[dt] *= alpha;
#pragma unroll
        for (int t = 0; t < 16; ++t)
#pragma unroll
            for (int j = 0; j < 4; ++j) { const float p = __expf(s[t][j] - mx); s[t][j] = p; ls += p; }
        l_run = ls;
#pragma unroll
        for (int blk = 0; blk < 8; ++blk) { const bf16x8 pf = na_pack8(s[2 * blk], s[2 * blk + 1]);
#pragma unroll
            for (int dt = 0; dt < 4; ++dt) { const bf16x8 vf = na_vfrag(CV + blk * 4096, lane, dt); acc[dt] = __builtin_amdgcn_mfma_f32_16x16x32_bf16(vf, pf, acc[dt], 0, 0, 0); } }
    }
    float lt = l_run; lt += __shfl_xor(lt, 16); lt += __shfl_xor(lt, 32);
    const float inv = 1.0f / lt;
    bf16_t* op = MIX + (size_t)(qrow0 + ql) * D + h * 64 + 4 * g;
#pragma unroll
    for (int dt = 0; dt < 4; ++dt) { u32x2 w; w.x = cvt_pk_bf16(acc[dt][0] * inv, acc[dt][1] * inv); w.y = cvt_pk_bf16(acc[dt][2] * inv, acc[dt][3] * inv); *(u32x2*)(op + dt * 16) = w; }
}
__device__ __forceinline__ void phase_na_mfma(const Frame& F, const Params& P, int l, bool ctx_queries) {
    const bf16_t* PL = (const bf16_t*)(F.ws + WS_PL); bf16_t* MIX = (bf16_t*)(F.ws + WS_MIX);
    int tid_ = F.tid; asm volatile("" : "+v"(tid_));
    const int tid = tid_;
    { const float* rpb = P.in[I_RPB] + (size_t)l * 8 * 15 * 31; LAS float* R = (LAS float*)(F.lds + NA_RPB); for (int i = tid; i < 8 * 15 * 31; i += NTHREADS) R[i] = rpb[i]; }
    for (int unit = F.bid; unit < 512; unit += F.G) {
        const int eighth = unit & 7, h = (unit >> 3) & 7, b = unit >> 6;
        __syncthreads();
        { int t2 = tid; asm volatile("" : "+v"(t2)); const int key = t2 >> 1, part = t2 & 1; const bf16_t* kp = PL + (size_t)(NLAT + b * CTXL + key) * INW + O_K + h * 64 + part * 32; const bf16_t* vp = kp + (O_V - O_K);
          LAS unsigned char* kr = F.lds + NA_CK + key * 128; LAS unsigned char* vr = F.lds + NA_CV + key * 128; const int sw = (key >> 1) & 3;
#pragma unroll
          for (int c = 0; c < 4; ++c) { *(LAS u32x4*)(kr + (((4 * part + c) ^ (key & 7)) * 16)) = *(const u32x4*)(kp + 8 * c);
              const int c16 = 4 * part + c; *(LAS u32x4*)(vr + (((c16 >> 1) ^ sw) * 32) + (c16 & 1) * 16) = *(const u32x4*)(vp + 8 * c); } }
        __syncthreads();
        for (int it = F.wave; it < 32; it += NWAVES) { const int gi = eighth * 8 + (it >> 2), cb = it & 3;
            na_item<true>(F, PL, MIX, b, h, b * SEQ + gi * 64 + cb * 16, gi, cb); }
        if (ctx_queries && F.wave < 2) na_item<false>(F, PL, MIX, b, h, NLAT + b * CTXL + (eighth * 2 + F.wave) * 16, 0, 0);
    }
}

__device__ __forceinline__ void phase_final(const Frame& F, const Params& P) {
    float* out = P.out; const float* g = P.in[I_FINALG]; const int lane = F.lane;
    for (int r = F.gw; r < NLAT; r += F.nw) {
        float* xr = out + (size_t)r * D; f32x4 x[4]; float ss = 0.f;
#pragma unroll
        for (int j = 0; j < 4; ++j) { x[j] = *(const f32x4*)(xr + j * 256 + lane * 4); ss += x[j][0] * x[j][0] + x[j][1] * x[j][1] + x[j][2] * x[j][2] + x[j][3] * x[j][3]; }
        ss = wave_sum(ss); const float rstd = rsqrtf(ss * (1.0f / D) + 1e-6f);
#pragma unroll
        for (int j = 0; j < 4; ++j) { const f32x4 gg = *(const f32x4*)(g + j * 256 + lane * 4); *(f32x4*)(xr + j * 256 + lane * 4) = x[j] * rstd * gg; }
    }
}

constexpr int PH_L0 = 1, PH_PER_L0 = 9, PH_L1 = PH_L0 + PH_PER_L0, PH_PER_L1 = 12, PH_FINAL = PH_L1 + PH_PER_L1, N_PHASES = PH_FINAL + 1;
#define RFL(x) __builtin_amdgcn_readfirstlane(x)

PHASE ph_prologue(const void* kp_, int wv_) { PHASE_ENTER; if constexpr (MKB(0)) phase_prologue(F, P); }
PHASE ph_norm1(const void* kp_, int wv_, int l_) { PHASE_ENTER; const int l = RFL(l_);
    if constexpr (MKB(1)) phase_norm<false>(F, P, l, 0, NROW, l == 0 ? P.in[I_X] : P.out, l == 0 ? P.in[I_CTX] : (const float*)(F.ws + WS_XC)); }
PHASE_INL ph_gemm_win(const void* kp_, int wv_, int l_) { PHASE_ENTER; const int l = RFL(l_);
    pg8::DenseSched S; S.init(NROW / 256, INW / 256, F.G, F.bid); S.A = (const bf16_t*)(F.ws + WS_HL); S.Bt = (const bf16_t*)(F.ws + WS_BTIN) + (size_t)l * INW * D; S.K = D;
    pg8::EpiBf16 E{(bf16_t*)(F.ws + WS_PL), INW, 2, 0.125f};
    if constexpr (MKB(2)) pg8::gemm_phase<pg8::EpiBf16, pg8::DenseSched, false>(F.lds, D, S, E, F.wave); }
PHASE_INL ph_rw_prep(const void* kp_, int wv_, int l_) { PHASE_ENTER; const int l = RFL(l_); if constexpr (MKB(3)) phase_rw_prep(F, P, l); }
PHASE ph_conv(const void* kp_, int wv_, int l_, int bid_, int G_) { PHASE_ENTER; const int l = RFL(l_); if constexpr (MKB(4)) phase_conv(sub_frame(F, RFL(bid_), RFL(G_)), P, l, l == 0 ? NROW : NLAT); }
PHASE_INL ph_na(const void* kp_, int wv_, int l_, int bid_, int G_) { PHASE_ENTER; const int l = RFL(l_); if constexpr (MKB(5)) phase_na_mfma(sub_frame(F, RFL(bid_), RFL(G_)), P, l, l == 0); }
PHASE_INL ph_scan(const void* kp_, int wv_, int bid_, int G_) { PHASE_ENTER; if constexpr (MKB(6)) phase_scan(sub_frame(F, RFL(bid_), RFL(G_))); }
PHASE_INL ph_rw_post(const void* kp_, int wv_, int l_) { PHASE_ENTER; const int l = RFL(l_); if constexpr (MKB(7)) phase_rw_post(F, P, l, l == 0 ? NROW : NLAT); }
PHASE_INL ph_gemm_wout(const void* kp_, int wv_, int l_) { PHASE_ENTER; const int l = RFL(l_);
    float* XC = (float*)(F.ws + WS_XC);
    pg8::DenseSched S; S.init((l == 0 ? NROW : NLAT) / 256, D / 256, F.G, F.bid); S.A = (const bf16_t*)(F.ws + WS_MIX); S.Bt = (const bf16_t*)(F.ws + WS_BTOUT) + (size_t)l * D * D; S.K = D; S.split_tail();
    pg8::EpiRes E{l == 0 ? P.in[I_X] : P.out, l == 0 ? P.in[I_CTX] : XC, P.out, XC, (const float*)(F.ws + WS_MODV) + (size_t)l * 9 * MODW + 2 * D};
    if constexpr (MKB(8)) pg8::gemm_phase<pg8::EpiRes, pg8::DenseSched, false>(F.lds, D, S, E, F.wave); }
PHASE ph_norm2_l0(const void* kp_, int wv_) { PHASE_ENTER; if constexpr (MKB(9)) phase_norm<false>(F, P, 0, 1, NROW, P.out, (const float*)(F.ws + WS_XC)); }
PHASE_INL ph_gemm_ffn_gu(const void* kp_, int wv_) { PHASE_ENTER;
    pg8::DenseSched S; S.init(NROW / 256, (2 * DFF) / 256, F.G, F.bid); S.A = (const bf16_t*)(F.ws + WS_HL); S.Bt = (const bf16_t*)(F.ws + WS_BTGU); S.K = D;
    pg8::EpiSwiGLU E{(bf16_t*)(F.ws + WS_H), DFF};
    if constexpr (MKB(10)) pg8::gemm_phase<pg8::EpiSwiGLU, pg8::DenseSched, false>(F.lds, D, S, E, F.wave); }
PHASE_INL ph_gemm_ffn_dn(const void* kp_, int wv_) { PHASE_ENTER;
    float* XC = (float*)(F.ws + WS_XC);
    pg8::DenseSched S; S.init(NROW / 256, D / 256, F.G, F.bid); S.A = (const bf16_t*)(F.ws + WS_H); S.Bt = (const bf16_t*)(F.ws + WS_BTDN); S.K = DFF; S.split_tail();
    pg8::EpiRes E{P.out, XC, P.out, XC, (const float*)(F.ws + WS_MODV) + 5 * D};
    if constexpr (MKB(11)) pg8::gemm_phase<pg8::EpiRes, pg8::DenseSched, false>(F.lds, DFF, S, E, F.wave); }
PHASE ph_norm2_l1(const void* kp_, int wv_) { PHASE_ENTER; if constexpr (MKB(12)) phase_norm<true>(F, P, 1, 1, NLAT, P.out, (const float*)(F.ws + WS_XC)); }
PHASE ph_moe_prep(const void* kp_, int wv_) { PHASE_ENTER; if constexpr (MKB(13)) { phase_moe_rowmap(F); phase_moe_convert(F, P); } }
PHASE_INL ph_gemm_moe_gu(const void* kp_, int wv_, int pass_) { PHASE_ENTER; const int pass = RFL(pass_);
    pg8::MoeSched S; { int ts[9]; moe_tstart(F, pass, ts); S.set_tstart(ts); S.init(RFL(ts[8]), (2 * DFE) / 256, F.G, F.bid); }
    S.A = (const bf16_t*)(F.ws + WS_HLG + (size_t)pass * NROW * D); S.Bt0 = F.ws + WS_MOE; S.e_stride = MOE8_E_BYTES; S.K = D / 2; S.rowmap = nullptr;
    pg8::EpiSwiGLU8 E{F.ws + WS_H, DFE, 1.0f / MOE8_GU_SCALE};
    if constexpr (MKB(14)) pg8::gemm_phase<pg8::EpiSwiGLU8, pg8::MoeSched, false, true>(F.lds, D / 2, S, E, F.wave); }
PHASE_INL ph_gemm_moe_dn(const void* kp_, int wv_, int pass_) { PHASE_ENTER; const int pass = RFL(pass_);
    pg8::MoeSched S; { int ts[9]; moe_tstart(F, pass, ts); S.set_tstart(ts); S.init(RFL(ts[8]), D / 256, F.G, F.bid); }
    S.A = (const bf16_t*)(F.ws + WS_H); S.Bt0 = F.ws + WS_MOE + MOE8_GU_BYTES; S.e_stride = MOE8_E_BYTES; S.K = DFE / 2; S.split_tail(); S.rowmap = nullptr;
    pg8::EpiMoeDown E{P.out, (const float*)(F.ws + WS_MODV) + (size_t)9 * MODW + 5 * D, (const int*)(F.ws + WS_ROUTE + RT_RMAP) + pass * NROW, (const float*)(F.ws + WS_ROUTE + RT_SGATE) + pass * NROW, 1.0f / MOE8_DN_SCALE};
    if constexpr (MKB(15)) pg8::gemm_phase<pg8::EpiMoeDown, pg8::MoeSched, false, true>(F.lds, DFE / 2, S, E, F.wave); }
PHASE ph_final(const void* kp_, int wv_) { PHASE_ENTER; if constexpr (MKB(16)) phase_final(F, P); }

static __attribute__((noinline)) __device__ void grid_barrier(const void* bar_, unsigned x_, int wv_) {
    const unsigned long long v = (unsigned long long)bar_;
    const unsigned lo = __builtin_amdgcn_readfirstlane((unsigned)v), hi = __builtin_amdgcn_readfirstlane((unsigned)(v >> 32));
    XcdBarrier b; b.bar = (unsigned*)(((unsigned long long)hi << 32) | lo); b.x = __builtin_amdgcn_readfirstlane(x_);
    b.st = (volatile LAS unsigned*)((LAS unsigned char*)lds_raw + LDS_MISC);
    xcd_barrier(b, __builtin_amdgcn_readfirstlane(wv_) * 64 + lane_id());
}
__device__ __forceinline__ bool ph_in(int lo, int hi, int k) { asm volatile("" : "+s"(lo), "+s"(hi)); return lo <= k && k < hi; }

__global__ void __launch_bounds__(NTHREADS, 2) mk_fwd(Params P) {
    const void* kp = (const void*)__builtin_amdgcn_kernarg_segment_ptr();
    LAS unsigned char* lds = (LAS unsigned char*)lds_raw;
    volatile LAS unsigned* misc = (volatile LAS unsigned*)(lds + LDS_MISC);
    const int wv = __builtin_amdgcn_readfirstlane((int)(threadIdx.x >> 6));
    if (wv == 0 && lane_id() < 4) misc[lane_id()] = 0u;
    __syncthreads();
    const int lo = P.ph_lo, hi = P.ph_hi;
    XcdBarrier bar; bar.bar = (unsigned*)(P.ws + WS_CTL) + CW_BAR; bar.x = 0; bar.st = misc;
    if (hi - lo > 1) bar = xcd_barrier_post((unsigned*)(P.ws + WS_CTL) + CW_BAR, misc, wv * 64 + lane_id());
#define IN(k) ph_in(lo, hi, (k))
#define SEAM(k) do { if (IN((k) + 1)) grid_barrier((const void*)bar.bar, bar.x, wv); } while (0)
    if (IN(0)) { for (int rep = 0; rep < REP_PRO; ++rep) ph_prologue(kp, wv); SEAM(0); }
#define LAYER_COMMON(l, pb) \
    if (IN((pb) + 0)) { for (int rep = 0; rep < REP_NORM; ++rep) ph_norm1(kp, wv, (l)); SEAM((pb) + 0); } \
    if (IN((pb) + 1)) { for (int rep = 0; rep < REP_GEMM; ++rep) ph_gemm_win(kp, wv, (l)); SEAM((pb) + 1); } \
    if (IN((pb) + 2)) { for (int rep = 0; rep < REP_PP; ++rep) ph_rw_prep(kp, wv, (l)); SEAM((pb) + 2); } \
    if (IN((pb) + 3)) { const int bx = (int)blockIdx.x, Gx = (int)gridDim.x; \
        if (Gx == 256) { if (bx < 64) { for (int rep = 0; rep < REP_SCAN; ++rep) ph_scan(kp, wv, bx, 64); } \
            else { for (int rep = 0; rep < REP_CONV; ++rep) ph_conv(kp, wv, (l), bx - 64, 192); for (int rep = 0; rep < REP_NA; ++rep) ph_na(kp, wv, (l), bx - 64, 192); } } \
        else { ph_conv(kp, wv, (l), bx, Gx); ph_na(kp, wv, (l), bx, Gx); ph_scan(kp, wv, bx, Gx); } SEAM((pb) + 3); } \
    if (IN((pb) + 4)) { for (int rep = 0; rep < REP_POST; ++rep) ph_rw_post(kp, wv, (l)); SEAM((pb) + 4); } \
    if (IN((pb) + 5)) { ph_gemm_wout(kp, wv, (l)); SEAM((pb) + 5); }
    LAYER_COMMON(0, PH_L0)
    if (IN(PH_L0 + 6)) { ph_norm2_l0(kp, wv); SEAM(PH_L0 + 6); }
    if (IN(PH_L0 + 7)) { for (int rep = 0; rep < REP_GEMM; ++rep) ph_gemm_ffn_gu(kp, wv); SEAM(PH_L0 + 7); }
    if (IN(PH_L0 + 8)) { ph_gemm_ffn_dn(kp, wv); SEAM(PH_L0 + 8); }
    LAYER_COMMON(1, PH_L1)
    if (IN(PH_L1 + 6)) { ph_norm2_l1(kp, wv); SEAM(PH_L1 + 6); }
    if (IN(PH_L1 + 7)) { for (int rep = 0; rep < REP_PRO; ++rep) ph_moe_prep(kp, wv); SEAM(PH_L1 + 7); }
#pragma unroll 1
    for (int pass = 0; pass < 2; ++pass) {
        int wvp = wv; asm volatile("" : "+s"(wvp));
        if (IN(PH_L1 + 8 + 2 * pass)) { for (int rep = 0; rep < REP_GEMM; ++rep) ph_gemm_moe_gu(kp, wvp, pass); SEAM(PH_L1 + 8 + 2 * pass); }
        asm volatile("" : "+s"(wvp));
        if (IN(PH_L1 + 9 + 2 * pass)) { ph_gemm_moe_dn(kp, wvp, pass); SEAM(PH_L1 + 9 + 2 * pass); }
    }
#undef LAYER_COMMON
    if (IN(PH_FINAL)) ph_final(kp, wv);
#undef IN
#undef SEAM
}

extern "C" void kernel_launch(void* const* d_in, const int* in_sizes, int n_in, void* d_out, int out_size, void* d_ws, size_t ws_size, hipStream_t stream) {
    static int grid = 0;
    if (grid == 0) {
        if (n_in != 35 || out_size != NLAT * D || ws_size < WS_END) { fprintf(stderr, "kernel_launch: unexpected shapes (n_in %d out %d ws %zu need %zu)\n", n_in, out_size, ws_size, (size_t)WS_END); grid = -1; return; }
        int dev = 0, cus = 0, per_cu = 0;
        if (hipGetDevice(&dev) != hipSuccess || hipDeviceGetAttribute(&cus, hipDeviceAttributeMultiprocessorCount, dev) != hipSuccess) { grid = -1; return; }
        if (hipFuncSetAttribute((const void*)mk_fwd, hipFuncAttributeMaxDynamicSharedMemorySize, LDS_BYTES) != hipSuccess) { fprintf(stderr, "kernel_launch: hipFuncSetAttribute failed\n"); grid = -1; return; }
        if (hipOccupancyMaxActiveBlocksPerMultiprocessor(&per_cu, (const void*)mk_fwd, NTHREADS, LDS_BYTES) != hipSuccess || per_cu < 1) { fprintf(stderr, "kernel_launch: occupancy query says %d\n", per_cu); (void)hipGetLastError(); }
        grid = cus;
    }
    if (grid < 0) return;
    (void)hipMemsetAsync((char*)d_ws + WS_CTL, 0, CTL_BYTES, stream);
    Params p{};
    for (int i = 0; i < 35; ++i) p.in[i] = (const float*)d_in[i];
    p.out = (float*)d_out; p.ws = (unsigned char*)d_ws;
#if MK_ONE_LAUNCH
    p.ph_lo = 0; p.ph_hi = N_PHASES;
    hipLaunchKernelGGL(mk_fwd, dim3(grid), dim3(NTHREADS), LDS_BYTES, stream, p);
#else
    for (int k = 0; k < N_PHASES && k <= MK_LAST; ++k) { p.ph_lo = k; p.ph_hi = k + 1; hipLaunchKernelGGL(mk_fwd, dim3(grid), dim3(NTHREADS), LDS_BYTES, stream, p); }
#endif
}
```

```cpp
#include <hip/hip_runtime.h>
#include <stdint.h>
#include <stdio.h>

#ifndef MK_MASK
#define MK_MASK 0xFFFFFFFFu
#endif
#define MKB(k) (((MK_MASK) >> (k)) & 1u)
#ifndef TS_MASK
#define TS_MASK 0
#endif
#ifndef TS_MULT
#define TS_MULT 4
#endif
#ifndef TS_SIDE
#define TS_SIDE 0
#endif
#ifndef REP_KLOOP_BF
#define REP_KLOOP_BF 1
#endif
#ifndef REP_KLOOP_F8
#define REP_KLOOP_F8 1
#endif
#ifndef REP_EPI
#define REP_EPI 1
#endif
#ifndef REP_SCAN
#define REP_SCAN 1
#endif
#ifndef REP_NA
#define REP_NA 1
#endif
#ifndef REP_GEMM
#define REP_GEMM 1
#endif
#ifndef REP_PP
#define REP_PP 1
#endif
#ifndef REP_POST
#define REP_POST 1
#endif
#ifndef REP_CONV
#define REP_CONV 1
#endif
#ifndef REP_NORM
#define REP_NORM 1
#endif
#ifndef REP_PRO
#define REP_PRO 1
#endif
#ifndef MK_LAST
#define MK_LAST 99
#endif
#ifndef MK_ONE_LAUNCH
#define MK_ONE_LAUNCH 1
#endif

#define LAS __attribute__((address_space(3)))
typedef unsigned short bf16_t;
typedef _Float16 f16_t;
typedef short bf16x8 __attribute__((ext_vector_type(8)));
typedef float f32x4 __attribute__((ext_vector_type(4)));
typedef float f32x2 __attribute__((ext_vector_type(2)));
typedef unsigned u32x4 __attribute__((ext_vector_type(4)));
typedef unsigned u32x2 __attribute__((ext_vector_type(2)));
typedef f16_t f16x4 __attribute__((ext_vector_type(4)));
typedef f16_t f16x8 __attribute__((ext_vector_type(8)));
typedef short v4i16_t __attribute__((ext_vector_type(4)));

constexpr int D = 1024, NB = 8, SEQ = 4096, CTXL = 256, TT = CTXL + SEQ;
constexpr int NLAT = NB * SEQ, NCTX = NB * CTXL, NROW = NLAT + NCTX;
constexpr int INW = 3328, DFF = 2816, DFE = 3584, NEXP = 8;
constexpr int O_Q = 0, O_K = 512, O_V = 1024, O_RW = 1536, O_CV = 2816;
constexpr int MODW = 6 * D;
constexpr int NTHREADS = 512, NWAVES = 8;
constexpr int LDS_BYTES = 160 * 1024;
constexpr int LDS_MISC = LDS_BYTES - 256;

constexpr size_t al256(size_t x) { return (x + 255) & ~(size_t)255; }
constexpr size_t WS_CTL   = 0;
constexpr size_t CTL_BYTES = 65536;
constexpr size_t WS_MODV  = WS_CTL + CTL_BYTES;
constexpr size_t WS_BTIN  = al256(WS_MODV + (size_t)2 * 9 * MODW * 4);
constexpr size_t WS_BTOUT = al256(WS_BTIN + (size_t)2 * INW * D * 2);
constexpr size_t WS_BTGU  = al256(WS_BTOUT + (size_t)2 * D * D * 2);
constexpr size_t WS_BTDN  = al256(WS_BTGU + (size_t)2 * DFF * D * 2);
constexpr size_t WS_LORA  = al256(WS_BTDN + (size_t)D * DFF * 2);
constexpr size_t LORA_LD_BYTES = (size_t)(256 * 64 * 2 + 256 * 128) * 2;
constexpr size_t WS_MOE   = al256(WS_LORA + 4 * LORA_LD_BYTES);
constexpr size_t MOE_GU_BYTES = (size_t)2 * DFE * D * 2, MOE_DN_BYTES = (size_t)D * DFE * 2, MOE_E_BYTES = MOE_GU_BYTES + MOE_DN_BYTES;
constexpr size_t MOE8_GU_BYTES = (size_t)2 * DFE * D, MOE8_DN_BYTES = (size_t)D * DFE, MOE8_E_BYTES = MOE8_GU_BYTES + MOE8_DN_BYTES;
constexpr float MOE8_GU_SCALE = 32.0f, MOE8_DN_SCALE = 64.0f, FFN8_DN_SCALE = 64.0f;
constexpr size_t WS_SH    = WS_MOE;
constexpr size_t SH_BYTES = (size_t)NB * 4 * TT * 192 * 2;
constexpr size_t WS_SD    = WS_SH + SH_BYTES;
constexpr size_t WS_HLG   = WS_MOE + (size_t)NEXP * MOE8_E_BYTES;
static_assert(WS_HLG + (size_t)2 * NROW * D <= WS_MOE + (size_t)NEXP * MOE_E_BYTES, "HLG overflows the MoE region");
constexpr size_t WS_XC    = al256(WS_MOE + (size_t)NEXP * MOE_E_BYTES);
constexpr size_t WS_HL    = al256(WS_XC + (size_t)NCTX * D * 4);
constexpr size_t WS_Y     = WS_HL;
constexpr size_t WS_PL    = al256(WS_HL + (size_t)NROW * D * 2);
constexpr size_t WS_MIX   = al256(WS_PL + (size_t)NROW * INW * 2);
constexpr size_t WS_H     = WS_PL;
static_assert(WS_H + (size_t)2 * NROW * DFE <= WS_MIX + (size_t)NROW * D * 2, "fp8 H of both passes overflows PL+MIX");
constexpr size_t WS_YM    = WS_HLG;
static_assert(WS_YM + (size_t)2 * NROW * D * 2 <= WS_HL + (size_t)NROW * D * 2, "YM overflows MoE tail + XC + HL");
constexpr size_t WS_ROUTE = al256(WS_MIX + (size_t)NROW * D * 2);
constexpr size_t RT_TOKE  = 0;
constexpr size_t RT_TOKG  = RT_TOKE + (size_t)NLAT * 2 * 4;
constexpr size_t RT_TOKP  = RT_TOKG + (size_t)NLAT * 2 * 4;
constexpr size_t RT_RMAP  = RT_TOKP + (size_t)NLAT * 2 * 4;
constexpr size_t RT_SGATE = RT_RMAP + (size_t)2 * NROW * 4;
constexpr size_t WS_END   = al256(WS_ROUTE + RT_SGATE + (size_t)2 * NROW * 4);
static_assert(SH_BYTES * 3 <= (size_t)NEXP * MOE_E_BYTES, "scan inputs must fit the MoE weight region");
static_assert((size_t)NROW * DFE * 2 <= (size_t)NROW * INW * 2 + (size_t)NROW * D * 2, "H must fit PL+MIX");

constexpr int CW_BAR = 0;
constexpr int CW_MOECNT = 4096;
constexpr int CW_WGCNT = 12288;

#define XB_TMO      128
#define XB_XCNT(j)  (256  + 64 * (j))
#define XB_XSUB(j)  (1280 + 64 * (j))
#define XB_XGEN(j)  (2304 + 64 * (j))
#define XB_TOP      3328
#define XB_TOPGEN   3392
#define XCD_BAR_WORDS 3456
#define XB_SPIN_CAP (1u << 22)

__device__ __forceinline__ unsigned xb_ld(unsigned* p)              { return __hip_atomic_load(p, __ATOMIC_RELAXED, __HIP_MEMORY_SCOPE_AGENT); }
__device__ __forceinline__ unsigned xb_add(unsigned* p, unsigned v) { return __hip_atomic_fetch_add(p, v, __ATOMIC_RELAXED, __HIP_MEMORY_SCOPE_AGENT); }
__device__ __forceinline__ unsigned xb_xcc_id() { return (unsigned)__builtin_amdgcn_s_getreg((3 << 11) | 20) & 0xFu; }
#define XB_SPIN(cond, bar) do { unsigned _sp = 0; while (cond) { __builtin_amdgcn_s_sleep(1); \
    if ((++_sp & 255u) == 0u) { if (xb_ld(&(bar)[XB_TMO])) break; if (_sp > XB_SPIN_CAP) { atomicAdd(&(bar)[XB_TMO], 1u); break; } } } } while (0)

struct XcdBarrier { unsigned* bar; unsigned x; volatile LAS unsigned* st; };

__device__ __forceinline__ XcdBarrier xcd_barrier_post(unsigned* bar, volatile LAS unsigned* st, int tid) {
    XcdBarrier b; b.bar = bar; b.x = xb_xcc_id(); b.st = st;
    if (tid == 0) (void)xb_add(&bar[XB_XCNT(b.x)], 1u);
    return b;
}
__device__ __forceinline__ void xcd_barrier_complete(unsigned* bar, unsigned x, unsigned& nloc, unsigned& nx) {
    const unsigned G = gridDim.x * gridDim.y * gridDim.z;
    unsigned sum, cnt, mine, sp = 0u;
    for (;;) {
        sum = 0u; cnt = 0u; mine = 0u;
#pragma unroll
        for (unsigned j = 0; j < 16; ++j) { const unsigned c = xb_ld(&bar[XB_XCNT(j)]); sum += c; cnt += (c > 0u) ? 1u : 0u; mine = (j == x) ? c : mine; }
        if (sum == G) break;
        __builtin_amdgcn_s_sleep(1);
        if ((++sp & 255u) == 0u) { if (xb_ld(&bar[XB_TMO])) break; if (sp > XB_SPIN_CAP) { atomicAdd(&bar[XB_TMO], 1u); break; } }
    }
    nloc = mine > 0u ? mine : 1u; nx = cnt > 0u ? cnt : 1u;
}
__device__ __forceinline__ void xcd_barrier(const XcdBarrier& b, int tid) {
    asm volatile("s_waitcnt vmcnt(0)" ::: "memory");
    __syncthreads();
    if (tid == 0) {
        unsigned* bar = b.bar;
        __builtin_amdgcn_s_waitcnt(0);
        unsigned nloc = b.st[0], nx = b.st[1];
        if (nloc == 0u) { xcd_barrier_complete(bar, b.x, nloc, nx); b.st[0] = nloc; b.st[1] = nx; }
        const unsigned old = xb_add(&bar[XB_XSUB(b.x)], 1u);
        const unsigned gen = old / nloc;
        if (old + 1u == (gen + 1u) * nloc) {
            __builtin_amdgcn_fence(__ATOMIC_RELEASE, "agent");
            asm volatile("s_waitcnt vmcnt(0)" ::: "memory");
            const unsigned og = xb_add(&bar[XB_TOP], 1u);
            const unsigned tg = og / nx;
            if (og + 1u == (tg + 1u) * nx) xb_add(&bar[XB_TOPGEN], 1u);
            else XB_SPIN(xb_ld(&bar[XB_TOPGEN]) == tg, bar);
            __builtin_amdgcn_fence(__ATOMIC_ACQUIRE, "agent");
            xb_add(&bar[XB_XGEN(b.x)], 1u);
            asm volatile("s_waitcnt vmcnt(0)" ::: "memory");
        } else {
            XB_SPIN(xb_ld(&bar[XB_XGEN(b.x)]) == gen, bar);
            __builtin_amdgcn_fence(__ATOMIC_ACQUIRE, "agent");
            asm volatile("s_waitcnt vmcnt(0)" ::: "memory");
        }
    }
    __syncthreads();
}

__device__ __forceinline__ int lane_id() { return (int)__builtin_amdgcn_mbcnt_hi(~0u, __builtin_amdgcn_mbcnt_lo(~0u, 0u)); }
__device__ __forceinline__ int lane_id_here() { int l; asm volatile("v_mbcnt_lo_u32_b32 %0, -1, 0\n\tv_mbcnt_hi_u32_b32 %0, -1, %0" : "=v"(l)); return l; }
__device__ __forceinline__ float bf2f(bf16_t b) { return __uint_as_float(((unsigned)b) << 16); }
__device__ __forceinline__ bf16_t f2bf(float f) { unsigned u = __float_as_uint(f); u += 0x7FFFu + ((u >> 16) & 1u); return (bf16_t)(u >> 16); }
__device__ __forceinline__ unsigned pk_bf16(float lo, float hi) { return (unsigned)f2bf(lo) | ((unsigned)f2bf(hi) << 16); }
typedef __bf16 bf16x2_t __attribute__((ext_vector_type(2)));
__device__ __forceinline__ unsigned cvt_pk_bf16(float lo, float hi) { return __builtin_bit_cast(unsigned, __builtin_convertvector((f32x2){lo, hi}, bf16x2_t)); }
__device__ __forceinline__ unsigned pk4_fp8(float a, float b, float c, float d) { int w = 0;
    a = __builtin_amdgcn_fmed3f(a, -448.0f, 448.0f); b = __builtin_amdgcn_fmed3f(b, -448.0f, 448.0f); c = __builtin_amdgcn_fmed3f(c, -448.0f, 448.0f); d = __builtin_amdgcn_fmed3f(d, -448.0f, 448.0f);
    w = __builtin_amdgcn_cvt_pk_fp8_f32(a, b, w, false); w = __builtin_amdgcn_cvt_pk_fp8_f32(c, d, w, true); return (unsigned)w; }
__device__ __forceinline__ float sigmoidf_(float x) { return __builtin_amdgcn_rcpf(1.0f + __expf(-x)); }
__device__ __forceinline__ float siluf_(float x) { return x * __builtin_amdgcn_rcpf(1.0f + __expf(-x)); }
__device__ __forceinline__ float wave_sum(float v) {
#pragma unroll
    for (int o = 32; o >= 1; o >>= 1) v += __shfl_xor(v, o);
    return v;
}
__device__ __forceinline__ float sum16(float v) {
    v += __shfl_xor(v, 1); v += __shfl_xor(v, 2); v += __shfl_xor(v, 4); v += __shfl_xor(v, 8); return v;
}
__device__ __forceinline__ void unpack4(u32x2 w, float (&f)[4]) {
    f[0] = __uint_as_float(w.x << 16); f[1] = __uint_as_float(w.x & 0xffff0000u); f[2] = __uint_as_float(w.y << 16); f[3] = __uint_as_float(w.y & 0xffff0000u);
}
__device__ __forceinline__ void unpack8(u32x4 w, float* f) {
    f[0] = __uint_as_float(w.x << 16); f[1] = __uint_as_float(w.x & 0xffff0000u); f[2] = __uint_as_float(w.y << 16); f[3] = __uint_as_float(w.y & 0xffff0000u);
    f[4] = __uint_as_float(w.z << 16); f[5] = __uint_as_float(w.z & 0xffff0000u); f[6] = __uint_as_float(w.w << 16); f[7] = __uint_as_float(w.w & 0xffff0000u);
}

struct Params {
    const float* in[35];
    float* out; unsigned char* ws;
    int ph_lo, ph_hi;
};
enum { I_X = 0, I_C, I_CTX, I_CCTX, I_N1G, I_N2G, I_MODW, I_MODB, I_WIN, I_WOUT, I_RPB, I_MUP, I_MUN, I_W0, I_W2, I_A0, I_A2, I_G2, I_KK, I_KA, I_RK, I_GNG, I_GNB,
       I_DWW, I_DWB, I_LNG, I_LNB, I_FG, I_FU, I_FD, I_ROUTER, I_MG, I_MU, I_MD, I_FINALG };

__device__ __forceinline__ int row_mi(int r) { return r < NLAT ? (r >> 12) : 8; }

namespace pg8 {
constexpr int BM = 256, BK = 64, HALF = 128, HTB = HALF * BK * 2, STAGE_BYTES = 8 * HTB, NXCD = 8, WGM = 8;
__device__ __forceinline__ int lds_byte(int r, int c) { const int st = (r >> 4) * 2 + (c >> 5), rr = r & 15, cc = c & 31, ob = rr * 64 + cc * 2; return st * 1024 + (ob ^ (((ob >> 9) & 1) << 5)); }
__device__ __forceinline__ void stage_rc(int b, int& R, int& C) { const int st = b / 1024, sb = b % 1024, swz = sb ^ (((sb >> 9) & 1) << 5); R = (st >> 1) * 16 + swz / 64; C = (st & 1) * 32 + (swz % 64) / 2; }
__device__ __forceinline__ int perm32(int rho) { const int n = rho >> 4, i = rho & 15; return 8 * (i >> 2) + 4 * n + (i & 3); }
struct Unit { int pm, pn, sub, ah, hb; };

struct TileOrder {
    int nM, nN, nwg, G, c, full;
    __device__ void init(int nM_, int nN_, int G_, int c_) { nM = nM_; nN = nN_; nwg = nM * nN; G = G_; c = c_; full = nwg; }
    __device__ void split_tail() { full = (nwg / G) * G; }
    __device__ bool next(int i, Unit& u) const {
        int L = i * G + c;
        u.sub = 0; u.ah = 0; u.hb = 0;
        if (L >= full + 4 * (nwg - full)) return false;
        if (L >= full) { const int j = L - full; L = full + (j >> 2); u.sub = 1; u.ah = (j >> 1) & 1; u.hb = j & 1; }
        int wgid = L; { const int q = nwg / NXCD, r = nwg % NXCD, xcd = wgid % NXCD, off = wgid / NXCD; wgid = (xcd < r ? xcd * (q + 1) : r * (q + 1) + (xcd - r) * q) + off; }
        const int nig = WGM * nN, gid = wgid / nig, fm = gid * WGM, gsz = (nM - fm) < WGM ? (nM - fm) : WGM;
        u.pm = fm + ((wgid % nig) % gsz); u.pn = (wgid % nig) / gsz; return true;
    }
};
struct DenseSched : TileOrder {
    const bf16_t* A; const bf16_t* Bt; int K;
    __device__ __forceinline__ const char* aptr(const Unit& u) const { return (const char*)A + (size_t)u.pm * BM * K * 2; }
    __device__ __forceinline__ const char* bptr(const Unit& u) const { return (const char*)Bt + (size_t)u.pn * BM * K * 2; }
    __device__ __forceinline__ const char* abase() const { return (const char*)A; }
    __device__ __forceinline__ int arow(const Unit&, int) const { return 0; }
};
struct MoeSched : TileOrder {
    static constexpr size_t e_stride = MOE8_E_BYTES; static constexpr const int* rowmap = nullptr;
    const bf16_t* A; const unsigned char* Bt0; int K; unsigned tw[4]; int T0;
    __device__ __forceinline__ void set_tstart(const int (&ts0)[9], const int (&ts1)[9]) {
        tw[0] = __builtin_amdgcn_readfirstlane((unsigned)ts0[1] | ((unsigned)ts0[2] << 8) | ((unsigned)ts0[3] << 16) | ((unsigned)ts0[4] << 24));
        tw[1] = __builtin_amdgcn_readfirstlane((unsigned)ts0[5] | ((unsigned)ts0[6] << 8) | ((unsigned)ts0[7] << 16) | (255u << 24));
        tw[2] = __builtin_amdgcn_readfirstlane((unsigned)ts1[1] | ((unsigned)ts1[2] << 8) | ((unsigned)ts1[3] << 16) | ((unsigned)ts1[4] << 24));
        tw[3] = __builtin_amdgcn_readfirstlane((unsigned)ts1[5] | ((unsigned)ts1[6] << 8) | ((unsigned)ts1[7] << 16) | (255u << 24));
        T0 = __builtin_amdgcn_readfirstlane(ts0[8]); }
    __device__ __forceinline__ bool next(int i, Unit& u) const { if (!TileOrder::next(i, u)) return false; const int pm = __builtin_amdgcn_readfirstlane(u.pm); u.pm = pm < T0 ? pm : (NROW / 256) + (pm - T0); return true; }
    __device__ __forceinline__ int expert(int pm) const { pm = __builtin_amdgcn_readfirstlane(pm); const bool p1 = pm >= NROW / 256; const int q = p1 ? pm - NROW / 256 : pm; const unsigned a = p1 ? tw[2] : tw[0], b = p1 ? tw[3] : tw[1]; int e = 0;
#pragma unroll
        for (int j = 0; j < 4; ++j) { e += (int)((unsigned)((int)((a >> (8 * j)) & 255u) - 1 - q) >> 31); e += (int)((unsigned)((int)((b >> (8 * j)) & 255u) - 1 - q) >> 31); }
        return __builtin_amdgcn_readfirstlane(e); }
    __device__ __forceinline__ const char* aptr(const Unit& u) const { return (const char*)A + (size_t)u.pm * BM * K * 2; }
    __device__ __forceinline__ const char* bptr(const Unit& u) const { return (const char*)Bt0 + (size_t)expert(u.pm) * e_stride + (size_t)u.pn * BM * K * 2; }
    __device__ __forceinline__ const char* abase() const { return (const char*)A; }
    __device__ __forceinline__ int arow(const Unit& u, int r) const { const int t = rowmap[u.pm * BM + r]; return t < 0 ? 0 : t; }
};

struct EpiBf16 {
    static constexpr bool PERM = true;
    bf16_t* O; int ldc; int nscale; float scale;
    __device__ __forceinline__ void operator()(const f32x4 (&acc)[2][2][4][2], const Unit& u, int wr, int wc, int fr, int fq) const {
        const int row0 = u.pm * BM + wr * 64 + fr, col0 = u.pn * BM + wc * 32 + 8 * fq;
        const float s = u.pn < nscale ? scale : 1.0f;
#pragma unroll
        for (int ai = 0; ai < 2; ++ai)
#pragma unroll
            for (int m = 0; m < 4; ++m) { bf16_t* rowp = O + (size_t)(row0 + ai * HALF + m * 16) * ldc + col0;
#pragma unroll
                for (int bj = 0; bj < 2; ++bj) { const f32x4 v0 = acc[ai][bj][m][0] * s, v1 = acc[ai][bj][m][1] * s;
                    u32x4 w; w.x = cvt_pk_bf16(v0[0], v0[1]); w.y = cvt_pk_bf16(v0[2], v0[3]); w.z = cvt_pk_bf16(v1[0], v1[1]); w.w = cvt_pk_bf16(v1[2], v1[3]);
                    *(u32x4*)(rowp + bj * HALF) = w; } }
    }
};
__device__ __forceinline__ f32x4 swiglu4(const f32x4& g, const f32x4& u, float c1, float c2) {
    const f32x4 t = g * c1; f32x4 r;
#pragma unroll
    for (int j = 0; j < 4; ++j) r[j] = __builtin_amdgcn_rcpf(1.0f + __builtin_amdgcn_exp2f(t[j]));
    return (g * u) * (r * c2);
}
struct EpiSwiGLU {
    static constexpr bool PERM = true;
    bf16_t* H; int ldh;
    __device__ __forceinline__ void operator()(const f32x4 (&acc)[2][2][4][2], const Unit& u, int wr, int wc, int fr, int fq) const {
        const int row0 = u.pm * BM + wr * 64 + fr, col0 = u.pn * HALF + wc * 32 + 8 * fq;
#pragma unroll
        for (int ai = 0; ai < 2; ++ai)
#pragma unroll
            for (int m = 0; m < 4; ++m) { bf16_t* rowp = H + (size_t)(row0 + ai * HALF + m * 16) * ldh + col0;
                const f32x4 h0 = swiglu4(acc[ai][0][m][0], acc[ai][1][m][0], -1.44269504f, 1.0f), h1 = swiglu4(acc[ai][0][m][1], acc[ai][1][m][1], -1.44269504f, 1.0f);
                u32x4 w; w.x = cvt_pk_bf16(h0[0], h0[1]); w.y = cvt_pk_bf16(h0[2], h0[3]); w.z = cvt_pk_bf16(h1[0], h1[1]); w.w = cvt_pk_bf16(h1[2], h1[3]);
                *(u32x4*)rowp = w; }
    }
};
struct EpiSwiGLU8 {
    static constexpr bool PERM = true;
    unsigned char* H; int ldh; float inv;
    __device__ __forceinline__ void operator()(const f32x4 (&acc)[2][2][4][2], const Unit& u, int wr, int wc, int fr, int fq) const {
        const int row0 = u.pm * BM + wr * 64 + fr, col0 = u.pn * HALF + wc * 32 + 8 * fq;
#pragma unroll
        for (int ai = 0; ai < 2; ++ai)
#pragma unroll
            for (int m = 0; m < 4; ++m) { unsigned char* rowp = H + (size_t)(row0 + ai * HALF + m * 16) * ldh + col0;
                const f32x4 h0 = swiglu4(acc[ai][0][m][0], acc[ai][1][m][0], -1.44269504f * inv, inv * inv), h1 = swiglu4(acc[ai][0][m][1], acc[ai][1][m][1], -1.44269504f * inv, inv * inv);
                u32x2 w; w.x = pk4_fp8(h0[0], h0[1], h0[2], h0[3]); w.y = pk4_fp8(h1[0], h1[1], h1[2], h1[3]);
                *(u32x2*)rowp = w; }
    }
};
struct EpiRes {
    static constexpr bool PERM = false;
    const float* resL; const float* resC; float* outL; float* outC; const float* gvec;
    float inv = 1.0f;
    __device__ __forceinline__ void operator()(const f32x4 (&acc)[2][2][4][2], const Unit& u, int wr, int wc, int fr, int fq) const {
        const int r0 = u.pm * BM; const bool lat = r0 < NLAT;
        const float* res = lat ? resL + (size_t)r0 * D : resC + (size_t)(r0 - NLAT) * D;
        float* out = lat ? outL + (size_t)r0 * D : outC + (size_t)(r0 - NLAT) * D;
        const float* gv = gvec + (size_t)(lat ? (r0 >> 12) : 8) * MODW;
        const int rl = wr * 64 + fr, col0 = u.pn * BM + wc * 32 + 4 * fq;
        const int nq = u.sub ? 1 : 2, ro = u.sub ? u.ah * HALF : 0, co = u.sub ? u.hb * HALF : 0;
        f32x4 g[2][2];
#pragma unroll
        for (int bj = 0; bj < 2; ++bj)
#pragma unroll
            for (int n = 0; n < 2; ++n) g[bj][n] = *(const f32x4*)(gv + col0 + co + (u.sub ? 0 : bj * HALF) + n * 16) * inv;
#pragma unroll
        for (int ai = 0; ai < 2; ++ai) if (ai < nq)
#pragma unroll
            for (int m = 0; m < 4; ++m) { const size_t off = (size_t)(rl + ro + ai * HALF + m * 16) * D + col0 + co;
#pragma unroll
                for (int bj = 0; bj < 2; ++bj) if (bj < nq)
#pragma unroll
                    for (int n = 0; n < 2; ++n) { const f32x4 rv = *(const f32x4*)(res + off + bj * HALF + n * 16);
                        *(f32x4*)(out + off + bj * HALF + n * 16) = rv + g[bj][n] * acc[ai][bj][m][n]; } }
    }
};
struct EpiMoeY {
    static constexpr bool PERM = true;
    bf16_t* Y; float scale;
    __device__ __forceinline__ void operator()(const f32x4 (&acc)[2][2][4][2], const Unit& u, int wr, int wc, int fr, int fq) const {
        const int nq = u.sub ? 1 : 2;
        const int row0 = u.pm * BM + wr * 64 + fr + (u.sub ? u.ah * HALF : 0), col0 = u.pn * BM + wc * 32 + 8 * fq + (u.sub ? u.hb * HALF : 0);
        float s = scale; asm volatile("" : "+v"(s));
#pragma unroll
        for (int ai = 0; ai < 2; ++ai) if (ai < nq)
#pragma unroll
            for (int m = 0; m < 4; ++m) { bf16_t* rowp = Y + (size_t)(row0 + ai * HALF + m * 16) * D + col0;
#pragma unroll
                for (int bj = 0; bj < 2; ++bj) if (bj < nq) { const f32x4 v0 = acc[ai][bj][m][0] * s, v1 = acc[ai][bj][m][1] * s;
                    u32x4 w; w.x = cvt_pk_bf16(v0[0], v0[1]); w.y = cvt_pk_bf16(v0[2], v0[3]); w.z = cvt_pk_bf16(v1[0], v1[1]); w.w = cvt_pk_bf16(v1[2], v1[3]);
                    *(u32x4*)(rowp + bj * HALF) = w; } }
    }
};

__device__ __forceinline__ const char* uni_ptr(const char* p) { const unsigned long long v = (unsigned long long)p; const unsigned lo = __builtin_amdgcn_readfirstlane((unsigned)v), hi = __builtin_amdgcn_readfirstlane((unsigned)(v >> 32)); return (const char*)(((unsigned long long)hi << 32) | lo); }
typedef int v8i32_t __attribute__((ext_vector_type(8)));
__device__ __forceinline__ v8i32_t pg8_cat(const bf16x8& a, const bf16x8& b) { const u32x4 x = __builtin_bit_cast(u32x4, a), y = __builtin_bit_cast(u32x4, b); v8i32_t r; r[0] = (int)x[0]; r[1] = (int)x[1]; r[2] = (int)x[2]; r[3] = (int)x[3]; r[4] = (int)y[0]; r[5] = (int)y[1]; r[6] = (int)y[2]; r[7] = (int)y[3]; return r; }
template <class Epi, class Sched, bool GATHER, bool FP8 = false>
__device__ __forceinline__ void gemm_phase(LAS unsigned char* lds, const int K, const Sched& S, const Epi& E, const int wave_) {
    int tid_ = wave_ * 64 + lane_id_here(); asm volatile("" : "+v"(tid_));
    const int tid = tid_, wid = wave_, lane = tid & 63, wr = wid >> 2, wc = wid & 3, fr = lane & 15, fq = lane >> 4;
    const int nt = K / BK;
    unsigned voffA[2], voffB[2]; int RA[2], CA[2];
#pragma unroll
    for (int i = 0; i < 2; ++i) { int R, C; stage_rc(tid * 16 + i * 8192, R, C); const int Rb = Epi::PERM ? ((R & ~31) + perm32(R & 31)) : R;
        voffA[i] = (unsigned)(R * K + C) * 2u; voffB[i] = (unsigned)(Rb * K + C) * 2u; RA[i] = R; CA[i] = C; }
    const size_t kstep = (size_t)(BK * 2);
    const size_t hstep = (size_t)HALF * K * 2;
    const unsigned ldsw = (unsigned)wid * 1024u;
    const int aoff = lds_byte(wr * 64 + fr, fq * 8), boff = lds_byte(wc * 32 + fr, fq * 8);
#define PG8_SA(b, h) (((b) * 2 + (h)) * HTB)
#define PG8_SB(b, h) ((4 + (b) * 2 + (h)) * HTB)
#define PG8_STAGE(bufoff, gbase, voff) do { _Pragma("unroll") for (int _i = 0; _i < 2; ++_i) { unsigned _o = (voff)[_i]; const char* _g = (const char*)(gbase); asm volatile("" : "+v"(_o), "+s"(_g)); \
        __builtin_amdgcn_global_load_lds((const unsigned*)(_g + _o), (LAS unsigned*)(lds + (bufoff) + ldsw + _i * 8192), 16, 0, 0); } } while (0)
#define PG8_LDA(dst, b, h) do { _Pragma("unroll") for (int m = 0; m < 4; ++m) _Pragma("unroll") for (int k = 0; k < 2; ++k) dst[m][k] = *(const LAS bf16x8*)(lds + PG8_SA(b, h) + aoff + m * 2048 + k * 1024); } while (0)
#define PG8_LDB(dst, b, h) do { _Pragma("unroll") for (int n = 0; n < 2; ++n) _Pragma("unroll") for (int k = 0; k < 2; ++k) dst[n][k] = *(const LAS bf16x8*)(lds + PG8_SB(b, h) + boff + n * 2048 + k * 1024); } while (0)
#define PG8_MMA(ai, bj, At, Bt) do { __builtin_amdgcn_s_setprio(1); _Pragma("unroll") for (int m = 0; m < 4; ++m) _Pragma("unroll") for (int n = 0; n < 2; ++n) { \
        if constexpr (FP8) { acc[ai][bj][m][n] = __builtin_amdgcn_mfma_scale_f32_16x16x128_f8f6f4(pg8_cat(Bt[n][0], Bt[n][1]), pg8_cat(At[m][0], At[m][1]), acc[ai][bj][m][n], 0, 0, 0, 0, 0, 0); } \
        else { _Pragma("unroll") for (int k = 0; k < 2; ++k) acc[ai][bj][m][n] = __builtin_amdgcn_mfma_f32_16x16x32_bf16(Bt[n][k], At[m][k], acc[ai][bj][m][n], 0, 0, 0); } } \
        __builtin_amdgcn_s_setprio(0); } while (0)
#define PG8_WAIT_V(n) asm volatile("s_waitcnt vmcnt(" #n ")" ::: "memory")
#define PG8_WAIT_L(n) asm volatile("s_waitcnt lgkmcnt(" #n ")" ::: "memory")
#define PG8_BAR __builtin_amdgcn_s_barrier()
#define PG8_SCHED __builtin_amdgcn_sched_barrier(0)
#define PG8_STAGE_A(bufoff, TS, H) do { if constexpr (GATHER) { PG8_STAGE(bufoff, gA##TS, oA##TS[H]); } else { PG8_STAGE(bufoff, a##TS + (H) * hA##TS, voffA); } } while (0)
    Unit cur, nxt; int ui = 0;
    if (!S.next(0, cur)) return;
    f32x4 acc[2][2][4][2];
#pragma unroll
    for (int a = 0; a < 2; ++a)
#pragma unroll
        for (int b = 0; b < 2; ++b)
#pragma unroll
            for (int m = 0; m < 4; ++m)
#pragma unroll
                for (int n = 0; n < 2; ++n) acc[a][b][m][n] = (f32x4){0.f, 0.f, 0.f, 0.f};
    bf16x8 At[4][2], B0[2][2], B1[2][2];
    const char* Abase = uni_ptr(S.abase());
    unsigned aoC[2][2] = {{0u, 0u}, {0u, 0u}}, aoN[2][2] = {{0u, 0u}, {0u, 0u}};
    if constexpr (GATHER) {
#pragma unroll
        for (int h = 0; h < 2; ++h)
#pragma unroll
            for (int i = 0; i < 2; ++i) aoC[h][i] = (unsigned)(S.arow(cur, h * HALF + RA[i]) * K + CA[i]) * 2u;
    }
    size_t hAc = cur.sub ? 0 : hstep, hBc = hAc, hAn = hAc, hBn = hAc;
    const char* cA = GATHER ? Abase : uni_ptr(S.aptr(cur) + (cur.sub ? cur.ah * hstep : 0)); const char* cB = uni_ptr(S.bptr(cur) + (cur.sub ? cur.hb * hstep : 0));
    if constexpr (GATHER) {
        PG8_STAGE(PG8_SB(0, 0), cB, voffB); PG8_STAGE(PG8_SA(0, 0), Abase, aoC[0]); PG8_STAGE(PG8_SB(0, 1), cB + hstep, voffB); PG8_STAGE(PG8_SA(0, 1), Abase, aoC[1]);
    } else {
        PG8_STAGE(PG8_SB(0, 0), cB, voffB); PG8_STAGE(PG8_SA(0, 0), cA, voffA); PG8_STAGE(PG8_SB(0, 1), cB + hBc, voffB); PG8_STAGE(PG8_SA(0, 1), cA + hAc, voffA);
    }
    if (wr == 1) PG8_BAR;
    PG8_WAIT_V(4); PG8_BAR;
    if constexpr (GATHER) {
        PG8_STAGE(PG8_SB(1, 0), cB + kstep, voffB); PG8_STAGE(PG8_SA(1, 0), Abase + kstep, aoC[0]); PG8_STAGE(PG8_SB(1, 1), cB + hstep + kstep, voffB);
    } else {
        PG8_STAGE(PG8_SB(1, 0), cB + kstep, voffB); PG8_STAGE(PG8_SA(1, 0), cA + kstep, voffA); PG8_STAGE(PG8_SB(1, 1), cB + hBc + kstep, voffB);
    }
    PG8_WAIT_V(6); PG8_BAR;
    for (;;) {
        constexpr int REP_KLOOP = FP8 ? REP_KLOOP_F8 : REP_KLOOP_BF;
        const bool has_next = S.next((ui + 1) / REP_KLOOP, nxt);
        const char* nA = uni_ptr(has_next ? (GATHER ? Abase : S.aptr(nxt) + (nxt.sub ? nxt.ah * hstep : 0)) : cA); const char* nB = uni_ptr(has_next ? S.bptr(nxt) + (nxt.sub ? nxt.hb * hstep : 0) : cB);
        hAn = has_next ? (nxt.sub ? 0 : hstep) : hAc; hBn = hAn;
        if constexpr (GATHER) {
            if (has_next) {
#pragma unroll
                for (int h = 0; h < 2; ++h)
#pragma unroll
                    for (int i = 0; i < 2; ++i) aoN[h][i] = (unsigned)(S.arow(nxt, h * HALF + RA[i]) * K + CA[i]) * 2u;
            } else {
#pragma unroll
                for (int h = 0; h < 2; ++h)
#pragma unroll
                    for (int i = 0; i < 2; ++i) aoN[h][i] = aoC[h][i];
            }
        }
        for (int t = 0; t < nt; t += 2) {
            const bool last = (t == nt - 2);
            const char* a1 = cA + (size_t)(t + 1) * kstep;
            const char* a2 = last ? nA : cA + (size_t)(t + 2) * kstep; const char* b2 = last ? nB : cB + (size_t)(t + 2) * kstep;
            const char* a3 = a2 + kstep; const char* b3 = b2 + kstep;
            const size_t hA1 = hAc, hA2 = last ? hAn : hAc, hA3 = hA2, hB2 = last ? hBn : hBc; (void)hA1; (void)hA3;
            const char* gA1 = Abase + (size_t)(t + 1) * kstep; const char* gA2 = Abase + (last ? (size_t)0 : (size_t)(t + 2) * kstep); const char* gA3 = gA2 + kstep;
            unsigned oA1[2][2], oA2[2][2], oA3[2][2];
#pragma unroll
            for (int h = 0; h < 2; ++h)
#pragma unroll
                for (int i = 0; i < 2; ++i) { oA1[h][i] = aoC[h][i]; oA2[h][i] = last ? aoN[h][i] : aoC[h][i]; oA3[h][i] = oA2[h][i]; }
            (void)a1; (void)a3; (void)gA1; (void)gA3; (void)oA1; (void)oA3;
            PG8_LDB(B0, 0, 0); PG8_SCHED; PG8_LDA(At, 0, 0); PG8_STAGE_A(PG8_SA(1, 1), 1, 1);
            PG8_WAIT_L(8); PG8_BAR; PG8_WAIT_L(0); PG8_MMA(0, 0, At, B0); PG8_BAR; PG8_SCHED;
            PG8_LDB(B1, 0, 1); PG8_STAGE(PG8_SB(0, 0), b2, voffB);
            PG8_BAR; PG8_WAIT_L(0); if (!cur.sub) PG8_MMA(0, 1, At, B1); PG8_BAR;
            PG8_LDA(At, 0, 1); PG8_STAGE_A(PG8_SA(0, 0), 2, 0);
            PG8_BAR; PG8_WAIT_L(0); if (!cur.sub) PG8_MMA(1, 0, At, B0); PG8_BAR; PG8_SCHED;
            PG8_STAGE(PG8_SB(0, 1), b2 + hB2, voffB);
            PG8_WAIT_V(6); PG8_BAR; if (!cur.sub) PG8_MMA(1, 1, At, B1); PG8_BAR;
            PG8_LDB(B0, 1, 0); PG8_SCHED; PG8_LDA(At, 1, 0); PG8_STAGE_A(PG8_SA(0, 1), 2, 1);
            PG8_WAIT_L(8); PG8_BAR; PG8_WAIT_L(0); PG8_MMA(0, 0, At, B0); PG8_BAR; PG8_SCHED;
            PG8_LDB(B1, 1, 1); PG8_STAGE(PG8_SB(1, 0), b3, voffB);
            PG8_BAR; PG8_WAIT_L(0); if (!cur.sub) PG8_MMA(0, 1, At, B1); PG8_BAR;
            PG8_LDA(At, 1, 1); PG8_STAGE_A(PG8_SA(1, 0), 3, 0);
            PG8_BAR; PG8_WAIT_L(0); if (!cur.sub) PG8_MMA(1, 0, At, B0); PG8_BAR; PG8_SCHED;
            PG8_STAGE(PG8_SB(1, 1), b3 + hB2, voffB);
            PG8_WAIT_V(6); PG8_BAR; if (!cur.sub) PG8_MMA(1, 1, At, B1); PG8_BAR;
        }
        if (REP_KLOOP == 1 || (ui % REP_KLOOP) == REP_KLOOP - 1) { int t2 = tid; asm volatile("" : "+v"(t2)); const int l2 = t2 & 63; E(acc, cur, wr, wc, l2 & 15, l2 >> 4);
            if constexpr (Epi::PERM && REP_EPI > 1) { for (int rep = 1; rep < REP_EPI; ++rep) { asm volatile("" ::: "memory"); E(acc, cur, wr, wc, l2 & 15, l2 >> 4); } } }
        if (!has_next) break;
#pragma unroll
        for (int a = 0; a < 2; ++a)
#pragma unroll
            for (int b = 0; b < 2; ++b)
#pragma unroll
                for (int m = 0; m < 4; ++m)
#pragma unroll
                    for (int n = 0; n < 2; ++n) acc[a][b][m][n] = (f32x4){0.f, 0.f, 0.f, 0.f};
        cur = nxt; cA = nA; cB = nB; hAc = hAn; hBc = hBn; ++ui;
        if constexpr (GATHER) {
#pragma unroll
            for (int h = 0; h < 2; ++h)
#pragma unroll
                for (int i = 0; i < 2; ++i) aoC[h][i] = aoN[h][i];
        }
    }
    PG8_WAIT_V(0);
    if (wr == 0) PG8_BAR;
    PG8_BAR;
#undef PG8_SA
#undef PG8_SB
#undef PG8_STAGE
#undef PG8_STAGE_A
#undef PG8_LDA
#undef PG8_LDB
#undef PG8_MMA
#undef PG8_WAIT_V
#undef PG8_WAIT_L
#undef PG8_BAR
#undef PG8_SCHED
}
}

struct Frame {
    LAS unsigned char* lds; int tid, lane, wave, G, bid, gw, nw;
    unsigned char* ws;
};
extern __shared__ __attribute__((aligned(16))) unsigned char lds_raw[];
typedef const __attribute__((address_space(4))) Params* KP;
__device__ __forceinline__ Params load_params(const void* kp_) {
    const unsigned long long v = (unsigned long long)kp_;
    const unsigned lo = __builtin_amdgcn_readfirstlane((unsigned)v), hi = __builtin_amdgcn_readfirstlane((unsigned)(v >> 32));
    KP kp = (KP)(((unsigned long long)hi << 32) | lo);
    Params P;
#pragma unroll
    for (int i = 0; i < 35; ++i) P.in[i] = kp->in[i];
    P.out = kp->out; P.ws = kp->ws; P.ph_lo = kp->ph_lo; P.ph_hi = kp->ph_hi;
    return P;
}
#define PHASE static __attribute__((noinline)) __device__ void
#define PHASE_INL static __device__ __forceinline__ void
__device__ __forceinline__ Frame make_frame(unsigned char* ws, int wave_) {
    Frame F; F.lds = (LAS unsigned char*)lds_raw; F.wave = __builtin_amdgcn_readfirstlane(wave_);
    int t_ = F.wave * 64 + lane_id_here(); asm volatile("" : "+v"(t_));
    F.tid = t_; F.lane = F.tid & 63;
    F.G = gridDim.x; F.bid = blockIdx.x; F.gw = F.bid * NWAVES + F.wave; F.nw = F.G * NWAVES; F.ws = ws; return F;
}
__device__ __forceinline__ Frame sub_frame(Frame F, int bid, int G) { F.bid = bid; F.G = G; F.gw = F.bid * NWAVES + F.wave; F.nw = F.G * NWAVES; return F; }
#define PHASE_ENTER const Params P = load_params(kp_); const Frame F = make_frame(P.ws, wv_)

struct ConvTile { const float* src; unsigned char* dst; int K, N, mode, tt, fp8; float scale; };
__device__ __forceinline__ void conv_load(const ConvTile& c, int lane, f32x4 (&v)[16]) {
    const int tn = c.N >> 6, k0 = (c.tt / tn) * 64, n0 = (c.tt % tn) * 64;
#pragma unroll
    for (int i = 0; i < 16; ++i) { const int row = i * 4 + (lane >> 4), c4 = (lane & 15) * 4; v[i] = *(const f32x4*)(c.src + (size_t)(k0 + row) * c.N + n0 + c4); }
}
__device__ __forceinline__ void conv_emit(const ConvTile& c, const LAS float* tile, int lane) {
    const int tn = c.N >> 6, k0 = (c.tt / tn) * 64, n0 = (c.tt % tn) * 64;
#pragma unroll 2
    for (int i = 0; i < 8; ++i) { const int n = i * 8 + (lane >> 3), kc = (lane & 7) * 8;
        float f[8];
#pragma unroll
        for (int j = 0; j < 8; ++j) f[j] = tile[(kc + j) * 65 + n] * c.scale;
        const int ng = n0 + n; const int drow = c.mode == 0 ? ng : ((ng >> 7) * 256 + (c.mode == 2 ? 128 : 0) + (ng & 127));
        if (c.mode == 3) {
            const int kabs = k0 + kc, KB = c.K >> 5, hh = ng >> 6, cp = ng & 63, tq = 2 * (cp >> 5) + ((cp >> 2) & 1), tkk = 4 * ((cp >> 3) & 3) + (cp & 3);
            const size_t idx = ((size_t)((hh * 4 + tq) * KB + (kabs >> 5)) * 64 + (tkk + 16 * ((kabs >> 3) & 3))) * 8;
            u32x4 w; w.x = pk_bf16(f[0], f[1]); w.y = pk_bf16(f[2], f[3]); w.z = pk_bf16(f[4], f[5]); w.w = pk_bf16(f[6], f[7]); *(u32x4*)(c.dst + idx * 2) = w; }
        else if (c.fp8) { u32x2 w; w.x = pk4_fp8(f[0], f[1], f[2], f[3]); w.y = pk4_fp8(f[4], f[5], f[6], f[7]); *(u32x2*)(c.dst + (size_t)drow * c.K + k0 + kc) = w; }
        else { u32x4 w; w.x = pk_bf16(f[0], f[1]); w.y = pk_bf16(f[2], f[3]); w.z = pk_bf16(f[4], f[5]); w.w = pk_bf16(f[6], f[7]); *(u32x4*)(c.dst + ((size_t)drow * c.K + k0 + kc) * 2) = w; } }
}
template <class Decode>
__device__ __forceinline__ void conv_run(const Frame& F, int total, const Decode& decode) {
    LAS float* tile = (LAS float*)(F.lds + F.wave * (64 * 65 * 4)); const int lane = F.lane;
    int t = F.gw; if (t >= total) return;
    ConvTile c = decode(t); f32x4 v[16]; conv_load(c, lane, v);
    for (;;) {
#pragma unroll
        for (int i = 0; i < 16; ++i) { const int row = i * 4 + (lane >> 4), c4 = (lane & 15) * 4; tile[row * 65 + c4 + 0] = v[i][0]; tile[row * 65 + c4 + 1] = v[i][1]; tile[row * 65 + c4 + 2] = v[i][2]; tile[row * 65 + c4 + 3] = v[i][3]; }
        __builtin_amdgcn_wave_barrier(); asm volatile("s_waitcnt lgkmcnt(0)" ::: "memory");
        const int tnext = t + F.nw; const bool more = tnext < total; ConvTile cn = c;
        if (more) { cn = decode(tnext); conv_load(cn, lane, v); }
        conv_emit(c, tile, lane);
        __builtin_amdgcn_wave_barrier(); asm volatile("s_waitcnt lgkmcnt(0)" ::: "memory");
        if (!more) break;
        c = cn; t = tnext;
    }
}

__device__ __forceinline__ void phase_prologue(const Frame& F, const Params& P) {
    float* modv = (float*)(F.ws + WS_MODV);
    LAS float* s = (LAS float*)F.lds;
    LAS float* red = (LAS float*)(F.lds + 9 * 1024 * 4);
    for (int cb = F.bid; cb < (2 * MODW) / 64; cb += F.G) {
        for (int i = F.tid; i < 9 * 1024; i += NTHREADS) { const int mi = i >> 10, k = i & 1023; const float c = mi < 8 ? P.in[I_C][mi * D + k] : P.in[I_CCTX][k]; s[i] = siluf_(c); }
        __syncthreads();
        const int cg = F.lane & 15, kr = F.lane >> 4;
        const int colg = cb * 64 + 4 * cg, l = colg / MODW, col = colg % MODW;
        const float* w = P.in[I_MODW] + (size_t)l * D * MODW + col;
        f32x4 acc[9];
#pragma unroll
        for (int mi = 0; mi < 9; ++mi) acc[mi] = (f32x4){0.f, 0.f, 0.f, 0.f};
        const int kb = F.wave * 128 + kr;
#pragma unroll 8
        for (int i = 0; i < 32; ++i) { const int k = kb + 4 * i; const f32x4 wv = *(const f32x4*)(w + (size_t)k * MODW);
#pragma unroll
            for (int mi = 0; mi < 9; ++mi) acc[mi] += wv * s[mi * 1024 + k]; }
#pragma unroll
        for (int mi = 0; mi < 9; ++mi) *(LAS f32x4*)(red + (((F.wave * 4 + kr) * 9 + mi) * 64 + 4 * cg)) = acc[mi];
        __syncthreads();
        for (int i = F.tid; i < 9 * 64; i += NTHREADS) { const int mi = i >> 6, ln = i & 63; float a = 0.f;
#pragma unroll
            for (int w32 = 0; w32 < 32; ++w32) a += red[(w32 * 9 + mi) * 64 + ln];
            const int cg2 = cb * 64 + ln, l2 = cg2 / MODW, c2 = cg2 % MODW;
            modv[((size_t)l2 * 9 + mi) * MODW + c2] = a + P.in[I_MODB][l2 * MODW + c2]; }
        __syncthreads();
    }
    conv_run(F, 4352, [&](int t) { ConvTile c; c.fp8 = 0; c.scale = 1.0f; c.mode = 0;
        if (t < 1664) { const int l = t >= 832 ? 1 : 0; c.tt = t - l * 832; c.src = P.in[I_WIN] + (size_t)l * D * INW; c.dst = F.ws + WS_BTIN + (size_t)l * INW * D * 2; c.K = D; c.N = INW; }
        else if (t < 2176) { const int u = t - 1664, l = u >= 256 ? 1 : 0; c.tt = u - l * 256; c.src = P.in[I_WOUT] + (size_t)l * D * D; c.dst = F.ws + WS_BTOUT + (size_t)l * D * D * 2; c.K = D; c.N = D; }
        else if (t < 2880) { c.tt = t - 2176; c.src = P.in[I_FG]; c.dst = F.ws + WS_BTGU; c.K = D; c.N = DFF; c.mode = 1; }
        else if (t < 3584) { c.tt = t - 2880; c.src = P.in[I_FU]; c.dst = F.ws + WS_BTGU; c.K = D; c.N = DFF; c.mode = 2; }
        else if (t < 4288) { c.tt = t - 3584; c.src = P.in[I_FD]; c.dst = F.ws + WS_BTDN; c.K = DFF; c.N = D; c.fp8 = 1; c.scale = FFN8_DN_SCALE; }
        else { const int u = t - 4288, ld = u >> 4, r = u & 15; unsigned char* base = F.ws + WS_LORA + (size_t)ld * LORA_LD_BYTES; c.N = 256; c.mode = 3;
            if (r < 4) { c.tt = r; c.src = P.in[I_W2] + (size_t)ld * 64 * 256; c.dst = base; c.K = 64; }
            else if (r < 8) { c.tt = r - 4; c.src = P.in[I_A2] + (size_t)ld * 64 * 256; c.dst = base + 256 * 64 * 2; c.K = 64; }
            else { c.tt = r - 8; c.src = P.in[I_G2] + (size_t)ld * 128 * 256; c.dst = base + 2 * 256 * 64 * 2; c.K = 128; } }
        return c; });
}
__device__ __forceinline__ void phase_moe_convert(const Frame& F, const Params& P) {
    conv_run(F, NEXP * 3 * 896, [&](int t) { ConvTile c; c.fp8 = 1;
        const int e = t / 2688, r = t - e * 2688, j = r / 896; c.tt = r - j * 896;
        unsigned char* gu = F.ws + WS_MOE + (size_t)e * MOE8_E_BYTES;
        if (j < 2) { c.src = (j == 0 ? P.in[I_MG] : P.in[I_MU]) + (size_t)e * D * DFE; c.dst = gu; c.K = D; c.N = DFE; c.mode = 1 + j; c.scale = MOE8_GU_SCALE; }
        else { c.src = P.in[I_MD] + (size_t)e * DFE * D; c.dst = gu + MOE8_GU_BYTES; c.K = DFE; c.N = D; c.mode = 0; c.scale = MOE8_DN_SCALE; }
        return c; });
}

template <bool ROUTER>
__device__ __forceinline__ void phase_norm(const Frame& F, const Params& P, int l, int which, int nrows, const float* srcL, const float* srcC) {
    const float* g = (which == 0 ? P.in[I_N1G] : P.in[I_N2G]) + l * D;
    const float* modv = (const float*)(F.ws + WS_MODV) + (size_t)l * 9 * MODW + (which == 0 ? 0 : 3 * D);
    bf16_t* HL = (bf16_t*)(F.ws + WS_HL);
    LAS float* rt = (LAS float*)F.lds;
    LAS unsigned* lcnt = (LAS unsigned*)(F.lds + D * NEXP * 4);
    if (ROUTER) {
        for (int i = F.tid; i < D * NEXP; i += NTHREADS) { const int col = i >> 3, e = i & 7; rt[((((col >> 8) * 4 + (col & 3)) * 2 + (e >> 2)) * 64 + ((col >> 2) & 63)) * 4 + (e & 3)] = P.in[I_ROUTER][i]; }
        if (F.tid < 16) lcnt[F.tid] = 0u;
        __syncthreads();
    }
    const int lane = F.lane;
    const int RB = ((nrows + F.G - 1) / F.G + 7) & ~7, rbeg = F.bid * RB, rend = min(rbeg + RB, nrows);
    f32x4 xn[4], mA[4], mB[4]; int cur_mi = -1;
    { const int r = rbeg + F.wave < rend ? rbeg + F.wave : 0; const float* xr = r < NLAT ? srcL + (size_t)r * D : srcC + (size_t)(r - NLAT) * D;
#pragma unroll
      for (int j = 0; j < 4; ++j) xn[j] = *(const f32x4*)(xr + j * 256 + lane * 4); }
    for (int r = rbeg + F.wave; r < rend; r += 8) {
        { const int mi = row_mi(r);
          if (mi != cur_mi) { cur_mi = mi; const float* mv = modv + (size_t)mi * MODW;
#pragma unroll
              for (int j = 0; j < 4; ++j) { const int c = j * 256 + lane * 4; const f32x4 gg = *(const f32x4*)(g + c), sc = *(const f32x4*)(mv + D + c); mA[j] = gg * (sc + 1.0f); mB[j] = *(const f32x4*)(mv + c); } } }
        f32x4 x[4]; float ss = 0.f;
#pragma unroll
        for (int j = 0; j < 4; ++j) x[j] = xn[j];
        { const int rn = r + 8 < rend ? r + 8 : r; const float* xr = rn < NLAT ? srcL + (size_t)rn * D : srcC + (size_t)(rn - NLAT) * D;
#pragma unroll
          for (int j = 0; j < 4; ++j) xn[j] = *(const f32x4*)(xr + j * 256 + lane * 4); }
#pragma unroll
        for (int j = 0; j < 4; ++j) ss += x[j][0] * x[j][0] + x[j][1] * x[j][1] + x[j][2] * x[j][2] + x[j][3] * x[j][3];
        ss = wave_sum(ss);
        const float rstd = rsqrtf(ss * (1.0f / D) + 1e-6f);
        float lg[NEXP];
        if (ROUTER) {
#pragma unroll
            for (int e = 0; e < NEXP; ++e) lg[e] = 0.f;
        }
#pragma unroll
        for (int j = 0; j < 4; ++j) { const int c = j * 256 + lane * 4;
            f32x4 y = (x[j] * rstd) * mA[j] + mB[j];
            if (ROUTER) { *(unsigned*)((unsigned char*)HL + (size_t)r * D + c) = pk4_fp8(y[0], y[1], y[2], y[3]); }
            else { u32x2 w; w.x = pk_bf16(y[0], y[1]); w.y = pk_bf16(y[2], y[3]); *(u32x2*)(HL + (size_t)r * D + c) = w; }
            if (ROUTER) {
#pragma unroll
                for (int q = 0; q < 4; ++q) { const f32x4 r0 = *(const LAS f32x4*)(rt + (((j * 4 + q) * 2 + 0) * 64 + lane) * 4), r1 = *(const LAS f32x4*)(rt + (((j * 4 + q) * 2 + 1) * 64 + lane) * 4);
                    lg[0] += y[q] * r0[0]; lg[1] += y[q] * r0[1]; lg[2] += y[q] * r0[2]; lg[3] += y[q] * r0[3];
                    lg[4] += y[q] * r1[0]; lg[5] += y[q] * r1[1]; lg[6] += y[q] * r1[2]; lg[7] += y[q] * r1[3]; asm volatile("" ::: "memory"); }
            }
        }
        if (ROUTER) {
#pragma unroll
            for (int e = 0; e < NEXP; ++e) lg[e] = wave_sum(lg[e]);
            if (lane == 0) {
                int e1 = 0; float l1 = lg[0];
#pragma unroll
                for (int e = 1; e < NEXP; ++e) if (lg[e] > l1) { l1 = lg[e]; e1 = e; }
                int e2 = -1; float l2 = -3.0e38f;
#pragma unroll
                for (int e = 0; e < NEXP; ++e) if (e != e1 && lg[e] > l2) { l2 = lg[e]; e2 = e; }
                if (e2 < 0) { e2 = e1 == 0 ? 1 : 0; l2 = l1; }
                const float ex = __expf(l2 - l1), g1 = 1.0f / (1.0f + ex), g2 = ex * g1;
                const unsigned p1 = __hip_atomic_fetch_add(lcnt + e1, 1u, __ATOMIC_RELAXED, __HIP_MEMORY_SCOPE_WORKGROUP), p2 = __hip_atomic_fetch_add(lcnt + 8 + e2, 1u, __ATOMIC_RELAXED, __HIP_MEMORY_SCOPE_WORKGROUP);
                int* te = (int*)(F.ws + WS_ROUTE + RT_TOKE); float* tg = (float*)(F.ws + WS_ROUTE + RT_TOKG); int* tp = (int*)(F.ws + WS_ROUTE + RT_TOKP);
                te[r * 2] = e1 | (F.bid << 8); te[r * 2 + 1] = e2 | (F.bid << 8); tg[r * 2] = g1; tg[r * 2 + 1] = g2; tp[r * 2] = (int)p1; tp[r * 2 + 1] = (int)p2;
            }
        }
    }
    if (ROUTER) {
        __syncthreads();
        if (F.tid < 16) ((unsigned*)(F.ws + WS_CTL) + CW_WGCNT)[F.bid * 16 + F.tid] = lcnt[F.tid];
    }
}
__device__ __forceinline__ void moe_tstart(const Frame& F, int pass, int (&ts)[9]) {
    const unsigned* cnt = (const unsigned*)(F.ws + WS_CTL) + CW_MOECNT + pass * 8;
    int a = 0;
#pragma unroll
    for (int e = 0; e < 8; ++e) { ts[e] = a; a += (int)((__hip_atomic_load(cnt + e, __ATOMIC_RELAXED, __HIP_MEMORY_SCOPE_AGENT) + 255u) >> 8); }
    ts[8] = a;
}
__device__ __forceinline__ void phase_moe_rowmap(const Frame& F) {
    LAS int* tab = (LAS int*)F.lds; LAS int* tot = tab + 256 * 16;
    const unsigned* wgcnt = (const unsigned*)(F.ws + WS_CTL) + CW_WGCNT;
    for (int i = F.tid; i < F.G * 16; i += NTHREADS) tab[i] = (int)__hip_atomic_load(wgcnt + i, __ATOMIC_RELAXED, __HIP_MEMORY_SCOPE_AGENT);
    __syncthreads();
    if (F.tid < 16) { int run = 0;
#pragma unroll 8
        for (int w = 0; w < F.G; ++w) { const int v = tab[w * 16 + F.tid]; tab[w * 16 + F.tid] = run; run += v; }
        tot[F.tid] = run;
        if (F.bid == 0) ((unsigned*)(F.ws + WS_CTL) + CW_MOECNT)[F.tid] = (unsigned)run; }
    __syncthreads();
    int ts0[9], ts1[9];
    { int a = 0, b = 0;
#pragma unroll
      for (int e = 0; e < 8; ++e) { ts0[e] = a; a += (tot[e] + 255) >> 8; ts1[e] = b; b += (tot[8 + e] + 255) >> 8; }
      ts0[8] = a; ts1[8] = b; }
    const int* te = (const int*)(F.ws + WS_ROUTE + RT_TOKE); const int* tp = (const int*)(F.ws + WS_ROUTE + RT_TOKP);
    int* tsl = (int*)(F.ws + WS_ROUTE + RT_RMAP);
    for (int t = F.bid * NTHREADS + F.tid; t < NLAT; t += F.G * NTHREADS) {
        { const int ew = te[t * 2], e = ew & 255; int st = 0;
#pragma unroll
          for (int j = 0; j < 8; ++j) st = (e == j) ? ts0[j] : st;
          tsl[t * 2] = st * 256 + tab[(ew >> 8) * 16 + e] + tp[t * 2]; }
        { const int ew = te[t * 2 + 1], e = ew & 255; int st = 0;
#pragma unroll
          for (int j = 0; j < 8; ++j) st = (e == j) ? ts1[j] : st;
          tsl[t * 2 + 1] = NROW + st * 256 + tab[(ew >> 8) * 16 + 8 + e] + tp[t * 2 + 1]; }
    }
    const unsigned char* HL8 = F.ws + WS_HL; unsigned char* HLG = F.ws + WS_HLG;
#pragma unroll 4
    for (int t = F.gw; t < NLAT; t += F.nw) {
        const int ew0 = te[t * 2], ew1 = te[t * 2 + 1], e0 = ew0 & 255, e1 = ew1 & 255; int s0 = 0, s1 = 0;
#pragma unroll
        for (int j = 0; j < 8; ++j) { s0 = (e0 == j) ? ts0[j] : s0; s1 = (e1 == j) ? ts1[j] : s1; }
        const u32x4 v = *(const u32x4*)(HL8 + (size_t)t * D + F.lane * 16);
        *(u32x4*)(HLG + (size_t)(s0 * 256 + tab[(ew0 >> 8) * 16 + e0] + tp[t * 2]) * D + F.lane * 16) = v;
        *(u32x4*)(HLG + (size_t)(NROW + s1 * 256 + tab[(ew1 >> 8) * 16 + 8 + e1] + tp[t * 2 + 1]) * D + F.lane * 16) = v;
    }
    for (int i = F.gw; i < 2 * 8 * 256; i += F.nw) {
        const int pe = i >> 8, r = i & 255, e = pe & 7; const int c = tot[pe];
        int st = 0;
#pragma unroll
        for (int j = 0; j < 8; ++j) st = (e == j) ? (pe < 8 ? ts0[j] : ts1[j]) : st;
        if ((c & 255) != 0 && r >= (c & 255)) *(u32x4*)(HLG + (size_t)((pe >> 3) * NROW + st * 256 + (c & ~255) + r) * D + F.lane * 16) = (u32x4){0u, 0u, 0u, 0u};
    }
    __syncthreads();
}

struct RowGeo { int b, tt, pos, len; };
__device__ __forceinline__ RowGeo row_geo(int r) { RowGeo g; if (r < NLAT) { g.b = r >> 12; g.pos = r & 4095; g.len = SEQ; g.tt = CTXL + g.pos; } else { const int q = r - NLAT; g.b = q >> 8; g.pos = q & 255; g.len = CTXL; g.tt = g.pos; } return g; }

__device__ __forceinline__ void rw_shift4(const bf16_t* PL, const float* mup, const float* mun, int r, const RowGeo& g, int j, float (&u)[4]) {
    const bf16_t* p = PL + (size_t)r * INW + O_RW + j;
    const bool hp = g.pos > 0, hn = g.pos < g.len - 1;
    float c[4], pv[4], nv[4];
    unpack4(*(const u32x2*)p, c); unpack4(*(const u32x2*)(p - (hp ? INW : 0)), pv); unpack4(*(const u32x2*)(p + (hn ? INW : 0)), nv);
    const f32x4 mp = *(const f32x4*)(mup + j), mn = *(const f32x4*)(mun + j);
#pragma unroll
    for (int q = 0; q < 4; ++q) u[q] = c[q] + mp[q] * ((hp ? pv[q] : 0.f) - c[q]) + mn[q] * ((hn ? nv[q] : 0.f) - c[q]);
}

__device__ __forceinline__ void rw_shift8(const bf16_t* PL, const float* mup, const float* mun, int r, const RowGeo& g, int j, float (&u)[8]) {
    const bf16_t* p = PL + (size_t)r * INW + O_RW + j;
    const bool hp = g.pos > 0, hn = g.pos < g.len - 1;
    float c[8], pv[8], nv[8];
    unpack8(*(const u32x4*)p, c); unpack8(*(const u32x4*)(p - (hp ? INW : 0)), pv); unpack8(*(const u32x4*)(p + (hn ? INW : 0)), nv);
    const f32x4 mp0 = *(const f32x4*)(mup + j), mp1 = *(const f32x4*)(mup + j + 4), mn0 = *(const f32x4*)(mun + j), mn1 = *(const f32x4*)(mun + j + 4);
#pragma unroll
    for (int q = 0; q < 4; ++q) { u[q] = c[q] + mp0[q] * ((hp ? pv[q] : 0.f) - c[q]) + mn0[q] * ((hn ? nv[q] : 0.f) - c[q]);
        u[4 + q] = c[4 + q] + mp1[q] * ((hp ? pv[4 + q] : 0.f) - c[4 + q]) + mn1[q] * ((hn ? nv[4 + q] : 0.f) - c[4 + q]); }
}
__device__ __forceinline__ bf16x8 pack8f(const float (&f)[8]) {
    u32x4 w; w.x = cvt_pk_bf16(f[0], f[1]); w.y = cvt_pk_bf16(f[2], f[3]); w.z = cvt_pk_bf16(f[4], f[5]); w.w = cvt_pk_bf16(f[6], f[7]); return __builtin_bit_cast(bf16x8, w);
}
constexpr int RL_MUP = 0, RL_MUN = 5120, RL_KK = 10240, RL_KA = 11264, RL_W0 = 12288, RL_A0 = 14336, RL_RK = 16384, RL_GNG = 17408, RL_GNB = 18432, RL_END = 19456;
__device__ __forceinline__ void rw_stage_tables(const Frame& F, const Params& P, int l) {
    LAS float* T = (LAS float*)F.lds;
    for (int i = F.tid; i < 1280; i += NTHREADS) { T[RL_MUP / 4 + i] = P.in[I_MUP][l * 1280 + i]; T[RL_MUN / 4 + i] = P.in[I_MUN][l * 1280 + i]; }
    for (int i = F.tid; i < 256; i += NTHREADS) { T[RL_KK / 4 + i] = P.in[I_KK][l * 256 + i]; T[RL_KA / 4 + i] = P.in[I_KA][l * 256 + i]; T[RL_RK / 4 + i] = P.in[I_RK][l * 256 + i];
        T[RL_GNG / 4 + i] = P.in[I_GNG][l * 256 + i]; T[RL_GNB / 4 + i] = P.in[I_GNB][l * 256 + i]; }
    for (int i = F.tid; i < 512; i += NTHREADS) { T[RL_W0 / 4 + i] = P.in[I_W0][l * 512 + i]; T[RL_A0 / 4 + i] = P.in[I_A0][l * 512 + i]; }
    __syncthreads();
}
__device__ __forceinline__ void rw_mix8(const LAS float* T, const u32x4 (&raw)[3], bool hp, bool hn, int j, float (&u)[8]) {
    float c[8], pv[8], nv[8]; unpack8(raw[0], c); unpack8(raw[1], pv); unpack8(raw[2], nv);
    const f32x4 mp0 = *(const LAS f32x4*)(T + RL_MUP / 4 + j), mp1 = *(const LAS f32x4*)(T + RL_MUP / 4 + j + 4), mn0 = *(const LAS f32x4*)(T + RL_MUN / 4 + j), mn1 = *(const LAS f32x4*)(T + RL_MUN / 4 + j + 4);
#pragma unroll
    for (int q = 0; q < 4; ++q) { u[q] = c[q] + mp0[q] * ((hp ? pv[q] : 0.f) - c[q]) + mn0[q] * ((hn ? nv[q] : 0.f) - c[q]);
        u[4 + q] = c[4 + q] + mp1[q] * ((hp ? pv[4 + q] : 0.f) - c[4 + q]) + mn1[q] * ((hn ? nv[4 + q] : 0.f) - c[4 + q]); }
}
__device__ __forceinline__ void rw_mix4(const LAS float* T, const u32x2 (&raw)[3], bool hp, bool hn, int j, float (&u)[4]) {
    float c[4], pv[4], nv[4]; unpack4(raw[0], c); unpack4(raw[1], pv); unpack4(raw[2], nv);
    const f32x4 mp = *(const LAS f32x4*)(T + RL_MUP / 4 + j), mn = *(const LAS f32x4*)(T + RL_MUN / 4 + j);
#pragma unroll
    for (int q = 0; q < 4; ++q) u[q] = c[q] + mp[q] * ((hp ? pv[q] : 0.f) - c[q]) + mn[q] * ((hn ? nv[q] : 0.f) - c[q]);
}
__device__ __forceinline__ void rw_neighbours(const bf16_t* p, int tk, int dpe, int dne, const u32x4& cur, u32x4& prev, u32x4& next) {
    const u32x4 ep = *(const u32x4*)(p - (size_t)tk * INW + dpe), en = *(const u32x4*)(p + (size_t)(15 - tk) * INW + dne);
#pragma unroll
    for (int q = 0; q < 4; ++q) {
        prev[q] = (unsigned)__builtin_amdgcn_update_dpp((int)ep[q], (int)cur[q], 0x111, 0xF, 0xF, false);
        next[q] = (unsigned)__builtin_amdgcn_update_dpp((int)en[q], (int)cur[q], 0x101, 0xF, 0xF, false); }
}
__device__ __forceinline__ void rw_block_flush(const LAS unsigned char* scr, f16_t* block, int lane) {
    __builtin_amdgcn_wave_barrier(); asm volatile("" ::: "memory");
    u32x4 v[6];
#pragma unroll
    for (int i = 0; i < 6; ++i) { const int p = i * 64 + lane, pr = p / 24, pc = p - pr * 24; v[i] = *(const LAS u32x4*)(scr + pr * 400 + pc * 16); }
#pragma unroll
    for (int i = 0; i < 6; ++i) *(u32x4*)((unsigned char*)block + (size_t)(i * 64 + lane) * 16) = v[i];
    __builtin_amdgcn_wave_barrier(); asm volatile("" ::: "memory");
}
__device__ __forceinline__ int rw_item(const Frame& F, int k, int nitems) {
    if (F.nw == NLAT / 16) { if (k == 0) return F.gw; const int j = (k - 1) * 2 * F.G + F.bid * 2 + F.wave; return (F.wave < 2 && NLAT / 16 + j < nitems) ? NLAT / 16 + j : -1; }
    const int item = F.gw + k * F.nw; return item < nitems ? item : -1;
}
__device__ __forceinline__ void phase_rw_prep(const Frame& F, const Params& P, int l) {
    const bf16_t* PL = (const bf16_t*)(F.ws + WS_PL);
    f16_t* SH = (f16_t*)(F.ws + WS_SH); f16_t* SD = (f16_t*)(F.ws + WS_SD);
    const int lane = F.lane;
    rw_stage_tables(F, P, l);
    const LAS float* T = (const LAS float*)F.lds;
    LAS unsigned char* scr = F.lds + RL_END + F.wave * 6400;
    for (int kit = 0, item; (item = rw_item(F, kit, NLAT / 16 + (NCTX / 16) * 4)) >= 0; ++kit) {
        const int tile = item < NLAT / 16 ? item : NLAT / 16 + ((item - NLAT / 16) >> 2), h0 = item < NLAT / 16 ? 0 : ((item - NLAT / 16) & 3), h1 = item < NLAT / 16 ? 4 : h0 + 1;
        int l1 = lane; asm volatile("" : "+v"(l1)); const int tk = l1 & 15, g = l1 >> 4;
        const int r = tile * 16 + tk; const RowGeo geo = row_geo(r);
        const bool hp = geo.pos > 0, hn = geo.pos < geo.len - 1;
        const bf16_t* prow = PL + (size_t)r * INW + O_RW; const int dprev = hp ? -INW : 0, dnext = hn ? INW : 0; (void)dprev; (void)dnext;
        const RowGeo ge0 = row_geo(tile * 16), ge15 = row_geo(tile * 16 + 15); const int dpe = ge0.pos > 0 ? -INW : 0, dne = ge15.pos < ge15.len - 1 ? INW : 0;
        bf16x8 tw[2][2], ta[2][2];
#pragma unroll
        for (int d = 0; d < 2; ++d) { u32x4 raw[4][3];
#pragma unroll
          for (int i = 0; i < 4; ++i) { const bf16_t* p = prow + 768 + 256 * d + 64 * (i & 1) + 32 * (i >> 1) + 8 * g;
              raw[i][0] = *(const u32x4*)p; rw_neighbours(p, tk, dpe, dne, raw[i][0], raw[i][1], raw[i][2]); }
#pragma unroll
          for (int i = 0; i < 4; ++i) { float u[8]; rw_mix8(T, raw[i], hp, hn, 768 + 256 * d + 64 * (i & 1) + 32 * (i >> 1) + 8 * g, u);
              if ((i & 1) == 0) {
#pragma unroll
                  for (int q = 0; q < 8; ++q) u[q] = 1.0f - 2.0f * __builtin_amdgcn_rcpf(1.0f + __expf(2.0f * u[q]));
                  tw[d][i >> 1] = pack8f(u); }
              else ta[d][i >> 1] = pack8f(u); }
          asm volatile("" ::: "memory"); }
        asm volatile("" ::: "memory");
#pragma unroll 1
        for (int h = h0; h < h1; ++h) {
            int l2 = lane; asm volatile("" : "+v"(l2)); const int tk = l2 & 15, g = l2 >> 4;
            const int r = tile * 16 + tk; const RowGeo geo = row_geo(r);
            const bool hp = geo.pos > 0, hn = geo.pos < geo.len - 1;
            const bf16_t* prow = PL + (size_t)r * INW + O_RW + 64 * h + 8 * g; const int dprev = hp ? -INW : 0, dnext = hn ? INW : 0; (void)dprev; (void)dnext;
        const RowGeo ge0 = row_geo(tile * 16), ge15 = row_geo(tile * 16 + 15); const int dpe = ge0.pos > 0 ? -INW : 0, dne = ge15.pos < ge15.len - 1 ? INW : 0;
            float ur[4][4], uk[4][4], uv[4][4], kkv[4][4]; float ss = 0.f;
            { u32x4 raw[6][3];
#pragma unroll
              for (int i = 0; i < 6; ++i) { const bf16_t* p = prow + 256 * (i >> 1) + 32 * (i & 1);
                  raw[i][0] = *(const u32x4*)p; raw[i][1] = *(const u32x4*)(p + dprev); raw[i][2] = *(const u32x4*)(p + dnext); }
#pragma unroll
              for (int u = 0; u < 2; ++u) { float x8[8]; const int c = 64 * h + 32 * u + 8 * g;
                  rw_mix8(T, raw[u], hp, hn, c, x8);
#pragma unroll
                  for (int e = 0; e < 8; ++e) ur[2 * u + (e >> 2)][e & 3] = x8[e];
                  rw_mix8(T, raw[2 + u], hp, hn, 256 + c, x8);
#pragma unroll
                  for (int e = 0; e < 8; ++e) uk[2 * u + (e >> 2)][e & 3] = x8[e];
                  rw_mix8(T, raw[4 + u], hp, hn, 512 + c, x8);
#pragma unroll
                  for (int e = 0; e < 8; ++e) uv[2 * u + (e >> 2)][e & 3] = x8[e];
                  const f32x4 k0 = *(const LAS f32x4*)(T + RL_KK / 4 + c), k1 = *(const LAS f32x4*)(T + RL_KK / 4 + c + 4);
#pragma unroll
                  for (int q = 0; q < 4; ++q) { kkv[2 * u][q] = uk[2 * u][q] * k0[q]; kkv[2 * u + 1][q] = uk[2 * u + 1][q] * k1[q]; ss += kkv[2 * u][q] * kkv[2 * u][q] + kkv[2 * u + 1][q] * kkv[2 * u + 1][q]; } } }
            ss += __shfl_xor(ss, 16); ss += __shfl_xor(ss, 32);
            const float rn = rsqrtf(ss + 1e-12f);
            const size_t shrow = ((size_t)(geo.b * 4 + h) * TT + geo.tt) * 192;
#pragma unroll
            for (int u = 0; u < 2; ++u) { f16x8 o1, o2, o3;
#pragma unroll
                for (int e = 0; e < 8; ++e) { const int t = 2 * u + (e >> 2), q = e & 3; kkv[t][q] *= rn; o1[e] = (f16_t)ur[t][q]; o2[e] = (f16_t)uv[t][q]; o3[e] = (f16_t)(-kkv[t][q]); }
                LAS unsigned char* sl = scr + tk * 400 + 64 * u + 16 * g; *(LAS f16x8*)sl = o1; *(LAS f16x8*)(sl + 128) = o2; *(LAS f16x8*)(sl + 256) = o3; }
            rw_block_flush(scr, SH + ((size_t)(geo.b * 4 + h) * TT + (geo.tt - tk)) * 192, l2);
#pragma unroll 1
            for (int d = 0; d < 2; ++d) {
                const bf16_t* w2t = (const bf16_t*)(F.ws + WS_LORA + (size_t)(l * 2 + d) * LORA_LD_BYTES); const bf16_t* a2t = w2t + 256 * 64;
                const size_t sdrow = ((size_t)((d * 8 + geo.b) * 4 + h) * TT + geo.tt) * 192;
                const bf16x8 tw0 = d ? tw[1][0] : tw[0][0], tw1 = d ? tw[1][1] : tw[0][1], ta0 = d ? ta[1][0] : ta[0][0], ta1 = d ? ta[1][1] : ta[0][1];
                bf16x8 wf[4][2], af[4][2];
#pragma unroll
                for (int t = 0; t < 4; ++t) { const size_t fo = (size_t)((h * 4 + t) * 2 * 64 + l2) * 8;
                    wf[t][0] = *(const bf16x8*)(w2t + fo); wf[t][1] = *(const bf16x8*)(w2t + fo + 512); af[t][0] = *(const bf16x8*)(a2t + fo); af[t][1] = *(const bf16x8*)(a2t + fo + 512); }
                f16x8 o1[2], o2[2], o3[2];
#pragma unroll
                for (int t = 0; t < 4; ++t) { const int c = 64 * h + 32 * (t >> 1) + 8 * g + 4 * (t & 1);
                    f32x4 xw = *(const LAS f32x4*)(T + RL_W0 / 4 + d * 256 + c), xa = *(const LAS f32x4*)(T + RL_A0 / 4 + d * 256 + c);
                    xw = __builtin_amdgcn_mfma_f32_16x16x32_bf16(wf[t][0], tw0, xw, 0, 0, 0); xw = __builtin_amdgcn_mfma_f32_16x16x32_bf16(wf[t][1], tw1, xw, 0, 0, 0);
                    xa = __builtin_amdgcn_mfma_f32_16x16x32_bf16(af[t][0], ta0, xa, 0, 0, 0); xa = __builtin_amdgcn_mfma_f32_16x16x32_bf16(af[t][1], ta1, xa, 0, 0, 0);
                    const f32x4 kaw = *(const LAS f32x4*)(T + RL_KA / 4 + c);
#pragma unroll
                    for (int q = 0; q < 4; ++q) {
                        const float nx = -xw[q]; const float sp = fmaxf(nx, 0.f) + __logf(1.0f + __expf(-fabsf(nx)));
                        const float e = __expf(-sp - 0.5f);
                        const float omw = 1.0f - __expf(-e);
                        const float a = sigmoidf_(xa[q]);
                        o1[t >> 1][(t & 1) * 4 + q] = (f16_t)omw; o2[t >> 1][(t & 1) * 4 + q] = (f16_t)(uk[t][q] * (1.0f + (a - 1.0f) * kaw[q])); o3[t >> 1][(t & 1) * 4 + q] = (f16_t)(kkv[t][q] * a); } }
#pragma unroll
                for (int u = 0; u < 2; ++u) { LAS unsigned char* sl = scr + tk * 400 + 64 * u + 16 * g; *(LAS f16x8*)sl = o1[u]; *(LAS f16x8*)(sl + 128) = o2[u]; *(LAS f16x8*)(sl + 256) = o3[u]; }
                rw_block_flush(scr, SD + (sdrow - (size_t)tk * 192), l2);
                asm volatile("" ::: "memory");
            }
        }
    }
    __syncthreads();
}

constexpr int CS_ZP = 0, CS_RPP = 2048, CS_BH = 4096, CS_KH = 6144, CS_VV = 8192, CS_MT = 10240, CS_NT = 11264, CS_WC = 12288, CS_SLOT = 12544;
constexpr int CS_ZIMG = 8 * CS_SLOT;
constexpr int CS_NCHUNK = TT / 16;
__device__ __forceinline__ int cs_tt(int d, int q, int s) { const int st = 16 * q + s; return d == 0 ? st : (st < CTXL ? CTXL - 1 - st : TT + CTXL - 1 - st); }
__device__ __forceinline__ float dpp_shr(float old, float v, int) { return v; }
template <int N> __device__ __forceinline__ float row_shr(float v, float old) {
    return __builtin_bit_cast(float, __builtin_amdgcn_update_dpp(__builtin_bit_cast(int, old), __builtin_bit_cast(int, v), 0x110 + N, 0xF, 0xF, false));
}
__device__ __forceinline__ bf16x8 cs_pack(const float (&a)[4], const float (&b)[4]) {
    u32x4 w; w.x = cvt_pk_bf16(a[0], a[1]); w.y = cvt_pk_bf16(a[2], a[3]); w.z = cvt_pk_bf16(b[0], b[1]); w.w = cvt_pk_bf16(b[2], b[3]); return __builtin_bit_cast(bf16x8, w);
}
__device__ __forceinline__ bf16x8 cs_op16(const f32x4& x) { u32x4 w; w.x = cvt_pk_bf16(x[0], x[1]); w.y = cvt_pk_bf16(x[2], x[3]); w.z = 0u; w.w = 0u; return __builtin_bit_cast(bf16x8, w); }
#define CS_MFMA(a, b, c) __builtin_amdgcn_mfma_f32_16x16x32_bf16((a), (b), (c), 0, 0, 0)
__device__ __forceinline__ f32x4 cs_mm16(const f32x4& xt_d, const f32x4& y_d) { return CS_MFMA(cs_op16(xt_d), cs_op16(y_d), ((f32x4){0.f, 0.f, 0.f, 0.f})); }
__device__ __forceinline__ v4i16_t cs_tr(const LAS unsigned char* img, int lane, int T) {
    const int g = lane >> 4, q = (lane & 15) >> 2, p = lane & 3;
    return __builtin_amdgcn_ds_read_tr16_b64_v4i16((LAS v4i16_t*)(img + (4 * g + q) * 128 + p * 32 + (T >> 1) * 16 + (T & 1) * 8));
}
__device__ __forceinline__ bf16x8 cs_lo(v4i16_t x) { bf16x8 r; r[0] = x[0]; r[1] = x[1]; r[2] = x[2]; r[3] = x[3]; r[4] = 0; r[5] = 0; r[6] = 0; r[7] = 0; return r; }

struct CsRaw { u32x2 x[4], z[4], r[4], b[4], k[4], v[4]; };
struct CsIn { u32x4 a[6], b[6]; };
__device__ __forceinline__ void cs_load(CsIn& R, const f16_t* sh, const f16_t* sd, int d, int q, int lane) {
    const int t0 = d == 0 ? cs_tt(0, q, 0) : cs_tt(1, q, 15);
    const unsigned char* shp = (const unsigned char*)(sh + (size_t)t0 * 192) + lane * 16; const unsigned char* sdp = (const unsigned char*)(sd + (size_t)t0 * 192) + lane * 16;
#pragma unroll
    for (int i = 0; i < 6; ++i) { R.a[i] = *(const u32x4*)(shp + i * 1024); R.b[i] = *(const u32x4*)(sdp + i * 1024); }
}
__device__ __forceinline__ void cs_redeal(CsRaw& R, const CsIn& in, LAS unsigned char* scr, int d, int lane) {
    const int s = lane & 15, g = lane >> 4, row = d == 0 ? s : 15 - s;
    const LAS unsigned char* rp = scr + row * 400 + 8 * g;
#pragma unroll
    for (int i = 0; i < 6; ++i) { const int p = i * 64 + lane, pr = p / 24, pc = p - pr * 24; *(LAS u32x4*)(scr + pr * 400 + pc * 16) = in.a[i]; }
    __builtin_amdgcn_wave_barrier(); asm volatile("" ::: "memory");
#pragma unroll
    for (int T = 0; T < 4; ++T) { R.r[T] = *(const LAS u32x2*)(rp + 32 * T); R.v[T] = *(const LAS u32x2*)(rp + 128 + 32 * T); R.z[T] = *(const LAS u32x2*)(rp + 256 + 32 * T); }
    __builtin_amdgcn_wave_barrier(); asm volatile("" ::: "memory");
#pragma unroll
    for (int i = 0; i < 6; ++i) { const int p = i * 64 + lane, pr = p / 24, pc = p - pr * 24; *(LAS u32x4*)(scr + pr * 400 + pc * 16) = in.b[i]; }
    __builtin_amdgcn_wave_barrier(); asm volatile("" ::: "memory");
#pragma unroll
    for (int T = 0; T < 4; ++T) { R.x[T] = *(const LAS u32x2*)(rp + 32 * T); R.k[T] = *(const LAS u32x2*)(rp + 128 + 32 * T); R.b[T] = *(const LAS u32x2*)(rp + 256 + 32 * T); }
    asm volatile("s_waitcnt lgkmcnt(0)" ::: "memory"); __builtin_amdgcn_wave_barrier();
}
__device__ __forceinline__ void cs_prepass(LAS unsigned char* slot, LAS unsigned char* zimg, CsIn& in, const f16_t* sh, const f16_t* sd, int d, int qn, int lane) {
    const int s = lane & 15, g = lane >> 4;
    CsRaw raw; cs_redeal(raw, in, slot, d, lane);
    float Wc[4][4], Wp[4][4], iW[4][4];
#pragma unroll
    for (int T = 0; T < 4; ++T) { const f16x4 x4 = __builtin_bit_cast(f16x4, raw.x[T]);
#pragma unroll
        for (int j = 0; j < 4; ++j) { float wc = 1.0f - (float)x4[j];
            wc *= row_shr<1>(wc, 1.0f); wc *= row_shr<2>(wc, 1.0f); wc *= row_shr<4>(wc, 1.0f); wc *= row_shr<8>(wc, 1.0f);
            Wc[T][j] = wc; Wp[T][j] = row_shr<1>(wc, 1.0f); iW[T][j] = __builtin_amdgcn_rcpf(wc); } }
    if (s == 15) {
#pragma unroll
        for (int T = 0; T < 4; ++T) *(LAS f32x4*)(slot + CS_WC + (16 * T + 4 * g) * 4) = (f32x4){Wc[T][0], Wc[T][1], Wc[T][2], Wc[T][3]}; }
    bf16x8 oZ[2], oR[2], oB[2], oK[2];
    const int ioff = s * 128 + g * 32;
#define CS_STAGE(dst, SRC, SC, IMG) do { float t_[4][4]; \
        _Pragma("unroll") for (int T = 0; T < 4; ++T) { const f16x4 q4 = __builtin_bit_cast(f16x4, SRC[T]); \
            _Pragma("unroll") for (int j = 0; j < 4; ++j) t_[T][j] = (float)q4[j] * SC; } \
        _Pragma("unroll") for (int kk = 0; kk < 2; ++kk) { dst[kk] = cs_pack(t_[2 * kk], t_[2 * kk + 1]); if (IMG) *(LAS bf16x8*)((IMG) + ioff + kk * 16) = dst[kk]; } \
        } while (0)
    CS_STAGE(oZ, raw.z, Wp[T][j], zimg);
    CS_STAGE(oR, raw.r, Wc[T][j], (LAS unsigned char*)nullptr);
    CS_STAGE(oB, raw.b, iW[T][j], slot + CS_BH);
    CS_STAGE(oK, raw.k, iW[T][j], slot + CS_KH);
    { bf16x8 oV[2]; CS_STAGE(oV, raw.v, 1.0f, slot + CS_VV); }
#undef CS_STAGE
    asm volatile("" ::: "memory");
    if (qn >= 0) cs_load(in, sh, sd, d, qn, lane);
    const f32x4 zero4 = (f32x4){0.f, 0.f, 0.f, 0.f};
    f32x4 A_D = CS_MFMA(oB[1], oZ[1], CS_MFMA(oB[0], oZ[0], zero4)), AT_D = CS_MFMA(oZ[1], oB[1], CS_MFMA(oZ[0], oB[0], zero4));
    f32x4 BkT_D = CS_MFMA(oZ[1], oK[1], CS_MFMA(oZ[0], oK[0], zero4));
    f32x4 Ar_D = CS_MFMA(oB[1], oR[1], CS_MFMA(oB[0], oR[0], zero4)), Kr_D = CS_MFMA(oK[1], oR[1], CS_MFMA(oK[0], oR[0], zero4));
    f32x4 I_D;
#pragma unroll
    for (int j = 0; j < 4; ++j) { const int m = 4 * g + j;
        A_D[j] = m < s ? A_D[j] : 0.f; AT_D[j] = s < m ? AT_D[j] : 0.f; BkT_D[j] = s < m ? BkT_D[j] : 0.f;
        Ar_D[j] = m <= s ? Ar_D[j] : 0.f; Kr_D[j] = m <= s ? Kr_D[j] : 0.f; I_D[j] = m == s ? 1.f : 0.f; }
    f32x4 Ab, AbT, A1, A2m;
#pragma unroll
    for (int j = 0; j < 4; ++j) { const int m = 4 * g + j; const bool b0 = (m >> 2) == (s >> 2), b1 = (m >> 3) == (s >> 3);
        Ab[j] = b0 ? A_D[j] : 0.f; AbT[j] = b0 ? AT_D[j] : 0.f; A1[j] = (b1 && !b0) ? A_D[j] : 0.f; A2m[j] = b1 ? 0.f : A_D[j]; }
    const f32x4 Ab2 = cs_mm16(AbT, Ab), Ab2T = cs_mm16(Ab, AbT);
    const f32x4 P0 = I_D + Ab, P0T = I_D + AbT;
    const f32x4 T0 = P0 + cs_mm16(P0T, Ab2), T0T = P0T + cs_mm16(Ab2, P0T);
    (void)Ab2T;
    const f32x4 ZT = cs_mm16(A1, T0T);
    const f32x4 T1 = T0 + cs_mm16(ZT, T0), T1T = T0T + cs_mm16(T0, ZT);
    const f32x4 Z2T = cs_mm16(A2m, T1T);
    const f32x4 T_D = T1 + cs_mm16(Z2T, T1);
    const f32x4 M_D = cs_mm16(BkT_D, T_D), MT_D = cs_mm16(T_D, BkT_D);
    const f32x4 N_D = cs_mm16(MT_D, Ar_D) + Kr_D;
    { u32x4 w; w.x = cvt_pk_bf16(M_D[0], M_D[1]); w.y = cvt_pk_bf16(M_D[2], M_D[3]); w.z = 0u; w.w = 0u; *(LAS u32x4*)(slot + CS_MT + s * 64 + g * 16) = w;
      w.x = cvt_pk_bf16(N_D[0], N_D[1]); w.y = cvt_pk_bf16(N_D[2], N_D[3]); *(LAS u32x4*)(slot + CS_NT + s * 64 + g * 16) = w; }
    __builtin_amdgcn_wave_barrier(); asm volatile("" ::: "memory");
    const bf16x8 oT = cs_op16(T_D), oAr = cs_op16(Ar_D);
    float Zp[4][4];
#pragma unroll
    for (int T = 0; T < 4; ++T) { const f32x4 zp = CS_MFMA(cs_lo(cs_tr(zimg, lane, T)), oT, zero4);
#pragma unroll
        for (int j = 0; j < 4; ++j) Zp[T][j] = zp[j]; }
#pragma unroll
    for (int kk = 0; kk < 2; ++kk) *(LAS bf16x8*)(slot + CS_ZP + s * 128 + g * 32 + kk * 16) = cs_pack(Zp[2 * kk], Zp[2 * kk + 1]);
    __builtin_amdgcn_wave_barrier(); asm volatile("" ::: "memory");
    float Rp[4][4];
#pragma unroll
    for (int T = 0; T < 4; ++T) { const f32x4 rp = CS_MFMA(cs_lo(cs_tr(slot + CS_ZP, lane, T)), oAr, zero4);
#pragma unroll
        for (int j = 0; j < 4; ++j) Rp[T][j] = rp[j] + bf2f((bf16_t)oR[T >> 1][(T & 1) * 4 + j]); }
#pragma unroll
    for (int kk = 0; kk < 2; ++kk) *(LAS bf16x8*)(slot + CS_RPP + s * 128 + g * 32 + kk * 16) = cs_pack(Rp[2 * kk], Rp[2 * kk + 1]);
}
__device__ __forceinline__ void cs_scan_chunk(const LAS unsigned char* slot, f32x4 (&acc)[4], float* yp  , int d, int q, int wave, int lane) {
    const int s = lane & 15, g = lane >> 4;
    const f32x4 zero4 = (f32x4){0.f, 0.f, 0.f, 0.f};
    bf16x8 Xb[2];
#pragma unroll
    for (int kk = 0; kk < 2; ++kk) { u32x4 w; w.x = cvt_pk_bf16(acc[2 * kk][0], acc[2 * kk][1]); w.y = cvt_pk_bf16(acc[2 * kk][2], acc[2 * kk][3]);
        w.z = cvt_pk_bf16(acc[2 * kk + 1][0], acc[2 * kk + 1][1]); w.w = cvt_pk_bf16(acc[2 * kk + 1][2], acc[2 * kk + 1][3]); Xb[kk] = __builtin_bit_cast(bf16x8, w); }
    const v4i16_t vt = cs_tr(slot + CS_VV, lane, wave);
    const bf16x8 Vb = cs_lo(vt);
    const int arow = s * 128 + g * 32, a16 = s * 64 + g * 16;
    f32x4 UT = CS_MFMA(*(const LAS bf16x8*)(slot + CS_MT + a16), Vb, zero4);
    UT = CS_MFMA(*(const LAS bf16x8*)(slot + CS_ZP + arow), Xb[0], UT); UT = CS_MFMA(*(const LAS bf16x8*)(slot + CS_ZP + arow + 16), Xb[1], UT);
    f32x4 YT = CS_MFMA(*(const LAS bf16x8*)(slot + CS_NT + a16), Vb, zero4); YT = CS_MFMA(*(const LAS bf16x8*)(slot + CS_RPP + arow), Xb[0], YT); YT = CS_MFMA(*(const LAS bf16x8*)(slot + CS_RPP + arow + 16), Xb[1], YT);
#pragma unroll
    for (int j = 0; j < 4; ++j) yp[(size_t)cs_tt(d, q, 4 * g + j) * 256] = YT[j];
    bf16x8 UV; { u32x2 w; w.x = cvt_pk_bf16(UT[0], UT[1]); w.y = cvt_pk_bf16(UT[2], UT[3]); const v4i16_t ub = __builtin_bit_cast(v4i16_t, w);
        UV[0] = ub[0]; UV[1] = ub[1]; UV[2] = ub[2]; UV[3] = ub[3]; UV[4] = vt[0]; UV[5] = vt[1]; UV[6] = vt[2]; UV[7] = vt[3]; }
#pragma unroll
    for (int T = 0; T < 4; ++T) { const v4i16_t bh = cs_tr(slot + CS_BH, lane, T), kh = cs_tr(slot + CS_KH, lane, T);
        bf16x8 BK; BK[0] = bh[0]; BK[1] = bh[1]; BK[2] = bh[2]; BK[3] = bh[3]; BK[4] = kh[0]; BK[5] = kh[1]; BK[6] = kh[2]; BK[7] = kh[3];
        acc[T] = CS_MFMA(BK, UV, acc[T]);
        acc[T] *= *(const LAS f32x4*)(slot + CS_WC + (16 * T + 4 * g) * 4); }
}
__device__ __forceinline__ void phase_scan(const Frame& F) {
    const f16_t* SH = (const f16_t*)(F.ws + WS_SH); const f16_t* SD = (const f16_t*)(F.ws + WS_SD);
    float* Y = (float*)(F.ws + WS_Y);
    const int lane = F.lane, wave = F.wave;
    for (int chain = F.bid; chain < 64; chain += F.G) {
        const int d = chain >> 5, b = (chain >> 2) & 7, h = chain & 3;
        const f16_t* sh = SH + (size_t)(b * 4 + h) * TT * 192; const f16_t* sd = SD + (size_t)((d * 8 + b) * 4 + h) * TT * 192;
        float* yp = Y + ((size_t)(d * 8 + b) * TT) * 256 + h * 64 + 16 * (wave & 3) + (lane & 15);
        f32x4 acc[4];
#pragma unroll
        for (int T = 0; T < 4; ++T) acc[T] = (f32x4){0.f, 0.f, 0.f, 0.f};
        const int cw = (wave + 4) & 7;
        LAS unsigned* sync4 = (LAS unsigned*)(F.lds + CS_ZIMG + 8 * 2048);
        if (F.tid == 0) *sync4 = 0u;
        __syncthreads();
        CsIn raw;
        constexpr int NR = CS_NCHUNK / 8;
        cs_load(raw, sh, sd, d, cw, lane);
        cs_prepass(F.lds + cw * CS_SLOT, F.lds + CS_ZIMG + wave * 2048, raw, sh, sd, d, (1 < NR) ? 8 + cw : -1, lane);
        asm volatile("s_waitcnt lgkmcnt(0)" ::: "memory"); __builtin_amdgcn_s_barrier(); asm volatile("" ::: "memory");
        for (int R = 0; R < NR; ++R) {
            if (wave < 4) {
#pragma unroll 1
                for (int c8 = 0; c8 < 4; ++c8) cs_scan_chunk(F.lds + c8 * CS_SLOT, acc, yp, d, 8 * R + c8, wave, lane);
            }
            asm volatile("s_waitcnt lgkmcnt(0)" ::: "memory"); __builtin_amdgcn_s_barrier(); asm volatile("" ::: "memory");
            if (wave < 4) {
#pragma unroll 1
                for (int c8 = 4; c8 < 8; ++c8) cs_scan_chunk(F.lds + c8 * CS_SLOT, acc, yp, d, 8 * R + c8, wave, lane);
                asm volatile("s_waitcnt lgkmcnt(0)" ::: "memory");
                if (lane == 0) __hip_atomic_fetch_add(sync4, 1u, __ATOMIC_RELAXED, __HIP_MEMORY_SCOPE_WORKGROUP);
                while (__hip_atomic_load(sync4, __ATOMIC_RELAXED, __HIP_MEMORY_SCOPE_WORKGROUP) < 4u * (unsigned)(R + 1)) __builtin_amdgcn_s_sleep(1);
                asm volatile("" ::: "memory");
            }
            if (R + 1 < NR) cs_prepass(F.lds + cw * CS_SLOT, F.lds + CS_ZIMG + wave * 2048, raw, sh, sd, d, (R + 2 < NR) ? 8 * (R + 2) + cw : -1, lane);
            asm volatile("s_waitcnt lgkmcnt(0)" ::: "memory"); __builtin_amdgcn_s_barrier(); asm volatile("" ::: "memory");
        }
    }
}

__device__ __forceinline__ void phase_rw_post(const Frame& F, const Params& P, int l, int nrows) {
    const bf16_t* PL = (const bf16_t*)(F.ws + WS_PL); bf16_t* MIX = (bf16_t*)(F.ws + WS_MIX);
    const f16_t* SH = (const f16_t*)(F.ws + WS_SH); const f16_t* SD = (const f16_t*)(F.ws + WS_SD); const float* Y = (const float*)(F.ws + WS_Y);
    const int lane = F.lane;
    rw_stage_tables(F, P, l);
    const LAS float* T = (const LAS float*)F.lds;
    for (int kit = 0, item; (item = rw_item(F, kit, NLAT / 16 + ((nrows - NLAT) / 16) * 4)) >= 0; ++kit) {
        const int tile = item < NLAT / 16 ? item : NLAT / 16 + ((item - NLAT / 16) >> 2), h0 = item < NLAT / 16 ? 0 : ((item - NLAT / 16) & 3), h1 = item < NLAT / 16 ? 4 : h0 + 1;
        int l1 = lane; asm volatile("" : "+v"(l1)); const int tk = l1 & 15, g = l1 >> 4;
        const int r = tile * 16 + tk; const RowGeo geo = row_geo(r);
        const bool hp = geo.pos > 0, hn = geo.pos < geo.len - 1;
        const bf16_t* prow = PL + (size_t)r * INW + O_RW; const int dprev = hp ? -INW : 0, dnext = hn ? INW : 0; (void)dprev; (void)dnext;
        const RowGeo ge0 = row_geo(tile * 16), ge15 = row_geo(tile * 16 + 15); const int dpe = ge0.pos > 0 ? -INW : 0, dne = ge15.pos < ge15.len - 1 ? INW : 0;
        bf16x8 sg[2][4];
#pragma unroll
        for (int d = 0; d < 2; ++d) { u32x4 raw[4][3];
#pragma unroll
            for (int kk = 0; kk < 4; ++kk) { const bf16_t* p = prow + 896 + 256 * d + 32 * kk + 8 * g;
                raw[kk][0] = *(const u32x4*)p; rw_neighbours(p, tk, dpe, dne, raw[kk][0], raw[kk][1], raw[kk][2]); }
#pragma unroll
            for (int kk = 0; kk < 4; ++kk) { float u[8]; rw_mix8(T, raw[kk], hp, hn, 896 + 256 * d + 32 * kk + 8 * g, u);
#pragma unroll
                for (int q = 0; q < 8; ++q) u[q] = sigmoidf_(u[q]);
                sg[d][kk] = pack8f(u); }
            asm volatile("" ::: "memory"); }
#pragma unroll 1
        for (int h = h0; h < h1; ++h) {
            int l2 = lane; asm volatile("" : "+v"(l2)); const int tk = l2 & 15, g = l2 >> 4;
            const int r = tile * 16 + tk; const RowGeo geo = row_geo(r);
            const size_t shrow = ((size_t)(geo.b * 4 + h) * TT + geo.tt) * 192;
            float out[4][4];
#pragma unroll
            for (int t = 0; t < 4; ++t)
#pragma unroll
                for (int q = 0; q < 4; ++q) out[t][q] = 0.f;
            f16x8 rh[2], vh[2];
#pragma unroll
            for (int u = 0; u < 2; ++u) { rh[u] = *(const f16x8*)(SH + shrow + 32 * u + 8 * g); vh[u] = *(const f16x8*)(SH + shrow + 64 + 32 * u + 8 * g); }
#pragma unroll 1
            for (int d = 0; d < 2; ++d) {
                const bf16_t* g2t = (const bf16_t*)(F.ws + WS_LORA + (size_t)(l * 2 + d) * LORA_LD_BYTES) + 2 * 256 * 64;
                const size_t sdrow = ((size_t)((d * 8 + geo.b) * 4 + h) * TT + geo.tt) * 192;
                const float* yrow = Y + ((size_t)(d * 8 + geo.b) * TT + geo.tt) * 256 + 64 * h + 8 * g;
                bf16x8 sgd[4];
#pragma unroll
                for (int kk = 0; kk < 4; ++kk) sgd[kk] = d ? sg[1][kk] : sg[0][kk];
                f32x4 y[4], gg[4]; f16x8 kdh[2]; bf16x8 gf[4][4];
#pragma unroll
                for (int u = 0; u < 2; ++u) { y[2 * u] = *(const f32x4*)(yrow + 32 * u); y[2 * u + 1] = *(const f32x4*)(yrow + 32 * u + 4); kdh[u] = *(const f16x8*)(SD + sdrow + 64 + 32 * u + 8 * g); }
#pragma unroll
                for (int t = 0; t < 4; ++t) { const bf16_t* gr = g2t + (size_t)((h * 4 + t) * 4 * 64 + l2) * 8;
#pragma unroll
                    for (int kk = 0; kk < 4; ++kk) gf[t][kk] = *(const bf16x8*)(gr + 512 * kk); }
                float sm = 0.f, bs = 0.f;
#pragma unroll
                for (int t = 0; t < 4; ++t) { const int c = 64 * h + 32 * (t >> 1) + 8 * g + 4 * (t & 1);
                    sm += (y[t][0] + y[t][1]) + (y[t][2] + y[t][3]);
                    const f32x4 rk = *(const LAS f32x4*)(T + RL_RK / 4 + c);
#pragma unroll
                    for (int q = 0; q < 4; ++q) bs += (float)rh[t >> 1][(t & 1) * 4 + q] * (float)kdh[t >> 1][(t & 1) * 4 + q] * rk[q];
                    f32x4 a = (f32x4){0.f, 0.f, 0.f, 0.f};
#pragma unroll
                    for (int kk = 0; kk < 4; ++kk) a = __builtin_amdgcn_mfma_f32_16x16x32_bf16(gf[t][kk], sgd[kk], a, 0, 0, 0);
                    gg[t] = a; }
                sm += __shfl_xor(sm, 16); sm += __shfl_xor(sm, 32); bs += __shfl_xor(bs, 16); bs += __shfl_xor(bs, 32);
                const float mu = sm * (1.0f / 64.0f); float vs = 0.f;
#pragma unroll
                for (int t = 0; t < 4; ++t)
#pragma unroll
                    for (int q = 0; q < 4; ++q) { const float dd = y[t][q] - mu; vs += dd * dd; }
                vs += __shfl_xor(vs, 16); vs += __shfl_xor(vs, 32);
                const float rstd = rsqrtf(vs * (1.0f / 64.0f) + 64e-5f);
#pragma unroll
                for (int t = 0; t < 4; ++t) { const int c = 64 * h + 32 * (t >> 1) + 8 * g + 4 * (t & 1);
                    const f32x4 gng = *(const LAS f32x4*)(T + RL_GNG / 4 + c), gnb = *(const LAS f32x4*)(T + RL_GNB / 4 + c);
#pragma unroll
                    for (int q = 0; q < 4; ++q) out[t][q] += ((y[t][q] - mu) * rstd * gng[q] + gnb[q] + bs * (float)vh[t >> 1][(t & 1) * 4 + q]) * gg[t][q]; }
                asm volatile("" ::: "memory");
            }
#pragma unroll
            for (int u = 0; u < 2; ++u) { u32x4 w; w.x = cvt_pk_bf16(out[2 * u][0], out[2 * u][1]); w.y = cvt_pk_bf16(out[2 * u][2], out[2 * u][3]); w.z = cvt_pk_bf16(out[2 * u + 1][0], out[2 * u + 1][1]); w.w = cvt_pk_bf16(out[2 * u + 1][2], out[2 * u + 1][3]);
                *(u32x4*)(MIX + (size_t)r * D + 512 + 64 * h + 32 * u + 8 * g) = w; }
        }
    }
    __syncthreads();
}

constexpr int CV_SEG = 64, CV_ROWS = CV_SEG + 30, CV_H = 0, CV_W = CV_ROWS * 256 * 4;
__device__ __forceinline__ void phase_conv(const Frame& F, const Params& P, int l, int nrows) {
    const bf16_t* PL = (const bf16_t*)(F.ws + WS_PL); bf16_t* MIX = (bf16_t*)(F.ws + WS_MIX);
    const int lane = F.lane, c4 = lane * 4, wave = F.wave;
    LAS float* H = (LAS float*)(F.lds + CV_H); LAS float* W = (LAS float*)(F.lds + CV_W);
    for (int i = F.tid; i < 31 * 256; i += NTHREADS) W[i] = P.in[I_DWW][(size_t)l * 31 * 256 + i];
    const f32x4 dwb = *(const f32x4*)(P.in[I_DWB] + l * 256 + c4), lng = *(const f32x4*)(P.in[I_LNG] + l * 256 + c4), lnb = *(const f32x4*)(P.in[I_LNB] + l * 256 + c4);
    for (int seg = F.bid; seg < nrows / CV_SEG; seg += F.G) {
        const int r0 = seg * CV_SEG; const RowGeo g0 = row_geo(r0);
        __syncthreads();
#pragma unroll 4
        for (int k = 0; k < 12; ++k) { const int rr = wave + 8 * k;
            if (rr < CV_ROWS) { const int pos = g0.pos - 15 + rr; f32x4 hv = (f32x4){0.f, 0.f, 0.f, 0.f};
                if (pos >= 0 && pos < g0.len) { const bf16_t* p = PL + (size_t)(r0 - 15 + rr) * INW + O_CV + c4; float a[4], bb[4];
                    unpack4(*(const u32x2*)p, a); unpack4(*(const u32x2*)(p + 256), bb);
#pragma unroll
                    for (int q = 0; q < 4; ++q) hv[q] = a[q] * sigmoidf_(bb[q]); }
                *(LAS f32x4*)(H + rr * 256 + c4) = hv; } }
        __syncthreads();
        f32x4 acc[8];
#pragma unroll
        for (int t = 0; t < 8; ++t) acc[t] = dwb;
#pragma unroll 1
        for (int j = 0; j < 31; ++j) { const f32x4 w = *(const LAS f32x4*)(W + j * 256 + c4);
#pragma unroll
            for (int t = 0; t < 8; ++t) acc[t] += *(const LAS f32x4*)(H + (wave * 8 + t + j) * 256 + c4) * w; }
#pragma unroll
        for (int t = 0; t < 8; ++t) {
            const float mu = wave_sum((acc[t][0] + acc[t][1]) + (acc[t][2] + acc[t][3])) * (1.0f / 256.0f);
            float vs = 0.f;
#pragma unroll
            for (int q = 0; q < 4; ++q) { const float dd = acc[t][q] - mu; vs += dd * dd; }
            const float rstd = rsqrtf(wave_sum(vs) * (1.0f / 256.0f) + 1e-5f);
            float o[4];
#pragma unroll
            for (int q = 0; q < 4; ++q) o[q] = siluf_((acc[t][q] - mu) * rstd * lng[q] + lnb[q]);
            u32x2 w; w.x = pk_bf16(o[0], o[1]); w.y = pk_bf16(o[2], o[3]);
            *(u32x2*)(MIX + (size_t)(r0 + wave * 8 + t) * D + 768 + c4) = w; }
    }
    __syncthreads();
}

__device__ __forceinline__ void phase_na_simple(const Frame& F, const Params& P, int l, int nq) {
    const bf16_t* PL = (const bf16_t*)(F.ws + WS_PL); bf16_t* MIX = (bf16_t*)(F.ws + WS_MIX);
    const float* rpb = P.in[I_RPB] + (size_t)l * 8 * 15 * 31;
    int tid_ = F.tid; asm volatile("" : "+v"(tid_));
    for (int gid = F.bid * NTHREADS + tid_; gid < nq * 8; gid += F.G * NTHREADS) {
        const int r = gid >> 3, h = gid & 7;
        const RowGeo g = row_geo(r);
        float q[64], o[64];
        { const bf16_t* qp = PL + (size_t)r * INW + O_Q + h * 64;
#pragma unroll
          for (int i = 0; i < 8; ++i) unpack8(*(const u32x4*)(qp + i * 8), q + i * 8); }
#pragma unroll
        for (int i = 0; i < 64; ++i) o[i] = 0.f;
        float m = -3.0e38f, lsum = 0.f;
        const bool lat = r < NLAT;
        const int gi = g.pos >> 6, gc = g.pos & 63;
        const int rs = min(max(gi - 4, 0), 56), wsc = min(max(gc - 8, 0), 48);
        const int nkey = lat ? 384 : 256;
#pragma unroll 1
        for (int kx = 0; kx < nkey; ++kx) {
            const bool win = lat && kx < 128;
            int krow; float bias = 0.f;
            if (win) { const int r8 = kx >> 4, cc = kx & 15; krow = g.b * SEQ + (rs + r8) * 64 + wsc + cc; bias = rpb[(h * 15 + (rs + r8 - gi + 7)) * 31 + (wsc + cc - gc + 15)]; }
            else krow = NLAT + g.b * CTXL + (kx - (lat ? 128 : 0));
            const bf16_t* kp = PL + (size_t)krow * INW + O_K + h * 64; float a = bias;
#pragma unroll
            for (int i = 0; i < 8; ++i) { float kf[8]; unpack8(*(const u32x4*)(kp + i * 8), kf);
#pragma unroll
                for (int j = 0; j < 8; ++j) a += q[i * 8 + j] * kf[j]; }
            if (a > m) { const float alpha = __expf(m - a); lsum *= alpha;
#pragma unroll
                for (int i = 0; i < 64; ++i) o[i] *= alpha;
                m = a; }
            const float p = __expf(a - m); lsum += p;
            const bf16_t* vp = kp + (O_V - O_K);
#pragma unroll
            for (int i = 0; i < 8; ++i) { float vf[8]; unpack8(*(const u32x4*)(vp + i * 8), vf);
#pragma unroll
                for (int j = 0; j < 8; ++j) o[i * 8 + j] += p * vf[j]; }
        }
        const float inv = 1.0f / lsum;
        bf16_t* op = MIX + (size_t)r * D + h * 64;
#pragma unroll
        for (int i = 0; i < 8; ++i) { u32x4 w; w.x = pk_bf16(o[i * 8] * inv, o[i * 8 + 1] * inv); w.y = pk_bf16(o[i * 8 + 2] * inv, o[i * 8 + 3] * inv);
            w.z = pk_bf16(o[i * 8 + 4] * inv, o[i * 8 + 5] * inv); w.w = pk_bf16(o[i * 8 + 6] * inv, o[i * 8 + 7] * inv); *(u32x4*)(op + i * 8) = w; }
    }
}

constexpr int NA_CK = 0, NA_CV = 32768, NA_RPB = 65536, NA_WV = 81920, NA_WK = NA_WV + 8 * 4096;
__device__ __forceinline__ bf16x8 na_pack8(const f32x4& a, const f32x4& b) {
    u32x4 w; w.x = cvt_pk_bf16(a[0], a[1]); w.y = cvt_pk_bf16(a[2], a[3]); w.z = cvt_pk_bf16(b[0], b[1]); w.w = cvt_pk_bf16(b[2], b[3]); return __builtin_bit_cast(bf16x8, w);
}
__device__ __forceinline__ bf16x8 na_vfrag(LAS unsigned char* blk, int lane, int dt) {
    const int g = lane >> 4, qq = (lane & 15) >> 2, p = lane & 3;
    const int r0 = 4 * g + qq, r1 = 16 + 4 * g + qq;
    const v4i16_t lo = __builtin_amdgcn_ds_read_tr16_b64_v4i16((LAS v4i16_t*)(blk + r0 * 128 + ((dt ^ ((r0 >> 1) & 3)) * 32) + p * 8));
    const v4i16_t hi = __builtin_amdgcn_ds_read_tr16_b64_v4i16((LAS v4i16_t*)(blk + r1 * 128 + ((dt ^ ((r1 >> 1) & 3)) * 32) + p * 8));
    bf16x8 r; r[0] = lo[0]; r[1] = lo[1]; r[2] = lo[2]; r[3] = lo[3]; r[4] = hi[0]; r[5] = hi[1]; r[6] = hi[2]; r[7] = hi[3]; return r;
}
template <bool WINDOW>
__device__ __forceinline__ void na_item(const Frame& F, const bf16_t* PL, bf16_t* MIX, int b, int h, int qrow0  , int gi, int cb) {
    const int lane = F.lane, ql = lane & 15, g = lane >> 4;
    LAS unsigned char* CK = F.lds + NA_CK; LAS unsigned char* CV = F.lds + NA_CV; const LAS float* RPB = (const LAS float*)(F.lds + NA_RPB);
    LAS unsigned char* WV = F.lds + NA_WV + F.wave * 4096;
    bf16x8 Qf[2];
    { const bf16_t* qp = PL + (size_t)(qrow0 + ql) * INW + O_Q + h * 64 + 8 * g; Qf[0] = *(const bf16x8*)qp; Qf[1] = *(const bf16x8*)(qp + 32); }
    f32x4 acc[4];
#pragma unroll
    for (int dt = 0; dt < 4; ++dt) acc[dt] = (f32x4){0.f, 0.f, 0.f, 0.f};
    float m_run = -3.0e38f, l_run = 0.f;
    if constexpr (WINDOW) {
        const int rs = min(max(gi - 4, 0), 56), kc0 = min(max(16 * cb - 8, 0), 32), qcol = 16 * cb + ql, wsq = min(max(qcol - 8, 0), 48);
        const size_t krow0 = (size_t)b * SEQ + (size_t)rs * 64 + kc0;
        f32x4 s[16];
        { const int rr = lane >> 3, pc = lane & 7;
          const bf16_t* kb = PL + (krow0 + rr) * INW + O_K + h * 64 + 8 * pc;
          LAS unsigned char* WK = F.lds + NA_WK + F.wave * 4608;
          u32x4 kc[16][2];
#pragma unroll
          for (int t = 0; t < 16; ++t) { const bf16_t* kp = kb + ((size_t)(t >> 1) * 64 + (t & 1) * 16) * INW; kc[t][0] = *(const u32x4*)kp; kc[t][1] = *(const u32x4*)(kp + (size_t)8 * INW); }
#pragma unroll
          for (int t = 0; t < 16; ++t) { LAS unsigned char* buf = WK + (t & 1) * 2304;
              *(LAS u32x4*)(buf + rr * 144 + pc * 16) = kc[t][0]; *(LAS u32x4*)(buf + (rr + 8) * 144 + pc * 16) = kc[t][1];
              __builtin_amdgcn_wave_barrier(); asm volatile("" ::: "memory");
              const bf16x8 k0 = *(const LAS bf16x8*)(buf + ql * 144 + g * 16), k1 = *(const LAS bf16x8*)(buf + ql * 144 + 64 + g * 16);
              __builtin_amdgcn_wave_barrier(); asm volatile("" ::: "memory");
              s[t] = __builtin_amdgcn_mfma_f32_16x16x32_bf16(k0, Qf[0], (f32x4){0.f, 0.f, 0.f, 0.f}, 0, 0, 0);
              s[t] = __builtin_amdgcn_mfma_f32_16x16x32_bf16(k1, Qf[1], s[t], 0, 0, 0); } }
        const int vr = lane >> 1, part = lane & 1;
        const bf16_t* vbase = PL + (krow0 + vr) * INW + O_V + h * 64 + part * 32;
        u32x4 vbuf[4][4];
#pragma unroll
        for (int k = 0; k < 4; ++k) { const bf16_t* vp = vbase + (size_t)k * 64 * INW; vbuf[k][0] = *(const u32x4*)vp; vbuf[k][1] = *(const u32x4*)(vp + 8); vbuf[k][2] = *(const u32x4*)(vp + 16); vbuf[k][3] = *(const u32x4*)(vp + 24); }
        float mx = -3.0e38f;
#pragma unroll
        for (int t = 0; t < 16; ++t) { const LAS float* bp = RPB + (h * 15 + (rs + (t >> 1) - gi + 7)) * 31 + 15 - qcol;
#pragma unroll
            for (int j = 0; j < 4; ++j) { const int kcol = kc0 + (t & 1) * 16 + 4 * g + j; const bool ok = kcol >= wsq && kcol < wsq + 16;
                const float v = ok ? s[t][j] + bp[ok ? kcol : qcol] : -INFINITY; s[t][j] = v; mx = fmaxf(mx, v); } }
        mx = fmaxf(mx, __shfl_xor(mx, 16)); mx = fmaxf(mx, __shfl_xor(mx, 32));
        m_run = mx;
        float ls = 0.f;
#pragma unroll
        for (int t = 0; t < 16; ++t)
#pragma unroll
            for (int j = 0; j < 4; ++j) { const float p = __expf(s[t][j] - mx); s[t][j] = p; ls += p; }
        l_run = ls;
#pragma unroll
        for (int r8 = 0; r8 < 8; ++r8) {
            { LAS unsigned char* wr = WV + vr * 128; const int sw = (vr >> 1) & 3;
              *(LAS u32x4*)(wr + (((2 * part) ^ sw) * 32)) = vbuf[r8 & 3][0]; *(LAS u32x4*)(wr + (((2 * part) ^ sw) * 32) + 16) = vbuf[r8 & 3][1];
              *(LAS u32x4*)(wr + (((2 * part + 1) ^ sw) * 32)) = vbuf[r8 & 3][2]; *(LAS u32x4*)(wr + (((2 * part + 1) ^ sw) * 32) + 16) = vbuf[r8 & 3][3];
              if (r8 + 4 < 8) { const bf16_t* vp = vbase + (size_t)(r8 + 4) * 64 * INW;
                  vbuf[r8 & 3][0] = *(const u32x4*)vp; vbuf[r8 & 3][1] = *(const u32x4*)(vp + 8); vbuf[r8 & 3][2] = *(const u32x4*)(vp + 16); vbuf[r8 & 3][3] = *(const u32x4*)(vp + 24); } }
            __builtin_amdgcn_wave_barrier(); asm volatile("" ::: "memory");
            const bf16x8 pf = na_pack8(s[2 * r8], s[2 * r8 + 1]);
#pragma unroll
            for (int dt = 0; dt < 4; ++dt) { const bf16x8 vf = na_vfrag(WV, lane, dt); acc[dt] = __builtin_amdgcn_mfma_f32_16x16x32_bf16(vf, pf, acc[dt], 0, 0, 0); }
            __builtin_amdgcn_wave_barrier(); asm volatile("" ::: "memory");
        }
    }
    {
        f32x4 s[16];
#pragma unroll
        for (int t = 0; t < 16; ++t) { const int key = 16 * t + ql; const LAS unsigned char* kr = CK + key * 128;
            const bf16x8 k0 = *(const LAS bf16x8*)(kr + ((g ^ (key & 7)) * 16)), k1 = *(const LAS bf16x8*)(kr + (((g + 4) ^ (key & 7)) * 16));
            s[t] = __builtin_amdgcn_mfma_f32_16x16x32_bf16(k0, Qf[0], (f32x4){0.f, 0.f, 0.f, 0.f}, 0, 0, 0);
            s[t] = __builtin_amdgcn_mfma_f32_16x16x32_bf16(k1, Qf[1], s[t], 0, 0, 0); }
        float mx = m_run;
#pragma unroll
        for (int t = 0; t < 16; ++t)
#pragma unroll
            for (int j = 0; j < 4; ++j) mx = fmaxf(mx, s[t][j]);
        mx = fmaxf(mx, __shfl_xor(mx, 16)); mx = fmaxf(mx, __shfl_xor(mx, 32));
        const float alpha = __expf(m_run - mx);
        float ls = l_run * alpha;
#pragma unroll
        for (int dt = 0; dt < 4; ++dt) acc[dt] *= alpha;
#pragma unroll
        for (int t = 0; t < 16; ++t)
#pragma unroll
            for (int j = 0; j < 4; ++j) { const float p = __expf(s[t][j] - mx); s[t][j] = p; ls += p; }
        l_run = ls;
#pragma unroll
        for (int blk = 0; blk < 8; ++blk) { const bf16x8 pf = na_pack8(s[2 * blk], s[2 * blk + 1]);
#pragma unroll
            for (int dt = 0; dt < 4; ++dt) { const bf16x8 vf = na_vfrag(CV + blk * 4096, lane, dt); acc[dt] = __builtin_amdgcn_mfma_f32_16x16x32_bf16(vf, pf, acc[dt], 0, 0, 0); } }
    }
    float lt = l_run; lt += __shfl_xor(lt, 16); lt += __shfl_xor(lt, 32);
    const float inv = 1.0f / lt;
    bf16_t* op = MIX + (size_t)(qrow0 + ql) * D + h * 64 + 4 * g;
#pragma unroll
    for (int dt = 0; dt < 4; ++dt) { u32x2 w; w.x = cvt_pk_bf16(acc[dt][0] * inv, acc[dt][1] * inv); w.y = cvt_pk_bf16(acc[dt][2] * inv, acc[dt][3] * inv); *(u32x2*)(op + dt * 16) = w; }
}
__device__ __forceinline__ void phase_na_mfma(const Frame& F, const Params& P, int l, bool ctx_queries) {
    const bf16_t* PL = (const bf16_t*)(F.ws + WS_PL); bf16_t* MIX = (bf16_t*)(F.ws + WS_MIX);
    int tid_ = F.tid; asm volatile("" : "+v"(tid_));
    const int tid = tid_;
    { const float* rpb = P.in[I_RPB] + (size_t)l * 8 * 15 * 31; LAS float* R = (LAS float*)(F.lds + NA_RPB); for (int i = tid; i < 8 * 15 * 31; i += NTHREADS) R[i] = rpb[i]; }
    for (int unit = F.bid; unit < 512; unit += F.G) {
        const int eighth = unit & 7, h = (unit >> 3) & 7, b = unit >> 6;
        __syncthreads();
        { int t2 = tid; asm volatile("" : "+v"(t2)); const int key = t2 >> 1, part = t2 & 1; const bf16_t* kp = PL + (size_t)(NLAT + b * CTXL + key) * INW + O_K + h * 64 + part * 32; const bf16_t* vp = kp + (O_V - O_K);
          LAS unsigned char* kr = F.lds + NA_CK + key * 128; LAS unsigned char* vr = F.lds + NA_CV + key * 128; const int sw = (key >> 1) & 3;
#pragma unroll
          for (int c = 0; c < 4; ++c) { *(LAS u32x4*)(kr + (((4 * part + c) ^ (key & 7)) * 16)) = *(const u32x4*)(kp + 8 * c);
              const int c16 = 4 * part + c; *(LAS u32x4*)(vr + (((c16 >> 1) ^ sw) * 32) + (c16 & 1) * 16) = *(const u32x4*)(vp + 8 * c); } }
        __syncthreads();
        for (int it = F.wave; it < 32; it += NWAVES) { const int gi = eighth * 8 + (it >> 2), cb = it & 3;
            na_item<true>(F, PL, MIX, b, h, b * SEQ + gi * 64 + cb * 16, gi, cb); }
        if (ctx_queries && F.wave < 2) na_item<false>(F, PL, MIX, b, h, NLAT + b * CTXL + (eighth * 2 + F.wave) * 16, 0, 0);
    }
}

__device__ __forceinline__ void phase_final(const Frame& F, const Params& P) {
    float* out = P.out; const float* g = P.in[I_FINALG]; const int lane = F.lane;
    const bf16_t* YM = (const bf16_t*)(F.ws + WS_YM); const int* tsl = (const int*)(F.ws + WS_ROUTE + RT_RMAP); const float* tg = (const float*)(F.ws + WS_ROUTE + RT_TOKG);
    const float* g2v = (const float*)(F.ws + WS_MODV) + (size_t)9 * MODW + 5 * D;
    const int RB = ((NLAT + F.G - 1) / F.G + 7) & ~7, rbeg = F.bid * RB, rend = min(rbeg + RB, NLAT);
    f32x4 xn[4], gG[4], gF[4]; u32x2 an[4], bn[4]; float w0n, w1n; int cur_b = -1;
#pragma unroll
    for (int j = 0; j < 4; ++j) gF[j] = *(const f32x4*)(g + j * 256 + lane * 4);
    { const int r = rbeg + F.wave < rend ? rbeg + F.wave : 0; const bf16_t* y0 = YM + (size_t)tsl[r * 2] * D; const bf16_t* y1 = YM + (size_t)tsl[r * 2 + 1] * D; w0n = tg[r * 2]; w1n = tg[r * 2 + 1];
#pragma unroll
      for (int j = 0; j < 4; ++j) { const int c = j * 256 + lane * 4; xn[j] = *(const f32x4*)(out + (size_t)r * D + c); an[j] = *(const u32x2*)(y0 + c); bn[j] = *(const u32x2*)(y1 + c); } }
    for (int r = rbeg + F.wave; r < rend; r += 8) {
        float* xr = out + (size_t)r * D; const float w0 = w0n, w1 = w1n;
        if ((r >> 12) != cur_b) { cur_b = r >> 12; const float* gv = g2v + (size_t)cur_b * MODW;
#pragma unroll
            for (int j = 0; j < 4; ++j) gG[j] = *(const f32x4*)(gv + j * 256 + lane * 4); }
        f32x4 x[4]; u32x2 ac[4], bc[4]; float ss = 0.f;
#pragma unroll
        for (int j = 0; j < 4; ++j) { x[j] = xn[j]; ac[j] = an[j]; bc[j] = bn[j]; }
        { const int rn = r + 8 < rend ? r + 8 : r; const bf16_t* y0 = YM + (size_t)tsl[rn * 2] * D; const bf16_t* y1 = YM + (size_t)tsl[rn * 2 + 1] * D; w0n = tg[rn * 2]; w1n = tg[rn * 2 + 1];
#pragma unroll
          for (int j = 0; j < 4; ++j) { const int c = j * 256 + lane * 4; xn[j] = *(const f32x4*)(out + (size_t)rn * D + c); an[j] = *(const u32x2*)(y0 + c); bn[j] = *(const u32x2*)(y1 + c); } }
#pragma unroll
        for (int j = 0; j < 4; ++j) {
            const u32x2 a = ac[j], b = bc[j]; const f32x4 gg = gG[j];
            float ya[4], yb[4]; unpack4(a, ya); unpack4(b, yb);
#pragma unroll
            for (int q = 0; q < 4; ++q) x[j][q] += gg[q] * (w0 * ya[q] + w1 * yb[q]);
            ss += x[j][0] * x[j][0] + x[j][1] * x[j][1] + x[j][2] * x[j][2] + x[j][3] * x[j][3]; }
        ss = wave_sum(ss); const float rstd = rsqrtf(ss * (1.0f / D) + 1e-6f);
#pragma unroll
        for (int j = 0; j < 4; ++j) *(f32x4*)(xr + j * 256 + lane * 4) = x[j] * rstd * gF[j];
    }
}

constexpr int PH_L0 = 1, PH_PER_L0 = 9, PH_L1 = PH_L0 + PH_PER_L0, PH_PER_L1 = 10, PH_FINAL = PH_L1 + PH_PER_L1, N_PHASES = PH_FINAL + 1;
#define RFL(x) __builtin_amdgcn_readfirstlane(x)

PHASE ph_prologue(const void* kp_, int wv_) { PHASE_ENTER; if constexpr (MKB(0)) phase_prologue(F, P); }
PHASE ph_norm1(const void* kp_, int wv_, int l_) { PHASE_ENTER; const int l = RFL(l_);
    if constexpr (MKB(1)) phase_norm<false>(F, P, l, 0, NROW, l == 0 ? P.in[I_X] : P.out, l == 0 ? P.in[I_CTX] : (const float*)(F.ws + WS_XC)); }
PHASE_INL ph_gemm_win(const void* kp_, int wv_, int l_) { PHASE_ENTER; const int l = RFL(l_);
    pg8::DenseSched S; S.init(NROW / 256, INW / 256, F.G, F.bid); S.A = (const bf16_t*)(F.ws + WS_HL); S.Bt = (const bf16_t*)(F.ws + WS_BTIN) + (size_t)l * INW * D; S.K = D;
    pg8::EpiBf16 E{(bf16_t*)(F.ws + WS_PL), INW, 2, 0.125f};
    if constexpr (MKB(2)) pg8::gemm_phase<pg8::EpiBf16, pg8::DenseSched, false>(F.lds, D, S, E, F.wave); }
PHASE_INL ph_rw_prep(const void* kp_, int wv_, int l_) { PHASE_ENTER; const int l = RFL(l_); if constexpr (MKB(3)) phase_rw_prep(F, P, l); }
PHASE ph_conv(const void* kp_, int wv_, int l_, int bid_, int G_) { PHASE_ENTER; const int l = RFL(l_); if constexpr (MKB(4)) phase_conv(sub_frame(F, RFL(bid_), RFL(G_)), P, l, l == 0 ? NROW : NLAT); }
PHASE_INL ph_na(const void* kp_, int wv_, int l_, int bid_, int G_) { PHASE_ENTER; const int l = RFL(l_); if constexpr (MKB(5)) phase_na_mfma(sub_frame(F, RFL(bid_), RFL(G_)), P, l, l == 0); }
PHASE_INL ph_scan(const void* kp_, int wv_, int bid_, int G_) { PHASE_ENTER; if constexpr (MKB(6)) phase_scan(sub_frame(F, RFL(bid_), RFL(G_))); }
PHASE_INL ph_rw_post(const void* kp_, int wv_, int l_) { PHASE_ENTER; const int l = RFL(l_); if constexpr (MKB(7)) phase_rw_post(F, P, l, l == 0 ? NROW : NLAT); }
PHASE_INL ph_gemm_wout(const void* kp_, int wv_, int l_) { PHASE_ENTER; const int l = RFL(l_);
    float* XC = (float*)(F.ws + WS_XC);
    pg8::DenseSched S; S.init((l == 0 ? NROW : NLAT) / 256, D / 256, F.G, F.bid); S.A = (const bf16_t*)(F.ws + WS_MIX); S.Bt = (const bf16_t*)(F.ws + WS_BTOUT) + (size_t)l * D * D; S.K = D; S.split_tail();
    pg8::EpiRes E{l == 0 ? P.in[I_X] : P.out, l == 0 ? P.in[I_CTX] : XC, P.out, XC, (const float*)(F.ws + WS_MODV) + (size_t)l * 9 * MODW + 2 * D};
    if constexpr (MKB(8)) pg8::gemm_phase<pg8::EpiRes, pg8::DenseSched, false>(F.lds, D, S, E, F.wave); }
PHASE ph_norm2_l0(const void* kp_, int wv_) { PHASE_ENTER; if constexpr (MKB(9)) phase_norm<false>(F, P, 0, 1, NROW, P.out, (const float*)(F.ws + WS_XC)); }
PHASE_INL ph_gemm_ffn_gu(const void* kp_, int wv_) { PHASE_ENTER;
    pg8::DenseSched S; S.init(NROW / 256, (2 * DFF) / 256, F.G, F.bid); S.A = (const bf16_t*)(F.ws + WS_HL); S.Bt = (const bf16_t*)(F.ws + WS_BTGU); S.K = D;
    pg8::EpiSwiGLU8 E{F.ws + WS_H, DFF, 1.0f};
    if constexpr (MKB(10)) pg8::gemm_phase<pg8::EpiSwiGLU8, pg8::DenseSched, false>(F.lds, D, S, E, F.wave); }
PHASE_INL ph_gemm_ffn_dn(const void* kp_, int wv_) { PHASE_ENTER;
    float* XC = (float*)(F.ws + WS_XC);
    pg8::DenseSched S; S.init(NROW / 256, D / 256, F.G, F.bid); S.A = (const bf16_t*)(F.ws + WS_H); S.Bt = (const bf16_t*)(F.ws + WS_BTDN); S.K = DFF / 2; S.split_tail();
    pg8::EpiRes E{P.out, XC, P.out, XC, (const float*)(F.ws + WS_MODV) + 5 * D, 1.0f / FFN8_DN_SCALE};
    if constexpr (MKB(11)) pg8::gemm_phase<pg8::EpiRes, pg8::DenseSched, false, true>(F.lds, DFF / 2, S, E, F.wave); }
PHASE ph_norm2_l1(const void* kp_, int wv_) { PHASE_ENTER; if constexpr (MKB(12)) phase_norm<true>(F, P, 1, 1, NLAT, P.out, (const float*)(F.ws + WS_XC)); }
PHASE ph_moe_prep(const void* kp_, int wv_) { PHASE_ENTER; if constexpr (MKB(13)) { phase_moe_rowmap(F); phase_moe_convert(F, P); } }
PHASE_INL ph_gemm_moe_gu(const void* kp_, int wv_) { PHASE_ENTER;
    pg8::MoeSched S; { int ts0[9], ts1[9]; moe_tstart(F, 0, ts0); moe_tstart(F, 1, ts1); S.set_tstart(ts0, ts1); S.init(RFL(ts0[8] + ts1[8]), (2 * DFE) / 256, F.G, F.bid); }
    S.A = (const bf16_t*)(F.ws + WS_HLG); S.Bt0 = F.ws + WS_MOE; S.K = D / 2;
    pg8::EpiSwiGLU8 E{F.ws + WS_H, DFE, 1.0f / MOE8_GU_SCALE};
    if constexpr (MKB(14)) pg8::gemm_phase<pg8::EpiSwiGLU8, pg8::MoeSched, false, true>(F.lds, D / 2, S, E, F.wave); }
PHASE_INL ph_gemm_moe_dn(const void* kp_, int wv_) { PHASE_ENTER;
    pg8::MoeSched S; { int ts0[9], ts1[9]; moe_tstart(F, 0, ts0); moe_tstart(F, 1, ts1); S.set_tstart(ts0, ts1); S.init(RFL(ts0[8] + ts1[8]), D / 256, F.G, F.bid); }
    S.A = (const bf16_t*)(F.ws + WS_H); S.Bt0 = F.ws + WS_MOE + MOE8_GU_BYTES; S.K = DFE / 2; S.split_tail();
    pg8::EpiMoeY E{(bf16_t*)(F.ws + WS_YM), 1.0f / MOE8_DN_SCALE};
    if constexpr (MKB(15)) pg8::gemm_phase<pg8::EpiMoeY, pg8::MoeSched, false, true>(F.lds, DFE / 2, S, E, F.wave); }
PHASE ph_final(const void* kp_, int wv_) { PHASE_ENTER; if constexpr (MKB(16)) phase_final(F, P); }

static __attribute__((noinline)) __device__ void grid_barrier(const void* bar_, unsigned x_, int wv_) {
    const unsigned long long v = (unsigned long long)bar_;
    const unsigned lo = __builtin_amdgcn_readfirstlane((unsigned)v), hi = __builtin_amdgcn_readfirstlane((unsigned)(v >> 32));
    XcdBarrier b; b.bar = (unsigned*)(((unsigned long long)hi << 32) | lo); b.x = __builtin_amdgcn_readfirstlane(x_);
    b.st = (volatile LAS unsigned*)((LAS unsigned char*)lds_raw + LDS_MISC);
    xcd_barrier(b, __builtin_amdgcn_readfirstlane(wv_) * 64 + lane_id());
}
#if TS_MASK
constexpr int CW_TS = 8192;
static __attribute__((noinline)) __device__ void ts_mark(const void* bar_, int idx_, int wv_) {
    if (blockIdx.x == 0 && wv_ == 0 && lane_id() == 0) { volatile unsigned long long* ts = (volatile unsigned long long*)((unsigned*)bar_ - CW_BAR + CW_TS); ts[idx_] = __builtin_amdgcn_s_memrealtime(); }
}
static __attribute__((noinline)) __device__ void ts_side(const void* bar_, int idx_, int wv_) {
    if (wv_ == 0 && lane_id() == 0) { unsigned long long* ts = (unsigned long long*)((unsigned*)bar_ - CW_BAR + CW_TS); atomicMax(ts + 32 + idx_, (unsigned long long)__builtin_amdgcn_s_memrealtime()); }
}
static __attribute__((noinline)) __device__ void ts_spin(const void* bar_, int wv_) {
    if (blockIdx.x == 0 && wv_ == 0 && lane_id() == 0) { volatile unsigned long long* ts = (volatile unsigned long long*)((unsigned*)bar_ - CW_BAR + CW_TS);
        unsigned long long sum = 0;
        for (int k = 0; k < 23; ++k) if ((TS_MASK >> k) & 1) sum += ts[k + 1] - ts[k];
        if ((TS_SIDE >> 4) & 1) sum += ts[40];
        for (int k = 0; k < 4; ++k) if ((TS_SIDE >> k) & 1) sum += ts[32 + k] - ts[(k >> 1) == 0 ? PH_L0 + 3 : PH_L1 + 3];
        const unsigned long long t0 = __builtin_amdgcn_s_memrealtime();
        while (__builtin_amdgcn_s_memrealtime() - t0 < sum * TS_MULT) __builtin_amdgcn_s_sleep(32); }
}
#endif
__device__ __forceinline__ bool ph_in(int lo, int hi, int k) { asm volatile("" : "+s"(lo), "+s"(hi)); return lo <= k && k < hi; }

__global__ void __launch_bounds__(NTHREADS, 2) mk_fwd(Params P) {
    const void* kp = (const void*)__builtin_amdgcn_kernarg_segment_ptr();
    LAS unsigned char* lds = (LAS unsigned char*)lds_raw;
    volatile LAS unsigned* misc = (volatile LAS unsigned*)(lds + LDS_MISC);
    const int wv = __builtin_amdgcn_readfirstlane((int)(threadIdx.x >> 6));
    if (wv == 0 && lane_id() < 4) misc[lane_id()] = 0u;
    __syncthreads();
    const int lo = P.ph_lo, hi = P.ph_hi;
    XcdBarrier bar; bar.bar = (unsigned*)(P.ws + WS_CTL) + CW_BAR; bar.x = 0; bar.st = misc;
    if (hi - lo > 1) bar = xcd_barrier_post((unsigned*)(P.ws + WS_CTL) + CW_BAR, misc, wv * 64 + lane_id());
#define IN(k) ph_in(lo, hi, (k))
#if TS_MASK
#define TS_SIDE_MARK(i) ts_side((const void*)bar.bar, (i), wv)
#define SEAM(k) do { if (IN((k) + 1)) grid_barrier((const void*)bar.bar, bar.x, wv); ts_mark((const void*)bar.bar, (k) + 1, wv); } while (0)
    ts_mark((const void*)bar.bar, 0, wv);
#else
#define TS_SIDE_MARK(i) do { } while (0)
#define SEAM(k) do { if (IN((k) + 1)) grid_barrier((const void*)bar.bar, bar.x, wv); } while (0)
#endif
    if (IN(0)) { for (int rep = 0; rep < REP_PRO; ++rep) ph_prologue(kp, wv); SEAM(0); }
#define LAYER_COMMON(l, pb) \
    if (IN((pb) + 0)) { for (int rep = 0; rep < REP_NORM; ++rep) ph_norm1(kp, wv, (l)); SEAM((pb) + 0); } \
    if (IN((pb) + 1)) { for (int rep = 0; rep < REP_GEMM; ++rep) ph_gemm_win(kp, wv, (l)); SEAM((pb) + 1); } \
    if (IN((pb) + 2)) { for (int rep = 0; rep < REP_PP; ++rep) ph_rw_prep(kp, wv, (l)); SEAM((pb) + 2); } \
    if (IN((pb) + 3)) { const int bx = (int)blockIdx.x, Gx = (int)gridDim.x; \
        if (Gx == 256) { if (bx < 64) { for (int rep = 0; rep < REP_SCAN; ++rep) ph_scan(kp, wv, bx, 64); TS_SIDE_MARK(2 * (l)); } \
            else { for (int rep = 0; rep < REP_CONV; ++rep) ph_conv(kp, wv, (l), bx - 64, 192); for (int rep = 0; rep < REP_NA; ++rep) ph_na(kp, wv, (l), bx - 64, 192); TS_SIDE_MARK(2 * (l) + 1); } } \
        else { ph_conv(kp, wv, (l), bx, Gx); ph_na(kp, wv, (l), bx, Gx); ph_scan(kp, wv, bx, Gx); } SEAM((pb) + 3); } \
    if (IN((pb) + 4)) { for (int rep = 0; rep < REP_POST; ++rep) ph_rw_post(kp, wv, (l)); SEAM((pb) + 4); } \
    if (IN((pb) + 5)) { ph_gemm_wout(kp, wv, (l)); SEAM((pb) + 5); }
    LAYER_COMMON(0, PH_L0)
    if (IN(PH_L0 + 6)) { ph_norm2_l0(kp, wv); SEAM(PH_L0 + 6); }
    if (IN(PH_L0 + 7)) { for (int rep = 0; rep < REP_GEMM; ++rep) ph_gemm_ffn_gu(kp, wv); SEAM(PH_L0 + 7); }
    if (IN(PH_L0 + 8)) { ph_gemm_ffn_dn(kp, wv); SEAM(PH_L0 + 8); }
    LAYER_COMMON(1, PH_L1)
    if (IN(PH_L1 + 6)) { ph_norm2_l1(kp, wv); SEAM(PH_L1 + 6); }
    if (IN(PH_L1 + 7)) { for (int rep = 0; rep < REP_PRO; ++rep) ph_moe_prep(kp, wv); SEAM(PH_L1 + 7); }
    { int wvp = wv; asm volatile("" : "+s"(wvp));
      if (IN(PH_L1 + 8)) { for (int rep = 0; rep < REP_GEMM; ++rep) ph_gemm_moe_gu(kp, wvp); SEAM(PH_L1 + 8); }
      asm volatile("" : "+s"(wvp));
      if (IN(PH_L1 + 9)) { ph_gemm_moe_dn(kp, wvp); SEAM(PH_L1 + 9); } }
#undef LAYER_COMMON
    if (IN(PH_FINAL)) ph_final(kp, wv);
#if TS_MASK
    ts_mark((const void*)bar.bar, 23, wv); ts_spin((const void*)bar.bar, wv);
#endif
#undef IN
#undef SEAM
}

extern "C" void kernel_launch(void* const* d_in, const int* in_sizes, int n_in, void* d_out, int out_size, void* d_ws, size_t ws_size, hipStream_t stream) {
    static int grid = 0;
    if (grid == 0) {
        if (n_in != 35 || out_size != NLAT * D || ws_size < WS_END) { fprintf(stderr, "kernel_launch: unexpected shapes (n_in %d out %d ws %zu need %zu)\n", n_in, out_size, ws_size, (size_t)WS_END); grid = -1; return; }
        int dev = 0, cus = 0, per_cu = 0;
        if (hipGetDevice(&dev) != hipSuccess || hipDeviceGetAttribute(&cus, hipDeviceAttributeMultiprocessorCount, dev) != hipSuccess) { grid = -1; return; }
        if (hipFuncSetAttribute((const void*)mk_fwd, hipFuncAttributeMaxDynamicSharedMemorySize, LDS_BYTES) != hipSuccess) { fprintf(stderr, "kernel_launch: hipFuncSetAttribute failed\n"); grid = -1; return; }
        if (hipOccupancyMaxActiveBlocksPerMultiprocessor(&per_cu, (const void*)mk_fwd, NTHREADS, LDS_BYTES) != hipSuccess || per_cu < 1) { fprintf(stderr, "kernel_launch: occupancy query says %d\n", per_cu); (void)hipGetLastError(); }
        grid = cus > 256 ? 256 : cus;
    }
    if (grid < 0) return;
    (void)hipMemsetAsync((char*)d_ws + WS_CTL, 0, CTL_BYTES, stream);
    Params p{};
    for (int i = 0; i < 35; ++i) p.in[i] = (const float*)d_in[i];
    p.out = (float*)d_out; p.ws = (unsigned char*)d_ws;
#if MK_ONE_LAUNCH
    p.ph_lo = 0; p.ph_hi = N_PHASES;
    hipLaunchKernelGGL(mk_fwd, dim3(grid), dim3(NTHREADS), LDS_BYTES, stream, p);
#else
    for (int k = 0; k < N_PHASES && k <= MK_LAST; ++k) { p.ph_lo = k; p.ph_hi = k + 1; hipLaunchKernelGGL(mk_fwd, dim3(grid), dim3(NTHREADS), LDS_BYTES, stream, p); }
#endif
}
```

```cpp
#include <hip/hip_runtime.h>
#include <stdint.h>
#include <stdio.h>

#ifndef MK_MASK
#define MK_MASK 0xFFFFFFFFu
#endif
#define MKB(k) (((MK_MASK) >> (k)) & 1u)
#ifndef TS_MASK
#define TS_MASK 0
#endif
#ifndef TS_MULT
#define TS_MULT 4
#endif
#ifndef TS_SIDE
#define TS_SIDE 0
#endif
#ifndef REP_KLOOP_BF
#define REP_KLOOP_BF 1
#endif
#ifndef REP_KLOOP_F8
#define REP_KLOOP_F8 1
#endif
#ifndef REP_EPI
#define REP_EPI 1
#endif
#ifndef REP_SCAN
#define REP_SCAN 1
#endif
#ifndef REP_NA
#define REP_NA 1
#endif
#ifndef REP_GEMM
#define REP_GEMM 1
#endif
#ifndef REP_PP
#define REP_PP 1
#endif
#ifndef REP_POST
#define REP_POST 1
#endif
#ifndef REP_CONV
#define REP_CONV 1
#endif
#ifndef REP_NORM
#define REP_NORM 1
#endif
#ifndef REP_PRO
#define REP_PRO 1
#endif
#ifndef MK_LAST
#define MK_LAST 99
#endif
#ifndef MK_ONE_LAUNCH
#define MK_ONE_LAUNCH 1
#endif

#define LAS __attribute__((address_space(3)))
typedef unsigned short bf16_t;
typedef _Float16 f16_t;
typedef short bf16x8 __attribute__((ext_vector_type(8)));
typedef float f32x4 __attribute__((ext_vector_type(4)));
typedef float f32x2 __attribute__((ext_vector_type(2)));
typedef unsigned u32x4 __attribute__((ext_vector_type(4)));
typedef unsigned u32x2 __attribute__((ext_vector_type(2)));
typedef f16_t f16x4 __attribute__((ext_vector_type(4)));
typedef f16_t f16x8 __attribute__((ext_vector_type(8)));
typedef short v4i16_t __attribute__((ext_vector_type(4)));

constexpr int D = 1024, NB = 8, SEQ = 4096, CTXL = 256, TT = CTXL + SEQ;
constexpr int NLAT = NB * SEQ, NCTX = NB * CTXL, NROW = NLAT + NCTX;
constexpr int INW = 3328, DFF = 2816, DFE = 3584, NEXP = 8;
constexpr int O_Q = 0, O_K = 512, O_V = 1024, O_RW = 1536, O_CV = 2816;
constexpr int MODW = 6 * D;
constexpr int NTHREADS = 512, NWAVES = 8;
constexpr int LDS_BYTES = 160 * 1024;
constexpr int LDS_MISC = LDS_BYTES - 256;

constexpr size_t al256(size_t x) { return (x + 255) & ~(size_t)255; }
constexpr size_t WS_CTL   = 0;
constexpr size_t CTL_BYTES = 65536;
constexpr size_t WS_MODV  = WS_CTL + CTL_BYTES;
constexpr size_t WS_BTIN  = al256(WS_MODV + (size_t)2 * 9 * MODW * 4);
constexpr size_t WS_BTOUT = al256(WS_BTIN + (size_t)2 * INW * D * 2);
constexpr size_t WS_BTGU  = al256(WS_BTOUT + (size_t)2 * D * D * 2);
constexpr size_t WS_BTDN  = al256(WS_BTGU + (size_t)2 * DFF * D * 2);
constexpr size_t WS_LORA  = al256(WS_BTDN + (size_t)D * DFF * 2);
constexpr size_t LORA_LD_BYTES = (size_t)(256 * 64 * 2 + 256 * 128) * 2;
constexpr size_t WS_MOE   = al256(WS_LORA + 4 * LORA_LD_BYTES);
constexpr size_t MOE_GU_BYTES = (size_t)2 * DFE * D * 2, MOE_DN_BYTES = (size_t)D * DFE * 2, MOE_E_BYTES = MOE_GU_BYTES + MOE_DN_BYTES;
constexpr size_t MOE8_GU_BYTES = (size_t)2 * DFE * D, MOE8_DN_BYTES = (size_t)D * DFE, MOE8_E_BYTES = MOE8_GU_BYTES + MOE8_DN_BYTES;
constexpr float MOE8_GU_SCALE = 32.0f, MOE8_DN_SCALE = 64.0f, FFN8_DN_SCALE = 64.0f;
constexpr size_t WS_SH    = WS_MOE;
constexpr size_t SH_BYTES = (size_t)NB * 4 * TT * 192 * 2;
constexpr size_t WS_SD    = WS_SH + SH_BYTES;
constexpr size_t WS_HLG   = WS_MOE + (size_t)NEXP * MOE8_E_BYTES;
static_assert(WS_HLG + (size_t)2 * NROW * D <= WS_MOE + (size_t)NEXP * MOE_E_BYTES, "HLG overflows the MoE region");
constexpr size_t WS_XC    = al256(WS_MOE + (size_t)NEXP * MOE_E_BYTES);
constexpr size_t WS_HL    = al256(WS_XC + (size_t)NCTX * D * 4);
constexpr size_t WS_Y     = WS_HL;
constexpr size_t WS_PL    = al256(WS_HL + (size_t)NROW * D * 2);
constexpr size_t WS_MIX   = al256(WS_PL + (size_t)NROW * INW * 2);
constexpr size_t WS_H     = WS_PL;
static_assert(WS_H + (size_t)2 * NROW * DFE <= WS_MIX + (size_t)NROW * D * 2, "fp8 H of both passes overflows PL+MIX");
constexpr size_t WS_YM    = WS_HLG;
static_assert(WS_YM + (size_t)2 * NROW * D * 2 <= WS_HL + (size_t)NROW * D * 2, "YM overflows MoE tail + XC + HL");
constexpr size_t WS_ROUTE = al256(WS_MIX + (size_t)NROW * D * 2);
constexpr size_t RT_TOKE  = 0;
constexpr size_t RT_TOKG  = RT_TOKE + (size_t)NLAT * 2 * 4;
constexpr size_t RT_TOKP  = RT_TOKG + (size_t)NLAT * 2 * 4;
constexpr size_t RT_RMAP  = RT_TOKP + (size_t)NLAT * 2 * 4;
constexpr size_t RT_SGATE = RT_RMAP + (size_t)2 * NROW * 4;
constexpr size_t WS_END   = al256(WS_ROUTE + RT_SGATE + (size_t)2 * NROW * 4);
static_assert(SH_BYTES * 3 <= (size_t)NEXP * MOE_E_BYTES, "scan inputs must fit the MoE weight region");
static_assert((size_t)NROW * DFE * 2 <= (size_t)NROW * INW * 2 + (size_t)NROW * D * 2, "H must fit PL+MIX");

constexpr int CW_BAR = 0;
constexpr int CW_MOECNT = 4096;
constexpr int CW_WGCNT = 12288;

#define XB_TMO      128
#define XB_XCNT(j)  (256  + 64 * (j))
#define XB_XSUB(j)  (1280 + 64 * (j))
#define XB_XGEN(j)  (2304 + 64 * (j))
#define XB_TOP      3328
#define XB_TOPGEN   3392
#define XCD_BAR_WORDS 3456
#define XB_SPIN_CAP (1u << 22)

__device__ __forceinline__ unsigned xb_ld(unsigned* p)              { return __hip_atomic_load(p, __ATOMIC_RELAXED, __HIP_MEMORY_SCOPE_AGENT); }
__device__ __forceinline__ unsigned xb_add(unsigned* p, unsigned v) { return __hip_atomic_fetch_add(p, v, __ATOMIC_RELAXED, __HIP_MEMORY_SCOPE_AGENT); }
__device__ __forceinline__ unsigned xb_xcc_id() { return (unsigned)__builtin_amdgcn_s_getreg((3 << 11) | 20) & 0xFu; }
#define XB_SPIN(cond, bar) do { unsigned _sp = 0; while (cond) { __builtin_amdgcn_s_sleep(1); \
    if ((++_sp & 255u) == 0u) { if (xb_ld(&(bar)[XB_TMO])) break; if (_sp > XB_SPIN_CAP) { atomicAdd(&(bar)[XB_TMO], 1u); break; } } } } while (0)

struct XcdBarrier { unsigned* bar; unsigned x; volatile LAS unsigned* st; };

__device__ __forceinline__ XcdBarrier xcd_barrier_post(unsigned* bar, volatile LAS unsigned* st, int tid) {
    XcdBarrier b; b.bar = bar; b.x = xb_xcc_id(); b.st = st;
    if (tid == 0) (void)xb_add(&bar[XB_XCNT(b.x)], 1u);
    return b;
}
__device__ __forceinline__ void xcd_barrier_complete(unsigned* bar, unsigned x, unsigned& nloc, unsigned& nx) {
    const unsigned G = gridDim.x * gridDim.y * gridDim.z;
    unsigned sum, cnt, mine, sp = 0u;
    for (;;) {
        sum = 0u; cnt = 0u; mine = 0u;
#pragma unroll
        for (unsigned j = 0; j < 16; ++j) { const unsigned c = xb_ld(&bar[XB_XCNT(j)]); sum += c; cnt += (c > 0u) ? 1u : 0u; mine = (j == x) ? c : mine; }
        if (sum == G) break;
        __builtin_amdgcn_s_sleep(1);
        if ((++sp & 255u) == 0u) { if (xb_ld(&bar[XB_TMO])) break; if (sp > XB_SPIN_CAP) { atomicAdd(&bar[XB_TMO], 1u); break; } }
    }
    nloc = mine > 0u ? mine : 1u; nx = cnt > 0u ? cnt : 1u;
}
__device__ __forceinline__ void xcd_barrier(const XcdBarrier& b, int tid) {
    asm volatile("s_waitcnt vmcnt(0)" ::: "memory");
    __syncthreads();
    if (tid == 0) {
        unsigned* bar = b.bar;
        __builtin_amdgcn_s_waitcnt(0);
        unsigned nloc = b.st[0], nx = b.st[1];
        if (nloc == 0u) { xcd_barrier_complete(bar, b.x, nloc, nx); b.st[0] = nloc; b.st[1] = nx; }
        const unsigned old = xb_add(&bar[XB_XSUB(b.x)], 1u);
        const unsigned gen = old / nloc;
        if (old + 1u == (gen + 1u) * nloc) {
            __builtin_amdgcn_fence(__ATOMIC_RELEASE, "agent");
            asm volatile("s_waitcnt vmcnt(0)" ::: "memory");
            const unsigned og = xb_add(&bar[XB_TOP], 1u);
            const unsigned tg = og / nx;
            if (og + 1u == (tg + 1u) * nx) xb_add(&bar[XB_TOPGEN], 1u);
            else XB_SPIN(xb_ld(&bar[XB_TOPGEN]) == tg, bar);
            __builtin_amdgcn_fence(__ATOMIC_ACQUIRE, "agent");
            xb_add(&bar[XB_XGEN(b.x)], 1u);
            asm volatile("s_waitcnt vmcnt(0)" ::: "memory");
        } else {
            XB_SPIN(xb_ld(&bar[XB_XGEN(b.x)]) == gen, bar);
            __builtin_amdgcn_fence(__ATOMIC_ACQUIRE, "agent");
            asm volatile("s_waitcnt vmcnt(0)" ::: "memory");
        }
    }
    __syncthreads();
}

__device__ __forceinline__ int lane_id() { return (int)__builtin_amdgcn_mbcnt_hi(~0u, __builtin_amdgcn_mbcnt_lo(~0u, 0u)); }
__device__ __forceinline__ int lane_id_here() { int l; asm volatile("v_mbcnt_lo_u32_b32 %0, -1, 0\n\tv_mbcnt_hi_u32_b32 %0, -1, %0" : "=v"(l)); return l; }
__device__ __forceinline__ float bf2f(bf16_t b) { return __uint_as_float(((unsigned)b) << 16); }
__device__ __forceinline__ bf16_t f2bf(float f) { unsigned u = __float_as_uint(f); u += 0x7FFFu + ((u >> 16) & 1u); return (bf16_t)(u >> 16); }
__device__ __forceinline__ unsigned pk_bf16(float lo, float hi) { return (unsigned)f2bf(lo) | ((unsigned)f2bf(hi) << 16); }
typedef __bf16 bf16x2_t __attribute__((ext_vector_type(2)));
__device__ __forceinline__ unsigned cvt_pk_bf16(float lo, float hi) { return __builtin_bit_cast(unsigned, __builtin_convertvector((f32x2){lo, hi}, bf16x2_t)); }
__device__ __forceinline__ unsigned pk4_fp8(float a, float b, float c, float d) { int w = 0;
    a = __builtin_amdgcn_fmed3f(a, -448.0f, 448.0f); b = __builtin_amdgcn_fmed3f(b, -448.0f, 448.0f); c = __builtin_amdgcn_fmed3f(c, -448.0f, 448.0f); d = __builtin_amdgcn_fmed3f(d, -448.0f, 448.0f);
    w = __builtin_amdgcn_cvt_pk_fp8_f32(a, b, w, false); w = __builtin_amdgcn_cvt_pk_fp8_f32(c, d, w, true); return (unsigned)w; }
__device__ __forceinline__ float sigmoidf_(float x) { return __builtin_amdgcn_rcpf(1.0f + __expf(-x)); }
__device__ __forceinline__ float siluf_(float x) { return x * __builtin_amdgcn_rcpf(1.0f + __expf(-x)); }
__device__ __forceinline__ float wave_sum(float v) {
#pragma unroll
    for (int o = 32; o >= 1; o >>= 1) v += __shfl_xor(v, o);
    return v;
}
__device__ __forceinline__ float sum16(float v) {
    v += __shfl_xor(v, 1); v += __shfl_xor(v, 2); v += __shfl_xor(v, 4); v += __shfl_xor(v, 8); return v;
}
__device__ __forceinline__ void unpack4(u32x2 w, float (&f)[4]) {
    f[0] = __uint_as_float(w.x << 16); f[1] = __uint_as_float(w.x & 0xffff0000u); f[2] = __uint_as_float(w.y << 16); f[3] = __uint_as_float(w.y & 0xffff0000u);
}
__device__ __forceinline__ void unpack8(u32x4 w, float* f) {
    f[0] = __uint_as_float(w.x << 16); f[1] = __uint_as_float(w.x & 0xffff0000u); f[2] = __uint_as_float(w.y << 16); f[3] = __uint_as_float(w.y & 0xffff0000u);
    f[4] = __uint_as_float(w.z << 16); f[5] = __uint_as_float(w.z & 0xffff0000u); f[6] = __uint_as_float(w.w << 16); f[7] = __uint_as_float(w.w & 0xffff0000u);
}

struct Params {
    const float* in[35];
    float* out; unsigned char* ws;
    int ph_lo, ph_hi;
};
enum { I_X = 0, I_C, I_CTX, I_CCTX, I_N1G, I_N2G, I_MODW, I_MODB, I_WIN, I_WOUT, I_RPB, I_MUP, I_MUN, I_W0, I_W2, I_A0, I_A2, I_G2, I_KK, I_KA, I_RK, I_GNG, I_GNB,
       I_DWW, I_DWB, I_LNG, I_LNB, I_FG, I_FU, I_FD, I_ROUTER, I_MG, I_MU, I_MD, I_FINALG };

__device__ __forceinline__ int row_mi(int r) { return r < NLAT ? (r >> 12) : 8; }

namespace pg8 {
constexpr int BM = 256, BK = 64, HALF = 128, HTB = HALF * BK * 2, STAGE_BYTES = 8 * HTB, NXCD = 8, WGM = 8;
__device__ __forceinline__ int lds_byte(int r, int c) { const int st = (r >> 4) * 2 + (c >> 5), rr = r & 15, cc = c & 31, ob = rr * 64 + cc * 2; return st * 1024 + (ob ^ (((ob >> 9) & 1) << 5)); }
__device__ __forceinline__ void stage_rc(int b, int& R, int& C) { const int st = b / 1024, sb = b % 1024, swz = sb ^ (((sb >> 9) & 1) << 5); R = (st >> 1) * 16 + swz / 64; C = (st & 1) * 32 + (swz % 64) / 2; }
__device__ __forceinline__ int perm32(int rho) { const int n = rho >> 4, i = rho & 15; return 8 * (i >> 2) + 4 * n + (i & 3); }
struct Unit { int pm, pn, sub, ah, hb; };

struct TileOrder {
    int nM, nN, nwg, G, c, full;
    __device__ void init(int nM_, int nN_, int G_, int c_) { nM = nM_; nN = nN_; nwg = nM * nN; G = G_; c = c_; full = nwg; }
    __device__ void split_tail() { full = (nwg / G) * G; }
    __device__ bool next(int i, Unit& u) const {
        int L = i * G + c;
        u.sub = 0; u.ah = 0; u.hb = 0;
        if (L >= full + 4 * (nwg - full)) return false;
        if (L >= full) { const int j = L - full; L = full + (j >> 2); u.sub = 1; u.ah = (j >> 1) & 1; u.hb = j & 1; }
        int wgid = L; { const int q = nwg / NXCD, r = nwg % NXCD, xcd = wgid % NXCD, off = wgid / NXCD; wgid = (xcd < r ? xcd * (q + 1) : r * (q + 1) + (xcd - r) * q) + off; }
        const int nig = WGM * nN, gid = wgid / nig, fm = gid * WGM, gsz = (nM - fm) < WGM ? (nM - fm) : WGM;
        u.pm = fm + ((wgid % nig) % gsz); u.pn = (wgid % nig) / gsz; return true;
    }
};
struct DenseSched : TileOrder {
    const bf16_t* A; const bf16_t* Bt; int K;
    __device__ __forceinline__ const char* aptr(const Unit& u) const { return (const char*)A + (size_t)u.pm * BM * K * 2; }
    __device__ __forceinline__ const char* bptr(const Unit& u) const { return (const char*)Bt + (size_t)u.pn * BM * K * 2; }
    __device__ __forceinline__ const char* abase() const { return (const char*)A; }
    __device__ __forceinline__ int arow(const Unit&, int) const { return 0; }
};
struct MoeSched : TileOrder {
    static constexpr size_t e_stride = MOE8_E_BYTES; static constexpr const int* rowmap = nullptr;
    const bf16_t* A; const unsigned char* Bt0; int K; unsigned tw[4]; int T0;
    __device__ __forceinline__ void set_tstart(const int (&ts0)[9], const int (&ts1)[9]) {
        tw[0] = __builtin_amdgcn_readfirstlane((unsigned)ts0[1] | ((unsigned)ts0[2] << 8) | ((unsigned)ts0[3] << 16) | ((unsigned)ts0[4] << 24));
        tw[1] = __builtin_amdgcn_readfirstlane((unsigned)ts0[5] | ((unsigned)ts0[6] << 8) | ((unsigned)ts0[7] << 16) | (255u << 24));
        tw[2] = __builtin_amdgcn_readfirstlane((unsigned)ts1[1] | ((unsigned)ts1[2] << 8) | ((unsigned)ts1[3] << 16) | ((unsigned)ts1[4] << 24));
        tw[3] = __builtin_amdgcn_readfirstlane((unsigned)ts1[5] | ((unsigned)ts1[6] << 8) | ((unsigned)ts1[7] << 16) | (255u << 24));
        T0 = __builtin_amdgcn_readfirstlane(ts0[8]); }
    __device__ __forceinline__ bool next(int i, Unit& u) const { if (!TileOrder::next(i, u)) return false; const int pm = __builtin_amdgcn_readfirstlane(u.pm); u.pm = pm < T0 ? pm : (NROW / 256) + (pm - T0); return true; }
    __device__ __forceinline__ int expert(int pm) const { pm = __builtin_amdgcn_readfirstlane(pm); const bool p1 = pm >= NROW / 256; const int q = p1 ? pm - NROW / 256 : pm; const unsigned a = p1 ? tw[2] : tw[0], b = p1 ? tw[3] : tw[1]; int e = 0;
#pragma unroll
        for (int j = 0; j < 4; ++j) { e += (int)((unsigned)((int)((a >> (8 * j)) & 255u) - 1 - q) >> 31); e += (int)((unsigned)((int)((b >> (8 * j)) & 255u) - 1 - q) >> 31); }
        return __builtin_amdgcn_readfirstlane(e); }
    __device__ __forceinline__ const char* aptr(const Unit& u) const { return (const char*)A + (size_t)u.pm * BM * K * 2; }
    __device__ __forceinline__ const char* bptr(const Unit& u) const { return (const char*)Bt0 + (size_t)expert(u.pm) * e_stride + (size_t)u.pn * BM * K * 2; }
    __device__ __forceinline__ const char* abase() const { return (const char*)A; }
    __device__ __forceinline__ int arow(const Unit& u, int r) const { const int t = rowmap[u.pm * BM + r]; return t < 0 ? 0 : t; }
};

struct EpiBf16 {
    static constexpr bool PERM = true;
    bf16_t* O; int ldc; int nscale; float scale;
    __device__ __forceinline__ void operator()(const f32x4 (&acc)[2][2][4][2], const Unit& u, int wr, int wc, int fr, int fq, LAS unsigned char* scr) const {
        const int lane = fr + 16 * fq, lr = lane >> 2, lp = lane & 3;
        const float s = u.pn < nscale ? scale : 1.0f;
        bf16_t* base = O + (size_t)(u.pm * BM + wr * 64 + lr) * ldc + u.pn * BM + wc * 32 + lp * 8;
        LAS unsigned char* wp = scr + fr * 80 + fq * 16; const LAS unsigned char* rp = scr + lr * 80 + lp * 16;
#pragma unroll
        for (int ai = 0; ai < 2; ++ai)
#pragma unroll
            for (int m = 0; m < 4; ++m)
#pragma unroll
                for (int bj = 0; bj < 2; ++bj) { const f32x4 v0 = acc[ai][bj][m][0] * s, v1 = acc[ai][bj][m][1] * s;
                    u32x4 w; w.x = cvt_pk_bf16(v0[0], v0[1]); w.y = cvt_pk_bf16(v0[2], v0[3]); w.z = cvt_pk_bf16(v1[0], v1[1]); w.w = cvt_pk_bf16(v1[2], v1[3]);
                    *(LAS u32x4*)(wp + bj * 1280) = w;
                    __builtin_amdgcn_wave_barrier(); asm volatile("" ::: "memory");
                    const u32x4 t = *(const LAS u32x4*)(rp + bj * 1280);
                    __builtin_amdgcn_wave_barrier(); asm volatile("" ::: "memory");
                    *(u32x4*)(base + (size_t)(ai * HALF + m * 16) * ldc + bj * HALF) = t; }
    }
};
__device__ __forceinline__ f32x4 swiglu4(const f32x4& g, const f32x4& u, float c1, float c2) {
    const f32x4 t = g * c1; f32x4 r;
#pragma unroll
    for (int j = 0; j < 4; ++j) r[j] = __builtin_amdgcn_rcpf(1.0f + __builtin_amdgcn_exp2f(t[j]));
    return (g * u) * (r * c2);
}
struct EpiSwiGLU {
    static constexpr bool PERM = true;
    bf16_t* H; int ldh;
    __device__ __forceinline__ void operator()(const f32x4 (&acc)[2][2][4][2], const Unit& u, int wr, int wc, int fr, int fq, LAS unsigned char* scr) const {
        const int row0 = u.pm * BM + wr * 64 + fr, col0 = u.pn * HALF + wc * 32 + 8 * fq;
#pragma unroll
        for (int ai = 0; ai < 2; ++ai)
#pragma unroll
            for (int m = 0; m < 4; ++m) { bf16_t* rowp = H + (size_t)(row0 + ai * HALF + m * 16) * ldh + col0;
                const f32x4 h0 = swiglu4(acc[ai][0][m][0], acc[ai][1][m][0], -1.44269504f, 1.0f), h1 = swiglu4(acc[ai][0][m][1], acc[ai][1][m][1], -1.44269504f, 1.0f);
                u32x4 w; w.x = cvt_pk_bf16(h0[0], h0[1]); w.y = cvt_pk_bf16(h0[2], h0[3]); w.z = cvt_pk_bf16(h1[0], h1[1]); w.w = cvt_pk_bf16(h1[2], h1[3]);
                *(u32x4*)rowp = w; }
    }
};
template <bool STG>
struct EpiSwiGLU8T {
    static constexpr bool PERM = true;
    unsigned char* H; int ldh; float inv;
    __device__ __forceinline__ void operator()(const f32x4 (&acc)[2][2][4][2], const Unit& u, int wr, int wc, int fr, int fq, LAS unsigned char* scr) const {
        const int lane = fr + 16 * fq, lr = lane >> 2, lp = lane & 3;
        unsigned char* base = H + (size_t)(u.pm * BM + wr * 64 + lr) * ldh + u.pn * HALF + wc * 32 + lp * 8;
        LAS unsigned char* wp = scr + fr * 40 + fq * 8; const LAS unsigned char* rp = scr + lr * 40 + lp * 8;
        float c1 = -1.44269504f * inv, c2 = inv * inv; asm volatile("" : "+v"(c1), "+v"(c2));
#pragma unroll
        for (int ai = 0; ai < 2; ++ai)
#pragma unroll
            for (int m = 0; m < 4; ++m) {
                const f32x4 h0 = swiglu4(acc[ai][0][m][0], acc[ai][1][m][0], c1, c2), h1 = swiglu4(acc[ai][0][m][1], acc[ai][1][m][1], c1, c2);
                u32x2 w; w.x = pk4_fp8(h0[0], h0[1], h0[2], h0[3]); w.y = pk4_fp8(h1[0], h1[1], h1[2], h1[3]);
                if constexpr (STG) {
                    *(LAS u32x2*)(wp + (m & 1) * 640) = w;
                    __builtin_amdgcn_wave_barrier(); asm volatile("" ::: "memory");
                    const u32x2 t = *(const LAS u32x2*)(rp + (m & 1) * 640);
                    __builtin_amdgcn_wave_barrier(); asm volatile("" ::: "memory");
                    *(u32x2*)(base + (size_t)(ai * HALF + m * 16) * ldh) = t;
                } else *(u32x2*)(H + (size_t)(u.pm * BM + wr * 64 + fr + ai * HALF + m * 16) * ldh + u.pn * HALF + wc * 32 + 8 * fq) = w; }
    }
};
struct EpiRes {
    static constexpr bool PERM = false;
    const float* resL; const float* resC; float* outL; float* outC; const float* gvec;
    float inv = 1.0f;
    __device__ __forceinline__ void operator()(const f32x4 (&acc)[2][2][4][2], const Unit& u, int wr, int wc, int fr, int fq, LAS unsigned char* scr) const {
        const int r0 = u.pm * BM; const bool lat = r0 < NLAT;
        const float* res = lat ? resL + (size_t)r0 * D : resC + (size_t)(r0 - NLAT) * D;
        float* out = lat ? outL + (size_t)r0 * D : outC + (size_t)(r0 - NLAT) * D;
        const float* gv = gvec + (size_t)(lat ? (r0 >> 12) : 8) * MODW;
        const int rl = wr * 64 + fr, col0 = u.pn * BM + wc * 32 + 4 * fq;
        const int nq = u.sub ? 1 : 2, ro = u.sub ? u.ah * HALF : 0, co = u.sub ? u.hb * HALF : 0;
        const int lane = fr + 16 * fq, rr = lane >> 3, pc = lane & 7;
        const size_t cb = (size_t)(wr * 64 + ro + rr) * D + u.pn * BM + co + wc * 32 + pc * 4;
        f32x4 gq[2];
#pragma unroll
        for (int bj = 0; bj < 2; ++bj) gq[bj] = *(const f32x4*)(gv + u.pn * BM + co + (u.sub ? 0 : bj * HALF) + wc * 32 + pc * 4) * inv;
        LAS unsigned char* wp = scr + fr * 144 + fq * 16; const LAS unsigned char* rp = scr + rr * 144 + pc * 16;
        (void)rl; (void)col0;
#pragma unroll
        for (int ai = 0; ai < 2; ++ai) if (ai < nq) {
            f32x4 cl[4][2][2];
#pragma unroll
            for (int m = 0; m < 4; ++m)
#pragma unroll
                for (int bj = 0; bj < 2; ++bj) if (bj < nq) { const float* p = res + cb + (size_t)(ai * HALF + m * 16) * D + bj * HALF; cl[m][bj][0] = *(const f32x4*)p; cl[m][bj][1] = *(const f32x4*)(p + (size_t)8 * D); }
#pragma unroll
            for (int m = 0; m < 4; ++m)
#pragma unroll
                for (int bj = 0; bj < 2; ++bj) if (bj < nq) {
                    *(LAS f32x4*)wp = acc[ai][bj][m][0]; *(LAS f32x4*)(wp + 64) = acc[ai][bj][m][1];
                    __builtin_amdgcn_wave_barrier(); asm volatile("" ::: "memory");
                    const f32x4 a0 = *(const LAS f32x4*)rp, a1 = *(const LAS f32x4*)(rp + 8 * 144);
                    __builtin_amdgcn_wave_barrier(); asm volatile("" ::: "memory");
                    float* q = out + cb + (size_t)(ai * HALF + m * 16) * D + bj * HALF;
                    *(f32x4*)q = cl[m][bj][0] + gq[bj] * a0; *(f32x4*)(q + (size_t)8 * D) = cl[m][bj][1] + gq[bj] * a1; }
        }
    }
};
struct EpiMoeY {
    static constexpr bool PERM = true;
    bf16_t* Y; float scale;
    __device__ __forceinline__ void operator()(const f32x4 (&acc)[2][2][4][2], const Unit& u, int wr, int wc, int fr, int fq, LAS unsigned char* scr) const {
        const int nq = u.sub ? 1 : 2;
        const int lane = fr + 16 * fq, lr = lane >> 2, lp = lane & 3;
        bf16_t* base = Y + (size_t)(u.pm * BM + wr * 64 + lr + (u.sub ? u.ah * HALF : 0)) * D + u.pn * BM + wc * 32 + lp * 8 + (u.sub ? u.hb * HALF : 0);
        LAS unsigned char* wp = scr + fr * 80 + fq * 16; const LAS unsigned char* rp = scr + lr * 80 + lp * 16;
        float s = scale; asm volatile("" : "+v"(s));
#pragma unroll
        for (int ai = 0; ai < 2; ++ai) if (ai < nq)
#pragma unroll
            for (int m = 0; m < 4; ++m)
#pragma unroll
                for (int bj = 0; bj < 2; ++bj) if (bj < nq) { const f32x4 v0 = acc[ai][bj][m][0] * s, v1 = acc[ai][bj][m][1] * s;
                    u32x4 w; w.x = cvt_pk_bf16(v0[0], v0[1]); w.y = cvt_pk_bf16(v0[2], v0[3]); w.z = cvt_pk_bf16(v1[0], v1[1]); w.w = cvt_pk_bf16(v1[2], v1[3]);
                    *(LAS u32x4*)(wp + bj * 1280) = w;
                    __builtin_amdgcn_wave_barrier(); asm volatile("" ::: "memory");
                    const u32x4 t = *(const LAS u32x4*)(rp + bj * 1280);
                    __builtin_amdgcn_wave_barrier(); asm volatile("" ::: "memory");
                    *(u32x4*)(base + (size_t)(ai * HALF + m * 16) * D + bj * HALF) = t; }
    }
};

__device__ __forceinline__ const char* uni_ptr(const char* p) { const unsigned long long v = (unsigned long long)p; const unsigned lo = __builtin_amdgcn_readfirstlane((unsigned)v), hi = __builtin_amdgcn_readfirstlane((unsigned)(v >> 32)); return (const char*)(((unsigned long long)hi << 32) | lo); }
typedef int v8i32_t __attribute__((ext_vector_type(8)));
__device__ __forceinline__ v8i32_t pg8_cat(const bf16x8& a, const bf16x8& b) { const u32x4 x = __builtin_bit_cast(u32x4, a), y = __builtin_bit_cast(u32x4, b); v8i32_t r; r[0] = (int)x[0]; r[1] = (int)x[1]; r[2] = (int)x[2]; r[3] = (int)x[3]; r[4] = (int)y[0]; r[5] = (int)y[1]; r[6] = (int)y[2]; r[7] = (int)y[3]; return r; }
template <class Epi, class Sched, bool GATHER, bool FP8 = false>
__device__ __forceinline__ void gemm_phase(LAS unsigned char* lds, const int K, const Sched& S, const Epi& E, const int wave_) {
    int tid_ = wave_ * 64 + lane_id_here(); asm volatile("" : "+v"(tid_));
    const int tid = tid_, wid = wave_, lane = tid & 63, wr = wid >> 2, wc = wid & 3, fr = lane & 15, fq = lane >> 4;
    const int nt = K / BK;
    unsigned voffA[2], voffB[2]; int RA[2], CA[2];
#pragma unroll
    for (int i = 0; i < 2; ++i) { int R, C; stage_rc(tid * 16 + i * 8192, R, C); const int Rb = Epi::PERM ? ((R & ~31) + perm32(R & 31)) : R;
        voffA[i] = (unsigned)(R * K + C) * 2u; voffB[i] = (unsigned)(Rb * K + C) * 2u; RA[i] = R; CA[i] = C; }
    const size_t kstep = (size_t)(BK * 2);
    const size_t hstep = (size_t)HALF * K * 2;
    const unsigned ldsw = (unsigned)wid * 1024u;
    const int aoff = lds_byte(wr * 64 + fr, fq * 8), boff = lds_byte(wc * 32 + fr, fq * 8);
#define PG8_SA(b, h) (((b) * 2 + (h)) * HTB)
#define PG8_SB(b, h) ((4 + (b) * 2 + (h)) * HTB)
#define PG8_STAGE(bufoff, gbase, voff) do { _Pragma("unroll") for (int _i = 0; _i < 2; ++_i) { unsigned _o = (voff)[_i]; const char* _g = (const char*)(gbase); asm volatile("" : "+v"(_o), "+s"(_g)); \
        __builtin_amdgcn_global_load_lds((const unsigned*)(_g + _o), (LAS unsigned*)(lds + (bufoff) + ldsw + _i * 8192), 16, 0, 0); } } while (0)
#define PG8_LDA(dst, b, h) do { _Pragma("unroll") for (int m = 0; m < 4; ++m) _Pragma("unroll") for (int k = 0; k < 2; ++k) dst[m][k] = *(const LAS bf16x8*)(lds + PG8_SA(b, h) + aoff + m * 2048 + k * 1024); } while (0)
#define PG8_LDB(dst, b, h) do { _Pragma("unroll") for (int n = 0; n < 2; ++n) _Pragma("unroll") for (int k = 0; k < 2; ++k) dst[n][k] = *(const LAS bf16x8*)(lds + PG8_SB(b, h) + boff + n * 2048 + k * 1024); } while (0)
#define PG8_MMA(ai, bj, At, Bt) do { __builtin_amdgcn_s_setprio(1); _Pragma("unroll") for (int m = 0; m < 4; ++m) _Pragma("unroll") for (int n = 0; n < 2; ++n) { \
        if constexpr (FP8) { acc[ai][bj][m][n] = __builtin_amdgcn_mfma_scale_f32_16x16x128_f8f6f4(pg8_cat(Bt[n][0], Bt[n][1]), pg8_cat(At[m][0], At[m][1]), acc[ai][bj][m][n], 0, 0, 0, 0, 0, 0); } \
        else { _Pragma("unroll") for (int k = 0; k < 2; ++k) acc[ai][bj][m][n] = __builtin_amdgcn_mfma_f32_16x16x32_bf16(Bt[n][k], At[m][k], acc[ai][bj][m][n], 0, 0, 0); } } \
        __builtin_amdgcn_s_setprio(0); } while (0)
#define PG8_WAIT_V(n) asm volatile("s_waitcnt vmcnt(" #n ")" ::: "memory")
#define PG8_WAIT_L(n) asm volatile("s_waitcnt lgkmcnt(" #n ")" ::: "memory")
#define PG8_BAR __builtin_amdgcn_s_barrier()
#define PG8_SCHED __builtin_amdgcn_sched_barrier(0)
#define PG8_STAGE_A(bufoff, TS, H) do { if constexpr (GATHER) { PG8_STAGE(bufoff, gA##TS, oA##TS[H]); } else { PG8_STAGE(bufoff, a##TS + (H) * hA##TS, voffA); } } while (0)
    Unit cur, nxt; int ui = 0;
    if (!S.next(0, cur)) return;
    f32x4 acc[2][2][4][2];
#pragma unroll
    for (int a = 0; a < 2; ++a)
#pragma unroll
        for (int b = 0; b < 2; ++b)
#pragma unroll
            for (int m = 0; m < 4; ++m)
#pragma unroll
                for (int n = 0; n < 2; ++n) acc[a][b][m][n] = (f32x4){0.f, 0.f, 0.f, 0.f};
    bf16x8 At[4][2], B0[2][2], B1[2][2];
    const char* Abase = uni_ptr(S.abase());
    unsigned aoC[2][2] = {{0u, 0u}, {0u, 0u}}, aoN[2][2] = {{0u, 0u}, {0u, 0u}};
    if constexpr (GATHER) {
#pragma unroll
        for (int h = 0; h < 2; ++h)
#pragma unroll
            for (int i = 0; i < 2; ++i) aoC[h][i] = (unsigned)(S.arow(cur, h * HALF + RA[i]) * K + CA[i]) * 2u;
    }
    size_t hAc = cur.sub ? 0 : hstep, hBc = hAc, hAn = hAc, hBn = hAc;
    const char* cA = GATHER ? Abase : uni_ptr(S.aptr(cur) + (cur.sub ? cur.ah * hstep : 0)); const char* cB = uni_ptr(S.bptr(cur) + (cur.sub ? cur.hb * hstep : 0));
    if constexpr (GATHER) {
        PG8_STAGE(PG8_SB(0, 0), cB, voffB); PG8_STAGE(PG8_SA(0, 0), Abase, aoC[0]); PG8_STAGE(PG8_SB(0, 1), cB + hstep, voffB); PG8_STAGE(PG8_SA(0, 1), Abase, aoC[1]);
    } else {
        PG8_STAGE(PG8_SB(0, 0), cB, voffB); PG8_STAGE(PG8_SA(0, 0), cA, voffA); PG8_STAGE(PG8_SB(0, 1), cB + hBc, voffB); PG8_STAGE(PG8_SA(0, 1), cA + hAc, voffA);
    }
    if (wr == 1) PG8_BAR;
    PG8_WAIT_V(4); PG8_BAR;
    if constexpr (GATHER) {
        PG8_STAGE(PG8_SB(1, 0), cB + kstep, voffB); PG8_STAGE(PG8_SA(1, 0), Abase + kstep, aoC[0]); PG8_STAGE(PG8_SB(1, 1), cB + hstep + kstep, voffB);
    } else {
        PG8_STAGE(PG8_SB(1, 0), cB + kstep, voffB); PG8_STAGE(PG8_SA(1, 0), cA + kstep, voffA); PG8_STAGE(PG8_SB(1, 1), cB + hBc + kstep, voffB);
    }
    PG8_WAIT_V(6); PG8_BAR;
    for (;;) {
        constexpr int REP_KLOOP = FP8 ? REP_KLOOP_F8 : REP_KLOOP_BF;
        const bool has_next = S.next((ui + 1) / REP_KLOOP, nxt);
        const char* nA = uni_ptr(has_next ? (GATHER ? Abase : S.aptr(nxt) + (nxt.sub ? nxt.ah * hstep : 0)) : cA); const char* nB = uni_ptr(has_next ? S.bptr(nxt) + (nxt.sub ? nxt.hb * hstep : 0) : cB);
        hAn = has_next ? (nxt.sub ? 0 : hstep) : hAc; hBn = hAn;
        if constexpr (GATHER) {
            if (has_next) {
#pragma unroll
                for (int h = 0; h < 2; ++h)
#pragma unroll
                    for (int i = 0; i < 2; ++i) aoN[h][i] = (unsigned)(S.arow(nxt, h * HALF + RA[i]) * K + CA[i]) * 2u;
            } else {
#pragma unroll
                for (int h = 0; h < 2; ++h)
#pragma unroll
                    for (int i = 0; i < 2; ++i) aoN[h][i] = aoC[h][i];
            }
        }
        for (int t = 0; t < nt; t += 2) {
            const bool last = (t == nt - 2);
            const char* a1 = cA + (size_t)(t + 1) * kstep;
            const char* a2 = last ? nA : cA + (size_t)(t + 2) * kstep; const char* b2 = last ? nB : cB + (size_t)(t + 2) * kstep;
            const char* a3 = a2 + kstep; const char* b3 = b2 + kstep;
            const size_t hA1 = hAc, hA2 = last ? hAn : hAc, hA3 = hA2, hB2 = last ? hBn : hBc; (void)hA1; (void)hA3;
            const char* gA1 = Abase + (size_t)(t + 1) * kstep; const char* gA2 = Abase + (last ? (size_t)0 : (size_t)(t + 2) * kstep); const char* gA3 = gA2 + kstep;
            unsigned oA1[2][2], oA2[2][2], oA3[2][2];
#pragma unroll
            for (int h = 0; h < 2; ++h)
#pragma unroll
                for (int i = 0; i < 2; ++i) { oA1[h][i] = aoC[h][i]; oA2[h][i] = last ? aoN[h][i] : aoC[h][i]; oA3[h][i] = oA2[h][i]; }
            (void)a1; (void)a3; (void)gA1; (void)gA3; (void)oA1; (void)oA3;
            PG8_LDB(B0, 0, 0); PG8_SCHED; PG8_LDA(At, 0, 0); PG8_STAGE_A(PG8_SA(1, 1), 1, 1);
            PG8_WAIT_L(8); PG8_BAR; PG8_WAIT_L(0); PG8_MMA(0, 0, At, B0); PG8_BAR; PG8_SCHED;
            PG8_LDB(B1, 0, 1); PG8_STAGE(PG8_SB(0, 0), b2, voffB);
            PG8_BAR; PG8_WAIT_L(0); if (!cur.sub) PG8_MMA(0, 1, At, B1); PG8_BAR;
            PG8_LDA(At, 0, 1); PG8_STAGE_A(PG8_SA(0, 0), 2, 0);
            PG8_BAR; PG8_WAIT_L(0); if (!cur.sub) PG8_MMA(1, 0, At, B0); PG8_BAR; PG8_SCHED;
            PG8_STAGE(PG8_SB(0, 1), b2 + hB2, voffB);
            PG8_WAIT_V(6); PG8_BAR; if (!cur.sub) PG8_MMA(1, 1, At, B1); PG8_BAR;
            PG8_LDB(B0, 1, 0); PG8_SCHED; PG8_LDA(At, 1, 0); PG8_STAGE_A(PG8_SA(0, 1), 2, 1);
            PG8_WAIT_L(8); PG8_BAR; PG8_WAIT_L(0); PG8_MMA(0, 0, At, B0); PG8_BAR; PG8_SCHED;
            PG8_LDB(B1, 1, 1); PG8_STAGE(PG8_SB(1, 0), b3, voffB);
            PG8_BAR; PG8_WAIT_L(0); if (!cur.sub) PG8_MMA(0, 1, At, B1); PG8_BAR;
            PG8_LDA(At, 1, 1); PG8_STAGE_A(PG8_SA(1, 0), 3, 0);
            PG8_BAR; PG8_WAIT_L(0); if (!cur.sub) PG8_MMA(1, 0, At, B0); PG8_BAR; PG8_SCHED;
            PG8_STAGE(PG8_SB(1, 1), b3 + hB2, voffB);
            PG8_WAIT_V(6); PG8_BAR; if (!cur.sub) PG8_MMA(1, 1, At, B1); PG8_BAR;
        }
        if (REP_KLOOP == 1 || (ui % REP_KLOOP) == REP_KLOOP - 1) { int t2 = tid; asm volatile("" : "+v"(t2)); const int l2 = t2 & 63; E(acc, cur, wr, wc, l2 & 15, l2 >> 4, lds + STAGE_BYTES + wid * 4064);
            if constexpr (Epi::PERM && REP_EPI > 1) { for (int rep = 1; rep < REP_EPI; ++rep) { asm volatile("" ::: "memory"); E(acc, cur, wr, wc, l2 & 15, l2 >> 4, lds + STAGE_BYTES + wid * 4064); } } }
        if (!has_next) break;
#pragma unroll
        for (int a = 0; a < 2; ++a)
#pragma unroll
            for (int b = 0; b < 2; ++b)
#pragma unroll
                for (int m = 0; m < 4; ++m)
#pragma unroll
                    for (int n = 0; n < 2; ++n) acc[a][b][m][n] = (f32x4){0.f, 0.f, 0.f, 0.f};
        cur = nxt; cA = nA; cB = nB; hAc = hAn; hBc = hBn; ++ui;
        if constexpr (GATHER) {
#pragma unroll
            for (int h = 0; h < 2; ++h)
#pragma unroll
                for (int i = 0; i < 2; ++i) aoC[h][i] = aoN[h][i];
        }
    }
    PG8_WAIT_V(0);
    if (wr == 0) PG8_BAR;
    PG8_BAR;
#undef PG8_SA
#undef PG8_SB
#undef PG8_STAGE
#undef PG8_STAGE_A
#undef PG8_LDA
#undef PG8_LDB
#undef PG8_MMA
#undef PG8_WAIT_V
#undef PG8_WAIT_L
#undef PG8_BAR
#undef PG8_SCHED
}
}

struct Frame {
    LAS unsigned char* lds; int tid, lane, wave, G, bid, gw, nw;
    unsigned char* ws;
};
extern __shared__ __attribute__((aligned(16))) unsigned char lds_raw[];
typedef const __attribute__((address_space(4))) Params* KP;
__device__ __forceinline__ Params load_params(const void* kp_) {
    const unsigned long long v = (unsigned long long)kp_;
    const unsigned lo = __builtin_amdgcn_readfirstlane((unsigned)v), hi = __builtin_amdgcn_readfirstlane((unsigned)(v >> 32));
    KP kp = (KP)(((unsigned long long)hi << 32) | lo);
    Params P;
#pragma unroll
    for (int i = 0; i < 35; ++i) P.in[i] = kp->in[i];
    P.out = kp->out; P.ws = kp->ws; P.ph_lo = kp->ph_lo; P.ph_hi = kp->ph_hi;
    return P;
}
#define PHASE static __attribute__((noinline)) __device__ void
#define PHASE_INL static __device__ __forceinline__ void
__device__ __forceinline__ Frame make_frame(unsigned char* ws, int wave_) {
    Frame F; F.lds = (LAS unsigned char*)lds_raw; F.wave = __builtin_amdgcn_readfirstlane(wave_);
    int t_ = F.wave * 64 + lane_id_here(); asm volatile("" : "+v"(t_));
    F.tid = t_; F.lane = F.tid & 63;
    F.G = gridDim.x; F.bid = blockIdx.x; F.gw = F.bid * NWAVES + F.wave; F.nw = F.G * NWAVES; F.ws = ws; return F;
}
__device__ __forceinline__ Frame sub_frame(Frame F, int bid, int G) { F.bid = bid; F.G = G; F.gw = F.bid * NWAVES + F.wave; F.nw = F.G * NWAVES; return F; }
#define PHASE_ENTER const Params P = load_params(kp_); const Frame F = make_frame(P.ws, wv_)

struct ConvTile { const float* src; unsigned char* dst; int K, N, mode, tt, fp8; float scale; };
__device__ __forceinline__ void conv_load(const ConvTile& c, int lane, f32x4 (&v)[16]) {
    const int tn = c.N >> 6, k0 = (c.tt / tn) * 64, n0 = (c.tt % tn) * 64;
#pragma unroll
    for (int i = 0; i < 16; ++i) { const int row = i * 4 + (lane >> 4), c4 = (lane & 15) * 4; v[i] = *(const f32x4*)(c.src + (size_t)(k0 + row) * c.N + n0 + c4); }
}
__device__ __forceinline__ void conv_emit(const ConvTile& c, const LAS float* tile, int lane) {
    const int tn = c.N >> 6, k0 = (c.tt / tn) * 64, n0 = (c.tt % tn) * 64;
#pragma unroll 2
    for (int i = 0; i < 8; ++i) { const int n = i * 8 + (lane >> 3), kc = (lane & 7) * 8;
        float f[8];
#pragma unroll
        for (int j = 0; j < 8; ++j) f[j] = tile[(kc + j) * 65 + n] * c.scale;
        const int ng = n0 + n; const int drow = c.mode == 0 ? ng : ((ng >> 7) * 256 + (c.mode == 2 ? 128 : 0) + (ng & 127));
        if (c.mode == 3) {
            const int kabs = k0 + kc, KB = c.K >> 5, hh = ng >> 6, cp = ng & 63, tq = 2 * (cp >> 5) + ((cp >> 2) & 1), tkk = 4 * ((cp >> 3) & 3) + (cp & 3);
            const size_t idx = ((size_t)((hh * 4 + tq) * KB + (kabs >> 5)) * 64 + (tkk + 16 * ((kabs >> 3) & 3))) * 8;
            u32x4 w; w.x = pk_bf16(f[0], f[1]); w.y = pk_bf16(f[2], f[3]); w.z = pk_bf16(f[4], f[5]); w.w = pk_bf16(f[6], f[7]); *(u32x4*)(c.dst + idx * 2) = w; }
        else if (c.fp8) { u32x2 w; w.x = pk4_fp8(f[0], f[1], f[2], f[3]); w.y = pk4_fp8(f[4], f[5], f[6], f[7]); *(u32x2*)(c.dst + (size_t)drow * c.K + k0 + kc) = w; }
        else { u32x4 w; w.x = pk_bf16(f[0], f[1]); w.y = pk_bf16(f[2], f[3]); w.z = pk_bf16(f[4], f[5]); w.w = pk_bf16(f[6], f[7]); *(u32x4*)(c.dst + ((size_t)drow * c.K + k0 + kc) * 2) = w; } }
}
template <class Decode>
__device__ __forceinline__ void conv_run(const Frame& F, int total, const Decode& decode) {
    LAS float* tile = (LAS float*)(F.lds + F.wave * (64 * 65 * 4)); const int lane = F.lane;
    int t = F.gw; if (t >= total) return;
    ConvTile c = decode(t); f32x4 v[16]; conv_load(c, lane, v);
    for (;;) {
#pragma unroll
        for (int i = 0; i < 16; ++i) { const int row = i * 4 + (lane >> 4), c4 = (lane & 15) * 4; tile[row * 65 + c4 + 0] = v[i][0]; tile[row * 65 + c4 + 1] = v[i][1]; tile[row * 65 + c4 + 2] = v[i][2]; tile[row * 65 + c4 + 3] = v[i][3]; }
        __builtin_amdgcn_wave_barrier(); asm volatile("s_waitcnt lgkmcnt(0)" ::: "memory");
        const int tnext = t + F.nw; const bool more = tnext < total; ConvTile cn = c;
        if (more) { cn = decode(tnext); conv_load(cn, lane, v); }
        conv_emit(c, tile, lane);
        __builtin_amdgcn_wave_barrier(); asm volatile("s_waitcnt lgkmcnt(0)" ::: "memory");
        if (!more) break;
        c = cn; t = tnext;
    }
}

__device__ __forceinline__ void phase_prologue(const Frame& F, const Params& P) {
    float* modv = (float*)(F.ws + WS_MODV);
    LAS float* s = (LAS float*)F.lds;
    LAS float* red = (LAS float*)(F.lds + 9 * 1024 * 4);
    for (int cb = F.bid; cb < (2 * MODW) / 64; cb += F.G) {
        for (int i = F.tid; i < 9 * 1024; i += NTHREADS) { const int mi = i >> 10, k = i & 1023; const float c = mi < 8 ? P.in[I_C][mi * D + k] : P.in[I_CCTX][k]; s[i] = siluf_(c); }
        __syncthreads();
        const int cg = F.lane & 15, kr = F.lane >> 4;
        const int colg = cb * 64 + 4 * cg, l = colg / MODW, col = colg % MODW;
        const float* w = P.in[I_MODW] + (size_t)l * D * MODW + col;
        f32x4 acc[9];
#pragma unroll
        for (int mi = 0; mi < 9; ++mi) acc[mi] = (f32x4){0.f, 0.f, 0.f, 0.f};
        const int kb = F.wave * 128 + kr;
#pragma unroll 8
        for (int i = 0; i < 32; ++i) { const int k = kb + 4 * i; const f32x4 wv = *(const f32x4*)(w + (size_t)k * MODW);
#pragma unroll
            for (int mi = 0; mi < 9; ++mi) acc[mi] += wv * s[mi * 1024 + k]; }
#pragma unroll
        for (int mi = 0; mi < 9; ++mi) *(LAS f32x4*)(red + (((F.wave * 4 + kr) * 9 + mi) * 64 + 4 * cg)) = acc[mi];
        __syncthreads();
        for (int i = F.tid; i < 9 * 64; i += NTHREADS) { const int mi = i >> 6, ln = i & 63; float a = 0.f;
#pragma unroll
            for (int w32 = 0; w32 < 32; ++w32) a += red[(w32 * 9 + mi) * 64 + ln];
            const int cg2 = cb * 64 + ln, l2 = cg2 / MODW, c2 = cg2 % MODW;
            modv[((size_t)l2 * 9 + mi) * MODW + c2] = a + P.in[I_MODB][l2 * MODW + c2]; }
        __syncthreads();
    }
    conv_run(F, 4352, [&](int t) { ConvTile c; c.fp8 = 0; c.scale = 1.0f; c.mode = 0;
        if (t < 1664) { const int l = t >= 832 ? 1 : 0; c.tt = t - l * 832; c.src = P.in[I_WIN] + (size_t)l * D * INW; c.dst = F.ws + WS_BTIN + (size_t)l * INW * D * 2; c.K = D; c.N = INW; }
        else if (t < 2176) { const int u = t - 1664, l = u >= 256 ? 1 : 0; c.tt = u - l * 256; c.src = P.in[I_WOUT] + (size_t)l * D * D; c.dst = F.ws + WS_BTOUT + (size_t)l * D * D * 2; c.K = D; c.N = D; }
        else if (t < 2880) { c.tt = t - 2176; c.src = P.in[I_FG]; c.dst = F.ws + WS_BTGU; c.K = D; c.N = DFF; c.mode = 1; }
        else if (t < 3584) { c.tt = t - 2880; c.src = P.in[I_FU]; c.dst = F.ws + WS_BTGU; c.K = D; c.N = DFF; c.mode = 2; }
        else if (t < 4288) { c.tt = t - 3584; c.src = P.in[I_FD]; c.dst = F.ws + WS_BTDN; c.K = DFF; c.N = D; c.fp8 = 1; c.scale = FFN8_DN_SCALE; }
        else { const int u = t - 4288, ld = u >> 4, r = u & 15; unsigned char* base = F.ws + WS_LORA + (size_t)ld * LORA_LD_BYTES; c.N = 256; c.mode = 3;
            if (r < 4) { c.tt = r; c.src = P.in[I_W2] + (size_t)ld * 64 * 256; c.dst = base; c.K = 64; }
            else if (r < 8) { c.tt = r - 4; c.src = P.in[I_A2] + (size_t)ld * 64 * 256; c.dst = base + 256 * 64 * 2; c.K = 64; }
            else { c.tt = r - 8; c.src = P.in[I_G2] + (size_t)ld * 128 * 256; c.dst = base + 2 * 256 * 64 * 2; c.K = 128; } }
        return c; });
}
__device__ __forceinline__ void phase_moe_convert(const Frame& F, const Params& P) {
    conv_run(F, NEXP * 3 * 896, [&](int t) { ConvTile c; c.fp8 = 1;
        const int e = t / 2688, r = t - e * 2688, j = r / 896; c.tt = r - j * 896;
        unsigned char* gu = F.ws + WS_MOE + (size_t)e * MOE8_E_BYTES;
        if (j < 2) { c.src = (j == 0 ? P.in[I_MG] : P.in[I_MU]) + (size_t)e * D * DFE; c.dst = gu; c.K = D; c.N = DFE; c.mode = 1 + j; c.scale = MOE8_GU_SCALE; }
        else { c.src = P.in[I_MD] + (size_t)e * DFE * D; c.dst = gu + MOE8_GU_BYTES; c.K = DFE; c.N = D; c.mode = 0; c.scale = MOE8_DN_SCALE; }
        return c; });
}

template <bool ROUTER>
__device__ __forceinline__ void phase_norm(const Frame& F, const Params& P, int l, int which, int nrows, const float* srcL, const float* srcC) {
    const float* g = (which == 0 ? P.in[I_N1G] : P.in[I_N2G]) + l * D;
    const float* modv = (const float*)(F.ws + WS_MODV) + (size_t)l * 9 * MODW + (which == 0 ? 0 : 3 * D);
    bf16_t* HL = (bf16_t*)(F.ws + WS_HL);
    LAS float* rt = (LAS float*)F.lds;
    LAS unsigned* lcnt = (LAS unsigned*)(F.lds + D * NEXP * 4);
    if (ROUTER) {
        for (int i = F.tid; i < D * NEXP; i += NTHREADS) { const int col = i >> 3, e = i & 7; rt[((((col >> 8) * 4 + (col & 3)) * 2 + (e >> 2)) * 64 + ((col >> 2) & 63)) * 4 + (e & 3)] = P.in[I_ROUTER][i]; }
        if (F.tid < 16) lcnt[F.tid] = 0u;
        __syncthreads();
    }
    const int lane = F.lane;
    const int RB = ((nrows + F.G - 1) / F.G + 7) & ~7, rbeg = F.bid * RB, rend = min(rbeg + RB, nrows);
    f32x4 xn[4], mA[4], mB[4]; int cur_mi = -1;
    { const int r = rbeg + F.wave < rend ? rbeg + F.wave : 0; const float* xr = r < NLAT ? srcL + (size_t)r * D : srcC + (size_t)(r - NLAT) * D;
#pragma unroll
      for (int j = 0; j < 4; ++j) xn[j] = *(const f32x4*)(xr + j * 256 + lane * 4); }
    for (int r = rbeg + F.wave; r < rend; r += 8) {
        { const int mi = row_mi(r);
          if (mi != cur_mi) { cur_mi = mi; const float* mv = modv + (size_t)mi * MODW;
#pragma unroll
              for (int j = 0; j < 4; ++j) { const int c = j * 256 + lane * 4; const f32x4 gg = *(const f32x4*)(g + c), sc = *(const f32x4*)(mv + D + c); mA[j] = gg * (sc + 1.0f); mB[j] = *(const f32x4*)(mv + c); } } }
        f32x4 x[4]; float ss = 0.f;
#pragma unroll
        for (int j = 0; j < 4; ++j) x[j] = xn[j];
        { const int rn = r + 8 < rend ? r + 8 : r; const float* xr = rn < NLAT ? srcL + (size_t)rn * D : srcC + (size_t)(rn - NLAT) * D;
#pragma unroll
          for (int j = 0; j < 4; ++j) xn[j] = *(const f32x4*)(xr + j * 256 + lane * 4); }
#pragma unroll
        for (int j = 0; j < 4; ++j) ss += x[j][0] * x[j][0] + x[j][1] * x[j][1] + x[j][2] * x[j][2] + x[j][3] * x[j][3];
        ss = wave_sum(ss);
        const float rstd = rsqrtf(ss * (1.0f / D) + 1e-6f);
        float lg[NEXP];
        if (ROUTER) {
#pragma unroll
            for (int e = 0; e < NEXP; ++e) lg[e] = 0.f;
        }
#pragma unroll
        for (int j = 0; j < 4; ++j) { const int c = j * 256 + lane * 4;
            f32x4 y = (x[j] * rstd) * mA[j] + mB[j];
            if (ROUTER) { *(unsigned*)((unsigned char*)HL + (size_t)r * D + c) = pk4_fp8(y[0], y[1], y[2], y[3]); }
            else { u32x2 w; w.x = pk_bf16(y[0], y[1]); w.y = pk_bf16(y[2], y[3]); *(u32x2*)(HL + (size_t)r * D + c) = w; }
            if (ROUTER) {
#pragma unroll
                for (int q = 0; q < 4; ++q) { const f32x4 r0 = *(const LAS f32x4*)(rt + (((j * 4 + q) * 2 + 0) * 64 + lane) * 4), r1 = *(const LAS f32x4*)(rt + (((j * 4 + q) * 2 + 1) * 64 + lane) * 4);
                    lg[0] += y[q] * r0[0]; lg[1] += y[q] * r0[1]; lg[2] += y[q] * r0[2]; lg[3] += y[q] * r0[3];
                    lg[4] += y[q] * r1[0]; lg[5] += y[q] * r1[1]; lg[6] += y[q] * r1[2]; lg[7] += y[q] * r1[3]; asm volatile("" ::: "memory"); }
            }
        }
        if (ROUTER) {
#pragma unroll
            for (int e = 0; e < NEXP; ++e) lg[e] = wave_sum(lg[e]);
            if (lane == 0) {
                int e1 = 0; float l1 = lg[0];
#pragma unroll
                for (int e = 1; e < NEXP; ++e) if (lg[e] > l1) { l1 = lg[e]; e1 = e; }
                int e2 = -1; float l2 = -3.0e38f;
#pragma unroll
                for (int e = 0; e < NEXP; ++e) if (e != e1 && lg[e] > l2) { l2 = lg[e]; e2 = e; }
                if (e2 < 0) { e2 = e1 == 0 ? 1 : 0; l2 = l1; }
                const float ex = __expf(l2 - l1), g1 = 1.0f / (1.0f + ex), g2 = ex * g1;
                const unsigned p1 = __hip_atomic_fetch_add(lcnt + e1, 1u, __ATOMIC_RELAXED, __HIP_MEMORY_SCOPE_WORKGROUP), p2 = __hip_atomic_fetch_add(lcnt + 8 + e2, 1u, __ATOMIC_RELAXED, __HIP_MEMORY_SCOPE_WORKGROUP);
                int* te = (int*)(F.ws + WS_ROUTE + RT_TOKE); float* tg = (float*)(F.ws + WS_ROUTE + RT_TOKG); int* tp = (int*)(F.ws + WS_ROUTE + RT_TOKP);
                te[r * 2] = e1 | (F.bid << 8); te[r * 2 + 1] = e2 | (F.bid << 8); tg[r * 2] = g1; tg[r * 2 + 1] = g2; tp[r * 2] = (int)p1; tp[r * 2 + 1] = (int)p2;
            }
        }
    }
    if (ROUTER) {
        __syncthreads();
        if (F.tid < 16) ((unsigned*)(F.ws + WS_CTL) + CW_WGCNT)[F.bid * 16 + F.tid] = lcnt[F.tid];
    }
}
__device__ __forceinline__ void moe_tstart(const Frame& F, int pass, int (&ts)[9]) {
    const unsigned* cnt = (const unsigned*)(F.ws + WS_CTL) + CW_MOECNT + pass * 8;
    int a = 0;
#pragma unroll
    for (int e = 0; e < 8; ++e) { ts[e] = a; a += (int)((__hip_atomic_load(cnt + e, __ATOMIC_RELAXED, __HIP_MEMORY_SCOPE_AGENT) + 255u) >> 8); }
    ts[8] = a;
}
__device__ __forceinline__ void phase_moe_rowmap(const Frame& F) {
    LAS int* tab = (LAS int*)F.lds; LAS int* tot = tab + 256 * 16;
    const unsigned* wgcnt = (const unsigned*)(F.ws + WS_CTL) + CW_WGCNT;
    for (int i = F.tid; i < F.G * 16; i += NTHREADS) tab[i] = (int)__hip_atomic_load(wgcnt + i, __ATOMIC_RELAXED, __HIP_MEMORY_SCOPE_AGENT);
    __syncthreads();
    if (F.tid < 16) { int run = 0;
#pragma unroll 8
        for (int w = 0; w < F.G; ++w) { const int v = tab[w * 16 + F.tid]; tab[w * 16 + F.tid] = run; run += v; }
        tot[F.tid] = run;
        if (F.bid == 0) ((unsigned*)(F.ws + WS_CTL) + CW_MOECNT)[F.tid] = (unsigned)run; }
    __syncthreads();
    int ts0[9], ts1[9];
    { int a = 0, b = 0;
#pragma unroll
      for (int e = 0; e < 8; ++e) { ts0[e] = a; a += (tot[e] + 255) >> 8; ts1[e] = b; b += (tot[8 + e] + 255) >> 8; }
      ts0[8] = a; ts1[8] = b; }
    const int* te = (const int*)(F.ws + WS_ROUTE + RT_TOKE); const int* tp = (const int*)(F.ws + WS_ROUTE + RT_TOKP);
    int* tsl = (int*)(F.ws + WS_ROUTE + RT_RMAP);
    for (int t = F.bid * NTHREADS + F.tid; t < NLAT; t += F.G * NTHREADS) {
        { const int ew = te[t * 2], e = ew & 255; int st = 0;
#pragma unroll
          for (int j = 0; j < 8; ++j) st = (e == j) ? ts0[j] : st;
          tsl[t * 2] = st * 256 + tab[(ew >> 8) * 16 + e] + tp[t * 2]; }
        { const int ew = te[t * 2 + 1], e = ew & 255; int st = 0;
#pragma unroll
          for (int j = 0; j < 8; ++j) st = (e == j) ? ts1[j] : st;
          tsl[t * 2 + 1] = NROW + st * 256 + tab[(ew >> 8) * 16 + 8 + e] + tp[t * 2 + 1]; }
    }
    const unsigned char* HL8 = F.ws + WS_HL; unsigned char* HLG = F.ws + WS_HLG;
#pragma unroll 4
    for (int t = F.gw; t < NLAT; t += F.nw) {
        const int ew0 = te[t * 2], ew1 = te[t * 2 + 1], e0 = ew0 & 255, e1 = ew1 & 255; int s0 = 0, s1 = 0;
#pragma unroll
        for (int j = 0; j < 8; ++j) { s0 = (e0 == j) ? ts0[j] : s0; s1 = (e1 == j) ? ts1[j] : s1; }
        const u32x4 v = *(const u32x4*)(HL8 + (size_t)t * D + F.lane * 16);
        *(u32x4*)(HLG + (size_t)(s0 * 256 + tab[(ew0 >> 8) * 16 + e0] + tp[t * 2]) * D + F.lane * 16) = v;
        *(u32x4*)(HLG + (size_t)(NROW + s1 * 256 + tab[(ew1 >> 8) * 16 + 8 + e1] + tp[t * 2 + 1]) * D + F.lane * 16) = v;
    }
    for (int i = F.gw; i < 2 * 8 * 256; i += F.nw) {
        const int pe = i >> 8, r = i & 255, e = pe & 7; const int c = tot[pe];
        int st = 0;
#pragma unroll
        for (int j = 0; j < 8; ++j) st = (e == j) ? (pe < 8 ? ts0[j] : ts1[j]) : st;
        if ((c & 255) != 0 && r >= (c & 255)) *(u32x4*)(HLG + (size_t)((pe >> 3) * NROW + st * 256 + (c & ~255) + r) * D + F.lane * 16) = (u32x4){0u, 0u, 0u, 0u};
    }
    __syncthreads();
}

struct RowGeo { int b, tt, pos, len; };
__device__ __forceinline__ RowGeo row_geo(int r) { RowGeo g; if (r < NLAT) { g.b = r >> 12; g.pos = r & 4095; g.len = SEQ; g.tt = CTXL + g.pos; } else { const int q = r - NLAT; g.b = q >> 8; g.pos = q & 255; g.len = CTXL; g.tt = g.pos; } return g; }

__device__ __forceinline__ void rw_shift4(const bf16_t* PL, const float* mup, const float* mun, int r, const RowGeo& g, int j, float (&u)[4]) {
    const bf16_t* p = PL + (size_t)r * INW + O_RW + j;
    const bool hp = g.pos > 0, hn = g.pos < g.len - 1;
    float c[4], pv[4], nv[4];
    unpack4(*(const u32x2*)p, c); unpack4(*(const u32x2*)(p - (hp ? INW : 0)), pv); unpack4(*(const u32x2*)(p + (hn ? INW : 0)), nv);
    const f32x4 mp = *(const f32x4*)(mup + j), mn = *(const f32x4*)(mun + j);
#pragma unroll
    for (int q = 0; q < 4; ++q) u[q] = c[q] + mp[q] * ((hp ? pv[q] : 0.f) - c[q]) + mn[q] * ((hn ? nv[q] : 0.f) - c[q]);
}

__device__ __forceinline__ void rw_shift8(const bf16_t* PL, const float* mup, const float* mun, int r, const RowGeo& g, int j, float (&u)[8]) {
    const bf16_t* p = PL + (size_t)r * INW + O_RW + j;
    const bool hp = g.pos > 0, hn = g.pos < g.len - 1;
    float c[8], pv[8], nv[8];
    unpack8(*(const u32x4*)p, c); unpack8(*(const u32x4*)(p - (hp ? INW : 0)), pv); unpack8(*(const u32x4*)(p + (hn ? INW : 0)), nv);
    const f32x4 mp0 = *(const f32x4*)(mup + j), mp1 = *(const f32x4*)(mup + j + 4), mn0 = *(const f32x4*)(mun + j), mn1 = *(const f32x4*)(mun + j + 4);
#pragma unroll
    for (int q = 0; q < 4; ++q) { u[q] = c[q] + mp0[q] * ((hp ? pv[q] : 0.f) - c[q]) + mn0[q] * ((hn ? nv[q] : 0.f) - c[q]);
        u[4 + q] = c[4 + q] + mp1[q] * ((hp ? pv[4 + q] : 0.f) - c[4 + q]) + mn1[q] * ((hn ? nv[4 + q] : 0.f) - c[4 + q]); }
}
__device__ __forceinline__ bf16x8 pack8f(const float (&f)[8]) {
    u32x4 w; w.x = cvt_pk_bf16(f[0], f[1]); w.y = cvt_pk_bf16(f[2], f[3]); w.z = cvt_pk_bf16(f[4], f[5]); w.w = cvt_pk_bf16(f[6], f[7]); return __builtin_bit_cast(bf16x8, w);
}
constexpr int RL_MUP = 0, RL_MUN = 5120, RL_KK = 10240, RL_KA = 11264, RL_W0 = 12288, RL_A0 = 14336, RL_RK = 16384, RL_GNG = 17408, RL_GNB = 18432, RL_END = 19456;
__device__ __forceinline__ void rw_stage_tables(const Frame& F, const Params& P, int l) {
    LAS float* T = (LAS float*)F.lds;
    for (int i = F.tid; i < 1280; i += NTHREADS) { T[RL_MUP / 4 + i] = P.in[I_MUP][l * 1280 + i]; T[RL_MUN / 4 + i] = P.in[I_MUN][l * 1280 + i]; }
    for (int i = F.tid; i < 256; i += NTHREADS) { T[RL_KK / 4 + i] = P.in[I_KK][l * 256 + i]; T[RL_KA / 4 + i] = P.in[I_KA][l * 256 + i]; T[RL_RK / 4 + i] = P.in[I_RK][l * 256 + i];
        T[RL_GNG / 4 + i] = P.in[I_GNG][l * 256 + i]; T[RL_GNB / 4 + i] = P.in[I_GNB][l * 256 + i]; }
    for (int i = F.tid; i < 512; i += NTHREADS) { T[RL_W0 / 4 + i] = P.in[I_W0][l * 512 + i]; T[RL_A0 / 4 + i] = P.in[I_A0][l * 512 + i]; }
    __syncthreads();
}
__device__ __forceinline__ void rw_mix8(const LAS float* T, const u32x4 (&raw)[3], bool hp, bool hn, int j, float (&u)[8]) {
    float c[8], pv[8], nv[8]; unpack8(raw[0], c); unpack8(raw[1], pv); unpack8(raw[2], nv);
    const f32x4 mp0 = *(const LAS f32x4*)(T + RL_MUP / 4 + j), mp1 = *(const LAS f32x4*)(T + RL_MUP / 4 + j + 4), mn0 = *(const LAS f32x4*)(T + RL_MUN / 4 + j), mn1 = *(const LAS f32x4*)(T + RL_MUN / 4 + j + 4);
#pragma unroll
    for (int q = 0; q < 4; ++q) { u[q] = c[q] + mp0[q] * ((hp ? pv[q] : 0.f) - c[q]) + mn0[q] * ((hn ? nv[q] : 0.f) - c[q]);
        u[4 + q] = c[4 + q] + mp1[q] * ((hp ? pv[4 + q] : 0.f) - c[4 + q]) + mn1[q] * ((hn ? nv[4 + q] : 0.f) - c[4 + q]); }
}
__device__ __forceinline__ void rw_mix4(const LAS float* T, const u32x2 (&raw)[3], bool hp, bool hn, int j, float (&u)[4]) {
    float c[4], pv[4], nv[4]; unpack4(raw[0], c); unpack4(raw[1], pv); unpack4(raw[2], nv);
    const f32x4 mp = *(const LAS f32x4*)(T + RL_MUP / 4 + j), mn = *(const LAS f32x4*)(T + RL_MUN / 4 + j);
#pragma unroll
    for (int q = 0; q < 4; ++q) u[q] = c[q] + mp[q] * ((hp ? pv[q] : 0.f) - c[q]) + mn[q] * ((hn ? nv[q] : 0.f) - c[q]);
}
__device__ __forceinline__ void rw_neighbours(const bf16_t* p, int tk, int dpe, int dne, const u32x4& cur, u32x4& prev, u32x4& next) {
    const u32x4 ep = *(const u32x4*)(p - (size_t)tk * INW + dpe), en = *(const u32x4*)(p + (size_t)(15 - tk) * INW + dne);
#pragma unroll
    for (int q = 0; q < 4; ++q) {
        prev[q] = (unsigned)__builtin_amdgcn_update_dpp((int)ep[q], (int)cur[q], 0x111, 0xF, 0xF, false);
        next[q] = (unsigned)__builtin_amdgcn_update_dpp((int)en[q], (int)cur[q], 0x101, 0xF, 0xF, false); }
}
__device__ __forceinline__ int rw_item(const Frame& F, int k, int nitems) {
    if (F.nw == NLAT / 16) { if (k == 0) return F.gw; const int j = (k - 1) * 2 * F.G + F.bid * 2 + F.wave; return (F.wave < 2 && NLAT / 16 + j < nitems) ? NLAT / 16 + j : -1; }
    const int item = F.gw + k * F.nw; return item < nitems ? item : -1;
}
__device__ __forceinline__ void phase_rw_prep(const Frame& F, const Params& P, int l) {
    const bf16_t* PL = (const bf16_t*)(F.ws + WS_PL);
    f16_t* SH = (f16_t*)(F.ws + WS_SH); f16_t* SD = (f16_t*)(F.ws + WS_SD);
    const int lane = F.lane;
    rw_stage_tables(F, P, l);
    const LAS float* T = (const LAS float*)F.lds;
    for (int kit = 0, item; (item = rw_item(F, kit, NLAT / 16 + (NCTX / 16) * 4)) >= 0; ++kit) {
        const int tile = item < NLAT / 16 ? item : NLAT / 16 + ((item - NLAT / 16) >> 2), h0 = item < NLAT / 16 ? 0 : ((item - NLAT / 16) & 3), h1 = item < NLAT / 16 ? 4 : h0 + 1;
        int l1 = lane; asm volatile("" : "+v"(l1)); const int tk = l1 & 15, g = l1 >> 4;
        const int r = tile * 16 + tk; const RowGeo geo = row_geo(r);
        const bool hp = geo.pos > 0, hn = geo.pos < geo.len - 1;
        const bf16_t* prow = PL + (size_t)r * INW + O_RW; const int dprev = hp ? -INW : 0, dnext = hn ? INW : 0; (void)dprev; (void)dnext;
        const RowGeo ge0 = row_geo(tile * 16), ge15 = row_geo(tile * 16 + 15); const int dpe = ge0.pos > 0 ? -INW : 0, dne = ge15.pos < ge15.len - 1 ? INW : 0;
        bf16x8 tw[2][2], ta[2][2];
#pragma unroll
        for (int d = 0; d < 2; ++d) { u32x4 raw[4][3];
#pragma unroll
          for (int i = 0; i < 4; ++i) { const bf16_t* p = prow + 768 + 256 * d + 64 * (i & 1) + 32 * (i >> 1) + 8 * g;
              raw[i][0] = *(const u32x4*)p; rw_neighbours(p, tk, dpe, dne, raw[i][0], raw[i][1], raw[i][2]); }
#pragma unroll
          for (int i = 0; i < 4; ++i) { float u[8]; rw_mix8(T, raw[i], hp, hn, 768 + 256 * d + 64 * (i & 1) + 32 * (i >> 1) + 8 * g, u);
              if ((i & 1) == 0) {
#pragma unroll
                  for (int q = 0; q < 8; ++q) u[q] = 1.0f - 2.0f * __builtin_amdgcn_rcpf(1.0f + __expf(2.0f * u[q]));
                  tw[d][i >> 1] = pack8f(u); }
              else ta[d][i >> 1] = pack8f(u); }
          asm volatile("" ::: "memory"); }
        asm volatile("" ::: "memory");
#pragma unroll 1
        for (int h = h0; h < h1; ++h) {
            int l2 = lane; asm volatile("" : "+v"(l2)); const int tk = l2 & 15, g = l2 >> 4;
            const int r = tile * 16 + tk; const RowGeo geo = row_geo(r);
            const bool hp = geo.pos > 0, hn = geo.pos < geo.len - 1;
            const bf16_t* prow = PL + (size_t)r * INW + O_RW + 64 * h + 8 * g; const int dprev = hp ? -INW : 0, dnext = hn ? INW : 0; (void)dprev; (void)dnext;
        const RowGeo ge0 = row_geo(tile * 16), ge15 = row_geo(tile * 16 + 15); const int dpe = ge0.pos > 0 ? -INW : 0, dne = ge15.pos < ge15.len - 1 ? INW : 0;
            float ur[4][4], uk[4][4], uv[4][4], kkv[4][4]; float ss = 0.f;
            { u32x4 raw[6][3];
#pragma unroll
              for (int i = 0; i < 6; ++i) { const bf16_t* p = prow + 256 * (i >> 1) + 32 * (i & 1);
                  raw[i][0] = *(const u32x4*)p; raw[i][1] = *(const u32x4*)(p + dprev); raw[i][2] = *(const u32x4*)(p + dnext); }
#pragma unroll
              for (int u = 0; u < 2; ++u) { float x8[8]; const int c = 64 * h + 32 * u + 8 * g;
                  rw_mix8(T, raw[u], hp, hn, c, x8);
#pragma unroll
                  for (int e = 0; e < 8; ++e) ur[2 * u + (e >> 2)][e & 3] = x8[e];
                  rw_mix8(T, raw[2 + u], hp, hn, 256 + c, x8);
#pragma unroll
                  for (int e = 0; e < 8; ++e) uk[2 * u + (e >> 2)][e & 3] = x8[e];
                  rw_mix8(T, raw[4 + u], hp, hn, 512 + c, x8);
#pragma unroll
                  for (int e = 0; e < 8; ++e) uv[2 * u + (e >> 2)][e & 3] = x8[e];
                  const f32x4 k0 = *(const LAS f32x4*)(T + RL_KK / 4 + c), k1 = *(const LAS f32x4*)(T + RL_KK / 4 + c + 4);
#pragma unroll
                  for (int q = 0; q < 4; ++q) { kkv[2 * u][q] = uk[2 * u][q] * k0[q]; kkv[2 * u + 1][q] = uk[2 * u + 1][q] * k1[q]; ss += kkv[2 * u][q] * kkv[2 * u][q] + kkv[2 * u + 1][q] * kkv[2 * u + 1][q]; } } }
            ss += __shfl_xor(ss, 16); ss += __shfl_xor(ss, 32);
            const float rn = rsqrtf(ss + 1e-12f);
            const size_t shrow = ((size_t)(geo.b * 4 + h) * TT + geo.tt) * 192;
#pragma unroll
            for (int u = 0; u < 2; ++u) { f16x8 o1, o2, o3;
#pragma unroll
                for (int e = 0; e < 8; ++e) { const int t = 2 * u + (e >> 2), q = e & 3; kkv[t][q] *= rn; o1[e] = (f16_t)ur[t][q]; o2[e] = (f16_t)uv[t][q]; o3[e] = (f16_t)(-kkv[t][q]); }
                f16_t* sp = SH + shrow + 32 * u + 8 * g; *(f16x8*)sp = o1; *(f16x8*)(sp + 64) = o2; *(f16x8*)(sp + 128) = o3; }
#pragma unroll 1
            for (int d = 0; d < 2; ++d) {
                const bf16_t* w2t = (const bf16_t*)(F.ws + WS_LORA + (size_t)(l * 2 + d) * LORA_LD_BYTES); const bf16_t* a2t = w2t + 256 * 64;
                const size_t sdrow = ((size_t)((d * 8 + geo.b) * 4 + h) * TT + geo.tt) * 192;
                const bf16x8 tw0 = d ? tw[1][0] : tw[0][0], tw1 = d ? tw[1][1] : tw[0][1], ta0 = d ? ta[1][0] : ta[0][0], ta1 = d ? ta[1][1] : ta[0][1];
                bf16x8 wf[4][2], af[4][2];
#pragma unroll
                for (int t = 0; t < 4; ++t) { const size_t fo = (size_t)((h * 4 + t) * 2 * 64 + l2) * 8;
                    wf[t][0] = *(const bf16x8*)(w2t + fo); wf[t][1] = *(const bf16x8*)(w2t + fo + 512); af[t][0] = *(const bf16x8*)(a2t + fo); af[t][1] = *(const bf16x8*)(a2t + fo + 512); }
                f16x8 o1[2], o2[2], o3[2];
#pragma unroll
                for (int t = 0; t < 4; ++t) { const int c = 64 * h + 32 * (t >> 1) + 8 * g + 4 * (t & 1);
                    f32x4 xw = *(const LAS f32x4*)(T + RL_W0 / 4 + d * 256 + c), xa = *(const LAS f32x4*)(T + RL_A0 / 4 + d * 256 + c);
                    xw = __builtin_amdgcn_mfma_f32_16x16x32_bf16(wf[t][0], tw0, xw, 0, 0, 0); xw = __builtin_amdgcn_mfma_f32_16x16x32_bf16(wf[t][1], tw1, xw, 0, 0, 0);
                    xa = __builtin_amdgcn_mfma_f32_16x16x32_bf16(af[t][0], ta0, xa, 0, 0, 0); xa = __builtin_amdgcn_mfma_f32_16x16x32_bf16(af[t][1], ta1, xa, 0, 0, 0);
                    const f32x4 kaw = *(const LAS f32x4*)(T + RL_KA / 4 + c);
#pragma unroll
                    for (int q = 0; q < 4; ++q) {
                        const float e = 0.60653066f * __builtin_amdgcn_rcpf(1.0f + __expf(-xw[q]));
                        const float omw = 1.0f - __expf(-e);
                        const float a = sigmoidf_(xa[q]);
                        o1[t >> 1][(t & 1) * 4 + q] = (f16_t)omw; o2[t >> 1][(t & 1) * 4 + q] = (f16_t)(uk[t][q] * (1.0f + (a - 1.0f) * kaw[q])); o3[t >> 1][(t & 1) * 4 + q] = (f16_t)(kkv[t][q] * a); } }
#pragma unroll
                for (int u = 0; u < 2; ++u) { f16_t* sp = SD + sdrow + 32 * u + 8 * g; *(f16x8*)sp = o1[u]; *(f16x8*)(sp + 64) = o2[u]; *(f16x8*)(sp + 128) = o3[u]; }
                asm volatile("" ::: "memory");
            }
        }
    }
    __syncthreads();
}

constexpr int CS_P = 144, CS_P16 = 80, CS_IMG = 16 * CS_P;
constexpr int CS_ZP = 0, CS_RPP = CS_IMG, CS_BH = 2 * CS_IMG, CS_KH = 3 * CS_IMG, CS_VV = 4 * CS_IMG, CS_MT = 5 * CS_IMG, CS_NT = CS_MT + 16 * CS_P16, CS_WC = CS_NT + 16 * CS_P16, CS_SLOT = CS_WC + 256;
constexpr int CS_ZIMG = 8 * CS_SLOT;
constexpr int CS_NCHUNK = TT / 16;
__device__ __forceinline__ int cs_tt(int d, int q, int s) { const int st = 16 * q + s; return d == 0 ? st : (st < CTXL ? CTXL - 1 - st : TT + CTXL - 1 - st); }
__device__ __forceinline__ float dpp_shr(float old, float v, int) { return v; }
template <int N> __device__ __forceinline__ float row_shr(float v, float old) {
    return __builtin_bit_cast(float, __builtin_amdgcn_update_dpp(__builtin_bit_cast(int, old), __builtin_bit_cast(int, v), 0x110 + N, 0xF, 0xF, false));
}
__device__ __forceinline__ bf16x8 cs_pack(const float (&a)[4], const float (&b)[4]) {
    u32x4 w; w.x = cvt_pk_bf16(a[0], a[1]); w.y = cvt_pk_bf16(a[2], a[3]); w.z = cvt_pk_bf16(b[0], b[1]); w.w = cvt_pk_bf16(b[2], b[3]); return __builtin_bit_cast(bf16x8, w);
}
__device__ __forceinline__ bf16x8 cs_op16(const f32x4& x) { u32x4 w; w.x = cvt_pk_bf16(x[0], x[1]); w.y = cvt_pk_bf16(x[2], x[3]); w.z = 0u; w.w = 0u; return __builtin_bit_cast(bf16x8, w); }
#define CS_MFMA(a, b, c) __builtin_amdgcn_mfma_f32_16x16x32_bf16((a), (b), (c), 0, 0, 0)
__device__ __forceinline__ f32x4 cs_mm16(const f32x4& xt_d, const f32x4& y_d) { return CS_MFMA(cs_op16(xt_d), cs_op16(y_d), ((f32x4){0.f, 0.f, 0.f, 0.f})); }
__device__ __forceinline__ v4i16_t cs_tr(const LAS unsigned char* img, int lane, int T) {
    const int g = lane >> 4, q = (lane & 15) >> 2, p = lane & 3;
    return __builtin_amdgcn_ds_read_tr16_b64_v4i16((LAS v4i16_t*)(img + (4 * g + q) * CS_P + p * 32 + (T >> 1) * 16 + (T & 1) * 8));
}
__device__ __forceinline__ bf16x8 cs_lo(v4i16_t x) { bf16x8 r; r[0] = x[0]; r[1] = x[1]; r[2] = x[2]; r[3] = x[3]; r[4] = 0; r[5] = 0; r[6] = 0; r[7] = 0; return r; }

struct CsRaw { u32x2 x[4], z[4], r[4], b[4], k[4], v[4]; };
struct CsIn { u32x4 a[6], b[6]; };
__device__ __forceinline__ void cs_load(CsIn& R, const f16_t* sh, const f16_t* sd, int d, int q, int lane) {
    const int t0 = d == 0 ? cs_tt(0, q, 0) : cs_tt(1, q, 15);
    const unsigned char* shp = (const unsigned char*)(sh + (size_t)t0 * 192) + lane * 16; const unsigned char* sdp = (const unsigned char*)(sd + (size_t)t0 * 192) + lane * 16;
#pragma unroll
    for (int i = 0; i < 6; ++i) { R.a[i] = *(const u32x4*)(shp + i * 1024); R.b[i] = *(const u32x4*)(sdp + i * 1024); }
}
__device__ __forceinline__ void cs_redeal(CsRaw& R, const CsIn& in, LAS unsigned char* scr, int d, int lane) {
    const int s = lane & 15, g = lane >> 4, row = d == 0 ? s : 15 - s;
    const LAS unsigned char* rp = scr + row * 400 + 8 * g;
    static_assert(2 * 6400 <= CS_SLOT, "the two re-deal tiles live in the wave's own slot");
#pragma unroll
    for (int i = 0; i < 6; ++i) { const int p = i * 64 + lane, pr = p / 24, pc = p - pr * 24; *(LAS u32x4*)(scr + pr * 400 + pc * 16) = in.a[i]; *(LAS u32x4*)(scr + 6400 + pr * 400 + pc * 16) = in.b[i]; }
    __builtin_amdgcn_wave_barrier(); asm volatile("" ::: "memory");
#pragma unroll
    for (int T = 0; T < 4; ++T) { R.r[T] = *(const LAS u32x2*)(rp + 32 * T); R.v[T] = *(const LAS u32x2*)(rp + 128 + 32 * T); R.z[T] = *(const LAS u32x2*)(rp + 256 + 32 * T);
        R.x[T] = *(const LAS u32x2*)(rp + 6400 + 32 * T); R.k[T] = *(const LAS u32x2*)(rp + 6400 + 128 + 32 * T); R.b[T] = *(const LAS u32x2*)(rp + 6400 + 256 + 32 * T); }
    asm volatile("s_waitcnt lgkmcnt(0)" ::: "memory"); __builtin_amdgcn_wave_barrier();
}
__device__ __forceinline__ void cs_prepass(LAS unsigned char* slot, LAS unsigned char* zimg, CsIn& in, const f16_t* sh, const f16_t* sd, int d, int qn, int lane) {
    const int s = lane & 15, g = lane >> 4;
    CsRaw raw; cs_redeal(raw, in, slot, d, lane);
    float Wc[4][4], Wp[4][4], iW[4][4];
#pragma unroll
    for (int T = 0; T < 4; ++T) { const f16x4 x4 = __builtin_bit_cast(f16x4, raw.x[T]);
#pragma unroll
        for (int j = 0; j < 4; ++j) { float wc = 1.0f - (float)x4[j];
            wc *= row_shr<1>(wc, 1.0f); wc *= row_shr<2>(wc, 1.0f); wc *= row_shr<4>(wc, 1.0f); wc *= row_shr<8>(wc, 1.0f);
            Wc[T][j] = wc; Wp[T][j] = row_shr<1>(wc, 1.0f); iW[T][j] = __builtin_amdgcn_rcpf(wc); } }
    if (s == 15) {
#pragma unroll
        for (int T = 0; T < 4; ++T) *(LAS f32x4*)(slot + CS_WC + (16 * T + 4 * g) * 4) = (f32x4){Wc[T][0], Wc[T][1], Wc[T][2], Wc[T][3]}; }
    bf16x8 oZ[2], oR[2], oB[2], oK[2];
    const int ioff = s * CS_P + g * 32;
#define CS_STAGE(dst, SRC, SC, IMG) do { float t_[4][4]; \
        _Pragma("unroll") for (int T = 0; T < 4; ++T) { const f16x4 q4 = __builtin_bit_cast(f16x4, SRC[T]); \
            _Pragma("unroll") for (int j = 0; j < 4; ++j) t_[T][j] = (float)q4[j] * SC; } \
        _Pragma("unroll") for (int kk = 0; kk < 2; ++kk) { dst[kk] = cs_pack(t_[2 * kk], t_[2 * kk + 1]); if (IMG) *(LAS bf16x8*)((IMG) + ioff + kk * 16) = dst[kk]; } \
        } while (0)
    CS_STAGE(oZ, raw.z, Wp[T][j], zimg);
    CS_STAGE(oR, raw.r, Wc[T][j], (LAS unsigned char*)nullptr);
    CS_STAGE(oB, raw.b, iW[T][j], slot + CS_BH);
    CS_STAGE(oK, raw.k, iW[T][j], slot + CS_KH);
    { bf16x8 oV[2]; CS_STAGE(oV, raw.v, 1.0f, slot + CS_VV); }
#undef CS_STAGE
    asm volatile("" ::: "memory");
    if (qn >= 0) cs_load(in, sh, sd, d, qn, lane);
    const f32x4 zero4 = (f32x4){0.f, 0.f, 0.f, 0.f};
    f32x4 A_D = CS_MFMA(oB[1], oZ[1], CS_MFMA(oB[0], oZ[0], zero4)), AT_D = CS_MFMA(oZ[1], oB[1], CS_MFMA(oZ[0], oB[0], zero4));
    f32x4 BkT_D = CS_MFMA(oZ[1], oK[1], CS_MFMA(oZ[0], oK[0], zero4));
    f32x4 Ar_D = CS_MFMA(oB[1], oR[1], CS_MFMA(oB[0], oR[0], zero4)), Kr_D = CS_MFMA(oK[1], oR[1], CS_MFMA(oK[0], oR[0], zero4));
    f32x4 I_D;
#pragma unroll
    for (int j = 0; j < 4; ++j) { const int m = 4 * g + j;
        A_D[j] = m < s ? A_D[j] : 0.f; AT_D[j] = s < m ? AT_D[j] : 0.f; BkT_D[j] = s < m ? BkT_D[j] : 0.f;
        Ar_D[j] = m <= s ? Ar_D[j] : 0.f; Kr_D[j] = m <= s ? Kr_D[j] : 0.f; I_D[j] = m == s ? 1.f : 0.f; }
    f32x4 Ab, AbT, A1, A2m;
#pragma unroll
    for (int j = 0; j < 4; ++j) { const int m = 4 * g + j; const bool b0 = (m >> 2) == (s >> 2), b1 = (m >> 3) == (s >> 3);
        Ab[j] = b0 ? A_D[j] : 0.f; AbT[j] = b0 ? AT_D[j] : 0.f; A1[j] = (b1 && !b0) ? A_D[j] : 0.f; A2m[j] = b1 ? 0.f : A_D[j]; }
    const f32x4 Ab2 = cs_mm16(AbT, Ab), Ab2T = cs_mm16(Ab, AbT);
    const f32x4 P0 = I_D + Ab, P0T = I_D + AbT;
    const f32x4 T0 = P0 + cs_mm16(P0T, Ab2), T0T = P0T + cs_mm16(Ab2, P0T);
    (void)Ab2T;
    const f32x4 ZT = cs_mm16(A1, T0T);
    const f32x4 T1 = T0 + cs_mm16(ZT, T0), T1T = T0T + cs_mm16(T0, ZT);
    const f32x4 Z2T = cs_mm16(A2m, T1T);
    const f32x4 T_D = T1 + cs_mm16(Z2T, T1);
    const f32x4 M_D = cs_mm16(BkT_D, T_D), MT_D = cs_mm16(T_D, BkT_D);
    const f32x4 N_D = cs_mm16(MT_D, Ar_D) + Kr_D;
    { u32x4 w; w.x = cvt_pk_bf16(M_D[0], M_D[1]); w.y = cvt_pk_bf16(M_D[2], M_D[3]); w.z = 0u; w.w = 0u; *(LAS u32x4*)(slot + CS_MT + s * CS_P16 + g * 16) = w;
      w.x = cvt_pk_bf16(N_D[0], N_D[1]); w.y = cvt_pk_bf16(N_D[2], N_D[3]); *(LAS u32x4*)(slot + CS_NT + s * CS_P16 + g * 16) = w; }
    __builtin_amdgcn_wave_barrier(); asm volatile("" ::: "memory");
    const bf16x8 oT = cs_op16(T_D), oAr = cs_op16(Ar_D);
    float Zp[4][4];
#pragma unroll
    for (int T = 0; T < 4; ++T) { const f32x4 zp = CS_MFMA(cs_lo(cs_tr(zimg, lane, T)), oT, zero4);
#pragma unroll
        for (int j = 0; j < 4; ++j) Zp[T][j] = zp[j]; }
#pragma unroll
    for (int kk = 0; kk < 2; ++kk) *(LAS bf16x8*)(slot + CS_ZP + s * CS_P + g * 32 + kk * 16) = cs_pack(Zp[2 * kk], Zp[2 * kk + 1]);
    __builtin_amdgcn_wave_barrier(); asm volatile("" ::: "memory");
    float Rp[4][4];
#pragma unroll
    for (int T = 0; T < 4; ++T) { const f32x4 rp = CS_MFMA(cs_lo(cs_tr(slot + CS_ZP, lane, T)), oAr, zero4);
#pragma unroll
        for (int j = 0; j < 4; ++j) Rp[T][j] = rp[j] + bf2f((bf16_t)oR[T >> 1][(T & 1) * 4 + j]); }
#pragma unroll
    for (int kk = 0; kk < 2; ++kk) *(LAS bf16x8*)(slot + CS_RPP + s * CS_P + g * 32 + kk * 16) = cs_pack(Rp[2 * kk], Rp[2 * kk + 1]);
}
__device__ __forceinline__ void cs_scan_chunk(const LAS unsigned char* slot, f32x4 (&acc)[4], float* yp  , int d, int q, int wave, int lane) {
    const int s = lane & 15, g = lane >> 4;
    const f32x4 zero4 = (f32x4){0.f, 0.f, 0.f, 0.f};
    bf16x8 Xb[2];
#pragma unroll
    for (int kk = 0; kk < 2; ++kk) { u32x4 w; w.x = cvt_pk_bf16(acc[2 * kk][0], acc[2 * kk][1]); w.y = cvt_pk_bf16(acc[2 * kk][2], acc[2 * kk][3]);
        w.z = cvt_pk_bf16(acc[2 * kk + 1][0], acc[2 * kk + 1][1]); w.w = cvt_pk_bf16(acc[2 * kk + 1][2], acc[2 * kk + 1][3]); Xb[kk] = __builtin_bit_cast(bf16x8, w); }
    const v4i16_t vt = cs_tr(slot + CS_VV, lane, wave);
    const bf16x8 Vb = cs_lo(vt);
    const int arow = s * CS_P + g * 32, a16 = s * CS_P16 + g * 16;
    f32x4 UT = CS_MFMA(*(const LAS bf16x8*)(slot + CS_MT + a16), Vb, zero4);
    UT = CS_MFMA(*(const LAS bf16x8*)(slot + CS_ZP + arow), Xb[0], UT); UT = CS_MFMA(*(const LAS bf16x8*)(slot + CS_ZP + arow + 16), Xb[1], UT);
    f32x4 YT = CS_MFMA(*(const LAS bf16x8*)(slot + CS_NT + a16), Vb, zero4); YT = CS_MFMA(*(const LAS bf16x8*)(slot + CS_RPP + arow), Xb[0], YT); YT = CS_MFMA(*(const LAS bf16x8*)(slot + CS_RPP + arow + 16), Xb[1], YT);
#pragma unroll
    for (int j = 0; j < 4; ++j) yp[(size_t)cs_tt(d, q, 4 * g + j) * 256] = YT[j];
    bf16x8 UV; { u32x2 w; w.x = cvt_pk_bf16(UT[0], UT[1]); w.y = cvt_pk_bf16(UT[2], UT[3]); const v4i16_t ub = __builtin_bit_cast(v4i16_t, w);
        UV[0] = ub[0]; UV[1] = ub[1]; UV[2] = ub[2]; UV[3] = ub[3]; UV[4] = vt[0]; UV[5] = vt[1]; UV[6] = vt[2]; UV[7] = vt[3]; }
#pragma unroll
    for (int T = 0; T < 4; ++T) { const v4i16_t bh = cs_tr(slot + CS_BH, lane, T), kh = cs_tr(slot + CS_KH, lane, T);
        bf16x8 BK; BK[0] = bh[0]; BK[1] = bh[1]; BK[2] = bh[2]; BK[3] = bh[3]; BK[4] = kh[0]; BK[5] = kh[1]; BK[6] = kh[2]; BK[7] = kh[3];
        acc[T] = CS_MFMA(BK, UV, acc[T]);
        acc[T] *= *(const LAS f32x4*)(slot + CS_WC + (16 * T + 4 * g) * 4); }
}
__device__ __forceinline__ void phase_scan(const Frame& F) {
    const f16_t* SH = (const f16_t*)(F.ws + WS_SH); const f16_t* SD = (const f16_t*)(F.ws + WS_SD);
    float* Y = (float*)(F.ws + WS_Y);
    const int lane = F.lane, wave = F.wave;
    for (int chain = F.bid; chain < 64; chain += F.G) {
        const int d = chain >> 5, b = (chain >> 2) & 7, h = chain & 3;
        const f16_t* sh = SH + (size_t)(b * 4 + h) * TT * 192; const f16_t* sd = SD + (size_t)((d * 8 + b) * 4 + h) * TT * 192;
        float* yp = Y + ((size_t)(d * 8 + b) * TT) * 256 + h * 64 + 16 * (wave & 3) + (lane & 15);
        f32x4 acc[4];
#pragma unroll
        for (int T = 0; T < 4; ++T) acc[T] = (f32x4){0.f, 0.f, 0.f, 0.f};
        const int cw = (wave + 4) & 7;
        LAS unsigned* sync4 = (LAS unsigned*)(F.lds + CS_ZIMG + 8 * CS_IMG);
        if (F.tid == 0) *sync4 = 0u;
        __syncthreads();
        CsIn raw;
        constexpr int NR = CS_NCHUNK / 8;
        cs_load(raw, sh, sd, d, cw, lane);
        cs_prepass(F.lds + cw * CS_SLOT, F.lds + CS_ZIMG + wave * CS_IMG, raw, sh, sd, d, (1 < NR) ? 8 + cw : -1, lane);
        asm volatile("s_waitcnt lgkmcnt(0)" ::: "memory"); __builtin_amdgcn_s_barrier(); asm volatile("" ::: "memory");
        for (int R = 0; R < NR; ++R) {
            if (wave < 4) {
#pragma unroll 1
                for (int c8 = 0; c8 < 4; ++c8) cs_scan_chunk(F.lds + c8 * CS_SLOT, acc, yp, d, 8 * R + c8, wave, lane);
            }
            asm volatile("s_waitcnt lgkmcnt(0)" ::: "memory"); __builtin_amdgcn_s_barrier(); asm volatile("" ::: "memory");
            if (wave < 4) {
#pragma unroll 1
                for (int c8 = 4; c8 < 8; ++c8) cs_scan_chunk(F.lds + c8 * CS_SLOT, acc, yp, d, 8 * R + c8, wave, lane);
                asm volatile("s_waitcnt lgkmcnt(0)" ::: "memory");
                if (lane == 0) __hip_atomic_fetch_add(sync4, 1u, __ATOMIC_RELAXED, __HIP_MEMORY_SCOPE_WORKGROUP);
                while (__hip_atomic_load(sync4, __ATOMIC_RELAXED, __HIP_MEMORY_SCOPE_WORKGROUP) < 4u * (unsigned)(R + 1)) __builtin_amdgcn_s_sleep(1);
                asm volatile("" ::: "memory");
            }
            if (R + 1 < NR) cs_prepass(F.lds + cw * CS_SLOT, F.lds + CS_ZIMG + wave * CS_IMG, raw, sh, sd, d, (R + 2 < NR) ? 8 * (R + 2) + cw : -1, lane);
            asm volatile("s_waitcnt lgkmcnt(0)" ::: "memory"); __builtin_amdgcn_s_barrier(); asm volatile("" ::: "memory");
        }
    }
}

__device__ __forceinline__ void phase_rw_post(const Frame& F, const Params& P, int l, int nrows) {
    const bf16_t* PL = (const bf16_t*)(F.ws + WS_PL); bf16_t* MIX = (bf16_t*)(F.ws + WS_MIX);
    const f16_t* SH = (const f16_t*)(F.ws + WS_SH); const f16_t* SD = (const f16_t*)(F.ws + WS_SD); const float* Y = (const float*)(F.ws + WS_Y);
    const int lane = F.lane;
    rw_stage_tables(F, P, l);
    const LAS float* T = (const LAS float*)F.lds;
    for (int kit = 0, item; (item = rw_item(F, kit, NLAT / 16 + ((nrows - NLAT) / 16) * 4)) >= 0; ++kit) {
        const int tile = item < NLAT / 16 ? item : NLAT / 16 + ((item - NLAT / 16) >> 2), h0 = item < NLAT / 16 ? 0 : ((item - NLAT / 16) & 3), h1 = item < NLAT / 16 ? 4 : h0 + 1;
        int l1 = lane; asm volatile("" : "+v"(l1)); const int tk = l1 & 15, g = l1 >> 4;
        const int r = tile * 16 + tk; const RowGeo geo = row_geo(r);
        const bool hp = geo.pos > 0, hn = geo.pos < geo.len - 1;
        const bf16_t* prow = PL + (size_t)r * INW + O_RW; const int dprev = hp ? -INW : 0, dnext = hn ? INW : 0; (void)dprev; (void)dnext;
        const RowGeo ge0 = row_geo(tile * 16), ge15 = row_geo(tile * 16 + 15); const int dpe = ge0.pos > 0 ? -INW : 0, dne = ge15.pos < ge15.len - 1 ? INW : 0;
        bf16x8 sg[2][4];
#pragma unroll
        for (int d = 0; d < 2; ++d) { u32x4 raw[4][3];
#pragma unroll
            for (int kk = 0; kk < 4; ++kk) { const bf16_t* p = prow + 896 + 256 * d + 32 * kk + 8 * g;
                raw[kk][0] = *(const u32x4*)p; rw_neighbours(p, tk, dpe, dne, raw[kk][0], raw[kk][1], raw[kk][2]); }
#pragma unroll
            for (int kk = 0; kk < 4; ++kk) { float u[8]; rw_mix8(T, raw[kk], hp, hn, 896 + 256 * d + 32 * kk + 8 * g, u);
#pragma unroll
                for (int q = 0; q < 8; ++q) u[q] = sigmoidf_(u[q]);
                sg[d][kk] = pack8f(u); }
            asm volatile("" ::: "memory"); }
#pragma unroll 1
        for (int h = h0; h < h1; ++h) {
            int l2 = lane; asm volatile("" : "+v"(l2)); const int tk = l2 & 15, g = l2 >> 4;
            const int r = tile * 16 + tk; const RowGeo geo = row_geo(r);
            const size_t shrow = ((size_t)(geo.b * 4 + h) * TT + geo.tt) * 192;
            float out[4][4];
#pragma unroll
            for (int t = 0; t < 4; ++t)
#pragma unroll
                for (int q = 0; q < 4; ++q) out[t][q] = 0.f;
            f16x8 rh[2], vh[2];
#pragma unroll
            for (int u = 0; u < 2; ++u) { rh[u] = *(const f16x8*)(SH + shrow + 32 * u + 8 * g); vh[u] = *(const f16x8*)(SH + shrow + 64 + 32 * u + 8 * g); }
#pragma unroll 1
            for (int d = 0; d < 2; ++d) {
                const bf16_t* g2t = (const bf16_t*)(F.ws + WS_LORA + (size_t)(l * 2 + d) * LORA_LD_BYTES) + 2 * 256 * 64;
                const size_t sdrow = ((size_t)((d * 8 + geo.b) * 4 + h) * TT + geo.tt) * 192;
                const float* yrow = Y + ((size_t)(d * 8 + geo.b) * TT + geo.tt) * 256 + 64 * h + 8 * g;
                bf16x8 sgd[4];
#pragma unroll
                for (int kk = 0; kk < 4; ++kk) sgd[kk] = d ? sg[1][kk] : sg[0][kk];
                f32x4 y[4], gg[4]; f16x8 kdh[2]; bf16x8 gf[4][4];
#pragma unroll
                for (int u = 0; u < 2; ++u) { y[2 * u] = *(const f32x4*)(yrow + 32 * u); y[2 * u + 1] = *(const f32x4*)(yrow + 32 * u + 4); kdh[u] = *(const f16x8*)(SD + sdrow + 64 + 32 * u + 8 * g); }
#pragma unroll
                for (int t = 0; t < 4; ++t) { const bf16_t* gr = g2t + (size_t)((h * 4 + t) * 4 * 64 + l2) * 8;
#pragma unroll
                    for (int kk = 0; kk < 4; ++kk) gf[t][kk] = *(const bf16x8*)(gr + 512 * kk); }
                float sm = 0.f, bs = 0.f;
#pragma unroll
                for (int t = 0; t < 4; ++t) { const int c = 64 * h + 32 * (t >> 1) + 8 * g + 4 * (t & 1);
                    sm += (y[t][0] + y[t][1]) + (y[t][2] + y[t][3]);
                    const f32x4 rk = *(const LAS f32x4*)(T + RL_RK / 4 + c);
#pragma unroll
                    for (int q = 0; q < 4; ++q) bs += (float)rh[t >> 1][(t & 1) * 4 + q] * (float)kdh[t >> 1][(t & 1) * 4 + q] * rk[q];
                    f32x4 a = (f32x4){0.f, 0.f, 0.f, 0.f};
#pragma unroll
                    for (int kk = 0; kk < 4; ++kk) a = __builtin_amdgcn_mfma_f32_16x16x32_bf16(gf[t][kk], sgd[kk], a, 0, 0, 0);
                    gg[t] = a; }
                sm += __shfl_xor(sm, 16); sm += __shfl_xor(sm, 32); bs += __shfl_xor(bs, 16); bs += __shfl_xor(bs, 32);
                const float mu = sm * (1.0f / 64.0f); float vs = 0.f;
#pragma unroll
                for (int t = 0; t < 4; ++t)
#pragma unroll
                    for (int q = 0; q < 4; ++q) { const float dd = y[t][q] - mu; vs += dd * dd; }
                vs += __shfl_xor(vs, 16); vs += __shfl_xor(vs, 32);
                const float rstd = rsqrtf(vs * (1.0f / 64.0f) + 64e-5f);
#pragma unroll
                for (int t = 0; t < 4; ++t) { const int c = 64 * h + 32 * (t >> 1) + 8 * g + 4 * (t & 1);
                    const f32x4 gng = *(const LAS f32x4*)(T + RL_GNG / 4 + c), gnb = *(const LAS f32x4*)(T + RL_GNB / 4 + c);
#pragma unroll
                    for (int q = 0; q < 4; ++q) out[t][q] += ((y[t][q] - mu) * rstd * gng[q] + gnb[q] + bs * (float)vh[t >> 1][(t & 1) * 4 + q]) * gg[t][q]; }
                asm volatile("" ::: "memory");
            }
#pragma unroll
            for (int u = 0; u < 2; ++u) { u32x4 w; w.x = cvt_pk_bf16(out[2 * u][0], out[2 * u][1]); w.y = cvt_pk_bf16(out[2 * u][2], out[2 * u][3]); w.z = cvt_pk_bf16(out[2 * u + 1][0], out[2 * u + 1][1]); w.w = cvt_pk_bf16(out[2 * u + 1][2], out[2 * u + 1][3]);
                *(u32x4*)(MIX + (size_t)r * D + 512 + 64 * h + 32 * u + 8 * g) = w; }
        }
    }
    __syncthreads();
}

constexpr int CV_SEG = 64, CV_ROWS = CV_SEG + 30, CV_H = 0, CV_W = CV_ROWS * 256 * 4;
__device__ __forceinline__ void phase_conv(const Frame& F, const Params& P, int l, int nrows) {
    const bf16_t* PL = (const bf16_t*)(F.ws + WS_PL); bf16_t* MIX = (bf16_t*)(F.ws + WS_MIX);
    const int lane = F.lane, c4 = lane * 4, wave = F.wave;
    LAS float* H = (LAS float*)(F.lds + CV_H); LAS float* W = (LAS float*)(F.lds + CV_W);
    for (int i = F.tid; i < 31 * 256; i += NTHREADS) W[i] = P.in[I_DWW][(size_t)l * 31 * 256 + i];
    const f32x4 dwb = *(const f32x4*)(P.in[I_DWB] + l * 256 + c4), lng = *(const f32x4*)(P.in[I_LNG] + l * 256 + c4), lnb = *(const f32x4*)(P.in[I_LNB] + l * 256 + c4);
    for (int seg = F.bid; seg < nrows / CV_SEG; seg += F.G) {
        const int r0 = seg * CV_SEG; const RowGeo g0 = row_geo(r0);
        __syncthreads();
#pragma unroll 4
        for (int k = 0; k < 12; ++k) { const int rr = wave + 8 * k;
            if (rr < CV_ROWS) { const int pos = g0.pos - 15 + rr; f32x4 hv = (f32x4){0.f, 0.f, 0.f, 0.f};
                if (pos >= 0 && pos < g0.len) { const bf16_t* p = PL + (size_t)(r0 - 15 + rr) * INW + O_CV + c4; float a[4], bb[4];
                    unpack4(*(const u32x2*)p, a); unpack4(*(const u32x2*)(p + 256), bb);
#pragma unroll
                    for (int q = 0; q < 4; ++q) hv[q] = a[q] * sigmoidf_(bb[q]); }
                *(LAS f32x4*)(H + rr * 256 + c4) = hv; } }
        __syncthreads();
        f32x4 acc[8];
#pragma unroll
        for (int t = 0; t < 8; ++t) acc[t] = dwb;
        f32x4 wj[31];
#pragma unroll
        for (int r = 0; r < 38; ++r) { const f32x4 hv = *(const LAS f32x4*)(H + (wave * 8 + r) * 256 + c4);
            if (r < 31) wj[r] = *(const LAS f32x4*)(W + r * 256 + c4);
#pragma unroll
            for (int t = 0; t < 8; ++t) if (r - t >= 0 && r - t < 31) acc[t] += hv * wj[r - t]; }
#pragma unroll
        for (int t = 0; t < 8; ++t) {
            const float mu = wave_sum((acc[t][0] + acc[t][1]) + (acc[t][2] + acc[t][3])) * (1.0f / 256.0f);
            float vs = 0.f;
#pragma unroll
            for (int q = 0; q < 4; ++q) { const float dd = acc[t][q] - mu; vs += dd * dd; }
            const float rstd = rsqrtf(wave_sum(vs) * (1.0f / 256.0f) + 1e-5f);
            float o[4];
#pragma unroll
            for (int q = 0; q < 4; ++q) o[q] = siluf_((acc[t][q] - mu) * rstd * lng[q] + lnb[q]);
            u32x2 w; w.x = pk_bf16(o[0], o[1]); w.y = pk_bf16(o[2], o[3]);
            *(u32x2*)(MIX + (size_t)(r0 + wave * 8 + t) * D + 768 + c4) = w; }
    }
    __syncthreads();
}

__device__ __forceinline__ void phase_na_simple(const Frame& F, const Params& P, int l, int nq) {
    const bf16_t* PL = (const bf16_t*)(F.ws + WS_PL); bf16_t* MIX = (bf16_t*)(F.ws + WS_MIX);
    const float* rpb = P.in[I_RPB] + (size_t)l * 8 * 15 * 31;
    int tid_ = F.tid; asm volatile("" : "+v"(tid_));
    for (int gid = F.bid * NTHREADS + tid_; gid < nq * 8; gid += F.G * NTHREADS) {
        const int r = gid >> 3, h = gid & 7;
        const RowGeo g = row_geo(r);
        float q[64], o[64];
        { const bf16_t* qp = PL + (size_t)r * INW + O_Q + h * 64;
#pragma unroll
          for (int i = 0; i < 8; ++i) unpack8(*(const u32x4*)(qp + i * 8), q + i * 8); }
#pragma unroll
        for (int i = 0; i < 64; ++i) o[i] = 0.f;
        float m = -3.0e38f, lsum = 0.f;
        const bool lat = r < NLAT;
        const int gi = g.pos >> 6, gc = g.pos & 63;
        const int rs = min(max(gi - 4, 0), 56), wsc = min(max(gc - 8, 0), 48);
        const int nkey = lat ? 384 : 256;
#pragma unroll 1
        for (int kx = 0; kx < nkey; ++kx) {
            const bool win = lat && kx < 128;
            int krow; float bias = 0.f;
            if (win) { const int r8 = kx >> 4, cc = kx & 15; krow = g.b * SEQ + (rs + r8) * 64 + wsc + cc; bias = rpb[(h * 15 + (rs + r8 - gi + 7)) * 31 + (wsc + cc - gc + 15)]; }
            else krow = NLAT + g.b * CTXL + (kx - (lat ? 128 : 0));
            const bf16_t* kp = PL + (size_t)krow * INW + O_K + h * 64; float a = bias;
#pragma unroll
            for (int i = 0; i < 8; ++i) { float kf[8]; unpack8(*(const u32x4*)(kp + i * 8), kf);
#pragma unroll
                for (int j = 0; j < 8; ++j) a += q[i * 8 + j] * kf[j]; }
            if (a > m) { const float alpha = __expf(m - a); lsum *= alpha;
#pragma unroll
                for (int i = 0; i < 64; ++i) o[i] *= alpha;
                m = a; }
            const float p = __expf(a - m); lsum += p;
            const bf16_t* vp = kp + (O_V - O_K);
#pragma unroll
            for (int i = 0; i < 8; ++i) { float vf[8]; unpack8(*(const u32x4*)(vp + i * 8), vf);
#pragma unroll
                for (int j = 0; j < 8; ++j) o[i * 8 + j] += p * vf[j]; }
        }
        const float inv = 1.0f / lsum;
        bf16_t* op = MIX + (size_t)r * D + h * 64;
#pragma unroll
        for (int i = 0; i < 8; ++i) { u32x4 w; w.x = pk_bf16(o[i * 8] * inv, o[i * 8 + 1] * inv); w.y = pk_bf16(o[i * 8 + 2] * inv, o[i * 8 + 3] * inv);
            w.z = pk_bf16(o[i * 8 + 4] * inv, o[i * 8 + 5] * inv); w.w = pk_bf16(o[i * 8 + 6] * inv, o[i * 8 + 7] * inv); *(u32x4*)(op + i * 8) = w; }
    }
}

constexpr int NA_CK = 0, NA_CV = 32768, NA_RPB = 65536, NA_WV = 81920, NA_WK = NA_WV + 8 * 4096;
__device__ __forceinline__ bf16x8 na_pack8(const f32x4& a, const f32x4& b) {
    u32x4 w; w.x = cvt_pk_bf16(a[0], a[1]); w.y = cvt_pk_bf16(a[2], a[3]); w.z = cvt_pk_bf16(b[0], b[1]); w.w = cvt_pk_bf16(b[2], b[3]); return __builtin_bit_cast(bf16x8, w);
}
__device__ __forceinline__ bf16x8 na_vfrag(LAS unsigned char* blk, int lane, int dt) {
    const int g = lane >> 4, qq = (lane & 15) >> 2, p = lane & 3;
    const int r0 = 4 * g + qq, r1 = 16 + 4 * g + qq;
    const v4i16_t lo = __builtin_amdgcn_ds_read_tr16_b64_v4i16((LAS v4i16_t*)(blk + r0 * 128 + ((dt ^ ((r0 >> 1) & 3)) * 32) + p * 8));
    const v4i16_t hi = __builtin_amdgcn_ds_read_tr16_b64_v4i16((LAS v4i16_t*)(blk + r1 * 128 + ((dt ^ ((r1 >> 1) & 3)) * 32) + p * 8));
    bf16x8 r; r[0] = lo[0]; r[1] = lo[1]; r[2] = lo[2]; r[3] = lo[3]; r[4] = hi[0]; r[5] = hi[1]; r[6] = hi[2]; r[7] = hi[3]; return r;
}
template <bool WINDOW>
__device__ __forceinline__ void na_item(const Frame& F, const bf16_t* PL, bf16_t* MIX, int b, int h, int qrow0  , int gi, int cb) {
    const int lane = F.lane, ql = lane & 15, g = lane >> 4;
    LAS unsigned char* CK = F.lds + NA_CK; LAS unsigned char* CV = F.lds + NA_CV; const LAS float* RPB = (const LAS float*)(F.lds + NA_RPB);
    LAS unsigned char* WV = F.lds + NA_WV + F.wave * 4096;
    bf16x8 Qf[2];
    LAS unsigned char* WKq = F.lds + NA_WK + F.wave * 4608;
    { const int rr = lane >> 3, pc = lane & 7; const bf16_t* qp = PL + (size_t)(qrow0 + rr) * INW + O_Q + h * 64 + 8 * pc;
      const u32x4 q0 = *(const u32x4*)qp, q1 = *(const u32x4*)(qp + (size_t)8 * INW);
      *(LAS u32x4*)(WKq + rr * 144 + pc * 16) = q0; *(LAS u32x4*)(WKq + (rr + 8) * 144 + pc * 16) = q1;
      __builtin_amdgcn_wave_barrier(); asm volatile("" ::: "memory");
      Qf[0] = *(const LAS bf16x8*)(WKq + ql * 144 + g * 16); Qf[1] = *(const LAS bf16x8*)(WKq + ql * 144 + 64 + g * 16);
      __builtin_amdgcn_wave_barrier(); asm volatile("" ::: "memory"); }
    f32x4 acc[4];
#pragma unroll
    for (int dt = 0; dt < 4; ++dt) acc[dt] = (f32x4){0.f, 0.f, 0.f, 0.f};
    float m_run = -3.0e38f, l_run = 0.f;
    if constexpr (WINDOW) {
        const int rs = min(max(gi - 4, 0), 56), kc0 = min(max(16 * cb - 8, 0), 32), qcol = 16 * cb + ql, wsq = min(max(qcol - 8, 0), 48);
        const size_t krow0 = (size_t)b * SEQ + (size_t)rs * 64 + kc0;
        f32x4 s[16];
        { const int rr = lane >> 3, pc = lane & 7;
          const bf16_t* kb = PL + (krow0 + rr) * INW + O_K + h * 64 + 8 * pc;
          LAS unsigned char* WK = F.lds + NA_WK + F.wave * 4608;
          u32x4 kc[16][2];
#pragma unroll
          for (int t = 0; t < 16; ++t) { const bf16_t* kp = kb + ((size_t)(t >> 1) * 64 + (t & 1) * 16) * INW; kc[t][0] = *(const u32x4*)kp; kc[t][1] = *(const u32x4*)(kp + (size_t)8 * INW); }
#pragma unroll
          for (int t = 0; t < 16; ++t) { LAS unsigned char* buf = WK + (t & 1) * 2304;
              *(LAS u32x4*)(buf + rr * 144 + pc * 16) = kc[t][0]; *(LAS u32x4*)(buf + (rr + 8) * 144 + pc * 16) = kc[t][1];
              __builtin_amdgcn_wave_barrier(); asm volatile("" ::: "memory");
              const bf16x8 k0 = *(const LAS bf16x8*)(buf + ql * 144 + g * 16), k1 = *(const LAS bf16x8*)(buf + ql * 144 + 64 + g * 16);
              __builtin_amdgcn_wave_barrier(); asm volatile("" ::: "memory");
              s[t] = __builtin_amdgcn_mfma_f32_16x16x32_bf16(k0, Qf[0], (f32x4){0.f, 0.f, 0.f, 0.f}, 0, 0, 0);
              s[t] = __builtin_amdgcn_mfma_f32_16x16x32_bf16(k1, Qf[1], s[t], 0, 0, 0); } }
        const int vr = lane >> 1, part = lane & 1;
        const bf16_t* vbase = PL + (krow0 + vr) * INW + O_V + h * 64 + part * 32;
        u32x4 vbuf[4][4];
#pragma unroll
        for (int k = 0; k < 4; ++k) { const bf16_t* vp = vbase + (size_t)k * 64 * INW; vbuf[k][0] = *(const u32x4*)vp; vbuf[k][1] = *(const u32x4*)(vp + 8); vbuf[k][2] = *(const u32x4*)(vp + 16); vbuf[k][3] = *(const u32x4*)(vp + 24); }
        float mx = -3.0e38f;
#pragma unroll
        for (int t = 0; t < 16; ++t) { const LAS float* bp = RPB + (h * 15 + (rs + (t >> 1) - gi + 7)) * 31 + 15 - qcol;
#pragma unroll
            for (int j = 0; j < 4; ++j) { const int kcol = kc0 + (t & 1) * 16 + 4 * g + j; const bool ok = kcol >= wsq && kcol < wsq + 16;
                const float v = ok ? s[t][j] + bp[ok ? kcol : qcol] : -INFINITY; s[t][j] = v; mx = fmaxf(mx, v); } }
        mx = fmaxf(mx, __shfl_xor(mx, 16)); mx = fmaxf(mx, __shfl_xor(mx, 32));
        m_run = mx;
        float ls = 0.f;
#pragma unroll
        for (int t = 0; t < 16; ++t)
#pragma unroll
            for (int j = 0; j < 4; ++j) { const float p = __expf(s[t][j] - mx); s[t][j] = p; ls += p; }
        l_run = ls;
#pragma unroll
        for (int r8 = 0; r8 < 8; ++r8) {
            { LAS unsigned char* wr = WV + vr * 128; const int sw = (vr >> 1) & 3;
              *(LAS u32x4*)(wr + (((2 * part) ^ sw) * 32)) = vbuf[r8 & 3][0]; *(LAS u32x4*)(wr + (((2 * part) ^ sw) * 32) + 16) = vbuf[r8 & 3][1];
              *(LAS u32x4*)(wr + (((2 * part + 1) ^ sw) * 32)) = vbuf[r8 & 3][2]; *(LAS u32x4*)(wr + (((2 * part + 1) ^ sw) * 32) + 16) = vbuf[r8 & 3][3];
              if (r8 + 4 < 8) { const bf16_t* vp = vbase + (size_t)(r8 + 4) * 64 * INW;
                  vbuf[r8 & 3][0] = *(const u32x4*)vp; vbuf[r8 & 3][1] = *(const u32x4*)(vp + 8); vbuf[r8 & 3][2] = *(const u32x4*)(vp + 16); vbuf[r8 & 3][3] = *(const u32x4*)(vp + 24); } }
            __builtin_amdgcn_wave_barrier(); asm volatile("" ::: "memory");
            const bf16x8 pf = na_pack8(s[2 * r8], s[2 * r8 + 1]);
#pragma unroll
            for (int dt = 0; dt < 4; ++dt) { const bf16x8 vf = na_vfrag(WV, lane, dt); acc[dt] = __builtin_amdgcn_mfma_f32_16x16x32_bf16(vf, pf, acc[dt], 0, 0, 0); }
            __builtin_amdgcn_wave_barrier(); asm volatile("" ::: "memory");
        }
    }
    {
        f32x4 s[16];
#pragma unroll
        for (int t = 0; t < 16; ++t) { const int key = 16 * t + ql; const LAS unsigned char* kr = CK + key * 128;
            const bf16x8 k0 = *(const LAS bf16x8*)(kr + ((g ^ (key & 7)) * 16)), k1 = *(const LAS bf16x8*)(kr + (((g + 4) ^ (key & 7)) * 16));
            s[t] = __builtin_amdgcn_mfma_f32_16x16x32_bf16(k0, Qf[0], (f32x4){0.f, 0.f, 0.f, 0.f}, 0, 0, 0);
            s[t] = __builtin_amdgcn_mfma_f32_16x16x32_bf16(k1, Qf[1], s[t], 0, 0, 0); }
        float mx = m_run;
#pragma unroll
        for (int t = 0; t < 16; ++t)
#pragma unroll
            for (int j = 0; j < 4; ++j) mx = fmaxf(mx, s[t][j]);
        mx = fmaxf(mx, __shfl_xor(mx, 16)); mx = fmaxf(mx, __shfl_xor(mx, 32));
        const float alpha = __expf(m_run - mx);
        float ls = l_run * alpha;
#pragma unroll
        for (int dt = 0; dt < 4; ++dt) acc[dt] *= alpha;
#pragma unroll
        for (int t = 0; t < 16; ++t)
#pragma unroll
            for (int j = 0; j < 4; ++j) { const float p = __expf(s[t][j] - mx); s[t][j] = p; ls += p; }
        l_run = ls;
#pragma unroll
        for (int blk = 0; blk < 8; ++blk) { const bf16x8 pf = na_pack8(s[2 * blk], s[2 * blk + 1]);
#pragma unroll
            for (int dt = 0; dt < 4; ++dt) { const bf16x8 vf = na_vfrag(CV + blk * 4096, lane, dt); acc[dt] = __builtin_amdgcn_mfma_f32_16x16x32_bf16(vf, pf, acc[dt], 0, 0, 0); } }
    }
    float lt = l_run; lt += __shfl_xor(lt, 16); lt += __shfl_xor(lt, 32);
    const float inv = 1.0f / lt;
    { LAS unsigned char* ot = WKq + 2304;
#pragma unroll
      for (int dt = 0; dt < 4; ++dt) { u32x2 w; w.x = cvt_pk_bf16(acc[dt][0] * inv, acc[dt][1] * inv); w.y = cvt_pk_bf16(acc[dt][2] * inv, acc[dt][3] * inv); *(LAS u32x2*)(ot + ql * 144 + dt * 32 + g * 8) = w; }
      __builtin_amdgcn_wave_barrier(); asm volatile("" ::: "memory");
      const int rr = lane >> 3, pc = lane & 7;
      const u32x4 o0 = *(const LAS u32x4*)(ot + rr * 144 + pc * 16), o1 = *(const LAS u32x4*)(ot + (rr + 8) * 144 + pc * 16);
      __builtin_amdgcn_wave_barrier(); asm volatile("" ::: "memory");
      bf16_t* op = MIX + (size_t)(qrow0 + rr) * D + h * 64 + 8 * pc;
      *(u32x4*)op = o0; *(u32x4*)(op + (size_t)8 * D) = o1; }
}
__device__ __forceinline__ void phase_na_mfma(const Frame& F, const Params& P, int l, bool ctx_queries) {
    const bf16_t* PL = (const bf16_t*)(F.ws + WS_PL); bf16_t* MIX = (bf16_t*)(F.ws + WS_MIX);
    int tid_ = F.tid; asm volatile("" : "+v"(tid_));
    const int tid = tid_;
    { const float* rpb = P.in[I_RPB] + (size_t)l * 8 * 15 * 31; LAS float* R = (LAS float*)(F.lds + NA_RPB); for (int i = tid; i < 8 * 15 * 31; i += NTHREADS) R[i] = rpb[i]; }
    const int nfull = (512 / F.G) * F.G, nwork = nfull + (512 - nfull) * 4;
    for (int w = F.bid; w < nwork; w += F.G) {
        const int unit = w < nfull ? w : nfull + ((w - nfull) >> 2), q4 = w < nfull ? -1 : ((w - nfull) & 3);
        const int eighth = unit & 7, h = (unit >> 3) & 7, b = unit >> 6;
        __syncthreads();
        { int t2 = tid; asm volatile("" : "+v"(t2)); const int key = t2 >> 1, part = t2 & 1; const bf16_t* kp = PL + (size_t)(NLAT + b * CTXL + key) * INW + O_K + h * 64 + part * 32; const bf16_t* vp = kp + (O_V - O_K);
          LAS unsigned char* kr = F.lds + NA_CK + key * 128; LAS unsigned char* vr = F.lds + NA_CV + key * 128; const int sw = (key >> 1) & 3;
#pragma unroll
          for (int c = 0; c < 4; ++c) { *(LAS u32x4*)(kr + (((4 * part + c) ^ (key & 7)) * 16)) = *(const u32x4*)(kp + 8 * c);
              const int c16 = 4 * part + c; *(LAS u32x4*)(vr + (((c16 >> 1) ^ sw) * 32) + (c16 & 1) * 16) = *(const u32x4*)(vp + 8 * c); } }
        __syncthreads();
        const int it0 = q4 < 0 ? 0 : q4 * 8, it1 = q4 < 0 ? 32 : it0 + 8;
        for (int it = it0 + F.wave; it < it1; it += NWAVES) { const int gi = eighth * 8 + (it >> 2), cb = it & 3;
            na_item<true>(F, PL, MIX, b, h, b * SEQ + gi * 64 + cb * 16, gi, cb); }
        if (ctx_queries && F.wave < 2 && q4 <= 0) na_item<false>(F, PL, MIX, b, h, NLAT + b * CTXL + (eighth * 2 + F.wave) * 16, 0, 0);
    }
}

__device__ __forceinline__ void phase_final(const Frame& F, const Params& P) {
    float* out = P.out; const float* g = P.in[I_FINALG]; const int lane = F.lane;
    const bf16_t* YM = (const bf16_t*)(F.ws + WS_YM); const int* tsl = (const int*)(F.ws + WS_ROUTE + RT_RMAP); const float* tg = (const float*)(F.ws + WS_ROUTE + RT_TOKG);
    const float* g2v = (const float*)(F.ws + WS_MODV) + (size_t)9 * MODW + 5 * D;
    const int RB = ((NLAT + F.G - 1) / F.G + 7) & ~7, rbeg = F.bid * RB, rend = min(rbeg + RB, NLAT);
    f32x4 xn[4], gG[4], gF[4]; u32x2 an[4], bn[4]; float w0n, w1n; int cur_b = -1;
#pragma unroll
    for (int j = 0; j < 4; ++j) gF[j] = *(const f32x4*)(g + j * 256 + lane * 4);
    { const int r = rbeg + F.wave < rend ? rbeg + F.wave : 0; const bf16_t* y0 = YM + (size_t)tsl[r * 2] * D; const bf16_t* y1 = YM + (size_t)tsl[r * 2 + 1] * D; w0n = tg[r * 2]; w1n = tg[r * 2 + 1];
#pragma unroll
      for (int j = 0; j < 4; ++j) { const int c = j * 256 + lane * 4; xn[j] = *(const f32x4*)(out + (size_t)r * D + c); an[j] = *(const u32x2*)(y0 + c); bn[j] = *(const u32x2*)(y1 + c); } }
    for (int r = rbeg + F.wave; r < rend; r += 8) {
        float* xr = out + (size_t)r * D; const float w0 = w0n, w1 = w1n;
        if ((r >> 12) != cur_b) { cur_b = r >> 12; const float* gv = g2v + (size_t)cur_b * MODW;
#pragma unroll
            for (int j = 0; j < 4; ++j) gG[j] = *(const f32x4*)(gv + j * 256 + lane * 4); }
        f32x4 x[4]; u32x2 ac[4], bc[4]; float ss = 0.f;
#pragma unroll
        for (int j = 0; j < 4; ++j) { x[j] = xn[j]; ac[j] = an[j]; bc[j] = bn[j]; }
        { const int rn = r + 8 < rend ? r + 8 : r; const bf16_t* y0 = YM + (size_t)tsl[rn * 2] * D; const bf16_t* y1 = YM + (size_t)tsl[rn * 2 + 1] * D; w0n = tg[rn * 2]; w1n = tg[rn * 2 + 1];
#pragma unroll
          for (int j = 0; j < 4; ++j) { const int c = j * 256 + lane * 4; xn[j] = *(const f32x4*)(out + (size_t)rn * D + c); an[j] = *(const u32x2*)(y0 + c); bn[j] = *(const u32x2*)(y1 + c); } }
#pragma unroll
        for (int j = 0; j < 4; ++j) {
            const u32x2 a = ac[j], b = bc[j]; const f32x4 gg = gG[j];
            float ya[4], yb[4]; unpack4(a, ya); unpack4(b, yb);
#pragma unroll
            for (int q = 0; q < 4; ++q) x[j][q] += gg[q] * (w0 * ya[q] + w1 * yb[q]);
            ss += x[j][0] * x[j][0] + x[j][1] * x[j][1] + x[j][2] * x[j][2] + x[j][3] * x[j][3]; }
        ss = wave_sum(ss); const float rstd = rsqrtf(ss * (1.0f / D) + 1e-6f);
#pragma unroll
        for (int j = 0; j < 4; ++j) *(f32x4*)(xr + j * 256 + lane * 4) = x[j] * rstd * gF[j];
    }
}

constexpr int PH_L0 = 1, PH_PER_L0 = 9, PH_L1 = PH_L0 + PH_PER_L0, PH_PER_L1 = 10, PH_FINAL = PH_L1 + PH_PER_L1, N_PHASES = PH_FINAL + 1;
#define RFL(x) __builtin_amdgcn_readfirstlane(x)

PHASE ph_prologue(const void* kp_, int wv_) { PHASE_ENTER; if constexpr (MKB(0)) phase_prologue(F, P); }
PHASE ph_norm1(const void* kp_, int wv_, int l_) { PHASE_ENTER; const int l = RFL(l_);
    if constexpr (MKB(1)) phase_norm<false>(F, P, l, 0, NROW, l == 0 ? P.in[I_X] : P.out, l == 0 ? P.in[I_CTX] : (const float*)(F.ws + WS_XC)); }
PHASE_INL ph_gemm_win(const void* kp_, int wv_, int l_) { PHASE_ENTER; const int l = RFL(l_);
    pg8::DenseSched S; S.init(NROW / 256, INW / 256, F.G, F.bid); S.A = (const bf16_t*)(F.ws + WS_HL); S.Bt = (const bf16_t*)(F.ws + WS_BTIN) + (size_t)l * INW * D; S.K = D;
    pg8::EpiBf16 E{(bf16_t*)(F.ws + WS_PL), INW, 2, 0.125f};
    if constexpr (MKB(2)) pg8::gemm_phase<pg8::EpiBf16, pg8::DenseSched, false>(F.lds, D, S, E, F.wave); }
PHASE_INL ph_rw_prep(const void* kp_, int wv_, int l_) { PHASE_ENTER; const int l = RFL(l_); if constexpr (MKB(3)) phase_rw_prep(F, P, l); }
PHASE ph_conv(const void* kp_, int wv_, int l_, int bid_, int G_) { PHASE_ENTER; const int l = RFL(l_); if constexpr (MKB(4)) phase_conv(sub_frame(F, RFL(bid_), RFL(G_)), P, l, l == 0 ? NROW : NLAT); }
PHASE_INL ph_na(const void* kp_, int wv_, int l_, int bid_, int G_) { PHASE_ENTER; const int l = RFL(l_); if constexpr (MKB(5)) phase_na_mfma(sub_frame(F, RFL(bid_), RFL(G_)), P, l, l == 0); }
PHASE_INL ph_scan(const void* kp_, int wv_, int bid_, int G_) { PHASE_ENTER; if constexpr (MKB(6)) phase_scan(sub_frame(F, RFL(bid_), RFL(G_))); }
PHASE_INL ph_rw_post(const void* kp_, int wv_, int l_) { PHASE_ENTER; const int l = RFL(l_); if constexpr (MKB(7)) phase_rw_post(F, P, l, l == 0 ? NROW : NLAT); }
PHASE_INL ph_gemm_wout(const void* kp_, int wv_, int l_) { PHASE_ENTER; const int l = RFL(l_);
    float* XC = (float*)(F.ws + WS_XC);
    pg8::DenseSched S; S.init((l == 0 ? NROW : NLAT) / 256, D / 256, F.G, F.bid); S.A = (const bf16_t*)(F.ws + WS_MIX); S.Bt = (const bf16_t*)(F.ws + WS_BTOUT) + (size_t)l * D * D; S.K = D; S.split_tail();
    pg8::EpiRes E{l == 0 ? P.in[I_X] : P.out, l == 0 ? P.in[I_CTX] : XC, P.out, XC, (const float*)(F.ws + WS_MODV) + (size_t)l * 9 * MODW + 2 * D};
    if constexpr (MKB(8)) pg8::gemm_phase<pg8::EpiRes, pg8::DenseSched, false>(F.lds, D, S, E, F.wave); }
PHASE ph_norm2_l0(const void* kp_, int wv_) { PHASE_ENTER; if constexpr (MKB(9)) phase_norm<false>(F, P, 0, 1, NROW, P.out, (const float*)(F.ws + WS_XC)); }
PHASE_INL ph_gemm_ffn_gu(const void* kp_, int wv_) { PHASE_ENTER;
    pg8::DenseSched S; S.init(NROW / 256, (2 * DFF) / 256, F.G, F.bid); S.A = (const bf16_t*)(F.ws + WS_HL); S.Bt = (const bf16_t*)(F.ws + WS_BTGU); S.K = D;
    pg8::EpiSwiGLU8T<true> E{F.ws + WS_H, DFF, 1.0f};
    if constexpr (MKB(10)) pg8::gemm_phase<pg8::EpiSwiGLU8T<true>, pg8::DenseSched, false>(F.lds, D, S, E, F.wave); }
PHASE_INL ph_gemm_ffn_dn(const void* kp_, int wv_) { PHASE_ENTER;
    float* XC = (float*)(F.ws + WS_XC);
    pg8::DenseSched S; S.init(NROW / 256, D / 256, F.G, F.bid); S.A = (const bf16_t*)(F.ws + WS_H); S.Bt = (const bf16_t*)(F.ws + WS_BTDN); S.K = DFF / 2; S.split_tail();
    pg8::EpiRes E{P.out, XC, P.out, XC, (const float*)(F.ws + WS_MODV) + 5 * D, 1.0f / FFN8_DN_SCALE};
    if constexpr (MKB(11)) pg8::gemm_phase<pg8::EpiRes, pg8::DenseSched, false, true>(F.lds, DFF / 2, S, E, F.wave); }
PHASE ph_norm2_l1(const void* kp_, int wv_) { PHASE_ENTER; if constexpr (MKB(12)) phase_norm<true>(F, P, 1, 1, NLAT, P.out, (const float*)(F.ws + WS_XC)); }
PHASE ph_moe_prep(const void* kp_, int wv_) { PHASE_ENTER; if constexpr (MKB(13)) { phase_moe_rowmap(F); phase_moe_convert(F, P); } }
PHASE_INL ph_gemm_moe_gu(const void* kp_, int wv_) { PHASE_ENTER;
    pg8::MoeSched S; { int ts0[9], ts1[9]; moe_tstart(F, 0, ts0); moe_tstart(F, 1, ts1); S.set_tstart(ts0, ts1); S.init(RFL(ts0[8] + ts1[8]), (2 * DFE) / 256, F.G, F.bid); }
    S.A = (const bf16_t*)(F.ws + WS_HLG); S.Bt0 = F.ws + WS_MOE; S.K = D / 2;
    pg8::EpiSwiGLU8T<false> E{F.ws + WS_H, DFE, 1.0f / MOE8_GU_SCALE};
    if constexpr (MKB(14)) pg8::gemm_phase<pg8::EpiSwiGLU8T<false>, pg8::MoeSched, false, true>(F.lds, D / 2, S, E, F.wave); }
PHASE_INL ph_gemm_moe_dn(const void* kp_, int wv_) { PHASE_ENTER;
    pg8::MoeSched S; { int ts0[9], ts1[9]; moe_tstart(F, 0, ts0); moe_tstart(F, 1, ts1); S.set_tstart(ts0, ts1); S.init(RFL(ts0[8] + ts1[8]), D / 256, F.G, F.bid); }
    S.A = (const bf16_t*)(F.ws + WS_H); S.Bt0 = F.ws + WS_MOE + MOE8_GU_BYTES; S.K = DFE / 2; S.split_tail();
    pg8::EpiMoeY E{(bf16_t*)(F.ws + WS_YM), 1.0f / MOE8_DN_SCALE};
    if constexpr (MKB(15)) pg8::gemm_phase<pg8::EpiMoeY, pg8::MoeSched, false, true>(F.lds, DFE / 2, S, E, F.wave); }
PHASE ph_final(const void* kp_, int wv_) { PHASE_ENTER; if constexpr (MKB(16)) phase_final(F, P); }

static __attribute__((noinline)) __device__ void grid_barrier(const void* bar_, unsigned x_, int wv_) {
    const unsigned long long v = (unsigned long long)bar_;
    const unsigned lo = __builtin_amdgcn_readfirstlane((unsigned)v), hi = __builtin_amdgcn_readfirstlane((unsigned)(v >> 32));
    XcdBarrier b; b.bar = (unsigned*)(((unsigned long long)hi << 32) | lo); b.x = __builtin_amdgcn_readfirstlane(x_);
    b.st = (volatile LAS unsigned*)((LAS unsigned char*)lds_raw + LDS_MISC);
    xcd_barrier(b, __builtin_amdgcn_readfirstlane(wv_) * 64 + lane_id());
}
#if TS_MASK
constexpr int CW_TS = 8192;
static __attribute__((noinline)) __device__ void ts_mark(const void* bar_, int idx_, int wv_) {
    if (blockIdx.x == 0 && wv_ == 0 && lane_id() == 0) { volatile unsigned long long* ts = (volatile unsigned long long*)((unsigned*)bar_ - CW_BAR + CW_TS); ts[idx_] = __builtin_amdgcn_s_memrealtime(); }
}
static __attribute__((noinline)) __device__ void ts_side(const void* bar_, int idx_, int wv_) {
    if (wv_ == 0 && lane_id() == 0) { unsigned long long* ts = (unsigned long long*)((unsigned*)bar_ - CW_BAR + CW_TS); atomicMax(ts + 32 + idx_, (unsigned long long)__builtin_amdgcn_s_memrealtime()); }
}
static __attribute__((noinline)) __device__ void ts_spin(const void* bar_, int wv_) {
    if (blockIdx.x == 0 && wv_ == 0 && lane_id() == 0) { volatile unsigned long long* ts = (volatile unsigned long long*)((unsigned*)bar_ - CW_BAR + CW_TS);
        unsigned long long sum = 0;
        for (int k = 0; k < 23; ++k) if ((TS_MASK >> k) & 1) sum += ts[k + 1] - ts[k];
        if ((TS_SIDE >> 4) & 1) sum += ts[40];
        for (int k = 0; k < 4; ++k) if ((TS_SIDE >> k) & 1) sum += ts[32 + k] - ts[(k >> 1) == 0 ? PH_L0 + 3 : PH_L1 + 3];
        const unsigned long long t0 = __builtin_amdgcn_s_memrealtime();
        while (__builtin_amdgcn_s_memrealtime() - t0 < sum * TS_MULT) __builtin_amdgcn_s_sleep(32); }
}
#endif
__device__ __forceinline__ bool ph_in(int lo, int hi, int k) { asm volatile("" : "+s"(lo), "+s"(hi)); return lo <= k && k < hi; }

__global__ void __launch_bounds__(NTHREADS, 2) mk_fwd(Params P) {
    const void* kp = (const void*)__builtin_amdgcn_kernarg_segment_ptr();
    LAS unsigned char* lds = (LAS unsigned char*)lds_raw;
    volatile LAS unsigned* misc = (volatile LAS unsigned*)(lds + LDS_MISC);
    const int wv = __builtin_amdgcn_readfirstlane((int)(threadIdx.x >> 6));
    if (wv == 0 && lane_id() < 4) misc[lane_id()] = 0u;
    __syncthreads();
    const int lo = P.ph_lo, hi = P.ph_hi;
    XcdBarrier bar; bar.bar = (unsigned*)(P.ws + WS_CTL) + CW_BAR; bar.x = 0; bar.st = misc;
    if (hi - lo > 1) bar = xcd_barrier_post((unsigned*)(P.ws + WS_CTL) + CW_BAR, misc, wv * 64 + lane_id());
#define IN(k) ph_in(lo, hi, (k))
#if TS_MASK
#define TS_SIDE_MARK(i) ts_side((const void*)bar.bar, (i), wv)
#define SEAM(k) do { if (IN((k) + 1)) grid_barrier((const void*)bar.bar, bar.x, wv); ts_mark((const void*)bar.bar, (k) + 1, wv); } while (0)
    ts_mark((const void*)bar.bar, 0, wv);
#else
#define TS_SIDE_MARK(i) do { } while (0)
#define SEAM(k) do { if (IN((k) + 1)) grid_barrier((const void*)bar.bar, bar.x, wv); } while (0)
#endif
    if (IN(0)) { for (int rep = 0; rep < REP_PRO; ++rep) ph_prologue(kp, wv); SEAM(0); }
#define LAYER_COMMON(l, pb) \
    if (IN((pb) + 0)) { for (int rep = 0; rep < REP_NORM; ++rep) ph_norm1(kp, wv, (l)); SEAM((pb) + 0); } \
    if (IN((pb) + 1)) { for (int rep = 0; rep < REP_GEMM; ++rep) ph_gemm_win(kp, wv, (l)); SEAM((pb) + 1); } \
    if (IN((pb) + 2)) { for (int rep = 0; rep < REP_PP; ++rep) ph_rw_prep(kp, wv, (l)); SEAM((pb) + 2); } \
    if (IN((pb) + 3)) { const int bx = (int)blockIdx.x, Gx = (int)gridDim.x; \
        if (Gx == 256) { if (bx < 64) { for (int rep = 0; rep < REP_SCAN; ++rep) ph_scan(kp, wv, bx, 64); TS_SIDE_MARK(2 * (l)); } \
            else { for (int rep = 0; rep < REP_CONV; ++rep) ph_conv(kp, wv, (l), bx - 64, 192); for (int rep = 0; rep < REP_NA; ++rep) ph_na(kp, wv, (l), bx - 64, 192); TS_SIDE_MARK(2 * (l) + 1); } } \
        else { ph_conv(kp, wv, (l), bx, Gx); ph_na(kp, wv, (l), bx, Gx); ph_scan(kp, wv, bx, Gx); } SEAM((pb) + 3); } \
    if (IN((pb) + 4)) { for (int rep = 0; rep < REP_POST; ++rep) ph_rw_post(kp, wv, (l)); SEAM((pb) + 4); } \
    if (IN((pb) + 5)) { ph_gemm_wout(kp, wv, (l)); SEAM((pb) + 5); }
    LAYER_COMMON(0, PH_L0)
    if (IN(PH_L0 + 6)) { ph_norm2_l0(kp, wv); SEAM(PH_L0 + 6); }
    if (IN(PH_L0 + 7)) { for (int rep = 0; rep < REP_GEMM; ++rep) ph_gemm_ffn_gu(kp, wv); SEAM(PH_L0 + 7); }
    if (IN(PH_L0 + 8)) { ph_gemm_ffn_dn(kp, wv); SEAM(PH_L0 + 8); }
    LAYER_COMMON(1, PH_L1)
    if (IN(PH_L1 + 6)) { ph_norm2_l1(kp, wv); SEAM(PH_L1 + 6); }
    if (IN(PH_L1 + 7)) { for (int rep = 0; rep < REP_PRO; ++rep) ph_moe_prep(kp, wv); SEAM(PH_L1 + 7); }
    { int wvp = wv; asm volatile("" : "+s"(wvp));
      if (IN(PH_L1 + 8)) { for (int rep = 0; rep < REP_GEMM; ++rep) ph_gemm_moe_gu(kp, wvp); SEAM(PH_L1 + 8); }
      asm volatile("" : "+s"(wvp));
      if (IN(PH_L1 + 9)) { ph_gemm_moe_dn(kp, wvp); SEAM(PH_L1 + 9); } }
#undef LAYER_COMMON
    if (IN(PH_FINAL)) ph_final(kp, wv);
#if TS_MASK
    ts_mark((const void*)bar.bar, 23, wv); ts_spin((const void*)bar.bar, wv);
#endif
#undef IN
#undef SEAM
}

extern "C" void kernel_launch(void* const* d_in, const int* in_sizes, int n_in, void* d_out, int out_size, void* d_ws, size_t ws_size, hipStream_t stream) {
    static int grid = 0;
    if (grid == 0) {
        if (n_in != 35 || out_size != NLAT * D || ws_size < WS_END) { fprintf(stderr, "kernel_launch: unexpected shapes (n_in %d out %d ws %zu need %zu)\n", n_in, out_size, ws_size, (size_t)WS_END); grid = -1; return; }
        int dev = 0, cus = 0, per_cu = 0;
        if (hipGetDevice(&dev) != hipSuccess || hipDeviceGetAttribute(&cus, hipDeviceAttributeMultiprocessorCount, dev) != hipSuccess) { grid = -1; return; }
        if (hipFuncSetAttribute((const void*)mk_fwd, hipFuncAttributeMaxDynamicSharedMemorySize, LDS_BYTES) != hipSuccess) { fprintf(stderr, "kernel_launch: hipFuncSetAttribute failed\n"); grid = -1; return; }
        if (hipOccupancyMaxActiveBlocksPerMultiprocessor(&per_cu, (const void*)mk_fwd, NTHREADS, LDS_BYTES) != hipSuccess || per_cu < 1) { fprintf(stderr, "kernel_launch: occupancy query says %d\n", per_cu); (void)hipGetLastError(); }
        grid = cus > 256 ? 256 : cus;
    }
    if (grid < 0) return;
    (void)hipMemsetAsync((char*)d_ws + WS_CTL, 0, CTL_BYTES, stream);
    Params p{};
    for (int i = 0; i < 35; ++i) p.in[i] = (const float*)d_in[i];
    p.out = (float*)d_out; p.ws = (unsigned char*)d_ws;
#if MK_ONE_LAUNCH
    p.ph_lo = 0; p.ph_hi = N_PHASES;
    hipLaunchKernelGGL(mk_fwd, dim3(grid), dim3(NTHREADS), LDS_BYTES, stream, p);
#else
    for (int k = 0; k < N_PHASES && k <= MK_LAST; ++k) { p.ph_lo = k; p.ph_hi = k + 1; hipLaunchKernelGGL(mk_fwd, dim3(grid), dim3(NTHREADS), LDS_BYTES, stream, p); }
#endif
}
```
